# Optimizing an MI355X kernel written in HIP

```python
import numpy as np
import jax
import jax.numpy as jnp
from jax import lax

D_MODEL = 1024
BATCH = 8
SEQ = 2048
DEPTH = 4

MEM_LEN = 256
HEAD_DIM = 64
N_MIXERS = 4
MIX_W = 256
Q_BLOCK = 128

NSA_HEADS = 4
NSA_KV_HEADS = 2
NSA_GROUP = NSA_HEADS // NSA_KV_HEADS
CMP_LEN = 32
CMP_STRIDE = 16
CMP_HID = 256
SEL_BLOCK = 64
SEL_TOPK = 8
WINDOW = 512
FORCE_SCORE = 1e4

SB_HEADS = 4

RNN_W = 256
RNN_BLOCKS = 4
RNN_BW = RNN_W // RNN_BLOCKS
CONV_W = 4
LRU_C = 8.0

MLA_HEADS = 4
MLA_Q_RANK = 192
MLA_KV_RANK = 128
MLA_NOPE = 64
MLA_ROPE = 32
MLA_V = 64
ROPE_THETA = 10000.0

X_HEADS = 4
X_HEAD_DIM = 128

N_GROUPS = 4
EXPERTS_PER_GROUP = 8
N_EXPERTS = N_GROUPS * EXPERTS_PER_GROUP
TOPK_IN_GROUP = 2
D_EXPERT = 512
EXPERT_CHUNK = 256

DN_ALPHA = (2.0 * DEPTH) ** 0.25
DN_BETA = (8.0 * DEPTH) ** -0.25
LN_EPS = 1e-5
RMS_EPS = 1e-6

IN_SPLITS = ((NSA_HEADS * HEAD_DIM,) + (NSA_KV_HEADS * HEAD_DIM,) * 6 + (NSA_HEADS * 3,)
             + (SB_HEADS * HEAD_DIM,) * 3
             + (RNN_W, RNN_W)
             + (MLA_Q_RANK, MLA_KV_RANK, MLA_ROPE)
             + (N_MIXERS * D_MODEL,))
IN_OFFSETS = tuple(int(o) for o in np.concatenate([[0], np.cumsum(IN_SPLITS)[:-1]]))
N_IN = sum(IN_SPLITS)

kernel_name = 'hybrid_nsa_sb_rglru_mla_hmoe_deepnorm'


def layer_norm(x, g, b):
    xf = x.astype(jnp.float32)
    mu = jnp.mean(xf, -1, keepdims=True)
    var = jnp.mean(jnp.square(xf - mu), -1, keepdims=True)
    return ((xf - mu) * lax.rsqrt(var + LN_EPS) * g + b).astype(x.dtype)


def rms_norm(x, g):
    xf = x.astype(jnp.float32)
    return (xf * lax.rsqrt(jnp.mean(jnp.square(xf), -1, keepdims=True) + RMS_EPS) * g).astype(x.dtype)


def masked_softmax(s, mask):
    s = jnp.where(mask, s.astype(jnp.float32), -jnp.inf)
    m = jnp.max(s, -1, keepdims=True)
    p = jnp.exp(s - jnp.where(jnp.isfinite(m), m, 0.0))
    return p / jnp.maximum(jnp.sum(p, -1, keepdims=True), 1e-30)


def alibi_slopes(n):
    return 2.0 ** (-8.0 * jnp.arange(1, n + 1, dtype=jnp.float32) / n)


def rope(x, pos):
    d = x.shape[-1]
    inv = ROPE_THETA ** (-jnp.arange(0, d, 2, dtype=jnp.float32) / d)
    ang = pos.astype(jnp.float32)[:, None] * inv[None, :]
    cos, sin = jnp.cos(ang)[:, None, :], jnp.sin(ang)[:, None, :]
    xf = x.astype(jnp.float32)
    x1, x2 = xf[..., : d // 2], xf[..., d // 2:]
    return jnp.concatenate([x1 * cos - x2 * sin, x1 * sin + x2 * cos], -1).astype(x.dtype)


def q_blocks(t):
    b, s = t.shape[:2]
    return jnp.moveaxis(t.reshape(b, s // Q_BLOCK, Q_BLOCK, *t.shape[2:]), 1, 0)


def unblock(t):
    nq, b, q = t.shape[:3]
    return jnp.moveaxis(t, 0, 1).reshape(b, nq * q, *t.shape[3:])


def nsa_attention(q, k_cmp, v_cmp, k_sel, v_sel, k_win, v_win, gate_logits, cmp_pos, cmp_w1, cmp_w2):
    B, S, H, dh = q.shape
    G = k_cmp.shape[2]
    f32 = jnp.float32
    scale = dh ** -0.5
    slopes = alibi_slopes(H).reshape(G, NSA_GROUP)
    t_pos = jnp.arange(S)
    nq = S // Q_BLOCK
    qpos = t_pos.reshape(nq, Q_BLOCK)
    qg = q.reshape(B, S, G, NSA_GROUP, dh)

    n_cmp = (S - CMP_LEN) // CMP_STRIDE + 1
    blk_idx = jnp.asarray(np.arange(n_cmp)[:, None] * CMP_STRIDE + np.arange(CMP_LEN)[None, :], jnp.int32)

    def compress(t, j):
        tb = t[:, blk_idx] + cmp_pos[j][None, None, :, None, :]
        tb = jnp.moveaxis(tb, 3, 2).reshape(B, n_cmp, G, CMP_LEN * dh)
        hid = jax.nn.gelu(jnp.einsum('bcgf,fh->bcgh', tb, cmp_w1[j]))
        return jnp.einsum('bcgh,hd->bcgd', hid, cmp_w2[j])

    kc, vc = compress(k_cmp, 0), compress(v_cmp, 1)
    blk_end = jnp.arange(n_cmp) * CMP_STRIDE + CMP_LEN - 1
    dist_c = (t_pos[:, None] - blk_end[None, :]).astype(f32)
    s_c = jnp.einsum('bsgnd,bcgd->bgnsc', qg, kc).astype(f32) * scale - slopes[None, :, :, None, None] * dist_c
    p_c = masked_softmax(s_c, dist_c >= 0)
    o_c = jnp.einsum('bgnsc,bcgd->bsgnd', p_c.astype(vc.dtype), vc)

    n_sel = S // SEL_BLOCK
    c0 = np.arange(n_cmp)[:, None] * CMP_STRIDE
    j0 = np.arange(n_sel)[None, :] * SEL_BLOCK
    cover = np.clip(np.minimum(c0 + CMP_LEN, j0 + SEL_BLOCK) - np.maximum(c0, j0), 0, None) / CMP_LEN
    imp = jnp.einsum('bgnsc,cj->bgsj', p_c, jnp.asarray(cover, f32))
    blk = jnp.arange(n_sel)[None, :]
    forced = (blk == 0) | (blk == (t_pos // SEL_BLOCK)[:, None])
    valid = blk * SEL_BLOCK <= t_pos[:, None]
    imp = jnp.where(forced, FORCE_SCORE, jnp.where(valid, imp, -1.0))
    n_top = min(SEL_TOPK, n_sel)
    _, sel_idx = lax.top_k(imp, n_top)

    kbt = jnp.moveaxis(k_sel.reshape(B, n_sel, SEL_BLOCK, G, dh), 3, 1)
    vbt = jnp.moveaxis(v_sel.reshape(B, n_sel, SEL_BLOCK, G, dh), 3, 1)
    bi = jnp.arange(B)[:, None, None, None]
    gi = jnp.arange(G)[None, :, None, None]
    n_keys = n_top * SEL_BLOCK

    def selected_block(args):
        qb, idx, qp = args
        kb = kbt[bi, gi, idx].reshape(B, G, Q_BLOCK, n_keys, dh)
        vb = vbt[bi, gi, idx].reshape(B, G, Q_BLOCK, n_keys, dh)
        kpos = (idx[..., None] * SEL_BLOCK + jnp.arange(SEL_BLOCK)).reshape(B, G, Q_BLOCK, n_keys)
        dist = (qp[None, None, :, None] - kpos).astype(f32)[:, :, None]
        s = jnp.einsum('bqgnd,bgqkd->bgnqk', qb, kb).astype(f32) * scale - slopes[None, :, :, None, None] * dist
        p = masked_softmax(s, dist >= 0)
        return jnp.einsum('bgnqk,bgqkd->bqgnd', p.astype(vb.dtype), vb)

    sel_blocks = jnp.moveaxis(sel_idx.reshape(B, G, nq, Q_BLOCK, n_top), 2, 0)
    o_s = unblock(lax.map(selected_block, (q_blocks(qg), sel_blocks, qpos)))

    band = Q_BLOCK + WINDOW
    band_np = np.arange(nq)[:, None] * Q_BLOCK + np.arange(band)[None, :]
    band_idx = jnp.asarray(band_np, jnp.int32)
    kpos_w = jnp.asarray(band_np - WINDOW, jnp.int32)
    pad = ((0, 0), (WINDOW, 0), (0, 0), (0, 0))
    kw = jnp.pad(k_win, pad)[:, band_idx]
    vw = jnp.pad(v_win, pad)[:, band_idx]
    dist_w = qpos[:, :, None] - kpos_w[:, None, :]
    mask_w = (dist_w >= 0) & (dist_w < WINDOW) & (kpos_w[:, None, :] >= 0)
    qw = qg.reshape(B, nq, Q_BLOCK, G, NSA_GROUP, dh)
    s_w = (jnp.einsum('bqtgnd,bqkgd->bgnqtk', qw, kw).astype(f32) * scale
           - slopes[None, :, :, None, None, None] * dist_w.astype(f32))
    p_w = masked_softmax(s_w, mask_w)
    o_w = jnp.einsum('bgnqtk,bqkgd->bqtgnd', p_w.astype(vw.dtype), vw).reshape(B, S, G, NSA_GROUP, dh)

    g = jax.nn.sigmoid(gate_logits.astype(f32)).reshape(B, S, G, NSA_GROUP, 3).astype(q.dtype)
    o = g[..., 0:1] * o_c + g[..., 1:2] * o_s + g[..., 2:3] * o_w
    return o.reshape(B, S, H * dh)


def stick_breaking_attention(q, k, v):
    B, S, H, dh = q.shape
    scale = dh ** -0.5
    key_pos = jnp.arange(S)

    def block(args):
        qb, qp = args
        z = jnp.einsum('bqhd,bkhd->bhqk', qb, k).astype(jnp.float32) * scale
        strict = key_pos[None, :] < qp[:, None]
        log_1m = jnp.where(strict, jax.nn.log_sigmoid(-z), 0.0)
        tail = lax.cumsum(log_1m, axis=3, reverse=True) - log_1m
        a = jnp.where(strict, jnp.exp(jax.nn.log_sigmoid(z) + tail), 0.0)
        return jnp.einsum('bhqk,bkhd->bqhd', a.astype(v.dtype), v)

    o = unblock(lax.map(block, (q_blocks(q), key_pos.reshape(-1, Q_BLOCK))))
    return o.reshape(B, S, H * dh)


def rglru_block(xr, xg, conv_w, conv_b, ga_w, ga_b, gx_w, gx_b, lru_lambda):
    B, S, W = xr.shape
    f32 = jnp.float32
    xp = jnp.pad(xr, ((0, 0), (CONV_W - 1, 0), (0, 0)))
    u = conv_b + xp[:, 0:S] * conv_w[0]
    for tap in range(1, CONV_W):
        u = u + xp[:, tap:tap + S] * conv_w[tap]
    ub = u.reshape(B, S, RNN_BLOCKS, RNN_BW)
    r = jax.nn.sigmoid(jnp.einsum('bsnc,ncd->bsnd', ub, ga_w).reshape(B, S, W) + ga_b)
    i = jax.nn.sigmoid(jnp.einsum('bsnc,ncd->bsnd', ub, gx_w).reshape(B, S, W) + gx_b)
    log_a = -LRU_C * r.astype(f32) * jax.nn.softplus(-lru_lambda.astype(f32))
    a = jnp.exp(log_a)
    b_in = jnp.sqrt(-jnp.expm1(2.0 * log_a)) * (i * u).astype(f32)

    def combine(left, right):
        a1, b1 = left
        a2, b2 = right
        return a1 * a2, a2 * b1 + b2

    _, h = lax.associative_scan(combine, (a, b_in), axis=1)
    return h.astype(xr.dtype) * jax.nn.gelu(xg)


def mla_attention(c_q_raw, c_kv_raw, k_rope_raw, q_norm, kv_norm, w_uq, w_ukv, pos):
    B, S, _ = c_q_raw.shape
    q = jnp.einsum('bsr,rf->bsf', rms_norm(c_q_raw, q_norm), w_uq).reshape(B, S, MLA_HEADS, MLA_NOPE + MLA_ROPE)
    q_nope, q_rope = q[..., :MLA_NOPE], rope(q[..., MLA_NOPE:], pos)
    kv = jnp.einsum('bsr,rf->bsf', rms_norm(c_kv_raw, kv_norm), w_ukv).reshape(B, S, MLA_HEADS, MLA_NOPE + MLA_V)
    k_nope, v = kv[..., :MLA_NOPE], kv[..., MLA_NOPE:]
    k_rope = rope(k_rope_raw[:, :, None, :], pos)[:, :, 0]
    scale = (MLA_NOPE + MLA_ROPE) ** -0.5
    key_pos = jnp.arange(S)

    def block(args):
        qn, qr, qp = args
        s = (jnp.einsum('bqhd,bkhd->bhqk', qn, k_nope) + jnp.einsum('bqhd,bkd->bhqk', qr, k_rope)) * scale
        p = masked_softmax(s, key_pos[None, :] <= qp[:, None])
        return jnp.einsum('bhqk,bkhd->bqhd', p.astype(v.dtype), v)

    o = unblock(lax.map(block, (q_blocks(q_nope), q_blocks(q_rope), key_pos.reshape(-1, Q_BLOCK))))
    return o.reshape(B, S, MLA_HEADS * MLA_V)


def hybrid_mixer(x, pos, w_in, cmp_pos, cmp_w1, cmp_w2, conv_w, conv_b, ga_w, ga_b, gx_w, gx_b, lru_lambda,
                 q_norm, kv_norm, w_uq, w_ukv, w_branch, w_out):
    B, S, D = x.shape
    h = jnp.einsum('bsd,df->bsf', x, w_in)
    (a_q, a_kc, a_vc, a_ks, a_vs, a_kw, a_vw, a_g, b_q, b_k, b_v, c_x, c_g, d_cq, d_ckv, d_kr,
     merge_g) = [h[..., o:o + w] for o, w in zip(IN_OFFSETS, IN_SPLITS)]

    def heads(t):
        return t.reshape(B, S, -1, HEAD_DIM)

    o_a = nsa_attention(heads(a_q), heads(a_kc), heads(a_vc), heads(a_ks), heads(a_vs), heads(a_kw), heads(a_vw),
                        a_g.reshape(B, S, NSA_HEADS, 3), cmp_pos, cmp_w1, cmp_w2)
    o_b = stick_breaking_attention(heads(b_q), heads(b_k), heads(b_v))
    o_c = rglru_block(c_x, c_g, conv_w, conv_b, ga_w, ga_b, gx_w, gx_b, lru_lambda)
    o_d = mla_attention(d_cq, d_ckv, d_kr, q_norm, kv_norm, w_uq, w_ukv, pos)
    branches = jnp.stack([o_a, o_b, o_c, o_d], axis=2)
    up = jnp.einsum('bsnc,ncd->bsnd', branches, w_branch)
    gates = jax.nn.sigmoid(merge_g.reshape(B, S, N_MIXERS, D))
    return jnp.einsum('bsd,de->bse', jnp.sum(gates * up, axis=2), w_out)


def memory_cross_attention(x, mem, wq, wkv, wo):
    B, S, _ = x.shape
    M = mem.shape[1]
    F = X_HEADS * X_HEAD_DIM
    q = jnp.einsum('bsd,df->bsf', x, wq).reshape(B, S, X_HEADS, X_HEAD_DIM)
    kv = jnp.einsum('bmd,df->bmf', mem, wkv)
    k = kv[..., :F].reshape(B, M, X_HEADS, X_HEAD_DIM)
    v = kv[..., F:].reshape(B, M, X_HEADS, X_HEAD_DIM)
    s = jnp.einsum('bshd,bmhd->bhsm', q, k).astype(jnp.float32) * X_HEAD_DIM ** -0.5
    p = jax.nn.softmax(s, axis=-1).astype(v.dtype)
    o = jnp.einsum('bhsm,bmhd->bshd', p, v).reshape(B, S, F)
    return jnp.einsum('bsf,fd->bsd', o, wo)


def grouped_expert_ffn(xt, expert_idx, weights, w_gu, w_down):
    N, D = xt.shape
    K = expert_idx.shape[1]
    E = w_gu.shape[0]
    F = w_down.shape[1]
    C = EXPERT_CHUNK
    A = N * K
    flat_e = expert_idx.reshape(A)
    flat_tok = jnp.arange(A, dtype=jnp.int32) // K
    order = jnp.argsort(flat_e)
    se, st = flat_e[order], flat_tok[order]
    counts = jax.ops.segment_sum(jnp.ones((A,), jnp.int32), flat_e, num_segments=E)
    padded = (counts + C - 1) // C * C
    pad_end = jnp.cumsum(padded)
    pad_start = pad_end - padded
    start = jnp.cumsum(counts) - counts
    dest = pad_start[se] + jnp.arange(A, dtype=jnp.int32) - start[se]
    n_chunks = -(-(A + E * (C - 1)) // C)
    P = n_chunks * C
    slot_tok = jnp.full((P,), N, jnp.int32).at[dest].set(st)
    x_pad = jnp.concatenate([xt, jnp.zeros((1, D), xt.dtype)], axis=0)
    xb = x_pad[slot_tok].reshape(n_chunks, C, D)
    chunk_start = jnp.arange(n_chunks, dtype=jnp.int32) * C
    chunk_e = jnp.minimum(jnp.sum((pad_end[None, :] <= chunk_start[:, None]).astype(jnp.int32), axis=1), E - 1)

    def run(args):
        xc, e = args
        gu = xc @ w_gu[e]
        return (jax.nn.silu(gu[:, :F]) * gu[:, F:]) @ w_down[e]

    yb = lax.map(run, (xb, chunk_e)).reshape(P, D)
    contrib = yb[dest] * weights.reshape(A)[order][:, None].astype(yb.dtype)
    return jnp.zeros((N, D), yb.dtype).at[st].add(contrib)


def hier_moe(x, rg_w, rg_b, re_w, re_b, w_gu, w_down):
    B, S, D = x.shape
    xt = x.reshape(B * S, D)
    N = xt.shape[0]
    rows = jnp.arange(N)
    p_grp = jax.nn.softmax((xt @ rg_w).astype(jnp.float32) + rg_b, axis=-1)
    grp = jnp.argmax(p_grp, axis=-1).astype(jnp.int32)
    p_g = p_grp[rows, grp]
    e_logits = ((xt @ re_w).astype(jnp.float32) + re_b).reshape(N, N_GROUPS, EXPERTS_PER_GROUP)
    p_e = jax.nn.softmax(e_logits[rows, grp], axis=-1)
    top_p, top_i = lax.top_k(p_e, TOPK_IN_GROUP)
    w = p_g[:, None] * top_p / jnp.sum(top_p, -1, keepdims=True)
    expert_idx = (grp[:, None] * EXPERTS_PER_GROUP + top_i).astype(jnp.int32)
    return grouped_expert_ffn(xt, expert_idx, w, w_gu, w_down).reshape(B, S, D)


def setup_inputs(seed: int = 0) -> dict:
    key = jax.random.key(seed)
    keys = jax.random.split(key, 48)
    ks = iter([keys[i] for i in range(48)])
    f32 = jnp.float32
    L = DEPTH

    def nrm(shape, scale):
        return jax.random.normal(next(ks), shape, f32) * scale

    def gain(n):
        return 1.0 + nrm((L, n), 0.02)

    u = jax.random.uniform(next(ks), (L, RNN_W), f32, 0.9, 0.999)
    a0 = u ** (1.0 / LRU_C)
    return {
        'x': nrm((BATCH, SEQ, D_MODEL), 1.0),
        'mem': nrm((BATCH, MEM_LEN, D_MODEL), 1.0),
        'w_in': nrm((L, D_MODEL, N_IN), D_MODEL ** -0.5),
        'nsa_cmp_pos': nrm((L, 2, CMP_LEN, HEAD_DIM), 0.1),
        'nsa_cmp_w1': nrm((L, 2, CMP_LEN * HEAD_DIM, CMP_HID), (CMP_LEN * HEAD_DIM) ** -0.5),
        'nsa_cmp_w2': nrm((L, 2, CMP_HID, HEAD_DIM), CMP_HID ** -0.5),
        'rnn_conv_w': nrm((L, CONV_W, RNN_W), CONV_W ** -0.5),
        'rnn_conv_b': nrm((L, RNN_W), 0.01),
        'rnn_ga_w': nrm((L, RNN_BLOCKS, RNN_BW, RNN_BW), RNN_BW ** -0.5),
        'rnn_ga_b': nrm((L, RNN_W), 0.01),
        'rnn_gx_w': nrm((L, RNN_BLOCKS, RNN_BW, RNN_BW), RNN_BW ** -0.5),
        'rnn_gx_b': nrm((L, RNN_W), 0.01),
        'rnn_lambda': jnp.log(a0) - jnp.log1p(-a0),
        'mla_q_norm': gain(MLA_Q_RANK),
        'mla_kv_norm': gain(MLA_KV_RANK),
        'mla_w_uq': nrm((L, MLA_Q_RANK, MLA_HEADS * (MLA_NOPE + MLA_ROPE)), MLA_Q_RANK ** -0.5),
        'mla_w_ukv': nrm((L, MLA_KV_RANK, MLA_HEADS * (MLA_NOPE + MLA_V)), MLA_KV_RANK ** -0.5),
        'w_branch': nrm((L, N_MIXERS, MIX_W, D_MODEL), MIX_W ** -0.5),
        'w_out': nrm((L, D_MODEL, D_MODEL), DN_BETA * D_MODEL ** -0.5),
        'ln1_g': gain(D_MODEL),
        'ln1_b': nrm((L, D_MODEL), 0.02),
        'x_wq': nrm((L, D_MODEL, X_HEADS * X_HEAD_DIM), D_MODEL ** -0.5),
        'x_wkv': nrm((L, D_MODEL, 2 * X_HEADS * X_HEAD_DIM), D_MODEL ** -0.5),
        'x_wo': nrm((L, X_HEADS * X_HEAD_DIM, D_MODEL), DN_BETA * (X_HEADS * X_HEAD_DIM) ** -0.5),
        'ln2_g': gain(D_MODEL),
        'ln2_b': nrm((L, D_MODEL), 0.02),
        'moe_rg_w': nrm((L, D_MODEL, N_GROUPS), D_MODEL ** -0.5),
        'moe_rg_b': nrm((L, N_GROUPS), 0.01),
        'moe_re_w': nrm((L, D_MODEL, N_EXPERTS), D_MODEL ** -0.5),
        'moe_re_b': nrm((L, N_EXPERTS), 0.01),
        'moe_w_gu': nrm((L, N_EXPERTS, D_MODEL, 2 * D_EXPERT), D_MODEL ** -0.5),
        'moe_w_down': nrm((L, N_EXPERTS, D_EXPERT, D_MODEL), DN_BETA * D_EXPERT ** -0.5),
        'ln3_g': gain(D_MODEL),
        'ln3_b': nrm((L, D_MODEL), 0.02),
    }


def reference(x, mem, w_in, nsa_cmp_pos, nsa_cmp_w1, nsa_cmp_w2, rnn_conv_w, rnn_conv_b, rnn_ga_w, rnn_ga_b,
              rnn_gx_w, rnn_gx_b, rnn_lambda, mla_q_norm, mla_kv_norm, mla_w_uq, mla_w_ukv, w_branch, w_out,
              ln1_g, ln1_b, x_wq, x_wkv, x_wo, ln2_g, ln2_b, moe_rg_w, moe_rg_b, moe_re_w, moe_re_b,
              moe_w_gu, moe_w_down, ln3_g, ln3_b):
    pos = jnp.arange(x.shape[1])
    for l in range(DEPTH):
        y = hybrid_mixer(x, pos, w_in[l], nsa_cmp_pos[l], nsa_cmp_w1[l], nsa_cmp_w2[l], rnn_conv_w[l], rnn_conv_b[l],
                         rnn_ga_w[l], rnn_ga_b[l], rnn_gx_w[l], rnn_gx_b[l], rnn_lambda[l], mla_q_norm[l],
                         mla_kv_norm[l], mla_w_uq[l], mla_w_ukv[l], w_branch[l], w_out[l])
        x = layer_norm(DN_ALPHA * x + y, ln1_g[l], ln1_b[l])
        y = memory_cross_attention(x, mem, x_wq[l], x_wkv[l], x_wo[l])
        x = layer_norm(DN_ALPHA * x + y, ln2_g[l], ln2_b[l])
        y = hier_moe(x, moe_rg_w[l], moe_rg_b[l], moe_re_w[l], moe_re_b[l], moe_w_gu[l], moe_w_down[l])
        x = layer_norm(DN_ALPHA * x + y, ln3_g[l], ln3_b[l])
    return x
```

```cpp
#include <hip/hip_runtime.h>
#include <stdint.h>
#include <stdio.h>

#ifndef MK_ONE_LAUNCH
#define MK_ONE_LAUNCH 0
#endif

#define DI __device__ __forceinline__
#define LAS __attribute__((address_space(3)))

constexpr int NT = 256;
constexpr int D = 1024, BATCH = 8, SEQ = 2048, T = BATCH * SEQ, DEPTH = 4;
constexpr int MEM_LEN = 256;
constexpr int NIN = 6764;
constexpr int O_AQ = 0, O_AKC = 256, O_AVC = 384, O_AKS = 512, O_AVS = 640, O_AKW = 768, O_AVW = 896, O_AG = 1024,
              O_BQ = 1036, O_BK = 1292, O_BV = 1548, O_CX = 1804, O_CG = 2060, O_DCQ = 2316, O_DCKV = 2508, O_DKR = 2636,
              O_MG = 2668;
constexpr int NCMP = 127, NCR = BATCH * NCMP * 2;
constexpr int NEXP = 32, NASSIGN = T * 2;
constexpr float DN_ALPHA = 1.681792830507429f;

constexpr size_t MiB = 1u << 20;
constexpr size_t al(size_t x) { return (x + 255) & ~(size_t)255; }
constexpr size_t WS_CTL = 0, CTL_BYTES = 1 * MiB;
constexpr size_t WS_H = WS_CTL + CTL_BYTES;
constexpr size_t SZ_H = al((size_t)T * NIN * 4);
constexpr size_t WS_GU = WS_H;
constexpr size_t WS_HH = WS_GU + (size_t)NASSIGN * 1024 * 4;
constexpr size_t WS_YK = WS_HH + (size_t)NASSIGN * 512 * 4;
static_assert(WS_YK + (size_t)NASSIGN * 1024 * 4 <= WS_H + SZ_H, "moe overlay fits in H");
constexpr size_t WS_TB = WS_H + SZ_H;
constexpr size_t WS_HID = WS_TB + al((size_t)2 * NCR * 2048 * 4);
constexpr size_t WS_KCVC = WS_HID + al((size_t)2 * NCR * 256 * 4);
constexpr size_t WS_PC = WS_KCVC + al((size_t)2 * NCR * 64 * 4);
constexpr size_t WS_SEL = WS_PC + al((size_t)BATCH * 4 * SEQ * 128 * 4);
constexpr size_t WS_OW = WS_SEL + al((size_t)BATCH * 2 * SEQ * 4);
constexpr size_t WS_BR = WS_OW + al((size_t)T * 256 * 4);
constexpr size_t WS_U = WS_BR + al((size_t)T * 1024 * 4);
constexpr size_t WS_RA = WS_U + al((size_t)T * 256 * 4);
constexpr size_t WS_RB = WS_RA + al((size_t)T * 256 * 4);
constexpr size_t WS_CQN = WS_RB + al((size_t)T * 256 * 4);
constexpr size_t WS_CKVN = WS_CQN + al((size_t)T * 192 * 4);
constexpr size_t WS_KR = WS_CKVN + al((size_t)T * 128 * 4);
constexpr size_t WS_Q = WS_KR + al((size_t)T * 32 * 4);
constexpr size_t WS_KV = WS_Q + al((size_t)T * 384 * 4);
constexpr size_t WS_M = WS_KV + al((size_t)T * 512 * 4);
constexpr size_t WS_Y = WS_M + al((size_t)T * 1024 * 4);
constexpr size_t WS_XA = WS_Y + al((size_t)T * 1024 * 4);
constexpr size_t WS_XB = WS_XA + al((size_t)T * 1024 * 4);
constexpr size_t WS_XC = WS_XB + al((size_t)T * 1024 * 4);
constexpr size_t WS_XQ = WS_XC + al((size_t)T * 1024 * 4);
constexpr size_t WS_XO = WS_XQ + al((size_t)T * 512 * 4);
constexpr size_t WS_KVM = WS_XO + al((size_t)T * 512 * 4);
constexpr size_t WS_LOG = WS_KVM + al((size_t)DEPTH * 2048 * 1024 * 4);
constexpr size_t WS_EIDX = WS_LOG + al((size_t)T * 36 * 4);
constexpr size_t WS_ESLOT = WS_EIDX + al((size_t)NASSIGN * 4);
constexpr size_t WS_EW = WS_ESLOT + al((size_t)NASSIGN * 4);
constexpr size_t WS_PERM = WS_EW + al((size_t)NASSIGN * 4);
constexpr size_t WS_END = WS_PERM + al((size_t)NASSIGN * 4);

constexpr int CW_BAR = 4096;
constexpr int CW_CNT = 16384;

struct Params {
    const float* in[34];
    float* out;
    unsigned char* ws;
};

#define XB_TMO      128
#define XB_XCNT(j)  (256  + 64 * (j))
#define XB_XSUB(j)  (1280 + 64 * (j))
#define XB_XGEN(j)  (2304 + 64 * (j))
#define XB_TOP      3328
#define XB_TOPGEN   3392
#define XCD_BAR_WORDS 3456
#define XB_SPIN_CAP (1u << 22)

__device__ __forceinline__ unsigned xb_ld(unsigned* p)              { return __hip_atomic_load(p, __ATOMIC_RELAXED, __HIP_MEMORY_SCOPE_AGENT); }
__device__ __forceinline__ unsigned xb_add(unsigned* p, unsigned v) { return __hip_atomic_fetch_add(p, v, __ATOMIC_RELAXED, __HIP_MEMORY_SCOPE_AGENT); }
__device__ __forceinline__ unsigned xb_xcc_id() { return (unsigned)__builtin_amdgcn_s_getreg((3 << 11) | 20) & 0xFu; }
#define XB_SPIN(cond, bar) do { unsigned _sp = 0; while (cond) { __builtin_amdgcn_s_sleep(1); \
    if ((++_sp & 255u) == 0u) { if (xb_ld(&(bar)[XB_TMO])) break; if (_sp > XB_SPIN_CAP) { atomicAdd(&(bar)[XB_TMO], 1u); break; } } } } while (0)

struct XcdBarrier { unsigned* bar; unsigned x; volatile LAS unsigned* st; };

__device__ __forceinline__ XcdBarrier xcd_barrier_post(unsigned* bar, volatile LAS unsigned* st) {
    XcdBarrier b; b.bar = bar; b.x = xb_xcc_id(); b.st = st;
    if (threadIdx.x == 0) (void)xb_add(&bar[XB_XCNT(b.x)], 1u);
    return b;
}
__device__ __forceinline__ void xcd_barrier_complete(unsigned* bar, unsigned x, unsigned& nloc, unsigned& nx) {
    const unsigned G = gridDim.x * gridDim.y * gridDim.z;
    unsigned sum, cnt, mine, sp = 0u;
    for (;;) {
        sum = 0u; cnt = 0u; mine = 0u;
#pragma unroll
        for (unsigned j = 0; j < 16; ++j) { const unsigned c = xb_ld(&bar[XB_XCNT(j)]); sum += c; cnt += (c > 0u) ? 1u : 0u; mine = (j == x) ? c : mine; }
        if (sum == G) break;
        __builtin_amdgcn_s_sleep(1);
        if ((++sp & 255u) == 0u) { if (xb_ld(&bar[XB_TMO])) break; if (sp > XB_SPIN_CAP) { atomicAdd(&bar[XB_TMO], 1u); break; } }
    }
    nloc = mine > 0u ? mine : 1u; nx = cnt > 0u ? cnt : 1u;
}
__device__ __forceinline__ void xcd_barrier(const XcdBarrier& b) {
    asm volatile("s_waitcnt vmcnt(0)" ::: "memory");
    __syncthreads();
    if (threadIdx.x == 0) {
        unsigned* bar = b.bar;
        __builtin_amdgcn_s_waitcnt(0);
        unsigned nloc = b.st[0], nx = b.st[1];
        if (nloc == 0u) { xcd_barrier_complete(bar, b.x, nloc, nx); b.st[0] = nloc; b.st[1] = nx; }
        const unsigned old = xb_add(&bar[XB_XSUB(b.x)], 1u);
        const unsigned gen = old / nloc;
        if (old + 1u == (gen + 1u) * nloc) {
            __builtin_amdgcn_fence(__ATOMIC_RELEASE, "agent");
            asm volatile("s_waitcnt vmcnt(0)" ::: "memory");
            const unsigned og = xb_add(&bar[XB_TOP], 1u);
            const unsigned tg = og / nx;
            if (og + 1u == (tg + 1u) * nx) xb_add(&bar[XB_TOPGEN], 1u);
            else XB_SPIN(xb_ld(&bar[XB_TOPGEN]) == tg, bar);
            __builtin_amdgcn_fence(__ATOMIC_ACQUIRE, "agent");
            xb_add(&bar[XB_XGEN(b.x)], 1u);
            asm volatile("s_waitcnt vmcnt(0)" ::: "memory");
        } else {
            XB_SPIN(xb_ld(&bar[XB_XGEN(b.x)]) == gen, bar);
            __builtin_amdgcn_fence(__ATOMIC_ACQUIRE, "agent");
            asm volatile("s_waitcnt vmcnt(0)" ::: "memory");
        }
    }
    __syncthreads();
}

DI float gelu_tanh(float x) { const float u = 0.7978845608028654f * (x + 0.044715f * x * x * x); return 0.5f * x * (1.f + tanhf(u)); }
DI float sigm(float x) { return 1.f / (1.f + expf(-x)); }
DI float logsig(float z) { return fminf(z, 0.f) - log1pf(expf(-fabsf(z))); }
DI float wave_sum(float v) {
#pragma unroll
    for (int o = 32; o > 0; o >>= 1) v += __shfl_xor(v, o, 64);
    return v;
}

struct GemmOp {
    const float* A; int lda; const int* aidx;
    const float* B; int ldb;
    int M, N, K;
};

DI void gemm_tile(const GemmOp& g, int m0, int n0, float (&acc)[8][8], float* lds) {
    float* As = lds;
    float* Bs = lds + 8 * 132;
    const int tid = threadIdx.x, tx = tid & 15, ty = tid >> 4;
#pragma unroll
    for (int i = 0; i < 8; ++i)
#pragma unroll
        for (int j = 0; j < 8; ++j) acc[i][j] = 0.f;
    const int ar = m0 + (tid >> 1), ak = (tid & 1) * 4;
    const int bk = tid >> 5, bn = n0 + (tid & 31) * 4;
    const float* aptr = nullptr;
    if (ar < g.M) { const long src = g.aidx ? (long)(g.aidx[ar] >> 1) : (long)ar; aptr = g.A + src * g.lda + ak; }
    const float* bptr = (bn < g.N) ? g.B + (long)bk * g.ldb + bn : nullptr;
    float4 av = aptr ? *(const float4*)aptr : make_float4(0.f, 0.f, 0.f, 0.f);
    float4 bv = bptr ? *(const float4*)bptr : make_float4(0.f, 0.f, 0.f, 0.f);
    for (int k0 = 0; k0 < g.K; k0 += 8) {
        __syncthreads();
        As[(ak + 0) * 132 + (tid >> 1)] = av.x; As[(ak + 1) * 132 + (tid >> 1)] = av.y;
        As[(ak + 2) * 132 + (tid >> 1)] = av.z; As[(ak + 3) * 132 + (tid >> 1)] = av.w;
        *(float4*)&Bs[bk * 128 + (tid & 31) * 4] = bv;
        __syncthreads();
        if (k0 + 8 < g.K) {
            if (aptr) av = *(const float4*)(aptr + k0 + 8);
            if (bptr) bv = *(const float4*)(bptr + (long)(k0 + 8) * g.ldb);
        }
#pragma unroll
        for (int kk = 0; kk < 8; ++kk) {
            const float4 a0 = *(const float4*)&As[kk * 132 + ty * 4], a1 = *(const float4*)&As[kk * 132 + 64 + ty * 4];
            const float4 b0 = *(const float4*)&Bs[kk * 128 + tx * 4], b1 = *(const float4*)&Bs[kk * 128 + 64 + tx * 4];
            const float a[8] = {a0.x, a0.y, a0.z, a0.w, a1.x, a1.y, a1.z, a1.w};
            const float b[8] = {b0.x, b0.y, b0.z, b0.w, b1.x, b1.y, b1.z, b1.w};
#pragma unroll
            for (int i = 0; i < 8; ++i)
#pragma unroll
                for (int j = 0; j < 8; ++j) acc[i][j] = fmaf(a[i], b[j], acc[i][j]);
        }
    }
}
#define GEMM_FOREACH(acc, m0, n0, M_, N_, ROW, COL, V, ...) do { const int _tx = threadIdx.x & 15, _ty = threadIdx.x >> 4; \
    _Pragma("unroll") for (int _i = 0; _i < 8; ++_i) { const int ROW = (m0) + (_i < 4 ? _ty * 4 + _i : 64 + _ty * 4 + _i - 4); \
    _Pragma("unroll") for (int _jh = 0; _jh < 2; ++_jh) { const int COL = (n0) + _jh * 64 + _tx * 4; \
        if (ROW < (M_) && COL < (N_)) { float4 V = make_float4(acc[_i][_jh * 4], acc[_i][_jh * 4 + 1], acc[_i][_jh * 4 + 2], acc[_i][_jh * 4 + 3]); __VA_ARGS__ } } } } while (0)

template <int ACT>
DI void gemm_job(const GemmOp& g, float* C, int ldc, int bid, int nblk, float* lds) {
    const int tm = (g.M + 127) / 128, tn = (g.N + 127) / 128;
    for (int u = bid; u < tm * tn; u += nblk) {
        const int m0 = (u / tn) * 128, n0 = (u % tn) * 128;
        float acc[8][8];
        gemm_tile(g, m0, n0, acc, lds);
        GEMM_FOREACH(acc, m0, n0, g.M, g.N, row, col, v, {
            if (ACT == 1) { v.x = gelu_tanh(v.x); v.y = gelu_tanh(v.y); v.z = gelu_tanh(v.z); v.w = gelu_tanh(v.w); }
            *(float4*)(C + (long)row * ldc + col) = v; });
    }
}

struct LayerW {
    const float *w_in, *cmp_pos, *cmp_w1, *cmp_w2, *conv_w, *conv_b, *ga_w, *ga_b, *gx_w, *gx_b, *lam, *q_norm, *kv_norm, *w_uq, *w_ukv,
        *w_branch, *w_out, *ln1_g, *ln1_b, *wq, *wkv, *wo, *ln2_g, *ln2_b, *rg_w, *rg_b, *re_w, *re_b, *w_gu, *w_down, *ln3_g, *ln3_b;
};
DI LayerW layer_w(const Params& p, int l) {
    LayerW w;
    w.w_in = p.in[2] + (size_t)l * D * NIN;
    w.cmp_pos = p.in[3] + (size_t)l * 2 * 32 * 64;
    w.cmp_w1 = p.in[4] + (size_t)l * 2 * 2048 * 256;
    w.cmp_w2 = p.in[5] + (size_t)l * 2 * 256 * 64;
    w.conv_w = p.in[6] + (size_t)l * 4 * 256;
    w.conv_b = p.in[7] + (size_t)l * 256;
    w.ga_w = p.in[8] + (size_t)l * 4 * 64 * 64;
    w.ga_b = p.in[9] + (size_t)l * 256;
    w.gx_w = p.in[10] + (size_t)l * 4 * 64 * 64;
    w.gx_b = p.in[11] + (size_t)l * 256;
    w.lam = p.in[12] + (size_t)l * 256;
    w.q_norm = p.in[13] + (size_t)l * 192;
    w.kv_norm = p.in[14] + (size_t)l * 128;
    w.w_uq = p.in[15] + (size_t)l * 192 * 384;
    w.w_ukv = p.in[16] + (size_t)l * 128 * 512;
    w.w_branch = p.in[17] + (size_t)l * 4 * 256 * 1024;
    w.w_out = p.in[18] + (size_t)l * 1024 * 1024;
    w.ln1_g = p.in[19] + (size_t)l * 1024; w.ln1_b = p.in[20] + (size_t)l * 1024;
    w.wq = p.in[21] + (size_t)l * 1024 * 512;
    w.wkv = p.in[22] + (size_t)l * 1024 * 1024;
    w.wo = p.in[23] + (size_t)l * 512 * 1024;
    w.ln2_g = p.in[24] + (size_t)l * 1024; w.ln2_b = p.in[25] + (size_t)l * 1024;
    w.rg_w = p.in[26] + (size_t)l * 1024 * 4; w.rg_b = p.in[27] + (size_t)l * 4;
    w.re_w = p.in[28] + (size_t)l * 1024 * 32; w.re_b = p.in[29] + (size_t)l * 32;
    w.w_gu = p.in[30] + (size_t)l * 32 * 1024 * 1024;
    w.w_down = p.in[31] + (size_t)l * 32 * 512 * 1024;
    w.ln3_g = p.in[32] + (size_t)l * 1024; w.ln3_b = p.in[33] + (size_t)l * 1024;
    return w;
}
#define WSF(off) ((float*)(p.ws + (off)))
#define WSI(off) ((int*)(p.ws + (off)))
#define WSU(off) ((unsigned*)(p.ws + (off)))

DI void job_cmp_gather(const Params& p, const LayerW& w, int bid, int nblk) {
    const float* H = WSF(WS_H); float* TB = WSF(WS_TB);
    const long total = (long)2 * NCR * 2048 / 4;
    for (long e = (long)bid * NT + threadIdx.x; e < total; e += (long)nblk * NT) {
        const long e4 = e * 4;
        const int f = (int)(e4 % 2048); const long r2 = e4 / 2048; const int r = (int)(r2 % NCR), j = (int)(r2 / NCR);
        const int g = r & 1, bc = r >> 1, c = bc % NCMP, b = bc / NCMP, i = f >> 6, d = f & 63;
        const float4 hv = *(const float4*)(H + (long)(b * SEQ + 16 * c + i) * NIN + (j ? O_AVC : O_AKC) + g * 64 + d);
        const float4 pv = *(const float4*)(w.cmp_pos + (j * 32 + i) * 64 + d);
        *(float4*)(TB + e4) = make_float4(hv.x + pv.x, hv.y + pv.y, hv.z + pv.z, hv.w + pv.w);
    }
}
DI void job_rnn_conv(const Params& p, const LayerW& w, int bid, int nblk) {
    const float* H = WSF(WS_H); float* U = WSF(WS_U);
    for (long e = (long)bid * NT + threadIdx.x; e < (long)T * 256; e += (long)nblk * NT) {
        const int ch = (int)(e & 255); const int t = (int)(e >> 8), s = t & (SEQ - 1);
        float u = w.conv_b[ch];
#pragma unroll
        for (int tap = 0; tap < 4; ++tap) { const int sp = s - 3 + tap; if (sp >= 0) u += H[(long)(t - 3 + tap) * NIN + O_CX + ch] * w.conv_w[tap * 256 + ch]; }
        U[e] = u;
    }
}
DI void job_rnn_gates(const Params& p, const LayerW& w, int bid, int nblk) {
    const float* U = WSF(WS_U); float* RA = WSF(WS_RA); float* RB = WSF(WS_RB);
    for (long e = (long)bid * NT + threadIdx.x; e < (long)T * 256; e += (long)nblk * NT) {
        const int ch = (int)(e & 255); const long t = e >> 8; const int blk = ch >> 6, j = ch & 63;
        const float* ur = U + t * 256 + blk * 64;
        float sa = 0.f, sx = 0.f;
        for (int c = 0; c < 64; ++c) { const float uv = ur[c]; sa = fmaf(uv, w.ga_w[(blk * 64 + c) * 64 + j], sa); sx = fmaf(uv, w.gx_w[(blk * 64 + c) * 64 + j], sx); }
        const float r = sigm(sa + w.ga_b[ch]), ig = sigm(sx + w.gx_b[ch]);
        const float nl = -w.lam[ch];
        const float sp = fmaxf(nl, 0.f) + log1pf(expf(-fabsf(nl)));
        const float log_a = -8.0f * r * sp;
        RA[e] = expf(log_a);
        RB[e] = sqrtf(-expm1f(2.0f * log_a)) * (ig * U[e]);
    }
}
DI void job_rnn_scan(const Params& p, int bid, int nblk) {
    const float* H = WSF(WS_H); const float* RA = WSF(WS_RA); const float* RB = WSF(WS_RB); float* BR = WSF(WS_BR);
    for (int e = bid * NT + threadIdx.x; e < BATCH * 256; e += nblk * NT) {
        const int ch = e & 255, b = e >> 8;
        float h = 0.f;
        for (int s0 = 0; s0 < SEQ; s0 += 8) {
            float av[8], bv[8], gv[8];
#pragma unroll
            for (int i = 0; i < 8; ++i) { const long t = (long)b * SEQ + s0 + i; av[i] = RA[t * 256 + ch]; bv[i] = RB[t * 256 + ch]; gv[i] = H[t * NIN + O_CG + ch]; }
#pragma unroll
            for (int i = 0; i < 8; ++i) { const long t = (long)b * SEQ + s0 + i; h = av[i] * h + bv[i]; BR[t * 1024 + 2 * 256 + ch] = h * gelu_tanh(gv[i]); }
        }
    }
}
DI void job_mla_norm(const Params& p, const LayerW& w, int bid, int nblk) {
    const float* H = WSF(WS_H); float* CQN = WSF(WS_CQN); float* CKVN = WSF(WS_CKVN); float* KR = WSF(WS_KR);
    const int lane = threadIdx.x & 63, wid = threadIdx.x >> 6;
    for (int t = bid * 4 + wid; t < T; t += nblk * 4) {
        const float* hr = H + (long)t * NIN;
        float q0 = hr[O_DCQ + lane], q1 = hr[O_DCQ + 64 + lane], q2 = hr[O_DCQ + 128 + lane];
        float ss = wave_sum(q0 * q0 + q1 * q1 + q2 * q2);
        float rs = rsqrtf(ss * (1.f / 192.f) + 1e-6f);
        CQN[(long)t * 192 + lane] = q0 * rs * w.q_norm[lane];
        CQN[(long)t * 192 + 64 + lane] = q1 * rs * w.q_norm[64 + lane];
        CQN[(long)t * 192 + 128 + lane] = q2 * rs * w.q_norm[128 + lane];
        float k0 = hr[O_DCKV + lane], k1 = hr[O_DCKV + 64 + lane];
        ss = wave_sum(k0 * k0 + k1 * k1);
        rs = rsqrtf(ss * (1.f / 128.f) + 1e-6f);
        CKVN[(long)t * 128 + lane] = k0 * rs * w.kv_norm[lane];
        CKVN[(long)t * 128 + 64 + lane] = k1 * rs * w.kv_norm[64 + lane];
        if (lane < 16) {
            const int s = t & (SEQ - 1);
            const float inv = powf(10000.f, -(float)(2 * lane) / 32.f);
            const float ang = (float)s * inv, cs = cosf(ang), sn = sinf(ang);
            const float x1 = hr[O_DKR + lane], x2 = hr[O_DKR + 16 + lane];
            KR[(long)t * 32 + lane] = x1 * cs - x2 * sn;
            KR[(long)t * 32 + 16 + lane] = x1 * sn + x2 * cs;
        }
    }
}
DI void job_q_rope(const Params& p, int bid, int nblk) {
    float* Q = WSF(WS_Q);
    for (long e = (long)bid * NT + threadIdx.x; e < (long)T * 64; e += (long)nblk * NT) {
        const int i = (int)(e & 15), h = (int)((e >> 4) & 3); const long t = e >> 6; const int s = (int)(t & (SEQ - 1));
        const float inv = powf(10000.f, -(float)(2 * i) / 32.f);
        const float ang = (float)s * inv, cs = cosf(ang), sn = sinf(ang);
        float* q = Q + t * 384 + h * 96 + 64;
        const float x1 = q[i], x2 = q[16 + i];
        q[i] = x1 * cs - x2 * sn; q[16 + i] = x1 * sn + x2 * cs;
    }
}

DI void job_nsa_cmp(const Params& p, int bid, int nblk) {
    const float* H = WSF(WS_H); const float* KC = WSF(WS_KCVC); const float* VC = KC + (size_t)NCR * 64;
    float* PC = WSF(WS_PC); float* BR = WSF(WS_BR);
    const int lane = threadIdx.x & 63, wid = threadIdx.x >> 6;
    for (int item0 = bid * 4 + wid; item0 < BATCH * 4 * 32; item0 += nblk * 4) {
        const int item = __builtin_amdgcn_readfirstlane(item0);
        const int qt = item & 31, h = (item >> 5) & 3, b = item >> 7, g = h >> 1, n = h & 1;
        const int s = qt * 64 + lane; const long t = (long)b * SEQ + s;
        const float slope = exp2f(-2.f * (float)(h + 1));
        float q[64];
#pragma unroll
        for (int d = 0; d < 64; d += 4) { const float4 v = *(const float4*)(H + t * NIN + O_AQ + h * 64 + d); q[d] = v.x; q[d + 1] = v.y; q[d + 2] = v.z; q[d + 3] = v.w; }
        const int smax = qt * 64 + 63;
        const int cend = smax >= 31 ? (smax - 31) / 16 + 1 : 0;
        float m = -1e30f, l = 0.f;
        for (int c = 0; c < cend; ++c) {
            const float* kr = KC + ((long)(b * NCMP + c) * 2 + g) * 64;
            float dot = 0.f;
#pragma unroll
            for (int d = 0; d < 64; ++d) dot = fmaf(q[d], kr[d], dot);
            const int dist = s - (16 * c + 31);
            const bool valid = dist >= 0;
            const float sc = valid ? dot * 0.125f - slope * (float)dist : -1e30f;
            const float mn = fmaxf(m, sc);
            l = l * expf(m - mn) + (valid ? expf(sc - mn) : 0.f);
            m = mn;
        }
        const float rl = 1.f / fmaxf(l, 1e-30f);
        float o[64];
#pragma unroll
        for (int d = 0; d < 64; ++d) o[d] = 0.f;
        float* pcrow = PC + ((long)((b * 2 + g) * 2 + n) * SEQ + s) * 128;
        for (int c = 0; c < 128; ++c) {
            float pr = 0.f;
            if (c < cend) {
                const float* kr = KC + ((long)(b * NCMP + c) * 2 + g) * 64;
                float dot = 0.f;
#pragma unroll
                for (int d = 0; d < 64; ++d) dot = fmaf(q[d], kr[d], dot);
                const int dist = s - (16 * c + 31);
                if (dist >= 0) pr = expf(dot * 0.125f - slope * (float)dist - m) * rl;
                const float* vr = VC + ((long)(b * NCMP + c) * 2 + g) * 64;
#pragma unroll
                for (int d = 0; d < 64; ++d) o[d] = fmaf(pr, vr[d], o[d]);
            }
            pcrow[c] = pr;
        }
        const float g0 = sigm(H[t * NIN + O_AG + h * 3 + 0]);
#pragma unroll
        for (int d = 0; d < 64; d += 4) *(float4*)(BR + t * 1024 + h * 64 + d) = make_float4(g0 * o[d], g0 * o[d + 1], g0 * o[d + 2], g0 * o[d + 3]);
    }
}
DI void job_nsa_select(const Params& p, int bid, int nblk, float* lds) {
    const float* PC = WSF(WS_PC); unsigned* SEL = WSU(WS_SEL);
    float* simp = lds + threadIdx.x * 33;
    for (int e = bid * NT + threadIdx.x; e < BATCH * 2 * SEQ; e += nblk * NT) {
        const int s = e & (SEQ - 1), bg = e >> 11;
        const float* p0 = PC + ((long)(bg * 2 + 0) * SEQ + s) * 128;
        const float* p1 = PC + ((long)(bg * 2 + 1) * SEQ + s) * 128;
        const int cur = s >> 6;
        float prev = 0.f;
        for (int j = 0; j < 32; ++j) {
            const float4 a = *(const float4*)(p0 + 4 * j), c = *(const float4*)(p1 + 4 * j);
            const float P0 = a.x + c.x, P1 = a.y + c.y, P2 = a.z + c.z, P3 = a.w + c.w;
            float imp = P0 + P1 + P2 + 0.5f * (P3 + prev);
            prev = P3;
            const bool forced = (j == 0) || (j == cur), valid = (j * 64 <= s);
            simp[j] = forced ? 1e4f : (valid ? imp : -1.0f);
        }
        unsigned mask = 0u;
        for (int it = 0; it < 8; ++it) {
            float best = -3e38f; int bj = 0;
            for (int j = 0; j < 32; ++j) { const float v = simp[j]; if (!((mask >> j) & 1u) && v > best) { best = v; bj = j; } }
            mask |= 1u << bj;
        }
        SEL[e] = mask;
    }
}

template <int MODE>
DI void job_attn(const Params& p, int layer, int bid, int nblk) {
    constexpr int DQK = MODE == 2 ? 96 : (MODE == 3 ? 128 : 64);
    const float* H = WSF(WS_H);
    const int lane = threadIdx.x & 63, wid = threadIdx.x >> 6;
    const int nitems = (MODE == 3) ? BATCH * 4 * 32 * 2 : BATCH * 4 * 32;
    for (int item0 = bid * 4 + wid; item0 < nitems; item0 += nblk * 4) {
        int item = __builtin_amdgcn_readfirstlane(item0);
        int half = 0; if (MODE == 3) { half = item & 1; item >>= 1; }
        const int qt = item & 31, h = (item >> 5) & 3, b = item >> 7, g = h >> 1;
        const int s = qt * 64 + lane; const long t = (long)b * SEQ + s;
        const int smin = qt * 64, smax = qt * 64 + 63;
        const float slope = exp2f(-2.f * (float)(h + 1));
        const float* qrow;
        if (MODE == 0 || MODE == 1) qrow = H + t * NIN + O_AQ + h * 64;
        else if (MODE == 2) qrow = WSF(WS_Q) + t * 384 + h * 96;
        else if (MODE == 3) qrow = WSF(WS_XQ) + t * 512 + h * 128;
        else qrow = H + t * NIN + O_BQ + h * 64;
        float q[DQK];
#pragma unroll
        for (int d = 0; d < DQK; d += 4) { const float4 v = *(const float4*)(qrow + d); q[d] = v.x; q[d + 1] = v.y; q[d + 2] = v.z; q[d + 3] = v.w; }
        float o[64];
#pragma unroll
        for (int d = 0; d < 64; ++d) o[d] = 0.f;
        unsigned selmask = 0u;
        if (MODE == 0) selmask = WSU(WS_SEL)[(b * 2 + g) * SEQ + s];
        const float scale = MODE == 2 ? 0.10206207261596577f : (MODE == 3 ? 0.08838834764831845f : 0.125f);
        if (MODE != 4) {
            int kbeg = 0, kend = smax;
            if (MODE == 1) kbeg = smin - 511 > 0 ? smin - 511 : 0;
            if (MODE == 3) kend = MEM_LEN - 1;
            float m = -1e30f, l = 0.f;
            for (int k = kbeg; k <= kend; ++k) {
                const float *kr, *kr2 = nullptr, *vr;
                if (MODE == 0) { kr = H + ((long)b * SEQ + k) * NIN + O_AKS + g * 64; vr = H + ((long)b * SEQ + k) * NIN + O_AVS + g * 64; }
                else if (MODE == 1) { kr = H + ((long)b * SEQ + k) * NIN + O_AKW + g * 64; vr = H + ((long)b * SEQ + k) * NIN + O_AVW + g * 64; }
                else if (MODE == 2) { kr = WSF(WS_KV) + ((long)b * SEQ + k) * 512 + h * 128; kr2 = WSF(WS_KR) + ((long)b * SEQ + k) * 32; vr = kr + 64; }
                else { kr = WSF(WS_KVM) + ((long)layer * 2048 + b * MEM_LEN + k) * 1024 + h * 128; vr = kr + 512 + half * 64; }
                float dot = 0.f;
                if constexpr (MODE == 2) {
#pragma unroll
                    for (int d = 0; d < 64; ++d) dot = fmaf(q[d], kr[d], dot);
#pragma unroll
                    for (int d = 0; d < 32; ++d) dot = fmaf(q[64 + d], kr2[d], dot);
                } else {
#pragma unroll
                    for (int d = 0; d < DQK; ++d) dot = fmaf(q[d], kr[d], dot);
                }
                bool valid = true; float sc = dot * scale;
                if (MODE == 0) { valid = (k <= s) && ((selmask >> (k >> 6)) & 1u); sc -= slope * (float)(s - k); }
                if (MODE == 1) { valid = (k <= s) && (s - k < 512); sc -= slope * (float)(s - k); }
                if (MODE == 2) valid = (k <= s);
                sc = valid ? sc : -1e30f;
                const float mn = fmaxf(m, sc);
                const float corr = expf(m - mn), pr = valid ? expf(sc - mn) : 0.f;
                l = l * corr + pr; m = mn;
#pragma unroll
                for (int d = 0; d < 64; ++d) o[d] = fmaf(pr, vr[d], o[d] * corr);
            }
            const float rl = 1.f / fmaxf(l, 1e-30f);
#pragma unroll
            for (int d = 0; d < 64; ++d) o[d] *= rl;
        } else {
            float tail = 0.f;
            for (int k = smax - 1; k >= 0; --k) {
                const float* kr = H + ((long)b * SEQ + k) * NIN + O_BK + h * 64;
                const float* vr = H + ((long)b * SEQ + k) * NIN + O_BV + h * 64;
                float dot = 0.f;
#pragma unroll
                for (int d = 0; d < 64; ++d) dot = fmaf(q[d], kr[d], dot);
                const float z = dot * 0.125f;
                const bool valid = k < s;
                const float lsp = logsig(z);
                const float a = valid ? expf(lsp + tail) : 0.f;
                tail += valid ? (lsp - z) : 0.f;
#pragma unroll
                for (int d = 0; d < 64; ++d) o[d] = fmaf(a, vr[d], o[d]);
            }
        }
        if (MODE == 0) {
            const float g1 = sigm(H[t * NIN + O_AG + h * 3 + 1]);
            float* br = WSF(WS_BR) + t * 1024 + h * 64; const float* ow = WSF(WS_OW) + t * 256 + h * 64;
#pragma unroll
            for (int d = 0; d < 64; d += 4) { float4 c = *(float4*)(br + d); const float4 w4 = *(const float4*)(ow + d);
                c.x += g1 * o[d] + w4.x; c.y += g1 * o[d + 1] + w4.y; c.z += g1 * o[d + 2] + w4.z; c.w += g1 * o[d + 3] + w4.w; *(float4*)(br + d) = c; }
        } else {
            float* dst; float gs = 1.f;
            if (MODE == 1) { dst = WSF(WS_OW) + t * 256 + h * 64; gs = sigm(H[t * NIN + O_AG + h * 3 + 2]); }
            else if (MODE == 2) dst = WSF(WS_BR) + t * 1024 + 3 * 256 + h * 64;
            else if (MODE == 3) dst = WSF(WS_XO) + t * 512 + h * 128 + half * 64;
            else dst = WSF(WS_BR) + t * 1024 + 1 * 256 + h * 64;
#pragma unroll
            for (int d = 0; d < 64; d += 4) *(float4*)(dst + d) = make_float4(gs * o[d], gs * o[d + 1], gs * o[d + 2], gs * o[d + 3]);
        }
    }
}

DI void job_merge(const Params& p, const LayerW& w, int bid, int nblk, float* lds) {
    const float* H = WSF(WS_H); float* M = WSF(WS_M);
    for (int u = bid; u < (T / 128) * 8; u += nblk) {
        const int m0 = (u >> 3) * 128, n0 = (u & 7) * 128;
        float macc[8][8];
#pragma unroll
        for (int i = 0; i < 8; ++i)
#pragma unroll
            for (int j = 0; j < 8; ++j) macc[i][j] = 0.f;
        for (int n = 0; n < 4; ++n) {
            GemmOp g; g.A = WSF(WS_BR) + n * 256; g.lda = 1024; g.aidx = nullptr; g.B = w.w_branch + (size_t)n * 256 * 1024; g.ldb = 1024; g.M = T; g.N = 1024; g.K = 256;
            float acc[8][8];
            gemm_tile(g, m0, n0, acc, lds);
            const int tx = threadIdx.x & 15, ty = threadIdx.x >> 4;
#pragma unroll
            for (int i = 0; i < 8; ++i) { const int row = m0 + (i < 4 ? ty * 4 + i : 64 + ty * 4 + i - 4);
#pragma unroll
                for (int jh = 0; jh < 2; ++jh) { const int col = n0 + jh * 64 + tx * 4;
                    const float4 gv = *(const float4*)(H + (long)row * NIN + O_MG + n * 1024 + col);
                    macc[i][jh * 4 + 0] += sigm(gv.x) * acc[i][jh * 4 + 0]; macc[i][jh * 4 + 1] += sigm(gv.y) * acc[i][jh * 4 + 1];
                    macc[i][jh * 4 + 2] += sigm(gv.z) * acc[i][jh * 4 + 2]; macc[i][jh * 4 + 3] += sigm(gv.w) * acc[i][jh * 4 + 3]; } }
        }
        GEMM_FOREACH(macc, m0, n0, T, 1024, row, col, v, { *(float4*)(M + (long)row * 1024 + col) = v; });
    }
}
DI void job_ln(const float* xin, const float* y, int ldy, const float* y2, const float* gw, const float* bw, float* out, int bid, int nblk) {
    const int lane = threadIdx.x & 63, wid = threadIdx.x >> 6;
    for (int t = bid * 4 + wid; t < T; t += nblk * 4) {
        float v[16];
        float s = 0.f;
#pragma unroll
        for (int i = 0; i < 4; ++i) {
            const int c = i * 256 + lane * 4;
            const float4 xv = *(const float4*)(xin + (long)t * 1024 + c);
            float4 yv = *(const float4*)(y + (long)t * ldy + c);
            if (y2) { const float4 z = *(const float4*)(y2 + (long)t * ldy + c); yv.x += z.x; yv.y += z.y; yv.z += z.z; yv.w += z.w; }
            v[i * 4 + 0] = DN_ALPHA * xv.x + yv.x; v[i * 4 + 1] = DN_ALPHA * xv.y + yv.y; v[i * 4 + 2] = DN_ALPHA * xv.z + yv.z; v[i * 4 + 3] = DN_ALPHA * xv.w + yv.w;
            s += (v[i * 4] + v[i * 4 + 1]) + (v[i * 4 + 2] + v[i * 4 + 3]);
        }
        const float mu = wave_sum(s) * (1.f / 1024.f);
        float q = 0.f;
#pragma unroll
        for (int i = 0; i < 16; ++i) { const float dlt = v[i] - mu; q += dlt * dlt; }
        const float rstd = rsqrtf(wave_sum(q) * (1.f / 1024.f) + 1e-5f);
#pragma unroll
        for (int i = 0; i < 4; ++i) {
            const int c = i * 256 + lane * 4;
            const float4 gv = *(const float4*)(gw + c), bv = *(const float4*)(bw + c);
            *(float4*)(out + (long)t * 1024 + c) = make_float4((v[i * 4] - mu) * rstd * gv.x + bv.x, (v[i * 4 + 1] - mu) * rstd * gv.y + bv.y,
                                                               (v[i * 4 + 2] - mu) * rstd * gv.z + bv.z, (v[i * 4 + 3] - mu) * rstd * gv.w + bv.w);
        }
    }
}
DI void job_router(const Params& p, const LayerW& w, int layer, int bid, int nblk) {
    const float* LOG = WSF(WS_LOG); int* EIDX = WSI(WS_EIDX); int* ESLOT = WSI(WS_ESLOT); float* EW = WSF(WS_EW);
    unsigned* cnt = WSU(WS_CTL) + CW_CNT + layer * 32;
    for (int t = bid * NT + threadIdx.x; t < T; t += nblk * NT) {
        const float* lr = LOG + (long)t * 36;
        const float g0 = lr[0] + w.rg_b[0], g1 = lr[1] + w.rg_b[1], g2 = lr[2] + w.rg_b[2], g3 = lr[3] + w.rg_b[3];
        const float gm = fmaxf(fmaxf(g0, g1), fmaxf(g2, g3));
        const float e0 = expf(g0 - gm), e1 = expf(g1 - gm), e2 = expf(g2 - gm), e3 = expf(g3 - gm);
        const float gs = (e0 + e1) + (e2 + e3);
        const float p0 = e0 / gs, p1 = e1 / gs, p2 = e2 / gs, p3 = e3 / gs;
        int grp = 0; float pg = p0;
        if (p1 > pg) { pg = p1; grp = 1; }
        if (p2 > pg) { pg = p2; grp = 2; }
        if (p3 > pg) { pg = p3; grp = 3; }
        float el[8];
#pragma unroll
        for (int i = 0; i < 8; ++i) el[i] = lr[4 + grp * 8 + i] + w.re_b[grp * 8 + i];
        float em = el[0];
#pragma unroll
        for (int i = 1; i < 8; ++i) em = fmaxf(em, el[i]);
        float es = 0.f;
#pragma unroll
        for (int i = 0; i < 8; ++i) { el[i] = expf(el[i] - em); es += el[i]; }
#pragma unroll
        for (int i = 0; i < 8; ++i) el[i] = el[i] / es;
        float b0 = el[0]; int i0 = 0;
#pragma unroll
        for (int i = 1; i < 8; ++i) if (el[i] > b0) { b0 = el[i]; i0 = i; }
        float b1 = -1.f; int i1 = 0;
#pragma unroll
        for (int i = 0; i < 8; ++i) if (i != i0 && el[i] > b1) { b1 = el[i]; i1 = i; }
        const float den = b0 + b1;
        const int ex0 = grp * 8 + i0, ex1 = grp * 8 + i1;
        EIDX[t * 2] = ex0; EIDX[t * 2 + 1] = ex1;
        EW[t * 2] = pg * b0 / den; EW[t * 2 + 1] = pg * b1 / den;
        ESLOT[t * 2] = (int)atomicAdd(&cnt[ex0], 1u);
        ESLOT[t * 2 + 1] = (int)atomicAdd(&cnt[ex1], 1u);
    }
}
DI void job_fill(const Params& p, int layer, int bid, int nblk) {
    const int* EIDX = WSI(WS_EIDX); const int* ESLOT = WSI(WS_ESLOT); int* PERM = WSI(WS_PERM);
    unsigned* cnt = WSU(WS_CTL) + CW_CNT + layer * 32;
    for (int a = bid * NT + threadIdx.x; a < NASSIGN; a += nblk * NT) {
        const int e = EIDX[a];
        int off = 0;
        for (int j = 0; j < e; ++j) off += (int)__hip_atomic_load(&cnt[j], __ATOMIC_RELAXED, __HIP_MEMORY_SCOPE_AGENT);
        PERM[off + ESLOT[a]] = a;
    }
}
template <int STAGE>
DI void job_moe_gemm(const Params& p, const LayerW& w, int layer, const float* X2, int bid, int nblk, float* lds) {
    unsigned* cnt = WSU(WS_CTL) + CW_CNT + layer * 32;
    int* s_off = (int*)(lds + 2200);
    int* s_uoff = s_off + 33;
    __syncthreads();
    if (threadIdx.x == 0) {
        int ro = 0, uo = 0;
        for (int e = 0; e < 32; ++e) { const int c = (int)__hip_atomic_load(&cnt[e], __ATOMIC_RELAXED, __HIP_MEMORY_SCOPE_AGENT); s_off[e] = ro; s_uoff[e] = uo; ro += c; uo += ((c + 127) / 128) * 8; }
        s_off[32] = ro; s_uoff[32] = uo;
    }
    __syncthreads();
    const int nunits = s_uoff[32];
    const int* PERM = WSI(WS_PERM);
    for (int u = bid; u < nunits; u += nblk) {
        int e = 0;
        while (e < 31 && u >= s_uoff[e + 1]) ++e;
        const int lu = u - s_uoff[e], m0 = (lu >> 3) * 128, n0 = (lu & 7) * 128;
        const int roff = s_off[e], cnt_e = s_off[e + 1] - roff;
        GemmOp g;
        if (STAGE == 0) { g.A = X2; g.lda = 1024; g.aidx = PERM + roff; g.B = w.w_gu + (size_t)e * 1024 * 1024; g.ldb = 1024; g.M = cnt_e; g.N = 1024; g.K = 1024; }
        else { g.A = WSF(WS_HH) + (size_t)roff * 512; g.lda = 512; g.aidx = nullptr; g.B = w.w_down + (size_t)e * 512 * 1024; g.ldb = 1024; g.M = cnt_e; g.N = 1024; g.K = 512; }
        float acc[8][8];
        gemm_tile(g, m0, n0, acc, lds);
        if (STAGE == 0) {
            float* GU = WSF(WS_GU);
            GEMM_FOREACH(acc, m0, n0, cnt_e, 1024, row, col, v, { *(float4*)(GU + (long)(roff + row) * 1024 + col) = v; });
        } else {
            float* YK = WSF(WS_YK); const float* EW = WSF(WS_EW);
            GEMM_FOREACH(acc, m0, n0, cnt_e, 1024, row, col, v, { const int a = PERM[roff + row]; const float sw = EW[a];
                *(float4*)(YK + (long)a * 1024 + col) = make_float4(v.x * sw, v.y * sw, v.z * sw, v.w * sw); });
        }
    }
}
DI void job_moe_act(const Params& p, int bid, int nblk) {
    const float* GU = WSF(WS_GU); float* HH = WSF(WS_HH);
    for (long e = (long)bid * NT + threadIdx.x; e < (long)NASSIGN * 128; e += (long)nblk * NT) {
        const long r = e >> 7; const int f = (int)(e & 127) * 4;
        const float4 gt = *(const float4*)(GU + r * 1024 + f), up = *(const float4*)(GU + r * 1024 + 512 + f);
        *(float4*)(HH + r * 512 + f) = make_float4(gt.x * sigm(gt.x) * up.x, gt.y * sigm(gt.y) * up.y, gt.z * sigm(gt.z) * up.z, gt.w * sigm(gt.w) * up.w);
    }
}

constexpr int NPH = 21;
constexpr int NPHASES = 1 + DEPTH * NPH;

__global__ void __launch_bounds__(NT, 1) mega(Params p, int ph_lo, int ph_hi) {
    extern __shared__ __attribute__((aligned(16))) float lds[];
    __shared__ uint4 xb_words;
    const int bid = blockIdx.x, nblk = gridDim.x;
    XcdBarrier bar;
    const bool multi = (ph_hi - ph_lo) > 1;
    if (multi) {
        if (threadIdx.x == 0) xb_words = make_uint4(0u, 0u, 0u, 0u);
        __syncthreads();
        bar = xcd_barrier_post(WSU(WS_CTL) + CW_BAR, (volatile LAS unsigned*)&xb_words);
    }
#define PHASE(id, ...) do { const int _id = (id); if (ph_lo <= _id && _id < ph_hi) { __VA_ARGS__; if (_id + 1 < ph_hi) xcd_barrier(bar); } } while (0)

    PHASE(0, {
        for (int l = 0; l < DEPTH; ++l) {
            GemmOp g; g.A = p.in[1]; g.lda = 1024; g.aidx = nullptr; g.B = p.in[22] + (size_t)l * 1024 * 1024; g.ldb = 1024; g.M = BATCH * MEM_LEN; g.N = 1024; g.K = 1024;
            gemm_job<0>(g, WSF(WS_KVM) + (size_t)l * 2048 * 1024, 1024, bid, nblk, lds);
        }
    });

    for (int layer = 0; layer < DEPTH; ++layer) {
        const LayerW w = layer_w(p, layer);
        const int base = 1 + layer * NPH;
        const float* Xin = (layer == 0) ? p.in[0] : WSF(WS_XC);
        float* Xout = (layer == DEPTH - 1) ? p.out : WSF(WS_XC);
        PHASE(base + 0, { GemmOp g; g.A = Xin; g.lda = 1024; g.aidx = nullptr; g.B = w.w_in; g.ldb = NIN; g.M = T; g.N = NIN; g.K = 1024;
                          gemm_job<0>(g, WSF(WS_H), NIN, bid, nblk, lds); });
        PHASE(base + 1, { job_cmp_gather(p, w, bid, nblk); job_rnn_conv(p, w, bid, nblk); job_mla_norm(p, w, bid, nblk); });
        PHASE(base + 2, {
            for (int j = 0; j < 2; ++j) { GemmOp g; g.A = WSF(WS_TB) + (size_t)j * NCR * 2048; g.lda = 2048; g.aidx = nullptr; g.B = w.cmp_w1 + (size_t)j * 2048 * 256; g.ldb = 256; g.M = NCR; g.N = 256; g.K = 2048;
                gemm_job<1>(g, WSF(WS_HID) + (size_t)j * NCR * 256, 256, bid, nblk, lds); }
            job_rnn_gates(p, w, bid, nblk);
            { GemmOp g; g.A = WSF(WS_CQN); g.lda = 192; g.aidx = nullptr; g.B = w.w_uq; g.ldb = 384; g.M = T; g.N = 384; g.K = 192; gemm_job<0>(g, WSF(WS_Q), 384, bid, nblk, lds); }
            { GemmOp g; g.A = WSF(WS_CKVN); g.lda = 128; g.aidx = nullptr; g.B = w.w_ukv; g.ldb = 512; g.M = T; g.N = 512; g.K = 128; gemm_job<0>(g, WSF(WS_KV), 512, bid, nblk, lds); }
        });
        PHASE(base + 3, {
            for (int j = 0; j < 2; ++j) { GemmOp g; g.A = WSF(WS_HID) + (size_t)j * NCR * 256; g.lda = 256; g.aidx = nullptr; g.B = w.cmp_w2 + (size_t)j * 256 * 64; g.ldb = 64; g.M = NCR; g.N = 64; g.K = 256;
                gemm_job<0>(g, WSF(WS_KCVC) + (size_t)j * NCR * 64, 64, bid, nblk, lds); }
            job_rnn_scan(p, bid, nblk);
            job_q_rope(p, bid, nblk);
        });
        PHASE(base + 4, { job_nsa_cmp(p, bid, nblk); job_attn<1>(p, layer, bid, nblk); job_attn<4>(p, layer, bid, nblk); job_attn<2>(p, layer, bid, nblk); });
        PHASE(base + 5, { job_nsa_select(p, bid, nblk, lds); });
        PHASE(base + 6, { job_attn<0>(p, layer, bid, nblk); });
        PHASE(base + 7, { job_merge(p, w, bid, nblk, lds); });
        PHASE(base + 8, { GemmOp g; g.A = WSF(WS_M); g.lda = 1024; g.aidx = nullptr; g.B = w.w_out; g.ldb = 1024; g.M = T; g.N = 1024; g.K = 1024; gemm_job<0>(g, WSF(WS_Y), 1024, bid, nblk, lds); });
        PHASE(base + 9, { job_ln(Xin, WSF(WS_Y), 1024, nullptr, w.ln1_g, w.ln1_b, WSF(WS_XA), bid, nblk); });
        PHASE(base + 10, { GemmOp g; g.A = WSF(WS_XA); g.lda = 1024; g.aidx = nullptr; g.B = w.wq; g.ldb = 512; g.M = T; g.N = 512; g.K = 1024; gemm_job<0>(g, WSF(WS_XQ), 512, bid, nblk, lds); });
        PHASE(base + 11, { job_attn<3>(p, layer, bid, nblk); });
        PHASE(base + 12, { GemmOp g; g.A = WSF(WS_XO); g.lda = 512; g.aidx = nullptr; g.B = w.wo; g.ldb = 1024; g.M = T; g.N = 1024; g.K = 512; gemm_job<0>(g, WSF(WS_Y), 1024, bid, nblk, lds); });
        PHASE(base + 13, { job_ln(WSF(WS_XA), WSF(WS_Y), 1024, nullptr, w.ln2_g, w.ln2_b, WSF(WS_XB), bid, nblk); });
        PHASE(base + 14, {
            { GemmOp g; g.A = WSF(WS_XB); g.lda = 1024; g.aidx = nullptr; g.B = w.rg_w; g.ldb = 4; g.M = T; g.N = 4; g.K = 1024; gemm_job<0>(g, WSF(WS_LOG), 36, bid, nblk, lds); }
            { GemmOp g; g.A = WSF(WS_XB); g.lda = 1024; g.aidx = nullptr; g.B = w.re_w; g.ldb = 32; g.M = T; g.N = 32; g.K = 1024; gemm_job<0>(g, WSF(WS_LOG) + 4, 36, bid, nblk, lds); }
        });
        PHASE(base + 15, { job_router(p, w, layer, bid, nblk); });
        PHASE(base + 16, { job_fill(p, layer, bid, nblk); });
        PHASE(base + 17, { job_moe_gemm<0>(p, w, layer, WSF(WS_XB), bid, nblk, lds); });
        PHASE(base + 18, { job_moe_act(p, bid, nblk); });
        PHASE(base + 19, { job_moe_gemm<1>(p, w, layer, WSF(WS_XB), bid, nblk, lds); });
        PHASE(base + 20, { job_ln(WSF(WS_XB), WSF(WS_YK), 2048, WSF(WS_YK) + 1024, w.ln3_g, w.ln3_b, Xout, bid, nblk); });
    }
}

extern "C" void kernel_launch(void* const* d_in, const int* in_sizes, int n_in, void* d_out, int out_size, void* d_ws, size_t ws_size, hipStream_t stream) {
    constexpr size_t kDynLds = 36864;
    static int grid = 0;
    if (!grid) {
        int dev = 0, cus = 0, per_cu = 0;
        hipGetDevice(&dev);
        hipDeviceGetAttribute(&cus, hipDeviceAttributeMultiprocessorCount, dev);
        hipOccupancyMaxActiveBlocksPerMultiprocessor(&per_cu, mega, NT, kDynLds);
        if (per_cu < 1) per_cu = 1;
        grid = cus * (per_cu < 2 ? per_cu : 2);
    }
    if (ws_size < WS_END) { fprintf(stderr, "workspace too small: %zu < %zu\n", ws_size, (size_t)WS_END); return; }
    Params p{};
    for (int i = 0; i < 34; ++i) p.in[i] = (const float*)d_in[i];
    p.out = (float*)d_out;
    p.ws = (unsigned char*)d_ws;
    hipMemsetAsync(d_ws, 0, CTL_BYTES, stream);
#if MK_ONE_LAUNCH
    hipLaunchKernelGGL(mega, dim3(grid), dim3(NT), kDynLds, stream, p, 0, NPHASES);
#else
    for (int ph = 0; ph < NPHASES; ++ph) hipLaunchKernelGGL(mega, dim3(grid), dim3(NT), kDynLds, stream, p, ph, ph + 1);
#endif
}
```

```cpp
#include <hip/hip_runtime.h>
#include <stdint.h>
#include <stdio.h>

#ifndef MK_ONE_LAUNCH
#define MK_ONE_LAUNCH 1
#endif

#define DI __device__ __forceinline__
#define LAS __attribute__((address_space(3)))

constexpr int NT = 256;
constexpr int D = 1024, BATCH = 8, SEQ = 2048, T = BATCH * SEQ, DEPTH = 4;
constexpr int MEM_LEN = 256;
constexpr int NIN = 6764;
constexpr int O_AQ = 0, O_AKC = 256, O_AVC = 384, O_AKS = 512, O_AVS = 640, O_AKW = 768, O_AVW = 896, O_AG = 1024,
              O_BQ = 1036, O_BK = 1292, O_BV = 1548, O_CX = 1804, O_CG = 2060, O_DCQ = 2316, O_DCKV = 2508, O_DKR = 2636,
              O_MG = 2668;
constexpr int NCMP = 127, NCR = BATCH * NCMP * 2;
constexpr int NEXP = 32, NASSIGN = T * 2;
constexpr float DN_ALPHA = 1.681792830507429f;

constexpr size_t MiB = 1u << 20;
constexpr size_t al(size_t x) { return (x + 255) & ~(size_t)255; }
constexpr size_t WS_CTL = 0, CTL_BYTES = 1 * MiB;
constexpr size_t WS_H = WS_CTL + CTL_BYTES;
constexpr size_t SZ_H = al((size_t)T * NIN * 4);
constexpr size_t WS_GU = WS_H;
constexpr size_t WS_HH = WS_GU + (size_t)NASSIGN * 1024 * 4;
constexpr size_t WS_YK = WS_HH + (size_t)NASSIGN * 512 * 4;
static_assert(WS_YK + (size_t)NASSIGN * 1024 * 4 <= WS_H + SZ_H, "moe overlay fits in H");
constexpr size_t WS_TB = WS_H + SZ_H;
constexpr size_t WS_HID = WS_TB + al((size_t)2 * NCR * 2048 * 4);
constexpr size_t WS_KCVC = WS_HID + al((size_t)2 * NCR * 256 * 4);
constexpr size_t WS_PC = WS_KCVC + al((size_t)2 * NCR * 64 * 4);
constexpr size_t WS_SEL = WS_PC + al((size_t)BATCH * 4 * SEQ * 128 * 4);
constexpr size_t WS_OW = WS_SEL + al((size_t)BATCH * 2 * SEQ * 4);
constexpr size_t WS_BR = WS_OW + al((size_t)T * 256 * 4);
constexpr size_t WS_U = WS_BR + al((size_t)T * 1024 * 4);
constexpr size_t WS_RA = WS_U + al((size_t)T * 256 * 4);
constexpr size_t WS_RB = WS_RA + al((size_t)T * 256 * 4);
constexpr size_t WS_CQN = WS_RB + al((size_t)T * 256 * 4);
constexpr size_t WS_CKVN = WS_CQN + al((size_t)T * 192 * 4);
constexpr size_t WS_KR = WS_CKVN + al((size_t)T * 128 * 4);
constexpr size_t WS_Q = WS_KR + al((size_t)T * 32 * 4);
constexpr size_t WS_KV = WS_Q + al((size_t)T * 384 * 4);
constexpr size_t WS_M = WS_KV + al((size_t)T * 512 * 4);
constexpr size_t WS_Y = WS_M + al((size_t)T * 1024 * 4);
constexpr size_t WS_XA = WS_Y + al((size_t)T * 1024 * 4);
constexpr size_t WS_XB = WS_XA + al((size_t)T * 1024 * 4);
constexpr size_t WS_XC = WS_XB + al((size_t)T * 1024 * 4);
constexpr size_t WS_XQ = WS_XC + al((size_t)T * 1024 * 4);
constexpr size_t WS_XO = WS_XQ + al((size_t)T * 512 * 4);
constexpr size_t WS_KVM = WS_XO + al((size_t)T * 512 * 4);
constexpr size_t WS_LOG = WS_KVM + al((size_t)DEPTH * 2048 * 1024 * 4);
constexpr size_t WS_EIDX = WS_LOG + al((size_t)T * 36 * 4);
constexpr size_t WS_ESLOT = WS_EIDX + al((size_t)NASSIGN * 4);
constexpr size_t WS_EW = WS_ESLOT + al((size_t)NASSIGN * 4);
constexpr size_t WS_PERM = WS_EW + al((size_t)NASSIGN * 4);
constexpr size_t WS_END = WS_PERM + al((size_t)NASSIGN * 4);

constexpr int CW_BAR = 4096;
constexpr int CW_CNT = 16384;

struct Params {
    const float* in[34];
    float* out;
    unsigned char* ws;
};

#define XB_TMO      128
#define XB_XCNT(j)  (256  + 64 * (j))
#define XB_XSUB(j)  (1280 + 64 * (j))
#define XB_XGEN(j)  (2304 + 64 * (j))
#define XB_TOP      3328
#define XB_TOPGEN   3392
#define XCD_BAR_WORDS 3456
#define XB_SPIN_CAP (1u << 22)

__device__ __forceinline__ unsigned xb_ld(unsigned* p)              { return __hip_atomic_load(p, __ATOMIC_RELAXED, __HIP_MEMORY_SCOPE_AGENT); }
__device__ __forceinline__ unsigned xb_add(unsigned* p, unsigned v) { return __hip_atomic_fetch_add(p, v, __ATOMIC_RELAXED, __HIP_MEMORY_SCOPE_AGENT); }
__device__ __forceinline__ unsigned xb_xcc_id() { return (unsigned)__builtin_amdgcn_s_getreg((3 << 11) | 20) & 0xFu; }
#define XB_SPIN(cond, bar) do { unsigned _sp = 0; while (cond) { __builtin_amdgcn_s_sleep(1); \
    if ((++_sp & 255u) == 0u) { if (xb_ld(&(bar)[XB_TMO])) break; if (_sp > XB_SPIN_CAP) { atomicAdd(&(bar)[XB_TMO], 1u); break; } } } } while (0)

struct XcdBarrier { unsigned* bar; unsigned x; volatile LAS unsigned* st; };

__device__ __forceinline__ XcdBarrier xcd_barrier_post(unsigned* bar, volatile LAS unsigned* st) {
    XcdBarrier b; b.bar = bar; b.x = xb_xcc_id(); b.st = st;
    if (threadIdx.x == 0) (void)xb_add(&bar[XB_XCNT(b.x)], 1u);
    return b;
}
__device__ __forceinline__ void xcd_barrier_complete(unsigned* bar, unsigned x, unsigned& nloc, unsigned& nx) {
    const unsigned G = gridDim.x * gridDim.y * gridDim.z;
    unsigned sum, cnt, mine, sp = 0u;
    for (;;) {
        sum = 0u; cnt = 0u; mine = 0u;
#pragma unroll
        for (unsigned j = 0; j < 16; ++j) { const unsigned c = xb_ld(&bar[XB_XCNT(j)]); sum += c; cnt += (c > 0u) ? 1u : 0u; mine = (j == x) ? c : mine; }
        if (sum == G) break;
        __builtin_amdgcn_s_sleep(1);
        if ((++sp & 255u) == 0u) { if (xb_ld(&bar[XB_TMO])) break; if (sp > XB_SPIN_CAP) { atomicAdd(&bar[XB_TMO], 1u); break; } }
    }
    nloc = mine > 0u ? mine : 1u; nx = cnt > 0u ? cnt : 1u;
}
__device__ __forceinline__ void xcd_barrier(const XcdBarrier& b) {
    asm volatile("s_waitcnt vmcnt(0)" ::: "memory");
    __syncthreads();
    if (threadIdx.x == 0) {
        unsigned* bar = b.bar;
        __builtin_amdgcn_s_waitcnt(0);
        unsigned nloc = b.st[0], nx = b.st[1];
        if (nloc == 0u) { xcd_barrier_complete(bar, b.x, nloc, nx); b.st[0] = nloc; b.st[1] = nx; }
        const unsigned old = xb_add(&bar[XB_XSUB(b.x)], 1u);
        const unsigned gen = old / nloc;
        if (old + 1u == (gen + 1u) * nloc) {
            __builtin_amdgcn_fence(__ATOMIC_RELEASE, "agent");
            asm volatile("s_waitcnt vmcnt(0)" ::: "memory");
            const unsigned og = xb_add(&bar[XB_TOP], 1u);
            const unsigned tg = og / nx;
            if (og + 1u == (tg + 1u) * nx) xb_add(&bar[XB_TOPGEN], 1u);
            else XB_SPIN(xb_ld(&bar[XB_TOPGEN]) == tg, bar);
            __builtin_amdgcn_fence(__ATOMIC_ACQUIRE, "agent");
            xb_add(&bar[XB_XGEN(b.x)], 1u);
            asm volatile("s_waitcnt vmcnt(0)" ::: "memory");
        } else {
            XB_SPIN(xb_ld(&bar[XB_XGEN(b.x)]) == gen, bar);
            __builtin_amdgcn_fence(__ATOMIC_ACQUIRE, "agent");
            asm volatile("s_waitcnt vmcnt(0)" ::: "memory");
        }
    }
    __syncthreads();
}

DI float gelu_tanh(float x) { const float u = 0.7978845608028654f * (x + 0.044715f * x * x * x); return 0.5f * x * (1.f + tanhf(u)); }
DI float sigm(float x) { return 1.f / (1.f + expf(-x)); }
DI float logsig(float z) { return fminf(z, 0.f) - log1pf(expf(-fabsf(z))); }
DI float wave_sum(float v) {
#pragma unroll
    for (int o = 32; o > 0; o >>= 1) v += __shfl_xor(v, o, 64);
    return v;
}

struct GemmOp {
    const float* A; int lda; const int* aidx;
    const float* B; int ldb;
    int M, N, K;
};

DI void gemm_tile(const GemmOp& g, int m0, int n0, float (&acc)[8][8], float* lds) {
    float* As = lds;
    float* Bs = lds + 8 * 132;
    const int tid = threadIdx.x, tx = tid & 15, ty = tid >> 4;
#pragma unroll
    for (int i = 0; i < 8; ++i)
#pragma unroll
        for (int j = 0; j < 8; ++j) acc[i][j] = 0.f;
    const int ar = m0 + (tid >> 1), ak = (tid & 1) * 4;
    const int bk = tid >> 5, bn = n0 + (tid & 31) * 4;
    const float* aptr = nullptr;
    if (ar < g.M) { const long src = g.aidx ? (long)(g.aidx[ar] >> 1) : (long)ar; aptr = g.A + src * g.lda + ak; }
    const float* bptr = (bn < g.N) ? g.B + (long)bk * g.ldb + bn : nullptr;
    float4 av = aptr ? *(const float4*)aptr : make_float4(0.f, 0.f, 0.f, 0.f);
    float4 bv = bptr ? *(const float4*)bptr : make_float4(0.f, 0.f, 0.f, 0.f);
    for (int k0 = 0; k0 < g.K; k0 += 8) {
        __syncthreads();
        As[(ak + 0) * 132 + (tid >> 1)] = av.x; As[(ak + 1) * 132 + (tid >> 1)] = av.y;
        As[(ak + 2) * 132 + (tid >> 1)] = av.z; As[(ak + 3) * 132 + (tid >> 1)] = av.w;
        *(float4*)&Bs[bk * 128 + (tid & 31) * 4] = bv;
        __syncthreads();
        if (k0 + 8 < g.K) {
            if (aptr) av = *(const float4*)(aptr + k0 + 8);
            if (bptr) bv = *(const float4*)(bptr + (long)(k0 + 8) * g.ldb);
        }
#pragma unroll
        for (int kk = 0; kk < 8; ++kk) {
            const float4 a0 = *(const float4*)&As[kk * 132 + ty * 4], a1 = *(const float4*)&As[kk * 132 + 64 + ty * 4];
            const float4 b0 = *(const float4*)&Bs[kk * 128 + tx * 4], b1 = *(const float4*)&Bs[kk * 128 + 64 + tx * 4];
            const float a[8] = {a0.x, a0.y, a0.z, a0.w, a1.x, a1.y, a1.z, a1.w};
            const float b[8] = {b0.x, b0.y, b0.z, b0.w, b1.x, b1.y, b1.z, b1.w};
#pragma unroll
            for (int i = 0; i < 8; ++i)
#pragma unroll
                for (int j = 0; j < 8; ++j) acc[i][j] = fmaf(a[i], b[j], acc[i][j]);
        }
    }
}
#define GEMM_FOREACH(acc, m0, n0, M_, N_, ROW, COL, V, ...) do { const int _tx = threadIdx.x & 15, _ty = threadIdx.x >> 4; \
    _Pragma("unroll") for (int _i = 0; _i < 8; ++_i) { const int ROW = (m0) + (_i < 4 ? _ty * 4 + _i : 64 + _ty * 4 + _i - 4); \
    _Pragma("unroll") for (int _jh = 0; _jh < 2; ++_jh) { const int COL = (n0) + _jh * 64 + _tx * 4; \
        if (ROW < (M_) && COL < (N_)) { float4 V = make_float4(acc[_i][_jh * 4], acc[_i][_jh * 4 + 1], acc[_i][_jh * 4 + 2], acc[_i][_jh * 4 + 3]); __VA_ARGS__ } } } } while (0)

template <int ACT>
DI void gemm_job(const GemmOp& g, float* C, int ldc, int bid, int nblk, float* lds) {
    const int tm = (g.M + 127) / 128, tn = (g.N + 127) / 128;
    for (int u = bid; u < tm * tn; u += nblk) {
        const int m0 = (u / tn) * 128, n0 = (u % tn) * 128;
        float acc[8][8];
        gemm_tile(g, m0, n0, acc, lds);
        GEMM_FOREACH(acc, m0, n0, g.M, g.N, row, col, v, {
            if (ACT == 1) { v.x = gelu_tanh(v.x); v.y = gelu_tanh(v.y); v.z = gelu_tanh(v.z); v.w = gelu_tanh(v.w); }
            *(float4*)(C + (long)row * ldc + col) = v; });
    }
}

struct LayerW {
    const float *w_in, *cmp_pos, *cmp_w1, *cmp_w2, *conv_w, *conv_b, *ga_w, *ga_b, *gx_w, *gx_b, *lam, *q_norm, *kv_norm, *w_uq, *w_ukv,
        *w_branch, *w_out, *ln1_g, *ln1_b, *wq, *wkv, *wo, *ln2_g, *ln2_b, *rg_w, *rg_b, *re_w, *re_b, *w_gu, *w_down, *ln3_g, *ln3_b;
};
DI LayerW layer_w(const Params& p, int l) {
    LayerW w;
    w.w_in = p.in[2] + (size_t)l * D * NIN;
    w.cmp_pos = p.in[3] + (size_t)l * 2 * 32 * 64;
    w.cmp_w1 = p.in[4] + (size_t)l * 2 * 2048 * 256;
    w.cmp_w2 = p.in[5] + (size_t)l * 2 * 256 * 64;
    w.conv_w = p.in[6] + (size_t)l * 4 * 256;
    w.conv_b = p.in[7] + (size_t)l * 256;
    w.ga_w = p.in[8] + (size_t)l * 4 * 64 * 64;
    w.ga_b = p.in[9] + (size_t)l * 256;
    w.gx_w = p.in[10] + (size_t)l * 4 * 64 * 64;
    w.gx_b = p.in[11] + (size_t)l * 256;
    w.lam = p.in[12] + (size_t)l * 256;
    w.q_norm = p.in[13] + (size_t)l * 192;
    w.kv_norm = p.in[14] + (size_t)l * 128;
    w.w_uq = p.in[15] + (size_t)l * 192 * 384;
    w.w_ukv = p.in[16] + (size_t)l * 128 * 512;
    w.w_branch = p.in[17] + (size_t)l * 4 * 256 * 1024;
    w.w_out = p.in[18] + (size_t)l * 1024 * 1024;
    w.ln1_g = p.in[19] + (size_t)l * 1024; w.ln1_b = p.in[20] + (size_t)l * 1024;
    w.wq = p.in[21] + (size_t)l * 1024 * 512;
    w.wkv = p.in[22] + (size_t)l * 1024 * 1024;
    w.wo = p.in[23] + (size_t)l * 512 * 1024;
    w.ln2_g = p.in[24] + (size_t)l * 1024; w.ln2_b = p.in[25] + (size_t)l * 1024;
    w.rg_w = p.in[26] + (size_t)l * 1024 * 4; w.rg_b = p.in[27] + (size_t)l * 4;
    w.re_w = p.in[28] + (size_t)l * 1024 * 32; w.re_b = p.in[29] + (size_t)l * 32;
    w.w_gu = p.in[30] + (size_t)l * 32 * 1024 * 1024;
    w.w_down = p.in[31] + (size_t)l * 32 * 512 * 1024;
    w.ln3_g = p.in[32] + (size_t)l * 1024; w.ln3_b = p.in[33] + (size_t)l * 1024;
    return w;
}
#define WSF(off) ((float*)(p.ws + (off)))
#define WSI(off) ((int*)(p.ws + (off)))
#define WSU(off) ((unsigned*)(p.ws + (off)))

DI void job_cmp_gather(const Params& p, const LayerW& w, int bid, int nblk) {
    const float* H = WSF(WS_H); float* TB = WSF(WS_TB);
    const long total = (long)2 * NCR * 2048 / 4;
    for (long e = (long)bid * NT + threadIdx.x; e < total; e += (long)nblk * NT) {
        const long e4 = e * 4;
        const int f = (int)(e4 % 2048); const long r2 = e4 / 2048; const int r = (int)(r2 % NCR), j = (int)(r2 / NCR);
        const int g = r & 1, bc = r >> 1, c = bc % NCMP, b = bc / NCMP, i = f >> 6, d = f & 63;
        const float4 hv = *(const float4*)(H + (long)(b * SEQ + 16 * c + i) * NIN + (j ? O_AVC : O_AKC) + g * 64 + d);
        const float4 pv = *(const float4*)(w.cmp_pos + (j * 32 + i) * 64 + d);
        *(float4*)(TB + e4) = make_float4(hv.x + pv.x, hv.y + pv.y, hv.z + pv.z, hv.w + pv.w);
    }
}
DI void job_rnn_conv(const Params& p, const LayerW& w, int bid, int nblk) {
    const float* H = WSF(WS_H); float* U = WSF(WS_U);
    for (long e = (long)bid * NT + threadIdx.x; e < (long)T * 256; e += (long)nblk * NT) {
        const int ch = (int)(e & 255); const int t = (int)(e >> 8), s = t & (SEQ - 1);
        float u = w.conv_b[ch];
#pragma unroll
        for (int tap = 0; tap < 4; ++tap) { const int sp = s - 3 + tap; if (sp >= 0) u += H[(long)(t - 3 + tap) * NIN + O_CX + ch] * w.conv_w[tap * 256 + ch]; }
        U[e] = u;
    }
}
DI void job_rnn_gates(const Params& p, const LayerW& w, int bid, int nblk) {
    const float* U = WSF(WS_U); float* RA = WSF(WS_RA); float* RB = WSF(WS_RB);
    for (long e = (long)bid * NT + threadIdx.x; e < (long)T * 256; e += (long)nblk * NT) {
        const int ch = (int)(e & 255); const long t = e >> 8; const int blk = ch >> 6, j = ch & 63;
        const float* ur = U + t * 256 + blk * 64;
        float sa = 0.f, sx = 0.f;
        for (int c = 0; c < 64; ++c) { const float uv = ur[c]; sa = fmaf(uv, w.ga_w[(blk * 64 + c) * 64 + j], sa); sx = fmaf(uv, w.gx_w[(blk * 64 + c) * 64 + j], sx); }
        const float r = sigm(sa + w.ga_b[ch]), ig = sigm(sx + w.gx_b[ch]);
        const float nl = -w.lam[ch];
        const float sp = fmaxf(nl, 0.f) + log1pf(expf(-fabsf(nl)));
        const float log_a = -8.0f * r * sp;
        RA[e] = expf(log_a);
        RB[e] = sqrtf(-expm1f(2.0f * log_a)) * (ig * U[e]);
    }
}
DI void job_rnn_scan(const Params& p, int bid, int nblk) {
    const float* H = WSF(WS_H); const float* RA = WSF(WS_RA); const float* RB = WSF(WS_RB); float* BR = WSF(WS_BR);
    for (int e = bid * NT + threadIdx.x; e < BATCH * 256; e += nblk * NT) {
        const int ch = e & 255, b = e >> 8;
        float h = 0.f;
        for (int s0 = 0; s0 < SEQ; s0 += 8) {
            float av[8], bv[8], gv[8];
#pragma unroll
            for (int i = 0; i < 8; ++i) { const long t = (long)b * SEQ + s0 + i; av[i] = RA[t * 256 + ch]; bv[i] = RB[t * 256 + ch]; gv[i] = H[t * NIN + O_CG + ch]; }
#pragma unroll
            for (int i = 0; i < 8; ++i) { const long t = (long)b * SEQ + s0 + i; h = av[i] * h + bv[i]; BR[t * 1024 + 2 * 256 + ch] = h * gelu_tanh(gv[i]); }
        }
    }
}
DI void job_mla_norm(const Params& p, const LayerW& w, int bid, int nblk) {
    const float* H = WSF(WS_H); float* CQN = WSF(WS_CQN); float* CKVN = WSF(WS_CKVN); float* KR = WSF(WS_KR);
    const int lane = threadIdx.x & 63, wid = threadIdx.x >> 6;
    for (int t = bid * 4 + wid; t < T; t += nblk * 4) {
        const float* hr = H + (long)t * NIN;
        float q0 = hr[O_DCQ + lane], q1 = hr[O_DCQ + 64 + lane], q2 = hr[O_DCQ + 128 + lane];
        float ss = wave_sum(q0 * q0 + q1 * q1 + q2 * q2);
        float rs = rsqrtf(ss * (1.f / 192.f) + 1e-6f);
        CQN[(long)t * 192 + lane] = q0 * rs * w.q_norm[lane];
        CQN[(long)t * 192 + 64 + lane] = q1 * rs * w.q_norm[64 + lane];
        CQN[(long)t * 192 + 128 + lane] = q2 * rs * w.q_norm[128 + lane];
        float k0 = hr[O_DCKV + lane], k1 = hr[O_DCKV + 64 + lane];
        ss = wave_sum(k0 * k0 + k1 * k1);
        rs = rsqrtf(ss * (1.f / 128.f) + 1e-6f);
        CKVN[(long)t * 128 + lane] = k0 * rs * w.kv_norm[lane];
        CKVN[(long)t * 128 + 64 + lane] = k1 * rs * w.kv_norm[64 + lane];
        if (lane < 16) {
            const int s = t & (SEQ - 1);
            const float inv = powf(10000.f, -(float)(2 * lane) / 32.f);
            const float ang = (float)s * inv, cs = cosf(ang), sn = sinf(ang);
            const float x1 = hr[O_DKR + lane], x2 = hr[O_DKR + 16 + lane];
            KR[(long)t * 32 + lane] = x1 * cs - x2 * sn;
            KR[(long)t * 32 + 16 + lane] = x1 * sn + x2 * cs;
        }
    }
}
DI void job_q_rope(const Params& p, int bid, int nblk) {
    float* Q = WSF(WS_Q);
    for (long e = (long)bid * NT + threadIdx.x; e < (long)T * 64; e += (long)nblk * NT) {
        const int i = (int)(e & 15), h = (int)((e >> 4) & 3); const long t = e >> 6; const int s = (int)(t & (SEQ - 1));
        const float inv = powf(10000.f, -(float)(2 * i) / 32.f);
        const float ang = (float)s * inv, cs = cosf(ang), sn = sinf(ang);
        float* q = Q + t * 384 + h * 96 + 64;
        const float x1 = q[i], x2 = q[16 + i];
        q[i] = x1 * cs - x2 * sn; q[16 + i] = x1 * sn + x2 * cs;
    }
}

DI void job_nsa_cmp(const Params& p, int bid, int nblk) {
    const float* H = WSF(WS_H); const float* KC = WSF(WS_KCVC); const float* VC = KC + (size_t)NCR * 64;
    float* PC = WSF(WS_PC); float* BR = WSF(WS_BR);
    const int lane = threadIdx.x & 63, wid = threadIdx.x >> 6;
    for (int item0 = bid * 4 + wid; item0 < BATCH * 4 * 32; item0 += nblk * 4) {
        const int item = __builtin_amdgcn_readfirstlane(item0);
        const int qt = item & 31, h = (item >> 5) & 3, b = item >> 7, g = h >> 1, n = h & 1;
        const int s = qt * 64 + lane; const long t = (long)b * SEQ + s;
        const float slope = exp2f(-2.f * (float)(h + 1));
        float q[64];
#pragma unroll
        for (int d = 0; d < 64; d += 4) { const float4 v = *(const float4*)(H + t * NIN + O_AQ + h * 64 + d); q[d] = v.x; q[d + 1] = v.y; q[d + 2] = v.z; q[d + 3] = v.w; }
        const int smax = qt * 64 + 63;
        const int cend = smax >= 31 ? (smax - 31) / 16 + 1 : 0;
        float m = -1e30f, l = 0.f;
        for (int c = 0; c < cend; ++c) {
            const float* kr = KC + ((long)(b * NCMP + c) * 2 + g) * 64;
            float dot = 0.f;
#pragma unroll
            for (int d = 0; d < 64; ++d) dot = fmaf(q[d], kr[d], dot);
            const int dist = s - (16 * c + 31);
            const bool valid = dist >= 0;
            const float sc = valid ? dot * 0.125f - slope * (float)dist : -1e30f;
            const float mn = fmaxf(m, sc);
            l = l * expf(m - mn) + (valid ? expf(sc - mn) : 0.f);
            m = mn;
        }
        const float rl = 1.f / fmaxf(l, 1e-30f);
        float o[64];
#pragma unroll
        for (int d = 0; d < 64; ++d) o[d] = 0.f;
        float* pcrow = PC + ((long)((b * 2 + g) * 2 + n) * SEQ + s) * 128;
        for (int c = 0; c < 128; ++c) {
            float pr = 0.f;
            if (c < cend) {
                const float* kr = KC + ((long)(b * NCMP + c) * 2 + g) * 64;
                float dot = 0.f;
#pragma unroll
                for (int d = 0; d < 64; ++d) dot = fmaf(q[d], kr[d], dot);
                const int dist = s - (16 * c + 31);
                if (dist >= 0) pr = expf(dot * 0.125f - slope * (float)dist - m) * rl;
                const float* vr = VC + ((long)(b * NCMP + c) * 2 + g) * 64;
#pragma unroll
                for (int d = 0; d < 64; ++d) o[d] = fmaf(pr, vr[d], o[d]);
            }
            pcrow[c] = pr;
        }
        const float g0 = sigm(H[t * NIN + O_AG + h * 3 + 0]);
#pragma unroll
        for (int d = 0; d < 64; d += 4) *(float4*)(BR + t * 1024 + h * 64 + d) = make_float4(g0 * o[d], g0 * o[d + 1], g0 * o[d + 2], g0 * o[d + 3]);
    }
}
DI void job_nsa_select(const Params& p, int bid, int nblk, float* lds) {
    const float* PC = WSF(WS_PC); unsigned* SEL = WSU(WS_SEL);
    float* simp = lds + threadIdx.x * 33;
    for (int e = bid * NT + threadIdx.x; e < BATCH * 2 * SEQ; e += nblk * NT) {
        const int s = e & (SEQ - 1), bg = e >> 11;
        const float* p0 = PC + ((long)(bg * 2 + 0) * SEQ + s) * 128;
        const float* p1 = PC + ((long)(bg * 2 + 1) * SEQ + s) * 128;
        const int cur = s >> 6;
        float prev = 0.f;
        for (int j = 0; j < 32; ++j) {
            const float4 a = *(const float4*)(p0 + 4 * j), c = *(const float4*)(p1 + 4 * j);
            const float P0 = a.x + c.x, P1 = a.y + c.y, P2 = a.z + c.z, P3 = a.w + c.w;
            float imp = P0 + P1 + P2 + 0.5f * (P3 + prev);
            prev = P3;
            const bool forced = (j == 0) || (j == cur), valid = (j * 64 <= s);
            simp[j] = forced ? 1e4f : (valid ? imp : -1.0f);
        }
        unsigned mask = 0u;
        for (int it = 0; it < 8; ++it) {
            float best = -3e38f; int bj = 0;
            for (int j = 0; j < 32; ++j) { const float v = simp[j]; if (!((mask >> j) & 1u) && v > best) { best = v; bj = j; } }
            mask |= 1u << bj;
        }
        SEL[e] = mask;
    }
}

template <int MODE>
DI void job_attn(const Params& p, int layer, int bid, int nblk) {
    constexpr int DQK = MODE == 2 ? 96 : (MODE == 3 ? 128 : 64);
    const float* H = WSF(WS_H);
    const int lane = threadIdx.x & 63, wid = threadIdx.x >> 6;
    const int nitems = (MODE == 3) ? BATCH * 4 * 32 * 2 : BATCH * 4 * 32;
    for (int item0 = bid * 4 + wid; item0 < nitems; item0 += nblk * 4) {
        int item = __builtin_amdgcn_readfirstlane(item0);
        int half = 0; if (MODE == 3) { half = item & 1; item >>= 1; }
        const int qt = item & 31, h = (item >> 5) & 3, b = item >> 7, g = h >> 1;
        const int s = qt * 64 + lane; const long t = (long)b * SEQ + s;
        const int smin = qt * 64, smax = qt * 64 + 63;
        const float slope = exp2f(-2.f * (float)(h + 1));
        const float* qrow;
        if (MODE == 0 || MODE == 1) qrow = H + t * NIN + O_AQ + h * 64;
        else if (MODE == 2) qrow = WSF(WS_Q) + t * 384 + h * 96;
        else if (MODE == 3) qrow = WSF(WS_XQ) + t * 512 + h * 128;
        else qrow = H + t * NIN + O_BQ + h * 64;
        float q[DQK];
#pragma unroll
        for (int d = 0; d < DQK; d += 4) { const float4 v = *(const float4*)(qrow + d); q[d] = v.x; q[d + 1] = v.y; q[d + 2] = v.z; q[d + 3] = v.w; }
        float o[64];
#pragma unroll
        for (int d = 0; d < 64; ++d) o[d] = 0.f;
        unsigned selmask = 0u;
        if (MODE == 0) selmask = WSU(WS_SEL)[(b * 2 + g) * SEQ + s];
        const float scale = MODE == 2 ? 0.10206207261596577f : (MODE == 3 ? 0.08838834764831845f : 0.125f);
        if (MODE != 4) {
            int kbeg = 0, kend = smax;
            if (MODE == 1) kbeg = smin - 511 > 0 ? smin - 511 : 0;
            if (MODE == 3) kend = MEM_LEN - 1;
            float m = -1e30f, l = 0.f;
            for (int k = kbeg; k <= kend; ++k) {
                const float *kr, *kr2 = nullptr, *vr;
                if (MODE == 0) { kr = H + ((long)b * SEQ + k) * NIN + O_AKS + g * 64; vr = H + ((long)b * SEQ + k) * NIN + O_AVS + g * 64; }
                else if (MODE == 1) { kr = H + ((long)b * SEQ + k) * NIN + O_AKW + g * 64; vr = H + ((long)b * SEQ + k) * NIN + O_AVW + g * 64; }
                else if (MODE == 2) { kr = WSF(WS_KV) + ((long)b * SEQ + k) * 512 + h * 128; kr2 = WSF(WS_KR) + ((long)b * SEQ + k) * 32; vr = kr + 64; }
                else { kr = WSF(WS_KVM) + ((long)layer * 2048 + b * MEM_LEN + k) * 1024 + h * 128; vr = kr + 512 + half * 64; }
                float dot = 0.f;
                if constexpr (MODE == 2) {
#pragma unroll
                    for (int d = 0; d < 64; ++d) dot = fmaf(q[d], kr[d], dot);
#pragma unroll
                    for (int d = 0; d < 32; ++d) dot = fmaf(q[64 + d], kr2[d], dot);
                } else {
#pragma unroll
                    for (int d = 0; d < DQK; ++d) dot = fmaf(q[d], kr[d], dot);
                }
                bool valid = true; float sc = dot * scale;
                if (MODE == 0) { valid = (k <= s) && ((selmask >> (k >> 6)) & 1u); sc -= slope * (float)(s - k); }
                if (MODE == 1) { valid = (k <= s) && (s - k < 512); sc -= slope * (float)(s - k); }
                if (MODE == 2) valid = (k <= s);
                sc = valid ? sc : -1e30f;
                const float mn = fmaxf(m, sc);
                const float corr = expf(m - mn), pr = valid ? expf(sc - mn) : 0.f;
                l = l * corr + pr; m = mn;
#pragma unroll
                for (int d = 0; d < 64; ++d) o[d] = fmaf(pr, vr[d], o[d] * corr);
            }
            const float rl = 1.f / fmaxf(l, 1e-30f);
#pragma unroll
            for (int d = 0; d < 64; ++d) o[d] *= rl;
        } else {
            float tail = 0.f;
            for (int k = smax - 1; k >= 0; --k) {
                const float* kr = H + ((long)b * SEQ + k) * NIN + O_BK + h * 64;
                const float* vr = H + ((long)b * SEQ + k) * NIN + O_BV + h * 64;
                float dot = 0.f;
#pragma unroll
                for (int d = 0; d < 64; ++d) dot = fmaf(q[d], kr[d], dot);
                const float z = dot * 0.125f;
                const bool valid = k < s;
                const float lsp = logsig(z);
                const float a = valid ? expf(lsp + tail) : 0.f;
                tail += valid ? (lsp - z) : 0.f;
#pragma unroll
                for (int d = 0; d < 64; ++d) o[d] = fmaf(a, vr[d], o[d]);
            }
        }
        if (MODE == 0) {
            const float g1 = sigm(H[t * NIN + O_AG + h * 3 + 1]);
            float* br = WSF(WS_BR) + t * 1024 + h * 64; const float* ow = WSF(WS_OW) + t * 256 + h * 64;
#pragma unroll
            for (int d = 0; d < 64; d += 4) { float4 c = *(float4*)(br + d); const float4 w4 = *(const float4*)(ow + d);
                c.x += g1 * o[d] + w4.x; c.y += g1 * o[d + 1] + w4.y; c.z += g1 * o[d + 2] + w4.z; c.w += g1 * o[d + 3] + w4.w; *(float4*)(br + d) = c; }
        } else {
            float* dst; float gs = 1.f;
            if (MODE == 1) { dst = WSF(WS_OW) + t * 256 + h * 64; gs = sigm(H[t * NIN + O_AG + h * 3 + 2]); }
            else if (MODE == 2) dst = WSF(WS_BR) + t * 1024 + 3 * 256 + h * 64;
            else if (MODE == 3) dst = WSF(WS_XO) + t * 512 + h * 128 + half * 64;
            else dst = WSF(WS_BR) + t * 1024 + 1 * 256 + h * 64;
#pragma unroll
            for (int d = 0; d < 64; d += 4) *(float4*)(dst + d) = make_float4(gs * o[d], gs * o[d + 1], gs * o[d + 2], gs * o[d + 3]);
        }
    }
}

DI void job_merge(const Params& p, const LayerW& w, int bid, int nblk, float* lds) {
    const float* H = WSF(WS_H); float* M = WSF(WS_M);
    for (int u = bid; u < (T / 128) * 8; u += nblk) {
        const int m0 = (u >> 3) * 128, n0 = (u & 7) * 128;
        float macc[8][8];
#pragma unroll
        for (int i = 0; i < 8; ++i)
#pragma unroll
            for (int j = 0; j < 8; ++j) macc[i][j] = 0.f;
        for (int n = 0; n < 4; ++n) {
            GemmOp g; g.A = WSF(WS_BR) + n * 256; g.lda = 1024; g.aidx = nullptr; g.B = w.w_branch + (size_t)n * 256 * 1024; g.ldb = 1024; g.M = T; g.N = 1024; g.K = 256;
            float acc[8][8];
            gemm_tile(g, m0, n0, acc, lds);
            const int tx = threadIdx.x & 15, ty = threadIdx.x >> 4;
#pragma unroll
            for (int i = 0; i < 8; ++i) { const int row = m0 + (i < 4 ? ty * 4 + i : 64 + ty * 4 + i - 4);
#pragma unroll
                for (int jh = 0; jh < 2; ++jh) { const int col = n0 + jh * 64 + tx * 4;
                    const float4 gv = *(const float4*)(H + (long)row * NIN + O_MG + n * 1024 + col);
                    macc[i][jh * 4 + 0] += sigm(gv.x) * acc[i][jh * 4 + 0]; macc[i][jh * 4 + 1] += sigm(gv.y) * acc[i][jh * 4 + 1];
                    macc[i][jh * 4 + 2] += sigm(gv.z) * acc[i][jh * 4 + 2]; macc[i][jh * 4 + 3] += sigm(gv.w) * acc[i][jh * 4 + 3]; } }
        }
        GEMM_FOREACH(macc, m0, n0, T, 1024, row, col, v, { *(float4*)(M + (long)row * 1024 + col) = v; });
    }
}
DI void job_ln(const float* xin, const float* y, int ldy, const float* y2, const float* gw, const float* bw, float* out, int bid, int nblk) {
    const int lane = threadIdx.x & 63, wid = threadIdx.x >> 6;
    for (int t = bid * 4 + wid; t < T; t += nblk * 4) {
        float v[16];
        float s = 0.f;
#pragma unroll
        for (int i = 0; i < 4; ++i) {
            const int c = i * 256 + lane * 4;
            const float4 xv = *(const float4*)(xin + (long)t * 1024 + c);
            float4 yv = *(const float4*)(y + (long)t * ldy + c);
            if (y2) { const float4 z = *(const float4*)(y2 + (long)t * ldy + c); yv.x += z.x; yv.y += z.y; yv.z += z.z; yv.w += z.w; }
            v[i * 4 + 0] = DN_ALPHA * xv.x + yv.x; v[i * 4 + 1] = DN_ALPHA * xv.y + yv.y; v[i * 4 + 2] = DN_ALPHA * xv.z + yv.z; v[i * 4 + 3] = DN_ALPHA * xv.w + yv.w;
            s += (v[i * 4] + v[i * 4 + 1]) + (v[i * 4 + 2] + v[i * 4 + 3]);
        }
        const float mu = wave_sum(s) * (1.f / 1024.f);
        float q = 0.f;
#pragma unroll
        for (int i = 0; i < 16; ++i) { const float dlt = v[i] - mu; q += dlt * dlt; }
        const float rstd = rsqrtf(wave_sum(q) * (1.f / 1024.f) + 1e-5f);
#pragma unroll
        for (int i = 0; i < 4; ++i) {
            const int c = i * 256 + lane * 4;
            const float4 gv = *(const float4*)(gw + c), bv = *(const float4*)(bw + c);
            *(float4*)(out + (long)t * 1024 + c) = make_float4((v[i * 4] - mu) * rstd * gv.x + bv.x, (v[i * 4 + 1] - mu) * rstd * gv.y + bv.y,
                                                               (v[i * 4 + 2] - mu) * rstd * gv.z + bv.z, (v[i * 4 + 3] - mu) * rstd * gv.w + bv.w);
        }
    }
}
DI void job_router(const Params& p, const LayerW& w, int layer, int bid, int nblk) {
    const float* LOG = WSF(WS_LOG); int* EIDX = WSI(WS_EIDX); int* ESLOT = WSI(WS_ESLOT); float* EW = WSF(WS_EW);
    unsigned* cnt = WSU(WS_CTL) + CW_CNT + layer * 32;
    for (int t = bid * NT + threadIdx.x; t < T; t += nblk * NT) {
        const float* lr = LOG + (long)t * 36;
        const float g0 = lr[0] + w.rg_b[0], g1 = lr[1] + w.rg_b[1], g2 = lr[2] + w.rg_b[2], g3 = lr[3] + w.rg_b[3];
        const float gm = fmaxf(fmaxf(g0, g1), fmaxf(g2, g3));
        const float e0 = expf(g0 - gm), e1 = expf(g1 - gm), e2 = expf(g2 - gm), e3 = expf(g3 - gm);
        const float gs = (e0 + e1) + (e2 + e3);
        const float p0 = e0 / gs, p1 = e1 / gs, p2 = e2 / gs, p3 = e3 / gs;
        int grp = 0; float pg = p0;
        if (p1 > pg) { pg = p1; grp = 1; }
        if (p2 > pg) { pg = p2; grp = 2; }
        if (p3 > pg) { pg = p3; grp = 3; }
        float el[8];
#pragma unroll
        for (int i = 0; i < 8; ++i) el[i] = lr[4 + grp * 8 + i] + w.re_b[grp * 8 + i];
        float em = el[0];
#pragma unroll
        for (int i = 1; i < 8; ++i) em = fmaxf(em, el[i]);
        float es = 0.f;
#pragma unroll
        for (int i = 0; i < 8; ++i) { el[i] = expf(el[i] - em); es += el[i]; }
#pragma unroll
        for (int i = 0; i < 8; ++i) el[i] = el[i] / es;
        float b0 = el[0]; int i0 = 0;
#pragma unroll
        for (int i = 1; i < 8; ++i) if (el[i] > b0) { b0 = el[i]; i0 = i; }
        float b1 = -1.f; int i1 = 0;
#pragma unroll
        for (int i = 0; i < 8; ++i) if (i != i0 && el[i] > b1) { b1 = el[i]; i1 = i; }
        const float den = b0 + b1;
        const int ex0 = grp * 8 + i0, ex1 = grp * 8 + i1;
        EIDX[t * 2] = ex0; EIDX[t * 2 + 1] = ex1;
        EW[t * 2] = pg * b0 / den; EW[t * 2 + 1] = pg * b1 / den;
        ESLOT[t * 2] = (int)atomicAdd(&cnt[ex0], 1u);
        ESLOT[t * 2 + 1] = (int)atomicAdd(&cnt[ex1], 1u);
    }
}
DI void job_fill(const Params& p, int layer, int bid, int nblk) {
    const int* EIDX = WSI(WS_EIDX); const int* ESLOT = WSI(WS_ESLOT); int* PERM = WSI(WS_PERM);
    unsigned* cnt = WSU(WS_CTL) + CW_CNT + layer * 32;
    for (int a = bid * NT + threadIdx.x; a < NASSIGN; a += nblk * NT) {
        const int e = EIDX[a];
        int off = 0;
        for (int j = 0; j < e; ++j) off += (int)__hip_atomic_load(&cnt[j], __ATOMIC_RELAXED, __HIP_MEMORY_SCOPE_AGENT);
        PERM[off + ESLOT[a]] = a;
    }
}
template <int STAGE>
DI void job_moe_gemm(const Params& p, const LayerW& w, int layer, const float* X2, int bid, int nblk, float* lds) {
    unsigned* cnt = WSU(WS_CTL) + CW_CNT + layer * 32;
    int* s_off = (int*)(lds + 2200);
    int* s_uoff = s_off + 33;
    __syncthreads();
    if (threadIdx.x == 0) {
        int ro = 0, uo = 0;
        for (int e = 0; e < 32; ++e) { const int c = (int)__hip_atomic_load(&cnt[e], __ATOMIC_RELAXED, __HIP_MEMORY_SCOPE_AGENT); s_off[e] = ro; s_uoff[e] = uo; ro += c; uo += ((c + 127) / 128) * 8; }
        s_off[32] = ro; s_uoff[32] = uo;
    }
    __syncthreads();
    const int nunits = s_uoff[32];
    const int* PERM = WSI(WS_PERM);
    for (int u = bid; u < nunits; u += nblk) {
        int e = 0;
        while (e < 31 && u >= s_uoff[e + 1]) ++e;
        const int lu = u - s_uoff[e], m0 = (lu >> 3) * 128, n0 = (lu & 7) * 128;
        const int roff = s_off[e], cnt_e = s_off[e + 1] - roff;
        GemmOp g;
        if (STAGE == 0) { g.A = X2; g.lda = 1024; g.aidx = PERM + roff; g.B = w.w_gu + (size_t)e * 1024 * 1024; g.ldb = 1024; g.M = cnt_e; g.N = 1024; g.K = 1024; }
        else { g.A = WSF(WS_HH) + (size_t)roff * 512; g.lda = 512; g.aidx = nullptr; g.B = w.w_down + (size_t)e * 512 * 1024; g.ldb = 1024; g.M = cnt_e; g.N = 1024; g.K = 512; }
        float acc[8][8];
        gemm_tile(g, m0, n0, acc, lds);
        if (STAGE == 0) {
            float* GU = WSF(WS_GU);
            GEMM_FOREACH(acc, m0, n0, cnt_e, 1024, row, col, v, { *(float4*)(GU + (long)(roff + row) * 1024 + col) = v; });
        } else {
            float* YK = WSF(WS_YK); const float* EW = WSF(WS_EW);
            GEMM_FOREACH(acc, m0, n0, cnt_e, 1024, row, col, v, { const int a = PERM[roff + row]; const float sw = EW[a];
                *(float4*)(YK + (long)a * 1024 + col) = make_float4(v.x * sw, v.y * sw, v.z * sw, v.w * sw); });
        }
    }
}
DI void job_moe_act(const Params& p, int bid, int nblk) {
    const float* GU = WSF(WS_GU); float* HH = WSF(WS_HH);
    for (long e = (long)bid * NT + threadIdx.x; e < (long)NASSIGN * 128; e += (long)nblk * NT) {
        const long r = e >> 7; const int f = (int)(e & 127) * 4;
        const float4 gt = *(const float4*)(GU + r * 1024 + f), up = *(const float4*)(GU + r * 1024 + 512 + f);
        *(float4*)(HH + r * 512 + f) = make_float4(gt.x * sigm(gt.x) * up.x, gt.y * sigm(gt.y) * up.y, gt.z * sigm(gt.z) * up.z, gt.w * sigm(gt.w) * up.w);
    }
}

constexpr int NPH = 21;
constexpr int NPHASES = 1 + DEPTH * NPH;

__global__ void __launch_bounds__(NT, 1) mega(Params p, int ph_lo, int ph_hi) {
    extern __shared__ __attribute__((aligned(16))) float lds[];
    __shared__ uint4 xb_words;
    const int bid = blockIdx.x, nblk = gridDim.x;
    XcdBarrier bar;
    const bool multi = (ph_hi - ph_lo) > 1;
    if (multi) {
        if (threadIdx.x == 0) xb_words = make_uint4(0u, 0u, 0u, 0u);
        __syncthreads();
        bar = xcd_barrier_post(WSU(WS_CTL) + CW_BAR, (volatile LAS unsigned*)&xb_words);
    }
#define PHASE(id, ...) do { const int _id = (id); if (ph_lo <= _id && _id < ph_hi) { __VA_ARGS__; if (_id + 1 < ph_hi) xcd_barrier(bar); } } while (0)

    PHASE(0, {
        for (int l = 0; l < DEPTH; ++l) {
            GemmOp g; g.A = p.in[1]; g.lda = 1024; g.aidx = nullptr; g.B = p.in[22] + (size_t)l * 1024 * 1024; g.ldb = 1024; g.M = BATCH * MEM_LEN; g.N = 1024; g.K = 1024;
            gemm_job<0>(g, WSF(WS_KVM) + (size_t)l * 2048 * 1024, 1024, bid, nblk, lds);
        }
    });

    for (int layer = 0; layer < DEPTH; ++layer) {
        const LayerW w = layer_w(p, layer);
        const int base = 1 + layer * NPH;
        const float* Xin = (layer == 0) ? p.in[0] : WSF(WS_XC);
        float* Xout = (layer == DEPTH - 1) ? p.out : WSF(WS_XC);
        PHASE(base + 0, { GemmOp g; g.A = Xin; g.lda = 1024; g.aidx = nullptr; g.B = w.w_in; g.ldb = NIN; g.M = T; g.N = NIN; g.K = 1024;
                          gemm_job<0>(g, WSF(WS_H), NIN, bid, nblk, lds); });
        PHASE(base + 1, { job_cmp_gather(p, w, bid, nblk); job_rnn_conv(p, w, bid, nblk); job_mla_norm(p, w, bid, nblk); });
        PHASE(base + 2, {
            for (int j = 0; j < 2; ++j) { GemmOp g; g.A = WSF(WS_TB) + (size_t)j * NCR * 2048; g.lda = 2048; g.aidx = nullptr; g.B = w.cmp_w1 + (size_t)j * 2048 * 256; g.ldb = 256; g.M = NCR; g.N = 256; g.K = 2048;
                gemm_job<1>(g, WSF(WS_HID) + (size_t)j * NCR * 256, 256, bid, nblk, lds); }
            job_rnn_gates(p, w, bid, nblk);
            { GemmOp g; g.A = WSF(WS_CQN); g.lda = 192; g.aidx = nullptr; g.B = w.w_uq; g.ldb = 384; g.M = T; g.N = 384; g.K = 192; gemm_job<0>(g, WSF(WS_Q), 384, bid, nblk, lds); }
            { GemmOp g; g.A = WSF(WS_CKVN); g.lda = 128; g.aidx = nullptr; g.B = w.w_ukv; g.ldb = 512; g.M = T; g.N = 512; g.K = 128; gemm_job<0>(g, WSF(WS_KV), 512, bid, nblk, lds); }
        });
        PHASE(base + 3, {
            for (int j = 0; j < 2; ++j) { GemmOp g; g.A = WSF(WS_HID) + (size_t)j * NCR * 256; g.lda = 256; g.aidx = nullptr; g.B = w.cmp_w2 + (size_t)j * 256 * 64; g.ldb = 64; g.M = NCR; g.N = 64; g.K = 256;
                gemm_job<0>(g, WSF(WS_KCVC) + (size_t)j * NCR * 64, 64, bid, nblk, lds); }
            job_rnn_scan(p, bid, nblk);
            job_q_rope(p, bid, nblk);
        });
        PHASE(base + 4, { job_nsa_cmp(p, bid, nblk); job_attn<1>(p, layer, bid, nblk); job_attn<4>(p, layer, bid, nblk); job_attn<2>(p, layer, bid, nblk); });
        PHASE(base + 5, { job_nsa_select(p, bid, nblk, lds); });
        PHASE(base + 6, { job_attn<0>(p, layer, bid, nblk); });
        PHASE(base + 7, { job_merge(p, w, bid, nblk, lds); });
        PHASE(base + 8, { GemmOp g; g.A = WSF(WS_M); g.lda = 1024; g.aidx = nullptr; g.B = w.w_out; g.ldb = 1024; g.M = T; g.N = 1024; g.K = 1024; gemm_job<0>(g, WSF(WS_Y), 1024, bid, nblk, lds); });
        PHASE(base + 9, { job_ln(Xin, WSF(WS_Y), 1024, nullptr, w.ln1_g, w.ln1_b, WSF(WS_XA), bid, nblk); });
        PHASE(base + 10, { GemmOp g; g.A = WSF(WS_XA); g.lda = 1024; g.aidx = nullptr; g.B = w.wq; g.ldb = 512; g.M = T; g.N = 512; g.K = 1024; gemm_job<0>(g, WSF(WS_XQ), 512, bid, nblk, lds); });
        PHASE(base + 11, { job_attn<3>(p, layer, bid, nblk); });
        PHASE(base + 12, { GemmOp g; g.A = WSF(WS_XO); g.lda = 512; g.aidx = nullptr; g.B = w.wo; g.ldb = 1024; g.M = T; g.N = 1024; g.K = 512; gemm_job<0>(g, WSF(WS_Y), 1024, bid, nblk, lds); });
        PHASE(base + 13, { job_ln(WSF(WS_XA), WSF(WS_Y), 1024, nullptr, w.ln2_g, w.ln2_b, WSF(WS_XB), bid, nblk); });
        PHASE(base + 14, {
            { GemmOp g; g.A = WSF(WS_XB); g.lda = 1024; g.aidx = nullptr; g.B = w.rg_w; g.ldb = 4; g.M = T; g.N = 4; g.K = 1024; gemm_job<0>(g, WSF(WS_LOG), 36, bid, nblk, lds); }
            { GemmOp g; g.A = WSF(WS_XB); g.lda = 1024; g.aidx = nullptr; g.B = w.re_w; g.ldb = 32; g.M = T; g.N = 32; g.K = 1024; gemm_job<0>(g, WSF(WS_LOG) + 4, 36, bid, nblk, lds); }
        });
        PHASE(base + 15, { job_router(p, w, layer, bid, nblk); });
        PHASE(base + 16, { job_fill(p, layer, bid, nblk); });
        PHASE(base + 17, { job_moe_gemm<0>(p, w, layer, WSF(WS_XB), bid, nblk, lds); });
        PHASE(base + 18, { job_moe_act(p, bid, nblk); });
        PHASE(base + 19, { job_moe_gemm<1>(p, w, layer, WSF(WS_XB), bid, nblk, lds); });
        PHASE(base + 20, { job_ln(WSF(WS_XB), WSF(WS_YK), 2048, WSF(WS_YK) + 1024, w.ln3_g, w.ln3_b, Xout, bid, nblk); });
    }
}

extern "C" void kernel_launch(void* const* d_in, const int* in_sizes, int n_in, void* d_out, int out_size, void* d_ws, size_t ws_size, hipStream_t stream) {
    constexpr size_t kDynLds = 36864;
    static int grid = 0;
    if (!grid) {
        int dev = 0, cus = 0, per_cu = 0;
        hipGetDevice(&dev);
        hipDeviceGetAttribute(&cus, hipDeviceAttributeMultiprocessorCount, dev);
        hipOccupancyMaxActiveBlocksPerMultiprocessor(&per_cu, mega, NT, kDynLds);
        if (per_cu < 1) per_cu = 1;
        grid = cus * (per_cu < 2 ? per_cu : 2);
    }
    if (ws_size < WS_END) { fprintf(stderr, "workspace too small: %zu < %zu\n", ws_size, (size_t)WS_END); return; }
    Params p{};
    for (int i = 0; i < 34; ++i) p.in[i] = (const float*)d_in[i];
    p.out = (float*)d_out;
    p.ws = (unsigned char*)d_ws;
    hipMemsetAsync(d_ws, 0, CTL_BYTES, stream);
#if MK_ONE_LAUNCH
    hipLaunchKernelGGL(mega, dim3(grid), dim3(NT), kDynLds, stream, p, 0, NPHASES);
#else
    for (int ph = 0; ph < NPHASES; ++ph) hipLaunchKernelGGL(mega, dim3(grid), dim3(NT), kDynLds, stream, p, ph, ph + 1);
#endif
}
```

```cpp
#include <hip/hip_runtime.h>
#include <stdint.h>
#include <stdio.h>

#ifndef MK_ONE_LAUNCH
#define MK_ONE_LAUNCH 1
#endif

#define DI __device__ __forceinline__
#define LAS __attribute__((address_space(3)))

constexpr int NT = 256;
constexpr int D = 1024, BATCH = 8, SEQ = 2048, T = BATCH * SEQ, DEPTH = 4;
constexpr int MEM_LEN = 256;
constexpr int NIN = 6764, NH = 6784;
constexpr int O_AQ = 0, O_AKC = 256, O_AVC = 384, O_AKS = 512, O_AVS = 640, O_AKW = 768, O_AVW = 896,
              O_BQ = 1024, O_BK = 1280, O_BV = 1536, O_CX = 1792, O_CG = 2048, O_DCQ = 2304, O_DCKV = 2496, O_DKR = 2624,
              O_AG = 2656, O_MG = 2688;
constexpr int NCMP = 127, NCR = BATCH * NCMP * 2;
constexpr int NEXP = 32, NASSIGN = T * 2;
constexpr float DN_ALPHA = 1.681792830507429f;

typedef unsigned short bf16_t;
typedef short bf16x8 __attribute__((ext_vector_type(8)));
typedef float f32x16 __attribute__((ext_vector_type(16)));
typedef unsigned u32x4 __attribute__((ext_vector_type(4)));

constexpr int G_WM = NT / 128;
constexpr int G_BM = 64 * G_WM;
constexpr int G_BN = 128;
constexpr int G_RS = 144;
constexpr int G_STAGE = (G_BM + G_BN) * G_RS;
constexpr int PADROWS = ((NASSIGN + NEXP * (G_BM - 1) + G_BM - 1) / G_BM) * G_BM;

constexpr size_t MiB = 1u << 20;
constexpr size_t al(size_t x) { return (x + 255) & ~(size_t)255; }
constexpr size_t WS_CTL = 0, CTL_BYTES = 1 * MiB;
constexpr size_t WT_IN = WS_CTL + CTL_BYTES;
constexpr size_t WT_BR = WT_IN + al((size_t)DEPTH * NH * 1024 * 2);
constexpr size_t WT_OUT = WT_BR + al((size_t)DEPTH * 4 * 1024 * 256 * 2);
constexpr size_t WT_Q = WT_OUT + al((size_t)DEPTH * 1024 * 1024 * 2);
constexpr size_t WT_KV = WT_Q + al((size_t)DEPTH * 512 * 1024 * 2);
constexpr size_t WT_O = WT_KV + al((size_t)DEPTH * 1024 * 1024 * 2);
constexpr size_t WT_GU = WT_O + al((size_t)DEPTH * 1024 * 512 * 2);
constexpr size_t WT_DN = WT_GU + al((size_t)DEPTH * 32 * 1024 * 1024 * 2);
constexpr size_t WS_X0B = WT_DN + al((size_t)DEPTH * 32 * 1024 * 512 * 2);
constexpr size_t WS_MEMB = WS_X0B + al((size_t)T * 1024 * 2);
constexpr size_t WS_H = WS_MEMB + al((size_t)2048 * 1024 * 2);
constexpr size_t SZ_H = al((size_t)T * NH * 2);
constexpr size_t WS_YK = WS_H;
constexpr size_t WS_HH = WS_YK + (size_t)NASSIGN * 1024 * 4;
static_assert(WS_HH + (size_t)PADROWS * 512 * 2 <= WS_H + SZ_H, "moe overlay fits in H");
constexpr size_t WS_TB = WS_H + SZ_H;
constexpr size_t WS_HID = WS_TB + al((size_t)2 * NCR * 2048 * 4);
constexpr size_t WS_KCVC = WS_HID + al((size_t)2 * NCR * 256 * 4);
constexpr size_t WS_PC = WS_KCVC + al((size_t)2 * NCR * 64 * 4);
constexpr size_t WS_SEL = WS_PC + al((size_t)BATCH * 4 * SEQ * 128 * 4);
constexpr size_t WS_OW = WS_SEL + al((size_t)BATCH * 2 * SEQ * 4);
constexpr size_t WS_OC = WS_OW + al((size_t)T * 256 * 4);
constexpr size_t WS_BR = WS_OC + al((size_t)T * 256 * 4);
constexpr size_t WS_U = WS_BR + al((size_t)T * 1024 * 2);
constexpr size_t WS_RA = WS_U + al((size_t)T * 256 * 4);
constexpr size_t WS_RB = WS_RA + al((size_t)T * 256 * 4);
constexpr size_t WS_CQN = WS_RB + al((size_t)T * 256 * 4);
constexpr size_t WS_CKVN = WS_CQN + al((size_t)T * 192 * 4);
constexpr size_t WS_KR = WS_CKVN + al((size_t)T * 128 * 4);
constexpr size_t WS_Q = WS_KR + al((size_t)T * 32 * 4);
constexpr size_t WS_KV = WS_Q + al((size_t)T * 384 * 4);
constexpr size_t WS_M = WS_KV + al((size_t)T * 512 * 4);
constexpr size_t WS_Y = WS_M + al((size_t)T * 1024 * 2);
constexpr size_t WS_XA = WS_Y + al((size_t)T * 1024 * 4);
constexpr size_t WS_XB = WS_XA + al((size_t)T * 1024 * 4);
constexpr size_t WS_XC = WS_XB + al((size_t)T * 1024 * 4);
constexpr size_t WS_XAB = WS_XC + al((size_t)T * 1024 * 4);
constexpr size_t WS_XBB = WS_XAB + al((size_t)T * 1024 * 2);
constexpr size_t WS_XCB = WS_XBB + al((size_t)T * 1024 * 2);
constexpr size_t WS_XQ = WS_XCB + al((size_t)T * 1024 * 2);
constexpr size_t WS_XO = WS_XQ + al((size_t)T * 512 * 2);
constexpr size_t WS_KVM = WS_XO + al((size_t)T * 512 * 2);
constexpr size_t WS_LOG = WS_KVM + al((size_t)DEPTH * 2048 * 1024 * 2);
constexpr size_t WS_EIDX = WS_LOG + al((size_t)T * 36 * 4);
constexpr size_t WS_ESLOT = WS_EIDX + al((size_t)NASSIGN * 4);
constexpr size_t WS_EW = WS_ESLOT + al((size_t)NASSIGN * 4);
constexpr size_t WS_PERM = WS_EW + al((size_t)NASSIGN * 4);
constexpr size_t WS_QB = WS_PERM + al((size_t)PADROWS * 4);
constexpr size_t WS_KM = WS_QB + al((size_t)T * 384 * 2);
constexpr size_t WS_VM = WS_KM + al((size_t)T * 384 * 2);
constexpr size_t WS_KCB = WS_VM + al((size_t)T * 256 * 2);
constexpr size_t WS_END = WS_KCB + al((size_t)2 * NCR * 64 * 2);

constexpr int CW_BAR = 4096;
constexpr int CW_CNT = 16384;

struct Params {
    const float* in[34];
    float* out;
    unsigned char* ws;
};

#define XB_TMO      128
#define XB_XCNT(j)  (256  + 64 * (j))
#define XB_XSUB(j)  (1280 + 64 * (j))
#define XB_XGEN(j)  (2304 + 64 * (j))
#define XB_TOP      3328
#define XB_TOPGEN   3392
#define XCD_BAR_WORDS 3456
#define XB_SPIN_CAP (1u << 22)

__device__ __forceinline__ unsigned xb_ld(unsigned* p)              { return __hip_atomic_load(p, __ATOMIC_RELAXED, __HIP_MEMORY_SCOPE_AGENT); }
__device__ __forceinline__ unsigned xb_add(unsigned* p, unsigned v) { return __hip_atomic_fetch_add(p, v, __ATOMIC_RELAXED, __HIP_MEMORY_SCOPE_AGENT); }
__device__ __forceinline__ unsigned xb_xcc_id() { return (unsigned)__builtin_amdgcn_s_getreg((3 << 11) | 20) & 0xFu; }
#define XB_SPIN(cond, bar) do { unsigned _sp = 0; while (cond) { __builtin_amdgcn_s_sleep(1); \
    if ((++_sp & 255u) == 0u) { if (xb_ld(&(bar)[XB_TMO])) break; if (_sp > XB_SPIN_CAP) { atomicAdd(&(bar)[XB_TMO], 1u); break; } } } } while (0)

struct XcdBarrier { unsigned* bar; unsigned x; volatile LAS unsigned* st; };

__device__ __forceinline__ XcdBarrier xcd_barrier_post(unsigned* bar, volatile LAS unsigned* st) {
    XcdBarrier b; b.bar = bar; b.x = xb_xcc_id(); b.st = st;
    if (threadIdx.x == 0) (void)xb_add(&bar[XB_XCNT(b.x)], 1u);
    return b;
}
__device__ __forceinline__ void xcd_barrier_complete(unsigned* bar, unsigned x, unsigned& nloc, unsigned& nx) {
    const unsigned G = gridDim.x * gridDim.y * gridDim.z;
    unsigned sum, cnt, mine, sp = 0u;
    for (;;) {
        sum = 0u; cnt = 0u; mine = 0u;
#pragma unroll
        for (unsigned j = 0; j < 16; ++j) { const unsigned c = xb_ld(&bar[XB_XCNT(j)]); sum += c; cnt += (c > 0u) ? 1u : 0u; mine = (j == x) ? c : mine; }
        if (sum == G) break;
        __builtin_amdgcn_s_sleep(1);
        if ((++sp & 255u) == 0u) { if (xb_ld(&bar[XB_TMO])) break; if (sp > XB_SPIN_CAP) { atomicAdd(&bar[XB_TMO], 1u); break; } }
    }
    nloc = mine > 0u ? mine : 1u; nx = cnt > 0u ? cnt : 1u;
}
__device__ __forceinline__ void xcd_barrier(const XcdBarrier& b) {
    asm volatile("s_waitcnt vmcnt(0)" ::: "memory");
    __syncthreads();
    if (threadIdx.x == 0) {
        unsigned* bar = b.bar;
        __builtin_amdgcn_s_waitcnt(0);
        unsigned nloc = b.st[0], nx = b.st[1];
        if (nloc == 0u) { xcd_barrier_complete(bar, b.x, nloc, nx); b.st[0] = nloc; b.st[1] = nx; }
        const unsigned old = xb_add(&bar[XB_XSUB(b.x)], 1u);
        const unsigned gen = old / nloc;
        if (old + 1u == (gen + 1u) * nloc) {
            __builtin_amdgcn_fence(__ATOMIC_RELEASE, "agent");
            asm volatile("s_waitcnt vmcnt(0)" ::: "memory");
            const unsigned og = xb_add(&bar[XB_TOP], 1u);
            const unsigned tg = og / nx;
            if (og + 1u == (tg + 1u) * nx) xb_add(&bar[XB_TOPGEN], 1u);
            else XB_SPIN(xb_ld(&bar[XB_TOPGEN]) == tg, bar);
            __builtin_amdgcn_fence(__ATOMIC_ACQUIRE, "agent");
            xb_add(&bar[XB_XGEN(b.x)], 1u);
            asm volatile("s_waitcnt vmcnt(0)" ::: "memory");
        } else {
            XB_SPIN(xb_ld(&bar[XB_XGEN(b.x)]) == gen, bar);
            __builtin_amdgcn_fence(__ATOMIC_ACQUIRE, "agent");
            asm volatile("s_waitcnt vmcnt(0)" ::: "memory");
        }
    }
    __syncthreads();
}

DI float gelu_tanh(float x) { const float u = 0.7978845608028654f * (x + 0.044715f * x * x * x); return 0.5f * x * (1.f + tanhf(u)); }
DI float sigm(float x) { return 1.f / (1.f + expf(-x)); }
DI float logsig(float z) { return fminf(z, 0.f) - log1pf(expf(-fabsf(z))); }
DI float wave_sum(float v) {
#pragma unroll
    for (int o = 32; o > 0; o >>= 1) v += __shfl_xor(v, o, 64);
    return v;
}

struct GemmOp {
    const float* A; int lda; const int* aidx;
    const float* B; int ldb;
    int M, N, K;
};

DI void gemm_tile(const GemmOp& g, int m0, int n0, float (&acc)[8][8], float* lds) {
    float* As = lds;
    float* Bs = lds + 8 * 132;
    const int tid = threadIdx.x, tx = tid & 15, ty = tid >> 4;
#pragma unroll
    for (int i = 0; i < 8; ++i)
#pragma unroll
        for (int j = 0; j < 8; ++j) acc[i][j] = 0.f;
    const int ar = m0 + (tid >> 1), ak = (tid & 1) * 4;
    const int bk = tid >> 5, bn = n0 + (tid & 31) * 4;
    const float* aptr = nullptr;
    if (ar < g.M) { const long src = g.aidx ? (long)(g.aidx[ar] >> 1) : (long)ar; aptr = g.A + src * g.lda + ak; }
    const float* bptr = (bn < g.N) ? g.B + (long)bk * g.ldb + bn : nullptr;
    float4 av = aptr ? *(const float4*)aptr : make_float4(0.f, 0.f, 0.f, 0.f);
    float4 bv = bptr ? *(const float4*)bptr : make_float4(0.f, 0.f, 0.f, 0.f);
    for (int k0 = 0; k0 < g.K; k0 += 8) {
        __syncthreads();
        As[(ak + 0) * 132 + (tid >> 1)] = av.x; As[(ak + 1) * 132 + (tid >> 1)] = av.y;
        As[(ak + 2) * 132 + (tid >> 1)] = av.z; As[(ak + 3) * 132 + (tid >> 1)] = av.w;
        *(float4*)&Bs[bk * 128 + (tid & 31) * 4] = bv;
        __syncthreads();
        if (k0 + 8 < g.K) {
            if (aptr) av = *(const float4*)(aptr + k0 + 8);
            if (bptr) bv = *(const float4*)(bptr + (long)(k0 + 8) * g.ldb);
        }
#pragma unroll
        for (int kk = 0; kk < 8; ++kk) {
            const float4 a0 = *(const float4*)&As[kk * 132 + ty * 4], a1 = *(const float4*)&As[kk * 132 + 64 + ty * 4];
            const float4 b0 = *(const float4*)&Bs[kk * 128 + tx * 4], b1 = *(const float4*)&Bs[kk * 128 + 64 + tx * 4];
            const float a[8] = {a0.x, a0.y, a0.z, a0.w, a1.x, a1.y, a1.z, a1.w};
            const float b[8] = {b0.x, b0.y, b0.z, b0.w, b1.x, b1.y, b1.z, b1.w};
#pragma unroll
            for (int i = 0; i < 8; ++i)
#pragma unroll
                for (int j = 0; j < 8; ++j) acc[i][j] = fmaf(a[i], b[j], acc[i][j]);
        }
    }
}
#define GEMM_FOREACH(acc, m0, n0, M_, N_, ROW, COL, V, ...) do { const int _tx = threadIdx.x & 15, _ty = threadIdx.x >> 4; \
    _Pragma("unroll") for (int _i = 0; _i < 8; ++_i) { const int ROW = (m0) + (_i < 4 ? _ty * 4 + _i : 64 + _ty * 4 + _i - 4); \
    _Pragma("unroll") for (int _jh = 0; _jh < 2; ++_jh) { const int COL = (n0) + _jh * 64 + _tx * 4; \
        if (ROW < (M_) && COL < (N_)) { float4 V = make_float4(acc[_i][_jh * 4], acc[_i][_jh * 4 + 1], acc[_i][_jh * 4 + 2], acc[_i][_jh * 4 + 3]); __VA_ARGS__ } } } } while (0)

template <int ACT>
DI void gemm_job(const GemmOp& g, float* C, int ldc, int bid, int nblk, float* lds) {
    const int tm = (g.M + 127) / 128, tn = (g.N + 127) / 128;
    for (int u = bid; u < tm * tn; u += nblk) {
        const int m0 = (u / tn) * 128, n0 = (u % tn) * 128;
        float acc[8][8];
        gemm_tile(g, m0, n0, acc, lds);
        GEMM_FOREACH(acc, m0, n0, g.M, g.N, row, col, v, {
            if (ACT == 1) { v.x = gelu_tanh(v.x); v.y = gelu_tanh(v.y); v.z = gelu_tanh(v.z); v.w = gelu_tanh(v.w); }
            *(float4*)(C + (long)row * ldc + col) = v; });
    }
}

DI float bflo(unsigned u) { return __uint_as_float(u << 16); }
DI float bfhi(unsigned u) { return __uint_as_float(u & 0xffff0000u); }
DI float bf2f(bf16_t x) { return __uint_as_float((unsigned)x << 16); }
DI unsigned pk_bf16(float lo, float hi) { unsigned r; asm volatile("v_cvt_pk_bf16_f32 %0, %1, %2" : "=v"(r) : "v"(lo), "v"(hi)); return r; }
DI bf16_t f2bf(float x) { return (bf16_t)(pk_bf16(x, 0.f) & 0xffffu); }
DI void st4bf(bf16_t* p, float a, float b, float c, float d) { uint2 v; v.x = pk_bf16(a, b); v.y = pk_bf16(c, d); *(uint2*)p = v; }
DI float4 ld4bf(const bf16_t* p) { const uint2 v = *(const uint2*)p; return make_float4(bflo(v.x), bfhi(v.x), bflo(v.y), bfhi(v.y)); }
template <int N> DI float dot_row(const float* q, const bf16_t* kr) {
    float dot = 0.f;
#pragma unroll
    for (int d = 0; d < N; d += 8) { const uint4 v = *(const uint4*)(kr + d);
        dot = fmaf(q[d], bflo(v.x), dot); dot = fmaf(q[d + 1], bfhi(v.x), dot); dot = fmaf(q[d + 2], bflo(v.y), dot); dot = fmaf(q[d + 3], bfhi(v.y), dot);
        dot = fmaf(q[d + 4], bflo(v.z), dot); dot = fmaf(q[d + 5], bfhi(v.z), dot); dot = fmaf(q[d + 6], bflo(v.w), dot); dot = fmaf(q[d + 7], bfhi(v.w), dot); }
    return dot;
}
template <int N> DI float dot_row(const float* q, const float* kr) {
    float dot = 0.f;
#pragma unroll
    for (int d = 0; d < N; ++d) dot = fmaf(q[d], kr[d], dot);
    return dot;
}
template <int N> DI void axpy_row(float* o, float pr, float corr, const bf16_t* vr) {
#pragma unroll
    for (int d = 0; d < N; d += 8) { const uint4 v = *(const uint4*)(vr + d);
        o[d] = fmaf(pr, bflo(v.x), o[d] * corr); o[d + 1] = fmaf(pr, bfhi(v.x), o[d + 1] * corr); o[d + 2] = fmaf(pr, bflo(v.y), o[d + 2] * corr); o[d + 3] = fmaf(pr, bfhi(v.y), o[d + 3] * corr);
        o[d + 4] = fmaf(pr, bflo(v.z), o[d + 4] * corr); o[d + 5] = fmaf(pr, bfhi(v.z), o[d + 5] * corr); o[d + 6] = fmaf(pr, bflo(v.w), o[d + 6] * corr); o[d + 7] = fmaf(pr, bfhi(v.w), o[d + 7] * corr); }
}
template <int N> DI void axpy_row(float* o, float pr, float corr, const float* vr) {
#pragma unroll
    for (int d = 0; d < N; ++d) o[d] = fmaf(pr, vr[d], o[d] * corr);
}
template <int N> DI void ld_row(float* q, const bf16_t* p) {
#pragma unroll
    for (int d = 0; d < N; d += 8) { const uint4 v = *(const uint4*)(p + d);
        q[d] = bflo(v.x); q[d + 1] = bfhi(v.x); q[d + 2] = bflo(v.y); q[d + 3] = bfhi(v.y); q[d + 4] = bflo(v.z); q[d + 5] = bfhi(v.z); q[d + 6] = bflo(v.w); q[d + 7] = bfhi(v.w); }
}
template <int N> DI void ld_row(float* q, const float* p) {
#pragma unroll
    for (int d = 0; d < N; d += 4) { const float4 v = *(const float4*)(p + d); q[d] = v.x; q[d + 1] = v.y; q[d + 2] = v.z; q[d + 3] = v.w; }
}

struct MG { const bf16_t* A; long lda; const bf16_t* Wt; long ldw; int K; };

template <class RowFn>
DI void mgemm_tile(const MG& g, int n0, RowFn rowfn, f32x16 (&acc)[2][2], unsigned char* lds) {
    constexpr int XI = G_BM * 8 / NT, WI = G_BN * 8 / NT;
    const int tid = threadIdx.x, lane = tid & 63, wid = tid >> 6, r = lane & 31, h = lane >> 5;
    const int wm = wid % G_WM, wn = wid / G_WM;
    const int cc = tid & 7, row0 = tid >> 3;
    const bf16_t* xp[XI]; const bf16_t* wp[WI];
#pragma unroll
    for (int i = 0; i < XI; ++i) xp[i] = g.A + (long)rowfn(row0 + (NT / 8) * i) * g.lda + cc * 8;
#pragma unroll
    for (int i = 0; i < WI; ++i) wp[i] = g.Wt + (long)(n0 + row0 + (NT / 8) * i) * g.ldw + cc * 8;
    const int st_off = row0 * G_RS + cc * 16;
#pragma unroll
    for (int a = 0; a < 2; ++a)
#pragma unroll
        for (int b = 0; b < 2; ++b)
#pragma unroll
            for (int i = 0; i < 16; ++i) acc[a][b][i] = 0.f;
    u32x4 xv[XI], wv[WI];
#pragma unroll
    for (int i = 0; i < XI; ++i) xv[i] = *(const u32x4*)(xp[i]);
#pragma unroll
    for (int i = 0; i < WI; ++i) wv[i] = *(const u32x4*)(wp[i]);
    __syncthreads();
#pragma unroll
    for (int i = 0; i < XI; ++i) *(u32x4*)(lds + st_off + (NT / 8) * i * G_RS) = xv[i];
#pragma unroll
    for (int i = 0; i < WI; ++i) *(u32x4*)(lds + G_BM * G_RS + st_off + (NT / 8) * i * G_RS) = wv[i];
    __syncthreads();
    const int nk = g.K >> 6;
    const int xf_off = (wm * 64 + r) * G_RS + h * 16, wf_off = G_BM * G_RS + (wn * 64 + r) * G_RS + h * 16;
    for (int kt = 0; kt < nk; ++kt) {
        const unsigned char* st = lds + (kt & 1) * G_STAGE;
        if (kt + 1 < nk) {
#pragma unroll
            for (int i = 0; i < XI; ++i) xv[i] = *(const u32x4*)(xp[i] + (kt + 1) * 64);
#pragma unroll
            for (int i = 0; i < WI; ++i) wv[i] = *(const u32x4*)(wp[i] + (kt + 1) * 64);
        }
#pragma unroll
        for (int ks = 0; ks < 4; ++ks) {
            const bf16x8 w0 = *(const bf16x8*)(st + wf_off + ks * 32), w1 = *(const bf16x8*)(st + wf_off + 32 * G_RS + ks * 32);
            const bf16x8 x0 = *(const bf16x8*)(st + xf_off + ks * 32), x1 = *(const bf16x8*)(st + xf_off + 32 * G_RS + ks * 32);
            acc[0][0] = __builtin_amdgcn_mfma_f32_32x32x16_bf16(w0, x0, acc[0][0], 0, 0, 0);
            acc[0][1] = __builtin_amdgcn_mfma_f32_32x32x16_bf16(w0, x1, acc[0][1], 0, 0, 0);
            acc[1][0] = __builtin_amdgcn_mfma_f32_32x32x16_bf16(w1, x0, acc[1][0], 0, 0, 0);
            acc[1][1] = __builtin_amdgcn_mfma_f32_32x32x16_bf16(w1, x1, acc[1][1], 0, 0, 0);
        }
        if (kt + 1 < nk) {
            unsigned char* sn = lds + ((kt + 1) & 1) * G_STAGE;
#pragma unroll
            for (int i = 0; i < XI; ++i) *(u32x4*)(sn + st_off + (NT / 8) * i * G_RS) = xv[i];
#pragma unroll
            for (int i = 0; i < WI; ++i) *(u32x4*)(sn + G_BM * G_RS + st_off + (NT / 8) * i * G_RS) = wv[i];
        }
        __syncthreads();
    }
}
#define MG_FOREACH(acc, LROW, FEAT, V, ...) do { const int _l = threadIdx.x & 63, _w = threadIdx.x >> 6, _wm = _w % G_WM, _wn = _w / G_WM; \
    _Pragma("unroll") for (int _ft = 0; _ft < 2; ++_ft) _Pragma("unroll") for (int _tt = 0; _tt < 2; ++_tt) _Pragma("unroll") for (int _i = 0; _i < 4; ++_i) { \
        const int LROW = _wm * 64 + _tt * 32 + (_l & 31); const int FEAT = _wn * 64 + _ft * 32 + 8 * _i + 4 * (_l >> 5); \
        float V[4] = {acc[_ft][_tt][4 * _i], acc[_ft][_tt][4 * _i + 1], acc[_ft][_tt][4 * _i + 2], acc[_ft][_tt][4 * _i + 3]}; __VA_ARGS__ } } while (0)

struct RowId { int m0; DI long operator()(int r) const { return m0 + r; } };

template <int OUTMODE>
DI void mgemm_job(const MG& g, int M, int N, void* out, long ldo, int bid, int nblk, unsigned char* lds) {
    const int tm = M / G_BM, tn = N / G_BN;
    for (int u = bid; u < tm * tn; u += nblk) {
        const int grp = u / (16 * tn), rem = u % (16 * tn);
        const int gm = (tm - grp * 16) < 16 ? (tm - grp * 16) : 16;
        const int mt = grp * 16 + rem % gm, nt = rem / gm;
        const int m0 = mt * G_BM, n0 = nt * G_BN;
        f32x16 acc[2][2];
        mgemm_tile(g, n0, RowId{m0}, acc, lds);
        MG_FOREACH(acc, lrow, feat, v, {
            const long o = (long)(m0 + lrow) * ldo + n0 + feat;
            if (OUTMODE == 1) *(float4*)((float*)out + o) = make_float4(v[0], v[1], v[2], v[3]);
            else {
                if (OUTMODE == 2 && n0 + feat >= O_MG) { v[0] = sigm(v[0]); v[1] = sigm(v[1]); v[2] = sigm(v[2]); v[3] = sigm(v[3]); }
                st4bf((bf16_t*)out + o, v[0], v[1], v[2], v[3]);
            } });
    }
}

struct LayerW {
    const float *cmp_pos, *cmp_w1, *cmp_w2, *conv_w, *conv_b, *ga_w, *ga_b, *gx_w, *gx_b, *lam, *q_norm, *kv_norm, *w_uq, *w_ukv,
        *ln1_g, *ln1_b, *ln2_g, *ln2_b, *rg_w, *rg_b, *re_w, *re_b, *ln3_g, *ln3_b;
    const bf16_t *t_in, *t_br, *t_out, *t_q, *t_o, *t_gu, *t_dn;
};
#define WSF(off) ((float*)(p.ws + (off)))
#define WSI(off) ((int*)(p.ws + (off)))
#define WSU(off) ((unsigned*)(p.ws + (off)))
#define WSB(off) ((bf16_t*)(p.ws + (off)))
DI LayerW layer_w(const Params& p, int l) {
    LayerW w;
    w.cmp_pos = p.in[3] + (size_t)l * 2 * 32 * 64;
    w.cmp_w1 = p.in[4] + (size_t)l * 2 * 2048 * 256;
    w.cmp_w2 = p.in[5] + (size_t)l * 2 * 256 * 64;
    w.conv_w = p.in[6] + (size_t)l * 4 * 256;
    w.conv_b = p.in[7] + (size_t)l * 256;
    w.ga_w = p.in[8] + (size_t)l * 4 * 64 * 64;
    w.ga_b = p.in[9] + (size_t)l * 256;
    w.gx_w = p.in[10] + (size_t)l * 4 * 64 * 64;
    w.gx_b = p.in[11] + (size_t)l * 256;
    w.lam = p.in[12] + (size_t)l * 256;
    w.q_norm = p.in[13] + (size_t)l * 192;
    w.kv_norm = p.in[14] + (size_t)l * 128;
    w.w_uq = p.in[15] + (size_t)l * 192 * 384;
    w.w_ukv = p.in[16] + (size_t)l * 128 * 512;
    w.ln1_g = p.in[19] + (size_t)l * 1024; w.ln1_b = p.in[20] + (size_t)l * 1024;
    w.ln2_g = p.in[24] + (size_t)l * 1024; w.ln2_b = p.in[25] + (size_t)l * 1024;
    w.rg_w = p.in[26] + (size_t)l * 1024 * 4; w.rg_b = p.in[27] + (size_t)l * 4;
    w.re_w = p.in[28] + (size_t)l * 1024 * 32; w.re_b = p.in[29] + (size_t)l * 32;
    w.ln3_g = p.in[32] + (size_t)l * 1024; w.ln3_b = p.in[33] + (size_t)l * 1024;
    w.t_in = WSB(WT_IN) + (size_t)l * NH * 1024;
    w.t_br = WSB(WT_BR) + (size_t)l * 4 * 1024 * 256;
    w.t_out = WSB(WT_OUT) + (size_t)l * 1024 * 1024;
    w.t_q = WSB(WT_Q) + (size_t)l * 512 * 1024;
    w.t_o = WSB(WT_O) + (size_t)l * 1024 * 512;
    w.t_gu = WSB(WT_GU) + (size_t)l * 32 * 1024 * 1024;
    w.t_dn = WSB(WT_DN) + (size_t)l * 32 * 1024 * 512;
    return w;
}

template <int MODE>
DI void job_wt(const float* src, int nmat, int K, int Nsrc, bf16_t* dst, int Npad, int bid, int nblk, unsigned char* lds) {
    bf16_t* tile = (bf16_t*)lds;
    const int tk = K / 64, tn = Npad / 64, per = tk * tn;
    const int tid = threadIdx.x;
    for (int u = bid; u < nmat * per; u += nblk) {
        const int mat = u / per, ru = u % per, k0 = (ru / tn) * 64, n0 = (ru % tn) * 64;
        const float* s = src + (size_t)mat * K * Nsrc;
        bf16_t* d = dst + (size_t)mat * Npad * K;
        const int nl = tid & 63, kl = tid >> 6;
        const int np = n0 + nl;
        int col;
        if (MODE == 0) col = np < Nsrc ? np : -1;
        else if (MODE == 2) col = np < 1024 ? np : (np < 2656 ? np + 12 : (np < 2668 ? 1024 + (np - 2656) : (np < 2688 ? -1 : np - 20)));
        else { const int j = np >> 7, q = np & 127, seg = q >> 5, i = q & 31; const int f = 64 * j + (seg >> 1) * 32 + i; col = (seg & 1) ? 512 + f : f; }
        __syncthreads();
#pragma unroll 4
        for (int pss = 0; pss < 64 / (NT / 64); ++pss) {
            const int k = kl + (NT / 64) * pss;
            const float v = col >= 0 ? s[(size_t)(k0 + k) * Nsrc + col] : 0.f;
            tile[nl * 72 + k] = f2bf(v);
        }
        __syncthreads();
        for (int c = tid; c < 64 * 8; c += NT) {
            const int n2 = c >> 3, kc = (c & 7) * 8;
            *(uint4*)(d + (size_t)(n0 + n2) * K + k0 + kc) = *(const uint4*)(tile + n2 * 72 + kc);
        }
    }
}
DI void job_cvt(const float* src, bf16_t* dst, long n, int bid, int nblk) {
    for (long e = ((long)bid * NT + threadIdx.x) * 4; e < n; e += (long)nblk * NT * 4) {
        const float4 v = *(const float4*)(src + e);
        st4bf(dst + e, v.x, v.y, v.z, v.w);
    }
}
DI void job_cmp_gather(const Params& p, const LayerW& w, int bid, int nblk) {
    const bf16_t* H = WSB(WS_H); float* TB = WSF(WS_TB);
    const long total = (long)2 * NCR * 2048 / 4;
    for (long e = (long)bid * NT + threadIdx.x; e < total; e += (long)nblk * NT) {
        const long e4 = e * 4;
        const int f = (int)(e4 % 2048); const long r2 = e4 / 2048; const int r = (int)(r2 % NCR), j = (int)(r2 / NCR);
        const int g = r & 1, bc = r >> 1, c = bc % NCMP, b = bc / NCMP, i = f >> 6, d = f & 63;
        const float4 hv = ld4bf(H + (long)(b * SEQ + 16 * c + i) * NH + (j ? O_AVC : O_AKC) + g * 64 + d);
        const float4 pv = *(const float4*)(w.cmp_pos + (j * 32 + i) * 64 + d);
        *(float4*)(TB + e4) = make_float4(hv.x + pv.x, hv.y + pv.y, hv.z + pv.z, hv.w + pv.w);
    }
}
DI void job_rnn_conv(const Params& p, const LayerW& w, int bid, int nblk) {
    const bf16_t* H = WSB(WS_H); float* U = WSF(WS_U);
    for (long e = (long)bid * NT + threadIdx.x; e < (long)T * 256; e += (long)nblk * NT) {
        const int ch = (int)(e & 255); const int t = (int)(e >> 8), s = t & (SEQ - 1);
        float u = w.conv_b[ch];
#pragma unroll
        for (int tap = 0; tap < 4; ++tap) { const int sp = s - 3 + tap; if (sp >= 0) u += bf2f(H[(long)(t - 3 + tap) * NH + O_CX + ch]) * w.conv_w[tap * 256 + ch]; }
        U[e] = u;
    }
}
DI void job_rnn_gates(const Params& p, const LayerW& w, int bid, int nblk) {
    const float* U = WSF(WS_U); float* RA = WSF(WS_RA); float* RB = WSF(WS_RB);
    for (long e = (long)bid * NT + threadIdx.x; e < (long)T * 256; e += (long)nblk * NT) {
        const int ch = (int)(e & 255); const long t = e >> 8; const int blk = ch >> 6, j = ch & 63;
        const float* ur = U + t * 256 + blk * 64;
        float sa = 0.f, sx = 0.f;
        for (int c = 0; c < 64; ++c) { const float uv = ur[c]; sa = fmaf(uv, w.ga_w[(blk * 64 + c) * 64 + j], sa); sx = fmaf(uv, w.gx_w[(blk * 64 + c) * 64 + j], sx); }
        const float r = sigm(sa + w.ga_b[ch]), ig = sigm(sx + w.gx_b[ch]);
        const float nl = -w.lam[ch];
        const float sp = fmaxf(nl, 0.f) + log1pf(expf(-fabsf(nl)));
        const float log_a = -8.0f * r * sp;
        RA[e] = expf(log_a);
        RB[e] = sqrtf(-expm1f(2.0f * log_a)) * (ig * U[e]);
    }
}
DI void job_rnn_scan(const Params& p, int bid, int nblk) {
    const bf16_t* H = WSB(WS_H); const float* RA = WSF(WS_RA); const float* RB = WSF(WS_RB); bf16_t* BR = WSB(WS_BR);
    for (int e = bid * NT + threadIdx.x; e < BATCH * 256; e += nblk * NT) {
        const int ch = e & 255, b = e >> 8;
        float h = 0.f;
        for (int s0 = 0; s0 < SEQ; s0 += 8) {
            float av[8], bv[8], gv[8];
#pragma unroll
            for (int i = 0; i < 8; ++i) { const long t = (long)b * SEQ + s0 + i; av[i] = RA[t * 256 + ch]; bv[i] = RB[t * 256 + ch]; gv[i] = bf2f(H[t * NH + O_CG + ch]); }
#pragma unroll
            for (int i = 0; i < 8; ++i) { const long t = (long)b * SEQ + s0 + i; h = av[i] * h + bv[i]; BR[t * 1024 + 2 * 256 + ch] = f2bf(h * gelu_tanh(gv[i])); }
        }
    }
}
DI void job_mla_norm(const Params& p, const LayerW& w, int bid, int nblk) {
    const bf16_t* H = WSB(WS_H); float* CQN = WSF(WS_CQN); float* CKVN = WSF(WS_CKVN); float* KR = WSF(WS_KR);
    const int lane = threadIdx.x & 63, wid = threadIdx.x >> 6;
    for (int t = bid * (NT / 64) + wid; t < T; t += nblk * (NT / 64)) {
        const bf16_t* hr = H + (long)t * NH;
        float q0 = bf2f(hr[O_DCQ + lane]), q1 = bf2f(hr[O_DCQ + 64 + lane]), q2 = bf2f(hr[O_DCQ + 128 + lane]);
        float ss = wave_sum(q0 * q0 + q1 * q1 + q2 * q2);
        float rs = rsqrtf(ss * (1.f / 192.f) + 1e-6f);
        CQN[(long)t * 192 + lane] = q0 * rs * w.q_norm[lane];
        CQN[(long)t * 192 + 64 + lane] = q1 * rs * w.q_norm[64 + lane];
        CQN[(long)t * 192 + 128 + lane] = q2 * rs * w.q_norm[128 + lane];
        float k0 = bf2f(hr[O_DCKV + lane]), k1 = bf2f(hr[O_DCKV + 64 + lane]);
        ss = wave_sum(k0 * k0 + k1 * k1);
        rs = rsqrtf(ss * (1.f / 128.f) + 1e-6f);
        CKVN[(long)t * 128 + lane] = k0 * rs * w.kv_norm[lane];
        CKVN[(long)t * 128 + 64 + lane] = k1 * rs * w.kv_norm[64 + lane];
        if (lane < 16) {
            const int s = t & (SEQ - 1);
            const float inv = powf(10000.f, -(float)(2 * lane) / 32.f);
            const float ang = (float)s * inv, cs = cosf(ang), sn = sinf(ang);
            const float x1 = bf2f(hr[O_DKR + lane]), x2 = bf2f(hr[O_DKR + 16 + lane]);
            KR[(long)t * 32 + lane] = x1 * cs - x2 * sn;
            KR[(long)t * 32 + 16 + lane] = x1 * sn + x2 * cs;
        }
    }
}
DI void job_q_rope(const Params& p, int bid, int nblk) {
    float* Q = WSF(WS_Q);
    for (long e = (long)bid * NT + threadIdx.x; e < (long)T * 64; e += (long)nblk * NT) {
        const int i = (int)(e & 15), h = (int)((e >> 4) & 3); const long t = e >> 6; const int s = (int)(t & (SEQ - 1));
        const float inv = powf(10000.f, -(float)(2 * i) / 32.f);
        const float ang = (float)s * inv, cs = cosf(ang), sn = sinf(ang);
        float* q = Q + t * 384 + h * 96 + 64;
        const float x1 = q[i], x2 = q[16 + i];
        q[i] = x1 * cs - x2 * sn; q[16 + i] = x1 * sn + x2 * cs;
    }
}

DI void job_nsa_cmp(const Params& p, int bid, int nblk) {
    const bf16_t* H = WSB(WS_H); const float* KC = WSF(WS_KCVC); const float* VC = KC + (size_t)NCR * 64;
    float* PC = WSF(WS_PC); float* OC = WSF(WS_OC);
    const int lane = threadIdx.x & 63, wid = threadIdx.x >> 6;
    for (int item0 = bid * (NT / 64) + wid; item0 < BATCH * 4 * 32; item0 += nblk * (NT / 64)) {
        const int item = __builtin_amdgcn_readfirstlane(item0);
        const int qt = item & 31, h = (item >> 5) & 3, b = item >> 7, g = h >> 1, n = h & 1;
        const int s = qt * 64 + lane; const long t = (long)b * SEQ + s;
        const float slope = exp2f(-2.f * (float)(h + 1));
        float q[64];
        ld_row<64>(q, H + t * NH + O_AQ + h * 64);
        const int smax = qt * 64 + 63;
        const int cend = smax >= 31 ? (smax - 31) / 16 + 1 : 0;
        float m = -1e30f, l = 0.f;
        for (int c = 0; c < cend; ++c) {
            const float* kr = KC + ((long)(b * NCMP + c) * 2 + g) * 64;
            const float dot = dot_row<64>(q, kr);
            const int dist = s - (16 * c + 31);
            const bool valid = dist >= 0;
            const float sc = valid ? dot * 0.125f - slope * (float)dist : -1e30f;
            const float mn = fmaxf(m, sc);
            l = l * expf(m - mn) + (valid ? expf(sc - mn) : 0.f);
            m = mn;
        }
        const float rl = 1.f / fmaxf(l, 1e-30f);
        float o[64];
#pragma unroll
        for (int d = 0; d < 64; ++d) o[d] = 0.f;
        float* pcrow = PC + ((long)((b * 2 + g) * 2 + n) * SEQ + s) * 128;
        for (int c = 0; c < 128; ++c) {
            float pr = 0.f;
            if (c < cend) {
                const float* kr = KC + ((long)(b * NCMP + c) * 2 + g) * 64;
                const float dot = dot_row<64>(q, kr);
                const int dist = s - (16 * c + 31);
                if (dist >= 0) pr = expf(dot * 0.125f - slope * (float)dist - m) * rl;
                const float* vr = VC + ((long)(b * NCMP + c) * 2 + g) * 64;
                axpy_row<64>(o, pr, 1.f, vr);
            }
            pcrow[c] = pr;
        }
        const float g0 = sigm(bf2f(H[t * NH + O_AG + h * 3 + 0]));
#pragma unroll
        for (int d = 0; d < 64; d += 4) *(float4*)(OC + t * 256 + h * 64 + d) = make_float4(g0 * o[d], g0 * o[d + 1], g0 * o[d + 2], g0 * o[d + 3]);
    }
}
DI void job_nsa_select(const Params& p, int bid, int nblk, float* lds) {
    const float* PC = WSF(WS_PC); unsigned* SEL = WSU(WS_SEL);
    float* simp = lds + threadIdx.x * 33;
    for (int e = bid * NT + threadIdx.x; e < BATCH * 2 * SEQ; e += nblk * NT) {
        const int s = e & (SEQ - 1), bg = e >> 11;
        const float* p0 = PC + ((long)(bg * 2 + 0) * SEQ + s) * 128;
        const float* p1 = PC + ((long)(bg * 2 + 1) * SEQ + s) * 128;
        const int cur = s >> 6;
        float prev = 0.f;
        for (int j = 0; j < 32; ++j) {
            const float4 a = *(const float4*)(p0 + 4 * j), c = *(const float4*)(p1 + 4 * j);
            const float P0 = a.x + c.x, P1 = a.y + c.y, P2 = a.z + c.z, P3 = a.w + c.w;
            float imp = P0 + P1 + P2 + 0.5f * (P3 + prev);
            prev = P3;
            const bool forced = (j == 0) || (j == cur), valid = (j * 64 <= s);
            simp[j] = forced ? 1e4f : (valid ? imp : -1.0f);
        }
        unsigned mask = 0u;
        for (int it = 0; it < 8; ++it) {
            float best = -3e38f; int bj = 0;
            for (int j = 0; j < 32; ++j) { const float v = simp[j]; if (!((mask >> j) & 1u) && v > best) { best = v; bj = j; } }
            mask |= 1u << bj;
        }
        SEL[e] = mask;
    }
}

template <int MODE>
DI void job_attn(const Params& p, int layer, int bid, int nblk) {
    constexpr int DQK = MODE == 2 ? 96 : (MODE == 3 ? 128 : 64);
    const bf16_t* H = WSB(WS_H);
    const int lane = threadIdx.x & 63, wid = threadIdx.x >> 6;
    const int nitems = (MODE == 3) ? BATCH * 4 * 32 * 2 : BATCH * 4 * 32;
    for (int item0 = bid * (NT / 64) + wid; item0 < nitems; item0 += nblk * (NT / 64)) {
        int item = __builtin_amdgcn_readfirstlane(item0);
        int half = 0; if (MODE == 3) { half = item & 1; item >>= 1; }
        const int qt = item & 31, h = (item >> 5) & 3, b = item >> 7, g = h >> 1;
        const int s = qt * 64 + lane; const long t = (long)b * SEQ + s;
        const int smin = qt * 64, smax = qt * 64 + 63;
        const float slope = exp2f(-2.f * (float)(h + 1));
        float q[DQK];
        if constexpr (MODE == 0 || MODE == 1) ld_row<64>(q, H + t * NH + O_AQ + h * 64);
        else if constexpr (MODE == 2) ld_row<96>(q, WSF(WS_Q) + t * 384 + h * 96);
        else if constexpr (MODE == 3) ld_row<128>(q, WSB(WS_XQ) + t * 512 + h * 128);
        else ld_row<64>(q, H + t * NH + O_BQ + h * 64);
        float o[64];
#pragma unroll
        for (int d = 0; d < 64; ++d) o[d] = 0.f;
        unsigned selmask = 0u;
        if (MODE == 0) selmask = WSU(WS_SEL)[(b * 2 + g) * SEQ + s];
        const float scale = MODE == 2 ? 0.10206207261596577f : (MODE == 3 ? 0.08838834764831845f : 0.125f);
        if constexpr (MODE != 4) {
            int kbeg = 0, kend = smax;
            if (MODE == 1) kbeg = smin - 511 > 0 ? smin - 511 : 0;
            if (MODE == 3) kend = MEM_LEN - 1;
            float m = -1e30f, l = 0.f;
            for (int k = kbeg; k <= kend; ++k) {
                float dot;
                if constexpr (MODE == 0) dot = dot_row<64>(q, H + ((long)b * SEQ + k) * NH + O_AKS + g * 64);
                else if constexpr (MODE == 1) dot = dot_row<64>(q, H + ((long)b * SEQ + k) * NH + O_AKW + g * 64);
                else if constexpr (MODE == 2) dot = dot_row<64>(q, WSF(WS_KV) + ((long)b * SEQ + k) * 512 + h * 128) + dot_row<32>(q + 64, WSF(WS_KR) + ((long)b * SEQ + k) * 32);
                else dot = dot_row<128>(q, WSB(WS_KVM) + ((long)layer * 2048 + b * MEM_LEN + k) * 1024 + h * 128);
                bool valid = true; float sc = dot * scale;
                if (MODE == 0) { valid = (k <= s) && ((selmask >> (k >> 6)) & 1u); sc -= slope * (float)(s - k); }
                if (MODE == 1) { valid = (k <= s) && (s - k < 512); sc -= slope * (float)(s - k); }
                if (MODE == 2) valid = (k <= s);
                sc = valid ? sc : -1e30f;
                const float mn = fmaxf(m, sc);
                const float corr = expf(m - mn), pr = valid ? expf(sc - mn) : 0.f;
                l = l * corr + pr; m = mn;
                if constexpr (MODE == 0) axpy_row<64>(o, pr, corr, H + ((long)b * SEQ + k) * NH + O_AVS + g * 64);
                else if constexpr (MODE == 1) axpy_row<64>(o, pr, corr, H + ((long)b * SEQ + k) * NH + O_AVW + g * 64);
                else if constexpr (MODE == 2) axpy_row<64>(o, pr, corr, WSF(WS_KV) + ((long)b * SEQ + k) * 512 + h * 128 + 64);
                else axpy_row<64>(o, pr, corr, WSB(WS_KVM) + ((long)layer * 2048 + b * MEM_LEN + k) * 1024 + 512 + h * 128 + half * 64);
            }
            const float rl = 1.f / fmaxf(l, 1e-30f);
#pragma unroll
            for (int d = 0; d < 64; ++d) o[d] *= rl;
        } else {
            float tail = 0.f;
            for (int k = smax - 1; k >= 0; --k) {
                const float z = dot_row<64>(q, H + ((long)b * SEQ + k) * NH + O_BK + h * 64) * 0.125f;
                const bool valid = k < s;
                const float lsp = logsig(z);
                const float a = valid ? expf(lsp + tail) : 0.f;
                tail += valid ? (lsp - z) : 0.f;
                axpy_row<64>(o, a, 1.f, H + ((long)b * SEQ + k) * NH + O_BV + h * 64);
            }
        }
        if (MODE == 0) {
            const float g1 = sigm(bf2f(H[t * NH + O_AG + h * 3 + 1]));
            bf16_t* br = WSB(WS_BR) + t * 1024 + h * 64; const float* ow = WSF(WS_OW) + t * 256 + h * 64; const float* oc = WSF(WS_OC) + t * 256 + h * 64;
#pragma unroll
            for (int d = 0; d < 64; d += 4) { const float4 c = *(const float4*)(oc + d); const float4 w4 = *(const float4*)(ow + d);
                st4bf(br + d, c.x + g1 * o[d] + w4.x, c.y + g1 * o[d + 1] + w4.y, c.z + g1 * o[d + 2] + w4.z, c.w + g1 * o[d + 3] + w4.w); }
        } else if (MODE == 1) {
            float* dst = WSF(WS_OW) + t * 256 + h * 64; const float gs = sigm(bf2f(H[t * NH + O_AG + h * 3 + 2]));
#pragma unroll
            for (int d = 0; d < 64; d += 4) *(float4*)(dst + d) = make_float4(gs * o[d], gs * o[d + 1], gs * o[d + 2], gs * o[d + 3]);
        } else {
            bf16_t* dst;
            if (MODE == 2) dst = WSB(WS_BR) + t * 1024 + 3 * 256 + h * 64;
            else if (MODE == 3) dst = WSB(WS_XO) + t * 512 + h * 128 + half * 64;
            else dst = WSB(WS_BR) + t * 1024 + 1 * 256 + h * 64;
#pragma unroll
            for (int d = 0; d < 64; d += 4) st4bf(dst + d, o[d], o[d + 1], o[d + 2], o[d + 3]);
        }
    }
}

DI void job_merge(const Params& p, const LayerW& w, int bid, int nblk, unsigned char* lds) {
    const bf16_t* H = WSB(WS_H); bf16_t* M = WSB(WS_M);
    for (int u = bid; u < (T / G_BM) * 8; u += nblk) {
        const int m0 = (u >> 3) * G_BM, n0 = (u & 7) * G_BN;
        f32x16 macc[2][2];
#pragma unroll
        for (int a = 0; a < 2; ++a)
#pragma unroll
            for (int b = 0; b < 2; ++b)
#pragma unroll
                for (int i = 0; i < 16; ++i) macc[a][b][i] = 0.f;
#pragma unroll 1
        for (int n = 0; n < 4; ++n) {
            MG g; g.A = WSB(WS_BR) + n * 256; g.lda = 1024; g.Wt = w.t_br + (size_t)n * 1024 * 256; g.ldw = 256; g.K = 256;
            f32x16 acc[2][2];
            mgemm_tile(g, n0, RowId{m0}, acc, lds);
            const int l = threadIdx.x & 63, wv = threadIdx.x >> 6, wm = wv % G_WM, wn = wv / G_WM;
#pragma unroll
            for (int ft = 0; ft < 2; ++ft)
#pragma unroll
                for (int tt = 0; tt < 2; ++tt)
#pragma unroll
                    for (int i = 0; i < 4; ++i) {
                        const int lrow = wm * 64 + tt * 32 + (l & 31), feat = wn * 64 + ft * 32 + 8 * i + 4 * (l >> 5);
                        const float4 gv = ld4bf(H + (long)(m0 + lrow) * NH + O_MG + n * 1024 + n0 + feat);
                        macc[ft][tt][4 * i] += gv.x * acc[ft][tt][4 * i]; macc[ft][tt][4 * i + 1] += gv.y * acc[ft][tt][4 * i + 1];
                        macc[ft][tt][4 * i + 2] += gv.z * acc[ft][tt][4 * i + 2]; macc[ft][tt][4 * i + 3] += gv.w * acc[ft][tt][4 * i + 3];
                    }
        }
        MG_FOREACH(macc, lrow, feat, v, { st4bf(M + (long)(m0 + lrow) * 1024 + n0 + feat, v[0], v[1], v[2], v[3]); });
    }
}
DI void job_ln(const float* xin, const float* y, int ldy, const float* y2, const float* gw, const float* bw, float* out, bf16_t* outb, int bid, int nblk) {
    const int lane = threadIdx.x & 63, wid = threadIdx.x >> 6;
    for (int t = bid * (NT / 64) + wid; t < T; t += nblk * (NT / 64)) {
        float v[16];
        float s = 0.f;
#pragma unroll
        for (int i = 0; i < 4; ++i) {
            const int c = i * 256 + lane * 4;
            const float4 xv = *(const float4*)(xin + (long)t * 1024 + c);
            float4 yv = *(const float4*)(y + (long)t * ldy + c);
            if (y2) { const float4 z = *(const float4*)(y2 + (long)t * ldy + c); yv.x += z.x; yv.y += z.y; yv.z += z.z; yv.w += z.w; }
            v[i * 4 + 0] = DN_ALPHA * xv.x + yv.x; v[i * 4 + 1] = DN_ALPHA * xv.y + yv.y; v[i * 4 + 2] = DN_ALPHA * xv.z + yv.z; v[i * 4 + 3] = DN_ALPHA * xv.w + yv.w;
            s += (v[i * 4] + v[i * 4 + 1]) + (v[i * 4 + 2] + v[i * 4 + 3]);
        }
        const float mu = wave_sum(s) * (1.f / 1024.f);
        float q = 0.f;
#pragma unroll
        for (int i = 0; i < 16; ++i) { const float dlt = v[i] - mu; q += dlt * dlt; }
        const float rstd = rsqrtf(wave_sum(q) * (1.f / 1024.f) + 1e-5f);
#pragma unroll
        for (int i = 0; i < 4; ++i) {
            const int c = i * 256 + lane * 4;
            const float4 gv = *(const float4*)(gw + c), bv = *(const float4*)(bw + c);
            const float o0 = (v[i * 4] - mu) * rstd * gv.x + bv.x, o1 = (v[i * 4 + 1] - mu) * rstd * gv.y + bv.y,
                        o2 = (v[i * 4 + 2] - mu) * rstd * gv.z + bv.z, o3 = (v[i * 4 + 3] - mu) * rstd * gv.w + bv.w;
            *(float4*)(out + (long)t * 1024 + c) = make_float4(o0, o1, o2, o3);
            if (outb) st4bf(outb + (long)t * 1024 + c, o0, o1, o2, o3);
        }
    }
}
DI void job_router(const Params& p, const LayerW& w, int layer, int bid, int nblk) {
    const float* LOG = WSF(WS_LOG); int* EIDX = WSI(WS_EIDX); int* ESLOT = WSI(WS_ESLOT); float* EW = WSF(WS_EW);
    unsigned* cnt = WSU(WS_CTL) + CW_CNT + layer * 32;
    for (int t = bid * NT + threadIdx.x; t < T; t += nblk * NT) {
        const float* lr = LOG + (long)t * 36;
        const float g0 = lr[0] + w.rg_b[0], g1 = lr[1] + w.rg_b[1], g2 = lr[2] + w.rg_b[2], g3 = lr[3] + w.rg_b[3];
        const float gm = fmaxf(fmaxf(g0, g1), fmaxf(g2, g3));
        const float e0 = expf(g0 - gm), e1 = expf(g1 - gm), e2 = expf(g2 - gm), e3 = expf(g3 - gm);
        const float gs = (e0 + e1) + (e2 + e3);
        const float p0 = e0 / gs, p1 = e1 / gs, p2 = e2 / gs, p3 = e3 / gs;
        int grp = 0; float pg = p0;
        if (p1 > pg) { pg = p1; grp = 1; }
        if (p2 > pg) { pg = p2; grp = 2; }
        if (p3 > pg) { pg = p3; grp = 3; }
        float el[8];
#pragma unroll
        for (int i = 0; i < 8; ++i) el[i] = lr[4 + grp * 8 + i] + w.re_b[grp * 8 + i];
        float em = el[0];
#pragma unroll
        for (int i = 1; i < 8; ++i) em = fmaxf(em, el[i]);
        float es = 0.f;
#pragma unroll
        for (int i = 0; i < 8; ++i) { el[i] = expf(el[i] - em); es += el[i]; }
#pragma unroll
        for (int i = 0; i < 8; ++i) el[i] = el[i] / es;
        float b0 = el[0]; int i0 = 0;
#pragma unroll
        for (int i = 1; i < 8; ++i) if (el[i] > b0) { b0 = el[i]; i0 = i; }
        float b1 = -1.f; int i1 = 0;
#pragma unroll
        for (int i = 0; i < 8; ++i) if (i != i0 && el[i] > b1) { b1 = el[i]; i1 = i; }
        const float den = b0 + b1;
        const int ex0 = grp * 8 + i0, ex1 = grp * 8 + i1;
        EIDX[t * 2] = ex0; EIDX[t * 2 + 1] = ex1;
        EW[t * 2] = pg * b0 / den; EW[t * 2 + 1] = pg * b1 / den;
        ESLOT[t * 2] = (int)atomicAdd(&cnt[ex0], 1u);
        ESLOT[t * 2 + 1] = (int)atomicAdd(&cnt[ex1], 1u);
    }
}
DI int pad_rows(int c) { return (c + G_BM - 1) / G_BM * G_BM; }
DI void job_fill(const Params& p, int layer, int bid, int nblk) {
    const int* EIDX = WSI(WS_EIDX); const int* ESLOT = WSI(WS_ESLOT); int* PERM = WSI(WS_PERM);
    unsigned* cnt = WSU(WS_CTL) + CW_CNT + layer * 32;
    for (int a = bid * NT + threadIdx.x; a < NASSIGN + NEXP * G_BM; a += nblk * NT) {
        const bool real = a < NASSIGN;
        const int e = real ? EIDX[a] : (a - NASSIGN) / G_BM;
        int off = 0;
        for (int j = 0; j < e; ++j) off += pad_rows((int)__hip_atomic_load(&cnt[j], __ATOMIC_RELAXED, __HIP_MEMORY_SCOPE_AGENT));
        if (real) PERM[off + ESLOT[a]] = a;
        else { const int c = (int)__hip_atomic_load(&cnt[e], __ATOMIC_RELAXED, __HIP_MEMORY_SCOPE_AGENT), j = (a - NASSIGN) % G_BM; if (c + j < pad_rows(c)) PERM[off + c + j] = -1; }
    }
}
struct RowPerm { const int* perm; DI long operator()(int r) const { const int a = perm[r]; return a >= 0 ? (a >> 1) : 0; } };
template <int STAGE>
DI void job_moe_gemm(const Params& p, const LayerW& w, int layer, const bf16_t* X2, int bid, int nblk, unsigned char* lds) {
    unsigned* cnt = WSU(WS_CTL) + CW_CNT + layer * 32;
    int* s_off = (int*)(lds + 2 * G_STAGE);
    int* s_uoff = s_off + 33;
    __syncthreads();
    if (threadIdx.x == 0) {
        int ro = 0, uo = 0;
        for (int e = 0; e < 32; ++e) { const int c = pad_rows((int)__hip_atomic_load(&cnt[e], __ATOMIC_RELAXED, __HIP_MEMORY_SCOPE_AGENT)); s_off[e] = ro; s_uoff[e] = uo; ro += c; uo += (c / G_BM) * 8; }
        s_off[32] = ro; s_uoff[32] = uo;
    }
    __syncthreads();
    const int nunits = s_uoff[32];
    const int* PERM = WSI(WS_PERM);
    for (int u = bid; u < nunits; u += nblk) {
        int e = 0;
        while (e < 31 && u >= s_uoff[e + 1]) ++e;
        const int lu = u - s_uoff[e];
        const int ntile = lu & 7, mt = lu >> 3;
        const int r0 = s_off[e] + mt * G_BM, n0 = ntile * G_BN;
        f32x16 acc[2][2];
        if (STAGE == 0) {
            MG g; g.A = X2; g.lda = 1024; g.Wt = w.t_gu + (size_t)e * 1024 * 1024; g.ldw = 1024; g.K = 1024;
            mgemm_tile(g, n0, RowPerm{PERM + r0}, acc, lds);
            bf16_t* HH = WSB(WS_HH);
            const int l = threadIdx.x & 63, wv = threadIdx.x >> 6, wm = wv % G_WM, wn = wv / G_WM;
#pragma unroll
            for (int tt = 0; tt < 2; ++tt)
#pragma unroll
                for (int i = 0; i < 4; ++i) {
                    const int lrow = wm * 64 + tt * 32 + (l & 31), f = 64 * ntile + wn * 32 + 8 * i + 4 * (l >> 5);
                    float hv[4];
#pragma unroll
                    for (int j = 0; j < 4; ++j) { const float gt = acc[0][tt][4 * i + j], up = acc[1][tt][4 * i + j]; hv[j] = gt * sigm(gt) * up; }
                    st4bf(HH + (long)(r0 + lrow) * 512 + f, hv[0], hv[1], hv[2], hv[3]);
                }
        } else {
            MG g; g.A = WSB(WS_HH); g.lda = 512; g.Wt = w.t_dn + (size_t)e * 1024 * 512; g.ldw = 512; g.K = 512;
            mgemm_tile(g, n0, RowId{r0}, acc, lds);
            float* YK = WSF(WS_YK); const float* EW = WSF(WS_EW);
            MG_FOREACH(acc, lrow, feat, v, { const int a = PERM[r0 + lrow];
                if (a >= 0) { const float sw = EW[a]; *(float4*)(YK + (long)a * 1024 + n0 + feat) = make_float4(v[0] * sw, v[1] * sw, v[2] * sw, v[3] * sw); } });
        }
    }
}

typedef short s16x4 __attribute__((ext_vector_type(4)));
typedef short v4i16_t __attribute__((ext_vector_type(4)));
typedef float f32x2_t __attribute__((ext_vector_type(2)));
typedef __bf16 bf16x2_t __attribute__((ext_vector_type(2)));
DI unsigned cvtpk(float lo, float hi) { f32x2_t v = {lo, hi}; bf16x2_t b = __builtin_convertvector(v, bf16x2_t); return __builtin_bit_cast(unsigned, b); }
DI int crow(int reg, int h) { return (reg & 3) + 8 * (reg >> 2) + 4 * h; }
DI s16x4 tr_read(const unsigned char* p) { return __builtin_bit_cast(s16x4, __builtin_amdgcn_ds_read_tr16_b64_v4i16((LAS v4i16_t*)p)); }
DI float xhalf_max(float m) { auto rr = __builtin_amdgcn_permlane32_swap(__float_as_uint(m), __float_as_uint(m), false, false); return fmaxf(__uint_as_float(rr[0]), __uint_as_float(rr[1])); }
DI float xhalf_sum(float m) { auto rr = __builtin_amdgcn_permlane32_swap(__float_as_uint(m), __float_as_uint(m), false, false); return __uint_as_float(rr[0]) + __uint_as_float(rr[1]); }
DI float xhalf_other(float v, int h) { auto rr = __builtin_amdgcn_permlane32_swap(__float_as_uint(v), __float_as_uint(v), false, false); return __uint_as_float(h ? rr[0] : rr[1]); }
DI bf16x8 pack8(const f32x16& x, int s2) {
    u32x4 pk; pk[0] = cvtpk(x[8 * s2], x[8 * s2 + 1]); pk[1] = cvtpk(x[8 * s2 + 2], x[8 * s2 + 3]); pk[2] = cvtpk(x[8 * s2 + 4], x[8 * s2 + 5]); pk[3] = cvtpk(x[8 * s2 + 6], x[8 * s2 + 7]);
    return __builtin_bit_cast(bf16x8, pk);
}
constexpr int ATT_QB = (NT / 64) * 32;
template <int DC> struct TileCfg { static constexpr int RS = DC * 2 + 16, BYTES = 64 * RS, NCH = 64 * DC / 8, NI = (NCH + NT - 1) / NT; };
template <int DC, class RowPtr> DI void tile_gload(u32x4 (&rg)[TileCfg<DC>::NI], RowPtr rp) {
#pragma unroll
    for (int i = 0; i < TileCfg<DC>::NI; ++i) { const int c = threadIdx.x + NT * i; if (c < TileCfg<DC>::NCH) { const int row = c / (DC / 8), cc = c % (DC / 8); rg[i] = *(const u32x4*)(rp(row) + cc * 8); } }
}
template <int DC> DI void tile_lstore(const u32x4 (&rg)[TileCfg<DC>::NI], unsigned char* base) {
#pragma unroll
    for (int i = 0; i < TileCfg<DC>::NI; ++i) { const int c = threadIdx.x + NT * i; if (c < TileCfg<DC>::NCH) { const int row = c / (DC / 8), cc = c % (DC / 8); *(u32x4*)(base + row * TileCfg<DC>::RS + cc * 16) = rg[i]; } }
}
template <int DK> DI void qk_tile(f32x16 (&s)[2], const bf16x8 (&qf)[DK / 16], const unsigned char* kl, int r, int h) {
    constexpr int RS = TileCfg<DK>::RS;
#pragma unroll
    for (int i = 0; i < 16; ++i) { s[0][i] = 0.f; s[1][i] = 0.f; }
#pragma unroll
    for (int ks = 0; ks < DK / 16; ++ks) {
        const bf16x8 k0 = *(const bf16x8*)(kl + r * RS + ks * 32 + h * 16), k1 = *(const bf16x8*)(kl + (32 + r) * RS + ks * 32 + h * 16);
        s[0] = __builtin_amdgcn_mfma_f32_32x32x16_bf16(k0, qf[ks], s[0], 0, 0, 0);
        s[1] = __builtin_amdgcn_mfma_f32_32x32x16_bf16(k1, qf[ks], s[1], 0, 0, 0);
    }
}
template <int DV> DI void pv_tile(f32x16 (&o)[DV / 32], const f32x16 (&pp)[2], const unsigned char* vl, int lane) {
    constexpr int RS = TileCfg<DV>::RS;
    const int h = lane >> 5, i16 = lane & 15, q = i16 >> 2, pq = i16 & 3, blk = (lane >> 4) & 1;
    const unsigned char* vb = vl + (4 * h + q) * RS + 2 * (16 * blk + 4 * pq);
#pragma unroll
    for (int kt = 0; kt < 2; ++kt)
#pragma unroll
        for (int s2 = 0; s2 < 2; ++s2) {
            const bf16x8 pf = pack8(pp[kt], s2);
#pragma unroll
            for (int dvt = 0; dvt < DV / 32; ++dvt) {
                const s16x4 lo = tr_read(vb + (kt * 32 + 16 * s2) * RS + dvt * 64), hi = tr_read(vb + (kt * 32 + 16 * s2 + 8) * RS + dvt * 64);
                const bf16x8 vf = __builtin_shufflevector(lo, hi, 0, 1, 2, 3, 4, 5, 6, 7);
                o[dvt] = __builtin_amdgcn_mfma_f32_32x32x16_bf16(vf, pf, o[dvt], 0, 0, 0);
            }
        }
}
template <int DK, int DV, class MaskFn>
DI void softmax_tile(const bf16x8 (&qf)[DK / 16], f32x16 (&o)[DV / 32], float& m, float& l, const unsigned char* kl, const unsigned char* vl, int kb, MaskFn mf, int lane) {
    const int r = lane & 31, h = lane >> 5;
    f32x16 s[2];
    qk_tile<DK>(s, qf, kl, r, h);
    float tmax = -INFINITY;
#pragma unroll
    for (int kt = 0; kt < 2; ++kt)
#pragma unroll
        for (int i = 0; i < 16; ++i) { const float v = mf(kb + kt * 32 + crow(i, h), s[kt][i]); s[kt][i] = v; tmax = fmaxf(tmax, v); }
    tmax = xhalf_max(tmax);
    const float mn = fmaxf(m, tmax), corr = __expf(m - mn);
    m = mn;
    float ps = 0.f;
#pragma unroll
    for (int kt = 0; kt < 2; ++kt)
#pragma unroll
        for (int i = 0; i < 16; ++i) { const float pr = __expf(s[kt][i] - mn); s[kt][i] = pr; ps += pr; }
    l = l * corr + ps;
#pragma unroll
    for (int dvt = 0; dvt < DV / 32; ++dvt)
#pragma unroll
        for (int i = 0; i < 16; ++i) o[dvt][i] *= corr;
    pv_tile<DV>(o, s, vl, lane);
}
template <int DK, int DV, int NHQ, class KPtr, class VPtr, class MaskFn>
DI void attn_stream(const bf16x8 (&qf)[NHQ][DK / 16], f32x16 (&o)[NHQ][DV / 32], float (&m)[NHQ], float (&l)[NHQ], unsigned tmask, int wave_qmax, int wave_kmin,
                    KPtr kp, VPtr vp, MaskFn mf, unsigned char* lds) {
    unsigned char* kl = lds; unsigned char* vl = lds + TileCfg<DK>::BYTES;
    const int lane = threadIdx.x & 63;
    u32x4 kr[TileCfg<DK>::NI], vr[TileCfg<DV>::NI];
    if (tmask) { const int j = __builtin_ctz(tmask); tile_gload<DK>(kr, [&](int row) { return kp(j * 64 + row); }); tile_gload<DV>(vr, [&](int row) { return vp(j * 64 + row); }); }
    while (tmask) {
        const int j = __builtin_ctz(tmask); tmask &= tmask - 1;
        __syncthreads();
        tile_lstore<DK>(kr, kl); tile_lstore<DV>(vr, vl);
        __syncthreads();
        if (tmask) { const int jn = __builtin_ctz(tmask); tile_gload<DK>(kr, [&](int row) { return kp(jn * 64 + row); }); tile_gload<DV>(vr, [&](int row) { return vp(jn * 64 + row); }); }
        if (j * 64 <= wave_qmax && j * 64 + 63 >= wave_kmin) {
#pragma unroll
            for (int hq = 0; hq < NHQ; ++hq) softmax_tile<DK, DV>(qf[hq], o[hq], m[hq], l[hq], kl, vl, j * 64, [&](int key, float sc) { return mf(hq, key, sc); }, lane);
        }
    }
}

DI void job_mla_attn(const Params& p, int bid, int nblk, unsigned char* lds) {
    const bf16_t* QB = WSB(WS_QB); const bf16_t* KM = WSB(WS_KM); const bf16_t* VM = WSB(WS_VM); bf16_t* BR = WSB(WS_BR);
    constexpr int NQB = SEQ / ATT_QB, NU = BATCH * 4 * NQB;
    const int lane = threadIdx.x & 63, wid = threadIdx.x >> 6, r = lane & 31, h = lane >> 5;
    for (int u = bid; u < NU; u += nblk) {
        const int half = u / (NU / 2), ru = u % (NU / 2);
        const int qi = ru / (BATCH * 4), bh = ru % (BATCH * 4);
        const int qblk = half == 0 ? (NQB - 1 - qi) : qi;
        const int b = bh >> 2, hd = bh & 3;
        const int q0 = qblk * ATT_QB, qw = q0 + wid * 32, qpos = qw + r;
        const long trow = (long)b * SEQ;
        bf16x8 qf[1][6];
#pragma unroll
        for (int ks = 0; ks < 6; ++ks) qf[0][ks] = *(const bf16x8*)(QB + (trow + qpos) * 384 + hd * 96 + ks * 16 + 8 * h);
        f32x16 o[1][2];
#pragma unroll
        for (int i = 0; i < 16; ++i) { o[0][0][i] = 0.f; o[0][1][i] = 0.f; }
        float m[1] = {-1e30f}, l[1] = {0.f};
        const int ntile = (q0 + ATT_QB - 1) / 64 + 1;
        const unsigned tmask = ntile >= 32 ? 0xffffffffu : ((1u << ntile) - 1u);
        attn_stream<96, 64, 1>(qf, o, m, l, tmask, qw + 31, 0,
            [&](int row) { return KM + (trow + row) * 384 + hd * 96; },
            [&](int row) { return VM + (trow + row) * 256 + hd * 64; },
            [&](int, int key, float sc) { return key <= qpos ? sc * 0.10206207261596577f : -INFINITY; }, lds);
        const float rl = 1.f / fmaxf(xhalf_sum(l[0]), 1e-30f);
        bf16_t* dst = BR + (trow + qpos) * 1024 + 3 * 256 + hd * 64;
#pragma unroll
        for (int dvt = 0; dvt < 2; ++dvt)
#pragma unroll
            for (int i = 0; i < 4; ++i)
                st4bf(dst + dvt * 32 + 8 * i + 4 * h, o[0][dvt][4 * i] * rl, o[0][dvt][4 * i + 1] * rl, o[0][dvt][4 * i + 2] * rl, o[0][dvt][4 * i + 3] * rl);
    }
}
DI void job_cross_attn(const Params& p, int layer, int bid, int nblk, unsigned char* lds) {
    const bf16_t* XQ = WSB(WS_XQ); const bf16_t* KVM = WSB(WS_KVM) + (size_t)layer * 2048 * 1024; bf16_t* XO = WSB(WS_XO);
    constexpr int NQB = SEQ / ATT_QB, NU = BATCH * 4 * NQB;
    const int lane = threadIdx.x & 63, wid = threadIdx.x >> 6, r = lane & 31, h = lane >> 5;
    for (int u = bid; u < NU; u += nblk) {
        const int bh = u % (BATCH * 4), qblk = u / (BATCH * 4);
        const int b = bh >> 2, hd = bh & 3;
        const int qpos = qblk * ATT_QB + wid * 32 + r;
        const long trow = (long)b * SEQ;
        bf16x8 qf[1][8];
#pragma unroll
        for (int ks = 0; ks < 8; ++ks) qf[0][ks] = *(const bf16x8*)(XQ + (trow + qpos) * 512 + hd * 128 + ks * 16 + 8 * h);
        f32x16 o[1][4];
#pragma unroll
        for (int d = 0; d < 4; ++d)
#pragma unroll
            for (int i = 0; i < 16; ++i) o[0][d][i] = 0.f;
        float m[1] = {-1e30f}, l[1] = {0.f};
        attn_stream<128, 128, 1>(qf, o, m, l, 0xFu, 1 << 30, 0,
            [&](int row) { return KVM + (long)(b * MEM_LEN + row) * 1024 + hd * 128; },
            [&](int row) { return KVM + (long)(b * MEM_LEN + row) * 1024 + 512 + hd * 128; },
            [&](int, int, float sc) { return sc * 0.08838834764831845f; }, lds);
        const float rl = 1.f / fmaxf(xhalf_sum(l[0]), 1e-30f);
        bf16_t* dst = XO + (trow + qpos) * 512 + hd * 128;
#pragma unroll
        for (int dvt = 0; dvt < 4; ++dvt)
#pragma unroll
            for (int i = 0; i < 4; ++i)
                st4bf(dst + dvt * 32 + 8 * i + 4 * h, o[0][dvt][4 * i] * rl, o[0][dvt][4 * i + 1] * rl, o[0][dvt][4 * i + 2] * rl, o[0][dvt][4 * i + 3] * rl);
    }
}
DI float logsig_fast(float z) { return fminf(z, 0.f) - __logf(1.f + __expf(-fabsf(z))); }
DI void job_sb_attn(const Params& p, int bid, int nblk, unsigned char* lds) {
    const bf16_t* H = WSB(WS_H); bf16_t* BR = WSB(WS_BR);
    constexpr int NQB = SEQ / ATT_QB, NU = BATCH * 4 * NQB;
    const int lane = threadIdx.x & 63, wid = threadIdx.x >> 6, r = lane & 31, h = lane >> 5;
    unsigned char* kl = lds; unsigned char* vl = lds + TileCfg<64>::BYTES;
    for (int u = bid; u < NU; u += nblk) {
        const int half = u / (NU / 2), ru = u % (NU / 2);
        const int qi = ru / (BATCH * 4), bh = ru % (BATCH * 4);
        const int qblk = half == 0 ? (NQB - 1 - qi) : qi;
        const int b = bh >> 2, hd = bh & 3;
        const int q0 = qblk * ATT_QB, qw = q0 + wid * 32, qpos = qw + r;
        const long trow = (long)b * SEQ;
        bf16x8 qf[4];
#pragma unroll
        for (int ks = 0; ks < 4; ++ks) qf[ks] = *(const bf16x8*)(H + (trow + qpos) * NH + O_BQ + hd * 64 + ks * 16 + 8 * h);
        f32x16 o[2];
#pragma unroll
        for (int i = 0; i < 16; ++i) { o[0][i] = 0.f; o[1][i] = 0.f; }
        float trun = 0.f;
        int j = (q0 + ATT_QB - 1) >> 6;
        u32x4 kr[TileCfg<64>::NI], vr[TileCfg<64>::NI];
        tile_gload<64>(kr, [&](int row) { return H + (trow + j * 64 + row) * NH + O_BK + hd * 64; });
        tile_gload<64>(vr, [&](int row) { return H + (trow + j * 64 + row) * NH + O_BV + hd * 64; });
        for (; j >= 0; --j) {
            __syncthreads();
            tile_lstore<64>(kr, kl); tile_lstore<64>(vr, vl);
            __syncthreads();
            if (j > 0) { const int jn = j - 1;
                tile_gload<64>(kr, [&](int row) { return H + (trow + jn * 64 + row) * NH + O_BK + hd * 64; });
                tile_gload<64>(vr, [&](int row) { return H + (trow + jn * 64 + row) * NH + O_BV + hd * 64; }); }
            if (j * 64 < qw + 31) {
                const int kb = j * 64;
                f32x16 s[2], L[2];
                qk_tile<64>(s, qf, kl, r, h);
#pragma unroll
                for (int kt = 0; kt < 2; ++kt)
#pragma unroll
                    for (int i = 0; i < 16; ++i) {
                        const int key = kb + kt * 32 + crow(i, h);
                        const float z = s[kt][i] * 0.125f, lsp = logsig_fast(z);
                        const bool valid = key < qpos;
                        L[kt][i] = valid ? lsp - z : 0.f;
                        s[kt][i] = valid ? lsp : -INFINITY;
                    }
                float G[2][4], O[2][4];
#pragma unroll
                for (int kt = 0; kt < 2; ++kt)
#pragma unroll
                    for (int ig = 0; ig < 4; ++ig) { G[kt][ig] = (L[kt][4 * ig] + L[kt][4 * ig + 1]) + (L[kt][4 * ig + 2] + L[kt][4 * ig + 3]); O[kt][ig] = xhalf_other(G[kt][ig], h); }
                float run = trun;
#pragma unroll
                for (int kt = 1; kt >= 0; --kt)
#pragma unroll
                    for (int ig = 3; ig >= 0; --ig) {
                        const float t3 = run + (h == 0 ? O[kt][ig] : 0.f);
                        const float t2 = t3 + L[kt][4 * ig + 3], t1 = t2 + L[kt][4 * ig + 2], t0 = t1 + L[kt][4 * ig + 1];
                        s[kt][4 * ig + 3] = __expf(s[kt][4 * ig + 3] + t3); s[kt][4 * ig + 2] = __expf(s[kt][4 * ig + 2] + t2);
                        s[kt][4 * ig + 1] = __expf(s[kt][4 * ig + 1] + t1); s[kt][4 * ig + 0] = __expf(s[kt][4 * ig + 0] + t0);
                        run += G[kt][ig] + O[kt][ig];
                    }
                trun = run;
                pv_tile<64>(o, s, vl, lane);
            }
        }
        bf16_t* dst = BR + (trow + qpos) * 1024 + 1 * 256 + hd * 64;
#pragma unroll
        for (int dvt = 0; dvt < 2; ++dvt)
#pragma unroll
            for (int i = 0; i < 4; ++i) st4bf(dst + dvt * 32 + 8 * i + 4 * h, o[dvt][4 * i], o[dvt][4 * i + 1], o[dvt][4 * i + 2], o[dvt][4 * i + 3]);
    }
}
constexpr int NSA_QB = (NT / 128) * 32;
DI void job_nsa(const Params& p, int bid, int nblk, unsigned char* lds) {
    const bf16_t* H = WSB(WS_H); const bf16_t* KCB = WSB(WS_KCB); const bf16_t* VCB = KCB + (size_t)NCR * 64;
    float* OACC = WSF(WS_OC); bf16_t* BR = WSB(WS_BR);
    constexpr int NQB = SEQ / NSA_QB, NU = BATCH * 2 * NQB;
    constexpr int TB_ = TileCfg<64>::BYTES;
    const int lane = threadIdx.x & 63, wid = threadIdx.x >> 6, r = lane & 31, h = lane >> 5;
    const int n = wid & 1, sub = wid >> 1;
    unsigned* orw = (unsigned*)(lds + 4 * TB_);
    float* impx = (float*)(lds + 4 * TB_ + 64);
    for (int u = bid; u < NU; u += nblk) {
        const int qblk = NQB - 1 - u / (BATCH * 2), bg = u % (BATCH * 2), b = bg >> 1, g = bg & 1;
        const int q0 = qblk * NSA_QB, qw = q0 + sub * 32, qpos = qw + r;
        const int head = g * 2 + n;
        const long trow = (long)b * SEQ;
        const bf16_t* hq_row = H + (trow + qpos) * NH;
        bf16x8 qf[1][4];
#pragma unroll
        for (int ks = 0; ks < 4; ++ks) qf[0][ks] = *(const bf16x8*)(hq_row + O_AQ + head * 64 + ks * 16 + 8 * h);
        const float sl = exp2f(-2.f * (float)(head + 1));
        const float gate0 = sigm(bf2f(hq_row[O_AG + head * 3 + 0])), gate1 = sigm(bf2f(hq_row[O_AG + head * 3 + 1])), gate2 = sigm(bf2f(hq_row[O_AG + head * 3 + 2]));
        float* oacc = OACC + (trow + qpos) * 256 + head * 64;
        __syncthreads();
        if (threadIdx.x == 0) *orw = 0u;
        {
            u32x4 rg[TileCfg<64>::NI];
#pragma unroll
            for (int tl = 0; tl < 4; ++tl) {
                const bf16_t* src = (tl & 2) ? VCB : KCB; const int cb = (tl & 1) * 64;
                tile_gload<64>(rg, [&](int row) { const int c = cb + row < NCMP ? cb + row : NCMP - 1; return src + ((long)(b * NCMP + c) * 2 + g) * 64; });
                tile_lstore<64>(rg, lds + tl * TB_);
            }
        }
        __syncthreads();
        float imp[16];
        {
            f32x16 s[2][2];
            qk_tile<64>(s[0], qf[0], lds, r, h);
            qk_tile<64>(s[1], qf[0], lds + TB_, r, h);
            float tmax = -INFINITY;
#pragma unroll
            for (int tl = 0; tl < 2; ++tl)
#pragma unroll
                for (int kt = 0; kt < 2; ++kt)
#pragma unroll
                    for (int i = 0; i < 16; ++i) {
                        const int c = tl * 64 + kt * 32 + crow(i, h), dist = qpos - (16 * c + 31);
                        const float v = (c < NCMP && dist >= 0) ? s[tl][kt][i] * 0.125f - sl * (float)dist : -INFINITY;
                        s[tl][kt][i] = v; tmax = fmaxf(tmax, v);
                    }
            const float mn = fmaxf(xhalf_max(tmax), -1e30f);
            float ps = 0.f;
#pragma unroll
            for (int tl = 0; tl < 2; ++tl)
#pragma unroll
                for (int kt = 0; kt < 2; ++kt)
#pragma unroll
                    for (int i = 0; i < 16; ++i) { const float pr = __expf(s[tl][kt][i] - mn); s[tl][kt][i] = pr; ps += pr; }
            const float rl = 1.f / fmaxf(xhalf_sum(ps), 1e-30f);
            float P3[16];
#pragma unroll
            for (int tl = 0; tl < 2; ++tl)
#pragma unroll
                for (int kt = 0; kt < 2; ++kt) {
#pragma unroll
                    for (int ig = 0; ig < 4; ++ig) {
                        const float p0 = s[tl][kt][4 * ig] * rl, p1 = s[tl][kt][4 * ig + 1] * rl, p2 = s[tl][kt][4 * ig + 2] * rl, p3 = s[tl][kt][4 * ig + 3] * rl;
                        imp[tl * 8 + kt * 4 + ig] = (p0 + p1) + (p2 + 0.5f * p3);
                        P3[tl * 8 + kt * 4 + ig] = 0.5f * p3;
                    }
                    const float gs = rl * gate0;
#pragma unroll
                    for (int i = 0; i < 16; ++i) s[tl][kt][i] *= gs;
                }
#pragma unroll
            for (int idx = 0; idx < 16; ++idx) {
                const float pp = xhalf_other(P3[idx], h);
                float prevp;
                if (idx == 0) prevp = h ? pp : 0.f; else { const float ppm = xhalf_other(P3[idx - 1], h); prevp = h ? pp : ppm; }
                imp[idx] += prevp;
                impx[(wid * 16 + idx) * 64 + lane] = imp[idx];
            }
            f32x16 oc[2];
#pragma unroll
            for (int i = 0; i < 16; ++i) { oc[0][i] = 0.f; oc[1][i] = 0.f; }
            pv_tile<64>(oc, s[0], lds + 2 * TB_, lane);
            pv_tile<64>(oc, s[1], lds + 3 * TB_, lane);
#pragma unroll
            for (int dvt = 0; dvt < 2; ++dvt)
#pragma unroll
                for (int i = 0; i < 4; ++i) *(float4*)(oacc + dvt * 32 + 8 * i + 4 * h) = make_float4(oc[dvt][4 * i], oc[dvt][4 * i + 1], oc[dvt][4 * i + 2], oc[dvt][4 * i + 3]);
        }
        __syncthreads();
        unsigned sel = 0u;
        {
            const int cur = qpos >> 6;
#pragma unroll
            for (int idx = 0; idx < 16; ++idx) {
                const float other = impx[((wid ^ 1) * 16 + idx) * 64 + lane];
                const float tot = n == 0 ? imp[idx] + other : other + imp[idx];
                const int j = 2 * idx + h;
                const bool forced = (j == 0) || (j == cur), valid = (j * 64 <= qpos);
                imp[idx] = forced ? 1e4f : (valid ? tot : -1.0f);
            }
#pragma unroll 1
            for (int it = 0; it < 8; ++it) {
                float best = -INFINITY; int bj = 64;
#pragma unroll
                for (int idx = 0; idx < 16; ++idx) if (imp[idx] > best) { best = imp[idx]; bj = 2 * idx + h; }
                const float pb = xhalf_other(best, h); const int pj = __float_as_int(xhalf_other(__int_as_float(bj), h));
                const bool own = (best > pb) || (best == pb && bj < pj);
                const int wj = own ? bj : pj;
                sel |= 1u << wj;
#pragma unroll
                for (int idx = 0; idx < 16; ++idx) if (2 * idx + h == wj) imp[idx] = -INFINITY;
            }
        }
        atomicOr(orw, sel);
        __syncthreads();
        const unsigned bmask = *orw;
        const int jhi = (q0 + NSA_QB - 1) >> 6;
        const unsigned upto = jhi >= 31 ? 0xffffffffu : ((1u << (jhi + 1)) - 1u);
        {
            f32x16 o[1][2];
#pragma unroll
            for (int i = 0; i < 16; ++i) { o[0][0][i] = 0.f; o[0][1][i] = 0.f; }
            float m[1] = {-1e30f}, l[1] = {0.f};
            const int jlo = (q0 - 511 > 0 ? q0 - 511 : 0) >> 6;
            const unsigned tmask = upto & ~((1u << jlo) - 1u);
            attn_stream<64, 64, 1>(qf, o, m, l, tmask, qw + 31, qw - 511,
                [&](int row) { return H + (trow + row) * NH + O_AKW + g * 64; },
                [&](int row) { return H + (trow + row) * NH + O_AVW + g * 64; },
                [&](int, int key, float sc) { const int dist = qpos - key; return (dist >= 0 && dist < 512) ? sc * 0.125f - sl * (float)dist : -INFINITY; }, lds);
            const float rl = gate2 / fmaxf(xhalf_sum(l[0]), 1e-30f);
#pragma unroll
            for (int dvt = 0; dvt < 2; ++dvt)
#pragma unroll
                for (int i = 0; i < 4; ++i) { float4* a = (float4*)(oacc + dvt * 32 + 8 * i + 4 * h); float4 c = *a;
                    c.x += o[0][dvt][4 * i] * rl; c.y += o[0][dvt][4 * i + 1] * rl; c.z += o[0][dvt][4 * i + 2] * rl; c.w += o[0][dvt][4 * i + 3] * rl; *a = c; }
        }
        {
            f32x16 o[1][2];
#pragma unroll
            for (int i = 0; i < 16; ++i) { o[0][0][i] = 0.f; o[0][1][i] = 0.f; }
            float m[1] = {-1e30f}, l[1] = {0.f};
            attn_stream<64, 64, 1>(qf, o, m, l, bmask & upto, qw + 31, 0,
                [&](int row) { return H + (trow + row) * NH + O_AKS + g * 64; },
                [&](int row) { return H + (trow + row) * NH + O_AVS + g * 64; },
                [&](int, int key, float sc) { const int dist = qpos - key; return (dist >= 0 && ((sel >> (key >> 6)) & 1u)) ? sc * 0.125f - sl * (float)dist : -INFINITY; }, lds);
            const float rl = gate1 / fmaxf(xhalf_sum(l[0]), 1e-30f);
            bf16_t* dst = BR + (trow + qpos) * 1024 + head * 64;
#pragma unroll
            for (int dvt = 0; dvt < 2; ++dvt)
#pragma unroll
                for (int i = 0; i < 4; ++i) { const float4 c = *(const float4*)(oacc + dvt * 32 + 8 * i + 4 * h);
                    st4bf(dst + dvt * 32 + 8 * i + 4 * h, c.x + o[0][dvt][4 * i] * rl, c.y + o[0][dvt][4 * i + 1] * rl, c.z + o[0][dvt][4 * i + 2] * rl, c.w + o[0][dvt][4 * i + 3] * rl); }
        }
    }
}
DI void job_mla_pack(const Params& p, int bid, int nblk) {
    const float* Q = WSF(WS_Q); const float* KV = WSF(WS_KV); const float* KR = WSF(WS_KR);
    bf16_t* QB = WSB(WS_QB); bf16_t* KM = WSB(WS_KM); bf16_t* VM = WSB(WS_VM);
    for (long e = (long)bid * NT + threadIdx.x; e < (long)T * 96; e += (long)nblk * NT) {
        const long t = e / 96; const int c4 = (int)(e % 96) * 4;
        const float4 qv = *(const float4*)(Q + t * 384 + c4);
        st4bf(QB + t * 384 + c4, qv.x, qv.y, qv.z, qv.w);
        const int hd = c4 / 96, f = c4 % 96;
        if (f < 64) { const float4 kv = *(const float4*)(KV + t * 512 + hd * 128 + f); st4bf(KM + t * 384 + c4, kv.x, kv.y, kv.z, kv.w); }
        else { const float4 kv = *(const float4*)(KR + t * 32 + (f - 64)); st4bf(KM + t * 384 + c4, kv.x, kv.y, kv.z, kv.w); }
        if (f < 64) { const float4 vv = *(const float4*)(KV + t * 512 + hd * 128 + 64 + f); st4bf(VM + t * 256 + hd * 64 + f, vv.x, vv.y, vv.z, vv.w); }
    }
}

constexpr int NPH = 20;
constexpr int NPHASES = 2 + DEPTH * NPH;

__global__ void __launch_bounds__(NT, 1) mega(Params pk, int ph_lo, int ph_hi) {
    extern __shared__ __attribute__((aligned(16))) unsigned char lds[];
    float* ldsf = (float*)lds;
    __shared__ uint4 xb_words;
    const int bid = blockIdx.x, nblk = gridDim.x;
    XcdBarrier bar;
    const bool multi = (ph_hi - ph_lo) > 1;
    if (multi) {
        if (threadIdx.x == 0) xb_words = make_uint4(0u, 0u, 0u, 0u);
        __syncthreads();
        bar = xcd_barrier_post((unsigned*)(pk.ws + WS_CTL) + CW_BAR, (volatile LAS unsigned*)&xb_words);
    }
#define PHASE(id, ...) do { const int _id = (id); if (ph_lo <= _id && _id < ph_hi) { { Params p = pk; int layer = layer_; asm volatile("" : "+s"(p.ws), "+s"(p.out), "+s"(layer)); \
        const LayerW w = layer_w(p, layer); const float* Xin = (layer == 0) ? p.in[0] : WSF(WS_XC); const bf16_t* XinB = (layer == 0) ? WSB(WS_X0B) : WSB(WS_XCB); float* Xout = (layer == DEPTH - 1) ? p.out : WSF(WS_XC); \
        (void)w; (void)Xin; (void)XinB; (void)Xout; __VA_ARGS__; } if (_id + 1 < ph_hi) xcd_barrier(bar); } } while (0)

    { const int layer_ = 0;
    PHASE(0, {
        job_wt<2>(p.in[2], DEPTH, 1024, NIN, WSB(WT_IN), NH, bid, nblk, lds);
        job_wt<0>(p.in[17], DEPTH * 4, 256, 1024, WSB(WT_BR), 1024, bid, nblk, lds);
        job_wt<0>(p.in[18], DEPTH, 1024, 1024, WSB(WT_OUT), 1024, bid, nblk, lds);
        job_wt<0>(p.in[21], DEPTH, 1024, 512, WSB(WT_Q), 512, bid, nblk, lds);
        job_wt<0>(p.in[22], DEPTH, 1024, 1024, WSB(WT_KV), 1024, bid, nblk, lds);
        job_wt<0>(p.in[23], DEPTH, 512, 1024, WSB(WT_O), 1024, bid, nblk, lds);
        job_wt<1>(p.in[30], DEPTH * 32, 1024, 1024, WSB(WT_GU), 1024, bid, nblk, lds);
        job_wt<0>(p.in[31], DEPTH * 32, 512, 1024, WSB(WT_DN), 1024, bid, nblk, lds);
        job_cvt(p.in[0], WSB(WS_X0B), (long)T * 1024, bid, nblk);
        job_cvt(p.in[1], WSB(WS_MEMB), (long)2048 * 1024, bid, nblk);
    });
    PHASE(1, {
        for (int l = 0; l < DEPTH; ++l) {
            MG g; g.A = WSB(WS_MEMB); g.lda = 1024; g.Wt = WSB(WT_KV) + (size_t)l * 1024 * 1024; g.ldw = 1024; g.K = 1024;
            mgemm_job<0>(g, BATCH * MEM_LEN, 1024, WSB(WS_KVM) + (size_t)l * 2048 * 1024, 1024, bid, nblk, lds);
        }
    });

    }
    for (int layer_ = 0; layer_ < DEPTH; ++layer_) {
        const int base = 2 + layer_ * NPH;
        PHASE(base + 0, { MG g; g.A = XinB; g.lda = 1024; g.Wt = w.t_in; g.ldw = 1024; g.K = 1024; mgemm_job<2>(g, T, NH, WSB(WS_H), NH, bid, nblk, lds); });
        PHASE(base + 1, { job_cmp_gather(p, w, bid, nblk); job_rnn_conv(p, w, bid, nblk); job_mla_norm(p, w, bid, nblk); });
        PHASE(base + 2, {
            for (int j = 0; j < 2; ++j) { GemmOp g; g.A = WSF(WS_TB) + (size_t)j * NCR * 2048; g.lda = 2048; g.aidx = nullptr; g.B = w.cmp_w1 + (size_t)j * 2048 * 256; g.ldb = 256; g.M = NCR; g.N = 256; g.K = 2048;
                gemm_job<1>(g, WSF(WS_HID) + (size_t)j * NCR * 256, 256, bid, nblk, ldsf); }
            job_rnn_gates(p, w, bid, nblk);
            { GemmOp g; g.A = WSF(WS_CQN); g.lda = 192; g.aidx = nullptr; g.B = w.w_uq; g.ldb = 384; g.M = T; g.N = 384; g.K = 192; gemm_job<0>(g, WSF(WS_Q), 384, bid, nblk, ldsf); }
            { GemmOp g; g.A = WSF(WS_CKVN); g.lda = 128; g.aidx = nullptr; g.B = w.w_ukv; g.ldb = 512; g.M = T; g.N = 512; g.K = 128; gemm_job<0>(g, WSF(WS_KV), 512, bid, nblk, ldsf); }
        });
        PHASE(base + 3, {
            for (int j = 0; j < 2; ++j) { GemmOp g; g.A = WSF(WS_HID) + (size_t)j * NCR * 256; g.lda = 256; g.aidx = nullptr; g.B = w.cmp_w2 + (size_t)j * 256 * 64; g.ldb = 64; g.M = NCR; g.N = 64; g.K = 256;
                gemm_job<0>(g, WSF(WS_KCVC) + (size_t)j * NCR * 64, 64, bid, nblk, ldsf); }
            job_rnn_scan(p, bid, nblk);
            job_q_rope(p, bid, nblk);
        });
        PHASE(base + 4, { job_sb_attn(p, bid, nblk, lds); job_mla_pack(p, bid, nblk); job_cvt(WSF(WS_KCVC), WSB(WS_KCB), (long)2 * NCR * 64, bid, nblk); });
        PHASE(base + 5, { job_nsa(p, bid, nblk, lds); job_mla_attn(p, bid, nblk, lds); });
        PHASE(base + 6, { });
        PHASE(base + 7, { job_merge(p, w, bid, nblk, lds); });
        PHASE(base + 8, { MG g; g.A = WSB(WS_M); g.lda = 1024; g.Wt = w.t_out; g.ldw = 1024; g.K = 1024; mgemm_job<1>(g, T, 1024, WSF(WS_Y), 1024, bid, nblk, lds); });
        PHASE(base + 9, { job_ln(Xin, WSF(WS_Y), 1024, nullptr, w.ln1_g, w.ln1_b, WSF(WS_XA), WSB(WS_XAB), bid, nblk); });
        PHASE(base + 10, { MG g; g.A = WSB(WS_XAB); g.lda = 1024; g.Wt = w.t_q; g.ldw = 1024; g.K = 1024; mgemm_job<0>(g, T, 512, WSB(WS_XQ), 512, bid, nblk, lds); });
        PHASE(base + 11, { job_cross_attn(p, layer, bid, nblk, lds); });
        PHASE(base + 12, { MG g; g.A = WSB(WS_XO); g.lda = 512; g.Wt = w.t_o; g.ldw = 512; g.K = 512; mgemm_job<1>(g, T, 1024, WSF(WS_Y), 1024, bid, nblk, lds); });
        PHASE(base + 13, { job_ln(WSF(WS_XA), WSF(WS_Y), 1024, nullptr, w.ln2_g, w.ln2_b, WSF(WS_XB), WSB(WS_XBB), bid, nblk); });
        PHASE(base + 14, {
            { GemmOp g; g.A = WSF(WS_XB); g.lda = 1024; g.aidx = nullptr; g.B = w.rg_w; g.ldb = 4; g.M = T; g.N = 4; g.K = 1024; gemm_job<0>(g, WSF(WS_LOG), 36, bid, nblk, ldsf); }
            { GemmOp g; g.A = WSF(WS_XB); g.lda = 1024; g.aidx = nullptr; g.B = w.re_w; g.ldb = 32; g.M = T; g.N = 32; g.K = 1024; gemm_job<0>(g, WSF(WS_LOG) + 4, 36, bid, nblk, ldsf); }
        });
        PHASE(base + 15, { job_router(p, w, layer, bid, nblk); });
        PHASE(base + 16, { job_fill(p, layer, bid, nblk); });
        PHASE(base + 17, { job_moe_gemm<0>(p, w, layer, WSB(WS_XBB), bid, nblk, lds); });
        PHASE(base + 18, { job_moe_gemm<1>(p, w, layer, WSB(WS_XBB), bid, nblk, lds); });
        PHASE(base + 19, { job_ln(WSF(WS_XB), WSF(WS_YK), 2048, WSF(WS_YK) + 1024, w.ln3_g, w.ln3_b, Xout, (layer == DEPTH - 1) ? nullptr : WSB(WS_XCB), bid, nblk); });
    }
}

extern "C" void kernel_launch(void* const* d_in, const int* in_sizes, int n_in, void* d_out, int out_size, void* d_ws, size_t ws_size, hipStream_t stream) {
    constexpr size_t kDynLds = 2 * G_STAGE + 1024;
    static_assert(kDynLds >= 256 * 33 * 4, "selection scratch");
    static int grid = 0;
    if (!grid) {
        int dev = 0, cus = 0, per_cu = 0;
        (void)hipGetDevice(&dev);
        (void)hipDeviceGetAttribute(&cus, hipDeviceAttributeMultiprocessorCount, dev);
        (void)hipFuncSetAttribute((const void*)mega, hipFuncAttributeMaxDynamicSharedMemorySize, (int)kDynLds);
        (void)hipOccupancyMaxActiveBlocksPerMultiprocessor(&per_cu, mega, NT, kDynLds);
        if (per_cu < 1) per_cu = 1;
        grid = cus * (per_cu < 2 ? per_cu : 2);
    }
    if (ws_size < WS_END) { fprintf(stderr, "workspace too small: %zu < %zu\n", ws_size, (size_t)WS_END); return; }
    Params p{};
    for (int i = 0; i < 34; ++i) p.in[i] = (const float*)d_in[i];
    p.out = (float*)d_out;
    p.ws = (unsigned char*)d_ws;
    (void)hipMemsetAsync(d_ws, 0, CTL_BYTES, stream);
#if MK_ONE_LAUNCH
    hipLaunchKernelGGL(mega, dim3(grid), dim3(NT), kDynLds, stream, p, 0, NPHASES);
#else
    for (int ph = 0; ph < NPHASES; ++ph) hipLaunchKernelGGL(mega, dim3(grid), dim3(NT), kDynLds, stream, p, ph, ph + 1);
#endif
}
```

```cpp
#include <hip/hip_runtime.h>
#include <stdint.h>
#include <stdio.h>

#ifndef MK_ONE_LAUNCH
#define MK_ONE_LAUNCH 1
#endif

#define DI __device__ __forceinline__
#define LAS __attribute__((address_space(3)))

constexpr int NT = 512;
constexpr int D = 1024, BATCH = 8, SEQ = 2048, T = BATCH * SEQ, DEPTH = 4;
constexpr int MEM_LEN = 256;
constexpr int NIN = 6764, NH = 6784;
constexpr int O_AQ = 0, O_AKC = 256, O_AVC = 384, O_AKS = 512, O_AVS = 640, O_AKW = 768, O_AVW = 896,
              O_BQ = 1024, O_BK = 1280, O_BV = 1536, O_CX = 1792, O_CG = 2048, O_DCQ = 2304, O_DCKV = 2496, O_DKR = 2624,
              O_AG = 2656, O_MG = 2688;
constexpr int NCMP = 127, NCR = BATCH * NCMP * 2;
constexpr int NEXP = 32, NASSIGN = T * 2;
constexpr float DN_ALPHA = 1.681792830507429f;

typedef unsigned short bf16_t;
typedef short bf16x8 __attribute__((ext_vector_type(8)));
typedef float f32x16 __attribute__((ext_vector_type(16)));
typedef unsigned u32x4 __attribute__((ext_vector_type(4)));

constexpr int G_WM = NT / 128;
constexpr int G_BM = 64 * G_WM;
constexpr int G_BN = 128;
constexpr int G_RS = 144;
constexpr int G_STAGE = (G_BM + G_BN) * G_RS;
constexpr int PADROWS = ((NASSIGN + NEXP * (G_BM - 1) + G_BM - 1) / G_BM) * G_BM;

constexpr size_t MiB = 1u << 20;
constexpr size_t al(size_t x) { return (x + 255) & ~(size_t)255; }
constexpr size_t WS_CTL = 0, CTL_BYTES = 1 * MiB;
constexpr size_t WT_IN = WS_CTL + CTL_BYTES;
constexpr size_t WT_BR = WT_IN + al((size_t)DEPTH * NH * 1024 * 2);
constexpr size_t WT_OUT = WT_BR + al((size_t)DEPTH * 4 * 1024 * 256 * 2);
constexpr size_t WT_Q = WT_OUT + al((size_t)DEPTH * 1024 * 1024 * 2);
constexpr size_t WT_KV = WT_Q + al((size_t)DEPTH * 512 * 1024 * 2);
constexpr size_t WT_O = WT_KV + al((size_t)DEPTH * 1024 * 1024 * 2);
constexpr size_t WT_GU = WT_O + al((size_t)DEPTH * 1024 * 512 * 2);
constexpr size_t WT_DN = WT_GU + al((size_t)DEPTH * 32 * 1024 * 1024 * 2);
constexpr size_t WS_X0B = WT_DN + al((size_t)DEPTH * 32 * 1024 * 512 * 2);
constexpr size_t WS_MEMB = WS_X0B + al((size_t)T * 1024 * 2);
constexpr size_t WS_H = WS_MEMB + al((size_t)2048 * 1024 * 2);
constexpr size_t SZ_H = al((size_t)T * NH * 2);
constexpr size_t WS_YK = WS_H;
constexpr size_t WS_HH = WS_YK + (size_t)NASSIGN * 1024 * 4;
static_assert(WS_HH + (size_t)PADROWS * 512 * 2 <= WS_H + SZ_H, "moe overlay fits in H");
constexpr size_t WS_TB = WS_H + SZ_H;
constexpr size_t WS_HID = WS_TB + al((size_t)2 * NCR * 2048 * 4);
constexpr size_t WS_KCVC = WS_HID + al((size_t)2 * NCR * 256 * 4);
constexpr size_t WS_PC = WS_KCVC + al((size_t)2 * NCR * 64 * 4);
constexpr size_t WS_SEL = WS_PC + al((size_t)BATCH * 4 * SEQ * 128 * 4);
constexpr size_t WS_OW = WS_SEL + al((size_t)BATCH * 2 * SEQ * 4);
constexpr size_t WS_OC = WS_OW + al((size_t)T * 256 * 4);
constexpr size_t WS_BR = WS_OC + al((size_t)T * 256 * 4);
constexpr size_t WS_U = WS_BR + al((size_t)T * 1024 * 2);
constexpr size_t WS_RA = WS_U + al((size_t)T * 256 * 4);
constexpr size_t WS_RB = WS_RA + al((size_t)T * 256 * 4);
constexpr size_t WS_CQN = WS_RB + al((size_t)T * 256 * 4);
constexpr size_t WS_CKVN = WS_CQN + al((size_t)T * 192 * 4);
constexpr size_t WS_KR = WS_CKVN + al((size_t)T * 128 * 4);
constexpr size_t WS_Q = WS_KR + al((size_t)T * 32 * 4);
constexpr size_t WS_KV = WS_Q + al((size_t)T * 384 * 4);
constexpr size_t WS_M = WS_KV + al((size_t)T * 512 * 4);
constexpr size_t WS_Y = WS_M + al((size_t)T * 1024 * 2);
constexpr size_t WS_XA = WS_Y + al((size_t)T * 1024 * 4);
constexpr size_t WS_XB = WS_XA + al((size_t)T * 1024 * 4);
constexpr size_t WS_XC = WS_XB + al((size_t)T * 1024 * 4);
constexpr size_t WS_XAB = WS_XC + al((size_t)T * 1024 * 4);
constexpr size_t WS_XBB = WS_XAB + al((size_t)T * 1024 * 2);
constexpr size_t WS_XCB = WS_XBB + al((size_t)T * 1024 * 2);
constexpr size_t WS_XQ = WS_XCB + al((size_t)T * 1024 * 2);
constexpr size_t WS_XO = WS_XQ + al((size_t)T * 512 * 2);
constexpr size_t WS_KVM = WS_XO + al((size_t)T * 512 * 2);
constexpr size_t WS_LOG = WS_KVM + al((size_t)DEPTH * 2048 * 1024 * 2);
constexpr size_t WS_EIDX = WS_LOG + al((size_t)T * 36 * 4);
constexpr size_t WS_ESLOT = WS_EIDX + al((size_t)NASSIGN * 4);
constexpr size_t WS_EW = WS_ESLOT + al((size_t)NASSIGN * 4);
constexpr size_t WS_PERM = WS_EW + al((size_t)NASSIGN * 4);
constexpr size_t WS_QB = WS_PERM + al((size_t)PADROWS * 4);
constexpr size_t WS_KM = WS_QB + al((size_t)T * 384 * 2);
constexpr size_t WS_VM = WS_KM + al((size_t)T * 384 * 2);
constexpr size_t WS_KCB = WS_VM + al((size_t)T * 256 * 2);
constexpr size_t WT_C1 = WS_KCB + al((size_t)2 * NCR * 64 * 2);
constexpr size_t WT_C2 = WT_C1 + al((size_t)DEPTH * 2 * 256 * 2048 * 2);
constexpr size_t WT_UQ = WT_C2 + al((size_t)DEPTH * 2 * 128 * 256 * 2);
constexpr size_t WT_UKV = WT_UQ + al((size_t)DEPTH * 384 * 192 * 2);
constexpr size_t WT_G = WT_UKV + al((size_t)DEPTH * 512 * 128 * 2);
constexpr size_t WT_RH = WT_G + al((size_t)DEPTH * 4 * 128 * 64 * 2);
constexpr size_t WT_RL = WT_RH + al((size_t)DEPTH * 128 * 1024 * 2);
constexpr size_t WS_TBB = WT_RL + al((size_t)DEPTH * 128 * 1024 * 2);
constexpr size_t WS_HIDB = WS_TBB + al((size_t)2 * 2048 * 2048 * 2);
constexpr size_t WS_UB = WS_HIDB + al((size_t)2 * 2048 * 256 * 2);
constexpr size_t WS_CQNB = WS_UB + al((size_t)T * 256 * 2);
constexpr size_t WS_CKVNB = WS_CQNB + al((size_t)T * 192 * 2);
constexpr size_t WS_XBL = WS_CKVNB + al((size_t)T * 128 * 2);
constexpr size_t WS_SA = WS_XBL + al((size_t)T * 1024 * 2);
constexpr size_t WS_SH = WS_SA + al((size_t)BATCH * 32 * 256 * 4);
constexpr size_t WS_END = WS_SH + al((size_t)BATCH * 32 * 256 * 4);

constexpr int CW_BAR = 4096;
constexpr int CW_CNT = 16384;

struct Params {
    const float* in[34];
    float* out;
    unsigned char* ws;
};

#define XB_TMO      128
#define XB_XCNT(j)  (256  + 64 * (j))
#define XB_XSUB(j)  (1280 + 64 * (j))
#define XB_XGEN(j)  (2304 + 64 * (j))
#define XB_TOP      3328
#define XB_TOPGEN   3392
#define XCD_BAR_WORDS 3456
#define XB_SPIN_CAP (1u << 22)

__device__ __forceinline__ unsigned xb_ld(unsigned* p)              { return __hip_atomic_load(p, __ATOMIC_RELAXED, __HIP_MEMORY_SCOPE_AGENT); }
__device__ __forceinline__ unsigned xb_add(unsigned* p, unsigned v) { return __hip_atomic_fetch_add(p, v, __ATOMIC_RELAXED, __HIP_MEMORY_SCOPE_AGENT); }
__device__ __forceinline__ unsigned xb_xcc_id() { return (unsigned)__builtin_amdgcn_s_getreg((3 << 11) | 20) & 0xFu; }
#define XB_SPIN(cond, bar) do { unsigned _sp = 0; while (cond) { __builtin_amdgcn_s_sleep(1); \
    if ((++_sp & 255u) == 0u) { if (xb_ld(&(bar)[XB_TMO])) break; if (_sp > XB_SPIN_CAP) { atomicAdd(&(bar)[XB_TMO], 1u); break; } } } } while (0)

struct XcdBarrier { unsigned* bar; unsigned x; volatile LAS unsigned* st; };

__device__ __forceinline__ XcdBarrier xcd_barrier_post(unsigned* bar, volatile LAS unsigned* st) {
    XcdBarrier b; b.bar = bar; b.x = xb_xcc_id(); b.st = st;
    if (threadIdx.x == 0) (void)xb_add(&bar[XB_XCNT(b.x)], 1u);
    return b;
}
__device__ __forceinline__ void xcd_barrier_complete(unsigned* bar, unsigned x, unsigned& nloc, unsigned& nx) {
    const unsigned G = gridDim.x * gridDim.y * gridDim.z;
    unsigned sum, cnt, mine, sp = 0u;
    for (;;) {
        sum = 0u; cnt = 0u; mine = 0u;
#pragma unroll
        for (unsigned j = 0; j < 16; ++j) { const unsigned c = xb_ld(&bar[XB_XCNT(j)]); sum += c; cnt += (c > 0u) ? 1u : 0u; mine = (j == x) ? c : mine; }
        if (sum == G) break;
        __builtin_amdgcn_s_sleep(1);
        if ((++sp & 255u) == 0u) { if (xb_ld(&bar[XB_TMO])) break; if (sp > XB_SPIN_CAP) { atomicAdd(&bar[XB_TMO], 1u); break; } }
    }
    nloc = mine > 0u ? mine : 1u; nx = cnt > 0u ? cnt : 1u;
}
__device__ __forceinline__ void xcd_barrier(const XcdBarrier& b) {
    asm volatile("s_waitcnt vmcnt(0)" ::: "memory");
    __syncthreads();
    if (threadIdx.x == 0) {
        unsigned* bar = b.bar;
        __builtin_amdgcn_s_waitcnt(0);
        unsigned nloc = b.st[0], nx = b.st[1];
        if (nloc == 0u) { xcd_barrier_complete(bar, b.x, nloc, nx); b.st[0] = nloc; b.st[1] = nx; }
        const unsigned old = xb_add(&bar[XB_XSUB(b.x)], 1u);
        const unsigned gen = old / nloc;
        if (old + 1u == (gen + 1u) * nloc) {
            __builtin_amdgcn_fence(__ATOMIC_RELEASE, "agent");
            asm volatile("s_waitcnt vmcnt(0)" ::: "memory");
            const unsigned og = xb_add(&bar[XB_TOP], 1u);
            const unsigned tg = og / nx;
            if (og + 1u == (tg + 1u) * nx) xb_add(&bar[XB_TOPGEN], 1u);
            else XB_SPIN(xb_ld(&bar[XB_TOPGEN]) == tg, bar);
            __builtin_amdgcn_fence(__ATOMIC_ACQUIRE, "agent");
            xb_add(&bar[XB_XGEN(b.x)], 1u);
            asm volatile("s_waitcnt vmcnt(0)" ::: "memory");
        } else {
            XB_SPIN(xb_ld(&bar[XB_XGEN(b.x)]) == gen, bar);
            __builtin_amdgcn_fence(__ATOMIC_ACQUIRE, "agent");
            asm volatile("s_waitcnt vmcnt(0)" ::: "memory");
        }
    }
    __syncthreads();
}

DI int tidx() { int t = threadIdx.x; asm volatile("" : "+v"(t)); return t; }
DI float gelu_tanh(float x) { const float u = 0.7978845608028654f * (x + 0.044715f * x * x * x); return 0.5f * x * (1.f + tanhf(u)); }
DI float sigm(float x) { return 1.f / (1.f + expf(-x)); }
DI float logsig(float z) { return fminf(z, 0.f) - log1pf(expf(-fabsf(z))); }
DI float wave_sum(float v) {
#pragma unroll
    for (int o = 32; o > 0; o >>= 1) v += __shfl_xor(v, o, 64);
    return v;
}

DI float bflo(unsigned u) { return __uint_as_float(u << 16); }
DI float bfhi(unsigned u) { return __uint_as_float(u & 0xffff0000u); }
DI float bf2f(bf16_t x) { return __uint_as_float((unsigned)x << 16); }
DI unsigned pk_bf16(float lo, float hi) { unsigned r; asm volatile("v_cvt_pk_bf16_f32 %0, %1, %2" : "=v"(r) : "v"(lo), "v"(hi)); return r; }
DI bf16_t f2bf(float x) { return (bf16_t)(pk_bf16(x, 0.f) & 0xffffu); }
DI void st4bf(bf16_t* p, float a, float b, float c, float d) { uint2 v; v.x = pk_bf16(a, b); v.y = pk_bf16(c, d); *(uint2*)p = v; }
DI float4 ld4bf(const bf16_t* p) { const uint2 v = *(const uint2*)p; return make_float4(bflo(v.x), bfhi(v.x), bflo(v.y), bfhi(v.y)); }
template <int N> DI float dot_row(const float* q, const bf16_t* kr) {
    float dot = 0.f;
#pragma unroll
    for (int d = 0; d < N; d += 8) { const uint4 v = *(const uint4*)(kr + d);
        dot = fmaf(q[d], bflo(v.x), dot); dot = fmaf(q[d + 1], bfhi(v.x), dot); dot = fmaf(q[d + 2], bflo(v.y), dot); dot = fmaf(q[d + 3], bfhi(v.y), dot);
        dot = fmaf(q[d + 4], bflo(v.z), dot); dot = fmaf(q[d + 5], bfhi(v.z), dot); dot = fmaf(q[d + 6], bflo(v.w), dot); dot = fmaf(q[d + 7], bfhi(v.w), dot); }
    return dot;
}
template <int N> DI float dot_row(const float* q, const float* kr) {
    float dot = 0.f;
#pragma unroll
    for (int d = 0; d < N; ++d) dot = fmaf(q[d], kr[d], dot);
    return dot;
}
template <int N> DI void axpy_row(float* o, float pr, float corr, const bf16_t* vr) {
#pragma unroll
    for (int d = 0; d < N; d += 8) { const uint4 v = *(const uint4*)(vr + d);
        o[d] = fmaf(pr, bflo(v.x), o[d] * corr); o[d + 1] = fmaf(pr, bfhi(v.x), o[d + 1] * corr); o[d + 2] = fmaf(pr, bflo(v.y), o[d + 2] * corr); o[d + 3] = fmaf(pr, bfhi(v.y), o[d + 3] * corr);
        o[d + 4] = fmaf(pr, bflo(v.z), o[d + 4] * corr); o[d + 5] = fmaf(pr, bfhi(v.z), o[d + 5] * corr); o[d + 6] = fmaf(pr, bflo(v.w), o[d + 6] * corr); o[d + 7] = fmaf(pr, bfhi(v.w), o[d + 7] * corr); }
}
template <int N> DI void axpy_row(float* o, float pr, float corr, const float* vr) {
#pragma unroll
    for (int d = 0; d < N; ++d) o[d] = fmaf(pr, vr[d], o[d] * corr);
}
template <int N> DI void ld_row(float* q, const bf16_t* p) {
#pragma unroll
    for (int d = 0; d < N; d += 8) { const uint4 v = *(const uint4*)(p + d);
        q[d] = bflo(v.x); q[d + 1] = bfhi(v.x); q[d + 2] = bflo(v.y); q[d + 3] = bfhi(v.y); q[d + 4] = bflo(v.z); q[d + 5] = bfhi(v.z); q[d + 6] = bflo(v.w); q[d + 7] = bfhi(v.w); }
}
template <int N> DI void ld_row(float* q, const float* p) {
#pragma unroll
    for (int d = 0; d < N; d += 4) { const float4 v = *(const float4*)(p + d); q[d] = v.x; q[d + 1] = v.y; q[d + 2] = v.z; q[d + 3] = v.w; }
}

struct MG { const bf16_t* A; long lda; const bf16_t* Wt; long ldw; int K; };

template <class RowFn>
DI void mgemm_tile(const MG& g, int n0, RowFn rowfn, f32x16 (&acc)[2][2], unsigned char* lds, bool zero = true) {
    constexpr int XI = G_BM * 8 / NT, WI = G_BN * 8 / NT;
    const int tid = tidx(), lane = tid & 63, wid = tid >> 6, r = lane & 31, h = lane >> 5;
    const int wm = wid % G_WM, wn = wid / G_WM;
    const int cc = tid & 7, row0 = tid >> 3;
    const bf16_t* xp[XI]; const bf16_t* wp[WI];
#pragma unroll
    for (int i = 0; i < XI; ++i) xp[i] = g.A + (long)rowfn(row0 + (NT / 8) * i) * g.lda + cc * 8;
#pragma unroll
    for (int i = 0; i < WI; ++i) wp[i] = g.Wt + (long)(n0 + row0 + (NT / 8) * i) * g.ldw + cc * 8;
    const int st_off = row0 * G_RS + cc * 16;
    if (zero)
#pragma unroll
    for (int a = 0; a < 2; ++a)
#pragma unroll
        for (int b = 0; b < 2; ++b)
#pragma unroll
            for (int i = 0; i < 16; ++i) acc[a][b][i] = 0.f;
    u32x4 xv[XI], wv[WI];
#pragma unroll
    for (int i = 0; i < XI; ++i) xv[i] = *(const u32x4*)(xp[i]);
#pragma unroll
    for (int i = 0; i < WI; ++i) wv[i] = *(const u32x4*)(wp[i]);
    __syncthreads();
#pragma unroll
    for (int i = 0; i < XI; ++i) *(u32x4*)(lds + st_off + (NT / 8) * i * G_RS) = xv[i];
#pragma unroll
    for (int i = 0; i < WI; ++i) *(u32x4*)(lds + G_BM * G_RS + st_off + (NT / 8) * i * G_RS) = wv[i];
    __syncthreads();
    const int nk = g.K >> 6;
    const int xf_off = (wm * 64 + r) * G_RS + h * 16, wf_off = G_BM * G_RS + (wn * 64 + r) * G_RS + h * 16;
    for (int kt = 0; kt < nk; ++kt) {
        const unsigned char* st = lds + (kt & 1) * G_STAGE;
        if (kt + 1 < nk) {
#pragma unroll
            for (int i = 0; i < XI; ++i) xv[i] = *(const u32x4*)(xp[i] + (kt + 1) * 64);
#pragma unroll
            for (int i = 0; i < WI; ++i) wv[i] = *(const u32x4*)(wp[i] + (kt + 1) * 64);
        }
#pragma unroll
        for (int ks = 0; ks < 4; ++ks) {
            const bf16x8 w0 = *(const bf16x8*)(st + wf_off + ks * 32), w1 = *(const bf16x8*)(st + wf_off + 32 * G_RS + ks * 32);
            const bf16x8 x0 = *(const bf16x8*)(st + xf_off + ks * 32), x1 = *(const bf16x8*)(st + xf_off + 32 * G_RS + ks * 32);
            acc[0][0] = __builtin_amdgcn_mfma_f32_32x32x16_bf16(w0, x0, acc[0][0], 0, 0, 0);
            acc[0][1] = __builtin_amdgcn_mfma_f32_32x32x16_bf16(w0, x1, acc[0][1], 0, 0, 0);
            acc[1][0] = __builtin_amdgcn_mfma_f32_32x32x16_bf16(w1, x0, acc[1][0], 0, 0, 0);
            acc[1][1] = __builtin_amdgcn_mfma_f32_32x32x16_bf16(w1, x1, acc[1][1], 0, 0, 0);
        }
        if (kt + 1 < nk) {
            unsigned char* sn = lds + ((kt + 1) & 1) * G_STAGE;
#pragma unroll
            for (int i = 0; i < XI; ++i) *(u32x4*)(sn + st_off + (NT / 8) * i * G_RS) = xv[i];
#pragma unroll
            for (int i = 0; i < WI; ++i) *(u32x4*)(sn + G_BM * G_RS + st_off + (NT / 8) * i * G_RS) = wv[i];
        }
        __syncthreads();
    }
}
#define MG_FOREACH(acc, LROW, FEAT, V, ...) do { const int _l = tidx() & 63, _w = tidx() >> 6, _wm = _w % G_WM, _wn = _w / G_WM; \
    _Pragma("unroll") for (int _ft = 0; _ft < 2; ++_ft) _Pragma("unroll") for (int _tt = 0; _tt < 2; ++_tt) _Pragma("unroll") for (int _i = 0; _i < 4; ++_i) { \
        const int LROW = _wm * 64 + _tt * 32 + (_l & 31); const int FEAT = _wn * 64 + _ft * 32 + 8 * _i + 4 * (_l >> 5); \
        float V[4] = {acc[_ft][_tt][4 * _i], acc[_ft][_tt][4 * _i + 1], acc[_ft][_tt][4 * _i + 2], acc[_ft][_tt][4 * _i + 3]}; __VA_ARGS__ } } while (0)

struct RowId { int m0; DI long operator()(int r) const { return m0 + r; } };

template <int OUTMODE>
DI void mgemm_job(const MG& g, int M, int N, void* out, long ldo, int bid, int nblk, unsigned char* lds) {
    const int tm = M / G_BM, tn = N / G_BN;
    for (int u = bid; u < tm * tn; u += nblk) {
        const int grp = u / (16 * tn), rem = u % (16 * tn);
        const int gm = (tm - grp * 16) < 16 ? (tm - grp * 16) : 16;
        const int mt = grp * 16 + rem % gm, nt = rem / gm;
        const int m0 = mt * G_BM, n0 = nt * G_BN;
        f32x16 acc[2][2];
        mgemm_tile(g, n0, RowId{m0}, acc, lds);
        MG_FOREACH(acc, lrow, feat, v, {
            const long o = (long)(m0 + lrow) * ldo + n0 + feat;
            if (OUTMODE == 1) *(float4*)((float*)out + o) = make_float4(v[0], v[1], v[2], v[3]);
            else {
                if (OUTMODE == 2 && n0 + feat >= O_MG) { v[0] = sigm(v[0]); v[1] = sigm(v[1]); v[2] = sigm(v[2]); v[3] = sigm(v[3]); }
                st4bf((bf16_t*)out + o, v[0], v[1], v[2], v[3]);
            } });
    }
}

struct LayerW {
    const float *cmp_pos, *conv_w, *conv_b, *ga_b, *gx_b, *lam, *q_norm, *kv_norm,
        *ln1_g, *ln1_b, *ln2_g, *ln2_b, *rg_b, *re_b, *ln3_g, *ln3_b;
    const bf16_t *t_in, *t_br, *t_out, *t_q, *t_o, *t_gu, *t_dn, *t_c1, *t_c2, *t_uq, *t_ukv, *t_g, *t_rh, *t_rl;
};
#define WSF(off) ((float*)(p.ws + (off)))
#define WSI(off) ((int*)(p.ws + (off)))
#define WSU(off) ((unsigned*)(p.ws + (off)))
#define WSB(off) ((bf16_t*)(p.ws + (off)))
DI LayerW layer_w(const Params& p, int l) {
    LayerW w;
    w.cmp_pos = p.in[3] + (size_t)l * 2 * 32 * 64;
    w.conv_w = p.in[6] + (size_t)l * 4 * 256;
    w.conv_b = p.in[7] + (size_t)l * 256;
    w.ga_b = p.in[9] + (size_t)l * 256;
    w.gx_b = p.in[11] + (size_t)l * 256;
    w.lam = p.in[12] + (size_t)l * 256;
    w.q_norm = p.in[13] + (size_t)l * 192;
    w.kv_norm = p.in[14] + (size_t)l * 128;
    w.ln1_g = p.in[19] + (size_t)l * 1024; w.ln1_b = p.in[20] + (size_t)l * 1024;
    w.ln2_g = p.in[24] + (size_t)l * 1024; w.ln2_b = p.in[25] + (size_t)l * 1024;
    w.rg_b = p.in[27] + (size_t)l * 4;
    w.re_b = p.in[29] + (size_t)l * 32;
    w.ln3_g = p.in[32] + (size_t)l * 1024; w.ln3_b = p.in[33] + (size_t)l * 1024;
    w.t_in = WSB(WT_IN) + (size_t)l * NH * 1024;
    w.t_br = WSB(WT_BR) + (size_t)l * 4 * 1024 * 256;
    w.t_out = WSB(WT_OUT) + (size_t)l * 1024 * 1024;
    w.t_q = WSB(WT_Q) + (size_t)l * 512 * 1024;
    w.t_o = WSB(WT_O) + (size_t)l * 1024 * 512;
    w.t_gu = WSB(WT_GU) + (size_t)l * 32 * 1024 * 1024;
    w.t_dn = WSB(WT_DN) + (size_t)l * 32 * 1024 * 512;
    w.t_c1 = WSB(WT_C1) + (size_t)l * 2 * 256 * 2048;
    w.t_c2 = WSB(WT_C2) + (size_t)l * 2 * 128 * 256;
    w.t_uq = WSB(WT_UQ) + (size_t)l * 384 * 192;
    w.t_ukv = WSB(WT_UKV) + (size_t)l * 512 * 128;
    w.t_g = WSB(WT_G) + (size_t)l * 4 * 128 * 64;
    w.t_rh = WSB(WT_RH) + (size_t)l * 128 * 1024;
    w.t_rl = WSB(WT_RL) + (size_t)l * 128 * 1024;
    return w;
}

template <int MODE>
DI void job_wt(const float* src, int nmat, int K, int Nsrc, bf16_t* dst, int Npad, int bid, int nblk, unsigned char* lds) {
    bf16_t* tile = (bf16_t*)lds;
    const int tk = K / 64, tn = Npad / 64, per = tk * tn;
    const int tid = tidx();
    for (int u = bid; u < nmat * per; u += nblk) {
        const int mat = u / per, ru = u % per, k0 = (ru / tn) * 64, n0 = (ru % tn) * 64;
        const float* s = src + (size_t)mat * K * Nsrc;
        bf16_t* d = dst + (size_t)mat * Npad * K;
        const int nl = tid & 63, kl = tid >> 6;
        const int np = n0 + nl;
        int col;
        if (MODE == 0) col = np < Nsrc ? np : -1;
        else if (MODE == 2) col = np < 1024 ? np : (np < 2656 ? np + 12 : (np < 2668 ? 1024 + (np - 2656) : (np < 2688 ? -1 : np - 20)));
        else { const int j = np >> 7, q = np & 127, seg = q >> 5, i = q & 31; const int f = 64 * j + (seg >> 1) * 32 + i; col = (seg & 1) ? 512 + f : f; }
        __syncthreads();
#pragma unroll 4
        for (int pss = 0; pss < 64 / (NT / 64); ++pss) {
            const int k = kl + (NT / 64) * pss;
            const float v = col >= 0 ? s[(size_t)(k0 + k) * Nsrc + col] : 0.f;
            tile[nl * 72 + k] = f2bf(v);
        }
        __syncthreads();
        for (int c = tid; c < 64 * 8; c += NT) {
            const int n2 = c >> 3, kc = (c & 7) * 8;
            *(uint4*)(d + (size_t)(n0 + n2) * K + k0 + kc) = *(const uint4*)(tile + n2 * 72 + kc);
        }
    }
}
DI void job_cvt(const float* src, bf16_t* dst, long n, int bid, int nblk) {
    for (long e = ((long)bid * NT + tidx()) * 4; e < n; e += (long)nblk * NT * 4) {
        const float4 v = *(const float4*)(src + e);
        st4bf(dst + e, v.x, v.y, v.z, v.w);
    }
}
DI void job_cmp_gather(const Params& p, const LayerW& w, int bid, int nblk) {
    const bf16_t* H = WSB(WS_H); bf16_t* TB = WSB(WS_TBB);
    const long total = (long)2 * NCR * 2048 / 4;
    for (long e = (long)bid * NT + tidx(); e < total; e += (long)nblk * NT) {
        const long e4 = e * 4;
        const int f = (int)(e4 % 2048); const long r2 = e4 / 2048; const int r = (int)(r2 % NCR), j = (int)(r2 / NCR);
        const int g = r & 1, bc = r >> 1, c = bc % NCMP, b = bc / NCMP, i = f >> 6, d = f & 63;
        const float4 hv = ld4bf(H + (long)(b * SEQ + 16 * c + i) * NH + (j ? O_AVC : O_AKC) + g * 64 + d);
        const float4 pv = *(const float4*)(w.cmp_pos + (j * 32 + i) * 64 + d);
        st4bf(TB + ((long)j * 2048 + r) * 2048 + f, hv.x + pv.x, hv.y + pv.y, hv.z + pv.z, hv.w + pv.w);
    }
}
DI void job_rnn_conv(const Params& p, const LayerW& w, int bid, int nblk) {
    const bf16_t* H = WSB(WS_H); float* U = WSF(WS_U); bf16_t* UB = WSB(WS_UB);
    for (long e = (long)bid * NT + tidx(); e < (long)T * 256; e += (long)nblk * NT) {
        const int ch = (int)(e & 255); const int t = (int)(e >> 8), s = t & (SEQ - 1);
        float u = w.conv_b[ch];
#pragma unroll
        for (int tap = 0; tap < 4; ++tap) { const int sp = s - 3 + tap; if (sp >= 0) u += bf2f(H[(long)(t - 3 + tap) * NH + O_CX + ch]) * w.conv_w[tap * 256 + ch]; }
        U[e] = u; UB[e] = f2bf(u);
    }
}
DI void job_rnn_gates(const Params& p, const LayerW& w, int bid, int nblk, unsigned char* lds) {
    const float* U = WSF(WS_U); float* RA = WSF(WS_RA); float* RB = WSF(WS_RB);
    for (int u = bid; u < (T / G_BM) * 4; u += nblk) {
        const int blk = u & 3, m0 = (u >> 2) * G_BM;
        MG g; g.A = WSB(WS_UB) + blk * 64; g.lda = 256; g.Wt = w.t_g + (size_t)blk * 128 * 64; g.ldw = 64; g.K = 64;
        f32x16 acc[2][2];
        mgemm_tile(g, 0, RowId{m0}, acc, lds);
        const int l = tidx() & 63, wv = tidx() >> 6, wm = wv % G_WM, wn = wv / G_WM;
#pragma unroll
        for (int tt = 0; tt < 2; ++tt)
#pragma unroll
            for (int i = 0; i < 4; ++i) {
                const long t = m0 + wm * 64 + tt * 32 + (l & 31); const int ch = blk * 64 + wn * 32 + 8 * i + 4 * (l >> 5);
                const float4 uv = *(const float4*)(U + t * 256 + ch);
                const float ua[4] = {uv.x, uv.y, uv.z, uv.w};
                float av[4], bv[4];
#pragma unroll
                for (int j = 0; j < 4; ++j) {
                    const float r = sigm(acc[0][tt][4 * i + j] + w.ga_b[ch + j]), ig = sigm(acc[1][tt][4 * i + j] + w.gx_b[ch + j]);
                    const float nl = -w.lam[ch + j];
                    const float sp = fmaxf(nl, 0.f) + log1pf(expf(-fabsf(nl)));
                    const float log_a = -8.0f * r * sp;
                    av[j] = expf(log_a); bv[j] = sqrtf(-expm1f(2.0f * log_a)) * (ig * ua[j]);
                }
                *(float4*)(RA + t * 256 + ch) = make_float4(av[0], av[1], av[2], av[3]);
                *(float4*)(RB + t * 256 + ch) = make_float4(bv[0], bv[1], bv[2], bv[3]);
            }
    }
}
DI void job_rnn_scan1(const Params& p, int bid, int nblk) {
    const float* RA = WSF(WS_RA); const float* RB = WSF(WS_RB); float* SA = WSF(WS_SA); float* SH = WSF(WS_SH);
    for (int e = bid * NT + tidx(); e < BATCH * 32 * 256; e += nblk * NT) {
        const int ch = e & 255, bc = e >> 8;
        float ap = 1.f, hl = 0.f;
        for (int s0 = 0; s0 < 64; s0 += 8) {
            float av[8], bv[8];
#pragma unroll
            for (int i = 0; i < 8; ++i) { const long t = (long)bc * 64 + s0 + i; av[i] = RA[t * 256 + ch]; bv[i] = RB[t * 256 + ch]; }
#pragma unroll
            for (int i = 0; i < 8; ++i) { ap *= av[i]; hl = av[i] * hl + bv[i]; }
        }
        SA[e] = ap; SH[e] = hl;
    }
}
DI void job_rnn_scan2(const Params& p, int bid, int nblk) {
    const bf16_t* H = WSB(WS_H); const float* RA = WSF(WS_RA); const float* RB = WSF(WS_RB); const float* SA = WSF(WS_SA); const float* SH = WSF(WS_SH); bf16_t* BR = WSB(WS_BR);
    for (int e = bid * NT + tidx(); e < BATCH * 32 * 256; e += nblk * NT) {
        const int ch = e & 255, bc = e >> 8, chunk = bc & 31, b = bc >> 5;
        float h = 0.f;
        for (int c = 0; c < chunk; ++c) { const int q = ((b * 32 + c) << 8) + ch; h = SA[q] * h + SH[q]; }
        for (int s0 = 0; s0 < 64; s0 += 8) {
            float av[8], bv[8], gv[8];
#pragma unroll
            for (int i = 0; i < 8; ++i) { const long t = (long)bc * 64 + s0 + i; av[i] = RA[t * 256 + ch]; bv[i] = RB[t * 256 + ch]; gv[i] = bf2f(H[t * NH + O_CG + ch]); }
#pragma unroll
            for (int i = 0; i < 8; ++i) { const long t = (long)bc * 64 + s0 + i; h = av[i] * h + bv[i]; BR[t * 1024 + 2 * 256 + ch] = f2bf(h * gelu_tanh(gv[i])); }
        }
    }
}
DI void job_mla_norm(const Params& p, const LayerW& w, int bid, int nblk) {
    const bf16_t* H = WSB(WS_H); bf16_t* CQN = WSB(WS_CQNB); bf16_t* CKVN = WSB(WS_CKVNB); bf16_t* KM = WSB(WS_KM);
    const int lane = tidx() & 63, wid = tidx() >> 6;
    for (int t = bid * (NT / 64) + wid; t < T; t += nblk * (NT / 64)) {
        const bf16_t* hr = H + (long)t * NH;
        float q0 = bf2f(hr[O_DCQ + lane]), q1 = bf2f(hr[O_DCQ + 64 + lane]), q2 = bf2f(hr[O_DCQ + 128 + lane]);
        float ss = wave_sum(q0 * q0 + q1 * q1 + q2 * q2);
        float rs = rsqrtf(ss * (1.f / 192.f) + 1e-6f);
        CQN[(long)t * 192 + lane] = f2bf(q0 * rs * w.q_norm[lane]);
        CQN[(long)t * 192 + 64 + lane] = f2bf(q1 * rs * w.q_norm[64 + lane]);
        CQN[(long)t * 192 + 128 + lane] = f2bf(q2 * rs * w.q_norm[128 + lane]);
        float k0 = bf2f(hr[O_DCKV + lane]), k1 = bf2f(hr[O_DCKV + 64 + lane]);
        ss = wave_sum(k0 * k0 + k1 * k1);
        rs = rsqrtf(ss * (1.f / 128.f) + 1e-6f);
        CKVN[(long)t * 128 + lane] = f2bf(k0 * rs * w.kv_norm[lane]);
        CKVN[(long)t * 128 + 64 + lane] = f2bf(k1 * rs * w.kv_norm[64 + lane]);
        {
            const int i = lane & 15, hd = lane >> 4;
            const int s = t & (SEQ - 1);
            const float inv = powf(10000.f, -(float)(2 * i) / 32.f);
            const float ang = (float)s * inv, cs = cosf(ang), sn = sinf(ang);
            const float x1 = bf2f(hr[O_DKR + i]), x2 = bf2f(hr[O_DKR + 16 + i]);
            KM[(long)t * 384 + hd * 96 + 64 + i] = f2bf(x1 * cs - x2 * sn);
            KM[(long)t * 384 + hd * 96 + 80 + i] = f2bf(x1 * sn + x2 * cs);
        }
    }
}
DI void job_mla_up(const Params& p, const LayerW& w, int bid, int nblk, unsigned char* lds) {
    bf16_t* QB = WSB(WS_QB); bf16_t* KM = WSB(WS_KM); bf16_t* VM = WSB(WS_VM);
    constexpr int TM = T / G_BM;
    for (int u = bid; u < TM * 7; u += nblk) {
        const int mt = u / 7, nt = u % 7, m0 = mt * G_BM;
        f32x16 acc[2][2];
        const int l = tidx() & 63, wv = tidx() >> 6, wm = wv % G_WM, wn = wv / G_WM, hh = l >> 5;
        if (nt < 3) {
            MG g; g.A = WSB(WS_CQNB); g.lda = 192; g.Wt = w.t_uq; g.ldw = 192; g.K = 192;
            const int n0 = nt * 128;
            mgemm_tile(g, n0, RowId{m0}, acc, lds);
#pragma unroll
            for (int ft = 0; ft < 2; ++ft) {
                const int fb = (n0 + wn * 64 + ft * 32) >> 5;
                if (fb % 3 == 2) {
#pragma unroll
                    for (int tt = 0; tt < 2; ++tt) {
                        const int pos = (m0 + wm * 64 + tt * 32 + (l & 31)) & (SEQ - 1);
#pragma unroll
                        for (int i = 0; i < 2; ++i)
#pragma unroll
                            for (int j = 0; j < 4; ++j) {
                                const int fi = 8 * i + 4 * hh + j;
                                const float inv = powf(10000.f, -(float)(2 * fi) / 32.f);
                                const float ang = (float)pos * inv, cs = cosf(ang), sn = sinf(ang);
                                const float x1 = acc[ft][tt][4 * i + j], x2 = acc[ft][tt][4 * (i + 2) + j];
                                acc[ft][tt][4 * i + j] = x1 * cs - x2 * sn; acc[ft][tt][4 * (i + 2) + j] = x1 * sn + x2 * cs;
                            }
                    }
                }
            }
            MG_FOREACH(acc, lrow, feat, v, { st4bf(QB + (long)(m0 + lrow) * 384 + n0 + feat, v[0], v[1], v[2], v[3]); });
        } else {
            MG g; g.A = WSB(WS_CKVNB); g.lda = 128; g.Wt = w.t_ukv; g.ldw = 128; g.K = 128;
            const int n0 = (nt - 3) * 128;
            mgemm_tile(g, n0, RowId{m0}, acc, lds);
            MG_FOREACH(acc, lrow, feat, v, {
                const int hd = nt - 3;
                if (feat < 64) st4bf(KM + (long)(m0 + lrow) * 384 + hd * 96 + feat, v[0], v[1], v[2], v[3]);
                else st4bf(VM + (long)(m0 + lrow) * 256 + hd * 64 + (feat - 64), v[0], v[1], v[2], v[3]); });
        }
    }
}
template <int STAGE>
DI void job_cmp_mlp(const Params& p, const LayerW& w, int bid, int nblk, unsigned char* lds) {
    constexpr int TM = 2048 / G_BM, TN = STAGE == 0 ? 2 : 1;
    for (int u = bid; u < 2 * TM * TN; u += nblk) {
        const int j = u / (TM * TN), ru = u % (TM * TN), mt = ru / TN, nt = ru % TN, m0 = mt * G_BM, n0 = nt * 128;
        MG g;
        if (STAGE == 0) { g.A = WSB(WS_TBB) + (size_t)j * 2048 * 2048; g.lda = 2048; g.Wt = w.t_c1 + (size_t)j * 256 * 2048; g.ldw = 2048; g.K = 2048; }
        else { g.A = WSB(WS_HIDB) + (size_t)j * 2048 * 256; g.lda = 256; g.Wt = w.t_c2 + (size_t)j * 128 * 256; g.ldw = 256; g.K = 256; }
        f32x16 acc[2][2];
        mgemm_tile(g, n0, [&](int r) { const int rr = m0 + r; return (long)(rr < NCR ? rr : NCR - 1); }, acc, lds);
        if (STAGE == 0) {
            bf16_t* HID = WSB(WS_HIDB) + (size_t)j * 2048 * 256;
            MG_FOREACH(acc, lrow, feat, v, { st4bf(HID + (long)(m0 + lrow) * 256 + n0 + feat, gelu_tanh(v[0]), gelu_tanh(v[1]), gelu_tanh(v[2]), gelu_tanh(v[3])); });
        } else {
            bf16_t* KC = WSB(WS_KCB) + (size_t)j * NCR * 64;
            MG_FOREACH(acc, lrow, feat, v, { if (feat < 64 && m0 + lrow < NCR) st4bf(KC + (long)(m0 + lrow) * 64 + feat, v[0], v[1], v[2], v[3]); });
        }
    }
}
DI void job_router_logits(const Params& p, const LayerW& w, int bid, int nblk, unsigned char* lds) {
    float* LOG = WSF(WS_LOG);
    for (int u = bid; u < T / G_BM; u += nblk) {
        const int m0 = u * G_BM;
        f32x16 acc[2][2];
        MG g; g.lda = 1024; g.ldw = 1024; g.K = 1024;
        g.A = WSB(WS_XBB); g.Wt = w.t_rh; mgemm_tile(g, 0, RowId{m0}, acc, lds, true);
        g.A = WSB(WS_XBL); g.Wt = w.t_rh; mgemm_tile(g, 0, RowId{m0}, acc, lds, false);
        g.A = WSB(WS_XBB); g.Wt = w.t_rl; mgemm_tile(g, 0, RowId{m0}, acc, lds, false);
        MG_FOREACH(acc, lrow, feat, v, { if (feat < 36) *(float4*)(LOG + (long)(m0 + lrow) * 36 + feat) = make_float4(v[0], v[1], v[2], v[3]); });
    }
}
DI void job_pack_small(const Params& p, int bid, int nblk) {
    bf16_t* TG = WSB(WT_G); bf16_t* RH = WSB(WT_RH); bf16_t* RL = WSB(WT_RL);
    for (int e = bid * NT + tidx(); e < DEPTH * 4 * 128 * 64; e += nblk * NT) {
        const int c = e & 63, q = (e >> 6) & 127, lb = e >> 13;
        const int seg = q >> 5, i = q & 31, chl = (seg >> 1) * 32 + i;
        const float* src = (seg & 1) ? p.in[10] : p.in[8];
        TG[e] = f2bf(src[((size_t)lb * 64 + c) * 64 + chl]);
    }
    for (int e = bid * NT + tidx(); e < DEPTH * 128 * 1024; e += nblk * NT) {
        const int k = e & 1023, n = (e >> 10) & 127, l = e >> 17;
        float v = 0.f;
        if (n < 4) v = p.in[26][((size_t)l * 1024 + k) * 4 + n];
        else if (n < 36) v = p.in[28][((size_t)l * 1024 + k) * 32 + (n - 4)];
        const bf16_t hi = f2bf(v);
        RH[e] = hi; RL[e] = f2bf(v - bf2f(hi));
    }
}

DI void job_merge(const Params& p, const LayerW& w, int bid, int nblk, unsigned char* lds) {
    const bf16_t* H = WSB(WS_H); bf16_t* M = WSB(WS_M);
    for (int u = bid; u < (T / G_BM) * 8; u += nblk) {
        const int m0 = (u >> 3) * G_BM, n0 = (u & 7) * G_BN;
        f32x16 macc[2][2];
#pragma unroll
        for (int a = 0; a < 2; ++a)
#pragma unroll
            for (int b = 0; b < 2; ++b)
#pragma unroll
                for (int i = 0; i < 16; ++i) macc[a][b][i] = 0.f;
#pragma unroll 1
        for (int n = 0; n < 4; ++n) {
            MG g; g.A = WSB(WS_BR) + n * 256; g.lda = 1024; g.Wt = w.t_br + (size_t)n * 1024 * 256; g.ldw = 256; g.K = 256;
            f32x16 acc[2][2];
            mgemm_tile(g, n0, RowId{m0}, acc, lds);
            const int l = tidx() & 63, wv = tidx() >> 6, wm = wv % G_WM, wn = wv / G_WM;
#pragma unroll
            for (int ft = 0; ft < 2; ++ft)
#pragma unroll
                for (int tt = 0; tt < 2; ++tt)
#pragma unroll
                    for (int i = 0; i < 4; ++i) {
                        const int lrow = wm * 64 + tt * 32 + (l & 31), feat = wn * 64 + ft * 32 + 8 * i + 4 * (l >> 5);
                        const float4 gv = ld4bf(H + (long)(m0 + lrow) * NH + O_MG + n * 1024 + n0 + feat);
                        macc[ft][tt][4 * i] += gv.x * acc[ft][tt][4 * i]; macc[ft][tt][4 * i + 1] += gv.y * acc[ft][tt][4 * i + 1];
                        macc[ft][tt][4 * i + 2] += gv.z * acc[ft][tt][4 * i + 2]; macc[ft][tt][4 * i + 3] += gv.w * acc[ft][tt][4 * i + 3];
                    }
        }
        MG_FOREACH(macc, lrow, feat, v, { st4bf(M + (long)(m0 + lrow) * 1024 + n0 + feat, v[0], v[1], v[2], v[3]); });
    }
}
DI void job_ln(const float* xin, const float* y, int ldy, const float* y2, const float* gw, const float* bw, float* out, bf16_t* outb, bf16_t* outl, int bid, int nblk) {
    const int lane = tidx() & 63, wid = tidx() >> 6;
    for (int t = bid * (NT / 64) + wid; t < T; t += nblk * (NT / 64)) {
        float v[16];
        float s = 0.f;
#pragma unroll
        for (int i = 0; i < 4; ++i) {
            const int c = i * 256 + lane * 4;
            const float4 xv = *(const float4*)(xin + (long)t * 1024 + c);
            float4 yv = *(const float4*)(y + (long)t * ldy + c);
            if (y2) { const float4 z = *(const float4*)(y2 + (long)t * ldy + c); yv.x += z.x; yv.y += z.y; yv.z += z.z; yv.w += z.w; }
            v[i * 4 + 0] = DN_ALPHA * xv.x + yv.x; v[i * 4 + 1] = DN_ALPHA * xv.y + yv.y; v[i * 4 + 2] = DN_ALPHA * xv.z + yv.z; v[i * 4 + 3] = DN_ALPHA * xv.w + yv.w;
            s += (v[i * 4] + v[i * 4 + 1]) + (v[i * 4 + 2] + v[i * 4 + 3]);
        }
        const float mu = wave_sum(s) * (1.f / 1024.f);
        float q = 0.f;
#pragma unroll
        for (int i = 0; i < 16; ++i) { const float dlt = v[i] - mu; q += dlt * dlt; }
        const float rstd = rsqrtf(wave_sum(q) * (1.f / 1024.f) + 1e-5f);
#pragma unroll
        for (int i = 0; i < 4; ++i) {
            const int c = i * 256 + lane * 4;
            const float4 gv = *(const float4*)(gw + c), bv = *(const float4*)(bw + c);
            const float o0 = (v[i * 4] - mu) * rstd * gv.x + bv.x, o1 = (v[i * 4 + 1] - mu) * rstd * gv.y + bv.y,
                        o2 = (v[i * 4 + 2] - mu) * rstd * gv.z + bv.z, o3 = (v[i * 4 + 3] - mu) * rstd * gv.w + bv.w;
            *(float4*)(out + (long)t * 1024 + c) = make_float4(o0, o1, o2, o3);
            if (outb) st4bf(outb + (long)t * 1024 + c, o0, o1, o2, o3);
            if (outl) st4bf(outl + (long)t * 1024 + c, o0 - bf2f(f2bf(o0)), o1 - bf2f(f2bf(o1)), o2 - bf2f(f2bf(o2)), o3 - bf2f(f2bf(o3)));
        }
    }
}
DI void job_router(const Params& p, const LayerW& w, int layer, int bid, int nblk) {
    const float* LOG = WSF(WS_LOG); int* EIDX = WSI(WS_EIDX); int* ESLOT = WSI(WS_ESLOT); float* EW = WSF(WS_EW);
    unsigned* cnt = WSU(WS_CTL) + CW_CNT + layer * 32;
    for (int t = bid * NT + tidx(); t < T; t += nblk * NT) {
        const float* lr = LOG + (long)t * 36;
        const float g0 = lr[0] + w.rg_b[0], g1 = lr[1] + w.rg_b[1], g2 = lr[2] + w.rg_b[2], g3 = lr[3] + w.rg_b[3];
        const float gm = fmaxf(fmaxf(g0, g1), fmaxf(g2, g3));
        const float e0 = expf(g0 - gm), e1 = expf(g1 - gm), e2 = expf(g2 - gm), e3 = expf(g3 - gm);
        const float gs = (e0 + e1) + (e2 + e3);
        const float p0 = e0 / gs, p1 = e1 / gs, p2 = e2 / gs, p3 = e3 / gs;
        int grp = 0; float pg = p0;
        if (p1 > pg) { pg = p1; grp = 1; }
        if (p2 > pg) { pg = p2; grp = 2; }
        if (p3 > pg) { pg = p3; grp = 3; }
        float el[8];
#pragma unroll
        for (int i = 0; i < 8; ++i) el[i] = lr[4 + grp * 8 + i] + w.re_b[grp * 8 + i];
        float em = el[0];
#pragma unroll
        for (int i = 1; i < 8; ++i) em = fmaxf(em, el[i]);
        float es = 0.f;
#pragma unroll
        for (int i = 0; i < 8; ++i) { el[i] = expf(el[i] - em); es += el[i]; }
#pragma unroll
        for (int i = 0; i < 8; ++i) el[i] = el[i] / es;
        float b0 = el[0]; int i0 = 0;
#pragma unroll
        for (int i = 1; i < 8; ++i) if (el[i] > b0) { b0 = el[i]; i0 = i; }
        float b1 = -1.f; int i1 = 0;
#pragma unroll
        for (int i = 0; i < 8; ++i) if (i != i0 && el[i] > b1) { b1 = el[i]; i1 = i; }
        const float den = b0 + b1;
        const int ex0 = grp * 8 + i0, ex1 = grp * 8 + i1;
        EIDX[t * 2] = ex0; EIDX[t * 2 + 1] = ex1;
        EW[t * 2] = pg * b0 / den; EW[t * 2 + 1] = pg * b1 / den;
        ESLOT[t * 2] = (int)atomicAdd(&cnt[ex0], 1u);
        ESLOT[t * 2 + 1] = (int)atomicAdd(&cnt[ex1], 1u);
    }
}
DI int pad_rows(int c) { return (c + G_BM - 1) / G_BM * G_BM; }
DI void job_fill(const Params& p, int layer, int bid, int nblk) {
    const int* EIDX = WSI(WS_EIDX); const int* ESLOT = WSI(WS_ESLOT); int* PERM = WSI(WS_PERM);
    unsigned* cnt = WSU(WS_CTL) + CW_CNT + layer * 32;
    for (int a = bid * NT + tidx(); a < NASSIGN + NEXP * G_BM; a += nblk * NT) {
        const bool real = a < NASSIGN;
        const int e = real ? EIDX[a] : (a - NASSIGN) / G_BM;
        int off = 0;
        for (int j = 0; j < e; ++j) off += pad_rows((int)__hip_atomic_load(&cnt[j], __ATOMIC_RELAXED, __HIP_MEMORY_SCOPE_AGENT));
        if (real) PERM[off + ESLOT[a]] = a;
        else { const int c = (int)__hip_atomic_load(&cnt[e], __ATOMIC_RELAXED, __HIP_MEMORY_SCOPE_AGENT), j = (a - NASSIGN) % G_BM; if (c + j < pad_rows(c)) PERM[off + c + j] = -1; }
    }
}
struct RowPerm { const int* perm; DI long operator()(int r) const { const int a = perm[r]; return a >= 0 ? (a >> 1) : 0; } };
template <int STAGE>
DI void job_moe_gemm(const Params& p, const LayerW& w, int layer, const bf16_t* X2, int bid, int nblk, unsigned char* lds) {
    unsigned* cnt = WSU(WS_CTL) + CW_CNT + layer * 32;
    int* s_off = (int*)(lds + 2 * G_STAGE);
    int* s_uoff = s_off + 33;
    __syncthreads();
    if (tidx() == 0) {
        int ro = 0, uo = 0;
        for (int e = 0; e < 32; ++e) { const int c = pad_rows((int)__hip_atomic_load(&cnt[e], __ATOMIC_RELAXED, __HIP_MEMORY_SCOPE_AGENT)); s_off[e] = ro; s_uoff[e] = uo; ro += c; uo += (c / G_BM) * 8; }
        s_off[32] = ro; s_uoff[32] = uo;
    }
    __syncthreads();
    const int nunits = s_uoff[32];
    const int* PERM = WSI(WS_PERM);
    for (int u = bid; u < nunits; u += nblk) {
        int e = 0;
        while (e < 31 && u >= s_uoff[e + 1]) ++e;
        const int lu = u - s_uoff[e];
        const int ntile = lu & 7, mt = lu >> 3;
        const int r0 = s_off[e] + mt * G_BM, n0 = ntile * G_BN;
        f32x16 acc[2][2];
        if (STAGE == 0) {
            MG g; g.A = X2; g.lda = 1024; g.Wt = w.t_gu + (size_t)e * 1024 * 1024; g.ldw = 1024; g.K = 1024;
            mgemm_tile(g, n0, RowPerm{PERM + r0}, acc, lds);
            bf16_t* HH = WSB(WS_HH);
            const int l = tidx() & 63, wv = tidx() >> 6, wm = wv % G_WM, wn = wv / G_WM;
#pragma unroll
            for (int tt = 0; tt < 2; ++tt)
#pragma unroll
                for (int i = 0; i < 4; ++i) {
                    const int lrow = wm * 64 + tt * 32 + (l & 31), f = 64 * ntile + wn * 32 + 8 * i + 4 * (l >> 5);
                    float hv[4];
#pragma unroll
                    for (int j = 0; j < 4; ++j) { const float gt = acc[0][tt][4 * i + j], up = acc[1][tt][4 * i + j]; hv[j] = gt * sigm(gt) * up; }
                    st4bf(HH + (long)(r0 + lrow) * 512 + f, hv[0], hv[1], hv[2], hv[3]);
                }
        } else {
            MG g; g.A = WSB(WS_HH); g.lda = 512; g.Wt = w.t_dn + (size_t)e * 1024 * 512; g.ldw = 512; g.K = 512;
            mgemm_tile(g, n0, RowId{r0}, acc, lds);
            float* YK = WSF(WS_YK); const float* EW = WSF(WS_EW);
            MG_FOREACH(acc, lrow, feat, v, { const int a = PERM[r0 + lrow];
                if (a >= 0) { const float sw = EW[a]; *(float4*)(YK + (long)a * 1024 + n0 + feat) = make_float4(v[0] * sw, v[1] * sw, v[2] * sw, v[3] * sw); } });
        }
    }
}

typedef short s16x4 __attribute__((ext_vector_type(4)));
typedef short v4i16_t __attribute__((ext_vector_type(4)));
typedef float f32x2_t __attribute__((ext_vector_type(2)));
typedef __bf16 bf16x2_t __attribute__((ext_vector_type(2)));
DI unsigned cvtpk(float lo, float hi) { f32x2_t v = {lo, hi}; bf16x2_t b = __builtin_convertvector(v, bf16x2_t); return __builtin_bit_cast(unsigned, b); }
DI int crow(int reg, int h) { return (reg & 3) + 8 * (reg >> 2) + 4 * h; }
DI s16x4 tr_read(const unsigned char* p) { return __builtin_bit_cast(s16x4, __builtin_amdgcn_ds_read_tr16_b64_v4i16((LAS v4i16_t*)p)); }
DI float xhalf_max(float m) { auto rr = __builtin_amdgcn_permlane32_swap(__float_as_uint(m), __float_as_uint(m), false, false); return fmaxf(__uint_as_float(rr[0]), __uint_as_float(rr[1])); }
DI float xhalf_sum(float m) { auto rr = __builtin_amdgcn_permlane32_swap(__float_as_uint(m), __float_as_uint(m), false, false); return __uint_as_float(rr[0]) + __uint_as_float(rr[1]); }
DI float xhalf_other(float v, int h) { auto rr = __builtin_amdgcn_permlane32_swap(__float_as_uint(v), __float_as_uint(v), false, false); return __uint_as_float(h ? rr[0] : rr[1]); }
DI bf16x8 pack8(const f32x16& x, int s2) {
    u32x4 pk; pk[0] = cvtpk(x[8 * s2], x[8 * s2 + 1]); pk[1] = cvtpk(x[8 * s2 + 2], x[8 * s2 + 3]); pk[2] = cvtpk(x[8 * s2 + 4], x[8 * s2 + 5]); pk[3] = cvtpk(x[8 * s2 + 6], x[8 * s2 + 7]);
    return __builtin_bit_cast(bf16x8, pk);
}
constexpr int ATT_QB = (NT / 64) * 32;
template <int DC> struct TileCfg { static constexpr int RS = DC * 2 + 16, BYTES = 64 * RS, NCH = 64 * DC / 8, NI = (NCH + NT - 1) / NT; };
template <int DC, class RowPtr> DI void tile_gload(u32x4 (&rg)[TileCfg<DC>::NI], RowPtr rp) {
#pragma unroll
    for (int i = 0; i < TileCfg<DC>::NI; ++i) { const int c = tidx() + NT * i; if (c < TileCfg<DC>::NCH) { const int row = c / (DC / 8), cc = c % (DC / 8); rg[i] = *(const u32x4*)(rp(row) + cc * 8); } }
}
template <int DC> DI void tile_lstore(const u32x4 (&rg)[TileCfg<DC>::NI], unsigned char* base) {
#pragma unroll
    for (int i = 0; i < TileCfg<DC>::NI; ++i) { const int c = tidx() + NT * i; if (c < TileCfg<DC>::NCH) { const int row = c / (DC / 8), cc = c % (DC / 8); *(u32x4*)(base + row * TileCfg<DC>::RS + cc * 16) = rg[i]; } }
}
template <int DK> DI void qk_tile(f32x16 (&s)[2], const bf16x8 (&qf)[DK / 16], const unsigned char* kl, int r, int h) {
    constexpr int RS = TileCfg<DK>::RS;
#pragma unroll
    for (int i = 0; i < 16; ++i) { s[0][i] = 0.f; s[1][i] = 0.f; }
#pragma unroll
    for (int ks = 0; ks < DK / 16; ++ks) {
        const bf16x8 k0 = *(const bf16x8*)(kl + r * RS + ks * 32 + h * 16), k1 = *(const bf16x8*)(kl + (32 + r) * RS + ks * 32 + h * 16);
        s[0] = __builtin_amdgcn_mfma_f32_32x32x16_bf16(k0, qf[ks], s[0], 0, 0, 0);
        s[1] = __builtin_amdgcn_mfma_f32_32x32x16_bf16(k1, qf[ks], s[1], 0, 0, 0);
    }
}
template <int DV> DI void pv_tile(f32x16 (&o)[DV / 32], const f32x16 (&pp)[2], const unsigned char* vl, int lane) {
    constexpr int RS = TileCfg<DV>::RS;
    const int h = lane >> 5, i16 = lane & 15, q = i16 >> 2, pq = i16 & 3, blk = (lane >> 4) & 1;
    const unsigned char* vb = vl + (4 * h + q) * RS + 2 * (16 * blk + 4 * pq);
#pragma unroll
    for (int kt = 0; kt < 2; ++kt)
#pragma unroll
        for (int s2 = 0; s2 < 2; ++s2) {
            const bf16x8 pf = pack8(pp[kt], s2);
#pragma unroll
            for (int dvt = 0; dvt < DV / 32; ++dvt) {
                const s16x4 lo = tr_read(vb + (kt * 32 + 16 * s2) * RS + dvt * 64), hi = tr_read(vb + (kt * 32 + 16 * s2 + 8) * RS + dvt * 64);
                const bf16x8 vf = __builtin_shufflevector(lo, hi, 0, 1, 2, 3, 4, 5, 6, 7);
                o[dvt] = __builtin_amdgcn_mfma_f32_32x32x16_bf16(vf, pf, o[dvt], 0, 0, 0);
            }
        }
}
template <int DK, int DV, class MaskFn>
DI void softmax_tile(const bf16x8 (&qf)[DK / 16], f32x16 (&o)[DV / 32], float& m, float& l, const unsigned char* kl, const unsigned char* vl, int kb, MaskFn mf, int lane) {
    const int r = lane & 31, h = lane >> 5;
    f32x16 s[2];
    qk_tile<DK>(s, qf, kl, r, h);
    float tmax = -INFINITY;
#pragma unroll
    for (int kt = 0; kt < 2; ++kt)
#pragma unroll
        for (int i = 0; i < 16; ++i) { const float v = mf(kb + kt * 32 + crow(i, h), s[kt][i]); s[kt][i] = v; tmax = fmaxf(tmax, v); }
    tmax = xhalf_max(tmax);
    const float mn = fmaxf(m, tmax), corr = __expf(m - mn);
    m = mn;
    float ps = 0.f;
#pragma unroll
    for (int kt = 0; kt < 2; ++kt)
#pragma unroll
        for (int i = 0; i < 16; ++i) { const float pr = __expf(s[kt][i] - mn); s[kt][i] = pr; ps += pr; }
    l = l * corr + ps;
#pragma unroll
    for (int dvt = 0; dvt < DV / 32; ++dvt)
#pragma unroll
        for (int i = 0; i < 16; ++i) o[dvt][i] *= corr;
    pv_tile<DV>(o, s, vl, lane);
}
template <int DK, int DV, int NHQ, class KPtr, class VPtr, class MaskFn>
DI void attn_stream(const bf16x8 (&qf)[NHQ][DK / 16], f32x16 (&o)[NHQ][DV / 32], float (&m)[NHQ], float (&l)[NHQ], unsigned tmask, int wave_qmax, int wave_kmin,
                    KPtr kp, VPtr vp, MaskFn mf, unsigned char* lds) {
    unsigned char* kl = lds; unsigned char* vl = lds + TileCfg<DK>::BYTES;
    const int lane = tidx() & 63;
    u32x4 kr[TileCfg<DK>::NI], vr[TileCfg<DV>::NI];
    if (tmask) { const int j = __builtin_ctz(tmask); tile_gload<DK>(kr, [&](int row) { return kp(j * 64 + row); }); tile_gload<DV>(vr, [&](int row) { return vp(j * 64 + row); }); }
    while (tmask) {
        const int j = __builtin_ctz(tmask); tmask &= tmask - 1;
        __syncthreads();
        tile_lstore<DK>(kr, kl); tile_lstore<DV>(vr, vl);
        __syncthreads();
        if (tmask) { const int jn = __builtin_ctz(tmask); tile_gload<DK>(kr, [&](int row) { return kp(jn * 64 + row); }); tile_gload<DV>(vr, [&](int row) { return vp(jn * 64 + row); }); }
        if (j * 64 <= wave_qmax && j * 64 + 63 >= wave_kmin) {
#pragma unroll
            for (int hq = 0; hq < NHQ; ++hq) softmax_tile<DK, DV>(qf[hq], o[hq], m[hq], l[hq], kl, vl, j * 64, [&](int key, float sc) { return mf(hq, key, sc); }, lane);
        }
    }
}

DI void job_mla_attn(const Params& p, int bid, int nblk, unsigned char* lds) {
    const bf16_t* QB = WSB(WS_QB); const bf16_t* KM = WSB(WS_KM); const bf16_t* VM = WSB(WS_VM); bf16_t* BR = WSB(WS_BR);
    constexpr int NQB = SEQ / ATT_QB, NU = BATCH * 4 * NQB;
    const int lane = tidx() & 63, wid = tidx() >> 6, r = lane & 31, h = lane >> 5;
    for (int u = bid; u < NU; u += nblk) {
        const int half = u / (NU / 2), ru = u % (NU / 2);
        const int qi = ru / (BATCH * 4), bh = ru % (BATCH * 4);
        const int qblk = half == 0 ? (NQB - 1 - qi) : qi;
        const int b = bh >> 2, hd = bh & 3;
        const int q0 = qblk * ATT_QB, qw = q0 + wid * 32, qpos = qw + r;
        const long trow = (long)b * SEQ;
        bf16x8 qf[1][6];
#pragma unroll
        for (int ks = 0; ks < 6; ++ks) qf[0][ks] = *(const bf16x8*)(QB + (trow + qpos) * 384 + hd * 96 + ks * 16 + 8 * h);
        f32x16 o[1][2];
#pragma unroll
        for (int i = 0; i < 16; ++i) { o[0][0][i] = 0.f; o[0][1][i] = 0.f; }
        float m[1] = {-1e30f}, l[1] = {0.f};
        const int ntile = (q0 + ATT_QB - 1) / 64 + 1;
        const unsigned tmask = ntile >= 32 ? 0xffffffffu : ((1u << ntile) - 1u);
        attn_stream<96, 64, 1>(qf, o, m, l, tmask, qw + 31, 0,
            [&](int row) { return KM + (trow + row) * 384 + hd * 96; },
            [&](int row) { return VM + (trow + row) * 256 + hd * 64; },
            [&](int, int key, float sc) { return key <= qpos ? sc * 0.10206207261596577f : -INFINITY; }, lds);
        const float rl = 1.f / fmaxf(xhalf_sum(l[0]), 1e-30f);
        bf16_t* dst = BR + (trow + qpos) * 1024 + 3 * 256 + hd * 64;
#pragma unroll
        for (int dvt = 0; dvt < 2; ++dvt)
#pragma unroll
            for (int i = 0; i < 4; ++i)
                st4bf(dst + dvt * 32 + 8 * i + 4 * h, o[0][dvt][4 * i] * rl, o[0][dvt][4 * i + 1] * rl, o[0][dvt][4 * i + 2] * rl, o[0][dvt][4 * i + 3] * rl);
    }
}
DI void job_cross_attn(const Params& p, int layer, int bid, int nblk, unsigned char* lds) {
    const bf16_t* XQ = WSB(WS_XQ); const bf16_t* KVM = WSB(WS_KVM) + (size_t)layer * 2048 * 1024; bf16_t* XO = WSB(WS_XO);
    constexpr int NQB = SEQ / ATT_QB, NU = BATCH * 4 * NQB;
    const int lane = tidx() & 63, wid = tidx() >> 6, r = lane & 31, h = lane >> 5;
    for (int u = bid; u < NU; u += nblk) {
        const int bh = u % (BATCH * 4), qblk = u / (BATCH * 4);
        const int b = bh >> 2, hd = bh & 3;
        const int qpos = qblk * ATT_QB + wid * 32 + r;
        const long trow = (long)b * SEQ;
        bf16x8 qf[1][8];
#pragma unroll
        for (int ks = 0; ks < 8; ++ks) qf[0][ks] = *(const bf16x8*)(XQ + (trow + qpos) * 512 + hd * 128 + ks * 16 + 8 * h);
        f32x16 o[1][4];
#pragma unroll
        for (int d = 0; d < 4; ++d)
#pragma unroll
            for (int i = 0; i < 16; ++i) o[0][d][i] = 0.f;
        float m[1] = {-1e30f}, l[1] = {0.f};
        attn_stream<128, 128, 1>(qf, o, m, l, 0xFu, 1 << 30, 0,
            [&](int row) { return KVM + (long)(b * MEM_LEN + row) * 1024 + hd * 128; },
            [&](int row) { return KVM + (long)(b * MEM_LEN + row) * 1024 + 512 + hd * 128; },
            [&](int, int, float sc) { return sc * 0.08838834764831845f; }, lds);
        const float rl = 1.f / fmaxf(xhalf_sum(l[0]), 1e-30f);
        bf16_t* dst = XO + (trow + qpos) * 512 + hd * 128;
#pragma unroll
        for (int dvt = 0; dvt < 4; ++dvt)
#pragma unroll
            for (int i = 0; i < 4; ++i)
                st4bf(dst + dvt * 32 + 8 * i + 4 * h, o[0][dvt][4 * i] * rl, o[0][dvt][4 * i + 1] * rl, o[0][dvt][4 * i + 2] * rl, o[0][dvt][4 * i + 3] * rl);
    }
}
DI float logsig_fast(float z) { return fminf(z, 0.f) - __logf(1.f + __expf(-fabsf(z))); }
DI void job_sb_attn(const Params& p, int bid, int nblk, unsigned char* lds) {
    const bf16_t* H = WSB(WS_H); bf16_t* BR = WSB(WS_BR);
    constexpr int NQB = SEQ / ATT_QB, NU = BATCH * 4 * NQB;
    const int lane = tidx() & 63, wid = tidx() >> 6, r = lane & 31, h = lane >> 5;
    unsigned char* kl = lds; unsigned char* vl = lds + TileCfg<64>::BYTES;
    for (int u = bid; u < NU; u += nblk) {
        const int half = u / (NU / 2), ru = u % (NU / 2);
        const int qi = ru / (BATCH * 4), bh = ru % (BATCH * 4);
        const int qblk = half == 0 ? (NQB - 1 - qi) : qi;
        const int b = bh >> 2, hd = bh & 3;
        const int q0 = qblk * ATT_QB, qw = q0 + wid * 32, qpos = qw + r;
        const long trow = (long)b * SEQ;
        bf16x8 qf[4];
#pragma unroll
        for (int ks = 0; ks < 4; ++ks) qf[ks] = *(const bf16x8*)(H + (trow + qpos) * NH + O_BQ + hd * 64 + ks * 16 + 8 * h);
        f32x16 o[2];
#pragma unroll
        for (int i = 0; i < 16; ++i) { o[0][i] = 0.f; o[1][i] = 0.f; }
        float trun = 0.f;
        int j = (q0 + ATT_QB - 1) >> 6;
        u32x4 kr[TileCfg<64>::NI], vr[TileCfg<64>::NI];
        tile_gload<64>(kr, [&](int row) { return H + (trow + j * 64 + row) * NH + O_BK + hd * 64; });
        tile_gload<64>(vr, [&](int row) { return H + (trow + j * 64 + row) * NH + O_BV + hd * 64; });
        for (; j >= 0; --j) {
            __syncthreads();
            tile_lstore<64>(kr, kl); tile_lstore<64>(vr, vl);
            __syncthreads();
            if (j > 0) { const int jn = j - 1;
                tile_gload<64>(kr, [&](int row) { return H + (trow + jn * 64 + row) * NH + O_BK + hd * 64; });
                tile_gload<64>(vr, [&](int row) { return H + (trow + jn * 64 + row) * NH + O_BV + hd * 64; }); }
            if (j * 64 < qw + 31) {
                const int kb = j * 64;
                f32x16 s[2], L[2];
                qk_tile<64>(s, qf, kl, r, h);
#pragma unroll
                for (int kt = 0; kt < 2; ++kt)
#pragma unroll
                    for (int i = 0; i < 16; ++i) {
                        const int key = kb + kt * 32 + crow(i, h);
                        const float z = s[kt][i] * 0.125f, lsp = logsig_fast(z);
                        const bool valid = key < qpos;
                        L[kt][i] = valid ? lsp - z : 0.f;
                        s[kt][i] = valid ? lsp : -INFINITY;
                    }
                float G[2][4], O[2][4];
#pragma unroll
                for (int kt = 0; kt < 2; ++kt)
#pragma unroll
                    for (int ig = 0; ig < 4; ++ig) { G[kt][ig] = (L[kt][4 * ig] + L[kt][4 * ig + 1]) + (L[kt][4 * ig + 2] + L[kt][4 * ig + 3]); O[kt][ig] = xhalf_other(G[kt][ig], h); }
                float run = trun;
#pragma unroll
                for (int kt = 1; kt >= 0; --kt)
#pragma unroll
                    for (int ig = 3; ig >= 0; --ig) {
                        const float t3 = run + (h == 0 ? O[kt][ig] : 0.f);
                        const float t2 = t3 + L[kt][4 * ig + 3], t1 = t2 + L[kt][4 * ig + 2], t0 = t1 + L[kt][4 * ig + 1];
                        s[kt][4 * ig + 3] = __expf(s[kt][4 * ig + 3] + t3); s[kt][4 * ig + 2] = __expf(s[kt][4 * ig + 2] + t2);
                        s[kt][4 * ig + 1] = __expf(s[kt][4 * ig + 1] + t1); s[kt][4 * ig + 0] = __expf(s[kt][4 * ig + 0] + t0);
                        run += G[kt][ig] + O[kt][ig];
                    }
                trun = run;
                pv_tile<64>(o, s, vl, lane);
            }
        }
        bf16_t* dst = BR + (trow + qpos) * 1024 + 1 * 256 + hd * 64;
#pragma unroll
        for (int dvt = 0; dvt < 2; ++dvt)
#pragma unroll
            for (int i = 0; i < 4; ++i) st4bf(dst + dvt * 32 + 8 * i + 4 * h, o[dvt][4 * i], o[dvt][4 * i + 1], o[dvt][4 * i + 2], o[dvt][4 * i + 3]);
    }
}
constexpr int NSA_QB = (NT / 128) * 32;
DI void job_nsa(const Params& p, int bid, int nblk, unsigned char* lds) {
    const bf16_t* H = WSB(WS_H); const bf16_t* KCB = WSB(WS_KCB); const bf16_t* VCB = KCB + (size_t)NCR * 64;
    float* OACC = WSF(WS_OC); bf16_t* BR = WSB(WS_BR);
    constexpr int NQB = SEQ / NSA_QB, NU = BATCH * 2 * NQB;
    constexpr int TB_ = TileCfg<64>::BYTES;
    const int lane = tidx() & 63, wid = tidx() >> 6, r = lane & 31, h = lane >> 5;
    const int n = wid & 1, sub = wid >> 1;
    unsigned* orw = (unsigned*)(lds + 4 * TB_);
    float* impx = (float*)(lds + 4 * TB_ + 64);
    for (int u = bid; u < NU; u += nblk) {
        const int qblk = NQB - 1 - u / (BATCH * 2), bg = u % (BATCH * 2), b = bg >> 1, g = bg & 1;
        const int q0 = qblk * NSA_QB, qw = q0 + sub * 32, qpos = qw + r;
        const int head = g * 2 + n;
        const long trow = (long)b * SEQ;
        const bf16_t* hq_row = H + (trow + qpos) * NH;
        bf16x8 qf[1][4];
#pragma unroll
        for (int ks = 0; ks < 4; ++ks) qf[0][ks] = *(const bf16x8*)(hq_row + O_AQ + head * 64 + ks * 16 + 8 * h);
        const float sl = exp2f(-2.f * (float)(head + 1));
        const float gate0 = sigm(bf2f(hq_row[O_AG + head * 3 + 0])), gate1 = sigm(bf2f(hq_row[O_AG + head * 3 + 1])), gate2 = sigm(bf2f(hq_row[O_AG + head * 3 + 2]));
        float* oacc = OACC + (trow + qpos) * 256 + head * 64;
        __syncthreads();
        if (tidx() == 0) *orw = 0u;
        {
            u32x4 rg[TileCfg<64>::NI];
#pragma unroll
            for (int tl = 0; tl < 4; ++tl) {
                const bf16_t* src = (tl & 2) ? VCB : KCB; const int cb = (tl & 1) * 64;
                tile_gload<64>(rg, [&](int row) { const int c = cb + row < NCMP ? cb + row : NCMP - 1; return src + ((long)(b * NCMP + c) * 2 + g) * 64; });
                tile_lstore<64>(rg, lds + tl * TB_);
            }
        }
        __syncthreads();
        float imp[16];
        {
            f32x16 s[2][2];
            qk_tile<64>(s[0], qf[0], lds, r, h);
            qk_tile<64>(s[1], qf[0], lds + TB_, r, h);
            float tmax = -INFINITY;
#pragma unroll
            for (int tl = 0; tl < 2; ++tl)
#pragma unroll
                for (int kt = 0; kt < 2; ++kt)
#pragma unroll
                    for (int i = 0; i < 16; ++i) {
                        const int c = tl * 64 + kt * 32 + crow(i, h), dist = qpos - (16 * c + 31);
                        const float v = (c < NCMP && dist >= 0) ? s[tl][kt][i] * 0.125f - sl * (float)dist : -INFINITY;
                        s[tl][kt][i] = v; tmax = fmaxf(tmax, v);
                    }
            const float mn = fmaxf(xhalf_max(tmax), -1e30f);
            float ps = 0.f;
#pragma unroll
            for (int tl = 0; tl < 2; ++tl)
#pragma unroll
                for (int kt = 0; kt < 2; ++kt)
#pragma unroll
                    for (int i = 0; i < 16; ++i) { const float pr = __expf(s[tl][kt][i] - mn); s[tl][kt][i] = pr; ps += pr; }
            const float rl = 1.f / fmaxf(xhalf_sum(ps), 1e-30f);
            float P3[16];
#pragma unroll
            for (int tl = 0; tl < 2; ++tl)
#pragma unroll
                for (int kt = 0; kt < 2; ++kt) {
#pragma unroll
                    for (int ig = 0; ig < 4; ++ig) {
                        const float p0 = s[tl][kt][4 * ig] * rl, p1 = s[tl][kt][4 * ig + 1] * rl, p2 = s[tl][kt][4 * ig + 2] * rl, p3 = s[tl][kt][4 * ig + 3] * rl;
                        imp[tl * 8 + kt * 4 + ig] = (p0 + p1) + (p2 + 0.5f * p3);
                        P3[tl * 8 + kt * 4 + ig] = 0.5f * p3;
                    }
                    const float gs = rl * gate0;
#pragma unroll
                    for (int i = 0; i < 16; ++i) s[tl][kt][i] *= gs;
                }
#pragma unroll
            for (int idx = 0; idx < 16; ++idx) {
                const float pp = xhalf_other(P3[idx], h);
                float prevp;
                if (idx == 0) prevp = h ? pp : 0.f; else { const float ppm = xhalf_other(P3[idx - 1], h); prevp = h ? pp : ppm; }
                imp[idx] += prevp;
                impx[(wid * 16 + idx) * 64 + lane] = imp[idx];
            }
            f32x16 oc[2];
#pragma unroll
            for (int i = 0; i < 16; ++i) { oc[0][i] = 0.f; oc[1][i] = 0.f; }
            pv_tile<64>(oc, s[0], lds + 2 * TB_, lane);
            pv_tile<64>(oc, s[1], lds + 3 * TB_, lane);
#pragma unroll
            for (int dvt = 0; dvt < 2; ++dvt)
#pragma unroll
                for (int i = 0; i < 4; ++i) *(float4*)(oacc + dvt * 32 + 8 * i + 4 * h) = make_float4(oc[dvt][4 * i], oc[dvt][4 * i + 1], oc[dvt][4 * i + 2], oc[dvt][4 * i + 3]);
        }
        __syncthreads();
        unsigned sel = 0u;
        {
            const int cur = qpos >> 6;
#pragma unroll
            for (int idx = 0; idx < 16; ++idx) {
                const float other = impx[((wid ^ 1) * 16 + idx) * 64 + lane];
                const float tot = n == 0 ? imp[idx] + other : other + imp[idx];
                const int j = 2 * idx + h;
                const bool forced = (j == 0) || (j == cur), valid = (j * 64 <= qpos);
                imp[idx] = forced ? 1e4f : (valid ? tot : -1.0f);
            }
#pragma unroll 1
            for (int it = 0; it < 8; ++it) {
                float best = -INFINITY; int bj = 64;
#pragma unroll
                for (int idx = 0; idx < 16; ++idx) if (imp[idx] > best) { best = imp[idx]; bj = 2 * idx + h; }
                const float pb = xhalf_other(best, h); const int pj = __float_as_int(xhalf_other(__int_as_float(bj), h));
                const bool own = (best > pb) || (best == pb && bj < pj);
                const int wj = own ? bj : pj;
                sel |= 1u << wj;
#pragma unroll
                for (int idx = 0; idx < 16; ++idx) if (2 * idx + h == wj) imp[idx] = -INFINITY;
            }
        }
        atomicOr(orw, sel);
        __syncthreads();
        const unsigned bmask = *orw;
        const int jhi = (q0 + NSA_QB - 1) >> 6;
        const unsigned upto = jhi >= 31 ? 0xffffffffu : ((1u << (jhi + 1)) - 1u);
        {
            f32x16 o[1][2];
#pragma unroll
            for (int i = 0; i < 16; ++i) { o[0][0][i] = 0.f; o[0][1][i] = 0.f; }
            float m[1] = {-1e30f}, l[1] = {0.f};
            const int jlo = (q0 - 511 > 0 ? q0 - 511 : 0) >> 6;
            const unsigned tmask = upto & ~((1u << jlo) - 1u);
            attn_stream<64, 64, 1>(qf, o, m, l, tmask, qw + 31, qw - 511,
                [&](int row) { return H + (trow + row) * NH + O_AKW + g * 64; },
                [&](int row) { return H + (trow + row) * NH + O_AVW + g * 64; },
                [&](int, int key, float sc) { const int dist = qpos - key; return (dist >= 0 && dist < 512) ? sc * 0.125f - sl * (float)dist : -INFINITY; }, lds);
            const float rl = gate2 / fmaxf(xhalf_sum(l[0]), 1e-30f);
#pragma unroll
            for (int dvt = 0; dvt < 2; ++dvt)
#pragma unroll
                for (int i = 0; i < 4; ++i) { float4* a = (float4*)(oacc + dvt * 32 + 8 * i + 4 * h); float4 c = *a;
                    c.x += o[0][dvt][4 * i] * rl; c.y += o[0][dvt][4 * i + 1] * rl; c.z += o[0][dvt][4 * i + 2] * rl; c.w += o[0][dvt][4 * i + 3] * rl; *a = c; }
        }
        {
            f32x16 o[1][2];
#pragma unroll
            for (int i = 0; i < 16; ++i) { o[0][0][i] = 0.f; o[0][1][i] = 0.f; }
            float m[1] = {-1e30f}, l[1] = {0.f};
            attn_stream<64, 64, 1>(qf, o, m, l, bmask & upto, qw + 31, 0,
                [&](int row) { return H + (trow + row) * NH + O_AKS + g * 64; },
                [&](int row) { return H + (trow + row) * NH + O_AVS + g * 64; },
                [&](int, int key, float sc) { const int dist = qpos - key; return (dist >= 0 && ((sel >> (key >> 6)) & 1u)) ? sc * 0.125f - sl * (float)dist : -INFINITY; }, lds);
            const float rl = gate1 / fmaxf(xhalf_sum(l[0]), 1e-30f);
            bf16_t* dst = BR + (trow + qpos) * 1024 + head * 64;
#pragma unroll
            for (int dvt = 0; dvt < 2; ++dvt)
#pragma unroll
                for (int i = 0; i < 4; ++i) { const float4 c = *(const float4*)(oacc + dvt * 32 + 8 * i + 4 * h);
                    st4bf(dst + dvt * 32 + 8 * i + 4 * h, c.x + o[0][dvt][4 * i] * rl, c.y + o[0][dvt][4 * i + 1] * rl, c.z + o[0][dvt][4 * i + 2] * rl, c.w + o[0][dvt][4 * i + 3] * rl); }
        }
    }
}
constexpr int NPH = 18;
constexpr int NPHASES = 2 + DEPTH * NPH;

__global__ void __launch_bounds__(NT, 2) mega(Params pk, int ph_lo, int ph_hi) {
    extern __shared__ __attribute__((aligned(16))) unsigned char lds[];
    __shared__ uint4 xb_words;
    const int bid = blockIdx.x, nblk = gridDim.x;
    XcdBarrier bar;
    const bool multi = (ph_hi - ph_lo) > 1;
    if (multi) {
        if (tidx() == 0) xb_words = make_uint4(0u, 0u, 0u, 0u);
        __syncthreads();
        bar = xcd_barrier_post((unsigned*)(pk.ws + WS_CTL) + CW_BAR, (volatile LAS unsigned*)&xb_words);
    }
#define PHASE(id, ...) do { const int _id = (id); if (ph_lo <= _id && _id < ph_hi) { { Params p = pk; int layer = layer_; asm volatile("" : "+s"(p.ws), "+s"(p.out), "+s"(layer)); \
        const LayerW w = layer_w(p, layer); const float* Xin = (layer == 0) ? p.in[0] : WSF(WS_XC); const bf16_t* XinB = (layer == 0) ? WSB(WS_X0B) : WSB(WS_XCB); float* Xout = (layer == DEPTH - 1) ? p.out : WSF(WS_XC); \
        (void)w; (void)Xin; (void)XinB; (void)Xout; __VA_ARGS__; } if (_id + 1 < ph_hi) xcd_barrier(bar); } } while (0)

    { const int layer_ = 0;
    PHASE(0, {
        job_wt<2>(p.in[2], DEPTH, 1024, NIN, WSB(WT_IN), NH, bid, nblk, lds);
        job_wt<0>(p.in[17], DEPTH * 4, 256, 1024, WSB(WT_BR), 1024, bid, nblk, lds);
        job_wt<0>(p.in[18], DEPTH, 1024, 1024, WSB(WT_OUT), 1024, bid, nblk, lds);
        job_wt<0>(p.in[21], DEPTH, 1024, 512, WSB(WT_Q), 512, bid, nblk, lds);
        job_wt<0>(p.in[22], DEPTH, 1024, 1024, WSB(WT_KV), 1024, bid, nblk, lds);
        job_wt<0>(p.in[23], DEPTH, 512, 1024, WSB(WT_O), 1024, bid, nblk, lds);
        job_wt<1>(p.in[30], DEPTH * 32, 1024, 1024, WSB(WT_GU), 1024, bid, nblk, lds);
        job_wt<0>(p.in[31], DEPTH * 32, 512, 1024, WSB(WT_DN), 1024, bid, nblk, lds);
        job_wt<0>(p.in[4], DEPTH * 2, 2048, 256, WSB(WT_C1), 256, bid, nblk, lds);
        job_wt<0>(p.in[5], DEPTH * 2, 256, 64, WSB(WT_C2), 128, bid, nblk, lds);
        job_wt<0>(p.in[15], DEPTH, 192, 384, WSB(WT_UQ), 384, bid, nblk, lds);
        job_wt<0>(p.in[16], DEPTH, 128, 512, WSB(WT_UKV), 512, bid, nblk, lds);
        job_pack_small(p, bid, nblk);
        job_cvt(p.in[0], WSB(WS_X0B), (long)T * 1024, bid, nblk);
        job_cvt(p.in[1], WSB(WS_MEMB), (long)2048 * 1024, bid, nblk);
    });
    PHASE(1, {
        for (int l = 0; l < DEPTH; ++l) {
            MG g; g.A = WSB(WS_MEMB); g.lda = 1024; g.Wt = WSB(WT_KV) + (size_t)l * 1024 * 1024; g.ldw = 1024; g.K = 1024;
            mgemm_job<0>(g, BATCH * MEM_LEN, 1024, WSB(WS_KVM) + (size_t)l * 2048 * 1024, 1024, bid, nblk, lds);
        }
    });
    }
    for (int layer_ = 0; layer_ < DEPTH; ++layer_) {
        const int base = 2 + layer_ * NPH;
        PHASE(base + 0, { MG g; g.A = XinB; g.lda = 1024; g.Wt = w.t_in; g.ldw = 1024; g.K = 1024; mgemm_job<2>(g, T, NH, WSB(WS_H), NH, bid, nblk, lds); });
        PHASE(base + 1, { job_sb_attn(p, bid, nblk, lds); job_cmp_gather(p, w, bid, nblk); job_rnn_conv(p, w, bid, nblk); job_mla_norm(p, w, bid, nblk); });
        PHASE(base + 2, { job_cmp_mlp<0>(p, w, bid, nblk, lds); job_rnn_gates(p, w, bid, nblk, lds); job_mla_up(p, w, bid, nblk, lds); });
        PHASE(base + 3, { job_cmp_mlp<1>(p, w, bid, nblk, lds); job_rnn_scan1(p, bid, nblk); });
        PHASE(base + 4, { job_nsa(p, bid, nblk, lds); job_mla_attn(p, bid, nblk, lds); job_rnn_scan2(p, bid, nblk); });
        PHASE(base + 5, { job_merge(p, w, bid, nblk, lds); });
        PHASE(base + 6, { MG g; g.A = WSB(WS_M); g.lda = 1024; g.Wt = w.t_out; g.ldw = 1024; g.K = 1024; mgemm_job<1>(g, T, 1024, WSF(WS_Y), 1024, bid, nblk, lds); });
        PHASE(base + 7, { job_ln(Xin, WSF(WS_Y), 1024, nullptr, w.ln1_g, w.ln1_b, WSF(WS_XA), WSB(WS_XAB), nullptr, bid, nblk); });
        PHASE(base + 8, { MG g; g.A = WSB(WS_XAB); g.lda = 1024; g.Wt = w.t_q; g.ldw = 1024; g.K = 1024; mgemm_job<0>(g, T, 512, WSB(WS_XQ), 512, bid, nblk, lds); });
        PHASE(base + 9, { job_cross_attn(p, layer, bid, nblk, lds); });
        PHASE(base + 10, { MG g; g.A = WSB(WS_XO); g.lda = 512; g.Wt = w.t_o; g.ldw = 512; g.K = 512; mgemm_job<1>(g, T, 1024, WSF(WS_Y), 1024, bid, nblk, lds); });
        PHASE(base + 11, { job_ln(WSF(WS_XA), WSF(WS_Y), 1024, nullptr, w.ln2_g, w.ln2_b, WSF(WS_XB), WSB(WS_XBB), WSB(WS_XBL), bid, nblk); });
        PHASE(base + 12, { job_router_logits(p, w, bid, nblk, lds); });
        PHASE(base + 13, { job_router(p, w, layer, bid, nblk); });
        PHASE(base + 14, { job_fill(p, layer, bid, nblk); });
        PHASE(base + 15, { job_moe_gemm<0>(p, w, layer, WSB(WS_XBB), bid, nblk, lds); });
        PHASE(base + 16, { job_moe_gemm<1>(p, w, layer, WSB(WS_XBB), bid, nblk, lds); });
        PHASE(base + 17, { job_ln(WSF(WS_XB), WSF(WS_YK), 2048, WSF(WS_YK) + 1024, w.ln3_g, w.ln3_b, Xout, (layer == DEPTH - 1) ? nullptr : WSB(WS_XCB), nullptr, bid, nblk); });
    }
}

extern "C" void kernel_launch(void* const* d_in, const int* in_sizes, int n_in, void* d_out, int out_size, void* d_ws, size_t ws_size, hipStream_t stream) {
    constexpr size_t kDynLds = 2 * G_STAGE + 1024;
    static int grid = 0;
    if (!grid) {
        int dev = 0, cus = 0, per_cu = 0;
        (void)hipGetDevice(&dev);
        (void)hipDeviceGetAttribute(&cus, hipDeviceAttributeMultiprocessorCount, dev);
        (void)hipFuncSetAttribute((const void*)mega, hipFuncAttributeMaxDynamicSharedMemorySize, (int)kDynLds);
        (void)hipOccupancyMaxActiveBlocksPerMultiprocessor(&per_cu, mega, NT, kDynLds);
        if (per_cu < 1) per_cu = 1;
        grid = cus * (per_cu < 2 ? per_cu : 2);
    }
    if (ws_size < WS_END) { fprintf(stderr, "workspace too small: %zu < %zu\n", ws_size, (size_t)WS_END); return; }
    Params p{};
    for (int i = 0; i < 34; ++i) p.in[i] = (const float*)d_in[i];
    p.out = (float*)d_out;
    p.ws = (unsigned char*)d_ws;
    (void)hipMemsetAsync(d_ws, 0, CTL_BYTES, stream);
#if MK_ONE_LAUNCH
    hipLaunchKernelGGL(mega, dim3(grid), dim3(NT), kDynLds, stream, p, 0, NPHASES);
#else
    for (int ph = 0; ph < NPHASES; ++ph) hipLaunchKernelGGL(mega, dim3(grid), dim3(NT), kDynLds, stream, p, ph, ph + 1);
#endif
}
```

```cpp
#include <hip/hip_runtime.h>
#include <stdint.h>
#include <stdio.h>

#ifndef MK_ONE_LAUNCH
#define MK_ONE_LAUNCH 1
#endif

#define DI __device__ __forceinline__
#define LAS __attribute__((address_space(3)))
DI int tidx() { int t = threadIdx.x; asm volatile("" : "+v"(t)); return t; }

constexpr int NT = 512;
constexpr int D = 1024, BATCH = 8, SEQ = 2048, T = BATCH * SEQ, DEPTH = 4;
constexpr int MEM_LEN = 256;
constexpr int NIN = 6764, NH = 6912;
constexpr int O_AQ = 0, O_AKC = 256, O_AVC = 384, O_AKS = 512, O_AVS = 640, O_AKW = 768, O_AVW = 896,
              O_BQ = 1024, O_BK = 1280, O_BV = 1536, O_CX = 1792, O_CG = 2048, O_DCQ = 2304, O_DCKV = 2496, O_DKR = 2624,
              O_AG = 2656, O_MG = 2688;
constexpr int NCMP = 127, NCR = BATCH * NCMP * 2;
constexpr int NEXP = 32, NASSIGN = T * 2;
constexpr float DN_ALPHA = 1.681792830507429f;

typedef unsigned short bf16_t;
typedef short bf16x8 __attribute__((ext_vector_type(8)));
typedef float f32x16 __attribute__((ext_vector_type(16)));
typedef unsigned u32x4 __attribute__((ext_vector_type(4)));

constexpr int G_WM = NT / 128;
constexpr int G_BM = 64 * G_WM;
constexpr int G_BN = 128;
constexpr int G_RS = 144;
constexpr int G_STAGE = (G_BM + G_BN) * G_RS;
constexpr int PADROWS = ((NASSIGN + NEXP * (G_BM - 1) + G_BM - 1) / G_BM) * G_BM;

constexpr size_t MiB = 1u << 20;
constexpr size_t al(size_t x) { return (x + 255) & ~(size_t)255; }
constexpr size_t WS_CTL = 0, CTL_BYTES = 1 * MiB;
constexpr size_t WT_IN = WS_CTL + CTL_BYTES;
constexpr size_t WT_BR = WT_IN + al((size_t)DEPTH * NH * 1024 * 2);
constexpr size_t WT_OUT = WT_BR + al((size_t)DEPTH * 4 * 1024 * 256 * 2);
constexpr size_t WT_Q = WT_OUT + al((size_t)DEPTH * 1024 * 1024 * 2);
constexpr size_t WT_KV = WT_Q + al((size_t)DEPTH * 512 * 1024 * 2);
constexpr size_t WT_O = WT_KV + al((size_t)DEPTH * 1024 * 1024 * 2);
constexpr size_t WT_GU = WT_O + al((size_t)DEPTH * 1024 * 512 * 2);
constexpr size_t WT_DN = WT_GU + al((size_t)DEPTH * 32 * 1024 * 1024 * 2);
constexpr size_t WS_X0B = WT_DN + al((size_t)DEPTH * 32 * 1024 * 512 * 2);
constexpr size_t WS_MEMB = WS_X0B + al((size_t)T * 1024 * 2);
constexpr size_t WS_H = WS_MEMB + al((size_t)2048 * 1024 * 2);
constexpr size_t SZ_H = al((size_t)T * NH * 2);
constexpr size_t WS_YK = WS_H;
constexpr size_t WS_HH = WS_YK + (size_t)NASSIGN * 1024 * 2;
static_assert(WS_HH + (size_t)PADROWS * 512 * 2 <= WS_H + SZ_H, "moe overlay fits in H");
constexpr size_t WS_TB = WS_H + SZ_H;
constexpr size_t WS_HID = WS_TB + al((size_t)2 * NCR * 2048 * 4);
constexpr size_t WS_KCVC = WS_HID + al((size_t)2 * NCR * 256 * 4);
constexpr size_t WS_PC = WS_KCVC + al((size_t)2 * NCR * 64 * 4);
constexpr size_t WS_SEL = WS_PC + al((size_t)BATCH * 4 * SEQ * 128 * 4);
constexpr size_t WS_OW = WS_SEL + al((size_t)BATCH * 2 * SEQ * 4);
constexpr size_t WS_OC = WS_OW + al((size_t)T * 256 * 4);
constexpr size_t WS_BR = WS_OC + al((size_t)T * 256 * 4);
constexpr size_t WS_U = WS_BR + al((size_t)T * 1024 * 2);
constexpr size_t WS_RA = WS_U + al((size_t)T * 256 * 4);
constexpr size_t WS_RB = WS_RA + al((size_t)T * 256 * 4);
constexpr size_t WS_CQN = WS_RB + al((size_t)T * 256 * 4);
constexpr size_t WS_CKVN = WS_CQN + al((size_t)T * 192 * 4);
constexpr size_t WS_KR = WS_CKVN + al((size_t)T * 128 * 4);
constexpr size_t WS_Q = WS_KR + al((size_t)T * 32 * 4);
constexpr size_t WS_KV = WS_Q + al((size_t)T * 384 * 4);
constexpr size_t WS_M = WS_KV + al((size_t)T * 512 * 4);
constexpr size_t WS_Y = WS_M + al((size_t)T * 1024 * 2);
constexpr size_t WS_XA = WS_Y + al((size_t)T * 1024 * 4);
constexpr size_t WS_XB = WS_XA + al((size_t)T * 1024 * 4);
constexpr size_t WS_XC = WS_XB + al((size_t)T * 1024 * 4);
constexpr size_t WS_XAB = WS_XC + al((size_t)T * 1024 * 4);
constexpr size_t WS_XBB = WS_XAB + al((size_t)T * 1024 * 2);
constexpr size_t WS_XCB = WS_XBB + al((size_t)T * 1024 * 2);
constexpr size_t WS_XQ = WS_XCB + al((size_t)T * 1024 * 2);
constexpr size_t WS_XO = WS_XQ + al((size_t)T * 512 * 2);
constexpr size_t WS_KVM = WS_XO + al((size_t)T * 512 * 2);
constexpr size_t WS_LOG = WS_KVM + al((size_t)DEPTH * 2048 * 1024 * 2);
constexpr size_t WS_EIDX = WS_LOG + al((size_t)T * 36 * 4);
constexpr size_t WS_ESLOT = WS_EIDX + al((size_t)NASSIGN * 4);
constexpr size_t WS_EW = WS_ESLOT + al((size_t)NASSIGN * 4);
constexpr size_t WS_PERM = WS_EW + al((size_t)NASSIGN * 4);
constexpr size_t WS_QB = WS_PERM + al((size_t)PADROWS * 4);
constexpr size_t WS_KM = WS_QB + al((size_t)T * 384 * 2);
constexpr size_t WS_VM = WS_KM + al((size_t)T * 384 * 2);
constexpr size_t WS_KCB = WS_VM + al((size_t)T * 256 * 2);
constexpr size_t WT_C1 = WS_KCB + al((size_t)2 * NCR * 64 * 2);
constexpr size_t WT_C2 = WT_C1 + al((size_t)DEPTH * 2 * 256 * 2048 * 2);
constexpr size_t WT_UQ = WT_C2 + al((size_t)DEPTH * 2 * 128 * 256 * 2);
constexpr size_t WT_UKV = WT_UQ + al((size_t)DEPTH * 384 * 192 * 2);
constexpr size_t WT_G = WT_UKV + al((size_t)DEPTH * 512 * 128 * 2);
constexpr size_t WT_RH = WT_G + al((size_t)DEPTH * 4 * 128 * 64 * 2);
constexpr size_t WT_RL = WT_RH + al((size_t)DEPTH * 128 * 1024 * 2);
constexpr size_t WS_TBB = WT_RL + al((size_t)DEPTH * 128 * 1024 * 2);
constexpr size_t WS_HIDB = WS_TBB + al((size_t)2 * 2048 * 2048 * 2);
constexpr size_t WS_UB = WS_HIDB + al((size_t)2 * 2048 * 256 * 2);
constexpr size_t WS_CQNB = WS_UB + al((size_t)T * 256 * 2);
constexpr size_t WS_CKVNB = WS_CQNB + al((size_t)T * 192 * 2);
constexpr size_t WS_XBL = WS_CKVNB + al((size_t)T * 128 * 2);
constexpr size_t WS_SA = WS_XBL + al((size_t)T * 1024 * 2);
constexpr size_t WS_SH = WS_SA + al((size_t)BATCH * 32 * 256 * 4);
constexpr size_t WS_XG = WS_SH + al((size_t)BATCH * 32 * 256 * 4);
constexpr size_t WS_END = WS_XG + al((size_t)PADROWS * 1024 * 2);

constexpr int CW_BAR = 4096;
constexpr int CW_CNT = 16384;

struct Params {
    const float* in[34];
    float* out;
    unsigned char* ws;
};

#define XB_TMO      128
#define XB_XCNT(j)  (256  + 64 * (j))
#define XB_XSUB(j)  (1280 + 64 * (j))
#define XB_XGEN(j)  (2304 + 64 * (j))
#define XB_TOP      3328
#define XB_TOPGEN   3392
#define XCD_BAR_WORDS 3456
#define XB_SPIN_CAP (1u << 22)

__device__ __forceinline__ unsigned xb_ld(unsigned* p)              { return __hip_atomic_load(p, __ATOMIC_RELAXED, __HIP_MEMORY_SCOPE_AGENT); }
__device__ __forceinline__ unsigned xb_add(unsigned* p, unsigned v) { return __hip_atomic_fetch_add(p, v, __ATOMIC_RELAXED, __HIP_MEMORY_SCOPE_AGENT); }
__device__ __forceinline__ unsigned xb_xcc_id() { return (unsigned)__builtin_amdgcn_s_getreg((3 << 11) | 20) & 0xFu; }
#define XB_SPIN(cond, bar) do { unsigned _sp = 0; while (cond) { __builtin_amdgcn_s_sleep(1); \
    if ((++_sp & 255u) == 0u) { if (xb_ld(&(bar)[XB_TMO])) break; if (_sp > XB_SPIN_CAP) { atomicAdd(&(bar)[XB_TMO], 1u); break; } } } } while (0)

struct XcdBarrier { unsigned* bar; unsigned x; volatile LAS unsigned* st; };

__device__ __forceinline__ XcdBarrier xcd_barrier_post(unsigned* bar, volatile LAS unsigned* st) {
    XcdBarrier b; b.bar = bar; b.x = xb_xcc_id(); b.st = st;
    if (threadIdx.x == 0) (void)xb_add(&bar[XB_XCNT(b.x)], 1u);
    return b;
}
__device__ __forceinline__ void xcd_barrier_complete(unsigned* bar, unsigned x, unsigned& nloc, unsigned& nx) {
    const unsigned G = gridDim.x * gridDim.y * gridDim.z;
    unsigned sum, cnt, mine, sp = 0u;
    for (;;) {
        sum = 0u; cnt = 0u; mine = 0u;
#pragma unroll
        for (unsigned j = 0; j < 16; ++j) { const unsigned c = xb_ld(&bar[XB_XCNT(j)]); sum += c; cnt += (c > 0u) ? 1u : 0u; mine = (j == x) ? c : mine; }
        if (sum == G) break;
        __builtin_amdgcn_s_sleep(1);
        if ((++sp & 255u) == 0u) { if (xb_ld(&bar[XB_TMO])) break; if (sp > XB_SPIN_CAP) { atomicAdd(&bar[XB_TMO], 1u); break; } }
    }
    nloc = mine > 0u ? mine : 1u; nx = cnt > 0u ? cnt : 1u;
}
__device__ __forceinline__ void xcd_barrier(const XcdBarrier& b) {
    asm volatile("s_waitcnt vmcnt(0)" ::: "memory");
    __syncthreads();
    if (threadIdx.x == 0) {
        unsigned* bar = b.bar;
        __builtin_amdgcn_s_waitcnt(0);
        unsigned nloc = b.st[0], nx = b.st[1];
        if (nloc == 0u) { xcd_barrier_complete(bar, b.x, nloc, nx); b.st[0] = nloc; b.st[1] = nx; }
        const unsigned old = xb_add(&bar[XB_XSUB(b.x)], 1u);
        const unsigned gen = old / nloc;
        if (old + 1u == (gen + 1u) * nloc) {
            __builtin_amdgcn_fence(__ATOMIC_RELEASE, "agent");
            asm volatile("s_waitcnt vmcnt(0)" ::: "memory");
            const unsigned og = xb_add(&bar[XB_TOP], 1u);
            const unsigned tg = og / nx;
            if (og + 1u == (tg + 1u) * nx) xb_add(&bar[XB_TOPGEN], 1u);
            else XB_SPIN(xb_ld(&bar[XB_TOPGEN]) == tg, bar);
            __builtin_amdgcn_fence(__ATOMIC_ACQUIRE, "agent");
            xb_add(&bar[XB_XGEN(b.x)], 1u);
            asm volatile("s_waitcnt vmcnt(0)" ::: "memory");
        } else {
            XB_SPIN(xb_ld(&bar[XB_XGEN(b.x)]) == gen, bar);
            __builtin_amdgcn_fence(__ATOMIC_ACQUIRE, "agent");
            asm volatile("s_waitcnt vmcnt(0)" ::: "memory");
        }
    }
    __syncthreads();
}

DI float gelu_tanh(float x) { const float u = 0.7978845608028654f * (x + 0.044715f * x * x * x); return 0.5f * x * (1.f + tanhf(u)); }
DI float sigm(float x) { return 1.f / (1.f + expf(-x)); }
DI float logsig(float z) { return fminf(z, 0.f) - log1pf(expf(-fabsf(z))); }
DI float wave_sum(float v) {
    const int lane = tidx() & 63;
#pragma unroll
    for (int o = 32; o > 0; o >>= 1) v += __int_as_float(__builtin_amdgcn_ds_bpermute((lane ^ o) << 2, __float_as_int(v)));
    return v;
}

DI float bflo(unsigned u) { return __uint_as_float(u << 16); }
DI float bfhi(unsigned u) { return __uint_as_float(u & 0xffff0000u); }
DI float bf2f(bf16_t x) { return __uint_as_float((unsigned)x << 16); }
typedef float f32x2_t __attribute__((ext_vector_type(2)));
typedef __bf16 bf16x2_t __attribute__((ext_vector_type(2)));
DI unsigned pk_bf16(float lo, float hi) { f32x2_t v = {lo, hi}; bf16x2_t b = __builtin_convertvector(v, bf16x2_t); return __builtin_bit_cast(unsigned, b); }
DI bf16_t f2bf(float x) { return (bf16_t)(pk_bf16(x, 0.f) & 0xffffu); }
DI void st4bf(bf16_t* p, float a, float b, float c, float d) { uint2 v; v.x = pk_bf16(a, b); v.y = pk_bf16(c, d); *(uint2*)p = v; }
DI float4 ld4bf(const bf16_t* p) { const uint2 v = *(const uint2*)p; return make_float4(bflo(v.x), bfhi(v.x), bflo(v.y), bfhi(v.y)); }
template <int N> DI float dot_row(const float* q, const bf16_t* kr) {
    float dot = 0.f;
#pragma unroll
    for (int d = 0; d < N; d += 8) { const uint4 v = *(const uint4*)(kr + d);
        dot = fmaf(q[d], bflo(v.x), dot); dot = fmaf(q[d + 1], bfhi(v.x), dot); dot = fmaf(q[d + 2], bflo(v.y), dot); dot = fmaf(q[d + 3], bfhi(v.y), dot);
        dot = fmaf(q[d + 4], bflo(v.z), dot); dot = fmaf(q[d + 5], bfhi(v.z), dot); dot = fmaf(q[d + 6], bflo(v.w), dot); dot = fmaf(q[d + 7], bfhi(v.w), dot); }
    return dot;
}
template <int N> DI float dot_row(const float* q, const float* kr) {
    float dot = 0.f;
#pragma unroll
    for (int d = 0; d < N; ++d) dot = fmaf(q[d], kr[d], dot);
    return dot;
}
template <int N> DI void axpy_row(float* o, float pr, float corr, const bf16_t* vr) {
#pragma unroll
    for (int d = 0; d < N; d += 8) { const uint4 v = *(const uint4*)(vr + d);
        o[d] = fmaf(pr, bflo(v.x), o[d] * corr); o[d + 1] = fmaf(pr, bfhi(v.x), o[d + 1] * corr); o[d + 2] = fmaf(pr, bflo(v.y), o[d + 2] * corr); o[d + 3] = fmaf(pr, bfhi(v.y), o[d + 3] * corr);
        o[d + 4] = fmaf(pr, bflo(v.z), o[d + 4] * corr); o[d + 5] = fmaf(pr, bfhi(v.z), o[d + 5] * corr); o[d + 6] = fmaf(pr, bflo(v.w), o[d + 6] * corr); o[d + 7] = fmaf(pr, bfhi(v.w), o[d + 7] * corr); }
}
template <int N> DI void axpy_row(float* o, float pr, float corr, const float* vr) {
#pragma unroll
    for (int d = 0; d < N; ++d) o[d] = fmaf(pr, vr[d], o[d] * corr);
}
template <int N> DI void ld_row(float* q, const bf16_t* p) {
#pragma unroll
    for (int d = 0; d < N; d += 8) { const uint4 v = *(const uint4*)(p + d);
        q[d] = bflo(v.x); q[d + 1] = bfhi(v.x); q[d + 2] = bflo(v.y); q[d + 3] = bfhi(v.y); q[d + 4] = bflo(v.z); q[d + 5] = bfhi(v.z); q[d + 6] = bflo(v.w); q[d + 7] = bfhi(v.w); }
}
template <int N> DI void ld_row(float* q, const float* p) {
#pragma unroll
    for (int d = 0; d < N; d += 4) { const float4 v = *(const float4*)(p + d); q[d] = v.x; q[d + 1] = v.y; q[d + 2] = v.z; q[d + 3] = v.w; }
}

struct MG { const bf16_t* A; long lda; const bf16_t* Wt; long ldw; int K; };

template <class RowFn>
DI void mgemm_tile(const MG& g, int n0, RowFn rowfn, f32x16 (&acc)[2][2], unsigned char* lds, bool zero = true) {
    constexpr int XI = G_BM * 8 / NT, WI = G_BN * 8 / NT;
    const int tid = tidx(), lane = tid & 63, wid = tid >> 6, r = lane & 31, h = lane >> 5;
    const int wm = wid % G_WM, wn = wid / G_WM;
    const int cc = tid & 7, row0 = tid >> 3;
    const bf16_t* xp[XI]; const bf16_t* wp[WI];
#pragma unroll
    for (int i = 0; i < XI; ++i) xp[i] = g.A + (long)rowfn(row0 + (NT / 8) * i) * g.lda + cc * 8;
#pragma unroll
    for (int i = 0; i < WI; ++i) wp[i] = g.Wt + (long)(n0 + row0 + (NT / 8) * i) * g.ldw + cc * 8;
    const int st_off = row0 * G_RS + cc * 16;
    if (zero)
#pragma unroll
    for (int a = 0; a < 2; ++a)
#pragma unroll
        for (int b = 0; b < 2; ++b)
#pragma unroll
            for (int i = 0; i < 16; ++i) acc[a][b][i] = 0.f;
    u32x4 xv[XI], wv[WI];
#pragma unroll
    for (int i = 0; i < XI; ++i) xv[i] = *(const u32x4*)(xp[i]);
#pragma unroll
    for (int i = 0; i < WI; ++i) wv[i] = *(const u32x4*)(wp[i]);
    __syncthreads();
#pragma unroll
    for (int i = 0; i < XI; ++i) *(u32x4*)(lds + st_off + (NT / 8) * i * G_RS) = xv[i];
#pragma unroll
    for (int i = 0; i < WI; ++i) *(u32x4*)(lds + G_BM * G_RS + st_off + (NT / 8) * i * G_RS) = wv[i];
    __syncthreads();
    const int nk = g.K >> 6;
    const int xf_off = (wm * 64 + r) * G_RS + h * 16, wf_off = G_BM * G_RS + (wn * 64 + r) * G_RS + h * 16;
    for (int kt = 0; kt < nk; ++kt) {
        const unsigned char* st = lds + (kt & 1) * G_STAGE;
        if (kt + 1 < nk) {
#pragma unroll
            for (int i = 0; i < XI; ++i) xv[i] = *(const u32x4*)(xp[i] + (kt + 1) * 64);
#pragma unroll
            for (int i = 0; i < WI; ++i) wv[i] = *(const u32x4*)(wp[i] + (kt + 1) * 64);
        }
#pragma unroll
        for (int ks = 0; ks < 4; ++ks) {
            const bf16x8 w0 = *(const bf16x8*)(st + wf_off + ks * 32), w1 = *(const bf16x8*)(st + wf_off + 32 * G_RS + ks * 32);
            const bf16x8 x0 = *(const bf16x8*)(st + xf_off + ks * 32), x1 = *(const bf16x8*)(st + xf_off + 32 * G_RS + ks * 32);
            acc[0][0] = __builtin_amdgcn_mfma_f32_32x32x16_bf16(w0, x0, acc[0][0], 0, 0, 0);
            acc[0][1] = __builtin_amdgcn_mfma_f32_32x32x16_bf16(w0, x1, acc[0][1], 0, 0, 0);
            acc[1][0] = __builtin_amdgcn_mfma_f32_32x32x16_bf16(w1, x0, acc[1][0], 0, 0, 0);
            acc[1][1] = __builtin_amdgcn_mfma_f32_32x32x16_bf16(w1, x1, acc[1][1], 0, 0, 0);
        }
        if (kt + 1 < nk) {
            unsigned char* sn = lds + ((kt + 1) & 1) * G_STAGE;
#pragma unroll
            for (int i = 0; i < XI; ++i) *(u32x4*)(sn + st_off + (NT / 8) * i * G_RS) = xv[i];
#pragma unroll
            for (int i = 0; i < WI; ++i) *(u32x4*)(sn + G_BM * G_RS + st_off + (NT / 8) * i * G_RS) = wv[i];
        }
        __syncthreads();
    }
}
#define MG_FOREACH(acc, LROW, FEAT, V, ...) do { const int _l = tidx() & 63, _w = tidx() >> 6, _wm = _w % G_WM, _wn = _w / G_WM; \
    _Pragma("unroll") for (int _ft = 0; _ft < 2; ++_ft) _Pragma("unroll") for (int _tt = 0; _tt < 2; ++_tt) _Pragma("unroll") for (int _i = 0; _i < 4; ++_i) { \
        const int LROW = _wm * 64 + _tt * 32 + (_l & 31); const int FEAT = _wn * 64 + _ft * 32 + 8 * _i + 4 * (_l >> 5); \
        float V[4] = {acc[_ft][_tt][4 * _i], acc[_ft][_tt][4 * _i + 1], acc[_ft][_tt][4 * _i + 2], acc[_ft][_tt][4 * _i + 3]}; __VA_ARGS__ } } while (0)

struct RowId { int m0; DI long operator()(int r) const { return m0 + r; } };

template <int OUTMODE>
DI void mgemm_job(const MG& g, int M, int N, void* out, long ldo, int bid, int nblk, unsigned char* lds) {
    const int tm = M / G_BM, tn = N / G_BN;
    for (int u = bid; u < tm * tn; u += nblk) {
        const int grp = u / (16 * tn), rem = u % (16 * tn);
        const int gm = (tm - grp * 16) < 16 ? (tm - grp * 16) : 16;
        const int mt = grp * 16 + rem % gm, nt = rem / gm;
        const int m0 = mt * G_BM, n0 = nt * G_BN;
        f32x16 acc[2][2];
        mgemm_tile(g, n0, RowId{m0}, acc, lds);
        MG_FOREACH(acc, lrow, feat, v, {
            const long o = (long)(m0 + lrow) * ldo + n0 + feat;
            if (OUTMODE == 1) *(float4*)((float*)out + o) = make_float4(v[0], v[1], v[2], v[3]);
            else {
                if (OUTMODE == 2 && n0 + feat >= O_MG) { v[0] = sigm(v[0]); v[1] = sigm(v[1]); v[2] = sigm(v[2]); v[3] = sigm(v[3]); }
                st4bf((bf16_t*)out + o, v[0], v[1], v[2], v[3]);
            } });
    }
}

namespace pg8 {
#define PG8_LAS __attribute__((address_space(3)))
typedef float f32x4 __attribute__((ext_vector_type(4)));
constexpr int BM = 256, BK = 64, HALF = 128, HTB = HALF * BK * 2  , STAGE_BYTES = 8 * HTB, NXCD = 8, WGM = 8;
__host__ __device__ __forceinline__ int lds_byte(int r, int c) { const int st = (r >> 4) * 2 + (c >> 5), rr = r & 15, cc = c & 31, ob = rr * 64 + cc * 2; return st * 1024 + (ob ^ (((ob >> 9) & 1) << 5)); }
__host__ __device__ __forceinline__ void stage_rc(int b, int& R, int& C) { const int st = b / 1024, sb = b % 1024, swz = sb ^ (((sb >> 9) & 1) << 5); R = (st >> 1) * 16 + swz / 64; C = (st & 1) * 32 + (swz % 64) / 2; }
__host__ __device__ __forceinline__ int perm32(int rho) { const int n = rho >> 4, i = rho & 15; return 8 * (i >> 2) + 4 * n + (i & 3); }
struct Unit { int pm, pn, e; };
struct Gemm { const bf16_t* A; const bf16_t* Bt; int M, N, K; };
struct StaticOrder {
    int nM, nN, nwg, G, c;
    __device__ void init(int M, int N, int G_, int c_) { nM = M / BM; nN = N / BM; nwg = nM * nN; G = G_; c = c_; }
    __device__ bool next(int i, Unit& u) const {
        const long L = (long)i * G + c; if (L >= nwg) return false;
        int wgid = (int)L; { const int q = nwg / NXCD, r = nwg % NXCD, xcd = wgid % NXCD, off = wgid / NXCD; wgid = (xcd < r ? xcd * (q + 1) : r * (q + 1) + (xcd - r) * q) + off; }
        const int nig = WGM * nN, gid = wgid / nig, fm = gid * WGM, gsz = (nM - fm) < WGM ? (nM - fm) : WGM;
        u.pm = fm + ((wgid % nig) % gsz); u.pn = (wgid % nig) / gsz; u.e = 0; return true;
    }
    __device__ __forceinline__ void a_ready(const Unit&) const {}
    __device__ __forceinline__ void done(const Unit&) const {}
};
struct ListOrder {
    Unit u0, u1, u2; int n;
    __device__ bool next(int i, Unit& u) const { if (i >= n) return false; u = (i == 0) ? u0 : ((i == 1) ? u1 : u2); return true; }
    __device__ __forceinline__ void a_ready(const Unit&) const {}
    __device__ __forceinline__ void done(const Unit&) const {}
};
template <class Epi, class Sched, bool ALIGN_EPI = false, bool SP2 = false>
__device__ __forceinline__ void gemm_phase(PG8_LAS unsigned char* lds, const Gemm g, const Sched& S, const Epi& E) {
    const int tid = tidx(), wid = __builtin_amdgcn_readfirstlane(tid >> 6), lane = tid & 63, wr = wid >> 2, wc = wid & 3, fr = lane & 15, fq = lane >> 4;
    const int K = g.K, nt = K / BK;
    unsigned voffA[2], voffB[2];
#pragma unroll
    for (int i = 0; i < 2; ++i) { int R, C; stage_rc(tid * 16 + i * 8192, R, C); const int Rb = Epi::PERM ? ((R & ~31) + perm32(R & 31)) : R;
        voffA[i] = (unsigned)(R * K + C) * 2u; voffB[i] = (unsigned)(Rb * K + C) * 2u; }
    const size_t kstep = (size_t)(BK * 2);
    const size_t hstep = (size_t)HALF * K * 2;
    const size_t tstep = 2 * hstep;
    const size_t estep = (size_t)g.N * K * 2;
    const unsigned ldsw = (unsigned)wid * 1024u;
    const int aoff = lds_byte(wr * 64 + fr, fq * 8), boff = lds_byte(wc * 32 + fr, fq * 8);
#define PG8_SA(b, h) (((b) * 2 + (h)) * HTB)
#define PG8_SB(b, h) ((4 + (b) * 2 + (h)) * HTB)
#define PG8_STAGE(bufoff, gbase, voff) do { _Pragma("unroll") for (int _i = 0; _i < 2; ++_i) \
        __builtin_amdgcn_global_load_lds((const unsigned*)((const char*)(gbase) + (voff)[_i]), (PG8_LAS unsigned*)(lds + (bufoff) + ldsw + _i * 8192), 16, 0, 0); } while (0)
#define PG8_LDA(dst, b, h) do { _Pragma("unroll") for (int m = 0; m < 4; ++m) _Pragma("unroll") for (int k = 0; k < 2; ++k) dst[m][k] = *(const PG8_LAS bf16x8*)(lds + PG8_SA(b, h) + aoff + m * 2048 + k * 1024); } while (0)
#define PG8_LDB(dst, b, h) do { _Pragma("unroll") for (int n = 0; n < 2; ++n) _Pragma("unroll") for (int k = 0; k < 2; ++k) dst[n][k] = *(const PG8_LAS bf16x8*)(lds + PG8_SB(b, h) + boff + n * 2048 + k * 1024); } while (0)
#define PG8_MMA(ai, bj, At, Bt) do { __builtin_amdgcn_s_setprio(1); _Pragma("unroll") for (int m = 0; m < 4; ++m) _Pragma("unroll") for (int n = 0; n < 2; ++n) _Pragma("unroll") for (int k = 0; k < 2; ++k) \
        acc[ai][bj][m][n] = __builtin_amdgcn_mfma_f32_16x16x32_bf16(Bt[n][k], At[m][k], acc[ai][bj][m][n], 0, 0, 0); __builtin_amdgcn_s_setprio(0); } while (0)
#define PG8_WAIT_V(n) asm volatile("s_waitcnt vmcnt(" #n ")" ::: "memory")
#define PG8_WAIT_L(n) asm volatile("s_waitcnt lgkmcnt(" #n ")" ::: "memory")
#define PG8_BAR __builtin_amdgcn_s_barrier()
#define PG8_SCHED __builtin_amdgcn_sched_barrier(0)
    Unit cur, nxt; int ui = 0;
    if (!S.next(0, cur)) return;
    f32x4 acc[2][2][4][2];
#pragma unroll
    for (int a = 0; a < 2; ++a)
#pragma unroll
        for (int b = 0; b < 2; ++b)
#pragma unroll
            for (int m = 0; m < 4; ++m)
#pragma unroll
                for (int n = 0; n < 2; ++n) acc[a][b][m][n] = (f32x4){0.f, 0.f, 0.f, 0.f};
    bf16x8 At[4][2], B0[2][2], B1[2][2];
    const char* cA = (const char*)g.A + (size_t)cur.pm * tstep; const char* cB = (const char*)g.Bt + (size_t)cur.e * estep + (size_t)cur.pn * tstep;
    S.a_ready(cur);
    if constexpr (SP2) {
        PG8_STAGE(PG8_SB(0, 0), cB, voffB); PG8_STAGE(PG8_SB(0, 1), cB + hstep, voffB); PG8_STAGE(PG8_SA(0, 0), cA, voffA); PG8_STAGE(PG8_SA(0, 1), cA + hstep, voffA);
        if (wr == 1) PG8_BAR;
        PG8_WAIT_V(2); PG8_BAR;
        PG8_STAGE(PG8_SB(1, 0), cB + kstep, voffB); PG8_STAGE(PG8_SA(1, 0), cA + kstep, voffA); PG8_STAGE(PG8_SB(1, 1), cB + hstep + kstep, voffB);
        PG8_WAIT_V(6); PG8_BAR;
    } else {
        PG8_STAGE(PG8_SB(0, 0), cB, voffB); PG8_STAGE(PG8_SA(0, 0), cA, voffA); PG8_STAGE(PG8_SB(0, 1), cB + hstep, voffB); PG8_STAGE(PG8_SA(0, 1), cA + hstep, voffA);
        if (wr == 1) PG8_BAR;
        PG8_WAIT_V(4); PG8_BAR;
        PG8_STAGE(PG8_SB(1, 0), cB + kstep, voffB); PG8_STAGE(PG8_SA(1, 0), cA + kstep, voffA); PG8_STAGE(PG8_SB(1, 1), cB + hstep + kstep, voffB);
        PG8_WAIT_V(6); PG8_BAR;
    }
    for (;;) {
        const bool has_next = S.next(ui + 1, nxt);
        const char* nA = has_next ? (const char*)g.A + (size_t)nxt.pm * tstep : cA; const char* nB = has_next ? (const char*)g.Bt + (size_t)nxt.e * estep + (size_t)nxt.pn * tstep : cB;
        for (int t = 0; t < nt; t += 2) {
            const bool last = (t == nt - 2);
            const char* a1 = cA + (size_t)(t + 1) * kstep;
            const char* a2 = last ? nA : cA + (size_t)(t + 2) * kstep; const char* b2 = last ? nB : cB + (size_t)(t + 2) * kstep;
            const char* a3 = a2 + kstep; const char* b3 = b2 + kstep;
            if (last && has_next) S.a_ready(nxt);
            if constexpr (SP2) {
            PG8_LDB(B0, 0, 0); PG8_LDB(B1, 0, 1); PG8_SCHED; PG8_LDA(At, 0, 0); PG8_STAGE(PG8_SA(1, 1), a1 + hstep, voffA);
            PG8_WAIT_V(8); PG8_WAIT_L(0); PG8_BAR; PG8_MMA(0, 0, At, B0); PG8_MMA(0, 1, At, B1); PG8_BAR; PG8_SCHED;
            PG8_LDA(At, 0, 1); PG8_STAGE(PG8_SB(0, 0), b2, voffB); PG8_STAGE(PG8_SB(0, 1), b2 + hstep, voffB); PG8_STAGE(PG8_SA(0, 0), a2, voffA);
            PG8_WAIT_V(8); PG8_WAIT_L(0); PG8_BAR; PG8_MMA(1, 0, At, B0); PG8_MMA(1, 1, At, B1); PG8_BAR; PG8_SCHED;
            PG8_LDB(B0, 1, 0); PG8_LDB(B1, 1, 1); PG8_SCHED; PG8_LDA(At, 1, 0); PG8_STAGE(PG8_SA(0, 1), a2 + hstep, voffA);
            PG8_WAIT_V(8); PG8_WAIT_L(0); PG8_BAR; PG8_MMA(0, 0, At, B0); PG8_MMA(0, 1, At, B1); PG8_BAR; PG8_SCHED;
            PG8_LDA(At, 1, 1); PG8_STAGE(PG8_SB(1, 0), b3, voffB); PG8_STAGE(PG8_SB(1, 1), b3 + hstep, voffB); PG8_STAGE(PG8_SA(1, 0), a3, voffA);
            PG8_WAIT_V(8); PG8_WAIT_L(0); PG8_BAR; PG8_MMA(1, 0, At, B0); PG8_MMA(1, 1, At, B1); PG8_BAR; PG8_SCHED;
            } else {
            PG8_LDB(B0, 0, 0); PG8_SCHED; PG8_LDA(At, 0, 0); PG8_STAGE(PG8_SA(1, 1), a1 + hstep, voffA);
            PG8_WAIT_L(8); PG8_BAR; PG8_WAIT_L(0); PG8_MMA(0, 0, At, B0); PG8_BAR; PG8_SCHED;
            PG8_LDB(B1, 0, 1); PG8_STAGE(PG8_SB(0, 0), b2, voffB);
            PG8_BAR; PG8_WAIT_L(0); PG8_MMA(0, 1, At, B1); PG8_BAR;
            PG8_LDA(At, 0, 1); PG8_STAGE(PG8_SA(0, 0), a2, voffA);
            PG8_BAR; PG8_WAIT_L(0); PG8_MMA(1, 0, At, B0); PG8_BAR; PG8_SCHED;
            PG8_STAGE(PG8_SB(0, 1), b2 + hstep, voffB);
            PG8_WAIT_V(6); PG8_BAR; PG8_MMA(1, 1, At, B1); PG8_BAR;
            PG8_LDB(B0, 1, 0); PG8_SCHED; PG8_LDA(At, 1, 0); PG8_STAGE(PG8_SA(0, 1), a2 + hstep, voffA);
            PG8_WAIT_L(8); PG8_BAR; PG8_WAIT_L(0); PG8_MMA(0, 0, At, B0); PG8_BAR; PG8_SCHED;
            PG8_LDB(B1, 1, 1); PG8_STAGE(PG8_SB(1, 0), b3, voffB);
            PG8_BAR; PG8_WAIT_L(0); PG8_MMA(0, 1, At, B1); PG8_BAR;
            PG8_LDA(At, 1, 1); PG8_STAGE(PG8_SA(1, 0), a3, voffA);
            PG8_BAR; PG8_WAIT_L(0); PG8_MMA(1, 0, At, B0); PG8_BAR; PG8_SCHED;
            PG8_STAGE(PG8_SB(1, 1), b3 + hstep, voffB);
            PG8_WAIT_V(6); PG8_BAR; PG8_MMA(1, 1, At, B1); PG8_BAR;
            }
        }
        if constexpr (ALIGN_EPI) { if (wr == 0) PG8_BAR; }
        if constexpr (!Epi::AFTER_DRAIN) { E(acc, cur, wr, wc, fr, fq); S.done(cur); }
        if (!has_next) break;
#pragma unroll
        for (int a = 0; a < 2; ++a)
#pragma unroll
            for (int b = 0; b < 2; ++b)
#pragma unroll
                for (int m = 0; m < 4; ++m)
#pragma unroll
                    for (int n = 0; n < 2; ++n) acc[a][b][m][n] = (f32x4){0.f, 0.f, 0.f, 0.f};
        cur = nxt; cA = nA; cB = nB; ++ui;
        if constexpr (ALIGN_EPI) { if (wr == 1) PG8_BAR; }
    }
    PG8_WAIT_V(0);
    if constexpr (!ALIGN_EPI) { if (wr == 0) PG8_BAR; }
    PG8_BAR;
    if constexpr (Epi::AFTER_DRAIN) { E.fused(acc, cur, wr, wc, fr, fq, lds, wid, lane); S.done(cur); }
#undef PG8_SA
#undef PG8_SB
#undef PG8_STAGE
#undef PG8_LDA
#undef PG8_LDB
#undef PG8_MMA
#undef PG8_WAIT_V
#undef PG8_WAIT_L
#undef PG8_BAR
#undef PG8_SCHED
}
}

struct EpiStoreBf16 {
    static constexpr bool PERM = true, AFTER_DRAIN = false;
    bf16_t* O; long ldo; int gate_from; long estride;
    __device__ __forceinline__ void operator()(const pg8::f32x4 (&acc)[2][2][4][2], const pg8::Unit& u, int wr, int wc, int fr, int fq) const {
        bf16_t* base = O + (long)u.e * estride;
#pragma unroll
        for (int ai = 0; ai < 2; ++ai)
#pragma unroll
            for (int m = 0; m < 4; ++m) {
                const long row = (long)u.pm * 256 + ai * 128 + wr * 64 + m * 16 + fr;
#pragma unroll
                for (int bj = 0; bj < 2; ++bj) {
                    pg8::f32x4 v0 = acc[ai][bj][m][0], v1 = acc[ai][bj][m][1];
                    if (u.pn * 2 + bj >= gate_from) {
#pragma unroll
                        for (int j = 0; j < 4; ++j) { v0[j] = sigm(v0[j]); v1[j] = sigm(v1[j]); }
                    }
                    u32x4 wv; wv[0] = pk_bf16(v0[0], v0[1]); wv[1] = pk_bf16(v0[2], v0[3]); wv[2] = pk_bf16(v1[0], v1[1]); wv[3] = pk_bf16(v1[2], v1[3]);
                    *(u32x4*)(base + row * ldo + u.pn * 256 + bj * 128 + wc * 32 + 8 * fq) = wv;
                }
            }
    }
};
struct EpiStoreF32 {
    static constexpr bool PERM = false, AFTER_DRAIN = false;
    float* O; long ldo;
    __device__ __forceinline__ void operator()(const pg8::f32x4 (&acc)[2][2][4][2], const pg8::Unit& u, int wr, int wc, int fr, int fq) const {
#pragma unroll
        for (int ai = 0; ai < 2; ++ai)
#pragma unroll
            for (int m = 0; m < 4; ++m) {
                const long row = (long)u.pm * 256 + ai * 128 + wr * 64 + m * 16 + fr;
#pragma unroll
                for (int bj = 0; bj < 2; ++bj)
#pragma unroll
                    for (int n = 0; n < 2; ++n) *(pg8::f32x4*)(O + row * ldo + u.pn * 256 + bj * 128 + wc * 32 + 16 * n + 4 * fq) = acc[ai][bj][m][n];
            }
    }
};
struct EpiMoeGU {
    static constexpr bool PERM = true, AFTER_DRAIN = false;
    bf16_t* HH;
    __device__ __forceinline__ void operator()(const pg8::f32x4 (&acc)[2][2][4][2], const pg8::Unit& u, int wr, int wc, int fr, int fq) const {
#pragma unroll
        for (int ai = 0; ai < 2; ++ai)
#pragma unroll
            for (int m = 0; m < 4; ++m) {
                const long row = (long)u.pm * 256 + ai * 128 + wr * 64 + m * 16 + fr;
                float hv[8];
#pragma unroll
                for (int n = 0; n < 2; ++n)
#pragma unroll
                    for (int j = 0; j < 4; ++j) { const float gt = acc[ai][0][m][n][j], up = acc[ai][1][m][n][j]; hv[4 * n + j] = gt * sigm(gt) * up; }
                u32x4 wv; wv[0] = pk_bf16(hv[0], hv[1]); wv[1] = pk_bf16(hv[2], hv[3]); wv[2] = pk_bf16(hv[4], hv[5]); wv[3] = pk_bf16(hv[6], hv[7]);
                *(u32x4*)(HH + row * 512 + u.pn * 128 + wc * 32 + 8 * fq) = wv;
            }
    }
};
struct EpiMoeDown {
    static constexpr bool PERM = true, AFTER_DRAIN = false;
    const int* perm; const float* ew; bf16_t* YK;
    __device__ __forceinline__ void operator()(const pg8::f32x4 (&acc)[2][2][4][2], const pg8::Unit& u, int wr, int wc, int fr, int fq) const {
#pragma unroll
        for (int ai = 0; ai < 2; ++ai)
#pragma unroll
            for (int m = 0; m < 4; ++m) {
                const int a = perm[u.pm * 256 + ai * 128 + wr * 64 + m * 16 + fr];
                if (a >= 0) {
                    const float sw = ew[a];
#pragma unroll
                    for (int bj = 0; bj < 2; ++bj) {
                        const pg8::f32x4 v0 = acc[ai][bj][m][0] * sw, v1 = acc[ai][bj][m][1] * sw;
                        u32x4 wv; wv[0] = pk_bf16(v0[0], v0[1]); wv[1] = pk_bf16(v0[2], v0[3]); wv[2] = pk_bf16(v1[0], v1[1]); wv[3] = pk_bf16(v1[2], v1[3]);
                        *(u32x4*)(YK + (long)a * 1024 + u.pn * 256 + bj * 128 + wc * 32 + 8 * fq) = wv;
                    }
                }
            }
    }
};
struct GroupedOrder {
    int nM, nN, nE, G, c;
    __device__ bool next(int i, pg8::Unit& u) const { const int L = i * G + c; if (L >= nM * nN * nE) return false; u.e = L / (nM * nN); const int rm = L % (nM * nN); u.pm = rm / nN; u.pn = rm % nN; return true; }
    __device__ __forceinline__ void a_ready(const pg8::Unit&) const {}
    __device__ __forceinline__ void done(const pg8::Unit&) const {}
};

struct LayerW {
    const float *cmp_pos, *conv_w, *conv_b, *ga_b, *gx_b, *lam, *q_norm, *kv_norm,
        *ln1_g, *ln1_b, *ln2_g, *ln2_b, *rg_b, *re_b, *ln3_g, *ln3_b;
    const bf16_t *t_in, *t_br, *t_out, *t_q, *t_o, *t_gu, *t_dn, *t_c1, *t_c2, *t_uq, *t_ukv, *t_g, *t_rh, *t_rl;
};
#define WSF(off) ((float*)(p.ws + (off)))
#define WSI(off) ((int*)(p.ws + (off)))
#define WSU(off) ((unsigned*)(p.ws + (off)))
#define WSB(off) ((bf16_t*)(p.ws + (off)))
DI LayerW layer_w(const Params& p, int l) {
    LayerW w;
    w.cmp_pos = p.in[3] + (size_t)l * 2 * 32 * 64;
    w.conv_w = p.in[6] + (size_t)l * 4 * 256;
    w.conv_b = p.in[7] + (size_t)l * 256;
    w.ga_b = p.in[9] + (size_t)l * 256;
    w.gx_b = p.in[11] + (size_t)l * 256;
    w.lam = p.in[12] + (size_t)l * 256;
    w.q_norm = p.in[13] + (size_t)l * 192;
    w.kv_norm = p.in[14] + (size_t)l * 128;
    w.ln1_g = p.in[19] + (size_t)l * 1024; w.ln1_b = p.in[20] + (size_t)l * 1024;
    w.ln2_g = p.in[24] + (size_t)l * 1024; w.ln2_b = p.in[25] + (size_t)l * 1024;
    w.rg_b = p.in[27] + (size_t)l * 4;
    w.re_b = p.in[29] + (size_t)l * 32;
    w.ln3_g = p.in[32] + (size_t)l * 1024; w.ln3_b = p.in[33] + (size_t)l * 1024;
    w.t_in = WSB(WT_IN) + (size_t)l * NH * 1024;
    w.t_br = WSB(WT_BR) + (size_t)l * 4 * 1024 * 256;
    w.t_out = WSB(WT_OUT) + (size_t)l * 1024 * 1024;
    w.t_q = WSB(WT_Q) + (size_t)l * 512 * 1024;
    w.t_o = WSB(WT_O) + (size_t)l * 1024 * 512;
    w.t_gu = WSB(WT_GU) + (size_t)l * 32 * 1024 * 1024;
    w.t_dn = WSB(WT_DN) + (size_t)l * 32 * 1024 * 512;
    w.t_c1 = WSB(WT_C1) + (size_t)l * 2 * 256 * 2048;
    w.t_c2 = WSB(WT_C2) + (size_t)l * 2 * 128 * 256;
    w.t_uq = WSB(WT_UQ) + (size_t)l * 384 * 192;
    w.t_ukv = WSB(WT_UKV) + (size_t)l * 512 * 128;
    w.t_g = WSB(WT_G) + (size_t)l * 4 * 128 * 64;
    w.t_rh = WSB(WT_RH) + (size_t)l * 128 * 1024;
    w.t_rl = WSB(WT_RL) + (size_t)l * 128 * 1024;
    return w;
}

template <int MODE>
DI int wt_col(int np, int Nsrc) {
    if (MODE == 0) return np < Nsrc ? np : -1;
    if (MODE == 2) return np < 1024 ? np : (np < 2656 ? np + 12 : (np < 2668 ? 1024 + (np - 2656) : (np < 2688 ? -1 : (np < 6784 ? np - 20 : -1))));
    const int pn = np >> 8, bj = (np >> 7) & 1, q = np & 127; return (bj ? 512 : 0) + 128 * pn + q;
}
template <int MODE>
DI void job_wt(const float* src, int nmat, int K, int Nsrc, bf16_t* dst, int Npad, int bid, int nblk, unsigned char* lds) {
    bf16_t* tile = (bf16_t*)lds;
    const int tk = K / 64, tn = Npad / 64, per = tk * tn;
    const int tid = tidx();
    const int kl = tid >> 4, n4 = (tid & 15) * 4;
    for (int u = bid; u < nmat * per; u += nblk) {
        const int mat = u / per, ru = u % per, k0 = (ru / tn) * 64, n0 = (ru % tn) * 64;
        const float* s = src + (size_t)mat * K * Nsrc;
        bf16_t* d = dst + (size_t)mat * Npad * K;
        const int col = wt_col<MODE>(n0 + n4, Nsrc);
        float4 v0 = make_float4(0.f, 0.f, 0.f, 0.f), v1 = v0;
        if (col >= 0) { v0 = *(const float4*)(s + (size_t)(k0 + kl) * Nsrc + col); v1 = *(const float4*)(s + (size_t)(k0 + kl + 32) * Nsrc + col); }
        __syncthreads();
        tile[(n4 + 0) * 72 + kl] = f2bf(v0.x); tile[(n4 + 1) * 72 + kl] = f2bf(v0.y); tile[(n4 + 2) * 72 + kl] = f2bf(v0.z); tile[(n4 + 3) * 72 + kl] = f2bf(v0.w);
        tile[(n4 + 0) * 72 + kl + 32] = f2bf(v1.x); tile[(n4 + 1) * 72 + kl + 32] = f2bf(v1.y); tile[(n4 + 2) * 72 + kl + 32] = f2bf(v1.z); tile[(n4 + 3) * 72 + kl + 32] = f2bf(v1.w);
        __syncthreads();
        { const int n2 = tid >> 3, kc = (tid & 7) * 8;
          *(uint4*)(d + (size_t)(n0 + n2) * K + k0 + kc) = *(const uint4*)(tile + n2 * 72 + kc); }
    }
}
DI void job_cvt(const float* src, bf16_t* dst, long n, int bid, int nblk) {
    for (long e = ((long)bid * NT + tidx()) * 4; e < n; e += (long)nblk * NT * 4) {
        const float4 v = *(const float4*)(src + e);
        st4bf(dst + e, v.x, v.y, v.z, v.w);
    }
}
DI void job_cmp_gather(const Params& p, const LayerW& w, int bid, int nblk) {
    const bf16_t* H = WSB(WS_H); bf16_t* TB = WSB(WS_TBB);
    const long total = (long)2 * NCR * 2048 / 4;
    for (long e = (long)bid * NT + tidx(); e < total; e += (long)nblk * NT) {
        const long e4 = e * 4;
        const int f = (int)(e4 % 2048); const long r2 = e4 / 2048; const int r = (int)(r2 % NCR), j = (int)(r2 / NCR);
        const int g = r & 1, bc = r >> 1, c = bc % NCMP, b = bc / NCMP, i = f >> 6, d = f & 63;
        const float4 hv = ld4bf(H + (long)(b * SEQ + 16 * c + i) * NH + (j ? O_AVC : O_AKC) + g * 64 + d);
        const float4 pv = *(const float4*)(w.cmp_pos + (j * 32 + i) * 64 + d);
        st4bf(TB + ((long)j * 2048 + r) * 2048 + f, hv.x + pv.x, hv.y + pv.y, hv.z + pv.z, hv.w + pv.w);
    }
}
DI void job_rnn_conv(const Params& p, const LayerW& w, int bid, int nblk) {
    const bf16_t* H = WSB(WS_H); float* U = WSF(WS_U); bf16_t* UB = WSB(WS_UB);
    for (long e = (long)bid * NT + tidx(); e < (long)T * 256; e += (long)nblk * NT) {
        const int ch = (int)(e & 255); const int t = (int)(e >> 8), s = t & (SEQ - 1);
        float u = w.conv_b[ch];
#pragma unroll
        for (int tap = 0; tap < 4; ++tap) { const int sp = s - 3 + tap; if (sp >= 0) u += bf2f(H[(long)(t - 3 + tap) * NH + O_CX + ch]) * w.conv_w[tap * 256 + ch]; }
        U[e] = u; UB[e] = f2bf(u);
    }
}
DI void job_rnn_gates(const Params& p, const LayerW& w, int bid, int nblk, unsigned char* lds) {
    const float* U = WSF(WS_U); float* RA = WSF(WS_RA); float* RB = WSF(WS_RB);
    for (int u = bid; u < (T / G_BM) * 4; u += nblk) {
        const int blk = u & 3, m0 = (u >> 2) * G_BM;
        MG g; g.A = WSB(WS_UB) + blk * 64; g.lda = 256; g.Wt = w.t_g + (size_t)blk * 128 * 64; g.ldw = 64; g.K = 64;
        f32x16 acc[2][2];
        mgemm_tile(g, 0, RowId{m0}, acc, lds);
        const int l = tidx() & 63, wv = tidx() >> 6, wm = wv % G_WM, wn = wv / G_WM;
#pragma unroll
        for (int tt = 0; tt < 2; ++tt)
#pragma unroll
            for (int i = 0; i < 4; ++i) {
                const long t = m0 + wm * 64 + tt * 32 + (l & 31); const int ch = blk * 64 + wn * 32 + 8 * i + 4 * (l >> 5);
                const float4 uv = *(const float4*)(U + t * 256 + ch);
                const float ua[4] = {uv.x, uv.y, uv.z, uv.w};
                float av[4], bv[4];
#pragma unroll
                for (int j = 0; j < 4; ++j) {
                    const float r = sigm(acc[0][tt][4 * i + j] + w.ga_b[ch + j]), ig = sigm(acc[1][tt][4 * i + j] + w.gx_b[ch + j]);
                    const float nl = -w.lam[ch + j];
                    const float sp = fmaxf(nl, 0.f) + log1pf(expf(-fabsf(nl)));
                    const float log_a = -8.0f * r * sp;
                    av[j] = expf(log_a); bv[j] = sqrtf(-expm1f(2.0f * log_a)) * (ig * ua[j]);
                }
                *(float4*)(RA + t * 256 + ch) = make_float4(av[0], av[1], av[2], av[3]);
                *(float4*)(RB + t * 256 + ch) = make_float4(bv[0], bv[1], bv[2], bv[3]);
            }
    }
}
DI void job_rnn_scan1(const Params& p, int bid, int nblk) {
    const float* RA = WSF(WS_RA); const float* RB = WSF(WS_RB); float* SA = WSF(WS_SA); float* SH = WSF(WS_SH);
    for (int e = bid * NT + tidx(); e < BATCH * 32 * 256; e += nblk * NT) {
        const int ch = e & 255, bc = e >> 8;
        float ap = 1.f, hl = 0.f;
        for (int s0 = 0; s0 < 64; s0 += 8) {
            float av[8], bv[8];
#pragma unroll
            for (int i = 0; i < 8; ++i) { const long t = (long)bc * 64 + s0 + i; av[i] = RA[t * 256 + ch]; bv[i] = RB[t * 256 + ch]; }
#pragma unroll
            for (int i = 0; i < 8; ++i) { ap *= av[i]; hl = av[i] * hl + bv[i]; }
        }
        SA[e] = ap; SH[e] = hl;
    }
}
DI void job_rnn_scan2(const Params& p, int bid, int nblk) {
    const bf16_t* H = WSB(WS_H); const float* RA = WSF(WS_RA); const float* RB = WSF(WS_RB); const float* SA = WSF(WS_SA); const float* SH = WSF(WS_SH); bf16_t* BR = WSB(WS_BR);
    for (int e = bid * NT + tidx(); e < BATCH * 32 * 256; e += nblk * NT) {
        const int ch = e & 255, bc = e >> 8, chunk = bc & 31, b = bc >> 5;
        float h = 0.f;
        for (int c = 0; c < chunk; ++c) { const int q = ((b * 32 + c) << 8) + ch; h = SA[q] * h + SH[q]; }
        for (int s0 = 0; s0 < 64; s0 += 8) {
            float av[8], bv[8], gv[8];
#pragma unroll
            for (int i = 0; i < 8; ++i) { const long t = (long)bc * 64 + s0 + i; av[i] = RA[t * 256 + ch]; bv[i] = RB[t * 256 + ch]; gv[i] = bf2f(H[t * NH + O_CG + ch]); }
#pragma unroll
            for (int i = 0; i < 8; ++i) { const long t = (long)bc * 64 + s0 + i; h = av[i] * h + bv[i]; BR[t * 1024 + 2 * 256 + ch] = f2bf(h * gelu_tanh(gv[i])); }
        }
    }
}
DI void job_mla_norm(const Params& p, const LayerW& w, int bid, int nblk) {
    const bf16_t* H = WSB(WS_H); bf16_t* CQN = WSB(WS_CQNB); bf16_t* CKVN = WSB(WS_CKVNB); bf16_t* KM = WSB(WS_KM);
    const int lane = tidx() & 63, wid = tidx() >> 6;
    for (int t = bid * (NT / 64) + wid; t < T; t += nblk * (NT / 64)) {
        const bf16_t* hr = H + (long)t * NH;
        float q0 = bf2f(hr[O_DCQ + lane]), q1 = bf2f(hr[O_DCQ + 64 + lane]), q2 = bf2f(hr[O_DCQ + 128 + lane]);
        float ss = wave_sum(q0 * q0 + q1 * q1 + q2 * q2);
        float rs = rsqrtf(ss * (1.f / 192.f) + 1e-6f);
        CQN[(long)t * 192 + lane] = f2bf(q0 * rs * w.q_norm[lane]);
        CQN[(long)t * 192 + 64 + lane] = f2bf(q1 * rs * w.q_norm[64 + lane]);
        CQN[(long)t * 192 + 128 + lane] = f2bf(q2 * rs * w.q_norm[128 + lane]);
        float k0 = bf2f(hr[O_DCKV + lane]), k1 = bf2f(hr[O_DCKV + 64 + lane]);
        ss = wave_sum(k0 * k0 + k1 * k1);
        rs = rsqrtf(ss * (1.f / 128.f) + 1e-6f);
        CKVN[(long)t * 128 + lane] = f2bf(k0 * rs * w.kv_norm[lane]);
        CKVN[(long)t * 128 + 64 + lane] = f2bf(k1 * rs * w.kv_norm[64 + lane]);
        {
            const int i = lane & 15, hd = lane >> 4;
            const int s = t & (SEQ - 1);
            const float inv = powf(10000.f, -(float)(2 * i) / 32.f);
            const float ang = (float)s * inv, cs = cosf(ang), sn = sinf(ang);
            const float x1 = bf2f(hr[O_DKR + i]), x2 = bf2f(hr[O_DKR + 16 + i]);
            KM[(long)t * 384 + hd * 96 + 64 + i] = f2bf(x1 * cs - x2 * sn);
            KM[(long)t * 384 + hd * 96 + 80 + i] = f2bf(x1 * sn + x2 * cs);
        }
    }
}
DI void job_mla_up(const Params& p, const LayerW& w, int bid, int nblk, unsigned char* lds) {
    bf16_t* QB = WSB(WS_QB); bf16_t* KM = WSB(WS_KM); bf16_t* VM = WSB(WS_VM);
    constexpr int TM = T / G_BM;
    for (int u = bid; u < TM * 7; u += nblk) {
        const int mt = u / 7, nt = u % 7, m0 = mt * G_BM;
        f32x16 acc[2][2];
        const int l = tidx() & 63, wv = tidx() >> 6, wm = wv % G_WM, wn = wv / G_WM, hh = l >> 5;
        if (nt < 3) {
            MG g; g.A = WSB(WS_CQNB); g.lda = 192; g.Wt = w.t_uq; g.ldw = 192; g.K = 192;
            const int n0 = nt * 128;
            mgemm_tile(g, n0, RowId{m0}, acc, lds);
#pragma unroll
            for (int ft = 0; ft < 2; ++ft) {
                const int fb = (n0 + wn * 64 + ft * 32) >> 5;
                if (fb % 3 == 2) {
#pragma unroll
                    for (int tt = 0; tt < 2; ++tt) {
                        const int pos = (m0 + wm * 64 + tt * 32 + (l & 31)) & (SEQ - 1);
#pragma unroll
                        for (int i = 0; i < 2; ++i)
#pragma unroll
                            for (int j = 0; j < 4; ++j) {
                                const int fi = 8 * i + 4 * hh + j;
                                const float inv = powf(10000.f, -(float)(2 * fi) / 32.f);
                                const float ang = (float)pos * inv, cs = cosf(ang), sn = sinf(ang);
                                const float x1 = acc[ft][tt][4 * i + j], x2 = acc[ft][tt][4 * (i + 2) + j];
                                acc[ft][tt][4 * i + j] = x1 * cs - x2 * sn; acc[ft][tt][4 * (i + 2) + j] = x1 * sn + x2 * cs;
                            }
                    }
                }
            }
            MG_FOREACH(acc, lrow, feat, v, { st4bf(QB + (long)(m0 + lrow) * 384 + n0 + feat, v[0], v[1], v[2], v[3]); });
        } else {
            MG g; g.A = WSB(WS_CKVNB); g.lda = 128; g.Wt = w.t_ukv; g.ldw = 128; g.K = 128;
            const int n0 = (nt - 3) * 128;
            mgemm_tile(g, n0, RowId{m0}, acc, lds);
            MG_FOREACH(acc, lrow, feat, v, {
                const int hd = nt - 3;
                if (feat < 64) st4bf(KM + (long)(m0 + lrow) * 384 + hd * 96 + feat, v[0], v[1], v[2], v[3]);
                else st4bf(VM + (long)(m0 + lrow) * 256 + hd * 64 + (feat - 64), v[0], v[1], v[2], v[3]); });
        }
    }
}
template <int STAGE>
DI void job_cmp_mlp(const Params& p, const LayerW& w, int bid, int nblk, unsigned char* lds) {
    constexpr int TM = 2048 / G_BM, TN = STAGE == 0 ? 2 : 1;
    for (int u = bid; u < 2 * TM * TN; u += nblk) {
        const int j = u / (TM * TN), ru = u % (TM * TN), mt = ru / TN, nt = ru % TN, m0 = mt * G_BM, n0 = nt * 128;
        MG g;
        if (STAGE == 0) { g.A = WSB(WS_TBB) + (size_t)j * 2048 * 2048; g.lda = 2048; g.Wt = w.t_c1 + (size_t)j * 256 * 2048; g.ldw = 2048; g.K = 2048; }
        else { g.A = WSB(WS_HIDB) + (size_t)j * 2048 * 256; g.lda = 256; g.Wt = w.t_c2 + (size_t)j * 128 * 256; g.ldw = 256; g.K = 256; }
        f32x16 acc[2][2];
        mgemm_tile(g, n0, [&](int r) { const int rr = m0 + r; return (long)(rr < NCR ? rr : NCR - 1); }, acc, lds);
        if (STAGE == 0) {
            bf16_t* HID = WSB(WS_HIDB) + (size_t)j * 2048 * 256;
            MG_FOREACH(acc, lrow, feat, v, { st4bf(HID + (long)(m0 + lrow) * 256 + n0 + feat, gelu_tanh(v[0]), gelu_tanh(v[1]), gelu_tanh(v[2]), gelu_tanh(v[3])); });
        } else {
            bf16_t* KC = WSB(WS_KCB) + (size_t)j * NCR * 64;
            MG_FOREACH(acc, lrow, feat, v, { if (feat < 64 && m0 + lrow < NCR) st4bf(KC + (long)(m0 + lrow) * 64 + feat, v[0], v[1], v[2], v[3]); });
        }
    }
}
DI void job_router_logits(const Params& p, const LayerW& w, int bid, int nblk, unsigned char* lds) {
    float* LOG = WSF(WS_LOG);
    for (int u = bid; u < T / G_BM; u += nblk) {
        const int m0 = u * G_BM;
        f32x16 acc[2][2];
        MG g; g.lda = 1024; g.ldw = 1024; g.K = 1024;
        g.A = WSB(WS_XBB); g.Wt = w.t_rh; mgemm_tile(g, 0, RowId{m0}, acc, lds, true);
        g.A = WSB(WS_XBL); g.Wt = w.t_rh; mgemm_tile(g, 0, RowId{m0}, acc, lds, false);
        g.A = WSB(WS_XBB); g.Wt = w.t_rl; mgemm_tile(g, 0, RowId{m0}, acc, lds, false);
        MG_FOREACH(acc, lrow, feat, v, { if (feat < 36) *(float4*)(LOG + (long)(m0 + lrow) * 36 + feat) = make_float4(v[0], v[1], v[2], v[3]); });
    }
}
DI void job_pack_small(const Params& p, int bid, int nblk) {
    bf16_t* TG = WSB(WT_G); bf16_t* RH = WSB(WT_RH); bf16_t* RL = WSB(WT_RL);
    for (int e = bid * NT + tidx(); e < DEPTH * 4 * 128 * 64; e += nblk * NT) {
        const int c = e & 63, q = (e >> 6) & 127, lb = e >> 13;
        const int seg = q >> 5, i = q & 31, chl = (seg >> 1) * 32 + i;
        const float* src = (seg & 1) ? p.in[10] : p.in[8];
        TG[e] = f2bf(src[((size_t)lb * 64 + c) * 64 + chl]);
    }
    for (int e = bid * NT + tidx(); e < DEPTH * 128 * 1024; e += nblk * NT) {
        const int k = e & 1023, n = (e >> 10) & 127, l = e >> 17;
        float v = 0.f;
        if (n < 4) v = p.in[26][((size_t)l * 1024 + k) * 4 + n];
        else if (n < 36) v = p.in[28][((size_t)l * 1024 + k) * 32 + (n - 4)];
        const bf16_t hi = f2bf(v);
        RH[e] = hi; RL[e] = f2bf(v - bf2f(hi));
    }
}

DI void job_merge(const Params& p, const LayerW& w, int bid, int nblk, unsigned char* lds) {
    const bf16_t* H = WSB(WS_H); bf16_t* M = WSB(WS_M);
    for (int u = bid; u < (T / G_BM) * 8; u += nblk) {
        const int m0 = (u >> 3) * G_BM, n0 = (u & 7) * G_BN;
        f32x16 macc[2][2];
#pragma unroll
        for (int a = 0; a < 2; ++a)
#pragma unroll
            for (int b = 0; b < 2; ++b)
#pragma unroll
                for (int i = 0; i < 16; ++i) macc[a][b][i] = 0.f;
#pragma unroll 1
        for (int n = 0; n < 4; ++n) {
            MG g; g.A = WSB(WS_BR) + n * 256; g.lda = 1024; g.Wt = w.t_br + (size_t)n * 1024 * 256; g.ldw = 256; g.K = 256;
            f32x16 acc[2][2];
            mgemm_tile(g, n0, RowId{m0}, acc, lds);
            const int l = tidx() & 63, wv = tidx() >> 6, wm = wv % G_WM, wn = wv / G_WM;
#pragma unroll
            for (int ft = 0; ft < 2; ++ft)
#pragma unroll
                for (int tt = 0; tt < 2; ++tt)
#pragma unroll
                    for (int i = 0; i < 4; ++i) {
                        const int lrow = wm * 64 + tt * 32 + (l & 31), feat = wn * 64 + ft * 32 + 8 * i + 4 * (l >> 5);
                        const float4 gv = ld4bf(H + (long)(m0 + lrow) * NH + O_MG + n * 1024 + n0 + feat);
                        macc[ft][tt][4 * i] += gv.x * acc[ft][tt][4 * i]; macc[ft][tt][4 * i + 1] += gv.y * acc[ft][tt][4 * i + 1];
                        macc[ft][tt][4 * i + 2] += gv.z * acc[ft][tt][4 * i + 2]; macc[ft][tt][4 * i + 3] += gv.w * acc[ft][tt][4 * i + 3];
                    }
        }
        MG_FOREACH(macc, lrow, feat, v, { st4bf(M + (long)(m0 + lrow) * 1024 + n0 + feat, v[0], v[1], v[2], v[3]); });
    }
}
DI void job_ln(const float* xin, const bf16_t* y, int ldy, const bf16_t* y2, const float* gw, const float* bw, float* out, bf16_t* outb, bf16_t* outl, int bid, int nblk) {
    const int lane = tidx() & 63, wid = tidx() >> 6;
    for (int t = bid * (NT / 64) + wid; t < T; t += nblk * (NT / 64)) {
        float v[16];
        float s = 0.f;
#pragma unroll
        for (int i = 0; i < 4; ++i) {
            const int c = i * 256 + lane * 4;
            const float4 xv = *(const float4*)(xin + (long)t * 1024 + c);
            float4 yv = ld4bf(y + (long)t * ldy + c);
            if (y2) { const float4 z = ld4bf(y2 + (long)t * ldy + c); yv.x += z.x; yv.y += z.y; yv.z += z.z; yv.w += z.w; }
            v[i * 4 + 0] = DN_ALPHA * xv.x + yv.x; v[i * 4 + 1] = DN_ALPHA * xv.y + yv.y; v[i * 4 + 2] = DN_ALPHA * xv.z + yv.z; v[i * 4 + 3] = DN_ALPHA * xv.w + yv.w;
            s += (v[i * 4] + v[i * 4 + 1]) + (v[i * 4 + 2] + v[i * 4 + 3]);
        }
        const float mu = wave_sum(s) * (1.f / 1024.f);
        float q = 0.f;
#pragma unroll
        for (int i = 0; i < 16; ++i) { const float dlt = v[i] - mu; q += dlt * dlt; }
        const float rstd = rsqrtf(wave_sum(q) * (1.f / 1024.f) + 1e-5f);
#pragma unroll
        for (int i = 0; i < 4; ++i) {
            const int c = i * 256 + lane * 4;
            const float4 gv = *(const float4*)(gw + c), bv = *(const float4*)(bw + c);
            const float o0 = (v[i * 4] - mu) * rstd * gv.x + bv.x, o1 = (v[i * 4 + 1] - mu) * rstd * gv.y + bv.y,
                        o2 = (v[i * 4 + 2] - mu) * rstd * gv.z + bv.z, o3 = (v[i * 4 + 3] - mu) * rstd * gv.w + bv.w;
            *(float4*)(out + (long)t * 1024 + c) = make_float4(o0, o1, o2, o3);
            if (outb) st4bf(outb + (long)t * 1024 + c, o0, o1, o2, o3);
            if (outl) st4bf(outl + (long)t * 1024 + c, o0 - bf2f(f2bf(o0)), o1 - bf2f(f2bf(o1)), o2 - bf2f(f2bf(o2)), o3 - bf2f(f2bf(o3)));
        }
    }
}
DI void job_router(const Params& p, const LayerW& w, int layer, int bid, int nblk) {
    const float* LOG = WSF(WS_LOG); int* EIDX = WSI(WS_EIDX); int* ESLOT = WSI(WS_ESLOT); float* EW = WSF(WS_EW);
    unsigned* cnt = WSU(WS_CTL) + CW_CNT + layer * 32;
    for (int t = bid * NT + tidx(); t < T; t += nblk * NT) {
        const float* lr = LOG + (long)t * 36;
        const float g0 = lr[0] + w.rg_b[0], g1 = lr[1] + w.rg_b[1], g2 = lr[2] + w.rg_b[2], g3 = lr[3] + w.rg_b[3];
        const float gm = fmaxf(fmaxf(g0, g1), fmaxf(g2, g3));
        const float e0 = expf(g0 - gm), e1 = expf(g1 - gm), e2 = expf(g2 - gm), e3 = expf(g3 - gm);
        const float gs = (e0 + e1) + (e2 + e3);
        const float p0 = e0 / gs, p1 = e1 / gs, p2 = e2 / gs, p3 = e3 / gs;
        int grp = 0; float pg = p0;
        if (p1 > pg) { pg = p1; grp = 1; }
        if (p2 > pg) { pg = p2; grp = 2; }
        if (p3 > pg) { pg = p3; grp = 3; }
        float el[8];
#pragma unroll
        for (int i = 0; i < 8; ++i) el[i] = lr[4 + grp * 8 + i] + w.re_b[grp * 8 + i];
        float em = el[0];
#pragma unroll
        for (int i = 1; i < 8; ++i) em = fmaxf(em, el[i]);
        float es = 0.f;
#pragma unroll
        for (int i = 0; i < 8; ++i) { el[i] = expf(el[i] - em); es += el[i]; }
#pragma unroll
        for (int i = 0; i < 8; ++i) el[i] = el[i] / es;
        float b0 = el[0]; int i0 = 0;
#pragma unroll
        for (int i = 1; i < 8; ++i) if (el[i] > b0) { b0 = el[i]; i0 = i; }
        float b1 = -1.f; int i1 = 0;
#pragma unroll
        for (int i = 0; i < 8; ++i) if (i != i0 && el[i] > b1) { b1 = el[i]; i1 = i; }
        const float den = b0 + b1;
        const int ex0 = grp * 8 + i0, ex1 = grp * 8 + i1;
        EIDX[t * 2] = ex0; EIDX[t * 2 + 1] = ex1;
        EW[t * 2] = pg * b0 / den; EW[t * 2 + 1] = pg * b1 / den;
        ESLOT[t * 2] = (int)atomicAdd(&cnt[ex0], 1u);
        ESLOT[t * 2 + 1] = (int)atomicAdd(&cnt[ex1], 1u);
    }
}
DI int pad_rows(int c) { return (c + G_BM - 1) / G_BM * G_BM; }
DI void job_fill(const Params& p, int layer, int bid, int nblk) {
    const int* EIDX = WSI(WS_EIDX); const int* ESLOT = WSI(WS_ESLOT); int* PERM = WSI(WS_PERM);
    const bf16_t* X2 = WSB(WS_XBB); bf16_t* XG = WSB(WS_XG);
    unsigned* cnt = WSU(WS_CTL) + CW_CNT + layer * 32;
    const int lane = tidx() & 63, wid = tidx() >> 6;
    for (int a = bid * (NT / 64) + wid; a < NASSIGN + NEXP; a += nblk * (NT / 64)) {
        const bool real = a < NASSIGN;
        const int e = real ? EIDX[a] : a - NASSIGN;
        int off = 0;
        for (int j = 0; j < e; ++j) off += pad_rows((int)__hip_atomic_load(&cnt[j], __ATOMIC_RELAXED, __HIP_MEMORY_SCOPE_AGENT));
        if (real) {
            const int R = off + ESLOT[a];
            if (lane == 0) PERM[R] = a;
            const u32x4* src = (const u32x4*)(X2 + (long)(a >> 1) * 1024); u32x4* dst = (u32x4*)(XG + (long)R * 1024);
            dst[lane] = src[lane]; dst[lane + 64] = src[lane + 64];
        } else {
            const int c = (int)__hip_atomic_load(&cnt[e], __ATOMIC_RELAXED, __HIP_MEMORY_SCOPE_AGENT);
            for (int j = lane; c + j < pad_rows(c); j += 64) PERM[off + c + j] = -1;
        }
    }
}
DI pg8::ListOrder moe_units(unsigned* cnt, int bid, int nblk) {
    pg8::ListOrder S; S.n = 0; S.u0 = S.u1 = S.u2 = pg8::Unit{0, 0, 0};
    int rt = 0, ub = 0;
    for (int e = 0; e < 32; ++e) {
        const int c = pad_rows((int)__hip_atomic_load(&cnt[e], __ATOMIC_RELAXED, __HIP_MEMORY_SCOPE_AGENT)) >> 8, ue = c * 4;
#pragma unroll
        for (int k = 0; k < 3; ++k) {
            const int L = bid + k * nblk;
            if (L >= ub && L < ub + ue) { const int lu = L - ub; const pg8::Unit u{rt + (lu >> 2), lu & 3, e};
                if (k == 0) S.u0 = u; else if (k == 1) S.u1 = u; else S.u2 = u;
                S.n = k + 1; }
        }
        rt += c; ub += ue;
    }
#define RFL(x) x = __builtin_amdgcn_readfirstlane(x)
    RFL(S.n); RFL(S.u0.pm); RFL(S.u0.pn); RFL(S.u0.e); RFL(S.u1.pm); RFL(S.u1.pn); RFL(S.u1.e); RFL(S.u2.pm); RFL(S.u2.pn); RFL(S.u2.e);
#undef RFL
    return S;
}
typedef short s16x4 __attribute__((ext_vector_type(4)));
typedef short v4i16_t __attribute__((ext_vector_type(4)));
DI unsigned cvtpk(float lo, float hi) { return pk_bf16(lo, hi); }
DI int crow(int reg, int h) { return (reg & 3) + 8 * (reg >> 2) + 4 * h; }
DI s16x4 tr_read(const unsigned char* p) { return __builtin_bit_cast(s16x4, __builtin_amdgcn_ds_read_tr16_b64_v4i16((LAS v4i16_t*)p)); }
DI float xhalf_max(float m) { auto rr = __builtin_amdgcn_permlane32_swap(__float_as_uint(m), __float_as_uint(m), false, false); return fmaxf(__uint_as_float(rr[0]), __uint_as_float(rr[1])); }
DI float xhalf_sum(float m) { auto rr = __builtin_amdgcn_permlane32_swap(__float_as_uint(m), __float_as_uint(m), false, false); return __uint_as_float(rr[0]) + __uint_as_float(rr[1]); }
DI float xhalf_other(float v, int h) { auto rr = __builtin_amdgcn_permlane32_swap(__float_as_uint(v), __float_as_uint(v), false, false); return __uint_as_float(h ? rr[0] : rr[1]); }
DI bf16x8 pack8(const f32x16& x, int s2) {
    u32x4 pk; pk[0] = cvtpk(x[8 * s2], x[8 * s2 + 1]); pk[1] = cvtpk(x[8 * s2 + 2], x[8 * s2 + 3]); pk[2] = cvtpk(x[8 * s2 + 4], x[8 * s2 + 5]); pk[3] = cvtpk(x[8 * s2 + 6], x[8 * s2 + 7]);
    return __builtin_bit_cast(bf16x8, pk);
}
constexpr int ATT_QB = (NT / 64) * 32;
template <int DC> struct TileCfg { static constexpr int RS = DC * 2 + 16, BYTES = 64 * RS, NCH = 64 * DC / 8, NI = (NCH + NT - 1) / NT; };
template <int DC, class RowPtr> DI void tile_gload(u32x4 (&rg)[TileCfg<DC>::NI], RowPtr rp) {
#pragma unroll
    for (int i = 0; i < TileCfg<DC>::NI; ++i) { const int c = tidx() + NT * i; if (c < TileCfg<DC>::NCH) { const int row = c / (DC / 8), cc = c % (DC / 8); rg[i] = *(const u32x4*)(rp(row) + cc * 8); } }
}
template <int DC> DI void tile_lstore(const u32x4 (&rg)[TileCfg<DC>::NI], unsigned char* base) {
#pragma unroll
    for (int i = 0; i < TileCfg<DC>::NI; ++i) { const int c = tidx() + NT * i; if (c < TileCfg<DC>::NCH) { const int row = c / (DC / 8), cc = c % (DC / 8); *(u32x4*)(base + row * TileCfg<DC>::RS + cc * 16) = rg[i]; } }
}
template <int DK> DI void qk_tile(f32x16 (&s)[2], const bf16x8 (&qf)[DK / 16], const unsigned char* kl, int r, int h) {
    constexpr int RS = TileCfg<DK>::RS;
#pragma unroll
    for (int i = 0; i < 16; ++i) { s[0][i] = 0.f; s[1][i] = 0.f; }
#pragma unroll
    for (int ks = 0; ks < DK / 16; ++ks) {
        const bf16x8 k0 = *(const bf16x8*)(kl + r * RS + ks * 32 + h * 16), k1 = *(const bf16x8*)(kl + (32 + r) * RS + ks * 32 + h * 16);
        s[0] = __builtin_amdgcn_mfma_f32_32x32x16_bf16(k0, qf[ks], s[0], 0, 0, 0);
        s[1] = __builtin_amdgcn_mfma_f32_32x32x16_bf16(k1, qf[ks], s[1], 0, 0, 0);
    }
}
template <int DV> DI void pv_tile(f32x16 (&o)[DV / 32], const f32x16 (&pp)[2], const unsigned char* vl, int lane) {
    constexpr int RS = TileCfg<DV>::RS;
    const int h = lane >> 5, i16 = lane & 15, q = i16 >> 2, pq = i16 & 3, blk = (lane >> 4) & 1;
    const unsigned char* vb = vl + (4 * h + q) * RS + 2 * (16 * blk + 4 * pq);
#pragma unroll
    for (int kt = 0; kt < 2; ++kt)
#pragma unroll
        for (int s2 = 0; s2 < 2; ++s2) {
            const bf16x8 pf = pack8(pp[kt], s2);
#pragma unroll
            for (int dvt = 0; dvt < DV / 32; ++dvt) {
                const s16x4 lo = tr_read(vb + (kt * 32 + 16 * s2) * RS + dvt * 64), hi = tr_read(vb + (kt * 32 + 16 * s2 + 8) * RS + dvt * 64);
                const bf16x8 vf = __builtin_shufflevector(lo, hi, 0, 1, 2, 3, 4, 5, 6, 7);
                o[dvt] = __builtin_amdgcn_mfma_f32_32x32x16_bf16(vf, pf, o[dvt], 0, 0, 0);
            }
        }
}
template <int DK, int DV, class MaskFn>
DI void softmax_tile(const bf16x8 (&qf)[DK / 16], f32x16 (&o)[DV / 32], float& m, float& l, const unsigned char* kl, const unsigned char* vl, int kb, MaskFn mf, int lane) {
    const int r = lane & 31, h = lane >> 5;
    f32x16 s[2];
    qk_tile<DK>(s, qf, kl, r, h);
    float tmax = -INFINITY;
#pragma unroll
    for (int kt = 0; kt < 2; ++kt)
#pragma unroll
        for (int i = 0; i < 16; ++i) { const float v = mf(kb + kt * 32 + crow(i, h), s[kt][i]); s[kt][i] = v; tmax = fmaxf(tmax, v); }
    tmax = xhalf_max(tmax);
    const float mn = fmaxf(m, tmax), corr = __expf(m - mn);
    m = mn;
    float ps = 0.f;
#pragma unroll
    for (int kt = 0; kt < 2; ++kt)
#pragma unroll
        for (int i = 0; i < 16; ++i) { const float pr = __expf(s[kt][i] - mn); s[kt][i] = pr; ps += pr; }
    l = l * corr + ps;
#pragma unroll
    for (int dvt = 0; dvt < DV / 32; ++dvt)
#pragma unroll
        for (int i = 0; i < 16; ++i) o[dvt][i] *= corr;
    pv_tile<DV>(o, s, vl, lane);
}
template <int DK, int DV, int NHQ, class KPtr, class VPtr, class MaskFn>
DI void attn_stream(const bf16x8 (&qf)[NHQ][DK / 16], f32x16 (&o)[NHQ][DV / 32], float (&m)[NHQ], float (&l)[NHQ], unsigned tmask, int wave_qmax, int wave_kmin,
                    KPtr kp, VPtr vp, MaskFn mf, unsigned char* lds) {
    unsigned char* kl = lds; unsigned char* vl = lds + TileCfg<DK>::BYTES;
    const int lane = tidx() & 63;
    u32x4 kr[TileCfg<DK>::NI], vr[TileCfg<DV>::NI];
    if (tmask) { const int j = __builtin_ctz(tmask); tile_gload<DK>(kr, [&](int row) { return kp(j * 64 + row); }); tile_gload<DV>(vr, [&](int row) { return vp(j * 64 + row); }); }
    while (tmask) {
        const int j = __builtin_ctz(tmask); tmask &= tmask - 1;
        __syncthreads();
        tile_lstore<DK>(kr, kl); tile_lstore<DV>(vr, vl);
        __syncthreads();
        if (tmask) { const int jn = __builtin_ctz(tmask); tile_gload<DK>(kr, [&](int row) { return kp(jn * 64 + row); }); tile_gload<DV>(vr, [&](int row) { return vp(jn * 64 + row); }); }
        if (j * 64 <= wave_qmax && j * 64 + 63 >= wave_kmin) {
#pragma unroll
            for (int hq = 0; hq < NHQ; ++hq) softmax_tile<DK, DV>(qf[hq], o[hq], m[hq], l[hq], kl, vl, j * 64, [&](int key, float sc) { return mf(hq, key, sc); }, lane);
        }
    }
}

DI void job_mla_attn(const Params& p, int bid, int nblk, unsigned char* lds) {
    const bf16_t* QB = WSB(WS_QB); const bf16_t* KM = WSB(WS_KM); const bf16_t* VM = WSB(WS_VM); bf16_t* BR = WSB(WS_BR);
    constexpr int NQB = SEQ / ATT_QB, NU = BATCH * 4 * NQB;
    const int lane = tidx() & 63, wid = tidx() >> 6, r = lane & 31, h = lane >> 5;
    for (int u = bid; u < NU; u += nblk) {
        const int half = u / (NU / 2), ru = u % (NU / 2);
        const int qi = ru / (BATCH * 4), bh = ru % (BATCH * 4);
        const int qblk = half == 0 ? (NQB - 1 - qi) : qi;
        const int b = bh >> 2, hd = bh & 3;
        const int q0 = qblk * ATT_QB, qw = q0 + wid * 32, qpos = qw + r;
        const long trow = (long)b * SEQ;
        bf16x8 qf[1][6];
#pragma unroll
        for (int ks = 0; ks < 6; ++ks) qf[0][ks] = *(const bf16x8*)(QB + (trow + qpos) * 384 + hd * 96 + ks * 16 + 8 * h);
        f32x16 o[1][2];
#pragma unroll
        for (int i = 0; i < 16; ++i) { o[0][0][i] = 0.f; o[0][1][i] = 0.f; }
        float m[1] = {-1e30f}, l[1] = {0.f};
        const int ntile = (q0 + ATT_QB - 1) / 64 + 1;
        const unsigned tmask = ntile >= 32 ? 0xffffffffu : ((1u << ntile) - 1u);
        attn_stream<96, 64, 1>(qf, o, m, l, tmask, qw + 31, 0,
            [&](int row) { return KM + (trow + row) * 384 + hd * 96; },
            [&](int row) { return VM + (trow + row) * 256 + hd * 64; },
            [&](int, int key, float sc) { return key <= qpos ? sc * 0.10206207261596577f : -INFINITY; }, lds);
        const float rl = 1.f / fmaxf(xhalf_sum(l[0]), 1e-30f);
        bf16_t* dst = BR + (trow + qpos) * 1024 + 3 * 256 + hd * 64;
#pragma unroll
        for (int dvt = 0; dvt < 2; ++dvt)
#pragma unroll
            for (int i = 0; i < 4; ++i)
                st4bf(dst + dvt * 32 + 8 * i + 4 * h, o[0][dvt][4 * i] * rl, o[0][dvt][4 * i + 1] * rl, o[0][dvt][4 * i + 2] * rl, o[0][dvt][4 * i + 3] * rl);
    }
}
DI void job_cross_attn(const Params& p, int layer, int bid, int nblk, unsigned char* lds) {
    const bf16_t* XQ = WSB(WS_XQ); const bf16_t* KVM = WSB(WS_KVM) + (size_t)layer * 2048 * 1024; bf16_t* XO = WSB(WS_XO);
    constexpr int NQB = SEQ / ATT_QB, NU = BATCH * 4 * NQB;
    const int lane = tidx() & 63, wid = tidx() >> 6, r = lane & 31, h = lane >> 5;
    for (int u = bid; u < NU; u += nblk) {
        const int bh = u % (BATCH * 4), qblk = u / (BATCH * 4);
        const int b = bh >> 2, hd = bh & 3;
        const int qpos = qblk * ATT_QB + wid * 32 + r;
        const long trow = (long)b * SEQ;
        bf16x8 qf[1][8];
#pragma unroll
        for (int ks = 0; ks < 8; ++ks) qf[0][ks] = *(const bf16x8*)(XQ + (trow + qpos) * 512 + hd * 128 + ks * 16 + 8 * h);
        f32x16 o[1][4];
#pragma unroll
        for (int d = 0; d < 4; ++d)
#pragma unroll
            for (int i = 0; i < 16; ++i) o[0][d][i] = 0.f;
        float m[1] = {-1e30f}, l[1] = {0.f};
        attn_stream<128, 128, 1>(qf, o, m, l, 0xFu, 1 << 30, 0,
            [&](int row) { return KVM + (long)(b * MEM_LEN + row) * 1024 + hd * 128; },
            [&](int row) { return KVM + (long)(b * MEM_LEN + row) * 1024 + 512 + hd * 128; },
            [&](int, int, float sc) { return sc * 0.08838834764831845f; }, lds);
        const float rl = 1.f / fmaxf(xhalf_sum(l[0]), 1e-30f);
        bf16_t* dst = XO + (trow + qpos) * 512 + hd * 128;
#pragma unroll
        for (int dvt = 0; dvt < 4; ++dvt)
#pragma unroll
            for (int i = 0; i < 4; ++i)
                st4bf(dst + dvt * 32 + 8 * i + 4 * h, o[0][dvt][4 * i] * rl, o[0][dvt][4 * i + 1] * rl, o[0][dvt][4 * i + 2] * rl, o[0][dvt][4 * i + 3] * rl);
    }
}
DI float logsig_fast(float z) { return fminf(z, 0.f) - __logf(1.f + __expf(-fabsf(z))); }
DI void job_sb_attn(const Params& p, int bid, int nblk, unsigned char* lds) {
    const bf16_t* H = WSB(WS_H); bf16_t* BR = WSB(WS_BR);
    constexpr int NQB = SEQ / ATT_QB, NU = BATCH * 4 * NQB;
    const int lane = tidx() & 63, wid = tidx() >> 6, r = lane & 31, h = lane >> 5;
    unsigned char* kl = lds; unsigned char* vl = lds + TileCfg<64>::BYTES;
    for (int u = bid; u < NU; u += nblk) {
        const int half = u / (NU / 2), ru = u % (NU / 2);
        const int qi = ru / (BATCH * 4), bh = ru % (BATCH * 4);
        const int qblk = half == 0 ? (NQB - 1 - qi) : qi;
        const int b = bh >> 2, hd = bh & 3;
        const int q0 = qblk * ATT_QB, qw = q0 + wid * 32, qpos = qw + r;
        const long trow = (long)b * SEQ;
        bf16x8 qf[4];
#pragma unroll
        for (int ks = 0; ks < 4; ++ks) qf[ks] = *(const bf16x8*)(H + (trow + qpos) * NH + O_BQ + hd * 64 + ks * 16 + 8 * h);
        f32x16 o[2];
#pragma unroll
        for (int i = 0; i < 16; ++i) { o[0][i] = 0.f; o[1][i] = 0.f; }
        float trun = 0.f;
        int j = (q0 + ATT_QB - 1) >> 6;
        volatile int* flag = (volatile int*)(lds + 2 * TileCfg<64>::BYTES);
        if (tidx() == 0) { flag[0] = 0; flag[1] = 0; }
        u32x4 kr[TileCfg<64>::NI], vr[TileCfg<64>::NI];
        tile_gload<64>(kr, [&](int row) { return H + (trow + j * 64 + row) * NH + O_BK + hd * 64; });
        tile_gload<64>(vr, [&](int row) { return H + (trow + j * 64 + row) * NH + O_BV + hd * 64; });
        for (int it = 0; j >= 0; --j, ++it) {
            __syncthreads();
            if (it > 0 && flag[(it - 1) & 1] == 0) break;
            tile_lstore<64>(kr, kl); tile_lstore<64>(vr, vl);
            __syncthreads();
            if (tidx() == 0) flag[(it + 1) & 1] = 0;
            if (j > 0) { const int jn = j - 1;
                tile_gload<64>(kr, [&](int row) { return H + (trow + jn * 64 + row) * NH + O_BK + hd * 64; });
                tile_gload<64>(vr, [&](int row) { return H + (trow + jn * 64 + row) * NH + O_BV + hd * 64; }); }
            const bool wave_dead = __all(trun < -110.f);
            if (j * 64 < qw + 31 && !wave_dead) {
                const int kb = j * 64;
                f32x16 s[2], L[2];
                qk_tile<64>(s, qf, kl, r, h);
#pragma unroll
                for (int kt = 0; kt < 2; ++kt)
#pragma unroll
                    for (int i = 0; i < 16; ++i) {
                        const int key = kb + kt * 32 + crow(i, h);
                        const float z = s[kt][i] * 0.125f, lsp = logsig_fast(z);
                        const bool valid = key < qpos;
                        L[kt][i] = valid ? lsp - z : 0.f;
                        s[kt][i] = valid ? lsp : -INFINITY;
                    }
                float G[2][4], O[2][4];
#pragma unroll
                for (int kt = 0; kt < 2; ++kt)
#pragma unroll
                    for (int ig = 0; ig < 4; ++ig) { G[kt][ig] = (L[kt][4 * ig] + L[kt][4 * ig + 1]) + (L[kt][4 * ig + 2] + L[kt][4 * ig + 3]); O[kt][ig] = xhalf_other(G[kt][ig], h); }
                float run = trun;
#pragma unroll
                for (int kt = 1; kt >= 0; --kt)
#pragma unroll
                    for (int ig = 3; ig >= 0; --ig) {
                        const float t3 = run + (h == 0 ? O[kt][ig] : 0.f);
                        const float t2 = t3 + L[kt][4 * ig + 3], t1 = t2 + L[kt][4 * ig + 2], t0 = t1 + L[kt][4 * ig + 1];
                        s[kt][4 * ig + 3] = __expf(s[kt][4 * ig + 3] + t3); s[kt][4 * ig + 2] = __expf(s[kt][4 * ig + 2] + t2);
                        s[kt][4 * ig + 1] = __expf(s[kt][4 * ig + 1] + t1); s[kt][4 * ig + 0] = __expf(s[kt][4 * ig + 0] + t0);
                        run += G[kt][ig] + O[kt][ig];
                    }
                trun = run;
                pv_tile<64>(o, s, vl, lane);
            }
            if (!__all(trun < -110.f)) flag[it & 1] = 1;
        }
        bf16_t* dst = BR + (trow + qpos) * 1024 + 1 * 256 + hd * 64;
#pragma unroll
        for (int dvt = 0; dvt < 2; ++dvt)
#pragma unroll
            for (int i = 0; i < 4; ++i) st4bf(dst + dvt * 32 + 8 * i + 4 * h, o[dvt][4 * i], o[dvt][4 * i + 1], o[dvt][4 * i + 2], o[dvt][4 * i + 3]);
    }
}
constexpr int NSA_QB = (NT / 128) * 32;
DI void job_nsa(const Params& p, int bid, int nblk, unsigned char* lds) {
    const bf16_t* H = WSB(WS_H); const bf16_t* KCB = WSB(WS_KCB); const bf16_t* VCB = KCB + (size_t)NCR * 64;
    float* OACC = WSF(WS_OC); bf16_t* BR = WSB(WS_BR);
    constexpr int NQB = SEQ / NSA_QB, NU = BATCH * 2 * NQB;
    constexpr int TB_ = TileCfg<64>::BYTES;
    const int lane = tidx() & 63, wid = tidx() >> 6, r = lane & 31, h = lane >> 5;
    const int n = wid & 1, sub = wid >> 1;
    unsigned* orw = (unsigned*)(lds + 4 * TB_);
    float* impx = (float*)(lds + 4 * TB_ + 64);
    for (int u = bid; u < NU; u += nblk) {
        const int qblk = NQB - 1 - u / (BATCH * 2), bg = u % (BATCH * 2), b = bg >> 1, g = bg & 1;
        const int q0 = qblk * NSA_QB, qw = q0 + sub * 32, qpos = qw + r;
        const int head = g * 2 + n;
        const long trow = (long)b * SEQ;
        const bf16_t* hq_row = H + (trow + qpos) * NH;
        bf16x8 qf[1][4];
#pragma unroll
        for (int ks = 0; ks < 4; ++ks) qf[0][ks] = *(const bf16x8*)(hq_row + O_AQ + head * 64 + ks * 16 + 8 * h);
        const float sl = exp2f(-2.f * (float)(head + 1));
        const float gate0 = sigm(bf2f(hq_row[O_AG + head * 3 + 0])), gate1 = sigm(bf2f(hq_row[O_AG + head * 3 + 1])), gate2 = sigm(bf2f(hq_row[O_AG + head * 3 + 2]));
        float* oacc = OACC + (trow + qpos) * 256 + head * 64;
        __syncthreads();
        if (tidx() == 0) *orw = 0u;
        {
            u32x4 rg[TileCfg<64>::NI];
#pragma unroll
            for (int tl = 0; tl < 4; ++tl) {
                const bf16_t* src = (tl & 2) ? VCB : KCB; const int cb = (tl & 1) * 64;
                tile_gload<64>(rg, [&](int row) { const int c = cb + row < NCMP ? cb + row : NCMP - 1; return src + ((long)(b * NCMP + c) * 2 + g) * 64; });
                tile_lstore<64>(rg, lds + tl * TB_);
            }
        }
        __syncthreads();
        float imp[16];
        {
            f32x16 s[2][2];
            qk_tile<64>(s[0], qf[0], lds, r, h);
            qk_tile<64>(s[1], qf[0], lds + TB_, r, h);
            float tmax = -INFINITY;
#pragma unroll
            for (int tl = 0; tl < 2; ++tl)
#pragma unroll
                for (int kt = 0; kt < 2; ++kt)
#pragma unroll
                    for (int i = 0; i < 16; ++i) {
                        const int c = tl * 64 + kt * 32 + crow(i, h), dist = qpos - (16 * c + 31);
                        const float v = (c < NCMP && dist >= 0) ? s[tl][kt][i] * 0.125f - sl * (float)dist : -INFINITY;
                        s[tl][kt][i] = v; tmax = fmaxf(tmax, v);
                    }
            const float mn = fmaxf(xhalf_max(tmax), -1e30f);
            float ps = 0.f;
#pragma unroll
            for (int tl = 0; tl < 2; ++tl)
#pragma unroll
                for (int kt = 0; kt < 2; ++kt)
#pragma unroll
                    for (int i = 0; i < 16; ++i) { const float pr = __expf(s[tl][kt][i] - mn); s[tl][kt][i] = pr; ps += pr; }
            const float rl = 1.f / fmaxf(xhalf_sum(ps), 1e-30f);
            float P3[16];
#pragma unroll
            for (int tl = 0; tl < 2; ++tl)
#pragma unroll
                for (int kt = 0; kt < 2; ++kt) {
#pragma unroll
                    for (int ig = 0; ig < 4; ++ig) {
                        const float p0 = s[tl][kt][4 * ig] * rl, p1 = s[tl][kt][4 * ig + 1] * rl, p2 = s[tl][kt][4 * ig + 2] * rl, p3 = s[tl][kt][4 * ig + 3] * rl;
                        imp[tl * 8 + kt * 4 + ig] = (p0 + p1) + (p2 + 0.5f * p3);
                        P3[tl * 8 + kt * 4 + ig] = 0.5f * p3;
                    }
                    const float gs = rl * gate0;
#pragma unroll
                    for (int i = 0; i < 16; ++i) s[tl][kt][i] *= gs;
                }
#pragma unroll
            for (int idx = 0; idx < 16; ++idx) {
                const float pp = xhalf_other(P3[idx], h);
                float prevp;
                if (idx == 0) prevp = h ? pp : 0.f; else { const float ppm = xhalf_other(P3[idx - 1], h); prevp = h ? pp : ppm; }
                imp[idx] += prevp;
                impx[(wid * 16 + idx) * 64 + lane] = imp[idx];
            }
            f32x16 oc[2];
#pragma unroll
            for (int i = 0; i < 16; ++i) { oc[0][i] = 0.f; oc[1][i] = 0.f; }
            pv_tile<64>(oc, s[0], lds + 2 * TB_, lane);
            pv_tile<64>(oc, s[1], lds + 3 * TB_, lane);
#pragma unroll
            for (int dvt = 0; dvt < 2; ++dvt)
#pragma unroll
                for (int i = 0; i < 4; ++i) *(float4*)(oacc + dvt * 32 + 8 * i + 4 * h) = make_float4(oc[dvt][4 * i], oc[dvt][4 * i + 1], oc[dvt][4 * i + 2], oc[dvt][4 * i + 3]);
        }
        __syncthreads();
        unsigned sel = 0u;
        {
            const int cur = qpos >> 6;
#pragma unroll
            for (int idx = 0; idx < 16; ++idx) {
                const float other = impx[((wid ^ 1) * 16 + idx) * 64 + lane];
                const float tot = n == 0 ? imp[idx] + other : other + imp[idx];
                const int j = 2 * idx + h;
                const bool forced = (j == 0) || (j == cur), valid = (j * 64 <= qpos);
                imp[idx] = forced ? 1e4f : (valid ? tot : -1.0f);
            }
#pragma unroll 1
            for (int it = 0; it < 8; ++it) {
                float best = -INFINITY; int bj = 64;
#pragma unroll
                for (int idx = 0; idx < 16; ++idx) if (imp[idx] > best) { best = imp[idx]; bj = 2 * idx + h; }
                const float pb = xhalf_other(best, h); const int pj = __float_as_int(xhalf_other(__int_as_float(bj), h));
                const bool own = (best > pb) || (best == pb && bj < pj);
                const int wj = own ? bj : pj;
                sel |= 1u << wj;
#pragma unroll
                for (int idx = 0; idx < 16; ++idx) if (2 * idx + h == wj) imp[idx] = -INFINITY;
            }
        }
        atomicOr(orw, sel);
        __syncthreads();
        const unsigned bmask = *orw;
        const int jhi = (q0 + NSA_QB - 1) >> 6;
        const unsigned upto = jhi >= 31 ? 0xffffffffu : ((1u << (jhi + 1)) - 1u);
        {
            f32x16 o[1][2];
#pragma unroll
            for (int i = 0; i < 16; ++i) { o[0][0][i] = 0.f; o[0][1][i] = 0.f; }
            float m[1] = {-1e30f}, l[1] = {0.f};
            const int jlo = (q0 - 511 > 0 ? q0 - 511 : 0) >> 6;
            const unsigned tmask = upto & ~((1u << jlo) - 1u);
            attn_stream<64, 64, 1>(qf, o, m, l, tmask, qw + 31, qw - 511,
                [&](int row) { return H + (trow + row) * NH + O_AKW + g * 64; },
                [&](int row) { return H + (trow + row) * NH + O_AVW + g * 64; },
                [&](int, int key, float sc) { const int dist = qpos - key; return (dist >= 0 && dist < 512) ? sc * 0.125f - sl * (float)dist : -INFINITY; }, lds);
            const float rl = gate2 / fmaxf(xhalf_sum(l[0]), 1e-30f);
#pragma unroll
            for (int dvt = 0; dvt < 2; ++dvt)
#pragma unroll
                for (int i = 0; i < 4; ++i) { float4* a = (float4*)(oacc + dvt * 32 + 8 * i + 4 * h); float4 c = *a;
                    c.x += o[0][dvt][4 * i] * rl; c.y += o[0][dvt][4 * i + 1] * rl; c.z += o[0][dvt][4 * i + 2] * rl; c.w += o[0][dvt][4 * i + 3] * rl; *a = c; }
        }
        {
            f32x16 o[1][2];
#pragma unroll
            for (int i = 0; i < 16; ++i) { o[0][0][i] = 0.f; o[0][1][i] = 0.f; }
            float m[1] = {-1e30f}, l[1] = {0.f};
            attn_stream<64, 64, 1>(qf, o, m, l, bmask & upto, qw + 31, 0,
                [&](int row) { return H + (trow + row) * NH + O_AKS + g * 64; },
                [&](int row) { return H + (trow + row) * NH + O_AVS + g * 64; },
                [&](int, int key, float sc) { const int dist = qpos - key; return (dist >= 0 && ((sel >> (key >> 6)) & 1u)) ? sc * 0.125f - sl * (float)dist : -INFINITY; }, lds);
            const float rl = gate1 / fmaxf(xhalf_sum(l[0]), 1e-30f);
            bf16_t* dst = BR + (trow + qpos) * 1024 + head * 64;
#pragma unroll
            for (int dvt = 0; dvt < 2; ++dvt)
#pragma unroll
                for (int i = 0; i < 4; ++i) { const float4 c = *(const float4*)(oacc + dvt * 32 + 8 * i + 4 * h);
                    st4bf(dst + dvt * 32 + 8 * i + 4 * h, c.x + o[0][dvt][4 * i] * rl, c.y + o[0][dvt][4 * i + 1] * rl, c.z + o[0][dvt][4 * i + 2] * rl, c.w + o[0][dvt][4 * i + 3] * rl); }
        }
    }
}
namespace pg8 { typedef PG8_LAS unsigned char* PG8_LAS_T; }
#define LDS3 ((pg8::PG8_LAS_T)lds)
#define GEMM256(EPI, SCHED, g, S, E) do { __syncthreads(); pg8::gemm_phase<EPI, SCHED, false, true>(LDS3, g, S, E); } while (0)
constexpr int NPH = 18;
constexpr int NPHASES = 2 + DEPTH * NPH;

__global__ void __launch_bounds__(NT, 2) mega(Params pk, int ph_lo, int ph_hi) {
    extern __shared__ __attribute__((aligned(16))) unsigned char lds[];
    const int bid = blockIdx.x, nblk = gridDim.x;
#define XB_HERE XcdBarrier bar_; bar_.bar = (unsigned*)(pk.ws + WS_CTL) + CW_BAR; bar_.x = xb_xcc_id(); bar_.st = (volatile LAS unsigned*)(lds + 131072)
    const bool multi = (ph_hi - ph_lo) > 1;
    if (multi) {
        uint4* xbw = (uint4*)(lds + 131072);
        if (tidx() == 0) *xbw = make_uint4(0u, 0u, 0u, 0u);
        __syncthreads();
        (void)xcd_barrier_post((unsigned*)(pk.ws + WS_CTL) + CW_BAR, (volatile LAS unsigned*)xbw);
    }
#ifndef PROBE_PH
#define PROBE_PH -100
#endif
#define PHASE(id, ...) do { const int _id = (id); if (ph_lo <= _id && _id < ph_hi) { for (int _rep = 0; _rep < ((PROBE_PH == -1 ? _id < 2 : (_id >= 2 && (_id - 2) % NPH == PROBE_PH)) ? 2 : 1); ++_rep) { if (_rep) { XB_HERE; xcd_barrier(bar_); } { Params p = pk; int layer = layer_; asm volatile("" : "+s"(p.ws), "+s"(p.out), "+s"(layer)); \
        const LayerW w = layer_w(p, layer); const float* Xin = (layer == 0) ? p.in[0] : WSF(WS_XC); const bf16_t* XinB = (layer == 0) ? WSB(WS_X0B) : WSB(WS_XCB); float* Xout = (layer == DEPTH - 1) ? p.out : WSF(WS_XC); \
        (void)w; (void)Xin; (void)XinB; (void)Xout; __VA_ARGS__; } } if (_id + 1 < ph_hi) { XB_HERE; xcd_barrier(bar_); } } } while (0)

    { const int layer_ = 0;
    PHASE(0, {
        job_wt<2>(p.in[2], DEPTH, 1024, NIN, WSB(WT_IN), NH, bid, nblk, lds);
        job_wt<0>(p.in[17], DEPTH * 4, 256, 1024, WSB(WT_BR), 1024, bid, nblk, lds);
        job_wt<0>(p.in[18], DEPTH, 1024, 1024, WSB(WT_OUT), 1024, bid, nblk, lds);
        job_wt<0>(p.in[21], DEPTH, 1024, 512, WSB(WT_Q), 512, bid, nblk, lds);
        job_wt<0>(p.in[22], DEPTH, 1024, 1024, WSB(WT_KV), 1024, bid, nblk, lds);
        job_wt<0>(p.in[23], DEPTH, 512, 1024, WSB(WT_O), 1024, bid, nblk, lds);
        job_wt<1>(p.in[30], DEPTH * 32, 1024, 1024, WSB(WT_GU), 1024, bid, nblk, lds);
        job_wt<0>(p.in[31], DEPTH * 32, 512, 1024, WSB(WT_DN), 1024, bid, nblk, lds);
        job_wt<0>(p.in[4], DEPTH * 2, 2048, 256, WSB(WT_C1), 256, bid, nblk, lds);
        job_wt<0>(p.in[5], DEPTH * 2, 256, 64, WSB(WT_C2), 128, bid, nblk, lds);
        job_wt<0>(p.in[15], DEPTH, 192, 384, WSB(WT_UQ), 384, bid, nblk, lds);
        job_wt<0>(p.in[16], DEPTH, 128, 512, WSB(WT_UKV), 512, bid, nblk, lds);
        job_pack_small(p, bid, nblk);
        job_cvt(p.in[0], WSB(WS_X0B), (long)T * 1024, bid, nblk);
        job_cvt(p.in[1], WSB(WS_MEMB), (long)2048 * 1024, bid, nblk);
    });
    PHASE(1, {
        pg8::Gemm g{WSB(WS_MEMB), WSB(WT_KV), BATCH * MEM_LEN, 1024, 1024};
        GroupedOrder S{8, 4, DEPTH, nblk, bid};
        EpiStoreBf16 E{WSB(WS_KVM), 1024, 1 << 30, (long)2048 * 1024};
        GEMM256(EpiStoreBf16, GroupedOrder, g, S, E);
    });
    }
    for (int layer_ = 0; layer_ < DEPTH; ++layer_) {
        const int base = 2 + layer_ * NPH;
        PHASE(base + 0, { pg8::Gemm g{XinB, w.t_in, T, NH, 1024}; pg8::StaticOrder S; S.init(T, NH, nblk, bid); EpiStoreBf16 E{WSB(WS_H), NH, O_MG / 128, 0}; GEMM256(EpiStoreBf16, pg8::StaticOrder, g, S, E); });
        PHASE(base + 1, { job_sb_attn(p, bid, nblk, lds); job_cmp_gather(p, w, bid, nblk); job_rnn_conv(p, w, bid, nblk); job_mla_norm(p, w, bid, nblk); });
        PHASE(base + 2, { job_cmp_mlp<0>(p, w, bid, nblk, lds); job_rnn_gates(p, w, bid, nblk, lds); job_mla_up(p, w, bid, nblk, lds); });
        PHASE(base + 3, { job_cmp_mlp<1>(p, w, bid, nblk, lds); job_rnn_scan1(p, bid, nblk); });
        PHASE(base + 4, { job_nsa(p, bid, nblk, lds); job_mla_attn(p, bid, nblk, lds); job_rnn_scan2(p, bid, nblk); });
        PHASE(base + 5, { job_merge(p, w, bid, nblk, lds); });
        PHASE(base + 6, { pg8::Gemm g{WSB(WS_M), w.t_out, T, 1024, 1024}; pg8::StaticOrder S; S.init(T, 1024, nblk, bid); EpiStoreBf16 E{WSB(WS_Y), 1024, 1 << 30, 0}; GEMM256(EpiStoreBf16, pg8::StaticOrder, g, S, E); });
        PHASE(base + 7, { job_ln(Xin, WSB(WS_Y), 1024, nullptr, w.ln1_g, w.ln1_b, WSF(WS_XA), WSB(WS_XAB), nullptr, bid, nblk); });
        PHASE(base + 8, { pg8::Gemm g{WSB(WS_XAB), w.t_q, T, 512, 1024}; pg8::StaticOrder S; S.init(T, 512, nblk, bid); EpiStoreBf16 E{WSB(WS_XQ), 512, 1 << 30, 0}; GEMM256(EpiStoreBf16, pg8::StaticOrder, g, S, E); });
        PHASE(base + 9, { job_cross_attn(p, layer, bid, nblk, lds); });
        PHASE(base + 10, { pg8::Gemm g{WSB(WS_XO), w.t_o, T, 1024, 512}; pg8::StaticOrder S; S.init(T, 1024, nblk, bid); EpiStoreBf16 E{WSB(WS_Y), 1024, 1 << 30, 0}; GEMM256(EpiStoreBf16, pg8::StaticOrder, g, S, E); });
        PHASE(base + 11, { job_ln(WSF(WS_XA), WSB(WS_Y), 1024, nullptr, w.ln2_g, w.ln2_b, WSF(WS_XB), WSB(WS_XBB), WSB(WS_XBL), bid, nblk); });
        PHASE(base + 12, { job_router_logits(p, w, bid, nblk, lds); });
        PHASE(base + 13, { job_router(p, w, layer, bid, nblk); });
        PHASE(base + 14, { job_fill(p, layer, bid, nblk); });
        PHASE(base + 15, { const pg8::ListOrder S = moe_units(WSU(WS_CTL) + CW_CNT + layer * 32, bid, nblk); pg8::Gemm g{WSB(WS_XG), w.t_gu, PADROWS, 1024, 1024}; EpiMoeGU E{WSB(WS_HH)}; GEMM256(EpiMoeGU, pg8::ListOrder, g, S, E); });
        PHASE(base + 16, { const pg8::ListOrder S = moe_units(WSU(WS_CTL) + CW_CNT + layer * 32, bid, nblk); pg8::Gemm g{WSB(WS_HH), w.t_dn, PADROWS, 1024, 512}; EpiMoeDown E{WSI(WS_PERM), WSF(WS_EW), WSB(WS_YK)}; GEMM256(EpiMoeDown, pg8::ListOrder, g, S, E); });
        PHASE(base + 17, { job_ln(WSF(WS_XB), WSB(WS_YK), 2048, WSB(WS_YK) + 1024, w.ln3_g, w.ln3_b, Xout, (layer == DEPTH - 1) ? nullptr : WSB(WS_XCB), nullptr, bid, nblk); });
    }
}

extern "C" void kernel_launch(void* const* d_in, const int* in_sizes, int n_in, void* d_out, int out_size, void* d_ws, size_t ws_size, hipStream_t stream) {
    constexpr size_t kDynLds = 131072 + 1024;
    static_assert(2 * G_STAGE + 1024 <= 131072, "engine stages fit");
    static int grid = 0;
    if (!grid) {
        int dev = 0, cus = 0, per_cu = 0;
        (void)hipGetDevice(&dev);
        (void)hipDeviceGetAttribute(&cus, hipDeviceAttributeMultiprocessorCount, dev);
        (void)hipFuncSetAttribute((const void*)mega, hipFuncAttributeMaxDynamicSharedMemorySize, (int)kDynLds);
        (void)hipOccupancyMaxActiveBlocksPerMultiprocessor(&per_cu, mega, NT, kDynLds);
        if (per_cu < 1) per_cu = 1;
        grid = cus * (per_cu < 2 ? per_cu : 2);
    }
    if (ws_size < WS_END) { fprintf(stderr, "workspace too small: %zu < %zu\n", ws_size, (size_t)WS_END); return; }
    Params p{};
    for (int i = 0; i < 34; ++i) p.in[i] = (const float*)d_in[i];
    p.out = (float*)d_out;
    p.ws = (unsigned char*)d_ws;
    (void)hipMemsetAsync(d_ws, 0, CTL_BYTES, stream);
#if MK_ONE_LAUNCH
    hipLaunchKernelGGL(mega, dim3(grid), dim3(NT), kDynLds, stream, p, 0, NPHASES);
#else
    for (int ph = 0; ph < NPHASES; ++ph) hipLaunchKernelGGL(mega, dim3(grid), dim3(NT), kDynLds, stream, p, ph, ph + 1);
#endif
}
```

```cpp
#include <hip/hip_runtime.h>
#include <stdint.h>
#include <stdio.h>

#ifndef MK_ONE_LAUNCH
#define MK_ONE_LAUNCH 1
#endif

#define DI __device__ __forceinline__
#define LAS __attribute__((address_space(3)))
DI int tidx() { int t = threadIdx.x; asm volatile("" : "+v"(t)); return t; }

constexpr int NT = 512;
constexpr int D = 1024, BATCH = 8, SEQ = 2048, T = BATCH * SEQ, DEPTH = 4;
constexpr int MEM_LEN = 256;
constexpr int NIN = 6764, NH = 6912;
constexpr int O_AQ = 0, O_AKC = 256, O_AVC = 384, O_AKS = 512, O_AVS = 640, O_AKW = 768, O_AVW = 896,
              O_BQ = 1024, O_BK = 1280, O_BV = 1536, O_CX = 1792, O_CG = 2048, O_DCQ = 2304, O_DCKV = 2496, O_DKR = 2624,
              O_AG = 2656, O_MG = 2688;
constexpr int NCMP = 127, NCR = BATCH * NCMP * 2;
constexpr int NEXP = 32, NASSIGN = T * 2;
constexpr float DN_ALPHA = 1.681792830507429f;

typedef unsigned short bf16_t;
typedef short bf16x8 __attribute__((ext_vector_type(8)));
typedef float f32x16 __attribute__((ext_vector_type(16)));
typedef unsigned u32x4 __attribute__((ext_vector_type(4)));

constexpr int G_WM = NT / 128;
constexpr int G_BM = 64 * G_WM;
constexpr int G_BN = 128;
constexpr int G_RS = 144;
constexpr int G_STAGE = (G_BM + G_BN) * G_RS;
constexpr int PADROWS = ((NASSIGN + NEXP * (G_BM - 1) + G_BM - 1) / G_BM) * G_BM;

constexpr size_t MiB = 1u << 20;
constexpr size_t al(size_t x) { return (x + 255) & ~(size_t)255; }
constexpr size_t WS_CTL = 0, CTL_BYTES = 1 * MiB;
constexpr size_t WT_IN = WS_CTL + CTL_BYTES;
constexpr size_t WT_BR = WT_IN + al((size_t)DEPTH * NH * 1024 * 2);
constexpr size_t WT_OUT = WT_BR + al((size_t)DEPTH * 4 * 1024 * 256 * 2);
constexpr size_t WT_Q = WT_OUT + al((size_t)DEPTH * 1024 * 1024 * 2);
constexpr size_t WT_KV = WT_Q + al((size_t)DEPTH * 512 * 1024 * 2);
constexpr size_t WT_O = WT_KV + al((size_t)DEPTH * 1024 * 1024 * 2);
constexpr size_t WT_GU = WT_O + al((size_t)DEPTH * 1024 * 512 * 2);
constexpr size_t WT_DN = WT_GU + al((size_t)DEPTH * 32 * 1024 * 1024 * 2);
constexpr size_t WS_X0B = WT_DN + al((size_t)DEPTH * 32 * 1024 * 512 * 2);
constexpr size_t WS_MEMB = WS_X0B + al((size_t)T * 1024 * 2);
constexpr size_t WS_H = WS_MEMB + al((size_t)2048 * 1024 * 2);
constexpr size_t SZ_H = al((size_t)T * NH * 2);
constexpr size_t WS_YK = WS_H;
constexpr size_t WS_HH = WS_YK + (size_t)NASSIGN * 1024 * 2;
static_assert(WS_HH + (size_t)PADROWS * 512 * 2 <= WS_H + SZ_H, "moe overlay fits in H");
constexpr size_t WS_TB = WS_H + SZ_H;
constexpr size_t WS_HID = WS_TB + al((size_t)2 * NCR * 2048 * 4);
constexpr size_t WS_KCVC = WS_HID + al((size_t)2 * NCR * 256 * 4);
constexpr size_t WS_PC = WS_KCVC + al((size_t)2 * NCR * 64 * 4);
constexpr size_t WS_SEL = WS_PC + al((size_t)BATCH * 4 * SEQ * 128 * 4);
constexpr size_t WS_OW = WS_SEL + al((size_t)BATCH * 2 * SEQ * 4);
constexpr size_t WS_OC = WS_OW + al((size_t)T * 256 * 4);
constexpr size_t WS_BR = WS_OC + al((size_t)T * 256 * 4);
constexpr size_t WS_U = WS_BR + al((size_t)T * 1024 * 2);
constexpr size_t WS_RA = WS_U + al((size_t)T * 256 * 4);
constexpr size_t WS_RB = WS_RA + al((size_t)T * 256 * 4);
constexpr size_t WS_CQN = WS_RB + al((size_t)T * 256 * 4);
constexpr size_t WS_CKVN = WS_CQN + al((size_t)T * 192 * 4);
constexpr size_t WS_KR = WS_CKVN + al((size_t)T * 128 * 4);
constexpr size_t WS_Q = WS_KR + al((size_t)T * 32 * 4);
constexpr size_t WS_KV = WS_Q + al((size_t)T * 384 * 4);
constexpr size_t WS_M = WS_KV + al((size_t)T * 512 * 4);
constexpr size_t WS_Y = WS_M + al((size_t)T * 1024 * 2);
constexpr size_t WS_XA = WS_Y + al((size_t)T * 1024 * 4);
constexpr size_t WS_XB = WS_XA + al((size_t)T * 1024 * 4);
constexpr size_t WS_XC = WS_XB + al((size_t)T * 1024 * 4);
constexpr size_t WS_XAB = WS_XC + al((size_t)T * 1024 * 4);
constexpr size_t WS_XBB = WS_XAB + al((size_t)T * 1024 * 2);
constexpr size_t WS_XCB = WS_XBB + al((size_t)T * 1024 * 2);
constexpr size_t WS_XQ = WS_XCB + al((size_t)T * 1024 * 2);
constexpr size_t WS_XO = WS_XQ + al((size_t)T * 512 * 2);
constexpr size_t WS_KVM = WS_XO + al((size_t)T * 512 * 2);
constexpr size_t WS_LOG = WS_KVM + al((size_t)DEPTH * 2048 * 1024 * 2);
constexpr size_t WS_EIDX = WS_LOG + al((size_t)3 * T * 36 * 4);
constexpr size_t WS_ESLOT = WS_EIDX + al((size_t)NASSIGN * 4);
constexpr size_t WS_EW = WS_ESLOT + al((size_t)NASSIGN * 4);
constexpr size_t WS_PERM = WS_EW + al((size_t)NASSIGN * 4);
constexpr size_t WS_QB = WS_PERM + al((size_t)PADROWS * 4);
constexpr size_t WS_KM = WS_QB + al((size_t)T * 384 * 2);
constexpr size_t WS_VM = WS_KM + al((size_t)T * 384 * 2);
constexpr size_t WS_KCB = WS_VM + al((size_t)T * 256 * 2);
constexpr size_t WT_C1 = WS_KCB + al((size_t)2 * NCR * 64 * 2);
constexpr size_t WT_C2 = WT_C1 + al((size_t)DEPTH * 2 * 256 * 2048 * 2);
constexpr size_t WT_UQ = WT_C2 + al((size_t)DEPTH * 2 * 128 * 256 * 2);
constexpr size_t WT_UKV = WT_UQ + al((size_t)DEPTH * 384 * 192 * 2);
constexpr size_t WT_G = WT_UKV + al((size_t)DEPTH * 512 * 128 * 2);
constexpr size_t WT_RH = WT_G + al((size_t)DEPTH * 4 * 128 * 64 * 2);
constexpr size_t WT_RL = WT_RH + al((size_t)DEPTH * 128 * 1024 * 2);
constexpr size_t WS_TBB = WT_RL + al((size_t)DEPTH * 128 * 1024 * 2);
constexpr size_t WS_HIDB = WS_TBB + al((size_t)2 * 2048 * 2048 * 2);
constexpr size_t WS_UB = WS_HIDB + al((size_t)2 * 2048 * 256 * 2);
constexpr size_t WS_CQNB = WS_UB + al((size_t)T * 256 * 2);
constexpr size_t WS_CKVNB = WS_CQNB + al((size_t)T * 192 * 2);
constexpr size_t WS_XBL = WS_CKVNB + al((size_t)T * 128 * 2);
constexpr size_t WS_SA = WS_XBL + al((size_t)T * 1024 * 2);
constexpr size_t WS_SH = WS_SA + al((size_t)BATCH * 32 * 256 * 4);
constexpr size_t WS_XG = WS_SH + al((size_t)BATCH * 32 * 256 * 4);
constexpr size_t WS_END = WS_XG + al((size_t)PADROWS * 1024 * 2);

constexpr int CW_BAR = 4096;
constexpr int CW_CNT = 16384;

struct Params {
    const float* in[34];
    float* out;
    unsigned char* ws;
};

#define XB_TMO      128
#define XB_XCNT(j)  (256  + 64 * (j))
#define XB_XSUB(j)  (1280 + 64 * (j))
#define XB_XGEN(j)  (2304 + 64 * (j))
#define XB_TOP      3328
#define XB_TOPGEN   3392
#define XCD_BAR_WORDS 3456
#define XB_SPIN_CAP (1u << 22)

__device__ __forceinline__ unsigned xb_ld(unsigned* p)              { return __hip_atomic_load(p, __ATOMIC_RELAXED, __HIP_MEMORY_SCOPE_AGENT); }
__device__ __forceinline__ unsigned xb_add(unsigned* p, unsigned v) { return __hip_atomic_fetch_add(p, v, __ATOMIC_RELAXED, __HIP_MEMORY_SCOPE_AGENT); }
__device__ __forceinline__ unsigned xb_xcc_id() { return (unsigned)__builtin_amdgcn_s_getreg((3 << 11) | 20) & 0xFu; }
#define XB_SPIN(cond, bar) do { unsigned _sp = 0; while (cond) { __builtin_amdgcn_s_sleep(1); \
    if ((++_sp & 255u) == 0u) { if (xb_ld(&(bar)[XB_TMO])) break; if (_sp > XB_SPIN_CAP) { atomicAdd(&(bar)[XB_TMO], 1u); break; } } } } while (0)

struct XcdBarrier { unsigned* bar; unsigned x; volatile LAS unsigned* st; };

__device__ __forceinline__ XcdBarrier xcd_barrier_post(unsigned* bar, volatile LAS unsigned* st) {
    XcdBarrier b; b.bar = bar; b.x = xb_xcc_id(); b.st = st;
    if (threadIdx.x == 0) (void)xb_add(&bar[XB_XCNT(b.x)], 1u);
    return b;
}
__device__ __forceinline__ void xcd_barrier_complete(unsigned* bar, unsigned x, unsigned& nloc, unsigned& nx) {
    const unsigned G = gridDim.x * gridDim.y * gridDim.z;
    unsigned sum, cnt, mine, sp = 0u;
    for (;;) {
        sum = 0u; cnt = 0u; mine = 0u;
#pragma unroll
        for (unsigned j = 0; j < 16; ++j) { const unsigned c = xb_ld(&bar[XB_XCNT(j)]); sum += c; cnt += (c > 0u) ? 1u : 0u; mine = (j == x) ? c : mine; }
        if (sum == G) break;
        __builtin_amdgcn_s_sleep(1);
        if ((++sp & 255u) == 0u) { if (xb_ld(&bar[XB_TMO])) break; if (sp > XB_SPIN_CAP) { atomicAdd(&bar[XB_TMO], 1u); break; } }
    }
    nloc = mine > 0u ? mine : 1u; nx = cnt > 0u ? cnt : 1u;
}
__device__ __forceinline__ void xcd_barrier(const XcdBarrier& b) {
    asm volatile("s_waitcnt vmcnt(0)" ::: "memory");
    __syncthreads();
    if (threadIdx.x == 0) {
        unsigned* bar = b.bar;
        __builtin_amdgcn_s_waitcnt(0);
        unsigned nloc = b.st[0], nx = b.st[1];
        if (nloc == 0u) { xcd_barrier_complete(bar, b.x, nloc, nx); b.st[0] = nloc; b.st[1] = nx; }
        const unsigned old = xb_add(&bar[XB_XSUB(b.x)], 1u);
        const unsigned gen = old / nloc;
        if (old + 1u == (gen + 1u) * nloc) {
            __builtin_amdgcn_fence(__ATOMIC_RELEASE, "agent");
            asm volatile("s_waitcnt vmcnt(0)" ::: "memory");
            const unsigned og = xb_add(&bar[XB_TOP], 1u);
            const unsigned tg = og / nx;
            if (og + 1u == (tg + 1u) * nx) xb_add(&bar[XB_TOPGEN], 1u);
            else XB_SPIN(xb_ld(&bar[XB_TOPGEN]) == tg, bar);
            __builtin_amdgcn_fence(__ATOMIC_ACQUIRE, "agent");
            xb_add(&bar[XB_XGEN(b.x)], 1u);
            asm volatile("s_waitcnt vmcnt(0)" ::: "memory");
        } else {
            XB_SPIN(xb_ld(&bar[XB_XGEN(b.x)]) == gen, bar);
            __builtin_amdgcn_fence(__ATOMIC_ACQUIRE, "agent");
            asm volatile("s_waitcnt vmcnt(0)" ::: "memory");
        }
    }
    __syncthreads();
}

DI float gelu_tanh(float x) { const float u = 0.7978845608028654f * (x + 0.044715f * x * x * x); return 0.5f * x * (1.f + tanhf(u)); }
DI float sigm(float x) { return 1.f / (1.f + expf(-x)); }
DI float sigm_fast(float x) { return __builtin_amdgcn_rcpf(1.f + __expf(-x)); }
DI float logsig(float z) { return fminf(z, 0.f) - log1pf(expf(-fabsf(z))); }
DI float wave_sum(float v) {
    const int lane = tidx() & 63;
#pragma unroll
    for (int o = 32; o > 0; o >>= 1) v += __int_as_float(__builtin_amdgcn_ds_bpermute((lane ^ o) << 2, __float_as_int(v)));
    return v;
}

DI float bflo(unsigned u) { return __uint_as_float(u << 16); }
DI float bfhi(unsigned u) { return __uint_as_float(u & 0xffff0000u); }
DI float bf2f(bf16_t x) { return __uint_as_float((unsigned)x << 16); }
typedef float f32x2_t __attribute__((ext_vector_type(2)));
typedef __bf16 bf16x2_t __attribute__((ext_vector_type(2)));
DI unsigned pk_bf16(float lo, float hi) { f32x2_t v = {lo, hi}; bf16x2_t b = __builtin_convertvector(v, bf16x2_t); return __builtin_bit_cast(unsigned, b); }
DI bf16_t f2bf(float x) { return (bf16_t)(pk_bf16(x, 0.f) & 0xffffu); }
DI void st4bf(bf16_t* p, float a, float b, float c, float d) { uint2 v; v.x = pk_bf16(a, b); v.y = pk_bf16(c, d); *(uint2*)p = v; }
DI float4 ld4bf(const bf16_t* p) { const uint2 v = *(const uint2*)p; return make_float4(bflo(v.x), bfhi(v.x), bflo(v.y), bfhi(v.y)); }
template <int N> DI float dot_row(const float* q, const bf16_t* kr) {
    float dot = 0.f;
#pragma unroll
    for (int d = 0; d < N; d += 8) { const uint4 v = *(const uint4*)(kr + d);
        dot = fmaf(q[d], bflo(v.x), dot); dot = fmaf(q[d + 1], bfhi(v.x), dot); dot = fmaf(q[d + 2], bflo(v.y), dot); dot = fmaf(q[d + 3], bfhi(v.y), dot);
        dot = fmaf(q[d + 4], bflo(v.z), dot); dot = fmaf(q[d + 5], bfhi(v.z), dot); dot = fmaf(q[d + 6], bflo(v.w), dot); dot = fmaf(q[d + 7], bfhi(v.w), dot); }
    return dot;
}
template <int N> DI float dot_row(const float* q, const float* kr) {
    float dot = 0.f;
#pragma unroll
    for (int d = 0; d < N; ++d) dot = fmaf(q[d], kr[d], dot);
    return dot;
}
template <int N> DI void axpy_row(float* o, float pr, float corr, const bf16_t* vr) {
#pragma unroll
    for (int d = 0; d < N; d += 8) { const uint4 v = *(const uint4*)(vr + d);
        o[d] = fmaf(pr, bflo(v.x), o[d] * corr); o[d + 1] = fmaf(pr, bfhi(v.x), o[d + 1] * corr); o[d + 2] = fmaf(pr, bflo(v.y), o[d + 2] * corr); o[d + 3] = fmaf(pr, bfhi(v.y), o[d + 3] * corr);
        o[d + 4] = fmaf(pr, bflo(v.z), o[d + 4] * corr); o[d + 5] = fmaf(pr, bfhi(v.z), o[d + 5] * corr); o[d + 6] = fmaf(pr, bflo(v.w), o[d + 6] * corr); o[d + 7] = fmaf(pr, bfhi(v.w), o[d + 7] * corr); }
}
template <int N> DI void axpy_row(float* o, float pr, float corr, const float* vr) {
#pragma unroll
    for (int d = 0; d < N; ++d) o[d] = fmaf(pr, vr[d], o[d] * corr);
}
template <int N> DI void ld_row(float* q, const bf16_t* p) {
#pragma unroll
    for (int d = 0; d < N; d += 8) { const uint4 v = *(const uint4*)(p + d);
        q[d] = bflo(v.x); q[d + 1] = bfhi(v.x); q[d + 2] = bflo(v.y); q[d + 3] = bfhi(v.y); q[d + 4] = bflo(v.z); q[d + 5] = bfhi(v.z); q[d + 6] = bflo(v.w); q[d + 7] = bfhi(v.w); }
}
template <int N> DI void ld_row(float* q, const float* p) {
#pragma unroll
    for (int d = 0; d < N; d += 4) { const float4 v = *(const float4*)(p + d); q[d] = v.x; q[d + 1] = v.y; q[d + 2] = v.z; q[d + 3] = v.w; }
}

struct MG { const bf16_t* A; long lda; const bf16_t* Wt; long ldw; int K; };

template <class RowFn>
DI void mgemm_tile(const MG& g, int n0, RowFn rowfn, f32x16 (&acc)[2][2], unsigned char* lds, bool zero = true) {
    constexpr int XI = G_BM * 8 / NT, WI = G_BN * 8 / NT;
    const int tid = tidx(), lane = tid & 63, wid = tid >> 6, r = lane & 31, h = lane >> 5;
    const int wm = wid % G_WM, wn = wid / G_WM;
    const int cc = tid & 7, row0 = tid >> 3;
    const bf16_t* xp[XI]; const bf16_t* wp[WI];
#pragma unroll
    for (int i = 0; i < XI; ++i) xp[i] = g.A + (long)rowfn(row0 + (NT / 8) * i) * g.lda + cc * 8;
#pragma unroll
    for (int i = 0; i < WI; ++i) wp[i] = g.Wt + (long)(n0 + row0 + (NT / 8) * i) * g.ldw + cc * 8;
    const int st_off = row0 * G_RS + cc * 16;
    if (zero)
#pragma unroll
    for (int a = 0; a < 2; ++a)
#pragma unroll
        for (int b = 0; b < 2; ++b)
#pragma unroll
            for (int i = 0; i < 16; ++i) acc[a][b][i] = 0.f;
    u32x4 xv[XI], wv[WI];
#pragma unroll
    for (int i = 0; i < XI; ++i) xv[i] = *(const u32x4*)(xp[i]);
#pragma unroll
    for (int i = 0; i < WI; ++i) wv[i] = *(const u32x4*)(wp[i]);
    __syncthreads();
#pragma unroll
    for (int i = 0; i < XI; ++i) *(u32x4*)(lds + st_off + (NT / 8) * i * G_RS) = xv[i];
#pragma unroll
    for (int i = 0; i < WI; ++i) *(u32x4*)(lds + G_BM * G_RS + st_off + (NT / 8) * i * G_RS) = wv[i];
    __syncthreads();
    const int nk = g.K >> 6;
    const int xf_off = (wm * 64 + r) * G_RS + h * 16, wf_off = G_BM * G_RS + (wn * 64 + r) * G_RS + h * 16;
    for (int kt = 0; kt < nk; ++kt) {
        const unsigned char* st = lds + (kt & 1) * G_STAGE;
        if (kt + 1 < nk) {
#pragma unroll
            for (int i = 0; i < XI; ++i) xv[i] = *(const u32x4*)(xp[i] + (kt + 1) * 64);
#pragma unroll
            for (int i = 0; i < WI; ++i) wv[i] = *(const u32x4*)(wp[i] + (kt + 1) * 64);
        }
#pragma unroll
        for (int ks = 0; ks < 4; ++ks) {
            const bf16x8 w0 = *(const bf16x8*)(st + wf_off + ks * 32), w1 = *(const bf16x8*)(st + wf_off + 32 * G_RS + ks * 32);
            const bf16x8 x0 = *(const bf16x8*)(st + xf_off + ks * 32), x1 = *(const bf16x8*)(st + xf_off + 32 * G_RS + ks * 32);
            acc[0][0] = __builtin_amdgcn_mfma_f32_32x32x16_bf16(w0, x0, acc[0][0], 0, 0, 0);
            acc[0][1] = __builtin_amdgcn_mfma_f32_32x32x16_bf16(w0, x1, acc[0][1], 0, 0, 0);
            acc[1][0] = __builtin_amdgcn_mfma_f32_32x32x16_bf16(w1, x0, acc[1][0], 0, 0, 0);
            acc[1][1] = __builtin_amdgcn_mfma_f32_32x32x16_bf16(w1, x1, acc[1][1], 0, 0, 0);
        }
        if (kt + 1 < nk) {
            unsigned char* sn = lds + ((kt + 1) & 1) * G_STAGE;
#pragma unroll
            for (int i = 0; i < XI; ++i) *(u32x4*)(sn + st_off + (NT / 8) * i * G_RS) = xv[i];
#pragma unroll
            for (int i = 0; i < WI; ++i) *(u32x4*)(sn + G_BM * G_RS + st_off + (NT / 8) * i * G_RS) = wv[i];
        }
        __syncthreads();
    }
}
#define MG_FOREACH(acc, LROW, FEAT, V, ...) do { const int _l = tidx() & 63, _w = tidx() >> 6, _wm = _w % G_WM, _wn = _w / G_WM; \
    _Pragma("unroll") for (int _ft = 0; _ft < 2; ++_ft) _Pragma("unroll") for (int _tt = 0; _tt < 2; ++_tt) _Pragma("unroll") for (int _i = 0; _i < 4; ++_i) { \
        const int LROW = _wm * 64 + _tt * 32 + (_l & 31); const int FEAT = _wn * 64 + _ft * 32 + 8 * _i + 4 * (_l >> 5); \
        float V[4] = {acc[_ft][_tt][4 * _i], acc[_ft][_tt][4 * _i + 1], acc[_ft][_tt][4 * _i + 2], acc[_ft][_tt][4 * _i + 3]}; __VA_ARGS__ } } while (0)

struct RowId { int m0; DI long operator()(int r) const { return m0 + r; } };

template <int OUTMODE>
DI void mgemm_job(const MG& g, int M, int N, void* out, long ldo, int bid, int nblk, unsigned char* lds) {
    const int tm = M / G_BM, tn = N / G_BN;
    for (int u = bid; u < tm * tn; u += nblk) {
        const int grp = u / (16 * tn), rem = u % (16 * tn);
        const int gm = (tm - grp * 16) < 16 ? (tm - grp * 16) : 16;
        const int mt = grp * 16 + rem % gm, nt = rem / gm;
        const int m0 = mt * G_BM, n0 = nt * G_BN;
        f32x16 acc[2][2];
        mgemm_tile(g, n0, RowId{m0}, acc, lds);
        MG_FOREACH(acc, lrow, feat, v, {
            const long o = (long)(m0 + lrow) * ldo + n0 + feat;
            if (OUTMODE == 1) *(float4*)((float*)out + o) = make_float4(v[0], v[1], v[2], v[3]);
            else {
                if (OUTMODE == 2 && n0 + feat >= O_MG) { v[0] = sigm(v[0]); v[1] = sigm(v[1]); v[2] = sigm(v[2]); v[3] = sigm(v[3]); }
                st4bf((bf16_t*)out + o, v[0], v[1], v[2], v[3]);
            } });
    }
}

namespace pg8 {
#define PG8_LAS __attribute__((address_space(3)))
typedef float f32x4 __attribute__((ext_vector_type(4)));
constexpr int BM = 256, BK = 64, HALF = 128, HTB = HALF * BK * 2  , STAGE_BYTES = 8 * HTB, NXCD = 8, WGM = 8;
__host__ __device__ __forceinline__ int lds_byte(int r, int c) { const int st = (r >> 4) * 2 + (c >> 5), rr = r & 15, cc = c & 31, ob = rr * 64 + cc * 2; return st * 1024 + (ob ^ (((ob >> 9) & 1) << 5)); }
__host__ __device__ __forceinline__ void stage_rc(int b, int& R, int& C) { const int st = b / 1024, sb = b % 1024, swz = sb ^ (((sb >> 9) & 1) << 5); R = (st >> 1) * 16 + swz / 64; C = (st & 1) * 32 + (swz % 64) / 2; }
__host__ __device__ __forceinline__ int perm32(int rho) { const int n = rho >> 4, i = rho & 15; return 8 * (i >> 2) + 4 * n + (i & 3); }
struct Unit { int pm, pn, e; };
struct Gemm { const bf16_t* A; const bf16_t* Bt; int M, N, K; };
struct StaticOrder {
    int nM, nN, nwg, G, c;
    __device__ void init(int M, int N, int G_, int c_) { nM = M / BM; nN = N / BM; nwg = nM * nN; G = G_; c = c_; }
    __device__ bool next(int i, Unit& u) const {
        const long L = (long)i * G + c; if (L >= nwg) return false;
        int wgid = (int)L; { const int q = nwg / NXCD, r = nwg % NXCD, xcd = wgid % NXCD, off = wgid / NXCD; wgid = (xcd < r ? xcd * (q + 1) : r * (q + 1) + (xcd - r) * q) + off; }
        const int nig = WGM * nN, gid = wgid / nig, fm = gid * WGM, gsz = (nM - fm) < WGM ? (nM - fm) : WGM;
        u.pm = fm + ((wgid % nig) % gsz); u.pn = (wgid % nig) / gsz; u.e = 0; return true;
    }
    __device__ __forceinline__ void a_ready(const Unit&) const {}
    __device__ __forceinline__ void done(const Unit&) const {}
};
struct ListOrder {
    Unit u0, u1, u2; int n;
    __device__ bool next(int i, Unit& u) const { if (i >= n) return false; u = (i == 0) ? u0 : ((i == 1) ? u1 : u2); return true; }
    __device__ __forceinline__ void a_ready(const Unit&) const {}
    __device__ __forceinline__ void done(const Unit&) const {}
};
template <class Epi, class Sched, bool ALIGN_EPI = false, bool SP2 = false>
__device__ __forceinline__ void gemm_phase(PG8_LAS unsigned char* lds, const Gemm g, const Sched& S, const Epi& E) {
    const int tid = tidx(), wid = __builtin_amdgcn_readfirstlane(tid >> 6), lane = tid & 63, wr = wid >> 2, wc = wid & 3, fr = lane & 15, fq = lane >> 4;
    const int K = g.K, nt = K / BK;
    unsigned voffA[2], voffB[2];
#pragma unroll
    for (int i = 0; i < 2; ++i) { int R, C; stage_rc(tid * 16 + i * 8192, R, C); const int Rb = Epi::PERM ? ((R & ~31) + perm32(R & 31)) : R;
        voffA[i] = (unsigned)(R * K + C) * 2u; voffB[i] = (unsigned)(Rb * K + C) * 2u; }
    const size_t kstep = (size_t)(BK * 2);
    const size_t hstep = (size_t)HALF * K * 2;
    const size_t tstep = 2 * hstep;
    const size_t estep = (size_t)g.N * K * 2;
    const unsigned ldsw = (unsigned)wid * 1024u;
    const int aoff = lds_byte(wr * 64 + fr, fq * 8), boff = lds_byte(wc * 32 + fr, fq * 8);
#define PG8_SA(b, h) (((b) * 2 + (h)) * HTB)
#define PG8_SB(b, h) ((4 + (b) * 2 + (h)) * HTB)
#define PG8_STAGE(bufoff, gbase, voff) do { _Pragma("unroll") for (int _i = 0; _i < 2; ++_i) \
        __builtin_amdgcn_global_load_lds((const unsigned*)((const char*)(gbase) + (voff)[_i]), (PG8_LAS unsigned*)(lds + (bufoff) + ldsw + _i * 8192), 16, 0, 0); } while (0)
#define PG8_LDA(dst, b, h) do { _Pragma("unroll") for (int m = 0; m < 4; ++m) _Pragma("unroll") for (int k = 0; k < 2; ++k) dst[m][k] = *(const PG8_LAS bf16x8*)(lds + PG8_SA(b, h) + aoff + m * 2048 + k * 1024); } while (0)
#define PG8_LDB(dst, b, h) do { _Pragma("unroll") for (int n = 0; n < 2; ++n) _Pragma("unroll") for (int k = 0; k < 2; ++k) dst[n][k] = *(const PG8_LAS bf16x8*)(lds + PG8_SB(b, h) + boff + n * 2048 + k * 1024); } while (0)
#define PG8_MMA(ai, bj, At, Bt) do { __builtin_amdgcn_s_setprio(1); _Pragma("unroll") for (int m = 0; m < 4; ++m) _Pragma("unroll") for (int n = 0; n < 2; ++n) _Pragma("unroll") for (int k = 0; k < 2; ++k) \
        acc[ai][bj][m][n] = __builtin_amdgcn_mfma_f32_16x16x32_bf16(Bt[n][k], At[m][k], acc[ai][bj][m][n], 0, 0, 0); __builtin_amdgcn_s_setprio(0); } while (0)
#define PG8_WAIT_V(n) asm volatile("s_waitcnt vmcnt(" #n ")" ::: "memory")
#define PG8_WAIT_L(n) asm volatile("s_waitcnt lgkmcnt(" #n ")" ::: "memory")
#define PG8_BAR __builtin_amdgcn_s_barrier()
#define PG8_SCHED __builtin_amdgcn_sched_barrier(0)
    Unit cur, nxt; int ui = 0;
    if (!S.next(0, cur)) return;
    f32x4 acc[2][2][4][2];
#pragma unroll
    for (int a = 0; a < 2; ++a)
#pragma unroll
        for (int b = 0; b < 2; ++b)
#pragma unroll
            for (int m = 0; m < 4; ++m)
#pragma unroll
                for (int n = 0; n < 2; ++n) acc[a][b][m][n] = (f32x4){0.f, 0.f, 0.f, 0.f};
    bf16x8 At[4][2], B0[2][2], B1[2][2];
    const char* cA = (const char*)g.A + (size_t)cur.pm * tstep; const char* cB = (const char*)g.Bt + (size_t)cur.e * estep + (size_t)cur.pn * tstep;
    S.a_ready(cur);
    if constexpr (SP2) {
        PG8_STAGE(PG8_SB(0, 0), cB, voffB); PG8_STAGE(PG8_SB(0, 1), cB + hstep, voffB); PG8_STAGE(PG8_SA(0, 0), cA, voffA); PG8_STAGE(PG8_SA(0, 1), cA + hstep, voffA);
        if (wr == 1) PG8_BAR;
        PG8_WAIT_V(2); PG8_BAR;
        PG8_STAGE(PG8_SB(1, 0), cB + kstep, voffB); PG8_STAGE(PG8_SA(1, 0), cA + kstep, voffA); PG8_STAGE(PG8_SB(1, 1), cB + hstep + kstep, voffB);
        PG8_WAIT_V(6); PG8_BAR;
    } else {
        PG8_STAGE(PG8_SB(0, 0), cB, voffB); PG8_STAGE(PG8_SA(0, 0), cA, voffA); PG8_STAGE(PG8_SB(0, 1), cB + hstep, voffB); PG8_STAGE(PG8_SA(0, 1), cA + hstep, voffA);
        if (wr == 1) PG8_BAR;
        PG8_WAIT_V(4); PG8_BAR;
        PG8_STAGE(PG8_SB(1, 0), cB + kstep, voffB); PG8_STAGE(PG8_SA(1, 0), cA + kstep, voffA); PG8_STAGE(PG8_SB(1, 1), cB + hstep + kstep, voffB);
        PG8_WAIT_V(6); PG8_BAR;
    }
    for (;;) {
        const bool has_next = S.next(ui + 1, nxt);
        const char* nA = has_next ? (const char*)g.A + (size_t)nxt.pm * tstep : cA; const char* nB = has_next ? (const char*)g.Bt + (size_t)nxt.e * estep + (size_t)nxt.pn * tstep : cB;
        for (int t = 0; t < nt; t += 2) {
            const bool last = (t == nt - 2);
            const char* a1 = cA + (size_t)(t + 1) * kstep;
            const char* a2 = last ? nA : cA + (size_t)(t + 2) * kstep; const char* b2 = last ? nB : cB + (size_t)(t + 2) * kstep;
            const char* a3 = a2 + kstep; const char* b3 = b2 + kstep;
            if (last && has_next) S.a_ready(nxt);
            if constexpr (SP2) {
            PG8_LDB(B0, 0, 0); PG8_LDB(B1, 0, 1); PG8_SCHED; PG8_LDA(At, 0, 0); PG8_STAGE(PG8_SA(1, 1), a1 + hstep, voffA);
            PG8_WAIT_V(8); PG8_WAIT_L(0); PG8_BAR; PG8_MMA(0, 0, At, B0); PG8_MMA(0, 1, At, B1); PG8_BAR; PG8_SCHED;
            PG8_LDA(At, 0, 1); PG8_STAGE(PG8_SB(0, 0), b2, voffB); PG8_STAGE(PG8_SB(0, 1), b2 + hstep, voffB); PG8_STAGE(PG8_SA(0, 0), a2, voffA);
            PG8_WAIT_V(8); PG8_WAIT_L(0); PG8_BAR; PG8_MMA(1, 0, At, B0); PG8_MMA(1, 1, At, B1); PG8_BAR; PG8_SCHED;
            PG8_LDB(B0, 1, 0); PG8_LDB(B1, 1, 1); PG8_SCHED; PG8_LDA(At, 1, 0); PG8_STAGE(PG8_SA(0, 1), a2 + hstep, voffA);
            PG8_WAIT_V(8); PG8_WAIT_L(0); PG8_BAR; PG8_MMA(0, 0, At, B0); PG8_MMA(0, 1, At, B1); PG8_BAR; PG8_SCHED;
            PG8_LDA(At, 1, 1); PG8_STAGE(PG8_SB(1, 0), b3, voffB); PG8_STAGE(PG8_SB(1, 1), b3 + hstep, voffB); PG8_STAGE(PG8_SA(1, 0), a3, voffA);
            PG8_WAIT_V(8); PG8_WAIT_L(0); PG8_BAR; PG8_MMA(1, 0, At, B0); PG8_MMA(1, 1, At, B1); PG8_BAR; PG8_SCHED;
            } else {
            PG8_LDB(B0, 0, 0); PG8_SCHED; PG8_LDA(At, 0, 0); PG8_STAGE(PG8_SA(1, 1), a1 + hstep, voffA);
            PG8_WAIT_L(8); PG8_BAR; PG8_WAIT_L(0); PG8_MMA(0, 0, At, B0); PG8_BAR; PG8_SCHED;
            PG8_LDB(B1, 0, 1); PG8_STAGE(PG8_SB(0, 0), b2, voffB);
            PG8_BAR; PG8_WAIT_L(0); PG8_MMA(0, 1, At, B1); PG8_BAR;
            PG8_LDA(At, 0, 1); PG8_STAGE(PG8_SA(0, 0), a2, voffA);
            PG8_BAR; PG8_WAIT_L(0); PG8_MMA(1, 0, At, B0); PG8_BAR; PG8_SCHED;
            PG8_STAGE(PG8_SB(0, 1), b2 + hstep, voffB);
            PG8_WAIT_V(6); PG8_BAR; PG8_MMA(1, 1, At, B1); PG8_BAR;
            PG8_LDB(B0, 1, 0); PG8_SCHED; PG8_LDA(At, 1, 0); PG8_STAGE(PG8_SA(0, 1), a2 + hstep, voffA);
            PG8_WAIT_L(8); PG8_BAR; PG8_WAIT_L(0); PG8_MMA(0, 0, At, B0); PG8_BAR; PG8_SCHED;
            PG8_LDB(B1, 1, 1); PG8_STAGE(PG8_SB(1, 0), b3, voffB);
            PG8_BAR; PG8_WAIT_L(0); PG8_MMA(0, 1, At, B1); PG8_BAR;
            PG8_LDA(At, 1, 1); PG8_STAGE(PG8_SA(1, 0), a3, voffA);
            PG8_BAR; PG8_WAIT_L(0); PG8_MMA(1, 0, At, B0); PG8_BAR; PG8_SCHED;
            PG8_STAGE(PG8_SB(1, 1), b3 + hstep, voffB);
            PG8_WAIT_V(6); PG8_BAR; PG8_MMA(1, 1, At, B1); PG8_BAR;
            }
        }
        if constexpr (ALIGN_EPI) { if (wr == 0) PG8_BAR; }
        if constexpr (!Epi::AFTER_DRAIN) { E(acc, cur, wr, wc, fr, fq); S.done(cur); }
        if (!has_next) break;
#pragma unroll
        for (int a = 0; a < 2; ++a)
#pragma unroll
            for (int b = 0; b < 2; ++b)
#pragma unroll
                for (int m = 0; m < 4; ++m)
#pragma unroll
                    for (int n = 0; n < 2; ++n) acc[a][b][m][n] = (f32x4){0.f, 0.f, 0.f, 0.f};
        cur = nxt; cA = nA; cB = nB; ++ui;
        if constexpr (ALIGN_EPI) { if (wr == 1) PG8_BAR; }
    }
    PG8_WAIT_V(0);
    if constexpr (!ALIGN_EPI) { if (wr == 0) PG8_BAR; }
    PG8_BAR;
    if constexpr (Epi::AFTER_DRAIN) { E.fused(acc, cur, wr, wc, fr, fq, lds, wid, lane); S.done(cur); }
#undef PG8_SA
#undef PG8_SB
#undef PG8_STAGE
#undef PG8_LDA
#undef PG8_LDB
#undef PG8_MMA
#undef PG8_WAIT_V
#undef PG8_WAIT_L
#undef PG8_BAR
#undef PG8_SCHED
}
}

struct EpiStoreBf16 {
    static constexpr bool PERM = true, AFTER_DRAIN = false;
    bf16_t* O; long ldo; int gate_from; long estride;
    __device__ __forceinline__ void operator()(const pg8::f32x4 (&acc)[2][2][4][2], const pg8::Unit& u, int wr, int wc, int fr, int fq) const {
        bf16_t* base = O + (long)u.e * estride;
#pragma unroll
        for (int ai = 0; ai < 2; ++ai)
#pragma unroll
            for (int m = 0; m < 4; ++m) {
                const long row = (long)u.pm * 256 + ai * 128 + wr * 64 + m * 16 + fr;
#pragma unroll
                for (int bj = 0; bj < 2; ++bj) {
                    pg8::f32x4 v0 = acc[ai][bj][m][0], v1 = acc[ai][bj][m][1];
                    if (u.pn * 2 + bj >= gate_from) {
#pragma unroll
                        for (int j = 0; j < 4; ++j) { v0[j] = sigm_fast(v0[j]); v1[j] = sigm_fast(v1[j]); }
                    }
                    u32x4 wv; wv[0] = pk_bf16(v0[0], v0[1]); wv[1] = pk_bf16(v0[2], v0[3]); wv[2] = pk_bf16(v1[0], v1[1]); wv[3] = pk_bf16(v1[2], v1[3]);
                    *(u32x4*)(base + row * ldo + u.pn * 256 + bj * 128 + wc * 32 + 8 * fq) = wv;
                }
            }
    }
};
struct EpiStoreF32 {
    static constexpr bool PERM = false, AFTER_DRAIN = false;
    float* O; long ldo;
    __device__ __forceinline__ void operator()(const pg8::f32x4 (&acc)[2][2][4][2], const pg8::Unit& u, int wr, int wc, int fr, int fq) const {
#pragma unroll
        for (int ai = 0; ai < 2; ++ai)
#pragma unroll
            for (int m = 0; m < 4; ++m) {
                const long row = (long)u.pm * 256 + ai * 128 + wr * 64 + m * 16 + fr;
#pragma unroll
                for (int bj = 0; bj < 2; ++bj)
#pragma unroll
                    for (int n = 0; n < 2; ++n) *(pg8::f32x4*)(O + row * ldo + u.pn * 256 + bj * 128 + wc * 32 + 16 * n + 4 * fq) = acc[ai][bj][m][n];
            }
    }
};
struct EpiMoeGU {
    static constexpr bool PERM = true, AFTER_DRAIN = false;
    bf16_t* HH;
    __device__ __forceinline__ void operator()(const pg8::f32x4 (&acc)[2][2][4][2], const pg8::Unit& u, int wr, int wc, int fr, int fq) const {
#pragma unroll
        for (int ai = 0; ai < 2; ++ai)
#pragma unroll
            for (int m = 0; m < 4; ++m) {
                const long row = (long)u.pm * 256 + ai * 128 + wr * 64 + m * 16 + fr;
                float hv[8];
#pragma unroll
                for (int n = 0; n < 2; ++n)
#pragma unroll
                    for (int j = 0; j < 4; ++j) { const float gt = acc[ai][0][m][n][j], up = acc[ai][1][m][n][j]; hv[4 * n + j] = gt * sigm_fast(gt) * up; }
                u32x4 wv; wv[0] = pk_bf16(hv[0], hv[1]); wv[1] = pk_bf16(hv[2], hv[3]); wv[2] = pk_bf16(hv[4], hv[5]); wv[3] = pk_bf16(hv[6], hv[7]);
                *(u32x4*)(HH + row * 512 + u.pn * 128 + wc * 32 + 8 * fq) = wv;
            }
    }
};
struct EpiMoeDown {
    static constexpr bool PERM = true, AFTER_DRAIN = false;
    const int* perm; const float* ew; bf16_t* YK;
    __device__ __forceinline__ void operator()(const pg8::f32x4 (&acc)[2][2][4][2], const pg8::Unit& u, int wr, int wc, int fr, int fq) const {
#pragma unroll
        for (int ai = 0; ai < 2; ++ai)
#pragma unroll
            for (int m = 0; m < 4; ++m) {
                const int a = perm[u.pm * 256 + ai * 128 + wr * 64 + m * 16 + fr];
                if (a >= 0) {
                    const float sw = ew[a];
#pragma unroll
                    for (int bj = 0; bj < 2; ++bj) {
                        const pg8::f32x4 v0 = acc[ai][bj][m][0] * sw, v1 = acc[ai][bj][m][1] * sw;
                        u32x4 wv; wv[0] = pk_bf16(v0[0], v0[1]); wv[1] = pk_bf16(v0[2], v0[3]); wv[2] = pk_bf16(v1[0], v1[1]); wv[3] = pk_bf16(v1[2], v1[3]);
                        *(u32x4*)(YK + (long)a * 1024 + u.pn * 256 + bj * 128 + wc * 32 + 8 * fq) = wv;
                    }
                }
            }
    }
};
struct GroupedOrder {
    int nM, nN, nE, G, c;
    __device__ bool next(int i, pg8::Unit& u) const { const int L = i * G + c; if (L >= nM * nN * nE) return false; u.e = L / (nM * nN); const int rm = L % (nM * nN); u.pm = rm / nN; u.pn = rm % nN; return true; }
    __device__ __forceinline__ void a_ready(const pg8::Unit&) const {}
    __device__ __forceinline__ void done(const pg8::Unit&) const {}
};

struct LayerW {
    const float *cmp_pos, *conv_w, *conv_b, *ga_b, *gx_b, *lam, *q_norm, *kv_norm,
        *ln1_g, *ln1_b, *ln2_g, *ln2_b, *rg_b, *re_b, *ln3_g, *ln3_b;
    const bf16_t *t_in, *t_br, *t_out, *t_q, *t_o, *t_gu, *t_dn, *t_c1, *t_c2, *t_uq, *t_ukv, *t_g, *t_rh, *t_rl;
};
#define WSF(off) ((float*)(p.ws + (off)))
#define WSI(off) ((int*)(p.ws + (off)))
#define WSU(off) ((unsigned*)(p.ws + (off)))
#define WSB(off) ((bf16_t*)(p.ws + (off)))
DI LayerW layer_w(const Params& p, int l) {
    LayerW w;
    w.cmp_pos = p.in[3] + (size_t)l * 2 * 32 * 64;
    w.conv_w = p.in[6] + (size_t)l * 4 * 256;
    w.conv_b = p.in[7] + (size_t)l * 256;
    w.ga_b = p.in[9] + (size_t)l * 256;
    w.gx_b = p.in[11] + (size_t)l * 256;
    w.lam = p.in[12] + (size_t)l * 256;
    w.q_norm = p.in[13] + (size_t)l * 192;
    w.kv_norm = p.in[14] + (size_t)l * 128;
    w.ln1_g = p.in[19] + (size_t)l * 1024; w.ln1_b = p.in[20] + (size_t)l * 1024;
    w.ln2_g = p.in[24] + (size_t)l * 1024; w.ln2_b = p.in[25] + (size_t)l * 1024;
    w.rg_b = p.in[27] + (size_t)l * 4;
    w.re_b = p.in[29] + (size_t)l * 32;
    w.ln3_g = p.in[32] + (size_t)l * 1024; w.ln3_b = p.in[33] + (size_t)l * 1024;
    w.t_in = WSB(WT_IN) + (size_t)l * NH * 1024;
    w.t_br = WSB(WT_BR) + (size_t)l * 4 * 1024 * 256;
    w.t_out = WSB(WT_OUT) + (size_t)l * 1024 * 1024;
    w.t_q = WSB(WT_Q) + (size_t)l * 512 * 1024;
    w.t_o = WSB(WT_O) + (size_t)l * 1024 * 512;
    w.t_gu = WSB(WT_GU) + (size_t)l * 32 * 1024 * 1024;
    w.t_dn = WSB(WT_DN) + (size_t)l * 32 * 1024 * 512;
    w.t_c1 = WSB(WT_C1) + (size_t)l * 2 * 256 * 2048;
    w.t_c2 = WSB(WT_C2) + (size_t)l * 2 * 128 * 256;
    w.t_uq = WSB(WT_UQ) + (size_t)l * 384 * 192;
    w.t_ukv = WSB(WT_UKV) + (size_t)l * 512 * 128;
    w.t_g = WSB(WT_G) + (size_t)l * 4 * 128 * 64;
    w.t_rh = WSB(WT_RH) + (size_t)l * 128 * 1024;
    w.t_rl = WSB(WT_RL) + (size_t)l * 128 * 1024;
    return w;
}

template <int MODE>
DI int wt_col(int np, int Nsrc) {
    if (MODE == 0) return np < Nsrc ? np : -1;
    if (MODE == 2) return np < 1024 ? np : (np < 2656 ? np + 12 : (np < 2668 ? 1024 + (np - 2656) : (np < 2688 ? -1 : (np < 6784 ? np - 20 : -1))));
    const int pn = np >> 8, bj = (np >> 7) & 1, q = np & 127; return (bj ? 512 : 0) + 128 * pn + q;
}
template <int MODE>
DI void job_wt(const float* src, int nmat, int K, int Nsrc, bf16_t* dst, int Npad, int bid, int nblk, unsigned char* lds) {
    bf16_t* tile = (bf16_t*)lds;
    const int tk = K / 64, tn = Npad / 64, per = tk * tn;
    const int tid = tidx();
    const int kl = tid >> 4, n4 = (tid & 15) * 4;
    for (int u = bid; u < nmat * per; u += nblk) {
        const int mat = u / per, ru = u % per, k0 = (ru / tn) * 64, n0 = (ru % tn) * 64;
        const float* s = src + (size_t)mat * K * Nsrc;
        bf16_t* d = dst + (size_t)mat * Npad * K;
        const int col = wt_col<MODE>(n0 + n4, Nsrc);
        float4 v0 = make_float4(0.f, 0.f, 0.f, 0.f), v1 = v0;
        if (col >= 0) { v0 = *(const float4*)(s + (size_t)(k0 + kl) * Nsrc + col); v1 = *(const float4*)(s + (size_t)(k0 + kl + 32) * Nsrc + col); }
        __syncthreads();
        tile[(n4 + 0) * 72 + kl] = f2bf(v0.x); tile[(n4 + 1) * 72 + kl] = f2bf(v0.y); tile[(n4 + 2) * 72 + kl] = f2bf(v0.z); tile[(n4 + 3) * 72 + kl] = f2bf(v0.w);
        tile[(n4 + 0) * 72 + kl + 32] = f2bf(v1.x); tile[(n4 + 1) * 72 + kl + 32] = f2bf(v1.y); tile[(n4 + 2) * 72 + kl + 32] = f2bf(v1.z); tile[(n4 + 3) * 72 + kl + 32] = f2bf(v1.w);
        __syncthreads();
        { const int n2 = tid >> 3, kc = (tid & 7) * 8;
          *(uint4*)(d + (size_t)(n0 + n2) * K + k0 + kc) = *(const uint4*)(tile + n2 * 72 + kc); }
    }
}
DI void job_cvt(const float* src, bf16_t* dst, long n, int bid, int nblk) {
    for (long e = ((long)bid * NT + tidx()) * 4; e < n; e += (long)nblk * NT * 4) {
        const float4 v = *(const float4*)(src + e);
        st4bf(dst + e, v.x, v.y, v.z, v.w);
    }
}
DI void job_cmp_gather(const Params& p, const LayerW& w, int bid, int nblk) {
    const bf16_t* H = WSB(WS_H); bf16_t* TB = WSB(WS_TBB);
    const long total = (long)2 * NCR * 2048 / 4;
    for (long e = (long)bid * NT + tidx(); e < total; e += (long)nblk * NT) {
        const long e4 = e * 4;
        const int f = (int)(e4 % 2048); const long r2 = e4 / 2048; const int r = (int)(r2 % NCR), j = (int)(r2 / NCR);
        const int g = r & 1, bc = r >> 1, c = bc % NCMP, b = bc / NCMP, i = f >> 6, d = f & 63;
        const float4 hv = ld4bf(H + (long)(b * SEQ + 16 * c + i) * NH + (j ? O_AVC : O_AKC) + g * 64 + d);
        const float4 pv = *(const float4*)(w.cmp_pos + (j * 32 + i) * 64 + d);
        st4bf(TB + ((long)j * 2048 + r) * 2048 + f, hv.x + pv.x, hv.y + pv.y, hv.z + pv.z, hv.w + pv.w);
    }
}
DI void job_rnn_conv(const Params& p, const LayerW& w, int bid, int nblk) {
    const bf16_t* H = WSB(WS_H); float* U = WSF(WS_U); bf16_t* UB = WSB(WS_UB);
    for (long e = (long)bid * NT + tidx(); e < (long)T * 256; e += (long)nblk * NT) {
        const int ch = (int)(e & 255); const int t = (int)(e >> 8), s = t & (SEQ - 1);
        float u = w.conv_b[ch];
#pragma unroll
        for (int tap = 0; tap < 4; ++tap) { const int sp = s - 3 + tap; if (sp >= 0) u += bf2f(H[(long)(t - 3 + tap) * NH + O_CX + ch]) * w.conv_w[tap * 256 + ch]; }
        U[e] = u; UB[e] = f2bf(u);
    }
}
DI void job_rnn_gates(const Params& p, const LayerW& w, int bid, int nblk, unsigned char* lds) {
    const float* U = WSF(WS_U); float* RA = WSF(WS_RA); float* RB = WSF(WS_RB);
    for (int u = bid; u < (T / G_BM) * 4; u += nblk) {
        const int blk = u & 3, m0 = (u >> 2) * G_BM;
        MG g; g.A = WSB(WS_UB) + blk * 64; g.lda = 256; g.Wt = w.t_g + (size_t)blk * 128 * 64; g.ldw = 64; g.K = 64;
        f32x16 acc[2][2];
        mgemm_tile(g, 0, RowId{m0}, acc, lds);
        const int l = tidx() & 63, wv = tidx() >> 6, wm = wv % G_WM, wn = wv / G_WM;
#pragma unroll
        for (int tt = 0; tt < 2; ++tt)
#pragma unroll
            for (int i = 0; i < 4; ++i) {
                const long t = m0 + wm * 64 + tt * 32 + (l & 31); const int ch = blk * 64 + wn * 32 + 8 * i + 4 * (l >> 5);
                const float4 uv = *(const float4*)(U + t * 256 + ch);
                const float ua[4] = {uv.x, uv.y, uv.z, uv.w};
                float av[4], bv[4];
#pragma unroll
                for (int j = 0; j < 4; ++j) {
                    const float r = sigm(acc[0][tt][4 * i + j] + w.ga_b[ch + j]), ig = sigm(acc[1][tt][4 * i + j] + w.gx_b[ch + j]);
                    const float nl = -w.lam[ch + j];
                    const float sp = fmaxf(nl, 0.f) + log1pf(expf(-fabsf(nl)));
                    const float log_a = -8.0f * r * sp;
                    av[j] = expf(log_a); bv[j] = sqrtf(-expm1f(2.0f * log_a)) * (ig * ua[j]);
                }
                *(float4*)(RA + t * 256 + ch) = make_float4(av[0], av[1], av[2], av[3]);
                *(float4*)(RB + t * 256 + ch) = make_float4(bv[0], bv[1], bv[2], bv[3]);
            }
    }
}
DI void job_rnn_scan1(const Params& p, int bid, int nblk) {
    const float* RA = WSF(WS_RA); const float* RB = WSF(WS_RB); float* SA = WSF(WS_SA); float* SH = WSF(WS_SH);
    for (int e = bid * NT + tidx(); e < BATCH * 32 * 256; e += nblk * NT) {
        const int ch = e & 255, bc = e >> 8;
        float ap = 1.f, hl = 0.f;
        for (int s0 = 0; s0 < 64; s0 += 8) {
            float av[8], bv[8];
#pragma unroll
            for (int i = 0; i < 8; ++i) { const long t = (long)bc * 64 + s0 + i; av[i] = RA[t * 256 + ch]; bv[i] = RB[t * 256 + ch]; }
#pragma unroll
            for (int i = 0; i < 8; ++i) { ap *= av[i]; hl = av[i] * hl + bv[i]; }
        }
        SA[e] = ap; SH[e] = hl;
    }
}
DI void job_rnn_scan2(const Params& p, int bid, int nblk) {
    const bf16_t* H = WSB(WS_H); const float* RA = WSF(WS_RA); const float* RB = WSF(WS_RB); const float* SA = WSF(WS_SA); const float* SH = WSF(WS_SH); bf16_t* BR = WSB(WS_BR);
    for (int e = bid * NT + tidx(); e < BATCH * 32 * 256; e += nblk * NT) {
        const int ch = e & 255, bc = e >> 8, chunk = bc & 31, b = bc >> 5;
        float h = 0.f;
        for (int c = 0; c < chunk; ++c) { const int q = ((b * 32 + c) << 8) + ch; h = SA[q] * h + SH[q]; }
        for (int s0 = 0; s0 < 64; s0 += 8) {
            float av[8], bv[8], gv[8];
#pragma unroll
            for (int i = 0; i < 8; ++i) { const long t = (long)bc * 64 + s0 + i; av[i] = RA[t * 256 + ch]; bv[i] = RB[t * 256 + ch]; gv[i] = bf2f(H[t * NH + O_CG + ch]); }
#pragma unroll
            for (int i = 0; i < 8; ++i) { const long t = (long)bc * 64 + s0 + i; h = av[i] * h + bv[i]; BR[t * 1024 + 2 * 256 + ch] = f2bf(h * gelu_tanh(gv[i])); }
        }
    }
}
DI void job_mla_norm(const Params& p, const LayerW& w, int bid, int nblk) {
    const bf16_t* H = WSB(WS_H); bf16_t* CQN = WSB(WS_CQNB); bf16_t* CKVN = WSB(WS_CKVNB); bf16_t* KM = WSB(WS_KM);
    const int lane = tidx() & 63, wid = tidx() >> 6;
    for (int t = bid * (NT / 64) + wid; t < T; t += nblk * (NT / 64)) {
        const bf16_t* hr = H + (long)t * NH;
        float q0 = bf2f(hr[O_DCQ + lane]), q1 = bf2f(hr[O_DCQ + 64 + lane]), q2 = bf2f(hr[O_DCQ + 128 + lane]);
        float ss = wave_sum(q0 * q0 + q1 * q1 + q2 * q2);
        float rs = rsqrtf(ss * (1.f / 192.f) + 1e-6f);
        CQN[(long)t * 192 + lane] = f2bf(q0 * rs * w.q_norm[lane]);
        CQN[(long)t * 192 + 64 + lane] = f2bf(q1 * rs * w.q_norm[64 + lane]);
        CQN[(long)t * 192 + 128 + lane] = f2bf(q2 * rs * w.q_norm[128 + lane]);
        float k0 = bf2f(hr[O_DCKV + lane]), k1 = bf2f(hr[O_DCKV + 64 + lane]);
        ss = wave_sum(k0 * k0 + k1 * k1);
        rs = rsqrtf(ss * (1.f / 128.f) + 1e-6f);
        CKVN[(long)t * 128 + lane] = f2bf(k0 * rs * w.kv_norm[lane]);
        CKVN[(long)t * 128 + 64 + lane] = f2bf(k1 * rs * w.kv_norm[64 + lane]);
        {
            const int i = lane & 15, hd = lane >> 4;
            const int s = t & (SEQ - 1);
            const float inv = powf(10000.f, -(float)(2 * i) / 32.f);
            const float ang = (float)s * inv, cs = cosf(ang), sn = sinf(ang);
            const float x1 = bf2f(hr[O_DKR + i]), x2 = bf2f(hr[O_DKR + 16 + i]);
            KM[(long)t * 384 + hd * 96 + 64 + i] = f2bf(x1 * cs - x2 * sn);
            KM[(long)t * 384 + hd * 96 + 80 + i] = f2bf(x1 * sn + x2 * cs);
        }
    }
}
DI void job_mla_up(const Params& p, const LayerW& w, int bid, int nblk, unsigned char* lds) {
    bf16_t* QB = WSB(WS_QB); bf16_t* KM = WSB(WS_KM); bf16_t* VM = WSB(WS_VM);
    constexpr int TM = T / G_BM;
    for (int u = bid; u < TM * 7; u += nblk) {
        const int mt = u / 7, nt = u % 7, m0 = mt * G_BM;
        f32x16 acc[2][2];
        const int l = tidx() & 63, wv = tidx() >> 6, wm = wv % G_WM, wn = wv / G_WM, hh = l >> 5;
        if (nt < 3) {
            MG g; g.A = WSB(WS_CQNB); g.lda = 192; g.Wt = w.t_uq; g.ldw = 192; g.K = 192;
            const int n0 = nt * 128;
            mgemm_tile(g, n0, RowId{m0}, acc, lds);
#pragma unroll
            for (int ft = 0; ft < 2; ++ft) {
                const int fb = (n0 + wn * 64 + ft * 32) >> 5;
                if (fb % 3 == 2) {
#pragma unroll
                    for (int tt = 0; tt < 2; ++tt) {
                        const int pos = (m0 + wm * 64 + tt * 32 + (l & 31)) & (SEQ - 1);
#pragma unroll
                        for (int i = 0; i < 2; ++i)
#pragma unroll
                            for (int j = 0; j < 4; ++j) {
                                const int fi = 8 * i + 4 * hh + j;
                                const float inv = powf(10000.f, -(float)(2 * fi) / 32.f);
                                const float ang = (float)pos * inv, cs = cosf(ang), sn = sinf(ang);
                                const float x1 = acc[ft][tt][4 * i + j], x2 = acc[ft][tt][4 * (i + 2) + j];
                                acc[ft][tt][4 * i + j] = x1 * cs - x2 * sn; acc[ft][tt][4 * (i + 2) + j] = x1 * sn + x2 * cs;
                            }
                    }
                }
            }
            MG_FOREACH(acc, lrow, feat, v, { st4bf(QB + (long)(m0 + lrow) * 384 + n0 + feat, v[0], v[1], v[2], v[3]); });
        } else {
            MG g; g.A = WSB(WS_CKVNB); g.lda = 128; g.Wt = w.t_ukv; g.ldw = 128; g.K = 128;
            const int n0 = (nt - 3) * 128;
            mgemm_tile(g, n0, RowId{m0}, acc, lds);
            MG_FOREACH(acc, lrow, feat, v, {
                const int hd = nt - 3;
                if (feat < 64) st4bf(KM + (long)(m0 + lrow) * 384 + hd * 96 + feat, v[0], v[1], v[2], v[3]);
                else st4bf(VM + (long)(m0 + lrow) * 256 + hd * 64 + (feat - 64), v[0], v[1], v[2], v[3]); });
        }
    }
}
template <int STAGE>
DI void job_cmp_mlp(const Params& p, const LayerW& w, int bid, int nblk, unsigned char* lds) {
    constexpr int TM = 2048 / G_BM, TN = STAGE == 0 ? 2 : 1;
    for (int u = bid; u < 2 * TM * TN; u += nblk) {
        const int j = u / (TM * TN), ru = u % (TM * TN), mt = ru / TN, nt = ru % TN, m0 = mt * G_BM, n0 = nt * 128;
        MG g;
        if (STAGE == 0) { g.A = WSB(WS_TBB) + (size_t)j * 2048 * 2048; g.lda = 2048; g.Wt = w.t_c1 + (size_t)j * 256 * 2048; g.ldw = 2048; g.K = 2048; }
        else { g.A = WSB(WS_HIDB) + (size_t)j * 2048 * 256; g.lda = 256; g.Wt = w.t_c2 + (size_t)j * 128 * 256; g.ldw = 256; g.K = 256; }
        f32x16 acc[2][2];
        mgemm_tile(g, n0, [&](int r) { const int rr = m0 + r; return (long)(rr < NCR ? rr : NCR - 1); }, acc, lds);
        if (STAGE == 0) {
            bf16_t* HID = WSB(WS_HIDB) + (size_t)j * 2048 * 256;
            MG_FOREACH(acc, lrow, feat, v, { st4bf(HID + (long)(m0 + lrow) * 256 + n0 + feat, gelu_tanh(v[0]), gelu_tanh(v[1]), gelu_tanh(v[2]), gelu_tanh(v[3])); });
        } else {
            bf16_t* KC = WSB(WS_KCB) + (size_t)j * NCR * 64;
            MG_FOREACH(acc, lrow, feat, v, { if (feat < 64 && m0 + lrow < NCR) st4bf(KC + (long)(m0 + lrow) * 64 + feat, v[0], v[1], v[2], v[3]); });
        }
    }
}
DI void job_router_logits(const Params& p, const LayerW& w, int bid, int nblk, unsigned char* lds) {
    float* LOG = WSF(WS_LOG);
    for (int u = bid; u < 3 * (T / G_BM); u += nblk) {
        const int pass = u / (T / G_BM), m0 = (u % (T / G_BM)) * G_BM;
        f32x16 acc[2][2];
        MG g; g.lda = 1024; g.ldw = 1024; g.K = 1024;
        g.A = pass == 1 ? WSB(WS_XBL) : WSB(WS_XBB); g.Wt = pass == 2 ? w.t_rl : w.t_rh;
        mgemm_tile(g, 0, RowId{m0}, acc, lds, true);
        float* dst = LOG + (size_t)pass * T * 36;
        MG_FOREACH(acc, lrow, feat, v, { if (feat < 36) *(float4*)(dst + (long)(m0 + lrow) * 36 + feat) = make_float4(v[0], v[1], v[2], v[3]); });
    }
}
DI void job_pack_small(const Params& p, int bid, int nblk) {
    bf16_t* TG = WSB(WT_G); bf16_t* RH = WSB(WT_RH); bf16_t* RL = WSB(WT_RL);
    for (int e = bid * NT + tidx(); e < DEPTH * 4 * 128 * 64; e += nblk * NT) {
        const int c = e & 63, q = (e >> 6) & 127, lb = e >> 13;
        const int seg = q >> 5, i = q & 31, chl = (seg >> 1) * 32 + i;
        const float* src = (seg & 1) ? p.in[10] : p.in[8];
        TG[e] = f2bf(src[((size_t)lb * 64 + c) * 64 + chl]);
    }
    for (int e = bid * NT + tidx(); e < DEPTH * 128 * 1024; e += nblk * NT) {
        const int k = e & 1023, n = (e >> 10) & 127, l = e >> 17;
        float v = 0.f;
        if (n < 4) v = p.in[26][((size_t)l * 1024 + k) * 4 + n];
        else if (n < 36) v = p.in[28][((size_t)l * 1024 + k) * 32 + (n - 4)];
        const bf16_t hi = f2bf(v);
        RH[e] = hi; RL[e] = f2bf(v - bf2f(hi));
    }
}

DI void job_merge(const Params& p, const LayerW& w, int bid, int nblk, unsigned char* lds) {
    const bf16_t* H = WSB(WS_H); bf16_t* M = WSB(WS_M);
    for (int u = bid; u < (T / G_BM) * 8; u += nblk) {
        const int m0 = (u >> 3) * G_BM, n0 = (u & 7) * G_BN;
        f32x16 macc[2][2];
#pragma unroll
        for (int a = 0; a < 2; ++a)
#pragma unroll
            for (int b = 0; b < 2; ++b)
#pragma unroll
                for (int i = 0; i < 16; ++i) macc[a][b][i] = 0.f;
#pragma unroll 1
        for (int n = 0; n < 4; ++n) {
            MG g; g.A = WSB(WS_BR) + n * 256; g.lda = 1024; g.Wt = w.t_br + (size_t)n * 1024 * 256; g.ldw = 256; g.K = 256;
            f32x16 acc[2][2];
            mgemm_tile(g, n0, RowId{m0}, acc, lds);
            const int l = tidx() & 63, wv = tidx() >> 6, wm = wv % G_WM, wn = wv / G_WM;
#pragma unroll
            for (int ft = 0; ft < 2; ++ft)
#pragma unroll
                for (int tt = 0; tt < 2; ++tt)
#pragma unroll
                    for (int i = 0; i < 4; ++i) {
                        const int lrow = wm * 64 + tt * 32 + (l & 31), feat = wn * 64 + ft * 32 + 8 * i + 4 * (l >> 5);
                        const float4 gv = ld4bf(H + (long)(m0 + lrow) * NH + O_MG + n * 1024 + n0 + feat);
                        macc[ft][tt][4 * i] += gv.x * acc[ft][tt][4 * i]; macc[ft][tt][4 * i + 1] += gv.y * acc[ft][tt][4 * i + 1];
                        macc[ft][tt][4 * i + 2] += gv.z * acc[ft][tt][4 * i + 2]; macc[ft][tt][4 * i + 3] += gv.w * acc[ft][tt][4 * i + 3];
                    }
        }
        MG_FOREACH(macc, lrow, feat, v, { st4bf(M + (long)(m0 + lrow) * 1024 + n0 + feat, v[0], v[1], v[2], v[3]); });
    }
}
DI void job_ln(const float* xin, const bf16_t* y, int ldy, const bf16_t* y2, const float* gw, const float* bw, float* out, bf16_t* outb, bf16_t* outl, int bid, int nblk) {
    const int lane = tidx() & 63, wid = tidx() >> 6;
    for (int t = bid * (NT / 64) + wid; t < T; t += nblk * (NT / 64)) {
        float v[16];
        float s = 0.f;
#pragma unroll
        for (int i = 0; i < 4; ++i) {
            const int c = i * 256 + lane * 4;
            const float4 xv = *(const float4*)(xin + (long)t * 1024 + c);
            float4 yv = ld4bf(y + (long)t * ldy + c);
            if (y2) { const float4 z = ld4bf(y2 + (long)t * ldy + c); yv.x += z.x; yv.y += z.y; yv.z += z.z; yv.w += z.w; }
            v[i * 4 + 0] = DN_ALPHA * xv.x + yv.x; v[i * 4 + 1] = DN_ALPHA * xv.y + yv.y; v[i * 4 + 2] = DN_ALPHA * xv.z + yv.z; v[i * 4 + 3] = DN_ALPHA * xv.w + yv.w;
            s += (v[i * 4] + v[i * 4 + 1]) + (v[i * 4 + 2] + v[i * 4 + 3]);
        }
        const float mu = wave_sum(s) * (1.f / 1024.f);
        float q = 0.f;
#pragma unroll
        for (int i = 0; i < 16; ++i) { const float dlt = v[i] - mu; q += dlt * dlt; }
        const float rstd = rsqrtf(wave_sum(q) * (1.f / 1024.f) + 1e-5f);
#pragma unroll
        for (int i = 0; i < 4; ++i) {
            const int c = i * 256 + lane * 4;
            const float4 gv = *(const float4*)(gw + c), bv = *(const float4*)(bw + c);
            const float o0 = (v[i * 4] - mu) * rstd * gv.x + bv.x, o1 = (v[i * 4 + 1] - mu) * rstd * gv.y + bv.y,
                        o2 = (v[i * 4 + 2] - mu) * rstd * gv.z + bv.z, o3 = (v[i * 4 + 3] - mu) * rstd * gv.w + bv.w;
            *(float4*)(out + (long)t * 1024 + c) = make_float4(o0, o1, o2, o3);
            if (outb) st4bf(outb + (long)t * 1024 + c, o0, o1, o2, o3);
            if (outl) st4bf(outl + (long)t * 1024 + c, o0 - bf2f(f2bf(o0)), o1 - bf2f(f2bf(o1)), o2 - bf2f(f2bf(o2)), o3 - bf2f(f2bf(o3)));
        }
    }
}
DI void job_router(const Params& p, const LayerW& w, int layer, int bid, int nblk) {
    const float* LOG = WSF(WS_LOG); int* EIDX = WSI(WS_EIDX); int* ESLOT = WSI(WS_ESLOT); float* EW = WSF(WS_EW);
    unsigned* cnt = WSU(WS_CTL) + CW_CNT + layer * 32;
    for (int t = bid * NT + tidx(); t < T; t += nblk * NT) {
        const float* lr = LOG + (long)t * 36; const float* lr1 = lr + (size_t)T * 36; const float* lr2 = lr1 + (size_t)T * 36;
#define LG(i) ((lr[i] + lr1[i]) + lr2[i])
        const float g0 = LG(0) + w.rg_b[0], g1 = LG(1) + w.rg_b[1], g2 = LG(2) + w.rg_b[2], g3 = LG(3) + w.rg_b[3];
        const float gm = fmaxf(fmaxf(g0, g1), fmaxf(g2, g3));
        const float e0 = expf(g0 - gm), e1 = expf(g1 - gm), e2 = expf(g2 - gm), e3 = expf(g3 - gm);
        const float gs = (e0 + e1) + (e2 + e3);
        const float p0 = e0 / gs, p1 = e1 / gs, p2 = e2 / gs, p3 = e3 / gs;
        int grp = 0; float pg = p0;
        if (p1 > pg) { pg = p1; grp = 1; }
        if (p2 > pg) { pg = p2; grp = 2; }
        if (p3 > pg) { pg = p3; grp = 3; }
        float el[8];
#pragma unroll
        for (int i = 0; i < 8; ++i) el[i] = LG(4 + grp * 8 + i) + w.re_b[grp * 8 + i];
#undef LG
        float em = el[0];
#pragma unroll
        for (int i = 1; i < 8; ++i) em = fmaxf(em, el[i]);
        float es = 0.f;
#pragma unroll
        for (int i = 0; i < 8; ++i) { el[i] = expf(el[i] - em); es += el[i]; }
#pragma unroll
        for (int i = 0; i < 8; ++i) el[i] = el[i] / es;
        float b0 = el[0]; int i0 = 0;
#pragma unroll
        for (int i = 1; i < 8; ++i) if (el[i] > b0) { b0 = el[i]; i0 = i; }
        float b1 = -1.f; int i1 = 0;
#pragma unroll
        for (int i = 0; i < 8; ++i) if (i != i0 && el[i] > b1) { b1 = el[i]; i1 = i; }
        const float den = b0 + b1;
        const int ex0 = grp * 8 + i0, ex1 = grp * 8 + i1;
        EIDX[t * 2] = ex0; EIDX[t * 2 + 1] = ex1;
        EW[t * 2] = pg * b0 / den; EW[t * 2 + 1] = pg * b1 / den;
        ESLOT[t * 2] = (int)atomicAdd(&cnt[ex0], 1u);
        ESLOT[t * 2 + 1] = (int)atomicAdd(&cnt[ex1], 1u);
    }
}
DI int pad_rows(int c) { return (c + G_BM - 1) / G_BM * G_BM; }
DI void job_fill(const Params& p, int layer, int bid, int nblk, unsigned char* lds) {
    const int* EIDX = WSI(WS_EIDX); const int* ESLOT = WSI(WS_ESLOT); int* PERM = WSI(WS_PERM);
    const bf16_t* X2 = WSB(WS_XBB); bf16_t* XG = WSB(WS_XG);
    unsigned* cnt = WSU(WS_CTL) + CW_CNT + layer * 32;
    const int lane = tidx() & 63, wid = tidx() >> 6;
    int* s_off = (int*)lds; int* s_cnt = s_off + 32;
    __syncthreads();
    if (tidx() < 32) s_cnt[tidx()] = (int)__hip_atomic_load(&cnt[tidx()], __ATOMIC_RELAXED, __HIP_MEMORY_SCOPE_AGENT);
    __syncthreads();
    if (tidx() == 0) { int o = 0; for (int e = 0; e < 32; ++e) { s_off[e] = o; o += pad_rows(s_cnt[e]); } }
    __syncthreads();
    for (int a = bid * (NT / 64) + wid; a < NASSIGN + NEXP; a += nblk * (NT / 64)) {
        const bool real = a < NASSIGN;
        const int e = real ? EIDX[a] : a - NASSIGN;
        const int off = s_off[e];
        if (real) {
            const int R = off + ESLOT[a];
            if (lane == 0) PERM[R] = a;
            const u32x4* src = (const u32x4*)(X2 + (long)(a >> 1) * 1024); u32x4* dst = (u32x4*)(XG + (long)R * 1024);
            dst[lane] = src[lane]; dst[lane + 64] = src[lane + 64];
        } else {
            const int c = s_cnt[e];
            for (int j = lane; c + j < pad_rows(c); j += 64) PERM[off + c + j] = -1;
        }
    }
}
DI pg8::ListOrder moe_units(unsigned* cnt, int bid, int nblk) {
    pg8::ListOrder S; S.n = 0; S.u0 = S.u1 = S.u2 = pg8::Unit{0, 0, 0};
    int rt = 0, ub = 0;
    for (int e = 0; e < 32; ++e) {
        const int c = pad_rows((int)__hip_atomic_load(&cnt[e], __ATOMIC_RELAXED, __HIP_MEMORY_SCOPE_AGENT)) >> 8, ue = c * 4;
#pragma unroll
        for (int k = 0; k < 3; ++k) {
            const int L = bid + k * nblk;
            if (L >= ub && L < ub + ue) { const int lu = L - ub; const pg8::Unit u{rt + (lu >> 2), lu & 3, e};
                if (k == 0) S.u0 = u; else if (k == 1) S.u1 = u; else S.u2 = u;
                S.n = k + 1; }
        }
        rt += c; ub += ue;
    }
#define RFL(x) x = __builtin_amdgcn_readfirstlane(x)
    RFL(S.n); RFL(S.u0.pm); RFL(S.u0.pn); RFL(S.u0.e); RFL(S.u1.pm); RFL(S.u1.pn); RFL(S.u1.e); RFL(S.u2.pm); RFL(S.u2.pn); RFL(S.u2.e);
#undef RFL
    return S;
}
typedef short s16x4 __attribute__((ext_vector_type(4)));
typedef short v4i16_t __attribute__((ext_vector_type(4)));
DI unsigned cvtpk(float lo, float hi) { return pk_bf16(lo, hi); }
DI int crow(int reg, int h) { return (reg & 3) + 8 * (reg >> 2) + 4 * h; }
DI s16x4 tr_read(const unsigned char* p) { return __builtin_bit_cast(s16x4, __builtin_amdgcn_ds_read_tr16_b64_v4i16((LAS v4i16_t*)p)); }
DI float xhalf_max(float m) { auto rr = __builtin_amdgcn_permlane32_swap(__float_as_uint(m), __float_as_uint(m), false, false); return fmaxf(__uint_as_float(rr[0]), __uint_as_float(rr[1])); }
DI float xhalf_sum(float m) { auto rr = __builtin_amdgcn_permlane32_swap(__float_as_uint(m), __float_as_uint(m), false, false); return __uint_as_float(rr[0]) + __uint_as_float(rr[1]); }
DI float xhalf_other(float v, int h) { auto rr = __builtin_amdgcn_permlane32_swap(__float_as_uint(v), __float_as_uint(v), false, false); return __uint_as_float(h ? rr[0] : rr[1]); }
DI bf16x8 pack8(const f32x16& x, int s2) {
    u32x4 pk; pk[0] = cvtpk(x[8 * s2], x[8 * s2 + 1]); pk[1] = cvtpk(x[8 * s2 + 2], x[8 * s2 + 3]); pk[2] = cvtpk(x[8 * s2 + 4], x[8 * s2 + 5]); pk[3] = cvtpk(x[8 * s2 + 6], x[8 * s2 + 7]);
    return __builtin_bit_cast(bf16x8, pk);
}
constexpr int ATT_QB = (NT / 64) * 32;
template <int DC> struct TileCfg { static constexpr int RS = DC * 2 + 16, BYTES = 64 * RS, NCH = 64 * DC / 8, NI = (NCH + NT - 1) / NT; };
template <int DC, class RowPtr> DI void tile_gload(u32x4 (&rg)[TileCfg<DC>::NI], RowPtr rp) {
#pragma unroll
    for (int i = 0; i < TileCfg<DC>::NI; ++i) { const int c = tidx() + NT * i; if (c < TileCfg<DC>::NCH) { const int row = c / (DC / 8), cc = c % (DC / 8); rg[i] = *(const u32x4*)(rp(row) + cc * 8); } }
}
template <int DC> DI void tile_lstore(const u32x4 (&rg)[TileCfg<DC>::NI], unsigned char* base) {
#pragma unroll
    for (int i = 0; i < TileCfg<DC>::NI; ++i) { const int c = tidx() + NT * i; if (c < TileCfg<DC>::NCH) { const int row = c / (DC / 8), cc = c % (DC / 8); *(u32x4*)(base + row * TileCfg<DC>::RS + cc * 16) = rg[i]; } }
}
template <int DK> DI void qk_tile(f32x16 (&s)[2], const bf16x8 (&qf)[DK / 16], const unsigned char* kl, int r, int h) {
    constexpr int RS = TileCfg<DK>::RS;
#pragma unroll
    for (int i = 0; i < 16; ++i) { s[0][i] = 0.f; s[1][i] = 0.f; }
#pragma unroll
    for (int ks = 0; ks < DK / 16; ++ks) {
        const bf16x8 k0 = *(const bf16x8*)(kl + r * RS + ks * 32 + h * 16), k1 = *(const bf16x8*)(kl + (32 + r) * RS + ks * 32 + h * 16);
        s[0] = __builtin_amdgcn_mfma_f32_32x32x16_bf16(k0, qf[ks], s[0], 0, 0, 0);
        s[1] = __builtin_amdgcn_mfma_f32_32x32x16_bf16(k1, qf[ks], s[1], 0, 0, 0);
    }
}
template <int DV> DI void pv_tile(f32x16 (&o)[DV / 32], const f32x16 (&pp)[2], const unsigned char* vl, int lane) {
    constexpr int RS = TileCfg<DV>::RS;
    const int h = lane >> 5, i16 = lane & 15, q = i16 >> 2, pq = i16 & 3, blk = (lane >> 4) & 1;
    const unsigned char* vb = vl + (4 * h + q) * RS + 2 * (16 * blk + 4 * pq);
#pragma unroll
    for (int kt = 0; kt < 2; ++kt)
#pragma unroll
        for (int s2 = 0; s2 < 2; ++s2) {
            const bf16x8 pf = pack8(pp[kt], s2);
#pragma unroll
            for (int dvt = 0; dvt < DV / 32; ++dvt) {
                const s16x4 lo = tr_read(vb + (kt * 32 + 16 * s2) * RS + dvt * 64), hi = tr_read(vb + (kt * 32 + 16 * s2 + 8) * RS + dvt * 64);
                const bf16x8 vf = __builtin_shufflevector(lo, hi, 0, 1, 2, 3, 4, 5, 6, 7);
                o[dvt] = __builtin_amdgcn_mfma_f32_32x32x16_bf16(vf, pf, o[dvt], 0, 0, 0);
            }
        }
}
template <int DK, int DV, class MaskFn>
DI void softmax_tile(const bf16x8 (&qf)[DK / 16], f32x16 (&o)[DV / 32], float& m, float& l, const unsigned char* kl, const unsigned char* vl, int kb, MaskFn mf, int lane) {
    const int r = lane & 31, h = lane >> 5;
    f32x16 s[2];
    qk_tile<DK>(s, qf, kl, r, h);
    float tmax = -INFINITY;
#pragma unroll
    for (int kt = 0; kt < 2; ++kt)
#pragma unroll
        for (int i = 0; i < 16; ++i) { const float v = mf(kb + kt * 32 + crow(i, h), s[kt][i]); s[kt][i] = v; tmax = fmaxf(tmax, v); }
    tmax = xhalf_max(tmax);
    const float mn = fmaxf(m, tmax), corr = __expf(m - mn);
    m = mn;
    float ps = 0.f;
#pragma unroll
    for (int kt = 0; kt < 2; ++kt)
#pragma unroll
        for (int i = 0; i < 16; ++i) { const float pr = __expf(s[kt][i] - mn); s[kt][i] = pr; ps += pr; }
    l = l * corr + ps;
#pragma unroll
    for (int dvt = 0; dvt < DV / 32; ++dvt)
#pragma unroll
        for (int i = 0; i < 16; ++i) o[dvt][i] *= corr;
    pv_tile<DV>(o, s, vl, lane);
}
template <int DK, int DV, int NHQ, class KPtr, class VPtr, class MaskFn>
DI void attn_stream(const bf16x8 (&qf)[NHQ][DK / 16], f32x16 (&o)[NHQ][DV / 32], float (&m)[NHQ], float (&l)[NHQ], unsigned tmask, int wave_qmax, int wave_kmin,
                    KPtr kp, VPtr vp, MaskFn mf, unsigned char* lds) {
    unsigned char* kl = lds; unsigned char* vl = lds + TileCfg<DK>::BYTES;
    const int lane = tidx() & 63;
    u32x4 kr[TileCfg<DK>::NI], vr[TileCfg<DV>::NI];
    if (tmask) { const int j = __builtin_ctz(tmask); tile_gload<DK>(kr, [&](int row) { return kp(j * 64 + row); }); tile_gload<DV>(vr, [&](int row) { return vp(j * 64 + row); }); }
    while (tmask) {
        const int j = __builtin_ctz(tmask); tmask &= tmask - 1;
        __syncthreads();
        tile_lstore<DK>(kr, kl); tile_lstore<DV>(vr, vl);
        __syncthreads();
        if (tmask) { const int jn = __builtin_ctz(tmask); tile_gload<DK>(kr, [&](int row) { return kp(jn * 64 + row); }); tile_gload<DV>(vr, [&](int row) { return vp(jn * 64 + row); }); }
        if (j * 64 <= wave_qmax && j * 64 + 63 >= wave_kmin) {
#pragma unroll
            for (int hq = 0; hq < NHQ; ++hq) softmax_tile<DK, DV>(qf[hq], o[hq], m[hq], l[hq], kl, vl, j * 64, [&](int key, float sc) { return mf(hq, key, sc); }, lane);
        }
    }
}

DI void job_mla_attn(const Params& p, int bid, int nblk, unsigned char* lds) {
    const bf16_t* QB = WSB(WS_QB); const bf16_t* KM = WSB(WS_KM); const bf16_t* VM = WSB(WS_VM); bf16_t* BR = WSB(WS_BR);
    constexpr int NQB = SEQ / ATT_QB, NU = BATCH * 4 * NQB;
    const int lane = tidx() & 63, wid = tidx() >> 6, r = lane & 31, h = lane >> 5;
    for (int u = bid; u < NU; u += nblk) {
        const int qblk = u / (BATCH * 4), bh = u % (BATCH * 4);
        const int b = bh >> 2, hd = bh & 3;
        const int q0 = qblk * ATT_QB, qw = q0 + wid * 32, qpos = qw + r;
        const long trow = (long)b * SEQ;
        bf16x8 qf[1][6];
#pragma unroll
        for (int ks = 0; ks < 6; ++ks) qf[0][ks] = *(const bf16x8*)(QB + (trow + qpos) * 384 + hd * 96 + ks * 16 + 8 * h);
        f32x16 o[1][2];
#pragma unroll
        for (int i = 0; i < 16; ++i) { o[0][0][i] = 0.f; o[0][1][i] = 0.f; }
        float m[1] = {-1e30f}, l[1] = {0.f};
        const int ntile = (q0 + ATT_QB - 1) / 64 + 1;
        const unsigned tmask = ntile >= 32 ? 0xffffffffu : ((1u << ntile) - 1u);
        attn_stream<96, 64, 1>(qf, o, m, l, tmask, qw + 31, 0,
            [&](int row) { return KM + (trow + row) * 384 + hd * 96; },
            [&](int row) { return VM + (trow + row) * 256 + hd * 64; },
            [&](int, int key, float sc) { return key <= qpos ? sc * 0.10206207261596577f : -INFINITY; }, lds);
        const float rl = 1.f / fmaxf(xhalf_sum(l[0]), 1e-30f);
        bf16_t* dst = BR + (trow + qpos) * 1024 + 3 * 256 + hd * 64;
#pragma unroll
        for (int dvt = 0; dvt < 2; ++dvt)
#pragma unroll
            for (int i = 0; i < 4; ++i)
                st4bf(dst + dvt * 32 + 8 * i + 4 * h, o[0][dvt][4 * i] * rl, o[0][dvt][4 * i + 1] * rl, o[0][dvt][4 * i + 2] * rl, o[0][dvt][4 * i + 3] * rl);
    }
}
DI void job_cross_attn(const Params& p, int layer, int bid, int nblk, unsigned char* lds) {
    const bf16_t* XQ = WSB(WS_XQ); const bf16_t* KVM = WSB(WS_KVM) + (size_t)layer * 2048 * 1024; bf16_t* XO = WSB(WS_XO);
    constexpr int NQB = SEQ / ATT_QB, NU = BATCH * 4 * NQB;
    const int lane = tidx() & 63, wid = tidx() >> 6, r = lane & 31, h = lane >> 5;
    for (int u = bid; u < NU; u += nblk) {
        const int bh = u % (BATCH * 4), qblk = u / (BATCH * 4);
        const int b = bh >> 2, hd = bh & 3;
        const int qpos = qblk * ATT_QB + wid * 32 + r;
        const long trow = (long)b * SEQ;
        bf16x8 qf[1][8];
#pragma unroll
        for (int ks = 0; ks < 8; ++ks) qf[0][ks] = *(const bf16x8*)(XQ + (trow + qpos) * 512 + hd * 128 + ks * 16 + 8 * h);
        f32x16 o[1][4];
#pragma unroll
        for (int d = 0; d < 4; ++d)
#pragma unroll
            for (int i = 0; i < 16; ++i) o[0][d][i] = 0.f;
        float m[1] = {-1e30f}, l[1] = {0.f};
        attn_stream<128, 128, 1>(qf, o, m, l, 0xFu, 1 << 30, 0,
            [&](int row) { return KVM + (long)(b * MEM_LEN + row) * 1024 + hd * 128; },
            [&](int row) { return KVM + (long)(b * MEM_LEN + row) * 1024 + 512 + hd * 128; },
            [&](int, int, float sc) { return sc * 0.08838834764831845f; }, lds);
        const float rl = 1.f / fmaxf(xhalf_sum(l[0]), 1e-30f);
        bf16_t* dst = XO + (trow + qpos) * 512 + hd * 128;
#pragma unroll
        for (int dvt = 0; dvt < 4; ++dvt)
#pragma unroll
            for (int i = 0; i < 4; ++i)
                st4bf(dst + dvt * 32 + 8 * i + 4 * h, o[0][dvt][4 * i] * rl, o[0][dvt][4 * i + 1] * rl, o[0][dvt][4 * i + 2] * rl, o[0][dvt][4 * i + 3] * rl);
    }
}
DI float logsig_fast(float z) { return fminf(z, 0.f) - __logf(1.f + __expf(-fabsf(z))); }
DI void job_sb_attn(const Params& p, int bid, int nblk, unsigned char* lds) {
    const bf16_t* H = WSB(WS_H); bf16_t* BR = WSB(WS_BR);
    constexpr int NQB = SEQ / ATT_QB, NU = BATCH * 4 * NQB;
    const int lane = tidx() & 63, wid = tidx() >> 6, r = lane & 31, h = lane >> 5;
    unsigned char* kl = lds; unsigned char* vl = lds + TileCfg<64>::BYTES;
    for (int u = bid; u < NU; u += nblk) {
        const int half = u / (NU / 2), ru = u % (NU / 2);
        const int qi = ru / (BATCH * 4), bh = ru % (BATCH * 4);
        const int qblk = half == 0 ? (NQB - 1 - qi) : qi;
        const int b = bh >> 2, hd = bh & 3;
        const int q0 = qblk * ATT_QB, qw = q0 + wid * 32, qpos = qw + r;
        const long trow = (long)b * SEQ;
        bf16x8 qf[4];
#pragma unroll
        for (int ks = 0; ks < 4; ++ks) qf[ks] = *(const bf16x8*)(H + (trow + qpos) * NH + O_BQ + hd * 64 + ks * 16 + 8 * h);
        f32x16 o[2];
#pragma unroll
        for (int i = 0; i < 16; ++i) { o[0][i] = 0.f; o[1][i] = 0.f; }
        float trun = 0.f;
        int j = (q0 + ATT_QB - 1) >> 6;
        volatile int* flag = (volatile int*)(lds + 2 * TileCfg<64>::BYTES);
        if (tidx() == 0) { flag[0] = 0; flag[1] = 0; }
        u32x4 kr[TileCfg<64>::NI], vr[TileCfg<64>::NI];
        tile_gload<64>(kr, [&](int row) { return H + (trow + j * 64 + row) * NH + O_BK + hd * 64; });
        tile_gload<64>(vr, [&](int row) { return H + (trow + j * 64 + row) * NH + O_BV + hd * 64; });
        for (int it = 0; j >= 0; --j, ++it) {
            __syncthreads();
            if (it > 0 && flag[(it - 1) & 1] == 0) break;
            tile_lstore<64>(kr, kl); tile_lstore<64>(vr, vl);
            __syncthreads();
            if (tidx() == 0) flag[(it + 1) & 1] = 0;
            if (j > 0) { const int jn = j - 1;
                tile_gload<64>(kr, [&](int row) { return H + (trow + jn * 64 + row) * NH + O_BK + hd * 64; });
                tile_gload<64>(vr, [&](int row) { return H + (trow + jn * 64 + row) * NH + O_BV + hd * 64; }); }
            const bool wave_dead = __all(trun < -110.f);
            if (j * 64 < qw + 31 && !wave_dead) {
                const int kb = j * 64;
                f32x16 s[2], L[2];
                qk_tile<64>(s, qf, kl, r, h);
#pragma unroll
                for (int kt = 0; kt < 2; ++kt)
#pragma unroll
                    for (int i = 0; i < 16; ++i) {
                        const int key = kb + kt * 32 + crow(i, h);
                        const float z = s[kt][i] * 0.125f, lsp = logsig_fast(z);
                        const bool valid = key < qpos;
                        L[kt][i] = valid ? lsp - z : 0.f;
                        s[kt][i] = valid ? lsp : -INFINITY;
                    }
                float G[2][4], O[2][4];
#pragma unroll
                for (int kt = 0; kt < 2; ++kt)
#pragma unroll
                    for (int ig = 0; ig < 4; ++ig) { G[kt][ig] = (L[kt][4 * ig] + L[kt][4 * ig + 1]) + (L[kt][4 * ig + 2] + L[kt][4 * ig + 3]); O[kt][ig] = xhalf_other(G[kt][ig], h); }
                float run = trun;
#pragma unroll
                for (int kt = 1; kt >= 0; --kt)
#pragma unroll
                    for (int ig = 3; ig >= 0; --ig) {
                        const float t3 = run + (h == 0 ? O[kt][ig] : 0.f);
                        const float t2 = t3 + L[kt][4 * ig + 3], t1 = t2 + L[kt][4 * ig + 2], t0 = t1 + L[kt][4 * ig + 1];
                        s[kt][4 * ig + 3] = __expf(s[kt][4 * ig + 3] + t3); s[kt][4 * ig + 2] = __expf(s[kt][4 * ig + 2] + t2);
                        s[kt][4 * ig + 1] = __expf(s[kt][4 * ig + 1] + t1); s[kt][4 * ig + 0] = __expf(s[kt][4 * ig + 0] + t0);
                        run += G[kt][ig] + O[kt][ig];
                    }
                trun = run;
                pv_tile<64>(o, s, vl, lane);
            }
            if (!__all(trun < -110.f)) flag[it & 1] = 1;
        }
        bf16_t* dst = BR + (trow + qpos) * 1024 + 1 * 256 + hd * 64;
#pragma unroll
        for (int dvt = 0; dvt < 2; ++dvt)
#pragma unroll
            for (int i = 0; i < 4; ++i) st4bf(dst + dvt * 32 + 8 * i + 4 * h, o[dvt][4 * i], o[dvt][4 * i + 1], o[dvt][4 * i + 2], o[dvt][4 * i + 3]);
    }
}
constexpr int NSA_QB = (NT / 128) * 32;
DI void job_nsa(const Params& p, int bid, int nblk, unsigned char* lds) {
    const bf16_t* H = WSB(WS_H); const bf16_t* KCB = WSB(WS_KCB); const bf16_t* VCB = KCB + (size_t)NCR * 64;
    float* OACC = WSF(WS_OC); bf16_t* BR = WSB(WS_BR);
    constexpr int NQB = SEQ / NSA_QB, NU = BATCH * 2 * NQB;
    constexpr int TB_ = TileCfg<64>::BYTES;
    const int lane = tidx() & 63, wid = tidx() >> 6, r = lane & 31, h = lane >> 5;
    const int n = wid & 1, sub = wid >> 1;
    unsigned* orw = (unsigned*)(lds + 4 * TB_);
    float* impx = (float*)(lds + 4 * TB_ + 64);
    for (int u = bid; u < NU; u += nblk) {
        const int qblk = NQB - 1 - u / (BATCH * 2), bg = u % (BATCH * 2), b = bg >> 1, g = bg & 1;
        const int q0 = qblk * NSA_QB, qw = q0 + sub * 32, qpos = qw + r;
        const int head = g * 2 + n;
        const long trow = (long)b * SEQ;
        const bf16_t* hq_row = H + (trow + qpos) * NH;
        bf16x8 qf[1][4];
#pragma unroll
        for (int ks = 0; ks < 4; ++ks) qf[0][ks] = *(const bf16x8*)(hq_row + O_AQ + head * 64 + ks * 16 + 8 * h);
        const float sl = exp2f(-2.f * (float)(head + 1));
        const float gate0 = sigm(bf2f(hq_row[O_AG + head * 3 + 0])), gate1 = sigm(bf2f(hq_row[O_AG + head * 3 + 1])), gate2 = sigm(bf2f(hq_row[O_AG + head * 3 + 2]));
        float* oacc = OACC + (trow + qpos) * 256 + head * 64;
        __syncthreads();
        if (tidx() == 0) *orw = 0u;
        {
            u32x4 rg[TileCfg<64>::NI];
#pragma unroll
            for (int tl = 0; tl < 4; ++tl) {
                const bf16_t* src = (tl & 2) ? VCB : KCB; const int cb = (tl & 1) * 64;
                tile_gload<64>(rg, [&](int row) { const int c = cb + row < NCMP ? cb + row : NCMP - 1; return src + ((long)(b * NCMP + c) * 2 + g) * 64; });
                tile_lstore<64>(rg, lds + tl * TB_);
            }
        }
        __syncthreads();
        float imp[16];
        {
            f32x16 s[2][2];
            qk_tile<64>(s[0], qf[0], lds, r, h);
            qk_tile<64>(s[1], qf[0], lds + TB_, r, h);
            float tmax = -INFINITY;
#pragma unroll
            for (int tl = 0; tl < 2; ++tl)
#pragma unroll
                for (int kt = 0; kt < 2; ++kt)
#pragma unroll
                    for (int i = 0; i < 16; ++i) {
                        const int c = tl * 64 + kt * 32 + crow(i, h), dist = qpos - (16 * c + 31);
                        const float v = (c < NCMP && dist >= 0) ? s[tl][kt][i] * 0.125f - sl * (float)dist : -INFINITY;
                        s[tl][kt][i] = v; tmax = fmaxf(tmax, v);
                    }
            const float mn = fmaxf(xhalf_max(tmax), -1e30f);
            float ps = 0.f;
#pragma unroll
            for (int tl = 0; tl < 2; ++tl)
#pragma unroll
                for (int kt = 0; kt < 2; ++kt)
#pragma unroll
                    for (int i = 0; i < 16; ++i) { const float pr = __expf(s[tl][kt][i] - mn); s[tl][kt][i] = pr; ps += pr; }
            const float rl = 1.f / fmaxf(xhalf_sum(ps), 1e-30f);
            float P3[16];
#pragma unroll
            for (int tl = 0; tl < 2; ++tl)
#pragma unroll
                for (int kt = 0; kt < 2; ++kt) {
#pragma unroll
                    for (int ig = 0; ig < 4; ++ig) {
                        const float p0 = s[tl][kt][4 * ig] * rl, p1 = s[tl][kt][4 * ig + 1] * rl, p2 = s[tl][kt][4 * ig + 2] * rl, p3 = s[tl][kt][4 * ig + 3] * rl;
                        imp[tl * 8 + kt * 4 + ig] = (p0 + p1) + (p2 + 0.5f * p3);
                        P3[tl * 8 + kt * 4 + ig] = 0.5f * p3;
                    }
                    const float gs = rl * gate0;
#pragma unroll
                    for (int i = 0; i < 16; ++i) s[tl][kt][i] *= gs;
                }
#pragma unroll
            for (int idx = 0; idx < 16; ++idx) {
                const float pp = xhalf_other(P3[idx], h);
                float prevp;
                if (idx == 0) prevp = h ? pp : 0.f; else { const float ppm = xhalf_other(P3[idx - 1], h); prevp = h ? pp : ppm; }
                imp[idx] += prevp;
                impx[(wid * 16 + idx) * 64 + lane] = imp[idx];
            }
            f32x16 oc[2];
#pragma unroll
            for (int i = 0; i < 16; ++i) { oc[0][i] = 0.f; oc[1][i] = 0.f; }
            pv_tile<64>(oc, s[0], lds + 2 * TB_, lane);
            pv_tile<64>(oc, s[1], lds + 3 * TB_, lane);
#pragma unroll
            for (int dvt = 0; dvt < 2; ++dvt)
#pragma unroll
                for (int i = 0; i < 4; ++i) *(float4*)(oacc + dvt * 32 + 8 * i + 4 * h) = make_float4(oc[dvt][4 * i], oc[dvt][4 * i + 1], oc[dvt][4 * i + 2], oc[dvt][4 * i + 3]);
        }
        __syncthreads();
        unsigned sel = 0u;
        {
            const int cur = qpos >> 6;
#pragma unroll
            for (int idx = 0; idx < 16; ++idx) {
                const float other = impx[((wid ^ 1) * 16 + idx) * 64 + lane];
                const float tot = n == 0 ? imp[idx] + other : other + imp[idx];
                const int j = 2 * idx + h;
                const bool forced = (j == 0) || (j == cur), valid = (j * 64 <= qpos);
                imp[idx] = forced ? 1e4f : (valid ? tot : -1.0f);
            }
#pragma unroll 1
            for (int it = 0; it < 8; ++it) {
                float best = -INFINITY; int bj = 64;
#pragma unroll
                for (int idx = 0; idx < 16; ++idx) if (imp[idx] > best) { best = imp[idx]; bj = 2 * idx + h; }
                const float pb = xhalf_other(best, h); const int pj = __float_as_int(xhalf_other(__int_as_float(bj), h));
                const bool own = (best > pb) || (best == pb && bj < pj);
                const int wj = own ? bj : pj;
                sel |= 1u << wj;
#pragma unroll
                for (int idx = 0; idx < 16; ++idx) if (2 * idx + h == wj) imp[idx] = -INFINITY;
            }
        }
        atomicOr(orw, sel);
        __syncthreads();
        const unsigned bmask = *orw;
        const int jhi = (q0 + NSA_QB - 1) >> 6;
        const unsigned upto = jhi >= 31 ? 0xffffffffu : ((1u << (jhi + 1)) - 1u);
        {
            f32x16 o[1][2];
#pragma unroll
            for (int i = 0; i < 16; ++i) { o[0][0][i] = 0.f; o[0][1][i] = 0.f; }
            float m[1] = {-1e30f}, l[1] = {0.f};
            const int jlo = (q0 - 511 > 0 ? q0 - 511 : 0) >> 6;
            const unsigned tmask = upto & ~((1u << jlo) - 1u);
            attn_stream<64, 64, 1>(qf, o, m, l, tmask, qw + 31, qw - 511,
                [&](int row) { return H + (trow + row) * NH + O_AKW + g * 64; },
                [&](int row) { return H + (trow + row) * NH + O_AVW + g * 64; },
                [&](int, int key, float sc) { const int dist = qpos - key; return (dist >= 0 && dist < 512) ? sc * 0.125f - sl * (float)dist : -INFINITY; }, lds);
            const float rl = gate2 / fmaxf(xhalf_sum(l[0]), 1e-30f);
#pragma unroll
            for (int dvt = 0; dvt < 2; ++dvt)
#pragma unroll
                for (int i = 0; i < 4; ++i) { float4* a = (float4*)(oacc + dvt * 32 + 8 * i + 4 * h); float4 c = *a;
                    c.x += o[0][dvt][4 * i] * rl; c.y += o[0][dvt][4 * i + 1] * rl; c.z += o[0][dvt][4 * i + 2] * rl; c.w += o[0][dvt][4 * i + 3] * rl; *a = c; }
        }
        {
            f32x16 o[1][2];
#pragma unroll
            for (int i = 0; i < 16; ++i) { o[0][0][i] = 0.f; o[0][1][i] = 0.f; }
            float m[1] = {-1e30f}, l[1] = {0.f};
            attn_stream<64, 64, 1>(qf, o, m, l, bmask & upto, qw + 31, 0,
                [&](int row) { return H + (trow + row) * NH + O_AKS + g * 64; },
                [&](int row) { return H + (trow + row) * NH + O_AVS + g * 64; },
                [&](int, int key, float sc) { const int dist = qpos - key; return (dist >= 0 && ((sel >> (key >> 6)) & 1u)) ? sc * 0.125f - sl * (float)dist : -INFINITY; }, lds);
            const float rl = gate1 / fmaxf(xhalf_sum(l[0]), 1e-30f);
            bf16_t* dst = BR + (trow + qpos) * 1024 + head * 64;
#pragma unroll
            for (int dvt = 0; dvt < 2; ++dvt)
#pragma unroll
                for (int i = 0; i < 4; ++i) { const float4 c = *(const float4*)(oacc + dvt * 32 + 8 * i + 4 * h);
                    st4bf(dst + dvt * 32 + 8 * i + 4 * h, c.x + o[0][dvt][4 * i] * rl, c.y + o[0][dvt][4 * i + 1] * rl, c.z + o[0][dvt][4 * i + 2] * rl, c.w + o[0][dvt][4 * i + 3] * rl); }
        }
    }
}
namespace pg8 { typedef PG8_LAS unsigned char* PG8_LAS_T; }
#define LDS3 ((pg8::PG8_LAS_T)lds)
#define GEMM256(EPI, SCHED, g, S, E) do { __syncthreads(); pg8::gemm_phase<EPI, SCHED, false, true>(LDS3, g, S, E); } while (0)
constexpr int NPH = 18;
constexpr int NPHASES = 2 + DEPTH * NPH;

__global__ void __launch_bounds__(NT, 2) mega(Params pk, int ph_lo, int ph_hi) {
    extern __shared__ __attribute__((aligned(16))) unsigned char lds[];
    const int bid = blockIdx.x, nblk = gridDim.x;
#define XB_HERE XcdBarrier bar_; bar_.bar = (unsigned*)(pk.ws + WS_CTL) + CW_BAR; bar_.x = xb_xcc_id(); bar_.st = (volatile LAS unsigned*)(lds + 131072)
    const bool multi = (ph_hi - ph_lo) > 1;
    if (multi) {
        uint4* xbw = (uint4*)(lds + 131072);
        if (tidx() == 0) *xbw = make_uint4(0u, 0u, 0u, 0u);
        __syncthreads();
        (void)xcd_barrier_post((unsigned*)(pk.ws + WS_CTL) + CW_BAR, (volatile LAS unsigned*)xbw);
    }
#ifndef PROBE_PH
#define PROBE_PH -100
#endif
#define PHASE(id, ...) do { const int _id = (id); if (ph_lo <= _id && _id < ph_hi) { for (int _rep = 0; _rep < ((PROBE_PH == -1 ? _id < 2 : (_id >= 2 && (_id - 2) % NPH == PROBE_PH)) ? 2 : 1); ++_rep) { if (_rep) { XB_HERE; xcd_barrier(bar_); } { Params p = pk; int layer = layer_; asm volatile("" : "+s"(p.ws), "+s"(p.out), "+s"(layer)); \
        const LayerW w = layer_w(p, layer); const float* Xin = (layer == 0) ? p.in[0] : WSF(WS_XC); const bf16_t* XinB = (layer == 0) ? WSB(WS_X0B) : WSB(WS_XCB); float* Xout = (layer == DEPTH - 1) ? p.out : WSF(WS_XC); \
        (void)w; (void)Xin; (void)XinB; (void)Xout; __VA_ARGS__; } } if (_id + 1 < ph_hi) { XB_HERE; xcd_barrier(bar_); } } } while (0)

    { const int layer_ = 0;
    PHASE(0, {
        job_wt<2>(p.in[2], DEPTH, 1024, NIN, WSB(WT_IN), NH, bid, nblk, lds);
        job_wt<0>(p.in[17], DEPTH * 4, 256, 1024, WSB(WT_BR), 1024, bid, nblk, lds);
        job_wt<0>(p.in[18], DEPTH, 1024, 1024, WSB(WT_OUT), 1024, bid, nblk, lds);
        job_wt<0>(p.in[21], DEPTH, 1024, 512, WSB(WT_Q), 512, bid, nblk, lds);
        job_wt<0>(p.in[22], DEPTH, 1024, 1024, WSB(WT_KV), 1024, bid, nblk, lds);
        job_wt<0>(p.in[23], DEPTH, 512, 1024, WSB(WT_O), 1024, bid, nblk, lds);
        job_wt<1>(p.in[30], DEPTH * 32, 1024, 1024, WSB(WT_GU), 1024, bid, nblk, lds);
        job_wt<0>(p.in[31], DEPTH * 32, 512, 1024, WSB(WT_DN), 1024, bid, nblk, lds);
        job_wt<0>(p.in[4], DEPTH * 2, 2048, 256, WSB(WT_C1), 256, bid, nblk, lds);
        job_wt<0>(p.in[5], DEPTH * 2, 256, 64, WSB(WT_C2), 128, bid, nblk, lds);
        job_wt<0>(p.in[15], DEPTH, 192, 384, WSB(WT_UQ), 384, bid, nblk, lds);
        job_wt<0>(p.in[16], DEPTH, 128, 512, WSB(WT_UKV), 512, bid, nblk, lds);
        job_pack_small(p, bid, nblk);
        job_cvt(p.in[0], WSB(WS_X0B), (long)T * 1024, bid, nblk);
        job_cvt(p.in[1], WSB(WS_MEMB), (long)2048 * 1024, bid, nblk);
    });
    PHASE(1, {
        pg8::Gemm g{WSB(WS_MEMB), WSB(WT_KV), BATCH * MEM_LEN, 1024, 1024};
        GroupedOrder S{8, 4, DEPTH, nblk, bid};
        EpiStoreBf16 E{WSB(WS_KVM), 1024, 1 << 30, (long)2048 * 1024};
        GEMM256(EpiStoreBf16, GroupedOrder, g, S, E);
    });
    }
    for (int layer_ = 0; layer_ < DEPTH; ++layer_) {
        const int base = 2 + layer_ * NPH;
        PHASE(base + 0, { pg8::Gemm g{XinB, w.t_in, T, NH, 1024}; pg8::StaticOrder S; S.init(T, NH, nblk, bid); EpiStoreBf16 E{WSB(WS_H), NH, O_MG / 128, 0}; GEMM256(EpiStoreBf16, pg8::StaticOrder, g, S, E); });
        PHASE(base + 1, { job_sb_attn(p, bid, nblk, lds); job_cmp_gather(p, w, bid, nblk); job_rnn_conv(p, w, bid, nblk); job_mla_norm(p, w, bid, nblk); });
        PHASE(base + 2, { if (bid < 16) job_cmp_mlp<0>(p, w, bid, 16, lds); else { job_rnn_gates(p, w, bid - 16, nblk - 16, lds); job_mla_up(p, w, bid - 16, nblk - 16, lds); } });
        PHASE(base + 3, { job_cmp_mlp<1>(p, w, bid, nblk, lds); job_rnn_scan1(p, bid, nblk); });
        PHASE(base + 4, { job_nsa(p, bid, nblk, lds); job_mla_attn(p, bid, nblk, lds); job_rnn_scan2(p, bid, nblk); });
        PHASE(base + 5, { job_merge(p, w, bid, nblk, lds); });
        PHASE(base + 6, { pg8::Gemm g{WSB(WS_M), w.t_out, T, 1024, 1024}; pg8::StaticOrder S; S.init(T, 1024, nblk, bid); EpiStoreBf16 E{WSB(WS_Y), 1024, 1 << 30, 0}; GEMM256(EpiStoreBf16, pg8::StaticOrder, g, S, E); });
        PHASE(base + 7, { job_ln(Xin, WSB(WS_Y), 1024, nullptr, w.ln1_g, w.ln1_b, WSF(WS_XA), WSB(WS_XAB), nullptr, bid, nblk); });
        PHASE(base + 8, { pg8::Gemm g{WSB(WS_XAB), w.t_q, T, 512, 1024}; pg8::StaticOrder S; S.init(T, 512, nblk, bid); EpiStoreBf16 E{WSB(WS_XQ), 512, 1 << 30, 0}; GEMM256(EpiStoreBf16, pg8::StaticOrder, g, S, E); });
        PHASE(base + 9, { job_cross_attn(p, layer, bid, nblk, lds); });
        PHASE(base + 10, { pg8::Gemm g{WSB(WS_XO), w.t_o, T, 1024, 512}; pg8::StaticOrder S; S.init(T, 1024, nblk, bid); EpiStoreBf16 E{WSB(WS_Y), 1024, 1 << 30, 0}; GEMM256(EpiStoreBf16, pg8::StaticOrder, g, S, E); });
        PHASE(base + 11, { job_ln(WSF(WS_XA), WSB(WS_Y), 1024, nullptr, w.ln2_g, w.ln2_b, WSF(WS_XB), WSB(WS_XBB), WSB(WS_XBL), bid, nblk); });
        PHASE(base + 12, { job_router_logits(p, w, bid, nblk, lds); });
        PHASE(base + 13, { job_router(p, w, layer, bid, nblk); });
        PHASE(base + 14, { job_fill(p, layer, bid, nblk, lds); });
        PHASE(base + 15, { const pg8::ListOrder S = moe_units(WSU(WS_CTL) + CW_CNT + layer * 32, bid, nblk); pg8::Gemm g{WSB(WS_XG), w.t_gu, PADROWS, 1024, 1024}; EpiMoeGU E{WSB(WS_HH)}; GEMM256(EpiMoeGU, pg8::ListOrder, g, S, E); });
        PHASE(base + 16, { const pg8::ListOrder S = moe_units(WSU(WS_CTL) + CW_CNT + layer * 32, bid, nblk); pg8::Gemm g{WSB(WS_HH), w.t_dn, PADROWS, 1024, 512}; EpiMoeDown E{WSI(WS_PERM), WSF(WS_EW), WSB(WS_YK)}; GEMM256(EpiMoeDown, pg8::ListOrder, g, S, E); });
        PHASE(base + 17, { job_ln(WSF(WS_XB), WSB(WS_YK), 2048, WSB(WS_YK) + 1024, w.ln3_g, w.ln3_b, Xout, (layer == DEPTH - 1) ? nullptr : WSB(WS_XCB), nullptr, bid, nblk); });
    }
}

extern "C" void kernel_launch(void* const* d_in, const int* in_sizes, int n_in, void* d_out, int out_size, void* d_ws, size_t ws_size, hipStream_t stream) {
    constexpr size_t kDynLds = 131072 + 1024;
    static_assert(2 * G_STAGE + 1024 <= 131072, "engine stages fit");
    static int grid = 0;
    if (!grid) {
        int dev = 0, cus = 0, per_cu = 0;
        (void)hipGetDevice(&dev);
        (void)hipDeviceGetAttribute(&cus, hipDeviceAttributeMultiprocessorCount, dev);
        (void)hipFuncSetAttribute((const void*)mega, hipFuncAttributeMaxDynamicSharedMemorySize, (int)kDynLds);
        (void)hipOccupancyMaxActiveBlocksPerMultiprocessor(&per_cu, mega, NT, kDynLds);
        if (per_cu < 1) per_cu = 1;
        grid = cus * (per_cu < 2 ? per_cu : 2);
    }
    if (ws_size < WS_END) { fprintf(stderr, "workspace too small: %zu < %zu\n", ws_size, (size_t)WS_END); return; }
    Params p{};
    for (int i = 0; i < 34; ++i) p.in[i] = (const float*)d_in[i];
    p.out = (float*)d_out;
    p.ws = (unsigned char*)d_ws;
    (void)hipMemsetAsync(d_ws, 0, CTL_BYTES, stream);
#if MK_ONE_LAUNCH
    hipLaunchKernelGGL(mega, dim3(grid), dim3(NT), kDynLds, stream, p, 0, NPHASES);
#else
    for (int ph = 0; ph < NPHASES; ++ph) hipLaunchKernelGGL(mega, dim3(grid), dim3(NT), kDynLds, stream, p, ph, ph + 1);
#endif
}
```

```cpp
#include <hip/hip_runtime.h>
#include <stdint.h>
#include <stdio.h>

#ifndef MK_ONE_LAUNCH
#define MK_ONE_LAUNCH 1
#endif

#define DI __device__ __forceinline__
#define LAS __attribute__((address_space(3)))
DI int tidx() { int t = threadIdx.x; asm volatile("" : "+v"(t)); return t; }

constexpr int NT = 512;
constexpr int D = 1024, BATCH = 8, SEQ = 2048, T = BATCH * SEQ, DEPTH = 4;
constexpr int MEM_LEN = 256;
constexpr int NIN = 6764, NH = 6912;
constexpr int O_AQ = 0, O_AKC = 256, O_AVC = 384, O_AKS = 512, O_AVS = 640, O_AKW = 768, O_AVW = 896,
              O_BQ = 1024, O_BK = 1280, O_BV = 1536, O_CX = 1792, O_CG = 2048, O_DCQ = 2304, O_DCKV = 2496, O_DKR = 2624,
              O_AG = 2656, O_MG = 2688;
constexpr int NCMP = 127, NCR = BATCH * NCMP * 2;
constexpr int NEXP = 32, NASSIGN = T * 2;
constexpr float DN_ALPHA = 1.681792830507429f;

typedef unsigned short bf16_t;
typedef short bf16x8 __attribute__((ext_vector_type(8)));
typedef float f32x16 __attribute__((ext_vector_type(16)));
typedef unsigned u32x4 __attribute__((ext_vector_type(4)));

constexpr int G_WM = NT / 128;
constexpr int G_BM = 64 * G_WM;
constexpr int G_BN = 128;
constexpr int G_RS = 144;
constexpr int G_STAGE = (G_BM + G_BN) * G_RS;
constexpr int PADROWS = ((NASSIGN + NEXP * (G_BM - 1) + G_BM - 1) / G_BM) * G_BM;

constexpr size_t MiB = 1u << 20;
constexpr size_t al(size_t x) { return (x + 255) & ~(size_t)255; }
constexpr size_t WS_CTL = 0, CTL_BYTES = 1 * MiB;
constexpr size_t WT_IN = WS_CTL + CTL_BYTES;
constexpr size_t WT_BR = WT_IN + al((size_t)DEPTH * NH * 1024 * 2);
constexpr size_t WT_OUT = WT_BR + al((size_t)DEPTH * 4 * 1024 * 256 * 2);
constexpr size_t WT_Q = WT_OUT + al((size_t)DEPTH * 1024 * 1024 * 2);
constexpr size_t WT_KV = WT_Q + al((size_t)DEPTH * 512 * 1024 * 2);
constexpr size_t WT_O = WT_KV + al((size_t)DEPTH * 1024 * 1024 * 2);
constexpr size_t WT_GU = WT_O + al((size_t)DEPTH * 1024 * 512 * 2);
constexpr size_t WT_DN = WT_GU + al((size_t)DEPTH * 32 * 1024 * 1024 * 2);
constexpr size_t WS_X0B = WT_DN + al((size_t)DEPTH * 32 * 1024 * 512 * 2);
constexpr size_t WS_MEMB = WS_X0B + al((size_t)T * 1024 * 2);
constexpr size_t WS_H = WS_MEMB + al((size_t)2048 * 1024 * 2);
constexpr size_t SZ_H = al((size_t)T * NH * 2);
constexpr size_t WS_YK = WS_H;
constexpr size_t WS_HH = WS_YK + (size_t)NASSIGN * 1024 * 2;
static_assert(WS_HH + (size_t)PADROWS * 512 * 2 <= WS_H + SZ_H, "moe overlay fits in H");
constexpr size_t WS_TB = WS_H + SZ_H;
constexpr size_t WS_HID = WS_TB + al((size_t)2 * NCR * 2048 * 4);
constexpr size_t WS_KCVC = WS_HID + al((size_t)2 * NCR * 256 * 4);
constexpr size_t WS_PC = WS_KCVC + al((size_t)2 * NCR * 64 * 4);
constexpr size_t WS_SEL = WS_PC + al((size_t)BATCH * 4 * SEQ * 128 * 4);
constexpr size_t WS_OW = WS_SEL + al((size_t)BATCH * 2 * SEQ * 4);
constexpr size_t WS_OC = WS_OW + al((size_t)T * 256 * 4);
constexpr size_t WS_BR = WS_OC + al((size_t)T * 256 * 4);
constexpr size_t WS_U = WS_BR + al((size_t)T * 1024 * 2);
constexpr size_t WS_RA = WS_U + al((size_t)T * 256 * 4);
constexpr size_t WS_RB = WS_RA + al((size_t)T * 256 * 4);
constexpr size_t WS_CQN = WS_RB + al((size_t)T * 256 * 4);
constexpr size_t WS_CKVN = WS_CQN + al((size_t)T * 192 * 4);
constexpr size_t WS_KR = WS_CKVN + al((size_t)T * 128 * 4);
constexpr size_t WS_Q = WS_KR + al((size_t)T * 32 * 4);
constexpr size_t WS_KV = WS_Q + al((size_t)T * 384 * 4);
constexpr size_t WS_M = WS_KV + al((size_t)T * 512 * 4);
constexpr size_t WS_Y = WS_M + al((size_t)T * 1024 * 2);
constexpr size_t WS_XA = WS_Y + al((size_t)T * 1024 * 4);
constexpr size_t WS_XB = WS_XA + al((size_t)T * 1024 * 4);
constexpr size_t WS_XC = WS_XB + al((size_t)T * 1024 * 4);
constexpr size_t WS_XAB = WS_XC + al((size_t)T * 1024 * 4);
constexpr size_t WS_XBB = WS_XAB + al((size_t)T * 1024 * 2);
constexpr size_t WS_XCB = WS_XBB + al((size_t)T * 1024 * 2);
constexpr size_t WS_XQ = WS_XCB + al((size_t)T * 1024 * 2);
constexpr size_t WS_XO = WS_XQ + al((size_t)T * 512 * 2);
constexpr size_t WS_KVM = WS_XO + al((size_t)T * 512 * 2);
constexpr size_t WS_LOG = WS_KVM + al((size_t)DEPTH * 2048 * 1024 * 2);
constexpr size_t WS_EIDX = WS_LOG + al((size_t)3 * T * 36 * 4);
constexpr size_t WS_ESLOT = WS_EIDX + al((size_t)NASSIGN * 4);
constexpr size_t WS_EW = WS_ESLOT + al((size_t)NASSIGN * 4);
constexpr size_t WS_PERM = WS_EW + al((size_t)NASSIGN * 4);
constexpr size_t WS_QB = WS_PERM + al((size_t)PADROWS * 4);
constexpr size_t WS_KM = WS_QB + al((size_t)T * 384 * 2);
constexpr size_t WS_VM = WS_KM + al((size_t)T * 384 * 2);
constexpr size_t WS_KCB = WS_VM + al((size_t)T * 256 * 2);
constexpr size_t WT_C1 = WS_KCB + al((size_t)2 * NCR * 64 * 2);
constexpr size_t WT_C2 = WT_C1 + al((size_t)DEPTH * 2 * 256 * 2048 * 2);
constexpr size_t WT_UQ = WT_C2 + al((size_t)DEPTH * 2 * 128 * 256 * 2);
constexpr size_t WT_UKV = WT_UQ + al((size_t)DEPTH * 384 * 192 * 2);
constexpr size_t WT_G = WT_UKV + al((size_t)DEPTH * 512 * 128 * 2);
constexpr size_t WT_RH = WT_G + al((size_t)DEPTH * 4 * 128 * 64 * 2);
constexpr size_t WT_RL = WT_RH + al((size_t)DEPTH * 128 * 1024 * 2);
constexpr size_t WS_TBB = WT_RL + al((size_t)DEPTH * 128 * 1024 * 2);
constexpr size_t WS_HIDB = WS_TBB + al((size_t)2 * 2048 * 2048 * 2);
constexpr size_t WS_UB = WS_HIDB + al((size_t)2 * 2048 * 256 * 2);
constexpr size_t WS_CQNB = WS_UB + al((size_t)T * 256 * 2);
constexpr size_t WS_CKVNB = WS_CQNB + al((size_t)T * 192 * 2);
constexpr size_t WS_XBL = WS_CKVNB + al((size_t)T * 128 * 2);
constexpr size_t WS_SA = WS_XBL + al((size_t)T * 1024 * 2);
constexpr size_t WS_SH = WS_SA + al((size_t)BATCH * 32 * 256 * 4);
constexpr size_t WS_XG = WS_SH + al((size_t)BATCH * 32 * 256 * 4);
constexpr size_t WS_ROPE = WS_XG + al((size_t)PADROWS * 1024 * 2);
constexpr size_t WS_END = WS_ROPE + al((size_t)SEQ * 16 * 2 * 4);

constexpr int CW_BAR = 4096;
constexpr int CW_CNT = 16384;

struct Params {
    const float* in[34];
    float* out;
    unsigned char* ws;
};

#define XB_TMO      128
#define XB_XCNT(j)  (256  + 64 * (j))
#define XB_XSUB(j)  (1280 + 64 * (j))
#define XB_XGEN(j)  (2304 + 64 * (j))
#define XB_TOP      3328
#define XB_TOPGEN   3392
#define XCD_BAR_WORDS 3456
#define XB_SPIN_CAP (1u << 22)

__device__ __forceinline__ unsigned xb_ld(unsigned* p)              { return __hip_atomic_load(p, __ATOMIC_RELAXED, __HIP_MEMORY_SCOPE_AGENT); }
__device__ __forceinline__ unsigned xb_add(unsigned* p, unsigned v) { return __hip_atomic_fetch_add(p, v, __ATOMIC_RELAXED, __HIP_MEMORY_SCOPE_AGENT); }
__device__ __forceinline__ unsigned xb_xcc_id() { return (unsigned)__builtin_amdgcn_s_getreg((3 << 11) | 20) & 0xFu; }
#define XB_SPIN(cond, bar) do { unsigned _sp = 0; while (cond) { __builtin_amdgcn_s_sleep(1); \
    if ((++_sp & 255u) == 0u) { if (xb_ld(&(bar)[XB_TMO])) break; if (_sp > XB_SPIN_CAP) { atomicAdd(&(bar)[XB_TMO], 1u); break; } } } } while (0)

struct XcdBarrier { unsigned* bar; unsigned x; volatile LAS unsigned* st; };

__device__ __forceinline__ XcdBarrier xcd_barrier_post(unsigned* bar, volatile LAS unsigned* st) {
    XcdBarrier b; b.bar = bar; b.x = xb_xcc_id(); b.st = st;
    if (threadIdx.x == 0) (void)xb_add(&bar[XB_XCNT(b.x)], 1u);
    return b;
}
__device__ __forceinline__ void xcd_barrier_complete(unsigned* bar, unsigned x, unsigned& nloc, unsigned& nx) {
    const unsigned G = gridDim.x * gridDim.y * gridDim.z;
    unsigned sum, cnt, mine, sp = 0u;
    for (;;) {
        sum = 0u; cnt = 0u; mine = 0u;
#pragma unroll
        for (unsigned j = 0; j < 16; ++j) { const unsigned c = xb_ld(&bar[XB_XCNT(j)]); sum += c; cnt += (c > 0u) ? 1u : 0u; mine = (j == x) ? c : mine; }
        if (sum == G) break;
        __builtin_amdgcn_s_sleep(1);
        if ((++sp & 255u) == 0u) { if (xb_ld(&bar[XB_TMO])) break; if (sp > XB_SPIN_CAP) { atomicAdd(&bar[XB_TMO], 1u); break; } }
    }
    nloc = mine > 0u ? mine : 1u; nx = cnt > 0u ? cnt : 1u;
}
__device__ __forceinline__ void xcd_barrier(const XcdBarrier& b) {
    asm volatile("s_waitcnt vmcnt(0)" ::: "memory");
    __syncthreads();
    if (threadIdx.x == 0) {
        unsigned* bar = b.bar;
        __builtin_amdgcn_s_waitcnt(0);
        unsigned nloc = b.st[0], nx = b.st[1];
        if (nloc == 0u) { xcd_barrier_complete(bar, b.x, nloc, nx); b.st[0] = nloc; b.st[1] = nx; }
        const unsigned old = xb_add(&bar[XB_XSUB(b.x)], 1u);
        const unsigned gen = old / nloc;
        if (old + 1u == (gen + 1u) * nloc) {
            __builtin_amdgcn_fence(__ATOMIC_RELEASE, "agent");
            asm volatile("s_waitcnt vmcnt(0)" ::: "memory");
            const unsigned og = xb_add(&bar[XB_TOP], 1u);
            const unsigned tg = og / nx;
            if (og + 1u == (tg + 1u) * nx) xb_add(&bar[XB_TOPGEN], 1u);
            else XB_SPIN(xb_ld(&bar[XB_TOPGEN]) == tg, bar);
            __builtin_amdgcn_fence(__ATOMIC_ACQUIRE, "agent");
            xb_add(&bar[XB_XGEN(b.x)], 1u);
            asm volatile("s_waitcnt vmcnt(0)" ::: "memory");
        } else {
            XB_SPIN(xb_ld(&bar[XB_XGEN(b.x)]) == gen, bar);
            __builtin_amdgcn_fence(__ATOMIC_ACQUIRE, "agent");
            asm volatile("s_waitcnt vmcnt(0)" ::: "memory");
        }
    }
    __syncthreads();
}

DI float gelu_tanh(float x) { const float u = 0.7978845608028654f * (x + 0.044715f * x * x * x); return 0.5f * x * (1.f + tanhf(u)); }
DI float sigm(float x) { return 1.f / (1.f + expf(-x)); }
DI float sigm_fast(float x) { return __builtin_amdgcn_rcpf(1.f + __expf(-x)); }
DI float logsig(float z) { return fminf(z, 0.f) - log1pf(expf(-fabsf(z))); }
DI float wave_sum(float v) {
    const int lane = tidx() & 63;
#pragma unroll
    for (int o = 32; o > 0; o >>= 1) v += __int_as_float(__builtin_amdgcn_ds_bpermute((lane ^ o) << 2, __float_as_int(v)));
    return v;
}

DI float bflo(unsigned u) { return __uint_as_float(u << 16); }
DI float bfhi(unsigned u) { return __uint_as_float(u & 0xffff0000u); }
DI float bf2f(bf16_t x) { return __uint_as_float((unsigned)x << 16); }
typedef float f32x2_t __attribute__((ext_vector_type(2)));
typedef __bf16 bf16x2_t __attribute__((ext_vector_type(2)));
DI unsigned pk_bf16(float lo, float hi) { f32x2_t v = {lo, hi}; bf16x2_t b = __builtin_convertvector(v, bf16x2_t); return __builtin_bit_cast(unsigned, b); }
DI bf16_t f2bf(float x) { return (bf16_t)(pk_bf16(x, 0.f) & 0xffffu); }
DI void st4bf(bf16_t* p, float a, float b, float c, float d) { uint2 v; v.x = pk_bf16(a, b); v.y = pk_bf16(c, d); *(uint2*)p = v; }
DI float4 ld4bf(const bf16_t* p) { const uint2 v = *(const uint2*)p; return make_float4(bflo(v.x), bfhi(v.x), bflo(v.y), bfhi(v.y)); }
template <int N> DI float dot_row(const float* q, const bf16_t* kr) {
    float dot = 0.f;
#pragma unroll
    for (int d = 0; d < N; d += 8) { const uint4 v = *(const uint4*)(kr + d);
        dot = fmaf(q[d], bflo(v.x), dot); dot = fmaf(q[d + 1], bfhi(v.x), dot); dot = fmaf(q[d + 2], bflo(v.y), dot); dot = fmaf(q[d + 3], bfhi(v.y), dot);
        dot = fmaf(q[d + 4], bflo(v.z), dot); dot = fmaf(q[d + 5], bfhi(v.z), dot); dot = fmaf(q[d + 6], bflo(v.w), dot); dot = fmaf(q[d + 7], bfhi(v.w), dot); }
    return dot;
}
template <int N> DI float dot_row(const float* q, const float* kr) {
    float dot = 0.f;
#pragma unroll
    for (int d = 0; d < N; ++d) dot = fmaf(q[d], kr[d], dot);
    return dot;
}
template <int N> DI void axpy_row(float* o, float pr, float corr, const bf16_t* vr) {
#pragma unroll
    for (int d = 0; d < N; d += 8) { const uint4 v = *(const uint4*)(vr + d);
        o[d] = fmaf(pr, bflo(v.x), o[d] * corr); o[d + 1] = fmaf(pr, bfhi(v.x), o[d + 1] * corr); o[d + 2] = fmaf(pr, bflo(v.y), o[d + 2] * corr); o[d + 3] = fmaf(pr, bfhi(v.y), o[d + 3] * corr);
        o[d + 4] = fmaf(pr, bflo(v.z), o[d + 4] * corr); o[d + 5] = fmaf(pr, bfhi(v.z), o[d + 5] * corr); o[d + 6] = fmaf(pr, bflo(v.w), o[d + 6] * corr); o[d + 7] = fmaf(pr, bfhi(v.w), o[d + 7] * corr); }
}
template <int N> DI void axpy_row(float* o, float pr, float corr, const float* vr) {
#pragma unroll
    for (int d = 0; d < N; ++d) o[d] = fmaf(pr, vr[d], o[d] * corr);
}
template <int N> DI void ld_row(float* q, const bf16_t* p) {
#pragma unroll
    for (int d = 0; d < N; d += 8) { const uint4 v = *(const uint4*)(p + d);
        q[d] = bflo(v.x); q[d + 1] = bfhi(v.x); q[d + 2] = bflo(v.y); q[d + 3] = bfhi(v.y); q[d + 4] = bflo(v.z); q[d + 5] = bfhi(v.z); q[d + 6] = bflo(v.w); q[d + 7] = bfhi(v.w); }
}
template <int N> DI void ld_row(float* q, const float* p) {
#pragma unroll
    for (int d = 0; d < N; d += 4) { const float4 v = *(const float4*)(p + d); q[d] = v.x; q[d + 1] = v.y; q[d + 2] = v.z; q[d + 3] = v.w; }
}

struct MG { const bf16_t* A; long lda; const bf16_t* Wt; long ldw; int K; };

struct NoFlush { DI void operator()(int, f32x16 (&)[2][2]) const {} };
template <class RowFn, class Flush>
DI void mgemm_tile_f(const MG& g, int n0, RowFn rowfn, f32x16 (&acc)[2][2], unsigned char* lds, bool zero, int flush_every, Flush flush) {
    constexpr int XI = G_BM * 8 / NT, WI = G_BN * 8 / NT;
    const int tid = tidx(), lane = tid & 63, wid = tid >> 6, r = lane & 31, h = lane >> 5;
    const int wm = wid % G_WM, wn = wid / G_WM;
    const int cc = tid & 7, row0 = tid >> 3;
    const bf16_t* xp[XI]; const bf16_t* wp[WI];
#pragma unroll
    for (int i = 0; i < XI; ++i) xp[i] = g.A + (long)rowfn(row0 + (NT / 8) * i) * g.lda + cc * 8;
#pragma unroll
    for (int i = 0; i < WI; ++i) wp[i] = g.Wt + (long)(n0 + row0 + (NT / 8) * i) * g.ldw + cc * 8;
    const int st_off = row0 * G_RS + cc * 16;
    if (zero)
#pragma unroll
    for (int a = 0; a < 2; ++a)
#pragma unroll
        for (int b = 0; b < 2; ++b)
#pragma unroll
            for (int i = 0; i < 16; ++i) acc[a][b][i] = 0.f;
    const int nk = g.K >> 6;
    u32x4 xv0[XI], wv0[WI], xv1[XI], wv1[WI];
#define MG_GLOAD(XV, WV, KT) do { _Pragma("unroll") for (int i = 0; i < XI; ++i) XV[i] = *(const u32x4*)(xp[i] + (KT) * 64); \
                                  _Pragma("unroll") for (int i = 0; i < WI; ++i) WV[i] = *(const u32x4*)(wp[i] + (KT) * 64); } while (0)
#define MG_LSTORE(XV, WV, STG) do { unsigned char* _s = lds + (STG) * G_STAGE; \
        _Pragma("unroll") for (int i = 0; i < XI; ++i) *(u32x4*)(_s + st_off + (NT / 8) * i * G_RS) = XV[i]; \
        _Pragma("unroll") for (int i = 0; i < WI; ++i) *(u32x4*)(_s + G_BM * G_RS + st_off + (NT / 8) * i * G_RS) = WV[i]; } while (0)
    MG_GLOAD(xv0, wv0, 0);
    if (nk > 1) MG_GLOAD(xv1, wv1, 1);
    __syncthreads();
    MG_LSTORE(xv0, wv0, 0);
    if (nk > 2) MG_GLOAD(xv0, wv0, 2);
    __syncthreads();
    const int xf_off = (wm * 64 + r) * G_RS + h * 16, wf_off = G_BM * G_RS + (wn * 64 + r) * G_RS + h * 16;
#define MG_COMPUTE(STG) do { const unsigned char* st = lds + (STG) * G_STAGE; \
        _Pragma("unroll") for (int ks = 0; ks < 4; ++ks) { \
            const bf16x8 w0 = *(const bf16x8*)(st + wf_off + ks * 32), w1 = *(const bf16x8*)(st + wf_off + 32 * G_RS + ks * 32); \
            const bf16x8 x0 = *(const bf16x8*)(st + xf_off + ks * 32), x1 = *(const bf16x8*)(st + xf_off + 32 * G_RS + ks * 32); \
            acc[0][0] = __builtin_amdgcn_mfma_f32_32x32x16_bf16(w0, x0, acc[0][0], 0, 0, 0); \
            acc[0][1] = __builtin_amdgcn_mfma_f32_32x32x16_bf16(w0, x1, acc[0][1], 0, 0, 0); \
            acc[1][0] = __builtin_amdgcn_mfma_f32_32x32x16_bf16(w1, x0, acc[1][0], 0, 0, 0); \
            acc[1][1] = __builtin_amdgcn_mfma_f32_32x32x16_bf16(w1, x1, acc[1][1], 0, 0, 0); } } while (0)
    for (int kt = 0; kt < nk; kt += 2) {
        MG_COMPUTE(0);
        if (kt + 1 < nk) { MG_LSTORE(xv1, wv1, 1); if (kt + 3 < nk) MG_GLOAD(xv1, wv1, kt + 3); }
        if (flush_every && (kt + 1) % flush_every == 0) flush(kt / flush_every, acc);
        __syncthreads();
        if (kt + 1 < nk) {
            MG_COMPUTE(1);
            if (kt + 2 < nk) { MG_LSTORE(xv0, wv0, 0); if (kt + 4 < nk) MG_GLOAD(xv0, wv0, kt + 4); }
            if (flush_every && (kt + 2) % flush_every == 0) flush((kt + 1) / flush_every, acc);
            __syncthreads();
        }
    }
#undef MG_GLOAD
#undef MG_LSTORE
#undef MG_COMPUTE
}
template <class RowFn>
DI void mgemm_tile(const MG& g, int n0, RowFn rowfn, f32x16 (&acc)[2][2], unsigned char* lds, bool zero = true) { mgemm_tile_f(g, n0, rowfn, acc, lds, zero, 0, NoFlush{}); }
#define MG_FOREACH(acc, LROW, FEAT, V, ...) do { const int _l = tidx() & 63, _w = tidx() >> 6, _wm = _w % G_WM, _wn = _w / G_WM; \
    _Pragma("unroll") for (int _ft = 0; _ft < 2; ++_ft) _Pragma("unroll") for (int _tt = 0; _tt < 2; ++_tt) _Pragma("unroll") for (int _i = 0; _i < 4; ++_i) { \
        const int LROW = _wm * 64 + _tt * 32 + (_l & 31); const int FEAT = _wn * 64 + _ft * 32 + 8 * _i + 4 * (_l >> 5); \
        float V[4] = {acc[_ft][_tt][4 * _i], acc[_ft][_tt][4 * _i + 1], acc[_ft][_tt][4 * _i + 2], acc[_ft][_tt][4 * _i + 3]}; __VA_ARGS__ } } while (0)

struct RowId { int m0; DI long operator()(int r) const { return m0 + r; } };

template <int OUTMODE>
DI void mgemm_job(const MG& g, int M, int N, void* out, long ldo, int bid, int nblk, unsigned char* lds) {
    const int tm = M / G_BM, tn = N / G_BN;
    for (int u = bid; u < tm * tn; u += nblk) {
        const int grp = u / (16 * tn), rem = u % (16 * tn);
        const int gm = (tm - grp * 16) < 16 ? (tm - grp * 16) : 16;
        const int mt = grp * 16 + rem % gm, nt = rem / gm;
        const int m0 = mt * G_BM, n0 = nt * G_BN;
        f32x16 acc[2][2];
        mgemm_tile(g, n0, RowId{m0}, acc, lds);
        MG_FOREACH(acc, lrow, feat, v, {
            const long o = (long)(m0 + lrow) * ldo + n0 + feat;
            if (OUTMODE == 1) *(float4*)((float*)out + o) = make_float4(v[0], v[1], v[2], v[3]);
            else {
                if (OUTMODE == 2 && n0 + feat >= O_MG) { v[0] = sigm(v[0]); v[1] = sigm(v[1]); v[2] = sigm(v[2]); v[3] = sigm(v[3]); }
                st4bf((bf16_t*)out + o, v[0], v[1], v[2], v[3]);
            } });
    }
}

namespace pg8 {
#define PG8_LAS __attribute__((address_space(3)))
typedef float f32x4 __attribute__((ext_vector_type(4)));
constexpr int BM = 256, BK = 64, HALF = 128, HTB = HALF * BK * 2  , STAGE_BYTES = 8 * HTB, NXCD = 8, WGM = 8;
__host__ __device__ __forceinline__ int lds_byte(int r, int c) { const int st = (r >> 4) * 2 + (c >> 5), rr = r & 15, cc = c & 31, ob = rr * 64 + cc * 2; return st * 1024 + (ob ^ (((ob >> 9) & 1) << 5)); }
__host__ __device__ __forceinline__ void stage_rc(int b, int& R, int& C) { const int st = b / 1024, sb = b % 1024, swz = sb ^ (((sb >> 9) & 1) << 5); R = (st >> 1) * 16 + swz / 64; C = (st & 1) * 32 + (swz % 64) / 2; }
__host__ __device__ __forceinline__ int perm32(int rho) { const int n = rho >> 4, i = rho & 15; return 8 * (i >> 2) + 4 * n + (i & 3); }
struct Unit { int pm, pn, e; };
struct Gemm { const bf16_t* A; const bf16_t* Bt; int M, N, K; };
struct StaticOrder {
    int nM, nN, nwg, G, c;
    __device__ void init(int M, int N, int G_, int c_) { nM = M / BM; nN = N / BM; nwg = nM * nN; G = G_; c = c_; }
    __device__ bool next(int i, Unit& u) const {
        const long L = (long)i * G + c; if (L >= nwg) return false;
        int wgid = (int)L; { const int q = nwg / NXCD, r = nwg % NXCD, xcd = wgid % NXCD, off = wgid / NXCD; wgid = (xcd < r ? xcd * (q + 1) : r * (q + 1) + (xcd - r) * q) + off; }
        const int nig = WGM * nN, gid = wgid / nig, fm = gid * WGM, gsz = (nM - fm) < WGM ? (nM - fm) : WGM;
        u.pm = fm + ((wgid % nig) % gsz); u.pn = (wgid % nig) / gsz; u.e = 0; return true;
    }
    __device__ __forceinline__ void a_ready(const Unit&) const {}
    __device__ __forceinline__ void done(const Unit&) const {}
};
struct ListOrder {
    Unit u0, u1, u2; int n;
    __device__ bool next(int i, Unit& u) const { if (i >= n) return false; u = (i == 0) ? u0 : ((i == 1) ? u1 : u2); return true; }
    __device__ __forceinline__ void a_ready(const Unit&) const {}
    __device__ __forceinline__ void done(const Unit&) const {}
};
template <class Epi, class Sched, bool ALIGN_EPI = false, bool SP2 = false>
__device__ __forceinline__ void gemm_phase(PG8_LAS unsigned char* lds, const Gemm g, const Sched& S, const Epi& E) {
    const int tid = tidx(), wid = __builtin_amdgcn_readfirstlane(tid >> 6), lane = tid & 63, wr = wid >> 2, wc = wid & 3, fr = lane & 15, fq = lane >> 4;
    const int K = g.K, nt = K / BK;
    unsigned voffA[2], voffB[2];
#pragma unroll
    for (int i = 0; i < 2; ++i) { int R, C; stage_rc(tid * 16 + i * 8192, R, C); const int Rb = Epi::PERM ? ((R & ~31) + perm32(R & 31)) : R;
        voffA[i] = (unsigned)(R * K + C) * 2u; voffB[i] = (unsigned)(Rb * K + C) * 2u; }
    const size_t kstep = (size_t)(BK * 2);
    const size_t hstep = (size_t)HALF * K * 2;
    const size_t tstep = 2 * hstep;
    const size_t estep = (size_t)g.N * K * 2;
    const unsigned ldsw = (unsigned)wid * 1024u;
    const int aoff = lds_byte(wr * 64 + fr, fq * 8), boff = lds_byte(wc * 32 + fr, fq * 8);
#define PG8_SA(b, h) (((b) * 2 + (h)) * HTB)
#define PG8_SB(b, h) ((4 + (b) * 2 + (h)) * HTB)
#define PG8_STAGE(bufoff, gbase, voff) do { _Pragma("unroll") for (int _i = 0; _i < 2; ++_i) \
        __builtin_amdgcn_global_load_lds((const unsigned*)((const char*)(gbase) + (voff)[_i]), (PG8_LAS unsigned*)(lds + (bufoff) + ldsw + _i * 8192), 16, 0, 0); } while (0)
#define PG8_LDA(dst, b, h) do { _Pragma("unroll") for (int m = 0; m < 4; ++m) _Pragma("unroll") for (int k = 0; k < 2; ++k) dst[m][k] = *(const PG8_LAS bf16x8*)(lds + PG8_SA(b, h) + aoff + m * 2048 + k * 1024); } while (0)
#define PG8_LDB(dst, b, h) do { _Pragma("unroll") for (int n = 0; n < 2; ++n) _Pragma("unroll") for (int k = 0; k < 2; ++k) dst[n][k] = *(const PG8_LAS bf16x8*)(lds + PG8_SB(b, h) + boff + n * 2048 + k * 1024); } while (0)
#define PG8_MMA(ai, bj, At, Bt) do { __builtin_amdgcn_s_setprio(1); _Pragma("unroll") for (int m = 0; m < 4; ++m) _Pragma("unroll") for (int n = 0; n < 2; ++n) _Pragma("unroll") for (int k = 0; k < 2; ++k) \
        acc[ai][bj][m][n] = __builtin_amdgcn_mfma_f32_16x16x32_bf16(Bt[n][k], At[m][k], acc[ai][bj][m][n], 0, 0, 0); __builtin_amdgcn_s_setprio(0); } while (0)
#define PG8_WAIT_V(n) asm volatile("s_waitcnt vmcnt(" #n ")" ::: "memory")
#define PG8_WAIT_L(n) asm volatile("s_waitcnt lgkmcnt(" #n ")" ::: "memory")
#define PG8_BAR __builtin_amdgcn_s_barrier()
#define PG8_SCHED __builtin_amdgcn_sched_barrier(0)
    Unit cur, nxt; int ui = 0;
    if (!S.next(0, cur)) return;
    f32x4 acc[2][2][4][2];
#pragma unroll
    for (int a = 0; a < 2; ++a)
#pragma unroll
        for (int b = 0; b < 2; ++b)
#pragma unroll
            for (int m = 0; m < 4; ++m)
#pragma unroll
                for (int n = 0; n < 2; ++n) acc[a][b][m][n] = (f32x4){0.f, 0.f, 0.f, 0.f};
    bf16x8 At[4][2], B0[2][2], B1[2][2];
    const char* cA = (const char*)g.A + (size_t)cur.pm * tstep; const char* cB = (const char*)g.Bt + (size_t)cur.e * estep + (size_t)cur.pn * tstep;
    S.a_ready(cur);
    if constexpr (SP2) {
        PG8_STAGE(PG8_SB(0, 0), cB, voffB); PG8_STAGE(PG8_SB(0, 1), cB + hstep, voffB); PG8_STAGE(PG8_SA(0, 0), cA, voffA); PG8_STAGE(PG8_SA(0, 1), cA + hstep, voffA);
        if (wr == 1) PG8_BAR;
        PG8_WAIT_V(2); PG8_BAR;
        PG8_STAGE(PG8_SB(1, 0), cB + kstep, voffB); PG8_STAGE(PG8_SA(1, 0), cA + kstep, voffA); PG8_STAGE(PG8_SB(1, 1), cB + hstep + kstep, voffB);
        PG8_WAIT_V(6); PG8_BAR;
    } else {
        PG8_STAGE(PG8_SB(0, 0), cB, voffB); PG8_STAGE(PG8_SA(0, 0), cA, voffA); PG8_STAGE(PG8_SB(0, 1), cB + hstep, voffB); PG8_STAGE(PG8_SA(0, 1), cA + hstep, voffA);
        if (wr == 1) PG8_BAR;
        PG8_WAIT_V(4); PG8_BAR;
        PG8_STAGE(PG8_SB(1, 0), cB + kstep, voffB); PG8_STAGE(PG8_SA(1, 0), cA + kstep, voffA); PG8_STAGE(PG8_SB(1, 1), cB + hstep + kstep, voffB);
        PG8_WAIT_V(6); PG8_BAR;
    }
    for (;;) {
        const bool has_next = S.next(ui + 1, nxt);
        const char* nA = has_next ? (const char*)g.A + (size_t)nxt.pm * tstep : cA; const char* nB = has_next ? (const char*)g.Bt + (size_t)nxt.e * estep + (size_t)nxt.pn * tstep : cB;
        for (int t = 0; t < nt; t += 2) {
            const bool last = (t == nt - 2);
            const char* a1 = cA + (size_t)(t + 1) * kstep;
            const char* a2 = last ? nA : cA + (size_t)(t + 2) * kstep; const char* b2 = last ? nB : cB + (size_t)(t + 2) * kstep;
            const char* a3 = a2 + kstep; const char* b3 = b2 + kstep;
            if (last && has_next) S.a_ready(nxt);
            if constexpr (SP2) {
            PG8_LDB(B0, 0, 0); PG8_LDB(B1, 0, 1); PG8_SCHED; PG8_LDA(At, 0, 0); PG8_STAGE(PG8_SA(1, 1), a1 + hstep, voffA);
            PG8_WAIT_V(8); PG8_WAIT_L(0); PG8_BAR; PG8_MMA(0, 0, At, B0); PG8_MMA(0, 1, At, B1); PG8_BAR; PG8_SCHED;
            PG8_LDA(At, 0, 1); PG8_STAGE(PG8_SB(0, 0), b2, voffB); PG8_STAGE(PG8_SB(0, 1), b2 + hstep, voffB); PG8_STAGE(PG8_SA(0, 0), a2, voffA);
            PG8_WAIT_V(8); PG8_WAIT_L(0); PG8_BAR; PG8_MMA(1, 0, At, B0); PG8_MMA(1, 1, At, B1); PG8_BAR; PG8_SCHED;
            PG8_LDB(B0, 1, 0); PG8_LDB(B1, 1, 1); PG8_SCHED; PG8_LDA(At, 1, 0); PG8_STAGE(PG8_SA(0, 1), a2 + hstep, voffA);
            PG8_WAIT_V(8); PG8_WAIT_L(0); PG8_BAR; PG8_MMA(0, 0, At, B0); PG8_MMA(0, 1, At, B1); PG8_BAR; PG8_SCHED;
            PG8_LDA(At, 1, 1); PG8_STAGE(PG8_SB(1, 0), b3, voffB); PG8_STAGE(PG8_SB(1, 1), b3 + hstep, voffB); PG8_STAGE(PG8_SA(1, 0), a3, voffA);
            PG8_WAIT_V(8); PG8_WAIT_L(0); PG8_BAR; PG8_MMA(1, 0, At, B0); PG8_MMA(1, 1, At, B1); PG8_BAR; PG8_SCHED;
            } else {
            PG8_LDB(B0, 0, 0); PG8_SCHED; PG8_LDA(At, 0, 0); PG8_STAGE(PG8_SA(1, 1), a1 + hstep, voffA);
            PG8_WAIT_L(8); PG8_BAR; PG8_WAIT_L(0); PG8_MMA(0, 0, At, B0); PG8_BAR; PG8_SCHED;
            PG8_LDB(B1, 0, 1); PG8_STAGE(PG8_SB(0, 0), b2, voffB);
            PG8_BAR; PG8_WAIT_L(0); PG8_MMA(0, 1, At, B1); PG8_BAR;
            PG8_LDA(At, 0, 1); PG8_STAGE(PG8_SA(0, 0), a2, voffA);
            PG8_BAR; PG8_WAIT_L(0); PG8_MMA(1, 0, At, B0); PG8_BAR; PG8_SCHED;
            PG8_STAGE(PG8_SB(0, 1), b2 + hstep, voffB);
            PG8_WAIT_V(6); PG8_BAR; PG8_MMA(1, 1, At, B1); PG8_BAR;
            PG8_LDB(B0, 1, 0); PG8_SCHED; PG8_LDA(At, 1, 0); PG8_STAGE(PG8_SA(0, 1), a2 + hstep, voffA);
            PG8_WAIT_L(8); PG8_BAR; PG8_WAIT_L(0); PG8_MMA(0, 0, At, B0); PG8_BAR; PG8_SCHED;
            PG8_LDB(B1, 1, 1); PG8_STAGE(PG8_SB(1, 0), b3, voffB);
            PG8_BAR; PG8_WAIT_L(0); PG8_MMA(0, 1, At, B1); PG8_BAR;
            PG8_LDA(At, 1, 1); PG8_STAGE(PG8_SA(1, 0), a3, voffA);
            PG8_BAR; PG8_WAIT_L(0); PG8_MMA(1, 0, At, B0); PG8_BAR; PG8_SCHED;
            PG8_STAGE(PG8_SB(1, 1), b3 + hstep, voffB);
            PG8_WAIT_V(6); PG8_BAR; PG8_MMA(1, 1, At, B1); PG8_BAR;
            }
        }
        if constexpr (ALIGN_EPI) { if (wr == 0) PG8_BAR; }
        if constexpr (!Epi::AFTER_DRAIN) { E(acc, cur, wr, wc, fr, fq); S.done(cur); }
        if (!has_next) break;
#pragma unroll
        for (int a = 0; a < 2; ++a)
#pragma unroll
            for (int b = 0; b < 2; ++b)
#pragma unroll
                for (int m = 0; m < 4; ++m)
#pragma unroll
                    for (int n = 0; n < 2; ++n) acc[a][b][m][n] = (f32x4){0.f, 0.f, 0.f, 0.f};
        cur = nxt; cA = nA; cB = nB; ++ui;
        if constexpr (ALIGN_EPI) { if (wr == 1) PG8_BAR; }
    }
    PG8_WAIT_V(0);
    if constexpr (!ALIGN_EPI) { if (wr == 0) PG8_BAR; }
    PG8_BAR;
    if constexpr (Epi::AFTER_DRAIN) { E.fused(acc, cur, wr, wc, fr, fq, lds, wid, lane); S.done(cur); }
#undef PG8_SA
#undef PG8_SB
#undef PG8_STAGE
#undef PG8_LDA
#undef PG8_LDB
#undef PG8_MMA
#undef PG8_WAIT_V
#undef PG8_WAIT_L
#undef PG8_BAR
#undef PG8_SCHED
}
}

struct EpiStoreBf16 {
    static constexpr bool PERM = true, AFTER_DRAIN = false;
    bf16_t* O; long ldo; int gate_from; long estride;
    __device__ __forceinline__ void operator()(const pg8::f32x4 (&acc)[2][2][4][2], const pg8::Unit& u, int wr, int wc, int fr, int fq) const {
        bf16_t* base = O + (long)u.e * estride;
#pragma unroll
        for (int ai = 0; ai < 2; ++ai)
#pragma unroll
            for (int m = 0; m < 4; ++m) {
                const long row = (long)u.pm * 256 + ai * 128 + wr * 64 + m * 16 + fr;
#pragma unroll
                for (int bj = 0; bj < 2; ++bj) {
                    pg8::f32x4 v0 = acc[ai][bj][m][0], v1 = acc[ai][bj][m][1];
                    if (u.pn * 2 + bj >= gate_from) {
#pragma unroll
                        for (int j = 0; j < 4; ++j) { v0[j] = sigm_fast(v0[j]); v1[j] = sigm_fast(v1[j]); }
                    }
                    u32x4 wv; wv[0] = pk_bf16(v0[0], v0[1]); wv[1] = pk_bf16(v0[2], v0[3]); wv[2] = pk_bf16(v1[0], v1[1]); wv[3] = pk_bf16(v1[2], v1[3]);
                    *(u32x4*)(base + row * ldo + u.pn * 256 + bj * 128 + wc * 32 + 8 * fq) = wv;
                }
            }
    }
};
struct EpiStoreF32 {
    static constexpr bool PERM = false, AFTER_DRAIN = false;
    float* O; long ldo;
    __device__ __forceinline__ void operator()(const pg8::f32x4 (&acc)[2][2][4][2], const pg8::Unit& u, int wr, int wc, int fr, int fq) const {
#pragma unroll
        for (int ai = 0; ai < 2; ++ai)
#pragma unroll
            for (int m = 0; m < 4; ++m) {
                const long row = (long)u.pm * 256 + ai * 128 + wr * 64 + m * 16 + fr;
#pragma unroll
                for (int bj = 0; bj < 2; ++bj)
#pragma unroll
                    for (int n = 0; n < 2; ++n) *(pg8::f32x4*)(O + row * ldo + u.pn * 256 + bj * 128 + wc * 32 + 16 * n + 4 * fq) = acc[ai][bj][m][n];
            }
    }
};
struct EpiMoeGU {
    static constexpr bool PERM = true, AFTER_DRAIN = false;
    bf16_t* HH;
    __device__ __forceinline__ void operator()(const pg8::f32x4 (&acc)[2][2][4][2], const pg8::Unit& u, int wr, int wc, int fr, int fq) const {
#pragma unroll
        for (int ai = 0; ai < 2; ++ai)
#pragma unroll
            for (int m = 0; m < 4; ++m) {
                const long row = (long)u.pm * 256 + ai * 128 + wr * 64 + m * 16 + fr;
                float hv[8];
#pragma unroll
                for (int n = 0; n < 2; ++n)
#pragma unroll
                    for (int j = 0; j < 4; ++j) { const float gt = acc[ai][0][m][n][j], up = acc[ai][1][m][n][j]; hv[4 * n + j] = gt * sigm_fast(gt) * up; }
                u32x4 wv; wv[0] = pk_bf16(hv[0], hv[1]); wv[1] = pk_bf16(hv[2], hv[3]); wv[2] = pk_bf16(hv[4], hv[5]); wv[3] = pk_bf16(hv[6], hv[7]);
                *(u32x4*)(HH + row * 512 + u.pn * 128 + wc * 32 + 8 * fq) = wv;
            }
    }
};
struct EpiMoeDown {
    static constexpr bool PERM = true, AFTER_DRAIN = false;
    const int* perm; const float* ew; bf16_t* YK;
    __device__ __forceinline__ void operator()(const pg8::f32x4 (&acc)[2][2][4][2], const pg8::Unit& u, int wr, int wc, int fr, int fq) const {
#pragma unroll
        for (int ai = 0; ai < 2; ++ai)
#pragma unroll
            for (int m = 0; m < 4; ++m) {
                const int a = perm[u.pm * 256 + ai * 128 + wr * 64 + m * 16 + fr];
                if (a >= 0) {
                    const float sw = ew[a];
#pragma unroll
                    for (int bj = 0; bj < 2; ++bj) {
                        const pg8::f32x4 v0 = acc[ai][bj][m][0] * sw, v1 = acc[ai][bj][m][1] * sw;
                        u32x4 wv; wv[0] = pk_bf16(v0[0], v0[1]); wv[1] = pk_bf16(v0[2], v0[3]); wv[2] = pk_bf16(v1[0], v1[1]); wv[3] = pk_bf16(v1[2], v1[3]);
                        *(u32x4*)(YK + (long)a * 1024 + u.pn * 256 + bj * 128 + wc * 32 + 8 * fq) = wv;
                    }
                }
            }
    }
};
struct GroupedOrder {
    int nM, nN, nE, G, c;
    __device__ bool next(int i, pg8::Unit& u) const { const int L = i * G + c; if (L >= nM * nN * nE) return false; u.e = L / (nM * nN); const int rm = L % (nM * nN); u.pm = rm / nN; u.pn = rm % nN; return true; }
    __device__ __forceinline__ void a_ready(const pg8::Unit&) const {}
    __device__ __forceinline__ void done(const pg8::Unit&) const {}
};

struct LayerW {
    const float *cmp_pos, *conv_w, *conv_b, *ga_b, *gx_b, *lam, *q_norm, *kv_norm,
        *ln1_g, *ln1_b, *ln2_g, *ln2_b, *rg_b, *re_b, *ln3_g, *ln3_b;
    const bf16_t *t_in, *t_br, *t_out, *t_q, *t_o, *t_gu, *t_dn, *t_c1, *t_c2, *t_uq, *t_ukv, *t_g, *t_rh, *t_rl;
};
#define WSF(off) ((float*)(p.ws + (off)))
#define WSI(off) ((int*)(p.ws + (off)))
#define WSU(off) ((unsigned*)(p.ws + (off)))
#define WSB(off) ((bf16_t*)(p.ws + (off)))
DI LayerW layer_w(const Params& p, int l) {
    LayerW w;
    w.cmp_pos = p.in[3] + (size_t)l * 2 * 32 * 64;
    w.conv_w = p.in[6] + (size_t)l * 4 * 256;
    w.conv_b = p.in[7] + (size_t)l * 256;
    w.ga_b = p.in[9] + (size_t)l * 256;
    w.gx_b = p.in[11] + (size_t)l * 256;
    w.lam = p.in[12] + (size_t)l * 256;
    w.q_norm = p.in[13] + (size_t)l * 192;
    w.kv_norm = p.in[14] + (size_t)l * 128;
    w.ln1_g = p.in[19] + (size_t)l * 1024; w.ln1_b = p.in[20] + (size_t)l * 1024;
    w.ln2_g = p.in[24] + (size_t)l * 1024; w.ln2_b = p.in[25] + (size_t)l * 1024;
    w.rg_b = p.in[27] + (size_t)l * 4;
    w.re_b = p.in[29] + (size_t)l * 32;
    w.ln3_g = p.in[32] + (size_t)l * 1024; w.ln3_b = p.in[33] + (size_t)l * 1024;
    w.t_in = WSB(WT_IN) + (size_t)l * NH * 1024;
    w.t_br = WSB(WT_BR) + (size_t)l * 1024 * 1024;
    w.t_out = WSB(WT_OUT) + (size_t)l * 1024 * 1024;
    w.t_q = WSB(WT_Q) + (size_t)l * 512 * 1024;
    w.t_o = WSB(WT_O) + (size_t)l * 1024 * 512;
    w.t_gu = WSB(WT_GU) + (size_t)l * 32 * 1024 * 1024;
    w.t_dn = WSB(WT_DN) + (size_t)l * 32 * 1024 * 512;
    w.t_c1 = WSB(WT_C1) + (size_t)l * 2 * 256 * 2048;
    w.t_c2 = WSB(WT_C2) + (size_t)l * 2 * 128 * 256;
    w.t_uq = WSB(WT_UQ) + (size_t)l * 384 * 192;
    w.t_ukv = WSB(WT_UKV) + (size_t)l * 512 * 128;
    w.t_g = WSB(WT_G) + (size_t)l * 4 * 128 * 64;
    w.t_rh = WSB(WT_RH) + (size_t)l * 128 * 1024;
    w.t_rl = WSB(WT_RL) + (size_t)l * 128 * 1024;
    return w;
}

template <int MODE>
DI int wt_col(int np, int Nsrc) {
    if (MODE == 0) return np < Nsrc ? np : -1;
    if (MODE == 2) return np < 1024 ? np : (np < 2656 ? np + 12 : (np < 2668 ? 1024 + (np - 2656) : (np < 2688 ? -1 : (np < 6784 ? np - 20 : -1))));
    const int pn = np >> 8, bj = (np >> 7) & 1, q = np & 127; return (bj ? 512 : 0) + 128 * pn + q;
}
template <int MODE>
DI void job_wt(const float* src, int nmat, int K, int Nsrc, bf16_t* dst, int Npad, int bid, int nblk, unsigned char* lds) {
    bf16_t* tile = (bf16_t*)lds;
    const int tk = K / 64, tn = Npad / 64, per = tk * tn;
    const int tid = tidx();
    const int kl = tid >> 4, n4 = (tid & 15) * 4;
    for (int u = bid; u < nmat * per; u += nblk) {
        const int mat = u / per, ru = u % per, k0 = (ru / tn) * 64, n0 = (ru % tn) * 64;
        const float* s = src + (size_t)mat * K * Nsrc;
        bf16_t* d = dst + (size_t)mat * Npad * K;
        const int col = wt_col<MODE>(n0 + n4, Nsrc);
        float4 v0 = make_float4(0.f, 0.f, 0.f, 0.f), v1 = v0;
        if (col >= 0) { v0 = *(const float4*)(s + (size_t)(k0 + kl) * Nsrc + col); v1 = *(const float4*)(s + (size_t)(k0 + kl + 32) * Nsrc + col); }
        __syncthreads();
        tile[(n4 + 0) * 72 + kl] = f2bf(v0.x); tile[(n4 + 1) * 72 + kl] = f2bf(v0.y); tile[(n4 + 2) * 72 + kl] = f2bf(v0.z); tile[(n4 + 3) * 72 + kl] = f2bf(v0.w);
        tile[(n4 + 0) * 72 + kl + 32] = f2bf(v1.x); tile[(n4 + 1) * 72 + kl + 32] = f2bf(v1.y); tile[(n4 + 2) * 72 + kl + 32] = f2bf(v1.z); tile[(n4 + 3) * 72 + kl + 32] = f2bf(v1.w);
        __syncthreads();
        { const int n2 = tid >> 3, kc = (tid & 7) * 8;
          *(uint4*)(d + (size_t)(n0 + n2) * K + k0 + kc) = *(const uint4*)(tile + n2 * 72 + kc); }
    }
}
DI void job_cvt(const float* src, bf16_t* dst, long n, int bid, int nblk) {
    for (long e = ((long)bid * NT + tidx()) * 4; e < n; e += (long)nblk * NT * 4) {
        const float4 v = *(const float4*)(src + e);
        st4bf(dst + e, v.x, v.y, v.z, v.w);
    }
}
DI void job_cmp_gather(const Params& p, const LayerW& w, int bid, int nblk) {
    const bf16_t* H = WSB(WS_H); bf16_t* TB = WSB(WS_TBB);
    const long total = (long)2 * NCR * 2048 / 4;
    for (long e = (long)bid * NT + tidx(); e < total; e += (long)nblk * NT) {
        const long e4 = e * 4;
        const int f = (int)(e4 % 2048); const long r2 = e4 / 2048; const int r = (int)(r2 % NCR), j = (int)(r2 / NCR);
        const int g = r & 1, bc = r >> 1, c = bc % NCMP, b = bc / NCMP, i = f >> 6, d = f & 63;
        const float4 hv = ld4bf(H + (long)(b * SEQ + 16 * c + i) * NH + (j ? O_AVC : O_AKC) + g * 64 + d);
        const float4 pv = *(const float4*)(w.cmp_pos + (j * 32 + i) * 64 + d);
        st4bf(TB + ((long)j * 2048 + r) * 2048 + f, hv.x + pv.x, hv.y + pv.y, hv.z + pv.z, hv.w + pv.w);
    }
}
DI void job_rnn_conv(const Params& p, const LayerW& w, int bid, int nblk) {
    const bf16_t* H = WSB(WS_H); float* U = WSF(WS_U); bf16_t* UB = WSB(WS_UB);
    for (long e = (long)bid * NT + tidx(); e < (long)T * 64; e += (long)nblk * NT) {
        const int ch = (int)(e & 63) * 4; const int t = (int)(e >> 6), s = t & (SEQ - 1);
        const float4 cb = *(const float4*)(w.conv_b + ch);
        float u0 = cb.x, u1 = cb.y, u2 = cb.z, u3 = cb.w;
#pragma unroll
        for (int tap = 0; tap < 4; ++tap) { const int sp = s - 3 + tap;
            if (sp >= 0) { const float4 hv = ld4bf(H + (long)(t - 3 + tap) * NH + O_CX + ch); const float4 cw = *(const float4*)(w.conv_w + tap * 256 + ch);
                u0 += hv.x * cw.x; u1 += hv.y * cw.y; u2 += hv.z * cw.z; u3 += hv.w * cw.w; } }
        *(float4*)(U + (long)t * 256 + ch) = make_float4(u0, u1, u2, u3); st4bf(UB + (long)t * 256 + ch, u0, u1, u2, u3);
    }
}
DI void job_rnn_gates(const Params& p, const LayerW& w, int bid, int nblk, unsigned char* lds) {
    const float* U = WSF(WS_U); float* RA = WSF(WS_RA); float* RB = WSF(WS_RB);
    for (int u = bid; u < (T / G_BM) * 4; u += nblk) {
        const int blk = u & 3, m0 = (u >> 2) * G_BM;
        MG g; g.A = WSB(WS_UB) + blk * 64; g.lda = 256; g.Wt = w.t_g + (size_t)blk * 128 * 64; g.ldw = 64; g.K = 64;
        f32x16 acc[2][2];
        mgemm_tile(g, 0, RowId{m0}, acc, lds);
        const int l = tidx() & 63, wv = tidx() >> 6, wm = wv % G_WM, wn = wv / G_WM;
#pragma unroll
        for (int tt = 0; tt < 2; ++tt)
#pragma unroll
            for (int i = 0; i < 4; ++i) {
                const long t = m0 + wm * 64 + tt * 32 + (l & 31); const int ch = blk * 64 + wn * 32 + 8 * i + 4 * (l >> 5);
                const float4 uv = *(const float4*)(U + t * 256 + ch);
                const float ua[4] = {uv.x, uv.y, uv.z, uv.w};
                float av[4], bv[4];
#pragma unroll
                for (int j = 0; j < 4; ++j) {
                    const float r = sigm(acc[0][tt][4 * i + j] + w.ga_b[ch + j]), ig = sigm(acc[1][tt][4 * i + j] + w.gx_b[ch + j]);
                    const float nl = -w.lam[ch + j];
                    const float sp = fmaxf(nl, 0.f) + log1pf(expf(-fabsf(nl)));
                    const float log_a = -8.0f * r * sp;
                    av[j] = expf(log_a); bv[j] = sqrtf(-expm1f(2.0f * log_a)) * (ig * ua[j]);
                }
                *(float4*)(RA + t * 256 + ch) = make_float4(av[0], av[1], av[2], av[3]);
                *(float4*)(RB + t * 256 + ch) = make_float4(bv[0], bv[1], bv[2], bv[3]);
            }
    }
}
DI void job_rnn_scan1(const Params& p, int bid, int nblk) {
    const float* RA = WSF(WS_RA); const float* RB = WSF(WS_RB); float* SA = WSF(WS_SA); float* SH = WSF(WS_SH);
    for (int e = bid * NT + tidx(); e < BATCH * 32 * 256; e += nblk * NT) {
        const int ch = e & 255, bc = e >> 8;
        float ap = 1.f, hl = 0.f;
        for (int s0 = 0; s0 < 64; s0 += 8) {
            float av[8], bv[8];
#pragma unroll
            for (int i = 0; i < 8; ++i) { const long t = (long)bc * 64 + s0 + i; av[i] = RA[t * 256 + ch]; bv[i] = RB[t * 256 + ch]; }
#pragma unroll
            for (int i = 0; i < 8; ++i) { ap *= av[i]; hl = av[i] * hl + bv[i]; }
        }
        SA[e] = ap; SH[e] = hl;
    }
}
DI void job_rnn_scan2(const Params& p, int bid, int nblk) {
    const bf16_t* H = WSB(WS_H); const float* RA = WSF(WS_RA); const float* RB = WSF(WS_RB); const float* SA = WSF(WS_SA); const float* SH = WSF(WS_SH); bf16_t* BR = WSB(WS_BR);
    for (int e = bid * NT + tidx(); e < BATCH * 32 * 256; e += nblk * NT) {
        const int ch = e & 255, bc = e >> 8, chunk = bc & 31, b = bc >> 5;
        float h = 0.f;
        for (int c = 0; c < chunk; ++c) { const int q = ((b * 32 + c) << 8) + ch; h = SA[q] * h + SH[q]; }
        for (int s0 = 0; s0 < 64; s0 += 8) {
            float av[8], bv[8], gv[8];
#pragma unroll
            for (int i = 0; i < 8; ++i) { const long t = (long)bc * 64 + s0 + i; av[i] = RA[t * 256 + ch]; bv[i] = RB[t * 256 + ch]; gv[i] = bf2f(H[t * NH + O_CG + ch]); }
#pragma unroll
            for (int i = 0; i < 8; ++i) { const long t = (long)bc * 64 + s0 + i; h = av[i] * h + bv[i]; BR[t * 1024 + 2 * 256 + ch] = f2bf(h * gelu_tanh(gv[i])); }
        }
    }
}
DI void job_mla_norm(const Params& p, const LayerW& w, int bid, int nblk) {
    const bf16_t* H = WSB(WS_H); bf16_t* CQN = WSB(WS_CQNB); bf16_t* CKVN = WSB(WS_CKVNB); bf16_t* KM = WSB(WS_KM);
    const int lane = tidx() & 63, wid = tidx() >> 6;
    for (int t = bid * (NT / 64) + wid; t < T; t += nblk * (NT / 64)) {
        const bf16_t* hr = H + (long)t * NH;
        float q0 = bf2f(hr[O_DCQ + lane]), q1 = bf2f(hr[O_DCQ + 64 + lane]), q2 = bf2f(hr[O_DCQ + 128 + lane]);
        float ss = wave_sum(q0 * q0 + q1 * q1 + q2 * q2);
        float rs = rsqrtf(ss * (1.f / 192.f) + 1e-6f);
        CQN[(long)t * 192 + lane] = f2bf(q0 * rs * w.q_norm[lane]);
        CQN[(long)t * 192 + 64 + lane] = f2bf(q1 * rs * w.q_norm[64 + lane]);
        CQN[(long)t * 192 + 128 + lane] = f2bf(q2 * rs * w.q_norm[128 + lane]);
        float k0 = bf2f(hr[O_DCKV + lane]), k1 = bf2f(hr[O_DCKV + 64 + lane]);
        ss = wave_sum(k0 * k0 + k1 * k1);
        rs = rsqrtf(ss * (1.f / 128.f) + 1e-6f);
        CKVN[(long)t * 128 + lane] = f2bf(k0 * rs * w.kv_norm[lane]);
        CKVN[(long)t * 128 + 64 + lane] = f2bf(k1 * rs * w.kv_norm[64 + lane]);
        {
            const int i = lane & 15, hd = lane >> 4;
            const int s = t & (SEQ - 1);
            const float2 csn = *(const float2*)(WSF(WS_ROPE) + (s * 16 + i) * 2); const float cs = csn.x, sn = csn.y;
            const float x1 = bf2f(hr[O_DKR + i]), x2 = bf2f(hr[O_DKR + 16 + i]);
            KM[(long)t * 384 + hd * 96 + 64 + i] = f2bf(x1 * cs - x2 * sn);
            KM[(long)t * 384 + hd * 96 + 80 + i] = f2bf(x1 * sn + x2 * cs);
        }
    }
}
DI void job_mla_up(const Params& p, const LayerW& w, int bid, int nblk, unsigned char* lds) {
    bf16_t* QB = WSB(WS_QB); bf16_t* KM = WSB(WS_KM); bf16_t* VM = WSB(WS_VM);
    constexpr int TM = T / G_BM;
    for (int u = bid; u < TM * 7; u += nblk) {
        const int mt = u / 7, nt = u % 7, m0 = mt * G_BM;
        f32x16 acc[2][2];
        const int l = tidx() & 63, wv = tidx() >> 6, wm = wv % G_WM, wn = wv / G_WM, hh = l >> 5;
        if (nt < 3) {
            MG g; g.A = WSB(WS_CQNB); g.lda = 192; g.Wt = w.t_uq; g.ldw = 192; g.K = 192;
            const int n0 = nt * 128;
            mgemm_tile(g, n0, RowId{m0}, acc, lds);
#pragma unroll
            for (int ft = 0; ft < 2; ++ft) {
                const int fb = (n0 + wn * 64 + ft * 32) >> 5;
                if (fb % 3 == 2) {
#pragma unroll
                    for (int tt = 0; tt < 2; ++tt) {
                        const int pos = (m0 + wm * 64 + tt * 32 + (l & 31)) & (SEQ - 1);
#pragma unroll
                        for (int i = 0; i < 2; ++i)
#pragma unroll
                            for (int j = 0; j < 4; ++j) {
                                const int fi = 8 * i + 4 * hh + j;
                                const float2 csn = *(const float2*)(WSF(WS_ROPE) + (pos * 16 + fi) * 2); const float cs = csn.x, sn = csn.y;
                                const float x1 = acc[ft][tt][4 * i + j], x2 = acc[ft][tt][4 * (i + 2) + j];
                                acc[ft][tt][4 * i + j] = x1 * cs - x2 * sn; acc[ft][tt][4 * (i + 2) + j] = x1 * sn + x2 * cs;
                            }
                    }
                }
            }
            MG_FOREACH(acc, lrow, feat, v, { st4bf(QB + (long)(m0 + lrow) * 384 + n0 + feat, v[0], v[1], v[2], v[3]); });
        } else {
            MG g; g.A = WSB(WS_CKVNB); g.lda = 128; g.Wt = w.t_ukv; g.ldw = 128; g.K = 128;
            const int n0 = (nt - 3) * 128;
            mgemm_tile(g, n0, RowId{m0}, acc, lds);
            MG_FOREACH(acc, lrow, feat, v, {
                const int hd = nt - 3;
                if (feat < 64) st4bf(KM + (long)(m0 + lrow) * 384 + hd * 96 + feat, v[0], v[1], v[2], v[3]);
                else st4bf(VM + (long)(m0 + lrow) * 256 + hd * 64 + (feat - 64), v[0], v[1], v[2], v[3]); });
        }
    }
}
template <int STAGE>
DI void job_cmp_mlp(const Params& p, const LayerW& w, int bid, int nblk, unsigned char* lds) {
    constexpr int TM = 2048 / G_BM, TN = STAGE == 0 ? 2 : 1;
    for (int u = bid; u < 2 * TM * TN; u += nblk) {
        const int j = u / (TM * TN), ru = u % (TM * TN), mt = ru / TN, nt = ru % TN, m0 = mt * G_BM, n0 = nt * 128;
        MG g;
        if (STAGE == 0) { g.A = WSB(WS_TBB) + (size_t)j * 2048 * 2048; g.lda = 2048; g.Wt = w.t_c1 + (size_t)j * 256 * 2048; g.ldw = 2048; g.K = 2048; }
        else { g.A = WSB(WS_HIDB) + (size_t)j * 2048 * 256; g.lda = 256; g.Wt = w.t_c2 + (size_t)j * 128 * 256; g.ldw = 256; g.K = 256; }
        f32x16 acc[2][2];
        mgemm_tile(g, n0, [&](int r) { const int rr = m0 + r; return (long)(rr < NCR ? rr : NCR - 1); }, acc, lds);
        if (STAGE == 0) {
            bf16_t* HID = WSB(WS_HIDB) + (size_t)j * 2048 * 256;
            MG_FOREACH(acc, lrow, feat, v, { st4bf(HID + (long)(m0 + lrow) * 256 + n0 + feat, gelu_tanh(v[0]), gelu_tanh(v[1]), gelu_tanh(v[2]), gelu_tanh(v[3])); });
        } else {
            bf16_t* KC = WSB(WS_KCB) + (size_t)j * NCR * 64;
            MG_FOREACH(acc, lrow, feat, v, { if (feat < 64 && m0 + lrow < NCR) st4bf(KC + (long)(m0 + lrow) * 64 + feat, v[0], v[1], v[2], v[3]); });
        }
    }
}
DI void job_router_logits(const Params& p, const LayerW& w, int bid, int nblk, unsigned char* lds) {
    float* LOG = WSF(WS_LOG);
    for (int u = bid; u < 3 * (T / G_BM); u += nblk) {
        const int pass = u / (T / G_BM), m0 = (u % (T / G_BM)) * G_BM;
        f32x16 acc[2][2];
        MG g; g.lda = 1024; g.ldw = 1024; g.K = 1024;
        g.A = pass == 1 ? WSB(WS_XBL) : WSB(WS_XBB); g.Wt = pass == 2 ? w.t_rl : w.t_rh;
        mgemm_tile(g, 0, RowId{m0}, acc, lds, true);
        float* dst = LOG + (size_t)pass * T * 36;
        MG_FOREACH(acc, lrow, feat, v, { if (feat < 36) *(float4*)(dst + (long)(m0 + lrow) * 36 + feat) = make_float4(v[0], v[1], v[2], v[3]); });
    }
}
DI void job_pack_small(const Params& p, int bid, int nblk) {
    bf16_t* TG = WSB(WT_G); bf16_t* RH = WSB(WT_RH); bf16_t* RL = WSB(WT_RL);
    for (int e = bid * NT + tidx(); e < SEQ * 16; e += nblk * NT) {
        const int i = e & 15, pos = e >> 4;
        const float inv = powf(10000.f, -(float)(2 * i) / 32.f);
        const float ang = (float)pos * inv;
        WSF(WS_ROPE)[e * 2] = cosf(ang); WSF(WS_ROPE)[e * 2 + 1] = sinf(ang);
    }
    for (int e = bid * NT + tidx(); e < DEPTH * 4 * 128 * 64; e += nblk * NT) {
        const int c = e & 63, q = (e >> 6) & 127, lb = e >> 13;
        const int seg = q >> 5, i = q & 31, chl = (seg >> 1) * 32 + i;
        const float* src = (seg & 1) ? p.in[10] : p.in[8];
        TG[e] = f2bf(src[((size_t)lb * 64 + c) * 64 + chl]);
    }
    for (int e = bid * NT + tidx(); e < DEPTH * 128 * 1024; e += nblk * NT) {
        const int k = e & 1023, n = (e >> 10) & 127, l = e >> 17;
        float v = 0.f;
        if (n < 4) v = p.in[26][((size_t)l * 1024 + k) * 4 + n];
        else if (n < 36) v = p.in[28][((size_t)l * 1024 + k) * 32 + (n - 4)];
        const bf16_t hi = f2bf(v);
        RH[e] = hi; RL[e] = f2bf(v - bf2f(hi));
    }
}

DI void job_merge(const Params& p, const LayerW& w, int bid, int nblk, unsigned char* lds) {
    const bf16_t* H = WSB(WS_H); bf16_t* M = WSB(WS_M);
    for (int u = bid; u < (T / G_BM) * 8; u += nblk) {
        const int m0 = (u >> 3) * G_BM, n0 = (u & 7) * G_BN;
        f32x16 macc[2][2];
#pragma unroll
        for (int a = 0; a < 2; ++a)
#pragma unroll
            for (int b = 0; b < 2; ++b)
#pragma unroll
                for (int i = 0; i < 16; ++i) macc[a][b][i] = 0.f;
        MG g; g.A = WSB(WS_BR); g.lda = 1024; g.Wt = w.t_br; g.ldw = 1024; g.K = 1024;
        f32x16 acc[2][2];
        const int l = tidx() & 63, wv = tidx() >> 6, wm = wv % G_WM, wn = wv / G_WM;
        mgemm_tile_f(g, n0, RowId{m0}, acc, lds, true, 4, [&](int n, f32x16 (&a)[2][2]) {
#pragma unroll
            for (int ft = 0; ft < 2; ++ft)
#pragma unroll
                for (int tt = 0; tt < 2; ++tt)
#pragma unroll
                    for (int i = 0; i < 4; ++i) {
                        const int lrow = wm * 64 + tt * 32 + (l & 31), feat = wn * 64 + ft * 32 + 8 * i + 4 * (l >> 5);
                        const float4 gv = ld4bf(H + (long)(m0 + lrow) * NH + O_MG + n * 1024 + n0 + feat);
                        macc[ft][tt][4 * i] += gv.x * a[ft][tt][4 * i]; macc[ft][tt][4 * i + 1] += gv.y * a[ft][tt][4 * i + 1];
                        macc[ft][tt][4 * i + 2] += gv.z * a[ft][tt][4 * i + 2]; macc[ft][tt][4 * i + 3] += gv.w * a[ft][tt][4 * i + 3];
                        a[ft][tt][4 * i] = 0.f; a[ft][tt][4 * i + 1] = 0.f; a[ft][tt][4 * i + 2] = 0.f; a[ft][tt][4 * i + 3] = 0.f;
                    }
        });
        MG_FOREACH(macc, lrow, feat, v, { st4bf(M + (long)(m0 + lrow) * 1024 + n0 + feat, v[0], v[1], v[2], v[3]); });
    }
}
DI void job_ln(const float* xin, const bf16_t* y, int ldy, const bf16_t* y2, const float* gw, const float* bw, float* out, bf16_t* outb, bf16_t* outl, int bid, int nblk) {
    const int lane = tidx() & 63, wid = tidx() >> 6;
    for (int t = bid * (NT / 64) + wid; t < T; t += nblk * (NT / 64)) {
        float v[16];
        float s = 0.f;
#pragma unroll
        for (int i = 0; i < 4; ++i) {
            const int c = i * 256 + lane * 4;
            const float4 xv = *(const float4*)(xin + (long)t * 1024 + c);
            float4 yv = ld4bf(y + (long)t * ldy + c);
            if (y2) { const float4 z = ld4bf(y2 + (long)t * ldy + c); yv.x += z.x; yv.y += z.y; yv.z += z.z; yv.w += z.w; }
            v[i * 4 + 0] = DN_ALPHA * xv.x + yv.x; v[i * 4 + 1] = DN_ALPHA * xv.y + yv.y; v[i * 4 + 2] = DN_ALPHA * xv.z + yv.z; v[i * 4 + 3] = DN_ALPHA * xv.w + yv.w;
            s += (v[i * 4] + v[i * 4 + 1]) + (v[i * 4 + 2] + v[i * 4 + 3]);
        }
        const float mu = wave_sum(s) * (1.f / 1024.f);
        float q = 0.f;
#pragma unroll
        for (int i = 0; i < 16; ++i) { const float dlt = v[i] - mu; q += dlt * dlt; }
        const float rstd = rsqrtf(wave_sum(q) * (1.f / 1024.f) + 1e-5f);
#pragma unroll
        for (int i = 0; i < 4; ++i) {
            const int c = i * 256 + lane * 4;
            const float4 gv = *(const float4*)(gw + c), bv = *(const float4*)(bw + c);
            const float o0 = (v[i * 4] - mu) * rstd * gv.x + bv.x, o1 = (v[i * 4 + 1] - mu) * rstd * gv.y + bv.y,
                        o2 = (v[i * 4 + 2] - mu) * rstd * gv.z + bv.z, o3 = (v[i * 4 + 3] - mu) * rstd * gv.w + bv.w;
            *(float4*)(out + (long)t * 1024 + c) = make_float4(o0, o1, o2, o3);
            if (outb) st4bf(outb + (long)t * 1024 + c, o0, o1, o2, o3);
            if (outl) st4bf(outl + (long)t * 1024 + c, o0 - bf2f(f2bf(o0)), o1 - bf2f(f2bf(o1)), o2 - bf2f(f2bf(o2)), o3 - bf2f(f2bf(o3)));
        }
    }
}
DI void job_router(const Params& p, const LayerW& w, int layer, int bid, int nblk) {
    const float* LOG = WSF(WS_LOG); int* EIDX = WSI(WS_EIDX); int* ESLOT = WSI(WS_ESLOT); float* EW = WSF(WS_EW);
    unsigned* cnt = WSU(WS_CTL) + CW_CNT + layer * 32;
    for (int t = bid * NT + tidx(); t < T; t += nblk * NT) {
        const float* lr = LOG + (long)t * 36; const float* lr1 = lr + (size_t)T * 36; const float* lr2 = lr1 + (size_t)T * 36;
#define LG(i) ((lr[i] + lr1[i]) + lr2[i])
        const float g0 = LG(0) + w.rg_b[0], g1 = LG(1) + w.rg_b[1], g2 = LG(2) + w.rg_b[2], g3 = LG(3) + w.rg_b[3];
        const float gm = fmaxf(fmaxf(g0, g1), fmaxf(g2, g3));
        const float e0 = expf(g0 - gm), e1 = expf(g1 - gm), e2 = expf(g2 - gm), e3 = expf(g3 - gm);
        const float gs = (e0 + e1) + (e2 + e3);
        const float p0 = e0 / gs, p1 = e1 / gs, p2 = e2 / gs, p3 = e3 / gs;
        int grp = 0; float pg = p0;
        if (p1 > pg) { pg = p1; grp = 1; }
        if (p2 > pg) { pg = p2; grp = 2; }
        if (p3 > pg) { pg = p3; grp = 3; }
        float el[8];
#pragma unroll
        for (int i = 0; i < 8; ++i) el[i] = LG(4 + grp * 8 + i) + w.re_b[grp * 8 + i];
#undef LG
        float em = el[0];
#pragma unroll
        for (int i = 1; i < 8; ++i) em = fmaxf(em, el[i]);
        float es = 0.f;
#pragma unroll
        for (int i = 0; i < 8; ++i) { el[i] = expf(el[i] - em); es += el[i]; }
#pragma unroll
        for (int i = 0; i < 8; ++i) el[i] = el[i] / es;
        float b0 = el[0]; int i0 = 0;
#pragma unroll
        for (int i = 1; i < 8; ++i) if (el[i] > b0) { b0 = el[i]; i0 = i; }
        float b1 = -1.f; int i1 = 0;
#pragma unroll
        for (int i = 0; i < 8; ++i) if (i != i0 && el[i] > b1) { b1 = el[i]; i1 = i; }
        const float den = b0 + b1;
        const int ex0 = grp * 8 + i0, ex1 = grp * 8 + i1;
        EIDX[t * 2] = ex0; EIDX[t * 2 + 1] = ex1;
        EW[t * 2] = pg * b0 / den; EW[t * 2 + 1] = pg * b1 / den;
        ESLOT[t * 2] = (int)atomicAdd(&cnt[ex0], 1u);
        ESLOT[t * 2 + 1] = (int)atomicAdd(&cnt[ex1], 1u);
    }
}
DI int pad_rows(int c) { return (c + G_BM - 1) / G_BM * G_BM; }
DI void job_fill(const Params& p, int layer, int bid, int nblk, unsigned char* lds) {
    const int* EIDX = WSI(WS_EIDX); const int* ESLOT = WSI(WS_ESLOT); int* PERM = WSI(WS_PERM);
    const bf16_t* X2 = WSB(WS_XBB); bf16_t* XG = WSB(WS_XG);
    unsigned* cnt = WSU(WS_CTL) + CW_CNT + layer * 32;
    const int lane = tidx() & 63, wid = tidx() >> 6;
    int* s_off = (int*)lds; int* s_cnt = s_off + 32;
    __syncthreads();
    if (tidx() < 32) s_cnt[tidx()] = (int)__hip_atomic_load(&cnt[tidx()], __ATOMIC_RELAXED, __HIP_MEMORY_SCOPE_AGENT);
    __syncthreads();
    if (tidx() == 0) { int o = 0; for (int e = 0; e < 32; ++e) { s_off[e] = o; o += pad_rows(s_cnt[e]); } }
    __syncthreads();
    for (int a = bid * (NT / 64) + wid; a < NASSIGN + NEXP; a += nblk * (NT / 64)) {
        const bool real = a < NASSIGN;
        const int e = real ? EIDX[a] : a - NASSIGN;
        const int off = s_off[e];
        if (real) {
            const int R = off + ESLOT[a];
            if (lane == 0) PERM[R] = a;
            const u32x4* src = (const u32x4*)(X2 + (long)(a >> 1) * 1024); u32x4* dst = (u32x4*)(XG + (long)R * 1024);
            dst[lane] = src[lane]; dst[lane + 64] = src[lane + 64];
        } else {
            const int c = s_cnt[e];
            for (int j = lane; c + j < pad_rows(c); j += 64) PERM[off + c + j] = -1;
        }
    }
}
DI pg8::ListOrder moe_units(unsigned* cnt, int bid, int nblk) {
    pg8::ListOrder S; S.n = 0; S.u0 = S.u1 = S.u2 = pg8::Unit{0, 0, 0};
    int rt = 0, ub = 0;
    for (int e = 0; e < 32; ++e) {
        const int c = pad_rows((int)__hip_atomic_load(&cnt[e], __ATOMIC_RELAXED, __HIP_MEMORY_SCOPE_AGENT)) >> 8, ue = c * 4;
#pragma unroll
        for (int k = 0; k < 3; ++k) {
            const int L = bid + k * nblk;
            if (L >= ub && L < ub + ue) { const int lu = L - ub; const pg8::Unit u{rt + (lu >> 2), lu & 3, e};
                if (k == 0) S.u0 = u; else if (k == 1) S.u1 = u; else S.u2 = u;
                S.n = k + 1; }
        }
        rt += c; ub += ue;
    }
#define RFL(x) x = __builtin_amdgcn_readfirstlane(x)
    RFL(S.n); RFL(S.u0.pm); RFL(S.u0.pn); RFL(S.u0.e); RFL(S.u1.pm); RFL(S.u1.pn); RFL(S.u1.e); RFL(S.u2.pm); RFL(S.u2.pn); RFL(S.u2.e);
#undef RFL
    return S;
}
typedef short s16x4 __attribute__((ext_vector_type(4)));
typedef short v4i16_t __attribute__((ext_vector_type(4)));
DI unsigned cvtpk(float lo, float hi) { return pk_bf16(lo, hi); }
DI int crow(int reg, int h) { return (reg & 3) + 8 * (reg >> 2) + 4 * h; }
DI s16x4 tr_read(const unsigned char* p) { return __builtin_bit_cast(s16x4, __builtin_amdgcn_ds_read_tr16_b64_v4i16((LAS v4i16_t*)p)); }
DI float xhalf_max(float m) { auto rr = __builtin_amdgcn_permlane32_swap(__float_as_uint(m), __float_as_uint(m), false, false); return fmaxf(__uint_as_float(rr[0]), __uint_as_float(rr[1])); }
DI float xhalf_sum(float m) { auto rr = __builtin_amdgcn_permlane32_swap(__float_as_uint(m), __float_as_uint(m), false, false); return __uint_as_float(rr[0]) + __uint_as_float(rr[1]); }
DI float xhalf_other(float v, int h) { auto rr = __builtin_amdgcn_permlane32_swap(__float_as_uint(v), __float_as_uint(v), false, false); return __uint_as_float(h ? rr[0] : rr[1]); }
DI bf16x8 pack8(const f32x16& x, int s2) {
    u32x4 pk; pk[0] = cvtpk(x[8 * s2], x[8 * s2 + 1]); pk[1] = cvtpk(x[8 * s2 + 2], x[8 * s2 + 3]); pk[2] = cvtpk(x[8 * s2 + 4], x[8 * s2 + 5]); pk[3] = cvtpk(x[8 * s2 + 6], x[8 * s2 + 7]);
    return __builtin_bit_cast(bf16x8, pk);
}
constexpr int ATT_QB = (NT / 64) * 32;
template <int DC> struct TileCfg { static constexpr int RS = DC * 2 + 16, BYTES = 64 * RS, NCH = 64 * DC / 8, NI = (NCH + NT - 1) / NT; };
template <int DC, class RowPtr> DI void tile_gload(u32x4 (&rg)[TileCfg<DC>::NI], RowPtr rp) {
#pragma unroll
    for (int i = 0; i < TileCfg<DC>::NI; ++i) { const int c = tidx() + NT * i; if (c < TileCfg<DC>::NCH) { const int row = c / (DC / 8), cc = c % (DC / 8); rg[i] = *(const u32x4*)(rp(row) + cc * 8); } }
}
template <int DC> DI void tile_lstore(const u32x4 (&rg)[TileCfg<DC>::NI], unsigned char* base) {
#pragma unroll
    for (int i = 0; i < TileCfg<DC>::NI; ++i) { const int c = tidx() + NT * i; if (c < TileCfg<DC>::NCH) { const int row = c / (DC / 8), cc = c % (DC / 8); *(u32x4*)(base + row * TileCfg<DC>::RS + cc * 16) = rg[i]; } }
}
template <int DK> DI void qk_tile(f32x16 (&s)[2], const bf16x8 (&qf)[DK / 16], const unsigned char* kl, int r, int h) {
    constexpr int RS = TileCfg<DK>::RS;
#pragma unroll
    for (int i = 0; i < 16; ++i) { s[0][i] = 0.f; s[1][i] = 0.f; }
#pragma unroll
    for (int ks = 0; ks < DK / 16; ++ks) {
        const bf16x8 k0 = *(const bf16x8*)(kl + r * RS + ks * 32 + h * 16), k1 = *(const bf16x8*)(kl + (32 + r) * RS + ks * 32 + h * 16);
        s[0] = __builtin_amdgcn_mfma_f32_32x32x16_bf16(k0, qf[ks], s[0], 0, 0, 0);
        s[1] = __builtin_amdgcn_mfma_f32_32x32x16_bf16(k1, qf[ks], s[1], 0, 0, 0);
    }
}
template <int DV> DI void pv_tile(f32x16 (&o)[DV / 32], const f32x16 (&pp)[2], const unsigned char* vl, int lane) {
    constexpr int RS = TileCfg<DV>::RS;
    const int h = lane >> 5, i16 = lane & 15, q = i16 >> 2, pq = i16 & 3, blk = (lane >> 4) & 1;
    const unsigned char* vb = vl + (4 * h + q) * RS + 2 * (16 * blk + 4 * pq);
#pragma unroll
    for (int kt = 0; kt < 2; ++kt)
#pragma unroll
        for (int s2 = 0; s2 < 2; ++s2) {
            const bf16x8 pf = pack8(pp[kt], s2);
#pragma unroll
            for (int dvt = 0; dvt < DV / 32; ++dvt) {
                const s16x4 lo = tr_read(vb + (kt * 32 + 16 * s2) * RS + dvt * 64), hi = tr_read(vb + (kt * 32 + 16 * s2 + 8) * RS + dvt * 64);
                const bf16x8 vf = __builtin_shufflevector(lo, hi, 0, 1, 2, 3, 4, 5, 6, 7);
                o[dvt] = __builtin_amdgcn_mfma_f32_32x32x16_bf16(vf, pf, o[dvt], 0, 0, 0);
            }
        }
}
constexpr float LOG2E = 1.4426950408889634f;
template <int DK, int DV, bool ALIBI, bool BOUNDARY, class ValidFn>
DI void softmax_tile(const bf16x8 (&qf)[DK / 16], f32x16 (&o)[DV / 32], float& m, float& l, const unsigned char* kl, const unsigned char* vl, int kb,
                     float c1, float sl2, int qpos, ValidFn valid, int lane) {
    const int r = lane & 31, h = lane >> 5;
    f32x16 s[2];
    qk_tile<DK>(s, qf, kl, r, h);
    const float base = ALIBI ? sl2 * (float)(kb + 4 * h - qpos) : 0.f;
    float tmax = -INFINITY;
#pragma unroll
    for (int kt = 0; kt < 2; ++kt)
#pragma unroll
        for (int i = 0; i < 16; ++i) {
            float v = ALIBI ? fmaf(s[kt][i], c1, fmaf(sl2, (float)(kt * 32 + (i & 3) + 8 * (i >> 2)), base)) : s[kt][i] * c1;
            if (BOUNDARY) v = valid(kb + kt * 32 + crow(i, h)) ? v : -INFINITY;
            s[kt][i] = v; tmax = fmaxf(tmax, v);
        }
    tmax = xhalf_max(tmax);
    const float mn = fmaxf(m, tmax);
    if (__any(mn > m)) {
        const float corr = __builtin_amdgcn_exp2f(m - mn);
        l *= corr;
#pragma unroll
        for (int dvt = 0; dvt < DV / 32; ++dvt)
#pragma unroll
            for (int i = 0; i < 16; ++i) o[dvt][i] *= corr;
        m = mn;
    }
    float ps = 0.f;
#pragma unroll
    for (int kt = 0; kt < 2; ++kt)
#pragma unroll
        for (int i = 0; i < 16; ++i) { const float pr = __builtin_amdgcn_exp2f(s[kt][i] - mn); s[kt][i] = pr; ps += pr; }
    l += ps;
    pv_tile<DV>(o, s, vl, lane);
}
template <int DK, int DV, bool ALIBI, class KPtr, class VPtr, class ValidFn, class InteriorFn>
DI void attn_stream(const bf16x8 (&qf)[DK / 16], f32x16 (&o)[DV / 32], float& m, float& l, unsigned tmask, int wave_qmax, int wave_kmin,
                    KPtr kp, VPtr vp, float c1, float sl2, int qpos, ValidFn valid, InteriorFn interior, unsigned char* lds) {
    unsigned char* kl = lds; unsigned char* vl = lds + TileCfg<DK>::BYTES;
    const int lane = tidx() & 63;
    u32x4 kA[TileCfg<DK>::NI], vA[TileCfg<DV>::NI], kB[TileCfg<DK>::NI], vB[TileCfg<DV>::NI];
    int ja = -1, jb = -1;
#define AS_NEXT(J, KR, VR) do { if (tmask) { J = __builtin_ctz(tmask); tmask &= tmask - 1; const int _j = J; \
        tile_gload<DK>(KR, [&](int row) { return kp(_j * 64 + row); }); tile_gload<DV>(VR, [&](int row) { return vp(_j * 64 + row); }); } else J = -1; } while (0)
#define AS_COMPUTE(J) do { const int _jc = (J); if (_jc * 64 <= wave_qmax && _jc * 64 + 63 >= wave_kmin) { \
        if (interior(_jc)) softmax_tile<DK, DV, ALIBI, false>(qf, o, m, l, kl, vl, _jc * 64, c1, sl2, qpos, valid, lane); \
        else softmax_tile<DK, DV, ALIBI, true>(qf, o, m, l, kl, vl, _jc * 64, c1, sl2, qpos, valid, lane); } } while (0)
    AS_NEXT(ja, kA, vA);
    AS_NEXT(jb, kB, vB);
    while (ja >= 0) {
        __syncthreads();
        tile_lstore<DK>(kA, kl); tile_lstore<DV>(vA, vl);
        __syncthreads();
        const int jc = ja;
        AS_NEXT(ja, kA, vA);
        AS_COMPUTE(jc);
        if (jb < 0) break;
        __syncthreads();
        tile_lstore<DK>(kB, kl); tile_lstore<DV>(vB, vl);
        __syncthreads();
        const int jd = jb;
        AS_NEXT(jb, kB, vB);
        AS_COMPUTE(jd);
    }
#undef AS_NEXT
#undef AS_COMPUTE
}

DI void job_mla_attn(const Params& p, int bid, int nblk, unsigned char* lds) {
    const bf16_t* QB = WSB(WS_QB); const bf16_t* KM = WSB(WS_KM); const bf16_t* VM = WSB(WS_VM); bf16_t* BR = WSB(WS_BR);
    constexpr int NQB = SEQ / ATT_QB, NU = BATCH * 4 * NQB;
    const int lane = tidx() & 63, wid = tidx() >> 6, r = lane & 31, h = lane >> 5;
    for (int u = bid; u < NU; u += nblk) {
        const int qblk = u / (BATCH * 4), bh = u % (BATCH * 4);
        const int b = bh >> 2, hd = bh & 3;
        const int q0 = qblk * ATT_QB, qw = q0 + wid * 32, qpos = qw + r;
        const long trow = (long)b * SEQ;
        bf16x8 qf[6];
#pragma unroll
        for (int ks = 0; ks < 6; ++ks) qf[ks] = *(const bf16x8*)(QB + (trow + qpos) * 384 + hd * 96 + ks * 16 + 8 * h);
        f32x16 o[2];
#pragma unroll
        for (int i = 0; i < 16; ++i) { o[0][i] = 0.f; o[1][i] = 0.f; }
        float m = -1e30f, l = 0.f;
        const int ntile = (q0 + ATT_QB - 1) / 64 + 1;
        const unsigned tmask = ntile >= 32 ? 0xffffffffu : ((1u << ntile) - 1u);
        attn_stream<96, 64, false>(qf, o, m, l, tmask, qw + 31, 0,
            [&](int row) { return KM + (trow + row) * 384 + hd * 96; },
            [&](int row) { return VM + (trow + row) * 256 + hd * 64; },
            0.10206207261596577f * LOG2E, 0.f, qpos,
            [&](int key) { return key <= qpos; }, [&](int j) { return j * 64 + 63 <= qw; }, lds);
        const float rl = 1.f / fmaxf(xhalf_sum(l), 1e-30f);
        bf16_t* dst = BR + (trow + qpos) * 1024 + 3 * 256 + hd * 64;
#pragma unroll
        for (int dvt = 0; dvt < 2; ++dvt)
#pragma unroll
            for (int i = 0; i < 4; ++i)
                st4bf(dst + dvt * 32 + 8 * i + 4 * h, o[dvt][4 * i] * rl, o[dvt][4 * i + 1] * rl, o[dvt][4 * i + 2] * rl, o[dvt][4 * i + 3] * rl);
    }
}
DI void job_cross_attn(const Params& p, int layer, int bid, int nblk, unsigned char* lds) {
    const bf16_t* XQ = WSB(WS_XQ); const bf16_t* KVM = WSB(WS_KVM) + (size_t)layer * 2048 * 1024; bf16_t* XO = WSB(WS_XO);
    constexpr int NQB = SEQ / ATT_QB, NU = BATCH * 4 * NQB;
    const int lane = tidx() & 63, wid = tidx() >> 6, r = lane & 31, h = lane >> 5;
    for (int u = bid; u < NU; u += nblk) {
        const int bh = u % (BATCH * 4), qblk = u / (BATCH * 4);
        const int b = bh >> 2, hd = bh & 3;
        const int qpos = qblk * ATT_QB + wid * 32 + r;
        const long trow = (long)b * SEQ;
        bf16x8 qf[8];
#pragma unroll
        for (int ks = 0; ks < 8; ++ks) qf[ks] = *(const bf16x8*)(XQ + (trow + qpos) * 512 + hd * 128 + ks * 16 + 8 * h);
        f32x16 o[4];
#pragma unroll
        for (int d = 0; d < 4; ++d)
#pragma unroll
            for (int i = 0; i < 16; ++i) o[d][i] = 0.f;
        float m = -1e30f, l = 0.f;
        attn_stream<128, 128, false>(qf, o, m, l, 0xFu, 1 << 30, 0,
            [&](int row) { return KVM + (long)(b * MEM_LEN + row) * 1024 + hd * 128; },
            [&](int row) { return KVM + (long)(b * MEM_LEN + row) * 1024 + 512 + hd * 128; },
            0.08838834764831845f * LOG2E, 0.f, qpos, [&](int) { return true; }, [&](int) { return true; }, lds);
        const float rl = 1.f / fmaxf(xhalf_sum(l), 1e-30f);
        bf16_t* dst = XO + (trow + qpos) * 512 + hd * 128;
#pragma unroll
        for (int dvt = 0; dvt < 4; ++dvt)
#pragma unroll
            for (int i = 0; i < 4; ++i)
                st4bf(dst + dvt * 32 + 8 * i + 4 * h, o[dvt][4 * i] * rl, o[dvt][4 * i + 1] * rl, o[dvt][4 * i + 2] * rl, o[dvt][4 * i + 3] * rl);
    }
}
DI float logsig_fast(float z) { return fminf(z, 0.f) - __logf(1.f + __expf(-fabsf(z))); }
DI void job_sb_attn(const Params& p, int bid, int nblk, unsigned char* lds) {
    const bf16_t* H = WSB(WS_H); bf16_t* BR = WSB(WS_BR);
    constexpr int NQB = SEQ / ATT_QB, NU = BATCH * 4 * NQB;
    const int lane = tidx() & 63, wid = tidx() >> 6, r = lane & 31, h = lane >> 5;
    unsigned char* kl = lds; unsigned char* vl = lds + TileCfg<64>::BYTES;
    for (int u = bid; u < NU; u += nblk) {
        const int half = u / (NU / 2), ru = u % (NU / 2);
        const int qi = ru / (BATCH * 4), bh = ru % (BATCH * 4);
        const int qblk = half == 0 ? (NQB - 1 - qi) : qi;
        const int b = bh >> 2, hd = bh & 3;
        const int q0 = qblk * ATT_QB, qw = q0 + wid * 32, qpos = qw + r;
        const long trow = (long)b * SEQ;
        bf16x8 qf[4];
#pragma unroll
        for (int ks = 0; ks < 4; ++ks) qf[ks] = *(const bf16x8*)(H + (trow + qpos) * NH + O_BQ + hd * 64 + ks * 16 + 8 * h);
        f32x16 o[2];
#pragma unroll
        for (int i = 0; i < 16; ++i) { o[0][i] = 0.f; o[1][i] = 0.f; }
        float trun = 0.f;
        int j = (q0 + ATT_QB - 1) >> 6;
        volatile int* flag = (volatile int*)(lds + 2 * TileCfg<64>::BYTES);
        if (tidx() == 0) { flag[0] = 0; flag[1] = 0; }
        u32x4 kr[TileCfg<64>::NI], vr[TileCfg<64>::NI];
        tile_gload<64>(kr, [&](int row) { return H + (trow + j * 64 + row) * NH + O_BK + hd * 64; });
        tile_gload<64>(vr, [&](int row) { return H + (trow + j * 64 + row) * NH + O_BV + hd * 64; });
        for (int it = 0; j >= 0; --j, ++it) {
            __syncthreads();
            if (it > 0 && flag[(it - 1) & 1] == 0) break;
            tile_lstore<64>(kr, kl); tile_lstore<64>(vr, vl);
            __syncthreads();
            if (tidx() == 0) flag[(it + 1) & 1] = 0;
            if (j > 0) { const int jn = j - 1;
                tile_gload<64>(kr, [&](int row) { return H + (trow + jn * 64 + row) * NH + O_BK + hd * 64; });
                tile_gload<64>(vr, [&](int row) { return H + (trow + jn * 64 + row) * NH + O_BV + hd * 64; }); }
            const bool wave_dead = __all(trun < -110.f);
            if (j * 64 < qw + 31 && !wave_dead) {
                const int kb = j * 64;
                f32x16 s[2], L[2];
                qk_tile<64>(s, qf, kl, r, h);
#pragma unroll
                for (int kt = 0; kt < 2; ++kt)
#pragma unroll
                    for (int i = 0; i < 16; ++i) {
                        const int key = kb + kt * 32 + crow(i, h);
                        const float z = s[kt][i] * 0.125f, lsp = logsig_fast(z);
                        const bool valid = key < qpos;
                        L[kt][i] = valid ? lsp - z : 0.f;
                        s[kt][i] = valid ? lsp : -INFINITY;
                    }
                float G[2][4], O[2][4];
#pragma unroll
                for (int kt = 0; kt < 2; ++kt)
#pragma unroll
                    for (int ig = 0; ig < 4; ++ig) { G[kt][ig] = (L[kt][4 * ig] + L[kt][4 * ig + 1]) + (L[kt][4 * ig + 2] + L[kt][4 * ig + 3]); O[kt][ig] = xhalf_other(G[kt][ig], h); }
                float run = trun;
#pragma unroll
                for (int kt = 1; kt >= 0; --kt)
#pragma unroll
                    for (int ig = 3; ig >= 0; --ig) {
                        const float t3 = run + (h == 0 ? O[kt][ig] : 0.f);
                        const float t2 = t3 + L[kt][4 * ig + 3], t1 = t2 + L[kt][4 * ig + 2], t0 = t1 + L[kt][4 * ig + 1];
                        s[kt][4 * ig + 3] = __expf(s[kt][4 * ig + 3] + t3); s[kt][4 * ig + 2] = __expf(s[kt][4 * ig + 2] + t2);
                        s[kt][4 * ig + 1] = __expf(s[kt][4 * ig + 1] + t1); s[kt][4 * ig + 0] = __expf(s[kt][4 * ig + 0] + t0);
                        run += G[kt][ig] + O[kt][ig];
                    }
                trun = run;
                pv_tile<64>(o, s, vl, lane);
            }
            if (!__all(trun < -110.f)) flag[it & 1] = 1;
        }
        bf16_t* dst = BR + (trow + qpos) * 1024 + 1 * 256 + hd * 64;
#pragma unroll
        for (int dvt = 0; dvt < 2; ++dvt)
#pragma unroll
            for (int i = 0; i < 4; ++i) st4bf(dst + dvt * 32 + 8 * i + 4 * h, o[dvt][4 * i], o[dvt][4 * i + 1], o[dvt][4 * i + 2], o[dvt][4 * i + 3]);
    }
}
constexpr int NSA_QB = (NT / 128) * 32;
DI void job_nsa(const Params& p, int bid, int nblk, unsigned char* lds) {
    const bf16_t* H = WSB(WS_H); const bf16_t* KCB = WSB(WS_KCB); const bf16_t* VCB = KCB + (size_t)NCR * 64;
    float* OACC = WSF(WS_OC); bf16_t* BR = WSB(WS_BR);
    constexpr int NQB = SEQ / NSA_QB, NU = BATCH * 2 * NQB;
    constexpr int TB_ = TileCfg<64>::BYTES;
    const int lane = tidx() & 63, wid = tidx() >> 6, r = lane & 31, h = lane >> 5;
    const int n = wid & 1, sub = wid >> 1;
    unsigned* orw = (unsigned*)(lds + 4 * TB_);
    float* impx = (float*)(lds + 4 * TB_ + 64);
    for (int u = bid; u < NU; u += nblk) {
        const int qblk = NQB - 1 - u / (BATCH * 2), bg = u % (BATCH * 2), b = bg >> 1, g = bg & 1;
        const int q0 = qblk * NSA_QB, qw = q0 + sub * 32, qpos = qw + r;
        const int head = g * 2 + n;
        const long trow = (long)b * SEQ;
        const bf16_t* hq_row = H + (trow + qpos) * NH;
        bf16x8 qf[1][4];
#pragma unroll
        for (int ks = 0; ks < 4; ++ks) qf[0][ks] = *(const bf16x8*)(hq_row + O_AQ + head * 64 + ks * 16 + 8 * h);
        const float sl = exp2f(-2.f * (float)(head + 1));
        const float gate0 = sigm(bf2f(hq_row[O_AG + head * 3 + 0])), gate1 = sigm(bf2f(hq_row[O_AG + head * 3 + 1])), gate2 = sigm(bf2f(hq_row[O_AG + head * 3 + 2]));
        float* oacc = OACC + (trow + qpos) * 256 + head * 64;
        __syncthreads();
        if (tidx() == 0) *orw = 0u;
        {
            u32x4 rg[TileCfg<64>::NI];
#pragma unroll
            for (int tl = 0; tl < 4; ++tl) {
                const bf16_t* src = (tl & 2) ? VCB : KCB; const int cb = (tl & 1) * 64;
                tile_gload<64>(rg, [&](int row) { const int c = cb + row < NCMP ? cb + row : NCMP - 1; return src + ((long)(b * NCMP + c) * 2 + g) * 64; });
                tile_lstore<64>(rg, lds + tl * TB_);
            }
        }
        __syncthreads();
        float imp[16];
        {
            f32x16 s[2][2];
            qk_tile<64>(s[0], qf[0], lds, r, h);
            qk_tile<64>(s[1], qf[0], lds + TB_, r, h);
            float tmax = -INFINITY;
#pragma unroll
            for (int tl = 0; tl < 2; ++tl)
#pragma unroll
                for (int kt = 0; kt < 2; ++kt)
#pragma unroll
                    for (int i = 0; i < 16; ++i) {
                        const int c = tl * 64 + kt * 32 + crow(i, h), dist = qpos - (16 * c + 31);
                        const float v = (c < NCMP && dist >= 0) ? s[tl][kt][i] * 0.125f - sl * (float)dist : -INFINITY;
                        s[tl][kt][i] = v; tmax = fmaxf(tmax, v);
                    }
            const float mn = fmaxf(xhalf_max(tmax), -1e30f);
            float ps = 0.f;
#pragma unroll
            for (int tl = 0; tl < 2; ++tl)
#pragma unroll
                for (int kt = 0; kt < 2; ++kt)
#pragma unroll
                    for (int i = 0; i < 16; ++i) { const float pr = __expf(s[tl][kt][i] - mn); s[tl][kt][i] = pr; ps += pr; }
            const float rl = 1.f / fmaxf(xhalf_sum(ps), 1e-30f);
            float P3[16];
#pragma unroll
            for (int tl = 0; tl < 2; ++tl)
#pragma unroll
                for (int kt = 0; kt < 2; ++kt) {
#pragma unroll
                    for (int ig = 0; ig < 4; ++ig) {
                        const float p0 = s[tl][kt][4 * ig] * rl, p1 = s[tl][kt][4 * ig + 1] * rl, p2 = s[tl][kt][4 * ig + 2] * rl, p3 = s[tl][kt][4 * ig + 3] * rl;
                        imp[tl * 8 + kt * 4 + ig] = (p0 + p1) + (p2 + 0.5f * p3);
                        P3[tl * 8 + kt * 4 + ig] = 0.5f * p3;
                    }
                    const float gs = rl * gate0;
#pragma unroll
                    for (int i = 0; i < 16; ++i) s[tl][kt][i] *= gs;
                }
#pragma unroll
            for (int idx = 0; idx < 16; ++idx) {
                const float pp = xhalf_other(P3[idx], h);
                float prevp;
                if (idx == 0) prevp = h ? pp : 0.f; else { const float ppm = xhalf_other(P3[idx - 1], h); prevp = h ? pp : ppm; }
                imp[idx] += prevp;
                impx[(wid * 16 + idx) * 64 + lane] = imp[idx];
            }
            f32x16 oc[2];
#pragma unroll
            for (int i = 0; i < 16; ++i) { oc[0][i] = 0.f; oc[1][i] = 0.f; }
            pv_tile<64>(oc, s[0], lds + 2 * TB_, lane);
            pv_tile<64>(oc, s[1], lds + 3 * TB_, lane);
#pragma unroll
            for (int dvt = 0; dvt < 2; ++dvt)
#pragma unroll
                for (int i = 0; i < 4; ++i) *(float4*)(oacc + dvt * 32 + 8 * i + 4 * h) = make_float4(oc[dvt][4 * i], oc[dvt][4 * i + 1], oc[dvt][4 * i + 2], oc[dvt][4 * i + 3]);
        }
        __syncthreads();
        unsigned sel = 0u;
        {
            const int cur = qpos >> 6;
#pragma unroll
            for (int idx = 0; idx < 16; ++idx) {
                const float other = impx[((wid ^ 1) * 16 + idx) * 64 + lane];
                const float tot = n == 0 ? imp[idx] + other : other + imp[idx];
                const int j = 2 * idx + h;
                const bool forced = (j == 0) || (j == cur), valid = (j * 64 <= qpos);
                imp[idx] = forced ? 1e4f : (valid ? tot : -1.0f);
            }
#pragma unroll 1
            for (int it = 0; it < 8; ++it) {
                float best = -INFINITY; int bj = 64;
#pragma unroll
                for (int idx = 0; idx < 16; ++idx) if (imp[idx] > best) { best = imp[idx]; bj = 2 * idx + h; }
                const float pb = xhalf_other(best, h); const int pj = __float_as_int(xhalf_other(__int_as_float(bj), h));
                const bool own = (best > pb) || (best == pb && bj < pj);
                const int wj = own ? bj : pj;
                sel |= 1u << wj;
#pragma unroll
                for (int idx = 0; idx < 16; ++idx) if (2 * idx + h == wj) imp[idx] = -INFINITY;
            }
        }
        atomicOr(orw, sel);
        __syncthreads();
        const unsigned bmask = *orw;
        const int jhi = (q0 + NSA_QB - 1) >> 6;
        const unsigned upto = jhi >= 31 ? 0xffffffffu : ((1u << (jhi + 1)) - 1u);
        const float c1 = 0.125f * LOG2E, sl2 = sl * LOG2E;
        {
            f32x16 o[2];
#pragma unroll
            for (int i = 0; i < 16; ++i) { o[0][i] = 0.f; o[1][i] = 0.f; }
            float m = -1e30f, l = 0.f;
            const int jlo = (q0 - 511 > 0 ? q0 - 511 : 0) >> 6;
            const unsigned tmask = upto & ~((1u << jlo) - 1u);
            attn_stream<64, 64, true>(qf[0], o, m, l, tmask, qw + 31, qw - 511,
                [&](int row) { return H + (trow + row) * NH + O_AKW + g * 64; },
                [&](int row) { return H + (trow + row) * NH + O_AVW + g * 64; },
                c1, sl2, qpos,
                [&](int key) { const int dist = qpos - key; return dist >= 0 && dist < 512; },
                [&](int j) { return j * 64 + 63 <= qw && qw + 31 - j * 64 < 512; }, lds);
            const float rl = gate2 / fmaxf(xhalf_sum(l), 1e-30f);
#pragma unroll
            for (int dvt = 0; dvt < 2; ++dvt)
#pragma unroll
                for (int i = 0; i < 4; ++i) { float4* a = (float4*)(oacc + dvt * 32 + 8 * i + 4 * h); float4 c = *a;
                    c.x += o[dvt][4 * i] * rl; c.y += o[dvt][4 * i + 1] * rl; c.z += o[dvt][4 * i + 2] * rl; c.w += o[dvt][4 * i + 3] * rl; *a = c; }
        }
        {
            f32x16 o[2];
#pragma unroll
            for (int i = 0; i < 16; ++i) { o[0][i] = 0.f; o[1][i] = 0.f; }
            float m = -1e30f, l = 0.f;
            attn_stream<64, 64, true>(qf[0], o, m, l, bmask & upto, qw + 31, 0,
                [&](int row) { return H + (trow + row) * NH + O_AKS + g * 64; },
                [&](int row) { return H + (trow + row) * NH + O_AVS + g * 64; },
                c1, sl2, qpos,
                [&](int key) { return key <= qpos && ((sel >> (key >> 6)) & 1u); },
                [&](int j) { return j * 64 + 63 <= qw && __all((sel >> j) & 1u); }, lds);
            const float rl = gate1 / fmaxf(xhalf_sum(l), 1e-30f);
            bf16_t* dst = BR + (trow + qpos) * 1024 + head * 64;
#pragma unroll
            for (int dvt = 0; dvt < 2; ++dvt)
#pragma unroll
                for (int i = 0; i < 4; ++i) { const float4 c = *(const float4*)(oacc + dvt * 32 + 8 * i + 4 * h);
                    st4bf(dst + dvt * 32 + 8 * i + 4 * h, c.x + o[dvt][4 * i] * rl, c.y + o[dvt][4 * i + 1] * rl, c.z + o[dvt][4 * i + 2] * rl, c.w + o[dvt][4 * i + 3] * rl); }
        }
    }
}

namespace pg8 { typedef PG8_LAS unsigned char* PG8_LAS_T; }
#define LDS3 ((pg8::PG8_LAS_T)lds)
#define GEMM256(EPI, SCHED, g, S, E) do { __syncthreads(); pg8::gemm_phase<EPI, SCHED, false, true>(LDS3, g, S, E); } while (0)
constexpr int NPH = 18;
constexpr int NPHASES = 2 + DEPTH * NPH;

__global__ void __launch_bounds__(NT, 2) mega(Params pk, int ph_lo, int ph_hi) {
    extern __shared__ __attribute__((aligned(16))) unsigned char lds[];
    const int bid = blockIdx.x, nblk = gridDim.x;
#define XB_HERE XcdBarrier bar_; bar_.bar = (unsigned*)(pk.ws + WS_CTL) + CW_BAR; bar_.x = xb_xcc_id(); bar_.st = (volatile LAS unsigned*)(lds + 131072)
    const bool multi = (ph_hi - ph_lo) > 1;
    if (multi) {
        uint4* xbw = (uint4*)(lds + 131072);
        if (tidx() == 0) *xbw = make_uint4(0u, 0u, 0u, 0u);
        __syncthreads();
        (void)xcd_barrier_post((unsigned*)(pk.ws + WS_CTL) + CW_BAR, (volatile LAS unsigned*)xbw);
    }
#ifndef PROBE_PH
#define PROBE_PH -100
#endif
#define PHASE(id, ...) do { const int _id = (id); if (ph_lo <= _id && _id < ph_hi) { for (int _rep = 0; _rep < ((PROBE_PH == -1 ? _id < 2 : (_id >= 2 && (_id - 2) % NPH == PROBE_PH)) ? 2 : 1); ++_rep) { if (_rep) { XB_HERE; xcd_barrier(bar_); } { Params p = pk; int layer = layer_; asm volatile("" : "+s"(p.ws), "+s"(p.out), "+s"(layer)); \
        const LayerW w = layer_w(p, layer); const float* Xin = (layer == 0) ? p.in[0] : WSF(WS_XC); const bf16_t* XinB = (layer == 0) ? WSB(WS_X0B) : WSB(WS_XCB); float* Xout = (layer == DEPTH - 1) ? p.out : WSF(WS_XC); \
        (void)w; (void)Xin; (void)XinB; (void)Xout; __VA_ARGS__; } } if (_id + 1 < ph_hi) { XB_HERE; xcd_barrier(bar_); } } } while (0)

    { const int layer_ = 0;
    PHASE(0, {
        job_wt<2>(p.in[2], DEPTH, 1024, NIN, WSB(WT_IN), NH, bid, nblk, lds);
        job_wt<0>(p.in[17], DEPTH, 1024, 1024, WSB(WT_BR), 1024, bid, nblk, lds);
        job_wt<0>(p.in[18], DEPTH, 1024, 1024, WSB(WT_OUT), 1024, bid, nblk, lds);
        job_wt<0>(p.in[21], DEPTH, 1024, 512, WSB(WT_Q), 512, bid, nblk, lds);
        job_wt<0>(p.in[22], DEPTH, 1024, 1024, WSB(WT_KV), 1024, bid, nblk, lds);
        job_wt<0>(p.in[23], DEPTH, 512, 1024, WSB(WT_O), 1024, bid, nblk, lds);
        job_wt<1>(p.in[30], DEPTH * 32, 1024, 1024, WSB(WT_GU), 1024, bid, nblk, lds);
        job_wt<0>(p.in[31], DEPTH * 32, 512, 1024, WSB(WT_DN), 1024, bid, nblk, lds);
        job_wt<0>(p.in[4], DEPTH * 2, 2048, 256, WSB(WT_C1), 256, bid, nblk, lds);
        job_wt<0>(p.in[5], DEPTH * 2, 256, 64, WSB(WT_C2), 128, bid, nblk, lds);
        job_wt<0>(p.in[15], DEPTH, 192, 384, WSB(WT_UQ), 384, bid, nblk, lds);
        job_wt<0>(p.in[16], DEPTH, 128, 512, WSB(WT_UKV), 512, bid, nblk, lds);
        job_pack_small(p, bid, nblk);
        job_cvt(p.in[0], WSB(WS_X0B), (long)T * 1024, bid, nblk);
        job_cvt(p.in[1], WSB(WS_MEMB), (long)2048 * 1024, bid, nblk);
    });
    PHASE(1, {
        pg8::Gemm g{WSB(WS_MEMB), WSB(WT_KV), BATCH * MEM_LEN, 1024, 1024};
        GroupedOrder S{8, 4, DEPTH, nblk, bid};
        EpiStoreBf16 E{WSB(WS_KVM), 1024, 1 << 30, (long)2048 * 1024};
        GEMM256(EpiStoreBf16, GroupedOrder, g, S, E);
    });
    }
    for (int layer_ = 0; layer_ < DEPTH; ++layer_) {
        const int base = 2 + layer_ * NPH;
        PHASE(base + 0, { pg8::Gemm g{XinB, w.t_in, T, NH, 1024}; pg8::StaticOrder S; S.init(T, NH, nblk, bid); EpiStoreBf16 E{WSB(WS_H), NH, O_MG / 128, 0}; GEMM256(EpiStoreBf16, pg8::StaticOrder, g, S, E); });
        PHASE(base + 1, { job_sb_attn(p, bid, nblk, lds); job_cmp_gather(p, w, bid, nblk); job_rnn_conv(p, w, bid, nblk); job_mla_norm(p, w, bid, nblk); });
        PHASE(base + 2, { if (bid < 16) job_cmp_mlp<0>(p, w, bid, 16, lds); else { job_rnn_gates(p, w, bid - 16, nblk - 16, lds); job_mla_up(p, w, bid - 16, nblk - 16, lds); } });
        PHASE(base + 3, { job_cmp_mlp<1>(p, w, bid, nblk, lds); job_rnn_scan1(p, bid, nblk); });
        PHASE(base + 4, { job_nsa(p, bid, nblk, lds); job_mla_attn(p, bid, nblk, lds); job_rnn_scan2(p, bid, nblk); });
        PHASE(base + 5, { job_merge(p, w, bid, nblk, lds); });
        PHASE(base + 6, { pg8::Gemm g{WSB(WS_M), w.t_out, T, 1024, 1024}; pg8::StaticOrder S; S.init(T, 1024, nblk, bid); EpiStoreBf16 E{WSB(WS_Y), 1024, 1 << 30, 0}; GEMM256(EpiStoreBf16, pg8::StaticOrder, g, S, E); });
        PHASE(base + 7, { job_ln(Xin, WSB(WS_Y), 1024, nullptr, w.ln1_g, w.ln1_b, WSF(WS_XA), WSB(WS_XAB), nullptr, bid, nblk); });
        PHASE(base + 8, { pg8::Gemm g{WSB(WS_XAB), w.t_q, T, 512, 1024}; pg8::StaticOrder S; S.init(T, 512, nblk, bid); EpiStoreBf16 E{WSB(WS_XQ), 512, 1 << 30, 0}; GEMM256(EpiStoreBf16, pg8::StaticOrder, g, S, E); });
        PHASE(base + 9, { job_cross_attn(p, layer, bid, nblk, lds); });
        PHASE(base + 10, { pg8::Gemm g{WSB(WS_XO), w.t_o, T, 1024, 512}; pg8::StaticOrder S; S.init(T, 1024, nblk, bid); EpiStoreBf16 E{WSB(WS_Y), 1024, 1 << 30, 0}; GEMM256(EpiStoreBf16, pg8::StaticOrder, g, S, E); });
        PHASE(base + 11, { job_ln(WSF(WS_XA), WSB(WS_Y), 1024, nullptr, w.ln2_g, w.ln2_b, WSF(WS_XB), WSB(WS_XBB), WSB(WS_XBL), bid, nblk); });
        PHASE(base + 12, { job_router_logits(p, w, bid, nblk, lds); });
        PHASE(base + 13, { job_router(p, w, layer, bid, nblk); });
        PHASE(base + 14, { job_fill(p, layer, bid, nblk, lds); });
        PHASE(base + 15, { const pg8::ListOrder S = moe_units(WSU(WS_CTL) + CW_CNT + layer * 32, bid, nblk); pg8::Gemm g{WSB(WS_XG), w.t_gu, PADROWS, 1024, 1024}; EpiMoeGU E{WSB(WS_HH)}; GEMM256(EpiMoeGU, pg8::ListOrder, g, S, E); });
        PHASE(base + 16, { const pg8::ListOrder S = moe_units(WSU(WS_CTL) + CW_CNT + layer * 32, bid, nblk); pg8::Gemm g{WSB(WS_HH), w.t_dn, PADROWS, 1024, 512}; EpiMoeDown E{WSI(WS_PERM), WSF(WS_EW), WSB(WS_YK)}; GEMM256(EpiMoeDown, pg8::ListOrder, g, S, E); });
        PHASE(base + 17, { job_ln(WSF(WS_XB), WSB(WS_YK), 2048, WSB(WS_YK) + 1024, w.ln3_g, w.ln3_b, Xout, (layer == DEPTH - 1) ? nullptr : WSB(WS_XCB), nullptr, bid, nblk); });
    }
}

extern "C" void kernel_launch(void* const* d_in, const int* in_sizes, int n_in, void* d_out, int out_size, void* d_ws, size_t ws_size, hipStream_t stream) {
    constexpr size_t kDynLds = 131072 + 1024;
    static_assert(2 * G_STAGE + 1024 <= 131072, "engine stages fit");
    static int grid = 0;
    if (!grid) {
        int dev = 0, cus = 0, per_cu = 0;
        (void)hipGetDevice(&dev);
        (void)hipDeviceGetAttribute(&cus, hipDeviceAttributeMultiprocessorCount, dev);
        (void)hipFuncSetAttribute((const void*)mega, hipFuncAttributeMaxDynamicSharedMemorySize, (int)kDynLds);
        (void)hipOccupancyMaxActiveBlocksPerMultiprocessor(&per_cu, mega, NT, kDynLds);
        if (per_cu < 1) per_cu = 1;
        grid = cus * (per_cu < 2 ? per_cu : 2);
    }
    if (ws_size < WS_END) { fprintf(stderr, "workspace too small: %zu < %zu\n", ws_size, (size_t)WS_END); return; }
    Params p{};
    for (int i = 0; i < 34; ++i) p.in[i] = (const float*)d_in[i];
    p.out = (float*)d_out;
    p.ws = (unsigned char*)d_ws;
    (void)hipMemsetAsync(d_ws, 0, CTL_BYTES, stream);
#if MK_ONE_LAUNCH
    hipLaunchKernelGGL(mega, dim3(grid), dim3(NT), kDynLds, stream, p, 0, NPHASES);
#else
    for (int ph = 0; ph < NPHASES; ++ph) hipLaunchKernelGGL(mega, dim3(grid), dim3(NT), kDynLds, stream, p, ph, ph + 1);
#endif
}
```

```cpp
#include <hip/hip_runtime.h>
#include <stdint.h>
#include <stdio.h>

#ifndef MK_ONE_LAUNCH
#define MK_ONE_LAUNCH 1
#endif

#define DI __device__ __forceinline__
#define LAS __attribute__((address_space(3)))
DI int tidx() { int t = threadIdx.x; asm volatile("" : "+v"(t)); return t; }

constexpr int NT = 512;
constexpr int D = 1024, BATCH = 8, SEQ = 2048, T = BATCH * SEQ, DEPTH = 4;
constexpr int MEM_LEN = 256;
constexpr int NIN = 6764, NH = 6912;
constexpr int O_AQ = 0, O_AKC = 256, O_AVC = 384, O_AKS = 512, O_AVS = 640, O_AKW = 768, O_AVW = 896,
              O_BQ = 1024, O_BK = 1280, O_BV = 1536, O_CX = 1792, O_CG = 2048, O_DCQ = 2304, O_DCKV = 2496, O_DKR = 2624,
              O_AG = 2656, O_MG = 2688;
constexpr int NCMP = 127, NCR = BATCH * NCMP * 2;
constexpr int NEXP = 32, NASSIGN = T * 2;
constexpr float DN_ALPHA = 1.681792830507429f;

typedef unsigned short bf16_t;
typedef short bf16x8 __attribute__((ext_vector_type(8)));
typedef float f32x16 __attribute__((ext_vector_type(16)));
typedef unsigned u32x4 __attribute__((ext_vector_type(4)));

constexpr int G_WM = NT / 128;
constexpr int G_BM = 64 * G_WM;
constexpr int G_BN = 128;
constexpr int G_RS = 144;
constexpr int G_STAGE = (G_BM + G_BN) * G_RS;
constexpr int PADROWS = ((NASSIGN + NEXP * (G_BM - 1) + G_BM - 1) / G_BM) * G_BM;

constexpr size_t MiB = 1u << 20;
constexpr size_t al(size_t x) { return (x + 255) & ~(size_t)255; }
constexpr size_t WS_CTL = 0, CTL_BYTES = 1 * MiB;
constexpr size_t WT_IN = WS_CTL + CTL_BYTES;
constexpr size_t WT_BR = WT_IN + al((size_t)DEPTH * NH * 1024 * 2);
constexpr size_t WT_OUT = WT_BR + al((size_t)DEPTH * 4 * 1024 * 256 * 2);
constexpr size_t WT_Q = WT_OUT + al((size_t)DEPTH * 1024 * 1024 * 2);
constexpr size_t WT_KV = WT_Q + al((size_t)DEPTH * 512 * 1024 * 2);
constexpr size_t WT_O = WT_KV + al((size_t)DEPTH * 1024 * 1024 * 2);
constexpr size_t WT_GU = WT_O + al((size_t)DEPTH * 1024 * 512 * 2);
constexpr size_t WT_DN = WT_GU + al((size_t)DEPTH * 32 * 1024 * 1024 * 2);
constexpr size_t WS_X0B = WT_DN + al((size_t)DEPTH * 32 * 1024 * 512 * 2);
constexpr size_t WS_MEMB = WS_X0B + al((size_t)T * 1024 * 2);
constexpr size_t WS_H = WS_MEMB + al((size_t)2048 * 1024 * 2);
constexpr size_t SZ_H = al((size_t)T * NH * 2);
constexpr size_t WS_YK = WS_H;
constexpr size_t WS_HH = WS_YK + (size_t)NASSIGN * 1024 * 2;
static_assert(WS_HH + (size_t)PADROWS * 512 * 2 <= WS_H + SZ_H, "moe overlay fits in H");
constexpr size_t WS_TB = WS_H + SZ_H;
constexpr size_t WS_HID = WS_TB + al((size_t)2 * NCR * 2048 * 4);
constexpr size_t WS_KCVC = WS_HID + al((size_t)2 * NCR * 256 * 4);
constexpr size_t WS_PC = WS_KCVC + al((size_t)2 * NCR * 64 * 4);
constexpr size_t WS_SEL = WS_PC + al((size_t)BATCH * 4 * SEQ * 128 * 4);
constexpr size_t WS_OW = WS_SEL + al((size_t)BATCH * 2 * SEQ * 4);
constexpr size_t WS_OC = WS_OW + al((size_t)T * 256 * 4);
constexpr size_t WS_BR = WS_OC + al((size_t)T * 256 * 4);
constexpr size_t WS_U = WS_BR + al((size_t)T * 1024 * 2);
constexpr size_t WS_RA = WS_U + al((size_t)T * 256 * 4);
constexpr size_t WS_RB = WS_RA + al((size_t)T * 256 * 4);
constexpr size_t WS_CQN = WS_RB + al((size_t)T * 256 * 4);
constexpr size_t WS_CKVN = WS_CQN + al((size_t)T * 192 * 4);
constexpr size_t WS_KR = WS_CKVN + al((size_t)T * 128 * 4);
constexpr size_t WS_Q = WS_KR + al((size_t)T * 32 * 4);
constexpr size_t WS_KV = WS_Q + al((size_t)T * 384 * 4);
constexpr size_t WS_M = WS_KV + al((size_t)T * 512 * 4);
constexpr size_t WS_Y = WS_M + al((size_t)T * 1024 * 2);
constexpr size_t WS_XA = WS_Y + al((size_t)T * 1024 * 4);
constexpr size_t WS_XB = WS_XA + al((size_t)T * 1024 * 4);
constexpr size_t WS_XC = WS_XB + al((size_t)T * 1024 * 4);
constexpr size_t WS_XAB = WS_XC + al((size_t)T * 1024 * 4);
constexpr size_t WS_XBB = WS_XAB + al((size_t)T * 1024 * 2);
constexpr size_t WS_XCB = WS_XBB + al((size_t)T * 1024 * 2);
constexpr size_t WS_XQ = WS_XCB + al((size_t)T * 1024 * 2);
constexpr size_t WS_XO = WS_XQ + al((size_t)T * 512 * 2);
constexpr size_t WS_KVM = WS_XO + al((size_t)T * 512 * 2);
constexpr size_t WS_LOG = WS_KVM + al((size_t)DEPTH * 2048 * 1024 * 2);
constexpr size_t WS_EIDX = WS_LOG + al((size_t)3 * T * 36 * 4);
constexpr size_t WS_ESLOT = WS_EIDX + al((size_t)NASSIGN * 4);
constexpr size_t WS_EW = WS_ESLOT + al((size_t)NASSIGN * 4);
constexpr size_t WS_PERM = WS_EW + al((size_t)NASSIGN * 4);
constexpr size_t WS_QB = WS_PERM + al((size_t)PADROWS * 4);
constexpr size_t WS_KM = WS_QB + al((size_t)T * 384 * 2);
constexpr size_t WS_VM = WS_KM + al((size_t)T * 384 * 2);
constexpr size_t WS_KCB = WS_VM + al((size_t)T * 256 * 2);
constexpr size_t WT_C1 = WS_KCB + al((size_t)2 * NCR * 64 * 2);
constexpr size_t WT_C2 = WT_C1 + al((size_t)DEPTH * 2 * 256 * 2048 * 2);
constexpr size_t WT_UQ = WT_C2 + al((size_t)DEPTH * 2 * 128 * 256 * 2);
constexpr size_t WT_UKV = WT_UQ + al((size_t)DEPTH * 384 * 192 * 2);
constexpr size_t WT_G = WT_UKV + al((size_t)DEPTH * 512 * 128 * 2);
constexpr size_t WT_RH = WT_G + al((size_t)DEPTH * 4 * 128 * 64 * 2);
constexpr size_t WT_RL = WT_RH + al((size_t)DEPTH * 128 * 1024 * 2);
constexpr size_t WS_TBB = WT_RL + al((size_t)DEPTH * 128 * 1024 * 2);
constexpr size_t WS_HIDB = WS_TBB + al((size_t)2 * 2048 * 2048 * 2);
constexpr size_t WS_UB = WS_HIDB + al((size_t)2 * 2048 * 256 * 2);
constexpr size_t WS_CQNB = WS_UB + al((size_t)T * 256 * 2);
constexpr size_t WS_CKVNB = WS_CQNB + al((size_t)T * 192 * 2);
constexpr size_t WS_XBL = WS_CKVNB + al((size_t)T * 128 * 2);
constexpr size_t WS_SA = WS_XBL + al((size_t)T * 1024 * 2);
constexpr size_t WS_SH = WS_SA + al((size_t)BATCH * 32 * 256 * 4);
constexpr size_t WS_XG = WS_SH + al((size_t)BATCH * 32 * 256 * 4);
constexpr size_t WS_ROPE = WS_XG + al((size_t)PADROWS * 1024 * 2);
constexpr size_t WS_END = WS_ROPE + al((size_t)SEQ * 16 * 2 * 4);

constexpr int CW_BAR = 4096;
constexpr int CW_CNT = 16384;

struct Params {
    const float* in[34];
    float* out;
    unsigned char* ws;
};

#define XB_TMO      128
#define XB_XCNT(j)  (256  + 64 * (j))
#define XB_XSUB(j)  (1280 + 64 * (j))
#define XB_XGEN(j)  (2304 + 64 * (j))
#define XB_TOP      3328
#define XB_TOPGEN   3392
#define XCD_BAR_WORDS 3456
#define XB_SPIN_CAP (1u << 22)

__device__ __forceinline__ unsigned xb_ld(unsigned* p)              { return __hip_atomic_load(p, __ATOMIC_RELAXED, __HIP_MEMORY_SCOPE_AGENT); }
__device__ __forceinline__ unsigned xb_add(unsigned* p, unsigned v) { return __hip_atomic_fetch_add(p, v, __ATOMIC_RELAXED, __HIP_MEMORY_SCOPE_AGENT); }
__device__ __forceinline__ unsigned xb_xcc_id() { return (unsigned)__builtin_amdgcn_s_getreg((3 << 11) | 20) & 0xFu; }
#define XB_SPIN(cond, bar) do { unsigned _sp = 0; while (cond) { __builtin_amdgcn_s_sleep(1); \
    if ((++_sp & 255u) == 0u) { if (xb_ld(&(bar)[XB_TMO])) break; if (_sp > XB_SPIN_CAP) { atomicAdd(&(bar)[XB_TMO], 1u); break; } } } } while (0)

struct XcdBarrier { unsigned* bar; unsigned x; volatile LAS unsigned* st; };

__device__ __forceinline__ XcdBarrier xcd_barrier_post(unsigned* bar, volatile LAS unsigned* st) {
    XcdBarrier b; b.bar = bar; b.x = xb_xcc_id(); b.st = st;
    if (threadIdx.x == 0) (void)xb_add(&bar[XB_XCNT(b.x)], 1u);
    return b;
}
__device__ __forceinline__ void xcd_barrier_complete(unsigned* bar, unsigned x, unsigned& nloc, unsigned& nx) {
    const unsigned G = gridDim.x * gridDim.y * gridDim.z;
    unsigned sum, cnt, mine, sp = 0u;
    for (;;) {
        sum = 0u; cnt = 0u; mine = 0u;
#pragma unroll
        for (unsigned j = 0; j < 16; ++j) { const unsigned c = xb_ld(&bar[XB_XCNT(j)]); sum += c; cnt += (c > 0u) ? 1u : 0u; mine = (j == x) ? c : mine; }
        if (sum == G) break;
        __builtin_amdgcn_s_sleep(1);
        if ((++sp & 255u) == 0u) { if (xb_ld(&bar[XB_TMO])) break; if (sp > XB_SPIN_CAP) { atomicAdd(&bar[XB_TMO], 1u); break; } }
    }
    nloc = mine > 0u ? mine : 1u; nx = cnt > 0u ? cnt : 1u;
}
__device__ __forceinline__ void xcd_barrier(const XcdBarrier& b) {
    asm volatile("s_waitcnt vmcnt(0)" ::: "memory");
    __syncthreads();
    if (threadIdx.x == 0) {
        unsigned* bar = b.bar;
        __builtin_amdgcn_s_waitcnt(0);
        unsigned nloc = b.st[0], nx = b.st[1];
        if (nloc == 0u) { xcd_barrier_complete(bar, b.x, nloc, nx); b.st[0] = nloc; b.st[1] = nx; }
        const unsigned old = xb_add(&bar[XB_XSUB(b.x)], 1u);
        const unsigned gen = old / nloc;
        if (old + 1u == (gen + 1u) * nloc) {
            __builtin_amdgcn_fence(__ATOMIC_RELEASE, "agent");
            asm volatile("s_waitcnt vmcnt(0)" ::: "memory");
            const unsigned og = xb_add(&bar[XB_TOP], 1u);
            const unsigned tg = og / nx;
            if (og + 1u == (tg + 1u) * nx) xb_add(&bar[XB_TOPGEN], 1u);
            else XB_SPIN(xb_ld(&bar[XB_TOPGEN]) == tg, bar);
            __builtin_amdgcn_fence(__ATOMIC_ACQUIRE, "agent");
            xb_add(&bar[XB_XGEN(b.x)], 1u);
            asm volatile("s_waitcnt vmcnt(0)" ::: "memory");
        } else {
            XB_SPIN(xb_ld(&bar[XB_XGEN(b.x)]) == gen, bar);
            __builtin_amdgcn_fence(__ATOMIC_ACQUIRE, "agent");
            asm volatile("s_waitcnt vmcnt(0)" ::: "memory");
        }
    }
    __syncthreads();
}

DI float gelu_tanh(float x) { const float u = 0.7978845608028654f * (x + 0.044715f * x * x * x); return 0.5f * x * (1.f + tanhf(u)); }
DI float sigm(float x) { return 1.f / (1.f + expf(-x)); }
DI float sigm_fast(float x) { return __builtin_amdgcn_rcpf(1.f + __expf(-x)); }
DI float logsig(float z) { return fminf(z, 0.f) - log1pf(expf(-fabsf(z))); }
DI float wave_sum(float v) {
    const int lane = tidx() & 63;
#pragma unroll
    for (int o = 32; o > 0; o >>= 1) v += __int_as_float(__builtin_amdgcn_ds_bpermute((lane ^ o) << 2, __float_as_int(v)));
    return v;
}

DI float bflo(unsigned u) { return __uint_as_float(u << 16); }
DI float bfhi(unsigned u) { return __uint_as_float(u & 0xffff0000u); }
DI float bf2f(bf16_t x) { return __uint_as_float((unsigned)x << 16); }
typedef float f32x2_t __attribute__((ext_vector_type(2)));
typedef __bf16 bf16x2_t __attribute__((ext_vector_type(2)));
DI unsigned pk_bf16(float lo, float hi) { f32x2_t v = {lo, hi}; bf16x2_t b = __builtin_convertvector(v, bf16x2_t); return __builtin_bit_cast(unsigned, b); }
DI bf16_t f2bf(float x) { return (bf16_t)(pk_bf16(x, 0.f) & 0xffffu); }
DI void st4bf(bf16_t* p, float a, float b, float c, float d) { uint2 v; v.x = pk_bf16(a, b); v.y = pk_bf16(c, d); *(uint2*)p = v; }
DI float4 ld4bf(const bf16_t* p) { const uint2 v = *(const uint2*)p; return make_float4(bflo(v.x), bfhi(v.x), bflo(v.y), bfhi(v.y)); }
template <int N> DI float dot_row(const float* q, const bf16_t* kr) {
    float dot = 0.f;
#pragma unroll
    for (int d = 0; d < N; d += 8) { const uint4 v = *(const uint4*)(kr + d);
        dot = fmaf(q[d], bflo(v.x), dot); dot = fmaf(q[d + 1], bfhi(v.x), dot); dot = fmaf(q[d + 2], bflo(v.y), dot); dot = fmaf(q[d + 3], bfhi(v.y), dot);
        dot = fmaf(q[d + 4], bflo(v.z), dot); dot = fmaf(q[d + 5], bfhi(v.z), dot); dot = fmaf(q[d + 6], bflo(v.w), dot); dot = fmaf(q[d + 7], bfhi(v.w), dot); }
    return dot;
}
template <int N> DI float dot_row(const float* q, const float* kr) {
    float dot = 0.f;
#pragma unroll
    for (int d = 0; d < N; ++d) dot = fmaf(q[d], kr[d], dot);
    return dot;
}
template <int N> DI void axpy_row(float* o, float pr, float corr, const bf16_t* vr) {
#pragma unroll
    for (int d = 0; d < N; d += 8) { const uint4 v = *(const uint4*)(vr + d);
        o[d] = fmaf(pr, bflo(v.x), o[d] * corr); o[d + 1] = fmaf(pr, bfhi(v.x), o[d + 1] * corr); o[d + 2] = fmaf(pr, bflo(v.y), o[d + 2] * corr); o[d + 3] = fmaf(pr, bfhi(v.y), o[d + 3] * corr);
        o[d + 4] = fmaf(pr, bflo(v.z), o[d + 4] * corr); o[d + 5] = fmaf(pr, bfhi(v.z), o[d + 5] * corr); o[d + 6] = fmaf(pr, bflo(v.w), o[d + 6] * corr); o[d + 7] = fmaf(pr, bfhi(v.w), o[d + 7] * corr); }
}
template <int N> DI void axpy_row(float* o, float pr, float corr, const float* vr) {
#pragma unroll
    for (int d = 0; d < N; ++d) o[d] = fmaf(pr, vr[d], o[d] * corr);
}
template <int N> DI void ld_row(float* q, const bf16_t* p) {
#pragma unroll
    for (int d = 0; d < N; d += 8) { const uint4 v = *(const uint4*)(p + d);
        q[d] = bflo(v.x); q[d + 1] = bfhi(v.x); q[d + 2] = bflo(v.y); q[d + 3] = bfhi(v.y); q[d + 4] = bflo(v.z); q[d + 5] = bfhi(v.z); q[d + 6] = bflo(v.w); q[d + 7] = bfhi(v.w); }
}
template <int N> DI void ld_row(float* q, const float* p) {
#pragma unroll
    for (int d = 0; d < N; d += 4) { const float4 v = *(const float4*)(p + d); q[d] = v.x; q[d + 1] = v.y; q[d + 2] = v.z; q[d + 3] = v.w; }
}

struct MG { const bf16_t* A; long lda; const bf16_t* Wt; long ldw; int K; };

struct NoFlush { DI void operator()(int, f32x16 (&)[2][2]) const {} };
template <class RowFn, class Flush>
DI void mgemm_tile_f(const MG& g, int n0, RowFn rowfn, f32x16 (&acc)[2][2], unsigned char* lds, bool zero, int flush_every, Flush flush) {
    constexpr int XI = G_BM * 8 / NT, WI = G_BN * 8 / NT;
    const int tid = tidx(), lane = tid & 63, wid = tid >> 6, r = lane & 31, h = lane >> 5;
    const int wm = wid % G_WM, wn = wid / G_WM;
    const int cc = tid & 7, row0 = tid >> 3;
    const bf16_t* xp[XI]; const bf16_t* wp[WI];
#pragma unroll
    for (int i = 0; i < XI; ++i) xp[i] = g.A + (long)rowfn(row0 + (NT / 8) * i) * g.lda + cc * 8;
#pragma unroll
    for (int i = 0; i < WI; ++i) wp[i] = g.Wt + (long)(n0 + row0 + (NT / 8) * i) * g.ldw + cc * 8;
    const int st_off = row0 * G_RS + cc * 16;
    if (zero)
#pragma unroll
    for (int a = 0; a < 2; ++a)
#pragma unroll
        for (int b = 0; b < 2; ++b)
#pragma unroll
            for (int i = 0; i < 16; ++i) acc[a][b][i] = 0.f;
    const int nk = g.K >> 6;
    u32x4 xv0[XI], wv0[WI], xv1[XI], wv1[WI];
#define MG_GLOAD(XV, WV, KT) do { _Pragma("unroll") for (int i = 0; i < XI; ++i) XV[i] = *(const u32x4*)(xp[i] + (KT) * 64); \
                                  _Pragma("unroll") for (int i = 0; i < WI; ++i) WV[i] = *(const u32x4*)(wp[i] + (KT) * 64); } while (0)
#define MG_LSTORE(XV, WV, STG) do { unsigned char* _s = lds + (STG) * G_STAGE; \
        _Pragma("unroll") for (int i = 0; i < XI; ++i) *(u32x4*)(_s + st_off + (NT / 8) * i * G_RS) = XV[i]; \
        _Pragma("unroll") for (int i = 0; i < WI; ++i) *(u32x4*)(_s + G_BM * G_RS + st_off + (NT / 8) * i * G_RS) = WV[i]; } while (0)
    MG_GLOAD(xv0, wv0, 0);
    if (nk > 1) MG_GLOAD(xv1, wv1, 1);
    __syncthreads();
    MG_LSTORE(xv0, wv0, 0);
    if (nk > 2) MG_GLOAD(xv0, wv0, 2);
    __syncthreads();
    const int xf_off = (wm * 64 + r) * G_RS + h * 16, wf_off = G_BM * G_RS + (wn * 64 + r) * G_RS + h * 16;
#define MG_COMPUTE(STG) do { const unsigned char* st = lds + (STG) * G_STAGE; \
        _Pragma("unroll") for (int ks = 0; ks < 4; ++ks) { \
            const bf16x8 w0 = *(const bf16x8*)(st + wf_off + ks * 32), w1 = *(const bf16x8*)(st + wf_off + 32 * G_RS + ks * 32); \
            const bf16x8 x0 = *(const bf16x8*)(st + xf_off + ks * 32), x1 = *(const bf16x8*)(st + xf_off + 32 * G_RS + ks * 32); \
            acc[0][0] = __builtin_amdgcn_mfma_f32_32x32x16_bf16(w0, x0, acc[0][0], 0, 0, 0); \
            acc[0][1] = __builtin_amdgcn_mfma_f32_32x32x16_bf16(w0, x1, acc[0][1], 0, 0, 0); \
            acc[1][0] = __builtin_amdgcn_mfma_f32_32x32x16_bf16(w1, x0, acc[1][0], 0, 0, 0); \
            acc[1][1] = __builtin_amdgcn_mfma_f32_32x32x16_bf16(w1, x1, acc[1][1], 0, 0, 0); } } while (0)
    for (int kt = 0; kt < nk; kt += 2) {
        MG_COMPUTE(0);
        if (kt + 1 < nk) { MG_LSTORE(xv1, wv1, 1); if (kt + 3 < nk) MG_GLOAD(xv1, wv1, kt + 3); }
        if (flush_every && (kt + 1) % flush_every == 0) flush(kt / flush_every, acc);
        __syncthreads();
        if (kt + 1 < nk) {
            MG_COMPUTE(1);
            if (kt + 2 < nk) { MG_LSTORE(xv0, wv0, 0); if (kt + 4 < nk) MG_GLOAD(xv0, wv0, kt + 4); }
            if (flush_every && (kt + 2) % flush_every == 0) flush((kt + 1) / flush_every, acc);
            __syncthreads();
        }
    }
#undef MG_GLOAD
#undef MG_LSTORE
#undef MG_COMPUTE
}
template <class RowFn>
DI void mgemm_tile(const MG& g, int n0, RowFn rowfn, f32x16 (&acc)[2][2], unsigned char* lds, bool zero = true) { mgemm_tile_f(g, n0, rowfn, acc, lds, zero, 0, NoFlush{}); }
#define MG_FOREACH(acc, LROW, FEAT, V, ...) do { const int _l = tidx() & 63, _w = tidx() >> 6, _wm = _w % G_WM, _wn = _w / G_WM; \
    _Pragma("unroll") for (int _ft = 0; _ft < 2; ++_ft) _Pragma("unroll") for (int _tt = 0; _tt < 2; ++_tt) _Pragma("unroll") for (int _i = 0; _i < 4; ++_i) { \
        const int LROW = _wm * 64 + _tt * 32 + (_l & 31); const int FEAT = _wn * 64 + _ft * 32 + 8 * _i + 4 * (_l >> 5); \
        float V[4] = {acc[_ft][_tt][4 * _i], acc[_ft][_tt][4 * _i + 1], acc[_ft][_tt][4 * _i + 2], acc[_ft][_tt][4 * _i + 3]}; __VA_ARGS__ } } while (0)

struct RowId { int m0; DI long operator()(int r) const { return m0 + r; } };

template <int OUTMODE>
DI void mgemm_job(const MG& g, int M, int N, void* out, long ldo, int bid, int nblk, unsigned char* lds) {
    const int tm = M / G_BM, tn = N / G_BN;
    for (int u = bid; u < tm * tn; u += nblk) {
        const int grp = u / (16 * tn), rem = u % (16 * tn);
        const int gm = (tm - grp * 16) < 16 ? (tm - grp * 16) : 16;
        const int mt = grp * 16 + rem % gm, nt = rem / gm;
        const int m0 = mt * G_BM, n0 = nt * G_BN;
        f32x16 acc[2][2];
        mgemm_tile(g, n0, RowId{m0}, acc, lds);
        MG_FOREACH(acc, lrow, feat, v, {
            const long o = (long)(m0 + lrow) * ldo + n0 + feat;
            if (OUTMODE == 1) *(float4*)((float*)out + o) = make_float4(v[0], v[1], v[2], v[3]);
            else {
                if (OUTMODE == 2 && n0 + feat >= O_MG) { v[0] = sigm(v[0]); v[1] = sigm(v[1]); v[2] = sigm(v[2]); v[3] = sigm(v[3]); }
                st4bf((bf16_t*)out + o, v[0], v[1], v[2], v[3]);
            } });
    }
}

namespace pg8 {
#define PG8_LAS __attribute__((address_space(3)))
typedef float f32x4 __attribute__((ext_vector_type(4)));
constexpr int BM = 256, BK = 64, HALF = 128, HTB = HALF * BK * 2  , STAGE_BYTES = 8 * HTB, NXCD = 8, WGM = 8;
__host__ __device__ __forceinline__ int lds_byte(int r, int c) { const int st = (r >> 4) * 2 + (c >> 5), rr = r & 15, cc = c & 31, ob = rr * 64 + cc * 2; return st * 1024 + (ob ^ (((ob >> 9) & 1) << 5)); }
__host__ __device__ __forceinline__ void stage_rc(int b, int& R, int& C) { const int st = b / 1024, sb = b % 1024, swz = sb ^ (((sb >> 9) & 1) << 5); R = (st >> 1) * 16 + swz / 64; C = (st & 1) * 32 + (swz % 64) / 2; }
__host__ __device__ __forceinline__ int perm32(int rho) { const int n = rho >> 4, i = rho & 15; return 8 * (i >> 2) + 4 * n + (i & 3); }
struct Unit { int pm, pn, e; };
struct Gemm { const bf16_t* A; const bf16_t* Bt; int M, N, K; };
struct StaticOrder {
    int nM, nN, nwg, G, c;
    __device__ void init(int M, int N, int G_, int c_) { nM = M / BM; nN = N / BM; nwg = nM * nN; G = G_; c = c_; }
    __device__ bool next(int i, Unit& u) const {
        const long L = (long)i * G + c; if (L >= nwg) return false;
        int wgid = (int)L; { const int q = nwg / NXCD, r = nwg % NXCD, xcd = wgid % NXCD, off = wgid / NXCD; wgid = (xcd < r ? xcd * (q + 1) : r * (q + 1) + (xcd - r) * q) + off; }
        const int nig = WGM * nN, gid = wgid / nig, fm = gid * WGM, gsz = (nM - fm) < WGM ? (nM - fm) : WGM;
        u.pm = fm + ((wgid % nig) % gsz); u.pn = (wgid % nig) / gsz; u.e = 0; return true;
    }
    __device__ __forceinline__ void a_ready(const Unit&) const {}
    __device__ __forceinline__ void done(const Unit&) const {}
};
struct ListOrder {
    Unit u0, u1, u2; int n;
    __device__ bool next(int i, Unit& u) const { if (i >= n) return false; u = (i == 0) ? u0 : ((i == 1) ? u1 : u2); return true; }
    __device__ __forceinline__ void a_ready(const Unit&) const {}
    __device__ __forceinline__ void done(const Unit&) const {}
};
template <class Epi, class Sched, bool ALIGN_EPI = false, bool SP2 = false>
__device__ __forceinline__ void gemm_phase(PG8_LAS unsigned char* lds, const Gemm g, const Sched& S, const Epi& E) {
    const int tid = tidx(), wid = __builtin_amdgcn_readfirstlane(tid >> 6), lane = tid & 63, wr = wid >> 2, wc = wid & 3, fr = lane & 15, fq = lane >> 4;
    const int K = g.K, nt = K / BK;
    unsigned voffA[2], voffB[2];
#pragma unroll
    for (int i = 0; i < 2; ++i) { int R, C; stage_rc(tid * 16 + i * 8192, R, C); const int Rb = Epi::PERM ? ((R & ~31) + perm32(R & 31)) : R;
        voffA[i] = (unsigned)(R * K + C) * 2u; voffB[i] = (unsigned)(Rb * K + C) * 2u; }
    const size_t kstep = (size_t)(BK * 2);
    const size_t hstep = (size_t)HALF * K * 2;
    const size_t tstep = 2 * hstep;
    const size_t estep = (size_t)g.N * K * 2;
    const unsigned ldsw = (unsigned)wid * 1024u;
    const int aoff = lds_byte(wr * 64 + fr, fq * 8), boff = lds_byte(wc * 32 + fr, fq * 8);
#define PG8_SA(b, h) (((b) * 2 + (h)) * HTB)
#define PG8_SB(b, h) ((4 + (b) * 2 + (h)) * HTB)
#define PG8_STAGE(bufoff, gbase, voff) do { _Pragma("unroll") for (int _i = 0; _i < 2; ++_i) \
        __builtin_amdgcn_global_load_lds((const unsigned*)((const char*)(gbase) + (voff)[_i]), (PG8_LAS unsigned*)(lds + (bufoff) + ldsw + _i * 8192), 16, 0, 0); } while (0)
#define PG8_LDA(dst, b, h) do { _Pragma("unroll") for (int m = 0; m < 4; ++m) _Pragma("unroll") for (int k = 0; k < 2; ++k) dst[m][k] = *(const PG8_LAS bf16x8*)(lds + PG8_SA(b, h) + aoff + m * 2048 + k * 1024); } while (0)
#define PG8_LDB(dst, b, h) do { _Pragma("unroll") for (int n = 0; n < 2; ++n) _Pragma("unroll") for (int k = 0; k < 2; ++k) dst[n][k] = *(const PG8_LAS bf16x8*)(lds + PG8_SB(b, h) + boff + n * 2048 + k * 1024); } while (0)
#define PG8_MMA(ai, bj, At, Bt) do { __builtin_amdgcn_s_setprio(1); _Pragma("unroll") for (int m = 0; m < 4; ++m) _Pragma("unroll") for (int n = 0; n < 2; ++n) _Pragma("unroll") for (int k = 0; k < 2; ++k) \
        acc[ai][bj][m][n] = __builtin_amdgcn_mfma_f32_16x16x32_bf16(Bt[n][k], At[m][k], acc[ai][bj][m][n], 0, 0, 0); __builtin_amdgcn_s_setprio(0); } while (0)
#define PG8_WAIT_V(n) asm volatile("s_waitcnt vmcnt(" #n ")" ::: "memory")
#define PG8_WAIT_L(n) asm volatile("s_waitcnt lgkmcnt(" #n ")" ::: "memory")
#define PG8_BAR __builtin_amdgcn_s_barrier()
#define PG8_SCHED __builtin_amdgcn_sched_barrier(0)
    Unit cur, nxt; int ui = 0;
    if (!S.next(0, cur)) return;
    f32x4 acc[2][2][4][2];
#pragma unroll
    for (int a = 0; a < 2; ++a)
#pragma unroll
        for (int b = 0; b < 2; ++b)
#pragma unroll
            for (int m = 0; m < 4; ++m)
#pragma unroll
                for (int n = 0; n < 2; ++n) acc[a][b][m][n] = (f32x4){0.f, 0.f, 0.f, 0.f};
    bf16x8 At[4][2], B0[2][2], B1[2][2];
    const char* cA = (const char*)g.A + (size_t)cur.pm * tstep; const char* cB = (const char*)g.Bt + (size_t)cur.e * estep + (size_t)cur.pn * tstep;
    S.a_ready(cur);
    if constexpr (SP2) {
        PG8_STAGE(PG8_SB(0, 0), cB, voffB); PG8_STAGE(PG8_SB(0, 1), cB + hstep, voffB); PG8_STAGE(PG8_SA(0, 0), cA, voffA); PG8_STAGE(PG8_SA(0, 1), cA + hstep, voffA);
        if (wr == 1) PG8_BAR;
        PG8_WAIT_V(2); PG8_BAR;
        PG8_STAGE(PG8_SB(1, 0), cB + kstep, voffB); PG8_STAGE(PG8_SA(1, 0), cA + kstep, voffA); PG8_STAGE(PG8_SB(1, 1), cB + hstep + kstep, voffB);
        PG8_WAIT_V(6); PG8_BAR;
    } else {
        PG8_STAGE(PG8_SB(0, 0), cB, voffB); PG8_STAGE(PG8_SA(0, 0), cA, voffA); PG8_STAGE(PG8_SB(0, 1), cB + hstep, voffB); PG8_STAGE(PG8_SA(0, 1), cA + hstep, voffA);
        if (wr == 1) PG8_BAR;
        PG8_WAIT_V(4); PG8_BAR;
        PG8_STAGE(PG8_SB(1, 0), cB + kstep, voffB); PG8_STAGE(PG8_SA(1, 0), cA + kstep, voffA); PG8_STAGE(PG8_SB(1, 1), cB + hstep + kstep, voffB);
        PG8_WAIT_V(6); PG8_BAR;
    }
    for (;;) {
        const bool has_next = S.next(ui + 1, nxt);
        const char* nA = has_next ? (const char*)g.A + (size_t)nxt.pm * tstep : cA; const char* nB = has_next ? (const char*)g.Bt + (size_t)nxt.e * estep + (size_t)nxt.pn * tstep : cB;
        for (int t = 0; t < nt; t += 2) {
            const bool last = (t == nt - 2);
            const char* a1 = cA + (size_t)(t + 1) * kstep;
            const char* a2 = last ? nA : cA + (size_t)(t + 2) * kstep; const char* b2 = last ? nB : cB + (size_t)(t + 2) * kstep;
            const char* a3 = a2 + kstep; const char* b3 = b2 + kstep;
            if (last && has_next) S.a_ready(nxt);
            if constexpr (SP2) {
            PG8_LDB(B0, 0, 0); PG8_LDB(B1, 0, 1); PG8_SCHED; PG8_LDA(At, 0, 0); PG8_STAGE(PG8_SA(1, 1), a1 + hstep, voffA);
            PG8_WAIT_V(8); PG8_WAIT_L(0); PG8_BAR; PG8_MMA(0, 0, At, B0); PG8_MMA(0, 1, At, B1); PG8_BAR; PG8_SCHED;
            PG8_LDA(At, 0, 1); PG8_STAGE(PG8_SB(0, 0), b2, voffB); PG8_STAGE(PG8_SB(0, 1), b2 + hstep, voffB); PG8_STAGE(PG8_SA(0, 0), a2, voffA);
            PG8_WAIT_V(8); PG8_WAIT_L(0); PG8_BAR; PG8_MMA(1, 0, At, B0); PG8_MMA(1, 1, At, B1); PG8_BAR; PG8_SCHED;
            PG8_LDB(B0, 1, 0); PG8_LDB(B1, 1, 1); PG8_SCHED; PG8_LDA(At, 1, 0); PG8_STAGE(PG8_SA(0, 1), a2 + hstep, voffA);
            PG8_WAIT_V(8); PG8_WAIT_L(0); PG8_BAR; PG8_MMA(0, 0, At, B0); PG8_MMA(0, 1, At, B1); PG8_BAR; PG8_SCHED;
            PG8_LDA(At, 1, 1); PG8_STAGE(PG8_SB(1, 0), b3, voffB); PG8_STAGE(PG8_SB(1, 1), b3 + hstep, voffB); PG8_STAGE(PG8_SA(1, 0), a3, voffA);
            PG8_WAIT_V(8); PG8_WAIT_L(0); PG8_BAR; PG8_MMA(1, 0, At, B0); PG8_MMA(1, 1, At, B1); PG8_BAR; PG8_SCHED;
            } else {
            PG8_LDB(B0, 0, 0); PG8_SCHED; PG8_LDA(At, 0, 0); PG8_STAGE(PG8_SA(1, 1), a1 + hstep, voffA);
            PG8_WAIT_L(8); PG8_BAR; PG8_WAIT_L(0); PG8_MMA(0, 0, At, B0); PG8_BAR; PG8_SCHED;
            PG8_LDB(B1, 0, 1); PG8_STAGE(PG8_SB(0, 0), b2, voffB);
            PG8_BAR; PG8_WAIT_L(0); PG8_MMA(0, 1, At, B1); PG8_BAR;
            PG8_LDA(At, 0, 1); PG8_STAGE(PG8_SA(0, 0), a2, voffA);
            PG8_BAR; PG8_WAIT_L(0); PG8_MMA(1, 0, At, B0); PG8_BAR; PG8_SCHED;
            PG8_STAGE(PG8_SB(0, 1), b2 + hstep, voffB);
            PG8_WAIT_V(6); PG8_BAR; PG8_MMA(1, 1, At, B1); PG8_BAR;
            PG8_LDB(B0, 1, 0); PG8_SCHED; PG8_LDA(At, 1, 0); PG8_STAGE(PG8_SA(0, 1), a2 + hstep, voffA);
            PG8_WAIT_L(8); PG8_BAR; PG8_WAIT_L(0); PG8_MMA(0, 0, At, B0); PG8_BAR; PG8_SCHED;
            PG8_LDB(B1, 1, 1); PG8_STAGE(PG8_SB(1, 0), b3, voffB);
            PG8_BAR; PG8_WAIT_L(0); PG8_MMA(0, 1, At, B1); PG8_BAR;
            PG8_LDA(At, 1, 1); PG8_STAGE(PG8_SA(1, 0), a3, voffA);
            PG8_BAR; PG8_WAIT_L(0); PG8_MMA(1, 0, At, B0); PG8_BAR; PG8_SCHED;
            PG8_STAGE(PG8_SB(1, 1), b3 + hstep, voffB);
            PG8_WAIT_V(6); PG8_BAR; PG8_MMA(1, 1, At, B1); PG8_BAR;
            }
        }
        if constexpr (ALIGN_EPI) { if (wr == 0) PG8_BAR; }
        if constexpr (!Epi::AFTER_DRAIN) { E(acc, cur, wr, wc, fr, fq); S.done(cur); }
        if (!has_next) break;
#pragma unroll
        for (int a = 0; a < 2; ++a)
#pragma unroll
            for (int b = 0; b < 2; ++b)
#pragma unroll
                for (int m = 0; m < 4; ++m)
#pragma unroll
                    for (int n = 0; n < 2; ++n) acc[a][b][m][n] = (f32x4){0.f, 0.f, 0.f, 0.f};
        cur = nxt; cA = nA; cB = nB; ++ui;
        if constexpr (ALIGN_EPI) { if (wr == 1) PG8_BAR; }
    }
    PG8_WAIT_V(0);
    if constexpr (!ALIGN_EPI) { if (wr == 0) PG8_BAR; }
    PG8_BAR;
    if constexpr (Epi::AFTER_DRAIN) { E.fused(acc, cur, wr, wc, fr, fq, lds, wid, lane); S.done(cur); }
#undef PG8_SA
#undef PG8_SB
#undef PG8_STAGE
#undef PG8_LDA
#undef PG8_LDB
#undef PG8_MMA
#undef PG8_WAIT_V
#undef PG8_WAIT_L
#undef PG8_BAR
#undef PG8_SCHED
}
}

struct EpiStoreBf16 {
    static constexpr bool PERM = true, AFTER_DRAIN = false;
    bf16_t* O; long ldo; int gate_from; long estride;
    __device__ __forceinline__ void operator()(const pg8::f32x4 (&acc)[2][2][4][2], const pg8::Unit& u, int wr, int wc, int fr, int fq) const {
        bf16_t* base = O + (long)u.e * estride;
#pragma unroll
        for (int ai = 0; ai < 2; ++ai)
#pragma unroll
            for (int m = 0; m < 4; ++m) {
                const long row = (long)u.pm * 256 + ai * 128 + wr * 64 + m * 16 + fr;
#pragma unroll
                for (int bj = 0; bj < 2; ++bj) {
                    pg8::f32x4 v0 = acc[ai][bj][m][0], v1 = acc[ai][bj][m][1];
                    if (u.pn * 2 + bj >= gate_from) {
#pragma unroll
                        for (int j = 0; j < 4; ++j) { v0[j] = sigm_fast(v0[j]); v1[j] = sigm_fast(v1[j]); }
                    }
                    u32x4 wv; wv[0] = pk_bf16(v0[0], v0[1]); wv[1] = pk_bf16(v0[2], v0[3]); wv[2] = pk_bf16(v1[0], v1[1]); wv[3] = pk_bf16(v1[2], v1[3]);
                    *(u32x4*)(base + row * ldo + u.pn * 256 + bj * 128 + wc * 32 + 8 * fq) = wv;
                }
            }
    }
};
struct EpiStoreF32 {
    static constexpr bool PERM = false, AFTER_DRAIN = false;
    float* O; long ldo;
    __device__ __forceinline__ void operator()(const pg8::f32x4 (&acc)[2][2][4][2], const pg8::Unit& u, int wr, int wc, int fr, int fq) const {
#pragma unroll
        for (int ai = 0; ai < 2; ++ai)
#pragma unroll
            for (int m = 0; m < 4; ++m) {
                const long row = (long)u.pm * 256 + ai * 128 + wr * 64 + m * 16 + fr;
#pragma unroll
                for (int bj = 0; bj < 2; ++bj)
#pragma unroll
                    for (int n = 0; n < 2; ++n) *(pg8::f32x4*)(O + row * ldo + u.pn * 256 + bj * 128 + wc * 32 + 16 * n + 4 * fq) = acc[ai][bj][m][n];
            }
    }
};
struct EpiMoeGU {
    static constexpr bool PERM = true, AFTER_DRAIN = false;
    bf16_t* HH;
    __device__ __forceinline__ void operator()(const pg8::f32x4 (&acc)[2][2][4][2], const pg8::Unit& u, int wr, int wc, int fr, int fq) const {
#pragma unroll
        for (int ai = 0; ai < 2; ++ai)
#pragma unroll
            for (int m = 0; m < 4; ++m) {
                const long row = (long)u.pm * 256 + ai * 128 + wr * 64 + m * 16 + fr;
                float hv[8];
#pragma unroll
                for (int n = 0; n < 2; ++n)
#pragma unroll
                    for (int j = 0; j < 4; ++j) { const float gt = acc[ai][0][m][n][j], up = acc[ai][1][m][n][j]; hv[4 * n + j] = gt * sigm_fast(gt) * up; }
                u32x4 wv; wv[0] = pk_bf16(hv[0], hv[1]); wv[1] = pk_bf16(hv[2], hv[3]); wv[2] = pk_bf16(hv[4], hv[5]); wv[3] = pk_bf16(hv[6], hv[7]);
                *(u32x4*)(HH + row * 512 + u.pn * 128 + wc * 32 + 8 * fq) = wv;
            }
    }
};
struct EpiMoeDown {
    static constexpr bool PERM = true, AFTER_DRAIN = false;
    const int* perm; const float* ew; bf16_t* YK;
    __device__ __forceinline__ void operator()(const pg8::f32x4 (&acc)[2][2][4][2], const pg8::Unit& u, int wr, int wc, int fr, int fq) const {
#pragma unroll
        for (int ai = 0; ai < 2; ++ai)
#pragma unroll
            for (int m = 0; m < 4; ++m) {
                const int a = perm[u.pm * 256 + ai * 128 + wr * 64 + m * 16 + fr];
                if (a >= 0) {
                    const float sw = ew[a];
#pragma unroll
                    for (int bj = 0; bj < 2; ++bj) {
                        const pg8::f32x4 v0 = acc[ai][bj][m][0] * sw, v1 = acc[ai][bj][m][1] * sw;
                        u32x4 wv; wv[0] = pk_bf16(v0[0], v0[1]); wv[1] = pk_bf16(v0[2], v0[3]); wv[2] = pk_bf16(v1[0], v1[1]); wv[3] = pk_bf16(v1[2], v1[3]);
                        *(u32x4*)(YK + (long)a * 1024 + u.pn * 256 + bj * 128 + wc * 32 + 8 * fq) = wv;
                    }
                }
            }
    }
};
struct GroupedOrder {
    int nM, nN, nE, G, c;
    __device__ bool next(int i, pg8::Unit& u) const { const int L = i * G + c; if (L >= nM * nN * nE) return false; u.e = L / (nM * nN); const int rm = L % (nM * nN); u.pm = rm / nN; u.pn = rm % nN; return true; }
    __device__ __forceinline__ void a_ready(const pg8::Unit&) const {}
    __device__ __forceinline__ void done(const pg8::Unit&) const {}
};

struct LayerW {
    const float *cmp_pos, *conv_w, *conv_b, *ga_b, *gx_b, *lam, *q_norm, *kv_norm,
        *ln1_g, *ln1_b, *ln2_g, *ln2_b, *rg_b, *re_b, *ln3_g, *ln3_b;
    const bf16_t *t_in, *t_br, *t_out, *t_q, *t_o, *t_gu, *t_dn, *t_c1, *t_c2, *t_uq, *t_ukv, *t_g, *t_rh, *t_rl;
};
#define WSF(off) ((float*)(p.ws + (off)))
#define WSI(off) ((int*)(p.ws + (off)))
#define WSU(off) ((unsigned*)(p.ws + (off)))
#define WSB(off) ((bf16_t*)(p.ws + (off)))
DI LayerW layer_w(const Params& p, int l) {
    LayerW w;
    w.cmp_pos = p.in[3] + (size_t)l * 2 * 32 * 64;
    w.conv_w = p.in[6] + (size_t)l * 4 * 256;
    w.conv_b = p.in[7] + (size_t)l * 256;
    w.ga_b = p.in[9] + (size_t)l * 256;
    w.gx_b = p.in[11] + (size_t)l * 256;
    w.lam = p.in[12] + (size_t)l * 256;
    w.q_norm = p.in[13] + (size_t)l * 192;
    w.kv_norm = p.in[14] + (size_t)l * 128;
    w.ln1_g = p.in[19] + (size_t)l * 1024; w.ln1_b = p.in[20] + (size_t)l * 1024;
    w.ln2_g = p.in[24] + (size_t)l * 1024; w.ln2_b = p.in[25] + (size_t)l * 1024;
    w.rg_b = p.in[27] + (size_t)l * 4;
    w.re_b = p.in[29] + (size_t)l * 32;
    w.ln3_g = p.in[32] + (size_t)l * 1024; w.ln3_b = p.in[33] + (size_t)l * 1024;
    w.t_in = WSB(WT_IN) + (size_t)l * NH * 1024;
    w.t_br = WSB(WT_BR) + (size_t)l * 1024 * 1024;
    w.t_out = WSB(WT_OUT) + (size_t)l * 1024 * 1024;
    w.t_q = WSB(WT_Q) + (size_t)l * 512 * 1024;
    w.t_o = WSB(WT_O) + (size_t)l * 1024 * 512;
    w.t_gu = WSB(WT_GU) + (size_t)l * 32 * 1024 * 1024;
    w.t_dn = WSB(WT_DN) + (size_t)l * 32 * 1024 * 512;
    w.t_c1 = WSB(WT_C1) + (size_t)l * 2 * 256 * 2048;
    w.t_c2 = WSB(WT_C2) + (size_t)l * 2 * 128 * 256;
    w.t_uq = WSB(WT_UQ) + (size_t)l * 384 * 192;
    w.t_ukv = WSB(WT_UKV) + (size_t)l * 512 * 128;
    w.t_g = WSB(WT_G) + (size_t)l * 4 * 128 * 64;
    w.t_rh = WSB(WT_RH) + (size_t)l * 128 * 1024;
    w.t_rl = WSB(WT_RL) + (size_t)l * 128 * 1024;
    return w;
}

template <int MODE>
DI int wt_col(int np, int Nsrc) {
    if (MODE == 0) return np < Nsrc ? np : -1;
    if (MODE == 2) return np < 1024 ? np : (np < 2656 ? np + 12 : (np < 2668 ? 1024 + (np - 2656) : (np < 2688 ? -1 : (np < 6784 ? np - 20 : -1))));
    const int pn = np >> 8, bj = (np >> 7) & 1, q = np & 127; return (bj ? 512 : 0) + 128 * pn + q;
}
template <int MODE>
DI void job_wt(const float* src, int nmat, int K, int Nsrc, bf16_t* dst, int Npad, int bid, int nblk, unsigned char* lds) {
    bf16_t* tile = (bf16_t*)lds;
    const int tk = K / 64, tn = Npad / 64, per = tk * tn;
    const int tid = tidx();
    const int kl = tid >> 4, n4 = (tid & 15) * 4;
    for (int u = bid; u < nmat * per; u += nblk) {
        const int mat = u / per, ru = u % per, k0 = (ru / tn) * 64, n0 = (ru % tn) * 64;
        const float* s = src + (size_t)mat * K * Nsrc;
        bf16_t* d = dst + (size_t)mat * Npad * K;
        const int col = wt_col<MODE>(n0 + n4, Nsrc);
        float4 v0 = make_float4(0.f, 0.f, 0.f, 0.f), v1 = v0;
        if (col >= 0) { v0 = *(const float4*)(s + (size_t)(k0 + kl) * Nsrc + col); v1 = *(const float4*)(s + (size_t)(k0 + kl + 32) * Nsrc + col); }
        __syncthreads();
        tile[(n4 + 0) * 72 + kl] = f2bf(v0.x); tile[(n4 + 1) * 72 + kl] = f2bf(v0.y); tile[(n4 + 2) * 72 + kl] = f2bf(v0.z); tile[(n4 + 3) * 72 + kl] = f2bf(v0.w);
        tile[(n4 + 0) * 72 + kl + 32] = f2bf(v1.x); tile[(n4 + 1) * 72 + kl + 32] = f2bf(v1.y); tile[(n4 + 2) * 72 + kl + 32] = f2bf(v1.z); tile[(n4 + 3) * 72 + kl + 32] = f2bf(v1.w);
        __syncthreads();
        { const int n2 = tid >> 3, kc = (tid & 7) * 8;
          *(uint4*)(d + (size_t)(n0 + n2) * K + k0 + kc) = *(const uint4*)(tile + n2 * 72 + kc); }
    }
}
DI void job_cvt(const float* src, bf16_t* dst, long n, int bid, int nblk) {
    for (long e = ((long)bid * NT + tidx()) * 4; e < n; e += (long)nblk * NT * 4) {
        const float4 v = *(const float4*)(src + e);
        st4bf(dst + e, v.x, v.y, v.z, v.w);
    }
}
DI void job_cmp_gather(const Params& p, const LayerW& w, int bid, int nblk) {
    const bf16_t* H = WSB(WS_H); bf16_t* TB = WSB(WS_TBB);
    const long total = (long)2 * NCR * 2048 / 4;
    for (long e = (long)bid * NT + tidx(); e < total; e += (long)nblk * NT) {
        const long e4 = e * 4;
        const int f = (int)(e4 % 2048); const long r2 = e4 / 2048; const int r = (int)(r2 % NCR), j = (int)(r2 / NCR);
        const int g = r & 1, bc = r >> 1, c = bc % NCMP, b = bc / NCMP, i = f >> 6, d = f & 63;
        const float4 hv = ld4bf(H + (long)(b * SEQ + 16 * c + i) * NH + (j ? O_AVC : O_AKC) + g * 64 + d);
        const float4 pv = *(const float4*)(w.cmp_pos + (j * 32 + i) * 64 + d);
        st4bf(TB + ((long)j * 2048 + r) * 2048 + f, hv.x + pv.x, hv.y + pv.y, hv.z + pv.z, hv.w + pv.w);
    }
}
DI void job_rnn_conv(const Params& p, const LayerW& w, int bid, int nblk) {
    const bf16_t* H = WSB(WS_H); float* U = WSF(WS_U); bf16_t* UB = WSB(WS_UB);
    for (long e = (long)bid * NT + tidx(); e < (long)T * 64; e += (long)nblk * NT) {
        const int ch = (int)(e & 63) * 4; const int t = (int)(e >> 6), s = t & (SEQ - 1);
        const float4 cb = *(const float4*)(w.conv_b + ch);
        float u0 = cb.x, u1 = cb.y, u2 = cb.z, u3 = cb.w;
#pragma unroll
        for (int tap = 0; tap < 4; ++tap) { const int sp = s - 3 + tap;
            if (sp >= 0) { const float4 hv = ld4bf(H + (long)(t - 3 + tap) * NH + O_CX + ch); const float4 cw = *(const float4*)(w.conv_w + tap * 256 + ch);
                u0 += hv.x * cw.x; u1 += hv.y * cw.y; u2 += hv.z * cw.z; u3 += hv.w * cw.w; } }
        *(float4*)(U + (long)t * 256 + ch) = make_float4(u0, u1, u2, u3); st4bf(UB + (long)t * 256 + ch, u0, u1, u2, u3);
    }
}
DI void job_rnn_gates(const Params& p, const LayerW& w, int bid, int nblk, unsigned char* lds) {
    const float* U = WSF(WS_U); float* RA = WSF(WS_RA); float* RB = WSF(WS_RB);
    for (int u = bid; u < (T / G_BM) * 4; u += nblk) {
        const int blk = u & 3, m0 = (u >> 2) * G_BM;
        MG g; g.A = WSB(WS_UB) + blk * 64; g.lda = 256; g.Wt = w.t_g + (size_t)blk * 128 * 64; g.ldw = 64; g.K = 64;
        f32x16 acc[2][2];
        mgemm_tile(g, 0, RowId{m0}, acc, lds);
        const int l = tidx() & 63, wv = tidx() >> 6, wm = wv % G_WM, wn = wv / G_WM;
#pragma unroll
        for (int tt = 0; tt < 2; ++tt)
#pragma unroll
            for (int i = 0; i < 4; ++i) {
                const long t = m0 + wm * 64 + tt * 32 + (l & 31); const int ch = blk * 64 + wn * 32 + 8 * i + 4 * (l >> 5);
                const float4 uv = *(const float4*)(U + t * 256 + ch);
                const float ua[4] = {uv.x, uv.y, uv.z, uv.w};
                float av[4], bv[4];
#pragma unroll
                for (int j = 0; j < 4; ++j) {
                    const float r = sigm(acc[0][tt][4 * i + j] + w.ga_b[ch + j]), ig = sigm(acc[1][tt][4 * i + j] + w.gx_b[ch + j]);
                    const float nl = -w.lam[ch + j];
                    const float sp = fmaxf(nl, 0.f) + log1pf(expf(-fabsf(nl)));
                    const float log_a = -8.0f * r * sp;
                    av[j] = expf(log_a); bv[j] = sqrtf(-expm1f(2.0f * log_a)) * (ig * ua[j]);
                }
                *(float4*)(RA + t * 256 + ch) = make_float4(av[0], av[1], av[2], av[3]);
                *(float4*)(RB + t * 256 + ch) = make_float4(bv[0], bv[1], bv[2], bv[3]);
            }
    }
}
DI void job_rnn_scan1(const Params& p, int bid, int nblk) {
    const float* RA = WSF(WS_RA); const float* RB = WSF(WS_RB); float* SA = WSF(WS_SA); float* SH = WSF(WS_SH);
    for (int e = bid * NT + tidx(); e < BATCH * 32 * 256; e += nblk * NT) {
        const int ch = e & 255, bc = e >> 8;
        float ap = 1.f, hl = 0.f;
        for (int s0 = 0; s0 < 64; s0 += 8) {
            float av[8], bv[8];
#pragma unroll
            for (int i = 0; i < 8; ++i) { const long t = (long)bc * 64 + s0 + i; av[i] = RA[t * 256 + ch]; bv[i] = RB[t * 256 + ch]; }
#pragma unroll
            for (int i = 0; i < 8; ++i) { ap *= av[i]; hl = av[i] * hl + bv[i]; }
        }
        SA[e] = ap; SH[e] = hl;
    }
}
DI void job_rnn_scan2(const Params& p, int bid, int nblk) {
    const bf16_t* H = WSB(WS_H); const float* RA = WSF(WS_RA); const float* RB = WSF(WS_RB); const float* SA = WSF(WS_SA); const float* SH = WSF(WS_SH); bf16_t* BR = WSB(WS_BR);
    for (int e = bid * NT + tidx(); e < BATCH * 32 * 256; e += nblk * NT) {
        const int ch = e & 255, bc = e >> 8, chunk = bc & 31, b = bc >> 5;
        float h = 0.f;
        for (int c = 0; c < chunk; ++c) { const int q = ((b * 32 + c) << 8) + ch; h = SA[q] * h + SH[q]; }
        for (int s0 = 0; s0 < 64; s0 += 8) {
            float av[8], bv[8], gv[8];
#pragma unroll
            for (int i = 0; i < 8; ++i) { const long t = (long)bc * 64 + s0 + i; av[i] = RA[t * 256 + ch]; bv[i] = RB[t * 256 + ch]; gv[i] = bf2f(H[t * NH + O_CG + ch]); }
#pragma unroll
            for (int i = 0; i < 8; ++i) { const long t = (long)bc * 64 + s0 + i; h = av[i] * h + bv[i]; BR[t * 1024 + 2 * 256 + ch] = f2bf(h * gelu_tanh(gv[i])); }
        }
    }
}
DI void job_mla_norm(const Params& p, const LayerW& w, int bid, int nblk) {
    const bf16_t* H = WSB(WS_H); bf16_t* CQN = WSB(WS_CQNB); bf16_t* CKVN = WSB(WS_CKVNB); bf16_t* KM = WSB(WS_KM);
    const int lane = tidx() & 63, wid = tidx() >> 6;
    for (int t = bid * (NT / 64) + wid; t < T; t += nblk * (NT / 64)) {
        const bf16_t* hr = H + (long)t * NH;
        float q0 = bf2f(hr[O_DCQ + lane]), q1 = bf2f(hr[O_DCQ + 64 + lane]), q2 = bf2f(hr[O_DCQ + 128 + lane]);
        float ss = wave_sum(q0 * q0 + q1 * q1 + q2 * q2);
        float rs = rsqrtf(ss * (1.f / 192.f) + 1e-6f);
        CQN[(long)t * 192 + lane] = f2bf(q0 * rs * w.q_norm[lane]);
        CQN[(long)t * 192 + 64 + lane] = f2bf(q1 * rs * w.q_norm[64 + lane]);
        CQN[(long)t * 192 + 128 + lane] = f2bf(q2 * rs * w.q_norm[128 + lane]);
        float k0 = bf2f(hr[O_DCKV + lane]), k1 = bf2f(hr[O_DCKV + 64 + lane]);
        ss = wave_sum(k0 * k0 + k1 * k1);
        rs = rsqrtf(ss * (1.f / 128.f) + 1e-6f);
        CKVN[(long)t * 128 + lane] = f2bf(k0 * rs * w.kv_norm[lane]);
        CKVN[(long)t * 128 + 64 + lane] = f2bf(k1 * rs * w.kv_norm[64 + lane]);
        {
            const int i = lane & 15, hd = lane >> 4;
            const int s = t & (SEQ - 1);
            const float2 csn = *(const float2*)(WSF(WS_ROPE) + (s * 16 + i) * 2); const float cs = csn.x, sn = csn.y;
            const float x1 = bf2f(hr[O_DKR + i]), x2 = bf2f(hr[O_DKR + 16 + i]);
            KM[(long)t * 384 + hd * 96 + 64 + i] = f2bf(x1 * cs - x2 * sn);
            KM[(long)t * 384 + hd * 96 + 80 + i] = f2bf(x1 * sn + x2 * cs);
        }
    }
}
DI void job_mla_up(const Params& p, const LayerW& w, int bid, int nblk, unsigned char* lds) {
    bf16_t* QB = WSB(WS_QB); bf16_t* KM = WSB(WS_KM); bf16_t* VM = WSB(WS_VM);
    constexpr int TM = T / G_BM;
    for (int u = bid; u < TM * 7; u += nblk) {
        const int mt = u / 7, nt = u % 7, m0 = mt * G_BM;
        f32x16 acc[2][2];
        const int l = tidx() & 63, wv = tidx() >> 6, wm = wv % G_WM, wn = wv / G_WM, hh = l >> 5;
        if (nt < 3) {
            MG g; g.A = WSB(WS_CQNB); g.lda = 192; g.Wt = w.t_uq; g.ldw = 192; g.K = 192;
            const int n0 = nt * 128;
            mgemm_tile(g, n0, RowId{m0}, acc, lds);
#pragma unroll
            for (int ft = 0; ft < 2; ++ft) {
                const int fb = (n0 + wn * 64 + ft * 32) >> 5;
                if (fb % 3 == 2) {
#pragma unroll
                    for (int tt = 0; tt < 2; ++tt) {
                        const int pos = (m0 + wm * 64 + tt * 32 + (l & 31)) & (SEQ - 1);
#pragma unroll
                        for (int i = 0; i < 2; ++i)
#pragma unroll
                            for (int j = 0; j < 4; ++j) {
                                const int fi = 8 * i + 4 * hh + j;
                                const float2 csn = *(const float2*)(WSF(WS_ROPE) + (pos * 16 + fi) * 2); const float cs = csn.x, sn = csn.y;
                                const float x1 = acc[ft][tt][4 * i + j], x2 = acc[ft][tt][4 * (i + 2) + j];
                                acc[ft][tt][4 * i + j] = x1 * cs - x2 * sn; acc[ft][tt][4 * (i + 2) + j] = x1 * sn + x2 * cs;
                            }
                    }
                }
            }
            MG_FOREACH(acc, lrow, feat, v, { st4bf(QB + (long)(m0 + lrow) * 384 + n0 + feat, v[0], v[1], v[2], v[3]); });
        } else {
            MG g; g.A = WSB(WS_CKVNB); g.lda = 128; g.Wt = w.t_ukv; g.ldw = 128; g.K = 128;
            const int n0 = (nt - 3) * 128;
            mgemm_tile(g, n0, RowId{m0}, acc, lds);
            MG_FOREACH(acc, lrow, feat, v, {
                const int hd = nt - 3;
                if (feat < 64) st4bf(KM + (long)(m0 + lrow) * 384 + hd * 96 + feat, v[0], v[1], v[2], v[3]);
                else st4bf(VM + (long)(m0 + lrow) * 256 + hd * 64 + (feat - 64), v[0], v[1], v[2], v[3]); });
        }
    }
}
template <int STAGE>
DI void job_cmp_mlp(const Params& p, const LayerW& w, int bid, int nblk, unsigned char* lds) {
    constexpr int TM = 2048 / G_BM, TN = STAGE == 0 ? 2 : 1;
    for (int u = bid; u < 2 * TM * TN; u += nblk) {
        const int j = u / (TM * TN), ru = u % (TM * TN), mt = ru / TN, nt = ru % TN, m0 = mt * G_BM, n0 = nt * 128;
        MG g;
        if (STAGE == 0) { g.A = WSB(WS_TBB) + (size_t)j * 2048 * 2048; g.lda = 2048; g.Wt = w.t_c1 + (size_t)j * 256 * 2048; g.ldw = 2048; g.K = 2048; }
        else { g.A = WSB(WS_HIDB) + (size_t)j * 2048 * 256; g.lda = 256; g.Wt = w.t_c2 + (size_t)j * 128 * 256; g.ldw = 256; g.K = 256; }
        f32x16 acc[2][2];
        mgemm_tile(g, n0, [&](int r) { const int rr = m0 + r; return (long)(rr < NCR ? rr : NCR - 1); }, acc, lds);
        if (STAGE == 0) {
            bf16_t* HID = WSB(WS_HIDB) + (size_t)j * 2048 * 256;
            MG_FOREACH(acc, lrow, feat, v, { st4bf(HID + (long)(m0 + lrow) * 256 + n0 + feat, gelu_tanh(v[0]), gelu_tanh(v[1]), gelu_tanh(v[2]), gelu_tanh(v[3])); });
        } else {
            bf16_t* KC = WSB(WS_KCB) + (size_t)j * NCR * 64;
            MG_FOREACH(acc, lrow, feat, v, { if (feat < 64 && m0 + lrow < NCR) st4bf(KC + (long)(m0 + lrow) * 64 + feat, v[0], v[1], v[2], v[3]); });
        }
    }
}
DI void job_router_logits(const Params& p, const LayerW& w, int bid, int nblk, unsigned char* lds) {
    float* LOG = WSF(WS_LOG);
    for (int u = bid; u < 3 * (T / G_BM); u += nblk) {
        const int pass = u / (T / G_BM), m0 = (u % (T / G_BM)) * G_BM;
        f32x16 acc[2][2];
        MG g; g.lda = 1024; g.ldw = 1024; g.K = 1024;
        g.A = pass == 1 ? WSB(WS_XBL) : WSB(WS_XBB); g.Wt = pass == 2 ? w.t_rl : w.t_rh;
        mgemm_tile(g, 0, RowId{m0}, acc, lds, true);
        float* dst = LOG + (size_t)pass * T * 36;
        MG_FOREACH(acc, lrow, feat, v, { if (feat < 36) *(float4*)(dst + (long)(m0 + lrow) * 36 + feat) = make_float4(v[0], v[1], v[2], v[3]); });
    }
}
DI void job_pack_small(const Params& p, int bid, int nblk) {
    bf16_t* TG = WSB(WT_G); bf16_t* RH = WSB(WT_RH); bf16_t* RL = WSB(WT_RL);
    for (int e = bid * NT + tidx(); e < SEQ * 16; e += nblk * NT) {
        const int i = e & 15, pos = e >> 4;
        const float inv = powf(10000.f, -(float)(2 * i) / 32.f);
        const float ang = (float)pos * inv;
        WSF(WS_ROPE)[e * 2] = cosf(ang); WSF(WS_ROPE)[e * 2 + 1] = sinf(ang);
    }
    for (int e = bid * NT + tidx(); e < DEPTH * 4 * 128 * 64; e += nblk * NT) {
        const int c = e & 63, q = (e >> 6) & 127, lb = e >> 13;
        const int seg = q >> 5, i = q & 31, chl = (seg >> 1) * 32 + i;
        const float* src = (seg & 1) ? p.in[10] : p.in[8];
        TG[e] = f2bf(src[((size_t)lb * 64 + c) * 64 + chl]);
    }
    for (int e = bid * NT + tidx(); e < DEPTH * 128 * 1024; e += nblk * NT) {
        const int k = e & 1023, n = (e >> 10) & 127, l = e >> 17;
        float v = 0.f;
        if (n < 4) v = p.in[26][((size_t)l * 1024 + k) * 4 + n];
        else if (n < 36) v = p.in[28][((size_t)l * 1024 + k) * 32 + (n - 4)];
        const bf16_t hi = f2bf(v);
        RH[e] = hi; RL[e] = f2bf(v - bf2f(hi));
    }
}

DI void job_merge(const Params& p, const LayerW& w, int bid, int nblk, unsigned char* lds) {
    const bf16_t* H = WSB(WS_H); bf16_t* M = WSB(WS_M);
    for (int u = bid; u < (T / G_BM) * 8; u += nblk) {
        const int m0 = (u >> 3) * G_BM, n0 = (u & 7) * G_BN;
        f32x16 macc[2][2];
#pragma unroll
        for (int a = 0; a < 2; ++a)
#pragma unroll
            for (int b = 0; b < 2; ++b)
#pragma unroll
                for (int i = 0; i < 16; ++i) macc[a][b][i] = 0.f;
        MG g; g.A = WSB(WS_BR); g.lda = 1024; g.Wt = w.t_br; g.ldw = 1024; g.K = 1024;
        f32x16 acc[2][2];
        const int l = tidx() & 63, wv = tidx() >> 6, wm = wv % G_WM, wn = wv / G_WM;
        mgemm_tile_f(g, n0, RowId{m0}, acc, lds, true, 4, [&](int n, f32x16 (&a)[2][2]) {
#pragma unroll
            for (int ft = 0; ft < 2; ++ft)
#pragma unroll
                for (int tt = 0; tt < 2; ++tt)
#pragma unroll
                    for (int i = 0; i < 4; ++i) {
                        const int lrow = wm * 64 + tt * 32 + (l & 31), feat = wn * 64 + ft * 32 + 8 * i + 4 * (l >> 5);
                        const float4 gv = ld4bf(H + (long)(m0 + lrow) * NH + O_MG + n * 1024 + n0 + feat);
                        macc[ft][tt][4 * i] += gv.x * a[ft][tt][4 * i]; macc[ft][tt][4 * i + 1] += gv.y * a[ft][tt][4 * i + 1];
                        macc[ft][tt][4 * i + 2] += gv.z * a[ft][tt][4 * i + 2]; macc[ft][tt][4 * i + 3] += gv.w * a[ft][tt][4 * i + 3];
                        a[ft][tt][4 * i] = 0.f; a[ft][tt][4 * i + 1] = 0.f; a[ft][tt][4 * i + 2] = 0.f; a[ft][tt][4 * i + 3] = 0.f;
                    }
        });
        MG_FOREACH(macc, lrow, feat, v, { st4bf(M + (long)(m0 + lrow) * 1024 + n0 + feat, v[0], v[1], v[2], v[3]); });
    }
}
DI void job_ln(const float* xin, const bf16_t* xinb, const bf16_t* xinl, const bf16_t* y, int ldy, const bf16_t* y2, const float* gw, const float* bw, float* out, bf16_t* outb, bf16_t* outl, int bid, int nblk) {
    const int lane = tidx() & 63, wid = tidx() >> 6;
    for (int t = bid * (NT / 64) + wid; t < T; t += nblk * (NT / 64)) {
        float v[16];
        float s = 0.f;
#pragma unroll
        for (int i = 0; i < 4; ++i) {
            const int c = i * 256 + lane * 4;
            float4 xv = xin ? *(const float4*)(xin + (long)t * 1024 + c) : ld4bf(xinb + (long)t * 1024 + c);
            if (xinl) { const float4 z = ld4bf(xinl + (long)t * 1024 + c); xv.x += z.x; xv.y += z.y; xv.z += z.z; xv.w += z.w; }
            float4 yv = ld4bf(y + (long)t * ldy + c);
            if (y2) { const float4 z = ld4bf(y2 + (long)t * ldy + c); yv.x += z.x; yv.y += z.y; yv.z += z.z; yv.w += z.w; }
            v[i * 4 + 0] = DN_ALPHA * xv.x + yv.x; v[i * 4 + 1] = DN_ALPHA * xv.y + yv.y; v[i * 4 + 2] = DN_ALPHA * xv.z + yv.z; v[i * 4 + 3] = DN_ALPHA * xv.w + yv.w;
            s += (v[i * 4] + v[i * 4 + 1]) + (v[i * 4 + 2] + v[i * 4 + 3]);
        }
        const float mu = wave_sum(s) * (1.f / 1024.f);
        float q = 0.f;
#pragma unroll
        for (int i = 0; i < 16; ++i) { const float dlt = v[i] - mu; q += dlt * dlt; }
        const float rstd = rsqrtf(wave_sum(q) * (1.f / 1024.f) + 1e-5f);
#pragma unroll
        for (int i = 0; i < 4; ++i) {
            const int c = i * 256 + lane * 4;
            const float4 gv = *(const float4*)(gw + c), bv = *(const float4*)(bw + c);
            const float o0 = (v[i * 4] - mu) * rstd * gv.x + bv.x, o1 = (v[i * 4 + 1] - mu) * rstd * gv.y + bv.y,
                        o2 = (v[i * 4 + 2] - mu) * rstd * gv.z + bv.z, o3 = (v[i * 4 + 3] - mu) * rstd * gv.w + bv.w;
            if (out) *(float4*)(out + (long)t * 1024 + c) = make_float4(o0, o1, o2, o3);
            if (outb) st4bf(outb + (long)t * 1024 + c, o0, o1, o2, o3);
            if (outl) st4bf(outl + (long)t * 1024 + c, o0 - bf2f(f2bf(o0)), o1 - bf2f(f2bf(o1)), o2 - bf2f(f2bf(o2)), o3 - bf2f(f2bf(o3)));
        }
    }
}
DI void job_router(const Params& p, const LayerW& w, int layer, int bid, int nblk) {
    const float* LOG = WSF(WS_LOG); int* EIDX = WSI(WS_EIDX); int* ESLOT = WSI(WS_ESLOT); float* EW = WSF(WS_EW);
    unsigned* cnt = WSU(WS_CTL) + CW_CNT + layer * 32;
    for (int t = bid * NT + tidx(); t < T; t += nblk * NT) {
        const float* lr = LOG + (long)t * 36; const float* lr1 = lr + (size_t)T * 36; const float* lr2 = lr1 + (size_t)T * 36;
#define LG(i) ((lr[i] + lr1[i]) + lr2[i])
        const float g0 = LG(0) + w.rg_b[0], g1 = LG(1) + w.rg_b[1], g2 = LG(2) + w.rg_b[2], g3 = LG(3) + w.rg_b[3];
        const float gm = fmaxf(fmaxf(g0, g1), fmaxf(g2, g3));
        const float e0 = expf(g0 - gm), e1 = expf(g1 - gm), e2 = expf(g2 - gm), e3 = expf(g3 - gm);
        const float gs = (e0 + e1) + (e2 + e3);
        const float p0 = e0 / gs, p1 = e1 / gs, p2 = e2 / gs, p3 = e3 / gs;
        int grp = 0; float pg = p0;
        if (p1 > pg) { pg = p1; grp = 1; }
        if (p2 > pg) { pg = p2; grp = 2; }
        if (p3 > pg) { pg = p3; grp = 3; }
        float el[8];
#pragma unroll
        for (int i = 0; i < 8; ++i) el[i] = LG(4 + grp * 8 + i) + w.re_b[grp * 8 + i];
#undef LG
        float em = el[0];
#pragma unroll
        for (int i = 1; i < 8; ++i) em = fmaxf(em, el[i]);
        float es = 0.f;
#pragma unroll
        for (int i = 0; i < 8; ++i) { el[i] = expf(el[i] - em); es += el[i]; }
#pragma unroll
        for (int i = 0; i < 8; ++i) el[i] = el[i] / es;
        float b0 = el[0]; int i0 = 0;
#pragma unroll
        for (int i = 1; i < 8; ++i) if (el[i] > b0) { b0 = el[i]; i0 = i; }
        float b1 = -1.f; int i1 = 0;
#pragma unroll
        for (int i = 0; i < 8; ++i) if (i != i0 && el[i] > b1) { b1 = el[i]; i1 = i; }
        const float den = b0 + b1;
        const int ex0 = grp * 8 + i0, ex1 = grp * 8 + i1;
        EIDX[t * 2] = ex0; EIDX[t * 2 + 1] = ex1;
        EW[t * 2] = pg * b0 / den; EW[t * 2 + 1] = pg * b1 / den;
        ESLOT[t * 2] = (int)atomicAdd(&cnt[ex0], 1u);
        ESLOT[t * 2 + 1] = (int)atomicAdd(&cnt[ex1], 1u);
    }
}
DI int pad_rows(int c) { return (c + G_BM - 1) / G_BM * G_BM; }
DI void job_fill(const Params& p, int layer, int bid, int nblk, unsigned char* lds) {
    const int* EIDX = WSI(WS_EIDX); const int* ESLOT = WSI(WS_ESLOT); int* PERM = WSI(WS_PERM);
    const bf16_t* X2 = WSB(WS_XBB); bf16_t* XG = WSB(WS_XG);
    unsigned* cnt = WSU(WS_CTL) + CW_CNT + layer * 32;
    const int lane = tidx() & 63, wid = tidx() >> 6;
    int* s_off = (int*)lds; int* s_cnt = s_off + 32;
    __syncthreads();
    if (tidx() < 32) s_cnt[tidx()] = (int)__hip_atomic_load(&cnt[tidx()], __ATOMIC_RELAXED, __HIP_MEMORY_SCOPE_AGENT);
    __syncthreads();
    if (tidx() == 0) { int o = 0; for (int e = 0; e < 32; ++e) { s_off[e] = o; o += pad_rows(s_cnt[e]); } }
    __syncthreads();
    for (int a = bid * (NT / 64) + wid; a < NASSIGN + NEXP; a += nblk * (NT / 64)) {
        const bool real = a < NASSIGN;
        const int e = real ? EIDX[a] : a - NASSIGN;
        const int off = s_off[e];
        if (real) {
            const int R = off + ESLOT[a];
            if (lane == 0) PERM[R] = a;
            const u32x4* src = (const u32x4*)(X2 + (long)(a >> 1) * 1024); u32x4* dst = (u32x4*)(XG + (long)R * 1024);
            dst[lane] = src[lane]; dst[lane + 64] = src[lane + 64];
        } else {
            const int c = s_cnt[e];
            for (int j = lane; c + j < pad_rows(c); j += 64) PERM[off + c + j] = -1;
        }
    }
}
DI pg8::ListOrder moe_units(unsigned* cnt, int bid, int nblk) {
    pg8::ListOrder S; S.n = 0; S.u0 = S.u1 = S.u2 = pg8::Unit{0, 0, 0};
    int rt = 0, ub = 0;
    for (int e = 0; e < 32; ++e) {
        const int c = pad_rows((int)__hip_atomic_load(&cnt[e], __ATOMIC_RELAXED, __HIP_MEMORY_SCOPE_AGENT)) >> 8, ue = c * 4;
#pragma unroll
        for (int k = 0; k < 3; ++k) {
            const int L = bid + k * nblk;
            if (L >= ub && L < ub + ue) { const int lu = L - ub; const pg8::Unit u{rt + (lu >> 2), lu & 3, e};
                if (k == 0) S.u0 = u; else if (k == 1) S.u1 = u; else S.u2 = u;
                S.n = k + 1; }
        }
        rt += c; ub += ue;
    }
#define RFL(x) x = __builtin_amdgcn_readfirstlane(x)
    RFL(S.n); RFL(S.u0.pm); RFL(S.u0.pn); RFL(S.u0.e); RFL(S.u1.pm); RFL(S.u1.pn); RFL(S.u1.e); RFL(S.u2.pm); RFL(S.u2.pn); RFL(S.u2.e);
#undef RFL
    return S;
}
typedef short s16x4 __attribute__((ext_vector_type(4)));
typedef short v4i16_t __attribute__((ext_vector_type(4)));
DI unsigned cvtpk(float lo, float hi) { return pk_bf16(lo, hi); }
DI int crow(int reg, int h) { return (reg & 3) + 8 * (reg >> 2) + 4 * h; }
DI s16x4 tr_read(const unsigned char* p) { return __builtin_bit_cast(s16x4, __builtin_amdgcn_ds_read_tr16_b64_v4i16((LAS v4i16_t*)p)); }
DI float xhalf_max(float m) { auto rr = __builtin_amdgcn_permlane32_swap(__float_as_uint(m), __float_as_uint(m), false, false); return fmaxf(__uint_as_float(rr[0]), __uint_as_float(rr[1])); }
DI float xhalf_sum(float m) { auto rr = __builtin_amdgcn_permlane32_swap(__float_as_uint(m), __float_as_uint(m), false, false); return __uint_as_float(rr[0]) + __uint_as_float(rr[1]); }
DI float xhalf_other(float v, int h) { auto rr = __builtin_amdgcn_permlane32_swap(__float_as_uint(v), __float_as_uint(v), false, false); return __uint_as_float(h ? rr[0] : rr[1]); }
DI bf16x8 pack8(const f32x16& x, int s2) {
    u32x4 pk; pk[0] = cvtpk(x[8 * s2], x[8 * s2 + 1]); pk[1] = cvtpk(x[8 * s2 + 2], x[8 * s2 + 3]); pk[2] = cvtpk(x[8 * s2 + 4], x[8 * s2 + 5]); pk[3] = cvtpk(x[8 * s2 + 6], x[8 * s2 + 7]);
    return __builtin_bit_cast(bf16x8, pk);
}
constexpr int ATT_QB = (NT / 64) * 32;
template <int DC> struct TileCfg { static constexpr int RS = DC * 2 + 16, BYTES = 64 * RS, NCH = 64 * DC / 8, NI = (NCH + NT - 1) / NT; };
template <int DC, class RowPtr> DI void tile_gload(u32x4 (&rg)[TileCfg<DC>::NI], RowPtr rp) {
#pragma unroll
    for (int i = 0; i < TileCfg<DC>::NI; ++i) { const int c = tidx() + NT * i; if (c < TileCfg<DC>::NCH) { const int row = c / (DC / 8), cc = c % (DC / 8); rg[i] = *(const u32x4*)(rp(row) + cc * 8); } }
}
template <int DC> DI void tile_lstore(const u32x4 (&rg)[TileCfg<DC>::NI], unsigned char* base) {
#pragma unroll
    for (int i = 0; i < TileCfg<DC>::NI; ++i) { const int c = tidx() + NT * i; if (c < TileCfg<DC>::NCH) { const int row = c / (DC / 8), cc = c % (DC / 8); *(u32x4*)(base + row * TileCfg<DC>::RS + cc * 16) = rg[i]; } }
}
template <int DK> DI void qk_tile(f32x16 (&s)[2], const bf16x8 (&qf)[DK / 16], const unsigned char* kl, int r, int h) {
    constexpr int RS = TileCfg<DK>::RS;
#pragma unroll
    for (int i = 0; i < 16; ++i) { s[0][i] = 0.f; s[1][i] = 0.f; }
#pragma unroll
    for (int ks = 0; ks < DK / 16; ++ks) {
        const bf16x8 k0 = *(const bf16x8*)(kl + r * RS + ks * 32 + h * 16), k1 = *(const bf16x8*)(kl + (32 + r) * RS + ks * 32 + h * 16);
        s[0] = __builtin_amdgcn_mfma_f32_32x32x16_bf16(k0, qf[ks], s[0], 0, 0, 0);
        s[1] = __builtin_amdgcn_mfma_f32_32x32x16_bf16(k1, qf[ks], s[1], 0, 0, 0);
    }
}
template <int DV> DI void pv_tile(f32x16 (&o)[DV / 32], const f32x16 (&pp)[2], const unsigned char* vl, int lane) {
    constexpr int RS = TileCfg<DV>::RS;
    const int h = lane >> 5, i16 = lane & 15, q = i16 >> 2, pq = i16 & 3, blk = (lane >> 4) & 1;
    const unsigned char* vb = vl + (4 * h + q) * RS + 2 * (16 * blk + 4 * pq);
#pragma unroll
    for (int kt = 0; kt < 2; ++kt)
#pragma unroll
        for (int s2 = 0; s2 < 2; ++s2) {
            const bf16x8 pf = pack8(pp[kt], s2);
#pragma unroll
            for (int dvt = 0; dvt < DV / 32; ++dvt) {
                const s16x4 lo = tr_read(vb + (kt * 32 + 16 * s2) * RS + dvt * 64), hi = tr_read(vb + (kt * 32 + 16 * s2 + 8) * RS + dvt * 64);
                const bf16x8 vf = __builtin_shufflevector(lo, hi, 0, 1, 2, 3, 4, 5, 6, 7);
                o[dvt] = __builtin_amdgcn_mfma_f32_32x32x16_bf16(vf, pf, o[dvt], 0, 0, 0);
            }
        }
}
constexpr float LOG2E = 1.4426950408889634f;
template <int DK, int DV, bool ALIBI, bool BOUNDARY, class ValidFn>
DI void softmax_tile(const bf16x8 (&qf)[DK / 16], f32x16 (&o)[DV / 32], float& m, float& l, const unsigned char* kl, const unsigned char* vl, int kb,
                     float c1, float sl2, int qpos, ValidFn valid, int lane) {
    const int r = lane & 31, h = lane >> 5;
    f32x16 s[2];
    qk_tile<DK>(s, qf, kl, r, h);
    const float base = ALIBI ? sl2 * (float)(kb + 4 * h - qpos) : 0.f;
    float tmax = -INFINITY;
#pragma unroll
    for (int kt = 0; kt < 2; ++kt)
#pragma unroll
        for (int i = 0; i < 16; ++i) {
            float v = ALIBI ? fmaf(s[kt][i], c1, fmaf(sl2, (float)(kt * 32 + (i & 3) + 8 * (i >> 2)), base)) : s[kt][i] * c1;
            if (BOUNDARY) v = valid(kb + kt * 32 + crow(i, h)) ? v : -INFINITY;
            s[kt][i] = v; tmax = fmaxf(tmax, v);
        }
    tmax = xhalf_max(tmax);
    const float mn = fmaxf(m, tmax);
    if (__any(mn > m)) {
        const float corr = __builtin_amdgcn_exp2f(m - mn);
        l *= corr;
#pragma unroll
        for (int dvt = 0; dvt < DV / 32; ++dvt)
#pragma unroll
            for (int i = 0; i < 16; ++i) o[dvt][i] *= corr;
        m = mn;
    }
    float ps = 0.f;
#pragma unroll
    for (int kt = 0; kt < 2; ++kt)
#pragma unroll
        for (int i = 0; i < 16; ++i) { const float pr = __builtin_amdgcn_exp2f(s[kt][i] - mn); s[kt][i] = pr; ps += pr; }
    l += ps;
    pv_tile<DV>(o, s, vl, lane);
}
template <int DK, int DV, bool ALIBI, class KPtr, class VPtr, class ValidFn, class InteriorFn>
DI void attn_stream(const bf16x8 (&qf)[DK / 16], f32x16 (&o)[DV / 32], float& m, float& l, unsigned tmask, int wave_qmax, int wave_kmin,
                    KPtr kp, VPtr vp, float c1, float sl2, int qpos, ValidFn valid, InteriorFn interior, unsigned char* lds) {
    unsigned char* kl = lds; unsigned char* vl = lds + TileCfg<DK>::BYTES;
    const int lane = tidx() & 63;
    u32x4 kA[TileCfg<DK>::NI], vA[TileCfg<DV>::NI], kB[TileCfg<DK>::NI], vB[TileCfg<DV>::NI];
    int ja = -1, jb = -1;
#define AS_NEXT(J, KR, VR) do { if (tmask) { J = __builtin_ctz(tmask); tmask &= tmask - 1; const int _j = J; \
        tile_gload<DK>(KR, [&](int row) { return kp(_j * 64 + row); }); tile_gload<DV>(VR, [&](int row) { return vp(_j * 64 + row); }); } else J = -1; } while (0)
#define AS_COMPUTE(J) do { const int _jc = (J); if (_jc * 64 <= wave_qmax && _jc * 64 + 63 >= wave_kmin) { \
        if (interior(_jc)) softmax_tile<DK, DV, ALIBI, false>(qf, o, m, l, kl, vl, _jc * 64, c1, sl2, qpos, valid, lane); \
        else softmax_tile<DK, DV, ALIBI, true>(qf, o, m, l, kl, vl, _jc * 64, c1, sl2, qpos, valid, lane); } } while (0)
    AS_NEXT(ja, kA, vA);
    AS_NEXT(jb, kB, vB);
    while (ja >= 0) {
        __syncthreads();
        tile_lstore<DK>(kA, kl); tile_lstore<DV>(vA, vl);
        __syncthreads();
        const int jc = ja;
        AS_NEXT(ja, kA, vA);
        AS_COMPUTE(jc);
        if (jb < 0) break;
        __syncthreads();
        tile_lstore<DK>(kB, kl); tile_lstore<DV>(vB, vl);
        __syncthreads();
        const int jd = jb;
        AS_NEXT(jb, kB, vB);
        AS_COMPUTE(jd);
    }
#undef AS_NEXT
#undef AS_COMPUTE
}

DI void job_mla_attn(const Params& p, int bid, int nblk, unsigned char* lds) {
    const bf16_t* QB = WSB(WS_QB); const bf16_t* KM = WSB(WS_KM); const bf16_t* VM = WSB(WS_VM); bf16_t* BR = WSB(WS_BR);
    constexpr int NQB = SEQ / ATT_QB, NU = BATCH * 4 * NQB;
    const int lane = tidx() & 63, wid = tidx() >> 6, r = lane & 31, h = lane >> 5;
    for (int u = bid; u < NU; u += nblk) {
        const int qblk = u / (BATCH * 4), bh = u % (BATCH * 4);
        const int b = bh >> 2, hd = bh & 3;
        const int q0 = qblk * ATT_QB, qw = q0 + wid * 32, qpos = qw + r;
        const long trow = (long)b * SEQ;
        bf16x8 qf[6];
#pragma unroll
        for (int ks = 0; ks < 6; ++ks) qf[ks] = *(const bf16x8*)(QB + (trow + qpos) * 384 + hd * 96 + ks * 16 + 8 * h);
        f32x16 o[2];
#pragma unroll
        for (int i = 0; i < 16; ++i) { o[0][i] = 0.f; o[1][i] = 0.f; }
        float m = -1e30f, l = 0.f;
        const int ntile = (q0 + ATT_QB - 1) / 64 + 1;
        const unsigned tmask = ntile >= 32 ? 0xffffffffu : ((1u << ntile) - 1u);
        attn_stream<96, 64, false>(qf, o, m, l, tmask, qw + 31, 0,
            [&](int row) { return KM + (trow + row) * 384 + hd * 96; },
            [&](int row) { return VM + (trow + row) * 256 + hd * 64; },
            0.10206207261596577f * LOG2E, 0.f, qpos,
            [&](int key) { return key <= qpos; }, [&](int j) { return j * 64 + 63 <= qw; }, lds);
        const float rl = 1.f / fmaxf(xhalf_sum(l), 1e-30f);
        bf16_t* dst = BR + (trow + qpos) * 1024 + 3 * 256 + hd * 64;
#pragma unroll
        for (int dvt = 0; dvt < 2; ++dvt)
#pragma unroll
            for (int i = 0; i < 4; ++i)
                st4bf(dst + dvt * 32 + 8 * i + 4 * h, o[dvt][4 * i] * rl, o[dvt][4 * i + 1] * rl, o[dvt][4 * i + 2] * rl, o[dvt][4 * i + 3] * rl);
    }
}
DI void job_cross_attn(const Params& p, int layer, int bid, int nblk, unsigned char* lds) {
    const bf16_t* XQ = WSB(WS_XQ); const bf16_t* KVM = WSB(WS_KVM) + (size_t)layer * 2048 * 1024; bf16_t* XO = WSB(WS_XO);
    constexpr int NQB = SEQ / ATT_QB, NU = BATCH * 4 * NQB;
    const int lane = tidx() & 63, wid = tidx() >> 6, r = lane & 31, h = lane >> 5;
    for (int u = bid; u < NU; u += nblk) {
        const int bh = u % (BATCH * 4), qblk = u / (BATCH * 4);
        const int b = bh >> 2, hd = bh & 3;
        const int qpos = qblk * ATT_QB + wid * 32 + r;
        const long trow = (long)b * SEQ;
        bf16x8 qf[8];
#pragma unroll
        for (int ks = 0; ks < 8; ++ks) qf[ks] = *(const bf16x8*)(XQ + (trow + qpos) * 512 + hd * 128 + ks * 16 + 8 * h);
        f32x16 o[4];
#pragma unroll
        for (int d = 0; d < 4; ++d)
#pragma unroll
            for (int i = 0; i < 16; ++i) o[d][i] = 0.f;
        float m = -1e30f, l = 0.f;
        attn_stream<128, 128, false>(qf, o, m, l, 0xFu, 1 << 30, 0,
            [&](int row) { return KVM + (long)(b * MEM_LEN + row) * 1024 + hd * 128; },
            [&](int row) { return KVM + (long)(b * MEM_LEN + row) * 1024 + 512 + hd * 128; },
            0.08838834764831845f * LOG2E, 0.f, qpos, [&](int) { return true; }, [&](int) { return true; }, lds);
        const float rl = 1.f / fmaxf(xhalf_sum(l), 1e-30f);
        bf16_t* dst = XO + (trow + qpos) * 512 + hd * 128;
#pragma unroll
        for (int dvt = 0; dvt < 4; ++dvt)
#pragma unroll
            for (int i = 0; i < 4; ++i)
                st4bf(dst + dvt * 32 + 8 * i + 4 * h, o[dvt][4 * i] * rl, o[dvt][4 * i + 1] * rl, o[dvt][4 * i + 2] * rl, o[dvt][4 * i + 3] * rl);
    }
}
DI float logsig_fast(float z) { return fminf(z, 0.f) - __logf(1.f + __expf(-fabsf(z))); }
DI void job_sb_attn(const Params& p, int bid, int nblk, unsigned char* lds) {
    const bf16_t* H = WSB(WS_H); bf16_t* BR = WSB(WS_BR);
    constexpr int NQB = SEQ / ATT_QB, NU = BATCH * 4 * NQB;
    const int lane = tidx() & 63, wid = tidx() >> 6, r = lane & 31, h = lane >> 5;
    unsigned char* kl = lds; unsigned char* vl = lds + TileCfg<64>::BYTES;
    for (int u = bid; u < NU; u += nblk) {
        const int half = u / (NU / 2), ru = u % (NU / 2);
        const int qi = ru / (BATCH * 4), bh = ru % (BATCH * 4);
        const int qblk = half == 0 ? (NQB - 1 - qi) : qi;
        const int b = bh >> 2, hd = bh & 3;
        const int q0 = qblk * ATT_QB, qw = q0 + wid * 32, qpos = qw + r;
        const long trow = (long)b * SEQ;
        bf16x8 qf[4];
#pragma unroll
        for (int ks = 0; ks < 4; ++ks) qf[ks] = *(const bf16x8*)(H + (trow + qpos) * NH + O_BQ + hd * 64 + ks * 16 + 8 * h);
        f32x16 o[2];
#pragma unroll
        for (int i = 0; i < 16; ++i) { o[0][i] = 0.f; o[1][i] = 0.f; }
        float trun = 0.f;
        int j = (q0 + ATT_QB - 1) >> 6;
        volatile int* flag = (volatile int*)(lds + 2 * TileCfg<64>::BYTES);
        if (tidx() == 0) { flag[0] = 0; flag[1] = 0; }
        u32x4 kr[TileCfg<64>::NI], vr[TileCfg<64>::NI];
        tile_gload<64>(kr, [&](int row) { return H + (trow + j * 64 + row) * NH + O_BK + hd * 64; });
        tile_gload<64>(vr, [&](int row) { return H + (trow + j * 64 + row) * NH + O_BV + hd * 64; });
        for (int it = 0; j >= 0; --j, ++it) {
            __syncthreads();
            if (it > 0 && flag[(it - 1) & 1] == 0) break;
            tile_lstore<64>(kr, kl); tile_lstore<64>(vr, vl);
            __syncthreads();
            if (tidx() == 0) flag[(it + 1) & 1] = 0;
            if (j > 0) { const int jn = j - 1;
                tile_gload<64>(kr, [&](int row) { return H + (trow + jn * 64 + row) * NH + O_BK + hd * 64; });
                tile_gload<64>(vr, [&](int row) { return H + (trow + jn * 64 + row) * NH + O_BV + hd * 64; }); }
            const bool wave_dead = __all(trun < -110.f);
            if (j * 64 < qw + 31 && !wave_dead) {
                const int kb = j * 64;
                f32x16 s[2], L[2];
                qk_tile<64>(s, qf, kl, r, h);
#pragma unroll
                for (int kt = 0; kt < 2; ++kt)
#pragma unroll
                    for (int i = 0; i < 16; ++i) {
                        const int key = kb + kt * 32 + crow(i, h);
                        const float z = s[kt][i] * 0.125f, lsp = logsig_fast(z);
                        const bool valid = key < qpos;
                        L[kt][i] = valid ? lsp - z : 0.f;
                        s[kt][i] = valid ? lsp : -INFINITY;
                    }
                float G[2][4], O[2][4];
#pragma unroll
                for (int kt = 0; kt < 2; ++kt)
#pragma unroll
                    for (int ig = 0; ig < 4; ++ig) { G[kt][ig] = (L[kt][4 * ig] + L[kt][4 * ig + 1]) + (L[kt][4 * ig + 2] + L[kt][4 * ig + 3]); O[kt][ig] = xhalf_other(G[kt][ig], h); }
                float run = trun;
#pragma unroll
                for (int kt = 1; kt >= 0; --kt)
#pragma unroll
                    for (int ig = 3; ig >= 0; --ig) {
                        const float t3 = run + (h == 0 ? O[kt][ig] : 0.f);
                        const float t2 = t3 + L[kt][4 * ig + 3], t1 = t2 + L[kt][4 * ig + 2], t0 = t1 + L[kt][4 * ig + 1];
                        s[kt][4 * ig + 3] = __expf(s[kt][4 * ig + 3] + t3); s[kt][4 * ig + 2] = __expf(s[kt][4 * ig + 2] + t2);
                        s[kt][4 * ig + 1] = __expf(s[kt][4 * ig + 1] + t1); s[kt][4 * ig + 0] = __expf(s[kt][4 * ig + 0] + t0);
                        run += G[kt][ig] + O[kt][ig];
                    }
                trun = run;
                pv_tile<64>(o, s, vl, lane);
            }
            if (!__all(trun < -110.f)) flag[it & 1] = 1;
        }
        bf16_t* dst = BR + (trow + qpos) * 1024 + 1 * 256 + hd * 64;
#pragma unroll
        for (int dvt = 0; dvt < 2; ++dvt)
#pragma unroll
            for (int i = 0; i < 4; ++i) st4bf(dst + dvt * 32 + 8 * i + 4 * h, o[dvt][4 * i], o[dvt][4 * i + 1], o[dvt][4 * i + 2], o[dvt][4 * i + 3]);
    }
}
constexpr int NSA_QB = (NT / 128) * 32;
DI void job_nsa(const Params& p, int bid, int nblk, unsigned char* lds) {
    const bf16_t* H = WSB(WS_H); const bf16_t* KCB = WSB(WS_KCB); const bf16_t* VCB = KCB + (size_t)NCR * 64;
    float* OACC = WSF(WS_OC); bf16_t* BR = WSB(WS_BR);
    constexpr int NQB = SEQ / NSA_QB, NU = BATCH * 2 * NQB;
    constexpr int TB_ = TileCfg<64>::BYTES;
    const int lane = tidx() & 63, wid = tidx() >> 6, r = lane & 31, h = lane >> 5;
    const int n = wid & 1, sub = wid >> 1;
    unsigned* orw = (unsigned*)(lds + 4 * TB_);
    float* impx = (float*)(lds + 4 * TB_ + 64);
    for (int u = bid; u < NU; u += nblk) {
        const int qblk = NQB - 1 - u / (BATCH * 2), bg = u % (BATCH * 2), b = bg >> 1, g = bg & 1;
        const int q0 = qblk * NSA_QB, qw = q0 + sub * 32, qpos = qw + r;
        const int head = g * 2 + n;
        const long trow = (long)b * SEQ;
        const bf16_t* hq_row = H + (trow + qpos) * NH;
        bf16x8 qf[1][4];
#pragma unroll
        for (int ks = 0; ks < 4; ++ks) qf[0][ks] = *(const bf16x8*)(hq_row + O_AQ + head * 64 + ks * 16 + 8 * h);
        const float sl = exp2f(-2.f * (float)(head + 1));
        const float gate0 = sigm(bf2f(hq_row[O_AG + head * 3 + 0])), gate1 = sigm(bf2f(hq_row[O_AG + head * 3 + 1])), gate2 = sigm(bf2f(hq_row[O_AG + head * 3 + 2]));
        float* oacc = OACC + (trow + qpos) * 256 + head * 64;
        __syncthreads();
        if (tidx() == 0) *orw = 0u;
        {
            u32x4 rg[TileCfg<64>::NI];
#pragma unroll
            for (int tl = 0; tl < 4; ++tl) {
                const bf16_t* src = (tl & 2) ? VCB : KCB; const int cb = (tl & 1) * 64;
                tile_gload<64>(rg, [&](int row) { const int c = cb + row < NCMP ? cb + row : NCMP - 1; return src + ((long)(b * NCMP + c) * 2 + g) * 64; });
                tile_lstore<64>(rg, lds + tl * TB_);
            }
        }
        __syncthreads();
        float imp[16];
        {
            f32x16 s[2][2];
            qk_tile<64>(s[0], qf[0], lds, r, h);
            qk_tile<64>(s[1], qf[0], lds + TB_, r, h);
            float tmax = -INFINITY;
#pragma unroll
            for (int tl = 0; tl < 2; ++tl)
#pragma unroll
                for (int kt = 0; kt < 2; ++kt)
#pragma unroll
                    for (int i = 0; i < 16; ++i) {
                        const int c = tl * 64 + kt * 32 + crow(i, h), dist = qpos - (16 * c + 31);
                        const float v = (c < NCMP && dist >= 0) ? s[tl][kt][i] * 0.125f - sl * (float)dist : -INFINITY;
                        s[tl][kt][i] = v; tmax = fmaxf(tmax, v);
                    }
            const float mn = fmaxf(xhalf_max(tmax), -1e30f);
            float ps = 0.f;
#pragma unroll
            for (int tl = 0; tl < 2; ++tl)
#pragma unroll
                for (int kt = 0; kt < 2; ++kt)
#pragma unroll
                    for (int i = 0; i < 16; ++i) { const float pr = __expf(s[tl][kt][i] - mn); s[tl][kt][i] = pr; ps += pr; }
            const float rl = 1.f / fmaxf(xhalf_sum(ps), 1e-30f);
            float P3[16];
#pragma unroll
            for (int tl = 0; tl < 2; ++tl)
#pragma unroll
                for (int kt = 0; kt < 2; ++kt) {
#pragma unroll
                    for (int ig = 0; ig < 4; ++ig) {
                        const float p0 = s[tl][kt][4 * ig] * rl, p1 = s[tl][kt][4 * ig + 1] * rl, p2 = s[tl][kt][4 * ig + 2] * rl, p3 = s[tl][kt][4 * ig + 3] * rl;
                        imp[tl * 8 + kt * 4 + ig] = (p0 + p1) + (p2 + 0.5f * p3);
                        P3[tl * 8 + kt * 4 + ig] = 0.5f * p3;
                    }
                    const float gs = rl * gate0;
#pragma unroll
                    for (int i = 0; i < 16; ++i) s[tl][kt][i] *= gs;
                }
#pragma unroll
            for (int idx = 0; idx < 16; ++idx) {
                const float pp = xhalf_other(P3[idx], h);
                float prevp;
                if (idx == 0) prevp = h ? pp : 0.f; else { const float ppm = xhalf_other(P3[idx - 1], h); prevp = h ? pp : ppm; }
                imp[idx] += prevp;
                impx[(wid * 16 + idx) * 64 + lane] = imp[idx];
            }
            f32x16 oc[2];
#pragma unroll
            for (int i = 0; i < 16; ++i) { oc[0][i] = 0.f; oc[1][i] = 0.f; }
            pv_tile<64>(oc, s[0], lds + 2 * TB_, lane);
            pv_tile<64>(oc, s[1], lds + 3 * TB_, lane);
#pragma unroll
            for (int dvt = 0; dvt < 2; ++dvt)
#pragma unroll
                for (int i = 0; i < 4; ++i) *(float4*)(oacc + dvt * 32 + 8 * i + 4 * h) = make_float4(oc[dvt][4 * i], oc[dvt][4 * i + 1], oc[dvt][4 * i + 2], oc[dvt][4 * i + 3]);
        }
        __syncthreads();
        unsigned sel = 0u;
        {
            const int cur = qpos >> 6;
#pragma unroll
            for (int idx = 0; idx < 16; ++idx) {
                const float other = impx[((wid ^ 1) * 16 + idx) * 64 + lane];
                const float tot = n == 0 ? imp[idx] + other : other + imp[idx];
                const int j = 2 * idx + h;
                const bool forced = (j == 0) || (j == cur), valid = (j * 64 <= qpos);
                imp[idx] = forced ? 1e4f : (valid ? tot : -1.0f);
            }
#pragma unroll 1
            for (int it = 0; it < 8; ++it) {
                float best = -INFINITY; int bj = 64;
#pragma unroll
                for (int idx = 0; idx < 16; ++idx) if (imp[idx] > best) { best = imp[idx]; bj = 2 * idx + h; }
                const float pb = xhalf_other(best, h); const int pj = __float_as_int(xhalf_other(__int_as_float(bj), h));
                const bool own = (best > pb) || (best == pb && bj < pj);
                const int wj = own ? bj : pj;
                sel |= 1u << wj;
#pragma unroll
                for (int idx = 0; idx < 16; ++idx) if (2 * idx + h == wj) imp[idx] = -INFINITY;
            }
        }
        atomicOr(orw, sel);
        __syncthreads();
        const unsigned bmask = *orw;
        const int jhi = (q0 + NSA_QB - 1) >> 6;
        const unsigned upto = jhi >= 31 ? 0xffffffffu : ((1u << (jhi + 1)) - 1u);
        const float c1 = 0.125f * LOG2E, sl2 = sl * LOG2E;
        {
            f32x16 o[2];
#pragma unroll
            for (int i = 0; i < 16; ++i) { o[0][i] = 0.f; o[1][i] = 0.f; }
            float m = -1e30f, l = 0.f;
            const int jlo = (q0 - 511 > 0 ? q0 - 511 : 0) >> 6;
            const unsigned tmask = upto & ~((1u << jlo) - 1u);
            attn_stream<64, 64, true>(qf[0], o, m, l, tmask, qw + 31, qw - 511,
                [&](int row) { return H + (trow + row) * NH + O_AKW + g * 64; },
                [&](int row) { return H + (trow + row) * NH + O_AVW + g * 64; },
                c1, sl2, qpos,
                [&](int key) { const int dist = qpos - key; return dist >= 0 && dist < 512; },
                [&](int j) { return j * 64 + 63 <= qw && qw + 31 - j * 64 < 512; }, lds);
            const float rl = gate2 / fmaxf(xhalf_sum(l), 1e-30f);
#pragma unroll
            for (int dvt = 0; dvt < 2; ++dvt)
#pragma unroll
                for (int i = 0; i < 4; ++i) { float4* a = (float4*)(oacc + dvt * 32 + 8 * i + 4 * h); float4 c = *a;
                    c.x += o[dvt][4 * i] * rl; c.y += o[dvt][4 * i + 1] * rl; c.z += o[dvt][4 * i + 2] * rl; c.w += o[dvt][4 * i + 3] * rl; *a = c; }
        }
        {
            f32x16 o[2];
#pragma unroll
            for (int i = 0; i < 16; ++i) { o[0][i] = 0.f; o[1][i] = 0.f; }
            float m = -1e30f, l = 0.f;
            attn_stream<64, 64, true>(qf[0], o, m, l, bmask & upto, qw + 31, 0,
                [&](int row) { return H + (trow + row) * NH + O_AKS + g * 64; },
                [&](int row) { return H + (trow + row) * NH + O_AVS + g * 64; },
                c1, sl2, qpos,
                [&](int key) { return key <= qpos && ((sel >> (key >> 6)) & 1u); },
                [&](int j) { return j * 64 + 63 <= qw && __all((sel >> j) & 1u); }, lds);
            const float rl = gate1 / fmaxf(xhalf_sum(l), 1e-30f);
            bf16_t* dst = BR + (trow + qpos) * 1024 + head * 64;
#pragma unroll
            for (int dvt = 0; dvt < 2; ++dvt)
#pragma unroll
                for (int i = 0; i < 4; ++i) { const float4 c = *(const float4*)(oacc + dvt * 32 + 8 * i + 4 * h);
                    st4bf(dst + dvt * 32 + 8 * i + 4 * h, c.x + o[dvt][4 * i] * rl, c.y + o[dvt][4 * i + 1] * rl, c.z + o[dvt][4 * i + 2] * rl, c.w + o[dvt][4 * i + 3] * rl); }
        }
    }
}

namespace pg8 { typedef PG8_LAS unsigned char* PG8_LAS_T; }
#define LDS3 ((pg8::PG8_LAS_T)lds)
#define GEMM256(EPI, SCHED, g, S, E) do { __syncthreads(); pg8::gemm_phase<EPI, SCHED, false, true>(LDS3, g, S, E); } while (0)
constexpr int NPH = 18;
constexpr int NPHASES = 2 + DEPTH * NPH;

__global__ void __launch_bounds__(NT, 2) mega(Params pk, int ph_lo, int ph_hi) {
    extern __shared__ __attribute__((aligned(16))) unsigned char lds[];
    const int bid = blockIdx.x, nblk = gridDim.x;
#define XB_HERE XcdBarrier bar_; bar_.bar = (unsigned*)(pk.ws + WS_CTL) + CW_BAR; bar_.x = xb_xcc_id(); bar_.st = (volatile LAS unsigned*)(lds + 131072)
    const bool multi = (ph_hi - ph_lo) > 1;
    if (multi) {
        uint4* xbw = (uint4*)(lds + 131072);
        if (tidx() == 0) *xbw = make_uint4(0u, 0u, 0u, 0u);
        __syncthreads();
        (void)xcd_barrier_post((unsigned*)(pk.ws + WS_CTL) + CW_BAR, (volatile LAS unsigned*)xbw);
    }
#ifndef PROBE_PH
#define PROBE_PH -100
#endif
#define PHASE(id, ...) do { const int _id = (id); if (ph_lo <= _id && _id < ph_hi) { for (int _rep = 0; _rep < ((PROBE_PH == -1 ? _id < 2 : (_id >= 2 && (_id - 2) % NPH == PROBE_PH)) ? 2 : 1); ++_rep) { if (_rep) { XB_HERE; xcd_barrier(bar_); } { Params p = pk; int layer = layer_; asm volatile("" : "+s"(p.ws), "+s"(p.out), "+s"(layer)); \
        const LayerW w = layer_w(p, layer); const float* Xin = (layer == 0) ? p.in[0] : WSF(WS_XC); const bf16_t* XinB = (layer == 0) ? WSB(WS_X0B) : WSB(WS_XCB); float* Xout = (layer == DEPTH - 1) ? p.out : WSF(WS_XC); \
        (void)w; (void)Xin; (void)XinB; (void)Xout; __VA_ARGS__; } } if (_id + 1 < ph_hi) { XB_HERE; xcd_barrier(bar_); } } } while (0)

    { const int layer_ = 0;
    PHASE(0, {
        job_wt<2>(p.in[2], DEPTH, 1024, NIN, WSB(WT_IN), NH, bid, nblk, lds);
        job_wt<0>(p.in[17], DEPTH, 1024, 1024, WSB(WT_BR), 1024, bid, nblk, lds);
        job_wt<0>(p.in[18], DEPTH, 1024, 1024, WSB(WT_OUT), 1024, bid, nblk, lds);
        job_wt<0>(p.in[21], DEPTH, 1024, 512, WSB(WT_Q), 512, bid, nblk, lds);
        job_wt<0>(p.in[22], DEPTH, 1024, 1024, WSB(WT_KV), 1024, bid, nblk, lds);
        job_wt<0>(p.in[23], DEPTH, 512, 1024, WSB(WT_O), 1024, bid, nblk, lds);
        job_wt<1>(p.in[30], DEPTH * 32, 1024, 1024, WSB(WT_GU), 1024, bid, nblk, lds);
        job_wt<0>(p.in[31], DEPTH * 32, 512, 1024, WSB(WT_DN), 1024, bid, nblk, lds);
        job_wt<0>(p.in[4], DEPTH * 2, 2048, 256, WSB(WT_C1), 256, bid, nblk, lds);
        job_wt<0>(p.in[5], DEPTH * 2, 256, 64, WSB(WT_C2), 128, bid, nblk, lds);
        job_wt<0>(p.in[15], DEPTH, 192, 384, WSB(WT_UQ), 384, bid, nblk, lds);
        job_wt<0>(p.in[16], DEPTH, 128, 512, WSB(WT_UKV), 512, bid, nblk, lds);
        job_pack_small(p, bid, nblk);
        job_cvt(p.in[0], WSB(WS_X0B), (long)T * 1024, bid, nblk);
        job_cvt(p.in[1], WSB(WS_MEMB), (long)2048 * 1024, bid, nblk);
    });
    PHASE(1, {
        pg8::Gemm g{WSB(WS_MEMB), WSB(WT_KV), BATCH * MEM_LEN, 1024, 1024};
        GroupedOrder S{8, 4, DEPTH, nblk, bid};
        EpiStoreBf16 E{WSB(WS_KVM), 1024, 1 << 30, (long)2048 * 1024};
        GEMM256(EpiStoreBf16, GroupedOrder, g, S, E);
    });
    }
    for (int layer_ = 0; layer_ < DEPTH; ++layer_) {
        const int base = 2 + layer_ * NPH;
        PHASE(base + 0, { pg8::Gemm g{XinB, w.t_in, T, NH, 1024}; pg8::StaticOrder S; S.init(T, NH, nblk, bid); EpiStoreBf16 E{WSB(WS_H), NH, O_MG / 128, 0}; GEMM256(EpiStoreBf16, pg8::StaticOrder, g, S, E); });
        PHASE(base + 1, { job_sb_attn(p, bid, nblk, lds); job_cmp_gather(p, w, bid, nblk); job_rnn_conv(p, w, bid, nblk); job_mla_norm(p, w, bid, nblk); });
        PHASE(base + 2, { if (bid < 16) job_cmp_mlp<0>(p, w, bid, 16, lds); else { job_rnn_gates(p, w, bid - 16, nblk - 16, lds); job_mla_up(p, w, bid - 16, nblk - 16, lds); } });
        PHASE(base + 3, { job_cmp_mlp<1>(p, w, bid, nblk, lds); job_rnn_scan1(p, bid, nblk); });
        PHASE(base + 4, { job_nsa(p, bid, nblk, lds); job_mla_attn(p, bid, nblk, lds); job_rnn_scan2(p, bid, nblk); });
        PHASE(base + 5, { job_merge(p, w, bid, nblk, lds); });
        PHASE(base + 6, { pg8::Gemm g{WSB(WS_M), w.t_out, T, 1024, 1024}; pg8::StaticOrder S; S.init(T, 1024, nblk, bid); EpiStoreBf16 E{WSB(WS_Y), 1024, 1 << 30, 0}; GEMM256(EpiStoreBf16, pg8::StaticOrder, g, S, E); });
        PHASE(base + 7, { job_ln(layer == 0 ? p.in[0] : nullptr, WSB(WS_XCB), nullptr, WSB(WS_Y), 1024, nullptr, w.ln1_g, w.ln1_b, nullptr, WSB(WS_XAB), nullptr, bid, nblk); });
        PHASE(base + 8, { pg8::Gemm g{WSB(WS_XAB), w.t_q, T, 512, 1024}; pg8::StaticOrder S; S.init(T, 512, nblk, bid); EpiStoreBf16 E{WSB(WS_XQ), 512, 1 << 30, 0}; GEMM256(EpiStoreBf16, pg8::StaticOrder, g, S, E); });
        PHASE(base + 9, { job_cross_attn(p, layer, bid, nblk, lds); });
        PHASE(base + 10, { pg8::Gemm g{WSB(WS_XO), w.t_o, T, 1024, 512}; pg8::StaticOrder S; S.init(T, 1024, nblk, bid); EpiStoreBf16 E{WSB(WS_Y), 1024, 1 << 30, 0}; GEMM256(EpiStoreBf16, pg8::StaticOrder, g, S, E); });
        PHASE(base + 11, { job_ln(nullptr, WSB(WS_XAB), nullptr, WSB(WS_Y), 1024, nullptr, w.ln2_g, w.ln2_b, nullptr, WSB(WS_XBB), WSB(WS_XBL), bid, nblk); });
        PHASE(base + 12, { job_router_logits(p, w, bid, nblk, lds); });
        PHASE(base + 13, { job_router(p, w, layer, bid, nblk); });
        PHASE(base + 14, { job_fill(p, layer, bid, nblk, lds); });
        PHASE(base + 15, { const pg8::ListOrder S = moe_units(WSU(WS_CTL) + CW_CNT + layer * 32, bid, nblk); pg8::Gemm g{WSB(WS_XG), w.t_gu, PADROWS, 1024, 1024}; EpiMoeGU E{WSB(WS_HH)}; GEMM256(EpiMoeGU, pg8::ListOrder, g, S, E); });
        PHASE(base + 16, { const pg8::ListOrder S = moe_units(WSU(WS_CTL) + CW_CNT + layer * 32, bid, nblk); pg8::Gemm g{WSB(WS_HH), w.t_dn, PADROWS, 1024, 512}; EpiMoeDown E{WSI(WS_PERM), WSF(WS_EW), WSB(WS_YK)}; GEMM256(EpiMoeDown, pg8::ListOrder, g, S, E); });
        PHASE(base + 17, { job_ln(nullptr, WSB(WS_XBB), WSB(WS_XBL), WSB(WS_YK), 2048, WSB(WS_YK) + 1024, w.ln3_g, w.ln3_b, (layer == DEPTH - 1) ? p.out : nullptr, (layer == DEPTH - 1) ? nullptr : WSB(WS_XCB), nullptr, bid, nblk); });
    }
}

extern "C" void kernel_launch(void* const* d_in, const int* in_sizes, int n_in, void* d_out, int out_size, void* d_ws, size_t ws_size, hipStream_t stream) {
    constexpr size_t kDynLds = 131072 + 1024;
    static_assert(2 * G_STAGE + 1024 <= 131072, "engine stages fit");
    static int grid = 0;
    if (!grid) {
        int dev = 0, cus = 0, per_cu = 0;
        (void)hipGetDevice(&dev);
        (void)hipDeviceGetAttribute(&cus, hipDeviceAttributeMultiprocessorCount, dev);
        (void)hipFuncSetAttribute((const void*)mega, hipFuncAttributeMaxDynamicSharedMemorySize, (int)kDynLds);
        (void)hipOccupancyMaxActiveBlocksPerMultiprocessor(&per_cu, mega, NT, kDynLds);
        if (per_cu < 1) per_cu = 1;
        grid = cus * (per_cu < 2 ? per_cu : 2);
    }
    if (ws_size < WS_END) { fprintf(stderr, "workspace too small: %zu < %zu\n", ws_size, (size_t)WS_END); return; }
    Params p{};
    for (int i = 0; i < 34; ++i) p.in[i] = (const float*)d_in[i];
    p.out = (float*)d_out;
    p.ws = (unsigned char*)d_ws;
    (void)hipMemsetAsync(d_ws, 0, CTL_BYTES, stream);
#if MK_ONE_LAUNCH
    hipLaunchKernelGGL(mega, dim3(grid), dim3(NT), kDynLds, stream, p, 0, NPHASES);
#else
    for (int ph = 0; ph < NPHASES; ++ph) hipLaunchKernelGGL(mega, dim3(grid), dim3(NT), kDynLds, stream, p, ph, ph + 1);
#endif
}
```

```cpp
#include <hip/hip_runtime.h>
#include <stdint.h>
#include <stdio.h>

#ifndef MK_ONE_LAUNCH
#define MK_ONE_LAUNCH 1
#endif

#define DI __device__ __forceinline__
#define LAS __attribute__((address_space(3)))
DI int tidx() { int t = threadIdx.x; asm volatile("" : "+v"(t)); return t; }

constexpr int NT = 512;
constexpr int D = 1024, BATCH = 8, SEQ = 2048, T = BATCH * SEQ, DEPTH = 4;
constexpr int MEM_LEN = 256;
constexpr int NIN = 6764, NH = 6912;
constexpr int O_AQ = 0, O_AKC = 256, O_AVC = 384, O_AKS = 512, O_AVS = 640, O_AKW = 768, O_AVW = 896,
              O_BQ = 1024, O_BK = 1280, O_BV = 1536, O_CX = 1792, O_CG = 2048, O_DCQ = 2304, O_DCKV = 2496, O_DKR = 2624,
              O_AG = 2656, O_MG = 2688;
constexpr int NCMP = 127, NCR = BATCH * NCMP * 2;
constexpr int NEXP = 32, NASSIGN = T * 2;
constexpr float DN_ALPHA = 1.681792830507429f;

typedef unsigned short bf16_t;
typedef short bf16x8 __attribute__((ext_vector_type(8)));
typedef float f32x16 __attribute__((ext_vector_type(16)));
typedef unsigned u32x4 __attribute__((ext_vector_type(4)));

constexpr int G_WM = NT / 128;
constexpr int G_BM = 64 * G_WM;
constexpr int G_BN = 128;
constexpr int G_RS = 144;
constexpr int G_STAGE = (G_BM + G_BN) * G_RS;
constexpr int PADROWS = ((NASSIGN + NEXP * (G_BM - 1) + G_BM - 1) / G_BM) * G_BM;

constexpr size_t MiB = 1u << 20;
constexpr size_t al(size_t x) { return (x + 255) & ~(size_t)255; }
constexpr size_t WS_CTL = 0, CTL_BYTES = 1 * MiB;
constexpr size_t WT_IN = WS_CTL + CTL_BYTES;
constexpr size_t WT_BR = WT_IN + al((size_t)DEPTH * NH * 1024 * 2);
constexpr size_t WT_OUT = WT_BR + al((size_t)DEPTH * 4 * 1024 * 256 * 2);
constexpr size_t WT_Q = WT_OUT + al((size_t)DEPTH * 1024 * 1024 * 2);
constexpr size_t WT_KV = WT_Q + al((size_t)DEPTH * 512 * 1024 * 2);
constexpr size_t WT_O = WT_KV + al((size_t)DEPTH * 1024 * 1024 * 2);
constexpr size_t WT_GU = WT_O + al((size_t)DEPTH * 1024 * 512 * 2);
constexpr size_t WT_DN = WT_GU + al((size_t)DEPTH * 32 * 1024 * 1024 * 2);
constexpr size_t WS_X0B = WT_DN + al((size_t)DEPTH * 32 * 1024 * 512 * 2);
constexpr size_t WS_MEMB = WS_X0B + al((size_t)T * 1024 * 2);
constexpr size_t WS_H = WS_MEMB + al((size_t)2048 * 1024 * 2);
constexpr size_t SZ_H = al((size_t)T * NH * 2);
constexpr size_t WS_YK = WS_H;
constexpr size_t WS_HH = WS_YK + (size_t)NASSIGN * 1024 * 2;
static_assert(WS_HH + (size_t)PADROWS * 512 * 2 <= WS_H + SZ_H, "moe overlay fits in H");
constexpr size_t WS_TB = WS_H + SZ_H;
constexpr size_t WS_HID = WS_TB + al((size_t)2 * NCR * 2048 * 4);
constexpr size_t WS_KCVC = WS_HID + al((size_t)2 * NCR * 256 * 4);
constexpr size_t WS_PC = WS_KCVC + al((size_t)2 * NCR * 64 * 4);
constexpr size_t WS_SEL = WS_PC + al((size_t)BATCH * 4 * SEQ * 128 * 4);
constexpr size_t WS_OW = WS_SEL + al((size_t)BATCH * 2 * SEQ * 4);
constexpr size_t WS_OC = WS_OW + al((size_t)T * 256 * 4);
constexpr size_t WS_BR = WS_OC + al((size_t)T * 256 * 4);
constexpr size_t WS_U = WS_BR + al((size_t)T * 1024 * 2);
constexpr size_t WS_RA = WS_U + al((size_t)T * 256 * 4);
constexpr size_t WS_RB = WS_RA + al((size_t)T * 256 * 4);
constexpr size_t WS_CQN = WS_RB + al((size_t)T * 256 * 4);
constexpr size_t WS_CKVN = WS_CQN + al((size_t)T * 192 * 4);
constexpr size_t WS_KR = WS_CKVN + al((size_t)T * 128 * 4);
constexpr size_t WS_Q = WS_KR + al((size_t)T * 32 * 4);
constexpr size_t WS_KV = WS_Q + al((size_t)T * 384 * 4);
constexpr size_t WS_M = WS_KV + al((size_t)T * 512 * 4);
constexpr size_t WS_Y = WS_M + al((size_t)T * 1024 * 2);
constexpr size_t WS_XA = WS_Y + al((size_t)T * 1024 * 4);
constexpr size_t WS_XB = WS_XA + al((size_t)T * 1024 * 4);
constexpr size_t WS_XC = WS_XB + al((size_t)T * 1024 * 4);
constexpr size_t WS_XAB = WS_XC + al((size_t)T * 1024 * 4);
constexpr size_t WS_XBB = WS_XAB + al((size_t)T * 1024 * 2);
constexpr size_t WS_XCB = WS_XBB + al((size_t)T * 1024 * 2);
constexpr size_t WS_XQ = WS_XCB + al((size_t)T * 1024 * 2);
constexpr size_t WS_XO = WS_XQ + al((size_t)T * 512 * 2);
constexpr size_t WS_KVM = WS_XO + al((size_t)T * 512 * 2);
constexpr size_t WS_LOG = WS_KVM + al((size_t)DEPTH * 2048 * 1024 * 2);
constexpr size_t WS_EIDX = WS_LOG + al((size_t)3 * T * 36 * 4);
constexpr size_t WS_ESLOT = WS_EIDX + al((size_t)NASSIGN * 4);
constexpr size_t WS_EW = WS_ESLOT + al((size_t)NASSIGN * 4);
constexpr size_t WS_PERM = WS_EW + al((size_t)NASSIGN * 4);
constexpr size_t WS_QB = WS_PERM + al((size_t)PADROWS * 4);
constexpr size_t WS_KM = WS_QB + al((size_t)T * 384 * 2);
constexpr size_t WS_VM = WS_KM + al((size_t)T * 384 * 2);
constexpr size_t WS_KCB = WS_VM + al((size_t)T * 256 * 2);
constexpr size_t WT_C1 = WS_KCB + al((size_t)2 * NCR * 64 * 2);
constexpr size_t WT_C2 = WT_C1 + al((size_t)DEPTH * 2 * 256 * 2048 * 2);
constexpr size_t WT_UQ = WT_C2 + al((size_t)DEPTH * 2 * 128 * 256 * 2);
constexpr size_t WT_UKV = WT_UQ + al((size_t)DEPTH * 384 * 192 * 2);
constexpr size_t WT_G = WT_UKV + al((size_t)DEPTH * 512 * 128 * 2);
constexpr size_t WT_RH = WT_G + al((size_t)DEPTH * 4 * 128 * 64 * 2);
constexpr size_t WT_RL = WT_RH + al((size_t)DEPTH * 128 * 1024 * 2);
constexpr size_t WS_TBB = WT_RL + al((size_t)DEPTH * 128 * 1024 * 2);
constexpr size_t WS_HIDB = WS_TBB + al((size_t)2 * 2048 * 2048 * 2);
constexpr size_t WS_UB = WS_HIDB + al((size_t)2 * 2048 * 256 * 2);
constexpr size_t WS_CQNB = WS_UB + al((size_t)T * 256 * 2);
constexpr size_t WS_CKVNB = WS_CQNB + al((size_t)T * 192 * 2);
constexpr size_t WS_XBL = WS_CKVNB + al((size_t)T * 128 * 2);
constexpr size_t WS_SA = WS_XBL + al((size_t)T * 1024 * 2);
constexpr size_t WS_SH = WS_SA + al((size_t)BATCH * 32 * 256 * 4);
constexpr size_t WS_XG = WS_SH + al((size_t)BATCH * 32 * 256 * 4);
constexpr size_t WS_ROPE = WS_XG + al((size_t)PADROWS * 1024 * 2);
constexpr size_t WS_END = WS_ROPE + al((size_t)SEQ * 16 * 2 * 4);

constexpr int CW_BAR = 4096;
constexpr int CW_CNT = 16384;

struct Params {
    const float* in[34];
    float* out;
    unsigned char* ws;
};

#define XB_TMO      128
#define XB_XCNT(j)  (256  + 64 * (j))
#define XB_XSUB(j)  (1280 + 64 * (j))
#define XB_XGEN(j)  (2304 + 64 * (j))
#define XB_TOP      3328
#define XB_TOPGEN   3392
#define XCD_BAR_WORDS 3456
#define XB_SPIN_CAP (1u << 22)

__device__ __forceinline__ unsigned xb_ld(unsigned* p)              { return __hip_atomic_load(p, __ATOMIC_RELAXED, __HIP_MEMORY_SCOPE_AGENT); }
__device__ __forceinline__ unsigned xb_add(unsigned* p, unsigned v) { return __hip_atomic_fetch_add(p, v, __ATOMIC_RELAXED, __HIP_MEMORY_SCOPE_AGENT); }
__device__ __forceinline__ unsigned xb_xcc_id() { return (unsigned)__builtin_amdgcn_s_getreg((3 << 11) | 20) & 0xFu; }
#define XB_SPIN(cond, bar) do { unsigned _sp = 0; while (cond) { __builtin_amdgcn_s_sleep(1); \
    if ((++_sp & 255u) == 0u) { if (xb_ld(&(bar)[XB_TMO])) break; if (_sp > XB_SPIN_CAP) { atomicAdd(&(bar)[XB_TMO], 1u); break; } } } } while (0)

struct XcdBarrier { unsigned* bar; unsigned x; volatile LAS unsigned* st; };

__device__ __forceinline__ XcdBarrier xcd_barrier_post(unsigned* bar, volatile LAS unsigned* st) {
    XcdBarrier b; b.bar = bar; b.x = xb_xcc_id(); b.st = st;
    if (threadIdx.x == 0) (void)xb_add(&bar[XB_XCNT(b.x)], 1u);
    return b;
}
__device__ __forceinline__ void xcd_barrier_complete(unsigned* bar, unsigned x, unsigned& nloc, unsigned& nx) {
    const unsigned G = gridDim.x * gridDim.y * gridDim.z;
    unsigned sum, cnt, mine, sp = 0u;
    for (;;) {
        sum = 0u; cnt = 0u; mine = 0u;
#pragma unroll
        for (unsigned j = 0; j < 16; ++j) { const unsigned c = xb_ld(&bar[XB_XCNT(j)]); sum += c; cnt += (c > 0u) ? 1u : 0u; mine = (j == x) ? c : mine; }
        if (sum == G) break;
        __builtin_amdgcn_s_sleep(1);
        if ((++sp & 255u) == 0u) { if (xb_ld(&bar[XB_TMO])) break; if (sp > XB_SPIN_CAP) { atomicAdd(&bar[XB_TMO], 1u); break; } }
    }
    nloc = mine > 0u ? mine : 1u; nx = cnt > 0u ? cnt : 1u;
}
__device__ __forceinline__ void xcd_barrier(const XcdBarrier& b) {
    asm volatile("s_waitcnt vmcnt(0)" ::: "memory");
    __syncthreads();
    if (threadIdx.x == 0) {
        unsigned* bar = b.bar;
        __builtin_amdgcn_s_waitcnt(0);
        unsigned nloc = b.st[0], nx = b.st[1];
        if (nloc == 0u) { xcd_barrier_complete(bar, b.x, nloc, nx); b.st[0] = nloc; b.st[1] = nx; }
        const unsigned old = xb_add(&bar[XB_XSUB(b.x)], 1u);
        const unsigned gen = old / nloc;
        if (old + 1u == (gen + 1u) * nloc) {
            __builtin_amdgcn_fence(__ATOMIC_RELEASE, "agent");
            asm volatile("s_waitcnt vmcnt(0)" ::: "memory");
            const unsigned og = xb_add(&bar[XB_TOP], 1u);
            const unsigned tg = og / nx;
            if (og + 1u == (tg + 1u) * nx) xb_add(&bar[XB_TOPGEN], 1u);
            else XB_SPIN(xb_ld(&bar[XB_TOPGEN]) == tg, bar);
            __builtin_amdgcn_fence(__ATOMIC_ACQUIRE, "agent");
            xb_add(&bar[XB_XGEN(b.x)], 1u);
            asm volatile("s_waitcnt vmcnt(0)" ::: "memory");
        } else {
            XB_SPIN(xb_ld(&bar[XB_XGEN(b.x)]) == gen, bar);
            __builtin_amdgcn_fence(__ATOMIC_ACQUIRE, "agent");
            asm volatile("s_waitcnt vmcnt(0)" ::: "memory");
        }
    }
    __syncthreads();
}

DI float gelu_tanh(float x) { const float u = 0.7978845608028654f * (x + 0.044715f * x * x * x); return 0.5f * x * (1.f + tanhf(u)); }
DI float sigm(float x) { return 1.f / (1.f + expf(-x)); }
DI float sigm_fast(float x) { return __builtin_amdgcn_rcpf(1.f + __expf(-x)); }
DI float logsig(float z) { return fminf(z, 0.f) - log1pf(expf(-fabsf(z))); }
DI float wave_sum(float v) {
    const int lane = tidx() & 63;
#pragma unroll
    for (int o = 32; o > 0; o >>= 1) v += __int_as_float(__builtin_amdgcn_ds_bpermute((lane ^ o) << 2, __float_as_int(v)));
    return v;
}

DI float bflo(unsigned u) { return __uint_as_float(u << 16); }
DI float bfhi(unsigned u) { return __uint_as_float(u & 0xffff0000u); }
DI float bf2f(bf16_t x) { return __uint_as_float((unsigned)x << 16); }
typedef float f32x2_t __attribute__((ext_vector_type(2)));
typedef __bf16 bf16x2_t __attribute__((ext_vector_type(2)));
DI unsigned pk_bf16(float lo, float hi) { f32x2_t v = {lo, hi}; bf16x2_t b = __builtin_convertvector(v, bf16x2_t); return __builtin_bit_cast(unsigned, b); }
DI bf16_t f2bf(float x) { return (bf16_t)(pk_bf16(x, 0.f) & 0xffffu); }
DI void st4bf(bf16_t* p, float a, float b, float c, float d) { uint2 v; v.x = pk_bf16(a, b); v.y = pk_bf16(c, d); *(uint2*)p = v; }
DI float4 ld4bf(const bf16_t* p) { const uint2 v = *(const uint2*)p; return make_float4(bflo(v.x), bfhi(v.x), bflo(v.y), bfhi(v.y)); }
template <int N> DI float dot_row(const float* q, const bf16_t* kr) {
    float dot = 0.f;
#pragma unroll
    for (int d = 0; d < N; d += 8) { const uint4 v = *(const uint4*)(kr + d);
        dot = fmaf(q[d], bflo(v.x), dot); dot = fmaf(q[d + 1], bfhi(v.x), dot); dot = fmaf(q[d + 2], bflo(v.y), dot); dot = fmaf(q[d + 3], bfhi(v.y), dot);
        dot = fmaf(q[d + 4], bflo(v.z), dot); dot = fmaf(q[d + 5], bfhi(v.z), dot); dot = fmaf(q[d + 6], bflo(v.w), dot); dot = fmaf(q[d + 7], bfhi(v.w), dot); }
    return dot;
}
template <int N> DI float dot_row(const float* q, const float* kr) {
    float dot = 0.f;
#pragma unroll
    for (int d = 0; d < N; ++d) dot = fmaf(q[d], kr[d], dot);
    return dot;
}
template <int N> DI void axpy_row(float* o, float pr, float corr, const bf16_t* vr) {
#pragma unroll
    for (int d = 0; d < N; d += 8) { const uint4 v = *(const uint4*)(vr + d);
        o[d] = fmaf(pr, bflo(v.x), o[d] * corr); o[d + 1] = fmaf(pr, bfhi(v.x), o[d + 1] * corr); o[d + 2] = fmaf(pr, bflo(v.y), o[d + 2] * corr); o[d + 3] = fmaf(pr, bfhi(v.y), o[d + 3] * corr);
        o[d + 4] = fmaf(pr, bflo(v.z), o[d + 4] * corr); o[d + 5] = fmaf(pr, bfhi(v.z), o[d + 5] * corr); o[d + 6] = fmaf(pr, bflo(v.w), o[d + 6] * corr); o[d + 7] = fmaf(pr, bfhi(v.w), o[d + 7] * corr); }
}
template <int N> DI void axpy_row(float* o, float pr, float corr, const float* vr) {
#pragma unroll
    for (int d = 0; d < N; ++d) o[d] = fmaf(pr, vr[d], o[d] * corr);
}
template <int N> DI void ld_row(float* q, const bf16_t* p) {
#pragma unroll
    for (int d = 0; d < N; d += 8) { const uint4 v = *(const uint4*)(p + d);
        q[d] = bflo(v.x); q[d + 1] = bfhi(v.x); q[d + 2] = bflo(v.y); q[d + 3] = bfhi(v.y); q[d + 4] = bflo(v.z); q[d + 5] = bfhi(v.z); q[d + 6] = bflo(v.w); q[d + 7] = bfhi(v.w); }
}
template <int N> DI void ld_row(float* q, const float* p) {
#pragma unroll
    for (int d = 0; d < N; d += 4) { const float4 v = *(const float4*)(p + d); q[d] = v.x; q[d + 1] = v.y; q[d + 2] = v.z; q[d + 3] = v.w; }
}

struct MG { const bf16_t* A; long lda; const bf16_t* Wt; long ldw; int K; };

struct NoFlush { DI void operator()(int, f32x16 (&)[2][2]) const {} };
template <class RowFn, class Flush>
DI void mgemm_tile_f(const MG& g, int n0, RowFn rowfn, f32x16 (&acc)[2][2], unsigned char* lds, bool zero, int flush_every, Flush flush) {
    constexpr int XI = G_BM * 8 / NT, WI = G_BN * 8 / NT;
    const int tid = tidx(), lane = tid & 63, wid = tid >> 6, r = lane & 31, h = lane >> 5;
    const int wm = wid % G_WM, wn = wid / G_WM;
    const int cc = tid & 7, row0 = tid >> 3;
    const bf16_t* xp[XI]; const bf16_t* wp[WI];
#pragma unroll
    for (int i = 0; i < XI; ++i) xp[i] = g.A + (long)rowfn(row0 + (NT / 8) * i) * g.lda + cc * 8;
#pragma unroll
    for (int i = 0; i < WI; ++i) wp[i] = g.Wt + (long)(n0 + row0 + (NT / 8) * i) * g.ldw + cc * 8;
    const int st_off = row0 * G_RS + cc * 16;
    if (zero)
#pragma unroll
    for (int a = 0; a < 2; ++a)
#pragma unroll
        for (int b = 0; b < 2; ++b)
#pragma unroll
            for (int i = 0; i < 16; ++i) acc[a][b][i] = 0.f;
    const int nk = g.K >> 6;
    u32x4 xv0[XI], wv0[WI], xv1[XI], wv1[WI];
#define MG_GLOAD(XV, WV, KT) do { _Pragma("unroll") for (int i = 0; i < XI; ++i) XV[i] = *(const u32x4*)(xp[i] + (KT) * 64); \
                                  _Pragma("unroll") for (int i = 0; i < WI; ++i) WV[i] = *(const u32x4*)(wp[i] + (KT) * 64); } while (0)
#define MG_LSTORE(XV, WV, STG) do { unsigned char* _s = lds + (STG) * G_STAGE; \
        _Pragma("unroll") for (int i = 0; i < XI; ++i) *(u32x4*)(_s + st_off + (NT / 8) * i * G_RS) = XV[i]; \
        _Pragma("unroll") for (int i = 0; i < WI; ++i) *(u32x4*)(_s + G_BM * G_RS + st_off + (NT / 8) * i * G_RS) = WV[i]; } while (0)
    MG_GLOAD(xv0, wv0, 0);
    if (nk > 1) MG_GLOAD(xv1, wv1, 1);
    __syncthreads();
    MG_LSTORE(xv0, wv0, 0);
    if (nk > 2) MG_GLOAD(xv0, wv0, 2);
    __syncthreads();
    const int xf_off = (wm * 64 + r) * G_RS + h * 16, wf_off = G_BM * G_RS + (wn * 64 + r) * G_RS + h * 16;
#define MG_COMPUTE(STG) do { const unsigned char* st = lds + (STG) * G_STAGE; \
        _Pragma("unroll") for (int ks = 0; ks < 4; ++ks) { \
            const bf16x8 w0 = *(const bf16x8*)(st + wf_off + ks * 32), w1 = *(const bf16x8*)(st + wf_off + 32 * G_RS + ks * 32); \
            const bf16x8 x0 = *(const bf16x8*)(st + xf_off + ks * 32), x1 = *(const bf16x8*)(st + xf_off + 32 * G_RS + ks * 32); \
            acc[0][0] = __builtin_amdgcn_mfma_f32_32x32x16_bf16(w0, x0, acc[0][0], 0, 0, 0); \
            acc[0][1] = __builtin_amdgcn_mfma_f32_32x32x16_bf16(w0, x1, acc[0][1], 0, 0, 0); \
            acc[1][0] = __builtin_amdgcn_mfma_f32_32x32x16_bf16(w1, x0, acc[1][0], 0, 0, 0); \
            acc[1][1] = __builtin_amdgcn_mfma_f32_32x32x16_bf16(w1, x1, acc[1][1], 0, 0, 0); } } while (0)
    for (int kt = 0; kt < nk; kt += 2) {
        MG_COMPUTE(0);
        if (kt + 1 < nk) { MG_LSTORE(xv1, wv1, 1); if (kt + 3 < nk) MG_GLOAD(xv1, wv1, kt + 3); }
        if (flush_every && (kt + 1) % flush_every == 0) flush(kt / flush_every, acc);
        __syncthreads();
        if (kt + 1 < nk) {
            MG_COMPUTE(1);
            if (kt + 2 < nk) { MG_LSTORE(xv0, wv0, 0); if (kt + 4 < nk) MG_GLOAD(xv0, wv0, kt + 4); }
            if (flush_every && (kt + 2) % flush_every == 0) flush((kt + 1) / flush_every, acc);
            __syncthreads();
        }
    }
#undef MG_GLOAD
#undef MG_LSTORE
#undef MG_COMPUTE
}
template <class RowFn>
DI void mgemm_tile(const MG& g, int n0, RowFn rowfn, f32x16 (&acc)[2][2], unsigned char* lds, bool zero = true) { mgemm_tile_f(g, n0, rowfn, acc, lds, zero, 0, NoFlush{}); }
#define MG_FOREACH(acc, LROW, FEAT, V, ...) do { const int _l = tidx() & 63, _w = tidx() >> 6, _wm = _w % G_WM, _wn = _w / G_WM; \
    _Pragma("unroll") for (int _ft = 0; _ft < 2; ++_ft) _Pragma("unroll") for (int _tt = 0; _tt < 2; ++_tt) _Pragma("unroll") for (int _i = 0; _i < 4; ++_i) { \
        const int LROW = _wm * 64 + _tt * 32 + (_l & 31); const int FEAT = _wn * 64 + _ft * 32 + 8 * _i + 4 * (_l >> 5); \
        float V[4] = {acc[_ft][_tt][4 * _i], acc[_ft][_tt][4 * _i + 1], acc[_ft][_tt][4 * _i + 2], acc[_ft][_tt][4 * _i + 3]}; __VA_ARGS__ } } while (0)

struct RowId { int m0; DI long operator()(int r) const { return m0 + r; } };

template <int OUTMODE>
DI void mgemm_job(const MG& g, int M, int N, void* out, long ldo, int bid, int nblk, unsigned char* lds) {
    const int tm = M / G_BM, tn = N / G_BN;
    for (int u = bid; u < tm * tn; u += nblk) {
        const int grp = u / (16 * tn), rem = u % (16 * tn);
        const int gm = (tm - grp * 16) < 16 ? (tm - grp * 16) : 16;
        const int mt = grp * 16 + rem % gm, nt = rem / gm;
        const int m0 = mt * G_BM, n0 = nt * G_BN;
        f32x16 acc[2][2];
        mgemm_tile(g, n0, RowId{m0}, acc, lds);
        MG_FOREACH(acc, lrow, feat, v, {
            const long o = (long)(m0 + lrow) * ldo + n0 + feat;
            if (OUTMODE == 1) *(float4*)((float*)out + o) = make_float4(v[0], v[1], v[2], v[3]);
            else {
                if (OUTMODE == 2 && n0 + feat >= O_MG) { v[0] = sigm(v[0]); v[1] = sigm(v[1]); v[2] = sigm(v[2]); v[3] = sigm(v[3]); }
                st4bf((bf16_t*)out + o, v[0], v[1], v[2], v[3]);
            } });
    }
}

namespace pg8 {
#define PG8_LAS __attribute__((address_space(3)))
typedef float f32x4 __attribute__((ext_vector_type(4)));
constexpr int BM = 256, BK = 64, HALF = 128, HTB = HALF * BK * 2  , STAGE_BYTES = 8 * HTB, NXCD = 8, WGM = 8;
__host__ __device__ __forceinline__ int lds_byte(int r, int c) { const int st = (r >> 4) * 2 + (c >> 5), rr = r & 15, cc = c & 31, ob = rr * 64 + cc * 2; return st * 1024 + (ob ^ (((ob >> 9) & 1) << 5)); }
__host__ __device__ __forceinline__ void stage_rc(int b, int& R, int& C) { const int st = b / 1024, sb = b % 1024, swz = sb ^ (((sb >> 9) & 1) << 5); R = (st >> 1) * 16 + swz / 64; C = (st & 1) * 32 + (swz % 64) / 2; }
__host__ __device__ __forceinline__ int perm32(int rho) { const int n = rho >> 4, i = rho & 15; return 8 * (i >> 2) + 4 * n + (i & 3); }
struct Unit { int pm, pn, e; };
struct Gemm { const bf16_t* A; const bf16_t* Bt; int M, N, K; };
struct StaticOrder {
    int nM, nN, nwg, G, c;
    __device__ void init(int M, int N, int G_, int c_) { nM = M / BM; nN = N / BM; nwg = nM * nN; G = G_; c = c_; }
    __device__ bool next(int i, Unit& u) const {
        const long L = (long)i * G + c; if (L >= nwg) return false;
        int wgid = (int)L; { const int q = nwg / NXCD, r = nwg % NXCD, xcd = wgid % NXCD, off = wgid / NXCD; wgid = (xcd < r ? xcd * (q + 1) : r * (q + 1) + (xcd - r) * q) + off; }
        const int nig = WGM * nN, gid = wgid / nig, fm = gid * WGM, gsz = (nM - fm) < WGM ? (nM - fm) : WGM;
        u.pm = fm + ((wgid % nig) % gsz); u.pn = (wgid % nig) / gsz; u.e = 0; return true;
    }
    __device__ __forceinline__ void a_ready(const Unit&) const {}
    __device__ __forceinline__ void done(const Unit&) const {}
};
struct ListOrder {
    Unit u0, u1, u2; int n;
    __device__ bool next(int i, Unit& u) const { if (i >= n) return false; u = (i == 0) ? u0 : ((i == 1) ? u1 : u2); return true; }
    __device__ __forceinline__ void a_ready(const Unit&) const {}
    __device__ __forceinline__ void done(const Unit&) const {}
};
template <class Epi, class Sched, bool ALIGN_EPI = false, bool SP2 = false>
__device__ __forceinline__ void gemm_phase(PG8_LAS unsigned char* lds, const Gemm g, const Sched& S, const Epi& E) {
    const int tid = tidx(), wid = __builtin_amdgcn_readfirstlane(tid >> 6), lane = tid & 63, wr = wid >> 2, wc = wid & 3, fr = lane & 15, fq = lane >> 4;
    const int K = g.K, nt = K / BK;
    unsigned voffA[2], voffB[2];
#pragma unroll
    for (int i = 0; i < 2; ++i) { int R, C; stage_rc(tid * 16 + i * 8192, R, C); const int Rb = Epi::PERM ? ((R & ~31) + perm32(R & 31)) : R;
        voffA[i] = (unsigned)(R * K + C) * 2u; voffB[i] = (unsigned)(Rb * K + C) * 2u; }
    const size_t kstep = (size_t)(BK * 2);
    const size_t hstep = (size_t)HALF * K * 2;
    const size_t tstep = 2 * hstep;
    const size_t estep = (size_t)g.N * K * 2;
    const unsigned ldsw = (unsigned)wid * 1024u;
    const int aoff = lds_byte(wr * 64 + fr, fq * 8), boff = lds_byte(wc * 32 + fr, fq * 8);
#define PG8_SA(b, h) (((b) * 2 + (h)) * HTB)
#define PG8_SB(b, h) ((4 + (b) * 2 + (h)) * HTB)
#define PG8_STAGE(bufoff, gbase, voff) do { _Pragma("unroll") for (int _i = 0; _i < 2; ++_i) \
        __builtin_amdgcn_global_load_lds((const unsigned*)((const char*)(gbase) + (voff)[_i]), (PG8_LAS unsigned*)(lds + (bufoff) + ldsw + _i * 8192), 16, 0, 0); } while (0)
#define PG8_LDA(dst, b, h) do { _Pragma("unroll") for (int m = 0; m < 4; ++m) _Pragma("unroll") for (int k = 0; k < 2; ++k) dst[m][k] = *(const PG8_LAS bf16x8*)(lds + PG8_SA(b, h) + aoff + m * 2048 + k * 1024); } while (0)
#define PG8_LDB(dst, b, h) do { _Pragma("unroll") for (int n = 0; n < 2; ++n) _Pragma("unroll") for (int k = 0; k < 2; ++k) dst[n][k] = *(const PG8_LAS bf16x8*)(lds + PG8_SB(b, h) + boff + n * 2048 + k * 1024); } while (0)
#define PG8_MMA(ai, bj, At, Bt) do { __builtin_amdgcn_s_setprio(1); _Pragma("unroll") for (int m = 0; m < 4; ++m) _Pragma("unroll") for (int n = 0; n < 2; ++n) _Pragma("unroll") for (int k = 0; k < 2; ++k) \
        acc[ai][bj][m][n] = __builtin_amdgcn_mfma_f32_16x16x32_bf16(Bt[n][k], At[m][k], acc[ai][bj][m][n], 0, 0, 0); __builtin_amdgcn_s_setprio(0); } while (0)
#define PG8_WAIT_V(n) asm volatile("s_waitcnt vmcnt(" #n ")" ::: "memory")
#define PG8_WAIT_L(n) asm volatile("s_waitcnt lgkmcnt(" #n ")" ::: "memory")
#define PG8_BAR __builtin_amdgcn_s_barrier()
#define PG8_SCHED __builtin_amdgcn_sched_barrier(0)
    Unit cur, nxt; int ui = 0;
    if (!S.next(0, cur)) return;
    f32x4 acc[2][2][4][2];
#pragma unroll
    for (int a = 0; a < 2; ++a)
#pragma unroll
        for (int b = 0; b < 2; ++b)
#pragma unroll
            for (int m = 0; m < 4; ++m)
#pragma unroll
                for (int n = 0; n < 2; ++n) acc[a][b][m][n] = (f32x4){0.f, 0.f, 0.f, 0.f};
    bf16x8 At[4][2], B0[2][2], B1[2][2];
    const char* cA = (const char*)g.A + (size_t)cur.pm * tstep; const char* cB = (const char*)g.Bt + (size_t)cur.e * estep + (size_t)cur.pn * tstep;
    S.a_ready(cur);
    if constexpr (SP2) {
        PG8_STAGE(PG8_SB(0, 0), cB, voffB); PG8_STAGE(PG8_SB(0, 1), cB + hstep, voffB); PG8_STAGE(PG8_SA(0, 0), cA, voffA); PG8_STAGE(PG8_SA(0, 1), cA + hstep, voffA);
        if (wr == 1) PG8_BAR;
        PG8_WAIT_V(2); PG8_BAR;
        PG8_STAGE(PG8_SB(1, 0), cB + kstep, voffB); PG8_STAGE(PG8_SA(1, 0), cA + kstep, voffA); PG8_STAGE(PG8_SB(1, 1), cB + hstep + kstep, voffB);
        PG8_WAIT_V(6); PG8_BAR;
    } else {
        PG8_STAGE(PG8_SB(0, 0), cB, voffB); PG8_STAGE(PG8_SA(0, 0), cA, voffA); PG8_STAGE(PG8_SB(0, 1), cB + hstep, voffB); PG8_STAGE(PG8_SA(0, 1), cA + hstep, voffA);
        if (wr == 1) PG8_BAR;
        PG8_WAIT_V(4); PG8_BAR;
        PG8_STAGE(PG8_SB(1, 0), cB + kstep, voffB); PG8_STAGE(PG8_SA(1, 0), cA + kstep, voffA); PG8_STAGE(PG8_SB(1, 1), cB + hstep + kstep, voffB);
        PG8_WAIT_V(6); PG8_BAR;
    }
    for (;;) {
        const bool has_next = S.next(ui + 1, nxt);
        const char* nA = has_next ? (const char*)g.A + (size_t)nxt.pm * tstep : cA; const char* nB = has_next ? (const char*)g.Bt + (size_t)nxt.e * estep + (size_t)nxt.pn * tstep : cB;
        for (int t = 0; t < nt; t += 2) {
            const bool last = (t == nt - 2);
            const char* a1 = cA + (size_t)(t + 1) * kstep;
            const char* a2 = last ? nA : cA + (size_t)(t + 2) * kstep; const char* b2 = last ? nB : cB + (size_t)(t + 2) * kstep;
            const char* a3 = a2 + kstep; const char* b3 = b2 + kstep;
            if (last && has_next) S.a_ready(nxt);
            if constexpr (SP2) {
            PG8_LDB(B0, 0, 0); PG8_LDB(B1, 0, 1); PG8_SCHED; PG8_LDA(At, 0, 0); PG8_STAGE(PG8_SA(1, 1), a1 + hstep, voffA);
            PG8_WAIT_V(8); PG8_WAIT_L(0); PG8_BAR; PG8_MMA(0, 0, At, B0); PG8_MMA(0, 1, At, B1); PG8_BAR; PG8_SCHED;
            PG8_LDA(At, 0, 1); PG8_STAGE(PG8_SB(0, 0), b2, voffB); PG8_STAGE(PG8_SB(0, 1), b2 + hstep, voffB); PG8_STAGE(PG8_SA(0, 0), a2, voffA);
            PG8_WAIT_V(8); PG8_WAIT_L(0); PG8_BAR; PG8_MMA(1, 0, At, B0); PG8_MMA(1, 1, At, B1); PG8_BAR; PG8_SCHED;
            PG8_LDB(B0, 1, 0); PG8_LDB(B1, 1, 1); PG8_SCHED; PG8_LDA(At, 1, 0); PG8_STAGE(PG8_SA(0, 1), a2 + hstep, voffA);
            PG8_WAIT_V(8); PG8_WAIT_L(0); PG8_BAR; PG8_MMA(0, 0, At, B0); PG8_MMA(0, 1, At, B1); PG8_BAR; PG8_SCHED;
            PG8_LDA(At, 1, 1); PG8_STAGE(PG8_SB(1, 0), b3, voffB); PG8_STAGE(PG8_SB(1, 1), b3 + hstep, voffB); PG8_STAGE(PG8_SA(1, 0), a3, voffA);
            PG8_WAIT_V(8); PG8_WAIT_L(0); PG8_BAR; PG8_MMA(1, 0, At, B0); PG8_MMA(1, 1, At, B1); PG8_BAR; PG8_SCHED;
            } else {
            PG8_LDB(B0, 0, 0); PG8_SCHED; PG8_LDA(At, 0, 0); PG8_STAGE(PG8_SA(1, 1), a1 + hstep, voffA);
            PG8_WAIT_L(8); PG8_BAR; PG8_WAIT_L(0); PG8_MMA(0, 0, At, B0); PG8_BAR; PG8_SCHED;
            PG8_LDB(B1, 0, 1); PG8_STAGE(PG8_SB(0, 0), b2, voffB);
            PG8_BAR; PG8_WAIT_L(0); PG8_MMA(0, 1, At, B1); PG8_BAR;
            PG8_LDA(At, 0, 1); PG8_STAGE(PG8_SA(0, 0), a2, voffA);
            PG8_BAR; PG8_WAIT_L(0); PG8_MMA(1, 0, At, B0); PG8_BAR; PG8_SCHED;
            PG8_STAGE(PG8_SB(0, 1), b2 + hstep, voffB);
            PG8_WAIT_V(6); PG8_BAR; PG8_MMA(1, 1, At, B1); PG8_BAR;
            PG8_LDB(B0, 1, 0); PG8_SCHED; PG8_LDA(At, 1, 0); PG8_STAGE(PG8_SA(0, 1), a2 + hstep, voffA);
            PG8_WAIT_L(8); PG8_BAR; PG8_WAIT_L(0); PG8_MMA(0, 0, At, B0); PG8_BAR; PG8_SCHED;
            PG8_LDB(B1, 1, 1); PG8_STAGE(PG8_SB(1, 0), b3, voffB);
            PG8_BAR; PG8_WAIT_L(0); PG8_MMA(0, 1, At, B1); PG8_BAR;
            PG8_LDA(At, 1, 1); PG8_STAGE(PG8_SA(1, 0), a3, voffA);
            PG8_BAR; PG8_WAIT_L(0); PG8_MMA(1, 0, At, B0); PG8_BAR; PG8_SCHED;
            PG8_STAGE(PG8_SB(1, 1), b3 + hstep, voffB);
            PG8_WAIT_V(6); PG8_BAR; PG8_MMA(1, 1, At, B1); PG8_BAR;
            }
        }
        if constexpr (ALIGN_EPI) { if (wr == 0) PG8_BAR; }
        if constexpr (!Epi::AFTER_DRAIN) { E(acc, cur, wr, wc, fr, fq); S.done(cur); }
        if (!has_next) break;
#pragma unroll
        for (int a = 0; a < 2; ++a)
#pragma unroll
            for (int b = 0; b < 2; ++b)
#pragma unroll
                for (int m = 0; m < 4; ++m)
#pragma unroll
                    for (int n = 0; n < 2; ++n) acc[a][b][m][n] = (f32x4){0.f, 0.f, 0.f, 0.f};
        cur = nxt; cA = nA; cB = nB; ++ui;
        if constexpr (ALIGN_EPI) { if (wr == 1) PG8_BAR; }
    }
    PG8_WAIT_V(0);
    if constexpr (!ALIGN_EPI) { if (wr == 0) PG8_BAR; }
    PG8_BAR;
    if constexpr (Epi::AFTER_DRAIN) { E.fused(acc, cur, wr, wc, fr, fq, lds, wid, lane); S.done(cur); }
#undef PG8_SA
#undef PG8_SB
#undef PG8_STAGE
#undef PG8_LDA
#undef PG8_LDB
#undef PG8_MMA
#undef PG8_WAIT_V
#undef PG8_WAIT_L
#undef PG8_BAR
#undef PG8_SCHED
}
}

struct EpiStoreBf16 {
    static constexpr bool PERM = true, AFTER_DRAIN = false;
    bf16_t* O; long ldo; int gate_from; long estride;
    __device__ __forceinline__ void operator()(const pg8::f32x4 (&acc)[2][2][4][2], const pg8::Unit& u, int wr, int wc, int fr, int fq) const {
        bf16_t* base = O + (long)u.e * estride;
#pragma unroll
        for (int ai = 0; ai < 2; ++ai)
#pragma unroll
            for (int m = 0; m < 4; ++m) {
                const long row = (long)u.pm * 256 + ai * 128 + wr * 64 + m * 16 + fr;
#pragma unroll
                for (int bj = 0; bj < 2; ++bj) {
                    pg8::f32x4 v0 = acc[ai][bj][m][0], v1 = acc[ai][bj][m][1];
                    if (u.pn * 2 + bj >= gate_from) {
#pragma unroll
                        for (int j = 0; j < 4; ++j) { v0[j] = sigm_fast(v0[j]); v1[j] = sigm_fast(v1[j]); }
                    }
                    u32x4 wv; wv[0] = pk_bf16(v0[0], v0[1]); wv[1] = pk_bf16(v0[2], v0[3]); wv[2] = pk_bf16(v1[0], v1[1]); wv[3] = pk_bf16(v1[2], v1[3]);
                    *(u32x4*)(base + row * ldo + u.pn * 256 + bj * 128 + wc * 32 + 8 * fq) = wv;
                }
            }
    }
};
struct EpiStoreF32 {
    static constexpr bool PERM = false, AFTER_DRAIN = false;
    float* O; long ldo;
    __device__ __forceinline__ void operator()(const pg8::f32x4 (&acc)[2][2][4][2], const pg8::Unit& u, int wr, int wc, int fr, int fq) const {
#pragma unroll
        for (int ai = 0; ai < 2; ++ai)
#pragma unroll
            for (int m = 0; m < 4; ++m) {
                const long row = (long)u.pm * 256 + ai * 128 + wr * 64 + m * 16 + fr;
#pragma unroll
                for (int bj = 0; bj < 2; ++bj)
#pragma unroll
                    for (int n = 0; n < 2; ++n) *(pg8::f32x4*)(O + row * ldo + u.pn * 256 + bj * 128 + wc * 32 + 16 * n + 4 * fq) = acc[ai][bj][m][n];
            }
    }
};
struct EpiMoeGU {
    static constexpr bool PERM = true, AFTER_DRAIN = false;
    bf16_t* HH;
    __device__ __forceinline__ void operator()(const pg8::f32x4 (&acc)[2][2][4][2], const pg8::Unit& u, int wr, int wc, int fr, int fq) const {
#pragma unroll
        for (int ai = 0; ai < 2; ++ai)
#pragma unroll
            for (int m = 0; m < 4; ++m) {
                const long row = (long)u.pm * 256 + ai * 128 + wr * 64 + m * 16 + fr;
                float hv[8];
#pragma unroll
                for (int n = 0; n < 2; ++n)
#pragma unroll
                    for (int j = 0; j < 4; ++j) { const float gt = acc[ai][0][m][n][j], up = acc[ai][1][m][n][j]; hv[4 * n + j] = gt * sigm_fast(gt) * up; }
                u32x4 wv; wv[0] = pk_bf16(hv[0], hv[1]); wv[1] = pk_bf16(hv[2], hv[3]); wv[2] = pk_bf16(hv[4], hv[5]); wv[3] = pk_bf16(hv[6], hv[7]);
                *(u32x4*)(HH + row * 512 + u.pn * 128 + wc * 32 + 8 * fq) = wv;
            }
    }
};
struct EpiMoeDown {
    static constexpr bool PERM = true, AFTER_DRAIN = false;
    const int* perm; const float* ew; bf16_t* YK;
    __device__ __forceinline__ void operator()(const pg8::f32x4 (&acc)[2][2][4][2], const pg8::Unit& u, int wr, int wc, int fr, int fq) const {
#pragma unroll
        for (int ai = 0; ai < 2; ++ai)
#pragma unroll
            for (int m = 0; m < 4; ++m) {
                const int a = perm[u.pm * 256 + ai * 128 + wr * 64 + m * 16 + fr];
                if (a >= 0) {
                    const float sw = ew[a];
#pragma unroll
                    for (int bj = 0; bj < 2; ++bj) {
                        const pg8::f32x4 v0 = acc[ai][bj][m][0] * sw, v1 = acc[ai][bj][m][1] * sw;
                        u32x4 wv; wv[0] = pk_bf16(v0[0], v0[1]); wv[1] = pk_bf16(v0[2], v0[3]); wv[2] = pk_bf16(v1[0], v1[1]); wv[3] = pk_bf16(v1[2], v1[3]);
                        *(u32x4*)(YK + (long)a * 1024 + u.pn * 256 + bj * 128 + wc * 32 + 8 * fq) = wv;
                    }
                }
            }
    }
};
struct GroupedOrder {
    int nM, nN, nE, G, c;
    __device__ bool next(int i, pg8::Unit& u) const { const int L = i * G + c; if (L >= nM * nN * nE) return false; u.e = L / (nM * nN); const int rm = L % (nM * nN); u.pm = rm / nN; u.pn = rm % nN; return true; }
    __device__ __forceinline__ void a_ready(const pg8::Unit&) const {}
    __device__ __forceinline__ void done(const pg8::Unit&) const {}
};

struct LayerW {
    const float *cmp_pos, *conv_w, *conv_b, *ga_b, *gx_b, *lam, *q_norm, *kv_norm,
        *ln1_g, *ln1_b, *ln2_g, *ln2_b, *rg_b, *re_b, *ln3_g, *ln3_b;
    const bf16_t *t_in, *t_br, *t_out, *t_q, *t_o, *t_gu, *t_dn, *t_c1, *t_c2, *t_uq, *t_ukv, *t_g, *t_rh, *t_rl;
};
#define WSF(off) ((float*)(p.ws + (off)))
#define WSI(off) ((int*)(p.ws + (off)))
#define WSU(off) ((unsigned*)(p.ws + (off)))
#define WSB(off) ((bf16_t*)(p.ws + (off)))
DI LayerW layer_w(const Params& p, int l) {
    LayerW w;
    w.cmp_pos = p.in[3] + (size_t)l * 2 * 32 * 64;
    w.conv_w = p.in[6] + (size_t)l * 4 * 256;
    w.conv_b = p.in[7] + (size_t)l * 256;
    w.ga_b = p.in[9] + (size_t)l * 256;
    w.gx_b = p.in[11] + (size_t)l * 256;
    w.lam = p.in[12] + (size_t)l * 256;
    w.q_norm = p.in[13] + (size_t)l * 192;
    w.kv_norm = p.in[14] + (size_t)l * 128;
    w.ln1_g = p.in[19] + (size_t)l * 1024; w.ln1_b = p.in[20] + (size_t)l * 1024;
    w.ln2_g = p.in[24] + (size_t)l * 1024; w.ln2_b = p.in[25] + (size_t)l * 1024;
    w.rg_b = p.in[27] + (size_t)l * 4;
    w.re_b = p.in[29] + (size_t)l * 32;
    w.ln3_g = p.in[32] + (size_t)l * 1024; w.ln3_b = p.in[33] + (size_t)l * 1024;
    w.t_in = WSB(WT_IN) + (size_t)l * NH * 1024;
    w.t_br = WSB(WT_BR) + (size_t)l * 1024 * 1024;
    w.t_out = WSB(WT_OUT) + (size_t)l * 1024 * 1024;
    w.t_q = WSB(WT_Q) + (size_t)l * 512 * 1024;
    w.t_o = WSB(WT_O) + (size_t)l * 1024 * 512;
    w.t_gu = WSB(WT_GU) + (size_t)l * 32 * 1024 * 1024;
    w.t_dn = WSB(WT_DN) + (size_t)l * 32 * 1024 * 512;
    w.t_c1 = WSB(WT_C1) + (size_t)l * 2 * 256 * 2048;
    w.t_c2 = WSB(WT_C2) + (size_t)l * 2 * 128 * 256;
    w.t_uq = WSB(WT_UQ) + (size_t)l * 384 * 192;
    w.t_ukv = WSB(WT_UKV) + (size_t)l * 512 * 128;
    w.t_g = WSB(WT_G) + (size_t)l * 4 * 128 * 64;
    w.t_rh = WSB(WT_RH) + (size_t)l * 128 * 1024;
    w.t_rl = WSB(WT_RL) + (size_t)l * 128 * 1024;
    return w;
}

template <int MODE>
DI int wt_col(int np, int Nsrc) {
    if (MODE == 0) return np < Nsrc ? np : -1;
    if (MODE == 2) return np < 1024 ? np : (np < 2656 ? np + 12 : (np < 2668 ? 1024 + (np - 2656) : (np < 2688 ? -1 : (np < 6784 ? np - 20 : -1))));
    const int pn = np >> 8, bj = (np >> 7) & 1, q = np & 127; return (bj ? 512 : 0) + 128 * pn + q;
}
template <int MODE>
DI void job_wt(const float* src, int nmat, int K, int Nsrc, bf16_t* dst, int Npad, int bid, int nblk, unsigned char* lds) {
    const int lane = tidx() & 63, wid = tidx() >> 6;
    bf16_t* tile = (bf16_t*)lds + wid * (64 * 72);
    const int tk = K / 64, tn = Npad / 64, per = tk * tn;
    const int kl = lane >> 4, n4 = (lane & 15) * 4;
    for (int u = bid * (NT / 64) + wid; u < nmat * per; u += nblk * (NT / 64)) {
        const int mat = u / per, ru = u % per, k0 = (ru / tn) * 64, n0 = (ru % tn) * 64;
        const float* s = src + (size_t)mat * K * Nsrc;
        bf16_t* d = dst + (size_t)mat * Npad * K;
        const int col = wt_col<MODE>(n0 + n4, Nsrc);
        float4 v[16];
#pragma unroll
        for (int ps = 0; ps < 16; ++ps) v[ps] = col >= 0 ? *(const float4*)(s + (size_t)(k0 + kl + 4 * ps) * Nsrc + col) : make_float4(0.f, 0.f, 0.f, 0.f);
#pragma unroll
        for (int ps = 0; ps < 16; ++ps) { const int k = kl + 4 * ps;
            tile[(n4 + 0) * 72 + k] = f2bf(v[ps].x); tile[(n4 + 1) * 72 + k] = f2bf(v[ps].y); tile[(n4 + 2) * 72 + k] = f2bf(v[ps].z); tile[(n4 + 3) * 72 + k] = f2bf(v[ps].w); }
        __builtin_amdgcn_fence(__ATOMIC_RELEASE, "wavefront"); __builtin_amdgcn_wave_barrier(); __builtin_amdgcn_fence(__ATOMIC_ACQUIRE, "wavefront");
#pragma unroll
        for (int c8 = 0; c8 < 8; ++c8) { const int c = lane + 64 * c8, n2 = c >> 3, kc = (c & 7) * 8;
            *(uint4*)(d + (size_t)(n0 + n2) * K + k0 + kc) = *(const uint4*)(tile + n2 * 72 + kc); }
        __builtin_amdgcn_fence(__ATOMIC_RELEASE, "wavefront"); __builtin_amdgcn_wave_barrier(); __builtin_amdgcn_fence(__ATOMIC_ACQUIRE, "wavefront");
    }
}
DI void job_cvt(const float* src, bf16_t* dst, long n, int bid, int nblk) {
    for (long e = ((long)bid * NT + tidx()) * 4; e < n; e += (long)nblk * NT * 4) {
        const float4 v = *(const float4*)(src + e);
        st4bf(dst + e, v.x, v.y, v.z, v.w);
    }
}
DI void job_cmp_gather(const Params& p, const LayerW& w, int bid, int nblk) {
    const bf16_t* H = WSB(WS_H); bf16_t* TB = WSB(WS_TBB);
    const long total = (long)2 * NCR * 2048 / 4;
    for (long e = (long)bid * NT + tidx(); e < total; e += (long)nblk * NT) {
        const long e4 = e * 4;
        const int f = (int)(e4 % 2048); const long r2 = e4 / 2048; const int r = (int)(r2 % NCR), j = (int)(r2 / NCR);
        const int g = r & 1, bc = r >> 1, c = bc % NCMP, b = bc / NCMP, i = f >> 6, d = f & 63;
        const float4 hv = ld4bf(H + (long)(b * SEQ + 16 * c + i) * NH + (j ? O_AVC : O_AKC) + g * 64 + d);
        const float4 pv = *(const float4*)(w.cmp_pos + (j * 32 + i) * 64 + d);
        st4bf(TB + ((long)j * 2048 + r) * 2048 + f, hv.x + pv.x, hv.y + pv.y, hv.z + pv.z, hv.w + pv.w);
    }
}
DI void job_rnn_conv(const Params& p, const LayerW& w, int bid, int nblk) {
    const bf16_t* H = WSB(WS_H); float* U = WSF(WS_U); bf16_t* UB = WSB(WS_UB);
    for (long e = (long)bid * NT + tidx(); e < (long)T * 64; e += (long)nblk * NT) {
        const int ch = (int)(e & 63) * 4; const int t = (int)(e >> 6), s = t & (SEQ - 1);
        const float4 cb = *(const float4*)(w.conv_b + ch);
        float u0 = cb.x, u1 = cb.y, u2 = cb.z, u3 = cb.w;
#pragma unroll
        for (int tap = 0; tap < 4; ++tap) { const int sp = s - 3 + tap;
            if (sp >= 0) { const float4 hv = ld4bf(H + (long)(t - 3 + tap) * NH + O_CX + ch); const float4 cw = *(const float4*)(w.conv_w + tap * 256 + ch);
                u0 += hv.x * cw.x; u1 += hv.y * cw.y; u2 += hv.z * cw.z; u3 += hv.w * cw.w; } }
        *(float4*)(U + (long)t * 256 + ch) = make_float4(u0, u1, u2, u3); st4bf(UB + (long)t * 256 + ch, u0, u1, u2, u3);
    }
}
DI void job_rnn_gates(const Params& p, const LayerW& w, int bid, int nblk, unsigned char* lds) {
    const float* U = WSF(WS_U); float* RA = WSF(WS_RA); float* RB = WSF(WS_RB);
    for (int u = bid; u < (T / G_BM) * 4; u += nblk) {
        const int blk = u & 3, m0 = (u >> 2) * G_BM;
        MG g; g.A = WSB(WS_UB) + blk * 64; g.lda = 256; g.Wt = w.t_g + (size_t)blk * 128 * 64; g.ldw = 64; g.K = 64;
        f32x16 acc[2][2];
        mgemm_tile(g, 0, RowId{m0}, acc, lds);
        const int l = tidx() & 63, wv = tidx() >> 6, wm = wv % G_WM, wn = wv / G_WM;
#pragma unroll
        for (int tt = 0; tt < 2; ++tt)
#pragma unroll
            for (int i = 0; i < 4; ++i) {
                const long t = m0 + wm * 64 + tt * 32 + (l & 31); const int ch = blk * 64 + wn * 32 + 8 * i + 4 * (l >> 5);
                const float4 uv = *(const float4*)(U + t * 256 + ch);
                const float ua[4] = {uv.x, uv.y, uv.z, uv.w};
                float av[4], bv[4];
#pragma unroll
                for (int j = 0; j < 4; ++j) {
                    const float r = sigm(acc[0][tt][4 * i + j] + w.ga_b[ch + j]), ig = sigm(acc[1][tt][4 * i + j] + w.gx_b[ch + j]);
                    const float nl = -w.lam[ch + j];
                    const float sp = fmaxf(nl, 0.f) + log1pf(expf(-fabsf(nl)));
                    const float log_a = -8.0f * r * sp;
                    av[j] = expf(log_a); bv[j] = sqrtf(-expm1f(2.0f * log_a)) * (ig * ua[j]);
                }
                *(float4*)(RA + t * 256 + ch) = make_float4(av[0], av[1], av[2], av[3]);
                *(float4*)(RB + t * 256 + ch) = make_float4(bv[0], bv[1], bv[2], bv[3]);
            }
    }
}
DI void job_rnn_scan1(const Params& p, int bid, int nblk) {
    const float* RA = WSF(WS_RA); const float* RB = WSF(WS_RB); float* SA = WSF(WS_SA); float* SH = WSF(WS_SH);
    for (int e = bid * NT + tidx(); e < BATCH * 32 * 256; e += nblk * NT) {
        const int ch = e & 255, bc = e >> 8;
        float ap = 1.f, hl = 0.f;
        for (int s0 = 0; s0 < 64; s0 += 8) {
            float av[8], bv[8];
#pragma unroll
            for (int i = 0; i < 8; ++i) { const long t = (long)bc * 64 + s0 + i; av[i] = RA[t * 256 + ch]; bv[i] = RB[t * 256 + ch]; }
#pragma unroll
            for (int i = 0; i < 8; ++i) { ap *= av[i]; hl = av[i] * hl + bv[i]; }
        }
        SA[e] = ap; SH[e] = hl;
    }
}
DI void job_rnn_scan2(const Params& p, int bid, int nblk) {
    const bf16_t* H = WSB(WS_H); const float* RA = WSF(WS_RA); const float* RB = WSF(WS_RB); const float* SA = WSF(WS_SA); const float* SH = WSF(WS_SH); bf16_t* BR = WSB(WS_BR);
    for (int e = bid * NT + tidx(); e < BATCH * 32 * 256; e += nblk * NT) {
        const int ch = e & 255, bc = e >> 8, chunk = bc & 31, b = bc >> 5;
        float h = 0.f;
        for (int c = 0; c < chunk; ++c) { const int q = ((b * 32 + c) << 8) + ch; h = SA[q] * h + SH[q]; }
        for (int s0 = 0; s0 < 64; s0 += 8) {
            float av[8], bv[8], gv[8];
#pragma unroll
            for (int i = 0; i < 8; ++i) { const long t = (long)bc * 64 + s0 + i; av[i] = RA[t * 256 + ch]; bv[i] = RB[t * 256 + ch]; gv[i] = bf2f(H[t * NH + O_CG + ch]); }
#pragma unroll
            for (int i = 0; i < 8; ++i) { const long t = (long)bc * 64 + s0 + i; h = av[i] * h + bv[i]; BR[t * 1024 + 2 * 256 + ch] = f2bf(h * gelu_tanh(gv[i])); }
        }
    }
}
DI void job_mla_norm(const Params& p, const LayerW& w, int bid, int nblk) {
    const bf16_t* H = WSB(WS_H); bf16_t* CQN = WSB(WS_CQNB); bf16_t* CKVN = WSB(WS_CKVNB); bf16_t* KM = WSB(WS_KM);
    const int lane = tidx() & 63, wid = tidx() >> 6;
    for (int t = bid * (NT / 64) + wid; t < T; t += nblk * (NT / 64)) {
        const bf16_t* hr = H + (long)t * NH;
        float q0 = bf2f(hr[O_DCQ + lane]), q1 = bf2f(hr[O_DCQ + 64 + lane]), q2 = bf2f(hr[O_DCQ + 128 + lane]);
        float ss = wave_sum(q0 * q0 + q1 * q1 + q2 * q2);
        float rs = rsqrtf(ss * (1.f / 192.f) + 1e-6f);
        CQN[(long)t * 192 + lane] = f2bf(q0 * rs * w.q_norm[lane]);
        CQN[(long)t * 192 + 64 + lane] = f2bf(q1 * rs * w.q_norm[64 + lane]);
        CQN[(long)t * 192 + 128 + lane] = f2bf(q2 * rs * w.q_norm[128 + lane]);
        float k0 = bf2f(hr[O_DCKV + lane]), k1 = bf2f(hr[O_DCKV + 64 + lane]);
        ss = wave_sum(k0 * k0 + k1 * k1);
        rs = rsqrtf(ss * (1.f / 128.f) + 1e-6f);
        CKVN[(long)t * 128 + lane] = f2bf(k0 * rs * w.kv_norm[lane]);
        CKVN[(long)t * 128 + 64 + lane] = f2bf(k1 * rs * w.kv_norm[64 + lane]);
        {
            const int i = lane & 15, hd = lane >> 4;
            const int s = t & (SEQ - 1);
            const float2 csn = *(const float2*)(WSF(WS_ROPE) + (s * 16 + i) * 2); const float cs = csn.x, sn = csn.y;
            const float x1 = bf2f(hr[O_DKR + i]), x2 = bf2f(hr[O_DKR + 16 + i]);
            KM[(long)t * 384 + hd * 96 + 64 + i] = f2bf(x1 * cs - x2 * sn);
            KM[(long)t * 384 + hd * 96 + 80 + i] = f2bf(x1 * sn + x2 * cs);
        }
    }
}
DI void job_mla_up(const Params& p, const LayerW& w, int bid, int nblk, unsigned char* lds) {
    bf16_t* QB = WSB(WS_QB); bf16_t* KM = WSB(WS_KM); bf16_t* VM = WSB(WS_VM);
    constexpr int TM = T / G_BM;
    for (int u = bid; u < TM * 7; u += nblk) {
        const int mt = u / 7, nt = u % 7, m0 = mt * G_BM;
        f32x16 acc[2][2];
        const int l = tidx() & 63, wv = tidx() >> 6, wm = wv % G_WM, wn = wv / G_WM, hh = l >> 5;
        if (nt < 3) {
            MG g; g.A = WSB(WS_CQNB); g.lda = 192; g.Wt = w.t_uq; g.ldw = 192; g.K = 192;
            const int n0 = nt * 128;
            mgemm_tile(g, n0, RowId{m0}, acc, lds);
#pragma unroll
            for (int ft = 0; ft < 2; ++ft) {
                const int fb = (n0 + wn * 64 + ft * 32) >> 5;
                if (fb % 3 == 2) {
#pragma unroll
                    for (int tt = 0; tt < 2; ++tt) {
                        const int pos = (m0 + wm * 64 + tt * 32 + (l & 31)) & (SEQ - 1);
#pragma unroll
                        for (int i = 0; i < 2; ++i)
#pragma unroll
                            for (int j = 0; j < 4; ++j) {
                                const int fi = 8 * i + 4 * hh + j;
                                const float2 csn = *(const float2*)(WSF(WS_ROPE) + (pos * 16 + fi) * 2); const float cs = csn.x, sn = csn.y;
                                const float x1 = acc[ft][tt][4 * i + j], x2 = acc[ft][tt][4 * (i + 2) + j];
                                acc[ft][tt][4 * i + j] = x1 * cs - x2 * sn; acc[ft][tt][4 * (i + 2) + j] = x1 * sn + x2 * cs;
                            }
                    }
                }
            }
            MG_FOREACH(acc, lrow, feat, v, { st4bf(QB + (long)(m0 + lrow) * 384 + n0 + feat, v[0], v[1], v[2], v[3]); });
        } else {
            MG g; g.A = WSB(WS_CKVNB); g.lda = 128; g.Wt = w.t_ukv; g.ldw = 128; g.K = 128;
            const int n0 = (nt - 3) * 128;
            mgemm_tile(g, n0, RowId{m0}, acc, lds);
            MG_FOREACH(acc, lrow, feat, v, {
                const int hd = nt - 3;
                if (feat < 64) st4bf(KM + (long)(m0 + lrow) * 384 + hd * 96 + feat, v[0], v[1], v[2], v[3]);
                else st4bf(VM + (long)(m0 + lrow) * 256 + hd * 64 + (feat - 64), v[0], v[1], v[2], v[3]); });
        }
    }
}
template <int STAGE>
DI void job_cmp_mlp(const Params& p, const LayerW& w, int bid, int nblk, unsigned char* lds) {
    constexpr int TM = 2048 / G_BM, TN = STAGE == 0 ? 2 : 1;
    for (int u = bid; u < 2 * TM * TN; u += nblk) {
        const int j = u / (TM * TN), ru = u % (TM * TN), mt = ru / TN, nt = ru % TN, m0 = mt * G_BM, n0 = nt * 128;
        MG g;
        if (STAGE == 0) { g.A = WSB(WS_TBB) + (size_t)j * 2048 * 2048; g.lda = 2048; g.Wt = w.t_c1 + (size_t)j * 256 * 2048; g.ldw = 2048; g.K = 2048; }
        else { g.A = WSB(WS_HIDB) + (size_t)j * 2048 * 256; g.lda = 256; g.Wt = w.t_c2 + (size_t)j * 128 * 256; g.ldw = 256; g.K = 256; }
        f32x16 acc[2][2];
        mgemm_tile(g, n0, [&](int r) { const int rr = m0 + r; return (long)(rr < NCR ? rr : NCR - 1); }, acc, lds);
        if (STAGE == 0) {
            bf16_t* HID = WSB(WS_HIDB) + (size_t)j * 2048 * 256;
            MG_FOREACH(acc, lrow, feat, v, { st4bf(HID + (long)(m0 + lrow) * 256 + n0 + feat, gelu_tanh(v[0]), gelu_tanh(v[1]), gelu_tanh(v[2]), gelu_tanh(v[3])); });
        } else {
            bf16_t* KC = WSB(WS_KCB) + (size_t)j * NCR * 64;
            MG_FOREACH(acc, lrow, feat, v, { if (feat < 64 && m0 + lrow < NCR) st4bf(KC + (long)(m0 + lrow) * 64 + feat, v[0], v[1], v[2], v[3]); });
        }
    }
}
DI void job_router_logits(const Params& p, const LayerW& w, int bid, int nblk, unsigned char* lds) {
    float* LOG = WSF(WS_LOG);
    for (int u = bid; u < 3 * (T / G_BM); u += nblk) {
        const int pass = u / (T / G_BM), m0 = (u % (T / G_BM)) * G_BM;
        f32x16 acc[2][2];
        MG g; g.lda = 1024; g.ldw = 1024; g.K = 1024;
        g.A = pass == 1 ? WSB(WS_XBL) : WSB(WS_XBB); g.Wt = pass == 2 ? w.t_rl : w.t_rh;
        mgemm_tile(g, 0, RowId{m0}, acc, lds, true);
        float* dst = LOG + (size_t)pass * T * 36;
        MG_FOREACH(acc, lrow, feat, v, { if (feat < 36) *(float4*)(dst + (long)(m0 + lrow) * 36 + feat) = make_float4(v[0], v[1], v[2], v[3]); });
    }
}
DI void job_pack_small(const Params& p, int bid, int nblk) {
    bf16_t* TG = WSB(WT_G); bf16_t* RH = WSB(WT_RH); bf16_t* RL = WSB(WT_RL);
    for (int e = bid * NT + tidx(); e < SEQ * 16; e += nblk * NT) {
        const int i = e & 15, pos = e >> 4;
        const float inv = powf(10000.f, -(float)(2 * i) / 32.f);
        const float ang = (float)pos * inv;
        WSF(WS_ROPE)[e * 2] = cosf(ang); WSF(WS_ROPE)[e * 2 + 1] = sinf(ang);
    }
    for (int e = bid * NT + tidx(); e < DEPTH * 4 * 128 * 64; e += nblk * NT) {
        const int c = e & 63, q = (e >> 6) & 127, lb = e >> 13;
        const int seg = q >> 5, i = q & 31, chl = (seg >> 1) * 32 + i;
        const float* src = (seg & 1) ? p.in[10] : p.in[8];
        TG[e] = f2bf(src[((size_t)lb * 64 + c) * 64 + chl]);
    }
    for (int e = bid * NT + tidx(); e < DEPTH * 128 * 1024; e += nblk * NT) {
        const int k = e & 1023, n = (e >> 10) & 127, l = e >> 17;
        float v = 0.f;
        if (n < 4) v = p.in[26][((size_t)l * 1024 + k) * 4 + n];
        else if (n < 36) v = p.in[28][((size_t)l * 1024 + k) * 32 + (n - 4)];
        const bf16_t hi = f2bf(v);
        RH[e] = hi; RL[e] = f2bf(v - bf2f(hi));
    }
}

DI void job_merge(const Params& p, const LayerW& w, int bid, int nblk, unsigned char* lds) {
    const bf16_t* H = WSB(WS_H); bf16_t* M = WSB(WS_M);
    for (int u = bid; u < (T / G_BM) * 8; u += nblk) {
        const int m0 = (u >> 3) * G_BM, n0 = (u & 7) * G_BN;
        f32x16 macc[2][2];
#pragma unroll
        for (int a = 0; a < 2; ++a)
#pragma unroll
            for (int b = 0; b < 2; ++b)
#pragma unroll
                for (int i = 0; i < 16; ++i) macc[a][b][i] = 0.f;
        MG g; g.A = WSB(WS_BR); g.lda = 1024; g.Wt = w.t_br; g.ldw = 1024; g.K = 1024;
        f32x16 acc[2][2];
        const int l = tidx() & 63, wv = tidx() >> 6, wm = wv % G_WM, wn = wv / G_WM;
        mgemm_tile_f(g, n0, RowId{m0}, acc, lds, true, 4, [&](int n, f32x16 (&a)[2][2]) {
#pragma unroll
            for (int ft = 0; ft < 2; ++ft)
#pragma unroll
                for (int tt = 0; tt < 2; ++tt)
#pragma unroll
                    for (int i = 0; i < 4; ++i) {
                        const int lrow = wm * 64 + tt * 32 + (l & 31), feat = wn * 64 + ft * 32 + 8 * i + 4 * (l >> 5);
                        const float4 gv = ld4bf(H + (long)(m0 + lrow) * NH + O_MG + n * 1024 + n0 + feat);
                        macc[ft][tt][4 * i] += gv.x * a[ft][tt][4 * i]; macc[ft][tt][4 * i + 1] += gv.y * a[ft][tt][4 * i + 1];
                        macc[ft][tt][4 * i + 2] += gv.z * a[ft][tt][4 * i + 2]; macc[ft][tt][4 * i + 3] += gv.w * a[ft][tt][4 * i + 3];
                        a[ft][tt][4 * i] = 0.f; a[ft][tt][4 * i + 1] = 0.f; a[ft][tt][4 * i + 2] = 0.f; a[ft][tt][4 * i + 3] = 0.f;
                    }
        });
        MG_FOREACH(macc, lrow, feat, v, { st4bf(M + (long)(m0 + lrow) * 1024 + n0 + feat, v[0], v[1], v[2], v[3]); });
    }
}
DI void ld8f(const bf16_t* p, float* f) { const u32x4 v = *(const u32x4*)p; f[0] = bflo(v[0]); f[1] = bfhi(v[0]); f[2] = bflo(v[1]); f[3] = bfhi(v[1]); f[4] = bflo(v[2]); f[5] = bfhi(v[2]); f[6] = bflo(v[3]); f[7] = bfhi(v[3]); }
DI void st8bf(bf16_t* p, const float* f) { u32x4 v; v[0] = pk_bf16(f[0], f[1]); v[1] = pk_bf16(f[2], f[3]); v[2] = pk_bf16(f[4], f[5]); v[3] = pk_bf16(f[6], f[7]); *(u32x4*)p = v; }
DI void job_ln(const float* xin, const bf16_t* xinb, const bf16_t* xinl, const bf16_t* y, int ldy, const bf16_t* y2, const float* gw, const float* bw, float* out, bf16_t* outb, bf16_t* outl, int bid, int nblk) {
    const int lane = tidx() & 63, wid = tidx() >> 6;
    float gv[16], bv[16];
#pragma unroll
    for (int i = 0; i < 2; ++i)
#pragma unroll
        for (int j = 0; j < 8; j += 4) { const int c = i * 512 + lane * 8 + j; const float4 g4 = *(const float4*)(gw + c), b4 = *(const float4*)(bw + c);
            gv[i * 8 + j] = g4.x; gv[i * 8 + j + 1] = g4.y; gv[i * 8 + j + 2] = g4.z; gv[i * 8 + j + 3] = g4.w; bv[i * 8 + j] = b4.x; bv[i * 8 + j + 1] = b4.y; bv[i * 8 + j + 2] = b4.z; bv[i * 8 + j + 3] = b4.w; }
    for (int t = bid * (NT / 64) + wid; t < T; t += nblk * (NT / 64)) {
        float v[16];
        float s = 0.f;
#pragma unroll
        for (int i = 0; i < 2; ++i) {
            const int c = i * 512 + lane * 8;
            float xv[8], yv[8];
            if (xin) { const float4 a = *(const float4*)(xin + (long)t * 1024 + c), b = *(const float4*)(xin + (long)t * 1024 + c + 4);
                xv[0] = a.x; xv[1] = a.y; xv[2] = a.z; xv[3] = a.w; xv[4] = b.x; xv[5] = b.y; xv[6] = b.z; xv[7] = b.w; }
            else ld8f(xinb + (long)t * 1024 + c, xv);
            if (xinl) { float z[8]; ld8f(xinl + (long)t * 1024 + c, z);
#pragma unroll
                for (int j = 0; j < 8; ++j) xv[j] += z[j]; }
            ld8f(y + (long)t * ldy + c, yv);
            if (y2) { float z[8]; ld8f(y2 + (long)t * ldy + c, z);
#pragma unroll
                for (int j = 0; j < 8; ++j) yv[j] += z[j]; }
#pragma unroll
            for (int j = 0; j < 8; ++j) { v[i * 8 + j] = DN_ALPHA * xv[j] + yv[j]; s += v[i * 8 + j]; }
        }
        const float mu = wave_sum(s) * (1.f / 1024.f);
        float q = 0.f;
#pragma unroll
        for (int i = 0; i < 16; ++i) { const float dlt = v[i] - mu; q += dlt * dlt; }
        const float rstd = rsqrtf(wave_sum(q) * (1.f / 1024.f) + 1e-5f);
#pragma unroll
        for (int i = 0; i < 2; ++i) {
            const int c = i * 512 + lane * 8;
            float o[8];
#pragma unroll
            for (int j = 0; j < 8; ++j) o[j] = (v[i * 8 + j] - mu) * rstd * gv[i * 8 + j] + bv[i * 8 + j];
            if (out) { *(float4*)(out + (long)t * 1024 + c) = make_float4(o[0], o[1], o[2], o[3]); *(float4*)(out + (long)t * 1024 + c + 4) = make_float4(o[4], o[5], o[6], o[7]); }
            if (outb) st8bf(outb + (long)t * 1024 + c, o);
            if (outl) { float lo[8];
#pragma unroll
                for (int j = 0; j < 8; ++j) lo[j] = o[j] - bf2f(f2bf(o[j]));
                st8bf(outl + (long)t * 1024 + c, lo); }
        }
    }
}
DI void job_router(const Params& p, const LayerW& w, int layer, int bid, int nblk) {
    const float* LOG = WSF(WS_LOG); int* EIDX = WSI(WS_EIDX); int* ESLOT = WSI(WS_ESLOT); float* EW = WSF(WS_EW);
    unsigned* cnt = WSU(WS_CTL) + CW_CNT + layer * 32;
    for (int t = bid * NT + tidx(); t < T; t += nblk * NT) {
        const float* lr = LOG + (long)t * 36; const float* lr1 = lr + (size_t)T * 36; const float* lr2 = lr1 + (size_t)T * 36;
#define LG(i) ((lr[i] + lr1[i]) + lr2[i])
        const float g0 = LG(0) + w.rg_b[0], g1 = LG(1) + w.rg_b[1], g2 = LG(2) + w.rg_b[2], g3 = LG(3) + w.rg_b[3];
        const float gm = fmaxf(fmaxf(g0, g1), fmaxf(g2, g3));
        const float e0 = expf(g0 - gm), e1 = expf(g1 - gm), e2 = expf(g2 - gm), e3 = expf(g3 - gm);
        const float gs = (e0 + e1) + (e2 + e3);
        const float p0 = e0 / gs, p1 = e1 / gs, p2 = e2 / gs, p3 = e3 / gs;
        int grp = 0; float pg = p0;
        if (p1 > pg) { pg = p1; grp = 1; }
        if (p2 > pg) { pg = p2; grp = 2; }
        if (p3 > pg) { pg = p3; grp = 3; }
        float el[8];
#pragma unroll
        for (int i = 0; i < 8; ++i) el[i] = LG(4 + grp * 8 + i) + w.re_b[grp * 8 + i];
#undef LG
        float em = el[0];
#pragma unroll
        for (int i = 1; i < 8; ++i) em = fmaxf(em, el[i]);
        float es = 0.f;
#pragma unroll
        for (int i = 0; i < 8; ++i) { el[i] = expf(el[i] - em); es += el[i]; }
#pragma unroll
        for (int i = 0; i < 8; ++i) el[i] = el[i] / es;
        float b0 = el[0]; int i0 = 0;
#pragma unroll
        for (int i = 1; i < 8; ++i) if (el[i] > b0) { b0 = el[i]; i0 = i; }
        float b1 = -1.f; int i1 = 0;
#pragma unroll
        for (int i = 0; i < 8; ++i) if (i != i0 && el[i] > b1) { b1 = el[i]; i1 = i; }
        const float den = b0 + b1;
        const int ex0 = grp * 8 + i0, ex1 = grp * 8 + i1;
        EIDX[t * 2] = ex0; EIDX[t * 2 + 1] = ex1;
        EW[t * 2] = pg * b0 / den; EW[t * 2 + 1] = pg * b1 / den;
        ESLOT[t * 2] = (int)atomicAdd(&cnt[ex0], 1u);
        ESLOT[t * 2 + 1] = (int)atomicAdd(&cnt[ex1], 1u);
    }
}
DI int pad_rows(int c) { return (c + G_BM - 1) / G_BM * G_BM; }
DI void job_fill(const Params& p, int layer, int bid, int nblk, unsigned char* lds) {
    const int* EIDX = WSI(WS_EIDX); const int* ESLOT = WSI(WS_ESLOT); int* PERM = WSI(WS_PERM);
    const bf16_t* X2 = WSB(WS_XBB); bf16_t* XG = WSB(WS_XG);
    unsigned* cnt = WSU(WS_CTL) + CW_CNT + layer * 32;
    const int lane = tidx() & 63, wid = tidx() >> 6;
    int* s_off = (int*)lds; int* s_cnt = s_off + 32;
    __syncthreads();
    if (tidx() < 32) s_cnt[tidx()] = (int)__hip_atomic_load(&cnt[tidx()], __ATOMIC_RELAXED, __HIP_MEMORY_SCOPE_AGENT);
    __syncthreads();
    if (tidx() == 0) { int o = 0; for (int e = 0; e < 32; ++e) { s_off[e] = o; o += pad_rows(s_cnt[e]); } }
    __syncthreads();
    for (int a = bid * (NT / 64) + wid; a < NASSIGN + NEXP; a += nblk * (NT / 64)) {
        const bool real = a < NASSIGN;
        const int e = real ? EIDX[a] : a - NASSIGN;
        const int off = s_off[e];
        if (real) {
            const int R = off + ESLOT[a];
            if (lane == 0) PERM[R] = a;
            const u32x4* src = (const u32x4*)(X2 + (long)(a >> 1) * 1024); u32x4* dst = (u32x4*)(XG + (long)R * 1024);
            dst[lane] = src[lane]; dst[lane + 64] = src[lane + 64];
        } else {
            const int c = s_cnt[e];
            for (int j = lane; c + j < pad_rows(c); j += 64) PERM[off + c + j] = -1;
        }
    }
}
DI pg8::ListOrder moe_units(unsigned* cnt, int bid, int nblk) {
    pg8::ListOrder S; S.n = 0; S.u0 = S.u1 = S.u2 = pg8::Unit{0, 0, 0};
    int rt = 0, ub = 0;
    for (int e = 0; e < 32; ++e) {
        const int c = pad_rows((int)__hip_atomic_load(&cnt[e], __ATOMIC_RELAXED, __HIP_MEMORY_SCOPE_AGENT)) >> 8, ue = c * 4;
#pragma unroll
        for (int k = 0; k < 3; ++k) {
            const int L = bid + k * nblk;
            if (L >= ub && L < ub + ue) { const int lu = L - ub; const pg8::Unit u{rt + (lu >> 2), lu & 3, e};
                if (k == 0) S.u0 = u; else if (k == 1) S.u1 = u; else S.u2 = u;
                S.n = k + 1; }
        }
        rt += c; ub += ue;
    }
#define RFL(x) x = __builtin_amdgcn_readfirstlane(x)
    RFL(S.n); RFL(S.u0.pm); RFL(S.u0.pn); RFL(S.u0.e); RFL(S.u1.pm); RFL(S.u1.pn); RFL(S.u1.e); RFL(S.u2.pm); RFL(S.u2.pn); RFL(S.u2.e);
#undef RFL
    return S;
}
typedef short s16x4 __attribute__((ext_vector_type(4)));
typedef short v4i16_t __attribute__((ext_vector_type(4)));
DI unsigned cvtpk(float lo, float hi) { return pk_bf16(lo, hi); }
DI int crow(int reg, int h) { return (reg & 3) + 8 * (reg >> 2) + 4 * h; }
DI s16x4 tr_read(const unsigned char* p) { return __builtin_bit_cast(s16x4, __builtin_amdgcn_ds_read_tr16_b64_v4i16((LAS v4i16_t*)p)); }
DI float xhalf_max(float m) { auto rr = __builtin_amdgcn_permlane32_swap(__float_as_uint(m), __float_as_uint(m), false, false); return fmaxf(__uint_as_float(rr[0]), __uint_as_float(rr[1])); }
DI float xhalf_sum(float m) { auto rr = __builtin_amdgcn_permlane32_swap(__float_as_uint(m), __float_as_uint(m), false, false); return __uint_as_float(rr[0]) + __uint_as_float(rr[1]); }
DI float xhalf_other(float v, int h) { auto rr = __builtin_amdgcn_permlane32_swap(__float_as_uint(v), __float_as_uint(v), false, false); return __uint_as_float(h ? rr[0] : rr[1]); }
DI bf16x8 pack8(const f32x16& x, int s2) {
    u32x4 pk; pk[0] = cvtpk(x[8 * s2], x[8 * s2 + 1]); pk[1] = cvtpk(x[8 * s2 + 2], x[8 * s2 + 3]); pk[2] = cvtpk(x[8 * s2 + 4], x[8 * s2 + 5]); pk[3] = cvtpk(x[8 * s2 + 6], x[8 * s2 + 7]);
    return __builtin_bit_cast(bf16x8, pk);
}
constexpr int ATT_QB = (NT / 64) * 32;
template <int DC> struct TileCfg { static constexpr int RS = DC * 2 + 16, BYTES = 64 * RS, NCH = 64 * DC / 8, NI = (NCH + NT - 1) / NT; };
template <int DC, class RowPtr> DI void tile_gload(u32x4 (&rg)[TileCfg<DC>::NI], RowPtr rp) {
#pragma unroll
    for (int i = 0; i < TileCfg<DC>::NI; ++i) { const int c = tidx() + NT * i; if (c < TileCfg<DC>::NCH) { const int row = c / (DC / 8), cc = c % (DC / 8); rg[i] = *(const u32x4*)(rp(row) + cc * 8); } }
}
template <int DC> DI void tile_lstore(const u32x4 (&rg)[TileCfg<DC>::NI], unsigned char* base) {
#pragma unroll
    for (int i = 0; i < TileCfg<DC>::NI; ++i) { const int c = tidx() + NT * i; if (c < TileCfg<DC>::NCH) { const int row = c / (DC / 8), cc = c % (DC / 8); *(u32x4*)(base + row * TileCfg<DC>::RS + cc * 16) = rg[i]; } }
}
template <int DK> DI void qk_tile(f32x16 (&s)[2], const bf16x8 (&qf)[DK / 16], const unsigned char* kl, int r, int h) {
    constexpr int RS = TileCfg<DK>::RS;
#pragma unroll
    for (int i = 0; i < 16; ++i) { s[0][i] = 0.f; s[1][i] = 0.f; }
#pragma unroll
    for (int ks = 0; ks < DK / 16; ++ks) {
        const bf16x8 k0 = *(const bf16x8*)(kl + r * RS + ks * 32 + h * 16), k1 = *(const bf16x8*)(kl + (32 + r) * RS + ks * 32 + h * 16);
        s[0] = __builtin_amdgcn_mfma_f32_32x32x16_bf16(k0, qf[ks], s[0], 0, 0, 0);
        s[1] = __builtin_amdgcn_mfma_f32_32x32x16_bf16(k1, qf[ks], s[1], 0, 0, 0);
    }
}
template <int DV> DI void pv_tile(f32x16 (&o)[DV / 32], const f32x16 (&pp)[2], const unsigned char* vl, int lane) {
    constexpr int RS = TileCfg<DV>::RS;
    const int h = lane >> 5, i16 = lane & 15, q = i16 >> 2, pq = i16 & 3, blk = (lane >> 4) & 1;
    const unsigned char* vb = vl + (4 * h + q) * RS + 2 * (16 * blk + 4 * pq);
#pragma unroll
    for (int kt = 0; kt < 2; ++kt)
#pragma unroll
        for (int s2 = 0; s2 < 2; ++s2) {
            const bf16x8 pf = pack8(pp[kt], s2);
#pragma unroll
            for (int dvt = 0; dvt < DV / 32; ++dvt) {
                const s16x4 lo = tr_read(vb + (kt * 32 + 16 * s2) * RS + dvt * 64), hi = tr_read(vb + (kt * 32 + 16 * s2 + 8) * RS + dvt * 64);
                const bf16x8 vf = __builtin_shufflevector(lo, hi, 0, 1, 2, 3, 4, 5, 6, 7);
                o[dvt] = __builtin_amdgcn_mfma_f32_32x32x16_bf16(vf, pf, o[dvt], 0, 0, 0);
            }
        }
}
constexpr float LOG2E = 1.4426950408889634f;
template <int DK, int DV, bool ALIBI, bool BOUNDARY, class ValidFn>
DI void softmax_tile(const bf16x8 (&qf)[DK / 16], f32x16 (&o)[DV / 32], float& m, float& l, const unsigned char* kl, const unsigned char* vl, int kb,
                     float c1, float sl2, int qpos, ValidFn valid, int lane) {
    const int r = lane & 31, h = lane >> 5;
    f32x16 s[2];
    qk_tile<DK>(s, qf, kl, r, h);
    const float base = ALIBI ? sl2 * (float)(kb + 4 * h - qpos) : 0.f;
    float tmax = -INFINITY;
#pragma unroll
    for (int kt = 0; kt < 2; ++kt)
#pragma unroll
        for (int i = 0; i < 16; ++i) {
            float v = ALIBI ? fmaf(s[kt][i], c1, fmaf(sl2, (float)(kt * 32 + (i & 3) + 8 * (i >> 2)), base)) : s[kt][i] * c1;
            if (BOUNDARY) v = valid(kb + kt * 32 + crow(i, h)) ? v : -INFINITY;
            s[kt][i] = v; tmax = fmaxf(tmax, v);
        }
    tmax = xhalf_max(tmax);
    const float mn = fmaxf(m, tmax);
    if (__any(mn > m)) {
        const float corr = __builtin_amdgcn_exp2f(m - mn);
        l *= corr;
#pragma unroll
        for (int dvt = 0; dvt < DV / 32; ++dvt)
#pragma unroll
            for (int i = 0; i < 16; ++i) o[dvt][i] *= corr;
        m = mn;
    }
    float ps = 0.f;
#pragma unroll
    for (int kt = 0; kt < 2; ++kt)
#pragma unroll
        for (int i = 0; i < 16; ++i) { const float pr = __builtin_amdgcn_exp2f(s[kt][i] - mn); s[kt][i] = pr; ps += pr; }
    l += ps;
    pv_tile<DV>(o, s, vl, lane);
}
template <int DK, int DV, bool ALIBI, class KPtr, class VPtr, class ValidFn, class InteriorFn>
DI void attn_stream(const bf16x8 (&qf)[DK / 16], f32x16 (&o)[DV / 32], float& m, float& l, unsigned tmask, int wave_qmax, int wave_kmin,
                    KPtr kp, VPtr vp, float c1, float sl2, int qpos, ValidFn valid, InteriorFn interior, unsigned char* lds) {
    unsigned char* kl = lds; unsigned char* vl = lds + TileCfg<DK>::BYTES;
    const int lane = tidx() & 63;
    u32x4 kA[TileCfg<DK>::NI], vA[TileCfg<DV>::NI], kB[TileCfg<DK>::NI], vB[TileCfg<DV>::NI];
    int ja = -1, jb = -1;
#define AS_NEXT(J, KR, VR) do { if (tmask) { J = __builtin_ctz(tmask); tmask &= tmask - 1; const int _j = J; \
        tile_gload<DK>(KR, [&](int row) { return kp(_j * 64 + row); }); tile_gload<DV>(VR, [&](int row) { return vp(_j * 64 + row); }); } else J = -1; } while (0)
#define AS_COMPUTE(J) do { const int _jc = (J); if (_jc * 64 <= wave_qmax && _jc * 64 + 63 >= wave_kmin) { \
        if (interior(_jc)) softmax_tile<DK, DV, ALIBI, false>(qf, o, m, l, kl, vl, _jc * 64, c1, sl2, qpos, valid, lane); \
        else softmax_tile<DK, DV, ALIBI, true>(qf, o, m, l, kl, vl, _jc * 64, c1, sl2, qpos, valid, lane); } } while (0)
    AS_NEXT(ja, kA, vA);
    AS_NEXT(jb, kB, vB);
    while (ja >= 0) {
        __syncthreads();
        tile_lstore<DK>(kA, kl); tile_lstore<DV>(vA, vl);
        __syncthreads();
        const int jc = ja;
        AS_NEXT(ja, kA, vA);
        AS_COMPUTE(jc);
        if (jb < 0) break;
        __syncthreads();
        tile_lstore<DK>(kB, kl); tile_lstore<DV>(vB, vl);
        __syncthreads();
        const int jd = jb;
        AS_NEXT(jb, kB, vB);
        AS_COMPUTE(jd);
    }
#undef AS_NEXT
#undef AS_COMPUTE
}

DI void job_mla_attn(const Params& p, int bid, int nblk, unsigned char* lds) {
    const bf16_t* QB = WSB(WS_QB); const bf16_t* KM = WSB(WS_KM); const bf16_t* VM = WSB(WS_VM); bf16_t* BR = WSB(WS_BR);
    constexpr int NQB = SEQ / ATT_QB, NU = BATCH * 4 * NQB;
    const int lane = tidx() & 63, wid = tidx() >> 6, r = lane & 31, h = lane >> 5;
    for (int u = bid; u < NU; u += nblk) {
        const int qblk = u / (BATCH * 4), bh = u % (BATCH * 4);
        const int b = bh >> 2, hd = bh & 3;
        const int q0 = qblk * ATT_QB, qw = q0 + wid * 32, qpos = qw + r;
        const long trow = (long)b * SEQ;
        bf16x8 qf[6];
#pragma unroll
        for (int ks = 0; ks < 6; ++ks) qf[ks] = *(const bf16x8*)(QB + (trow + qpos) * 384 + hd * 96 + ks * 16 + 8 * h);
        f32x16 o[2];
#pragma unroll
        for (int i = 0; i < 16; ++i) { o[0][i] = 0.f; o[1][i] = 0.f; }
        float m = -1e30f, l = 0.f;
        const int ntile = (q0 + ATT_QB - 1) / 64 + 1;
        const unsigned tmask = ntile >= 32 ? 0xffffffffu : ((1u << ntile) - 1u);
        attn_stream<96, 64, false>(qf, o, m, l, tmask, qw + 31, 0,
            [&](int row) { return KM + (trow + row) * 384 + hd * 96; },
            [&](int row) { return VM + (trow + row) * 256 + hd * 64; },
            0.10206207261596577f * LOG2E, 0.f, qpos,
            [&](int key) { return key <= qpos; }, [&](int j) { return j * 64 + 63 <= qw; }, lds);
        const float rl = 1.f / fmaxf(xhalf_sum(l), 1e-30f);
        bf16_t* dst = BR + (trow + qpos) * 1024 + 3 * 256 + hd * 64;
#pragma unroll
        for (int dvt = 0; dvt < 2; ++dvt)
#pragma unroll
            for (int i = 0; i < 4; ++i)
                st4bf(dst + dvt * 32 + 8 * i + 4 * h, o[dvt][4 * i] * rl, o[dvt][4 * i + 1] * rl, o[dvt][4 * i + 2] * rl, o[dvt][4 * i + 3] * rl);
    }
}
DI void job_cross_attn(const Params& p, int layer, int bid, int nblk, unsigned char* lds) {
    const bf16_t* XQ = WSB(WS_XQ); const bf16_t* KVM = WSB(WS_KVM) + (size_t)layer * 2048 * 1024; bf16_t* XO = WSB(WS_XO);
    constexpr int NQB = SEQ / ATT_QB, NU = BATCH * 4 * NQB;
    const int lane = tidx() & 63, wid = tidx() >> 6, r = lane & 31, h = lane >> 5;
    for (int u = bid; u < NU; u += nblk) {
        const int bh = u % (BATCH * 4), qblk = u / (BATCH * 4);
        const int b = bh >> 2, hd = bh & 3;
        const int qpos = qblk * ATT_QB + wid * 32 + r;
        const long trow = (long)b * SEQ;
        bf16x8 qf[8];
#pragma unroll
        for (int ks = 0; ks < 8; ++ks) qf[ks] = *(const bf16x8*)(XQ + (trow + qpos) * 512 + hd * 128 + ks * 16 + 8 * h);
        f32x16 o[4];
#pragma unroll
        for (int d = 0; d < 4; ++d)
#pragma unroll
            for (int i = 0; i < 16; ++i) o[d][i] = 0.f;
        float m = -1e30f, l = 0.f;
        attn_stream<128, 128, false>(qf, o, m, l, 0xFu, 1 << 30, 0,
            [&](int row) { return KVM + (long)(b * MEM_LEN + row) * 1024 + hd * 128; },
            [&](int row) { return KVM + (long)(b * MEM_LEN + row) * 1024 + 512 + hd * 128; },
            0.08838834764831845f * LOG2E, 0.f, qpos, [&](int) { return true; }, [&](int) { return true; }, lds);
        const float rl = 1.f / fmaxf(xhalf_sum(l), 1e-30f);
        bf16_t* dst = XO + (trow + qpos) * 512 + hd * 128;
#pragma unroll
        for (int dvt = 0; dvt < 4; ++dvt)
#pragma unroll
            for (int i = 0; i < 4; ++i)
                st4bf(dst + dvt * 32 + 8 * i + 4 * h, o[dvt][4 * i] * rl, o[dvt][4 * i + 1] * rl, o[dvt][4 * i + 2] * rl, o[dvt][4 * i + 3] * rl);
    }
}
DI float logsig_fast(float z) { return fminf(z, 0.f) - __logf(1.f + __expf(-fabsf(z))); }
DI void job_sb_attn(const Params& p, int bid, int nblk, unsigned char* lds) {
    const bf16_t* H = WSB(WS_H); bf16_t* BR = WSB(WS_BR);
    constexpr int NQB = SEQ / ATT_QB, NU = BATCH * 4 * NQB;
    const int lane = tidx() & 63, wid = tidx() >> 6, r = lane & 31, h = lane >> 5;
    unsigned char* kl = lds; unsigned char* vl = lds + TileCfg<64>::BYTES;
    for (int u = bid; u < NU; u += nblk) {
        const int half = u / (NU / 2), ru = u % (NU / 2);
        const int qi = ru / (BATCH * 4), bh = ru % (BATCH * 4);
        const int qblk = half == 0 ? (NQB - 1 - qi) : qi;
        const int b = bh >> 2, hd = bh & 3;
        const int q0 = qblk * ATT_QB, qw = q0 + wid * 32, qpos = qw + r;
        const long trow = (long)b * SEQ;
        bf16x8 qf[4];
#pragma unroll
        for (int ks = 0; ks < 4; ++ks) qf[ks] = *(const bf16x8*)(H + (trow + qpos) * NH + O_BQ + hd * 64 + ks * 16 + 8 * h);
        f32x16 o[2];
#pragma unroll
        for (int i = 0; i < 16; ++i) { o[0][i] = 0.f; o[1][i] = 0.f; }
        float trun = 0.f;
        int j = (q0 + ATT_QB - 1) >> 6;
        volatile int* flag = (volatile int*)(lds + 2 * TileCfg<64>::BYTES);
        if (tidx() == 0) { flag[0] = 0; flag[1] = 0; }
        u32x4 kr[TileCfg<64>::NI], vr[TileCfg<64>::NI];
        tile_gload<64>(kr, [&](int row) { return H + (trow + j * 64 + row) * NH + O_BK + hd * 64; });
        tile_gload<64>(vr, [&](int row) { return H + (trow + j * 64 + row) * NH + O_BV + hd * 64; });
        for (int it = 0; j >= 0; --j, ++it) {
            __syncthreads();
            if (it > 0 && flag[(it - 1) & 1] == 0) break;
            tile_lstore<64>(kr, kl); tile_lstore<64>(vr, vl);
            __syncthreads();
            if (tidx() == 0) flag[(it + 1) & 1] = 0;
            if (j > 0) { const int jn = j - 1;
                tile_gload<64>(kr, [&](int row) { return H + (trow + jn * 64 + row) * NH + O_BK + hd * 64; });
                tile_gload<64>(vr, [&](int row) { return H + (trow + jn * 64 + row) * NH + O_BV + hd * 64; }); }
            const bool wave_dead = __all(trun < -110.f);
            if (j * 64 < qw + 31 && !wave_dead) {
                const int kb = j * 64;
                f32x16 s[2], L[2];
                qk_tile<64>(s, qf, kl, r, h);
#pragma unroll
                for (int kt = 0; kt < 2; ++kt)
#pragma unroll
                    for (int i = 0; i < 16; ++i) {
                        const int key = kb + kt * 32 + crow(i, h);
                        const float z = s[kt][i] * 0.125f, lsp = logsig_fast(z);
                        const bool valid = key < qpos;
                        L[kt][i] = valid ? lsp - z : 0.f;
                        s[kt][i] = valid ? lsp : -INFINITY;
                    }
                float G[2][4], O[2][4];
#pragma unroll
                for (int kt = 0; kt < 2; ++kt)
#pragma unroll
                    for (int ig = 0; ig < 4; ++ig) { G[kt][ig] = (L[kt][4 * ig] + L[kt][4 * ig + 1]) + (L[kt][4 * ig + 2] + L[kt][4 * ig + 3]); O[kt][ig] = xhalf_other(G[kt][ig], h); }
                float run = trun;
#pragma unroll
                for (int kt = 1; kt >= 0; --kt)
#pragma unroll
                    for (int ig = 3; ig >= 0; --ig) {
                        const float t3 = run + (h == 0 ? O[kt][ig] : 0.f);
                        const float t2 = t3 + L[kt][4 * ig + 3], t1 = t2 + L[kt][4 * ig + 2], t0 = t1 + L[kt][4 * ig + 1];
                        s[kt][4 * ig + 3] = __expf(s[kt][4 * ig + 3] + t3); s[kt][4 * ig + 2] = __expf(s[kt][4 * ig + 2] + t2);
                        s[kt][4 * ig + 1] = __expf(s[kt][4 * ig + 1] + t1); s[kt][4 * ig + 0] = __expf(s[kt][4 * ig + 0] + t0);
                        run += G[kt][ig] + O[kt][ig];
                    }
                trun = run;
                pv_tile<64>(o, s, vl, lane);
            }
            if (!__all(trun < -110.f)) flag[it & 1] = 1;
        }
        bf16_t* dst = BR + (trow + qpos) * 1024 + 1 * 256 + hd * 64;
#pragma unroll
        for (int dvt = 0; dvt < 2; ++dvt)
#pragma unroll
            for (int i = 0; i < 4; ++i) st4bf(dst + dvt * 32 + 8 * i + 4 * h, o[dvt][4 * i], o[dvt][4 * i + 1], o[dvt][4 * i + 2], o[dvt][4 * i + 3]);
    }
}
constexpr int NSA_QB = (NT / 128) * 32;
DI void job_nsa(const Params& p, int bid, int nblk, unsigned char* lds) {
    const bf16_t* H = WSB(WS_H); const bf16_t* KCB = WSB(WS_KCB); const bf16_t* VCB = KCB + (size_t)NCR * 64;
    float* OACC = WSF(WS_OC); bf16_t* BR = WSB(WS_BR);
    constexpr int NQB = SEQ / NSA_QB, NU = BATCH * 2 * NQB;
    constexpr int TB_ = TileCfg<64>::BYTES;
    const int lane = tidx() & 63, wid = tidx() >> 6, r = lane & 31, h = lane >> 5;
    const int n = wid & 1, sub = wid >> 1;
    unsigned* orw = (unsigned*)(lds + 4 * TB_);
    float* impx = (float*)(lds + 4 * TB_ + 64);
    for (int u = bid; u < NU; u += nblk) {
        const int qblk = NQB - 1 - u / (BATCH * 2), bg = u % (BATCH * 2), b = bg >> 1, g = bg & 1;
        const int q0 = qblk * NSA_QB, qw = q0 + sub * 32, qpos = qw + r;
        const int head = g * 2 + n;
        const long trow = (long)b * SEQ;
        const bf16_t* hq_row = H + (trow + qpos) * NH;
        bf16x8 qf[1][4];
#pragma unroll
        for (int ks = 0; ks < 4; ++ks) qf[0][ks] = *(const bf16x8*)(hq_row + O_AQ + head * 64 + ks * 16 + 8 * h);
        const float sl = exp2f(-2.f * (float)(head + 1));
        const float gate0 = sigm(bf2f(hq_row[O_AG + head * 3 + 0])), gate1 = sigm(bf2f(hq_row[O_AG + head * 3 + 1])), gate2 = sigm(bf2f(hq_row[O_AG + head * 3 + 2]));
        float* oacc = OACC + (trow + qpos) * 256 + head * 64;
        __syncthreads();
        if (tidx() == 0) *orw = 0u;
        {
            u32x4 rg[TileCfg<64>::NI];
#pragma unroll
            for (int tl = 0; tl < 4; ++tl) {
                const bf16_t* src = (tl & 2) ? VCB : KCB; const int cb = (tl & 1) * 64;
                tile_gload<64>(rg, [&](int row) { const int c = cb + row < NCMP ? cb + row : NCMP - 1; return src + ((long)(b * NCMP + c) * 2 + g) * 64; });
                tile_lstore<64>(rg, lds + tl * TB_);
            }
        }
        __syncthreads();
        float imp[16];
        {
            f32x16 s[2][2];
            qk_tile<64>(s[0], qf[0], lds, r, h);
            qk_tile<64>(s[1], qf[0], lds + TB_, r, h);
            float tmax = -INFINITY;
#pragma unroll
            for (int tl = 0; tl < 2; ++tl)
#pragma unroll
                for (int kt = 0; kt < 2; ++kt)
#pragma unroll
                    for (int i = 0; i < 16; ++i) {
                        const int c = tl * 64 + kt * 32 + crow(i, h), dist = qpos - (16 * c + 31);
                        const float v = (c < NCMP && dist >= 0) ? s[tl][kt][i] * 0.125f - sl * (float)dist : -INFINITY;
                        s[tl][kt][i] = v; tmax = fmaxf(tmax, v);
                    }
            const float mn = fmaxf(xhalf_max(tmax), -1e30f);
            float ps = 0.f;
#pragma unroll
            for (int tl = 0; tl < 2; ++tl)
#pragma unroll
                for (int kt = 0; kt < 2; ++kt)
#pragma unroll
                    for (int i = 0; i < 16; ++i) { const float pr = __expf(s[tl][kt][i] - mn); s[tl][kt][i] = pr; ps += pr; }
            const float rl = 1.f / fmaxf(xhalf_sum(ps), 1e-30f);
            float P3[16];
#pragma unroll
            for (int tl = 0; tl < 2; ++tl)
#pragma unroll
                for (int kt = 0; kt < 2; ++kt) {
#pragma unroll
                    for (int ig = 0; ig < 4; ++ig) {
                        const float p0 = s[tl][kt][4 * ig] * rl, p1 = s[tl][kt][4 * ig + 1] * rl, p2 = s[tl][kt][4 * ig + 2] * rl, p3 = s[tl][kt][4 * ig + 3] * rl;
                        imp[tl * 8 + kt * 4 + ig] = (p0 + p1) + (p2 + 0.5f * p3);
                        P3[tl * 8 + kt * 4 + ig] = 0.5f * p3;
                    }
                    const float gs = rl * gate0;
#pragma unroll
                    for (int i = 0; i < 16; ++i) s[tl][kt][i] *= gs;
                }
#pragma unroll
            for (int idx = 0; idx < 16; ++idx) {
                const float pp = xhalf_other(P3[idx], h);
                float prevp;
                if (idx == 0) prevp = h ? pp : 0.f; else { const float ppm = xhalf_other(P3[idx - 1], h); prevp = h ? pp : ppm; }
                imp[idx] += prevp;
                impx[(wid * 16 + idx) * 64 + lane] = imp[idx];
            }
            f32x16 oc[2];
#pragma unroll
            for (int i = 0; i < 16; ++i) { oc[0][i] = 0.f; oc[1][i] = 0.f; }
            pv_tile<64>(oc, s[0], lds + 2 * TB_, lane);
            pv_tile<64>(oc, s[1], lds + 3 * TB_, lane);
#pragma unroll
            for (int dvt = 0; dvt < 2; ++dvt)
#pragma unroll
                for (int i = 0; i < 4; ++i) *(float4*)(oacc + dvt * 32 + 8 * i + 4 * h) = make_float4(oc[dvt][4 * i], oc[dvt][4 * i + 1], oc[dvt][4 * i + 2], oc[dvt][4 * i + 3]);
        }
        __syncthreads();
        unsigned sel = 0u;
        {
            const int cur = qpos >> 6;
#pragma unroll
            for (int idx = 0; idx < 16; ++idx) {
                const float other = impx[((wid ^ 1) * 16 + idx) * 64 + lane];
                const float tot = n == 0 ? imp[idx] + other : other + imp[idx];
                const int j = 2 * idx + h;
                const bool forced = (j == 0) || (j == cur), valid = (j * 64 <= qpos);
                imp[idx] = forced ? 1e4f : (valid ? tot : -1.0f);
            }
#pragma unroll 1
            for (int it = 0; it < 8; ++it) {
                float best = -INFINITY; int bj = 64;
#pragma unroll
                for (int idx = 0; idx < 16; ++idx) if (imp[idx] > best) { best = imp[idx]; bj = 2 * idx + h; }
                const float pb = xhalf_other(best, h); const int pj = __float_as_int(xhalf_other(__int_as_float(bj), h));
                const bool own = (best > pb) || (best == pb && bj < pj);
                const int wj = own ? bj : pj;
                sel |= 1u << wj;
#pragma unroll
                for (int idx = 0; idx < 16; ++idx) if (2 * idx + h == wj) imp[idx] = -INFINITY;
            }
        }
        atomicOr(orw, sel);
        __syncthreads();
        const unsigned bmask = *orw;
        const int jhi = (q0 + NSA_QB - 1) >> 6;
        const unsigned upto = jhi >= 31 ? 0xffffffffu : ((1u << (jhi + 1)) - 1u);
        const float c1 = 0.125f * LOG2E, sl2 = sl * LOG2E;
        {
            f32x16 o[2];
#pragma unroll
            for (int i = 0; i < 16; ++i) { o[0][i] = 0.f; o[1][i] = 0.f; }
            float m = -1e30f, l = 0.f;
            const int jlo = (q0 - 511 > 0 ? q0 - 511 : 0) >> 6;
            const unsigned tmask = upto & ~((1u << jlo) - 1u);
            attn_stream<64, 64, true>(qf[0], o, m, l, tmask, qw + 31, qw - 511,
                [&](int row) { return H + (trow + row) * NH + O_AKW + g * 64; },
                [&](int row) { return H + (trow + row) * NH + O_AVW + g * 64; },
                c1, sl2, qpos,
                [&](int key) { const int dist = qpos - key; return dist >= 0 && dist < 512; },
                [&](int j) { return j * 64 + 63 <= qw && qw + 31 - j * 64 < 512; }, lds);
            const float rl = gate2 / fmaxf(xhalf_sum(l), 1e-30f);
#pragma unroll
            for (int dvt = 0; dvt < 2; ++dvt)
#pragma unroll
                for (int i = 0; i < 4; ++i) { float4* a = (float4*)(oacc + dvt * 32 + 8 * i + 4 * h); float4 c = *a;
                    c.x += o[dvt][4 * i] * rl; c.y += o[dvt][4 * i + 1] * rl; c.z += o[dvt][4 * i + 2] * rl; c.w += o[dvt][4 * i + 3] * rl; *a = c; }
        }
        {
            f32x16 o[2];
#pragma unroll
            for (int i = 0; i < 16; ++i) { o[0][i] = 0.f; o[1][i] = 0.f; }
            float m = -1e30f, l = 0.f;
            attn_stream<64, 64, true>(qf[0], o, m, l, bmask & upto, qw + 31, 0,
                [&](int row) { return H + (trow + row) * NH + O_AKS + g * 64; },
                [&](int row) { return H + (trow + row) * NH + O_AVS + g * 64; },
                c1, sl2, qpos,
                [&](int key) { return key <= qpos && ((sel >> (key >> 6)) & 1u); },
                [&](int j) { return j * 64 + 63 <= qw && __all((sel >> j) & 1u); }, lds);
            const float rl = gate1 / fmaxf(xhalf_sum(l), 1e-30f);
            bf16_t* dst = BR + (trow + qpos) * 1024 + head * 64;
#pragma unroll
            for (int dvt = 0; dvt < 2; ++dvt)
#pragma unroll
                for (int i = 0; i < 4; ++i) { const float4 c = *(const float4*)(oacc + dvt * 32 + 8 * i + 4 * h);
                    st4bf(dst + dvt * 32 + 8 * i + 4 * h, c.x + o[dvt][4 * i] * rl, c.y + o[dvt][4 * i + 1] * rl, c.z + o[dvt][4 * i + 2] * rl, c.w + o[dvt][4 * i + 3] * rl); }
        }
    }
}

namespace pg8 { typedef PG8_LAS unsigned char* PG8_LAS_T; }
#define LDS3 ((pg8::PG8_LAS_T)lds)
#define GEMM256(EPI, SCHED, g, S, E) do { __syncthreads(); pg8::gemm_phase<EPI, SCHED, false, true>(LDS3, g, S, E); } while (0)
constexpr int NPH = 18;
constexpr int NPHASES = 2 + DEPTH * NPH;

__global__ void __launch_bounds__(NT, 2) mega(Params pk, int ph_lo, int ph_hi) {
    extern __shared__ __attribute__((aligned(16))) unsigned char lds[];
    const int bid = blockIdx.x, nblk = gridDim.x;
#define XB_HERE XcdBarrier bar_; bar_.bar = (unsigned*)(pk.ws + WS_CTL) + CW_BAR; bar_.x = xb_xcc_id(); bar_.st = (volatile LAS unsigned*)(lds + 131072)
    const bool multi = (ph_hi - ph_lo) > 1;
    if (multi) {
        uint4* xbw = (uint4*)(lds + 131072);
        if (tidx() == 0) *xbw = make_uint4(0u, 0u, 0u, 0u);
        __syncthreads();
        (void)xcd_barrier_post((unsigned*)(pk.ws + WS_CTL) + CW_BAR, (volatile LAS unsigned*)xbw);
    }
#ifndef PROBE_PH
#define PROBE_PH -100
#endif
#define PHASE(id, ...) do { const int _id = (id); if (ph_lo <= _id && _id < ph_hi) { for (int _rep = 0; _rep < ((PROBE_PH == -1 ? _id < 2 : (_id >= 2 && (_id - 2) % NPH == PROBE_PH)) ? 2 : 1); ++_rep) { if (_rep) { XB_HERE; xcd_barrier(bar_); } { Params p = pk; int layer = layer_; asm volatile("" : "+s"(p.ws), "+s"(p.out), "+s"(layer)); \
        const LayerW w = layer_w(p, layer); const float* Xin = (layer == 0) ? p.in[0] : WSF(WS_XC); const bf16_t* XinB = (layer == 0) ? WSB(WS_X0B) : WSB(WS_XCB); float* Xout = (layer == DEPTH - 1) ? p.out : WSF(WS_XC); \
        (void)w; (void)Xin; (void)XinB; (void)Xout; __VA_ARGS__; } } if (_id + 1 < ph_hi) { XB_HERE; xcd_barrier(bar_); } } } while (0)

    { const int layer_ = 0;
    PHASE(0, {
        job_wt<2>(p.in[2], DEPTH, 1024, NIN, WSB(WT_IN), NH, bid, nblk, lds);
        job_wt<0>(p.in[17], DEPTH, 1024, 1024, WSB(WT_BR), 1024, bid, nblk, lds);
        job_wt<0>(p.in[18], DEPTH, 1024, 1024, WSB(WT_OUT), 1024, bid, nblk, lds);
        job_wt<0>(p.in[21], DEPTH, 1024, 512, WSB(WT_Q), 512, bid, nblk, lds);
        job_wt<0>(p.in[22], DEPTH, 1024, 1024, WSB(WT_KV), 1024, bid, nblk, lds);
        job_wt<0>(p.in[23], DEPTH, 512, 1024, WSB(WT_O), 1024, bid, nblk, lds);
        job_wt<1>(p.in[30], DEPTH * 32, 1024, 1024, WSB(WT_GU), 1024, bid, nblk, lds);
        job_wt<0>(p.in[31], DEPTH * 32, 512, 1024, WSB(WT_DN), 1024, bid, nblk, lds);
        job_wt<0>(p.in[4], DEPTH * 2, 2048, 256, WSB(WT_C1), 256, bid, nblk, lds);
        job_wt<0>(p.in[5], DEPTH * 2, 256, 64, WSB(WT_C2), 128, bid, nblk, lds);
        job_wt<0>(p.in[15], DEPTH, 192, 384, WSB(WT_UQ), 384, bid, nblk, lds);
        job_wt<0>(p.in[16], DEPTH, 128, 512, WSB(WT_UKV), 512, bid, nblk, lds);
        job_pack_small(p, bid, nblk);
        job_cvt(p.in[0], WSB(WS_X0B), (long)T * 1024, bid, nblk);
        job_cvt(p.in[1], WSB(WS_MEMB), (long)2048 * 1024, bid, nblk);
    });
    PHASE(1, {
        pg8::Gemm g{WSB(WS_MEMB), WSB(WT_KV), BATCH * MEM_LEN, 1024, 1024};
        GroupedOrder S{8, 4, DEPTH, nblk, bid};
        EpiStoreBf16 E{WSB(WS_KVM), 1024, 1 << 30, (long)2048 * 1024};
        GEMM256(EpiStoreBf16, GroupedOrder, g, S, E);
    });
    }
    for (int layer_ = 0; layer_ < DEPTH; ++layer_) {
        const int base = 2 + layer_ * NPH;
        PHASE(base + 0, { pg8::Gemm g{XinB, w.t_in, T, NH, 1024}; pg8::StaticOrder S; S.init(T, NH, nblk, bid); EpiStoreBf16 E{WSB(WS_H), NH, O_MG / 128, 0}; GEMM256(EpiStoreBf16, pg8::StaticOrder, g, S, E); });
        PHASE(base + 1, { job_sb_attn(p, bid, nblk, lds); job_cmp_gather(p, w, bid, nblk); job_rnn_conv(p, w, bid, nblk); job_mla_norm(p, w, bid, nblk); });
        PHASE(base + 2, { if (bid < 16) job_cmp_mlp<0>(p, w, bid, 16, lds); else { job_rnn_gates(p, w, bid - 16, nblk - 16, lds); job_mla_up(p, w, bid - 16, nblk - 16, lds); } });
        PHASE(base + 3, { job_cmp_mlp<1>(p, w, bid, nblk, lds); job_rnn_scan1(p, bid, nblk); });
        PHASE(base + 4, { job_nsa(p, bid, nblk, lds); job_mla_attn(p, bid, nblk, lds); job_rnn_scan2(p, bid, nblk); });
        PHASE(base + 5, { job_merge(p, w, bid, nblk, lds); });
        PHASE(base + 6, { pg8::Gemm g{WSB(WS_M), w.t_out, T, 1024, 1024}; pg8::StaticOrder S; S.init(T, 1024, nblk, bid); EpiStoreBf16 E{WSB(WS_Y), 1024, 1 << 30, 0}; GEMM256(EpiStoreBf16, pg8::StaticOrder, g, S, E); });
        PHASE(base + 7, { job_ln(layer == 0 ? p.in[0] : nullptr, WSB(WS_XCB), nullptr, WSB(WS_Y), 1024, nullptr, w.ln1_g, w.ln1_b, nullptr, WSB(WS_XAB), nullptr, bid, nblk); });
        PHASE(base + 8, { pg8::Gemm g{WSB(WS_XAB), w.t_q, T, 512, 1024}; pg8::StaticOrder S; S.init(T, 512, nblk, bid); EpiStoreBf16 E{WSB(WS_XQ), 512, 1 << 30, 0}; GEMM256(EpiStoreBf16, pg8::StaticOrder, g, S, E); });
        PHASE(base + 9, { job_cross_attn(p, layer, bid, nblk, lds); });
        PHASE(base + 10, { pg8::Gemm g{WSB(WS_XO), w.t_o, T, 1024, 512}; pg8::StaticOrder S; S.init(T, 1024, nblk, bid); EpiStoreBf16 E{WSB(WS_Y), 1024, 1 << 30, 0}; GEMM256(EpiStoreBf16, pg8::StaticOrder, g, S, E); });
        PHASE(base + 11, { job_ln(nullptr, WSB(WS_XAB), nullptr, WSB(WS_Y), 1024, nullptr, w.ln2_g, w.ln2_b, nullptr, WSB(WS_XBB), WSB(WS_XBL), bid, nblk); });
        PHASE(base + 12, { job_router_logits(p, w, bid, nblk, lds); });
        PHASE(base + 13, { job_router(p, w, layer, bid, nblk); });
        PHASE(base + 14, { job_fill(p, layer, bid, nblk, lds); });
        PHASE(base + 15, { const pg8::ListOrder S = moe_units(WSU(WS_CTL) + CW_CNT + layer * 32, bid, nblk); pg8::Gemm g{WSB(WS_XG), w.t_gu, PADROWS, 1024, 1024}; EpiMoeGU E{WSB(WS_HH)}; GEMM256(EpiMoeGU, pg8::ListOrder, g, S, E); });
        PHASE(base + 16, { const pg8::ListOrder S = moe_units(WSU(WS_CTL) + CW_CNT + layer * 32, bid, nblk); pg8::Gemm g{WSB(WS_HH), w.t_dn, PADROWS, 1024, 512}; EpiMoeDown E{WSI(WS_PERM), WSF(WS_EW), WSB(WS_YK)}; GEMM256(EpiMoeDown, pg8::ListOrder, g, S, E); });
        PHASE(base + 17, { job_ln(nullptr, WSB(WS_XBB), WSB(WS_XBL), WSB(WS_YK), 2048, WSB(WS_YK) + 1024, w.ln3_g, w.ln3_b, (layer == DEPTH - 1) ? p.out : nullptr, (layer == DEPTH - 1) ? nullptr : WSB(WS_XCB), nullptr, bid, nblk); });
    }
}

extern "C" void kernel_launch(void* const* d_in, const int* in_sizes, int n_in, void* d_out, int out_size, void* d_ws, size_t ws_size, hipStream_t stream) {
    constexpr size_t kDynLds = 131072 + 1024;
    static_assert(2 * G_STAGE + 1024 <= 131072, "engine stages fit");
    static int grid = 0;
    if (!grid) {
        int dev = 0, cus = 0, per_cu = 0;
        (void)hipGetDevice(&dev);
        (void)hipDeviceGetAttribute(&cus, hipDeviceAttributeMultiprocessorCount, dev);
        (void)hipFuncSetAttribute((const void*)mega, hipFuncAttributeMaxDynamicSharedMemorySize, (int)kDynLds);
        (void)hipOccupancyMaxActiveBlocksPerMultiprocessor(&per_cu, mega, NT, kDynLds);
        if (per_cu < 1) per_cu = 1;
        grid = cus * (per_cu < 2 ? per_cu : 2);
    }
    if (ws_size < WS_END) { fprintf(stderr, "workspace too small: %zu < %zu\n", ws_size, (size_t)WS_END); return; }
    Params p{};
    for (int i = 0; i < 34; ++i) p.in[i] = (const float*)d_in[i];
    p.out = (float*)d_out;
    p.ws = (unsigned char*)d_ws;
    (void)hipMemsetAsync(d_ws, 0, CTL_BYTES, stream);
#if MK_ONE_LAUNCH
    hipLaunchKernelGGL(mega, dim3(grid), dim3(NT), kDynLds, stream, p, 0, NPHASES);
#else
    for (int ph = 0; ph < NPHASES; ++ph) hipLaunchKernelGGL(mega, dim3(grid), dim3(NT), kDynLds, stream, p, ph, ph + 1);
#endif
}
```

```cpp
#include <hip/hip_runtime.h>
#include <stdint.h>
#include <stdio.h>

#ifndef MK_ONE_LAUNCH
#define MK_ONE_LAUNCH 1
#endif

#define DI __device__ __forceinline__
#define LAS __attribute__((address_space(3)))
DI int tidx() { int t = threadIdx.x; asm volatile("" : "+v"(t)); return t; }

constexpr int NT = 512;
constexpr int D = 1024, BATCH = 8, SEQ = 2048, T = BATCH * SEQ, DEPTH = 4;
constexpr int MEM_LEN = 256;
constexpr int NIN = 6764, NH = 6912;
constexpr int O_AQ = 0, O_AKC = 256, O_AVC = 384, O_AKS = 512, O_AVS = 640, O_AKW = 768, O_AVW = 896,
              O_BQ = 1024, O_BK = 1280, O_BV = 1536, O_CX = 1792, O_CG = 2048, O_DCQ = 2304, O_DCKV = 2496, O_DKR = 2624,
              O_AG = 2656, O_MG = 2688;
constexpr int NCMP = 127, NCR = BATCH * NCMP * 2;
constexpr int NEXP = 32, NASSIGN = T * 2;
constexpr float DN_ALPHA = 1.681792830507429f;

typedef unsigned short bf16_t;
typedef short bf16x8 __attribute__((ext_vector_type(8)));
typedef float f32x16 __attribute__((ext_vector_type(16)));
typedef unsigned u32x4 __attribute__((ext_vector_type(4)));

constexpr int G_WM = NT / 128;
constexpr int G_BM = 64 * G_WM;
constexpr int G_BN = 128;
constexpr int G_RS = 144;
constexpr int G_STAGE = (G_BM + G_BN) * G_RS;
constexpr int PADROWS = ((NASSIGN + NEXP * (G_BM - 1) + G_BM - 1) / G_BM) * G_BM;

constexpr size_t MiB = 1u << 20;
constexpr size_t al(size_t x) { return (x + 255) & ~(size_t)255; }
constexpr size_t WS_CTL = 0, CTL_BYTES = 1 * MiB;
constexpr size_t WT_IN = WS_CTL + CTL_BYTES;
constexpr size_t WT_BR = WT_IN + al((size_t)DEPTH * NH * 1024 * 2);
constexpr size_t WT_OUT = WT_BR + al((size_t)DEPTH * 4 * 1024 * 256 * 2);
constexpr size_t WT_Q = WT_OUT + al((size_t)DEPTH * 1024 * 1024 * 2);
constexpr size_t WT_KV = WT_Q + al((size_t)DEPTH * 512 * 1024 * 2);
constexpr size_t WT_O = WT_KV + al((size_t)DEPTH * 1024 * 1024 * 2);
constexpr size_t WT_GU = WT_O + al((size_t)DEPTH * 1024 * 512 * 2);
constexpr size_t WT_DN = WT_GU + al((size_t)DEPTH * 32 * 1024 * 1024 * 2);
constexpr size_t WS_X0B = WT_DN + al((size_t)DEPTH * 32 * 1024 * 512 * 2);
constexpr size_t WS_MEMB = WS_X0B + al((size_t)T * 1024 * 2);
constexpr size_t WS_H = WS_MEMB + al((size_t)2048 * 1024 * 2);
constexpr size_t SZ_H = al((size_t)T * NH * 2);
constexpr size_t WS_YK = WS_H;
constexpr size_t WS_HH = WS_YK + (size_t)PADROWS * 1024 * 2;
static_assert(WS_HH + (size_t)PADROWS * 512 * 2 <= WS_H + SZ_H, "moe overlay fits in H");
constexpr size_t WS_TB = WS_H + SZ_H;
constexpr size_t WS_HID = WS_TB + al((size_t)2 * NCR * 2048 * 4);
constexpr size_t WS_KCVC = WS_HID + al((size_t)2 * NCR * 256 * 4);
constexpr size_t WS_PC = WS_KCVC + al((size_t)2 * NCR * 64 * 4);
constexpr size_t WS_SEL = WS_PC + al((size_t)BATCH * 4 * SEQ * 128 * 4);
constexpr size_t WS_OW = WS_SEL + al((size_t)BATCH * 2 * SEQ * 4);
constexpr size_t WS_OC = WS_OW + al((size_t)T * 256 * 4);
constexpr size_t WS_BR = WS_OC + al((size_t)T * 256 * 4);
constexpr size_t WS_U = WS_BR + al((size_t)T * 1024 * 2);
constexpr size_t WS_RA = WS_U + al((size_t)T * 256 * 4);
constexpr size_t WS_RB = WS_RA + al((size_t)T * 256 * 4);
constexpr size_t WS_CQN = WS_RB + al((size_t)T * 256 * 4);
constexpr size_t WS_CKVN = WS_CQN + al((size_t)T * 192 * 4);
constexpr size_t WS_KR = WS_CKVN + al((size_t)T * 128 * 4);
constexpr size_t WS_Q = WS_KR + al((size_t)T * 32 * 4);
constexpr size_t WS_KV = WS_Q + al((size_t)T * 384 * 4);
constexpr size_t WS_M = WS_KV + al((size_t)T * 512 * 4);
constexpr size_t WS_Y = WS_M + al((size_t)T * 1024 * 2);
constexpr size_t WS_XA = WS_Y + al((size_t)T * 1024 * 4);
constexpr size_t WS_XB = WS_XA + al((size_t)T * 1024 * 4);
constexpr size_t WS_XC = WS_XB + al((size_t)T * 1024 * 4);
constexpr size_t WS_XAB = WS_XC + al((size_t)T * 1024 * 4);
constexpr size_t WS_XBB = WS_XAB + al((size_t)T * 1024 * 2);
constexpr size_t WS_XCB = WS_XBB + al((size_t)T * 1024 * 2);
constexpr size_t WS_XQ = WS_XCB + al((size_t)T * 1024 * 2);
constexpr size_t WS_XO = WS_XQ + al((size_t)T * 512 * 2);
constexpr size_t WS_KVM = WS_XO + al((size_t)T * 512 * 2);
constexpr size_t WS_LOG = WS_KVM + al((size_t)DEPTH * 2048 * 1024 * 2);
constexpr size_t WS_EIDX = WS_LOG + al((size_t)3 * T * 36 * 4);
constexpr size_t WS_ESLOT = WS_EIDX + al((size_t)NASSIGN * 4);
constexpr size_t WS_EW = WS_ESLOT + al((size_t)NASSIGN * 4);
constexpr size_t WS_PERM = WS_EW + al((size_t)NASSIGN * 4);
constexpr size_t WS_QB = WS_PERM + al((size_t)PADROWS * 4);
constexpr size_t WS_KM = WS_QB + al((size_t)T * 384 * 2);
constexpr size_t WS_VM = WS_KM + al((size_t)T * 384 * 2);
constexpr size_t WS_KCB = WS_VM + al((size_t)T * 256 * 2);
constexpr size_t WT_C1 = WS_KCB + al((size_t)2 * NCR * 64 * 2);
constexpr size_t WT_C2 = WT_C1 + al((size_t)DEPTH * 2 * 256 * 2048 * 2);
constexpr size_t WT_UQ = WT_C2 + al((size_t)DEPTH * 2 * 128 * 256 * 2);
constexpr size_t WT_UKV = WT_UQ + al((size_t)DEPTH * 384 * 192 * 2);
constexpr size_t WT_G = WT_UKV + al((size_t)DEPTH * 512 * 128 * 2);
constexpr size_t WT_RH = WT_G + al((size_t)DEPTH * 4 * 128 * 64 * 2);
constexpr size_t WT_RL = WT_RH + al((size_t)DEPTH * 128 * 1024 * 2);
constexpr size_t WS_TBB = WT_RL + al((size_t)DEPTH * 128 * 1024 * 2);
constexpr size_t WS_HIDB = WS_TBB + al((size_t)2 * 2048 * 2048 * 2);
constexpr size_t WS_UB = WS_HIDB + al((size_t)2 * 2048 * 256 * 2);
constexpr size_t WS_CQNB = WS_UB + al((size_t)T * 256 * 2);
constexpr size_t WS_CKVNB = WS_CQNB + al((size_t)T * 192 * 2);
constexpr size_t WS_XBL = WS_CKVNB + al((size_t)T * 128 * 2);
constexpr size_t WS_SA = WS_XBL + al((size_t)T * 1024 * 2);
constexpr size_t WS_SH = WS_SA + al((size_t)BATCH * 32 * 256 * 4);
constexpr size_t WS_XG = WS_SH + al((size_t)BATCH * 32 * 256 * 4);
constexpr size_t WS_ROWOF = WS_XG + al((size_t)PADROWS * 1024 * 2);
constexpr size_t WS_ROPE_PRE = WS_ROWOF + al((size_t)NASSIGN * 4);
constexpr size_t WS_ROPE = WS_ROPE_PRE;
constexpr size_t WS_END = WS_ROPE + al((size_t)SEQ * 16 * 2 * 4);

constexpr int CW_BAR = 4096;
constexpr int CW_CNT = 16384;

struct Params {
    const float* in[34];
    float* out;
    unsigned char* ws;
};

#define XB_TMO      128
#define XB_XCNT(j)  (256  + 64 * (j))
#define XB_XSUB(j)  (1280 + 64 * (j))
#define XB_XGEN(j)  (2304 + 64 * (j))
#define XB_TOP      3328
#define XB_TOPGEN   3392
#define XCD_BAR_WORDS 3456
#define XB_SPIN_CAP (1u << 22)

__device__ __forceinline__ unsigned xb_ld(unsigned* p)              { return __hip_atomic_load(p, __ATOMIC_RELAXED, __HIP_MEMORY_SCOPE_AGENT); }
__device__ __forceinline__ unsigned xb_add(unsigned* p, unsigned v) { return __hip_atomic_fetch_add(p, v, __ATOMIC_RELAXED, __HIP_MEMORY_SCOPE_AGENT); }
__device__ __forceinline__ unsigned xb_xcc_id() { return (unsigned)__builtin_amdgcn_s_getreg((3 << 11) | 20) & 0xFu; }
#define XB_SPIN(cond, bar) do { unsigned _sp = 0; while (cond) { __builtin_amdgcn_s_sleep(1); \
    if ((++_sp & 255u) == 0u) { if (xb_ld(&(bar)[XB_TMO])) break; if (_sp > XB_SPIN_CAP) { atomicAdd(&(bar)[XB_TMO], 1u); break; } } } } while (0)

struct XcdBarrier { unsigned* bar; unsigned x; volatile LAS unsigned* st; };

__device__ __forceinline__ XcdBarrier xcd_barrier_post(unsigned* bar, volatile LAS unsigned* st) {
    XcdBarrier b; b.bar = bar; b.x = xb_xcc_id(); b.st = st;
    if (threadIdx.x == 0) (void)xb_add(&bar[XB_XCNT(b.x)], 1u);
    return b;
}
__device__ __forceinline__ void xcd_barrier_complete(unsigned* bar, unsigned x, unsigned& nloc, unsigned& nx) {
    const unsigned G = gridDim.x * gridDim.y * gridDim.z;
    unsigned sum, cnt, mine, sp = 0u;
    for (;;) {
        sum = 0u; cnt = 0u; mine = 0u;
#pragma unroll
        for (unsigned j = 0; j < 16; ++j) { const unsigned c = xb_ld(&bar[XB_XCNT(j)]); sum += c; cnt += (c > 0u) ? 1u : 0u; mine = (j == x) ? c : mine; }
        if (sum == G) break;
        __builtin_amdgcn_s_sleep(1);
        if ((++sp & 255u) == 0u) { if (xb_ld(&bar[XB_TMO])) break; if (sp > XB_SPIN_CAP) { atomicAdd(&bar[XB_TMO], 1u); break; } }
    }
    nloc = mine > 0u ? mine : 1u; nx = cnt > 0u ? cnt : 1u;
}
__device__ __forceinline__ void xcd_barrier(const XcdBarrier& b) {
    asm volatile("s_waitcnt vmcnt(0)" ::: "memory");
    __syncthreads();
    if (threadIdx.x == 0) {
        unsigned* bar = b.bar;
        __builtin_amdgcn_s_waitcnt(0);
        unsigned nloc = b.st[0], nx = b.st[1];
        if (nloc == 0u) { xcd_barrier_complete(bar, b.x, nloc, nx); b.st[0] = nloc; b.st[1] = nx; }
        const unsigned old = xb_add(&bar[XB_XSUB(b.x)], 1u);
        const unsigned gen = old / nloc;
        if (old + 1u == (gen + 1u) * nloc) {
            __builtin_amdgcn_fence(__ATOMIC_RELEASE, "agent");
            asm volatile("s_waitcnt vmcnt(0)" ::: "memory");
            const unsigned og = xb_add(&bar[XB_TOP], 1u);
            const unsigned tg = og / nx;
            if (og + 1u == (tg + 1u) * nx) xb_add(&bar[XB_TOPGEN], 1u);
            else XB_SPIN(xb_ld(&bar[XB_TOPGEN]) == tg, bar);
            __builtin_amdgcn_fence(__ATOMIC_ACQUIRE, "agent");
            xb_add(&bar[XB_XGEN(b.x)], 1u);
            asm volatile("s_waitcnt vmcnt(0)" ::: "memory");
        } else {
            XB_SPIN(xb_ld(&bar[XB_XGEN(b.x)]) == gen, bar);
            __builtin_amdgcn_fence(__ATOMIC_ACQUIRE, "agent");
            asm volatile("s_waitcnt vmcnt(0)" ::: "memory");
        }
    }
    __syncthreads();
}

DI float gelu_tanh(float x) { const float u = 0.7978845608028654f * (x + 0.044715f * x * x * x); return 0.5f * x * (1.f + tanhf(u)); }
DI float sigm(float x) { return 1.f / (1.f + expf(-x)); }
DI float sigm_fast(float x) { return __builtin_amdgcn_rcpf(1.f + __expf(-x)); }
DI float logsig(float z) { return fminf(z, 0.f) - log1pf(expf(-fabsf(z))); }
DI float wave_sum(float v) {
    const int lane = tidx() & 63;
#pragma unroll
    for (int o = 32; o > 0; o >>= 1) v += __int_as_float(__builtin_amdgcn_ds_bpermute((lane ^ o) << 2, __float_as_int(v)));
    return v;
}

DI float bflo(unsigned u) { return __uint_as_float(u << 16); }
DI float bfhi(unsigned u) { return __uint_as_float(u & 0xffff0000u); }
DI float bf2f(bf16_t x) { return __uint_as_float((unsigned)x << 16); }
typedef float f32x2_t __attribute__((ext_vector_type(2)));
typedef __bf16 bf16x2_t __attribute__((ext_vector_type(2)));
DI unsigned pk_bf16(float lo, float hi) { f32x2_t v = {lo, hi}; bf16x2_t b = __builtin_convertvector(v, bf16x2_t); return __builtin_bit_cast(unsigned, b); }
DI bf16_t f2bf(float x) { return (bf16_t)(pk_bf16(x, 0.f) & 0xffffu); }
DI void st4bf(bf16_t* p, float a, float b, float c, float d) { uint2 v; v.x = pk_bf16(a, b); v.y = pk_bf16(c, d); *(uint2*)p = v; }
DI float4 ld4bf(const bf16_t* p) { const uint2 v = *(const uint2*)p; return make_float4(bflo(v.x), bfhi(v.x), bflo(v.y), bfhi(v.y)); }
template <int N> DI float dot_row(const float* q, const bf16_t* kr) {
    float dot = 0.f;
#pragma unroll
    for (int d = 0; d < N; d += 8) { const uint4 v = *(const uint4*)(kr + d);
        dot = fmaf(q[d], bflo(v.x), dot); dot = fmaf(q[d + 1], bfhi(v.x), dot); dot = fmaf(q[d + 2], bflo(v.y), dot); dot = fmaf(q[d + 3], bfhi(v.y), dot);
        dot = fmaf(q[d + 4], bflo(v.z), dot); dot = fmaf(q[d + 5], bfhi(v.z), dot); dot = fmaf(q[d + 6], bflo(v.w), dot); dot = fmaf(q[d + 7], bfhi(v.w), dot); }
    return dot;
}
template <int N> DI float dot_row(const float* q, const float* kr) {
    float dot = 0.f;
#pragma unroll
    for (int d = 0; d < N; ++d) dot = fmaf(q[d], kr[d], dot);
    return dot;
}
template <int N> DI void axpy_row(float* o, float pr, float corr, const bf16_t* vr) {
#pragma unroll
    for (int d = 0; d < N; d += 8) { const uint4 v = *(const uint4*)(vr + d);
        o[d] = fmaf(pr, bflo(v.x), o[d] * corr); o[d + 1] = fmaf(pr, bfhi(v.x), o[d + 1] * corr); o[d + 2] = fmaf(pr, bflo(v.y), o[d + 2] * corr); o[d + 3] = fmaf(pr, bfhi(v.y), o[d + 3] * corr);
        o[d + 4] = fmaf(pr, bflo(v.z), o[d + 4] * corr); o[d + 5] = fmaf(pr, bfhi(v.z), o[d + 5] * corr); o[d + 6] = fmaf(pr, bflo(v.w), o[d + 6] * corr); o[d + 7] = fmaf(pr, bfhi(v.w), o[d + 7] * corr); }
}
template <int N> DI void axpy_row(float* o, float pr, float corr, const float* vr) {
#pragma unroll
    for (int d = 0; d < N; ++d) o[d] = fmaf(pr, vr[d], o[d] * corr);
}
template <int N> DI void ld_row(float* q, const bf16_t* p) {
#pragma unroll
    for (int d = 0; d < N; d += 8) { const uint4 v = *(const uint4*)(p + d);
        q[d] = bflo(v.x); q[d + 1] = bfhi(v.x); q[d + 2] = bflo(v.y); q[d + 3] = bfhi(v.y); q[d + 4] = bflo(v.z); q[d + 5] = bfhi(v.z); q[d + 6] = bflo(v.w); q[d + 7] = bfhi(v.w); }
}
template <int N> DI void ld_row(float* q, const float* p) {
#pragma unroll
    for (int d = 0; d < N; d += 4) { const float4 v = *(const float4*)(p + d); q[d] = v.x; q[d + 1] = v.y; q[d + 2] = v.z; q[d + 3] = v.w; }
}

struct MG { const bf16_t* A; long lda; const bf16_t* Wt; long ldw; int K; };

struct NoFlush { DI void operator()(int, f32x16 (&)[2][2]) const {} };
template <class RowFn, class Flush>
DI void mgemm_tile_f(const MG& g, int n0, RowFn rowfn, f32x16 (&acc)[2][2], unsigned char* lds, bool zero, int flush_every, Flush flush) {
    constexpr int XI = G_BM * 8 / NT, WI = G_BN * 8 / NT;
    const int tid = tidx(), lane = tid & 63, wid = tid >> 6, r = lane & 31, h = lane >> 5;
    const int wm = wid % G_WM, wn = wid / G_WM;
    const int cc = tid & 7, row0 = tid >> 3;
    const bf16_t* xp[XI]; const bf16_t* wp[WI];
#pragma unroll
    for (int i = 0; i < XI; ++i) xp[i] = g.A + (long)rowfn(row0 + (NT / 8) * i) * g.lda + cc * 8;
#pragma unroll
    for (int i = 0; i < WI; ++i) wp[i] = g.Wt + (long)(n0 + row0 + (NT / 8) * i) * g.ldw + cc * 8;
    const int st_off = row0 * G_RS + cc * 16;
    if (zero)
#pragma unroll
    for (int a = 0; a < 2; ++a)
#pragma unroll
        for (int b = 0; b < 2; ++b)
#pragma unroll
            for (int i = 0; i < 16; ++i) acc[a][b][i] = 0.f;
    const int nk = g.K >> 6;
    u32x4 xv0[XI], wv0[WI], xv1[XI], wv1[WI];
#define MG_GLOAD(XV, WV, KT) do { _Pragma("unroll") for (int i = 0; i < XI; ++i) XV[i] = *(const u32x4*)(xp[i] + (KT) * 64); \
                                  _Pragma("unroll") for (int i = 0; i < WI; ++i) WV[i] = *(const u32x4*)(wp[i] + (KT) * 64); } while (0)
#define MG_LSTORE(XV, WV, STG) do { unsigned char* _s = lds + (STG) * G_STAGE; \
        _Pragma("unroll") for (int i = 0; i < XI; ++i) *(u32x4*)(_s + st_off + (NT / 8) * i * G_RS) = XV[i]; \
        _Pragma("unroll") for (int i = 0; i < WI; ++i) *(u32x4*)(_s + G_BM * G_RS + st_off + (NT / 8) * i * G_RS) = WV[i]; } while (0)
    MG_GLOAD(xv0, wv0, 0);
    if (nk > 1) MG_GLOAD(xv1, wv1, 1);
    __syncthreads();
    MG_LSTORE(xv0, wv0, 0);
    if (nk > 2) MG_GLOAD(xv0, wv0, 2);
    __syncthreads();
    const int xf_off = (wm * 64 + r) * G_RS + h * 16, wf_off = G_BM * G_RS + (wn * 64 + r) * G_RS + h * 16;
#define MG_COMPUTE(STG) do { const unsigned char* st = lds + (STG) * G_STAGE; \
        _Pragma("unroll") for (int ks = 0; ks < 4; ++ks) { \
            const bf16x8 w0 = *(const bf16x8*)(st + wf_off + ks * 32), w1 = *(const bf16x8*)(st + wf_off + 32 * G_RS + ks * 32); \
            const bf16x8 x0 = *(const bf16x8*)(st + xf_off + ks * 32), x1 = *(const bf16x8*)(st + xf_off + 32 * G_RS + ks * 32); \
            acc[0][0] = __builtin_amdgcn_mfma_f32_32x32x16_bf16(w0, x0, acc[0][0], 0, 0, 0); \
            acc[0][1] = __builtin_amdgcn_mfma_f32_32x32x16_bf16(w0, x1, acc[0][1], 0, 0, 0); \
            acc[1][0] = __builtin_amdgcn_mfma_f32_32x32x16_bf16(w1, x0, acc[1][0], 0, 0, 0); \
            acc[1][1] = __builtin_amdgcn_mfma_f32_32x32x16_bf16(w1, x1, acc[1][1], 0, 0, 0); } } while (0)
    for (int kt = 0; kt < nk; kt += 2) {
        MG_COMPUTE(0);
        if (kt + 1 < nk) { MG_LSTORE(xv1, wv1, 1); if (kt + 3 < nk) MG_GLOAD(xv1, wv1, kt + 3); }
        if (flush_every && (kt + 1) % flush_every == 0) flush(kt / flush_every, acc);
        __syncthreads();
        if (kt + 1 < nk) {
            MG_COMPUTE(1);
            if (kt + 2 < nk) { MG_LSTORE(xv0, wv0, 0); if (kt + 4 < nk) MG_GLOAD(xv0, wv0, kt + 4); }
            if (flush_every && (kt + 2) % flush_every == 0) flush((kt + 1) / flush_every, acc);
            __syncthreads();
        }
    }
#undef MG_GLOAD
#undef MG_LSTORE
#undef MG_COMPUTE
}
template <class RowFn>
DI void mgemm_tile(const MG& g, int n0, RowFn rowfn, f32x16 (&acc)[2][2], unsigned char* lds, bool zero = true) { mgemm_tile_f(g, n0, rowfn, acc, lds, zero, 0, NoFlush{}); }
#define MG_FOREACH(acc, LROW, FEAT, V, ...) do { const int _l = tidx() & 63, _w = tidx() >> 6, _wm = _w % G_WM, _wn = _w / G_WM; \
    _Pragma("unroll") for (int _ft = 0; _ft < 2; ++_ft) _Pragma("unroll") for (int _tt = 0; _tt < 2; ++_tt) _Pragma("unroll") for (int _i = 0; _i < 4; ++_i) { \
        const int LROW = _wm * 64 + _tt * 32 + (_l & 31); const int FEAT = _wn * 64 + _ft * 32 + 8 * _i + 4 * (_l >> 5); \
        float V[4] = {acc[_ft][_tt][4 * _i], acc[_ft][_tt][4 * _i + 1], acc[_ft][_tt][4 * _i + 2], acc[_ft][_tt][4 * _i + 3]}; __VA_ARGS__ } } while (0)

struct RowId { int m0; DI long operator()(int r) const { return m0 + r; } };

template <int OUTMODE>
DI void mgemm_job(const MG& g, int M, int N, void* out, long ldo, int bid, int nblk, unsigned char* lds) {
    const int tm = M / G_BM, tn = N / G_BN;
    for (int u = bid; u < tm * tn; u += nblk) {
        const int grp = u / (16 * tn), rem = u % (16 * tn);
        const int gm = (tm - grp * 16) < 16 ? (tm - grp * 16) : 16;
        const int mt = grp * 16 + rem % gm, nt = rem / gm;
        const int m0 = mt * G_BM, n0 = nt * G_BN;
        f32x16 acc[2][2];
        mgemm_tile(g, n0, RowId{m0}, acc, lds);
        MG_FOREACH(acc, lrow, feat, v, {
            const long o = (long)(m0 + lrow) * ldo + n0 + feat;
            if (OUTMODE == 1) *(float4*)((float*)out + o) = make_float4(v[0], v[1], v[2], v[3]);
            else {
                if (OUTMODE == 2 && n0 + feat >= O_MG) { v[0] = sigm(v[0]); v[1] = sigm(v[1]); v[2] = sigm(v[2]); v[3] = sigm(v[3]); }
                st4bf((bf16_t*)out + o, v[0], v[1], v[2], v[3]);
            } });
    }
}

namespace pg8 {
#define PG8_LAS __attribute__((address_space(3)))
typedef float f32x4 __attribute__((ext_vector_type(4)));
constexpr int BM = 256, BK = 64, HALF = 128, HTB = HALF * BK * 2  , STAGE_BYTES = 8 * HTB, NXCD = 8, WGM = 8;
__host__ __device__ __forceinline__ int lds_byte(int r, int c) { const int st = (r >> 4) * 2 + (c >> 5), rr = r & 15, cc = c & 31, ob = rr * 64 + cc * 2; return st * 1024 + (ob ^ (((ob >> 9) & 1) << 5)); }
__host__ __device__ __forceinline__ void stage_rc(int b, int& R, int& C) { const int st = b / 1024, sb = b % 1024, swz = sb ^ (((sb >> 9) & 1) << 5); R = (st >> 1) * 16 + swz / 64; C = (st & 1) * 32 + (swz % 64) / 2; }
__host__ __device__ __forceinline__ int perm32(int rho) { const int n = rho >> 4, i = rho & 15; return 8 * (i >> 2) + 4 * n + (i & 3); }
struct Unit { int pm, pn, e; };
struct Gemm { const bf16_t* A; const bf16_t* Bt; int M, N, K; const int* rowidx; };
struct StaticOrder {
    int nM, nN, nwg, G, c;
    __device__ void init(int M, int N, int G_, int c_) { nM = M / BM; nN = N / BM; nwg = nM * nN; G = G_; c = c_; }
    __device__ bool next(int i, Unit& u) const {
        const long L = (long)i * G + c; if (L >= nwg) return false;
        int wgid = (int)L; { const int q = nwg / NXCD, r = nwg % NXCD, xcd = wgid % NXCD, off = wgid / NXCD; wgid = (xcd < r ? xcd * (q + 1) : r * (q + 1) + (xcd - r) * q) + off; }
        const int nig = WGM * nN, gid = wgid / nig, fm = gid * WGM, gsz = (nM - fm) < WGM ? (nM - fm) : WGM;
        u.pm = fm + ((wgid % nig) % gsz); u.pn = (wgid % nig) / gsz; u.e = 0; return true;
    }
    __device__ __forceinline__ void a_ready(const Unit&) const {}
    __device__ __forceinline__ void done(const Unit&) const {}
};
struct ListOrder {
    Unit u0, u1, u2; int n;
    __device__ bool next(int i, Unit& u) const { if (i >= n) return false; u = (i == 0) ? u0 : ((i == 1) ? u1 : u2); return true; }
    __device__ __forceinline__ void a_ready(const Unit&) const {}
    __device__ __forceinline__ void done(const Unit&) const {}
};
template <class Epi, class Sched, bool ALIGN_EPI = false, bool SP2 = false, bool GATHER = false>
__device__ __forceinline__ void gemm_phase(PG8_LAS unsigned char* lds, const Gemm g, const Sched& S, const Epi& E) {
    const int tid = tidx(), wid = __builtin_amdgcn_readfirstlane(tid >> 6), lane = tid & 63, wr = wid >> 2, wc = wid & 3, fr = lane & 15, fq = lane >> 4;
    const int K = g.K, nt = K / BK;
    unsigned voffA[2], voffB[2];
#pragma unroll
    for (int i = 0; i < 2; ++i) { int R, C; stage_rc(tid * 16 + i * 8192, R, C); const int Rb = Epi::PERM ? ((R & ~31) + perm32(R & 31)) : R;
        voffA[i] = (unsigned)(R * K + C) * 2u; voffB[i] = (unsigned)(Rb * K + C) * 2u; }
    unsigned voffC[2][2] = {{0u, 0u}, {0u, 0u}}, voffN[2][2] = {{0u, 0u}, {0u, 0u}};
    auto gather_offs = [&](int pm, unsigned (&vo)[2][2]) {
#pragma unroll
        for (int hh = 0; hh < 2; ++hh)
#pragma unroll
            for (int i = 0; i < 2; ++i) { int R, C; stage_rc(tid * 16 + i * 8192, R, C); int a = g.rowidx[pm * BM + hh * HALF + R]; a = a < 0 ? 0 : (a >> 1); vo[hh][i] = (unsigned)(a * K + C) * 2u; }
    };
    const size_t kstep = (size_t)(BK * 2);
    const size_t hstep = (size_t)HALF * K * 2;
    const size_t tstep = 2 * hstep;
    const size_t estep = (size_t)g.N * K * 2;
    const unsigned ldsw = (unsigned)wid * 1024u;
    const int aoff = lds_byte(wr * 64 + fr, fq * 8), boff = lds_byte(wc * 32 + fr, fq * 8);
#define PG8_SA(b, h) (((b) * 2 + (h)) * HTB)
#define PG8_SB(b, h) ((4 + (b) * 2 + (h)) * HTB)
#define PG8_STAGE(bufoff, gbase, voff) do { _Pragma("unroll") for (int _i = 0; _i < 2; ++_i) \
        __builtin_amdgcn_global_load_lds((const unsigned*)((const char*)(gbase) + (voff)[_i]), (PG8_LAS unsigned*)(lds + (bufoff) + ldsw + _i * 8192), 16, 0, 0); } while (0)
#define PG8_STAGE_A(bufoff, HH, KT, NX, densebase) do { if constexpr (GATHER) { const char* _gb = (const char*)g.A + (size_t)(KT) * kstep; if (NX) PG8_STAGE(bufoff, _gb, voffN[HH]); else PG8_STAGE(bufoff, _gb, voffC[HH]); } else PG8_STAGE(bufoff, densebase, voffA); } while (0)
#define PG8_LDA(dst, b, h) do { _Pragma("unroll") for (int m = 0; m < 4; ++m) _Pragma("unroll") for (int k = 0; k < 2; ++k) dst[m][k] = *(const PG8_LAS bf16x8*)(lds + PG8_SA(b, h) + aoff + m * 2048 + k * 1024); } while (0)
#define PG8_LDB(dst, b, h) do { _Pragma("unroll") for (int n = 0; n < 2; ++n) _Pragma("unroll") for (int k = 0; k < 2; ++k) dst[n][k] = *(const PG8_LAS bf16x8*)(lds + PG8_SB(b, h) + boff + n * 2048 + k * 1024); } while (0)
#define PG8_MMA(ai, bj, At, Bt) do { __builtin_amdgcn_s_setprio(1); _Pragma("unroll") for (int m = 0; m < 4; ++m) _Pragma("unroll") for (int n = 0; n < 2; ++n) _Pragma("unroll") for (int k = 0; k < 2; ++k) \
        acc[ai][bj][m][n] = __builtin_amdgcn_mfma_f32_16x16x32_bf16(Bt[n][k], At[m][k], acc[ai][bj][m][n], 0, 0, 0); __builtin_amdgcn_s_setprio(0); } while (0)
#define PG8_WAIT_V(n) asm volatile("s_waitcnt vmcnt(" #n ")" ::: "memory")
#define PG8_WAIT_L(n) asm volatile("s_waitcnt lgkmcnt(" #n ")" ::: "memory")
#define PG8_BAR __builtin_amdgcn_s_barrier()
#define PG8_SCHED __builtin_amdgcn_sched_barrier(0)
    Unit cur, nxt; int ui = 0;
    if (!S.next(0, cur)) return;
    f32x4 acc[2][2][4][2];
#pragma unroll
    for (int a = 0; a < 2; ++a)
#pragma unroll
        for (int b = 0; b < 2; ++b)
#pragma unroll
            for (int m = 0; m < 4; ++m)
#pragma unroll
                for (int n = 0; n < 2; ++n) acc[a][b][m][n] = (f32x4){0.f, 0.f, 0.f, 0.f};
    bf16x8 At[4][2], B0[2][2], B1[2][2];
    const char* cA = (const char*)g.A + (size_t)cur.pm * tstep; const char* cB = (const char*)g.Bt + (size_t)cur.e * estep + (size_t)cur.pn * tstep;
    S.a_ready(cur);
    if constexpr (GATHER) gather_offs(cur.pm, voffC);
    if constexpr (SP2) {
        PG8_STAGE(PG8_SB(0, 0), cB, voffB); PG8_STAGE(PG8_SB(0, 1), cB + hstep, voffB); PG8_STAGE_A(PG8_SA(0, 0), 0, 0, false, cA); PG8_STAGE_A(PG8_SA(0, 1), 1, 0, false, cA + hstep);
        if (wr == 1) PG8_BAR;
        PG8_WAIT_V(2); PG8_BAR;
        PG8_STAGE(PG8_SB(1, 0), cB + kstep, voffB); PG8_STAGE_A(PG8_SA(1, 0), 0, 1, false, cA + kstep); PG8_STAGE(PG8_SB(1, 1), cB + hstep + kstep, voffB);
        PG8_WAIT_V(6); PG8_BAR;
    } else {
        PG8_STAGE(PG8_SB(0, 0), cB, voffB); PG8_STAGE_A(PG8_SA(0, 0), 0, 0, false, cA); PG8_STAGE(PG8_SB(0, 1), cB + hstep, voffB); PG8_STAGE_A(PG8_SA(0, 1), 1, 0, false, cA + hstep);
        if (wr == 1) PG8_BAR;
        PG8_WAIT_V(4); PG8_BAR;
        PG8_STAGE(PG8_SB(1, 0), cB + kstep, voffB); PG8_STAGE_A(PG8_SA(1, 0), 0, 1, false, cA + kstep); PG8_STAGE(PG8_SB(1, 1), cB + hstep + kstep, voffB);
        PG8_WAIT_V(6); PG8_BAR;
    }
    for (;;) {
        const bool has_next = S.next(ui + 1, nxt);
        if constexpr (GATHER) { if (has_next) gather_offs(nxt.pm, voffN); else {
#pragma unroll
            for (int hh = 0; hh < 2; ++hh) { voffN[hh][0] = voffC[hh][0]; voffN[hh][1] = voffC[hh][1]; } } }
        const char* nA = has_next ? (const char*)g.A + (size_t)nxt.pm * tstep : cA; const char* nB = has_next ? (const char*)g.Bt + (size_t)nxt.e * estep + (size_t)nxt.pn * tstep : cB;
        for (int t = 0; t < nt; t += 2) {
            const bool last = (t == nt - 2);
            const char* a1 = cA + (size_t)(t + 1) * kstep;
            const char* a2 = last ? nA : cA + (size_t)(t + 2) * kstep; const char* b2 = last ? nB : cB + (size_t)(t + 2) * kstep;
            const char* a3 = a2 + kstep; const char* b3 = b2 + kstep;
            if (last && has_next) S.a_ready(nxt);
            if constexpr (SP2) {
            PG8_LDB(B0, 0, 0); PG8_LDB(B1, 0, 1); PG8_SCHED; PG8_LDA(At, 0, 0); PG8_STAGE_A(PG8_SA(1, 1), 1, t + 1, false, a1 + hstep);
            PG8_WAIT_V(8); PG8_WAIT_L(0); PG8_BAR; PG8_MMA(0, 0, At, B0); PG8_MMA(0, 1, At, B1); PG8_BAR; PG8_SCHED;
            PG8_LDA(At, 0, 1); PG8_STAGE(PG8_SB(0, 0), b2, voffB); PG8_STAGE(PG8_SB(0, 1), b2 + hstep, voffB); PG8_STAGE_A(PG8_SA(0, 0), 0, (last ? 0 : t + 2), last, a2);
            PG8_WAIT_V(8); PG8_WAIT_L(0); PG8_BAR; PG8_MMA(1, 0, At, B0); PG8_MMA(1, 1, At, B1); PG8_BAR; PG8_SCHED;
            PG8_LDB(B0, 1, 0); PG8_LDB(B1, 1, 1); PG8_SCHED; PG8_LDA(At, 1, 0); PG8_STAGE_A(PG8_SA(0, 1), 1, (last ? 0 : t + 2), last, a2 + hstep);
            PG8_WAIT_V(8); PG8_WAIT_L(0); PG8_BAR; PG8_MMA(0, 0, At, B0); PG8_MMA(0, 1, At, B1); PG8_BAR; PG8_SCHED;
            PG8_LDA(At, 1, 1); PG8_STAGE(PG8_SB(1, 0), b3, voffB); PG8_STAGE(PG8_SB(1, 1), b3 + hstep, voffB); PG8_STAGE_A(PG8_SA(1, 0), 0, (last ? 1 : t + 3), last, a3);
            PG8_WAIT_V(8); PG8_WAIT_L(0); PG8_BAR; PG8_MMA(1, 0, At, B0); PG8_MMA(1, 1, At, B1); PG8_BAR; PG8_SCHED;
            } else {
            PG8_LDB(B0, 0, 0); PG8_SCHED; PG8_LDA(At, 0, 0); PG8_STAGE_A(PG8_SA(1, 1), 1, t + 1, false, a1 + hstep);
            PG8_WAIT_L(8); PG8_BAR; PG8_WAIT_L(0); PG8_MMA(0, 0, At, B0); PG8_BAR; PG8_SCHED;
            PG8_LDB(B1, 0, 1); PG8_STAGE(PG8_SB(0, 0), b2, voffB);
            PG8_BAR; PG8_WAIT_L(0); PG8_MMA(0, 1, At, B1); PG8_BAR;
            PG8_LDA(At, 0, 1); PG8_STAGE_A(PG8_SA(0, 0), 0, (last ? 0 : t + 2), last, a2);
            PG8_BAR; PG8_WAIT_L(0); PG8_MMA(1, 0, At, B0); PG8_BAR; PG8_SCHED;
            PG8_STAGE(PG8_SB(0, 1), b2 + hstep, voffB);
            PG8_WAIT_V(6); PG8_BAR; PG8_MMA(1, 1, At, B1); PG8_BAR;
            PG8_LDB(B0, 1, 0); PG8_SCHED; PG8_LDA(At, 1, 0); PG8_STAGE_A(PG8_SA(0, 1), 1, (last ? 0 : t + 2), last, a2 + hstep);
            PG8_WAIT_L(8); PG8_BAR; PG8_WAIT_L(0); PG8_MMA(0, 0, At, B0); PG8_BAR; PG8_SCHED;
            PG8_LDB(B1, 1, 1); PG8_STAGE(PG8_SB(1, 0), b3, voffB);
            PG8_BAR; PG8_WAIT_L(0); PG8_MMA(0, 1, At, B1); PG8_BAR;
            PG8_LDA(At, 1, 1); PG8_STAGE_A(PG8_SA(1, 0), 0, (last ? 1 : t + 3), last, a3);
            PG8_BAR; PG8_WAIT_L(0); PG8_MMA(1, 0, At, B0); PG8_BAR; PG8_SCHED;
            PG8_STAGE(PG8_SB(1, 1), b3 + hstep, voffB);
            PG8_WAIT_V(6); PG8_BAR; PG8_MMA(1, 1, At, B1); PG8_BAR;
            }
        }
        if constexpr (ALIGN_EPI) { if (wr == 0) PG8_BAR; }
        if constexpr (!Epi::AFTER_DRAIN) { E(acc, cur, wr, wc, fr, fq); S.done(cur); }
        if (!has_next) break;
#pragma unroll
        for (int a = 0; a < 2; ++a)
#pragma unroll
            for (int b = 0; b < 2; ++b)
#pragma unroll
                for (int m = 0; m < 4; ++m)
#pragma unroll
                    for (int n = 0; n < 2; ++n) acc[a][b][m][n] = (f32x4){0.f, 0.f, 0.f, 0.f};
        cur = nxt; cA = nA; cB = nB; ++ui;
        if constexpr (GATHER) {
#pragma unroll
            for (int hh = 0; hh < 2; ++hh) { voffC[hh][0] = voffN[hh][0]; voffC[hh][1] = voffN[hh][1]; } }
        if constexpr (ALIGN_EPI) { if (wr == 1) PG8_BAR; }
    }
    PG8_WAIT_V(0);
    if constexpr (!ALIGN_EPI) { if (wr == 0) PG8_BAR; }
    PG8_BAR;
    if constexpr (Epi::AFTER_DRAIN) { E.fused(acc, cur, wr, wc, fr, fq, lds, wid, lane); S.done(cur); }
#undef PG8_SA
#undef PG8_SB
#undef PG8_STAGE
#undef PG8_STAGE_A
#undef PG8_LDA
#undef PG8_LDB
#undef PG8_MMA
#undef PG8_WAIT_V
#undef PG8_WAIT_L
#undef PG8_BAR
#undef PG8_SCHED
}
}

struct EpiStoreBf16 {
    static constexpr bool PERM = true, AFTER_DRAIN = false;
    bf16_t* O; long ldo; int gate_from; long estride;
    __device__ __forceinline__ void operator()(const pg8::f32x4 (&acc)[2][2][4][2], const pg8::Unit& u, int wr, int wc, int fr, int fq) const {
        bf16_t* base = O + (long)u.e * estride;
#pragma unroll
        for (int ai = 0; ai < 2; ++ai)
#pragma unroll
            for (int m = 0; m < 4; ++m) {
                const long row = (long)u.pm * 256 + ai * 128 + wr * 64 + m * 16 + fr;
#pragma unroll
                for (int bj = 0; bj < 2; ++bj) {
                    pg8::f32x4 v0 = acc[ai][bj][m][0], v1 = acc[ai][bj][m][1];
                    if (u.pn * 2 + bj >= gate_from) {
#pragma unroll
                        for (int j = 0; j < 4; ++j) { v0[j] = sigm_fast(v0[j]); v1[j] = sigm_fast(v1[j]); }
                    }
                    u32x4 wv; wv[0] = pk_bf16(v0[0], v0[1]); wv[1] = pk_bf16(v0[2], v0[3]); wv[2] = pk_bf16(v1[0], v1[1]); wv[3] = pk_bf16(v1[2], v1[3]);
                    *(u32x4*)(base + row * ldo + u.pn * 256 + bj * 128 + wc * 32 + 8 * fq) = wv;
                }
            }
    }
};
struct EpiStoreF32 {
    static constexpr bool PERM = false, AFTER_DRAIN = false;
    float* O; long ldo;
    __device__ __forceinline__ void operator()(const pg8::f32x4 (&acc)[2][2][4][2], const pg8::Unit& u, int wr, int wc, int fr, int fq) const {
#pragma unroll
        for (int ai = 0; ai < 2; ++ai)
#pragma unroll
            for (int m = 0; m < 4; ++m) {
                const long row = (long)u.pm * 256 + ai * 128 + wr * 64 + m * 16 + fr;
#pragma unroll
                for (int bj = 0; bj < 2; ++bj)
#pragma unroll
                    for (int n = 0; n < 2; ++n) *(pg8::f32x4*)(O + row * ldo + u.pn * 256 + bj * 128 + wc * 32 + 16 * n + 4 * fq) = acc[ai][bj][m][n];
            }
    }
};
struct EpiMoeGU {
    static constexpr bool PERM = true, AFTER_DRAIN = false;
    bf16_t* HH;
    __device__ __forceinline__ void operator()(const pg8::f32x4 (&acc)[2][2][4][2], const pg8::Unit& u, int wr, int wc, int fr, int fq) const {
#pragma unroll
        for (int ai = 0; ai < 2; ++ai)
#pragma unroll
            for (int m = 0; m < 4; ++m) {
                const long row = (long)u.pm * 256 + ai * 128 + wr * 64 + m * 16 + fr;
                float hv[8];
#pragma unroll
                for (int n = 0; n < 2; ++n)
#pragma unroll
                    for (int j = 0; j < 4; ++j) { const float gt = acc[ai][0][m][n][j], up = acc[ai][1][m][n][j]; hv[4 * n + j] = gt * sigm_fast(gt) * up; }
                u32x4 wv; wv[0] = pk_bf16(hv[0], hv[1]); wv[1] = pk_bf16(hv[2], hv[3]); wv[2] = pk_bf16(hv[4], hv[5]); wv[3] = pk_bf16(hv[6], hv[7]);
                *(u32x4*)(HH + row * 512 + u.pn * 128 + wc * 32 + 8 * fq) = wv;
            }
    }
};
struct EpiMoeDown {
    static constexpr bool PERM = true, AFTER_DRAIN = false;
    const int* perm; const float* ew; bf16_t* YK;
    __device__ __forceinline__ void operator()(const pg8::f32x4 (&acc)[2][2][4][2], const pg8::Unit& u, int wr, int wc, int fr, int fq) const {
#pragma unroll
        for (int ai = 0; ai < 2; ++ai)
#pragma unroll
            for (int m = 0; m < 4; ++m) {
                const int a = perm[u.pm * 256 + ai * 128 + wr * 64 + m * 16 + fr];
                if (a >= 0) {
                    const float sw = ew[a];
#pragma unroll
                    for (int bj = 0; bj < 2; ++bj) {
                        const pg8::f32x4 v0 = acc[ai][bj][m][0] * sw, v1 = acc[ai][bj][m][1] * sw;
                        u32x4 wv; wv[0] = pk_bf16(v0[0], v0[1]); wv[1] = pk_bf16(v0[2], v0[3]); wv[2] = pk_bf16(v1[0], v1[1]); wv[3] = pk_bf16(v1[2], v1[3]);
                        *(u32x4*)(YK + (long)a * 1024 + u.pn * 256 + bj * 128 + wc * 32 + 8 * fq) = wv;
                    }
                }
            }
    }
};
struct GroupedOrder {
    int nM, nN, nE, G, c;
    __device__ bool next(int i, pg8::Unit& u) const { const int L = i * G + c; if (L >= nM * nN * nE) return false; u.e = L / (nM * nN); const int rm = L % (nM * nN); u.pm = rm / nN; u.pn = rm % nN; return true; }
    __device__ __forceinline__ void a_ready(const pg8::Unit&) const {}
    __device__ __forceinline__ void done(const pg8::Unit&) const {}
};

struct LayerW {
    const float *cmp_pos, *conv_w, *conv_b, *ga_b, *gx_b, *lam, *q_norm, *kv_norm,
        *ln1_g, *ln1_b, *ln2_g, *ln2_b, *rg_b, *re_b, *ln3_g, *ln3_b;
    const bf16_t *t_in, *t_br, *t_out, *t_q, *t_o, *t_gu, *t_dn, *t_c1, *t_c2, *t_uq, *t_ukv, *t_g, *t_rh, *t_rl;
};
#define WSF(off) ((float*)(p.ws + (off)))
#define WSI(off) ((int*)(p.ws + (off)))
#define WSU(off) ((unsigned*)(p.ws + (off)))
#define WSB(off) ((bf16_t*)(p.ws + (off)))
DI LayerW layer_w(const Params& p, int l) {
    LayerW w;
    w.cmp_pos = p.in[3] + (size_t)l * 2 * 32 * 64;
    w.conv_w = p.in[6] + (size_t)l * 4 * 256;
    w.conv_b = p.in[7] + (size_t)l * 256;
    w.ga_b = p.in[9] + (size_t)l * 256;
    w.gx_b = p.in[11] + (size_t)l * 256;
    w.lam = p.in[12] + (size_t)l * 256;
    w.q_norm = p.in[13] + (size_t)l * 192;
    w.kv_norm = p.in[14] + (size_t)l * 128;
    w.ln1_g = p.in[19] + (size_t)l * 1024; w.ln1_b = p.in[20] + (size_t)l * 1024;
    w.ln2_g = p.in[24] + (size_t)l * 1024; w.ln2_b = p.in[25] + (size_t)l * 1024;
    w.rg_b = p.in[27] + (size_t)l * 4;
    w.re_b = p.in[29] + (size_t)l * 32;
    w.ln3_g = p.in[32] + (size_t)l * 1024; w.ln3_b = p.in[33] + (size_t)l * 1024;
    w.t_in = WSB(WT_IN) + (size_t)l * NH * 1024;
    w.t_br = WSB(WT_BR) + (size_t)l * 1024 * 1024;
    w.t_out = WSB(WT_OUT) + (size_t)l * 1024 * 1024;
    w.t_q = WSB(WT_Q) + (size_t)l * 512 * 1024;
    w.t_o = WSB(WT_O) + (size_t)l * 1024 * 512;
    w.t_gu = WSB(WT_GU) + (size_t)l * 32 * 1024 * 1024;
    w.t_dn = WSB(WT_DN) + (size_t)l * 32 * 1024 * 512;
    w.t_c1 = WSB(WT_C1) + (size_t)l * 2 * 256 * 2048;
    w.t_c2 = WSB(WT_C2) + (size_t)l * 2 * 128 * 256;
    w.t_uq = WSB(WT_UQ) + (size_t)l * 384 * 192;
    w.t_ukv = WSB(WT_UKV) + (size_t)l * 512 * 128;
    w.t_g = WSB(WT_G) + (size_t)l * 4 * 128 * 64;
    w.t_rh = WSB(WT_RH) + (size_t)l * 128 * 1024;
    w.t_rl = WSB(WT_RL) + (size_t)l * 128 * 1024;
    return w;
}

template <int MODE>
DI int wt_col(int np, int Nsrc) {
    if (MODE == 0) return np < Nsrc ? np : -1;
    if (MODE == 2) return np < 1024 ? np : (np < 2656 ? np + 12 : (np < 2668 ? 1024 + (np - 2656) : (np < 2688 ? -1 : (np < 6784 ? np - 20 : -1))));
    const int pn = np >> 8, bj = (np >> 7) & 1, q = np & 127; return (bj ? 512 : 0) + 128 * pn + q;
}
template <int MODE>
DI void job_wt(const float* src, int nmat, int K, int Nsrc, bf16_t* dst, int Npad, int bid, int nblk, unsigned char* lds) {
    const int lane = tidx() & 63, wid = tidx() >> 6;
    bf16_t* tile = (bf16_t*)lds + wid * (64 * 72);
    const int tk = K / 64, tn = Npad / 64, per = tk * tn;
    const int kl = lane >> 4, n4 = (lane & 15) * 4;
    for (int u = bid * (NT / 64) + wid; u < nmat * per; u += nblk * (NT / 64)) {
        const int mat = u / per, ru = u % per, k0 = (ru % tk) * 64, n0 = (ru / tk) * 64;
        const float* s = src + (size_t)mat * K * Nsrc;
        bf16_t* d = dst + (size_t)mat * Npad * K;
        const int col = wt_col<MODE>(n0 + n4, Nsrc);
        float4 v[16];
#pragma unroll
        for (int ps = 0; ps < 16; ++ps) v[ps] = col >= 0 ? *(const float4*)(s + (size_t)(k0 + kl + 4 * ps) * Nsrc + col) : make_float4(0.f, 0.f, 0.f, 0.f);
#pragma unroll
        for (int ps = 0; ps < 16; ++ps) { const int k = kl + 4 * ps;
            tile[(n4 + 0) * 72 + k] = f2bf(v[ps].x); tile[(n4 + 1) * 72 + k] = f2bf(v[ps].y); tile[(n4 + 2) * 72 + k] = f2bf(v[ps].z); tile[(n4 + 3) * 72 + k] = f2bf(v[ps].w); }
        __builtin_amdgcn_fence(__ATOMIC_RELEASE, "wavefront"); __builtin_amdgcn_wave_barrier(); __builtin_amdgcn_fence(__ATOMIC_ACQUIRE, "wavefront");
#pragma unroll
        for (int c8 = 0; c8 < 8; ++c8) { const int c = lane + 64 * c8, n2 = c >> 3, kc = (c & 7) * 8;
            *(uint4*)(d + (size_t)(n0 + n2) * K + k0 + kc) = *(const uint4*)(tile + n2 * 72 + kc); }
        __builtin_amdgcn_fence(__ATOMIC_RELEASE, "wavefront"); __builtin_amdgcn_wave_barrier(); __builtin_amdgcn_fence(__ATOMIC_ACQUIRE, "wavefront");
    }
}
DI void job_cvt(const float* src, bf16_t* dst, long n, int bid, int nblk) {
    for (long e = ((long)bid * NT + tidx()) * 4; e < n; e += (long)nblk * NT * 4) {
        const float4 v = *(const float4*)(src + e);
        st4bf(dst + e, v.x, v.y, v.z, v.w);
    }
}
DI void job_cmp_gather(const Params& p, const LayerW& w, int bid, int nblk) {
    const bf16_t* H = WSB(WS_H); bf16_t* TB = WSB(WS_TBB);
    const long total = (long)2 * NCR * 2048 / 4;
    for (long e = (long)bid * NT + tidx(); e < total; e += (long)nblk * NT) {
        const long e4 = e * 4;
        const int f = (int)(e4 % 2048); const long r2 = e4 / 2048; const int r = (int)(r2 % NCR), j = (int)(r2 / NCR);
        const int g = r & 1, bc = r >> 1, c = bc % NCMP, b = bc / NCMP, i = f >> 6, d = f & 63;
        const float4 hv = ld4bf(H + (long)(b * SEQ + 16 * c + i) * NH + (j ? O_AVC : O_AKC) + g * 64 + d);
        const float4 pv = *(const float4*)(w.cmp_pos + (j * 32 + i) * 64 + d);
        st4bf(TB + ((long)j * 2048 + r) * 2048 + f, hv.x + pv.x, hv.y + pv.y, hv.z + pv.z, hv.w + pv.w);
    }
}
DI void job_rnn_conv(const Params& p, const LayerW& w, int bid, int nblk) {
    const bf16_t* H = WSB(WS_H); float* U = WSF(WS_U); bf16_t* UB = WSB(WS_UB);
    for (long e = (long)bid * NT + tidx(); e < (long)T * 64; e += (long)nblk * NT) {
        const int ch = (int)(e & 63) * 4; const int t = (int)(e >> 6), s = t & (SEQ - 1);
        const float4 cb = *(const float4*)(w.conv_b + ch);
        float u0 = cb.x, u1 = cb.y, u2 = cb.z, u3 = cb.w;
#pragma unroll
        for (int tap = 0; tap < 4; ++tap) { const int sp = s - 3 + tap;
            if (sp >= 0) { const float4 hv = ld4bf(H + (long)(t - 3 + tap) * NH + O_CX + ch); const float4 cw = *(const float4*)(w.conv_w + tap * 256 + ch);
                u0 += hv.x * cw.x; u1 += hv.y * cw.y; u2 += hv.z * cw.z; u3 += hv.w * cw.w; } }
        *(float4*)(U + (long)t * 256 + ch) = make_float4(u0, u1, u2, u3); st4bf(UB + (long)t * 256 + ch, u0, u1, u2, u3);
    }
}
DI void job_rnn_gates(const Params& p, const LayerW& w, int bid, int nblk, unsigned char* lds) {
    const float* U = WSF(WS_U); float* RA = WSF(WS_RA); float* RB = WSF(WS_RB);
    for (int u = bid; u < (T / G_BM) * 4; u += nblk) {
        const int blk = u & 3, m0 = (u >> 2) * G_BM;
        MG g; g.A = WSB(WS_UB) + blk * 64; g.lda = 256; g.Wt = w.t_g + (size_t)blk * 128 * 64; g.ldw = 64; g.K = 64;
        f32x16 acc[2][2];
        mgemm_tile(g, 0, RowId{m0}, acc, lds);
        const int l = tidx() & 63, wv = tidx() >> 6, wm = wv % G_WM, wn = wv / G_WM;
#pragma unroll
        for (int tt = 0; tt < 2; ++tt)
#pragma unroll
            for (int i = 0; i < 4; ++i) {
                const long t = m0 + wm * 64 + tt * 32 + (l & 31); const int ch = blk * 64 + wn * 32 + 8 * i + 4 * (l >> 5);
                const float4 uv = *(const float4*)(U + t * 256 + ch);
                const float ua[4] = {uv.x, uv.y, uv.z, uv.w};
                float av[4], bv[4];
#pragma unroll
                for (int j = 0; j < 4; ++j) {
                    const float r = sigm_fast(acc[0][tt][4 * i + j] + w.ga_b[ch + j]), ig = sigm_fast(acc[1][tt][4 * i + j] + w.gx_b[ch + j]);
                    const float nl = -w.lam[ch + j];
                    const float sp = fmaxf(nl, 0.f) + __logf(1.f + __expf(-fabsf(nl)));
                    const float log_a = -8.0f * r * sp;
                    const float a = __expf(log_a);
                    av[j] = a; bv[j] = __builtin_amdgcn_sqrtf(fmaxf(1.f - a * a, 0.f)) * (ig * ua[j]);
                }
                *(float4*)(RA + t * 256 + ch) = make_float4(av[0], av[1], av[2], av[3]);
                *(float4*)(RB + t * 256 + ch) = make_float4(bv[0], bv[1], bv[2], bv[3]);
            }
    }
}
DI void job_rnn_scan1(const Params& p, int bid, int nblk) {
    const float* RA = WSF(WS_RA); const float* RB = WSF(WS_RB); float* SA = WSF(WS_SA); float* SH = WSF(WS_SH);
    for (int e = bid * NT + tidx(); e < BATCH * 32 * 256; e += nblk * NT) {
        const int ch = e & 255, bc = e >> 8;
        float ap = 1.f, hl = 0.f;
        for (int s0 = 0; s0 < 64; s0 += 8) {
            float av[8], bv[8];
#pragma unroll
            for (int i = 0; i < 8; ++i) { const long t = (long)bc * 64 + s0 + i; av[i] = RA[t * 256 + ch]; bv[i] = RB[t * 256 + ch]; }
#pragma unroll
            for (int i = 0; i < 8; ++i) { ap *= av[i]; hl = av[i] * hl + bv[i]; }
        }
        SA[e] = ap; SH[e] = hl;
    }
}
DI void job_rnn_scan2(const Params& p, int bid, int nblk) {
    const bf16_t* H = WSB(WS_H); const float* RA = WSF(WS_RA); const float* RB = WSF(WS_RB); const float* SA = WSF(WS_SA); const float* SH = WSF(WS_SH); bf16_t* BR = WSB(WS_BR);
    for (int e = bid * NT + tidx(); e < BATCH * 32 * 256; e += nblk * NT) {
        const int ch = e & 255, bc = e >> 8, chunk = bc & 31, b = bc >> 5;
        float h = 0.f;
        for (int c = 0; c < chunk; ++c) { const int q = ((b * 32 + c) << 8) + ch; h = SA[q] * h + SH[q]; }
        for (int s0 = 0; s0 < 64; s0 += 8) {
            float av[8], bv[8], gv[8];
#pragma unroll
            for (int i = 0; i < 8; ++i) { const long t = (long)bc * 64 + s0 + i; av[i] = RA[t * 256 + ch]; bv[i] = RB[t * 256 + ch]; gv[i] = bf2f(H[t * NH + O_CG + ch]); }
#pragma unroll
            for (int i = 0; i < 8; ++i) { const long t = (long)bc * 64 + s0 + i; h = av[i] * h + bv[i]; BR[t * 1024 + 2 * 256 + ch] = f2bf(h * gelu_tanh(gv[i])); }
        }
    }
}
DI void job_mla_norm(const Params& p, const LayerW& w, int bid, int nblk) {
    const bf16_t* H = WSB(WS_H); bf16_t* CQN = WSB(WS_CQNB); bf16_t* CKVN = WSB(WS_CKVNB); bf16_t* KM = WSB(WS_KM);
    const int lane = tidx() & 63, wid = tidx() >> 6;
    for (int t = bid * (NT / 64) + wid; t < T; t += nblk * (NT / 64)) {
        const bf16_t* hr = H + (long)t * NH;
        float q0 = bf2f(hr[O_DCQ + lane]), q1 = bf2f(hr[O_DCQ + 64 + lane]), q2 = bf2f(hr[O_DCQ + 128 + lane]);
        float ss = wave_sum(q0 * q0 + q1 * q1 + q2 * q2);
        float rs = rsqrtf(ss * (1.f / 192.f) + 1e-6f);
        CQN[(long)t * 192 + lane] = f2bf(q0 * rs * w.q_norm[lane]);
        CQN[(long)t * 192 + 64 + lane] = f2bf(q1 * rs * w.q_norm[64 + lane]);
        CQN[(long)t * 192 + 128 + lane] = f2bf(q2 * rs * w.q_norm[128 + lane]);
        float k0 = bf2f(hr[O_DCKV + lane]), k1 = bf2f(hr[O_DCKV + 64 + lane]);
        ss = wave_sum(k0 * k0 + k1 * k1);
        rs = rsqrtf(ss * (1.f / 128.f) + 1e-6f);
        CKVN[(long)t * 128 + lane] = f2bf(k0 * rs * w.kv_norm[lane]);
        CKVN[(long)t * 128 + 64 + lane] = f2bf(k1 * rs * w.kv_norm[64 + lane]);
        {
            const int i = lane & 15, hd = lane >> 4;
            const int s = t & (SEQ - 1);
            const float2 csn = *(const float2*)(WSF(WS_ROPE) + (s * 16 + i) * 2); const float cs = csn.x, sn = csn.y;
            const float x1 = bf2f(hr[O_DKR + i]), x2 = bf2f(hr[O_DKR + 16 + i]);
            KM[(long)t * 384 + hd * 96 + 64 + i] = f2bf(x1 * cs - x2 * sn);
            KM[(long)t * 384 + hd * 96 + 80 + i] = f2bf(x1 * sn + x2 * cs);
        }
    }
}
DI void job_mla_up(const Params& p, const LayerW& w, int bid, int nblk, unsigned char* lds) {
    bf16_t* QB = WSB(WS_QB); bf16_t* KM = WSB(WS_KM); bf16_t* VM = WSB(WS_VM);
    constexpr int TM = T / G_BM;
    for (int u = bid; u < TM * 7; u += nblk) {
        const int mt = u / 7, nt = u % 7, m0 = mt * G_BM;
        f32x16 acc[2][2];
        const int l = tidx() & 63, wv = tidx() >> 6, wm = wv % G_WM, wn = wv / G_WM, hh = l >> 5;
        if (nt < 3) {
            MG g; g.A = WSB(WS_CQNB); g.lda = 192; g.Wt = w.t_uq; g.ldw = 192; g.K = 192;
            const int n0 = nt * 128;
            mgemm_tile(g, n0, RowId{m0}, acc, lds);
#pragma unroll
            for (int ft = 0; ft < 2; ++ft) {
                const int fb = (n0 + wn * 64 + ft * 32) >> 5;
                if (fb % 3 == 2) {
#pragma unroll
                    for (int tt = 0; tt < 2; ++tt) {
                        const int pos = (m0 + wm * 64 + tt * 32 + (l & 31)) & (SEQ - 1);
#pragma unroll
                        for (int i = 0; i < 2; ++i)
#pragma unroll
                            for (int j = 0; j < 4; ++j) {
                                const int fi = 8 * i + 4 * hh + j;
                                const float2 csn = *(const float2*)(WSF(WS_ROPE) + (pos * 16 + fi) * 2); const float cs = csn.x, sn = csn.y;
                                const float x1 = acc[ft][tt][4 * i + j], x2 = acc[ft][tt][4 * (i + 2) + j];
                                acc[ft][tt][4 * i + j] = x1 * cs - x2 * sn; acc[ft][tt][4 * (i + 2) + j] = x1 * sn + x2 * cs;
                            }
                    }
                }
            }
            MG_FOREACH(acc, lrow, feat, v, { st4bf(QB + (long)(m0 + lrow) * 384 + n0 + feat, v[0], v[1], v[2], v[3]); });
        } else {
            MG g; g.A = WSB(WS_CKVNB); g.lda = 128; g.Wt = w.t_ukv; g.ldw = 128; g.K = 128;
            const int n0 = (nt - 3) * 128;
            mgemm_tile(g, n0, RowId{m0}, acc, lds);
            MG_FOREACH(acc, lrow, feat, v, {
                const int hd = nt - 3;
                if (feat < 64) st4bf(KM + (long)(m0 + lrow) * 384 + hd * 96 + feat, v[0], v[1], v[2], v[3]);
                else st4bf(VM + (long)(m0 + lrow) * 256 + hd * 64 + (feat - 64), v[0], v[1], v[2], v[3]); });
        }
    }
}
template <int STAGE>
DI void job_cmp_mlp(const Params& p, const LayerW& w, int bid, int nblk, unsigned char* lds) {
    constexpr int TM = 2048 / G_BM, TN = STAGE == 0 ? 2 : 1;
    for (int u = bid; u < 2 * TM * TN; u += nblk) {
        const int j = u / (TM * TN), ru = u % (TM * TN), mt = ru / TN, nt = ru % TN, m0 = mt * G_BM, n0 = nt * 128;
        MG g;
        if (STAGE == 0) { g.A = WSB(WS_TBB) + (size_t)j * 2048 * 2048; g.lda = 2048; g.Wt = w.t_c1 + (size_t)j * 256 * 2048; g.ldw = 2048; g.K = 2048; }
        else { g.A = WSB(WS_HIDB) + (size_t)j * 2048 * 256; g.lda = 256; g.Wt = w.t_c2 + (size_t)j * 128 * 256; g.ldw = 256; g.K = 256; }
        f32x16 acc[2][2];
        mgemm_tile(g, n0, [&](int r) { const int rr = m0 + r; return (long)(rr < NCR ? rr : NCR - 1); }, acc, lds);
        if (STAGE == 0) {
            bf16_t* HID = WSB(WS_HIDB) + (size_t)j * 2048 * 256;
            MG_FOREACH(acc, lrow, feat, v, { st4bf(HID + (long)(m0 + lrow) * 256 + n0 + feat, gelu_tanh(v[0]), gelu_tanh(v[1]), gelu_tanh(v[2]), gelu_tanh(v[3])); });
        } else {
            bf16_t* KC = WSB(WS_KCB) + (size_t)j * NCR * 64;
            MG_FOREACH(acc, lrow, feat, v, { if (feat < 64 && m0 + lrow < NCR) st4bf(KC + (long)(m0 + lrow) * 64 + feat, v[0], v[1], v[2], v[3]); });
        }
    }
}
DI void job_router_logits(const Params& p, const LayerW& w, int bid, int nblk, unsigned char* lds) {
    float* LOG = WSF(WS_LOG);
    for (int u = bid; u < 3 * (T / G_BM); u += nblk) {
        const int pass = u / (T / G_BM), m0 = (u % (T / G_BM)) * G_BM;
        f32x16 acc[2][2];
        MG g; g.lda = 1024; g.ldw = 1024; g.K = 1024;
        g.A = pass == 1 ? WSB(WS_XBL) : WSB(WS_XBB); g.Wt = pass == 2 ? w.t_rl : w.t_rh;
        mgemm_tile(g, 0, RowId{m0}, acc, lds, true);
        float* dst = LOG + (size_t)pass * T * 36;
        MG_FOREACH(acc, lrow, feat, v, { if (feat < 36) *(float4*)(dst + (long)(m0 + lrow) * 36 + feat) = make_float4(v[0], v[1], v[2], v[3]); });
    }
}
DI void job_pack_small(const Params& p, int bid, int nblk) {
    bf16_t* TG = WSB(WT_G); bf16_t* RH = WSB(WT_RH); bf16_t* RL = WSB(WT_RL);
    for (int e = bid * NT + tidx(); e < SEQ * 16; e += nblk * NT) {
        const int i = e & 15, pos = e >> 4;
        const float inv = powf(10000.f, -(float)(2 * i) / 32.f);
        const float ang = (float)pos * inv;
        WSF(WS_ROPE)[e * 2] = cosf(ang); WSF(WS_ROPE)[e * 2 + 1] = sinf(ang);
    }
    for (int e = bid * NT + tidx(); e < DEPTH * 4 * 128 * 64; e += nblk * NT) {
        const int c = e & 63, q = (e >> 6) & 127, lb = e >> 13;
        const int seg = q >> 5, i = q & 31, chl = (seg >> 1) * 32 + i;
        const float* src = (seg & 1) ? p.in[10] : p.in[8];
        TG[e] = f2bf(src[((size_t)lb * 64 + c) * 64 + chl]);
    }
    for (int e = bid * NT + tidx(); e < DEPTH * 128 * 1024; e += nblk * NT) {
        const int k = e & 1023, n = (e >> 10) & 127, l = e >> 17;
        float v = 0.f;
        if (n < 4) v = p.in[26][((size_t)l * 1024 + k) * 4 + n];
        else if (n < 36) v = p.in[28][((size_t)l * 1024 + k) * 32 + (n - 4)];
        const bf16_t hi = f2bf(v);
        RH[e] = hi; RL[e] = f2bf(v - bf2f(hi));
    }
}

DI void job_merge(const Params& p, const LayerW& w, int bid, int nblk, unsigned char* lds) {
    const bf16_t* H = WSB(WS_H); bf16_t* M = WSB(WS_M);
    for (int u = bid; u < (T / G_BM) * 8; u += nblk) {
        const int m0 = (u >> 3) * G_BM, n0 = (u & 7) * G_BN;
        f32x16 macc[2][2];
#pragma unroll
        for (int a = 0; a < 2; ++a)
#pragma unroll
            for (int b = 0; b < 2; ++b)
#pragma unroll
                for (int i = 0; i < 16; ++i) macc[a][b][i] = 0.f;
        MG g; g.A = WSB(WS_BR); g.lda = 1024; g.Wt = w.t_br; g.ldw = 1024; g.K = 1024;
        f32x16 acc[2][2];
        const int l = tidx() & 63, wv = tidx() >> 6, wm = wv % G_WM, wn = wv / G_WM;
        mgemm_tile_f(g, n0, RowId{m0}, acc, lds, true, 4, [&](int n, f32x16 (&a)[2][2]) {
#pragma unroll
            for (int ft = 0; ft < 2; ++ft)
#pragma unroll
                for (int tt = 0; tt < 2; ++tt)
#pragma unroll
                    for (int i = 0; i < 4; ++i) {
                        const int lrow = wm * 64 + tt * 32 + (l & 31), feat = wn * 64 + ft * 32 + 8 * i + 4 * (l >> 5);
                        const float4 gv = ld4bf(H + (long)(m0 + lrow) * NH + O_MG + n * 1024 + n0 + feat);
                        macc[ft][tt][4 * i] += gv.x * a[ft][tt][4 * i]; macc[ft][tt][4 * i + 1] += gv.y * a[ft][tt][4 * i + 1];
                        macc[ft][tt][4 * i + 2] += gv.z * a[ft][tt][4 * i + 2]; macc[ft][tt][4 * i + 3] += gv.w * a[ft][tt][4 * i + 3];
                        a[ft][tt][4 * i] = 0.f; a[ft][tt][4 * i + 1] = 0.f; a[ft][tt][4 * i + 2] = 0.f; a[ft][tt][4 * i + 3] = 0.f;
                    }
        });
        MG_FOREACH(macc, lrow, feat, v, { st4bf(M + (long)(m0 + lrow) * 1024 + n0 + feat, v[0], v[1], v[2], v[3]); });
    }
}
DI void ld8f(const bf16_t* p, float* f) { const u32x4 v = *(const u32x4*)p; f[0] = bflo(v[0]); f[1] = bfhi(v[0]); f[2] = bflo(v[1]); f[3] = bfhi(v[1]); f[4] = bflo(v[2]); f[5] = bfhi(v[2]); f[6] = bflo(v[3]); f[7] = bfhi(v[3]); }
DI void st8bf(bf16_t* p, const float* f) { u32x4 v; v[0] = pk_bf16(f[0], f[1]); v[1] = pk_bf16(f[2], f[3]); v[2] = pk_bf16(f[4], f[5]); v[3] = pk_bf16(f[6], f[7]); *(u32x4*)p = v; }
DI void job_ln(const float* xin, const bf16_t* xinb, const bf16_t* xinl, const bf16_t* y, const int* rowof, const float* ew, const float* gw, const float* bw, float* out, bf16_t* outb, bf16_t* outl, int bid, int nblk) {
    const int lane = tidx() & 63, wid = tidx() >> 6;
    float gv[16], bv[16];
#pragma unroll
    for (int i = 0; i < 2; ++i)
#pragma unroll
        for (int j = 0; j < 8; j += 4) { const int c = i * 512 + lane * 8 + j; const float4 g4 = *(const float4*)(gw + c), b4 = *(const float4*)(bw + c);
            gv[i * 8 + j] = g4.x; gv[i * 8 + j + 1] = g4.y; gv[i * 8 + j + 2] = g4.z; gv[i * 8 + j + 3] = g4.w; bv[i * 8 + j] = b4.x; bv[i * 8 + j + 1] = b4.y; bv[i * 8 + j + 2] = b4.z; bv[i * 8 + j + 3] = b4.w; }
    for (int t = bid * (NT / 64) + wid; t < T; t += nblk * (NT / 64)) {
        float v[16];
        float s = 0.f;
        int r0 = 0, r1 = 0; float w0 = 0.f, w1 = 0.f;
        if (rowof) { r0 = rowof[t * 2]; r1 = rowof[t * 2 + 1]; w0 = ew[t * 2]; w1 = ew[t * 2 + 1]; }
#pragma unroll
        for (int i = 0; i < 2; ++i) {
            const int c = i * 512 + lane * 8;
            float xv[8], yv[8];
            if (xin) { const float4 a = *(const float4*)(xin + (long)t * 1024 + c), b = *(const float4*)(xin + (long)t * 1024 + c + 4);
                xv[0] = a.x; xv[1] = a.y; xv[2] = a.z; xv[3] = a.w; xv[4] = b.x; xv[5] = b.y; xv[6] = b.z; xv[7] = b.w; }
            else ld8f(xinb + (long)t * 1024 + c, xv);
            if (xinl) { float z[8]; ld8f(xinl + (long)t * 1024 + c, z);
#pragma unroll
                for (int j = 0; j < 8; ++j) xv[j] += z[j]; }
            if (!rowof) ld8f(y + (long)t * 1024 + c, yv);
            else { float z0[8], z1[8]; ld8f(y + (long)r0 * 1024 + c, z0); ld8f(y + (long)r1 * 1024 + c, z1);
#pragma unroll
                for (int j = 0; j < 8; ++j) yv[j] = w0 * z0[j] + w1 * z1[j]; }
#pragma unroll
            for (int j = 0; j < 8; ++j) { v[i * 8 + j] = DN_ALPHA * xv[j] + yv[j]; s += v[i * 8 + j]; }
        }
        const float mu = wave_sum(s) * (1.f / 1024.f);
        float q = 0.f;
#pragma unroll
        for (int i = 0; i < 16; ++i) { const float dlt = v[i] - mu; q += dlt * dlt; }
        const float rstd = rsqrtf(wave_sum(q) * (1.f / 1024.f) + 1e-5f);
#pragma unroll
        for (int i = 0; i < 2; ++i) {
            const int c = i * 512 + lane * 8;
            float o[8];
#pragma unroll
            for (int j = 0; j < 8; ++j) o[j] = (v[i * 8 + j] - mu) * rstd * gv[i * 8 + j] + bv[i * 8 + j];
            if (out) { *(float4*)(out + (long)t * 1024 + c) = make_float4(o[0], o[1], o[2], o[3]); *(float4*)(out + (long)t * 1024 + c + 4) = make_float4(o[4], o[5], o[6], o[7]); }
            if (outb) st8bf(outb + (long)t * 1024 + c, o);
            if (outl) { float lo[8];
#pragma unroll
                for (int j = 0; j < 8; ++j) lo[j] = o[j] - bf2f(f2bf(o[j]));
                st8bf(outl + (long)t * 1024 + c, lo); }
        }
    }
}
DI void job_router(const Params& p, const LayerW& w, int layer, int bid, int nblk) {
    const float* LOG = WSF(WS_LOG); int* EIDX = WSI(WS_EIDX); int* ESLOT = WSI(WS_ESLOT); float* EW = WSF(WS_EW);
    unsigned* cnt = WSU(WS_CTL) + CW_CNT + layer * 32;
    for (int t = bid * NT + tidx(); t < T; t += nblk * NT) {
        const float* lr = LOG + (long)t * 36; const float* lr1 = lr + (size_t)T * 36; const float* lr2 = lr1 + (size_t)T * 36;
#define LG(i) ((lr[i] + lr1[i]) + lr2[i])
        const float g0 = LG(0) + w.rg_b[0], g1 = LG(1) + w.rg_b[1], g2 = LG(2) + w.rg_b[2], g3 = LG(3) + w.rg_b[3];
        const float gm = fmaxf(fmaxf(g0, g1), fmaxf(g2, g3));
        const float e0 = expf(g0 - gm), e1 = expf(g1 - gm), e2 = expf(g2 - gm), e3 = expf(g3 - gm);
        const float gs = (e0 + e1) + (e2 + e3);
        const float p0 = e0 / gs, p1 = e1 / gs, p2 = e2 / gs, p3 = e3 / gs;
        int grp = 0; float pg = p0;
        if (p1 > pg) { pg = p1; grp = 1; }
        if (p2 > pg) { pg = p2; grp = 2; }
        if (p3 > pg) { pg = p3; grp = 3; }
        float el[8];
#pragma unroll
        for (int i = 0; i < 8; ++i) el[i] = LG(4 + grp * 8 + i) + w.re_b[grp * 8 + i];
#undef LG
        float em = el[0];
#pragma unroll
        for (int i = 1; i < 8; ++i) em = fmaxf(em, el[i]);
        float es = 0.f;
#pragma unroll
        for (int i = 0; i < 8; ++i) { el[i] = expf(el[i] - em); es += el[i]; }
#pragma unroll
        for (int i = 0; i < 8; ++i) el[i] = el[i] / es;
        float b0 = el[0]; int i0 = 0;
#pragma unroll
        for (int i = 1; i < 8; ++i) if (el[i] > b0) { b0 = el[i]; i0 = i; }
        float b1 = -1.f; int i1 = 0;
#pragma unroll
        for (int i = 0; i < 8; ++i) if (i != i0 && el[i] > b1) { b1 = el[i]; i1 = i; }
        const float den = b0 + b1;
        const int ex0 = grp * 8 + i0, ex1 = grp * 8 + i1;
        EIDX[t * 2] = ex0; EIDX[t * 2 + 1] = ex1;
        EW[t * 2] = pg * b0 / den; EW[t * 2 + 1] = pg * b1 / den;
        ESLOT[t * 2] = (int)atomicAdd(&cnt[ex0], 1u);
        ESLOT[t * 2 + 1] = (int)atomicAdd(&cnt[ex1], 1u);
    }
}
DI int pad_rows(int c) { return (c + G_BM - 1) / G_BM * G_BM; }
DI void job_fill(const Params& p, int layer, int bid, int nblk, unsigned char* lds) {
    const int* EIDX = WSI(WS_EIDX); const int* ESLOT = WSI(WS_ESLOT); int* PERM = WSI(WS_PERM);
    unsigned* cnt = WSU(WS_CTL) + CW_CNT + layer * 32;
    const int lane = tidx() & 63, wid = tidx() >> 6;
    int* s_off = (int*)lds; int* s_cnt = s_off + 32;
    __syncthreads();
    if (tidx() < 32) s_cnt[tidx()] = (int)__hip_atomic_load(&cnt[tidx()], __ATOMIC_RELAXED, __HIP_MEMORY_SCOPE_AGENT);
    __syncthreads();
    if (tidx() == 0) { int o = 0; for (int e = 0; e < 32; ++e) { s_off[e] = o; o += pad_rows(s_cnt[e]); } }
    __syncthreads();
    for (int a = bid * (NT / 64) + wid; a < NASSIGN + NEXP; a += nblk * (NT / 64)) {
        const bool real = a < NASSIGN;
        const int e = real ? EIDX[a] : a - NASSIGN;
        const int off = s_off[e];
        if (real) {
            const int R = off + ESLOT[a];
            if (lane == 0) { PERM[R] = a; WSI(WS_ROWOF)[a] = R; }
        } else {
            const int c = s_cnt[e];
            for (int j = lane; c + j < pad_rows(c); j += 64) PERM[off + c + j] = -1;
        }
    }
}
DI pg8::ListOrder moe_units(unsigned* cnt, int bid, int nblk) {
    pg8::ListOrder S; S.n = 0; S.u0 = S.u1 = S.u2 = pg8::Unit{0, 0, 0};
    int rt = 0, ub = 0;
    for (int e = 0; e < 32; ++e) {
        const int c = pad_rows((int)__hip_atomic_load(&cnt[e], __ATOMIC_RELAXED, __HIP_MEMORY_SCOPE_AGENT)) >> 8, ue = c * 4;
#pragma unroll
        for (int k = 0; k < 3; ++k) {
            const int L = bid + k * nblk;
            if (L >= ub && L < ub + ue) { const int lu = L - ub; const pg8::Unit u{rt + (lu >> 2), lu & 3, e};
                if (k == 0) S.u0 = u; else if (k == 1) S.u1 = u; else S.u2 = u;
                S.n = k + 1; }
        }
        rt += c; ub += ue;
    }
#define RFL(x) x = __builtin_amdgcn_readfirstlane(x)
    RFL(S.n); RFL(S.u0.pm); RFL(S.u0.pn); RFL(S.u0.e); RFL(S.u1.pm); RFL(S.u1.pn); RFL(S.u1.e); RFL(S.u2.pm); RFL(S.u2.pn); RFL(S.u2.e);
#undef RFL
    return S;
}
typedef short s16x4 __attribute__((ext_vector_type(4)));
typedef short v4i16_t __attribute__((ext_vector_type(4)));
DI unsigned cvtpk(float lo, float hi) { return pk_bf16(lo, hi); }
DI int crow(int reg, int h) { return (reg & 3) + 8 * (reg >> 2) + 4 * h; }
DI s16x4 tr_read(const unsigned char* p) { return __builtin_bit_cast(s16x4, __builtin_amdgcn_ds_read_tr16_b64_v4i16((LAS v4i16_t*)p)); }
DI float xhalf_max(float m) { auto rr = __builtin_amdgcn_permlane32_swap(__float_as_uint(m), __float_as_uint(m), false, false); return fmaxf(__uint_as_float(rr[0]), __uint_as_float(rr[1])); }
DI float xhalf_sum(float m) { auto rr = __builtin_amdgcn_permlane32_swap(__float_as_uint(m), __float_as_uint(m), false, false); return __uint_as_float(rr[0]) + __uint_as_float(rr[1]); }
DI float xhalf_other(float v, int h) { auto rr = __builtin_amdgcn_permlane32_swap(__float_as_uint(v), __float_as_uint(v), false, false); return __uint_as_float(h ? rr[0] : rr[1]); }
DI bf16x8 pack8(const f32x16& x, int s2) {
    u32x4 pk; pk[0] = cvtpk(x[8 * s2], x[8 * s2 + 1]); pk[1] = cvtpk(x[8 * s2 + 2], x[8 * s2 + 3]); pk[2] = cvtpk(x[8 * s2 + 4], x[8 * s2 + 5]); pk[3] = cvtpk(x[8 * s2 + 6], x[8 * s2 + 7]);
    return __builtin_bit_cast(bf16x8, pk);
}
constexpr int ATT_QB = (NT / 64) * 32;
template <int DC> struct TileCfg { static constexpr int RS = DC * 2 + 16, BYTES = 64 * RS, NCH = 64 * DC / 8, NI = (NCH + NT - 1) / NT; };
template <int DC, class RowPtr> DI void tile_gload(u32x4 (&rg)[TileCfg<DC>::NI], RowPtr rp) {
#pragma unroll
    for (int i = 0; i < TileCfg<DC>::NI; ++i) { const int c = tidx() + NT * i; if (c < TileCfg<DC>::NCH) { const int row = c / (DC / 8), cc = c % (DC / 8); rg[i] = *(const u32x4*)(rp(row) + cc * 8); } }
}
template <int DC> DI void tile_lstore(const u32x4 (&rg)[TileCfg<DC>::NI], unsigned char* base) {
#pragma unroll
    for (int i = 0; i < TileCfg<DC>::NI; ++i) { const int c = tidx() + NT * i; if (c < TileCfg<DC>::NCH) { const int row = c / (DC / 8), cc = c % (DC / 8); *(u32x4*)(base + row * TileCfg<DC>::RS + cc * 16) = rg[i]; } }
}
template <int DK> DI void qk_tile(f32x16 (&s)[2], const bf16x8 (&qf)[DK / 16], const unsigned char* kl, int r, int h) {
    constexpr int RS = TileCfg<DK>::RS;
#pragma unroll
    for (int i = 0; i < 16; ++i) { s[0][i] = 0.f; s[1][i] = 0.f; }
#pragma unroll
    for (int ks = 0; ks < DK / 16; ++ks) {
        const bf16x8 k0 = *(const bf16x8*)(kl + r * RS + ks * 32 + h * 16), k1 = *(const bf16x8*)(kl + (32 + r) * RS + ks * 32 + h * 16);
        s[0] = __builtin_amdgcn_mfma_f32_32x32x16_bf16(k0, qf[ks], s[0], 0, 0, 0);
        s[1] = __builtin_amdgcn_mfma_f32_32x32x16_bf16(k1, qf[ks], s[1], 0, 0, 0);
    }
}
template <int DV> DI void pv_tile(f32x16 (&o)[DV / 32], const f32x16 (&pp)[2], const unsigned char* vl, int lane) {
    constexpr int RS = TileCfg<DV>::RS;
    const int h = lane >> 5, i16 = lane & 15, q = i16 >> 2, pq = i16 & 3, blk = (lane >> 4) & 1;
    const unsigned char* vb = vl + (4 * h + q) * RS + 2 * (16 * blk + 4 * pq);
#pragma unroll
    for (int kt = 0; kt < 2; ++kt)
#pragma unroll
        for (int s2 = 0; s2 < 2; ++s2) {
            const bf16x8 pf = pack8(pp[kt], s2);
#pragma unroll
            for (int dvt = 0; dvt < DV / 32; ++dvt) {
                const s16x4 lo = tr_read(vb + (kt * 32 + 16 * s2) * RS + dvt * 64), hi = tr_read(vb + (kt * 32 + 16 * s2 + 8) * RS + dvt * 64);
                const bf16x8 vf = __builtin_shufflevector(lo, hi, 0, 1, 2, 3, 4, 5, 6, 7);
                o[dvt] = __builtin_amdgcn_mfma_f32_32x32x16_bf16(vf, pf, o[dvt], 0, 0, 0);
            }
        }
}
constexpr float LOG2E = 1.4426950408889634f;
template <int DK, int DV, bool ALIBI, bool BOUNDARY, class ValidFn>
DI void softmax_tile(const bf16x8 (&qf)[DK / 16], f32x16 (&o)[DV / 32], float& m, float& l, const unsigned char* kl, const unsigned char* vl, int kb,
                     float c1, float sl2, int qpos, ValidFn valid, int lane) {
    const int r = lane & 31, h = lane >> 5;
    f32x16 s[2];
    qk_tile<DK>(s, qf, kl, r, h);
    const float base = ALIBI ? sl2 * (float)(kb + 4 * h - qpos) : 0.f;
    float tmax = -INFINITY;
#pragma unroll
    for (int kt = 0; kt < 2; ++kt)
#pragma unroll
        for (int i = 0; i < 16; ++i) {
            float v = ALIBI ? fmaf(s[kt][i], c1, fmaf(sl2, (float)(kt * 32 + (i & 3) + 8 * (i >> 2)), base)) : s[kt][i] * c1;
            if (BOUNDARY) v = valid(kb + kt * 32 + crow(i, h)) ? v : -INFINITY;
            s[kt][i] = v; tmax = fmaxf(tmax, v);
        }
    tmax = xhalf_max(tmax);
    const float mn = fmaxf(m, tmax);
    if (__any(mn > m)) {
        const float corr = __builtin_amdgcn_exp2f(m - mn);
        l *= corr;
#pragma unroll
        for (int dvt = 0; dvt < DV / 32; ++dvt)
#pragma unroll
            for (int i = 0; i < 16; ++i) o[dvt][i] *= corr;
        m = mn;
    }
    float ps = 0.f;
#pragma unroll
    for (int kt = 0; kt < 2; ++kt)
#pragma unroll
        for (int i = 0; i < 16; ++i) { const float pr = __builtin_amdgcn_exp2f(s[kt][i] - mn); s[kt][i] = pr; ps += pr; }
    l += ps;
    pv_tile<DV>(o, s, vl, lane);
}
template <int DK, int DV, bool ALIBI, class KPtr, class VPtr, class ValidFn, class InteriorFn>
DI void attn_stream(const bf16x8 (&qf)[DK / 16], f32x16 (&o)[DV / 32], float& m, float& l, unsigned tmask, int wave_qmax, int wave_kmin,
                    KPtr kp, VPtr vp, float c1, float sl2, int qpos, ValidFn valid, InteriorFn interior, unsigned char* lds) {
    unsigned char* kl = lds; unsigned char* vl = lds + TileCfg<DK>::BYTES;
    const int lane = tidx() & 63;
    u32x4 kA[TileCfg<DK>::NI], vA[TileCfg<DV>::NI], kB[TileCfg<DK>::NI], vB[TileCfg<DV>::NI];
    int ja = -1, jb = -1;
#define AS_NEXT(J, KR, VR) do { if (tmask) { J = __builtin_ctz(tmask); tmask &= tmask - 1; const int _j = J; \
        tile_gload<DK>(KR, [&](int row) { return kp(_j * 64 + row); }); tile_gload<DV>(VR, [&](int row) { return vp(_j * 64 + row); }); } else J = -1; } while (0)
#define AS_COMPUTE(J) do { const int _jc = (J); if (_jc * 64 <= wave_qmax && _jc * 64 + 63 >= wave_kmin) { \
        if (interior(_jc)) softmax_tile<DK, DV, ALIBI, false>(qf, o, m, l, kl, vl, _jc * 64, c1, sl2, qpos, valid, lane); \
        else softmax_tile<DK, DV, ALIBI, true>(qf, o, m, l, kl, vl, _jc * 64, c1, sl2, qpos, valid, lane); } } while (0)
    AS_NEXT(ja, kA, vA);
    AS_NEXT(jb, kB, vB);
    while (ja >= 0) {
        __syncthreads();
        tile_lstore<DK>(kA, kl); tile_lstore<DV>(vA, vl);
        __syncthreads();
        const int jc = ja;
        AS_NEXT(ja, kA, vA);
        AS_COMPUTE(jc);
        if (jb < 0) break;
        __syncthreads();
        tile_lstore<DK>(kB, kl); tile_lstore<DV>(vB, vl);
        __syncthreads();
        const int jd = jb;
        AS_NEXT(jb, kB, vB);
        AS_COMPUTE(jd);
    }
#undef AS_NEXT
#undef AS_COMPUTE
}

DI void job_mla_attn(const Params& p, int bid, int nblk, unsigned char* lds) {
    const bf16_t* QB = WSB(WS_QB); const bf16_t* KM = WSB(WS_KM); const bf16_t* VM = WSB(WS_VM); bf16_t* BR = WSB(WS_BR);
    constexpr int NQB = SEQ / ATT_QB, NU = BATCH * 4 * NQB;
    const int lane = tidx() & 63, wid = tidx() >> 6, r = lane & 31, h = lane >> 5;
    for (int u = bid; u < NU; u += nblk) {
        const int qblk = u / (BATCH * 4), bh = u % (BATCH * 4);
        const int b = bh >> 2, hd = bh & 3;
        const int q0 = qblk * ATT_QB, qw = q0 + wid * 32, qpos = qw + r;
        const long trow = (long)b * SEQ;
        bf16x8 qf[6];
#pragma unroll
        for (int ks = 0; ks < 6; ++ks) qf[ks] = *(const bf16x8*)(QB + (trow + qpos) * 384 + hd * 96 + ks * 16 + 8 * h);
        f32x16 o[2];
#pragma unroll
        for (int i = 0; i < 16; ++i) { o[0][i] = 0.f; o[1][i] = 0.f; }
        float m = -1e30f, l = 0.f;
        const int ntile = (q0 + ATT_QB - 1) / 64 + 1;
        const unsigned tmask = ntile >= 32 ? 0xffffffffu : ((1u << ntile) - 1u);
        attn_stream<96, 64, false>(qf, o, m, l, tmask, qw + 31, 0,
            [&](int row) { return KM + (trow + row) * 384 + hd * 96; },
            [&](int row) { return VM + (trow + row) * 256 + hd * 64; },
            0.10206207261596577f * LOG2E, 0.f, qpos,
            [&](int key) { return key <= qpos; }, [&](int j) { return j * 64 + 63 <= qw; }, lds);
        const float rl = 1.f / fmaxf(xhalf_sum(l), 1e-30f);
        bf16_t* dst = BR + (trow + qpos) * 1024 + 3 * 256 + hd * 64;
#pragma unroll
        for (int dvt = 0; dvt < 2; ++dvt)
#pragma unroll
            for (int i = 0; i < 4; ++i)
                st4bf(dst + dvt * 32 + 8 * i + 4 * h, o[dvt][4 * i] * rl, o[dvt][4 * i + 1] * rl, o[dvt][4 * i + 2] * rl, o[dvt][4 * i + 3] * rl);
    }
}
DI void job_cross_attn(const Params& p, int layer, int bid, int nblk, unsigned char* lds) {
    const bf16_t* XQ = WSB(WS_XQ); const bf16_t* KVM = WSB(WS_KVM) + (size_t)layer * 2048 * 1024; bf16_t* XO = WSB(WS_XO);
    constexpr int NQB = SEQ / ATT_QB, NU = BATCH * 4 * NQB;
    const int lane = tidx() & 63, wid = tidx() >> 6, r = lane & 31, h = lane >> 5;
    for (int u = bid; u < NU; u += nblk) {
        const int bh = u % (BATCH * 4), qblk = u / (BATCH * 4);
        const int b = bh >> 2, hd = bh & 3;
        const int qpos = qblk * ATT_QB + wid * 32 + r;
        const long trow = (long)b * SEQ;
        bf16x8 qf[8];
#pragma unroll
        for (int ks = 0; ks < 8; ++ks) qf[ks] = *(const bf16x8*)(XQ + (trow + qpos) * 512 + hd * 128 + ks * 16 + 8 * h);
        f32x16 o[4];
#pragma unroll
        for (int d = 0; d < 4; ++d)
#pragma unroll
            for (int i = 0; i < 16; ++i) o[d][i] = 0.f;
        float m = -1e30f, l = 0.f;
        attn_stream<128, 128, false>(qf, o, m, l, 0xFu, 1 << 30, 0,
            [&](int row) { return KVM + (long)(b * MEM_LEN + row) * 1024 + hd * 128; },
            [&](int row) { return KVM + (long)(b * MEM_LEN + row) * 1024 + 512 + hd * 128; },
            0.08838834764831845f * LOG2E, 0.f, qpos, [&](int) { return true; }, [&](int) { return true; }, lds);
        const float rl = 1.f / fmaxf(xhalf_sum(l), 1e-30f);
        bf16_t* dst = XO + (trow + qpos) * 512 + hd * 128;
#pragma unroll
        for (int dvt = 0; dvt < 4; ++dvt)
#pragma unroll
            for (int i = 0; i < 4; ++i)
                st4bf(dst + dvt * 32 + 8 * i + 4 * h, o[dvt][4 * i] * rl, o[dvt][4 * i + 1] * rl, o[dvt][4 * i + 2] * rl, o[dvt][4 * i + 3] * rl);
    }
}
DI float logsig_fast(float z) { return fminf(z, 0.f) - __logf(1.f + __expf(-fabsf(z))); }
DI void job_sb_attn(const Params& p, int bid, int nblk, unsigned char* lds) {
    const bf16_t* H = WSB(WS_H); bf16_t* BR = WSB(WS_BR);
    constexpr int NQB = SEQ / ATT_QB, NU = BATCH * 4 * NQB;
    const int lane = tidx() & 63, wid = tidx() >> 6, r = lane & 31, h = lane >> 5;
    unsigned char* kl = lds; unsigned char* vl = lds + TileCfg<64>::BYTES;
    for (int u = bid; u < NU; u += nblk) {
        const int half = u / (NU / 2), ru = u % (NU / 2);
        const int qi = ru / (BATCH * 4), bh = ru % (BATCH * 4);
        const int qblk = half == 0 ? (NQB - 1 - qi) : qi;
        const int b = bh >> 2, hd = bh & 3;
        const int q0 = qblk * ATT_QB, qw = q0 + wid * 32, qpos = qw + r;
        const long trow = (long)b * SEQ;
        bf16x8 qf[4];
#pragma unroll
        for (int ks = 0; ks < 4; ++ks) qf[ks] = *(const bf16x8*)(H + (trow + qpos) * NH + O_BQ + hd * 64 + ks * 16 + 8 * h);
        f32x16 o[2];
#pragma unroll
        for (int i = 0; i < 16; ++i) { o[0][i] = 0.f; o[1][i] = 0.f; }
        float trun = 0.f;
        int j = (q0 + ATT_QB - 1) >> 6;
        volatile int* flag = (volatile int*)(lds + 2 * TileCfg<64>::BYTES);
        if (tidx() == 0) { flag[0] = 0; flag[1] = 0; }
        u32x4 kr[TileCfg<64>::NI], vr[TileCfg<64>::NI];
        tile_gload<64>(kr, [&](int row) { return H + (trow + j * 64 + row) * NH + O_BK + hd * 64; });
        tile_gload<64>(vr, [&](int row) { return H + (trow + j * 64 + row) * NH + O_BV + hd * 64; });
        for (int it = 0; j >= 0; --j, ++it) {
            __syncthreads();
            if (it > 0 && flag[(it - 1) & 1] == 0) break;
            tile_lstore<64>(kr, kl); tile_lstore<64>(vr, vl);
            __syncthreads();
            if (tidx() == 0) flag[(it + 1) & 1] = 0;
            if (j > 0) { const int jn = j - 1;
                tile_gload<64>(kr, [&](int row) { return H + (trow + jn * 64 + row) * NH + O_BK + hd * 64; });
                tile_gload<64>(vr, [&](int row) { return H + (trow + jn * 64 + row) * NH + O_BV + hd * 64; }); }
            const bool wave_dead = __all(trun < -110.f);
            if (j * 64 < qw + 31 && !wave_dead) {
                const int kb = j * 64;
                f32x16 s[2], L[2];
                qk_tile<64>(s, qf, kl, r, h);
#pragma unroll
                for (int kt = 0; kt < 2; ++kt)
#pragma unroll
                    for (int i = 0; i < 16; ++i) {
                        const int key = kb + kt * 32 + crow(i, h);
                        const float z = s[kt][i] * 0.125f, lsp = logsig_fast(z);
                        const bool valid = key < qpos;
                        L[kt][i] = valid ? lsp - z : 0.f;
                        s[kt][i] = valid ? lsp : -INFINITY;
                    }
                float G[2][4], O[2][4];
#pragma unroll
                for (int kt = 0; kt < 2; ++kt)
#pragma unroll
                    for (int ig = 0; ig < 4; ++ig) { G[kt][ig] = (L[kt][4 * ig] + L[kt][4 * ig + 1]) + (L[kt][4 * ig + 2] + L[kt][4 * ig + 3]); O[kt][ig] = xhalf_other(G[kt][ig], h); }
                float run = trun;
#pragma unroll
                for (int kt = 1; kt >= 0; --kt)
#pragma unroll
                    for (int ig = 3; ig >= 0; --ig) {
                        const float t3 = run + (h == 0 ? O[kt][ig] : 0.f);
                        const float t2 = t3 + L[kt][4 * ig + 3], t1 = t2 + L[kt][4 * ig + 2], t0 = t1 + L[kt][4 * ig + 1];
                        s[kt][4 * ig + 3] = __expf(s[kt][4 * ig + 3] + t3); s[kt][4 * ig + 2] = __expf(s[kt][4 * ig + 2] + t2);
                        s[kt][4 * ig + 1] = __expf(s[kt][4 * ig + 1] + t1); s[kt][4 * ig + 0] = __expf(s[kt][4 * ig + 0] + t0);
                        run += G[kt][ig] + O[kt][ig];
                    }
                trun = run;
                pv_tile<64>(o, s, vl, lane);
            }
            if (!__all(trun < -110.f)) flag[it & 1] = 1;
        }
        bf16_t* dst = BR + (trow + qpos) * 1024 + 1 * 256 + hd * 64;
#pragma unroll
        for (int dvt = 0; dvt < 2; ++dvt)
#pragma unroll
            for (int i = 0; i < 4; ++i) st4bf(dst + dvt * 32 + 8 * i + 4 * h, o[dvt][4 * i], o[dvt][4 * i + 1], o[dvt][4 * i + 2], o[dvt][4 * i + 3]);
    }
}
constexpr int NSA_QB = (NT / 128) * 32;
DI void job_nsa(const Params& p, int bid, int nblk, unsigned char* lds) {
    const bf16_t* H = WSB(WS_H); const bf16_t* KCB = WSB(WS_KCB); const bf16_t* VCB = KCB + (size_t)NCR * 64;
    float* OACC = WSF(WS_OC); bf16_t* BR = WSB(WS_BR);
    constexpr int NQB = SEQ / NSA_QB, NU = BATCH * 2 * NQB;
    constexpr int TB_ = TileCfg<64>::BYTES;
    const int lane = tidx() & 63, wid = tidx() >> 6, r = lane & 31, h = lane >> 5;
    const int n = wid & 1, sub = wid >> 1;
    unsigned* orw = (unsigned*)(lds + 4 * TB_);
    float* impx = (float*)(lds + 4 * TB_ + 64);
    for (int u = bid; u < NU; u += nblk) {
        const int qblk = NQB - 1 - u / (BATCH * 2), bg = u % (BATCH * 2), b = bg >> 1, g = bg & 1;
        const int q0 = qblk * NSA_QB, qw = q0 + sub * 32, qpos = qw + r;
        const int head = g * 2 + n;
        const long trow = (long)b * SEQ;
        const bf16_t* hq_row = H + (trow + qpos) * NH;
        bf16x8 qf[1][4];
#pragma unroll
        for (int ks = 0; ks < 4; ++ks) qf[0][ks] = *(const bf16x8*)(hq_row + O_AQ + head * 64 + ks * 16 + 8 * h);
        const float sl = exp2f(-2.f * (float)(head + 1));
        const float gate0 = sigm(bf2f(hq_row[O_AG + head * 3 + 0])), gate1 = sigm(bf2f(hq_row[O_AG + head * 3 + 1])), gate2 = sigm(bf2f(hq_row[O_AG + head * 3 + 2]));
        float* oacc = OACC + (trow + qpos) * 256 + head * 64;
        __syncthreads();
        if (tidx() == 0) *orw = 0u;
        {
            u32x4 rg[TileCfg<64>::NI];
#pragma unroll
            for (int tl = 0; tl < 4; ++tl) {
                const bf16_t* src = (tl & 2) ? VCB : KCB; const int cb = (tl & 1) * 64;
                tile_gload<64>(rg, [&](int row) { const int c = cb + row < NCMP ? cb + row : NCMP - 1; return src + ((long)(b * NCMP + c) * 2 + g) * 64; });
                tile_lstore<64>(rg, lds + tl * TB_);
            }
        }
        __syncthreads();
        float imp[16];
        {
            f32x16 s[2][2];
            qk_tile<64>(s[0], qf[0], lds, r, h);
            qk_tile<64>(s[1], qf[0], lds + TB_, r, h);
            float tmax = -INFINITY;
#pragma unroll
            for (int tl = 0; tl < 2; ++tl)
#pragma unroll
                for (int kt = 0; kt < 2; ++kt)
#pragma unroll
                    for (int i = 0; i < 16; ++i) {
                        const int c = tl * 64 + kt * 32 + crow(i, h), dist = qpos - (16 * c + 31);
                        const float v = (c < NCMP && dist >= 0) ? s[tl][kt][i] * 0.125f - sl * (float)dist : -INFINITY;
                        s[tl][kt][i] = v; tmax = fmaxf(tmax, v);
                    }
            const float mn = fmaxf(xhalf_max(tmax), -1e30f);
            float ps = 0.f;
#pragma unroll
            for (int tl = 0; tl < 2; ++tl)
#pragma unroll
                for (int kt = 0; kt < 2; ++kt)
#pragma unroll
                    for (int i = 0; i < 16; ++i) { const float pr = __expf(s[tl][kt][i] - mn); s[tl][kt][i] = pr; ps += pr; }
            const float rl = 1.f / fmaxf(xhalf_sum(ps), 1e-30f);
            float P3[16];
#pragma unroll
            for (int tl = 0; tl < 2; ++tl)
#pragma unroll
                for (int kt = 0; kt < 2; ++kt) {
#pragma unroll
                    for (int ig = 0; ig < 4; ++ig) {
                        const float p0 = s[tl][kt][4 * ig] * rl, p1 = s[tl][kt][4 * ig + 1] * rl, p2 = s[tl][kt][4 * ig + 2] * rl, p3 = s[tl][kt][4 * ig + 3] * rl;
                        imp[tl * 8 + kt * 4 + ig] = (p0 + p1) + (p2 + 0.5f * p3);
                        P3[tl * 8 + kt * 4 + ig] = 0.5f * p3;
                    }
                    const float gs = rl * gate0;
#pragma unroll
                    for (int i = 0; i < 16; ++i) s[tl][kt][i] *= gs;
                }
#pragma unroll
            for (int idx = 0; idx < 16; ++idx) {
                const float pp = xhalf_other(P3[idx], h);
                float prevp;
                if (idx == 0) prevp = h ? pp : 0.f; else { const float ppm = xhalf_other(P3[idx - 1], h); prevp = h ? pp : ppm; }
                imp[idx] += prevp;
                impx[(wid * 16 + idx) * 64 + lane] = imp[idx];
            }
            f32x16 oc[2];
#pragma unroll
            for (int i = 0; i < 16; ++i) { oc[0][i] = 0.f; oc[1][i] = 0.f; }
            pv_tile<64>(oc, s[0], lds + 2 * TB_, lane);
            pv_tile<64>(oc, s[1], lds + 3 * TB_, lane);
#pragma unroll
            for (int dvt = 0; dvt < 2; ++dvt)
#pragma unroll
                for (int i = 0; i < 4; ++i) *(float4*)(oacc + dvt * 32 + 8 * i + 4 * h) = make_float4(oc[dvt][4 * i], oc[dvt][4 * i + 1], oc[dvt][4 * i + 2], oc[dvt][4 * i + 3]);
        }
        __syncthreads();
        unsigned sel = 0u;
        {
            const int cur = qpos >> 6;
#pragma unroll
            for (int idx = 0; idx < 16; ++idx) {
                const float other = impx[((wid ^ 1) * 16 + idx) * 64 + lane];
                const float tot = n == 0 ? imp[idx] + other : other + imp[idx];
                const int j = 2 * idx + h;
                const bool forced = (j == 0) || (j == cur), valid = (j * 64 <= qpos);
                imp[idx] = forced ? 1e4f : (valid ? tot : -1.0f);
            }
#pragma unroll 1
            for (int it = 0; it < 8; ++it) {
                float best = -INFINITY; int bj = 64;
#pragma unroll
                for (int idx = 0; idx < 16; ++idx) if (imp[idx] > best) { best = imp[idx]; bj = 2 * idx + h; }
                const float pb = xhalf_other(best, h); const int pj = __float_as_int(xhalf_other(__int_as_float(bj), h));
                const bool own = (best > pb) || (best == pb && bj < pj);
                const int wj = own ? bj : pj;
                sel |= 1u << wj;
#pragma unroll
                for (int idx = 0; idx < 16; ++idx) if (2 * idx + h == wj) imp[idx] = -INFINITY;
            }
        }
        atomicOr(orw, sel);
        __syncthreads();
        const unsigned bmask = *orw;
        const int jhi = (q0 + NSA_QB - 1) >> 6;
        const unsigned upto = jhi >= 31 ? 0xffffffffu : ((1u << (jhi + 1)) - 1u);
        const float c1 = 0.125f * LOG2E, sl2 = sl * LOG2E;
        {
            f32x16 o[2];
#pragma unroll
            for (int i = 0; i < 16; ++i) { o[0][i] = 0.f; o[1][i] = 0.f; }
            float m = -1e30f, l = 0.f;
            const int jlo = (q0 - 511 > 0 ? q0 - 511 : 0) >> 6;
            const unsigned tmask = upto & ~((1u << jlo) - 1u);
            attn_stream<64, 64, true>(qf[0], o, m, l, tmask, qw + 31, qw - 511,
                [&](int row) { return H + (trow + row) * NH + O_AKW + g * 64; },
                [&](int row) { return H + (trow + row) * NH + O_AVW + g * 64; },
                c1, sl2, qpos,
                [&](int key) { const int dist = qpos - key; return dist >= 0 && dist < 512; },
                [&](int j) { return j * 64 + 63 <= qw && qw + 31 - j * 64 < 512; }, lds);
            const float rl = gate2 / fmaxf(xhalf_sum(l), 1e-30f);
#pragma unroll
            for (int dvt = 0; dvt < 2; ++dvt)
#pragma unroll
                for (int i = 0; i < 4; ++i) { float4* a = (float4*)(oacc + dvt * 32 + 8 * i + 4 * h); float4 c = *a;
                    c.x += o[dvt][4 * i] * rl; c.y += o[dvt][4 * i + 1] * rl; c.z += o[dvt][4 * i + 2] * rl; c.w += o[dvt][4 * i + 3] * rl; *a = c; }
        }
        {
            f32x16 o[2];
#pragma unroll
            for (int i = 0; i < 16; ++i) { o[0][i] = 0.f; o[1][i] = 0.f; }
            float m = -1e30f, l = 0.f;
            attn_stream<64, 64, true>(qf[0], o, m, l, bmask & upto, qw + 31, 0,
                [&](int row) { return H + (trow + row) * NH + O_AKS + g * 64; },
                [&](int row) { return H + (trow + row) * NH + O_AVS + g * 64; },
                c1, sl2, qpos,
                [&](int key) { return key <= qpos && ((sel >> (key >> 6)) & 1u); },
                [&](int j) { return j * 64 + 63 <= qw && __all((sel >> j) & 1u); }, lds);
            const float rl = gate1 / fmaxf(xhalf_sum(l), 1e-30f);
            bf16_t* dst = BR + (trow + qpos) * 1024 + head * 64;
#pragma unroll
            for (int dvt = 0; dvt < 2; ++dvt)
#pragma unroll
                for (int i = 0; i < 4; ++i) { const float4 c = *(const float4*)(oacc + dvt * 32 + 8 * i + 4 * h);
                    st4bf(dst + dvt * 32 + 8 * i + 4 * h, c.x + o[dvt][4 * i] * rl, c.y + o[dvt][4 * i + 1] * rl, c.z + o[dvt][4 * i + 2] * rl, c.w + o[dvt][4 * i + 3] * rl); }
        }
    }
}

namespace pg8 { typedef PG8_LAS unsigned char* PG8_LAS_T; }
#define LDS3 ((pg8::PG8_LAS_T)lds)
#define GEMM256(EPI, SCHED, g, S, E) do { __syncthreads(); pg8::gemm_phase<EPI, SCHED, false, true>(LDS3, g, S, E); } while (0)
constexpr int NPH = 18;
constexpr int NPHASES = 2 + DEPTH * NPH;

__global__ void __launch_bounds__(NT, 2) mega(Params pk, int ph_lo, int ph_hi) {
    extern __shared__ __attribute__((aligned(16))) unsigned char lds[];
    const int bid = blockIdx.x, nblk = gridDim.x;
#define XB_HERE XcdBarrier bar_; bar_.bar = (unsigned*)(pk.ws + WS_CTL) + CW_BAR; bar_.x = xb_xcc_id(); bar_.st = (volatile LAS unsigned*)(lds + 131072)
    const bool multi = (ph_hi - ph_lo) > 1;
    if (multi) {
        uint4* xbw = (uint4*)(lds + 131072);
        if (tidx() == 0) *xbw = make_uint4(0u, 0u, 0u, 0u);
        __syncthreads();
        (void)xcd_barrier_post((unsigned*)(pk.ws + WS_CTL) + CW_BAR, (volatile LAS unsigned*)xbw);
    }
#ifndef PROBE_PH
#define PROBE_PH -100
#endif
#define PHASE(id, ...) do { const int _id = (id); if (ph_lo <= _id && _id < ph_hi) { for (int _rep = 0; _rep < ((PROBE_PH == -1 ? _id < 2 : (_id >= 2 && (_id - 2) % NPH == PROBE_PH)) ? 2 : 1); ++_rep) { if (_rep) { XB_HERE; xcd_barrier(bar_); } { Params p = pk; int layer = layer_; asm volatile("" : "+s"(p.ws), "+s"(p.out), "+s"(layer)); \
        const LayerW w = layer_w(p, layer); const float* Xin = (layer == 0) ? p.in[0] : WSF(WS_XC); const bf16_t* XinB = (layer == 0) ? WSB(WS_X0B) : WSB(WS_XCB); float* Xout = (layer == DEPTH - 1) ? p.out : WSF(WS_XC); \
        (void)w; (void)Xin; (void)XinB; (void)Xout; __VA_ARGS__; } } if (_id + 1 < ph_hi) { XB_HERE; xcd_barrier(bar_); } } } while (0)

    { const int layer_ = 0;
    PHASE(0, {
        job_wt<2>(p.in[2], DEPTH, 1024, NIN, WSB(WT_IN), NH, bid, nblk, lds);
        job_wt<0>(p.in[17], DEPTH, 1024, 1024, WSB(WT_BR), 1024, bid, nblk, lds);
        job_wt<0>(p.in[18], DEPTH, 1024, 1024, WSB(WT_OUT), 1024, bid, nblk, lds);
        job_wt<0>(p.in[21], DEPTH, 1024, 512, WSB(WT_Q), 512, bid, nblk, lds);
        job_wt<0>(p.in[22], DEPTH, 1024, 1024, WSB(WT_KV), 1024, bid, nblk, lds);
        job_wt<0>(p.in[23], DEPTH, 512, 1024, WSB(WT_O), 1024, bid, nblk, lds);
        job_wt<1>(p.in[30], DEPTH * 32, 1024, 1024, WSB(WT_GU), 1024, bid, nblk, lds);
        job_wt<0>(p.in[31], DEPTH * 32, 512, 1024, WSB(WT_DN), 1024, bid, nblk, lds);
        job_wt<0>(p.in[4], DEPTH * 2, 2048, 256, WSB(WT_C1), 256, bid, nblk, lds);
        job_wt<0>(p.in[5], DEPTH * 2, 256, 64, WSB(WT_C2), 128, bid, nblk, lds);
        job_wt<0>(p.in[15], DEPTH, 192, 384, WSB(WT_UQ), 384, bid, nblk, lds);
        job_wt<0>(p.in[16], DEPTH, 128, 512, WSB(WT_UKV), 512, bid, nblk, lds);
        job_pack_small(p, bid, nblk);
        job_cvt(p.in[0], WSB(WS_X0B), (long)T * 1024, bid, nblk);
        job_cvt(p.in[1], WSB(WS_MEMB), (long)2048 * 1024, bid, nblk);
    });
    PHASE(1, {
        pg8::Gemm g{WSB(WS_MEMB), WSB(WT_KV), BATCH * MEM_LEN, 1024, 1024, nullptr};
        GroupedOrder S{8, 4, DEPTH, nblk, bid};
        EpiStoreBf16 E{WSB(WS_KVM), 1024, 1 << 30, (long)2048 * 1024};
        GEMM256(EpiStoreBf16, GroupedOrder, g, S, E);
    });
    }
    for (int layer_ = 0; layer_ < DEPTH; ++layer_) {
        const int base = 2 + layer_ * NPH;
        PHASE(base + 0, { pg8::Gemm g{XinB, w.t_in, T, NH, 1024, nullptr}; pg8::StaticOrder S; S.init(T, NH, nblk, bid); EpiStoreBf16 E{WSB(WS_H), NH, O_MG / 128, 0}; GEMM256(EpiStoreBf16, pg8::StaticOrder, g, S, E); });
        PHASE(base + 1, { job_sb_attn(p, bid, nblk, lds); job_cmp_gather(p, w, bid, nblk); job_rnn_conv(p, w, bid, nblk); job_mla_norm(p, w, bid, nblk); });
        PHASE(base + 2, { if (bid < 16) job_cmp_mlp<0>(p, w, bid, 16, lds); else { job_rnn_gates(p, w, bid - 16, nblk - 16, lds); job_mla_up(p, w, bid - 16, nblk - 16, lds); } });
        PHASE(base + 3, { job_cmp_mlp<1>(p, w, bid, nblk, lds); job_rnn_scan1(p, bid, nblk); });
        PHASE(base + 4, { job_nsa(p, bid, nblk, lds); job_mla_attn(p, bid, nblk, lds); job_rnn_scan2(p, bid, nblk); });
        PHASE(base + 5, { job_merge(p, w, bid, nblk, lds); });
        PHASE(base + 6, { pg8::Gemm g{WSB(WS_M), w.t_out, T, 1024, 1024, nullptr}; pg8::StaticOrder S; S.init(T, 1024, nblk, bid); EpiStoreBf16 E{WSB(WS_Y), 1024, 1 << 30, 0}; GEMM256(EpiStoreBf16, pg8::StaticOrder, g, S, E); });
        PHASE(base + 7, { job_ln(layer == 0 ? p.in[0] : nullptr, WSB(WS_XCB), nullptr, WSB(WS_Y), nullptr, nullptr, w.ln1_g, w.ln1_b, nullptr, WSB(WS_XAB), nullptr, bid, nblk); });
        PHASE(base + 8, { pg8::Gemm g{WSB(WS_XAB), w.t_q, T, 512, 1024, nullptr}; pg8::StaticOrder S; S.init(T, 512, nblk, bid); EpiStoreBf16 E{WSB(WS_XQ), 512, 1 << 30, 0}; GEMM256(EpiStoreBf16, pg8::StaticOrder, g, S, E); });
        PHASE(base + 9, { job_cross_attn(p, layer, bid, nblk, lds); });
        PHASE(base + 10, { pg8::Gemm g{WSB(WS_XO), w.t_o, T, 1024, 512, nullptr}; pg8::StaticOrder S; S.init(T, 1024, nblk, bid); EpiStoreBf16 E{WSB(WS_Y), 1024, 1 << 30, 0}; GEMM256(EpiStoreBf16, pg8::StaticOrder, g, S, E); });
        PHASE(base + 11, { job_ln(nullptr, WSB(WS_XAB), nullptr, WSB(WS_Y), nullptr, nullptr, w.ln2_g, w.ln2_b, nullptr, WSB(WS_XBB), WSB(WS_XBL), bid, nblk); });
        PHASE(base + 12, { job_router_logits(p, w, bid, nblk, lds); });
        PHASE(base + 13, { job_router(p, w, layer, bid, nblk); });
        PHASE(base + 14, { job_fill(p, layer, bid, nblk, lds); });
        PHASE(base + 15, { const pg8::ListOrder S = moe_units(WSU(WS_CTL) + CW_CNT + layer * 32, bid, nblk); pg8::Gemm g{WSB(WS_XBB), w.t_gu, PADROWS, 1024, 1024, WSI(WS_PERM)}; EpiMoeGU E{WSB(WS_HH)}; __syncthreads(); pg8::gemm_phase<EpiMoeGU, pg8::ListOrder, false, true, true>(LDS3, g, S, E); });
        PHASE(base + 16, { const pg8::ListOrder S = moe_units(WSU(WS_CTL) + CW_CNT + layer * 32, bid, nblk); pg8::Gemm g{WSB(WS_HH), w.t_dn, PADROWS, 1024, 512, nullptr}; EpiStoreBf16 E{WSB(WS_YK), 1024, 1 << 30, 0}; GEMM256(EpiStoreBf16, pg8::ListOrder, g, S, E); });
        PHASE(base + 17, { job_ln(nullptr, WSB(WS_XBB), WSB(WS_XBL), WSB(WS_YK), WSI(WS_ROWOF), WSF(WS_EW), w.ln3_g, w.ln3_b, (layer == DEPTH - 1) ? p.out : nullptr, (layer == DEPTH - 1) ? nullptr : WSB(WS_XCB), nullptr, bid, nblk); });
    }
}

extern "C" void kernel_launch(void* const* d_in, const int* in_sizes, int n_in, void* d_out, int out_size, void* d_ws, size_t ws_size, hipStream_t stream) {
    constexpr size_t kDynLds = 131072 + 1024;
    static_assert(2 * G_STAGE + 1024 <= 131072, "engine stages fit");
    static int grid = 0;
    if (!grid) {
        int dev = 0, cus = 0, per_cu = 0;
        (void)hipGetDevice(&dev);
        (void)hipDeviceGetAttribute(&cus, hipDeviceAttributeMultiprocessorCount, dev);
        (void)hipFuncSetAttribute((const void*)mega, hipFuncAttributeMaxDynamicSharedMemorySize, (int)kDynLds);
        (void)hipOccupancyMaxActiveBlocksPerMultiprocessor(&per_cu, mega, NT, kDynLds);
        if (per_cu < 1) per_cu = 1;
        grid = cus * (per_cu < 2 ? per_cu : 2);
    }
    if (ws_size < WS_END) { fprintf(stderr, "workspace too small: %zu < %zu\n", ws_size, (size_t)WS_END); return; }
    Params p{};
    for (int i = 0; i < 34; ++i) p.in[i] = (const float*)d_in[i];
    p.out = (float*)d_out;
    p.ws = (unsigned char*)d_ws;
    (void)hipMemsetAsync(d_ws, 0, CTL_BYTES, stream);
#if MK_ONE_LAUNCH
    hipLaunchKernelGGL(mega, dim3(grid), dim3(NT), kDynLds, stream, p, 0, NPHASES);
#else
    for (int ph = 0; ph < NPHASES; ++ph) hipLaunchKernelGGL(mega, dim3(grid), dim3(NT), kDynLds, stream, p, ph, ph + 1);
#endif
}
```

```cpp
#include <hip/hip_runtime.h>
#include <stdint.h>
#include <stdio.h>

#ifndef MK_ONE_LAUNCH
#define MK_ONE_LAUNCH 1
#endif

#define DI __device__ __forceinline__
#define LAS __attribute__((address_space(3)))
DI int tidx() { int t = threadIdx.x; asm volatile("" : "+v"(t)); return t; }

constexpr int NT = 512;
constexpr int D = 1024, BATCH = 8, SEQ = 2048, T = BATCH * SEQ, DEPTH = 4;
constexpr int MEM_LEN = 256;
constexpr int NIN = 6764, NH = 6912;
constexpr int O_AQ = 0, O_AKC = 256, O_AVC = 384, O_AKS = 512, O_AVS = 640, O_AKW = 768, O_AVW = 896,
              O_BQ = 1024, O_BK = 1280, O_BV = 1536, O_CX = 1792, O_CG = 2048, O_DCQ = 2304, O_DCKV = 2496, O_DKR = 2624,
              O_AG = 2656, O_MG = 2688;
constexpr int NCMP = 127, NCR = BATCH * NCMP * 2;
constexpr int NEXP = 32, NASSIGN = T * 2;
constexpr float DN_ALPHA = 1.681792830507429f;

typedef unsigned short bf16_t;
typedef short bf16x8 __attribute__((ext_vector_type(8)));
typedef float f32x16 __attribute__((ext_vector_type(16)));
typedef unsigned u32x4 __attribute__((ext_vector_type(4)));

constexpr int G_WM = NT / 128;
constexpr int G_BM = 64 * G_WM;
constexpr int G_BN = 128;
constexpr int G_RS = 144;
constexpr int G_STAGE = (G_BM + G_BN) * G_RS;
constexpr int PADROWS = ((NASSIGN + NEXP * (G_BM - 1) + G_BM - 1) / G_BM) * G_BM;

constexpr size_t MiB = 1u << 20;
constexpr size_t al(size_t x) { return (x + 255) & ~(size_t)255; }
constexpr size_t WS_CTL = 0, CTL_BYTES = 1 * MiB;
constexpr size_t WT_IN = WS_CTL + CTL_BYTES;
constexpr size_t WT_BR = WT_IN + al((size_t)DEPTH * NH * 1024 * 2);
constexpr size_t WT_OUT = WT_BR + al((size_t)DEPTH * 4 * 1024 * 256 * 2);
constexpr size_t WT_Q = WT_OUT + al((size_t)DEPTH * 1024 * 1024 * 2);
constexpr size_t WT_KV = WT_Q + al((size_t)DEPTH * 512 * 1024 * 2);
constexpr size_t WT_O = WT_KV + al((size_t)DEPTH * 1024 * 1024 * 2);
constexpr size_t WT_GU = WT_O + al((size_t)DEPTH * 1024 * 512 * 2);
constexpr size_t WT_DN = WT_GU + al((size_t)DEPTH * 32 * 1024 * 1024 * 2);
constexpr size_t WS_X0B = WT_DN + al((size_t)DEPTH * 32 * 1024 * 512 * 2);
constexpr size_t WS_MEMB = WS_X0B + al((size_t)T * 1024 * 2);
constexpr size_t WS_H = WS_MEMB + al((size_t)2048 * 1024 * 2);
constexpr size_t SZ_H = al((size_t)T * NH * 2);
constexpr size_t WS_YK = WS_H;
constexpr size_t WS_HH = WS_YK + (size_t)PADROWS * 1024 * 2;
static_assert(WS_HH + (size_t)PADROWS * 512 * 2 <= WS_H + SZ_H, "moe overlay fits in H");
constexpr size_t WS_TB = WS_H + SZ_H;
constexpr size_t WS_HID = WS_TB + al((size_t)2 * NCR * 2048 * 4);
constexpr size_t WS_KCVC = WS_HID + al((size_t)2 * NCR * 256 * 4);
constexpr size_t WS_PC = WS_KCVC + al((size_t)2 * NCR * 64 * 4);
constexpr size_t WS_SEL = WS_PC + al((size_t)BATCH * 4 * SEQ * 128 * 4);
constexpr size_t WS_OW = WS_SEL + al((size_t)BATCH * 2 * SEQ * 4);
constexpr size_t WS_OC = WS_OW + al((size_t)T * 256 * 4);
constexpr size_t WS_BR = WS_OC + al((size_t)T * 256 * 4);
constexpr size_t WS_U = WS_BR + al((size_t)T * 1024 * 2);
constexpr size_t WS_RA = WS_U + al((size_t)T * 256 * 4);
constexpr size_t WS_RB = WS_RA + al((size_t)T * 256 * 4);
constexpr size_t WS_CQN = WS_RB + al((size_t)T * 256 * 4);
constexpr size_t WS_CKVN = WS_CQN + al((size_t)T * 192 * 4);
constexpr size_t WS_KR = WS_CKVN + al((size_t)T * 128 * 4);
constexpr size_t WS_Q = WS_KR + al((size_t)T * 32 * 4);
constexpr size_t WS_KV = WS_Q + al((size_t)T * 384 * 4);
constexpr size_t WS_M = WS_KV + al((size_t)T * 512 * 4);
constexpr size_t WS_Y = WS_M + al((size_t)T * 1024 * 2);
constexpr size_t WS_XA = WS_Y + al((size_t)T * 1024 * 4);
constexpr size_t WS_XB = WS_XA + al((size_t)T * 1024 * 4);
constexpr size_t WS_XC = WS_XB + al((size_t)T * 1024 * 4);
constexpr size_t WS_XAB = WS_XC + al((size_t)T * 1024 * 4);
constexpr size_t WS_XBB = WS_XAB + al((size_t)T * 1024 * 2);
constexpr size_t WS_XCB = WS_XBB + al((size_t)T * 1024 * 2);
constexpr size_t WS_XQ = WS_XCB + al((size_t)T * 1024 * 2);
constexpr size_t WS_XO = WS_XQ + al((size_t)T * 512 * 2);
constexpr size_t WS_KVM = WS_XO + al((size_t)T * 512 * 2);
constexpr size_t WS_LOG = WS_KVM + al((size_t)DEPTH * 2048 * 1024 * 2);
constexpr size_t WS_EIDX = WS_LOG + al((size_t)3 * T * 36 * 4);
constexpr size_t WS_ESLOT = WS_EIDX + al((size_t)NASSIGN * 4);
constexpr size_t WS_EW = WS_ESLOT + al((size_t)NASSIGN * 4);
constexpr size_t WS_PERM = WS_EW + al((size_t)NASSIGN * 4);
constexpr size_t WS_QB = WS_PERM + al((size_t)PADROWS * 4);
constexpr size_t WS_KM = WS_QB + al((size_t)T * 384 * 2);
constexpr size_t WS_VM = WS_KM + al((size_t)T * 384 * 2);
constexpr size_t WS_KCB = WS_VM + al((size_t)T * 256 * 2);
constexpr size_t WT_C1 = WS_KCB + al((size_t)2 * NCR * 64 * 2);
constexpr size_t WT_C2 = WT_C1 + al((size_t)DEPTH * 2 * 256 * 2048 * 2);
constexpr size_t WT_UQ = WT_C2 + al((size_t)DEPTH * 2 * 128 * 256 * 2);
constexpr size_t WT_UKV = WT_UQ + al((size_t)DEPTH * 384 * 192 * 2);
constexpr size_t WT_G = WT_UKV + al((size_t)DEPTH * 512 * 128 * 2);
constexpr size_t WT_RH = WT_G + al((size_t)DEPTH * 4 * 128 * 64 * 2);
constexpr size_t WT_RL = WT_RH + al((size_t)DEPTH * 128 * 1024 * 2);
constexpr size_t WS_TBB = WT_RL + al((size_t)DEPTH * 128 * 1024 * 2);
constexpr size_t WS_HIDB = WS_TBB + al((size_t)2 * 2048 * 2048 * 2);
constexpr size_t WS_UB = WS_HIDB + al((size_t)2 * 2048 * 256 * 2);
constexpr size_t WS_CQNB = WS_UB + al((size_t)T * 256 * 2);
constexpr size_t WS_CKVNB = WS_CQNB + al((size_t)T * 192 * 2);
constexpr size_t WS_XBL = WS_CKVNB + al((size_t)T * 128 * 2);
constexpr size_t WS_SA = WS_XBL + al((size_t)T * 1024 * 2);
constexpr size_t WS_SH = WS_SA + al((size_t)BATCH * 32 * 256 * 4);
constexpr size_t WS_XG = WS_SH + al((size_t)BATCH * 32 * 256 * 4);
constexpr size_t WS_ROWOF = WS_XG + al((size_t)PADROWS * 1024 * 2);
constexpr size_t WS_ROPE_PRE = WS_ROWOF + al((size_t)NASSIGN * 4);
constexpr size_t WS_ROPE = WS_ROPE_PRE;
constexpr size_t WS_END = WS_ROPE + al((size_t)SEQ * 16 * 2 * 4);

constexpr int CW_BAR = 4096;
constexpr int CW_CNT = 16384;

struct Params {
    const float* in[34];
    float* out;
    unsigned char* ws;
};

#define XB_TMO      128
#define XB_XCNT(j)  (256  + 64 * (j))
#define XB_XSUB(j)  (1280 + 64 * (j))
#define XB_XGEN(j)  (2304 + 64 * (j))
#define XB_TOP      3328
#define XB_TOPGEN   3392
#define XCD_BAR_WORDS 3456
#define XB_SPIN_CAP (1u << 22)

__device__ __forceinline__ unsigned xb_ld(unsigned* p)              { return __hip_atomic_load(p, __ATOMIC_RELAXED, __HIP_MEMORY_SCOPE_AGENT); }
__device__ __forceinline__ unsigned xb_add(unsigned* p, unsigned v) { return __hip_atomic_fetch_add(p, v, __ATOMIC_RELAXED, __HIP_MEMORY_SCOPE_AGENT); }
__device__ __forceinline__ unsigned xb_xcc_id() { return (unsigned)__builtin_amdgcn_s_getreg((3 << 11) | 20) & 0xFu; }
#define XB_SPIN(cond, bar) do { unsigned _sp = 0; while (cond) { __builtin_amdgcn_s_sleep(1); \
    if ((++_sp & 255u) == 0u) { if (xb_ld(&(bar)[XB_TMO])) break; if (_sp > XB_SPIN_CAP) { atomicAdd(&(bar)[XB_TMO], 1u); break; } } } } while (0)

struct XcdBarrier { unsigned* bar; unsigned x; volatile LAS unsigned* st; };

__device__ __forceinline__ XcdBarrier xcd_barrier_post(unsigned* bar, volatile LAS unsigned* st) {
    XcdBarrier b; b.bar = bar; b.x = xb_xcc_id(); b.st = st;
    if (threadIdx.x == 0) (void)xb_add(&bar[XB_XCNT(b.x)], 1u);
    return b;
}
__device__ __forceinline__ void xcd_barrier_complete(unsigned* bar, unsigned x, unsigned& nloc, unsigned& nx) {
    const unsigned G = gridDim.x * gridDim.y * gridDim.z;
    unsigned sum, cnt, mine, sp = 0u;
    for (;;) {
        sum = 0u; cnt = 0u; mine = 0u;
#pragma unroll
        for (unsigned j = 0; j < 16; ++j) { const unsigned c = xb_ld(&bar[XB_XCNT(j)]); sum += c; cnt += (c > 0u) ? 1u : 0u; mine = (j == x) ? c : mine; }
        if (sum == G) break;
        __builtin_amdgcn_s_sleep(1);
        if ((++sp & 255u) == 0u) { if (xb_ld(&bar[XB_TMO])) break; if (sp > XB_SPIN_CAP) { atomicAdd(&bar[XB_TMO], 1u); break; } }
    }
    nloc = mine > 0u ? mine : 1u; nx = cnt > 0u ? cnt : 1u;
}
__device__ __forceinline__ void xcd_barrier(const XcdBarrier& b) {
    asm volatile("s_waitcnt vmcnt(0)" ::: "memory");
    __syncthreads();
    if (threadIdx.x == 0) {
        unsigned* bar = b.bar;
        __builtin_amdgcn_s_waitcnt(0);
        unsigned nloc = b.st[0], nx = b.st[1];
        if (nloc == 0u) { xcd_barrier_complete(bar, b.x, nloc, nx); b.st[0] = nloc; b.st[1] = nx; }
        const unsigned old = xb_add(&bar[XB_XSUB(b.x)], 1u);
        const unsigned gen = old / nloc;
        if (old + 1u == (gen + 1u) * nloc) {
            __builtin_amdgcn_fence(__ATOMIC_RELEASE, "agent");
            asm volatile("s_waitcnt vmcnt(0)" ::: "memory");
            const unsigned og = xb_add(&bar[XB_TOP], 1u);
            const unsigned tg = og / nx;
            if (og + 1u == (tg + 1u) * nx) xb_add(&bar[XB_TOPGEN], 1u);
            else XB_SPIN(xb_ld(&bar[XB_TOPGEN]) == tg, bar);
            __builtin_amdgcn_fence(__ATOMIC_ACQUIRE, "agent");
            xb_add(&bar[XB_XGEN(b.x)], 1u);
            asm volatile("s_waitcnt vmcnt(0)" ::: "memory");
        } else {
            XB_SPIN(xb_ld(&bar[XB_XGEN(b.x)]) == gen, bar);
            __builtin_amdgcn_fence(__ATOMIC_ACQUIRE, "agent");
            asm volatile("s_waitcnt vmcnt(0)" ::: "memory");
        }
    }
    __syncthreads();
}

DI float gelu_tanh(float x) { const float u = 0.7978845608028654f * (x + 0.044715f * x * x * x); return 0.5f * x * (1.f + tanhf(u)); }
DI float sigm(float x) { return 1.f / (1.f + expf(-x)); }
DI float sigm_fast(float x) { return __builtin_amdgcn_rcpf(1.f + __expf(-x)); }
DI float logsig(float z) { return fminf(z, 0.f) - log1pf(expf(-fabsf(z))); }
DI float wave_sum(float v) {
    const int lane = tidx() & 63;
#pragma unroll
    for (int o = 32; o > 0; o >>= 1) v += __int_as_float(__builtin_amdgcn_ds_bpermute((lane ^ o) << 2, __float_as_int(v)));
    return v;
}

DI float bflo(unsigned u) { return __uint_as_float(u << 16); }
DI float bfhi(unsigned u) { return __uint_as_float(u & 0xffff0000u); }
DI float bf2f(bf16_t x) { return __uint_as_float((unsigned)x << 16); }
typedef float f32x2_t __attribute__((ext_vector_type(2)));
typedef __bf16 bf16x2_t __attribute__((ext_vector_type(2)));
DI unsigned pk_bf16(float lo, float hi) { f32x2_t v = {lo, hi}; bf16x2_t b = __builtin_convertvector(v, bf16x2_t); return __builtin_bit_cast(unsigned, b); }
DI bf16_t f2bf(float x) { return (bf16_t)(pk_bf16(x, 0.f) & 0xffffu); }
DI void st4bf(bf16_t* p, float a, float b, float c, float d) { uint2 v; v.x = pk_bf16(a, b); v.y = pk_bf16(c, d); *(uint2*)p = v; }
DI float4 ld4bf(const bf16_t* p) { const uint2 v = *(const uint2*)p; return make_float4(bflo(v.x), bfhi(v.x), bflo(v.y), bfhi(v.y)); }
template <int N> DI float dot_row(const float* q, const bf16_t* kr) {
    float dot = 0.f;
#pragma unroll
    for (int d = 0; d < N; d += 8) { const uint4 v = *(const uint4*)(kr + d);
        dot = fmaf(q[d], bflo(v.x), dot); dot = fmaf(q[d + 1], bfhi(v.x), dot); dot = fmaf(q[d + 2], bflo(v.y), dot); dot = fmaf(q[d + 3], bfhi(v.y), dot);
        dot = fmaf(q[d + 4], bflo(v.z), dot); dot = fmaf(q[d + 5], bfhi(v.z), dot); dot = fmaf(q[d + 6], bflo(v.w), dot); dot = fmaf(q[d + 7], bfhi(v.w), dot); }
    return dot;
}
template <int N> DI float dot_row(const float* q, const float* kr) {
    float dot = 0.f;
#pragma unroll
    for (int d = 0; d < N; ++d) dot = fmaf(q[d], kr[d], dot);
    return dot;
}
template <int N> DI void axpy_row(float* o, float pr, float corr, const bf16_t* vr) {
#pragma unroll
    for (int d = 0; d < N; d += 8) { const uint4 v = *(const uint4*)(vr + d);
        o[d] = fmaf(pr, bflo(v.x), o[d] * corr); o[d + 1] = fmaf(pr, bfhi(v.x), o[d + 1] * corr); o[d + 2] = fmaf(pr, bflo(v.y), o[d + 2] * corr); o[d + 3] = fmaf(pr, bfhi(v.y), o[d + 3] * corr);
        o[d + 4] = fmaf(pr, bflo(v.z), o[d + 4] * corr); o[d + 5] = fmaf(pr, bfhi(v.z), o[d + 5] * corr); o[d + 6] = fmaf(pr, bflo(v.w), o[d + 6] * corr); o[d + 7] = fmaf(pr, bfhi(v.w), o[d + 7] * corr); }
}
template <int N> DI void axpy_row(float* o, float pr, float corr, const float* vr) {
#pragma unroll
    for (int d = 0; d < N; ++d) o[d] = fmaf(pr, vr[d], o[d] * corr);
}
template <int N> DI void ld_row(float* q, const bf16_t* p) {
#pragma unroll
    for (int d = 0; d < N; d += 8) { const uint4 v = *(const uint4*)(p + d);
        q[d] = bflo(v.x); q[d + 1] = bfhi(v.x); q[d + 2] = bflo(v.y); q[d + 3] = bfhi(v.y); q[d + 4] = bflo(v.z); q[d + 5] = bfhi(v.z); q[d + 6] = bflo(v.w); q[d + 7] = bfhi(v.w); }
}
template <int N> DI void ld_row(float* q, const float* p) {
#pragma unroll
    for (int d = 0; d < N; d += 4) { const float4 v = *(const float4*)(p + d); q[d] = v.x; q[d + 1] = v.y; q[d + 2] = v.z; q[d + 3] = v.w; }
}

struct MG { const bf16_t* A; long lda; const bf16_t* Wt; long ldw; int K; };

struct NoFlush { DI void operator()(int, f32x16 (&)[2][2]) const {} };
template <class RowFn, class Flush>
DI void mgemm_tile_f(const MG& g, int n0, RowFn rowfn, f32x16 (&acc)[2][2], unsigned char* lds, bool zero, int flush_every, Flush flush) {
    constexpr int XI = G_BM * 8 / NT, WI = G_BN * 8 / NT;
    const int tid = tidx(), lane = tid & 63, wid = tid >> 6, r = lane & 31, h = lane >> 5;
    const int wm = wid % G_WM, wn = wid / G_WM;
    const int cc = tid & 7, row0 = tid >> 3;
    const bf16_t* xp[XI]; const bf16_t* wp[WI];
#pragma unroll
    for (int i = 0; i < XI; ++i) xp[i] = g.A + (long)rowfn(row0 + (NT / 8) * i) * g.lda + cc * 8;
#pragma unroll
    for (int i = 0; i < WI; ++i) wp[i] = g.Wt + (long)(n0 + row0 + (NT / 8) * i) * g.ldw + cc * 8;
    const int st_off = row0 * G_RS + cc * 16;
    if (zero)
#pragma unroll
    for (int a = 0; a < 2; ++a)
#pragma unroll
        for (int b = 0; b < 2; ++b)
#pragma unroll
            for (int i = 0; i < 16; ++i) acc[a][b][i] = 0.f;
    const int nk = g.K >> 6;
    u32x4 xv0[XI], wv0[WI], xv1[XI], wv1[WI];
#define MG_GLOAD(XV, WV, KT) do { _Pragma("unroll") for (int i = 0; i < XI; ++i) XV[i] = *(const u32x4*)(xp[i] + (KT) * 64); \
                                  _Pragma("unroll") for (int i = 0; i < WI; ++i) WV[i] = *(const u32x4*)(wp[i] + (KT) * 64); } while (0)
#define MG_LSTORE(XV, WV, STG) do { unsigned char* _s = lds + (STG) * G_STAGE; \
        _Pragma("unroll") for (int i = 0; i < XI; ++i) *(u32x4*)(_s + st_off + (NT / 8) * i * G_RS) = XV[i]; \
        _Pragma("unroll") for (int i = 0; i < WI; ++i) *(u32x4*)(_s + G_BM * G_RS + st_off + (NT / 8) * i * G_RS) = WV[i]; } while (0)
    MG_GLOAD(xv0, wv0, 0);
    if (nk > 1) MG_GLOAD(xv1, wv1, 1);
    __syncthreads();
    MG_LSTORE(xv0, wv0, 0);
    if (nk > 2) MG_GLOAD(xv0, wv0, 2);
    __syncthreads();
    const int xf_off = (wm * 64 + r) * G_RS + h * 16, wf_off = G_BM * G_RS + (wn * 64 + r) * G_RS + h * 16;
#define MG_COMPUTE(STG) do { const unsigned char* st = lds + (STG) * G_STAGE; \
        _Pragma("unroll") for (int ks = 0; ks < 4; ++ks) { \
            const bf16x8 w0 = *(const bf16x8*)(st + wf_off + ks * 32), w1 = *(const bf16x8*)(st + wf_off + 32 * G_RS + ks * 32); \
            const bf16x8 x0 = *(const bf16x8*)(st + xf_off + ks * 32), x1 = *(const bf16x8*)(st + xf_off + 32 * G_RS + ks * 32); \
            acc[0][0] = __builtin_amdgcn_mfma_f32_32x32x16_bf16(w0, x0, acc[0][0], 0, 0, 0); \
            acc[0][1] = __builtin_amdgcn_mfma_f32_32x32x16_bf16(w0, x1, acc[0][1], 0, 0, 0); \
            acc[1][0] = __builtin_amdgcn_mfma_f32_32x32x16_bf16(w1, x0, acc[1][0], 0, 0, 0); \
            acc[1][1] = __builtin_amdgcn_mfma_f32_32x32x16_bf16(w1, x1, acc[1][1], 0, 0, 0); } } while (0)
    for (int kt = 0; kt < nk; kt += 2) {
        MG_COMPUTE(0);
        if (kt + 1 < nk) { MG_LSTORE(xv1, wv1, 1); if (kt + 3 < nk) MG_GLOAD(xv1, wv1, kt + 3); }
        if (flush_every && (kt + 1) % flush_every == 0) flush(kt / flush_every, acc);
        __syncthreads();
        if (kt + 1 < nk) {
            MG_COMPUTE(1);
            if (kt + 2 < nk) { MG_LSTORE(xv0, wv0, 0); if (kt + 4 < nk) MG_GLOAD(xv0, wv0, kt + 4); }
            if (flush_every && (kt + 2) % flush_every == 0) flush((kt + 1) / flush_every, acc);
            __syncthreads();
        }
    }
#undef MG_GLOAD
#undef MG_LSTORE
#undef MG_COMPUTE
}
template <class RowFn>
DI void mgemm_tile(const MG& g, int n0, RowFn rowfn, f32x16 (&acc)[2][2], unsigned char* lds, bool zero = true) { mgemm_tile_f(g, n0, rowfn, acc, lds, zero, 0, NoFlush{}); }
#define MG_FOREACH(acc, LROW, FEAT, V, ...) do { const int _l = tidx() & 63, _w = tidx() >> 6, _wm = _w % G_WM, _wn = _w / G_WM; \
    _Pragma("unroll") for (int _ft = 0; _ft < 2; ++_ft) _Pragma("unroll") for (int _tt = 0; _tt < 2; ++_tt) _Pragma("unroll") for (int _i = 0; _i < 4; ++_i) { \
        const int LROW = _wm * 64 + _tt * 32 + (_l & 31); const int FEAT = _wn * 64 + _ft * 32 + 8 * _i + 4 * (_l >> 5); \
        float V[4] = {acc[_ft][_tt][4 * _i], acc[_ft][_tt][4 * _i + 1], acc[_ft][_tt][4 * _i + 2], acc[_ft][_tt][4 * _i + 3]}; __VA_ARGS__ } } while (0)

struct RowId { int m0; DI long operator()(int r) const { return m0 + r; } };

template <int OUTMODE>
DI void mgemm_job(const MG& g, int M, int N, void* out, long ldo, int bid, int nblk, unsigned char* lds) {
    const int tm = M / G_BM, tn = N / G_BN;
    for (int u = bid; u < tm * tn; u += nblk) {
        const int grp = u / (16 * tn), rem = u % (16 * tn);
        const int gm = (tm - grp * 16) < 16 ? (tm - grp * 16) : 16;
        const int mt = grp * 16 + rem % gm, nt = rem / gm;
        const int m0 = mt * G_BM, n0 = nt * G_BN;
        f32x16 acc[2][2];
        mgemm_tile(g, n0, RowId{m0}, acc, lds);
        MG_FOREACH(acc, lrow, feat, v, {
            const long o = (long)(m0 + lrow) * ldo + n0 + feat;
            if (OUTMODE == 1) *(float4*)((float*)out + o) = make_float4(v[0], v[1], v[2], v[3]);
            else {
                if (OUTMODE == 2 && n0 + feat >= O_MG) { v[0] = sigm(v[0]); v[1] = sigm(v[1]); v[2] = sigm(v[2]); v[3] = sigm(v[3]); }
                st4bf((bf16_t*)out + o, v[0], v[1], v[2], v[3]);
            } });
    }
}

namespace pg8 {
#define PG8_LAS __attribute__((address_space(3)))
typedef float f32x4 __attribute__((ext_vector_type(4)));
constexpr int BM = 256, BK = 64, HALF = 128, HTB = HALF * BK * 2  , STAGE_BYTES = 8 * HTB, NXCD = 8, WGM = 8;
__host__ __device__ __forceinline__ int lds_byte(int r, int c) { const int st = (r >> 4) * 2 + (c >> 5), rr = r & 15, cc = c & 31, ob = rr * 64 + cc * 2; return st * 1024 + (ob ^ (((ob >> 9) & 1) << 5)); }
__host__ __device__ __forceinline__ void stage_rc(int b, int& R, int& C) { const int st = b / 1024, sb = b % 1024, swz = sb ^ (((sb >> 9) & 1) << 5); R = (st >> 1) * 16 + swz / 64; C = (st & 1) * 32 + (swz % 64) / 2; }
__host__ __device__ __forceinline__ int perm32(int rho) { const int n = rho >> 4, i = rho & 15; return 8 * (i >> 2) + 4 * n + (i & 3); }
struct Unit { int pm, pn, e; };
struct Gemm { const bf16_t* A; const bf16_t* Bt; int M, N, K; const int* rowidx; };
struct StaticOrder {
    int nM, nN, nwg, G, c;
    __device__ void init(int M, int N, int G_, int c_) { nM = M / BM; nN = N / BM; nwg = nM * nN; G = G_; c = c_; }
    __device__ bool next(int i, Unit& u) const {
        const long L = (long)i * G + c; if (L >= nwg) return false;
        int wgid = (int)L; { const int q = nwg / NXCD, r = nwg % NXCD, xcd = wgid % NXCD, off = wgid / NXCD; wgid = (xcd < r ? xcd * (q + 1) : r * (q + 1) + (xcd - r) * q) + off; }
        const int nig = WGM * nN, gid = wgid / nig, fm = gid * WGM, gsz = (nM - fm) < WGM ? (nM - fm) : WGM;
        u.pm = fm + ((wgid % nig) % gsz); u.pn = (wgid % nig) / gsz; u.e = 0; return true;
    }
    __device__ __forceinline__ void a_ready(const Unit&) const {}
    __device__ __forceinline__ void done(const Unit&) const {}
};
struct ListOrder {
    Unit u0, u1, u2; int n;
    __device__ bool next(int i, Unit& u) const { if (i >= n) return false; u = (i == 0) ? u0 : ((i == 1) ? u1 : u2); return true; }
    __device__ __forceinline__ void a_ready(const Unit&) const {}
    __device__ __forceinline__ void done(const Unit&) const {}
};
template <class Epi, class Sched, bool ALIGN_EPI = false, bool SP2 = false, bool GATHER = false>
__device__ __forceinline__ void gemm_phase(PG8_LAS unsigned char* lds, const Gemm g, const Sched& S, const Epi& E) {
    const int tid = tidx(), wid = __builtin_amdgcn_readfirstlane(tid >> 6), lane = tid & 63, wr = wid >> 2, wc = wid & 3, fr = lane & 15, fq = lane >> 4;
    const int K = g.K, nt = K / BK;
    unsigned voffA[2], voffB[2];
#pragma unroll
    for (int i = 0; i < 2; ++i) { int R, C; stage_rc(tid * 16 + i * 8192, R, C); const int Rb = Epi::PERM ? ((R & ~31) + perm32(R & 31)) : R;
        voffA[i] = (unsigned)(R * K + C) * 2u; voffB[i] = (unsigned)(Rb * K + C) * 2u; }
    unsigned voffC[2][2] = {{0u, 0u}, {0u, 0u}}, voffN[2][2] = {{0u, 0u}, {0u, 0u}};
    auto gather_offs = [&](int pm, unsigned (&vo)[2][2]) {
#pragma unroll
        for (int hh = 0; hh < 2; ++hh)
#pragma unroll
            for (int i = 0; i < 2; ++i) { int R, C; stage_rc(tid * 16 + i * 8192, R, C); int a = g.rowidx[pm * BM + hh * HALF + R]; a = a < 0 ? 0 : (a >> 1); vo[hh][i] = (unsigned)(a * K + C) * 2u; }
    };
    const size_t kstep = (size_t)(BK * 2);
    const size_t hstep = (size_t)HALF * K * 2;
    const size_t tstep = 2 * hstep;
    const size_t estep = (size_t)g.N * K * 2;
    const unsigned ldsw = (unsigned)wid * 1024u;
    const int aoff = lds_byte(wr * 64 + fr, fq * 8), boff = lds_byte(wc * 32 + fr, fq * 8);
#define PG8_SA(b, h) (((b) * 2 + (h)) * HTB)
#define PG8_SB(b, h) ((4 + (b) * 2 + (h)) * HTB)
#define PG8_STAGE(bufoff, gbase, voff) do { _Pragma("unroll") for (int _i = 0; _i < 2; ++_i) \
        __builtin_amdgcn_global_load_lds((const unsigned*)((const char*)(gbase) + (voff)[_i]), (PG8_LAS unsigned*)(lds + (bufoff) + ldsw + _i * 8192), 16, 0, 0); } while (0)
#define PG8_STAGE_A(bufoff, HH, KT, NX, densebase) do { if constexpr (GATHER) { const char* _gb = (const char*)g.A + (size_t)(KT) * kstep; if (NX) PG8_STAGE(bufoff, _gb, voffN[HH]); else PG8_STAGE(bufoff, _gb, voffC[HH]); } else PG8_STAGE(bufoff, densebase, voffA); } while (0)
#define PG8_LDA(dst, b, h) do { _Pragma("unroll") for (int m = 0; m < 4; ++m) _Pragma("unroll") for (int k = 0; k < 2; ++k) dst[m][k] = *(const PG8_LAS bf16x8*)(lds + PG8_SA(b, h) + aoff + m * 2048 + k * 1024); } while (0)
#define PG8_LDB(dst, b, h) do { _Pragma("unroll") for (int n = 0; n < 2; ++n) _Pragma("unroll") for (int k = 0; k < 2; ++k) dst[n][k] = *(const PG8_LAS bf16x8*)(lds + PG8_SB(b, h) + boff + n * 2048 + k * 1024); } while (0)
#define PG8_MMA(ai, bj, At, Bt) do { __builtin_amdgcn_s_setprio(1); _Pragma("unroll") for (int m = 0; m < 4; ++m) _Pragma("unroll") for (int n = 0; n < 2; ++n) _Pragma("unroll") for (int k = 0; k < 2; ++k) \
        acc[ai][bj][m][n] = __builtin_amdgcn_mfma_f32_16x16x32_bf16(Bt[n][k], At[m][k], acc[ai][bj][m][n], 0, 0, 0); __builtin_amdgcn_s_setprio(0); } while (0)
#define PG8_WAIT_V(n) asm volatile("s_waitcnt vmcnt(" #n ")" ::: "memory")
#define PG8_WAIT_L(n) asm volatile("s_waitcnt lgkmcnt(" #n ")" ::: "memory")
#define PG8_BAR __builtin_amdgcn_s_barrier()
#define PG8_SCHED __builtin_amdgcn_sched_barrier(0)
    Unit cur, nxt; int ui = 0;
    if (!S.next(0, cur)) return;
    f32x4 acc[2][2][4][2];
#pragma unroll
    for (int a = 0; a < 2; ++a)
#pragma unroll
        for (int b = 0; b < 2; ++b)
#pragma unroll
            for (int m = 0; m < 4; ++m)
#pragma unroll
                for (int n = 0; n < 2; ++n) acc[a][b][m][n] = (f32x4){0.f, 0.f, 0.f, 0.f};
    bf16x8 At[4][2], B0[2][2], B1[2][2];
    const char* cA = (const char*)g.A + (size_t)cur.pm * tstep; const char* cB = (const char*)g.Bt + (size_t)cur.e * estep + (size_t)cur.pn * tstep;
    S.a_ready(cur);
    if constexpr (GATHER) gather_offs(cur.pm, voffC);
    if constexpr (SP2) {
        PG8_STAGE(PG8_SB(0, 0), cB, voffB); PG8_STAGE(PG8_SB(0, 1), cB + hstep, voffB); PG8_STAGE_A(PG8_SA(0, 0), 0, 0, false, cA); PG8_STAGE_A(PG8_SA(0, 1), 1, 0, false, cA + hstep);
        if (wr == 1) PG8_BAR;
        PG8_WAIT_V(2); PG8_BAR;
        PG8_STAGE(PG8_SB(1, 0), cB + kstep, voffB); PG8_STAGE_A(PG8_SA(1, 0), 0, 1, false, cA + kstep); PG8_STAGE(PG8_SB(1, 1), cB + hstep + kstep, voffB);
        PG8_WAIT_V(6); PG8_BAR;
    } else {
        PG8_STAGE(PG8_SB(0, 0), cB, voffB); PG8_STAGE_A(PG8_SA(0, 0), 0, 0, false, cA); PG8_STAGE(PG8_SB(0, 1), cB + hstep, voffB); PG8_STAGE_A(PG8_SA(0, 1), 1, 0, false, cA + hstep);
        if (wr == 1) PG8_BAR;
        PG8_WAIT_V(4); PG8_BAR;
        PG8_STAGE(PG8_SB(1, 0), cB + kstep, voffB); PG8_STAGE_A(PG8_SA(1, 0), 0, 1, false, cA + kstep); PG8_STAGE(PG8_SB(1, 1), cB + hstep + kstep, voffB);
        PG8_WAIT_V(6); PG8_BAR;
    }
    for (;;) {
        const bool has_next = S.next(ui + 1, nxt);
        if constexpr (GATHER) { if (has_next) gather_offs(nxt.pm, voffN); else {
#pragma unroll
            for (int hh = 0; hh < 2; ++hh) { voffN[hh][0] = voffC[hh][0]; voffN[hh][1] = voffC[hh][1]; } } }
        const char* nA = has_next ? (const char*)g.A + (size_t)nxt.pm * tstep : cA; const char* nB = has_next ? (const char*)g.Bt + (size_t)nxt.e * estep + (size_t)nxt.pn * tstep : cB;
        for (int t = 0; t < nt; t += 2) {
            const bool last = (t == nt - 2);
            const char* a1 = cA + (size_t)(t + 1) * kstep;
            const char* a2 = last ? nA : cA + (size_t)(t + 2) * kstep; const char* b2 = last ? nB : cB + (size_t)(t + 2) * kstep;
            const char* a3 = a2 + kstep; const char* b3 = b2 + kstep;
            if (last && has_next) S.a_ready(nxt);
            if constexpr (SP2) {
            PG8_LDB(B0, 0, 0); PG8_LDB(B1, 0, 1); PG8_SCHED; PG8_LDA(At, 0, 0); PG8_STAGE_A(PG8_SA(1, 1), 1, t + 1, false, a1 + hstep);
            PG8_WAIT_V(8); PG8_WAIT_L(0); PG8_BAR; PG8_MMA(0, 0, At, B0); PG8_MMA(0, 1, At, B1); PG8_BAR; PG8_SCHED;
            PG8_LDA(At, 0, 1); PG8_STAGE(PG8_SB(0, 0), b2, voffB); PG8_STAGE(PG8_SB(0, 1), b2 + hstep, voffB); PG8_STAGE_A(PG8_SA(0, 0), 0, (last ? 0 : t + 2), last, a2);
            PG8_WAIT_V(8); PG8_WAIT_L(0); PG8_BAR; PG8_MMA(1, 0, At, B0); PG8_MMA(1, 1, At, B1); PG8_BAR; PG8_SCHED;
            PG8_LDB(B0, 1, 0); PG8_LDB(B1, 1, 1); PG8_SCHED; PG8_LDA(At, 1, 0); PG8_STAGE_A(PG8_SA(0, 1), 1, (last ? 0 : t + 2), last, a2 + hstep);
            PG8_WAIT_V(8); PG8_WAIT_L(0); PG8_BAR; PG8_MMA(0, 0, At, B0); PG8_MMA(0, 1, At, B1); PG8_BAR; PG8_SCHED;
            PG8_LDA(At, 1, 1); PG8_STAGE(PG8_SB(1, 0), b3, voffB); PG8_STAGE(PG8_SB(1, 1), b3 + hstep, voffB); PG8_STAGE_A(PG8_SA(1, 0), 0, (last ? 1 : t + 3), last, a3);
            PG8_WAIT_V(8); PG8_WAIT_L(0); PG8_BAR; PG8_MMA(1, 0, At, B0); PG8_MMA(1, 1, At, B1); PG8_BAR; PG8_SCHED;
            } else {
            PG8_LDB(B0, 0, 0); PG8_SCHED; PG8_LDA(At, 0, 0); PG8_STAGE_A(PG8_SA(1, 1), 1, t + 1, false, a1 + hstep);
            PG8_WAIT_L(8); PG8_BAR; PG8_WAIT_L(0); PG8_MMA(0, 0, At, B0); PG8_BAR; PG8_SCHED;
            PG8_LDB(B1, 0, 1); PG8_STAGE(PG8_SB(0, 0), b2, voffB);
            PG8_BAR; PG8_WAIT_L(0); PG8_MMA(0, 1, At, B1); PG8_BAR;
            PG8_LDA(At, 0, 1); PG8_STAGE_A(PG8_SA(0, 0), 0, (last ? 0 : t + 2), last, a2);
            PG8_BAR; PG8_WAIT_L(0); PG8_MMA(1, 0, At, B0); PG8_BAR; PG8_SCHED;
            PG8_STAGE(PG8_SB(0, 1), b2 + hstep, voffB);
            PG8_WAIT_V(6); PG8_BAR; PG8_MMA(1, 1, At, B1); PG8_BAR;
            PG8_LDB(B0, 1, 0); PG8_SCHED; PG8_LDA(At, 1, 0); PG8_STAGE_A(PG8_SA(0, 1), 1, (last ? 0 : t + 2), last, a2 + hstep);
            PG8_WAIT_L(8); PG8_BAR; PG8_WAIT_L(0); PG8_MMA(0, 0, At, B0); PG8_BAR; PG8_SCHED;
            PG8_LDB(B1, 1, 1); PG8_STAGE(PG8_SB(1, 0), b3, voffB);
            PG8_BAR; PG8_WAIT_L(0); PG8_MMA(0, 1, At, B1); PG8_BAR;
            PG8_LDA(At, 1, 1); PG8_STAGE_A(PG8_SA(1, 0), 0, (last ? 1 : t + 3), last, a3);
            PG8_BAR; PG8_WAIT_L(0); PG8_MMA(1, 0, At, B0); PG8_BAR; PG8_SCHED;
            PG8_STAGE(PG8_SB(1, 1), b3 + hstep, voffB);
            PG8_WAIT_V(6); PG8_BAR; PG8_MMA(1, 1, At, B1); PG8_BAR;
            }
        }
        if constexpr (ALIGN_EPI) { if (wr == 0) PG8_BAR; }
        if constexpr (!Epi::AFTER_DRAIN) { E(acc, cur, wr, wc, fr, fq); S.done(cur); }
        if (!has_next) break;
#pragma unroll
        for (int a = 0; a < 2; ++a)
#pragma unroll
            for (int b = 0; b < 2; ++b)
#pragma unroll
                for (int m = 0; m < 4; ++m)
#pragma unroll
                    for (int n = 0; n < 2; ++n) acc[a][b][m][n] = (f32x4){0.f, 0.f, 0.f, 0.f};
        cur = nxt; cA = nA; cB = nB; ++ui;
        if constexpr (GATHER) {
#pragma unroll
            for (int hh = 0; hh < 2; ++hh) { voffC[hh][0] = voffN[hh][0]; voffC[hh][1] = voffN[hh][1]; } }
        if constexpr (ALIGN_EPI) { if (wr == 1) PG8_BAR; }
    }
    PG8_WAIT_V(0);
    if constexpr (!ALIGN_EPI) { if (wr == 0) PG8_BAR; }
    PG8_BAR;
    if constexpr (Epi::AFTER_DRAIN) { E.fused(acc, cur, wr, wc, fr, fq, lds, wid, lane); S.done(cur); }
#undef PG8_SA
#undef PG8_SB
#undef PG8_STAGE
#undef PG8_STAGE_A
#undef PG8_LDA
#undef PG8_LDB
#undef PG8_MMA
#undef PG8_WAIT_V
#undef PG8_WAIT_L
#undef PG8_BAR
#undef PG8_SCHED
}
}

struct EpiStoreBf16 {
    static constexpr bool PERM = true, AFTER_DRAIN = false;
    bf16_t* O; long ldo; int gate_from; long estride;
    __device__ __forceinline__ void operator()(const pg8::f32x4 (&acc)[2][2][4][2], const pg8::Unit& u, int wr, int wc, int fr, int fq) const {
        bf16_t* base = O + (long)u.e * estride;
#pragma unroll
        for (int ai = 0; ai < 2; ++ai)
#pragma unroll
            for (int m = 0; m < 4; ++m) {
                const long row = (long)u.pm * 256 + ai * 128 + wr * 64 + m * 16 + fr;
#pragma unroll
                for (int bj = 0; bj < 2; ++bj) {
                    pg8::f32x4 v0 = acc[ai][bj][m][0], v1 = acc[ai][bj][m][1];
                    if (u.pn * 2 + bj >= gate_from) {
#pragma unroll
                        for (int j = 0; j < 4; ++j) { v0[j] = sigm_fast(v0[j]); v1[j] = sigm_fast(v1[j]); }
                    }
                    u32x4 wv; wv[0] = pk_bf16(v0[0], v0[1]); wv[1] = pk_bf16(v0[2], v0[3]); wv[2] = pk_bf16(v1[0], v1[1]); wv[3] = pk_bf16(v1[2], v1[3]);
                    *(u32x4*)(base + row * ldo + u.pn * 256 + bj * 128 + wc * 32 + 8 * fq) = wv;
                }
            }
    }
};
struct EpiStoreF32 {
    static constexpr bool PERM = false, AFTER_DRAIN = false;
    float* O; long ldo;
    __device__ __forceinline__ void operator()(const pg8::f32x4 (&acc)[2][2][4][2], const pg8::Unit& u, int wr, int wc, int fr, int fq) const {
#pragma unroll
        for (int ai = 0; ai < 2; ++ai)
#pragma unroll
            for (int m = 0; m < 4; ++m) {
                const long row = (long)u.pm * 256 + ai * 128 + wr * 64 + m * 16 + fr;
#pragma unroll
                for (int bj = 0; bj < 2; ++bj)
#pragma unroll
                    for (int n = 0; n < 2; ++n) *(pg8::f32x4*)(O + row * ldo + u.pn * 256 + bj * 128 + wc * 32 + 16 * n + 4 * fq) = acc[ai][bj][m][n];
            }
    }
};
struct EpiMoeGU {
    static constexpr bool PERM = true, AFTER_DRAIN = false;
    bf16_t* HH;
    __device__ __forceinline__ void operator()(const pg8::f32x4 (&acc)[2][2][4][2], const pg8::Unit& u, int wr, int wc, int fr, int fq) const {
#pragma unroll
        for (int ai = 0; ai < 2; ++ai)
#pragma unroll
            for (int m = 0; m < 4; ++m) {
                const long row = (long)u.pm * 256 + ai * 128 + wr * 64 + m * 16 + fr;
                float hv[8];
#pragma unroll
                for (int n = 0; n < 2; ++n)
#pragma unroll
                    for (int j = 0; j < 4; ++j) { const float gt = acc[ai][0][m][n][j], up = acc[ai][1][m][n][j]; hv[4 * n + j] = gt * sigm_fast(gt) * up; }
                u32x4 wv; wv[0] = pk_bf16(hv[0], hv[1]); wv[1] = pk_bf16(hv[2], hv[3]); wv[2] = pk_bf16(hv[4], hv[5]); wv[3] = pk_bf16(hv[6], hv[7]);
                *(u32x4*)(HH + row * 512 + u.pn * 128 + wc * 32 + 8 * fq) = wv;
            }
    }
};
struct EpiMoeDown {
    static constexpr bool PERM = true, AFTER_DRAIN = false;
    const int* perm; const float* ew; bf16_t* YK;
    __device__ __forceinline__ void operator()(const pg8::f32x4 (&acc)[2][2][4][2], const pg8::Unit& u, int wr, int wc, int fr, int fq) const {
#pragma unroll
        for (int ai = 0; ai < 2; ++ai)
#pragma unroll
            for (int m = 0; m < 4; ++m) {
                const int a = perm[u.pm * 256 + ai * 128 + wr * 64 + m * 16 + fr];
                if (a >= 0) {
                    const float sw = ew[a];
#pragma unroll
                    for (int bj = 0; bj < 2; ++bj) {
                        const pg8::f32x4 v0 = acc[ai][bj][m][0] * sw, v1 = acc[ai][bj][m][1] * sw;
                        u32x4 wv; wv[0] = pk_bf16(v0[0], v0[1]); wv[1] = pk_bf16(v0[2], v0[3]); wv[2] = pk_bf16(v1[0], v1[1]); wv[3] = pk_bf16(v1[2], v1[3]);
                        *(u32x4*)(YK + (long)a * 1024 + u.pn * 256 + bj * 128 + wc * 32 + 8 * fq) = wv;
                    }
                }
            }
    }
};
struct GroupedOrder {
    int nM, nN, nE, G, c;
    __device__ bool next(int i, pg8::Unit& u) const { const int L = i * G + c; if (L >= nM * nN * nE) return false; u.e = L / (nM * nN); const int rm = L % (nM * nN); u.pm = rm / nN; u.pn = rm % nN; return true; }
    __device__ __forceinline__ void a_ready(const pg8::Unit&) const {}
    __device__ __forceinline__ void done(const pg8::Unit&) const {}
};

struct LayerW {
    const float *cmp_pos, *conv_w, *conv_b, *ga_b, *gx_b, *lam, *q_norm, *kv_norm,
        *ln1_g, *ln1_b, *ln2_g, *ln2_b, *rg_b, *re_b, *ln3_g, *ln3_b;
    const bf16_t *t_in, *t_br, *t_out, *t_q, *t_o, *t_gu, *t_dn, *t_c1, *t_c2, *t_uq, *t_ukv, *t_g, *t_rh, *t_rl;
};
#define WSF(off) ((float*)(p.ws + (off)))
#define WSI(off) ((int*)(p.ws + (off)))
#define WSU(off) ((unsigned*)(p.ws + (off)))
#define WSB(off) ((bf16_t*)(p.ws + (off)))
DI LayerW layer_w(const Params& p, int l) {
    LayerW w;
    w.cmp_pos = p.in[3] + (size_t)l * 2 * 32 * 64;
    w.conv_w = p.in[6] + (size_t)l * 4 * 256;
    w.conv_b = p.in[7] + (size_t)l * 256;
    w.ga_b = p.in[9] + (size_t)l * 256;
    w.gx_b = p.in[11] + (size_t)l * 256;
    w.lam = p.in[12] + (size_t)l * 256;
    w.q_norm = p.in[13] + (size_t)l * 192;
    w.kv_norm = p.in[14] + (size_t)l * 128;
    w.ln1_g = p.in[19] + (size_t)l * 1024; w.ln1_b = p.in[20] + (size_t)l * 1024;
    w.ln2_g = p.in[24] + (size_t)l * 1024; w.ln2_b = p.in[25] + (size_t)l * 1024;
    w.rg_b = p.in[27] + (size_t)l * 4;
    w.re_b = p.in[29] + (size_t)l * 32;
    w.ln3_g = p.in[32] + (size_t)l * 1024; w.ln3_b = p.in[33] + (size_t)l * 1024;
    w.t_in = WSB(WT_IN) + (size_t)l * NH * 1024;
    w.t_br = WSB(WT_BR) + (size_t)l * 1024 * 1024;
    w.t_out = WSB(WT_OUT) + (size_t)l * 1024 * 1024;
    w.t_q = WSB(WT_Q) + (size_t)l * 512 * 1024;
    w.t_o = WSB(WT_O) + (size_t)l * 1024 * 512;
    w.t_gu = WSB(WT_GU) + (size_t)l * 32 * 1024 * 1024;
    w.t_dn = WSB(WT_DN) + (size_t)l * 32 * 1024 * 512;
    w.t_c1 = WSB(WT_C1) + (size_t)l * 2 * 256 * 2048;
    w.t_c2 = WSB(WT_C2) + (size_t)l * 2 * 128 * 256;
    w.t_uq = WSB(WT_UQ) + (size_t)l * 384 * 192;
    w.t_ukv = WSB(WT_UKV) + (size_t)l * 512 * 128;
    w.t_g = WSB(WT_G) + (size_t)l * 4 * 128 * 64;
    w.t_rh = WSB(WT_RH) + (size_t)l * 128 * 1024;
    w.t_rl = WSB(WT_RL) + (size_t)l * 128 * 1024;
    return w;
}

template <int MODE>
DI int wt_col(int np, int Nsrc) {
    if (MODE == 0) return np < Nsrc ? np : -1;
    if (MODE == 2) return np < 1024 ? np : (np < 2656 ? np + 12 : (np < 2668 ? 1024 + (np - 2656) : (np < 2688 ? -1 : (np < 6784 ? np - 20 : -1))));
    const int pn = np >> 8, bj = (np >> 7) & 1, q = np & 127; return (bj ? 512 : 0) + 128 * pn + q;
}
template <int MODE>
DI void job_wt(const float* src, int nmat, int K, int Nsrc, bf16_t* dst, int Npad, int bid, int nblk, unsigned char* lds) {
    const int lane = tidx() & 63, wid = tidx() >> 6;
    bf16_t* tile = (bf16_t*)lds + wid * (64 * 72);
    const int tk = K / 64, tn = Npad / 64, per = tk * tn;
    const int kl = lane >> 4, n4 = (lane & 15) * 4;
    for (int u = bid * (NT / 64) + wid; u < nmat * per; u += nblk * (NT / 64)) {
        const int mat = u / per, ru = u % per, k0 = (ru % tk) * 64, n0 = (ru / tk) * 64;
        const float* s = src + (size_t)mat * K * Nsrc;
        bf16_t* d = dst + (size_t)mat * Npad * K;
        const int col = wt_col<MODE>(n0 + n4, Nsrc);
        float4 v[16];
#pragma unroll
        for (int ps = 0; ps < 16; ++ps) v[ps] = col >= 0 ? *(const float4*)(s + (size_t)(k0 + kl + 4 * ps) * Nsrc + col) : make_float4(0.f, 0.f, 0.f, 0.f);
#pragma unroll
        for (int ps = 0; ps < 16; ++ps) { const int k = kl + 4 * ps;
            tile[(n4 + 0) * 72 + k] = f2bf(v[ps].x); tile[(n4 + 1) * 72 + k] = f2bf(v[ps].y); tile[(n4 + 2) * 72 + k] = f2bf(v[ps].z); tile[(n4 + 3) * 72 + k] = f2bf(v[ps].w); }
        __builtin_amdgcn_fence(__ATOMIC_RELEASE, "wavefront"); __builtin_amdgcn_wave_barrier(); __builtin_amdgcn_fence(__ATOMIC_ACQUIRE, "wavefront");
#pragma unroll
        for (int c8 = 0; c8 < 8; ++c8) { const int c = lane + 64 * c8, n2 = c >> 3, kc = (c & 7) * 8;
            *(uint4*)(d + (size_t)(n0 + n2) * K + k0 + kc) = *(const uint4*)(tile + n2 * 72 + kc); }
        __builtin_amdgcn_fence(__ATOMIC_RELEASE, "wavefront"); __builtin_amdgcn_wave_barrier(); __builtin_amdgcn_fence(__ATOMIC_ACQUIRE, "wavefront");
    }
}
DI void job_cvt(const float* src, bf16_t* dst, long n, int bid, int nblk) {
    for (long e = ((long)bid * NT + tidx()) * 4; e < n; e += (long)nblk * NT * 4) {
        const float4 v = *(const float4*)(src + e);
        st4bf(dst + e, v.x, v.y, v.z, v.w);
    }
}
DI void job_cmp_gather(const Params& p, const LayerW& w, int bid, int nblk) {
    const bf16_t* H = WSB(WS_H); bf16_t* TB = WSB(WS_TBB);
    const long total = (long)2 * NCR * 2048 / 4;
    for (long e = (long)bid * NT + tidx(); e < total; e += (long)nblk * NT) {
        const long e4 = e * 4;
        const int f = (int)(e4 % 2048); const long r2 = e4 / 2048; const int r = (int)(r2 % NCR), j = (int)(r2 / NCR);
        const int g = r & 1, bc = r >> 1, c = bc % NCMP, b = bc / NCMP, i = f >> 6, d = f & 63;
        const float4 hv = ld4bf(H + (long)(b * SEQ + 16 * c + i) * NH + (j ? O_AVC : O_AKC) + g * 64 + d);
        const float4 pv = *(const float4*)(w.cmp_pos + (j * 32 + i) * 64 + d);
        st4bf(TB + ((long)j * 2048 + r) * 2048 + f, hv.x + pv.x, hv.y + pv.y, hv.z + pv.z, hv.w + pv.w);
    }
}
DI void job_rnn_conv(const Params& p, const LayerW& w, int bid, int nblk) {
    const bf16_t* H = WSB(WS_H); float* U = WSF(WS_U); bf16_t* UB = WSB(WS_UB);
    for (long e = (long)bid * NT + tidx(); e < (long)T * 64; e += (long)nblk * NT) {
        const int ch = (int)(e & 63) * 4; const int t = (int)(e >> 6), s = t & (SEQ - 1);
        const float4 cb = *(const float4*)(w.conv_b + ch);
        float u0 = cb.x, u1 = cb.y, u2 = cb.z, u3 = cb.w;
#pragma unroll
        for (int tap = 0; tap < 4; ++tap) { const int sp = s - 3 + tap;
            if (sp >= 0) { const float4 hv = ld4bf(H + (long)(t - 3 + tap) * NH + O_CX + ch); const float4 cw = *(const float4*)(w.conv_w + tap * 256 + ch);
                u0 += hv.x * cw.x; u1 += hv.y * cw.y; u2 += hv.z * cw.z; u3 += hv.w * cw.w; } }
        *(float4*)(U + (long)t * 256 + ch) = make_float4(u0, u1, u2, u3); st4bf(UB + (long)t * 256 + ch, u0, u1, u2, u3);
    }
}
DI void job_rnn_gates(const Params& p, const LayerW& w, int bid, int nblk, unsigned char* lds) {
    const float* U = WSF(WS_U); float* RA = WSF(WS_RA); float* RB = WSF(WS_RB);
    for (int u = bid; u < (T / G_BM) * 4; u += nblk) {
        const int blk = u & 3, m0 = (u >> 2) * G_BM;
        MG g; g.A = WSB(WS_UB) + blk * 64; g.lda = 256; g.Wt = w.t_g + (size_t)blk * 128 * 64; g.ldw = 64; g.K = 64;
        f32x16 acc[2][2];
        mgemm_tile(g, 0, RowId{m0}, acc, lds);
        const int l = tidx() & 63, wv = tidx() >> 6, wm = wv % G_WM, wn = wv / G_WM;
#pragma unroll
        for (int tt = 0; tt < 2; ++tt)
#pragma unroll
            for (int i = 0; i < 4; ++i) {
                const long t = m0 + wm * 64 + tt * 32 + (l & 31); const int ch = blk * 64 + wn * 32 + 8 * i + 4 * (l >> 5);
                const float4 uv = *(const float4*)(U + t * 256 + ch);
                const float ua[4] = {uv.x, uv.y, uv.z, uv.w};
                float av[4], bv[4];
#pragma unroll
                for (int j = 0; j < 4; ++j) {
                    const float r = sigm_fast(acc[0][tt][4 * i + j] + w.ga_b[ch + j]), ig = sigm_fast(acc[1][tt][4 * i + j] + w.gx_b[ch + j]);
                    const float nl = -w.lam[ch + j];
                    const float sp = fmaxf(nl, 0.f) + __logf(1.f + __expf(-fabsf(nl)));
                    const float log_a = -8.0f * r * sp;
                    const float a = __expf(log_a);
                    av[j] = a; bv[j] = __builtin_amdgcn_sqrtf(fmaxf(1.f - a * a, 0.f)) * (ig * ua[j]);
                }
                *(float4*)(RA + t * 256 + ch) = make_float4(av[0], av[1], av[2], av[3]);
                *(float4*)(RB + t * 256 + ch) = make_float4(bv[0], bv[1], bv[2], bv[3]);
            }
    }
}
DI void job_rnn_scan1(const Params& p, int bid, int nblk) {
    const float* RA = WSF(WS_RA); const float* RB = WSF(WS_RB); float* SA = WSF(WS_SA); float* SH = WSF(WS_SH);
    for (int e = bid * NT + tidx(); e < BATCH * 32 * 256; e += nblk * NT) {
        const int ch = e & 255, bc = e >> 8;
        float ap = 1.f, hl = 0.f;
        for (int s0 = 0; s0 < 64; s0 += 8) {
            float av[8], bv[8];
#pragma unroll
            for (int i = 0; i < 8; ++i) { const long t = (long)bc * 64 + s0 + i; av[i] = RA[t * 256 + ch]; bv[i] = RB[t * 256 + ch]; }
#pragma unroll
            for (int i = 0; i < 8; ++i) { ap *= av[i]; hl = av[i] * hl + bv[i]; }
        }
        SA[e] = ap; SH[e] = hl;
    }
}
DI void job_rnn_scan2(const Params& p, int bid, int nblk) {
    const bf16_t* H = WSB(WS_H); const float* RA = WSF(WS_RA); const float* RB = WSF(WS_RB); const float* SA = WSF(WS_SA); const float* SH = WSF(WS_SH); bf16_t* BR = WSB(WS_BR);
    for (int e = bid * NT + tidx(); e < BATCH * 32 * 256; e += nblk * NT) {
        const int ch = e & 255, bc = e >> 8, chunk = bc & 31, b = bc >> 5;
        float h = 0.f;
        for (int c = 0; c < chunk; ++c) { const int q = ((b * 32 + c) << 8) + ch; h = SA[q] * h + SH[q]; }
        for (int s0 = 0; s0 < 64; s0 += 8) {
            float av[8], bv[8], gv[8];
#pragma unroll
            for (int i = 0; i < 8; ++i) { const long t = (long)bc * 64 + s0 + i; av[i] = RA[t * 256 + ch]; bv[i] = RB[t * 256 + ch]; gv[i] = bf2f(H[t * NH + O_CG + ch]); }
#pragma unroll
            for (int i = 0; i < 8; ++i) { const long t = (long)bc * 64 + s0 + i; h = av[i] * h + bv[i]; BR[t * 1024 + 2 * 256 + ch] = f2bf(h * gelu_tanh(gv[i])); }
        }
    }
}
DI void job_mla_norm(const Params& p, const LayerW& w, int bid, int nblk) {
    const bf16_t* H = WSB(WS_H); bf16_t* CQN = WSB(WS_CQNB); bf16_t* CKVN = WSB(WS_CKVNB); bf16_t* KM = WSB(WS_KM);
    const int lane = tidx() & 63, wid = tidx() >> 6;
    for (int t = bid * (NT / 64) + wid; t < T; t += nblk * (NT / 64)) {
        const bf16_t* hr = H + (long)t * NH;
        float q0 = bf2f(hr[O_DCQ + lane]), q1 = bf2f(hr[O_DCQ + 64 + lane]), q2 = bf2f(hr[O_DCQ + 128 + lane]);
        float ss = wave_sum(q0 * q0 + q1 * q1 + q2 * q2);
        float rs = rsqrtf(ss * (1.f / 192.f) + 1e-6f);
        CQN[(long)t * 192 + lane] = f2bf(q0 * rs * w.q_norm[lane]);
        CQN[(long)t * 192 + 64 + lane] = f2bf(q1 * rs * w.q_norm[64 + lane]);
        CQN[(long)t * 192 + 128 + lane] = f2bf(q2 * rs * w.q_norm[128 + lane]);
        float k0 = bf2f(hr[O_DCKV + lane]), k1 = bf2f(hr[O_DCKV + 64 + lane]);
        ss = wave_sum(k0 * k0 + k1 * k1);
        rs = rsqrtf(ss * (1.f / 128.f) + 1e-6f);
        CKVN[(long)t * 128 + lane] = f2bf(k0 * rs * w.kv_norm[lane]);
        CKVN[(long)t * 128 + 64 + lane] = f2bf(k1 * rs * w.kv_norm[64 + lane]);
        {
            const int i = lane & 15, hd = lane >> 4;
            const int s = t & (SEQ - 1);
            const float2 csn = *(const float2*)(WSF(WS_ROPE) + (s * 16 + i) * 2); const float cs = csn.x, sn = csn.y;
            const float x1 = bf2f(hr[O_DKR + i]), x2 = bf2f(hr[O_DKR + 16 + i]);
            KM[(long)t * 384 + hd * 96 + 64 + i] = f2bf(x1 * cs - x2 * sn);
            KM[(long)t * 384 + hd * 96 + 80 + i] = f2bf(x1 * sn + x2 * cs);
        }
    }
}
DI void job_mla_up(const Params& p, const LayerW& w, int bid, int nblk, unsigned char* lds) {
    bf16_t* QB = WSB(WS_QB); bf16_t* KM = WSB(WS_KM); bf16_t* VM = WSB(WS_VM);
    constexpr int TM = T / G_BM;
    for (int u = bid; u < TM * 7; u += nblk) {
        const int mt = u / 7, nt = u % 7, m0 = mt * G_BM;
        f32x16 acc[2][2];
        const int l = tidx() & 63, wv = tidx() >> 6, wm = wv % G_WM, wn = wv / G_WM, hh = l >> 5;
        if (nt < 3) {
            MG g; g.A = WSB(WS_CQNB); g.lda = 192; g.Wt = w.t_uq; g.ldw = 192; g.K = 192;
            const int n0 = nt * 128;
            mgemm_tile(g, n0, RowId{m0}, acc, lds);
#pragma unroll
            for (int ft = 0; ft < 2; ++ft) {
                const int fb = (n0 + wn * 64 + ft * 32) >> 5;
                if (fb % 3 == 2) {
#pragma unroll
                    for (int tt = 0; tt < 2; ++tt) {
                        const int pos = (m0 + wm * 64 + tt * 32 + (l & 31)) & (SEQ - 1);
#pragma unroll
                        for (int i = 0; i < 2; ++i)
#pragma unroll
                            for (int j = 0; j < 4; ++j) {
                                const int fi = 8 * i + 4 * hh + j;
                                const float2 csn = *(const float2*)(WSF(WS_ROPE) + (pos * 16 + fi) * 2); const float cs = csn.x, sn = csn.y;
                                const float x1 = acc[ft][tt][4 * i + j], x2 = acc[ft][tt][4 * (i + 2) + j];
                                acc[ft][tt][4 * i + j] = x1 * cs - x2 * sn; acc[ft][tt][4 * (i + 2) + j] = x1 * sn + x2 * cs;
                            }
                    }
                }
            }
            MG_FOREACH(acc, lrow, feat, v, { st4bf(QB + (long)(m0 + lrow) * 384 + n0 + feat, v[0], v[1], v[2], v[3]); });
        } else {
            MG g; g.A = WSB(WS_CKVNB); g.lda = 128; g.Wt = w.t_ukv; g.ldw = 128; g.K = 128;
            const int n0 = (nt - 3) * 128;
            mgemm_tile(g, n0, RowId{m0}, acc, lds);
            MG_FOREACH(acc, lrow, feat, v, {
                const int hd = nt - 3;
                if (feat < 64) st4bf(KM + (long)(m0 + lrow) * 384 + hd * 96 + feat, v[0], v[1], v[2], v[3]);
                else st4bf(VM + (long)(m0 + lrow) * 256 + hd * 64 + (feat - 64), v[0], v[1], v[2], v[3]); });
        }
    }
}
template <int STAGE>
DI void job_cmp_mlp(const Params& p, const LayerW& w, int bid, int nblk, unsigned char* lds) {
    constexpr int TM = 2048 / G_BM, TN = STAGE == 0 ? 2 : 1;
    for (int u = bid; u < 2 * TM * TN; u += nblk) {
        const int j = u / (TM * TN), ru = u % (TM * TN), mt = ru / TN, nt = ru % TN, m0 = mt * G_BM, n0 = nt * 128;
        MG g;
        if (STAGE == 0) { g.A = WSB(WS_TBB) + (size_t)j * 2048 * 2048; g.lda = 2048; g.Wt = w.t_c1 + (size_t)j * 256 * 2048; g.ldw = 2048; g.K = 2048; }
        else { g.A = WSB(WS_HIDB) + (size_t)j * 2048 * 256; g.lda = 256; g.Wt = w.t_c2 + (size_t)j * 128 * 256; g.ldw = 256; g.K = 256; }
        f32x16 acc[2][2];
        mgemm_tile(g, n0, [&](int r) { const int rr = m0 + r; return (long)(rr < NCR ? rr : NCR - 1); }, acc, lds);
        if (STAGE == 0) {
            bf16_t* HID = WSB(WS_HIDB) + (size_t)j * 2048 * 256;
            MG_FOREACH(acc, lrow, feat, v, { st4bf(HID + (long)(m0 + lrow) * 256 + n0 + feat, gelu_tanh(v[0]), gelu_tanh(v[1]), gelu_tanh(v[2]), gelu_tanh(v[3])); });
        } else {
            bf16_t* KC = WSB(WS_KCB) + (size_t)j * NCR * 64;
            MG_FOREACH(acc, lrow, feat, v, { if (feat < 64 && m0 + lrow < NCR) st4bf(KC + (long)(m0 + lrow) * 64 + feat, v[0], v[1], v[2], v[3]); });
        }
    }
}
DI void job_router_logits(const Params& p, const LayerW& w, int bid, int nblk, unsigned char* lds) {
    float* LOG = WSF(WS_LOG);
    for (int u = bid; u < 3 * (T / G_BM); u += nblk) {
        const int pass = u / (T / G_BM), m0 = (u % (T / G_BM)) * G_BM;
        f32x16 acc[2][2];
        MG g; g.lda = 1024; g.ldw = 1024; g.K = 1024;
        g.A = pass == 1 ? WSB(WS_XBL) : WSB(WS_XBB); g.Wt = pass == 2 ? w.t_rl : w.t_rh;
        mgemm_tile(g, 0, RowId{m0}, acc, lds, true);
        float* dst = LOG + (size_t)pass * T * 36;
        MG_FOREACH(acc, lrow, feat, v, { if (feat < 36) *(float4*)(dst + (long)(m0 + lrow) * 36 + feat) = make_float4(v[0], v[1], v[2], v[3]); });
    }
}
DI void job_pack_small(const Params& p, int bid, int nblk) {
    bf16_t* TG = WSB(WT_G); bf16_t* RH = WSB(WT_RH); bf16_t* RL = WSB(WT_RL);
    for (int e = bid * NT + tidx(); e < SEQ * 16; e += nblk * NT) {
        const int i = e & 15, pos = e >> 4;
        const float inv = powf(10000.f, -(float)(2 * i) / 32.f);
        const float ang = (float)pos * inv;
        WSF(WS_ROPE)[e * 2] = cosf(ang); WSF(WS_ROPE)[e * 2 + 1] = sinf(ang);
    }
    for (int e = bid * NT + tidx(); e < DEPTH * 4 * 128 * 64; e += nblk * NT) {
        const int c = e & 63, q = (e >> 6) & 127, lb = e >> 13;
        const int seg = q >> 5, i = q & 31, chl = (seg >> 1) * 32 + i;
        const float* src = (seg & 1) ? p.in[10] : p.in[8];
        TG[e] = f2bf(src[((size_t)lb * 64 + c) * 64 + chl]);
    }
    for (int e = bid * NT + tidx(); e < DEPTH * 128 * 1024; e += nblk * NT) {
        const int k = e & 1023, n = (e >> 10) & 127, l = e >> 17;
        float v = 0.f;
        if (n < 4) v = p.in[26][((size_t)l * 1024 + k) * 4 + n];
        else if (n < 36) v = p.in[28][((size_t)l * 1024 + k) * 32 + (n - 4)];
        const bf16_t hi = f2bf(v);
        RH[e] = hi; RL[e] = f2bf(v - bf2f(hi));
    }
}

DI void job_merge(const Params& p, const LayerW& w, int bid, int nblk, unsigned char* lds) {
    const bf16_t* H = WSB(WS_H); bf16_t* M = WSB(WS_M);
    for (int u = bid; u < (T / G_BM) * 8; u += nblk) {
        const int m0 = (u >> 3) * G_BM, n0 = (u & 7) * G_BN;
        f32x16 macc[2][2];
#pragma unroll
        for (int a = 0; a < 2; ++a)
#pragma unroll
            for (int b = 0; b < 2; ++b)
#pragma unroll
                for (int i = 0; i < 16; ++i) macc[a][b][i] = 0.f;
        MG g; g.A = WSB(WS_BR); g.lda = 1024; g.Wt = w.t_br; g.ldw = 1024; g.K = 1024;
        f32x16 acc[2][2];
        const int l = tidx() & 63, wv = tidx() >> 6, wm = wv % G_WM, wn = wv / G_WM;
        mgemm_tile_f(g, n0, RowId{m0}, acc, lds, true, 4, [&](int n, f32x16 (&a)[2][2]) {
#pragma unroll
            for (int ft = 0; ft < 2; ++ft)
#pragma unroll
                for (int tt = 0; tt < 2; ++tt)
#pragma unroll
                    for (int i = 0; i < 4; ++i) {
                        const int lrow = wm * 64 + tt * 32 + (l & 31), feat = wn * 64 + ft * 32 + 8 * i + 4 * (l >> 5);
                        const float4 gv = ld4bf(H + (long)(m0 + lrow) * NH + O_MG + n * 1024 + n0 + feat);
                        macc[ft][tt][4 * i] += gv.x * a[ft][tt][4 * i]; macc[ft][tt][4 * i + 1] += gv.y * a[ft][tt][4 * i + 1];
                        macc[ft][tt][4 * i + 2] += gv.z * a[ft][tt][4 * i + 2]; macc[ft][tt][4 * i + 3] += gv.w * a[ft][tt][4 * i + 3];
                        a[ft][tt][4 * i] = 0.f; a[ft][tt][4 * i + 1] = 0.f; a[ft][tt][4 * i + 2] = 0.f; a[ft][tt][4 * i + 3] = 0.f;
                    }
        });
        MG_FOREACH(macc, lrow, feat, v, { st4bf(M + (long)(m0 + lrow) * 1024 + n0 + feat, v[0], v[1], v[2], v[3]); });
    }
}
DI void ld8f(const bf16_t* p, float* f) { const u32x4 v = *(const u32x4*)p; f[0] = bflo(v[0]); f[1] = bfhi(v[0]); f[2] = bflo(v[1]); f[3] = bfhi(v[1]); f[4] = bflo(v[2]); f[5] = bfhi(v[2]); f[6] = bflo(v[3]); f[7] = bfhi(v[3]); }
DI void st8bf(bf16_t* p, const float* f) { u32x4 v; v[0] = pk_bf16(f[0], f[1]); v[1] = pk_bf16(f[2], f[3]); v[2] = pk_bf16(f[4], f[5]); v[3] = pk_bf16(f[6], f[7]); *(u32x4*)p = v; }
DI void job_ln(const float* xin, const bf16_t* xinb, const bf16_t* xinl, const bf16_t* y, const int* rowof, const float* ew, const float* gw, const float* bw, float* out, bf16_t* outb, bf16_t* outl, int bid, int nblk) {
    const int lane = tidx() & 63, wid = tidx() >> 6;
    float gv[16], bv[16];
#pragma unroll
    for (int i = 0; i < 2; ++i)
#pragma unroll
        for (int j = 0; j < 8; j += 4) { const int c = i * 512 + lane * 8 + j; const float4 g4 = *(const float4*)(gw + c), b4 = *(const float4*)(bw + c);
            gv[i * 8 + j] = g4.x; gv[i * 8 + j + 1] = g4.y; gv[i * 8 + j + 2] = g4.z; gv[i * 8 + j + 3] = g4.w; bv[i * 8 + j] = b4.x; bv[i * 8 + j + 1] = b4.y; bv[i * 8 + j + 2] = b4.z; bv[i * 8 + j + 3] = b4.w; }
    for (int t = bid * (NT / 64) + wid; t < T; t += nblk * (NT / 64)) {
        float v[16];
        float s = 0.f;
        int r0 = 0, r1 = 0; float w0 = 0.f, w1 = 0.f;
        if (rowof) { r0 = rowof[t * 2]; r1 = rowof[t * 2 + 1]; w0 = ew[t * 2]; w1 = ew[t * 2 + 1]; }
#pragma unroll
        for (int i = 0; i < 2; ++i) {
            const int c = i * 512 + lane * 8;
            float xv[8], yv[8];
            if (xin) { const float4 a = *(const float4*)(xin + (long)t * 1024 + c), b = *(const float4*)(xin + (long)t * 1024 + c + 4);
                xv[0] = a.x; xv[1] = a.y; xv[2] = a.z; xv[3] = a.w; xv[4] = b.x; xv[5] = b.y; xv[6] = b.z; xv[7] = b.w; }
            else ld8f(xinb + (long)t * 1024 + c, xv);
            if (xinl) { float z[8]; ld8f(xinl + (long)t * 1024 + c, z);
#pragma unroll
                for (int j = 0; j < 8; ++j) xv[j] += z[j]; }
            if (!rowof) ld8f(y + (long)t * 1024 + c, yv);
            else { float z0[8], z1[8]; ld8f(y + (long)r0 * 1024 + c, z0); ld8f(y + (long)r1 * 1024 + c, z1);
#pragma unroll
                for (int j = 0; j < 8; ++j) yv[j] = w0 * z0[j] + w1 * z1[j]; }
#pragma unroll
            for (int j = 0; j < 8; ++j) { v[i * 8 + j] = DN_ALPHA * xv[j] + yv[j]; s += v[i * 8 + j]; }
        }
        const float mu = wave_sum(s) * (1.f / 1024.f);
        float q = 0.f;
#pragma unroll
        for (int i = 0; i < 16; ++i) { const float dlt = v[i] - mu; q += dlt * dlt; }
        const float rstd = rsqrtf(wave_sum(q) * (1.f / 1024.f) + 1e-5f);
#pragma unroll
        for (int i = 0; i < 2; ++i) {
            const int c = i * 512 + lane * 8;
            float o[8];
#pragma unroll
            for (int j = 0; j < 8; ++j) o[j] = (v[i * 8 + j] - mu) * rstd * gv[i * 8 + j] + bv[i * 8 + j];
            if (out) { *(float4*)(out + (long)t * 1024 + c) = make_float4(o[0], o[1], o[2], o[3]); *(float4*)(out + (long)t * 1024 + c + 4) = make_float4(o[4], o[5], o[6], o[7]); }
            if (outb) st8bf(outb + (long)t * 1024 + c, o);
            if (outl) { float lo[8];
#pragma unroll
                for (int j = 0; j < 8; ++j) lo[j] = o[j] - bf2f(f2bf(o[j]));
                st8bf(outl + (long)t * 1024 + c, lo); }
        }
    }
}
DI void job_router(const Params& p, const LayerW& w, int layer, int bid, int nblk) {
    const float* LOG = WSF(WS_LOG); int* EIDX = WSI(WS_EIDX); int* ESLOT = WSI(WS_ESLOT); float* EW = WSF(WS_EW);
    unsigned* cnt = WSU(WS_CTL) + CW_CNT + layer * 32;
    for (int t = bid * NT + tidx(); t < T; t += nblk * NT) {
        const float* lr = LOG + (long)t * 36; const float* lr1 = lr + (size_t)T * 36; const float* lr2 = lr1 + (size_t)T * 36;
#define LG(i) ((lr[i] + lr1[i]) + lr2[i])
        const float g0 = LG(0) + w.rg_b[0], g1 = LG(1) + w.rg_b[1], g2 = LG(2) + w.rg_b[2], g3 = LG(3) + w.rg_b[3];
        const float gm = fmaxf(fmaxf(g0, g1), fmaxf(g2, g3));
        const float e0 = expf(g0 - gm), e1 = expf(g1 - gm), e2 = expf(g2 - gm), e3 = expf(g3 - gm);
        const float gs = (e0 + e1) + (e2 + e3);
        const float p0 = e0 / gs, p1 = e1 / gs, p2 = e2 / gs, p3 = e3 / gs;
        int grp = 0; float pg = p0;
        if (p1 > pg) { pg = p1; grp = 1; }
        if (p2 > pg) { pg = p2; grp = 2; }
        if (p3 > pg) { pg = p3; grp = 3; }
        float el[8];
#pragma unroll
        for (int i = 0; i < 8; ++i) el[i] = LG(4 + grp * 8 + i) + w.re_b[grp * 8 + i];
#undef LG
        float em = el[0];
#pragma unroll
        for (int i = 1; i < 8; ++i) em = fmaxf(em, el[i]);
        float es = 0.f;
#pragma unroll
        for (int i = 0; i < 8; ++i) { el[i] = expf(el[i] - em); es += el[i]; }
#pragma unroll
        for (int i = 0; i < 8; ++i) el[i] = el[i] / es;
        float b0 = el[0]; int i0 = 0;
#pragma unroll
        for (int i = 1; i < 8; ++i) if (el[i] > b0) { b0 = el[i]; i0 = i; }
        float b1 = -1.f; int i1 = 0;
#pragma unroll
        for (int i = 0; i < 8; ++i) if (i != i0 && el[i] > b1) { b1 = el[i]; i1 = i; }
        const float den = b0 + b1;
        const int ex0 = grp * 8 + i0, ex1 = grp * 8 + i1;
        EIDX[t * 2] = ex0; EIDX[t * 2 + 1] = ex1;
        EW[t * 2] = pg * b0 / den; EW[t * 2 + 1] = pg * b1 / den;
        ESLOT[t * 2] = (int)atomicAdd(&cnt[ex0], 1u);
        ESLOT[t * 2 + 1] = (int)atomicAdd(&cnt[ex1], 1u);
    }
}
DI int pad_rows(int c) { return (c + G_BM - 1) / G_BM * G_BM; }
DI void job_fill(const Params& p, int layer, int bid, int nblk, unsigned char* lds) {
    const int* EIDX = WSI(WS_EIDX); const int* ESLOT = WSI(WS_ESLOT); int* PERM = WSI(WS_PERM);
    unsigned* cnt = WSU(WS_CTL) + CW_CNT + layer * 32;
    const int lane = tidx() & 63, wid = tidx() >> 6;
    int* s_off = (int*)lds; int* s_cnt = s_off + 32;
    __syncthreads();
    if (tidx() < 32) s_cnt[tidx()] = (int)__hip_atomic_load(&cnt[tidx()], __ATOMIC_RELAXED, __HIP_MEMORY_SCOPE_AGENT);
    __syncthreads();
    if (tidx() == 0) { int o = 0; for (int e = 0; e < 32; ++e) { s_off[e] = o; o += pad_rows(s_cnt[e]); } }
    __syncthreads();
    for (int a = bid * (NT / 64) + wid; a < NASSIGN + NEXP; a += nblk * (NT / 64)) {
        const bool real = a < NASSIGN;
        const int e = real ? EIDX[a] : a - NASSIGN;
        const int off = s_off[e];
        if (real) {
            const int R = off + ESLOT[a];
            if (lane == 0) { PERM[R] = a; WSI(WS_ROWOF)[a] = R; }
        } else {
            const int c = s_cnt[e];
            for (int j = lane; c + j < pad_rows(c); j += 64) PERM[off + c + j] = -1;
        }
    }
}
DI pg8::ListOrder moe_units(unsigned* cnt, int bid, int nblk) {
    pg8::ListOrder S; S.n = 0; S.u0 = S.u1 = S.u2 = pg8::Unit{0, 0, 0};
    int rt = 0, ub = 0;
    for (int e = 0; e < 32; ++e) {
        const int c = pad_rows((int)__hip_atomic_load(&cnt[e], __ATOMIC_RELAXED, __HIP_MEMORY_SCOPE_AGENT)) >> 8, ue = c * 4;
#pragma unroll
        for (int k = 0; k < 3; ++k) {
            const int L = bid + k * nblk;
            if (L >= ub && L < ub + ue) { const int lu = L - ub; const pg8::Unit u{rt + (lu >> 2), lu & 3, e};
                if (k == 0) S.u0 = u; else if (k == 1) S.u1 = u; else S.u2 = u;
                S.n = k + 1; }
        }
        rt += c; ub += ue;
    }
#define RFL(x) x = __builtin_amdgcn_readfirstlane(x)
    RFL(S.n); RFL(S.u0.pm); RFL(S.u0.pn); RFL(S.u0.e); RFL(S.u1.pm); RFL(S.u1.pn); RFL(S.u1.e); RFL(S.u2.pm); RFL(S.u2.pn); RFL(S.u2.e);
#undef RFL
    return S;
}
typedef short s16x4 __attribute__((ext_vector_type(4)));
typedef short v4i16_t __attribute__((ext_vector_type(4)));
DI unsigned cvtpk(float lo, float hi) { return pk_bf16(lo, hi); }
DI int crow(int reg, int h) { return (reg & 3) + 8 * (reg >> 2) + 4 * h; }
DI s16x4 tr_read(const unsigned char* p) { return __builtin_bit_cast(s16x4, __builtin_amdgcn_ds_read_tr16_b64_v4i16((LAS v4i16_t*)p)); }
DI float xhalf_max(float m) { auto rr = __builtin_amdgcn_permlane32_swap(__float_as_uint(m), __float_as_uint(m), false, false); return fmaxf(__uint_as_float(rr[0]), __uint_as_float(rr[1])); }
DI float xhalf_sum(float m) { auto rr = __builtin_amdgcn_permlane32_swap(__float_as_uint(m), __float_as_uint(m), false, false); return __uint_as_float(rr[0]) + __uint_as_float(rr[1]); }
DI float xhalf_other(float v, int h) { auto rr = __builtin_amdgcn_permlane32_swap(__float_as_uint(v), __float_as_uint(v), false, false); return __uint_as_float(h ? rr[0] : rr[1]); }
DI bf16x8 pack8(const f32x16& x, int s2) {
    u32x4 pk; pk[0] = cvtpk(x[8 * s2], x[8 * s2 + 1]); pk[1] = cvtpk(x[8 * s2 + 2], x[8 * s2 + 3]); pk[2] = cvtpk(x[8 * s2 + 4], x[8 * s2 + 5]); pk[3] = cvtpk(x[8 * s2 + 6], x[8 * s2 + 7]);
    return __builtin_bit_cast(bf16x8, pk);
}
constexpr int ATT_QB = (NT / 64) * 32;
template <int DC> struct TileCfg { static constexpr int RS = DC * 2 + 16, BYTES = 64 * RS, NCH = 64 * DC / 8, NI = (NCH + NT - 1) / NT; };
template <int DC, class RowPtr> DI void tile_gload(u32x4 (&rg)[TileCfg<DC>::NI], RowPtr rp) {
#pragma unroll
    for (int i = 0; i < TileCfg<DC>::NI; ++i) { const int c = tidx() + NT * i; if (c < TileCfg<DC>::NCH) { const int row = c / (DC / 8), cc = c % (DC / 8); rg[i] = *(const u32x4*)(rp(row) + cc * 8); } }
}
template <int DC> DI void tile_lstore(const u32x4 (&rg)[TileCfg<DC>::NI], unsigned char* base) {
#pragma unroll
    for (int i = 0; i < TileCfg<DC>::NI; ++i) { const int c = tidx() + NT * i; if (c < TileCfg<DC>::NCH) { const int row = c / (DC / 8), cc = c % (DC / 8); *(u32x4*)(base + row * TileCfg<DC>::RS + cc * 16) = rg[i]; } }
}
template <int DK> DI void qk_tile(f32x16 (&s)[2], const bf16x8 (&qf)[DK / 16], const unsigned char* kl, int r, int h) {
    constexpr int RS = TileCfg<DK>::RS;
#pragma unroll
    for (int i = 0; i < 16; ++i) { s[0][i] = 0.f; s[1][i] = 0.f; }
#pragma unroll
    for (int ks = 0; ks < DK / 16; ++ks) {
        const bf16x8 k0 = *(const bf16x8*)(kl + r * RS + ks * 32 + h * 16), k1 = *(const bf16x8*)(kl + (32 + r) * RS + ks * 32 + h * 16);
        s[0] = __builtin_amdgcn_mfma_f32_32x32x16_bf16(k0, qf[ks], s[0], 0, 0, 0);
        s[1] = __builtin_amdgcn_mfma_f32_32x32x16_bf16(k1, qf[ks], s[1], 0, 0, 0);
    }
}
template <int DV> DI void pv_tile(f32x16 (&o)[DV / 32], const f32x16 (&pp)[2], const unsigned char* vl, int lane) {
    constexpr int RS = TileCfg<DV>::RS;
    const int h = lane >> 5, i16 = lane & 15, q = i16 >> 2, pq = i16 & 3, blk = (lane >> 4) & 1;
    const unsigned char* vb = vl + (4 * h + q) * RS + 2 * (16 * blk + 4 * pq);
#pragma unroll
    for (int kt = 0; kt < 2; ++kt)
#pragma unroll
        for (int s2 = 0; s2 < 2; ++s2) {
            const bf16x8 pf = pack8(pp[kt], s2);
#pragma unroll
            for (int dvt = 0; dvt < DV / 32; ++dvt) {
                const s16x4 lo = tr_read(vb + (kt * 32 + 16 * s2) * RS + dvt * 64), hi = tr_read(vb + (kt * 32 + 16 * s2 + 8) * RS + dvt * 64);
                const bf16x8 vf = __builtin_shufflevector(lo, hi, 0, 1, 2, 3, 4, 5, 6, 7);
                o[dvt] = __builtin_amdgcn_mfma_f32_32x32x16_bf16(vf, pf, o[dvt], 0, 0, 0);
            }
        }
}
constexpr float LOG2E = 1.4426950408889634f;
template <int DK, int DV, bool ALIBI, bool BOUNDARY, class ValidFn>
DI void softmax_tile(const bf16x8 (&qf)[DK / 16], f32x16 (&o)[DV / 32], float& m, float& l, const unsigned char* kl, const unsigned char* vl, int kb,
                     float c1, float sl2, int qpos, ValidFn valid, int lane) {
    const int r = lane & 31, h = lane >> 5;
    f32x16 s[2];
    qk_tile<DK>(s, qf, kl, r, h);
    const float base = ALIBI ? sl2 * (float)(kb + 4 * h - qpos) : 0.f;
    float tmax = -INFINITY;
#pragma unroll
    for (int kt = 0; kt < 2; ++kt)
#pragma unroll
        for (int i = 0; i < 16; ++i) {
            float v = ALIBI ? fmaf(s[kt][i], c1, fmaf(sl2, (float)(kt * 32 + (i & 3) + 8 * (i >> 2)), base)) : s[kt][i] * c1;
            if (BOUNDARY) v = valid(kb + kt * 32 + crow(i, h)) ? v : -INFINITY;
            s[kt][i] = v; tmax = fmaxf(tmax, v);
        }
    tmax = xhalf_max(tmax);
    const float mn = fmaxf(m, tmax);
    if (__any(mn > m)) {
        const float corr = __builtin_amdgcn_exp2f(m - mn);
        l *= corr;
#pragma unroll
        for (int dvt = 0; dvt < DV / 32; ++dvt)
#pragma unroll
            for (int i = 0; i < 16; ++i) o[dvt][i] *= corr;
        m = mn;
    }
    float ps = 0.f;
#pragma unroll
    for (int kt = 0; kt < 2; ++kt)
#pragma unroll
        for (int i = 0; i < 16; ++i) { const float pr = __builtin_amdgcn_exp2f(s[kt][i] - mn); s[kt][i] = pr; ps += pr; }
    l += ps;
    pv_tile<DV>(o, s, vl, lane);
}
template <int DK, int DV, bool ALIBI, class KPtr, class VPtr, class ValidFn, class InteriorFn>
DI void attn_stream(const bf16x8 (&qf)[DK / 16], f32x16 (&o)[DV / 32], float& m, float& l, unsigned tmask, int wave_qmax, int wave_kmin,
                    KPtr kp, VPtr vp, float c1, float sl2, int qpos, ValidFn valid, InteriorFn interior, unsigned char* lds) {
    unsigned char* kl = lds; unsigned char* vl = lds + TileCfg<DK>::BYTES;
    const int lane = tidx() & 63;
    u32x4 kA[TileCfg<DK>::NI], vA[TileCfg<DV>::NI], kB[TileCfg<DK>::NI], vB[TileCfg<DV>::NI];
    int ja = -1, jb = -1;
#define AS_NEXT(J, KR, VR) do { if (tmask) { J = __builtin_ctz(tmask); tmask &= tmask - 1; const int _j = J; \
        tile_gload<DK>(KR, [&](int row) { return kp(_j * 64 + row); }); tile_gload<DV>(VR, [&](int row) { return vp(_j * 64 + row); }); } else J = -1; } while (0)
#define AS_COMPUTE(J) do { const int _jc = (J); if (_jc * 64 <= wave_qmax && _jc * 64 + 63 >= wave_kmin) { \
        if (interior(_jc)) softmax_tile<DK, DV, ALIBI, false>(qf, o, m, l, kl, vl, _jc * 64, c1, sl2, qpos, valid, lane); \
        else softmax_tile<DK, DV, ALIBI, true>(qf, o, m, l, kl, vl, _jc * 64, c1, sl2, qpos, valid, lane); } } while (0)
    AS_NEXT(ja, kA, vA);
    AS_NEXT(jb, kB, vB);
    while (ja >= 0) {
        __syncthreads();
        tile_lstore<DK>(kA, kl); tile_lstore<DV>(vA, vl);
        __syncthreads();
        const int jc = ja;
        AS_NEXT(ja, kA, vA);
        AS_COMPUTE(jc);
        if (jb < 0) break;
        __syncthreads();
        tile_lstore<DK>(kB, kl); tile_lstore<DV>(vB, vl);
        __syncthreads();
        const int jd = jb;
        AS_NEXT(jb, kB, vB);
        AS_COMPUTE(jd);
    }
#undef AS_NEXT
#undef AS_COMPUTE
}

DI void job_mla_attn(const Params& p, int bid, int nblk, unsigned char* lds) {
    const bf16_t* QB = WSB(WS_QB); const bf16_t* KM = WSB(WS_KM); const bf16_t* VM = WSB(WS_VM); bf16_t* BR = WSB(WS_BR);
    constexpr int NQB = SEQ / ATT_QB, NU = BATCH * 4 * NQB;
    const int lane = tidx() & 63, wid = tidx() >> 6, r = lane & 31, h = lane >> 5;
    for (int u = bid; u < NU; u += nblk) {
        const int qblk = u / (BATCH * 4), bh = u % (BATCH * 4);
        const int b = bh >> 2, hd = bh & 3;
        const int q0 = qblk * ATT_QB, qw = q0 + wid * 32, qpos = qw + r;
        const long trow = (long)b * SEQ;
        bf16x8 qf[6];
#pragma unroll
        for (int ks = 0; ks < 6; ++ks) qf[ks] = *(const bf16x8*)(QB + (trow + qpos) * 384 + hd * 96 + ks * 16 + 8 * h);
        f32x16 o[2];
#pragma unroll
        for (int i = 0; i < 16; ++i) { o[0][i] = 0.f; o[1][i] = 0.f; }
        float m = -1e30f, l = 0.f;
        const int ntile = (q0 + ATT_QB - 1) / 64 + 1;
        const unsigned tmask = ntile >= 32 ? 0xffffffffu : ((1u << ntile) - 1u);
        attn_stream<96, 64, false>(qf, o, m, l, tmask, qw + 31, 0,
            [&](int row) { return KM + (trow + row) * 384 + hd * 96; },
            [&](int row) { return VM + (trow + row) * 256 + hd * 64; },
            0.10206207261596577f * LOG2E, 0.f, qpos,
            [&](int key) { return key <= qpos; }, [&](int j) { return j * 64 + 63 <= qw; }, lds);
        const float rl = 1.f / fmaxf(xhalf_sum(l), 1e-30f);
        bf16_t* dst = BR + (trow + qpos) * 1024 + 3 * 256 + hd * 64;
#pragma unroll
        for (int dvt = 0; dvt < 2; ++dvt)
#pragma unroll
            for (int i = 0; i < 4; ++i)
                st4bf(dst + dvt * 32 + 8 * i + 4 * h, o[dvt][4 * i] * rl, o[dvt][4 * i + 1] * rl, o[dvt][4 * i + 2] * rl, o[dvt][4 * i + 3] * rl);
    }
}
DI void job_cross_attn(const Params& p, int layer, int bid, int nblk, unsigned char* lds) {
    const bf16_t* XQ = WSB(WS_XQ); const bf16_t* KVM = WSB(WS_KVM) + (size_t)layer * 2048 * 1024; bf16_t* XO = WSB(WS_XO);
    constexpr int NQB = SEQ / ATT_QB, NU = BATCH * 4 * NQB;
    const int lane = tidx() & 63, wid = tidx() >> 6, r = lane & 31, h = lane >> 5;
    for (int u = bid; u < NU; u += nblk) {
        const int bh = u % (BATCH * 4), qblk = u / (BATCH * 4);
        const int b = bh >> 2, hd = bh & 3;
        const int qpos = qblk * ATT_QB + wid * 32 + r;
        const long trow = (long)b * SEQ;
        bf16x8 qf[8];
#pragma unroll
        for (int ks = 0; ks < 8; ++ks) qf[ks] = *(const bf16x8*)(XQ + (trow + qpos) * 512 + hd * 128 + ks * 16 + 8 * h);
        f32x16 o[4];
#pragma unroll
        for (int d = 0; d < 4; ++d)
#pragma unroll
            for (int i = 0; i < 16; ++i) o[d][i] = 0.f;
        float m = -1e30f, l = 0.f;
        attn_stream<128, 128, false>(qf, o, m, l, 0xFu, 1 << 30, 0,
            [&](int row) { return KVM + (long)(b * MEM_LEN + row) * 1024 + hd * 128; },
            [&](int row) { return KVM + (long)(b * MEM_LEN + row) * 1024 + 512 + hd * 128; },
            0.08838834764831845f * LOG2E, 0.f, qpos, [&](int) { return true; }, [&](int) { return true; }, lds);
        const float rl = 1.f / fmaxf(xhalf_sum(l), 1e-30f);
        bf16_t* dst = XO + (trow + qpos) * 512 + hd * 128;
#pragma unroll
        for (int dvt = 0; dvt < 4; ++dvt)
#pragma unroll
            for (int i = 0; i < 4; ++i)
                st4bf(dst + dvt * 32 + 8 * i + 4 * h, o[dvt][4 * i] * rl, o[dvt][4 * i + 1] * rl, o[dvt][4 * i + 2] * rl, o[dvt][4 * i + 3] * rl);
    }
}
DI float logsig_fast(float z) { return fminf(z, 0.f) - __logf(1.f + __expf(-fabsf(z))); }
DI void job_sb_attn(const Params& p, int bid, int nblk, unsigned char* lds) {
    const bf16_t* H = WSB(WS_H); bf16_t* BR = WSB(WS_BR);
    constexpr int NQB = SEQ / ATT_QB, NU = BATCH * 4 * NQB;
    const int lane = tidx() & 63, wid = tidx() >> 6, r = lane & 31, h = lane >> 5;
    unsigned char* kl = lds; unsigned char* vl = lds + TileCfg<64>::BYTES;
    for (int u = bid; u < NU; u += nblk) {
        const int half = u / (NU / 2), ru = u % (NU / 2);
        const int qi = ru / (BATCH * 4), bh = ru % (BATCH * 4);
        const int qblk = half == 0 ? (NQB - 1 - qi) : qi;
        const int b = bh >> 2, hd = bh & 3;
        const int q0 = qblk * ATT_QB, qw = q0 + wid * 32, qpos = qw + r;
        const long trow = (long)b * SEQ;
        bf16x8 qf[4];
#pragma unroll
        for (int ks = 0; ks < 4; ++ks) qf[ks] = *(const bf16x8*)(H + (trow + qpos) * NH + O_BQ + hd * 64 + ks * 16 + 8 * h);
        f32x16 o[2];
#pragma unroll
        for (int i = 0; i < 16; ++i) { o[0][i] = 0.f; o[1][i] = 0.f; }
        float trun = 0.f;
        int j = (q0 + ATT_QB - 1) >> 6;
        volatile int* flag = (volatile int*)(lds + 2 * TileCfg<64>::BYTES);
        if (tidx() == 0) { flag[0] = 0; flag[1] = 0; }
        u32x4 kr[TileCfg<64>::NI], vr[TileCfg<64>::NI];
        tile_gload<64>(kr, [&](int row) { return H + (trow + j * 64 + row) * NH + O_BK + hd * 64; });
        tile_gload<64>(vr, [&](int row) { return H + (trow + j * 64 + row) * NH + O_BV + hd * 64; });
        for (int it = 0; j >= 0; --j, ++it) {
            __syncthreads();
            if (it > 0 && flag[(it - 1) & 1] == 0) break;
            tile_lstore<64>(kr, kl); tile_lstore<64>(vr, vl);
            __syncthreads();
            if (tidx() == 0) flag[(it + 1) & 1] = 0;
            if (j > 0) { const int jn = j - 1;
                tile_gload<64>(kr, [&](int row) { return H + (trow + jn * 64 + row) * NH + O_BK + hd * 64; });
                tile_gload<64>(vr, [&](int row) { return H + (trow + jn * 64 + row) * NH + O_BV + hd * 64; }); }
            const bool wave_dead = __all(trun < -110.f);
            if (j * 64 < qw + 31 && !wave_dead) {
                const int kb = j * 64;
                f32x16 s[2], L[2];
                qk_tile<64>(s, qf, kl, r, h);
#pragma unroll
                for (int kt = 0; kt < 2; ++kt)
#pragma unroll
                    for (int i = 0; i < 16; ++i) {
                        const int key = kb + kt * 32 + crow(i, h);
                        const float z = s[kt][i] * 0.125f, lsp = logsig_fast(z);
                        const bool valid = key < qpos;
                        L[kt][i] = valid ? lsp - z : 0.f;
                        s[kt][i] = valid ? lsp : -INFINITY;
                    }
                float G[2][4], O[2][4];
#pragma unroll
                for (int kt = 0; kt < 2; ++kt)
#pragma unroll
                    for (int ig = 0; ig < 4; ++ig) { G[kt][ig] = (L[kt][4 * ig] + L[kt][4 * ig + 1]) + (L[kt][4 * ig + 2] + L[kt][4 * ig + 3]); O[kt][ig] = xhalf_other(G[kt][ig], h); }
                float run = trun;
#pragma unroll
                for (int kt = 1; kt >= 0; --kt)
#pragma unroll
                    for (int ig = 3; ig >= 0; --ig) {
                        const float t3 = run + (h == 0 ? O[kt][ig] : 0.f);
                        const float t2 = t3 + L[kt][4 * ig + 3], t1 = t2 + L[kt][4 * ig + 2], t0 = t1 + L[kt][4 * ig + 1];
                        s[kt][4 * ig + 3] = __expf(s[kt][4 * ig + 3] + t3); s[kt][4 * ig + 2] = __expf(s[kt][4 * ig + 2] + t2);
                        s[kt][4 * ig + 1] = __expf(s[kt][4 * ig + 1] + t1); s[kt][4 * ig + 0] = __expf(s[kt][4 * ig + 0] + t0);
                        run += G[kt][ig] + O[kt][ig];
                    }
                trun = run;
                pv_tile<64>(o, s, vl, lane);
            }
            if (!__all(trun < -110.f)) flag[it & 1] = 1;
        }
        bf16_t* dst = BR + (trow + qpos) * 1024 + 1 * 256 + hd * 64;
#pragma unroll
        for (int dvt = 0; dvt < 2; ++dvt)
#pragma unroll
            for (int i = 0; i < 4; ++i) st4bf(dst + dvt * 32 + 8 * i + 4 * h, o[dvt][4 * i], o[dvt][4 * i + 1], o[dvt][4 * i + 2], o[dvt][4 * i + 3]);
    }
}
constexpr int NSA_QB = (NT / 128) * 32;
DI void job_nsa(const Params& p, int bid, int nblk, unsigned char* lds) {
    const bf16_t* H = WSB(WS_H); const bf16_t* KCB = WSB(WS_KCB); const bf16_t* VCB = KCB + (size_t)NCR * 64;
    float* OACC = WSF(WS_OC); bf16_t* BR = WSB(WS_BR);
    constexpr int NQB = SEQ / NSA_QB, NU = BATCH * 2 * NQB;
    constexpr int TB_ = TileCfg<64>::BYTES;
    const int lane = tidx() & 63, wid = tidx() >> 6, r = lane & 31, h = lane >> 5;
    const int n = wid & 1, sub = wid >> 1;
    unsigned* orw = (unsigned*)(lds + 4 * TB_);
    float* impx = (float*)(lds + 4 * TB_ + 64);
    for (int u = bid; u < NU; u += nblk) {
        const int qblk = NQB - 1 - u / (BATCH * 2), bg = u % (BATCH * 2), b = bg >> 1, g = bg & 1;
        const int q0 = qblk * NSA_QB, qw = q0 + sub * 32, qpos = qw + r;
        const int head = g * 2 + n;
        const long trow = (long)b * SEQ;
        const bf16_t* hq_row = H + (trow + qpos) * NH;
        bf16x8 qf[1][4];
#pragma unroll
        for (int ks = 0; ks < 4; ++ks) qf[0][ks] = *(const bf16x8*)(hq_row + O_AQ + head * 64 + ks * 16 + 8 * h);
        const float sl = exp2f(-2.f * (float)(head + 1));
        const float gate0 = sigm(bf2f(hq_row[O_AG + head * 3 + 0])), gate1 = sigm(bf2f(hq_row[O_AG + head * 3 + 1])), gate2 = sigm(bf2f(hq_row[O_AG + head * 3 + 2]));
        float* oacc = OACC + (trow + qpos) * 256 + head * 64;
        __syncthreads();
        if (tidx() == 0) *orw = 0u;
        {
            u32x4 rg[TileCfg<64>::NI];
#pragma unroll
            for (int tl = 0; tl < 4; ++tl) {
                const bf16_t* src = (tl & 2) ? VCB : KCB; const int cb = (tl & 1) * 64;
                tile_gload<64>(rg, [&](int row) { const int c = cb + row < NCMP ? cb + row : NCMP - 1; return src + ((long)(b * NCMP + c) * 2 + g) * 64; });
                tile_lstore<64>(rg, lds + tl * TB_);
            }
        }
        __syncthreads();
        float imp[16];
        {
            f32x16 s[2][2];
            qk_tile<64>(s[0], qf[0], lds, r, h);
            qk_tile<64>(s[1], qf[0], lds + TB_, r, h);
            float tmax = -INFINITY;
#pragma unroll
            for (int tl = 0; tl < 2; ++tl)
#pragma unroll
                for (int kt = 0; kt < 2; ++kt)
#pragma unroll
                    for (int i = 0; i < 16; ++i) {
                        const int c = tl * 64 + kt * 32 + crow(i, h), dist = qpos - (16 * c + 31);
                        const float v = (c < NCMP && dist >= 0) ? s[tl][kt][i] * 0.125f - sl * (float)dist : -INFINITY;
                        s[tl][kt][i] = v; tmax = fmaxf(tmax, v);
                    }
            const float mn = fmaxf(xhalf_max(tmax), -1e30f);
            float ps = 0.f;
#pragma unroll
            for (int tl = 0; tl < 2; ++tl)
#pragma unroll
                for (int kt = 0; kt < 2; ++kt)
#pragma unroll
                    for (int i = 0; i < 16; ++i) { const float pr = __expf(s[tl][kt][i] - mn); s[tl][kt][i] = pr; ps += pr; }
            const float rl = 1.f / fmaxf(xhalf_sum(ps), 1e-30f);
            float P3[16];
#pragma unroll
            for (int tl = 0; tl < 2; ++tl)
#pragma unroll
                for (int kt = 0; kt < 2; ++kt) {
#pragma unroll
                    for (int ig = 0; ig < 4; ++ig) {
                        const float p0 = s[tl][kt][4 * ig] * rl, p1 = s[tl][kt][4 * ig + 1] * rl, p2 = s[tl][kt][4 * ig + 2] * rl, p3 = s[tl][kt][4 * ig + 3] * rl;
                        imp[tl * 8 + kt * 4 + ig] = (p0 + p1) + (p2 + 0.5f * p3);
                        P3[tl * 8 + kt * 4 + ig] = 0.5f * p3;
                    }
                    const float gs = rl * gate0;
#pragma unroll
                    for (int i = 0; i < 16; ++i) s[tl][kt][i] *= gs;
                }
#pragma unroll
            for (int idx = 0; idx < 16; ++idx) {
                const float pp = xhalf_other(P3[idx], h);
                float prevp;
                if (idx == 0) prevp = h ? pp : 0.f; else { const float ppm = xhalf_other(P3[idx - 1], h); prevp = h ? pp : ppm; }
                imp[idx] += prevp;
                impx[(wid * 16 + idx) * 64 + lane] = imp[idx];
            }
            f32x16 oc[2];
#pragma unroll
            for (int i = 0; i < 16; ++i) { oc[0][i] = 0.f; oc[1][i] = 0.f; }
            pv_tile<64>(oc, s[0], lds + 2 * TB_, lane);
            pv_tile<64>(oc, s[1], lds + 3 * TB_, lane);
#pragma unroll
            for (int dvt = 0; dvt < 2; ++dvt)
#pragma unroll
                for (int i = 0; i < 4; ++i) *(float4*)(oacc + dvt * 32 + 8 * i + 4 * h) = make_float4(oc[dvt][4 * i], oc[dvt][4 * i + 1], oc[dvt][4 * i + 2], oc[dvt][4 * i + 3]);
        }
        __syncthreads();
        unsigned sel = 0u;
        {
            const int cur = qpos >> 6;
#pragma unroll
            for (int idx = 0; idx < 16; ++idx) {
                const float other = impx[((wid ^ 1) * 16 + idx) * 64 + lane];
                const float tot = n == 0 ? imp[idx] + other : other + imp[idx];
                const int j = 2 * idx + h;
                const bool forced = (j == 0) || (j == cur), valid = (j * 64 <= qpos);
                imp[idx] = forced ? 1e4f : (valid ? tot : -1.0f);
            }
#pragma unroll 1
            for (int it = 0; it < 8; ++it) {
                float best = -INFINITY; int bj = 64;
#pragma unroll
                for (int idx = 0; idx < 16; ++idx) if (imp[idx] > best) { best = imp[idx]; bj = 2 * idx + h; }
                const float pb = xhalf_other(best, h); const int pj = __float_as_int(xhalf_other(__int_as_float(bj), h));
                const bool own = (best > pb) || (best == pb && bj < pj);
                const int wj = own ? bj : pj;
                sel |= 1u << wj;
#pragma unroll
                for (int idx = 0; idx < 16; ++idx) if (2 * idx + h == wj) imp[idx] = -INFINITY;
            }
        }
        atomicOr(orw, sel);
        __syncthreads();
        const unsigned bmask = *orw;
        const int jhi = (q0 + NSA_QB - 1) >> 6;
        const unsigned upto = jhi >= 31 ? 0xffffffffu : ((1u << (jhi + 1)) - 1u);
        const float c1 = 0.125f * LOG2E, sl2 = sl * LOG2E;
        {
            f32x16 o[2];
#pragma unroll
            for (int i = 0; i < 16; ++i) { o[0][i] = 0.f; o[1][i] = 0.f; }
            float m = -1e30f, l = 0.f;
            const int jlo = (q0 - 511 > 0 ? q0 - 511 : 0) >> 6;
            const unsigned tmask = upto & ~((1u << jlo) - 1u);
            attn_stream<64, 64, true>(qf[0], o, m, l, tmask, qw + 31, qw - 511,
                [&](int row) { return H + (trow + row) * NH + O_AKW + g * 64; },
                [&](int row) { return H + (trow + row) * NH + O_AVW + g * 64; },
                c1, sl2, qpos,
                [&](int key) { const int dist = qpos - key; return dist >= 0 && dist < 512; },
                [&](int j) { return j * 64 + 63 <= qw && qw + 31 - j * 64 < 512; }, lds);
            const float rl = gate2 / fmaxf(xhalf_sum(l), 1e-30f);
#pragma unroll
            for (int dvt = 0; dvt < 2; ++dvt)
#pragma unroll
                for (int i = 0; i < 4; ++i) { float4* a = (float4*)(oacc + dvt * 32 + 8 * i + 4 * h); float4 c = *a;
                    c.x += o[dvt][4 * i] * rl; c.y += o[dvt][4 * i + 1] * rl; c.z += o[dvt][4 * i + 2] * rl; c.w += o[dvt][4 * i + 3] * rl; *a = c; }
        }
        {
            f32x16 o[2];
#pragma unroll
            for (int i = 0; i < 16; ++i) { o[0][i] = 0.f; o[1][i] = 0.f; }
            float m = -1e30f, l = 0.f;
            attn_stream<64, 64, true>(qf[0], o, m, l, bmask & upto, qw + 31, 0,
                [&](int row) { return H + (trow + row) * NH + O_AKS + g * 64; },
                [&](int row) { return H + (trow + row) * NH + O_AVS + g * 64; },
                c1, sl2, qpos,
                [&](int key) { return key <= qpos && ((sel >> (key >> 6)) & 1u); },
                [&](int j) { return j * 64 + 63 <= qw && __all((sel >> j) & 1u); }, lds);
            const float rl = gate1 / fmaxf(xhalf_sum(l), 1e-30f);
            bf16_t* dst = BR + (trow + qpos) * 1024 + head * 64;
#pragma unroll
            for (int dvt = 0; dvt < 2; ++dvt)
#pragma unroll
                for (int i = 0; i < 4; ++i) { const float4 c = *(const float4*)(oacc + dvt * 32 + 8 * i + 4 * h);
                    st4bf(dst + dvt * 32 + 8 * i + 4 * h, c.x + o[dvt][4 * i] * rl, c.y + o[dvt][4 * i + 1] * rl, c.z + o[dvt][4 * i + 2] * rl, c.w + o[dvt][4 * i + 3] * rl); }
        }
    }
}

namespace pg8 { typedef PG8_LAS unsigned char* PG8_LAS_T; }
#define LDS3 ((pg8::PG8_LAS_T)lds)
#define GEMM256(EPI, SCHED, g, S, E) do { __syncthreads(); pg8::gemm_phase<EPI, SCHED, false, true>(LDS3, g, S, E); } while (0)
constexpr int NPH = 18;
constexpr int NPHASES = 2 + DEPTH * NPH;

__global__ void __launch_bounds__(NT, 2) mega(Params pk, int ph_lo, int ph_hi) {
    extern __shared__ __attribute__((aligned(16))) unsigned char lds[];
    const int bid = blockIdx.x, nblk = gridDim.x;
#define XB_HERE XcdBarrier bar_; bar_.bar = (unsigned*)(pk.ws + WS_CTL) + CW_BAR; bar_.x = xb_xcc_id(); bar_.st = (volatile LAS unsigned*)(lds + 131072)
    const bool multi = (ph_hi - ph_lo) > 1;
    if (multi) {
        uint4* xbw = (uint4*)(lds + 131072);
        if (tidx() == 0) *xbw = make_uint4(0u, 0u, 0u, 0u);
        __syncthreads();
        (void)xcd_barrier_post((unsigned*)(pk.ws + WS_CTL) + CW_BAR, (volatile LAS unsigned*)xbw);
    }
#ifndef PROBE_PH
#define PROBE_PH -100
#endif
#define PHASE(id, ...) do { const int _id = (id); if (ph_lo <= _id && _id < ph_hi) { for (int _rep = 0; _rep < ((PROBE_PH == -1 ? _id < 2 : (_id >= 2 && (_id - 2) % NPH == PROBE_PH)) ? 2 : 1); ++_rep) { if (_rep) { XB_HERE; xcd_barrier(bar_); } { Params p = pk; int layer = layer_; asm volatile("" : "+s"(p.ws), "+s"(p.out), "+s"(layer)); \
        const LayerW w = layer_w(p, layer); const float* Xin = (layer == 0) ? p.in[0] : WSF(WS_XC); const bf16_t* XinB = (layer == 0) ? WSB(WS_X0B) : WSB(WS_XCB); float* Xout = (layer == DEPTH - 1) ? p.out : WSF(WS_XC); \
        (void)w; (void)Xin; (void)XinB; (void)Xout; __VA_ARGS__; } } if (_id + 1 < ph_hi) { XB_HERE; xcd_barrier(bar_); } } } while (0)

    { const int layer_ = 0;
    PHASE(0, {
        job_wt<2>(p.in[2], DEPTH, 1024, NIN, WSB(WT_IN), NH, bid, nblk, lds);
        job_wt<0>(p.in[17], DEPTH, 1024, 1024, WSB(WT_BR), 1024, bid, nblk, lds);
        job_wt<0>(p.in[18], DEPTH, 1024, 1024, WSB(WT_OUT), 1024, bid, nblk, lds);
        job_wt<0>(p.in[21], DEPTH, 1024, 512, WSB(WT_Q), 512, bid, nblk, lds);
        job_wt<0>(p.in[22], DEPTH, 1024, 1024, WSB(WT_KV), 1024, bid, nblk, lds);
        job_wt<0>(p.in[23], DEPTH, 512, 1024, WSB(WT_O), 1024, bid, nblk, lds);
        job_wt<1>(p.in[30], DEPTH * 32, 1024, 1024, WSB(WT_GU), 1024, bid, nblk, lds);
        job_wt<0>(p.in[31], DEPTH * 32, 512, 1024, WSB(WT_DN), 1024, bid, nblk, lds);
        job_wt<0>(p.in[4], DEPTH * 2, 2048, 256, WSB(WT_C1), 256, bid, nblk, lds);
        job_wt<0>(p.in[5], DEPTH * 2, 256, 64, WSB(WT_C2), 128, bid, nblk, lds);
        job_wt<0>(p.in[15], DEPTH, 192, 384, WSB(WT_UQ), 384, bid, nblk, lds);
        job_wt<0>(p.in[16], DEPTH, 128, 512, WSB(WT_UKV), 512, bid, nblk, lds);
        job_pack_small(p, bid, nblk);
        job_cvt(p.in[0], WSB(WS_X0B), (long)T * 1024, bid, nblk);
        job_cvt(p.in[1], WSB(WS_MEMB), (long)2048 * 1024, bid, nblk);
    });
    PHASE(1, {
        pg8::Gemm g{WSB(WS_MEMB), WSB(WT_KV), BATCH * MEM_LEN, 1024, 1024, nullptr};
        GroupedOrder S{8, 4, DEPTH, nblk, bid};
        EpiStoreBf16 E{WSB(WS_KVM), 1024, 1 << 30, (long)2048 * 1024};
        GEMM256(EpiStoreBf16, GroupedOrder, g, S, E);
    });
    }
    for (int layer_ = 0; layer_ < DEPTH; ++layer_) {
        const int base = 2 + layer_ * NPH;
        PHASE(base + 0, { pg8::Gemm g{XinB, w.t_in, T, NH, 1024, nullptr}; pg8::StaticOrder S; S.init(T, NH, nblk, bid); EpiStoreBf16 E{WSB(WS_H), NH, O_MG / 128, 0}; GEMM256(EpiStoreBf16, pg8::StaticOrder, g, S, E); });
        PHASE(base + 1, { job_sb_attn(p, bid, nblk, lds); job_cmp_gather(p, w, bid, nblk); job_rnn_conv(p, w, bid, nblk); job_mla_norm(p, w, bid, nblk); });
        PHASE(base + 2, { if (bid < 32) job_cmp_mlp<0>(p, w, bid, 32, lds); else { job_rnn_gates(p, w, bid - 32, nblk - 32, lds); job_mla_up(p, w, bid - 32, nblk - 32, lds); } });
        PHASE(base + 3, { job_cmp_mlp<1>(p, w, bid, nblk, lds); job_rnn_scan1(p, bid, nblk); });
        PHASE(base + 4, { job_nsa(p, bid, nblk, lds); job_mla_attn(p, bid, nblk, lds); job_rnn_scan2(p, bid, nblk); });
        PHASE(base + 5, { job_merge(p, w, bid, nblk, lds); });
        PHASE(base + 6, { pg8::Gemm g{WSB(WS_M), w.t_out, T, 1024, 1024, nullptr}; pg8::StaticOrder S; S.init(T, 1024, nblk, bid); EpiStoreBf16 E{WSB(WS_Y), 1024, 1 << 30, 0}; GEMM256(EpiStoreBf16, pg8::StaticOrder, g, S, E); });
        PHASE(base + 7, { job_ln(layer == 0 ? p.in[0] : nullptr, WSB(WS_XCB), nullptr, WSB(WS_Y), nullptr, nullptr, w.ln1_g, w.ln1_b, nullptr, WSB(WS_XAB), nullptr, bid, nblk); });
        PHASE(base + 8, { pg8::Gemm g{WSB(WS_XAB), w.t_q, T, 512, 1024, nullptr}; pg8::StaticOrder S; S.init(T, 512, nblk, bid); EpiStoreBf16 E{WSB(WS_XQ), 512, 1 << 30, 0}; GEMM256(EpiStoreBf16, pg8::StaticOrder, g, S, E); });
        PHASE(base + 9, { job_cross_attn(p, layer, bid, nblk, lds); });
        PHASE(base + 10, { pg8::Gemm g{WSB(WS_XO), w.t_o, T, 1024, 512, nullptr}; pg8::StaticOrder S; S.init(T, 1024, nblk, bid); EpiStoreBf16 E{WSB(WS_Y), 1024, 1 << 30, 0}; GEMM256(EpiStoreBf16, pg8::StaticOrder, g, S, E); });
        PHASE(base + 11, { job_ln(nullptr, WSB(WS_XAB), nullptr, WSB(WS_Y), nullptr, nullptr, w.ln2_g, w.ln2_b, nullptr, WSB(WS_XBB), WSB(WS_XBL), bid, nblk); });
        PHASE(base + 12, { job_router_logits(p, w, bid, nblk, lds); });
        PHASE(base + 13, { job_router(p, w, layer, bid, nblk); });
        PHASE(base + 14, { job_fill(p, layer, bid, nblk, lds); });
        PHASE(base + 15, { const pg8::ListOrder S = moe_units(WSU(WS_CTL) + CW_CNT + layer * 32, bid, nblk); pg8::Gemm g{WSB(WS_XBB), w.t_gu, PADROWS, 1024, 1024, WSI(WS_PERM)}; EpiMoeGU E{WSB(WS_HH)}; __syncthreads(); pg8::gemm_phase<EpiMoeGU, pg8::ListOrder, false, true, true>(LDS3, g, S, E); });
        PHASE(base + 16, { const pg8::ListOrder S = moe_units(WSU(WS_CTL) + CW_CNT + layer * 32, bid, nblk); pg8::Gemm g{WSB(WS_HH), w.t_dn, PADROWS, 1024, 512, nullptr}; EpiStoreBf16 E{WSB(WS_YK), 1024, 1 << 30, 0}; GEMM256(EpiStoreBf16, pg8::ListOrder, g, S, E); });
        PHASE(base + 17, { job_ln(nullptr, WSB(WS_XBB), WSB(WS_XBL), WSB(WS_YK), WSI(WS_ROWOF), WSF(WS_EW), w.ln3_g, w.ln3_b, (layer == DEPTH - 1) ? p.out : nullptr, (layer == DEPTH - 1) ? nullptr : WSB(WS_XCB), nullptr, bid, nblk); });
    }
}

extern "C" void kernel_launch(void* const* d_in, const int* in_sizes, int n_in, void* d_out, int out_size, void* d_ws, size_t ws_size, hipStream_t stream) {
    constexpr size_t kDynLds = 131072 + 1024;
    static_assert(2 * G_STAGE + 1024 <= 131072, "engine stages fit");
    static int grid = 0;
    if (!grid) {
        int dev = 0, cus = 0, per_cu = 0;
        (void)hipGetDevice(&dev);
        (void)hipDeviceGetAttribute(&cus, hipDeviceAttributeMultiprocessorCount, dev);
        (void)hipFuncSetAttribute((const void*)mega, hipFuncAttributeMaxDynamicSharedMemorySize, (int)kDynLds);
        (void)hipOccupancyMaxActiveBlocksPerMultiprocessor(&per_cu, mega, NT, kDynLds);
        if (per_cu < 1) per_cu = 1;
        grid = cus * (per_cu < 2 ? per_cu : 2);
    }
    if (ws_size < WS_END) { fprintf(stderr, "workspace too small: %zu < %zu\n", ws_size, (size_t)WS_END); return; }
    Params p{};
    for (int i = 0; i < 34; ++i) p.in[i] = (const float*)d_in[i];
    p.out = (float*)d_out;
    p.ws = (unsigned char*)d_ws;
    (void)hipMemsetAsync(d_ws, 0, CTL_BYTES, stream);
#if MK_ONE_LAUNCH
    hipLaunchKernelGGL(mega, dim3(grid), dim3(NT), kDynLds, stream, p, 0, NPHASES);
#else
    for (int ph = 0; ph < NPHASES; ++ph) hipLaunchKernelGGL(mega, dim3(grid), dim3(NT), kDynLds, stream, p, ph, ph + 1);
#endif
}
```

```cpp
#include <hip/hip_runtime.h>
#include <stdint.h>
#include <stdio.h>

#ifndef MK_ONE_LAUNCH
#define MK_ONE_LAUNCH 1
#endif

#define DI __device__ __forceinline__
#define LAS __attribute__((address_space(3)))
DI int tidx() { int t = threadIdx.x; asm volatile("" : "+v"(t)); return t; }

constexpr int NT = 512;
constexpr int D = 1024, BATCH = 8, SEQ = 2048, T = BATCH * SEQ, DEPTH = 4;
constexpr int MEM_LEN = 256;
constexpr int NIN = 6764, NH = 6912;
constexpr int O_AQ = 0, O_AKC = 256, O_AVC = 384, O_AKS = 512, O_AVS = 640, O_AKW = 768, O_AVW = 896,
              O_BQ = 1024, O_BK = 1280, O_BV = 1536, O_CX = 1792, O_CG = 2048, O_DCQ = 2304, O_DCKV = 2496, O_DKR = 2624,
              O_AG = 2656, O_MG = 2688;
constexpr int NCMP = 127, NCR = BATCH * NCMP * 2;
constexpr int NEXP = 32, NASSIGN = T * 2;
constexpr float DN_ALPHA = 1.681792830507429f;

typedef unsigned short bf16_t;
typedef short bf16x8 __attribute__((ext_vector_type(8)));
typedef float f32x16 __attribute__((ext_vector_type(16)));
typedef unsigned u32x4 __attribute__((ext_vector_type(4)));

constexpr int G_WM = NT / 128;
constexpr int G_BM = 64 * G_WM;
constexpr int G_BN = 128;
constexpr int G_RS = 144;
constexpr int G_STAGE = (G_BM + G_BN) * G_RS;
constexpr int PADROWS = ((NASSIGN + NEXP * (G_BM - 1) + G_BM - 1) / G_BM) * G_BM;

constexpr size_t MiB = 1u << 20;
constexpr size_t al(size_t x) { return (x + 255) & ~(size_t)255; }
constexpr size_t WS_CTL = 0, CTL_BYTES = 1 * MiB;
constexpr size_t WT_IN = WS_CTL + CTL_BYTES;
constexpr size_t WT_BR = WT_IN + al((size_t)DEPTH * NH * 1024 * 2);
constexpr size_t WT_OUT = WT_BR + al((size_t)DEPTH * 4 * 1024 * 256 * 2);
constexpr size_t WT_Q = WT_OUT + al((size_t)DEPTH * 1024 * 1024 * 2);
constexpr size_t WT_KV = WT_Q + al((size_t)DEPTH * 512 * 1024 * 2);
constexpr size_t WT_O = WT_KV + al((size_t)DEPTH * 1024 * 1024 * 2);
constexpr size_t WT_GU = WT_O + al((size_t)DEPTH * 1024 * 512 * 2);
constexpr size_t WT_DN = WT_GU + al((size_t)DEPTH * 32 * 1024 * 1024 * 2);
constexpr size_t WS_X0B = WT_DN + al((size_t)DEPTH * 32 * 1024 * 512 * 2);
constexpr size_t WS_MEMB = WS_X0B + al((size_t)T * 1024 * 2);
constexpr size_t WS_H = WS_MEMB + al((size_t)2048 * 1024 * 2);
constexpr size_t SZ_H = al((size_t)T * NH * 2);
constexpr size_t WS_YK = WS_H;
constexpr size_t WS_HH = WS_YK + (size_t)PADROWS * 1024 * 2;
static_assert(WS_HH + (size_t)PADROWS * 512 * 2 <= WS_H + SZ_H, "moe overlay fits in H");
constexpr size_t WS_TB = WS_H + SZ_H;
constexpr size_t WS_HID = WS_TB + al((size_t)2 * NCR * 2048 * 4);
constexpr size_t WS_KCVC = WS_HID + al((size_t)2 * NCR * 256 * 4);
constexpr size_t WS_PC = WS_KCVC + al((size_t)2 * NCR * 64 * 4);
constexpr size_t WS_SEL = WS_PC + al((size_t)BATCH * 4 * SEQ * 128 * 4);
constexpr size_t WS_OW = WS_SEL + al((size_t)BATCH * 2 * SEQ * 4);
constexpr size_t WS_OC = WS_OW + al((size_t)T * 256 * 4);
constexpr size_t WS_BR = WS_OC + al((size_t)T * 256 * 4);
constexpr size_t WS_U = WS_BR + al((size_t)T * 1024 * 2);
constexpr size_t WS_RA = WS_U + al((size_t)T * 256 * 4);
constexpr size_t WS_RB = WS_RA + al((size_t)T * 256 * 4);
constexpr size_t WS_CQN = WS_RB + al((size_t)T * 256 * 4);
constexpr size_t WS_CKVN = WS_CQN + al((size_t)T * 192 * 4);
constexpr size_t WS_KR = WS_CKVN + al((size_t)T * 128 * 4);
constexpr size_t WS_Q = WS_KR + al((size_t)T * 32 * 4);
constexpr size_t WS_KV = WS_Q + al((size_t)T * 384 * 4);
constexpr size_t WS_M = WS_KV + al((size_t)T * 512 * 4);
constexpr size_t WS_Y = WS_M + al((size_t)T * 1024 * 2);
constexpr size_t WS_XA = WS_Y + al((size_t)T * 1024 * 4);
constexpr size_t WS_XB = WS_XA + al((size_t)T * 1024 * 4);
constexpr size_t WS_XC = WS_XB + al((size_t)T * 1024 * 4);
constexpr size_t WS_XAB = WS_XC + al((size_t)T * 1024 * 4);
constexpr size_t WS_XBB = WS_XAB + al((size_t)T * 1024 * 2);
constexpr size_t WS_XCB = WS_XBB + al((size_t)T * 1024 * 2);
constexpr size_t WS_XQ = WS_XCB + al((size_t)T * 1024 * 2);
constexpr size_t WS_XO = WS_XQ + al((size_t)T * 512 * 2);
constexpr size_t WS_KVM = WS_XO + al((size_t)T * 512 * 2);
constexpr size_t WS_LOG = WS_KVM + al((size_t)DEPTH * 2048 * 1024 * 2);
constexpr size_t WS_EIDX = WS_LOG + al((size_t)3 * T * 36 * 4);
constexpr size_t WS_ESLOT = WS_EIDX + al((size_t)NASSIGN * 4);
constexpr size_t WS_EW = WS_ESLOT + al((size_t)NASSIGN * 4);
constexpr size_t WS_PERM = WS_EW + al((size_t)NASSIGN * 4);
constexpr size_t WS_QB = WS_PERM + al((size_t)PADROWS * 4);
constexpr size_t WS_KM = WS_QB + al((size_t)T * 384 * 2);
constexpr size_t WS_VM = WS_KM + al((size_t)T * 384 * 2);
constexpr size_t WS_KCB = WS_VM + al((size_t)T * 256 * 2);
constexpr size_t WT_C1 = WS_KCB + al((size_t)2 * NCR * 64 * 2);
constexpr size_t WT_C2 = WT_C1 + al((size_t)DEPTH * 2 * 256 * 2048 * 2);
constexpr size_t WT_UQ = WT_C2 + al((size_t)DEPTH * 2 * 128 * 256 * 2);
constexpr size_t WT_UKV = WT_UQ + al((size_t)DEPTH * 384 * 192 * 2);
constexpr size_t WT_G = WT_UKV + al((size_t)DEPTH * 512 * 128 * 2);
constexpr size_t WT_RH = WT_G + al((size_t)DEPTH * 4 * 128 * 64 * 2);
constexpr size_t WT_RL = WT_RH + al((size_t)DEPTH * 128 * 1024 * 2);
constexpr size_t WS_TBB = WT_RL + al((size_t)DEPTH * 128 * 1024 * 2);
constexpr size_t WS_HIDB = WS_TBB + al((size_t)2 * 2048 * 2048 * 2);
constexpr size_t WS_UB = WS_HIDB + al((size_t)2 * 2048 * 256 * 2);
constexpr size_t WS_CQNB = WS_UB + al((size_t)T * 256 * 2);
constexpr size_t WS_CKVNB = WS_CQNB + al((size_t)T * 192 * 2);
constexpr size_t WS_XBL = WS_CKVNB + al((size_t)T * 128 * 2);
constexpr size_t WS_SA = WS_XBL + al((size_t)T * 1024 * 2);
constexpr size_t WS_SH = WS_SA + al((size_t)BATCH * 32 * 256 * 4);
constexpr size_t WS_XG = WS_SH + al((size_t)BATCH * 32 * 256 * 4);
constexpr size_t WS_ROWOF = WS_XG + al((size_t)PADROWS * 1024 * 2);
constexpr size_t WS_ROPE_PRE = WS_ROWOF + al((size_t)NASSIGN * 4);
constexpr size_t WS_ROPE = WS_ROPE_PRE;
constexpr size_t WS_END = WS_ROPE + al((size_t)SEQ * 16 * 2 * 4);

constexpr int CW_BAR = 4096;
constexpr int CW_CNT = 16384;

struct Params {
    const float* in[34];
    float* out;
    unsigned char* ws;
};

#define XB_TMO      128
#define XB_XCNT(j)  (256  + 64 * (j))
#define XB_XSUB(j)  (1280 + 64 * (j))
#define XB_XGEN(j)  (2304 + 64 * (j))
#define XB_TOP      3328
#define XB_TOPGEN   3392
#define XCD_BAR_WORDS 3456
#define XB_SPIN_CAP (1u << 22)

__device__ __forceinline__ unsigned xb_ld(unsigned* p)              { return __hip_atomic_load(p, __ATOMIC_RELAXED, __HIP_MEMORY_SCOPE_AGENT); }
__device__ __forceinline__ unsigned xb_add(unsigned* p, unsigned v) { return __hip_atomic_fetch_add(p, v, __ATOMIC_RELAXED, __HIP_MEMORY_SCOPE_AGENT); }
__device__ __forceinline__ unsigned xb_xcc_id() { return (unsigned)__builtin_amdgcn_s_getreg((3 << 11) | 20) & 0xFu; }
#define XB_SPIN(cond, bar) do { unsigned _sp = 0; while (cond) { __builtin_amdgcn_s_sleep(1); \
    if ((++_sp & 255u) == 0u) { if (xb_ld(&(bar)[XB_TMO])) break; if (_sp > XB_SPIN_CAP) { atomicAdd(&(bar)[XB_TMO], 1u); break; } } } } while (0)

struct XcdBarrier { unsigned* bar; unsigned x; volatile LAS unsigned* st; };

__device__ __forceinline__ XcdBarrier xcd_barrier_post(unsigned* bar, volatile LAS unsigned* st) {
    XcdBarrier b; b.bar = bar; b.x = xb_xcc_id(); b.st = st;
    if (threadIdx.x == 0) (void)xb_add(&bar[XB_XCNT(b.x)], 1u);
    return b;
}
__device__ __forceinline__ void xcd_barrier_complete(unsigned* bar, unsigned x, unsigned& nloc, unsigned& nx) {
    const unsigned G = gridDim.x * gridDim.y * gridDim.z;
    unsigned sum, cnt, mine, sp = 0u;
    for (;;) {
        sum = 0u; cnt = 0u; mine = 0u;
#pragma unroll
        for (unsigned j = 0; j < 16; ++j) { const unsigned c = xb_ld(&bar[XB_XCNT(j)]); sum += c; cnt += (c > 0u) ? 1u : 0u; mine = (j == x) ? c : mine; }
        if (sum == G) break;
        __builtin_amdgcn_s_sleep(1);
        if ((++sp & 255u) == 0u) { if (xb_ld(&bar[XB_TMO])) break; if (sp > XB_SPIN_CAP) { atomicAdd(&bar[XB_TMO], 1u); break; } }
    }
    nloc = mine > 0u ? mine : 1u; nx = cnt > 0u ? cnt : 1u;
}
__device__ __forceinline__ void xcd_barrier(const XcdBarrier& b) {
    asm volatile("s_waitcnt vmcnt(0)" ::: "memory");
    __syncthreads();
    if (threadIdx.x == 0) {
        unsigned* bar = b.bar;
        __builtin_amdgcn_s_waitcnt(0);
        unsigned nloc = b.st[0], nx = b.st[1];
        if (nloc == 0u) { xcd_barrier_complete(bar, b.x, nloc, nx); b.st[0] = nloc; b.st[1] = nx; }
        const unsigned old = xb_add(&bar[XB_XSUB(b.x)], 1u);
        const unsigned gen = old / nloc;
        if (old + 1u == (gen + 1u) * nloc) {
            __builtin_amdgcn_fence(__ATOMIC_RELEASE, "agent");
            asm volatile("s_waitcnt vmcnt(0)" ::: "memory");
            const unsigned og = xb_add(&bar[XB_TOP], 1u);
            const unsigned tg = og / nx;
            if (og + 1u == (tg + 1u) * nx) xb_add(&bar[XB_TOPGEN], 1u);
            else XB_SPIN(xb_ld(&bar[XB_TOPGEN]) == tg, bar);
            __builtin_amdgcn_fence(__ATOMIC_ACQUIRE, "agent");
            xb_add(&bar[XB_XGEN(b.x)], 1u);
            asm volatile("s_waitcnt vmcnt(0)" ::: "memory");
        } else {
            XB_SPIN(xb_ld(&bar[XB_XGEN(b.x)]) == gen, bar);
            __builtin_amdgcn_fence(__ATOMIC_ACQUIRE, "agent");
            asm volatile("s_waitcnt vmcnt(0)" ::: "memory");
        }
    }
    __syncthreads();
}

DI float gelu_tanh(float x) { const float u = 0.7978845608028654f * (x + 0.044715f * x * x * x); return 0.5f * x * (1.f + tanhf(u)); }
DI float sigm(float x) { return 1.f / (1.f + expf(-x)); }
DI float sigm_fast(float x) { return __builtin_amdgcn_rcpf(1.f + __expf(-x)); }
DI float logsig(float z) { return fminf(z, 0.f) - log1pf(expf(-fabsf(z))); }
DI float wave_sum(float v) {
    const int lane = tidx() & 63;
#pragma unroll
    for (int o = 32; o > 0; o >>= 1) v += __int_as_float(__builtin_amdgcn_ds_bpermute((lane ^ o) << 2, __float_as_int(v)));
    return v;
}
DI void wave_sum2(float& a, float& b) {
    const int lane = tidx() & 63;
#pragma unroll
    for (int o = 32; o > 0; o >>= 1) {
        const float a2 = __int_as_float(__builtin_amdgcn_ds_bpermute((lane ^ o) << 2, __float_as_int(a)));
        const float b2 = __int_as_float(__builtin_amdgcn_ds_bpermute((lane ^ o) << 2, __float_as_int(b)));
        a += a2; b += b2;
    }
}

DI float bflo(unsigned u) { return __uint_as_float(u << 16); }
DI float bfhi(unsigned u) { return __uint_as_float(u & 0xffff0000u); }
DI float bf2f(bf16_t x) { return __uint_as_float((unsigned)x << 16); }
typedef float f32x2_t __attribute__((ext_vector_type(2)));
typedef __bf16 bf16x2_t __attribute__((ext_vector_type(2)));
DI unsigned pk_bf16(float lo, float hi) { f32x2_t v = {lo, hi}; bf16x2_t b = __builtin_convertvector(v, bf16x2_t); return __builtin_bit_cast(unsigned, b); }
DI bf16_t f2bf(float x) { return (bf16_t)(pk_bf16(x, 0.f) & 0xffffu); }
DI void st4bf(bf16_t* p, float a, float b, float c, float d) { uint2 v; v.x = pk_bf16(a, b); v.y = pk_bf16(c, d); *(uint2*)p = v; }
DI void ld8f(const bf16_t* p, float* f) { const u32x4 v = *(const u32x4*)p; f[0] = bflo(v[0]); f[1] = bfhi(v[0]); f[2] = bflo(v[1]); f[3] = bfhi(v[1]); f[4] = bflo(v[2]); f[5] = bfhi(v[2]); f[6] = bflo(v[3]); f[7] = bfhi(v[3]); }
DI void st8bf(bf16_t* p, const float* f) { u32x4 v; v[0] = pk_bf16(f[0], f[1]); v[1] = pk_bf16(f[2], f[3]); v[2] = pk_bf16(f[4], f[5]); v[3] = pk_bf16(f[6], f[7]); *(u32x4*)p = v; }
DI float4 ld4bf(const bf16_t* p) { const uint2 v = *(const uint2*)p; return make_float4(bflo(v.x), bfhi(v.x), bflo(v.y), bfhi(v.y)); }
template <int N> DI float dot_row(const float* q, const bf16_t* kr) {
    float dot = 0.f;
#pragma unroll
    for (int d = 0; d < N; d += 8) { const uint4 v = *(const uint4*)(kr + d);
        dot = fmaf(q[d], bflo(v.x), dot); dot = fmaf(q[d + 1], bfhi(v.x), dot); dot = fmaf(q[d + 2], bflo(v.y), dot); dot = fmaf(q[d + 3], bfhi(v.y), dot);
        dot = fmaf(q[d + 4], bflo(v.z), dot); dot = fmaf(q[d + 5], bfhi(v.z), dot); dot = fmaf(q[d + 6], bflo(v.w), dot); dot = fmaf(q[d + 7], bfhi(v.w), dot); }
    return dot;
}
template <int N> DI float dot_row(const float* q, const float* kr) {
    float dot = 0.f;
#pragma unroll
    for (int d = 0; d < N; ++d) dot = fmaf(q[d], kr[d], dot);
    return dot;
}
template <int N> DI void axpy_row(float* o, float pr, float corr, const bf16_t* vr) {
#pragma unroll
    for (int d = 0; d < N; d += 8) { const uint4 v = *(const uint4*)(vr + d);
        o[d] = fmaf(pr, bflo(v.x), o[d] * corr); o[d + 1] = fmaf(pr, bfhi(v.x), o[d + 1] * corr); o[d + 2] = fmaf(pr, bflo(v.y), o[d + 2] * corr); o[d + 3] = fmaf(pr, bfhi(v.y), o[d + 3] * corr);
        o[d + 4] = fmaf(pr, bflo(v.z), o[d + 4] * corr); o[d + 5] = fmaf(pr, bfhi(v.z), o[d + 5] * corr); o[d + 6] = fmaf(pr, bflo(v.w), o[d + 6] * corr); o[d + 7] = fmaf(pr, bfhi(v.w), o[d + 7] * corr); }
}
template <int N> DI void axpy_row(float* o, float pr, float corr, const float* vr) {
#pragma unroll
    for (int d = 0; d < N; ++d) o[d] = fmaf(pr, vr[d], o[d] * corr);
}
template <int N> DI void ld_row(float* q, const bf16_t* p) {
#pragma unroll
    for (int d = 0; d < N; d += 8) { const uint4 v = *(const uint4*)(p + d);
        q[d] = bflo(v.x); q[d + 1] = bfhi(v.x); q[d + 2] = bflo(v.y); q[d + 3] = bfhi(v.y); q[d + 4] = bflo(v.z); q[d + 5] = bfhi(v.z); q[d + 6] = bflo(v.w); q[d + 7] = bfhi(v.w); }
}
template <int N> DI void ld_row(float* q, const float* p) {
#pragma unroll
    for (int d = 0; d < N; d += 4) { const float4 v = *(const float4*)(p + d); q[d] = v.x; q[d + 1] = v.y; q[d + 2] = v.z; q[d + 3] = v.w; }
}

struct MG { const bf16_t* A; long lda; const bf16_t* Wt; long ldw; int K; };

struct NoFlush { DI void operator()(int, f32x16 (&)[2][2]) const {} };
template <class RowFn, class Flush>
DI void mgemm_tile_f(const MG& g, int n0, RowFn rowfn, f32x16 (&acc)[2][2], unsigned char* lds, bool zero, int flush_every, Flush flush) {
    constexpr int XI = G_BM * 8 / NT, WI = G_BN * 8 / NT;
    const int tid = tidx(), lane = tid & 63, wid = tid >> 6, r = lane & 31, h = lane >> 5;
    const int wm = wid % G_WM, wn = wid / G_WM;
    const int cc = tid & 7, row0 = tid >> 3;
    const bf16_t* xp[XI]; const bf16_t* wp[WI];
#pragma unroll
    for (int i = 0; i < XI; ++i) xp[i] = g.A + (long)rowfn(row0 + (NT / 8) * i) * g.lda + cc * 8;
#pragma unroll
    for (int i = 0; i < WI; ++i) wp[i] = g.Wt + (long)(n0 + row0 + (NT / 8) * i) * g.ldw + cc * 8;
    const int st_off = row0 * G_RS + cc * 16;
    if (zero)
#pragma unroll
    for (int a = 0; a < 2; ++a)
#pragma unroll
        for (int b = 0; b < 2; ++b)
#pragma unroll
            for (int i = 0; i < 16; ++i) acc[a][b][i] = 0.f;
    const int nk = g.K >> 6;
    u32x4 xv0[XI], wv0[WI], xv1[XI], wv1[WI];
#define MG_GLOAD(XV, WV, KT) do { _Pragma("unroll") for (int i = 0; i < XI; ++i) XV[i] = *(const u32x4*)(xp[i] + (KT) * 64); \
                                  _Pragma("unroll") for (int i = 0; i < WI; ++i) WV[i] = *(const u32x4*)(wp[i] + (KT) * 64); } while (0)
#define MG_LSTORE(XV, WV, STG) do { unsigned char* _s = lds + (STG) * G_STAGE; \
        _Pragma("unroll") for (int i = 0; i < XI; ++i) *(u32x4*)(_s + st_off + (NT / 8) * i * G_RS) = XV[i]; \
        _Pragma("unroll") for (int i = 0; i < WI; ++i) *(u32x4*)(_s + G_BM * G_RS + st_off + (NT / 8) * i * G_RS) = WV[i]; } while (0)
    MG_GLOAD(xv0, wv0, 0);
    if (nk > 1) MG_GLOAD(xv1, wv1, 1);
    __syncthreads();
    MG_LSTORE(xv0, wv0, 0);
    if (nk > 2) MG_GLOAD(xv0, wv0, 2);
    __syncthreads();
    const int xf_off = (wm * 64 + r) * G_RS + h * 16, wf_off = G_BM * G_RS + (wn * 64 + r) * G_RS + h * 16;
#define MG_COMPUTE(STG) do { const unsigned char* st = lds + (STG) * G_STAGE; \
        _Pragma("unroll") for (int ks = 0; ks < 4; ++ks) { \
            const bf16x8 w0 = *(const bf16x8*)(st + wf_off + ks * 32), w1 = *(const bf16x8*)(st + wf_off + 32 * G_RS + ks * 32); \
            const bf16x8 x0 = *(const bf16x8*)(st + xf_off + ks * 32), x1 = *(const bf16x8*)(st + xf_off + 32 * G_RS + ks * 32); \
            acc[0][0] = __builtin_amdgcn_mfma_f32_32x32x16_bf16(w0, x0, acc[0][0], 0, 0, 0); \
            acc[0][1] = __builtin_amdgcn_mfma_f32_32x32x16_bf16(w0, x1, acc[0][1], 0, 0, 0); \
            acc[1][0] = __builtin_amdgcn_mfma_f32_32x32x16_bf16(w1, x0, acc[1][0], 0, 0, 0); \
            acc[1][1] = __builtin_amdgcn_mfma_f32_32x32x16_bf16(w1, x1, acc[1][1], 0, 0, 0); } } while (0)
    for (int kt = 0; kt < nk; kt += 2) {
        MG_COMPUTE(0);
        if (kt + 1 < nk) { MG_LSTORE(xv1, wv1, 1); if (kt + 3 < nk) MG_GLOAD(xv1, wv1, kt + 3); }
        if (flush_every && (kt + 1) % flush_every == 0) flush(kt / flush_every, acc);
        __syncthreads();
        if (kt + 1 < nk) {
            MG_COMPUTE(1);
            if (kt + 2 < nk) { MG_LSTORE(xv0, wv0, 0); if (kt + 4 < nk) MG_GLOAD(xv0, wv0, kt + 4); }
            if (flush_every && (kt + 2) % flush_every == 0) flush((kt + 1) / flush_every, acc);
            __syncthreads();
        }
    }
#undef MG_GLOAD
#undef MG_LSTORE
#undef MG_COMPUTE
}
template <class RowFn>
DI void mgemm_tile(const MG& g, int n0, RowFn rowfn, f32x16 (&acc)[2][2], unsigned char* lds, bool zero = true) { mgemm_tile_f(g, n0, rowfn, acc, lds, zero, 0, NoFlush{}); }
#define MG_FOREACH(acc, LROW, FEAT, V, ...) do { const int _l = tidx() & 63, _w = tidx() >> 6, _wm = _w % G_WM, _wn = _w / G_WM; \
    _Pragma("unroll") for (int _ft = 0; _ft < 2; ++_ft) _Pragma("unroll") for (int _tt = 0; _tt < 2; ++_tt) _Pragma("unroll") for (int _i = 0; _i < 4; ++_i) { \
        const int LROW = _wm * 64 + _tt * 32 + (_l & 31); const int FEAT = _wn * 64 + _ft * 32 + 8 * _i + 4 * (_l >> 5); \
        float V[4] = {acc[_ft][_tt][4 * _i], acc[_ft][_tt][4 * _i + 1], acc[_ft][_tt][4 * _i + 2], acc[_ft][_tt][4 * _i + 3]}; __VA_ARGS__ } } while (0)

struct RowId { int m0; DI long operator()(int r) const { return m0 + r; } };

template <int OUTMODE>
DI void mgemm_job(const MG& g, int M, int N, void* out, long ldo, int bid, int nblk, unsigned char* lds) {
    const int tm = M / G_BM, tn = N / G_BN;
    for (int u = bid; u < tm * tn; u += nblk) {
        const int grp = u / (16 * tn), rem = u % (16 * tn);
        const int gm = (tm - grp * 16) < 16 ? (tm - grp * 16) : 16;
        const int mt = grp * 16 + rem % gm, nt = rem / gm;
        const int m0 = mt * G_BM, n0 = nt * G_BN;
        f32x16 acc[2][2];
        mgemm_tile(g, n0, RowId{m0}, acc, lds);
        MG_FOREACH(acc, lrow, feat, v, {
            const long o = (long)(m0 + lrow) * ldo + n0 + feat;
            if (OUTMODE == 1) *(float4*)((float*)out + o) = make_float4(v[0], v[1], v[2], v[3]);
            else {
                if (OUTMODE == 2 && n0 + feat >= O_MG) { v[0] = sigm(v[0]); v[1] = sigm(v[1]); v[2] = sigm(v[2]); v[3] = sigm(v[3]); }
                st4bf((bf16_t*)out + o, v[0], v[1], v[2], v[3]);
            } });
    }
}

namespace pg8 {
#define PG8_LAS __attribute__((address_space(3)))
typedef float f32x4 __attribute__((ext_vector_type(4)));
constexpr int BM = 256, BK = 64, HALF = 128, HTB = HALF * BK * 2  , STAGE_BYTES = 8 * HTB, NXCD = 8, WGM = 8;
__host__ __device__ __forceinline__ int lds_byte(int r, int c) { const int st = (r >> 4) * 2 + (c >> 5), rr = r & 15, cc = c & 31, ob = rr * 64 + cc * 2; return st * 1024 + (ob ^ (((ob >> 9) & 1) << 5)); }
__host__ __device__ __forceinline__ void stage_rc(int b, int& R, int& C) { const int st = b / 1024, sb = b % 1024, swz = sb ^ (((sb >> 9) & 1) << 5); R = (st >> 1) * 16 + swz / 64; C = (st & 1) * 32 + (swz % 64) / 2; }
__host__ __device__ __forceinline__ int perm32(int rho) { const int n = rho >> 4, i = rho & 15; return 8 * (i >> 2) + 4 * n + (i & 3); }
struct Unit { int pm, pn, e; };
struct Gemm { const bf16_t* A; const bf16_t* Bt; int M, N, K; const int* rowidx; };
struct StaticOrder {
    int nM, nN, nwg, G, c;
    __device__ void init(int M, int N, int G_, int c_) { nM = M / BM; nN = N / BM; nwg = nM * nN; G = G_; c = c_; }
    __device__ bool next(int i, Unit& u) const {
        const long L = (long)i * G + c; if (L >= nwg) return false;
        int wgid = (int)L; { const int q = nwg / NXCD, r = nwg % NXCD, xcd = wgid % NXCD, off = wgid / NXCD; wgid = (xcd < r ? xcd * (q + 1) : r * (q + 1) + (xcd - r) * q) + off; }
        const int nig = WGM * nN, gid = wgid / nig, fm = gid * WGM, gsz = (nM - fm) < WGM ? (nM - fm) : WGM;
        u.pm = fm + ((wgid % nig) % gsz); u.pn = (wgid % nig) / gsz; u.e = 0; return true;
    }
    __device__ __forceinline__ void a_ready(const Unit&) const {}
    __device__ __forceinline__ void done(const Unit&) const {}
};
struct ListOrder {
    Unit u0, u1, u2; int n;
    __device__ bool next(int i, Unit& u) const { if (i >= n) return false; u = (i == 0) ? u0 : ((i == 1) ? u1 : u2); return true; }
    __device__ __forceinline__ void a_ready(const Unit&) const {}
    __device__ __forceinline__ void done(const Unit&) const {}
};
template <class Epi, class Sched, bool ALIGN_EPI = false, bool SP2 = false, bool GATHER = false>
__device__ __forceinline__ void gemm_phase(PG8_LAS unsigned char* lds, const Gemm g, const Sched& S, const Epi& E) {
    const int tid = tidx(), wid = __builtin_amdgcn_readfirstlane(tid >> 6), lane = tid & 63, wr = wid >> 2, wc = wid & 3, fr = lane & 15, fq = lane >> 4;
    const int K = g.K, nt = K / BK;
    unsigned voffA[2], voffB[2];
#pragma unroll
    for (int i = 0; i < 2; ++i) { int R, C; stage_rc(tid * 16 + i * 8192, R, C); const int Rb = Epi::PERM ? ((R & ~31) + perm32(R & 31)) : R;
        voffA[i] = (unsigned)(R * K + C) * 2u; voffB[i] = (unsigned)(Rb * K + C) * 2u; }
    unsigned voffC[2][2] = {{0u, 0u}, {0u, 0u}}, voffN[2][2] = {{0u, 0u}, {0u, 0u}};
    auto gather_offs = [&](int pm, unsigned (&vo)[2][2]) {
#pragma unroll
        for (int hh = 0; hh < 2; ++hh)
#pragma unroll
            for (int i = 0; i < 2; ++i) { int R, C; stage_rc(tid * 16 + i * 8192, R, C); int a = g.rowidx[pm * BM + hh * HALF + R]; a = a < 0 ? 0 : (a >> 1); vo[hh][i] = (unsigned)(a * K + C) * 2u; }
    };
    const size_t kstep = (size_t)(BK * 2);
    const size_t hstep = (size_t)HALF * K * 2;
    const size_t tstep = 2 * hstep;
    const size_t estep = (size_t)g.N * K * 2;
    const unsigned ldsw = (unsigned)wid * 1024u;
    const int aoff = lds_byte(wr * 64 + fr, fq * 8), boff = lds_byte(wc * 32 + fr, fq * 8);
#define PG8_SA(b, h) (((b) * 2 + (h)) * HTB)
#define PG8_SB(b, h) ((4 + (b) * 2 + (h)) * HTB)
#define PG8_STAGE(bufoff, gbase, voff) do { _Pragma("unroll") for (int _i = 0; _i < 2; ++_i) \
        __builtin_amdgcn_global_load_lds((const unsigned*)((const char*)(gbase) + (voff)[_i]), (PG8_LAS unsigned*)(lds + (bufoff) + ldsw + _i * 8192), 16, 0, 0); } while (0)
#define PG8_STAGE_A(bufoff, HH, KT, NX, densebase) do { if constexpr (GATHER) { const char* _gb = (const char*)g.A + (size_t)(KT) * kstep; if (NX) PG8_STAGE(bufoff, _gb, voffN[HH]); else PG8_STAGE(bufoff, _gb, voffC[HH]); } else PG8_STAGE(bufoff, densebase, voffA); } while (0)
#define PG8_LDA(dst, b, h) do { _Pragma("unroll") for (int m = 0; m < 4; ++m) _Pragma("unroll") for (int k = 0; k < 2; ++k) dst[m][k] = *(const PG8_LAS bf16x8*)(lds + PG8_SA(b, h) + aoff + m * 2048 + k * 1024); } while (0)
#define PG8_LDB(dst, b, h) do { _Pragma("unroll") for (int n = 0; n < 2; ++n) _Pragma("unroll") for (int k = 0; k < 2; ++k) dst[n][k] = *(const PG8_LAS bf16x8*)(lds + PG8_SB(b, h) + boff + n * 2048 + k * 1024); } while (0)
#define PG8_MMA(ai, bj, At, Bt) do { __builtin_amdgcn_s_setprio(1); _Pragma("unroll") for (int m = 0; m < 4; ++m) _Pragma("unroll") for (int n = 0; n < 2; ++n) _Pragma("unroll") for (int k = 0; k < 2; ++k) \
        acc[ai][bj][m][n] = __builtin_amdgcn_mfma_f32_16x16x32_bf16(Bt[n][k], At[m][k], acc[ai][bj][m][n], 0, 0, 0); __builtin_amdgcn_s_setprio(0); } while (0)
#define PG8_WAIT_V(n) asm volatile("s_waitcnt vmcnt(" #n ")" ::: "memory")
#define PG8_WAIT_L(n) asm volatile("s_waitcnt lgkmcnt(" #n ")" ::: "memory")
#define PG8_BAR __builtin_amdgcn_s_barrier()
#define PG8_SCHED __builtin_amdgcn_sched_barrier(0)
    Unit cur, nxt; int ui = 0;
    if (!S.next(0, cur)) return;
    f32x4 acc[2][2][4][2];
#pragma unroll
    for (int a = 0; a < 2; ++a)
#pragma unroll
        for (int b = 0; b < 2; ++b)
#pragma unroll
            for (int m = 0; m < 4; ++m)
#pragma unroll
                for (int n = 0; n < 2; ++n) acc[a][b][m][n] = (f32x4){0.f, 0.f, 0.f, 0.f};
    bf16x8 At[4][2], B0[2][2], B1[2][2];
    const char* cA = (const char*)g.A + (size_t)cur.pm * tstep; const char* cB = (const char*)g.Bt + (size_t)cur.e * estep + (size_t)cur.pn * tstep;
    S.a_ready(cur);
    if constexpr (GATHER) gather_offs(cur.pm, voffC);
    if constexpr (SP2) {
        PG8_STAGE(PG8_SB(0, 0), cB, voffB); PG8_STAGE(PG8_SB(0, 1), cB + hstep, voffB); PG8_STAGE_A(PG8_SA(0, 0), 0, 0, false, cA); PG8_STAGE_A(PG8_SA(0, 1), 1, 0, false, cA + hstep);
        if (wr == 1) PG8_BAR;
        PG8_WAIT_V(2); PG8_BAR;
        PG8_STAGE(PG8_SB(1, 0), cB + kstep, voffB); PG8_STAGE_A(PG8_SA(1, 0), 0, 1, false, cA + kstep); PG8_STAGE(PG8_SB(1, 1), cB + hstep + kstep, voffB);
        PG8_WAIT_V(6); PG8_BAR;
    } else {
        PG8_STAGE(PG8_SB(0, 0), cB, voffB); PG8_STAGE_A(PG8_SA(0, 0), 0, 0, false, cA); PG8_STAGE(PG8_SB(0, 1), cB + hstep, voffB); PG8_STAGE_A(PG8_SA(0, 1), 1, 0, false, cA + hstep);
        if (wr == 1) PG8_BAR;
        PG8_WAIT_V(4); PG8_BAR;
        PG8_STAGE(PG8_SB(1, 0), cB + kstep, voffB); PG8_STAGE_A(PG8_SA(1, 0), 0, 1, false, cA + kstep); PG8_STAGE(PG8_SB(1, 1), cB + hstep + kstep, voffB);
        PG8_WAIT_V(6); PG8_BAR;
    }
    for (;;) {
        const bool has_next = S.next(ui + 1, nxt);
        if constexpr (GATHER) { if (has_next) gather_offs(nxt.pm, voffN); else {
#pragma unroll
            for (int hh = 0; hh < 2; ++hh) { voffN[hh][0] = voffC[hh][0]; voffN[hh][1] = voffC[hh][1]; } } }
        const char* nA = has_next ? (const char*)g.A + (size_t)nxt.pm * tstep : cA; const char* nB = has_next ? (const char*)g.Bt + (size_t)nxt.e * estep + (size_t)nxt.pn * tstep : cB;
        for (int t = 0; t < nt; t += 2) {
            const bool last = (t == nt - 2);
            const char* a1 = cA + (size_t)(t + 1) * kstep;
            const char* a2 = last ? nA : cA + (size_t)(t + 2) * kstep; const char* b2 = last ? nB : cB + (size_t)(t + 2) * kstep;
            const char* a3 = a2 + kstep; const char* b3 = b2 + kstep;
            if (last && has_next) S.a_ready(nxt);
            if constexpr (SP2) {
            PG8_LDB(B0, 0, 0); PG8_LDB(B1, 0, 1); PG8_SCHED; PG8_LDA(At, 0, 0); PG8_STAGE_A(PG8_SA(1, 1), 1, t + 1, false, a1 + hstep);
            PG8_WAIT_V(8); PG8_WAIT_L(0); PG8_BAR; PG8_MMA(0, 0, At, B0); PG8_MMA(0, 1, At, B1); PG8_BAR; PG8_SCHED;
            PG8_LDA(At, 0, 1); PG8_STAGE(PG8_SB(0, 0), b2, voffB); PG8_STAGE(PG8_SB(0, 1), b2 + hstep, voffB); PG8_STAGE_A(PG8_SA(0, 0), 0, (last ? 0 : t + 2), last, a2);
            PG8_WAIT_V(8); PG8_WAIT_L(0); PG8_BAR; PG8_MMA(1, 0, At, B0); PG8_MMA(1, 1, At, B1); PG8_BAR; PG8_SCHED;
            PG8_LDB(B0, 1, 0); PG8_LDB(B1, 1, 1); PG8_SCHED; PG8_LDA(At, 1, 0); PG8_STAGE_A(PG8_SA(0, 1), 1, (last ? 0 : t + 2), last, a2 + hstep);
            PG8_WAIT_V(8); PG8_WAIT_L(0); PG8_BAR; PG8_MMA(0, 0, At, B0); PG8_MMA(0, 1, At, B1); PG8_BAR; PG8_SCHED;
            PG8_LDA(At, 1, 1); PG8_STAGE(PG8_SB(1, 0), b3, voffB); PG8_STAGE(PG8_SB(1, 1), b3 + hstep, voffB); PG8_STAGE_A(PG8_SA(1, 0), 0, (last ? 1 : t + 3), last, a3);
            PG8_WAIT_V(8); PG8_WAIT_L(0); PG8_BAR; PG8_MMA(1, 0, At, B0); PG8_MMA(1, 1, At, B1); PG8_BAR; PG8_SCHED;
            } else {
            PG8_LDB(B0, 0, 0); PG8_SCHED; PG8_LDA(At, 0, 0); PG8_STAGE_A(PG8_SA(1, 1), 1, t + 1, false, a1 + hstep);
            PG8_WAIT_L(8); PG8_BAR; PG8_WAIT_L(0); PG8_MMA(0, 0, At, B0); PG8_BAR; PG8_SCHED;
            PG8_LDB(B1, 0, 1); PG8_STAGE(PG8_SB(0, 0), b2, voffB);
            PG8_BAR; PG8_WAIT_L(0); PG8_MMA(0, 1, At, B1); PG8_BAR;
            PG8_LDA(At, 0, 1); PG8_STAGE_A(PG8_SA(0, 0), 0, (last ? 0 : t + 2), last, a2);
            PG8_BAR; PG8_WAIT_L(0); PG8_MMA(1, 0, At, B0); PG8_BAR; PG8_SCHED;
            PG8_STAGE(PG8_SB(0, 1), b2 + hstep, voffB);
            PG8_WAIT_V(6); PG8_BAR; PG8_MMA(1, 1, At, B1); PG8_BAR;
            PG8_LDB(B0, 1, 0); PG8_SCHED; PG8_LDA(At, 1, 0); PG8_STAGE_A(PG8_SA(0, 1), 1, (last ? 0 : t + 2), last, a2 + hstep);
            PG8_WAIT_L(8); PG8_BAR; PG8_WAIT_L(0); PG8_MMA(0, 0, At, B0); PG8_BAR; PG8_SCHED;
            PG8_LDB(B1, 1, 1); PG8_STAGE(PG8_SB(1, 0), b3, voffB);
            PG8_BAR; PG8_WAIT_L(0); PG8_MMA(0, 1, At, B1); PG8_BAR;
            PG8_LDA(At, 1, 1); PG8_STAGE_A(PG8_SA(1, 0), 0, (last ? 1 : t + 3), last, a3);
            PG8_BAR; PG8_WAIT_L(0); PG8_MMA(1, 0, At, B0); PG8_BAR; PG8_SCHED;
            PG8_STAGE(PG8_SB(1, 1), b3 + hstep, voffB);
            PG8_WAIT_V(6); PG8_BAR; PG8_MMA(1, 1, At, B1); PG8_BAR;
            }
        }
        if constexpr (ALIGN_EPI) { if (wr == 0) PG8_BAR; }
        if constexpr (!Epi::AFTER_DRAIN) { E(acc, cur, wr, wc, fr, fq); S.done(cur); }
        if (!has_next) break;
#pragma unroll
        for (int a = 0; a < 2; ++a)
#pragma unroll
            for (int b = 0; b < 2; ++b)
#pragma unroll
                for (int m = 0; m < 4; ++m)
#pragma unroll
                    for (int n = 0; n < 2; ++n) acc[a][b][m][n] = (f32x4){0.f, 0.f, 0.f, 0.f};
        cur = nxt; cA = nA; cB = nB; ++ui;
        if constexpr (GATHER) {
#pragma unroll
            for (int hh = 0; hh < 2; ++hh) { voffC[hh][0] = voffN[hh][0]; voffC[hh][1] = voffN[hh][1]; } }
        if constexpr (ALIGN_EPI) { if (wr == 1) PG8_BAR; }
    }
    PG8_WAIT_V(0);
    if constexpr (!ALIGN_EPI) { if (wr == 0) PG8_BAR; }
    PG8_BAR;
    if constexpr (Epi::AFTER_DRAIN) { E.fused(acc, cur, wr, wc, fr, fq, lds, wid, lane); S.done(cur); }
#undef PG8_SA
#undef PG8_SB
#undef PG8_STAGE
#undef PG8_STAGE_A
#undef PG8_LDA
#undef PG8_LDB
#undef PG8_MMA
#undef PG8_WAIT_V
#undef PG8_WAIT_L
#undef PG8_BAR
#undef PG8_SCHED
}
}

struct EpiStoreBf16 {
    static constexpr bool PERM = true, AFTER_DRAIN = false;
    bf16_t* O; long ldo; int gate_from; long estride;
    __device__ __forceinline__ void operator()(const pg8::f32x4 (&acc)[2][2][4][2], const pg8::Unit& u, int wr, int wc, int fr, int fq) const {
        bf16_t* base = O + (long)u.e * estride;
#pragma unroll
        for (int ai = 0; ai < 2; ++ai)
#pragma unroll
            for (int m = 0; m < 4; ++m) {
                const long row = (long)u.pm * 256 + ai * 128 + wr * 64 + m * 16 + fr;
#pragma unroll
                for (int bj = 0; bj < 2; ++bj) {
                    pg8::f32x4 v0 = acc[ai][bj][m][0], v1 = acc[ai][bj][m][1];
                    if (u.pn * 2 + bj >= gate_from) {
#pragma unroll
                        for (int j = 0; j < 4; ++j) { v0[j] = sigm_fast(v0[j]); v1[j] = sigm_fast(v1[j]); }
                    }
                    u32x4 wv; wv[0] = pk_bf16(v0[0], v0[1]); wv[1] = pk_bf16(v0[2], v0[3]); wv[2] = pk_bf16(v1[0], v1[1]); wv[3] = pk_bf16(v1[2], v1[3]);
                    *(u32x4*)(base + row * ldo + u.pn * 256 + bj * 128 + wc * 32 + 8 * fq) = wv;
                }
            }
    }
};
struct EpiStoreF32 {
    static constexpr bool PERM = false, AFTER_DRAIN = false;
    float* O; long ldo;
    __device__ __forceinline__ void operator()(const pg8::f32x4 (&acc)[2][2][4][2], const pg8::Unit& u, int wr, int wc, int fr, int fq) const {
#pragma unroll
        for (int ai = 0; ai < 2; ++ai)
#pragma unroll
            for (int m = 0; m < 4; ++m) {
                const long row = (long)u.pm * 256 + ai * 128 + wr * 64 + m * 16 + fr;
#pragma unroll
                for (int bj = 0; bj < 2; ++bj)
#pragma unroll
                    for (int n = 0; n < 2; ++n) *(pg8::f32x4*)(O + row * ldo + u.pn * 256 + bj * 128 + wc * 32 + 16 * n + 4 * fq) = acc[ai][bj][m][n];
            }
    }
};
struct EpiMoeGU {
    static constexpr bool PERM = true, AFTER_DRAIN = false;
    bf16_t* HH;
    __device__ __forceinline__ void operator()(const pg8::f32x4 (&acc)[2][2][4][2], const pg8::Unit& u, int wr, int wc, int fr, int fq) const {
#pragma unroll
        for (int ai = 0; ai < 2; ++ai)
#pragma unroll
            for (int m = 0; m < 4; ++m) {
                const long row = (long)u.pm * 256 + ai * 128 + wr * 64 + m * 16 + fr;
                float hv[8];
#pragma unroll
                for (int n = 0; n < 2; ++n)
#pragma unroll
                    for (int j = 0; j < 4; ++j) { const float gt = acc[ai][0][m][n][j], up = acc[ai][1][m][n][j]; hv[4 * n + j] = gt * sigm_fast(gt) * up; }
                u32x4 wv; wv[0] = pk_bf16(hv[0], hv[1]); wv[1] = pk_bf16(hv[2], hv[3]); wv[2] = pk_bf16(hv[4], hv[5]); wv[3] = pk_bf16(hv[6], hv[7]);
                *(u32x4*)(HH + row * 512 + u.pn * 128 + wc * 32 + 8 * fq) = wv;
            }
    }
};
struct EpiMoeDown {
    static constexpr bool PERM = true, AFTER_DRAIN = false;
    const int* perm; const float* ew; bf16_t* YK;
    __device__ __forceinline__ void operator()(const pg8::f32x4 (&acc)[2][2][4][2], const pg8::Unit& u, int wr, int wc, int fr, int fq) const {
#pragma unroll
        for (int ai = 0; ai < 2; ++ai)
#pragma unroll
            for (int m = 0; m < 4; ++m) {
                const int a = perm[u.pm * 256 + ai * 128 + wr * 64 + m * 16 + fr];
                if (a >= 0) {
                    const float sw = ew[a];
#pragma unroll
                    for (int bj = 0; bj < 2; ++bj) {
                        const pg8::f32x4 v0 = acc[ai][bj][m][0] * sw, v1 = acc[ai][bj][m][1] * sw;
                        u32x4 wv; wv[0] = pk_bf16(v0[0], v0[1]); wv[1] = pk_bf16(v0[2], v0[3]); wv[2] = pk_bf16(v1[0], v1[1]); wv[3] = pk_bf16(v1[2], v1[3]);
                        *(u32x4*)(YK + (long)a * 1024 + u.pn * 256 + bj * 128 + wc * 32 + 8 * fq) = wv;
                    }
                }
            }
    }
};
struct GroupedOrder {
    int nM, nN, nE, G, c;
    __device__ bool next(int i, pg8::Unit& u) const { const int L = i * G + c; if (L >= nM * nN * nE) return false; u.e = L / (nM * nN); const int rm = L % (nM * nN); u.pm = rm / nN; u.pn = rm % nN; return true; }
    __device__ __forceinline__ void a_ready(const pg8::Unit&) const {}
    __device__ __forceinline__ void done(const pg8::Unit&) const {}
};

struct LayerW {
    const float *cmp_pos, *conv_w, *conv_b, *ga_b, *gx_b, *lam, *q_norm, *kv_norm,
        *ln1_g, *ln1_b, *ln2_g, *ln2_b, *rg_b, *re_b, *ln3_g, *ln3_b;
    const bf16_t *t_in, *t_br, *t_out, *t_q, *t_o, *t_gu, *t_dn, *t_c1, *t_c2, *t_uq, *t_ukv, *t_g, *t_rh, *t_rl;
};
#define WSF(off) ((float*)(p.ws + (off)))
#define WSI(off) ((int*)(p.ws + (off)))
#define WSU(off) ((unsigned*)(p.ws + (off)))
#define WSB(off) ((bf16_t*)(p.ws + (off)))
DI LayerW layer_w(const Params& p, int l) {
    LayerW w;
    w.cmp_pos = p.in[3] + (size_t)l * 2 * 32 * 64;
    w.conv_w = p.in[6] + (size_t)l * 4 * 256;
    w.conv_b = p.in[7] + (size_t)l * 256;
    w.ga_b = p.in[9] + (size_t)l * 256;
    w.gx_b = p.in[11] + (size_t)l * 256;
    w.lam = p.in[12] + (size_t)l * 256;
    w.q_norm = p.in[13] + (size_t)l * 192;
    w.kv_norm = p.in[14] + (size_t)l * 128;
    w.ln1_g = p.in[19] + (size_t)l * 1024; w.ln1_b = p.in[20] + (size_t)l * 1024;
    w.ln2_g = p.in[24] + (size_t)l * 1024; w.ln2_b = p.in[25] + (size_t)l * 1024;
    w.rg_b = p.in[27] + (size_t)l * 4;
    w.re_b = p.in[29] + (size_t)l * 32;
    w.ln3_g = p.in[32] + (size_t)l * 1024; w.ln3_b = p.in[33] + (size_t)l * 1024;
    w.t_in = WSB(WT_IN) + (size_t)l * NH * 1024;
    w.t_br = WSB(WT_BR) + (size_t)l * 1024 * 1024;
    w.t_out = WSB(WT_OUT) + (size_t)l * 1024 * 1024;
    w.t_q = WSB(WT_Q) + (size_t)l * 512 * 1024;
    w.t_o = WSB(WT_O) + (size_t)l * 1024 * 512;
    w.t_gu = WSB(WT_GU) + (size_t)l * 32 * 1024 * 1024;
    w.t_dn = WSB(WT_DN) + (size_t)l * 32 * 1024 * 512;
    w.t_c1 = WSB(WT_C1) + (size_t)l * 2 * 256 * 2048;
    w.t_c2 = WSB(WT_C2) + (size_t)l * 2 * 128 * 256;
    w.t_uq = WSB(WT_UQ) + (size_t)l * 384 * 192;
    w.t_ukv = WSB(WT_UKV) + (size_t)l * 512 * 128;
    w.t_g = WSB(WT_G) + (size_t)l * 4 * 128 * 64;
    w.t_rh = WSB(WT_RH) + (size_t)l * 128 * 1024;
    w.t_rl = WSB(WT_RL) + (size_t)l * 128 * 1024;
    return w;
}

template <int MODE>
DI int wt_col(int np, int Nsrc) {
    if (MODE == 0) return np < Nsrc ? np : -1;
    if (MODE == 2) return np < 1024 ? np : (np < 2656 ? np + 12 : (np < 2668 ? 1024 + (np - 2656) : (np < 2688 ? -1 : (np < 6784 ? np - 20 : -1))));
    const int pn = np >> 8, bj = (np >> 7) & 1, q = np & 127; return (bj ? 512 : 0) + 128 * pn + q;
}
template <int MODE>
DI void job_wt(const float* src, int nmat, int K, int Nsrc, bf16_t* dst, int Npad, int bid, int nblk, unsigned char* lds) {
    const int lane = tidx() & 63, wid = tidx() >> 6;
    bf16_t* tile = (bf16_t*)lds + wid * (64 * 72);
    const int tk = K / 64, tn = Npad / 64;
    const int tk2 = (tk + 1) / 2, tn4 = (tn + 3) / 4, per = tk2 * tn4;
    const int kl = lane >> 4, n4 = (lane & 15) * 4;
    for (int ub = bid; ub < nmat * per; ub += nblk) {
        const int mat = ub / per, ru = ub % per, kt = (ru % tk2) * 2 + (wid & 1), nt = (ru / tk2) * 4 + (wid >> 1);
        if (kt >= tk || nt >= tn) continue;
        const int k0 = kt * 64, n0 = nt * 64;
        const float* s = src + (size_t)mat * K * Nsrc;
        bf16_t* d = dst + (size_t)mat * Npad * K;
        const int col = wt_col<MODE>(n0 + n4, Nsrc);
        float4 v[16];
#pragma unroll
        for (int ps = 0; ps < 16; ++ps) v[ps] = col >= 0 ? *(const float4*)(s + (size_t)(k0 + kl + 4 * ps) * Nsrc + col) : make_float4(0.f, 0.f, 0.f, 0.f);
#pragma unroll
        for (int ps = 0; ps < 16; ++ps) { const int k = kl + 4 * ps;
            tile[(n4 + 0) * 72 + k] = f2bf(v[ps].x); tile[(n4 + 1) * 72 + k] = f2bf(v[ps].y); tile[(n4 + 2) * 72 + k] = f2bf(v[ps].z); tile[(n4 + 3) * 72 + k] = f2bf(v[ps].w); }
        __builtin_amdgcn_fence(__ATOMIC_RELEASE, "wavefront"); __builtin_amdgcn_wave_barrier(); __builtin_amdgcn_fence(__ATOMIC_ACQUIRE, "wavefront");
#pragma unroll
        for (int c8 = 0; c8 < 8; ++c8) { const int c = lane + 64 * c8, n2 = c >> 3, kc = (c & 7) * 8;
            *(uint4*)(d + (size_t)(n0 + n2) * K + k0 + kc) = *(const uint4*)(tile + n2 * 72 + kc); }
        __builtin_amdgcn_fence(__ATOMIC_RELEASE, "wavefront"); __builtin_amdgcn_wave_barrier(); __builtin_amdgcn_fence(__ATOMIC_ACQUIRE, "wavefront");
    }
}
DI void job_cvt(const float* src, bf16_t* dst, long n, int bid, int nblk) {
    for (long e = ((long)bid * NT + tidx()) * 4; e < n; e += (long)nblk * NT * 4) {
        const float4 v = *(const float4*)(src + e);
        st4bf(dst + e, v.x, v.y, v.z, v.w);
    }
}
DI void job_cmp_gather(const Params& p, const LayerW& w, int bid, int nblk) {
    const bf16_t* H = WSB(WS_H); bf16_t* TB = WSB(WS_TBB);
    const long total = (long)2 * NCR * 2048 / 8;
    for (long e = (long)bid * NT + tidx(); e < total; e += (long)nblk * NT) {
        const long e8 = e * 8;
        const int f = (int)(e8 % 2048); const long r2 = e8 / 2048; const int r = (int)(r2 % NCR), j = (int)(r2 / NCR);
        const int g = r & 1, bc = r >> 1, c = bc % NCMP, b = bc / NCMP, i = f >> 6, d = f & 63;
        float hv[8];
        ld8f(H + (long)(b * SEQ + 16 * c + i) * NH + (j ? O_AVC : O_AKC) + g * 64 + d, hv);
        const float4 p0 = *(const float4*)(w.cmp_pos + (j * 32 + i) * 64 + d), p1 = *(const float4*)(w.cmp_pos + (j * 32 + i) * 64 + d + 4);
        hv[0] += p0.x; hv[1] += p0.y; hv[2] += p0.z; hv[3] += p0.w; hv[4] += p1.x; hv[5] += p1.y; hv[6] += p1.z; hv[7] += p1.w;
        st8bf(TB + ((long)j * 2048 + r) * 2048 + f, hv);
    }
}
DI void job_rnn_conv(const Params& p, const LayerW& w, int bid, int nblk) {
    const bf16_t* H = WSB(WS_H); float* U = WSF(WS_U); bf16_t* UB = WSB(WS_UB);
    for (long e = (long)bid * NT + tidx(); e < (long)T * 64; e += (long)nblk * NT) {
        const int ch = (int)(e & 63) * 4; const int t = (int)(e >> 6), s = t & (SEQ - 1);
        const float4 cb = *(const float4*)(w.conv_b + ch);
        float u0 = cb.x, u1 = cb.y, u2 = cb.z, u3 = cb.w;
#pragma unroll
        for (int tap = 0; tap < 4; ++tap) { const int sp = s - 3 + tap;
            if (sp >= 0) { const float4 hv = ld4bf(H + (long)(t - 3 + tap) * NH + O_CX + ch); const float4 cw = *(const float4*)(w.conv_w + tap * 256 + ch);
                u0 += hv.x * cw.x; u1 += hv.y * cw.y; u2 += hv.z * cw.z; u3 += hv.w * cw.w; } }
        *(float4*)(U + (long)t * 256 + ch) = make_float4(u0, u1, u2, u3); st4bf(UB + (long)t * 256 + ch, u0, u1, u2, u3);
    }
}
DI void job_rnn_gates(const Params& p, const LayerW& w, int bid, int nblk, unsigned char* lds) {
    const float* U = WSF(WS_U); float* RA = WSF(WS_RA); float* RB = WSF(WS_RB);
    for (int u = bid; u < (T / G_BM) * 4; u += nblk) {
        const int blk = u & 3, m0 = (u >> 2) * G_BM;
        MG g; g.A = WSB(WS_UB) + blk * 64; g.lda = 256; g.Wt = w.t_g + (size_t)blk * 128 * 64; g.ldw = 64; g.K = 64;
        f32x16 acc[2][2];
        mgemm_tile(g, 0, RowId{m0}, acc, lds);
        const int l = tidx() & 63, wv = tidx() >> 6, wm = wv % G_WM, wn = wv / G_WM;
#pragma unroll
        for (int tt = 0; tt < 2; ++tt)
#pragma unroll
            for (int i = 0; i < 4; ++i) {
                const long t = m0 + wm * 64 + tt * 32 + (l & 31); const int ch = blk * 64 + wn * 32 + 8 * i + 4 * (l >> 5);
                const float4 uv = *(const float4*)(U + t * 256 + ch);
                const float ua[4] = {uv.x, uv.y, uv.z, uv.w};
                float av[4], bv[4];
#pragma unroll
                for (int j = 0; j < 4; ++j) {
                    const float r = sigm_fast(acc[0][tt][4 * i + j] + w.ga_b[ch + j]), ig = sigm_fast(acc[1][tt][4 * i + j] + w.gx_b[ch + j]);
                    const float nl = -w.lam[ch + j];
                    const float sp = fmaxf(nl, 0.f) + __logf(1.f + __expf(-fabsf(nl)));
                    const float log_a = -8.0f * r * sp;
                    const float a = __expf(log_a);
                    av[j] = a; bv[j] = __builtin_amdgcn_sqrtf(fmaxf(1.f - a * a, 0.f)) * (ig * ua[j]);
                }
                *(float4*)(RA + t * 256 + ch) = make_float4(av[0], av[1], av[2], av[3]);
                *(float4*)(RB + t * 256 + ch) = make_float4(bv[0], bv[1], bv[2], bv[3]);
            }
    }
}
DI void job_rnn_scan1(const Params& p, int bid, int nblk) {
    const float* RA = WSF(WS_RA); const float* RB = WSF(WS_RB); float* SA = WSF(WS_SA); float* SH = WSF(WS_SH);
    for (int e = bid * NT + tidx(); e < BATCH * 32 * 256; e += nblk * NT) {
        const int ch = e & 255, bc = e >> 8;
        float ap = 1.f, hl = 0.f;
        for (int s0 = 0; s0 < 64; s0 += 8) {
            float av[8], bv[8];
#pragma unroll
            for (int i = 0; i < 8; ++i) { const long t = (long)bc * 64 + s0 + i; av[i] = RA[t * 256 + ch]; bv[i] = RB[t * 256 + ch]; }
#pragma unroll
            for (int i = 0; i < 8; ++i) { ap *= av[i]; hl = av[i] * hl + bv[i]; }
        }
        SA[e] = ap; SH[e] = hl;
    }
}
DI void job_rnn_scan2(const Params& p, int bid, int nblk) {
    const bf16_t* H = WSB(WS_H); const float* RA = WSF(WS_RA); const float* RB = WSF(WS_RB); const float* SA = WSF(WS_SA); const float* SH = WSF(WS_SH); bf16_t* BR = WSB(WS_BR);
    for (int e = bid * NT + tidx(); e < BATCH * 32 * 256; e += nblk * NT) {
        const int ch = e & 255, bc = e >> 8, chunk = bc & 31, b = bc >> 5;
        float h = 0.f;
#pragma unroll
        for (int c0 = 0; c0 < 32; c0 += 8) {
            float sa[8], sh[8];
#pragma unroll
            for (int i = 0; i < 8; ++i) { const int q = ((b * 32 + c0 + i) << 8) + ch; sa[i] = SA[q]; sh[i] = SH[q]; }
#pragma unroll
            for (int i = 0; i < 8; ++i) h = (c0 + i < chunk) ? sa[i] * h + sh[i] : h;
        }
        for (int s0 = 0; s0 < 64; s0 += 8) {
            float av[8], bv[8], gv[8];
#pragma unroll
            for (int i = 0; i < 8; ++i) { const long t = (long)bc * 64 + s0 + i; av[i] = RA[t * 256 + ch]; bv[i] = RB[t * 256 + ch]; gv[i] = bf2f(H[t * NH + O_CG + ch]); }
#pragma unroll
            for (int i = 0; i < 8; ++i) { const long t = (long)bc * 64 + s0 + i; h = av[i] * h + bv[i]; BR[t * 1024 + 2 * 256 + ch] = f2bf(h * gelu_tanh(gv[i])); }
        }
    }
}
DI void job_mla_norm(const Params& p, const LayerW& w, int bid, int nblk) {
    const bf16_t* H = WSB(WS_H); bf16_t* CQN = WSB(WS_CQNB); bf16_t* CKVN = WSB(WS_CKVNB); bf16_t* KM = WSB(WS_KM);
    const int lane = tidx() & 63, wid = tidx() >> 6;
    const bool isq = lane < 24, iskv = lane >= 32 && lane < 48;
    const int coff = isq ? O_DCQ + lane * 8 : O_DCKV + (lane - 32) * 8;
    float gn[8];
#pragma unroll
    for (int j = 0; j < 8; ++j) gn[j] = isq ? w.q_norm[lane * 8 + j] : (iskv ? w.kv_norm[(lane - 32) * 8 + j] : 0.f);
    for (int t = bid * (NT / 64) + wid; t < T; t += nblk * (NT / 64)) {
        const bf16_t* hr = H + (long)t * NH;
        float v[8];
        float ss = 0.f;
        if (isq || iskv) { ld8f(hr + coff, v);
#pragma unroll
            for (int j = 0; j < 8; ++j) ss += v[j] * v[j]; }
        const float sq = wave_sum(isq ? ss : 0.f), skv = wave_sum(iskv ? ss : 0.f);
        const float rs = isq ? rsqrtf(sq * (1.f / 192.f) + 1e-6f) : rsqrtf(skv * (1.f / 128.f) + 1e-6f);
        if (isq || iskv) {
#pragma unroll
            for (int j = 0; j < 8; ++j) v[j] = v[j] * rs * gn[j];
            if (isq) st8bf(CQN + (long)t * 192 + lane * 8, v); else st8bf(CKVN + (long)t * 128 + (lane - 32) * 8, v);
        }
        {
            const int i = lane & 15, hd = lane >> 4;
            const int s = t & (SEQ - 1);
            const float2 csn = *(const float2*)(WSF(WS_ROPE) + (s * 16 + i) * 2); const float cs = csn.x, sn = csn.y;
            const float x1 = bf2f(hr[O_DKR + i]), x2 = bf2f(hr[O_DKR + 16 + i]);
            KM[(long)t * 384 + hd * 96 + 64 + i] = f2bf(x1 * cs - x2 * sn);
            KM[(long)t * 384 + hd * 96 + 80 + i] = f2bf(x1 * sn + x2 * cs);
        }
    }
}
DI void job_mla_up(const Params& p, const LayerW& w, int bid, int nblk, unsigned char* lds) {
    bf16_t* QB = WSB(WS_QB); bf16_t* KM = WSB(WS_KM); bf16_t* VM = WSB(WS_VM);
    constexpr int TM = T / G_BM;
    for (int u = bid; u < TM * 7; u += nblk) {
        const int mt = u / 7, nt = u % 7, m0 = mt * G_BM;
        f32x16 acc[2][2];
        const int l = tidx() & 63, wv = tidx() >> 6, wm = wv % G_WM, wn = wv / G_WM, hh = l >> 5;
        if (nt < 3) {
            MG g; g.A = WSB(WS_CQNB); g.lda = 192; g.Wt = w.t_uq; g.ldw = 192; g.K = 192;
            const int n0 = nt * 128;
            mgemm_tile(g, n0, RowId{m0}, acc, lds);
#pragma unroll
            for (int ft = 0; ft < 2; ++ft) {
                const int fb = (n0 + wn * 64 + ft * 32) >> 5;
                if (fb % 3 == 2) {
#pragma unroll
                    for (int tt = 0; tt < 2; ++tt) {
                        const int pos = (m0 + wm * 64 + tt * 32 + (l & 31)) & (SEQ - 1);
#pragma unroll
                        for (int i = 0; i < 2; ++i)
#pragma unroll
                            for (int j = 0; j < 4; ++j) {
                                const int fi = 8 * i + 4 * hh + j;
                                const float2 csn = *(const float2*)(WSF(WS_ROPE) + (pos * 16 + fi) * 2); const float cs = csn.x, sn = csn.y;
                                const float x1 = acc[ft][tt][4 * i + j], x2 = acc[ft][tt][4 * (i + 2) + j];
                                acc[ft][tt][4 * i + j] = x1 * cs - x2 * sn; acc[ft][tt][4 * (i + 2) + j] = x1 * sn + x2 * cs;
                            }
                    }
                }
            }
            MG_FOREACH(acc, lrow, feat, v, { st4bf(QB + (long)(m0 + lrow) * 384 + n0 + feat, v[0], v[1], v[2], v[3]); });
        } else {
            MG g; g.A = WSB(WS_CKVNB); g.lda = 128; g.Wt = w.t_ukv; g.ldw = 128; g.K = 128;
            const int n0 = (nt - 3) * 128;
            mgemm_tile(g, n0, RowId{m0}, acc, lds);
            MG_FOREACH(acc, lrow, feat, v, {
                const int hd = nt - 3;
                if (feat < 64) st4bf(KM + (long)(m0 + lrow) * 384 + hd * 96 + feat, v[0], v[1], v[2], v[3]);
                else st4bf(VM + (long)(m0 + lrow) * 256 + hd * 64 + (feat - 64), v[0], v[1], v[2], v[3]); });
        }
    }
}
template <int STAGE>
DI void job_cmp_mlp(const Params& p, const LayerW& w, int bid, int nblk, unsigned char* lds) {
    constexpr int TM = 2048 / G_BM, TN = STAGE == 0 ? 2 : 1;
    for (int u = bid; u < 2 * TM * TN; u += nblk) {
        const int j = u / (TM * TN), ru = u % (TM * TN), mt = ru / TN, nt = ru % TN, m0 = mt * G_BM, n0 = nt * 128;
        MG g;
        if (STAGE == 0) { g.A = WSB(WS_TBB) + (size_t)j * 2048 * 2048; g.lda = 2048; g.Wt = w.t_c1 + (size_t)j * 256 * 2048; g.ldw = 2048; g.K = 2048; }
        else { g.A = WSB(WS_HIDB) + (size_t)j * 2048 * 256; g.lda = 256; g.Wt = w.t_c2 + (size_t)j * 128 * 256; g.ldw = 256; g.K = 256; }
        f32x16 acc[2][2];
        mgemm_tile(g, n0, [&](int r) { const int rr = m0 + r; return (long)(rr < NCR ? rr : NCR - 1); }, acc, lds);
        if (STAGE == 0) {
            bf16_t* HID = WSB(WS_HIDB) + (size_t)j * 2048 * 256;
            MG_FOREACH(acc, lrow, feat, v, { st4bf(HID + (long)(m0 + lrow) * 256 + n0 + feat, gelu_tanh(v[0]), gelu_tanh(v[1]), gelu_tanh(v[2]), gelu_tanh(v[3])); });
        } else {
            bf16_t* KC = WSB(WS_KCB) + (size_t)j * NCR * 64;
            MG_FOREACH(acc, lrow, feat, v, { if (feat < 64 && m0 + lrow < NCR) st4bf(KC + (long)(m0 + lrow) * 64 + feat, v[0], v[1], v[2], v[3]); });
        }
    }
}
DI void job_router_logits(const Params& p, const LayerW& w, int bid, int nblk, unsigned char* lds) {
    float* LOG = WSF(WS_LOG);
    for (int u = bid; u < 3 * (T / G_BM); u += nblk) {
        const int pass = u / (T / G_BM), m0 = (u % (T / G_BM)) * G_BM;
        f32x16 acc[2][2];
        MG g; g.lda = 1024; g.ldw = 1024; g.K = 1024;
        g.A = pass == 1 ? WSB(WS_XBL) : WSB(WS_XBB); g.Wt = pass == 2 ? w.t_rl : w.t_rh;
        mgemm_tile(g, 0, RowId{m0}, acc, lds, true);
        float* dst = LOG + (size_t)pass * T * 36;
        MG_FOREACH(acc, lrow, feat, v, { if (feat < 36) *(float4*)(dst + (long)(m0 + lrow) * 36 + feat) = make_float4(v[0], v[1], v[2], v[3]); });
    }
}
DI void job_pack_small(const Params& p, int bid, int nblk) {
    bf16_t* TG = WSB(WT_G); bf16_t* RH = WSB(WT_RH); bf16_t* RL = WSB(WT_RL);
    for (int e = bid * NT + tidx(); e < SEQ * 16; e += nblk * NT) {
        const int i = e & 15, pos = e >> 4;
        const float inv = powf(10000.f, -(float)(2 * i) / 32.f);
        const float ang = (float)pos * inv;
        WSF(WS_ROPE)[e * 2] = cosf(ang); WSF(WS_ROPE)[e * 2 + 1] = sinf(ang);
    }
    for (int e = bid * NT + tidx(); e < DEPTH * 4 * 128 * 64; e += nblk * NT) {
        const int c = e & 63, q = (e >> 6) & 127, lb = e >> 13;
        const int seg = q >> 5, i = q & 31, chl = (seg >> 1) * 32 + i;
        const float* src = (seg & 1) ? p.in[10] : p.in[8];
        TG[e] = f2bf(src[((size_t)lb * 64 + c) * 64 + chl]);
    }
    for (int e = bid * NT + tidx(); e < DEPTH * 128 * 1024; e += nblk * NT) {
        const int k = e & 1023, n = (e >> 10) & 127, l = e >> 17;
        float v = 0.f;
        if (n < 4) v = p.in[26][((size_t)l * 1024 + k) * 4 + n];
        else if (n < 36) v = p.in[28][((size_t)l * 1024 + k) * 32 + (n - 4)];
        const bf16_t hi = f2bf(v);
        RH[e] = hi; RL[e] = f2bf(v - bf2f(hi));
    }
}

DI void job_merge(const Params& p, const LayerW& w, int bid, int nblk, unsigned char* lds) {
    const bf16_t* H = WSB(WS_H); bf16_t* M = WSB(WS_M);
    for (int u = bid; u < (T / G_BM) * 8; u += nblk) {
        const int m0 = (u >> 3) * G_BM, n0 = (u & 7) * G_BN;
        f32x16 macc[2][2];
#pragma unroll
        for (int a = 0; a < 2; ++a)
#pragma unroll
            for (int b = 0; b < 2; ++b)
#pragma unroll
                for (int i = 0; i < 16; ++i) macc[a][b][i] = 0.f;
        MG g; g.A = WSB(WS_BR); g.lda = 1024; g.Wt = w.t_br; g.ldw = 1024; g.K = 1024;
        f32x16 acc[2][2];
        const int l = tidx() & 63, wv = tidx() >> 6, wm = wv % G_WM, wn = wv / G_WM;
        mgemm_tile_f(g, n0, RowId{m0}, acc, lds, true, 4, [&](int n, f32x16 (&a)[2][2]) {
#pragma unroll
            for (int ft = 0; ft < 2; ++ft)
#pragma unroll
                for (int tt = 0; tt < 2; ++tt)
#pragma unroll
                    for (int i = 0; i < 4; ++i) {
                        const int lrow = wm * 64 + tt * 32 + (l & 31), feat = wn * 64 + ft * 32 + 8 * i + 4 * (l >> 5);
                        const float4 gv = ld4bf(H + (long)(m0 + lrow) * NH + O_MG + n * 1024 + n0 + feat);
                        macc[ft][tt][4 * i] += gv.x * a[ft][tt][4 * i]; macc[ft][tt][4 * i + 1] += gv.y * a[ft][tt][4 * i + 1];
                        macc[ft][tt][4 * i + 2] += gv.z * a[ft][tt][4 * i + 2]; macc[ft][tt][4 * i + 3] += gv.w * a[ft][tt][4 * i + 3];
                        a[ft][tt][4 * i] = 0.f; a[ft][tt][4 * i + 1] = 0.f; a[ft][tt][4 * i + 2] = 0.f; a[ft][tt][4 * i + 3] = 0.f;
                    }
        });
        MG_FOREACH(macc, lrow, feat, v, { st4bf(M + (long)(m0 + lrow) * 1024 + n0 + feat, v[0], v[1], v[2], v[3]); });
    }
}
DI void job_ln(const float* xin, const bf16_t* xinb, const bf16_t* xinl, const bf16_t* y, const int* rowof, const float* ew, const float* gw, const float* bw, float* out, bf16_t* outb, bf16_t* outl, int bid, int nblk) {
    const int lane = tidx() & 63, wid = tidx() >> 6;
    float gv[16], bv[16];
#pragma unroll
    for (int i = 0; i < 2; ++i)
#pragma unroll
        for (int j = 0; j < 8; j += 4) { const int c = i * 512 + lane * 8 + j; const float4 g4 = *(const float4*)(gw + c), b4 = *(const float4*)(bw + c);
            gv[i * 8 + j] = g4.x; gv[i * 8 + j + 1] = g4.y; gv[i * 8 + j + 2] = g4.z; gv[i * 8 + j + 3] = g4.w; bv[i * 8 + j] = b4.x; bv[i * 8 + j + 1] = b4.y; bv[i * 8 + j + 2] = b4.z; bv[i * 8 + j + 3] = b4.w; }
    for (int t = bid * (NT / 64) + wid; t < T; t += nblk * (NT / 64)) {
        float v[16];
        float s = 0.f;
        int r0 = 0, r1 = 0; float w0 = 0.f, w1 = 0.f;
        if (rowof) { r0 = rowof[t * 2]; r1 = rowof[t * 2 + 1]; w0 = ew[t * 2]; w1 = ew[t * 2 + 1]; }
#pragma unroll
        for (int i = 0; i < 2; ++i) {
            const int c = i * 512 + lane * 8;
            float xv[8], yv[8];
            if (xin) { const float4 a = *(const float4*)(xin + (long)t * 1024 + c), b = *(const float4*)(xin + (long)t * 1024 + c + 4);
                xv[0] = a.x; xv[1] = a.y; xv[2] = a.z; xv[3] = a.w; xv[4] = b.x; xv[5] = b.y; xv[6] = b.z; xv[7] = b.w; }
            else ld8f(xinb + (long)t * 1024 + c, xv);
            if (xinl) { float z[8]; ld8f(xinl + (long)t * 1024 + c, z);
#pragma unroll
                for (int j = 0; j < 8; ++j) xv[j] += z[j]; }
            if (!rowof) ld8f(y + (long)t * 1024 + c, yv);
            else { float z0[8], z1[8]; ld8f(y + (long)r0 * 1024 + c, z0); ld8f(y + (long)r1 * 1024 + c, z1);
#pragma unroll
                for (int j = 0; j < 8; ++j) yv[j] = w0 * z0[j] + w1 * z1[j]; }
#pragma unroll
            for (int j = 0; j < 8; ++j) { v[i * 8 + j] = DN_ALPHA * xv[j] + yv[j]; s += v[i * 8 + j]; }
        }
        float q = 0.f;
#pragma unroll
        for (int i = 0; i < 16; ++i) q += v[i] * v[i];
        wave_sum2(s, q);
        const float mu = s * (1.f / 1024.f);
        const float rstd = rsqrtf(fmaxf(q * (1.f / 1024.f) - mu * mu, 0.f) + 1e-5f);
#pragma unroll
        for (int i = 0; i < 2; ++i) {
            const int c = i * 512 + lane * 8;
            float o[8];
#pragma unroll
            for (int j = 0; j < 8; ++j) o[j] = (v[i * 8 + j] - mu) * rstd * gv[i * 8 + j] + bv[i * 8 + j];
            if (out) { *(float4*)(out + (long)t * 1024 + c) = make_float4(o[0], o[1], o[2], o[3]); *(float4*)(out + (long)t * 1024 + c + 4) = make_float4(o[4], o[5], o[6], o[7]); }
            if (outb) st8bf(outb + (long)t * 1024 + c, o);
            if (outl) { float lo[8];
#pragma unroll
                for (int j = 0; j < 8; ++j) lo[j] = o[j] - bf2f(f2bf(o[j]));
                st8bf(outl + (long)t * 1024 + c, lo); }
        }
    }
}
DI void job_router(const Params& p, const LayerW& w, int layer, int bid, int nblk) {
    const float* LOG = WSF(WS_LOG); int* EIDX = WSI(WS_EIDX); int* ESLOT = WSI(WS_ESLOT); float* EW = WSF(WS_EW);
    unsigned* cnt = WSU(WS_CTL) + CW_CNT + layer * 32;
    for (int t = bid * NT + tidx(); t < T; t += nblk * NT) {
        const float* lr = LOG + (long)t * 36; const float* lr1 = lr + (size_t)T * 36; const float* lr2 = lr1 + (size_t)T * 36;
#define LG(i) ((lr[i] + lr1[i]) + lr2[i])
        const float g0 = LG(0) + w.rg_b[0], g1 = LG(1) + w.rg_b[1], g2 = LG(2) + w.rg_b[2], g3 = LG(3) + w.rg_b[3];
        const float gm = fmaxf(fmaxf(g0, g1), fmaxf(g2, g3));
        const float e0 = expf(g0 - gm), e1 = expf(g1 - gm), e2 = expf(g2 - gm), e3 = expf(g3 - gm);
        const float gs = (e0 + e1) + (e2 + e3);
        const float p0 = e0 / gs, p1 = e1 / gs, p2 = e2 / gs, p3 = e3 / gs;
        int grp = 0; float pg = p0;
        if (p1 > pg) { pg = p1; grp = 1; }
        if (p2 > pg) { pg = p2; grp = 2; }
        if (p3 > pg) { pg = p3; grp = 3; }
        float el[8];
#pragma unroll
        for (int i = 0; i < 8; ++i) el[i] = LG(4 + grp * 8 + i) + w.re_b[grp * 8 + i];
#undef LG
        float em = el[0];
#pragma unroll
        for (int i = 1; i < 8; ++i) em = fmaxf(em, el[i]);
        float es = 0.f;
#pragma unroll
        for (int i = 0; i < 8; ++i) { el[i] = expf(el[i] - em); es += el[i]; }
#pragma unroll
        for (int i = 0; i < 8; ++i) el[i] = el[i] / es;
        float b0 = el[0]; int i0 = 0;
#pragma unroll
        for (int i = 1; i < 8; ++i) if (el[i] > b0) { b0 = el[i]; i0 = i; }
        float b1 = -1.f; int i1 = 0;
#pragma unroll
        for (int i = 0; i < 8; ++i) if (i != i0 && el[i] > b1) { b1 = el[i]; i1 = i; }
        const float den = b0 + b1;
        const int ex0 = grp * 8 + i0, ex1 = grp * 8 + i1;
        EIDX[t * 2] = ex0; EIDX[t * 2 + 1] = ex1;
        EW[t * 2] = pg * b0 / den; EW[t * 2 + 1] = pg * b1 / den;
        ESLOT[t * 2] = (int)atomicAdd(&cnt[ex0], 1u);
        ESLOT[t * 2 + 1] = (int)atomicAdd(&cnt[ex1], 1u);
    }
}
DI int pad_rows(int c) { return (c + G_BM - 1) / G_BM * G_BM; }
DI void job_fill(const Params& p, int layer, int bid, int nblk, unsigned char* lds) {
    const int* EIDX = WSI(WS_EIDX); const int* ESLOT = WSI(WS_ESLOT); int* PERM = WSI(WS_PERM);
    unsigned* cnt = WSU(WS_CTL) + CW_CNT + layer * 32;
    const int lane = tidx() & 63, wid = tidx() >> 6;
    int* s_off = (int*)lds; int* s_cnt = s_off + 32;
    __syncthreads();
    if (tidx() < 32) s_cnt[tidx()] = (int)__hip_atomic_load(&cnt[tidx()], __ATOMIC_RELAXED, __HIP_MEMORY_SCOPE_AGENT);
    __syncthreads();
    if (tidx() == 0) { int o = 0; for (int e = 0; e < 32; ++e) { s_off[e] = o; o += pad_rows(s_cnt[e]); } }
    __syncthreads();
    for (int a = bid * (NT / 64) + wid; a < NASSIGN + NEXP; a += nblk * (NT / 64)) {
        const bool real = a < NASSIGN;
        const int e = real ? EIDX[a] : a - NASSIGN;
        const int off = s_off[e];
        if (real) {
            const int R = off + ESLOT[a];
            if (lane == 0) { PERM[R] = a; WSI(WS_ROWOF)[a] = R; }
        } else {
            const int c = s_cnt[e];
            for (int j = lane; c + j < pad_rows(c); j += 64) PERM[off + c + j] = -1;
        }
    }
}
DI pg8::ListOrder moe_units(unsigned* cnt, int bid, int nblk) {
    pg8::ListOrder S; S.n = 0; S.u0 = S.u1 = S.u2 = pg8::Unit{0, 0, 0};
    int rt = 0, ub = 0;
    for (int e = 0; e < 32; ++e) {
        const int c = pad_rows((int)__hip_atomic_load(&cnt[e], __ATOMIC_RELAXED, __HIP_MEMORY_SCOPE_AGENT)) >> 8, ue = c * 4;
#pragma unroll
        for (int k = 0; k < 3; ++k) {
            const int L = bid + k * nblk;
            if (L >= ub && L < ub + ue) { const int lu = L - ub; const pg8::Unit u{rt + (lu >> 2), lu & 3, e};
                if (k == 0) S.u0 = u; else if (k == 1) S.u1 = u; else S.u2 = u;
                S.n = k + 1; }
        }
        rt += c; ub += ue;
    }
#define RFL(x) x = __builtin_amdgcn_readfirstlane(x)
    RFL(S.n); RFL(S.u0.pm); RFL(S.u0.pn); RFL(S.u0.e); RFL(S.u1.pm); RFL(S.u1.pn); RFL(S.u1.e); RFL(S.u2.pm); RFL(S.u2.pn); RFL(S.u2.e);
#undef RFL
    return S;
}
typedef short s16x4 __attribute__((ext_vector_type(4)));
typedef short v4i16_t __attribute__((ext_vector_type(4)));
DI unsigned cvtpk(float lo, float hi) { return pk_bf16(lo, hi); }
DI int crow(int reg, int h) { return (reg & 3) + 8 * (reg >> 2) + 4 * h; }
DI s16x4 tr_read(const unsigned char* p) { return __builtin_bit_cast(s16x4, __builtin_amdgcn_ds_read_tr16_b64_v4i16((LAS v4i16_t*)p)); }
DI float xhalf_max(float m) { auto rr = __builtin_amdgcn_permlane32_swap(__float_as_uint(m), __float_as_uint(m), false, false); return fmaxf(__uint_as_float(rr[0]), __uint_as_float(rr[1])); }
DI float xhalf_sum(float m) { auto rr = __builtin_amdgcn_permlane32_swap(__float_as_uint(m), __float_as_uint(m), false, false); return __uint_as_float(rr[0]) + __uint_as_float(rr[1]); }
DI float xhalf_other(float v, int h) { auto rr = __builtin_amdgcn_permlane32_swap(__float_as_uint(v), __float_as_uint(v), false, false); return __uint_as_float(h ? rr[0] : rr[1]); }
DI bf16x8 pack8(const f32x16& x, int s2) {
    u32x4 pk; pk[0] = cvtpk(x[8 * s2], x[8 * s2 + 1]); pk[1] = cvtpk(x[8 * s2 + 2], x[8 * s2 + 3]); pk[2] = cvtpk(x[8 * s2 + 4], x[8 * s2 + 5]); pk[3] = cvtpk(x[8 * s2 + 6], x[8 * s2 + 7]);
    return __builtin_bit_cast(bf16x8, pk);
}
constexpr int ATT_QB = (NT / 64) * 32;
template <int DC> struct TileCfg { static constexpr int RS = DC * 2 + 16, BYTES = 64 * RS, NCH = 64 * DC / 8, NI = (NCH + NT - 1) / NT; };
template <int DC, class RowPtr> DI void tile_gload(u32x4 (&rg)[TileCfg<DC>::NI], RowPtr rp) {
#pragma unroll
    for (int i = 0; i < TileCfg<DC>::NI; ++i) { const int c = tidx() + NT * i; if (c < TileCfg<DC>::NCH) { const int row = c / (DC / 8), cc = c % (DC / 8); rg[i] = *(const u32x4*)(rp(row) + cc * 8); } }
}
template <int DC> DI void tile_lstore(const u32x4 (&rg)[TileCfg<DC>::NI], unsigned char* base) {
#pragma unroll
    for (int i = 0; i < TileCfg<DC>::NI; ++i) { const int c = tidx() + NT * i; if (c < TileCfg<DC>::NCH) { const int row = c / (DC / 8), cc = c % (DC / 8); *(u32x4*)(base + row * TileCfg<DC>::RS + cc * 16) = rg[i]; } }
}
template <int DK> DI void qk_tile(f32x16 (&s)[2], const bf16x8 (&qf)[DK / 16], const unsigned char* kl, int r, int h) {
    constexpr int RS = TileCfg<DK>::RS;
#pragma unroll
    for (int i = 0; i < 16; ++i) { s[0][i] = 0.f; s[1][i] = 0.f; }
#pragma unroll
    for (int ks = 0; ks < DK / 16; ++ks) {
        const bf16x8 k0 = *(const bf16x8*)(kl + r * RS + ks * 32 + h * 16), k1 = *(const bf16x8*)(kl + (32 + r) * RS + ks * 32 + h * 16);
        s[0] = __builtin_amdgcn_mfma_f32_32x32x16_bf16(k0, qf[ks], s[0], 0, 0, 0);
        s[1] = __builtin_amdgcn_mfma_f32_32x32x16_bf16(k1, qf[ks], s[1], 0, 0, 0);
    }
}
template <int DV> DI void pv_tile(f32x16 (&o)[DV / 32], const f32x16 (&pp)[2], const unsigned char* vl, int lane) {
    constexpr int RS = TileCfg<DV>::RS;
    const int h = lane >> 5, i16 = lane & 15, q = i16 >> 2, pq = i16 & 3, blk = (lane >> 4) & 1;
    const unsigned char* vb = vl + (4 * h + q) * RS + 2 * (16 * blk + 4 * pq);
#pragma unroll
    for (int kt = 0; kt < 2; ++kt)
#pragma unroll
        for (int s2 = 0; s2 < 2; ++s2) {
            const bf16x8 pf = pack8(pp[kt], s2);
#pragma unroll
            for (int dvt = 0; dvt < DV / 32; ++dvt) {
                const s16x4 lo = tr_read(vb + (kt * 32 + 16 * s2) * RS + dvt * 64), hi = tr_read(vb + (kt * 32 + 16 * s2 + 8) * RS + dvt * 64);
                const bf16x8 vf = __builtin_shufflevector(lo, hi, 0, 1, 2, 3, 4, 5, 6, 7);
                o[dvt] = __builtin_amdgcn_mfma_f32_32x32x16_bf16(vf, pf, o[dvt], 0, 0, 0);
            }
        }
}
constexpr float LOG2E = 1.4426950408889634f;
template <int DK, int DV, bool ALIBI, bool BOUNDARY, class ValidFn>
DI void softmax_tile(const bf16x8 (&qf)[DK / 16], f32x16 (&o)[DV / 32], float& m, float& l, const unsigned char* kl, const unsigned char* vl, int kb,
                     float c1, float sl2, int qpos, ValidFn valid, int lane) {
    const int r = lane & 31, h = lane >> 5;
    f32x16 s[2];
    qk_tile<DK>(s, qf, kl, r, h);
    const float base = ALIBI ? sl2 * (float)(kb + 4 * h - qpos) : 0.f;
    float tmax = -INFINITY;
#pragma unroll
    for (int kt = 0; kt < 2; ++kt)
#pragma unroll
        for (int i = 0; i < 16; ++i) {
            float v = ALIBI ? fmaf(s[kt][i], c1, fmaf(sl2, (float)(kt * 32 + (i & 3) + 8 * (i >> 2)), base)) : s[kt][i] * c1;
            if (BOUNDARY) v = valid(kb + kt * 32 + crow(i, h)) ? v : -INFINITY;
            s[kt][i] = v; tmax = fmaxf(tmax, v);
        }
    tmax = xhalf_max(tmax);
    const float mn = fmaxf(m, tmax);
    if (__any(mn > m)) {
        const float corr = __builtin_amdgcn_exp2f(m - mn);
        l *= corr;
#pragma unroll
        for (int dvt = 0; dvt < DV / 32; ++dvt)
#pragma unroll
            for (int i = 0; i < 16; ++i) o[dvt][i] *= corr;
        m = mn;
    }
    float ps = 0.f;
#pragma unroll
    for (int kt = 0; kt < 2; ++kt)
#pragma unroll
        for (int i = 0; i < 16; ++i) { const float pr = __builtin_amdgcn_exp2f(s[kt][i] - mn); s[kt][i] = pr; ps += pr; }
    l += ps;
    pv_tile<DV>(o, s, vl, lane);
}
template <int DK, int DV, bool ALIBI, class KPtr, class VPtr, class ValidFn, class InteriorFn>
DI void attn_stream(const bf16x8 (&qf)[DK / 16], f32x16 (&o)[DV / 32], float& m, float& l, unsigned tmask, int wave_qmax, int wave_kmin,
                    KPtr kp, VPtr vp, float c1, float sl2, int qpos, ValidFn valid, InteriorFn interior, unsigned char* lds) {
    unsigned char* kl = lds; unsigned char* vl = lds + TileCfg<DK>::BYTES;
    const int lane = tidx() & 63;
    u32x4 kA[TileCfg<DK>::NI], vA[TileCfg<DV>::NI], kB[TileCfg<DK>::NI], vB[TileCfg<DV>::NI];
    int ja = -1, jb = -1;
#define AS_NEXT(J, KR, VR) do { if (tmask) { J = __builtin_ctz(tmask); tmask &= tmask - 1; const int _j = J; \
        tile_gload<DK>(KR, [&](int row) { return kp(_j * 64 + row); }); tile_gload<DV>(VR, [&](int row) { return vp(_j * 64 + row); }); } else J = -1; } while (0)
#define AS_COMPUTE(J) do { const int _jc = (J); if (_jc * 64 <= wave_qmax && _jc * 64 + 63 >= wave_kmin) { \
        if (interior(_jc)) softmax_tile<DK, DV, ALIBI, false>(qf, o, m, l, kl, vl, _jc * 64, c1, sl2, qpos, valid, lane); \
        else softmax_tile<DK, DV, ALIBI, true>(qf, o, m, l, kl, vl, _jc * 64, c1, sl2, qpos, valid, lane); } } while (0)
    AS_NEXT(ja, kA, vA);
    AS_NEXT(jb, kB, vB);
    while (ja >= 0) {
        __syncthreads();
        tile_lstore<DK>(kA, kl); tile_lstore<DV>(vA, vl);
        __syncthreads();
        const int jc = ja;
        AS_NEXT(ja, kA, vA);
        AS_COMPUTE(jc);
        if (jb < 0) break;
        __syncthreads();
        tile_lstore<DK>(kB, kl); tile_lstore<DV>(vB, vl);
        __syncthreads();
        const int jd = jb;
        AS_NEXT(jb, kB, vB);
        AS_COMPUTE(jd);
    }
#undef AS_NEXT
#undef AS_COMPUTE
}

DI void job_mla_attn(const Params& p, int bid, int nblk, unsigned char* lds) {
    const bf16_t* QB = WSB(WS_QB); const bf16_t* KM = WSB(WS_KM); const bf16_t* VM = WSB(WS_VM); bf16_t* BR = WSB(WS_BR);
    constexpr int NQB = SEQ / ATT_QB, NU = BATCH * 4 * NQB;
    const int lane = tidx() & 63, wid = tidx() >> 6, r = lane & 31, h = lane >> 5;
    for (int u = bid; u < NU; u += nblk) {
        const int qblk = u / (BATCH * 4), bh = u % (BATCH * 4);
        const int b = bh >> 2, hd = bh & 3;
        const int q0 = qblk * ATT_QB, qw = q0 + wid * 32, qpos = qw + r;
        const long trow = (long)b * SEQ;
        bf16x8 qf[6];
#pragma unroll
        for (int ks = 0; ks < 6; ++ks) qf[ks] = *(const bf16x8*)(QB + (trow + qpos) * 384 + hd * 96 + ks * 16 + 8 * h);
        f32x16 o[2];
#pragma unroll
        for (int i = 0; i < 16; ++i) { o[0][i] = 0.f; o[1][i] = 0.f; }
        float m = -1e30f, l = 0.f;
        const int ntile = (q0 + ATT_QB - 1) / 64 + 1;
        const unsigned tmask = ntile >= 32 ? 0xffffffffu : ((1u << ntile) - 1u);
        attn_stream<96, 64, false>(qf, o, m, l, tmask, qw + 31, 0,
            [&](int row) { return KM + (trow + row) * 384 + hd * 96; },
            [&](int row) { return VM + (trow + row) * 256 + hd * 64; },
            0.10206207261596577f * LOG2E, 0.f, qpos,
            [&](int key) { return key <= qpos; }, [&](int j) { return j * 64 + 63 <= qw; }, lds);
        const float rl = 1.f / fmaxf(xhalf_sum(l), 1e-30f);
        bf16_t* dst = BR + (trow + qpos) * 1024 + 3 * 256 + hd * 64;
#pragma unroll
        for (int dvt = 0; dvt < 2; ++dvt)
#pragma unroll
            for (int i = 0; i < 4; ++i)
                st4bf(dst + dvt * 32 + 8 * i + 4 * h, o[dvt][4 * i] * rl, o[dvt][4 * i + 1] * rl, o[dvt][4 * i + 2] * rl, o[dvt][4 * i + 3] * rl);
    }
}
DI void job_cross_attn(const Params& p, int layer, int bid, int nblk, unsigned char* lds) {
    const bf16_t* XQ = WSB(WS_XQ); const bf16_t* KVM = WSB(WS_KVM) + (size_t)layer * 2048 * 1024; bf16_t* XO = WSB(WS_XO);
    constexpr int NQB = SEQ / ATT_QB, NU = BATCH * 4 * NQB;
    const int lane = tidx() & 63, wid = tidx() >> 6, r = lane & 31, h = lane >> 5;
    for (int u = bid; u < NU; u += nblk) {
        const int bh = u % (BATCH * 4), qblk = u / (BATCH * 4);
        const int b = bh >> 2, hd = bh & 3;
        const int qpos = qblk * ATT_QB + wid * 32 + r;
        const long trow = (long)b * SEQ;
        bf16x8 qf[8];
#pragma unroll
        for (int ks = 0; ks < 8; ++ks) qf[ks] = *(const bf16x8*)(XQ + (trow + qpos) * 512 + hd * 128 + ks * 16 + 8 * h);
        f32x16 o[4];
#pragma unroll
        for (int d = 0; d < 4; ++d)
#pragma unroll
            for (int i = 0; i < 16; ++i) o[d][i] = 0.f;
        float m = -1e30f, l = 0.f;
        attn_stream<128, 128, false>(qf, o, m, l, 0xFu, 1 << 30, 0,
            [&](int row) { return KVM + (long)(b * MEM_LEN + row) * 1024 + hd * 128; },
            [&](int row) { return KVM + (long)(b * MEM_LEN + row) * 1024 + 512 + hd * 128; },
            0.08838834764831845f * LOG2E, 0.f, qpos, [&](int) { return true; }, [&](int) { return true; }, lds);
        const float rl = 1.f / fmaxf(xhalf_sum(l), 1e-30f);
        bf16_t* dst = XO + (trow + qpos) * 512 + hd * 128;
#pragma unroll
        for (int dvt = 0; dvt < 4; ++dvt)
#pragma unroll
            for (int i = 0; i < 4; ++i)
                st4bf(dst + dvt * 32 + 8 * i + 4 * h, o[dvt][4 * i] * rl, o[dvt][4 * i + 1] * rl, o[dvt][4 * i + 2] * rl, o[dvt][4 * i + 3] * rl);
    }
}
DI float logsig_fast(float z) { return fminf(z, 0.f) - __logf(1.f + __expf(-fabsf(z))); }
DI void job_sb_attn(const Params& p, int bid, int nblk, unsigned char* lds) {
    const bf16_t* H = WSB(WS_H); bf16_t* BR = WSB(WS_BR);
    constexpr int NQB = SEQ / ATT_QB, NU = BATCH * 4 * NQB;
    const int lane = tidx() & 63, wid = tidx() >> 6, r = lane & 31, h = lane >> 5;
    unsigned char* kl = lds; unsigned char* vl = lds + TileCfg<64>::BYTES;
    for (int u = bid; u < NU; u += nblk) {
        const int half = u / (NU / 2), ru = u % (NU / 2);
        const int qi = ru / (BATCH * 4), bh = ru % (BATCH * 4);
        const int qblk = half == 0 ? (NQB - 1 - qi) : qi;
        const int b = bh >> 2, hd = bh & 3;
        const int q0 = qblk * ATT_QB, qw = q0 + wid * 32, qpos = qw + r;
        const long trow = (long)b * SEQ;
        bf16x8 qf[4];
#pragma unroll
        for (int ks = 0; ks < 4; ++ks) qf[ks] = *(const bf16x8*)(H + (trow + qpos) * NH + O_BQ + hd * 64 + ks * 16 + 8 * h);
        f32x16 o[2];
#pragma unroll
        for (int i = 0; i < 16; ++i) { o[0][i] = 0.f; o[1][i] = 0.f; }
        float trun = 0.f;
        int j = (q0 + ATT_QB - 1) >> 6;
        volatile int* flag = (volatile int*)(lds + 2 * TileCfg<64>::BYTES);
        if (tidx() == 0) { flag[0] = 0; flag[1] = 0; }
        u32x4 kr[TileCfg<64>::NI], vr[TileCfg<64>::NI];
        tile_gload<64>(kr, [&](int row) { return H + (trow + j * 64 + row) * NH + O_BK + hd * 64; });
        tile_gload<64>(vr, [&](int row) { return H + (trow + j * 64 + row) * NH + O_BV + hd * 64; });
        for (int it = 0; j >= 0; --j, ++it) {
            __syncthreads();
            if (it > 0 && flag[(it - 1) & 1] == 0) break;
            tile_lstore<64>(kr, kl); tile_lstore<64>(vr, vl);
            __syncthreads();
            if (tidx() == 0) flag[(it + 1) & 1] = 0;
            if (j > 0) { const int jn = j - 1;
                tile_gload<64>(kr, [&](int row) { return H + (trow + jn * 64 + row) * NH + O_BK + hd * 64; });
                tile_gload<64>(vr, [&](int row) { return H + (trow + jn * 64 + row) * NH + O_BV + hd * 64; }); }
            const bool wave_dead = __all(trun < -110.f);
            if (j * 64 < qw + 31 && !wave_dead) {
                const int kb = j * 64;
                f32x16 s[2], L[2];
                qk_tile<64>(s, qf, kl, r, h);
#pragma unroll
                for (int kt = 0; kt < 2; ++kt)
#pragma unroll
                    for (int i = 0; i < 16; ++i) {
                        const int key = kb + kt * 32 + crow(i, h);
                        const float z = s[kt][i] * 0.125f, lsp = logsig_fast(z);
                        const bool valid = key < qpos;
                        L[kt][i] = valid ? lsp - z : 0.f;
                        s[kt][i] = valid ? lsp : -INFINITY;
                    }
                float G[2][4], O[2][4];
#pragma unroll
                for (int kt = 0; kt < 2; ++kt)
#pragma unroll
                    for (int ig = 0; ig < 4; ++ig) { G[kt][ig] = (L[kt][4 * ig] + L[kt][4 * ig + 1]) + (L[kt][4 * ig + 2] + L[kt][4 * ig + 3]); O[kt][ig] = xhalf_other(G[kt][ig], h); }
                float run = trun;
#pragma unroll
                for (int kt = 1; kt >= 0; --kt)
#pragma unroll
                    for (int ig = 3; ig >= 0; --ig) {
                        const float t3 = run + (h == 0 ? O[kt][ig] : 0.f);
                        const float t2 = t3 + L[kt][4 * ig + 3], t1 = t2 + L[kt][4 * ig + 2], t0 = t1 + L[kt][4 * ig + 1];
                        s[kt][4 * ig + 3] = __expf(s[kt][4 * ig + 3] + t3); s[kt][4 * ig + 2] = __expf(s[kt][4 * ig + 2] + t2);
                        s[kt][4 * ig + 1] = __expf(s[kt][4 * ig + 1] + t1); s[kt][4 * ig + 0] = __expf(s[kt][4 * ig + 0] + t0);
                        run += G[kt][ig] + O[kt][ig];
                    }
                trun = run;
                pv_tile<64>(o, s, vl, lane);
            }
            if (!__all(trun < -110.f)) flag[it & 1] = 1;
        }
        bf16_t* dst = BR + (trow + qpos) * 1024 + 1 * 256 + hd * 64;
#pragma unroll
        for (int dvt = 0; dvt < 2; ++dvt)
#pragma unroll
            for (int i = 0; i < 4; ++i) st4bf(dst + dvt * 32 + 8 * i + 4 * h, o[dvt][4 * i], o[dvt][4 * i + 1], o[dvt][4 * i + 2], o[dvt][4 * i + 3]);
    }
}
constexpr int NSA_QB = (NT / 128) * 32;
DI void job_nsa(const Params& p, int bid, int nblk, unsigned char* lds) {
    const bf16_t* H = WSB(WS_H); const bf16_t* KCB = WSB(WS_KCB); const bf16_t* VCB = KCB + (size_t)NCR * 64;
    float* OACC = WSF(WS_OC); bf16_t* BR = WSB(WS_BR);
    constexpr int NQB = SEQ / NSA_QB, NU = BATCH * 2 * NQB;
    constexpr int TB_ = TileCfg<64>::BYTES;
    const int lane = tidx() & 63, wid = tidx() >> 6, r = lane & 31, h = lane >> 5;
    const int n = wid & 1, sub = wid >> 1;
    unsigned* orw = (unsigned*)(lds + 4 * TB_);
    float* impx = (float*)(lds + 4 * TB_ + 64);
    for (int u = bid; u < NU; u += nblk) {
        const int qblk = NQB - 1 - u / (BATCH * 2), bg = u % (BATCH * 2), b = bg >> 1, g = bg & 1;
        const int q0 = qblk * NSA_QB, qw = q0 + sub * 32, qpos = qw + r;
        const int head = g * 2 + n;
        const long trow = (long)b * SEQ;
        const bf16_t* hq_row = H + (trow + qpos) * NH;
        bf16x8 qf[1][4];
#pragma unroll
        for (int ks = 0; ks < 4; ++ks) qf[0][ks] = *(const bf16x8*)(hq_row + O_AQ + head * 64 + ks * 16 + 8 * h);
        const float sl = exp2f(-2.f * (float)(head + 1));
        const float gate0 = sigm(bf2f(hq_row[O_AG + head * 3 + 0])), gate1 = sigm(bf2f(hq_row[O_AG + head * 3 + 1])), gate2 = sigm(bf2f(hq_row[O_AG + head * 3 + 2]));
        float* oacc = OACC + (trow + qpos) * 256 + head * 64;
        __syncthreads();
        if (tidx() == 0) *orw = 0u;
        {
            u32x4 rg[TileCfg<64>::NI];
#pragma unroll
            for (int tl = 0; tl < 4; ++tl) {
                const bf16_t* src = (tl & 2) ? VCB : KCB; const int cb = (tl & 1) * 64;
                tile_gload<64>(rg, [&](int row) { const int c = cb + row < NCMP ? cb + row : NCMP - 1; return src + ((long)(b * NCMP + c) * 2 + g) * 64; });
                tile_lstore<64>(rg, lds + tl * TB_);
            }
        }
        __syncthreads();
        float imp[16];
        {
            f32x16 s[2][2];
            qk_tile<64>(s[0], qf[0], lds, r, h);
            qk_tile<64>(s[1], qf[0], lds + TB_, r, h);
            float tmax = -INFINITY;
#pragma unroll
            for (int tl = 0; tl < 2; ++tl)
#pragma unroll
                for (int kt = 0; kt < 2; ++kt)
#pragma unroll
                    for (int i = 0; i < 16; ++i) {
                        const int c = tl * 64 + kt * 32 + crow(i, h), dist = qpos - (16 * c + 31);
                        const float v = (c < NCMP && dist >= 0) ? s[tl][kt][i] * 0.125f - sl * (float)dist : -INFINITY;
                        s[tl][kt][i] = v; tmax = fmaxf(tmax, v);
                    }
            const float mn = fmaxf(xhalf_max(tmax), -1e30f);
            float ps = 0.f;
#pragma unroll
            for (int tl = 0; tl < 2; ++tl)
#pragma unroll
                for (int kt = 0; kt < 2; ++kt)
#pragma unroll
                    for (int i = 0; i < 16; ++i) { const float pr = __expf(s[tl][kt][i] - mn); s[tl][kt][i] = pr; ps += pr; }
            const float rl = 1.f / fmaxf(xhalf_sum(ps), 1e-30f);
            float P3[16];
#pragma unroll
            for (int tl = 0; tl < 2; ++tl)
#pragma unroll
                for (int kt = 0; kt < 2; ++kt) {
#pragma unroll
                    for (int ig = 0; ig < 4; ++ig) {
                        const float p0 = s[tl][kt][4 * ig] * rl, p1 = s[tl][kt][4 * ig + 1] * rl, p2 = s[tl][kt][4 * ig + 2] * rl, p3 = s[tl][kt][4 * ig + 3] * rl;
                        imp[tl * 8 + kt * 4 + ig] = (p0 + p1) + (p2 + 0.5f * p3);
                        P3[tl * 8 + kt * 4 + ig] = 0.5f * p3;
                    }
                    const float gs = rl * gate0;
#pragma unroll
                    for (int i = 0; i < 16; ++i) s[tl][kt][i] *= gs;
                }
#pragma unroll
            for (int idx = 0; idx < 16; ++idx) {
                const float pp = xhalf_other(P3[idx], h);
                float prevp;
                if (idx == 0) prevp = h ? pp : 0.f; else { const float ppm = xhalf_other(P3[idx - 1], h); prevp = h ? pp : ppm; }
                imp[idx] += prevp;
                impx[(wid * 16 + idx) * 64 + lane] = imp[idx];
            }
            f32x16 oc[2];
#pragma unroll
            for (int i = 0; i < 16; ++i) { oc[0][i] = 0.f; oc[1][i] = 0.f; }
            pv_tile<64>(oc, s[0], lds + 2 * TB_, lane);
            pv_tile<64>(oc, s[1], lds + 3 * TB_, lane);
#pragma unroll
            for (int dvt = 0; dvt < 2; ++dvt)
#pragma unroll
                for (int i = 0; i < 4; ++i) *(float4*)(oacc + dvt * 32 + 8 * i + 4 * h) = make_float4(oc[dvt][4 * i], oc[dvt][4 * i + 1], oc[dvt][4 * i + 2], oc[dvt][4 * i + 3]);
        }
        __syncthreads();
        unsigned sel = 0u;
        {
            const int cur = qpos >> 6;
#pragma unroll
            for (int idx = 0; idx < 16; ++idx) {
                const float other = impx[((wid ^ 1) * 16 + idx) * 64 + lane];
                const float tot = n == 0 ? imp[idx] + other : other + imp[idx];
                const int j = 2 * idx + h;
                const bool forced = (j == 0) || (j == cur), valid = (j * 64 <= qpos);
                imp[idx] = forced ? 1e4f : (valid ? tot : -1.0f);
            }
#pragma unroll 1
            for (int it = 0; it < 8; ++it) {
                float best = -INFINITY; int bj = 64;
#pragma unroll
                for (int idx = 0; idx < 16; ++idx) if (imp[idx] > best) { best = imp[idx]; bj = 2 * idx + h; }
                const float pb = xhalf_other(best, h); const int pj = __float_as_int(xhalf_other(__int_as_float(bj), h));
                const bool own = (best > pb) || (best == pb && bj < pj);
                const int wj = own ? bj : pj;
                sel |= 1u << wj;
#pragma unroll
                for (int idx = 0; idx < 16; ++idx) if (2 * idx + h == wj) imp[idx] = -INFINITY;
            }
        }
        atomicOr(orw, sel);
        __syncthreads();
        const unsigned bmask = *orw;
        const int jhi = (q0 + NSA_QB - 1) >> 6;
        const unsigned upto = jhi >= 31 ? 0xffffffffu : ((1u << (jhi + 1)) - 1u);
        const float c1 = 0.125f * LOG2E, sl2 = sl * LOG2E;
        {
            f32x16 o[2];
#pragma unroll
            for (int i = 0; i < 16; ++i) { o[0][i] = 0.f; o[1][i] = 0.f; }
            float m = -1e30f, l = 0.f;
            const int jlo = (q0 - 511 > 0 ? q0 - 511 : 0) >> 6;
            const unsigned tmask = upto & ~((1u << jlo) - 1u);
            attn_stream<64, 64, true>(qf[0], o, m, l, tmask, qw + 31, qw - 511,
                [&](int row) { return H + (trow + row) * NH + O_AKW + g * 64; },
                [&](int row) { return H + (trow + row) * NH + O_AVW + g * 64; },
                c1, sl2, qpos,
                [&](int key) { const int dist = qpos - key; return dist >= 0 && dist < 512; },
                [&](int j) { return j * 64 + 63 <= qw && qw + 31 - j * 64 < 512; }, lds);
            const float rl = gate2 / fmaxf(xhalf_sum(l), 1e-30f);
#pragma unroll
            for (int dvt = 0; dvt < 2; ++dvt)
#pragma unroll
                for (int i = 0; i < 4; ++i) { float4* a = (float4*)(oacc + dvt * 32 + 8 * i + 4 * h); float4 c = *a;
                    c.x += o[dvt][4 * i] * rl; c.y += o[dvt][4 * i + 1] * rl; c.z += o[dvt][4 * i + 2] * rl; c.w += o[dvt][4 * i + 3] * rl; *a = c; }
        }
        {
            f32x16 o[2];
#pragma unroll
            for (int i = 0; i < 16; ++i) { o[0][i] = 0.f; o[1][i] = 0.f; }
            float m = -1e30f, l = 0.f;
            attn_stream<64, 64, true>(qf[0], o, m, l, bmask & upto, qw + 31, 0,
                [&](int row) { return H + (trow + row) * NH + O_AKS + g * 64; },
                [&](int row) { return H + (trow + row) * NH + O_AVS + g * 64; },
                c1, sl2, qpos,
                [&](int key) { return key <= qpos && ((sel >> (key >> 6)) & 1u); },
                [&](int j) { return j * 64 + 63 <= qw && __all((sel >> j) & 1u); }, lds);
            const float rl = gate1 / fmaxf(xhalf_sum(l), 1e-30f);
            bf16_t* dst = BR + (trow + qpos) * 1024 + head * 64;
#pragma unroll
            for (int dvt = 0; dvt < 2; ++dvt)
#pragma unroll
                for (int i = 0; i < 4; ++i) { const float4 c = *(const float4*)(oacc + dvt * 32 + 8 * i + 4 * h);
                    st4bf(dst + dvt * 32 + 8 * i + 4 * h, c.x + o[dvt][4 * i] * rl, c.y + o[dvt][4 * i + 1] * rl, c.z + o[dvt][4 * i + 2] * rl, c.w + o[dvt][4 * i + 3] * rl); }
        }
    }
}

namespace pg8 { typedef PG8_LAS unsigned char* PG8_LAS_T; }
#define LDS3 ((pg8::PG8_LAS_T)lds)
#define GEMM256(EPI, SCHED, g, S, E) do { __syncthreads(); pg8::gemm_phase<EPI, SCHED, false, true>(LDS3, g, S, E); } while (0)
constexpr int NPH = 18;
constexpr int NPHASES = 2 + DEPTH * NPH;

__global__ void __launch_bounds__(NT, 2) mega(Params pk, int ph_lo, int ph_hi) {
    extern __shared__ __attribute__((aligned(16))) unsigned char lds[];
    const int bid = blockIdx.x, nblk = gridDim.x;
#define XB_HERE XcdBarrier bar_; bar_.bar = (unsigned*)(pk.ws + WS_CTL) + CW_BAR; bar_.x = xb_xcc_id(); bar_.st = (volatile LAS unsigned*)(lds + 131072)
    const bool multi = (ph_hi - ph_lo) > 1;
    if (multi) {
        uint4* xbw = (uint4*)(lds + 131072);
        if (tidx() == 0) *xbw = make_uint4(0u, 0u, 0u, 0u);
        __syncthreads();
        (void)xcd_barrier_post((unsigned*)(pk.ws + WS_CTL) + CW_BAR, (volatile LAS unsigned*)xbw);
    }
#ifndef PROBE_PH
#define PROBE_PH -100
#endif
#define PHASE(id, ...) do { const int _id = (id); if (ph_lo <= _id && _id < ph_hi) { for (int _rep = 0; _rep < ((PROBE_PH == -1 ? _id < 2 : (_id >= 2 && (_id - 2) % NPH == PROBE_PH)) ? 2 : 1); ++_rep) { if (_rep) { XB_HERE; xcd_barrier(bar_); } { Params p = pk; int layer = layer_; asm volatile("" : "+s"(p.ws), "+s"(p.out), "+s"(layer)); \
        const LayerW w = layer_w(p, layer); const float* Xin = (layer == 0) ? p.in[0] : WSF(WS_XC); const bf16_t* XinB = (layer == 0) ? WSB(WS_X0B) : WSB(WS_XCB); float* Xout = (layer == DEPTH - 1) ? p.out : WSF(WS_XC); \
        (void)w; (void)Xin; (void)XinB; (void)Xout; __VA_ARGS__; } } if (_id + 1 < ph_hi) { XB_HERE; xcd_barrier(bar_); } } } while (0)

    { const int layer_ = 0;
    PHASE(0, {
        job_wt<2>(p.in[2], DEPTH, 1024, NIN, WSB(WT_IN), NH, bid, nblk, lds);
        job_wt<0>(p.in[17], DEPTH, 1024, 1024, WSB(WT_BR), 1024, bid, nblk, lds);
        job_wt<0>(p.in[18], DEPTH, 1024, 1024, WSB(WT_OUT), 1024, bid, nblk, lds);
        job_wt<0>(p.in[21], DEPTH, 1024, 512, WSB(WT_Q), 512, bid, nblk, lds);
        job_wt<0>(p.in[22], DEPTH, 1024, 1024, WSB(WT_KV), 1024, bid, nblk, lds);
        job_wt<0>(p.in[23], DEPTH, 512, 1024, WSB(WT_O), 1024, bid, nblk, lds);
        job_wt<1>(p.in[30], DEPTH * 32, 1024, 1024, WSB(WT_GU), 1024, bid, nblk, lds);
        job_wt<0>(p.in[31], DEPTH * 32, 512, 1024, WSB(WT_DN), 1024, bid, nblk, lds);
        job_wt<0>(p.in[4], DEPTH * 2, 2048, 256, WSB(WT_C1), 256, bid, nblk, lds);
        job_wt<0>(p.in[5], DEPTH * 2, 256, 64, WSB(WT_C2), 128, bid, nblk, lds);
        job_wt<0>(p.in[15], DEPTH, 192, 384, WSB(WT_UQ), 384, bid, nblk, lds);
        job_wt<0>(p.in[16], DEPTH, 128, 512, WSB(WT_UKV), 512, bid, nblk, lds);
        job_pack_small(p, bid, nblk);
        job_cvt(p.in[0], WSB(WS_X0B), (long)T * 1024, bid, nblk);
        job_cvt(p.in[1], WSB(WS_MEMB), (long)2048 * 1024, bid, nblk);
    });
    PHASE(1, {
        pg8::Gemm g{WSB(WS_MEMB), WSB(WT_KV), BATCH * MEM_LEN, 1024, 1024, nullptr};
        GroupedOrder S{8, 4, DEPTH, nblk, bid};
        EpiStoreBf16 E{WSB(WS_KVM), 1024, 1 << 30, (long)2048 * 1024};
        GEMM256(EpiStoreBf16, GroupedOrder, g, S, E);
    });
    }
    for (int layer_ = 0; layer_ < DEPTH; ++layer_) {
        const int base = 2 + layer_ * NPH;
        PHASE(base + 0, { pg8::Gemm g{XinB, w.t_in, T, NH, 1024, nullptr}; pg8::StaticOrder S; S.init(T, NH, nblk, bid); EpiStoreBf16 E{WSB(WS_H), NH, O_MG / 128, 0}; GEMM256(EpiStoreBf16, pg8::StaticOrder, g, S, E); });
        PHASE(base + 1, { job_sb_attn(p, bid, nblk, lds); job_cmp_gather(p, w, bid, nblk); job_rnn_conv(p, w, bid, nblk); job_mla_norm(p, w, bid, nblk); });
        PHASE(base + 2, { if (bid < 32) job_cmp_mlp<0>(p, w, bid, 32, lds); else { job_rnn_gates(p, w, bid - 32, nblk - 32, lds); job_mla_up(p, w, bid - 32, nblk - 32, lds); } });
        PHASE(base + 3, { job_cmp_mlp<1>(p, w, bid, nblk, lds); job_rnn_scan1(p, bid, nblk); });
        PHASE(base + 4, { job_nsa(p, bid, nblk, lds); job_mla_attn(p, bid, nblk, lds); job_rnn_scan2(p, bid, nblk); });
        PHASE(base + 5, { job_merge(p, w, bid, nblk, lds); });
        PHASE(base + 6, { pg8::Gemm g{WSB(WS_M), w.t_out, T, 1024, 1024, nullptr}; pg8::StaticOrder S; S.init(T, 1024, nblk, bid); EpiStoreBf16 E{WSB(WS_Y), 1024, 1 << 30, 0}; GEMM256(EpiStoreBf16, pg8::StaticOrder, g, S, E); });
        PHASE(base + 7, { job_ln(layer == 0 ? p.in[0] : nullptr, WSB(WS_XCB), nullptr, WSB(WS_Y), nullptr, nullptr, w.ln1_g, w.ln1_b, nullptr, WSB(WS_XAB), nullptr, bid, nblk); });
        PHASE(base + 8, { pg8::Gemm g{WSB(WS_XAB), w.t_q, T, 512, 1024, nullptr}; pg8::StaticOrder S; S.init(T, 512, nblk, bid); EpiStoreBf16 E{WSB(WS_XQ), 512, 1 << 30, 0}; GEMM256(EpiStoreBf16, pg8::StaticOrder, g, S, E); });
        PHASE(base + 9, { job_cross_attn(p, layer, bid, nblk, lds); });
        PHASE(base + 10, { pg8::Gemm g{WSB(WS_XO), w.t_o, T, 1024, 512, nullptr}; pg8::StaticOrder S; S.init(T, 1024, nblk, bid); EpiStoreBf16 E{WSB(WS_Y), 1024, 1 << 30, 0}; GEMM256(EpiStoreBf16, pg8::StaticOrder, g, S, E); });
        PHASE(base + 11, { job_ln(nullptr, WSB(WS_XAB), nullptr, WSB(WS_Y), nullptr, nullptr, w.ln2_g, w.ln2_b, nullptr, WSB(WS_XBB), WSB(WS_XBL), bid, nblk); });
        PHASE(base + 12, { job_router_logits(p, w, bid, nblk, lds); });
        PHASE(base + 13, { job_router(p, w, layer, bid, nblk); });
        PHASE(base + 14, { job_fill(p, layer, bid, nblk, lds); });
        PHASE(base + 15, { const pg8::ListOrder S = moe_units(WSU(WS_CTL) + CW_CNT + layer * 32, bid, nblk); pg8::Gemm g{WSB(WS_XBB), w.t_gu, PADROWS, 1024, 1024, WSI(WS_PERM)}; EpiMoeGU E{WSB(WS_HH)}; __syncthreads(); pg8::gemm_phase<EpiMoeGU, pg8::ListOrder, false, true, true>(LDS3, g, S, E); });
        PHASE(base + 16, { const pg8::ListOrder S = moe_units(WSU(WS_CTL) + CW_CNT + layer * 32, bid, nblk); pg8::Gemm g{WSB(WS_HH), w.t_dn, PADROWS, 1024, 512, nullptr}; EpiStoreBf16 E{WSB(WS_YK), 1024, 1 << 30, 0}; GEMM256(EpiStoreBf16, pg8::ListOrder, g, S, E); });
        PHASE(base + 17, { job_ln(nullptr, WSB(WS_XBB), WSB(WS_XBL), WSB(WS_YK), WSI(WS_ROWOF), WSF(WS_EW), w.ln3_g, w.ln3_b, (layer == DEPTH - 1) ? p.out : nullptr, (layer == DEPTH - 1) ? nullptr : WSB(WS_XCB), nullptr, bid, nblk); });
    }
}

extern "C" void kernel_launch(void* const* d_in, const int* in_sizes, int n_in, void* d_out, int out_size, void* d_ws, size_t ws_size, hipStream_t stream) {
    constexpr size_t kDynLds = 131072 + 1024;
    static_assert(2 * G_STAGE + 1024 <= 131072, "engine stages fit");
    static int grid = 0;
    if (!grid) {
        int dev = 0, cus = 0, per_cu = 0;
        (void)hipGetDevice(&dev);
        (void)hipDeviceGetAttribute(&cus, hipDeviceAttributeMultiprocessorCount, dev);
        (void)hipFuncSetAttribute((const void*)mega, hipFuncAttributeMaxDynamicSharedMemorySize, (int)kDynLds);
        (void)hipOccupancyMaxActiveBlocksPerMultiprocessor(&per_cu, mega, NT, kDynLds);
        if (per_cu < 1) per_cu = 1;
        grid = cus * (per_cu < 2 ? per_cu : 2);
    }
    if (ws_size < WS_END) { fprintf(stderr, "workspace too small: %zu < %zu\n", ws_size, (size_t)WS_END); return; }
    Params p{};
    for (int i = 0; i < 34; ++i) p.in[i] = (const float*)d_in[i];
    p.out = (float*)d_out;
    p.ws = (unsigned char*)d_ws;
    (void)hipMemsetAsync(d_ws, 0, CTL_BYTES, stream);
#if MK_ONE_LAUNCH
    hipLaunchKernelGGL(mega, dim3(grid), dim3(NT), kDynLds, stream, p, 0, NPHASES);
#else
    for (int ph = 0; ph < NPHASES; ++ph) hipLaunchKernelGGL(mega, dim3(grid), dim3(NT), kDynLds, stream, p, ph, ph + 1);
#endif
}
```

```cpp
#include <hip/hip_runtime.h>
#include <stdint.h>
#include <stdio.h>

#ifndef MK_ONE_LAUNCH
#define MK_ONE_LAUNCH 1
#endif

#define DI __device__ __forceinline__
#define LAS __attribute__((address_space(3)))
DI int tidx() { int t = threadIdx.x; asm volatile("" : "+v"(t)); return t; }

constexpr int NT = 512;
constexpr int D = 1024, BATCH = 8, SEQ = 2048, T = BATCH * SEQ, DEPTH = 4;
constexpr int MEM_LEN = 256;
constexpr int NIN = 6764, NH = 6912;
constexpr int O_AQ = 0, O_AKC = 256, O_AVC = 384, O_AKS = 512, O_AVS = 640, O_AKW = 768, O_AVW = 896,
              O_BQ = 1024, O_BK = 1280, O_BV = 1536, O_CX = 1792, O_CG = 2048, O_DCQ = 2304, O_DCKV = 2496, O_DKR = 2624,
              O_AG = 2656, O_MG = 2688;
constexpr int NCMP = 127, NCR = BATCH * NCMP * 2;
constexpr int NEXP = 32, NASSIGN = T * 2;
constexpr float DN_ALPHA = 1.681792830507429f;

typedef unsigned short bf16_t;
typedef short bf16x8 __attribute__((ext_vector_type(8)));
typedef float f32x16 __attribute__((ext_vector_type(16)));
typedef unsigned u32x4 __attribute__((ext_vector_type(4)));

constexpr int G_WM = NT / 128;
constexpr int G_BM = 64 * G_WM;
constexpr int G_BN = 128;
constexpr int G_RS = 144;
constexpr int G_STAGE = (G_BM + G_BN) * G_RS;
constexpr int PADROWS = ((NASSIGN + NEXP * (G_BM - 1) + G_BM - 1) / G_BM) * G_BM;

constexpr size_t MiB = 1u << 20;
constexpr size_t al(size_t x) { return (x + 255) & ~(size_t)255; }
constexpr size_t WS_CTL = 0, CTL_BYTES = 1 * MiB;
constexpr size_t WT_IN = WS_CTL + CTL_BYTES;
constexpr size_t WT_BR = WT_IN + al((size_t)DEPTH * NH * 1024 * 2);
constexpr size_t WT_OUT = WT_BR + al((size_t)DEPTH * 4 * 1024 * 256 * 2);
constexpr size_t WT_Q = WT_OUT + al((size_t)DEPTH * 1024 * 1024 * 2);
constexpr size_t WT_KV = WT_Q + al((size_t)DEPTH * 512 * 1024 * 2);
constexpr size_t WT_O = WT_KV + al((size_t)DEPTH * 1024 * 1024 * 2);
constexpr size_t WT_GU = WT_O + al((size_t)DEPTH * 1024 * 512 * 2);
constexpr size_t WT_DN = WT_GU + al((size_t)DEPTH * 32 * 1024 * 1024 * 2);
constexpr size_t WS_X0B = WT_DN + al((size_t)DEPTH * 32 * 1024 * 512 * 2);
constexpr size_t WS_MEMB = WS_X0B + al((size_t)T * 1024 * 2);
constexpr size_t WS_H = WS_MEMB + al((size_t)2048 * 1024 * 2);
constexpr size_t SZ_H = al((size_t)T * NH * 2);
constexpr size_t WS_YK = WS_H;
constexpr size_t WS_HH = WS_YK + (size_t)PADROWS * 1024 * 2;
static_assert(WS_HH + (size_t)PADROWS * 512 * 2 <= WS_H + SZ_H, "moe overlay fits in H");
constexpr size_t WS_TB = WS_H + SZ_H;
constexpr size_t WS_HID = WS_TB + al((size_t)2 * NCR * 2048 * 4);
constexpr size_t WS_KCVC = WS_HID + al((size_t)2 * NCR * 256 * 4);
constexpr size_t WS_PC = WS_KCVC + al((size_t)2 * NCR * 64 * 4);
constexpr size_t WS_SEL = WS_PC + al((size_t)BATCH * 4 * SEQ * 128 * 4);
constexpr size_t WS_OW = WS_SEL + al((size_t)BATCH * 2 * SEQ * 4);
constexpr size_t WS_OC = WS_OW + al((size_t)T * 256 * 4);
constexpr size_t WS_BR = WS_OC + al((size_t)T * 256 * 4);
constexpr size_t WS_U = WS_BR + al((size_t)T * 1024 * 2);
constexpr size_t WS_RA = WS_U + al((size_t)T * 256 * 4);
constexpr size_t WS_RB = WS_RA + al((size_t)T * 256 * 4);
constexpr size_t WS_CQN = WS_RB + al((size_t)T * 256 * 4);
constexpr size_t WS_CKVN = WS_CQN + al((size_t)T * 192 * 4);
constexpr size_t WS_KR = WS_CKVN + al((size_t)T * 128 * 4);
constexpr size_t WS_Q = WS_KR + al((size_t)T * 32 * 4);
constexpr size_t WS_KV = WS_Q + al((size_t)T * 384 * 4);
constexpr size_t WS_M = WS_KV + al((size_t)T * 512 * 4);
constexpr size_t WS_Y = WS_M + al((size_t)T * 1024 * 2);
constexpr size_t WS_XA = WS_Y + al((size_t)T * 1024 * 4);
constexpr size_t WS_XB = WS_XA + al((size_t)T * 1024 * 4);
constexpr size_t WS_XC = WS_XB + al((size_t)T * 1024 * 4);
constexpr size_t WS_XAB = WS_XC + al((size_t)T * 1024 * 4);
constexpr size_t WS_XBB = WS_XAB + al((size_t)T * 1024 * 2);
constexpr size_t WS_XCB = WS_XBB + al((size_t)T * 1024 * 2);
constexpr size_t WS_XQ = WS_XCB + al((size_t)T * 1024 * 2);
constexpr size_t WS_XO = WS_XQ + al((size_t)T * 512 * 2);
constexpr size_t WS_KVM = WS_XO + al((size_t)T * 512 * 2);
constexpr size_t WS_LOG = WS_KVM + al((size_t)DEPTH * 2048 * 1024 * 2);
constexpr size_t WS_EIDX = WS_LOG + al((size_t)3 * T * 36 * 4);
constexpr size_t WS_ESLOT = WS_EIDX + al((size_t)NASSIGN * 4);
constexpr size_t WS_EW = WS_ESLOT + al((size_t)NASSIGN * 4);
constexpr size_t WS_PERM = WS_EW + al((size_t)NASSIGN * 4);
constexpr size_t WS_QB = WS_PERM + al((size_t)PADROWS * 4);
constexpr size_t WS_KM = WS_QB + al((size_t)T * 384 * 2);
constexpr size_t WS_VM = WS_KM + al((size_t)T * 384 * 2);
constexpr size_t WS_KCB = WS_VM + al((size_t)T * 256 * 2);
constexpr size_t WT_C1 = WS_KCB + al((size_t)2 * NCR * 64 * 2);
constexpr size_t WT_C2 = WT_C1 + al((size_t)DEPTH * 2 * 256 * 2048 * 2);
constexpr size_t WT_UQ = WT_C2 + al((size_t)DEPTH * 2 * 128 * 256 * 2);
constexpr size_t WT_UKV = WT_UQ + al((size_t)DEPTH * 384 * 192 * 2);
constexpr size_t WT_G = WT_UKV + al((size_t)DEPTH * 512 * 128 * 2);
constexpr size_t WT_RH = WT_G + al((size_t)DEPTH * 4 * 128 * 64 * 2);
constexpr size_t WT_RL = WT_RH + al((size_t)DEPTH * 128 * 1024 * 2);
constexpr size_t WS_TBB = WT_RL + al((size_t)DEPTH * 128 * 1024 * 2);
constexpr size_t WS_HIDB = WS_TBB + al((size_t)2 * 2048 * 2048 * 2);
constexpr size_t WS_UB = WS_HIDB + al((size_t)2 * 2048 * 256 * 2);
constexpr size_t WS_CQNB = WS_UB + al((size_t)T * 256 * 2);
constexpr size_t WS_CKVNB = WS_CQNB + al((size_t)T * 192 * 2);
constexpr size_t WS_XBL = WS_CKVNB + al((size_t)T * 128 * 2);
constexpr size_t WS_SA = WS_XBL + al((size_t)T * 1024 * 2);
constexpr size_t WS_SH = WS_SA + al((size_t)BATCH * 32 * 256 * 4);
constexpr size_t WS_XG = WS_SH + al((size_t)BATCH * 32 * 256 * 4);
constexpr size_t WS_ROWOF = WS_XG + al((size_t)PADROWS * 1024 * 2);
constexpr size_t WS_ROPE_PRE = WS_ROWOF + al((size_t)NASSIGN * 4);
constexpr size_t WS_ROPE = WS_ROPE_PRE;
constexpr size_t WS_END = WS_ROPE + al((size_t)SEQ * 16 * 2 * 4);

constexpr int CW_BAR = 4096;
constexpr int CW_CNT = 16384;

struct Params {
    const float* in[34];
    float* out;
    unsigned char* ws;
};

#define XB_TMO      128
#define XB_XCNT(j)  (256  + 64 * (j))
#define XB_XSUB(j)  (1280 + 64 * (j))
#define XB_XGEN(j)  (2304 + 64 * (j))
#define XB_TOP      3328
#define XB_TOPGEN   3392
#define XCD_BAR_WORDS 3456
#define XB_SPIN_CAP (1u << 22)

__device__ __forceinline__ unsigned xb_ld(unsigned* p)              { return __hip_atomic_load(p, __ATOMIC_RELAXED, __HIP_MEMORY_SCOPE_AGENT); }
__device__ __forceinline__ unsigned xb_add(unsigned* p, unsigned v) { return __hip_atomic_fetch_add(p, v, __ATOMIC_RELAXED, __HIP_MEMORY_SCOPE_AGENT); }
__device__ __forceinline__ unsigned xb_xcc_id() { return (unsigned)__builtin_amdgcn_s_getreg((3 << 11) | 20) & 0xFu; }
#define XB_SPIN(cond, bar) do { unsigned _sp = 0; while (cond) { __builtin_amdgcn_s_sleep(1); \
    if ((++_sp & 255u) == 0u) { if (xb_ld(&(bar)[XB_TMO])) break; if (_sp > XB_SPIN_CAP) { atomicAdd(&(bar)[XB_TMO], 1u); break; } } } } while (0)

struct XcdBarrier { unsigned* bar; unsigned x; volatile LAS unsigned* st; };

__device__ __forceinline__ XcdBarrier xcd_barrier_post(unsigned* bar, volatile LAS unsigned* st) {
    XcdBarrier b; b.bar = bar; b.x = xb_xcc_id(); b.st = st;
    if (threadIdx.x == 0) (void)xb_add(&bar[XB_XCNT(b.x)], 1u);
    return b;
}
__device__ __forceinline__ void xcd_barrier_complete(unsigned* bar, unsigned x, unsigned& nloc, unsigned& nx) {
    const unsigned G = gridDim.x * gridDim.y * gridDim.z;
    unsigned sum, cnt, mine, sp = 0u;
    for (;;) {
        sum = 0u; cnt = 0u; mine = 0u;
#pragma unroll
        for (unsigned j = 0; j < 16; ++j) { const unsigned c = xb_ld(&bar[XB_XCNT(j)]); sum += c; cnt += (c > 0u) ? 1u : 0u; mine = (j == x) ? c : mine; }
        if (sum == G) break;
        __builtin_amdgcn_s_sleep(1);
        if ((++sp & 255u) == 0u) { if (xb_ld(&bar[XB_TMO])) break; if (sp > XB_SPIN_CAP) { atomicAdd(&bar[XB_TMO], 1u); break; } }
    }
    nloc = mine > 0u ? mine : 1u; nx = cnt > 0u ? cnt : 1u;
}
__device__ __forceinline__ void xcd_barrier(const XcdBarrier& b) {
    asm volatile("s_waitcnt vmcnt(0)" ::: "memory");
    __syncthreads();
    if (threadIdx.x == 0) {
        unsigned* bar = b.bar;
        __builtin_amdgcn_s_waitcnt(0);
        unsigned nloc = b.st[0], nx = b.st[1];
        if (nloc == 0u) { xcd_barrier_complete(bar, b.x, nloc, nx); b.st[0] = nloc; b.st[1] = nx; }
        const unsigned old = xb_add(&bar[XB_XSUB(b.x)], 1u);
        const unsigned gen = old / nloc;
        if (old + 1u == (gen + 1u) * nloc) {
            __builtin_amdgcn_fence(__ATOMIC_RELEASE, "agent");
            asm volatile("s_waitcnt vmcnt(0)" ::: "memory");
            const unsigned og = xb_add(&bar[XB_TOP], 1u);
            const unsigned tg = og / nx;
            if (og + 1u == (tg + 1u) * nx) xb_add(&bar[XB_TOPGEN], 1u);
            else XB_SPIN(xb_ld(&bar[XB_TOPGEN]) == tg, bar);
            __builtin_amdgcn_fence(__ATOMIC_ACQUIRE, "agent");
            xb_add(&bar[XB_XGEN(b.x)], 1u);
            asm volatile("s_waitcnt vmcnt(0)" ::: "memory");
        } else {
            XB_SPIN(xb_ld(&bar[XB_XGEN(b.x)]) == gen, bar);
            __builtin_amdgcn_fence(__ATOMIC_ACQUIRE, "agent");
            asm volatile("s_waitcnt vmcnt(0)" ::: "memory");
        }
    }
    __syncthreads();
}

DI float gelu_tanh(float x) { const float u = 0.7978845608028654f * (x + 0.044715f * x * x * x); return 0.5f * x * (1.f + tanhf(u)); }
DI float sigm(float x) { return 1.f / (1.f + expf(-x)); }
DI float sigm_fast(float x) { return __builtin_amdgcn_rcpf(1.f + __expf(-x)); }
DI float logsig(float z) { return fminf(z, 0.f) - log1pf(expf(-fabsf(z))); }
DI float wave_sum(float v) {
    const int lane = tidx() & 63;
#pragma unroll
    for (int o = 32; o > 0; o >>= 1) v += __int_as_float(__builtin_amdgcn_ds_bpermute((lane ^ o) << 2, __float_as_int(v)));
    return v;
}
DI void wave_sum2(float& a, float& b) {
    const int lane = tidx() & 63;
#pragma unroll
    for (int o = 32; o > 0; o >>= 1) {
        const float a2 = __int_as_float(__builtin_amdgcn_ds_bpermute((lane ^ o) << 2, __float_as_int(a)));
        const float b2 = __int_as_float(__builtin_amdgcn_ds_bpermute((lane ^ o) << 2, __float_as_int(b)));
        a += a2; b += b2;
    }
}

DI float bflo(unsigned u) { return __uint_as_float(u << 16); }
DI float bfhi(unsigned u) { return __uint_as_float(u & 0xffff0000u); }
DI float bf2f(bf16_t x) { return __uint_as_float((unsigned)x << 16); }
typedef float f32x2_t __attribute__((ext_vector_type(2)));
typedef __bf16 bf16x2_t __attribute__((ext_vector_type(2)));
DI unsigned pk_bf16(float lo, float hi) { f32x2_t v = {lo, hi}; bf16x2_t b = __builtin_convertvector(v, bf16x2_t); return __builtin_bit_cast(unsigned, b); }
DI bf16_t f2bf(float x) { return (bf16_t)(pk_bf16(x, 0.f) & 0xffffu); }
DI void st4bf(bf16_t* p, float a, float b, float c, float d) { uint2 v; v.x = pk_bf16(a, b); v.y = pk_bf16(c, d); *(uint2*)p = v; }
DI void ld8f(const bf16_t* p, float* f) { const u32x4 v = *(const u32x4*)p; f[0] = bflo(v[0]); f[1] = bfhi(v[0]); f[2] = bflo(v[1]); f[3] = bfhi(v[1]); f[4] = bflo(v[2]); f[5] = bfhi(v[2]); f[6] = bflo(v[3]); f[7] = bfhi(v[3]); }
DI void st8bf(bf16_t* p, const float* f) { u32x4 v; v[0] = pk_bf16(f[0], f[1]); v[1] = pk_bf16(f[2], f[3]); v[2] = pk_bf16(f[4], f[5]); v[3] = pk_bf16(f[6], f[7]); *(u32x4*)p = v; }
DI float4 ld4bf(const bf16_t* p) { const uint2 v = *(const uint2*)p; return make_float4(bflo(v.x), bfhi(v.x), bflo(v.y), bfhi(v.y)); }
template <int N> DI float dot_row(const float* q, const bf16_t* kr) {
    float dot = 0.f;
#pragma unroll
    for (int d = 0; d < N; d += 8) { const uint4 v = *(const uint4*)(kr + d);
        dot = fmaf(q[d], bflo(v.x), dot); dot = fmaf(q[d + 1], bfhi(v.x), dot); dot = fmaf(q[d + 2], bflo(v.y), dot); dot = fmaf(q[d + 3], bfhi(v.y), dot);
        dot = fmaf(q[d + 4], bflo(v.z), dot); dot = fmaf(q[d + 5], bfhi(v.z), dot); dot = fmaf(q[d + 6], bflo(v.w), dot); dot = fmaf(q[d + 7], bfhi(v.w), dot); }
    return dot;
}
template <int N> DI float dot_row(const float* q, const float* kr) {
    float dot = 0.f;
#pragma unroll
    for (int d = 0; d < N; ++d) dot = fmaf(q[d], kr[d], dot);
    return dot;
}
template <int N> DI void axpy_row(float* o, float pr, float corr, const bf16_t* vr) {
#pragma unroll
    for (int d = 0; d < N; d += 8) { const uint4 v = *(const uint4*)(vr + d);
        o[d] = fmaf(pr, bflo(v.x), o[d] * corr); o[d + 1] = fmaf(pr, bfhi(v.x), o[d + 1] * corr); o[d + 2] = fmaf(pr, bflo(v.y), o[d + 2] * corr); o[d + 3] = fmaf(pr, bfhi(v.y), o[d + 3] * corr);
        o[d + 4] = fmaf(pr, bflo(v.z), o[d + 4] * corr); o[d + 5] = fmaf(pr, bfhi(v.z), o[d + 5] * corr); o[d + 6] = fmaf(pr, bflo(v.w), o[d + 6] * corr); o[d + 7] = fmaf(pr, bfhi(v.w), o[d + 7] * corr); }
}
template <int N> DI void axpy_row(float* o, float pr, float corr, const float* vr) {
#pragma unroll
    for (int d = 0; d < N; ++d) o[d] = fmaf(pr, vr[d], o[d] * corr);
}
template <int N> DI void ld_row(float* q, const bf16_t* p) {
#pragma unroll
    for (int d = 0; d < N; d += 8) { const uint4 v = *(const uint4*)(p + d);
        q[d] = bflo(v.x); q[d + 1] = bfhi(v.x); q[d + 2] = bflo(v.y); q[d + 3] = bfhi(v.y); q[d + 4] = bflo(v.z); q[d + 5] = bfhi(v.z); q[d + 6] = bflo(v.w); q[d + 7] = bfhi(v.w); }
}
template <int N> DI void ld_row(float* q, const float* p) {
#pragma unroll
    for (int d = 0; d < N; d += 4) { const float4 v = *(const float4*)(p + d); q[d] = v.x; q[d + 1] = v.y; q[d + 2] = v.z; q[d + 3] = v.w; }
}

struct MG { const bf16_t* A; long lda; const bf16_t* Wt; long ldw; int K; };

struct NoFlush { DI void operator()(int, f32x16 (&)[2][2]) const {} };
template <class RowFn, class Flush>
DI void mgemm_tile_f(const MG& g, int n0, RowFn rowfn, f32x16 (&acc)[2][2], unsigned char* lds, bool zero, int flush_every, Flush flush) {
    constexpr int XI = G_BM * 8 / NT, WI = G_BN * 8 / NT;
    const int tid = tidx(), lane = tid & 63, wid = tid >> 6, r = lane & 31, h = lane >> 5;
    const int wm = wid % G_WM, wn = wid / G_WM;
    const int cc = tid & 7, row0 = tid >> 3;
    const bf16_t* xp[XI]; const bf16_t* wp[WI];
#pragma unroll
    for (int i = 0; i < XI; ++i) xp[i] = g.A + (long)rowfn(row0 + (NT / 8) * i) * g.lda + cc * 8;
#pragma unroll
    for (int i = 0; i < WI; ++i) wp[i] = g.Wt + (long)(n0 + row0 + (NT / 8) * i) * g.ldw + cc * 8;
    const int st_off = row0 * G_RS + cc * 16;
    if (zero)
#pragma unroll
    for (int a = 0; a < 2; ++a)
#pragma unroll
        for (int b = 0; b < 2; ++b)
#pragma unroll
            for (int i = 0; i < 16; ++i) acc[a][b][i] = 0.f;
    const int nk = g.K >> 6;
    u32x4 xv0[XI], wv0[WI], xv1[XI], wv1[WI];
#define MG_GLOAD(XV, WV, KT) do { _Pragma("unroll") for (int i = 0; i < XI; ++i) XV[i] = *(const u32x4*)(xp[i] + (KT) * 64); \
                                  _Pragma("unroll") for (int i = 0; i < WI; ++i) WV[i] = *(const u32x4*)(wp[i] + (KT) * 64); } while (0)
#define MG_LSTORE(XV, WV, STG) do { unsigned char* _s = lds + (STG) * G_STAGE; \
        _Pragma("unroll") for (int i = 0; i < XI; ++i) *(u32x4*)(_s + st_off + (NT / 8) * i * G_RS) = XV[i]; \
        _Pragma("unroll") for (int i = 0; i < WI; ++i) *(u32x4*)(_s + G_BM * G_RS + st_off + (NT / 8) * i * G_RS) = WV[i]; } while (0)
    MG_GLOAD(xv0, wv0, 0);
    if (nk > 1) MG_GLOAD(xv1, wv1, 1);
    __syncthreads();
    MG_LSTORE(xv0, wv0, 0);
    if (nk > 2) MG_GLOAD(xv0, wv0, 2);
    __syncthreads();
    const int xf_off = (wm * 64 + r) * G_RS + h * 16, wf_off = G_BM * G_RS + (wn * 64 + r) * G_RS + h * 16;
#define MG_COMPUTE(STG) do { const unsigned char* st = lds + (STG) * G_STAGE; \
        _Pragma("unroll") for (int ks = 0; ks < 4; ++ks) { \
            const bf16x8 w0 = *(const bf16x8*)(st + wf_off + ks * 32), w1 = *(const bf16x8*)(st + wf_off + 32 * G_RS + ks * 32); \
            const bf16x8 x0 = *(const bf16x8*)(st + xf_off + ks * 32), x1 = *(const bf16x8*)(st + xf_off + 32 * G_RS + ks * 32); \
            acc[0][0] = __builtin_amdgcn_mfma_f32_32x32x16_bf16(w0, x0, acc[0][0], 0, 0, 0); \
            acc[0][1] = __builtin_amdgcn_mfma_f32_32x32x16_bf16(w0, x1, acc[0][1], 0, 0, 0); \
            acc[1][0] = __builtin_amdgcn_mfma_f32_32x32x16_bf16(w1, x0, acc[1][0], 0, 0, 0); \
            acc[1][1] = __builtin_amdgcn_mfma_f32_32x32x16_bf16(w1, x1, acc[1][1], 0, 0, 0); } } while (0)
    for (int kt = 0; kt < nk; kt += 2) {
        MG_COMPUTE(0);
        if (kt + 1 < nk) { MG_LSTORE(xv1, wv1, 1); if (kt + 3 < nk) MG_GLOAD(xv1, wv1, kt + 3); }
        if (flush_every && (kt + 1) % flush_every == 0) flush(kt / flush_every, acc);
        __syncthreads();
        if (kt + 1 < nk) {
            MG_COMPUTE(1);
            if (kt + 2 < nk) { MG_LSTORE(xv0, wv0, 0); if (kt + 4 < nk) MG_GLOAD(xv0, wv0, kt + 4); }
            if (flush_every && (kt + 2) % flush_every == 0) flush((kt + 1) / flush_every, acc);
            __syncthreads();
        }
    }
#undef MG_GLOAD
#undef MG_LSTORE
#undef MG_COMPUTE
}
template <class RowFn>
DI void mgemm_tile(const MG& g, int n0, RowFn rowfn, f32x16 (&acc)[2][2], unsigned char* lds, bool zero = true) { mgemm_tile_f(g, n0, rowfn, acc, lds, zero, 0, NoFlush{}); }
#define MG_FOREACH(acc, LROW, FEAT, V, ...) do { const int _l = tidx() & 63, _w = tidx() >> 6, _wm = _w % G_WM, _wn = _w / G_WM; \
    _Pragma("unroll") for (int _ft = 0; _ft < 2; ++_ft) _Pragma("unroll") for (int _tt = 0; _tt < 2; ++_tt) _Pragma("unroll") for (int _i = 0; _i < 4; ++_i) { \
        const int LROW = _wm * 64 + _tt * 32 + (_l & 31); const int FEAT = _wn * 64 + _ft * 32 + 8 * _i + 4 * (_l >> 5); \
        float V[4] = {acc[_ft][_tt][4 * _i], acc[_ft][_tt][4 * _i + 1], acc[_ft][_tt][4 * _i + 2], acc[_ft][_tt][4 * _i + 3]}; __VA_ARGS__ } } while (0)

struct RowId { int m0; DI long operator()(int r) const { return m0 + r; } };

template <int OUTMODE>
DI void mgemm_job(const MG& g, int M, int N, void* out, long ldo, int bid, int nblk, unsigned char* lds) {
    const int tm = M / G_BM, tn = N / G_BN;
    for (int u = bid; u < tm * tn; u += nblk) {
        const int grp = u / (16 * tn), rem = u % (16 * tn);
        const int gm = (tm - grp * 16) < 16 ? (tm - grp * 16) : 16;
        const int mt = grp * 16 + rem % gm, nt = rem / gm;
        const int m0 = mt * G_BM, n0 = nt * G_BN;
        f32x16 acc[2][2];
        mgemm_tile(g, n0, RowId{m0}, acc, lds);
        MG_FOREACH(acc, lrow, feat, v, {
            const long o = (long)(m0 + lrow) * ldo + n0 + feat;
            if (OUTMODE == 1) *(float4*)((float*)out + o) = make_float4(v[0], v[1], v[2], v[3]);
            else {
                if (OUTMODE == 2 && n0 + feat >= O_MG) { v[0] = sigm(v[0]); v[1] = sigm(v[1]); v[2] = sigm(v[2]); v[3] = sigm(v[3]); }
                st4bf((bf16_t*)out + o, v[0], v[1], v[2], v[3]);
            } });
    }
}

namespace pg8 {
#define PG8_LAS __attribute__((address_space(3)))
typedef float f32x4 __attribute__((ext_vector_type(4)));
constexpr int BM = 256, BK = 64, HALF = 128, HTB = HALF * BK * 2  , STAGE_BYTES = 8 * HTB, NXCD = 8, WGM = 8;
__host__ __device__ __forceinline__ int lds_byte(int r, int c) { const int st = (r >> 4) * 2 + (c >> 5), rr = r & 15, cc = c & 31, ob = rr * 64 + cc * 2; return st * 1024 + (ob ^ (((ob >> 9) & 1) << 5)); }
__host__ __device__ __forceinline__ void stage_rc(int b, int& R, int& C) { const int st = b / 1024, sb = b % 1024, swz = sb ^ (((sb >> 9) & 1) << 5); R = (st >> 1) * 16 + swz / 64; C = (st & 1) * 32 + (swz % 64) / 2; }
__host__ __device__ __forceinline__ int perm32(int rho) { const int n = rho >> 4, i = rho & 15; return 8 * (i >> 2) + 4 * n + (i & 3); }
struct Unit { int pm, pn, e; };
struct Gemm { const bf16_t* A; const bf16_t* Bt; int M, N, K; const int* rowidx; };
struct StaticOrder {
    int nM, nN, nwg, G, c;
    __device__ void init(int M, int N, int G_, int c_) { nM = M / BM; nN = N / BM; nwg = nM * nN; G = G_; c = c_; }
    __device__ bool next(int i, Unit& u) const {
        const long L = (long)i * G + c; if (L >= nwg) return false;
        int wgid = (int)L; { const int q = nwg / NXCD, r = nwg % NXCD, xcd = wgid % NXCD, off = wgid / NXCD; wgid = (xcd < r ? xcd * (q + 1) : r * (q + 1) + (xcd - r) * q) + off; }
        const int nig = WGM * nN, gid = wgid / nig, fm = gid * WGM, gsz = (nM - fm) < WGM ? (nM - fm) : WGM;
        u.pm = fm + ((wgid % nig) % gsz); u.pn = (wgid % nig) / gsz; u.e = 0; return true;
    }
    __device__ __forceinline__ void a_ready(const Unit&) const {}
    __device__ __forceinline__ void done(const Unit&) const {}
};
struct ListOrder {
    Unit u0, u1, u2; int n;
    __device__ bool next(int i, Unit& u) const { if (i >= n) return false; u = (i == 0) ? u0 : ((i == 1) ? u1 : u2); return true; }
    __device__ __forceinline__ void a_ready(const Unit&) const {}
    __device__ __forceinline__ void done(const Unit&) const {}
};
template <class Epi, class Sched, bool ALIGN_EPI = false, bool SP2 = false, bool GATHER = false>
__device__ __forceinline__ void gemm_phase(PG8_LAS unsigned char* lds, const Gemm g, const Sched& S, const Epi& E) {
    const int tid = tidx(), wid = __builtin_amdgcn_readfirstlane(tid >> 6), lane = tid & 63, wr = wid >> 2, wc = wid & 3, fr = lane & 15, fq = lane >> 4;
    const int K = g.K, nt = K / BK;
    unsigned voffA[2], voffB[2];
#pragma unroll
    for (int i = 0; i < 2; ++i) { int R, C; stage_rc(tid * 16 + i * 8192, R, C); const int Rb = Epi::PERM ? ((R & ~31) + perm32(R & 31)) : R;
        voffA[i] = (unsigned)(R * K + C) * 2u; voffB[i] = (unsigned)(Rb * K + C) * 2u; }
    unsigned voffC[2][2] = {{0u, 0u}, {0u, 0u}}, voffN[2][2] = {{0u, 0u}, {0u, 0u}};
    auto gather_offs = [&](int pm, unsigned (&vo)[2][2]) {
#pragma unroll
        for (int hh = 0; hh < 2; ++hh)
#pragma unroll
            for (int i = 0; i < 2; ++i) { int R, C; stage_rc(tid * 16 + i * 8192, R, C); int a = g.rowidx[pm * BM + hh * HALF + R]; a = a < 0 ? 0 : (a >> 1); vo[hh][i] = (unsigned)(a * K + C) * 2u; }
    };
    const size_t kstep = (size_t)(BK * 2);
    const size_t hstep = (size_t)HALF * K * 2;
    const size_t tstep = 2 * hstep;
    const size_t estep = (size_t)g.N * K * 2;
    const unsigned ldsw = (unsigned)wid * 1024u;
    const int aoff = lds_byte(wr * 64 + fr, fq * 8), boff = lds_byte(wc * 32 + fr, fq * 8);
#define PG8_SA(b, h) (((b) * 2 + (h)) * HTB)
#define PG8_SB(b, h) ((4 + (b) * 2 + (h)) * HTB)
#define PG8_STAGE(bufoff, gbase, voff) do { _Pragma("unroll") for (int _i = 0; _i < 2; ++_i) \
        __builtin_amdgcn_global_load_lds((const unsigned*)((const char*)(gbase) + (voff)[_i]), (PG8_LAS unsigned*)(lds + (bufoff) + ldsw + _i * 8192), 16, 0, 0); } while (0)
#define PG8_STAGE_A(bufoff, HH, KT, NX, densebase) do { if constexpr (GATHER) { const char* _gb = (const char*)g.A + (size_t)(KT) * kstep; if (NX) PG8_STAGE(bufoff, _gb, voffN[HH]); else PG8_STAGE(bufoff, _gb, voffC[HH]); } else PG8_STAGE(bufoff, densebase, voffA); } while (0)
#define PG8_LDA(dst, b, h) do { _Pragma("unroll") for (int m = 0; m < 4; ++m) _Pragma("unroll") for (int k = 0; k < 2; ++k) dst[m][k] = *(const PG8_LAS bf16x8*)(lds + PG8_SA(b, h) + aoff + m * 2048 + k * 1024); } while (0)
#define PG8_LDB(dst, b, h) do { _Pragma("unroll") for (int n = 0; n < 2; ++n) _Pragma("unroll") for (int k = 0; k < 2; ++k) dst[n][k] = *(const PG8_LAS bf16x8*)(lds + PG8_SB(b, h) + boff + n * 2048 + k * 1024); } while (0)
#define PG8_MMA(ai, bj, At, Bt) do { __builtin_amdgcn_s_setprio(1); _Pragma("unroll") for (int m = 0; m < 4; ++m) _Pragma("unroll") for (int n = 0; n < 2; ++n) _Pragma("unroll") for (int k = 0; k < 2; ++k) \
        acc[ai][bj][m][n] = __builtin_amdgcn_mfma_f32_16x16x32_bf16(Bt[n][k], At[m][k], acc[ai][bj][m][n], 0, 0, 0); __builtin_amdgcn_s_setprio(0); } while (0)
#define PG8_WAIT_V(n) asm volatile("s_waitcnt vmcnt(" #n ")" ::: "memory")
#define PG8_WAIT_L(n) asm volatile("s_waitcnt lgkmcnt(" #n ")" ::: "memory")
#define PG8_BAR __builtin_amdgcn_s_barrier()
#define PG8_SCHED __builtin_amdgcn_sched_barrier(0)
    Unit cur, nxt; int ui = 0;
    if (!S.next(0, cur)) return;
    f32x4 acc[2][2][4][2];
#pragma unroll
    for (int a = 0; a < 2; ++a)
#pragma unroll
        for (int b = 0; b < 2; ++b)
#pragma unroll
            for (int m = 0; m < 4; ++m)
#pragma unroll
                for (int n = 0; n < 2; ++n) acc[a][b][m][n] = (f32x4){0.f, 0.f, 0.f, 0.f};
    bf16x8 At[4][2], B0[2][2], B1[2][2];
    const char* cA = (const char*)g.A + (size_t)cur.pm * tstep; const char* cB = (const char*)g.Bt + (size_t)cur.e * estep + (size_t)cur.pn * tstep;
    S.a_ready(cur);
    if constexpr (GATHER) gather_offs(cur.pm, voffC);
    if constexpr (SP2) {
        PG8_STAGE(PG8_SB(0, 0), cB, voffB); PG8_STAGE(PG8_SB(0, 1), cB + hstep, voffB); PG8_STAGE_A(PG8_SA(0, 0), 0, 0, false, cA); PG8_STAGE_A(PG8_SA(0, 1), 1, 0, false, cA + hstep);
        if (wr == 1) PG8_BAR;
        PG8_WAIT_V(2); PG8_BAR;
        PG8_STAGE(PG8_SB(1, 0), cB + kstep, voffB); PG8_STAGE_A(PG8_SA(1, 0), 0, 1, false, cA + kstep); PG8_STAGE(PG8_SB(1, 1), cB + hstep + kstep, voffB);
        PG8_WAIT_V(6); PG8_BAR;
    } else {
        PG8_STAGE(PG8_SB(0, 0), cB, voffB); PG8_STAGE_A(PG8_SA(0, 0), 0, 0, false, cA); PG8_STAGE(PG8_SB(0, 1), cB + hstep, voffB); PG8_STAGE_A(PG8_SA(0, 1), 1, 0, false, cA + hstep);
        if (wr == 1) PG8_BAR;
        PG8_WAIT_V(4); PG8_BAR;
        PG8_STAGE(PG8_SB(1, 0), cB + kstep, voffB); PG8_STAGE_A(PG8_SA(1, 0), 0, 1, false, cA + kstep); PG8_STAGE(PG8_SB(1, 1), cB + hstep + kstep, voffB);
        PG8_WAIT_V(6); PG8_BAR;
    }
    for (;;) {
        const bool has_next = S.next(ui + 1, nxt);
        if constexpr (GATHER) { if (has_next) gather_offs(nxt.pm, voffN); else {
#pragma unroll
            for (int hh = 0; hh < 2; ++hh) { voffN[hh][0] = voffC[hh][0]; voffN[hh][1] = voffC[hh][1]; } } }
        const char* nA = has_next ? (const char*)g.A + (size_t)nxt.pm * tstep : cA; const char* nB = has_next ? (const char*)g.Bt + (size_t)nxt.e * estep + (size_t)nxt.pn * tstep : cB;
        for (int t = 0; t < nt; t += 2) {
            const bool last = (t == nt - 2);
            const char* a1 = cA + (size_t)(t + 1) * kstep;
            const char* a2 = last ? nA : cA + (size_t)(t + 2) * kstep; const char* b2 = last ? nB : cB + (size_t)(t + 2) * kstep;
            const char* a3 = a2 + kstep; const char* b3 = b2 + kstep;
            if (last && has_next) S.a_ready(nxt);
            if constexpr (SP2) {
            PG8_LDB(B0, 0, 0); PG8_LDB(B1, 0, 1); PG8_SCHED; PG8_LDA(At, 0, 0); PG8_STAGE_A(PG8_SA(1, 1), 1, t + 1, false, a1 + hstep);
            PG8_WAIT_V(8); PG8_WAIT_L(0); PG8_BAR; PG8_MMA(0, 0, At, B0); PG8_MMA(0, 1, At, B1); PG8_BAR; PG8_SCHED;
            PG8_LDA(At, 0, 1); PG8_STAGE(PG8_SB(0, 0), b2, voffB); PG8_STAGE(PG8_SB(0, 1), b2 + hstep, voffB); PG8_STAGE_A(PG8_SA(0, 0), 0, (last ? 0 : t + 2), last, a2);
            PG8_WAIT_V(8); PG8_WAIT_L(0); PG8_BAR; PG8_MMA(1, 0, At, B0); PG8_MMA(1, 1, At, B1); PG8_BAR; PG8_SCHED;
            PG8_LDB(B0, 1, 0); PG8_LDB(B1, 1, 1); PG8_SCHED; PG8_LDA(At, 1, 0); PG8_STAGE_A(PG8_SA(0, 1), 1, (last ? 0 : t + 2), last, a2 + hstep);
            PG8_WAIT_V(8); PG8_WAIT_L(0); PG8_BAR; PG8_MMA(0, 0, At, B0); PG8_MMA(0, 1, At, B1); PG8_BAR; PG8_SCHED;
            PG8_LDA(At, 1, 1); PG8_STAGE(PG8_SB(1, 0), b3, voffB); PG8_STAGE(PG8_SB(1, 1), b3 + hstep, voffB); PG8_STAGE_A(PG8_SA(1, 0), 0, (last ? 1 : t + 3), last, a3);
            PG8_WAIT_V(8); PG8_WAIT_L(0); PG8_BAR; PG8_MMA(1, 0, At, B0); PG8_MMA(1, 1, At, B1); PG8_BAR; PG8_SCHED;
            } else {
            PG8_LDB(B0, 0, 0); PG8_SCHED; PG8_LDA(At, 0, 0); PG8_STAGE_A(PG8_SA(1, 1), 1, t + 1, false, a1 + hstep);
            PG8_WAIT_L(8); PG8_BAR; PG8_WAIT_L(0); PG8_MMA(0, 0, At, B0); PG8_BAR; PG8_SCHED;
            PG8_LDB(B1, 0, 1); PG8_STAGE(PG8_SB(0, 0), b2, voffB);
            PG8_BAR; PG8_WAIT_L(0); PG8_MMA(0, 1, At, B1); PG8_BAR;
            PG8_LDA(At, 0, 1); PG8_STAGE_A(PG8_SA(0, 0), 0, (last ? 0 : t + 2), last, a2);
            PG8_BAR; PG8_WAIT_L(0); PG8_MMA(1, 0, At, B0); PG8_BAR; PG8_SCHED;
            PG8_STAGE(PG8_SB(0, 1), b2 + hstep, voffB);
            PG8_WAIT_V(6); PG8_BAR; PG8_MMA(1, 1, At, B1); PG8_BAR;
            PG8_LDB(B0, 1, 0); PG8_SCHED; PG8_LDA(At, 1, 0); PG8_STAGE_A(PG8_SA(0, 1), 1, (last ? 0 : t + 2), last, a2 + hstep);
            PG8_WAIT_L(8); PG8_BAR; PG8_WAIT_L(0); PG8_MMA(0, 0, At, B0); PG8_BAR; PG8_SCHED;
            PG8_LDB(B1, 1, 1); PG8_STAGE(PG8_SB(1, 0), b3, voffB);
            PG8_BAR; PG8_WAIT_L(0); PG8_MMA(0, 1, At, B1); PG8_BAR;
            PG8_LDA(At, 1, 1); PG8_STAGE_A(PG8_SA(1, 0), 0, (last ? 1 : t + 3), last, a3);
            PG8_BAR; PG8_WAIT_L(0); PG8_MMA(1, 0, At, B0); PG8_BAR; PG8_SCHED;
            PG8_STAGE(PG8_SB(1, 1), b3 + hstep, voffB);
            PG8_WAIT_V(6); PG8_BAR; PG8_MMA(1, 1, At, B1); PG8_BAR;
            }
        }
        if constexpr (ALIGN_EPI) { if (wr == 0) PG8_BAR; }
        if constexpr (!Epi::AFTER_DRAIN) { E(acc, cur, wr, wc, fr, fq); S.done(cur); }
        if (!has_next) break;
#pragma unroll
        for (int a = 0; a < 2; ++a)
#pragma unroll
            for (int b = 0; b < 2; ++b)
#pragma unroll
                for (int m = 0; m < 4; ++m)
#pragma unroll
                    for (int n = 0; n < 2; ++n) acc[a][b][m][n] = (f32x4){0.f, 0.f, 0.f, 0.f};
        cur = nxt; cA = nA; cB = nB; ++ui;
        if constexpr (GATHER) {
#pragma unroll
            for (int hh = 0; hh < 2; ++hh) { voffC[hh][0] = voffN[hh][0]; voffC[hh][1] = voffN[hh][1]; } }
        if constexpr (ALIGN_EPI) { if (wr == 1) PG8_BAR; }
    }
    PG8_WAIT_V(0);
    if constexpr (!ALIGN_EPI) { if (wr == 0) PG8_BAR; }
    PG8_BAR;
    if constexpr (Epi::AFTER_DRAIN) { E.fused(acc, cur, wr, wc, fr, fq, lds, wid, lane); S.done(cur); }
#undef PG8_SA
#undef PG8_SB
#undef PG8_STAGE
#undef PG8_STAGE_A
#undef PG8_LDA
#undef PG8_LDB
#undef PG8_MMA
#undef PG8_WAIT_V
#undef PG8_WAIT_L
#undef PG8_BAR
#undef PG8_SCHED
}
}

struct EpiStoreBf16 {
    static constexpr bool PERM = true, AFTER_DRAIN = false;
    bf16_t* O; long ldo; int gate_from; long estride;
    __device__ __forceinline__ void operator()(const pg8::f32x4 (&acc)[2][2][4][2], const pg8::Unit& u, int wr, int wc, int fr, int fq) const {
        bf16_t* base = O + (long)u.e * estride;
#pragma unroll
        for (int ai = 0; ai < 2; ++ai)
#pragma unroll
            for (int m = 0; m < 4; ++m) {
                const long row = (long)u.pm * 256 + ai * 128 + wr * 64 + m * 16 + fr;
#pragma unroll
                for (int bj = 0; bj < 2; ++bj) {
                    pg8::f32x4 v0 = acc[ai][bj][m][0], v1 = acc[ai][bj][m][1];
                    if (u.pn * 2 + bj >= gate_from) {
#pragma unroll
                        for (int j = 0; j < 4; ++j) { v0[j] = sigm_fast(v0[j]); v1[j] = sigm_fast(v1[j]); }
                    }
                    u32x4 wv; wv[0] = pk_bf16(v0[0], v0[1]); wv[1] = pk_bf16(v0[2], v0[3]); wv[2] = pk_bf16(v1[0], v1[1]); wv[3] = pk_bf16(v1[2], v1[3]);
                    *(u32x4*)(base + row * ldo + u.pn * 256 + bj * 128 + wc * 32 + 8 * fq) = wv;
                }
            }
    }
};
struct EpiStoreF32 {
    static constexpr bool PERM = false, AFTER_DRAIN = false;
    float* O; long ldo;
    __device__ __forceinline__ void operator()(const pg8::f32x4 (&acc)[2][2][4][2], const pg8::Unit& u, int wr, int wc, int fr, int fq) const {
#pragma unroll
        for (int ai = 0; ai < 2; ++ai)
#pragma unroll
            for (int m = 0; m < 4; ++m) {
                const long row = (long)u.pm * 256 + ai * 128 + wr * 64 + m * 16 + fr;
#pragma unroll
                for (int bj = 0; bj < 2; ++bj)
#pragma unroll
                    for (int n = 0; n < 2; ++n) *(pg8::f32x4*)(O + row * ldo + u.pn * 256 + bj * 128 + wc * 32 + 16 * n + 4 * fq) = acc[ai][bj][m][n];
            }
    }
};
struct EpiMoeGU {
    static constexpr bool PERM = true, AFTER_DRAIN = false;
    bf16_t* HH;
    __device__ __forceinline__ void operator()(const pg8::f32x4 (&acc)[2][2][4][2], const pg8::Unit& u, int wr, int wc, int fr, int fq) const {
#pragma unroll
        for (int ai = 0; ai < 2; ++ai)
#pragma unroll
            for (int m = 0; m < 4; ++m) {
                const long row = (long)u.pm * 256 + ai * 128 + wr * 64 + m * 16 + fr;
                float hv[8];
#pragma unroll
                for (int n = 0; n < 2; ++n)
#pragma unroll
                    for (int j = 0; j < 4; ++j) { const float gt = acc[ai][0][m][n][j], up = acc[ai][1][m][n][j]; hv[4 * n + j] = gt * sigm_fast(gt) * up; }
                u32x4 wv; wv[0] = pk_bf16(hv[0], hv[1]); wv[1] = pk_bf16(hv[2], hv[3]); wv[2] = pk_bf16(hv[4], hv[5]); wv[3] = pk_bf16(hv[6], hv[7]);
                *(u32x4*)(HH + row * 512 + u.pn * 128 + wc * 32 + 8 * fq) = wv;
            }
    }
};
struct EpiMoeDown {
    static constexpr bool PERM = true, AFTER_DRAIN = false;
    const int* perm; const float* ew; bf16_t* YK;
    __device__ __forceinline__ void operator()(const pg8::f32x4 (&acc)[2][2][4][2], const pg8::Unit& u, int wr, int wc, int fr, int fq) const {
#pragma unroll
        for (int ai = 0; ai < 2; ++ai)
#pragma unroll
            for (int m = 0; m < 4; ++m) {
                const int a = perm[u.pm * 256 + ai * 128 + wr * 64 + m * 16 + fr];
                if (a >= 0) {
                    const float sw = ew[a];
#pragma unroll
                    for (int bj = 0; bj < 2; ++bj) {
                        const pg8::f32x4 v0 = acc[ai][bj][m][0] * sw, v1 = acc[ai][bj][m][1] * sw;
                        u32x4 wv; wv[0] = pk_bf16(v0[0], v0[1]); wv[1] = pk_bf16(v0[2], v0[3]); wv[2] = pk_bf16(v1[0], v1[1]); wv[3] = pk_bf16(v1[2], v1[3]);
                        *(u32x4*)(YK + (long)a * 1024 + u.pn * 256 + bj * 128 + wc * 32 + 8 * fq) = wv;
                    }
                }
            }
    }
};
struct GroupedOrder {
    int nM, nN, nE, G, c;
    __device__ bool next(int i, pg8::Unit& u) const { const int L = i * G + c; if (L >= nM * nN * nE) return false; u.e = L / (nM * nN); const int rm = L % (nM * nN); u.pm = rm / nN; u.pn = rm % nN; return true; }
    __device__ __forceinline__ void a_ready(const pg8::Unit&) const {}
    __device__ __forceinline__ void done(const pg8::Unit&) const {}
};

struct LayerW {
    const float *cmp_pos, *conv_w, *conv_b, *ga_b, *gx_b, *lam, *q_norm, *kv_norm,
        *ln1_g, *ln1_b, *ln2_g, *ln2_b, *rg_b, *re_b, *ln3_g, *ln3_b;
    const bf16_t *t_in, *t_br, *t_out, *t_q, *t_o, *t_gu, *t_dn, *t_c1, *t_c2, *t_uq, *t_ukv, *t_g, *t_rh, *t_rl;
};
#define WSF(off) ((float*)(p.ws + (off)))
#define WSI(off) ((int*)(p.ws + (off)))
#define WSU(off) ((unsigned*)(p.ws + (off)))
#define WSB(off) ((bf16_t*)(p.ws + (off)))
DI LayerW layer_w(const Params& p, int l) {
    LayerW w;
    w.cmp_pos = p.in[3] + (size_t)l * 2 * 32 * 64;
    w.conv_w = p.in[6] + (size_t)l * 4 * 256;
    w.conv_b = p.in[7] + (size_t)l * 256;
    w.ga_b = p.in[9] + (size_t)l * 256;
    w.gx_b = p.in[11] + (size_t)l * 256;
    w.lam = p.in[12] + (size_t)l * 256;
    w.q_norm = p.in[13] + (size_t)l * 192;
    w.kv_norm = p.in[14] + (size_t)l * 128;
    w.ln1_g = p.in[19] + (size_t)l * 1024; w.ln1_b = p.in[20] + (size_t)l * 1024;
    w.ln2_g = p.in[24] + (size_t)l * 1024; w.ln2_b = p.in[25] + (size_t)l * 1024;
    w.rg_b = p.in[27] + (size_t)l * 4;
    w.re_b = p.in[29] + (size_t)l * 32;
    w.ln3_g = p.in[32] + (size_t)l * 1024; w.ln3_b = p.in[33] + (size_t)l * 1024;
    w.t_in = WSB(WT_IN) + (size_t)l * NH * 1024;
    w.t_br = WSB(WT_BR) + (size_t)l * 1024 * 1024;
    w.t_out = WSB(WT_OUT) + (size_t)l * 1024 * 1024;
    w.t_q = WSB(WT_Q) + (size_t)l * 512 * 1024;
    w.t_o = WSB(WT_O) + (size_t)l * 1024 * 512;
    w.t_gu = WSB(WT_GU) + (size_t)l * 32 * 1024 * 1024;
    w.t_dn = WSB(WT_DN) + (size_t)l * 32 * 1024 * 512;
    w.t_c1 = WSB(WT_C1) + (size_t)l * 2 * 256 * 2048;
    w.t_c2 = WSB(WT_C2) + (size_t)l * 2 * 128 * 256;
    w.t_uq = WSB(WT_UQ) + (size_t)l * 384 * 192;
    w.t_ukv = WSB(WT_UKV) + (size_t)l * 512 * 128;
    w.t_g = WSB(WT_G) + (size_t)l * 4 * 128 * 64;
    w.t_rh = WSB(WT_RH) + (size_t)l * 128 * 1024;
    w.t_rl = WSB(WT_RL) + (size_t)l * 128 * 1024;
    return w;
}

template <int MODE>
DI int wt_col(int np, int Nsrc) {
    if (MODE == 0) return np < Nsrc ? np : -1;
    if (MODE == 2) return np < 1024 ? np : (np < 2656 ? np + 12 : (np < 2668 ? 1024 + (np - 2656) : (np < 2688 ? -1 : (np < 6784 ? np - 20 : -1))));
    const int pn = np >> 8, bj = (np >> 7) & 1, q = np & 127; return (bj ? 512 : 0) + 128 * pn + q;
}
template <int MODE>
DI void job_wt(const float* src, int nmat, int K, int Nsrc, bf16_t* dst, int Npad, int bid, int nblk, unsigned char* lds) {
    const int lane = tidx() & 63, wid = tidx() >> 6;
    bf16_t* tile = (bf16_t*)lds + wid * (64 * 72);
    const int tk = K / 64, tn = Npad / 64;
    const int tk2 = (tk + 1) / 2, tn4 = (tn + 3) / 4, per = tk2 * tn4;
    const int kl = lane >> 4, n4 = (lane & 15) * 4;
    for (int ub = bid; ub < nmat * per; ub += nblk) {
        const int mat = ub / per, ru = ub % per, kt = (ru % tk2) * 2 + (wid & 1), nt = (ru / tk2) * 4 + (wid >> 1);
        if (kt >= tk || nt >= tn) continue;
        const int k0 = kt * 64, n0 = nt * 64;
        const float* s = src + (size_t)mat * K * Nsrc;
        bf16_t* d = dst + (size_t)mat * Npad * K;
        const int col = wt_col<MODE>(n0 + n4, Nsrc);
        float4 v[16];
#pragma unroll
        for (int ps = 0; ps < 16; ++ps) v[ps] = col >= 0 ? *(const float4*)(s + (size_t)(k0 + kl + 4 * ps) * Nsrc + col) : make_float4(0.f, 0.f, 0.f, 0.f);
#pragma unroll
        for (int ps = 0; ps < 16; ++ps) { const int k = kl + 4 * ps;
            tile[(n4 + 0) * 72 + k] = f2bf(v[ps].x); tile[(n4 + 1) * 72 + k] = f2bf(v[ps].y); tile[(n4 + 2) * 72 + k] = f2bf(v[ps].z); tile[(n4 + 3) * 72 + k] = f2bf(v[ps].w); }
        __builtin_amdgcn_fence(__ATOMIC_RELEASE, "wavefront"); __builtin_amdgcn_wave_barrier(); __builtin_amdgcn_fence(__ATOMIC_ACQUIRE, "wavefront");
#pragma unroll
        for (int c8 = 0; c8 < 8; ++c8) { const int c = lane + 64 * c8, n2 = c >> 3, kc = (c & 7) * 8;
            *(uint4*)(d + (size_t)(n0 + n2) * K + k0 + kc) = *(const uint4*)(tile + n2 * 72 + kc); }
        __builtin_amdgcn_fence(__ATOMIC_RELEASE, "wavefront"); __builtin_amdgcn_wave_barrier(); __builtin_amdgcn_fence(__ATOMIC_ACQUIRE, "wavefront");
    }
}
DI void job_cvt(const float* src, bf16_t* dst, long n, int bid, int nblk) {
    for (long e = ((long)bid * NT + tidx()) * 4; e < n; e += (long)nblk * NT * 4) {
        const float4 v = *(const float4*)(src + e);
        st4bf(dst + e, v.x, v.y, v.z, v.w);
    }
}
DI void job_cmp_gather(const Params& p, const LayerW& w, int bid, int nblk) {
    const bf16_t* H = WSB(WS_H); bf16_t* TB = WSB(WS_TBB);
    const long total = (long)2 * NCR * 2048 / 8;
    for (long e = (long)bid * NT + tidx(); e < total; e += (long)nblk * NT) {
        const long e8 = e * 8;
        const int f = (int)(e8 % 2048); const long r2 = e8 / 2048; const int r = (int)(r2 % NCR), j = (int)(r2 / NCR);
        const int g = r & 1, bc = r >> 1, c = bc % NCMP, b = bc / NCMP, i = f >> 6, d = f & 63;
        float hv[8];
        ld8f(H + (long)(b * SEQ + 16 * c + i) * NH + (j ? O_AVC : O_AKC) + g * 64 + d, hv);
        const float4 p0 = *(const float4*)(w.cmp_pos + (j * 32 + i) * 64 + d), p1 = *(const float4*)(w.cmp_pos + (j * 32 + i) * 64 + d + 4);
        hv[0] += p0.x; hv[1] += p0.y; hv[2] += p0.z; hv[3] += p0.w; hv[4] += p1.x; hv[5] += p1.y; hv[6] += p1.z; hv[7] += p1.w;
        st8bf(TB + ((long)j * 2048 + r) * 2048 + f, hv);
    }
}
DI void job_rnn_conv(const Params& p, const LayerW& w, int bid, int nblk) {
    const bf16_t* H = WSB(WS_H); float* U = WSF(WS_U); bf16_t* UB = WSB(WS_UB);
    for (long e = (long)bid * NT + tidx(); e < (long)T * 64; e += (long)nblk * NT) {
        const int ch = (int)(e & 63) * 4; const int t = (int)(e >> 6), s = t & (SEQ - 1);
        const float4 cb = *(const float4*)(w.conv_b + ch);
        float u0 = cb.x, u1 = cb.y, u2 = cb.z, u3 = cb.w;
#pragma unroll
        for (int tap = 0; tap < 4; ++tap) { const int sp = s - 3 + tap;
            if (sp >= 0) { const float4 hv = ld4bf(H + (long)(t - 3 + tap) * NH + O_CX + ch); const float4 cw = *(const float4*)(w.conv_w + tap * 256 + ch);
                u0 += hv.x * cw.x; u1 += hv.y * cw.y; u2 += hv.z * cw.z; u3 += hv.w * cw.w; } }
        *(float4*)(U + (long)t * 256 + ch) = make_float4(u0, u1, u2, u3); st4bf(UB + (long)t * 256 + ch, u0, u1, u2, u3);
    }
}
DI void job_rnn_gates(const Params& p, const LayerW& w, int bid, int nblk, unsigned char* lds) {
    const float* U = WSF(WS_U); float* RA = WSF(WS_RA); float* RB = WSF(WS_RB);
    for (int u = bid; u < (T / G_BM) * 4; u += nblk) {
        const int blk = u & 3, m0 = (u >> 2) * G_BM;
        MG g; g.A = WSB(WS_UB) + blk * 64; g.lda = 256; g.Wt = w.t_g + (size_t)blk * 128 * 64; g.ldw = 64; g.K = 64;
        f32x16 acc[2][2];
        mgemm_tile(g, 0, RowId{m0}, acc, lds);
        const int l = tidx() & 63, wv = tidx() >> 6, wm = wv % G_WM, wn = wv / G_WM;
#pragma unroll
        for (int tt = 0; tt < 2; ++tt)
#pragma unroll
            for (int i = 0; i < 4; ++i) {
                const long t = m0 + wm * 64 + tt * 32 + (l & 31); const int ch = blk * 64 + wn * 32 + 8 * i + 4 * (l >> 5);
                const float4 uv = *(const float4*)(U + t * 256 + ch);
                const float ua[4] = {uv.x, uv.y, uv.z, uv.w};
                float av[4], bv[4];
#pragma unroll
                for (int j = 0; j < 4; ++j) {
                    const float r = sigm_fast(acc[0][tt][4 * i + j] + w.ga_b[ch + j]), ig = sigm_fast(acc[1][tt][4 * i + j] + w.gx_b[ch + j]);
                    const float nl = -w.lam[ch + j];
                    const float sp = fmaxf(nl, 0.f) + __logf(1.f + __expf(-fabsf(nl)));
                    const float log_a = -8.0f * r * sp;
                    const float a = __expf(log_a);
                    av[j] = a; bv[j] = __builtin_amdgcn_sqrtf(fmaxf(1.f - a * a, 0.f)) * (ig * ua[j]);
                }
                *(float4*)(RA + t * 256 + ch) = make_float4(av[0], av[1], av[2], av[3]);
                *(float4*)(RB + t * 256 + ch) = make_float4(bv[0], bv[1], bv[2], bv[3]);
            }
    }
}
DI void job_rnn_scan1(const Params& p, int bid, int nblk) {
    const float* RA = WSF(WS_RA); const float* RB = WSF(WS_RB); float* SA = WSF(WS_SA); float* SH = WSF(WS_SH);
    for (int e = bid * NT + tidx(); e < BATCH * 32 * 256; e += nblk * NT) {
        const int ch = e & 255, bc = e >> 8;
        float ap = 1.f, hl = 0.f;
        for (int s0 = 0; s0 < 64; s0 += 8) {
            float av[8], bv[8];
#pragma unroll
            for (int i = 0; i < 8; ++i) { const long t = (long)bc * 64 + s0 + i; av[i] = RA[t * 256 + ch]; bv[i] = RB[t * 256 + ch]; }
#pragma unroll
            for (int i = 0; i < 8; ++i) { ap *= av[i]; hl = av[i] * hl + bv[i]; }
        }
        SA[e] = ap; SH[e] = hl;
    }
}
DI void job_rnn_scan2(const Params& p, int bid, int nblk) {
    const bf16_t* H = WSB(WS_H); const float* RA = WSF(WS_RA); const float* RB = WSF(WS_RB); const float* SA = WSF(WS_SA); const float* SH = WSF(WS_SH); bf16_t* BR = WSB(WS_BR);
    for (int e = bid * NT + tidx(); e < BATCH * 32 * 256; e += nblk * NT) {
        const int ch = e & 255, bc = e >> 8, chunk = bc & 31, b = bc >> 5;
        float h = 0.f;
#pragma unroll
        for (int c0 = 0; c0 < 32; c0 += 8) {
            float sa[8], sh[8];
#pragma unroll
            for (int i = 0; i < 8; ++i) { const int q = ((b * 32 + c0 + i) << 8) + ch; sa[i] = SA[q]; sh[i] = SH[q]; }
#pragma unroll
            for (int i = 0; i < 8; ++i) h = (c0 + i < chunk) ? sa[i] * h + sh[i] : h;
        }
        for (int s0 = 0; s0 < 64; s0 += 8) {
            float av[8], bv[8], gv[8];
#pragma unroll
            for (int i = 0; i < 8; ++i) { const long t = (long)bc * 64 + s0 + i; av[i] = RA[t * 256 + ch]; bv[i] = RB[t * 256 + ch]; gv[i] = bf2f(H[t * NH + O_CG + ch]); }
#pragma unroll
            for (int i = 0; i < 8; ++i) { const long t = (long)bc * 64 + s0 + i; h = av[i] * h + bv[i]; BR[t * 1024 + 2 * 256 + ch] = f2bf(h * gelu_tanh(gv[i])); }
        }
    }
}
DI void job_mla_norm(const Params& p, const LayerW& w, int bid, int nblk) {
    const bf16_t* H = WSB(WS_H); bf16_t* CQN = WSB(WS_CQNB); bf16_t* CKVN = WSB(WS_CKVNB); bf16_t* KM = WSB(WS_KM);
    const int lane = tidx() & 63, wid = tidx() >> 6;
    const bool isq = lane < 24, iskv = lane >= 32 && lane < 48;
    const int coff = isq ? O_DCQ + lane * 8 : O_DCKV + (lane - 32) * 8;
    float gn[8];
#pragma unroll
    for (int j = 0; j < 8; ++j) gn[j] = isq ? w.q_norm[lane * 8 + j] : (iskv ? w.kv_norm[(lane - 32) * 8 + j] : 0.f);
    for (int t = bid * (NT / 64) + wid; t < T; t += nblk * (NT / 64)) {
        const bf16_t* hr = H + (long)t * NH;
        float v[8];
        float ss = 0.f;
        if (isq || iskv) { ld8f(hr + coff, v);
#pragma unroll
            for (int j = 0; j < 8; ++j) ss += v[j] * v[j]; }
        const float sq = wave_sum(isq ? ss : 0.f), skv = wave_sum(iskv ? ss : 0.f);
        const float rs = isq ? rsqrtf(sq * (1.f / 192.f) + 1e-6f) : rsqrtf(skv * (1.f / 128.f) + 1e-6f);
        if (isq || iskv) {
#pragma unroll
            for (int j = 0; j < 8; ++j) v[j] = v[j] * rs * gn[j];
            if (isq) st8bf(CQN + (long)t * 192 + lane * 8, v); else st8bf(CKVN + (long)t * 128 + (lane - 32) * 8, v);
        }
        {
            const int i = lane & 15, hd = lane >> 4;
            const int s = t & (SEQ - 1);
            const float2 csn = *(const float2*)(WSF(WS_ROPE) + (s * 16 + i) * 2); const float cs = csn.x, sn = csn.y;
            const float x1 = bf2f(hr[O_DKR + i]), x2 = bf2f(hr[O_DKR + 16 + i]);
            KM[(long)t * 384 + hd * 96 + 64 + i] = f2bf(x1 * cs - x2 * sn);
            KM[(long)t * 384 + hd * 96 + 80 + i] = f2bf(x1 * sn + x2 * cs);
        }
    }
}
DI void job_mla_up(const Params& p, const LayerW& w, int bid, int nblk, unsigned char* lds) {
    bf16_t* QB = WSB(WS_QB); bf16_t* KM = WSB(WS_KM); bf16_t* VM = WSB(WS_VM);
    constexpr int TM = T / G_BM;
    for (int u = bid; u < TM * 7; u += nblk) {
        const int mt = u / 7, nt = u % 7, m0 = mt * G_BM;
        f32x16 acc[2][2];
        const int l = tidx() & 63, wv = tidx() >> 6, wm = wv % G_WM, wn = wv / G_WM, hh = l >> 5;
        if (nt < 3) {
            MG g; g.A = WSB(WS_CQNB); g.lda = 192; g.Wt = w.t_uq; g.ldw = 192; g.K = 192;
            const int n0 = nt * 128;
            mgemm_tile(g, n0, RowId{m0}, acc, lds);
#pragma unroll
            for (int ft = 0; ft < 2; ++ft) {
                const int fb = (n0 + wn * 64 + ft * 32) >> 5;
                if (fb % 3 == 2) {
#pragma unroll
                    for (int tt = 0; tt < 2; ++tt) {
                        const int pos = (m0 + wm * 64 + tt * 32 + (l & 31)) & (SEQ - 1);
#pragma unroll
                        for (int i = 0; i < 2; ++i)
#pragma unroll
                            for (int j = 0; j < 4; ++j) {
                                const int fi = 8 * i + 4 * hh + j;
                                const float2 csn = *(const float2*)(WSF(WS_ROPE) + (pos * 16 + fi) * 2); const float cs = csn.x, sn = csn.y;
                                const float x1 = acc[ft][tt][4 * i + j], x2 = acc[ft][tt][4 * (i + 2) + j];
                                acc[ft][tt][4 * i + j] = x1 * cs - x2 * sn; acc[ft][tt][4 * (i + 2) + j] = x1 * sn + x2 * cs;
                            }
                    }
                }
            }
            MG_FOREACH(acc, lrow, feat, v, { st4bf(QB + (long)(m0 + lrow) * 384 + n0 + feat, v[0], v[1], v[2], v[3]); });
        } else {
            MG g; g.A = WSB(WS_CKVNB); g.lda = 128; g.Wt = w.t_ukv; g.ldw = 128; g.K = 128;
            const int n0 = (nt - 3) * 128;
            mgemm_tile(g, n0, RowId{m0}, acc, lds);
            MG_FOREACH(acc, lrow, feat, v, {
                const int hd = nt - 3;
                if (feat < 64) st4bf(KM + (long)(m0 + lrow) * 384 + hd * 96 + feat, v[0], v[1], v[2], v[3]);
                else st4bf(VM + (long)(m0 + lrow) * 256 + hd * 64 + (feat - 64), v[0], v[1], v[2], v[3]); });
        }
    }
}
template <int STAGE>
DI void job_cmp_mlp(const Params& p, const LayerW& w, int bid, int nblk, unsigned char* lds) {
    constexpr int TM = 2048 / G_BM, TN = STAGE == 0 ? 2 : 1;
    for (int u = bid; u < 2 * TM * TN; u += nblk) {
        const int j = u / (TM * TN), ru = u % (TM * TN), mt = ru / TN, nt = ru % TN, m0 = mt * G_BM, n0 = nt * 128;
        MG g;
        if (STAGE == 0) { g.A = WSB(WS_TBB) + (size_t)j * 2048 * 2048; g.lda = 2048; g.Wt = w.t_c1 + (size_t)j * 256 * 2048; g.ldw = 2048; g.K = 2048; }
        else { g.A = WSB(WS_HIDB) + (size_t)j * 2048 * 256; g.lda = 256; g.Wt = w.t_c2 + (size_t)j * 128 * 256; g.ldw = 256; g.K = 256; }
        f32x16 acc[2][2];
        mgemm_tile(g, n0, [&](int r) { const int rr = m0 + r; return (long)(rr < NCR ? rr : NCR - 1); }, acc, lds);
        if (STAGE == 0) {
            bf16_t* HID = WSB(WS_HIDB) + (size_t)j * 2048 * 256;
            MG_FOREACH(acc, lrow, feat, v, { st4bf(HID + (long)(m0 + lrow) * 256 + n0 + feat, gelu_tanh(v[0]), gelu_tanh(v[1]), gelu_tanh(v[2]), gelu_tanh(v[3])); });
        } else {
            bf16_t* KC = WSB(WS_KCB) + (size_t)j * NCR * 64;
            MG_FOREACH(acc, lrow, feat, v, { if (feat < 64 && m0 + lrow < NCR) st4bf(KC + (long)(m0 + lrow) * 64 + feat, v[0], v[1], v[2], v[3]); });
        }
    }
}
DI void job_router_logits(const Params& p, const LayerW& w, int bid, int nblk, unsigned char* lds) {
    float* LOG = WSF(WS_LOG);
    for (int u = bid; u < 3 * (T / G_BM); u += nblk) {
        const int pass = u / (T / G_BM), m0 = (u % (T / G_BM)) * G_BM;
        f32x16 acc[2][2];
        MG g; g.lda = 1024; g.ldw = 1024; g.K = 1024;
        g.A = pass == 1 ? WSB(WS_XBL) : WSB(WS_XBB); g.Wt = pass == 2 ? w.t_rl : w.t_rh;
        mgemm_tile(g, 0, RowId{m0}, acc, lds, true);
        float* dst = LOG + (size_t)pass * T * 36;
        MG_FOREACH(acc, lrow, feat, v, { if (feat < 36) *(float4*)(dst + (long)(m0 + lrow) * 36 + feat) = make_float4(v[0], v[1], v[2], v[3]); });
    }
}
DI void job_pack_small(const Params& p, int bid, int nblk) {
    bf16_t* TG = WSB(WT_G); bf16_t* RH = WSB(WT_RH); bf16_t* RL = WSB(WT_RL);
    for (int e = bid * NT + tidx(); e < SEQ * 16; e += nblk * NT) {
        const int i = e & 15, pos = e >> 4;
        const float inv = powf(10000.f, -(float)(2 * i) / 32.f);
        const float ang = (float)pos * inv;
        WSF(WS_ROPE)[e * 2] = cosf(ang); WSF(WS_ROPE)[e * 2 + 1] = sinf(ang);
    }
    for (int e = bid * NT + tidx(); e < DEPTH * 4 * 128 * 64; e += nblk * NT) {
        const int c = e & 63, q = (e >> 6) & 127, lb = e >> 13;
        const int seg = q >> 5, i = q & 31, chl = (seg >> 1) * 32 + i;
        const float* src = (seg & 1) ? p.in[10] : p.in[8];
        TG[e] = f2bf(src[((size_t)lb * 64 + c) * 64 + chl]);
    }
    for (int e = bid * NT + tidx(); e < DEPTH * 128 * 1024; e += nblk * NT) {
        const int k = e & 1023, n = (e >> 10) & 127, l = e >> 17;
        float v = 0.f;
        if (n < 4) v = p.in[26][((size_t)l * 1024 + k) * 4 + n];
        else if (n < 36) v = p.in[28][((size_t)l * 1024 + k) * 32 + (n - 4)];
        const bf16_t hi = f2bf(v);
        RH[e] = hi; RL[e] = f2bf(v - bf2f(hi));
    }
}

DI void job_merge(const Params& p, const LayerW& w, int bid, int nblk, unsigned char* lds) {
    const bf16_t* H = WSB(WS_H); bf16_t* M = WSB(WS_M);
    for (int u0 = bid; u0 < (T / G_BM) * 8; u0 += nblk) {
        int u = u0;
        if ((nblk & 7) == 0) { const int per = nblk >> 3, x = u0 & 7, q = u0 >> 3, ul = (q % per) + per * (q / per);
            u = ((x + 8 * (ul >> 3)) << 3) + (ul & 7); }
        const int m0 = (u >> 3) * G_BM, n0 = (u & 7) * G_BN;
        f32x16 macc[2][2];
#pragma unroll
        for (int a = 0; a < 2; ++a)
#pragma unroll
            for (int b = 0; b < 2; ++b)
#pragma unroll
                for (int i = 0; i < 16; ++i) macc[a][b][i] = 0.f;
        MG g; g.A = WSB(WS_BR); g.lda = 1024; g.Wt = w.t_br; g.ldw = 1024; g.K = 1024;
        f32x16 acc[2][2];
        const int l = tidx() & 63, wv = tidx() >> 6, wm = wv % G_WM, wn = wv / G_WM;
        mgemm_tile_f(g, n0, RowId{m0}, acc, lds, true, 4, [&](int n, f32x16 (&a)[2][2]) {
#pragma unroll
            for (int ft = 0; ft < 2; ++ft)
#pragma unroll
                for (int tt = 0; tt < 2; ++tt)
#pragma unroll
                    for (int i = 0; i < 4; ++i) {
                        const int lrow = wm * 64 + tt * 32 + (l & 31), feat = wn * 64 + ft * 32 + 8 * i + 4 * (l >> 5);
                        const float4 gv = ld4bf(H + (long)(m0 + lrow) * NH + O_MG + n * 1024 + n0 + feat);
                        macc[ft][tt][4 * i] += gv.x * a[ft][tt][4 * i]; macc[ft][tt][4 * i + 1] += gv.y * a[ft][tt][4 * i + 1];
                        macc[ft][tt][4 * i + 2] += gv.z * a[ft][tt][4 * i + 2]; macc[ft][tt][4 * i + 3] += gv.w * a[ft][tt][4 * i + 3];
                        a[ft][tt][4 * i] = 0.f; a[ft][tt][4 * i + 1] = 0.f; a[ft][tt][4 * i + 2] = 0.f; a[ft][tt][4 * i + 3] = 0.f;
                    }
        });
        MG_FOREACH(macc, lrow, feat, v, { st4bf(M + (long)(m0 + lrow) * 1024 + n0 + feat, v[0], v[1], v[2], v[3]); });
    }
}
DI void job_ln(const float* xin, const bf16_t* xinb, const bf16_t* xinl, const bf16_t* y, const int* rowof, const float* ew, const float* gw, const float* bw, float* out, bf16_t* outb, bf16_t* outl, int bid, int nblk) {
    const int lane = tidx() & 63, wid = tidx() >> 6;
    float gv[16], bv[16];
#pragma unroll
    for (int i = 0; i < 2; ++i)
#pragma unroll
        for (int j = 0; j < 8; j += 4) { const int c = i * 512 + lane * 8 + j; const float4 g4 = *(const float4*)(gw + c), b4 = *(const float4*)(bw + c);
            gv[i * 8 + j] = g4.x; gv[i * 8 + j + 1] = g4.y; gv[i * 8 + j + 2] = g4.z; gv[i * 8 + j + 3] = g4.w; bv[i * 8 + j] = b4.x; bv[i * 8 + j + 1] = b4.y; bv[i * 8 + j + 2] = b4.z; bv[i * 8 + j + 3] = b4.w; }
    for (int t = bid * (NT / 64) + wid; t < T; t += nblk * (NT / 64)) {
        float v[16];
        float s = 0.f;
        int r0 = 0, r1 = 0; float w0 = 0.f, w1 = 0.f;
        if (rowof) { r0 = rowof[t * 2]; r1 = rowof[t * 2 + 1]; w0 = ew[t * 2]; w1 = ew[t * 2 + 1]; }
#pragma unroll
        for (int i = 0; i < 2; ++i) {
            const int c = i * 512 + lane * 8;
            float xv[8], yv[8];
            if (xin) { const float4 a = *(const float4*)(xin + (long)t * 1024 + c), b = *(const float4*)(xin + (long)t * 1024 + c + 4);
                xv[0] = a.x; xv[1] = a.y; xv[2] = a.z; xv[3] = a.w; xv[4] = b.x; xv[5] = b.y; xv[6] = b.z; xv[7] = b.w; }
            else ld8f(xinb + (long)t * 1024 + c, xv);
            if (xinl) { float z[8]; ld8f(xinl + (long)t * 1024 + c, z);
#pragma unroll
                for (int j = 0; j < 8; ++j) xv[j] += z[j]; }
            if (!rowof) ld8f(y + (long)t * 1024 + c, yv);
            else { float z0[8], z1[8]; ld8f(y + (long)r0 * 1024 + c, z0); ld8f(y + (long)r1 * 1024 + c, z1);
#pragma unroll
                for (int j = 0; j < 8; ++j) yv[j] = w0 * z0[j] + w1 * z1[j]; }
#pragma unroll
            for (int j = 0; j < 8; ++j) { v[i * 8 + j] = DN_ALPHA * xv[j] + yv[j]; s += v[i * 8 + j]; }
        }
        float q = 0.f;
#pragma unroll
        for (int i = 0; i < 16; ++i) q += v[i] * v[i];
        wave_sum2(s, q);
        const float mu = s * (1.f / 1024.f);
        const float rstd = rsqrtf(fmaxf(q * (1.f / 1024.f) - mu * mu, 0.f) + 1e-5f);
#pragma unroll
        for (int i = 0; i < 2; ++i) {
            const int c = i * 512 + lane * 8;
            float o[8];
#pragma unroll
            for (int j = 0; j < 8; ++j) o[j] = (v[i * 8 + j] - mu) * rstd * gv[i * 8 + j] + bv[i * 8 + j];
            if (out) { *(float4*)(out + (long)t * 1024 + c) = make_float4(o[0], o[1], o[2], o[3]); *(float4*)(out + (long)t * 1024 + c + 4) = make_float4(o[4], o[5], o[6], o[7]); }
            if (outb) st8bf(outb + (long)t * 1024 + c, o);
            if (outl) { float lo[8];
#pragma unroll
                for (int j = 0; j < 8; ++j) lo[j] = o[j] - bf2f(f2bf(o[j]));
                st8bf(outl + (long)t * 1024 + c, lo); }
        }
    }
}
DI void job_router(const Params& p, const LayerW& w, int layer, int bid, int nblk) {
    const float* LOG = WSF(WS_LOG); int* EIDX = WSI(WS_EIDX); int* ESLOT = WSI(WS_ESLOT); float* EW = WSF(WS_EW);
    unsigned* cnt = WSU(WS_CTL) + CW_CNT + layer * 32;
    for (int t = bid * NT + tidx(); t < T; t += nblk * NT) {
        const float* lr = LOG + (long)t * 36; const float* lr1 = lr + (size_t)T * 36; const float* lr2 = lr1 + (size_t)T * 36;
#define LG(i) ((lr[i] + lr1[i]) + lr2[i])
        const float g0 = LG(0) + w.rg_b[0], g1 = LG(1) + w.rg_b[1], g2 = LG(2) + w.rg_b[2], g3 = LG(3) + w.rg_b[3];
        const float gm = fmaxf(fmaxf(g0, g1), fmaxf(g2, g3));
        const float e0 = expf(g0 - gm), e1 = expf(g1 - gm), e2 = expf(g2 - gm), e3 = expf(g3 - gm);
        const float gs = (e0 + e1) + (e2 + e3);
        const float p0 = e0 / gs, p1 = e1 / gs, p2 = e2 / gs, p3 = e3 / gs;
        int grp = 0; float pg = p0;
        if (p1 > pg) { pg = p1; grp = 1; }
        if (p2 > pg) { pg = p2; grp = 2; }
        if (p3 > pg) { pg = p3; grp = 3; }
        float el[8];
#pragma unroll
        for (int i = 0; i < 8; ++i) el[i] = LG(4 + grp * 8 + i) + w.re_b[grp * 8 + i];
#undef LG
        float em = el[0];
#pragma unroll
        for (int i = 1; i < 8; ++i) em = fmaxf(em, el[i]);
        float es = 0.f;
#pragma unroll
        for (int i = 0; i < 8; ++i) { el[i] = expf(el[i] - em); es += el[i]; }
#pragma unroll
        for (int i = 0; i < 8; ++i) el[i] = el[i] / es;
        float b0 = el[0]; int i0 = 0;
#pragma unroll
        for (int i = 1; i < 8; ++i) if (el[i] > b0) { b0 = el[i]; i0 = i; }
        float b1 = -1.f; int i1 = 0;
#pragma unroll
        for (int i = 0; i < 8; ++i) if (i != i0 && el[i] > b1) { b1 = el[i]; i1 = i; }
        const float den = b0 + b1;
        const int ex0 = grp * 8 + i0, ex1 = grp * 8 + i1;
        EIDX[t * 2] = ex0; EIDX[t * 2 + 1] = ex1;
        EW[t * 2] = pg * b0 / den; EW[t * 2 + 1] = pg * b1 / den;
        ESLOT[t * 2] = (int)atomicAdd(&cnt[ex0], 1u);
        ESLOT[t * 2 + 1] = (int)atomicAdd(&cnt[ex1], 1u);
    }
}
DI int pad_rows(int c) { return (c + G_BM - 1) / G_BM * G_BM; }
DI void job_fill(const Params& p, int layer, int bid, int nblk, unsigned char* lds) {
    const int* EIDX = WSI(WS_EIDX); const int* ESLOT = WSI(WS_ESLOT); int* PERM = WSI(WS_PERM);
    unsigned* cnt = WSU(WS_CTL) + CW_CNT + layer * 32;
    const int lane = tidx() & 63, wid = tidx() >> 6;
    int* s_off = (int*)lds; int* s_cnt = s_off + 32;
    __syncthreads();
    if (tidx() < 32) s_cnt[tidx()] = (int)__hip_atomic_load(&cnt[tidx()], __ATOMIC_RELAXED, __HIP_MEMORY_SCOPE_AGENT);
    __syncthreads();
    if (tidx() == 0) { int o = 0; for (int e = 0; e < 32; ++e) { s_off[e] = o; o += pad_rows(s_cnt[e]); } }
    __syncthreads();
    for (int a = bid * (NT / 64) + wid; a < NASSIGN + NEXP; a += nblk * (NT / 64)) {
        const bool real = a < NASSIGN;
        const int e = real ? EIDX[a] : a - NASSIGN;
        const int off = s_off[e];
        if (real) {
            const int R = off + ESLOT[a];
            if (lane == 0) { PERM[R] = a; WSI(WS_ROWOF)[a] = R; }
        } else {
            const int c = s_cnt[e];
            for (int j = lane; c + j < pad_rows(c); j += 64) PERM[off + c + j] = -1;
        }
    }
}
DI pg8::ListOrder moe_units(unsigned* cnt, int bid, int nblk) {
    pg8::ListOrder S; S.n = 0; S.u0 = S.u1 = S.u2 = pg8::Unit{0, 0, 0};
    int rt = 0, ub = 0;
    for (int e = 0; e < 32; ++e) {
        const int c = pad_rows((int)__hip_atomic_load(&cnt[e], __ATOMIC_RELAXED, __HIP_MEMORY_SCOPE_AGENT)) >> 8, ue = c * 4;
#pragma unroll
        for (int k = 0; k < 3; ++k) {
            const int L = bid + k * nblk;
            if (L >= ub && L < ub + ue) { const int lu = L - ub; const pg8::Unit u{rt + (lu >> 2), lu & 3, e};
                if (k == 0) S.u0 = u; else if (k == 1) S.u1 = u; else S.u2 = u;
                S.n = k + 1; }
        }
        rt += c; ub += ue;
    }
#define RFL(x) x = __builtin_amdgcn_readfirstlane(x)
    RFL(S.n); RFL(S.u0.pm); RFL(S.u0.pn); RFL(S.u0.e); RFL(S.u1.pm); RFL(S.u1.pn); RFL(S.u1.e); RFL(S.u2.pm); RFL(S.u2.pn); RFL(S.u2.e);
#undef RFL
    return S;
}
typedef short s16x4 __attribute__((ext_vector_type(4)));
typedef short v4i16_t __attribute__((ext_vector_type(4)));
DI unsigned cvtpk(float lo, float hi) { return pk_bf16(lo, hi); }
DI int crow(int reg, int h) { return (reg & 3) + 8 * (reg >> 2) + 4 * h; }
DI s16x4 tr_read(const unsigned char* p) { return __builtin_bit_cast(s16x4, __builtin_amdgcn_ds_read_tr16_b64_v4i16((LAS v4i16_t*)p)); }
DI float xhalf_max(float m) { auto rr = __builtin_amdgcn_permlane32_swap(__float_as_uint(m), __float_as_uint(m), false, false); return fmaxf(__uint_as_float(rr[0]), __uint_as_float(rr[1])); }
DI float xhalf_sum(float m) { auto rr = __builtin_amdgcn_permlane32_swap(__float_as_uint(m), __float_as_uint(m), false, false); return __uint_as_float(rr[0]) + __uint_as_float(rr[1]); }
DI float xhalf_other(float v, int h) { auto rr = __builtin_amdgcn_permlane32_swap(__float_as_uint(v), __float_as_uint(v), false, false); return __uint_as_float(h ? rr[0] : rr[1]); }
DI bf16x8 pack8(const f32x16& x, int s2) {
    u32x4 pk; pk[0] = cvtpk(x[8 * s2], x[8 * s2 + 1]); pk[1] = cvtpk(x[8 * s2 + 2], x[8 * s2 + 3]); pk[2] = cvtpk(x[8 * s2 + 4], x[8 * s2 + 5]); pk[3] = cvtpk(x[8 * s2 + 6], x[8 * s2 + 7]);
    return __builtin_bit_cast(bf16x8, pk);
}
constexpr int ATT_QB = (NT / 64) * 32;
template <int DC> struct TileCfg { static constexpr int RS = DC * 2 + 16, BYTES = 64 * RS, NCH = 64 * DC / 8, NI = (NCH + NT - 1) / NT; };
template <int DC, class RowPtr> DI void tile_gload(u32x4 (&rg)[TileCfg<DC>::NI], RowPtr rp) {
#pragma unroll
    for (int i = 0; i < TileCfg<DC>::NI; ++i) { const int c = tidx() + NT * i; if (c < TileCfg<DC>::NCH) { const int row = c / (DC / 8), cc = c % (DC / 8); rg[i] = *(const u32x4*)(rp(row) + cc * 8); } }
}
template <int DC> DI void tile_lstore(const u32x4 (&rg)[TileCfg<DC>::NI], unsigned char* base) {
#pragma unroll
    for (int i = 0; i < TileCfg<DC>::NI; ++i) { const int c = tidx() + NT * i; if (c < TileCfg<DC>::NCH) { const int row = c / (DC / 8), cc = c % (DC / 8); *(u32x4*)(base + row * TileCfg<DC>::RS + cc * 16) = rg[i]; } }
}
template <int DK> DI void qk_tile(f32x16 (&s)[2], const bf16x8 (&qf)[DK / 16], const unsigned char* kl, int r, int h) {
    constexpr int RS = TileCfg<DK>::RS;
#pragma unroll
    for (int i = 0; i < 16; ++i) { s[0][i] = 0.f; s[1][i] = 0.f; }
#pragma unroll
    for (int ks = 0; ks < DK / 16; ++ks) {
        const bf16x8 k0 = *(const bf16x8*)(kl + r * RS + ks * 32 + h * 16), k1 = *(const bf16x8*)(kl + (32 + r) * RS + ks * 32 + h * 16);
        s[0] = __builtin_amdgcn_mfma_f32_32x32x16_bf16(k0, qf[ks], s[0], 0, 0, 0);
        s[1] = __builtin_amdgcn_mfma_f32_32x32x16_bf16(k1, qf[ks], s[1], 0, 0, 0);
    }
}
template <int DV> DI void pv_tile(f32x16 (&o)[DV / 32], const f32x16 (&pp)[2], const unsigned char* vl, int lane) {
    constexpr int RS = TileCfg<DV>::RS;
    const int h = lane >> 5, i16 = lane & 15, q = i16 >> 2, pq = i16 & 3, blk = (lane >> 4) & 1;
    const unsigned char* vb = vl + (4 * h + q) * RS + 2 * (16 * blk + 4 * pq);
#pragma unroll
    for (int kt = 0; kt < 2; ++kt)
#pragma unroll
        for (int s2 = 0; s2 < 2; ++s2) {
            const bf16x8 pf = pack8(pp[kt], s2);
#pragma unroll
            for (int dvt = 0; dvt < DV / 32; ++dvt) {
                const s16x4 lo = tr_read(vb + (kt * 32 + 16 * s2) * RS + dvt * 64), hi = tr_read(vb + (kt * 32 + 16 * s2 + 8) * RS + dvt * 64);
                const bf16x8 vf = __builtin_shufflevector(lo, hi, 0, 1, 2, 3, 4, 5, 6, 7);
                o[dvt] = __builtin_amdgcn_mfma_f32_32x32x16_bf16(vf, pf, o[dvt], 0, 0, 0);
            }
        }
}
constexpr float LOG2E = 1.4426950408889634f;
template <int DK, int DV, bool ALIBI, bool BOUNDARY, class ValidFn>
DI void softmax_tile(const bf16x8 (&qf)[DK / 16], f32x16 (&o)[DV / 32], float& m, float& l, const unsigned char* kl, const unsigned char* vl, int kb,
                     float c1, float sl2, int qpos, ValidFn valid, int lane) {
    const int r = lane & 31, h = lane >> 5;
    f32x16 s[2];
    qk_tile<DK>(s, qf, kl, r, h);
    const float base = ALIBI ? sl2 * (float)(kb + 4 * h - qpos) : 0.f;
    float tmax = -INFINITY;
#pragma unroll
    for (int kt = 0; kt < 2; ++kt)
#pragma unroll
        for (int i = 0; i < 16; ++i) {
            float v = ALIBI ? fmaf(s[kt][i], c1, fmaf(sl2, (float)(kt * 32 + (i & 3) + 8 * (i >> 2)), base)) : s[kt][i] * c1;
            if (BOUNDARY) v = valid(kb + kt * 32 + crow(i, h)) ? v : -INFINITY;
            s[kt][i] = v; tmax = fmaxf(tmax, v);
        }
    tmax = xhalf_max(tmax);
    const float mn = fmaxf(m, tmax);
    if (__any(mn > m)) {
        const float corr = __builtin_amdgcn_exp2f(m - mn);
        l *= corr;
#pragma unroll
        for (int dvt = 0; dvt < DV / 32; ++dvt)
#pragma unroll
            for (int i = 0; i < 16; ++i) o[dvt][i] *= corr;
        m = mn;
    }
    float ps = 0.f;
#pragma unroll
    for (int kt = 0; kt < 2; ++kt)
#pragma unroll
        for (int i = 0; i < 16; ++i) { const float pr = __builtin_amdgcn_exp2f(s[kt][i] - mn); s[kt][i] = pr; ps += pr; }
    l += ps;
    pv_tile<DV>(o, s, vl, lane);
}
template <int DK, int DV, bool ALIBI, class KPtr, class VPtr, class ValidFn, class InteriorFn>
DI void attn_stream(const bf16x8 (&qf)[DK / 16], f32x16 (&o)[DV / 32], float& m, float& l, unsigned tmask, int wave_qmax, int wave_kmin,
                    KPtr kp, VPtr vp, float c1, float sl2, int qpos, ValidFn valid, InteriorFn interior, unsigned char* lds) {
    unsigned char* kl = lds; unsigned char* vl = lds + TileCfg<DK>::BYTES;
    const int lane = tidx() & 63;
    u32x4 kA[TileCfg<DK>::NI], vA[TileCfg<DV>::NI], kB[TileCfg<DK>::NI], vB[TileCfg<DV>::NI];
    int ja = -1, jb = -1;
#define AS_NEXT(J, KR, VR) do { if (tmask) { J = __builtin_ctz(tmask); tmask &= tmask - 1; const int _j = J; \
        tile_gload<DK>(KR, [&](int row) { return kp(_j * 64 + row); }); tile_gload<DV>(VR, [&](int row) { return vp(_j * 64 + row); }); } else J = -1; } while (0)
#define AS_COMPUTE(J) do { const int _jc = (J); if (_jc * 64 <= wave_qmax && _jc * 64 + 63 >= wave_kmin) { \
        if (interior(_jc)) softmax_tile<DK, DV, ALIBI, false>(qf, o, m, l, kl, vl, _jc * 64, c1, sl2, qpos, valid, lane); \
        else softmax_tile<DK, DV, ALIBI, true>(qf, o, m, l, kl, vl, _jc * 64, c1, sl2, qpos, valid, lane); } } while (0)
    AS_NEXT(ja, kA, vA);
    AS_NEXT(jb, kB, vB);
    while (ja >= 0) {
        __syncthreads();
        tile_lstore<DK>(kA, kl); tile_lstore<DV>(vA, vl);
        __syncthreads();
        const int jc = ja;
        AS_NEXT(ja, kA, vA);
        AS_COMPUTE(jc);
        if (jb < 0) break;
        __syncthreads();
        tile_lstore<DK>(kB, kl); tile_lstore<DV>(vB, vl);
        __syncthreads();
        const int jd = jb;
        AS_NEXT(jb, kB, vB);
        AS_COMPUTE(jd);
    }
#undef AS_NEXT
#undef AS_COMPUTE
}

DI void job_mla_attn(const Params& p, int bid, int nblk, unsigned char* lds) {
    const bf16_t* QB = WSB(WS_QB); const bf16_t* KM = WSB(WS_KM); const bf16_t* VM = WSB(WS_VM); bf16_t* BR = WSB(WS_BR);
    constexpr int NQB = SEQ / ATT_QB, NU = BATCH * 4 * NQB;
    const int lane = tidx() & 63, wid = tidx() >> 6, r = lane & 31, h = lane >> 5;
    for (int u = bid; u < NU; u += nblk) {
        const int qblk = u / (BATCH * 4), bh = u % (BATCH * 4);
        const int b = bh >> 2, hd = bh & 3;
        const int q0 = qblk * ATT_QB, qw = q0 + wid * 32, qpos = qw + r;
        const long trow = (long)b * SEQ;
        bf16x8 qf[6];
#pragma unroll
        for (int ks = 0; ks < 6; ++ks) qf[ks] = *(const bf16x8*)(QB + (trow + qpos) * 384 + hd * 96 + ks * 16 + 8 * h);
        f32x16 o[2];
#pragma unroll
        for (int i = 0; i < 16; ++i) { o[0][i] = 0.f; o[1][i] = 0.f; }
        float m = -1e30f, l = 0.f;
        const int ntile = (q0 + ATT_QB - 1) / 64 + 1;
        const unsigned tmask = ntile >= 32 ? 0xffffffffu : ((1u << ntile) - 1u);
        attn_stream<96, 64, false>(qf, o, m, l, tmask, qw + 31, 0,
            [&](int row) { return KM + (trow + row) * 384 + hd * 96; },
            [&](int row) { return VM + (trow + row) * 256 + hd * 64; },
            0.10206207261596577f * LOG2E, 0.f, qpos,
            [&](int key) { return key <= qpos; }, [&](int j) { return j * 64 + 63 <= qw; }, lds);
        const float rl = 1.f / fmaxf(xhalf_sum(l), 1e-30f);
        bf16_t* dst = BR + (trow + qpos) * 1024 + 3 * 256 + hd * 64;
#pragma unroll
        for (int dvt = 0; dvt < 2; ++dvt)
#pragma unroll
            for (int i = 0; i < 4; ++i)
                st4bf(dst + dvt * 32 + 8 * i + 4 * h, o[dvt][4 * i] * rl, o[dvt][4 * i + 1] * rl, o[dvt][4 * i + 2] * rl, o[dvt][4 * i + 3] * rl);
    }
}
DI void job_cross_attn(const Params& p, int layer, int bid, int nblk, unsigned char* lds) {
    const bf16_t* XQ = WSB(WS_XQ); const bf16_t* KVM = WSB(WS_KVM) + (size_t)layer * 2048 * 1024; bf16_t* XO = WSB(WS_XO);
    constexpr int NQB = SEQ / ATT_QB, NU = BATCH * 4 * NQB;
    const int lane = tidx() & 63, wid = tidx() >> 6, r = lane & 31, h = lane >> 5;
    for (int u = bid; u < NU; u += nblk) {
        const int bh = u % (BATCH * 4), qblk = u / (BATCH * 4);
        const int b = bh >> 2, hd = bh & 3;
        const int qpos = qblk * ATT_QB + wid * 32 + r;
        const long trow = (long)b * SEQ;
        bf16x8 qf[8];
#pragma unroll
        for (int ks = 0; ks < 8; ++ks) qf[ks] = *(const bf16x8*)(XQ + (trow + qpos) * 512 + hd * 128 + ks * 16 + 8 * h);
        f32x16 o[4];
#pragma unroll
        for (int d = 0; d < 4; ++d)
#pragma unroll
            for (int i = 0; i < 16; ++i) o[d][i] = 0.f;
        float m = -1e30f, l = 0.f;
        attn_stream<128, 128, false>(qf, o, m, l, 0xFu, 1 << 30, 0,
            [&](int row) { return KVM + (long)(b * MEM_LEN + row) * 1024 + hd * 128; },
            [&](int row) { return KVM + (long)(b * MEM_LEN + row) * 1024 + 512 + hd * 128; },
            0.08838834764831845f * LOG2E, 0.f, qpos, [&](int) { return true; }, [&](int) { return true; }, lds);
        const float rl = 1.f / fmaxf(xhalf_sum(l), 1e-30f);
        bf16_t* dst = XO + (trow + qpos) * 512 + hd * 128;
#pragma unroll
        for (int dvt = 0; dvt < 4; ++dvt)
#pragma unroll
            for (int i = 0; i < 4; ++i)
                st4bf(dst + dvt * 32 + 8 * i + 4 * h, o[dvt][4 * i] * rl, o[dvt][4 * i + 1] * rl, o[dvt][4 * i + 2] * rl, o[dvt][4 * i + 3] * rl);
    }
}
DI float logsig_fast(float z) { return fminf(z, 0.f) - __logf(1.f + __expf(-fabsf(z))); }
DI void job_sb_attn(const Params& p, int bid, int nblk, unsigned char* lds) {
    const bf16_t* H = WSB(WS_H); bf16_t* BR = WSB(WS_BR);
    constexpr int NQB = SEQ / ATT_QB, NU = BATCH * 4 * NQB;
    const int lane = tidx() & 63, wid = tidx() >> 6, r = lane & 31, h = lane >> 5;
    unsigned char* kl = lds; unsigned char* vl = lds + TileCfg<64>::BYTES;
    for (int u = bid; u < NU; u += nblk) {
        const int half = u / (NU / 2), ru = u % (NU / 2);
        const int qi = ru / (BATCH * 4), bh = ru % (BATCH * 4);
        const int qblk = half == 0 ? (NQB - 1 - qi) : qi;
        const int b = bh >> 2, hd = bh & 3;
        const int q0 = qblk * ATT_QB, qw = q0 + wid * 32, qpos = qw + r;
        const long trow = (long)b * SEQ;
        bf16x8 qf[4];
#pragma unroll
        for (int ks = 0; ks < 4; ++ks) qf[ks] = *(const bf16x8*)(H + (trow + qpos) * NH + O_BQ + hd * 64 + ks * 16 + 8 * h);
        f32x16 o[2];
#pragma unroll
        for (int i = 0; i < 16; ++i) { o[0][i] = 0.f; o[1][i] = 0.f; }
        float trun = 0.f;
        int j = (q0 + ATT_QB - 1) >> 6;
        volatile int* flag = (volatile int*)(lds + 2 * TileCfg<64>::BYTES);
        if (tidx() == 0) { flag[0] = 0; flag[1] = 0; }
        u32x4 kr[TileCfg<64>::NI], vr[TileCfg<64>::NI];
        tile_gload<64>(kr, [&](int row) { return H + (trow + j * 64 + row) * NH + O_BK + hd * 64; });
        tile_gload<64>(vr, [&](int row) { return H + (trow + j * 64 + row) * NH + O_BV + hd * 64; });
        for (int it = 0; j >= 0; --j, ++it) {
            __syncthreads();
            if (it > 0 && flag[(it - 1) & 1] == 0) break;
            tile_lstore<64>(kr, kl); tile_lstore<64>(vr, vl);
            __syncthreads();
            if (tidx() == 0) flag[(it + 1) & 1] = 0;
            if (j > 0) { const int jn = j - 1;
                tile_gload<64>(kr, [&](int row) { return H + (trow + jn * 64 + row) * NH + O_BK + hd * 64; });
                tile_gload<64>(vr, [&](int row) { return H + (trow + jn * 64 + row) * NH + O_BV + hd * 64; }); }
            const bool wave_dead = __all(trun < -110.f);
            if (j * 64 < qw + 31 && !wave_dead) {
                const int kb = j * 64;
                f32x16 s[2], L[2];
                qk_tile<64>(s, qf, kl, r, h);
#pragma unroll
                for (int kt = 0; kt < 2; ++kt)
#pragma unroll
                    for (int i = 0; i < 16; ++i) {
                        const int key = kb + kt * 32 + crow(i, h);
                        const float z = s[kt][i] * 0.125f, lsp = logsig_fast(z);
                        const bool valid = key < qpos;
                        L[kt][i] = valid ? lsp - z : 0.f;
                        s[kt][i] = valid ? lsp : -INFINITY;
                    }
                float G[2][4], O[2][4];
#pragma unroll
                for (int kt = 0; kt < 2; ++kt)
#pragma unroll
                    for (int ig = 0; ig < 4; ++ig) { G[kt][ig] = (L[kt][4 * ig] + L[kt][4 * ig + 1]) + (L[kt][4 * ig + 2] + L[kt][4 * ig + 3]); O[kt][ig] = xhalf_other(G[kt][ig], h); }
                float run = trun;
#pragma unroll
                for (int kt = 1; kt >= 0; --kt)
#pragma unroll
                    for (int ig = 3; ig >= 0; --ig) {
                        const float t3 = run + (h == 0 ? O[kt][ig] : 0.f);
                        const float t2 = t3 + L[kt][4 * ig + 3], t1 = t2 + L[kt][4 * ig + 2], t0 = t1 + L[kt][4 * ig + 1];
                        s[kt][4 * ig + 3] = __expf(s[kt][4 * ig + 3] + t3); s[kt][4 * ig + 2] = __expf(s[kt][4 * ig + 2] + t2);
                        s[kt][4 * ig + 1] = __expf(s[kt][4 * ig + 1] + t1); s[kt][4 * ig + 0] = __expf(s[kt][4 * ig + 0] + t0);
                        run += G[kt][ig] + O[kt][ig];
                    }
                trun = run;
                pv_tile<64>(o, s, vl, lane);
            }
            if (!__all(trun < -110.f)) flag[it & 1] = 1;
        }
        bf16_t* dst = BR + (trow + qpos) * 1024 + 1 * 256 + hd * 64;
#pragma unroll
        for (int dvt = 0; dvt < 2; ++dvt)
#pragma unroll
            for (int i = 0; i < 4; ++i) st4bf(dst + dvt * 32 + 8 * i + 4 * h, o[dvt][4 * i], o[dvt][4 * i + 1], o[dvt][4 * i + 2], o[dvt][4 * i + 3]);
    }
}
constexpr int NSA_QB = (NT / 128) * 32;
DI void job_nsa(const Params& p, int bid, int nblk, unsigned char* lds) {
    const bf16_t* H = WSB(WS_H); const bf16_t* KCB = WSB(WS_KCB); const bf16_t* VCB = KCB + (size_t)NCR * 64;
    float* OACC = WSF(WS_OC); bf16_t* BR = WSB(WS_BR);
    constexpr int NQB = SEQ / NSA_QB, NU = BATCH * 2 * NQB;
    constexpr int TB_ = TileCfg<64>::BYTES;
    const int lane = tidx() & 63, wid = tidx() >> 6, r = lane & 31, h = lane >> 5;
    const int n = wid & 1, sub = wid >> 1;
    unsigned* orw = (unsigned*)(lds + 4 * TB_);
    float* impx = (float*)(lds + 4 * TB_ + 64);
    for (int u = bid; u < NU; u += nblk) {
        const int qblk = NQB - 1 - u / (BATCH * 2), bg = u % (BATCH * 2), b = bg >> 1, g = bg & 1;
        const int q0 = qblk * NSA_QB, qw = q0 + sub * 32, qpos = qw + r;
        const int head = g * 2 + n;
        const long trow = (long)b * SEQ;
        const bf16_t* hq_row = H + (trow + qpos) * NH;
        bf16x8 qf[1][4];
#pragma unroll
        for (int ks = 0; ks < 4; ++ks) qf[0][ks] = *(const bf16x8*)(hq_row + O_AQ + head * 64 + ks * 16 + 8 * h);
        const float sl = exp2f(-2.f * (float)(head + 1));
        const float gate0 = sigm(bf2f(hq_row[O_AG + head * 3 + 0])), gate1 = sigm(bf2f(hq_row[O_AG + head * 3 + 1])), gate2 = sigm(bf2f(hq_row[O_AG + head * 3 + 2]));
        float* oacc = OACC + (trow + qpos) * 256 + head * 64;
        __syncthreads();
        if (tidx() == 0) *orw = 0u;
        {
            u32x4 rg[TileCfg<64>::NI];
#pragma unroll
            for (int tl = 0; tl < 4; ++tl) {
                const bf16_t* src = (tl & 2) ? VCB : KCB; const int cb = (tl & 1) * 64;
                tile_gload<64>(rg, [&](int row) { const int c = cb + row < NCMP ? cb + row : NCMP - 1; return src + ((long)(b * NCMP + c) * 2 + g) * 64; });
                tile_lstore<64>(rg, lds + tl * TB_);
            }
        }
        __syncthreads();
        float imp[16];
        {
            f32x16 s[2][2];
            qk_tile<64>(s[0], qf[0], lds, r, h);
            qk_tile<64>(s[1], qf[0], lds + TB_, r, h);
            float tmax = -INFINITY;
#pragma unroll
            for (int tl = 0; tl < 2; ++tl)
#pragma unroll
                for (int kt = 0; kt < 2; ++kt)
#pragma unroll
                    for (int i = 0; i < 16; ++i) {
                        const int c = tl * 64 + kt * 32 + crow(i, h), dist = qpos - (16 * c + 31);
                        const float v = (c < NCMP && dist >= 0) ? s[tl][kt][i] * 0.125f - sl * (float)dist : -INFINITY;
                        s[tl][kt][i] = v; tmax = fmaxf(tmax, v);
                    }
            const float mn = fmaxf(xhalf_max(tmax), -1e30f);
            float ps = 0.f;
#pragma unroll
            for (int tl = 0; tl < 2; ++tl)
#pragma unroll
                for (int kt = 0; kt < 2; ++kt)
#pragma unroll
                    for (int i = 0; i < 16; ++i) { const float pr = __expf(s[tl][kt][i] - mn); s[tl][kt][i] = pr; ps += pr; }
            const float rl = 1.f / fmaxf(xhalf_sum(ps), 1e-30f);
            float P3[16];
#pragma unroll
            for (int tl = 0; tl < 2; ++tl)
#pragma unroll
                for (int kt = 0; kt < 2; ++kt) {
#pragma unroll
                    for (int ig = 0; ig < 4; ++ig) {
                        const float p0 = s[tl][kt][4 * ig] * rl, p1 = s[tl][kt][4 * ig + 1] * rl, p2 = s[tl][kt][4 * ig + 2] * rl, p3 = s[tl][kt][4 * ig + 3] * rl;
                        imp[tl * 8 + kt * 4 + ig] = (p0 + p1) + (p2 + 0.5f * p3);
                        P3[tl * 8 + kt * 4 + ig] = 0.5f * p3;
                    }
                    const float gs = rl * gate0;
#pragma unroll
                    for (int i = 0; i < 16; ++i) s[tl][kt][i] *= gs;
                }
#pragma unroll
            for (int idx = 0; idx < 16; ++idx) {
                const float pp = xhalf_other(P3[idx], h);
                float prevp;
                if (idx == 0) prevp = h ? pp : 0.f; else { const float ppm = xhalf_other(P3[idx - 1], h); prevp = h ? pp : ppm; }
                imp[idx] += prevp;
                impx[(wid * 16 + idx) * 64 + lane] = imp[idx];
            }
            f32x16 oc[2];
#pragma unroll
            for (int i = 0; i < 16; ++i) { oc[0][i] = 0.f; oc[1][i] = 0.f; }
            pv_tile<64>(oc, s[0], lds + 2 * TB_, lane);
            pv_tile<64>(oc, s[1], lds + 3 * TB_, lane);
#pragma unroll
            for (int dvt = 0; dvt < 2; ++dvt)
#pragma unroll
                for (int i = 0; i < 4; ++i) *(float4*)(oacc + dvt * 32 + 8 * i + 4 * h) = make_float4(oc[dvt][4 * i], oc[dvt][4 * i + 1], oc[dvt][4 * i + 2], oc[dvt][4 * i + 3]);
        }
        __syncthreads();
        unsigned sel = 0u;
        {
            const int cur = qpos >> 6;
#pragma unroll
            for (int idx = 0; idx < 16; ++idx) {
                const float other = impx[((wid ^ 1) * 16 + idx) * 64 + lane];
                const float tot = n == 0 ? imp[idx] + other : other + imp[idx];
                const int j = 2 * idx + h;
                const bool forced = (j == 0) || (j == cur), valid = (j * 64 <= qpos);
                imp[idx] = forced ? 1e4f : (valid ? tot : -1.0f);
            }
#pragma unroll 1
            for (int it = 0; it < 8; ++it) {
                float best = -INFINITY; int bj = 64;
#pragma unroll
                for (int idx = 0; idx < 16; ++idx) if (imp[idx] > best) { best = imp[idx]; bj = 2 * idx + h; }
                const float pb = xhalf_other(best, h); const int pj = __float_as_int(xhalf_other(__int_as_float(bj), h));
                const bool own = (best > pb) || (best == pb && bj < pj);
                const int wj = own ? bj : pj;
                sel |= 1u << wj;
#pragma unroll
                for (int idx = 0; idx < 16; ++idx) if (2 * idx + h == wj) imp[idx] = -INFINITY;
            }
        }
        atomicOr(orw, sel);
        __syncthreads();
        const unsigned bmask = *orw;
        const int jhi = (q0 + NSA_QB - 1) >> 6;
        const unsigned upto = jhi >= 31 ? 0xffffffffu : ((1u << (jhi + 1)) - 1u);
        const float c1 = 0.125f * LOG2E, sl2 = sl * LOG2E;
        {
            f32x16 o[2];
#pragma unroll
            for (int i = 0; i < 16; ++i) { o[0][i] = 0.f; o[1][i] = 0.f; }
            float m = -1e30f, l = 0.f;
            const int jlo = (q0 - 511 > 0 ? q0 - 511 : 0) >> 6;
            const unsigned tmask = upto & ~((1u << jlo) - 1u);
            attn_stream<64, 64, true>(qf[0], o, m, l, tmask, qw + 31, qw - 511,
                [&](int row) { return H + (trow + row) * NH + O_AKW + g * 64; },
                [&](int row) { return H + (trow + row) * NH + O_AVW + g * 64; },
                c1, sl2, qpos,
                [&](int key) { const int dist = qpos - key; return dist >= 0 && dist < 512; },
                [&](int j) { return j * 64 + 63 <= qw && qw + 31 - j * 64 < 512; }, lds);
            const float rl = gate2 / fmaxf(xhalf_sum(l), 1e-30f);
#pragma unroll
            for (int dvt = 0; dvt < 2; ++dvt)
#pragma unroll
                for (int i = 0; i < 4; ++i) { float4* a = (float4*)(oacc + dvt * 32 + 8 * i + 4 * h); float4 c = *a;
                    c.x += o[dvt][4 * i] * rl; c.y += o[dvt][4 * i + 1] * rl; c.z += o[dvt][4 * i + 2] * rl; c.w += o[dvt][4 * i + 3] * rl; *a = c; }
        }
        {
            f32x16 o[2];
#pragma unroll
            for (int i = 0; i < 16; ++i) { o[0][i] = 0.f; o[1][i] = 0.f; }
            float m = -1e30f, l = 0.f;
            attn_stream<64, 64, true>(qf[0], o, m, l, bmask & upto, qw + 31, 0,
                [&](int row) { return H + (trow + row) * NH + O_AKS + g * 64; },
                [&](int row) { return H + (trow + row) * NH + O_AVS + g * 64; },
                c1, sl2, qpos,
                [&](int key) { return key <= qpos && ((sel >> (key >> 6)) & 1u); },
                [&](int j) { return j * 64 + 63 <= qw && __all((sel >> j) & 1u); }, lds);
            const float rl = gate1 / fmaxf(xhalf_sum(l), 1e-30f);
            bf16_t* dst = BR + (trow + qpos) * 1024 + head * 64;
#pragma unroll
            for (int dvt = 0; dvt < 2; ++dvt)
#pragma unroll
                for (int i = 0; i < 4; ++i) { const float4 c = *(const float4*)(oacc + dvt * 32 + 8 * i + 4 * h);
                    st4bf(dst + dvt * 32 + 8 * i + 4 * h, c.x + o[dvt][4 * i] * rl, c.y + o[dvt][4 * i + 1] * rl, c.z + o[dvt][4 * i + 2] * rl, c.w + o[dvt][4 * i + 3] * rl); }
        }
    }
}

namespace pg8 { typedef PG8_LAS unsigned char* PG8_LAS_T; }
#define LDS3 ((pg8::PG8_LAS_T)lds)
#define GEMM256(EPI, SCHED, g, S, E) do { __syncthreads(); pg8::gemm_phase<EPI, SCHED, true, true>(LDS3, g, S, E); } while (0)
constexpr int NPH = 18;
constexpr int NPHASES = 2 + DEPTH * NPH;

__global__ void __launch_bounds__(NT, 2) mega(Params pk, int ph_lo, int ph_hi) {
    extern __shared__ __attribute__((aligned(16))) unsigned char lds[];
    const int bid = blockIdx.x, nblk = gridDim.x;
#define XB_HERE XcdBarrier bar_; bar_.bar = (unsigned*)(pk.ws + WS_CTL) + CW_BAR; bar_.x = xb_xcc_id(); bar_.st = (volatile LAS unsigned*)(lds + 131072)
    const bool multi = (ph_hi - ph_lo) > 1;
    if (multi) {
        uint4* xbw = (uint4*)(lds + 131072);
        if (tidx() == 0) *xbw = make_uint4(0u, 0u, 0u, 0u);
        __syncthreads();
        (void)xcd_barrier_post((unsigned*)(pk.ws + WS_CTL) + CW_BAR, (volatile LAS unsigned*)xbw);
    }
#ifndef PROBE_PH
#define PROBE_PH -100
#endif
#define PHASE(id, ...) do { const int _id = (id); if (ph_lo <= _id && _id < ph_hi) { for (int _rep = 0; _rep < ((PROBE_PH == -1 ? _id < 2 : (_id >= 2 && (_id - 2) % NPH == PROBE_PH)) ? 2 : 1); ++_rep) { if (_rep) { XB_HERE; xcd_barrier(bar_); } { Params p = pk; int layer = layer_; asm volatile("" : "+s"(p.ws), "+s"(p.out), "+s"(layer)); \
        const LayerW w = layer_w(p, layer); const float* Xin = (layer == 0) ? p.in[0] : WSF(WS_XC); const bf16_t* XinB = (layer == 0) ? WSB(WS_X0B) : WSB(WS_XCB); float* Xout = (layer == DEPTH - 1) ? p.out : WSF(WS_XC); \
        (void)w; (void)Xin; (void)XinB; (void)Xout; __VA_ARGS__; } } if (_id + 1 < ph_hi) { XB_HERE; xcd_barrier(bar_); } } } while (0)

    { const int layer_ = 0;
    PHASE(0, {
        job_wt<2>(p.in[2], DEPTH, 1024, NIN, WSB(WT_IN), NH, bid, nblk, lds);
        job_wt<0>(p.in[17], DEPTH, 1024, 1024, WSB(WT_BR), 1024, bid, nblk, lds);
        job_wt<0>(p.in[18], DEPTH, 1024, 1024, WSB(WT_OUT), 1024, bid, nblk, lds);
        job_wt<0>(p.in[21], DEPTH, 1024, 512, WSB(WT_Q), 512, bid, nblk, lds);
        job_wt<0>(p.in[22], DEPTH, 1024, 1024, WSB(WT_KV), 1024, bid, nblk, lds);
        job_wt<0>(p.in[23], DEPTH, 512, 1024, WSB(WT_O), 1024, bid, nblk, lds);
        job_wt<1>(p.in[30], DEPTH * 32, 1024, 1024, WSB(WT_GU), 1024, bid, nblk, lds);
        job_wt<0>(p.in[31], DEPTH * 32, 512, 1024, WSB(WT_DN), 1024, bid, nblk, lds);
        job_wt<0>(p.in[4], DEPTH * 2, 2048, 256, WSB(WT_C1), 256, bid, nblk, lds);
        job_wt<0>(p.in[5], DEPTH * 2, 256, 64, WSB(WT_C2), 128, bid, nblk, lds);
        job_wt<0>(p.in[15], DEPTH, 192, 384, WSB(WT_UQ), 384, bid, nblk, lds);
        job_wt<0>(p.in[16], DEPTH, 128, 512, WSB(WT_UKV), 512, bid, nblk, lds);
        job_pack_small(p, bid, nblk);
        job_cvt(p.in[0], WSB(WS_X0B), (long)T * 1024, bid, nblk);
        job_cvt(p.in[1], WSB(WS_MEMB), (long)2048 * 1024, bid, nblk);
    });
    PHASE(1, {
        pg8::Gemm g{WSB(WS_MEMB), WSB(WT_KV), BATCH * MEM_LEN, 1024, 1024, nullptr};
        GroupedOrder S{8, 4, DEPTH, nblk, bid};
        EpiStoreBf16 E{WSB(WS_KVM), 1024, 1 << 30, (long)2048 * 1024};
        GEMM256(EpiStoreBf16, GroupedOrder, g, S, E);
    });
    }
    for (int layer_ = 0; layer_ < DEPTH; ++layer_) {
        const int base = 2 + layer_ * NPH;
        PHASE(base + 0, { pg8::Gemm g{XinB, w.t_in, T, NH, 1024, nullptr}; pg8::StaticOrder S; S.init(T, NH, nblk, bid); EpiStoreBf16 E{WSB(WS_H), NH, O_MG / 128, 0}; GEMM256(EpiStoreBf16, pg8::StaticOrder, g, S, E); });
        PHASE(base + 1, { job_sb_attn(p, bid, nblk, lds); job_cmp_gather(p, w, bid, nblk); job_rnn_conv(p, w, bid, nblk); job_mla_norm(p, w, bid, nblk); });
        PHASE(base + 2, { if (bid < 32) job_cmp_mlp<0>(p, w, bid, 32, lds); else { job_rnn_gates(p, w, bid - 32, nblk - 32, lds); job_mla_up(p, w, bid - 32, nblk - 32, lds); } });
        PHASE(base + 3, { job_cmp_mlp<1>(p, w, bid, nblk, lds); job_rnn_scan1(p, bid, nblk); });
        PHASE(base + 4, { job_nsa(p, bid, nblk, lds); job_mla_attn(p, bid, nblk, lds); job_rnn_scan2(p, bid, nblk); });
        PHASE(base + 5, { job_merge(p, w, bid, nblk, lds); });
        PHASE(base + 6, { pg8::Gemm g{WSB(WS_M), w.t_out, T, 1024, 1024, nullptr}; pg8::StaticOrder S; S.init(T, 1024, nblk, bid); EpiStoreBf16 E{WSB(WS_Y), 1024, 1 << 30, 0}; GEMM256(EpiStoreBf16, pg8::StaticOrder, g, S, E); });
        PHASE(base + 7, { job_ln(layer == 0 ? p.in[0] : nullptr, WSB(WS_XCB), nullptr, WSB(WS_Y), nullptr, nullptr, w.ln1_g, w.ln1_b, nullptr, WSB(WS_XAB), nullptr, bid, nblk); });
        PHASE(base + 8, { pg8::Gemm g{WSB(WS_XAB), w.t_q, T, 512, 1024, nullptr}; pg8::StaticOrder S; S.init(T, 512, nblk, bid); EpiStoreBf16 E{WSB(WS_XQ), 512, 1 << 30, 0}; GEMM256(EpiStoreBf16, pg8::StaticOrder, g, S, E); });
        PHASE(base + 9, { job_cross_attn(p, layer, bid, nblk, lds); });
        PHASE(base + 10, { pg8::Gemm g{WSB(WS_XO), w.t_o, T, 1024, 512, nullptr}; pg8::StaticOrder S; S.init(T, 1024, nblk, bid); EpiStoreBf16 E{WSB(WS_Y), 1024, 1 << 30, 0}; GEMM256(EpiStoreBf16, pg8::StaticOrder, g, S, E); });
        PHASE(base + 11, { job_ln(nullptr, WSB(WS_XAB), nullptr, WSB(WS_Y), nullptr, nullptr, w.ln2_g, w.ln2_b, nullptr, WSB(WS_XBB), WSB(WS_XBL), bid, nblk); });
        PHASE(base + 12, { job_router_logits(p, w, bid, nblk, lds); });
        PHASE(base + 13, { job_router(p, w, layer, bid, nblk); });
        PHASE(base + 14, { job_fill(p, layer, bid, nblk, lds); });
        PHASE(base + 15, { const pg8::ListOrder S = moe_units(WSU(WS_CTL) + CW_CNT + layer * 32, bid, nblk); pg8::Gemm g{WSB(WS_XBB), w.t_gu, PADROWS, 1024, 1024, WSI(WS_PERM)}; EpiMoeGU E{WSB(WS_HH)}; __syncthreads(); pg8::gemm_phase<EpiMoeGU, pg8::ListOrder, true, true, true>(LDS3, g, S, E); });
        PHASE(base + 16, { const pg8::ListOrder S = moe_units(WSU(WS_CTL) + CW_CNT + layer * 32, bid, nblk); pg8::Gemm g{WSB(WS_HH), w.t_dn, PADROWS, 1024, 512, nullptr}; EpiStoreBf16 E{WSB(WS_YK), 1024, 1 << 30, 0}; GEMM256(EpiStoreBf16, pg8::ListOrder, g, S, E); });
        PHASE(base + 17, { job_ln(nullptr, WSB(WS_XBB), WSB(WS_XBL), WSB(WS_YK), WSI(WS_ROWOF), WSF(WS_EW), w.ln3_g, w.ln3_b, (layer == DEPTH - 1) ? p.out : nullptr, (layer == DEPTH - 1) ? nullptr : WSB(WS_XCB), nullptr, bid, nblk); });
    }
}

extern "C" void kernel_launch(void* const* d_in, const int* in_sizes, int n_in, void* d_out, int out_size, void* d_ws, size_t ws_size, hipStream_t stream) {
    constexpr size_t kDynLds = 131072 + 1024;
    static_assert(2 * G_STAGE + 1024 <= 131072, "engine stages fit");
    static int grid = 0;
    if (!grid) {
        int dev = 0, cus = 0, per_cu = 0;
        (void)hipGetDevice(&dev);
        (void)hipDeviceGetAttribute(&cus, hipDeviceAttributeMultiprocessorCount, dev);
        (void)hipFuncSetAttribute((const void*)mega, hipFuncAttributeMaxDynamicSharedMemorySize, (int)kDynLds);
        (void)hipOccupancyMaxActiveBlocksPerMultiprocessor(&per_cu, mega, NT, kDynLds);
        if (per_cu < 1) per_cu = 1;
        grid = cus * (per_cu < 2 ? per_cu : 2);
    }
    if (ws_size < WS_END) { fprintf(stderr, "workspace too small: %zu < %zu\n", ws_size, (size_t)WS_END); return; }
    Params p{};
    for (int i = 0; i < 34; ++i) p.in[i] = (const float*)d_in[i];
    p.out = (float*)d_out;
    p.ws = (unsigned char*)d_ws;
    (void)hipMemsetAsync(d_ws, 0, CTL_BYTES, stream);
#if MK_ONE_LAUNCH
    hipLaunchKernelGGL(mega, dim3(grid), dim3(NT), kDynLds, stream, p, 0, NPHASES);
#else
    for (int ph = 0; ph < NPHASES; ++ph) hipLaunchKernelGGL(mega, dim3(grid), dim3(NT), kDynLds, stream, p, ph, ph + 1);
#endif
}
```

```cpp
#include <hip/hip_runtime.h>
#include <stdint.h>
#include <stdio.h>

#ifndef MK_ONE_LAUNCH
#define MK_ONE_LAUNCH 1
#endif

#define DI __device__ __forceinline__
#define LAS __attribute__((address_space(3)))
DI int tidx() { int t = threadIdx.x; asm volatile("" : "+v"(t)); return t; }

constexpr int NT = 512;
constexpr int D = 1024, BATCH = 8, SEQ = 2048, T = BATCH * SEQ, DEPTH = 4;
constexpr int MEM_LEN = 256;
constexpr int NIN = 6764, NH = 6912;
constexpr int O_AQ = 0, O_AKC = 256, O_AVC = 384, O_AKS = 512, O_AVS = 640, O_AKW = 768, O_AVW = 896,
              O_BQ = 1024, O_BK = 1280, O_BV = 1536, O_CX = 1792, O_CG = 2048, O_DCQ = 2304, O_DCKV = 2496, O_DKR = 2624,
              O_AG = 2656, O_MG = 2688;
constexpr int NCMP = 127, NCR = BATCH * NCMP * 2;
constexpr int NEXP = 32, NASSIGN = T * 2;
constexpr int PCAP = T;
constexpr float DN_ALPHA = 1.681792830507429f;

typedef unsigned short bf16_t;
typedef short bf16x8 __attribute__((ext_vector_type(8)));
typedef float f32x16 __attribute__((ext_vector_type(16)));
typedef unsigned u32x4 __attribute__((ext_vector_type(4)));

constexpr int G_WM = NT / 128;
constexpr int G_BM = 64 * G_WM;
constexpr int G_BN = 128;
constexpr int G_RS = 144;
constexpr int G_STAGE = (G_BM + G_BN) * G_RS;
constexpr int PADROWS = ((NASSIGN + NEXP * (G_BM - 1) + G_BM - 1) / G_BM) * G_BM;

constexpr size_t MiB = 1u << 20;
constexpr size_t al(size_t x) { return (x + 255) & ~(size_t)255; }
constexpr size_t WS_CTL = 0, CTL_BYTES = 1 * MiB;
constexpr size_t WT_IN = WS_CTL + CTL_BYTES;
constexpr size_t WT_BR = WT_IN + al((size_t)DEPTH * NH * 1024 * 2);
constexpr size_t WT_OUT = WT_BR + al((size_t)DEPTH * 4 * 1024 * 256 * 2);
constexpr size_t WT_Q = WT_OUT + al((size_t)DEPTH * 1024 * 1024 * 2);
constexpr size_t WT_KV = WT_Q + al((size_t)DEPTH * 512 * 1024 * 2);
constexpr size_t WT_O = WT_KV + al((size_t)DEPTH * 1024 * 1024 * 2);
constexpr size_t WT_GU = WT_O + al((size_t)DEPTH * 1024 * 512 * 2);
constexpr size_t WT_DN = WT_GU + al((size_t)DEPTH * 32 * 1024 * 1024 * 2);
constexpr size_t WS_X0B = WT_DN + al((size_t)DEPTH * 32 * 1024 * 512 * 2);
constexpr size_t WS_MEMB = WS_X0B + al((size_t)T * 1024 * 2);
constexpr size_t WS_H = WS_MEMB + al((size_t)2048 * 1024 * 2);
constexpr size_t SZ_H = al((size_t)T * NH * 2);
constexpr size_t WS_YK = WS_H;
constexpr size_t WS_HH = WS_YK + (size_t)PADROWS * 1024 * 2;
static_assert(WS_HH + (size_t)PADROWS * 512 * 2 <= WS_H + SZ_H, "moe overlay fits in H");
constexpr size_t WS_TB = WS_H + SZ_H;
constexpr size_t WS_HID = WS_TB + al((size_t)2 * NCR * 2048 * 4);
constexpr size_t WS_KCVC = WS_HID + al((size_t)2 * NCR * 256 * 4);
constexpr size_t WS_PC = WS_KCVC + al((size_t)2 * NCR * 64 * 4);
constexpr size_t WS_SEL = WS_PC + al((size_t)BATCH * 4 * SEQ * 128 * 4);
constexpr size_t WS_OW = WS_SEL + al((size_t)BATCH * 2 * SEQ * 4);
constexpr size_t WS_OC = WS_OW + al((size_t)T * 256 * 4);
constexpr size_t WS_BR = WS_OC + al((size_t)T * 256 * 4);
constexpr size_t WS_U = WS_BR + al((size_t)T * 1024 * 2);
constexpr size_t WS_RA = WS_U + al((size_t)T * 256 * 4);
constexpr size_t WS_RB = WS_RA + al((size_t)T * 256 * 4);
constexpr size_t WS_CQN = WS_RB + al((size_t)T * 256 * 4);
constexpr size_t WS_CKVN = WS_CQN + al((size_t)T * 192 * 4);
constexpr size_t WS_KR = WS_CKVN + al((size_t)T * 128 * 4);
constexpr size_t WS_Q = WS_KR + al((size_t)T * 32 * 4);
constexpr size_t WS_KV = WS_Q + al((size_t)T * 384 * 4);
constexpr size_t WS_M = WS_KV + al((size_t)T * 512 * 4);
constexpr size_t WS_Y = WS_M + al((size_t)T * 1024 * 2);
constexpr size_t WS_XA = WS_Y + al((size_t)T * 1024 * 4);
constexpr size_t WS_XB = WS_XA + al((size_t)T * 1024 * 4);
constexpr size_t WS_XC = WS_XB + al((size_t)T * 1024 * 4);
constexpr size_t WS_XAB = WS_XC + al((size_t)T * 1024 * 4);
constexpr size_t WS_XBB = WS_XAB + al((size_t)T * 1024 * 2);
constexpr size_t WS_XCB = WS_XBB + al((size_t)T * 1024 * 2);
constexpr size_t WS_XQ = WS_XCB + al((size_t)T * 1024 * 2);
constexpr size_t WS_XO = WS_XQ + al((size_t)T * 512 * 2);
constexpr size_t WS_KVM = WS_XO + al((size_t)T * 512 * 2);
constexpr size_t WS_LOG = WS_KVM + al((size_t)DEPTH * 2048 * 1024 * 2);
constexpr size_t WS_EIDX = WS_LOG + al((size_t)3 * T * 36 * 4);
constexpr size_t WS_ESLOT = WS_EIDX + al((size_t)NASSIGN * 4);
constexpr size_t WS_EW = WS_ESLOT + al((size_t)NASSIGN * 4);
constexpr size_t WS_PERM = WS_EW + al((size_t)NASSIGN * 4);
constexpr size_t WS_QB = WS_PERM + al((size_t)NEXP * T * 4);
constexpr size_t WS_KM = WS_QB + al((size_t)T * 384 * 2);
constexpr size_t WS_VM = WS_KM + al((size_t)T * 384 * 2);
constexpr size_t WS_KCB = WS_VM + al((size_t)T * 256 * 2);
constexpr size_t WT_C1 = WS_KCB + al((size_t)2 * NCR * 64 * 2);
constexpr size_t WT_C2 = WT_C1 + al((size_t)DEPTH * 2 * 256 * 2048 * 2);
constexpr size_t WT_UQ = WT_C2 + al((size_t)DEPTH * 2 * 128 * 256 * 2);
constexpr size_t WT_UKV = WT_UQ + al((size_t)DEPTH * 384 * 192 * 2);
constexpr size_t WT_G = WT_UKV + al((size_t)DEPTH * 512 * 128 * 2);
constexpr size_t WT_RH = WT_G + al((size_t)DEPTH * 4 * 128 * 64 * 2);
constexpr size_t WT_RL = WT_RH + al((size_t)DEPTH * 128 * 1024 * 2);
constexpr size_t WS_TBB = WT_RL + al((size_t)DEPTH * 128 * 1024 * 2);
constexpr size_t WS_HIDB = WS_TBB + al((size_t)2 * 2048 * 2048 * 2);
constexpr size_t WS_UB = WS_HIDB + al((size_t)2 * 2048 * 256 * 2);
constexpr size_t WS_CQNB = WS_UB + al((size_t)T * 256 * 2);
constexpr size_t WS_CKVNB = WS_CQNB + al((size_t)T * 192 * 2);
constexpr size_t WS_XBL = WS_CKVNB + al((size_t)T * 128 * 2);
constexpr size_t WS_SA = WS_XBL + al((size_t)T * 1024 * 2);
constexpr size_t WS_SH = WS_SA + al((size_t)BATCH * 32 * 256 * 4);
constexpr size_t WS_XG = WS_SH + al((size_t)BATCH * 32 * 256 * 4);
constexpr size_t WS_ROWOF = WS_XG + al((size_t)PADROWS * 1024 * 2);
constexpr size_t WS_ROPE_PRE = WS_ROWOF + al((size_t)NASSIGN * 4);
constexpr size_t WS_ROPE = WS_ROPE_PRE;
constexpr size_t WS_END = WS_ROPE + al((size_t)SEQ * 16 * 2 * 4);

constexpr int CW_BAR = 4096;
constexpr int CW_CNT = 16384;

struct Params {
    const float* in[34];
    float* out;
    unsigned char* ws;
};

#define XB_TMO      128
#define XB_XCNT(j)  (256  + 64 * (j))
#define XB_XSUB(j)  (1280 + 64 * (j))
#define XB_XGEN(j)  (2304 + 64 * (j))
#define XB_TOP      3328
#define XB_TOPGEN   3392
#define XCD_BAR_WORDS 3456
#define XB_SPIN_CAP (1u << 22)

__device__ __forceinline__ unsigned xb_ld(unsigned* p)              { return __hip_atomic_load(p, __ATOMIC_RELAXED, __HIP_MEMORY_SCOPE_AGENT); }
__device__ __forceinline__ unsigned xb_add(unsigned* p, unsigned v) { return __hip_atomic_fetch_add(p, v, __ATOMIC_RELAXED, __HIP_MEMORY_SCOPE_AGENT); }
__device__ __forceinline__ unsigned xb_xcc_id() { return (unsigned)__builtin_amdgcn_s_getreg((3 << 11) | 20) & 0xFu; }
#define XB_SPIN(cond, bar) do { unsigned _sp = 0; while (cond) { __builtin_amdgcn_s_sleep(1); \
    if ((++_sp & 255u) == 0u) { if (xb_ld(&(bar)[XB_TMO])) break; if (_sp > XB_SPIN_CAP) { atomicAdd(&(bar)[XB_TMO], 1u); break; } } } } while (0)

struct XcdBarrier { unsigned* bar; unsigned x; volatile LAS unsigned* st; };

__device__ __forceinline__ XcdBarrier xcd_barrier_post(unsigned* bar, volatile LAS unsigned* st) {
    XcdBarrier b; b.bar = bar; b.x = xb_xcc_id(); b.st = st;
    if (threadIdx.x == 0) (void)xb_add(&bar[XB_XCNT(b.x)], 1u);
    return b;
}
__device__ __forceinline__ void xcd_barrier_complete(unsigned* bar, unsigned x, unsigned& nloc, unsigned& nx) {
    const unsigned G = gridDim.x * gridDim.y * gridDim.z;
    unsigned sum, cnt, mine, sp = 0u;
    for (;;) {
        sum = 0u; cnt = 0u; mine = 0u;
#pragma unroll
        for (unsigned j = 0; j < 16; ++j) { const unsigned c = xb_ld(&bar[XB_XCNT(j)]); sum += c; cnt += (c > 0u) ? 1u : 0u; mine = (j == x) ? c : mine; }
        if (sum == G) break;
        __builtin_amdgcn_s_sleep(1);
        if ((++sp & 255u) == 0u) { if (xb_ld(&bar[XB_TMO])) break; if (sp > XB_SPIN_CAP) { atomicAdd(&bar[XB_TMO], 1u); break; } }
    }
    nloc = mine > 0u ? mine : 1u; nx = cnt > 0u ? cnt : 1u;
}
__device__ __forceinline__ void xcd_barrier(const XcdBarrier& b) {
    asm volatile("s_waitcnt vmcnt(0)" ::: "memory");
    __syncthreads();
    if (threadIdx.x == 0) {
        unsigned* bar = b.bar;
        __builtin_amdgcn_s_waitcnt(0);
        unsigned nloc = b.st[0], nx = b.st[1];
        if (nloc == 0u) { xcd_barrier_complete(bar, b.x, nloc, nx); b.st[0] = nloc; b.st[1] = nx; }
        const unsigned old = xb_add(&bar[XB_XSUB(b.x)], 1u);
        const unsigned gen = old / nloc;
        if (old + 1u == (gen + 1u) * nloc) {
            __builtin_amdgcn_fence(__ATOMIC_RELEASE, "agent");
            asm volatile("s_waitcnt vmcnt(0)" ::: "memory");
            const unsigned og = xb_add(&bar[XB_TOP], 1u);
            const unsigned tg = og / nx;
            if (og + 1u == (tg + 1u) * nx) xb_add(&bar[XB_TOPGEN], 1u);
            else XB_SPIN(xb_ld(&bar[XB_TOPGEN]) == tg, bar);
            __builtin_amdgcn_fence(__ATOMIC_ACQUIRE, "agent");
            xb_add(&bar[XB_XGEN(b.x)], 1u);
            asm volatile("s_waitcnt vmcnt(0)" ::: "memory");
        } else {
            XB_SPIN(xb_ld(&bar[XB_XGEN(b.x)]) == gen, bar);
            __builtin_amdgcn_fence(__ATOMIC_ACQUIRE, "agent");
            asm volatile("s_waitcnt vmcnt(0)" ::: "memory");
        }
    }
    __syncthreads();
}

DI float gelu_tanh(float x) { const float u = 0.7978845608028654f * (x + 0.044715f * x * x * x); return 0.5f * x * (1.f + tanhf(u)); }
DI float sigm(float x) { return 1.f / (1.f + expf(-x)); }
DI float sigm_fast(float x) { return __builtin_amdgcn_rcpf(1.f + __expf(-x)); }
DI float logsig(float z) { return fminf(z, 0.f) - log1pf(expf(-fabsf(z))); }
DI float wave_sum(float v) {
    const int lane = tidx() & 63;
#pragma unroll
    for (int o = 32; o > 0; o >>= 1) v += __int_as_float(__builtin_amdgcn_ds_bpermute((lane ^ o) << 2, __float_as_int(v)));
    return v;
}
DI void wave_sum2(float& a, float& b) {
    const int lane = tidx() & 63;
#pragma unroll
    for (int o = 32; o > 0; o >>= 1) {
        const float a2 = __int_as_float(__builtin_amdgcn_ds_bpermute((lane ^ o) << 2, __float_as_int(a)));
        const float b2 = __int_as_float(__builtin_amdgcn_ds_bpermute((lane ^ o) << 2, __float_as_int(b)));
        a += a2; b += b2;
    }
}

DI float bflo(unsigned u) { return __uint_as_float(u << 16); }
DI float bfhi(unsigned u) { return __uint_as_float(u & 0xffff0000u); }
DI float bf2f(bf16_t x) { return __uint_as_float((unsigned)x << 16); }
typedef float f32x2_t __attribute__((ext_vector_type(2)));
typedef __bf16 bf16x2_t __attribute__((ext_vector_type(2)));
DI unsigned pk_bf16(float lo, float hi) { f32x2_t v = {lo, hi}; bf16x2_t b = __builtin_convertvector(v, bf16x2_t); return __builtin_bit_cast(unsigned, b); }
DI bf16_t f2bf(float x) { return (bf16_t)(pk_bf16(x, 0.f) & 0xffffu); }
DI void st4bf(bf16_t* p, float a, float b, float c, float d) { uint2 v; v.x = pk_bf16(a, b); v.y = pk_bf16(c, d); *(uint2*)p = v; }
DI void ld8f(const bf16_t* p, float* f) { const u32x4 v = *(const u32x4*)p; f[0] = bflo(v[0]); f[1] = bfhi(v[0]); f[2] = bflo(v[1]); f[3] = bfhi(v[1]); f[4] = bflo(v[2]); f[5] = bfhi(v[2]); f[6] = bflo(v[3]); f[7] = bfhi(v[3]); }
DI void st8bf(bf16_t* p, const float* f) { u32x4 v; v[0] = pk_bf16(f[0], f[1]); v[1] = pk_bf16(f[2], f[3]); v[2] = pk_bf16(f[4], f[5]); v[3] = pk_bf16(f[6], f[7]); *(u32x4*)p = v; }
DI float4 ld4bf(const bf16_t* p) { const uint2 v = *(const uint2*)p; return make_float4(bflo(v.x), bfhi(v.x), bflo(v.y), bfhi(v.y)); }
template <int N> DI float dot_row(const float* q, const bf16_t* kr) {
    float dot = 0.f;
#pragma unroll
    for (int d = 0; d < N; d += 8) { const uint4 v = *(const uint4*)(kr + d);
        dot = fmaf(q[d], bflo(v.x), dot); dot = fmaf(q[d + 1], bfhi(v.x), dot); dot = fmaf(q[d + 2], bflo(v.y), dot); dot = fmaf(q[d + 3], bfhi(v.y), dot);
        dot = fmaf(q[d + 4], bflo(v.z), dot); dot = fmaf(q[d + 5], bfhi(v.z), dot); dot = fmaf(q[d + 6], bflo(v.w), dot); dot = fmaf(q[d + 7], bfhi(v.w), dot); }
    return dot;
}
template <int N> DI float dot_row(const float* q, const float* kr) {
    float dot = 0.f;
#pragma unroll
    for (int d = 0; d < N; ++d) dot = fmaf(q[d], kr[d], dot);
    return dot;
}
template <int N> DI void axpy_row(float* o, float pr, float corr, const bf16_t* vr) {
#pragma unroll
    for (int d = 0; d < N; d += 8) { const uint4 v = *(const uint4*)(vr + d);
        o[d] = fmaf(pr, bflo(v.x), o[d] * corr); o[d + 1] = fmaf(pr, bfhi(v.x), o[d + 1] * corr); o[d + 2] = fmaf(pr, bflo(v.y), o[d + 2] * corr); o[d + 3] = fmaf(pr, bfhi(v.y), o[d + 3] * corr);
        o[d + 4] = fmaf(pr, bflo(v.z), o[d + 4] * corr); o[d + 5] = fmaf(pr, bfhi(v.z), o[d + 5] * corr); o[d + 6] = fmaf(pr, bflo(v.w), o[d + 6] * corr); o[d + 7] = fmaf(pr, bfhi(v.w), o[d + 7] * corr); }
}
template <int N> DI void axpy_row(float* o, float pr, float corr, const float* vr) {
#pragma unroll
    for (int d = 0; d < N; ++d) o[d] = fmaf(pr, vr[d], o[d] * corr);
}
template <int N> DI void ld_row(float* q, const bf16_t* p) {
#pragma unroll
    for (int d = 0; d < N; d += 8) { const uint4 v = *(const uint4*)(p + d);
        q[d] = bflo(v.x); q[d + 1] = bfhi(v.x); q[d + 2] = bflo(v.y); q[d + 3] = bfhi(v.y); q[d + 4] = bflo(v.z); q[d + 5] = bfhi(v.z); q[d + 6] = bflo(v.w); q[d + 7] = bfhi(v.w); }
}
template <int N> DI void ld_row(float* q, const float* p) {
#pragma unroll
    for (int d = 0; d < N; d += 4) { const float4 v = *(const float4*)(p + d); q[d] = v.x; q[d + 1] = v.y; q[d + 2] = v.z; q[d + 3] = v.w; }
}

struct MG { const bf16_t* A; long lda; const bf16_t* Wt; long ldw; int K; };

struct NoFlush { DI void operator()(int, f32x16 (&)[2][2]) const {} };
template <class RowFn, class Flush>
DI void mgemm_tile_f(const MG& g, int n0, RowFn rowfn, f32x16 (&acc)[2][2], unsigned char* lds, bool zero, int flush_every, Flush flush) {
    constexpr int XI = G_BM * 8 / NT, WI = G_BN * 8 / NT;
    const int tid = tidx(), lane = tid & 63, wid = tid >> 6, r = lane & 31, h = lane >> 5;
    const int wm = wid % G_WM, wn = wid / G_WM;
    const int cc = tid & 7, row0 = tid >> 3;
    const bf16_t* xp[XI]; const bf16_t* wp[WI];
#pragma unroll
    for (int i = 0; i < XI; ++i) xp[i] = g.A + (long)rowfn(row0 + (NT / 8) * i) * g.lda + cc * 8;
#pragma unroll
    for (int i = 0; i < WI; ++i) wp[i] = g.Wt + (long)(n0 + row0 + (NT / 8) * i) * g.ldw + cc * 8;
    const int st_off = row0 * G_RS + cc * 16;
    if (zero)
#pragma unroll
    for (int a = 0; a < 2; ++a)
#pragma unroll
        for (int b = 0; b < 2; ++b)
#pragma unroll
            for (int i = 0; i < 16; ++i) acc[a][b][i] = 0.f;
    const int nk = g.K >> 6;
    u32x4 xv0[XI], wv0[WI], xv1[XI], wv1[WI];
#define MG_GLOAD(XV, WV, KT) do { _Pragma("unroll") for (int i = 0; i < XI; ++i) XV[i] = *(const u32x4*)(xp[i] + (KT) * 64); \
                                  _Pragma("unroll") for (int i = 0; i < WI; ++i) WV[i] = *(const u32x4*)(wp[i] + (KT) * 64); } while (0)
#define MG_LSTORE(XV, WV, STG) do { unsigned char* _s = lds + (STG) * G_STAGE; \
        _Pragma("unroll") for (int i = 0; i < XI; ++i) *(u32x4*)(_s + st_off + (NT / 8) * i * G_RS) = XV[i]; \
        _Pragma("unroll") for (int i = 0; i < WI; ++i) *(u32x4*)(_s + G_BM * G_RS + st_off + (NT / 8) * i * G_RS) = WV[i]; } while (0)
    MG_GLOAD(xv0, wv0, 0);
    if (nk > 1) MG_GLOAD(xv1, wv1, 1);
    __syncthreads();
    MG_LSTORE(xv0, wv0, 0);
    if (nk > 2) MG_GLOAD(xv0, wv0, 2);
    __syncthreads();
    const int xf_off = (wm * 64 + r) * G_RS + h * 16, wf_off = G_BM * G_RS + (wn * 64 + r) * G_RS + h * 16;
#define MG_COMPUTE(STG) do { const unsigned char* st = lds + (STG) * G_STAGE; \
        _Pragma("unroll") for (int ks = 0; ks < 4; ++ks) { \
            const bf16x8 w0 = *(const bf16x8*)(st + wf_off + ks * 32), w1 = *(const bf16x8*)(st + wf_off + 32 * G_RS + ks * 32); \
            const bf16x8 x0 = *(const bf16x8*)(st + xf_off + ks * 32), x1 = *(const bf16x8*)(st + xf_off + 32 * G_RS + ks * 32); \
            acc[0][0] = __builtin_amdgcn_mfma_f32_32x32x16_bf16(w0, x0, acc[0][0], 0, 0, 0); \
            acc[0][1] = __builtin_amdgcn_mfma_f32_32x32x16_bf16(w0, x1, acc[0][1], 0, 0, 0); \
            acc[1][0] = __builtin_amdgcn_mfma_f32_32x32x16_bf16(w1, x0, acc[1][0], 0, 0, 0); \
            acc[1][1] = __builtin_amdgcn_mfma_f32_32x32x16_bf16(w1, x1, acc[1][1], 0, 0, 0); } } while (0)
    for (int kt = 0; kt < nk; kt += 2) {
        MG_COMPUTE(0);
        if (kt + 1 < nk) { MG_LSTORE(xv1, wv1, 1); if (kt + 3 < nk) MG_GLOAD(xv1, wv1, kt + 3); }
        if (flush_every && (kt + 1) % flush_every == 0) flush(kt / flush_every, acc);
        __syncthreads();
        if (kt + 1 < nk) {
            MG_COMPUTE(1);
            if (kt + 2 < nk) { MG_LSTORE(xv0, wv0, 0); if (kt + 4 < nk) MG_GLOAD(xv0, wv0, kt + 4); }
            if (flush_every && (kt + 2) % flush_every == 0) flush((kt + 1) / flush_every, acc);
            __syncthreads();
        }
    }
#undef MG_GLOAD
#undef MG_LSTORE
#undef MG_COMPUTE
}
template <class RowFn>
DI void mgemm_tile(const MG& g, int n0, RowFn rowfn, f32x16 (&acc)[2][2], unsigned char* lds, bool zero = true) { mgemm_tile_f(g, n0, rowfn, acc, lds, zero, 0, NoFlush{}); }
#define MG_FOREACH(acc, LROW, FEAT, V, ...) do { const int _l = tidx() & 63, _w = tidx() >> 6, _wm = _w % G_WM, _wn = _w / G_WM; \
    _Pragma("unroll") for (int _ft = 0; _ft < 2; ++_ft) _Pragma("unroll") for (int _tt = 0; _tt < 2; ++_tt) _Pragma("unroll") for (int _i = 0; _i < 4; ++_i) { \
        const int LROW = _wm * 64 + _tt * 32 + (_l & 31); const int FEAT = _wn * 64 + _ft * 32 + 8 * _i + 4 * (_l >> 5); \
        float V[4] = {acc[_ft][_tt][4 * _i], acc[_ft][_tt][4 * _i + 1], acc[_ft][_tt][4 * _i + 2], acc[_ft][_tt][4 * _i + 3]}; __VA_ARGS__ } } while (0)

struct RowId { int m0; DI long operator()(int r) const { return m0 + r; } };

template <int OUTMODE>
DI void mgemm_job(const MG& g, int M, int N, void* out, long ldo, int bid, int nblk, unsigned char* lds) {
    const int tm = M / G_BM, tn = N / G_BN;
    for (int u = bid; u < tm * tn; u += nblk) {
        const int grp = u / (16 * tn), rem = u % (16 * tn);
        const int gm = (tm - grp * 16) < 16 ? (tm - grp * 16) : 16;
        const int mt = grp * 16 + rem % gm, nt = rem / gm;
        const int m0 = mt * G_BM, n0 = nt * G_BN;
        f32x16 acc[2][2];
        mgemm_tile(g, n0, RowId{m0}, acc, lds);
        MG_FOREACH(acc, lrow, feat, v, {
            const long o = (long)(m0 + lrow) * ldo + n0 + feat;
            if (OUTMODE == 1) *(float4*)((float*)out + o) = make_float4(v[0], v[1], v[2], v[3]);
            else {
                if (OUTMODE == 2 && n0 + feat >= O_MG) { v[0] = sigm(v[0]); v[1] = sigm(v[1]); v[2] = sigm(v[2]); v[3] = sigm(v[3]); }
                st4bf((bf16_t*)out + o, v[0], v[1], v[2], v[3]);
            } });
    }
}

namespace pg8 {
#define PG8_LAS __attribute__((address_space(3)))
typedef float f32x4 __attribute__((ext_vector_type(4)));
constexpr int BM = 256, BK = 64, HALF = 128, HTB = HALF * BK * 2  , STAGE_BYTES = 8 * HTB, NXCD = 8, WGM = 8;
__host__ __device__ __forceinline__ int lds_byte(int r, int c) { const int st = (r >> 4) * 2 + (c >> 5), rr = r & 15, cc = c & 31, ob = rr * 64 + cc * 2; return st * 1024 + (ob ^ (((ob >> 9) & 1) << 5)); }
__host__ __device__ __forceinline__ void stage_rc(int b, int& R, int& C) { const int st = b / 1024, sb = b % 1024, swz = sb ^ (((sb >> 9) & 1) << 5); R = (st >> 1) * 16 + swz / 64; C = (st & 1) * 32 + (swz % 64) / 2; }
__host__ __device__ __forceinline__ int perm32(int rho) { const int n = rho >> 4, i = rho & 15; return 8 * (i >> 2) + 4 * n + (i & 3); }
struct Unit { int pm, pn, e, gt, nv; };
struct Gemm { const bf16_t* A; const bf16_t* Bt; int M, N, K; const int* rowidx; };
struct StaticOrder {
    int nM, nN, nwg, G, c;
    __device__ void init(int M, int N, int G_, int c_) { nM = M / BM; nN = N / BM; nwg = nM * nN; G = G_; c = c_; }
    __device__ bool next(int i, Unit& u) const {
        const long L = (long)i * G + c; if (L >= nwg) return false;
        int wgid = (int)L; { const int q = nwg / NXCD, r = nwg % NXCD, xcd = wgid % NXCD, off = wgid / NXCD; wgid = (xcd < r ? xcd * (q + 1) : r * (q + 1) + (xcd - r) * q) + off; }
        const int nig = WGM * nN, gid = wgid / nig, fm = gid * WGM, gsz = (nM - fm) < WGM ? (nM - fm) : WGM;
        u.pm = fm + ((wgid % nig) % gsz); u.pn = (wgid % nig) / gsz; u.e = 0; u.gt = 0; u.nv = 0; return true;
    }
    __device__ __forceinline__ void a_ready(const Unit&) const {}
    __device__ __forceinline__ void done(const Unit&) const {}
};
struct ListOrder {
    Unit u0, u1, u2; int n;
    __device__ bool next(int i, Unit& u) const { if (i >= n) return false; u = (i == 0) ? u0 : ((i == 1) ? u1 : u2); return true; }
    __device__ __forceinline__ void a_ready(const Unit&) const {}
    __device__ __forceinline__ void done(const Unit&) const {}
};
template <class Epi, class Sched, bool ALIGN_EPI = false, bool SP2 = false, bool GATHER = false>
__device__ __forceinline__ void gemm_phase(PG8_LAS unsigned char* lds, const Gemm g, const Sched& S, const Epi& E) {
    const int tid = tidx(), wid = __builtin_amdgcn_readfirstlane(tid >> 6), lane = tid & 63, wr = wid >> 2, wc = wid & 3, fr = lane & 15, fq = lane >> 4;
    const int K = g.K, nt = K / BK;
    unsigned voffA[2], voffB[2];
#pragma unroll
    for (int i = 0; i < 2; ++i) { int R, C; stage_rc(tid * 16 + i * 8192, R, C); const int Rb = Epi::PERM ? ((R & ~31) + perm32(R & 31)) : R;
        voffA[i] = (unsigned)(R * K + C) * 2u; voffB[i] = (unsigned)(Rb * K + C) * 2u; }
    unsigned voffC[2][2] = {{0u, 0u}, {0u, 0u}}, voffN[2][2] = {{0u, 0u}, {0u, 0u}};
    auto gather_offs = [&](const Unit& uu, unsigned (&vo)[2][2]) {
#pragma unroll
        for (int hh = 0; hh < 2; ++hh)
#pragma unroll
            for (int i = 0; i < 2; ++i) { int R, C; stage_rc(tid * 16 + i * 8192, R, C); const int lr = hh * HALF + R; int a = g.rowidx[uu.gt * BM + lr]; a = lr < uu.nv ? (a >> 1) : 0; vo[hh][i] = (unsigned)(a * K + C) * 2u; }
    };
    const size_t kstep = (size_t)(BK * 2);
    const size_t hstep = (size_t)HALF * K * 2;
    const size_t tstep = 2 * hstep;
    const size_t estep = (size_t)g.N * K * 2;
    const unsigned ldsw = (unsigned)wid * 1024u;
    const int aoff = lds_byte(wr * 64 + fr, fq * 8), boff = lds_byte(wc * 32 + fr, fq * 8);
#define PG8_SA(b, h) (((b) * 2 + (h)) * HTB)
#define PG8_SB(b, h) ((4 + (b) * 2 + (h)) * HTB)
#define PG8_STAGE(bufoff, gbase, voff) do { _Pragma("unroll") for (int _i = 0; _i < 2; ++_i) \
        __builtin_amdgcn_global_load_lds((const unsigned*)((const char*)(gbase) + (voff)[_i]), (PG8_LAS unsigned*)(lds + (bufoff) + ldsw + _i * 8192), 16, 0, 0); } while (0)
#define PG8_STAGE_A(bufoff, HH, KT, NX, densebase) do { if constexpr (GATHER) { const char* _gb = (const char*)g.A + (size_t)(KT) * kstep; if (NX) PG8_STAGE(bufoff, _gb, voffN[HH]); else PG8_STAGE(bufoff, _gb, voffC[HH]); } else PG8_STAGE(bufoff, densebase, voffA); } while (0)
#define PG8_LDA(dst, b, h) do { _Pragma("unroll") for (int m = 0; m < 4; ++m) _Pragma("unroll") for (int k = 0; k < 2; ++k) dst[m][k] = *(const PG8_LAS bf16x8*)(lds + PG8_SA(b, h) + aoff + m * 2048 + k * 1024); } while (0)
#define PG8_LDB(dst, b, h) do { _Pragma("unroll") for (int n = 0; n < 2; ++n) _Pragma("unroll") for (int k = 0; k < 2; ++k) dst[n][k] = *(const PG8_LAS bf16x8*)(lds + PG8_SB(b, h) + boff + n * 2048 + k * 1024); } while (0)
#define PG8_MMA(ai, bj, At, Bt) do { __builtin_amdgcn_s_setprio(1); _Pragma("unroll") for (int m = 0; m < 4; ++m) _Pragma("unroll") for (int n = 0; n < 2; ++n) _Pragma("unroll") for (int k = 0; k < 2; ++k) \
        acc[ai][bj][m][n] = __builtin_amdgcn_mfma_f32_16x16x32_bf16(Bt[n][k], At[m][k], acc[ai][bj][m][n], 0, 0, 0); __builtin_amdgcn_s_setprio(0); } while (0)
#define PG8_WAIT_V(n) asm volatile("s_waitcnt vmcnt(" #n ")" ::: "memory")
#define PG8_WAIT_L(n) asm volatile("s_waitcnt lgkmcnt(" #n ")" ::: "memory")
#define PG8_BAR __builtin_amdgcn_s_barrier()
#define PG8_SCHED __builtin_amdgcn_sched_barrier(0)
    Unit cur, nxt; int ui = 0;
    if (!S.next(0, cur)) return;
    f32x4 acc[2][2][4][2];
#pragma unroll
    for (int a = 0; a < 2; ++a)
#pragma unroll
        for (int b = 0; b < 2; ++b)
#pragma unroll
            for (int m = 0; m < 4; ++m)
#pragma unroll
                for (int n = 0; n < 2; ++n) acc[a][b][m][n] = (f32x4){0.f, 0.f, 0.f, 0.f};
    bf16x8 At[4][2], B0[2][2], B1[2][2];
    const char* cA = (const char*)g.A + (size_t)cur.pm * tstep; const char* cB = (const char*)g.Bt + (size_t)cur.e * estep + (size_t)cur.pn * tstep;
    S.a_ready(cur);
    if constexpr (GATHER) gather_offs(cur, voffC);
    if constexpr (SP2) {
        PG8_STAGE(PG8_SB(0, 0), cB, voffB); PG8_STAGE(PG8_SB(0, 1), cB + hstep, voffB); PG8_STAGE_A(PG8_SA(0, 0), 0, 0, false, cA); PG8_STAGE_A(PG8_SA(0, 1), 1, 0, false, cA + hstep);
        if (wr == 1) PG8_BAR;
        PG8_WAIT_V(2); PG8_BAR;
        PG8_STAGE(PG8_SB(1, 0), cB + kstep, voffB); PG8_STAGE_A(PG8_SA(1, 0), 0, 1, false, cA + kstep); PG8_STAGE(PG8_SB(1, 1), cB + hstep + kstep, voffB);
        PG8_WAIT_V(6); PG8_BAR;
    } else {
        PG8_STAGE(PG8_SB(0, 0), cB, voffB); PG8_STAGE_A(PG8_SA(0, 0), 0, 0, false, cA); PG8_STAGE(PG8_SB(0, 1), cB + hstep, voffB); PG8_STAGE_A(PG8_SA(0, 1), 1, 0, false, cA + hstep);
        if (wr == 1) PG8_BAR;
        PG8_WAIT_V(4); PG8_BAR;
        PG8_STAGE(PG8_SB(1, 0), cB + kstep, voffB); PG8_STAGE_A(PG8_SA(1, 0), 0, 1, false, cA + kstep); PG8_STAGE(PG8_SB(1, 1), cB + hstep + kstep, voffB);
        PG8_WAIT_V(6); PG8_BAR;
    }
    for (;;) {
        const bool has_next = S.next(ui + 1, nxt);
        if constexpr (GATHER) { if (has_next) gather_offs(nxt, voffN); else {
#pragma unroll
            for (int hh = 0; hh < 2; ++hh) { voffN[hh][0] = voffC[hh][0]; voffN[hh][1] = voffC[hh][1]; } } }
        const char* nA = has_next ? (const char*)g.A + (size_t)nxt.pm * tstep : cA; const char* nB = has_next ? (const char*)g.Bt + (size_t)nxt.e * estep + (size_t)nxt.pn * tstep : cB;
        for (int t = 0; t < nt; t += 2) {
            const bool last = (t == nt - 2);
            const char* a1 = cA + (size_t)(t + 1) * kstep;
            const char* a2 = last ? nA : cA + (size_t)(t + 2) * kstep; const char* b2 = last ? nB : cB + (size_t)(t + 2) * kstep;
            const char* a3 = a2 + kstep; const char* b3 = b2 + kstep;
            if (last && has_next) S.a_ready(nxt);
            if constexpr (SP2) {
            PG8_LDB(B0, 0, 0); PG8_LDB(B1, 0, 1); PG8_SCHED; PG8_LDA(At, 0, 0); PG8_STAGE_A(PG8_SA(1, 1), 1, t + 1, false, a1 + hstep);
            PG8_WAIT_V(8); PG8_WAIT_L(0); PG8_BAR; PG8_MMA(0, 0, At, B0); PG8_MMA(0, 1, At, B1); PG8_BAR; PG8_SCHED;
            PG8_LDA(At, 0, 1); PG8_STAGE(PG8_SB(0, 0), b2, voffB); PG8_STAGE(PG8_SB(0, 1), b2 + hstep, voffB); PG8_STAGE_A(PG8_SA(0, 0), 0, (last ? 0 : t + 2), last, a2);
            PG8_WAIT_V(8); PG8_WAIT_L(0); PG8_BAR; PG8_MMA(1, 0, At, B0); PG8_MMA(1, 1, At, B1); PG8_BAR; PG8_SCHED;
            PG8_LDB(B0, 1, 0); PG8_LDB(B1, 1, 1); PG8_SCHED; PG8_LDA(At, 1, 0); PG8_STAGE_A(PG8_SA(0, 1), 1, (last ? 0 : t + 2), last, a2 + hstep);
            PG8_WAIT_V(8); PG8_WAIT_L(0); PG8_BAR; PG8_MMA(0, 0, At, B0); PG8_MMA(0, 1, At, B1); PG8_BAR; PG8_SCHED;
            PG8_LDA(At, 1, 1); PG8_STAGE(PG8_SB(1, 0), b3, voffB); PG8_STAGE(PG8_SB(1, 1), b3 + hstep, voffB); PG8_STAGE_A(PG8_SA(1, 0), 0, (last ? 1 : t + 3), last, a3);
            PG8_WAIT_V(8); PG8_WAIT_L(0); PG8_BAR; PG8_MMA(1, 0, At, B0); PG8_MMA(1, 1, At, B1); PG8_BAR; PG8_SCHED;
            } else {
            PG8_LDB(B0, 0, 0); PG8_SCHED; PG8_LDA(At, 0, 0); PG8_STAGE_A(PG8_SA(1, 1), 1, t + 1, false, a1 + hstep);
            PG8_WAIT_L(8); PG8_BAR; PG8_WAIT_L(0); PG8_MMA(0, 0, At, B0); PG8_BAR; PG8_SCHED;
            PG8_LDB(B1, 0, 1); PG8_STAGE(PG8_SB(0, 0), b2, voffB);
            PG8_BAR; PG8_WAIT_L(0); PG8_MMA(0, 1, At, B1); PG8_BAR;
            PG8_LDA(At, 0, 1); PG8_STAGE_A(PG8_SA(0, 0), 0, (last ? 0 : t + 2), last, a2);
            PG8_BAR; PG8_WAIT_L(0); PG8_MMA(1, 0, At, B0); PG8_BAR; PG8_SCHED;
            PG8_STAGE(PG8_SB(0, 1), b2 + hstep, voffB);
            PG8_WAIT_V(6); PG8_BAR; PG8_MMA(1, 1, At, B1); PG8_BAR;
            PG8_LDB(B0, 1, 0); PG8_SCHED; PG8_LDA(At, 1, 0); PG8_STAGE_A(PG8_SA(0, 1), 1, (last ? 0 : t + 2), last, a2 + hstep);
            PG8_WAIT_L(8); PG8_BAR; PG8_WAIT_L(0); PG8_MMA(0, 0, At, B0); PG8_BAR; PG8_SCHED;
            PG8_LDB(B1, 1, 1); PG8_STAGE(PG8_SB(1, 0), b3, voffB);
            PG8_BAR; PG8_WAIT_L(0); PG8_MMA(0, 1, At, B1); PG8_BAR;
            PG8_LDA(At, 1, 1); PG8_STAGE_A(PG8_SA(1, 0), 0, (last ? 1 : t + 3), last, a3);
            PG8_BAR; PG8_WAIT_L(0); PG8_MMA(1, 0, At, B0); PG8_BAR; PG8_SCHED;
            PG8_STAGE(PG8_SB(1, 1), b3 + hstep, voffB);
            PG8_WAIT_V(6); PG8_BAR; PG8_MMA(1, 1, At, B1); PG8_BAR;
            }
        }
        if constexpr (ALIGN_EPI) { if (wr == 0) PG8_BAR; }
        if constexpr (!Epi::AFTER_DRAIN) { E(acc, cur, wr, wc, fr, fq); S.done(cur); }
        if (!has_next) break;
#pragma unroll
        for (int a = 0; a < 2; ++a)
#pragma unroll
            for (int b = 0; b < 2; ++b)
#pragma unroll
                for (int m = 0; m < 4; ++m)
#pragma unroll
                    for (int n = 0; n < 2; ++n) acc[a][b][m][n] = (f32x4){0.f, 0.f, 0.f, 0.f};
        cur = nxt; cA = nA; cB = nB; ++ui;
        if constexpr (GATHER) {
#pragma unroll
            for (int hh = 0; hh < 2; ++hh) { voffC[hh][0] = voffN[hh][0]; voffC[hh][1] = voffN[hh][1]; } }
        if constexpr (ALIGN_EPI) { if (wr == 1) PG8_BAR; }
    }
    PG8_WAIT_V(0);
    if constexpr (!ALIGN_EPI) { if (wr == 0) PG8_BAR; }
    PG8_BAR;
    if constexpr (Epi::AFTER_DRAIN) { E.fused(acc, cur, wr, wc, fr, fq, lds, wid, lane); S.done(cur); }
#undef PG8_SA
#undef PG8_SB
#undef PG8_STAGE
#undef PG8_STAGE_A
#undef PG8_LDA
#undef PG8_LDB
#undef PG8_MMA
#undef PG8_WAIT_V
#undef PG8_WAIT_L
#undef PG8_BAR
#undef PG8_SCHED
}
}

struct EpiStoreBf16 {
    static constexpr bool PERM = true, AFTER_DRAIN = false;
    bf16_t* O; long ldo; int gate_from; long estride;
    __device__ __forceinline__ void operator()(const pg8::f32x4 (&acc)[2][2][4][2], const pg8::Unit& u, int wr, int wc, int fr, int fq) const {
        bf16_t* base = O + (long)u.e * estride;
#pragma unroll
        for (int ai = 0; ai < 2; ++ai)
#pragma unroll
            for (int m = 0; m < 4; ++m) {
                const long row = (long)u.pm * 256 + ai * 128 + wr * 64 + m * 16 + fr;
#pragma unroll
                for (int bj = 0; bj < 2; ++bj) {
                    pg8::f32x4 v0 = acc[ai][bj][m][0], v1 = acc[ai][bj][m][1];
                    if (u.pn * 2 + bj >= gate_from) {
#pragma unroll
                        for (int j = 0; j < 4; ++j) { v0[j] = sigm_fast(v0[j]); v1[j] = sigm_fast(v1[j]); }
                    }
                    u32x4 wv; wv[0] = pk_bf16(v0[0], v0[1]); wv[1] = pk_bf16(v0[2], v0[3]); wv[2] = pk_bf16(v1[0], v1[1]); wv[3] = pk_bf16(v1[2], v1[3]);
                    *(u32x4*)(base + row * ldo + u.pn * 256 + bj * 128 + wc * 32 + 8 * fq) = wv;
                }
            }
    }
};
struct EpiStoreF32 {
    static constexpr bool PERM = false, AFTER_DRAIN = false;
    float* O; long ldo;
    __device__ __forceinline__ void operator()(const pg8::f32x4 (&acc)[2][2][4][2], const pg8::Unit& u, int wr, int wc, int fr, int fq) const {
#pragma unroll
        for (int ai = 0; ai < 2; ++ai)
#pragma unroll
            for (int m = 0; m < 4; ++m) {
                const long row = (long)u.pm * 256 + ai * 128 + wr * 64 + m * 16 + fr;
#pragma unroll
                for (int bj = 0; bj < 2; ++bj)
#pragma unroll
                    for (int n = 0; n < 2; ++n) *(pg8::f32x4*)(O + row * ldo + u.pn * 256 + bj * 128 + wc * 32 + 16 * n + 4 * fq) = acc[ai][bj][m][n];
            }
    }
};
struct EpiMoeGU {
    static constexpr bool PERM = true, AFTER_DRAIN = false;
    bf16_t* HH;
    __device__ __forceinline__ void operator()(const pg8::f32x4 (&acc)[2][2][4][2], const pg8::Unit& u, int wr, int wc, int fr, int fq) const {
#pragma unroll
        for (int ai = 0; ai < 2; ++ai)
#pragma unroll
            for (int m = 0; m < 4; ++m) {
                const long row = (long)u.pm * 256 + ai * 128 + wr * 64 + m * 16 + fr;
                float hv[8];
#pragma unroll
                for (int n = 0; n < 2; ++n)
#pragma unroll
                    for (int j = 0; j < 4; ++j) { const float gt = acc[ai][0][m][n][j], up = acc[ai][1][m][n][j]; hv[4 * n + j] = gt * sigm_fast(gt) * up; }
                u32x4 wv; wv[0] = pk_bf16(hv[0], hv[1]); wv[1] = pk_bf16(hv[2], hv[3]); wv[2] = pk_bf16(hv[4], hv[5]); wv[3] = pk_bf16(hv[6], hv[7]);
                *(u32x4*)(HH + row * 512 + u.pn * 128 + wc * 32 + 8 * fq) = wv;
            }
    }
};
struct EpiMoeDown {
    static constexpr bool PERM = true, AFTER_DRAIN = false;
    const int* perm; const float* ew; bf16_t* YK;
    __device__ __forceinline__ void operator()(const pg8::f32x4 (&acc)[2][2][4][2], const pg8::Unit& u, int wr, int wc, int fr, int fq) const {
#pragma unroll
        for (int ai = 0; ai < 2; ++ai)
#pragma unroll
            for (int m = 0; m < 4; ++m) {
                const int a = perm[u.pm * 256 + ai * 128 + wr * 64 + m * 16 + fr];
                if (a >= 0) {
                    const float sw = ew[a];
#pragma unroll
                    for (int bj = 0; bj < 2; ++bj) {
                        const pg8::f32x4 v0 = acc[ai][bj][m][0] * sw, v1 = acc[ai][bj][m][1] * sw;
                        u32x4 wv; wv[0] = pk_bf16(v0[0], v0[1]); wv[1] = pk_bf16(v0[2], v0[3]); wv[2] = pk_bf16(v1[0], v1[1]); wv[3] = pk_bf16(v1[2], v1[3]);
                        *(u32x4*)(YK + (long)a * 1024 + u.pn * 256 + bj * 128 + wc * 32 + 8 * fq) = wv;
                    }
                }
            }
    }
};
struct GroupedOrder {
    int nM, nN, nE, G, c;
    __device__ bool next(int i, pg8::Unit& u) const { const int L = i * G + c; if (L >= nM * nN * nE) return false; u.e = L / (nM * nN); const int rm = L % (nM * nN); u.pm = rm / nN; u.pn = rm % nN; u.gt = 0; u.nv = 0; return true; }
    __device__ __forceinline__ void a_ready(const pg8::Unit&) const {}
    __device__ __forceinline__ void done(const pg8::Unit&) const {}
};

struct LayerW {
    const float *cmp_pos, *conv_w, *conv_b, *ga_b, *gx_b, *lam, *q_norm, *kv_norm,
        *ln1_g, *ln1_b, *ln2_g, *ln2_b, *rg_b, *re_b, *ln3_g, *ln3_b;
    const bf16_t *t_in, *t_br, *t_out, *t_q, *t_o, *t_gu, *t_dn, *t_c1, *t_c2, *t_uq, *t_ukv, *t_g, *t_rh, *t_rl;
};
#define WSF(off) ((float*)(p.ws + (off)))
#define WSI(off) ((int*)(p.ws + (off)))
#define WSU(off) ((unsigned*)(p.ws + (off)))
#define WSB(off) ((bf16_t*)(p.ws + (off)))
DI LayerW layer_w(const Params& p, int l) {
    LayerW w;
    w.cmp_pos = p.in[3] + (size_t)l * 2 * 32 * 64;
    w.conv_w = p.in[6] + (size_t)l * 4 * 256;
    w.conv_b = p.in[7] + (size_t)l * 256;
    w.ga_b = p.in[9] + (size_t)l * 256;
    w.gx_b = p.in[11] + (size_t)l * 256;
    w.lam = p.in[12] + (size_t)l * 256;
    w.q_norm = p.in[13] + (size_t)l * 192;
    w.kv_norm = p.in[14] + (size_t)l * 128;
    w.ln1_g = p.in[19] + (size_t)l * 1024; w.ln1_b = p.in[20] + (size_t)l * 1024;
    w.ln2_g = p.in[24] + (size_t)l * 1024; w.ln2_b = p.in[25] + (size_t)l * 1024;
    w.rg_b = p.in[27] + (size_t)l * 4;
    w.re_b = p.in[29] + (size_t)l * 32;
    w.ln3_g = p.in[32] + (size_t)l * 1024; w.ln3_b = p.in[33] + (size_t)l * 1024;
    w.t_in = WSB(WT_IN) + (size_t)l * NH * 1024;
    w.t_br = WSB(WT_BR) + (size_t)l * 1024 * 1024;
    w.t_out = WSB(WT_OUT) + (size_t)l * 1024 * 1024;
    w.t_q = WSB(WT_Q) + (size_t)l * 512 * 1024;
    w.t_o = WSB(WT_O) + (size_t)l * 1024 * 512;
    w.t_gu = WSB(WT_GU) + (size_t)l * 32 * 1024 * 1024;
    w.t_dn = WSB(WT_DN) + (size_t)l * 32 * 1024 * 512;
    w.t_c1 = WSB(WT_C1) + (size_t)l * 2 * 256 * 2048;
    w.t_c2 = WSB(WT_C2) + (size_t)l * 2 * 128 * 256;
    w.t_uq = WSB(WT_UQ) + (size_t)l * 384 * 192;
    w.t_ukv = WSB(WT_UKV) + (size_t)l * 512 * 128;
    w.t_g = WSB(WT_G) + (size_t)l * 4 * 128 * 64;
    w.t_rh = WSB(WT_RH) + (size_t)l * 128 * 1024;
    w.t_rl = WSB(WT_RL) + (size_t)l * 128 * 1024;
    return w;
}

template <int MODE>
DI int wt_col(int np, int Nsrc) {
    if (MODE == 0) return np < Nsrc ? np : -1;
    if (MODE == 2) return np < 1024 ? np : (np < 2656 ? np + 12 : (np < 2668 ? 1024 + (np - 2656) : (np < 2688 ? -1 : (np < 6784 ? np - 20 : -1))));
    const int pn = np >> 8, bj = (np >> 7) & 1, q = np & 127; return (bj ? 512 : 0) + 128 * pn + q;
}
template <int MODE>
DI void job_wt(const float* src, int nmat, int K, int Nsrc, bf16_t* dst, int Npad, int bid, int nblk, unsigned char* lds) {
    const int lane = tidx() & 63, wid = tidx() >> 6;
    bf16_t* tile = (bf16_t*)lds + wid * (64 * 72);
    const int tk = K / 64, tn = Npad / 64;
    const int tk2 = (tk + 1) / 2, tn4 = (tn + 3) / 4, per = tk2 * tn4;
    const int kl = lane >> 4, n4 = (lane & 15) * 4;
    for (int ub = bid; ub < nmat * per; ub += nblk) {
        const int mat = ub / per, ru = ub % per, kt = (ru % tk2) * 2 + (wid & 1), nt = (ru / tk2) * 4 + (wid >> 1);
        if (kt >= tk || nt >= tn) continue;
        const int k0 = kt * 64, n0 = nt * 64;
        const float* s = src + (size_t)mat * K * Nsrc;
        bf16_t* d = dst + (size_t)mat * Npad * K;
        const int col = wt_col<MODE>(n0 + n4, Nsrc);
        float4 v[16];
#pragma unroll
        for (int ps = 0; ps < 16; ++ps) v[ps] = col >= 0 ? *(const float4*)(s + (size_t)(k0 + kl + 4 * ps) * Nsrc + col) : make_float4(0.f, 0.f, 0.f, 0.f);
#pragma unroll
        for (int ps = 0; ps < 16; ++ps) { const int k = kl + 4 * ps;
            tile[(n4 + 0) * 72 + k] = f2bf(v[ps].x); tile[(n4 + 1) * 72 + k] = f2bf(v[ps].y); tile[(n4 + 2) * 72 + k] = f2bf(v[ps].z); tile[(n4 + 3) * 72 + k] = f2bf(v[ps].w); }
        __builtin_amdgcn_fence(__ATOMIC_RELEASE, "wavefront"); __builtin_amdgcn_wave_barrier(); __builtin_amdgcn_fence(__ATOMIC_ACQUIRE, "wavefront");
#pragma unroll
        for (int c8 = 0; c8 < 8; ++c8) { const int c = lane + 64 * c8, n2 = c >> 3, kc = (c & 7) * 8;
            *(uint4*)(d + (size_t)(n0 + n2) * K + k0 + kc) = *(const uint4*)(tile + n2 * 72 + kc); }
        __builtin_amdgcn_fence(__ATOMIC_RELEASE, "wavefront"); __builtin_amdgcn_wave_barrier(); __builtin_amdgcn_fence(__ATOMIC_ACQUIRE, "wavefront");
    }
}
DI void job_cvt(const float* src, bf16_t* dst, long n, int bid, int nblk) {
    for (long e = ((long)bid * NT + tidx()) * 4; e < n; e += (long)nblk * NT * 4) {
        const float4 v = *(const float4*)(src + e);
        st4bf(dst + e, v.x, v.y, v.z, v.w);
    }
}
DI void job_cmp_gather(const Params& p, const LayerW& w, int bid, int nblk) {
    const bf16_t* H = WSB(WS_H); bf16_t* TB = WSB(WS_TBB);
    const long total = (long)2 * NCR * 2048 / 8;
    for (long e = (long)bid * NT + tidx(); e < total; e += (long)nblk * NT) {
        const long e8 = e * 8;
        const int f = (int)(e8 % 2048); const long r2 = e8 / 2048; const int r = (int)(r2 % NCR), j = (int)(r2 / NCR);
        const int g = r & 1, bc = r >> 1, c = bc % NCMP, b = bc / NCMP, i = f >> 6, d = f & 63;
        float hv[8];
        ld8f(H + (long)(b * SEQ + 16 * c + i) * NH + (j ? O_AVC : O_AKC) + g * 64 + d, hv);
        const float4 p0 = *(const float4*)(w.cmp_pos + (j * 32 + i) * 64 + d), p1 = *(const float4*)(w.cmp_pos + (j * 32 + i) * 64 + d + 4);
        hv[0] += p0.x; hv[1] += p0.y; hv[2] += p0.z; hv[3] += p0.w; hv[4] += p1.x; hv[5] += p1.y; hv[6] += p1.z; hv[7] += p1.w;
        st8bf(TB + ((long)j * 2048 + r) * 2048 + f, hv);
    }
}
DI void job_rnn_conv(const Params& p, const LayerW& w, int bid, int nblk) {
    const bf16_t* H = WSB(WS_H); float* U = WSF(WS_U); bf16_t* UB = WSB(WS_UB);
    for (long e = (long)bid * NT + tidx(); e < (long)T * 64; e += (long)nblk * NT) {
        const int ch = (int)(e & 63) * 4; const int t = (int)(e >> 6), s = t & (SEQ - 1);
        const float4 cb = *(const float4*)(w.conv_b + ch);
        float u0 = cb.x, u1 = cb.y, u2 = cb.z, u3 = cb.w;
#pragma unroll
        for (int tap = 0; tap < 4; ++tap) { const int sp = s - 3 + tap;
            if (sp >= 0) { const float4 hv = ld4bf(H + (long)(t - 3 + tap) * NH + O_CX + ch); const float4 cw = *(const float4*)(w.conv_w + tap * 256 + ch);
                u0 += hv.x * cw.x; u1 += hv.y * cw.y; u2 += hv.z * cw.z; u3 += hv.w * cw.w; } }
        *(float4*)(U + (long)t * 256 + ch) = make_float4(u0, u1, u2, u3); st4bf(UB + (long)t * 256 + ch, u0, u1, u2, u3);
    }
}
DI void job_rnn_gates(const Params& p, const LayerW& w, int bid, int nblk, unsigned char* lds) {
    const float* U = WSF(WS_U); float* RA = WSF(WS_RA); float* RB = WSF(WS_RB);
    for (int u = bid; u < (T / G_BM) * 4; u += nblk) {
        const int blk = u & 3, m0 = (u >> 2) * G_BM;
        MG g; g.A = WSB(WS_UB) + blk * 64; g.lda = 256; g.Wt = w.t_g + (size_t)blk * 128 * 64; g.ldw = 64; g.K = 64;
        f32x16 acc[2][2];
        mgemm_tile(g, 0, RowId{m0}, acc, lds);
        const int l = tidx() & 63, wv = tidx() >> 6, wm = wv % G_WM, wn = wv / G_WM;
#pragma unroll
        for (int tt = 0; tt < 2; ++tt)
#pragma unroll
            for (int i = 0; i < 4; ++i) {
                const long t = m0 + wm * 64 + tt * 32 + (l & 31); const int ch = blk * 64 + wn * 32 + 8 * i + 4 * (l >> 5);
                const float4 uv = *(const float4*)(U + t * 256 + ch);
                const float ua[4] = {uv.x, uv.y, uv.z, uv.w};
                float av[4], bv[4];
#pragma unroll
                for (int j = 0; j < 4; ++j) {
                    const float r = sigm_fast(acc[0][tt][4 * i + j] + w.ga_b[ch + j]), ig = sigm_fast(acc[1][tt][4 * i + j] + w.gx_b[ch + j]);
                    const float nl = -w.lam[ch + j];
                    const float sp = fmaxf(nl, 0.f) + __logf(1.f + __expf(-fabsf(nl)));
                    const float log_a = -8.0f * r * sp;
                    const float a = __expf(log_a);
                    av[j] = a; bv[j] = __builtin_amdgcn_sqrtf(fmaxf(1.f - a * a, 0.f)) * (ig * ua[j]);
                }
                *(float4*)(RA + t * 256 + ch) = make_float4(av[0], av[1], av[2], av[3]);
                *(float4*)(RB + t * 256 + ch) = make_float4(bv[0], bv[1], bv[2], bv[3]);
            }
    }
}
DI void job_rnn_scan1(const Params& p, int bid, int nblk) {
    const float* RA = WSF(WS_RA); const float* RB = WSF(WS_RB); float* SA = WSF(WS_SA); float* SH = WSF(WS_SH);
    for (int e = bid * NT + tidx(); e < BATCH * 32 * 256; e += nblk * NT) {
        const int ch = e & 255, bc = e >> 8;
        float ap = 1.f, hl = 0.f;
        for (int s0 = 0; s0 < 64; s0 += 8) {
            float av[8], bv[8];
#pragma unroll
            for (int i = 0; i < 8; ++i) { const long t = (long)bc * 64 + s0 + i; av[i] = RA[t * 256 + ch]; bv[i] = RB[t * 256 + ch]; }
#pragma unroll
            for (int i = 0; i < 8; ++i) { ap *= av[i]; hl = av[i] * hl + bv[i]; }
        }
        SA[e] = ap; SH[e] = hl;
    }
}
DI void job_rnn_scan2(const Params& p, int bid, int nblk) {
    const bf16_t* H = WSB(WS_H); const float* RA = WSF(WS_RA); const float* RB = WSF(WS_RB); const float* SA = WSF(WS_SA); const float* SH = WSF(WS_SH); bf16_t* BR = WSB(WS_BR);
    for (int e = bid * NT + tidx(); e < BATCH * 32 * 256; e += nblk * NT) {
        const int ch = e & 255, bc = e >> 8, chunk = bc & 31, b = bc >> 5;
        float h = 0.f;
#pragma unroll
        for (int c0 = 0; c0 < 32; c0 += 8) {
            float sa[8], sh[8];
#pragma unroll
            for (int i = 0; i < 8; ++i) { const int q = ((b * 32 + c0 + i) << 8) + ch; sa[i] = SA[q]; sh[i] = SH[q]; }
#pragma unroll
            for (int i = 0; i < 8; ++i) h = (c0 + i < chunk) ? sa[i] * h + sh[i] : h;
        }
        for (int s0 = 0; s0 < 64; s0 += 8) {
            float av[8], bv[8], gv[8];
#pragma unroll
            for (int i = 0; i < 8; ++i) { const long t = (long)bc * 64 + s0 + i; av[i] = RA[t * 256 + ch]; bv[i] = RB[t * 256 + ch]; gv[i] = bf2f(H[t * NH + O_CG + ch]); }
#pragma unroll
            for (int i = 0; i < 8; ++i) { const long t = (long)bc * 64 + s0 + i; h = av[i] * h + bv[i]; BR[t * 1024 + 2 * 256 + ch] = f2bf(h * gelu_tanh(gv[i])); }
        }
    }
}
DI void job_mla_norm(const Params& p, const LayerW& w, int bid, int nblk) {
    const bf16_t* H = WSB(WS_H); bf16_t* CQN = WSB(WS_CQNB); bf16_t* CKVN = WSB(WS_CKVNB); bf16_t* KM = WSB(WS_KM);
    const int lane = tidx() & 63, wid = tidx() >> 6;
    const bool isq = lane < 24, iskv = lane >= 32 && lane < 48;
    const int coff = isq ? O_DCQ + lane * 8 : O_DCKV + (lane - 32) * 8;
    float gn[8];
#pragma unroll
    for (int j = 0; j < 8; ++j) gn[j] = isq ? w.q_norm[lane * 8 + j] : (iskv ? w.kv_norm[(lane - 32) * 8 + j] : 0.f);
    for (int t = bid * (NT / 64) + wid; t < T; t += nblk * (NT / 64)) {
        const bf16_t* hr = H + (long)t * NH;
        float v[8];
        float ss = 0.f;
        if (isq || iskv) { ld8f(hr + coff, v);
#pragma unroll
            for (int j = 0; j < 8; ++j) ss += v[j] * v[j]; }
        const float sq = wave_sum(isq ? ss : 0.f), skv = wave_sum(iskv ? ss : 0.f);
        const float rs = isq ? rsqrtf(sq * (1.f / 192.f) + 1e-6f) : rsqrtf(skv * (1.f / 128.f) + 1e-6f);
        if (isq || iskv) {
#pragma unroll
            for (int j = 0; j < 8; ++j) v[j] = v[j] * rs * gn[j];
            if (isq) st8bf(CQN + (long)t * 192 + lane * 8, v); else st8bf(CKVN + (long)t * 128 + (lane - 32) * 8, v);
        }
        {
            const int i = lane & 15, hd = lane >> 4;
            const int s = t & (SEQ - 1);
            const float2 csn = *(const float2*)(WSF(WS_ROPE) + (s * 16 + i) * 2); const float cs = csn.x, sn = csn.y;
            const float x1 = bf2f(hr[O_DKR + i]), x2 = bf2f(hr[O_DKR + 16 + i]);
            KM[(long)t * 384 + hd * 96 + 64 + i] = f2bf(x1 * cs - x2 * sn);
            KM[(long)t * 384 + hd * 96 + 80 + i] = f2bf(x1 * sn + x2 * cs);
        }
    }
}
DI void job_mla_up(const Params& p, const LayerW& w, int bid, int nblk, unsigned char* lds) {
    bf16_t* QB = WSB(WS_QB); bf16_t* KM = WSB(WS_KM); bf16_t* VM = WSB(WS_VM);
    constexpr int TM = T / G_BM;
    for (int u = bid; u < TM * 7; u += nblk) {
        const int mt = u / 7, nt = u % 7, m0 = mt * G_BM;
        f32x16 acc[2][2];
        const int l = tidx() & 63, wv = tidx() >> 6, wm = wv % G_WM, wn = wv / G_WM, hh = l >> 5;
        if (nt < 3) {
            MG g; g.A = WSB(WS_CQNB); g.lda = 192; g.Wt = w.t_uq; g.ldw = 192; g.K = 192;
            const int n0 = nt * 128;
            mgemm_tile(g, n0, RowId{m0}, acc, lds);
#pragma unroll
            for (int ft = 0; ft < 2; ++ft) {
                const int fb = (n0 + wn * 64 + ft * 32) >> 5;
                if (fb % 3 == 2) {
#pragma unroll
                    for (int tt = 0; tt < 2; ++tt) {
                        const int pos = (m0 + wm * 64 + tt * 32 + (l & 31)) & (SEQ - 1);
#pragma unroll
                        for (int i = 0; i < 2; ++i)
#pragma unroll
                            for (int j = 0; j < 4; ++j) {
                                const int fi = 8 * i + 4 * hh + j;
                                const float2 csn = *(const float2*)(WSF(WS_ROPE) + (pos * 16 + fi) * 2); const float cs = csn.x, sn = csn.y;
                                const float x1 = acc[ft][tt][4 * i + j], x2 = acc[ft][tt][4 * (i + 2) + j];
                                acc[ft][tt][4 * i + j] = x1 * cs - x2 * sn; acc[ft][tt][4 * (i + 2) + j] = x1 * sn + x2 * cs;
                            }
                    }
                }
            }
            MG_FOREACH(acc, lrow, feat, v, { st4bf(QB + (long)(m0 + lrow) * 384 + n0 + feat, v[0], v[1], v[2], v[3]); });
        } else {
            MG g; g.A = WSB(WS_CKVNB); g.lda = 128; g.Wt = w.t_ukv; g.ldw = 128; g.K = 128;
            const int n0 = (nt - 3) * 128;
            mgemm_tile(g, n0, RowId{m0}, acc, lds);
            MG_FOREACH(acc, lrow, feat, v, {
                const int hd = nt - 3;
                if (feat < 64) st4bf(KM + (long)(m0 + lrow) * 384 + hd * 96 + feat, v[0], v[1], v[2], v[3]);
                else st4bf(VM + (long)(m0 + lrow) * 256 + hd * 64 + (feat - 64), v[0], v[1], v[2], v[3]); });
        }
    }
}
template <int STAGE>
DI void job_cmp_mlp(const Params& p, const LayerW& w, int bid, int nblk, unsigned char* lds) {
    constexpr int TM = 2048 / G_BM, TN = STAGE == 0 ? 2 : 1;
    for (int u = bid; u < 2 * TM * TN; u += nblk) {
        const int j = u / (TM * TN), ru = u % (TM * TN), mt = ru / TN, nt = ru % TN, m0 = mt * G_BM, n0 = nt * 128;
        MG g;
        if (STAGE == 0) { g.A = WSB(WS_TBB) + (size_t)j * 2048 * 2048; g.lda = 2048; g.Wt = w.t_c1 + (size_t)j * 256 * 2048; g.ldw = 2048; g.K = 2048; }
        else { g.A = WSB(WS_HIDB) + (size_t)j * 2048 * 256; g.lda = 256; g.Wt = w.t_c2 + (size_t)j * 128 * 256; g.ldw = 256; g.K = 256; }
        f32x16 acc[2][2];
        mgemm_tile(g, n0, [&](int r) { const int rr = m0 + r; return (long)(rr < NCR ? rr : NCR - 1); }, acc, lds);
        if (STAGE == 0) {
            bf16_t* HID = WSB(WS_HIDB) + (size_t)j * 2048 * 256;
            MG_FOREACH(acc, lrow, feat, v, { st4bf(HID + (long)(m0 + lrow) * 256 + n0 + feat, gelu_tanh(v[0]), gelu_tanh(v[1]), gelu_tanh(v[2]), gelu_tanh(v[3])); });
        } else {
            bf16_t* KC = WSB(WS_KCB) + (size_t)j * NCR * 64;
            MG_FOREACH(acc, lrow, feat, v, { if (feat < 64 && m0 + lrow < NCR) st4bf(KC + (long)(m0 + lrow) * 64 + feat, v[0], v[1], v[2], v[3]); });
        }
    }
}
DI void job_router_logits(const Params& p, const LayerW& w, int bid, int nblk, unsigned char* lds) {
    float* LOG = WSF(WS_LOG);
    for (int u = bid; u < 3 * (T / G_BM); u += nblk) {
        const int pass = u / (T / G_BM), m0 = (u % (T / G_BM)) * G_BM;
        f32x16 acc[2][2];
        MG g; g.lda = 1024; g.ldw = 1024; g.K = 1024;
        g.A = pass == 1 ? WSB(WS_XBL) : WSB(WS_XBB); g.Wt = pass == 2 ? w.t_rl : w.t_rh;
        mgemm_tile(g, 0, RowId{m0}, acc, lds, true);
        float* dst = LOG + (size_t)pass * T * 36;
        MG_FOREACH(acc, lrow, feat, v, { if (feat < 36) *(float4*)(dst + (long)(m0 + lrow) * 36 + feat) = make_float4(v[0], v[1], v[2], v[3]); });
    }
}
DI void job_pack_small(const Params& p, int bid, int nblk) {
    bf16_t* TG = WSB(WT_G); bf16_t* RH = WSB(WT_RH); bf16_t* RL = WSB(WT_RL);
    for (int e = bid * NT + tidx(); e < SEQ * 16; e += nblk * NT) {
        const int i = e & 15, pos = e >> 4;
        const float inv = powf(10000.f, -(float)(2 * i) / 32.f);
        const float ang = (float)pos * inv;
        WSF(WS_ROPE)[e * 2] = cosf(ang); WSF(WS_ROPE)[e * 2 + 1] = sinf(ang);
    }
    for (int e = bid * NT + tidx(); e < DEPTH * 4 * 128 * 64; e += nblk * NT) {
        const int c = e & 63, q = (e >> 6) & 127, lb = e >> 13;
        const int seg = q >> 5, i = q & 31, chl = (seg >> 1) * 32 + i;
        const float* src = (seg & 1) ? p.in[10] : p.in[8];
        TG[e] = f2bf(src[((size_t)lb * 64 + c) * 64 + chl]);
    }
    for (int e = bid * NT + tidx(); e < DEPTH * 128 * 1024; e += nblk * NT) {
        const int k = e & 1023, n = (e >> 10) & 127, l = e >> 17;
        float v = 0.f;
        if (n < 4) v = p.in[26][((size_t)l * 1024 + k) * 4 + n];
        else if (n < 36) v = p.in[28][((size_t)l * 1024 + k) * 32 + (n - 4)];
        const bf16_t hi = f2bf(v);
        RH[e] = hi; RL[e] = f2bf(v - bf2f(hi));
    }
}

DI void job_merge(const Params& p, const LayerW& w, int bid, int nblk, unsigned char* lds) {
    const bf16_t* H = WSB(WS_H); bf16_t* M = WSB(WS_M);
    for (int u0 = bid; u0 < (T / G_BM) * 8; u0 += nblk) {
        int u = u0;
        if ((nblk & 7) == 0) { const int per = nblk >> 3, x = u0 & 7, q = u0 >> 3, ul = (q % per) + per * (q / per);
            u = ((x + 8 * (ul >> 3)) << 3) + (ul & 7); }
        const int m0 = (u >> 3) * G_BM, n0 = (u & 7) * G_BN;
        f32x16 macc[2][2];
#pragma unroll
        for (int a = 0; a < 2; ++a)
#pragma unroll
            for (int b = 0; b < 2; ++b)
#pragma unroll
                for (int i = 0; i < 16; ++i) macc[a][b][i] = 0.f;
        MG g; g.A = WSB(WS_BR); g.lda = 1024; g.Wt = w.t_br; g.ldw = 1024; g.K = 1024;
        f32x16 acc[2][2];
        const int l = tidx() & 63, wv = tidx() >> 6, wm = wv % G_WM, wn = wv / G_WM;
        mgemm_tile_f(g, n0, RowId{m0}, acc, lds, true, 4, [&](int n, f32x16 (&a)[2][2]) {
#pragma unroll
            for (int ft = 0; ft < 2; ++ft)
#pragma unroll
                for (int tt = 0; tt < 2; ++tt)
#pragma unroll
                    for (int i = 0; i < 4; ++i) {
                        const int lrow = wm * 64 + tt * 32 + (l & 31), feat = wn * 64 + ft * 32 + 8 * i + 4 * (l >> 5);
                        const float4 gv = ld4bf(H + (long)(m0 + lrow) * NH + O_MG + n * 1024 + n0 + feat);
                        macc[ft][tt][4 * i] += gv.x * a[ft][tt][4 * i]; macc[ft][tt][4 * i + 1] += gv.y * a[ft][tt][4 * i + 1];
                        macc[ft][tt][4 * i + 2] += gv.z * a[ft][tt][4 * i + 2]; macc[ft][tt][4 * i + 3] += gv.w * a[ft][tt][4 * i + 3];
                        a[ft][tt][4 * i] = 0.f; a[ft][tt][4 * i + 1] = 0.f; a[ft][tt][4 * i + 2] = 0.f; a[ft][tt][4 * i + 3] = 0.f;
                    }
        });
        MG_FOREACH(macc, lrow, feat, v, { st4bf(M + (long)(m0 + lrow) * 1024 + n0 + feat, v[0], v[1], v[2], v[3]); });
    }
}
DI int pad_rows(int c) { return (c + G_BM - 1) / G_BM * G_BM; }
DI void job_ln(const float* xin, const bf16_t* xinb, const bf16_t* xinl, const bf16_t* y, const int* eidx, const int* eslot, unsigned* cnt, const float* ew, const float* gw, const float* bw, float* out, bf16_t* outb, bf16_t* outl, int bid, int nblk, unsigned char* lds) {
    const int lane = tidx() & 63, wid = tidx() >> 6;
    int* s_base = (int*)lds;
    if (eidx) {
        __syncthreads();
        if (tidx() < 32) s_base[32 + tidx()] = pad_rows((int)__hip_atomic_load(&cnt[tidx()], __ATOMIC_RELAXED, __HIP_MEMORY_SCOPE_AGENT));
        __syncthreads();
        if (tidx() == 0) { int o = 0; for (int e = 0; e < 32; ++e) { s_base[e] = o; o += s_base[32 + e]; } }
        __syncthreads();
    }
    float gv[16], bv[16];
#pragma unroll
    for (int i = 0; i < 2; ++i)
#pragma unroll
        for (int j = 0; j < 8; j += 4) { const int c = i * 512 + lane * 8 + j; const float4 g4 = *(const float4*)(gw + c), b4 = *(const float4*)(bw + c);
            gv[i * 8 + j] = g4.x; gv[i * 8 + j + 1] = g4.y; gv[i * 8 + j + 2] = g4.z; gv[i * 8 + j + 3] = g4.w; bv[i * 8 + j] = b4.x; bv[i * 8 + j + 1] = b4.y; bv[i * 8 + j + 2] = b4.z; bv[i * 8 + j + 3] = b4.w; }
    for (int t = bid * (NT / 64) + wid; t < T; t += nblk * (NT / 64)) {
        float v[16];
        float s = 0.f;
        int r0 = 0, r1 = 0; float w0 = 0.f, w1 = 0.f;
        if (eidx) { r0 = s_base[eidx[t * 2]] + eslot[t * 2]; r1 = s_base[eidx[t * 2 + 1]] + eslot[t * 2 + 1]; w0 = ew[t * 2]; w1 = ew[t * 2 + 1]; }
#pragma unroll
        for (int i = 0; i < 2; ++i) {
            const int c = i * 512 + lane * 8;
            float xv[8], yv[8];
            if (xin) { const float4 a = *(const float4*)(xin + (long)t * 1024 + c), b = *(const float4*)(xin + (long)t * 1024 + c + 4);
                xv[0] = a.x; xv[1] = a.y; xv[2] = a.z; xv[3] = a.w; xv[4] = b.x; xv[5] = b.y; xv[6] = b.z; xv[7] = b.w; }
            else ld8f(xinb + (long)t * 1024 + c, xv);
            if (xinl) { float z[8]; ld8f(xinl + (long)t * 1024 + c, z);
#pragma unroll
                for (int j = 0; j < 8; ++j) xv[j] += z[j]; }
            if (!eidx) ld8f(y + (long)t * 1024 + c, yv);
            else { float z0[8], z1[8]; ld8f(y + (long)r0 * 1024 + c, z0); ld8f(y + (long)r1 * 1024 + c, z1);
#pragma unroll
                for (int j = 0; j < 8; ++j) yv[j] = w0 * z0[j] + w1 * z1[j]; }
#pragma unroll
            for (int j = 0; j < 8; ++j) { v[i * 8 + j] = DN_ALPHA * xv[j] + yv[j]; s += v[i * 8 + j]; }
        }
        float q = 0.f;
#pragma unroll
        for (int i = 0; i < 16; ++i) q += v[i] * v[i];
        wave_sum2(s, q);
        const float mu = s * (1.f / 1024.f);
        const float rstd = rsqrtf(fmaxf(q * (1.f / 1024.f) - mu * mu, 0.f) + 1e-5f);
#pragma unroll
        for (int i = 0; i < 2; ++i) {
            const int c = i * 512 + lane * 8;
            float o[8];
#pragma unroll
            for (int j = 0; j < 8; ++j) o[j] = (v[i * 8 + j] - mu) * rstd * gv[i * 8 + j] + bv[i * 8 + j];
            if (out) { *(float4*)(out + (long)t * 1024 + c) = make_float4(o[0], o[1], o[2], o[3]); *(float4*)(out + (long)t * 1024 + c + 4) = make_float4(o[4], o[5], o[6], o[7]); }
            if (outb) st8bf(outb + (long)t * 1024 + c, o);
            if (outl) { float lo[8];
#pragma unroll
                for (int j = 0; j < 8; ++j) lo[j] = o[j] - bf2f(f2bf(o[j]));
                st8bf(outl + (long)t * 1024 + c, lo); }
        }
    }
}
DI void job_router(const Params& p, const LayerW& w, int layer, int bid, int nblk) {
    const float* LOG = WSF(WS_LOG); int* EIDX = WSI(WS_EIDX); int* ESLOT = WSI(WS_ESLOT); float* EW = WSF(WS_EW);
    unsigned* cnt = WSU(WS_CTL) + CW_CNT + layer * 32;
    for (int t = bid * NT + tidx(); t < T; t += nblk * NT) {
        const float* lr = LOG + (long)t * 36; const float* lr1 = lr + (size_t)T * 36; const float* lr2 = lr1 + (size_t)T * 36;
#define LG(i) ((lr[i] + lr1[i]) + lr2[i])
        const float g0 = LG(0) + w.rg_b[0], g1 = LG(1) + w.rg_b[1], g2 = LG(2) + w.rg_b[2], g3 = LG(3) + w.rg_b[3];
        const float gm = fmaxf(fmaxf(g0, g1), fmaxf(g2, g3));
        const float e0 = expf(g0 - gm), e1 = expf(g1 - gm), e2 = expf(g2 - gm), e3 = expf(g3 - gm);
        const float gs = (e0 + e1) + (e2 + e3);
        const float p0 = e0 / gs, p1 = e1 / gs, p2 = e2 / gs, p3 = e3 / gs;
        int grp = 0; float pg = p0;
        if (p1 > pg) { pg = p1; grp = 1; }
        if (p2 > pg) { pg = p2; grp = 2; }
        if (p3 > pg) { pg = p3; grp = 3; }
        float el[8];
#pragma unroll
        for (int i = 0; i < 8; ++i) el[i] = LG(4 + grp * 8 + i) + w.re_b[grp * 8 + i];
#undef LG
        float em = el[0];
#pragma unroll
        for (int i = 1; i < 8; ++i) em = fmaxf(em, el[i]);
        float es = 0.f;
#pragma unroll
        for (int i = 0; i < 8; ++i) { el[i] = expf(el[i] - em); es += el[i]; }
#pragma unroll
        for (int i = 0; i < 8; ++i) el[i] = el[i] / es;
        float b0 = el[0]; int i0 = 0;
#pragma unroll
        for (int i = 1; i < 8; ++i) if (el[i] > b0) { b0 = el[i]; i0 = i; }
        float b1 = -1.f; int i1 = 0;
#pragma unroll
        for (int i = 0; i < 8; ++i) if (i != i0 && el[i] > b1) { b1 = el[i]; i1 = i; }
        const float den = b0 + b1;
        const int ex0 = grp * 8 + i0, ex1 = grp * 8 + i1;
        EIDX[t * 2] = ex0; EIDX[t * 2 + 1] = ex1;
        EW[t * 2] = pg * b0 / den; EW[t * 2 + 1] = pg * b1 / den;
        const int s0 = (int)atomicAdd(&cnt[ex0], 1u), s1 = (int)atomicAdd(&cnt[ex1], 1u);
        ESLOT[t * 2] = s0; ESLOT[t * 2 + 1] = s1;
        WSI(WS_PERM)[ex0 * PCAP + s0] = t * 2; WSI(WS_PERM)[ex1 * PCAP + s1] = t * 2 + 1;
    }
}
DI pg8::ListOrder moe_units(unsigned* cnt, int bid, int nblk, unsigned char* lds) {
    pg8::ListOrder S; S.n = 0; S.u0 = S.u1 = S.u2 = pg8::Unit{0, 0, 0, 0, 0};
    int* s_cnt = (int*)lds;
    __syncthreads();
    if (tidx() < 32) s_cnt[tidx()] = (int)__hip_atomic_load(&cnt[tidx()], __ATOMIC_RELAXED, __HIP_MEMORY_SCOPE_AGENT);
    __syncthreads();
    int rt = 0, ub = 0;
    for (int e = 0; e < 32; ++e) {
        const int ce = s_cnt[e];
        const int c = pad_rows(ce) >> 8, ue = c * 4;
#pragma unroll
        for (int k = 0; k < 3; ++k) {
            const int L = bid + k * nblk;
            if (L >= ub && L < ub + ue) { const int lu = L - ub, mt = lu >> 2; const int nv = ce - mt * 256 < 256 ? ce - mt * 256 : 256;
                const pg8::Unit u{rt + mt, lu & 3, e, e * (PCAP / 256) + mt, nv};
                if (k == 0) S.u0 = u; else if (k == 1) S.u1 = u; else S.u2 = u;
                S.n = k + 1; }
        }
        rt += c; ub += ue;
    }
#define RFL(x) x = __builtin_amdgcn_readfirstlane(x)
    RFL(S.n); RFL(S.u0.pm); RFL(S.u0.pn); RFL(S.u0.e); RFL(S.u0.gt); RFL(S.u0.nv); RFL(S.u1.pm); RFL(S.u1.pn); RFL(S.u1.e); RFL(S.u1.gt); RFL(S.u1.nv);
    RFL(S.u2.pm); RFL(S.u2.pn); RFL(S.u2.e); RFL(S.u2.gt); RFL(S.u2.nv);
#undef RFL
    return S;
}

typedef short s16x4 __attribute__((ext_vector_type(4)));
typedef short v4i16_t __attribute__((ext_vector_type(4)));
DI unsigned cvtpk(float lo, float hi) { return pk_bf16(lo, hi); }
DI int crow(int reg, int h) { return (reg & 3) + 8 * (reg >> 2) + 4 * h; }
DI s16x4 tr_read(const unsigned char* p) { return __builtin_bit_cast(s16x4, __builtin_amdgcn_ds_read_tr16_b64_v4i16((LAS v4i16_t*)p)); }
DI float xhalf_max(float m) { auto rr = __builtin_amdgcn_permlane32_swap(__float_as_uint(m), __float_as_uint(m), false, false); return fmaxf(__uint_as_float(rr[0]), __uint_as_float(rr[1])); }
DI float xhalf_sum(float m) { auto rr = __builtin_amdgcn_permlane32_swap(__float_as_uint(m), __float_as_uint(m), false, false); return __uint_as_float(rr[0]) + __uint_as_float(rr[1]); }
DI float xhalf_other(float v, int h) { auto rr = __builtin_amdgcn_permlane32_swap(__float_as_uint(v), __float_as_uint(v), false, false); return __uint_as_float(h ? rr[0] : rr[1]); }
DI bf16x8 pack8(const f32x16& x, int s2) {
    u32x4 pk; pk[0] = cvtpk(x[8 * s2], x[8 * s2 + 1]); pk[1] = cvtpk(x[8 * s2 + 2], x[8 * s2 + 3]); pk[2] = cvtpk(x[8 * s2 + 4], x[8 * s2 + 5]); pk[3] = cvtpk(x[8 * s2 + 6], x[8 * s2 + 7]);
    return __builtin_bit_cast(bf16x8, pk);
}
constexpr int ATT_QB = (NT / 64) * 32;
template <int DC> struct TileCfg { static constexpr int RS = DC * 2 + 16, BYTES = 64 * RS, NCH = 64 * DC / 8, NI = (NCH + NT - 1) / NT; };
template <int DC, class RowPtr> DI void tile_gload(u32x4 (&rg)[TileCfg<DC>::NI], RowPtr rp) {
#pragma unroll
    for (int i = 0; i < TileCfg<DC>::NI; ++i) { const int c = tidx() + NT * i; if (c < TileCfg<DC>::NCH) { const int row = c / (DC / 8), cc = c % (DC / 8); rg[i] = *(const u32x4*)(rp(row) + cc * 8); } }
}
template <int DC> DI void tile_lstore(const u32x4 (&rg)[TileCfg<DC>::NI], unsigned char* base) {
#pragma unroll
    for (int i = 0; i < TileCfg<DC>::NI; ++i) { const int c = tidx() + NT * i; if (c < TileCfg<DC>::NCH) { const int row = c / (DC / 8), cc = c % (DC / 8); *(u32x4*)(base + row * TileCfg<DC>::RS + cc * 16) = rg[i]; } }
}
template <int DK> DI void qk_tile(f32x16 (&s)[2], const bf16x8 (&qf)[DK / 16], const unsigned char* kl, int r, int h) {
    constexpr int RS = TileCfg<DK>::RS;
#pragma unroll
    for (int i = 0; i < 16; ++i) { s[0][i] = 0.f; s[1][i] = 0.f; }
#pragma unroll
    for (int ks = 0; ks < DK / 16; ++ks) {
        const bf16x8 k0 = *(const bf16x8*)(kl + r * RS + ks * 32 + h * 16), k1 = *(const bf16x8*)(kl + (32 + r) * RS + ks * 32 + h * 16);
        s[0] = __builtin_amdgcn_mfma_f32_32x32x16_bf16(k0, qf[ks], s[0], 0, 0, 0);
        s[1] = __builtin_amdgcn_mfma_f32_32x32x16_bf16(k1, qf[ks], s[1], 0, 0, 0);
    }
}
template <int DV> DI void pv_tile(f32x16 (&o)[DV / 32], const f32x16 (&pp)[2], const unsigned char* vl, int lane) {
    constexpr int RS = TileCfg<DV>::RS;
    const int h = lane >> 5, i16 = lane & 15, q = i16 >> 2, pq = i16 & 3, blk = (lane >> 4) & 1;
    const unsigned char* vb = vl + (4 * h + q) * RS + 2 * (16 * blk + 4 * pq);
#pragma unroll
    for (int kt = 0; kt < 2; ++kt)
#pragma unroll
        for (int s2 = 0; s2 < 2; ++s2) {
            const bf16x8 pf = pack8(pp[kt], s2);
#pragma unroll
            for (int dvt = 0; dvt < DV / 32; ++dvt) {
                const s16x4 lo = tr_read(vb + (kt * 32 + 16 * s2) * RS + dvt * 64), hi = tr_read(vb + (kt * 32 + 16 * s2 + 8) * RS + dvt * 64);
                const bf16x8 vf = __builtin_shufflevector(lo, hi, 0, 1, 2, 3, 4, 5, 6, 7);
                o[dvt] = __builtin_amdgcn_mfma_f32_32x32x16_bf16(vf, pf, o[dvt], 0, 0, 0);
            }
        }
}
constexpr float LOG2E = 1.4426950408889634f;
template <int DK, int DV, bool ALIBI, bool BOUNDARY, class ValidFn>
DI void softmax_tile(const bf16x8 (&qf)[DK / 16], f32x16 (&o)[DV / 32], float& m, float& l, const unsigned char* kl, const unsigned char* vl, int kb,
                     float c1, float sl2, int qpos, ValidFn valid, int lane) {
    const int r = lane & 31, h = lane >> 5;
    f32x16 s[2];
    qk_tile<DK>(s, qf, kl, r, h);
    const float base = ALIBI ? sl2 * (float)(kb + 4 * h - qpos) : 0.f;
    float tmax = -INFINITY;
#pragma unroll
    for (int kt = 0; kt < 2; ++kt)
#pragma unroll
        for (int i = 0; i < 16; ++i) {
            float v = ALIBI ? fmaf(s[kt][i], c1, fmaf(sl2, (float)(kt * 32 + (i & 3) + 8 * (i >> 2)), base)) : s[kt][i] * c1;
            if (BOUNDARY) v = valid(kb + kt * 32 + crow(i, h)) ? v : -INFINITY;
            s[kt][i] = v; tmax = fmaxf(tmax, v);
        }
    tmax = xhalf_max(tmax);
    const float mn = fmaxf(m, tmax);
    if (__any(mn > m)) {
        const float corr = __builtin_amdgcn_exp2f(m - mn);
        l *= corr;
#pragma unroll
        for (int dvt = 0; dvt < DV / 32; ++dvt)
#pragma unroll
            for (int i = 0; i < 16; ++i) o[dvt][i] *= corr;
        m = mn;
    }
    float ps = 0.f;
#pragma unroll
    for (int kt = 0; kt < 2; ++kt)
#pragma unroll
        for (int i = 0; i < 16; ++i) { const float pr = __builtin_amdgcn_exp2f(s[kt][i] - mn); s[kt][i] = pr; ps += pr; }
    l += ps;
    pv_tile<DV>(o, s, vl, lane);
}
template <int DK, int DV, bool ALIBI, class KPtr, class VPtr, class ValidFn, class InteriorFn>
DI void attn_stream(const bf16x8 (&qf)[DK / 16], f32x16 (&o)[DV / 32], float& m, float& l, unsigned tmask, int wave_qmax, int wave_kmin,
                    KPtr kp, VPtr vp, float c1, float sl2, int qpos, ValidFn valid, InteriorFn interior, unsigned char* lds) {
    unsigned char* kl = lds; unsigned char* vl = lds + TileCfg<DK>::BYTES;
    const int lane = tidx() & 63;
    u32x4 kA[TileCfg<DK>::NI], vA[TileCfg<DV>::NI], kB[TileCfg<DK>::NI], vB[TileCfg<DV>::NI];
    int ja = -1, jb = -1;
#define AS_NEXT(J, KR, VR) do { if (tmask) { J = __builtin_ctz(tmask); tmask &= tmask - 1; const int _j = J; \
        tile_gload<DK>(KR, [&](int row) { return kp(_j * 64 + row); }); tile_gload<DV>(VR, [&](int row) { return vp(_j * 64 + row); }); } else J = -1; } while (0)
#define AS_COMPUTE(J) do { const int _jc = (J); if (_jc * 64 <= wave_qmax && _jc * 64 + 63 >= wave_kmin) { \
        if (interior(_jc)) softmax_tile<DK, DV, ALIBI, false>(qf, o, m, l, kl, vl, _jc * 64, c1, sl2, qpos, valid, lane); \
        else softmax_tile<DK, DV, ALIBI, true>(qf, o, m, l, kl, vl, _jc * 64, c1, sl2, qpos, valid, lane); } } while (0)
    AS_NEXT(ja, kA, vA);
    AS_NEXT(jb, kB, vB);
    while (ja >= 0) {
        __syncthreads();
        tile_lstore<DK>(kA, kl); tile_lstore<DV>(vA, vl);
        __syncthreads();
        const int jc = ja;
        AS_NEXT(ja, kA, vA);
        AS_COMPUTE(jc);
        if (jb < 0) break;
        __syncthreads();
        tile_lstore<DK>(kB, kl); tile_lstore<DV>(vB, vl);
        __syncthreads();
        const int jd = jb;
        AS_NEXT(jb, kB, vB);
        AS_COMPUTE(jd);
    }
#undef AS_NEXT
#undef AS_COMPUTE
}

DI void job_mla_attn(const Params& p, int bid, int nblk, unsigned char* lds) {
    const bf16_t* QB = WSB(WS_QB); const bf16_t* KM = WSB(WS_KM); const bf16_t* VM = WSB(WS_VM); bf16_t* BR = WSB(WS_BR);
    constexpr int NQB = SEQ / ATT_QB, NU = BATCH * 4 * NQB;
    const int lane = tidx() & 63, wid = tidx() >> 6, r = lane & 31, h = lane >> 5;
    for (int u = bid; u < NU; u += nblk) {
        const int qblk = u / (BATCH * 4), bh = u % (BATCH * 4);
        const int b = bh >> 2, hd = bh & 3;
        const int q0 = qblk * ATT_QB, qw = q0 + wid * 32, qpos = qw + r;
        const long trow = (long)b * SEQ;
        bf16x8 qf[6];
#pragma unroll
        for (int ks = 0; ks < 6; ++ks) qf[ks] = *(const bf16x8*)(QB + (trow + qpos) * 384 + hd * 96 + ks * 16 + 8 * h);
        f32x16 o[2];
#pragma unroll
        for (int i = 0; i < 16; ++i) { o[0][i] = 0.f; o[1][i] = 0.f; }
        float m = -1e30f, l = 0.f;
        const int ntile = (q0 + ATT_QB - 1) / 64 + 1;
        const unsigned tmask = ntile >= 32 ? 0xffffffffu : ((1u << ntile) - 1u);
        attn_stream<96, 64, false>(qf, o, m, l, tmask, qw + 31, 0,
            [&](int row) { return KM + (trow + row) * 384 + hd * 96; },
            [&](int row) { return VM + (trow + row) * 256 + hd * 64; },
            0.10206207261596577f * LOG2E, 0.f, qpos,
            [&](int key) { return key <= qpos; }, [&](int j) { return j * 64 + 63 <= qw; }, lds);
        const float rl = 1.f / fmaxf(xhalf_sum(l), 1e-30f);
        bf16_t* dst = BR + (trow + qpos) * 1024 + 3 * 256 + hd * 64;
#pragma unroll
        for (int dvt = 0; dvt < 2; ++dvt)
#pragma unroll
            for (int i = 0; i < 4; ++i)
                st4bf(dst + dvt * 32 + 8 * i + 4 * h, o[dvt][4 * i] * rl, o[dvt][4 * i + 1] * rl, o[dvt][4 * i + 2] * rl, o[dvt][4 * i + 3] * rl);
    }
}
DI void job_cross_attn(const Params& p, int layer, int bid, int nblk, unsigned char* lds) {
    const bf16_t* XQ = WSB(WS_XQ); const bf16_t* KVM = WSB(WS_KVM) + (size_t)layer * 2048 * 1024; bf16_t* XO = WSB(WS_XO);
    constexpr int NQB = SEQ / ATT_QB, NU = BATCH * 4 * NQB;
    const int lane = tidx() & 63, wid = tidx() >> 6, r = lane & 31, h = lane >> 5;
    for (int u = bid; u < NU; u += nblk) {
        const int bh = u % (BATCH * 4), qblk = u / (BATCH * 4);
        const int b = bh >> 2, hd = bh & 3;
        const int qpos = qblk * ATT_QB + wid * 32 + r;
        const long trow = (long)b * SEQ;
        bf16x8 qf[8];
#pragma unroll
        for (int ks = 0; ks < 8; ++ks) qf[ks] = *(const bf16x8*)(XQ + (trow + qpos) * 512 + hd * 128 + ks * 16 + 8 * h);
        f32x16 o[4];
#pragma unroll
        for (int d = 0; d < 4; ++d)
#pragma unroll
            for (int i = 0; i < 16; ++i) o[d][i] = 0.f;
        float m = -1e30f, l = 0.f;
        attn_stream<128, 128, false>(qf, o, m, l, 0xFu, 1 << 30, 0,
            [&](int row) { return KVM + (long)(b * MEM_LEN + row) * 1024 + hd * 128; },
            [&](int row) { return KVM + (long)(b * MEM_LEN + row) * 1024 + 512 + hd * 128; },
            0.08838834764831845f * LOG2E, 0.f, qpos, [&](int) { return true; }, [&](int) { return true; }, lds);
        const float rl = 1.f / fmaxf(xhalf_sum(l), 1e-30f);
        bf16_t* dst = XO + (trow + qpos) * 512 + hd * 128;
#pragma unroll
        for (int dvt = 0; dvt < 4; ++dvt)
#pragma unroll
            for (int i = 0; i < 4; ++i)
                st4bf(dst + dvt * 32 + 8 * i + 4 * h, o[dvt][4 * i] * rl, o[dvt][4 * i + 1] * rl, o[dvt][4 * i + 2] * rl, o[dvt][4 * i + 3] * rl);
    }
}
DI float logsig_fast(float z) { return fminf(z, 0.f) - __logf(1.f + __expf(-fabsf(z))); }
DI void job_sb_attn(const Params& p, int bid, int nblk, unsigned char* lds) {
    const bf16_t* H = WSB(WS_H); bf16_t* BR = WSB(WS_BR);
    constexpr int NQB = SEQ / ATT_QB, NU = BATCH * 4 * NQB;
    const int lane = tidx() & 63, wid = tidx() >> 6, r = lane & 31, h = lane >> 5;
    unsigned char* kl = lds; unsigned char* vl = lds + TileCfg<64>::BYTES;
    for (int u = bid; u < NU; u += nblk) {
        const int half = u / (NU / 2), ru = u % (NU / 2);
        const int qi = ru / (BATCH * 4), bh = ru % (BATCH * 4);
        const int qblk = half == 0 ? (NQB - 1 - qi) : qi;
        const int b = bh >> 2, hd = bh & 3;
        const int q0 = qblk * ATT_QB, qw = q0 + wid * 32, qpos = qw + r;
        const long trow = (long)b * SEQ;
        bf16x8 qf[4];
#pragma unroll
        for (int ks = 0; ks < 4; ++ks) qf[ks] = *(const bf16x8*)(H + (trow + qpos) * NH + O_BQ + hd * 64 + ks * 16 + 8 * h);
        f32x16 o[2];
#pragma unroll
        for (int i = 0; i < 16; ++i) { o[0][i] = 0.f; o[1][i] = 0.f; }
        float trun = 0.f;
        int j = (q0 + ATT_QB - 1) >> 6;
        volatile int* flag = (volatile int*)(lds + 2 * TileCfg<64>::BYTES);
        if (tidx() == 0) { flag[0] = 0; flag[1] = 0; }
        u32x4 kr[TileCfg<64>::NI], vr[TileCfg<64>::NI];
        tile_gload<64>(kr, [&](int row) { return H + (trow + j * 64 + row) * NH + O_BK + hd * 64; });
        tile_gload<64>(vr, [&](int row) { return H + (trow + j * 64 + row) * NH + O_BV + hd * 64; });
        for (int it = 0; j >= 0; --j, ++it) {
            __syncthreads();
            if (it > 0 && flag[(it - 1) & 1] == 0) break;
            tile_lstore<64>(kr, kl); tile_lstore<64>(vr, vl);
            __syncthreads();
            if (tidx() == 0) flag[(it + 1) & 1] = 0;
            if (j > 0) { const int jn = j - 1;
                tile_gload<64>(kr, [&](int row) { return H + (trow + jn * 64 + row) * NH + O_BK + hd * 64; });
                tile_gload<64>(vr, [&](int row) { return H + (trow + jn * 64 + row) * NH + O_BV + hd * 64; }); }
            const bool wave_dead = __all(trun < -110.f);
            if (j * 64 < qw + 31 && !wave_dead) {
                const int kb = j * 64;
                f32x16 s[2], L[2];
                qk_tile<64>(s, qf, kl, r, h);
#pragma unroll
                for (int kt = 0; kt < 2; ++kt)
#pragma unroll
                    for (int i = 0; i < 16; ++i) {
                        const int key = kb + kt * 32 + crow(i, h);
                        const float z = s[kt][i] * 0.125f, lsp = logsig_fast(z);
                        const bool valid = key < qpos;
                        L[kt][i] = valid ? lsp - z : 0.f;
                        s[kt][i] = valid ? lsp : -INFINITY;
                    }
                float G[2][4], O[2][4];
#pragma unroll
                for (int kt = 0; kt < 2; ++kt)
#pragma unroll
                    for (int ig = 0; ig < 4; ++ig) { G[kt][ig] = (L[kt][4 * ig] + L[kt][4 * ig + 1]) + (L[kt][4 * ig + 2] + L[kt][4 * ig + 3]); O[kt][ig] = xhalf_other(G[kt][ig], h); }
                float run = trun;
#pragma unroll
                for (int kt = 1; kt >= 0; --kt)
#pragma unroll
                    for (int ig = 3; ig >= 0; --ig) {
                        const float t3 = run + (h == 0 ? O[kt][ig] : 0.f);
                        const float t2 = t3 + L[kt][4 * ig + 3], t1 = t2 + L[kt][4 * ig + 2], t0 = t1 + L[kt][4 * ig + 1];
                        s[kt][4 * ig + 3] = __expf(s[kt][4 * ig + 3] + t3); s[kt][4 * ig + 2] = __expf(s[kt][4 * ig + 2] + t2);
                        s[kt][4 * ig + 1] = __expf(s[kt][4 * ig + 1] + t1); s[kt][4 * ig + 0] = __expf(s[kt][4 * ig + 0] + t0);
                        run += G[kt][ig] + O[kt][ig];
                    }
                trun = run;
                pv_tile<64>(o, s, vl, lane);
            }
            if (!__all(trun < -110.f)) flag[it & 1] = 1;
        }
        bf16_t* dst = BR + (trow + qpos) * 1024 + 1 * 256 + hd * 64;
#pragma unroll
        for (int dvt = 0; dvt < 2; ++dvt)
#pragma unroll
            for (int i = 0; i < 4; ++i) st4bf(dst + dvt * 32 + 8 * i + 4 * h, o[dvt][4 * i], o[dvt][4 * i + 1], o[dvt][4 * i + 2], o[dvt][4 * i + 3]);
    }
}
constexpr int NSA_QB = (NT / 128) * 32;
DI void job_nsa(const Params& p, int bid, int nblk, unsigned char* lds) {
    const bf16_t* H = WSB(WS_H); const bf16_t* KCB = WSB(WS_KCB); const bf16_t* VCB = KCB + (size_t)NCR * 64;
    float* OACC = WSF(WS_OC); bf16_t* BR = WSB(WS_BR);
    constexpr int NQB = SEQ / NSA_QB, NU = BATCH * 2 * NQB;
    constexpr int TB_ = TileCfg<64>::BYTES;
    const int lane = tidx() & 63, wid = tidx() >> 6, r = lane & 31, h = lane >> 5;
    const int n = wid & 1, sub = wid >> 1;
    unsigned* orw = (unsigned*)(lds + 4 * TB_);
    float* impx = (float*)(lds + 4 * TB_ + 64);
    for (int u = bid; u < NU; u += nblk) {
        const int qblk = NQB - 1 - u / (BATCH * 2), bg = u % (BATCH * 2), b = bg >> 1, g = bg & 1;
        const int q0 = qblk * NSA_QB, qw = q0 + sub * 32, qpos = qw + r;
        const int head = g * 2 + n;
        const long trow = (long)b * SEQ;
        const bf16_t* hq_row = H + (trow + qpos) * NH;
        bf16x8 qf[1][4];
#pragma unroll
        for (int ks = 0; ks < 4; ++ks) qf[0][ks] = *(const bf16x8*)(hq_row + O_AQ + head * 64 + ks * 16 + 8 * h);
        const float sl = exp2f(-2.f * (float)(head + 1));
        const float gate0 = sigm(bf2f(hq_row[O_AG + head * 3 + 0])), gate1 = sigm(bf2f(hq_row[O_AG + head * 3 + 1])), gate2 = sigm(bf2f(hq_row[O_AG + head * 3 + 2]));
        float* oacc = OACC + (trow + qpos) * 256 + head * 64;
        __syncthreads();
        if (tidx() == 0) *orw = 0u;
        {
            u32x4 rg[TileCfg<64>::NI];
#pragma unroll
            for (int tl = 0; tl < 4; ++tl) {
                const bf16_t* src = (tl & 2) ? VCB : KCB; const int cb = (tl & 1) * 64;
                tile_gload<64>(rg, [&](int row) { const int c = cb + row < NCMP ? cb + row : NCMP - 1; return src + ((long)(b * NCMP + c) * 2 + g) * 64; });
                tile_lstore<64>(rg, lds + tl * TB_);
            }
        }
        __syncthreads();
        float imp[16];
        {
            f32x16 s[2][2];
            qk_tile<64>(s[0], qf[0], lds, r, h);
            qk_tile<64>(s[1], qf[0], lds + TB_, r, h);
            float tmax = -INFINITY;
#pragma unroll
            for (int tl = 0; tl < 2; ++tl)
#pragma unroll
                for (int kt = 0; kt < 2; ++kt)
#pragma unroll
                    for (int i = 0; i < 16; ++i) {
                        const int c = tl * 64 + kt * 32 + crow(i, h), dist = qpos - (16 * c + 31);
                        const float v = (c < NCMP && dist >= 0) ? s[tl][kt][i] * 0.125f - sl * (float)dist : -INFINITY;
                        s[tl][kt][i] = v; tmax = fmaxf(tmax, v);
                    }
            const float mn = fmaxf(xhalf_max(tmax), -1e30f);
            float ps = 0.f;
#pragma unroll
            for (int tl = 0; tl < 2; ++tl)
#pragma unroll
                for (int kt = 0; kt < 2; ++kt)
#pragma unroll
                    for (int i = 0; i < 16; ++i) { const float pr = __expf(s[tl][kt][i] - mn); s[tl][kt][i] = pr; ps += pr; }
            const float rl = 1.f / fmaxf(xhalf_sum(ps), 1e-30f);
            float P3[16];
#pragma unroll
            for (int tl = 0; tl < 2; ++tl)
#pragma unroll
                for (int kt = 0; kt < 2; ++kt) {
#pragma unroll
                    for (int ig = 0; ig < 4; ++ig) {
                        const float p0 = s[tl][kt][4 * ig] * rl, p1 = s[tl][kt][4 * ig + 1] * rl, p2 = s[tl][kt][4 * ig + 2] * rl, p3 = s[tl][kt][4 * ig + 3] * rl;
                        imp[tl * 8 + kt * 4 + ig] = (p0 + p1) + (p2 + 0.5f * p3);
                        P3[tl * 8 + kt * 4 + ig] = 0.5f * p3;
                    }
                    const float gs = rl * gate0;
#pragma unroll
                    for (int i = 0; i < 16; ++i) s[tl][kt][i] *= gs;
                }
#pragma unroll
            for (int idx = 0; idx < 16; ++idx) {
                const float pp = xhalf_other(P3[idx], h);
                float prevp;
                if (idx == 0) prevp = h ? pp : 0.f; else { const float ppm = xhalf_other(P3[idx - 1], h); prevp = h ? pp : ppm; }
                imp[idx] += prevp;
                impx[(wid * 16 + idx) * 64 + lane] = imp[idx];
            }
            f32x16 oc[2];
#pragma unroll
            for (int i = 0; i < 16; ++i) { oc[0][i] = 0.f; oc[1][i] = 0.f; }
            pv_tile<64>(oc, s[0], lds + 2 * TB_, lane);
            pv_tile<64>(oc, s[1], lds + 3 * TB_, lane);
#pragma unroll
            for (int dvt = 0; dvt < 2; ++dvt)
#pragma unroll
                for (int i = 0; i < 4; ++i) *(float4*)(oacc + dvt * 32 + 8 * i + 4 * h) = make_float4(oc[dvt][4 * i], oc[dvt][4 * i + 1], oc[dvt][4 * i + 2], oc[dvt][4 * i + 3]);
        }
        __syncthreads();
        unsigned sel = 0u;
        {
            const int cur = qpos >> 6;
#pragma unroll
            for (int idx = 0; idx < 16; ++idx) {
                const float other = impx[((wid ^ 1) * 16 + idx) * 64 + lane];
                const float tot = n == 0 ? imp[idx] + other : other + imp[idx];
                const int j = 2 * idx + h;
                const bool forced = (j == 0) || (j == cur), valid = (j * 64 <= qpos);
                imp[idx] = forced ? 1e4f : (valid ? tot : -1.0f);
            }
#pragma unroll 1
            for (int it = 0; it < 8; ++it) {
                float best = -INFINITY; int bj = 64;
#pragma unroll
                for (int idx = 0; idx < 16; ++idx) if (imp[idx] > best) { best = imp[idx]; bj = 2 * idx + h; }
                const float pb = xhalf_other(best, h); const int pj = __float_as_int(xhalf_other(__int_as_float(bj), h));
                const bool own = (best > pb) || (best == pb && bj < pj);
                const int wj = own ? bj : pj;
                sel |= 1u << wj;
#pragma unroll
                for (int idx = 0; idx < 16; ++idx) if (2 * idx + h == wj) imp[idx] = -INFINITY;
            }
        }
        atomicOr(orw, sel);
        __syncthreads();
        const unsigned bmask = *orw;
        const int jhi = (q0 + NSA_QB - 1) >> 6;
        const unsigned upto = jhi >= 31 ? 0xffffffffu : ((1u << (jhi + 1)) - 1u);
        const float c1 = 0.125f * LOG2E, sl2 = sl * LOG2E;
        {
            f32x16 o[2];
#pragma unroll
            for (int i = 0; i < 16; ++i) { o[0][i] = 0.f; o[1][i] = 0.f; }
            float m = -1e30f, l = 0.f;
            const int jlo = (q0 - 511 > 0 ? q0 - 511 : 0) >> 6;
            const unsigned tmask = upto & ~((1u << jlo) - 1u);
            attn_stream<64, 64, true>(qf[0], o, m, l, tmask, qw + 31, qw - 511,
                [&](int row) { return H + (trow + row) * NH + O_AKW + g * 64; },
                [&](int row) { return H + (trow + row) * NH + O_AVW + g * 64; },
                c1, sl2, qpos,
                [&](int key) { const int dist = qpos - key; return dist >= 0 && dist < 512; },
                [&](int j) { return j * 64 + 63 <= qw && qw + 31 - j * 64 < 512; }, lds);
            const float rl = gate2 / fmaxf(xhalf_sum(l), 1e-30f);
#pragma unroll
            for (int dvt = 0; dvt < 2; ++dvt)
#pragma unroll
                for (int i = 0; i < 4; ++i) { float4* a = (float4*)(oacc + dvt * 32 + 8 * i + 4 * h); float4 c = *a;
                    c.x += o[dvt][4 * i] * rl; c.y += o[dvt][4 * i + 1] * rl; c.z += o[dvt][4 * i + 2] * rl; c.w += o[dvt][4 * i + 3] * rl; *a = c; }
        }
        {
            f32x16 o[2];
#pragma unroll
            for (int i = 0; i < 16; ++i) { o[0][i] = 0.f; o[1][i] = 0.f; }
            float m = -1e30f, l = 0.f;
            attn_stream<64, 64, true>(qf[0], o, m, l, bmask & upto, qw + 31, 0,
                [&](int row) { return H + (trow + row) * NH + O_AKS + g * 64; },
                [&](int row) { return H + (trow + row) * NH + O_AVS + g * 64; },
                c1, sl2, qpos,
                [&](int key) { return key <= qpos && ((sel >> (key >> 6)) & 1u); },
                [&](int j) { return j * 64 + 63 <= qw && __all((sel >> j) & 1u); }, lds);
            const float rl = gate1 / fmaxf(xhalf_sum(l), 1e-30f);
            bf16_t* dst = BR + (trow + qpos) * 1024 + head * 64;
#pragma unroll
            for (int dvt = 0; dvt < 2; ++dvt)
#pragma unroll
                for (int i = 0; i < 4; ++i) { const float4 c = *(const float4*)(oacc + dvt * 32 + 8 * i + 4 * h);
                    st4bf(dst + dvt * 32 + 8 * i + 4 * h, c.x + o[dvt][4 * i] * rl, c.y + o[dvt][4 * i + 1] * rl, c.z + o[dvt][4 * i + 2] * rl, c.w + o[dvt][4 * i + 3] * rl); }
        }
    }
}

namespace pg8 { typedef PG8_LAS unsigned char* PG8_LAS_T; }
#define LDS3 ((pg8::PG8_LAS_T)lds)
#define GEMM256(EPI, SCHED, g, S, E) do { __syncthreads(); pg8::gemm_phase<EPI, SCHED, true, true>(LDS3, g, S, E); } while (0)
constexpr int NPH = 17;
constexpr int NPHASES = 2 + DEPTH * NPH;

__global__ void __launch_bounds__(NT, 2) mega(Params pk, int ph_lo, int ph_hi) {
    extern __shared__ __attribute__((aligned(16))) unsigned char lds[];
    const int bid = blockIdx.x, nblk = gridDim.x;
#define XB_HERE XcdBarrier bar_; bar_.bar = (unsigned*)(pk.ws + WS_CTL) + CW_BAR; bar_.x = xb_xcc_id(); bar_.st = (volatile LAS unsigned*)(lds + 131072)
    const bool multi = (ph_hi - ph_lo) > 1;
    if (multi) {
        uint4* xbw = (uint4*)(lds + 131072);
        if (tidx() == 0) *xbw = make_uint4(0u, 0u, 0u, 0u);
        __syncthreads();
        (void)xcd_barrier_post((unsigned*)(pk.ws + WS_CTL) + CW_BAR, (volatile LAS unsigned*)xbw);
    }
#ifndef PROBE_PH
#define PROBE_PH -100
#endif
#define PHASE(id, ...) do { const int _id = (id); if (ph_lo <= _id && _id < ph_hi) { for (int _rep = 0; _rep < ((PROBE_PH == -1 ? _id < 2 : (_id >= 2 && (_id - 2) % NPH == PROBE_PH)) ? 2 : 1); ++_rep) { if (_rep) { XB_HERE; xcd_barrier(bar_); } { Params p = pk; int layer = layer_; asm volatile("" : "+s"(p.ws), "+s"(p.out), "+s"(layer)); \
        const LayerW w = layer_w(p, layer); const float* Xin = (layer == 0) ? p.in[0] : WSF(WS_XC); const bf16_t* XinB = (layer == 0) ? WSB(WS_X0B) : WSB(WS_XCB); float* Xout = (layer == DEPTH - 1) ? p.out : WSF(WS_XC); \
        (void)w; (void)Xin; (void)XinB; (void)Xout; __VA_ARGS__; } } if (_id + 1 < ph_hi) { XB_HERE; xcd_barrier(bar_); } } } while (0)

    { const int layer_ = 0;
    PHASE(0, {
        job_wt<2>(p.in[2], DEPTH, 1024, NIN, WSB(WT_IN), NH, bid, nblk, lds);
        job_wt<0>(p.in[17], DEPTH, 1024, 1024, WSB(WT_BR), 1024, bid, nblk, lds);
        job_wt<0>(p.in[18], DEPTH, 1024, 1024, WSB(WT_OUT), 1024, bid, nblk, lds);
        job_wt<0>(p.in[21], DEPTH, 1024, 512, WSB(WT_Q), 512, bid, nblk, lds);
        job_wt<0>(p.in[22], DEPTH, 1024, 1024, WSB(WT_KV), 1024, bid, nblk, lds);
        job_wt<0>(p.in[23], DEPTH, 512, 1024, WSB(WT_O), 1024, bid, nblk, lds);
        job_wt<1>(p.in[30], DEPTH * 32, 1024, 1024, WSB(WT_GU), 1024, bid, nblk, lds);
        job_wt<0>(p.in[31], DEPTH * 32, 512, 1024, WSB(WT_DN), 1024, bid, nblk, lds);
        job_wt<0>(p.in[4], DEPTH * 2, 2048, 256, WSB(WT_C1), 256, bid, nblk, lds);
        job_wt<0>(p.in[5], DEPTH * 2, 256, 64, WSB(WT_C2), 128, bid, nblk, lds);
        job_wt<0>(p.in[15], DEPTH, 192, 384, WSB(WT_UQ), 384, bid, nblk, lds);
        job_wt<0>(p.in[16], DEPTH, 128, 512, WSB(WT_UKV), 512, bid, nblk, lds);
        job_pack_small(p, bid, nblk);
        job_cvt(p.in[0], WSB(WS_X0B), (long)T * 1024, bid, nblk);
        job_cvt(p.in[1], WSB(WS_MEMB), (long)2048 * 1024, bid, nblk);
    });
    PHASE(1, {
        pg8::Gemm g{WSB(WS_MEMB), WSB(WT_KV), BATCH * MEM_LEN, 1024, 1024, nullptr};
        GroupedOrder S{8, 4, DEPTH, nblk, bid};
        EpiStoreBf16 E{WSB(WS_KVM), 1024, 1 << 30, (long)2048 * 1024};
        GEMM256(EpiStoreBf16, GroupedOrder, g, S, E);
    });
    }
    for (int layer_ = 0; layer_ < DEPTH; ++layer_) {
        const int base = 2 + layer_ * NPH;
        PHASE(base + 0, { pg8::Gemm g{XinB, w.t_in, T, NH, 1024, nullptr}; pg8::StaticOrder S; S.init(T, NH, nblk, bid); EpiStoreBf16 E{WSB(WS_H), NH, O_MG / 128, 0}; GEMM256(EpiStoreBf16, pg8::StaticOrder, g, S, E); });
        PHASE(base + 1, { job_sb_attn(p, bid, nblk, lds); job_cmp_gather(p, w, bid, nblk); job_rnn_conv(p, w, bid, nblk); job_mla_norm(p, w, bid, nblk); });
        PHASE(base + 2, { if (bid < 32) job_cmp_mlp<0>(p, w, bid, 32, lds); else { job_rnn_gates(p, w, bid - 32, nblk - 32, lds); job_mla_up(p, w, bid - 32, nblk - 32, lds); } });
        PHASE(base + 3, { job_cmp_mlp<1>(p, w, bid, nblk, lds); job_rnn_scan1(p, bid, nblk); });
        PHASE(base + 4, { job_nsa(p, bid, nblk, lds); job_mla_attn(p, bid, nblk, lds); job_rnn_scan2(p, bid, nblk); });
        PHASE(base + 5, { job_merge(p, w, bid, nblk, lds); });
        PHASE(base + 6, { pg8::Gemm g{WSB(WS_M), w.t_out, T, 1024, 1024, nullptr}; pg8::StaticOrder S; S.init(T, 1024, nblk, bid); EpiStoreBf16 E{WSB(WS_Y), 1024, 1 << 30, 0}; GEMM256(EpiStoreBf16, pg8::StaticOrder, g, S, E); });
        PHASE(base + 7, { job_ln(layer == 0 ? p.in[0] : nullptr, WSB(WS_XCB), nullptr, WSB(WS_Y), nullptr, nullptr, nullptr, nullptr, w.ln1_g, w.ln1_b, nullptr, WSB(WS_XAB), nullptr, bid, nblk, lds); });
        PHASE(base + 8, { pg8::Gemm g{WSB(WS_XAB), w.t_q, T, 512, 1024, nullptr}; pg8::StaticOrder S; S.init(T, 512, nblk, bid); EpiStoreBf16 E{WSB(WS_XQ), 512, 1 << 30, 0}; GEMM256(EpiStoreBf16, pg8::StaticOrder, g, S, E); });
        PHASE(base + 9, { job_cross_attn(p, layer, bid, nblk, lds); });
        PHASE(base + 10, { pg8::Gemm g{WSB(WS_XO), w.t_o, T, 1024, 512, nullptr}; pg8::StaticOrder S; S.init(T, 1024, nblk, bid); EpiStoreBf16 E{WSB(WS_Y), 1024, 1 << 30, 0}; GEMM256(EpiStoreBf16, pg8::StaticOrder, g, S, E); });
        PHASE(base + 11, { job_ln(nullptr, WSB(WS_XAB), nullptr, WSB(WS_Y), nullptr, nullptr, nullptr, nullptr, w.ln2_g, w.ln2_b, nullptr, WSB(WS_XBB), WSB(WS_XBL), bid, nblk, lds); });
        PHASE(base + 12, { job_router_logits(p, w, bid, nblk, lds); });
        PHASE(base + 13, { job_router(p, w, layer, bid, nblk); });
        PHASE(base + 14, { const pg8::ListOrder S = moe_units(WSU(WS_CTL) + CW_CNT + layer * 32, bid, nblk, lds); pg8::Gemm g{WSB(WS_XBB), w.t_gu, PADROWS, 1024, 1024, WSI(WS_PERM)}; EpiMoeGU E{WSB(WS_HH)}; __syncthreads(); pg8::gemm_phase<EpiMoeGU, pg8::ListOrder, true, true, true>(LDS3, g, S, E); });
        PHASE(base + 15, { const pg8::ListOrder S = moe_units(WSU(WS_CTL) + CW_CNT + layer * 32, bid, nblk, lds); pg8::Gemm g{WSB(WS_HH), w.t_dn, PADROWS, 1024, 512, nullptr}; EpiStoreBf16 E{WSB(WS_YK), 1024, 1 << 30, 0}; GEMM256(EpiStoreBf16, pg8::ListOrder, g, S, E); });
        PHASE(base + 16, { job_ln(nullptr, WSB(WS_XBB), WSB(WS_XBL), WSB(WS_YK), WSI(WS_EIDX), WSI(WS_ESLOT), WSU(WS_CTL) + CW_CNT + layer * 32, WSF(WS_EW), w.ln3_g, w.ln3_b, (layer == DEPTH - 1) ? p.out : nullptr, (layer == DEPTH - 1) ? nullptr : WSB(WS_XCB), nullptr, bid, nblk, lds); });
    }
}

extern "C" void kernel_launch(void* const* d_in, const int* in_sizes, int n_in, void* d_out, int out_size, void* d_ws, size_t ws_size, hipStream_t stream) {
    constexpr size_t kDynLds = 131072 + 1024;
    static_assert(2 * G_STAGE + 1024 <= 131072, "engine stages fit");
    static int grid = 0;
    if (!grid) {
        int dev = 0, cus = 0, per_cu = 0;
        (void)hipGetDevice(&dev);
        (void)hipDeviceGetAttribute(&cus, hipDeviceAttributeMultiprocessorCount, dev);
        (void)hipFuncSetAttribute((const void*)mega, hipFuncAttributeMaxDynamicSharedMemorySize, (int)kDynLds);
        (void)hipOccupancyMaxActiveBlocksPerMultiprocessor(&per_cu, mega, NT, kDynLds);
        if (per_cu < 1) per_cu = 1;
        grid = cus * (per_cu < 2 ? per_cu : 2);
    }
    if (ws_size < WS_END) { fprintf(stderr, "workspace too small: %zu < %zu\n", ws_size, (size_t)WS_END); return; }
    Params p{};
    for (int i = 0; i < 34; ++i) p.in[i] = (const float*)d_in[i];
    p.out = (float*)d_out;
    p.ws = (unsigned char*)d_ws;
    (void)hipMemsetAsync(d_ws, 0, CTL_BYTES, stream);
#if MK_ONE_LAUNCH
    hipLaunchKernelGGL(mega, dim3(grid), dim3(NT), kDynLds, stream, p, 0, NPHASES);
#else
    for (int ph = 0; ph < NPHASES; ++ph) hipLaunchKernelGGL(mega, dim3(grid), dim3(NT), kDynLds, stream, p, ph, ph + 1);
#endif
}
```

```cpp
#include <hip/hip_runtime.h>
#include <stdint.h>
#include <stdio.h>

#ifndef MK_ONE_LAUNCH
#define MK_ONE_LAUNCH 1
#endif

#define DI __device__ __forceinline__
#define LAS __attribute__((address_space(3)))
DI int tidx() { int t = threadIdx.x; asm volatile("" : "+v"(t)); return t; }

constexpr int NT = 512;
constexpr int D = 1024, BATCH = 8, SEQ = 2048, T = BATCH * SEQ, DEPTH = 4;
constexpr int MEM_LEN = 256;
constexpr int NIN = 6764, NH = 6912;
constexpr int O_AQ = 0, O_AKC = 256, O_AVC = 384, O_AKS = 512, O_AVS = 640, O_AKW = 768, O_AVW = 896,
              O_BQ = 1024, O_BK = 1280, O_BV = 1536, O_CX = 1792, O_CG = 2048, O_DCQ = 2304, O_DCKV = 2496, O_DKR = 2624,
              O_AG = 2656, O_MG = 2688;
constexpr int NCMP = 127, NCR = BATCH * NCMP * 2;
constexpr int NEXP = 32, NASSIGN = T * 2;
constexpr int PCAP = T;
constexpr float DN_ALPHA = 1.681792830507429f;

typedef unsigned short bf16_t;
typedef short bf16x8 __attribute__((ext_vector_type(8)));
typedef float f32x16 __attribute__((ext_vector_type(16)));
typedef unsigned u32x4 __attribute__((ext_vector_type(4)));

constexpr int G_WM = NT / 128;
constexpr int G_BM = 64 * G_WM;
constexpr int G_BN = 128;
constexpr int G_RS = 144;
constexpr int G_STAGE = (G_BM + G_BN) * G_RS;
constexpr int PADROWS = ((NASSIGN + NEXP * (G_BM - 1) + G_BM - 1) / G_BM) * G_BM;

constexpr size_t MiB = 1u << 20;
constexpr size_t al(size_t x) { return (x + 255) & ~(size_t)255; }
constexpr size_t WS_CTL = 0, CTL_BYTES = 1 * MiB;
constexpr size_t WT_IN = WS_CTL + CTL_BYTES;
constexpr size_t WT_BR = WT_IN + al((size_t)DEPTH * NH * 1024 * 2);
constexpr size_t WT_OUT = WT_BR + al((size_t)DEPTH * 4 * 1024 * 256 * 2);
constexpr size_t WT_Q = WT_OUT + al((size_t)DEPTH * 1024 * 1024 * 2);
constexpr size_t WT_KV = WT_Q + al((size_t)DEPTH * 512 * 1024 * 2);
constexpr size_t WT_O = WT_KV + al((size_t)DEPTH * 1024 * 1024 * 2);
constexpr size_t WT_GU = WT_O + al((size_t)DEPTH * 1024 * 512 * 2);
constexpr size_t WT_DN = WT_GU + al((size_t)DEPTH * 32 * 1024 * 1024 * 2);
constexpr size_t WS_X0B = WT_DN + al((size_t)DEPTH * 32 * 1024 * 512 * 2);
constexpr size_t WS_MEMB = WS_X0B + al((size_t)T * 1024 * 2);
constexpr size_t WS_H = WS_MEMB + al((size_t)2048 * 1024 * 2);
constexpr size_t SZ_H = al((size_t)T * NH * 2);
constexpr size_t WS_YK = WS_H;
constexpr size_t WS_HH = WS_YK + (size_t)PADROWS * 1024 * 2;
static_assert(WS_HH + (size_t)PADROWS * 512 * 2 <= WS_H + SZ_H, "moe overlay fits in H");
constexpr size_t WS_TB = WS_H + SZ_H;
constexpr size_t WS_HID = WS_TB + al((size_t)2 * NCR * 2048 * 4);
constexpr size_t WS_KCVC = WS_HID + al((size_t)2 * NCR * 256 * 4);
constexpr size_t WS_PC = WS_KCVC + al((size_t)2 * NCR * 64 * 4);
constexpr size_t WS_SEL = WS_PC + al((size_t)BATCH * 4 * SEQ * 128 * 4);
constexpr size_t WS_OW = WS_SEL + al((size_t)BATCH * 2 * SEQ * 4);
constexpr size_t WS_OC = WS_OW + al((size_t)T * 256 * 4);
constexpr size_t WS_BR = WS_OC + al((size_t)T * 256 * 4);
constexpr size_t WS_U = WS_BR + al((size_t)T * 1024 * 2);
constexpr size_t WS_RA = WS_U + al((size_t)T * 256 * 4);
constexpr size_t WS_RB = WS_RA + al((size_t)T * 256 * 4);
constexpr size_t WS_CQN = WS_RB + al((size_t)T * 256 * 4);
constexpr size_t WS_CKVN = WS_CQN + al((size_t)T * 192 * 4);
constexpr size_t WS_KR = WS_CKVN + al((size_t)T * 128 * 4);
constexpr size_t WS_Q = WS_KR + al((size_t)T * 32 * 4);
constexpr size_t WS_KV = WS_Q + al((size_t)T * 384 * 4);
constexpr size_t WS_M = WS_KV + al((size_t)T * 512 * 4);
constexpr size_t WS_Y = WS_M + al((size_t)T * 1024 * 2);
constexpr size_t WS_XA = WS_Y + al((size_t)T * 1024 * 4);
constexpr size_t WS_XB = WS_XA + al((size_t)T * 1024 * 4);
constexpr size_t WS_XC = WS_XB + al((size_t)T * 1024 * 4);
constexpr size_t WS_XAB = WS_XC + al((size_t)T * 1024 * 4);
constexpr size_t WS_XBB = WS_XAB + al((size_t)T * 1024 * 2);
constexpr size_t WS_XCB = WS_XBB + al((size_t)T * 1024 * 2);
constexpr size_t WS_XQ = WS_XCB + al((size_t)T * 1024 * 2);
constexpr size_t WS_XO = WS_XQ + al((size_t)T * 512 * 2);
constexpr size_t WS_KVM = WS_XO + al((size_t)T * 512 * 2);
constexpr size_t WS_LOG = WS_KVM + al((size_t)DEPTH * 2048 * 1024 * 2);
constexpr size_t WS_EIDX = WS_LOG + al((size_t)3 * T * 36 * 4);
constexpr size_t WS_ESLOT = WS_EIDX + al((size_t)NASSIGN * 4);
constexpr size_t WS_EW = WS_ESLOT + al((size_t)NASSIGN * 4);
constexpr size_t WS_PERM = WS_EW + al((size_t)NASSIGN * 4);
constexpr size_t WS_QB = WS_PERM + al((size_t)NEXP * T * 4);
constexpr size_t WS_KM = WS_QB + al((size_t)T * 384 * 2);
constexpr size_t WS_VM = WS_KM + al((size_t)T * 384 * 2);
constexpr size_t WS_KCB = WS_VM + al((size_t)T * 256 * 2);
constexpr size_t WT_C1 = WS_KCB + al((size_t)2 * NCR * 64 * 2);
constexpr size_t WT_C2 = WT_C1 + al((size_t)DEPTH * 2 * 256 * 2048 * 2);
constexpr size_t WT_UQ = WT_C2 + al((size_t)DEPTH * 2 * 128 * 256 * 2);
constexpr size_t WT_UKV = WT_UQ + al((size_t)DEPTH * 384 * 192 * 2);
constexpr size_t WT_G = WT_UKV + al((size_t)DEPTH * 512 * 128 * 2);
constexpr size_t WT_RH = WT_G + al((size_t)DEPTH * 4 * 128 * 64 * 2);
constexpr size_t WT_RL = WT_RH + al((size_t)DEPTH * 128 * 1024 * 2);
constexpr size_t WS_TBB = WT_RL + al((size_t)DEPTH * 128 * 1024 * 2);
constexpr size_t WS_HIDB = WS_TBB + al((size_t)2 * 2048 * 2048 * 2);
constexpr size_t WS_UB = WS_HIDB + al((size_t)2 * 2048 * 256 * 2);
constexpr size_t WS_CQNB = WS_UB + al((size_t)T * 256 * 2);
constexpr size_t WS_CKVNB = WS_CQNB + al((size_t)T * 192 * 2);
constexpr size_t WS_XBL = WS_CKVNB + al((size_t)T * 128 * 2);
constexpr size_t WS_SA = WS_XBL + al((size_t)T * 1024 * 2);
constexpr size_t WS_SH = WS_SA + al((size_t)BATCH * 32 * 256 * 4);
constexpr size_t WS_XG = WS_SH + al((size_t)BATCH * 32 * 256 * 4);
constexpr size_t WS_ROWOF = WS_XG + al((size_t)PADROWS * 1024 * 2);
constexpr size_t WS_ROPE_PRE = WS_ROWOF + al((size_t)NASSIGN * 4);
constexpr size_t WS_ROPE = WS_ROPE_PRE;
constexpr size_t WS_END = WS_ROPE + al((size_t)SEQ * 16 * 2 * 4);

constexpr int CW_BAR = 4096;
constexpr int CW_CNT = 16384;

struct Params {
    const float* in[34];
    float* out;
    unsigned char* ws;
};

#define XB_TMO      128
#define XB_XCNT(j)  (256  + 64 * (j))
#define XB_XSUB(j)  (1280 + 64 * (j))
#define XB_XGEN(j)  (2304 + 64 * (j))
#define XB_TOP      3328
#define XB_TOPGEN   3392
#define XCD_BAR_WORDS 3456
#define XB_SPIN_CAP (1u << 22)

__device__ __forceinline__ unsigned xb_ld(unsigned* p)              { return __hip_atomic_load(p, __ATOMIC_RELAXED, __HIP_MEMORY_SCOPE_AGENT); }
__device__ __forceinline__ unsigned xb_add(unsigned* p, unsigned v) { return __hip_atomic_fetch_add(p, v, __ATOMIC_RELAXED, __HIP_MEMORY_SCOPE_AGENT); }
__device__ __forceinline__ unsigned xb_xcc_id() { return (unsigned)__builtin_amdgcn_s_getreg((3 << 11) | 20) & 0xFu; }
#define XB_SPIN(cond, bar) do { unsigned _sp = 0; while (cond) { __builtin_amdgcn_s_sleep(1); \
    if ((++_sp & 255u) == 0u) { if (xb_ld(&(bar)[XB_TMO])) break; if (_sp > XB_SPIN_CAP) { atomicAdd(&(bar)[XB_TMO], 1u); break; } } } } while (0)

struct XcdBarrier { unsigned* bar; unsigned x; volatile LAS unsigned* st; };

__device__ __forceinline__ XcdBarrier xcd_barrier_post(unsigned* bar, volatile LAS unsigned* st) {
    XcdBarrier b; b.bar = bar; b.x = xb_xcc_id(); b.st = st;
    if (threadIdx.x == 0) (void)xb_add(&bar[XB_XCNT(b.x)], 1u);
    return b;
}
__device__ __forceinline__ void xcd_barrier_complete(unsigned* bar, unsigned x, unsigned& nloc, unsigned& nx) {
    const unsigned G = gridDim.x * gridDim.y * gridDim.z;
    unsigned sum, cnt, mine, sp = 0u;
    for (;;) {
        sum = 0u; cnt = 0u; mine = 0u;
#pragma unroll
        for (unsigned j = 0; j < 16; ++j) { const unsigned c = xb_ld(&bar[XB_XCNT(j)]); sum += c; cnt += (c > 0u) ? 1u : 0u; mine = (j == x) ? c : mine; }
        if (sum == G) break;
        __builtin_amdgcn_s_sleep(1);
        if ((++sp & 255u) == 0u) { if (xb_ld(&bar[XB_TMO])) break; if (sp > XB_SPIN_CAP) { atomicAdd(&bar[XB_TMO], 1u); break; } }
    }
    nloc = mine > 0u ? mine : 1u; nx = cnt > 0u ? cnt : 1u;
}
__device__ __forceinline__ void xcd_barrier(const XcdBarrier& b) {
    asm volatile("s_waitcnt vmcnt(0)" ::: "memory");
    __syncthreads();
    if (threadIdx.x == 0) {
        unsigned* bar = b.bar;
        __builtin_amdgcn_s_waitcnt(0);
        unsigned nloc = b.st[0], nx = b.st[1];
        if (nloc == 0u) { xcd_barrier_complete(bar, b.x, nloc, nx); b.st[0] = nloc; b.st[1] = nx; }
        const unsigned old = xb_add(&bar[XB_XSUB(b.x)], 1u);
        const unsigned gen = old / nloc;
        if (old + 1u == (gen + 1u) * nloc) {
            __builtin_amdgcn_fence(__ATOMIC_RELEASE, "agent");
            asm volatile("s_waitcnt vmcnt(0)" ::: "memory");
            const unsigned og = xb_add(&bar[XB_TOP], 1u);
            const unsigned tg = og / nx;
            if (og + 1u == (tg + 1u) * nx) xb_add(&bar[XB_TOPGEN], 1u);
            else XB_SPIN(xb_ld(&bar[XB_TOPGEN]) == tg, bar);
            __builtin_amdgcn_fence(__ATOMIC_ACQUIRE, "agent");
            xb_add(&bar[XB_XGEN(b.x)], 1u);
            asm volatile("s_waitcnt vmcnt(0)" ::: "memory");
        } else {
            XB_SPIN(xb_ld(&bar[XB_XGEN(b.x)]) == gen, bar);
            __builtin_amdgcn_fence(__ATOMIC_ACQUIRE, "agent");
            asm volatile("s_waitcnt vmcnt(0)" ::: "memory");
        }
    }
    __syncthreads();
}

DI float gelu_tanh(float x) { const float u = 0.7978845608028654f * (x + 0.044715f * x * x * x); return 0.5f * x * (1.f + tanhf(u)); }
DI float sigm(float x) { return 1.f / (1.f + expf(-x)); }
DI float sigm_fast(float x) { return __builtin_amdgcn_rcpf(1.f + __expf(-x)); }
DI float logsig(float z) { return fminf(z, 0.f) - log1pf(expf(-fabsf(z))); }
DI float wave_sum(float v) {
    const int lane = tidx() & 63;
#pragma unroll
    for (int o = 32; o > 0; o >>= 1) v += __int_as_float(__builtin_amdgcn_ds_bpermute((lane ^ o) << 2, __float_as_int(v)));
    return v;
}
DI void wave_sum2(float& a, float& b) {
    const int lane = tidx() & 63;
#pragma unroll
    for (int o = 32; o > 0; o >>= 1) {
        const float a2 = __int_as_float(__builtin_amdgcn_ds_bpermute((lane ^ o) << 2, __float_as_int(a)));
        const float b2 = __int_as_float(__builtin_amdgcn_ds_bpermute((lane ^ o) << 2, __float_as_int(b)));
        a += a2; b += b2;
    }
}

DI float bflo(unsigned u) { return __uint_as_float(u << 16); }
DI float bfhi(unsigned u) { return __uint_as_float(u & 0xffff0000u); }
DI float bf2f(bf16_t x) { return __uint_as_float((unsigned)x << 16); }
typedef float f32x2_t __attribute__((ext_vector_type(2)));
typedef __bf16 bf16x2_t __attribute__((ext_vector_type(2)));
DI unsigned pk_bf16(float lo, float hi) { f32x2_t v = {lo, hi}; bf16x2_t b = __builtin_convertvector(v, bf16x2_t); return __builtin_bit_cast(unsigned, b); }
DI bf16_t f2bf(float x) { return (bf16_t)(pk_bf16(x, 0.f) & 0xffffu); }
DI void st4bf(bf16_t* p, float a, float b, float c, float d) { uint2 v; v.x = pk_bf16(a, b); v.y = pk_bf16(c, d); *(uint2*)p = v; }
DI void ld8f(const bf16_t* p, float* f) { const u32x4 v = *(const u32x4*)p; f[0] = bflo(v[0]); f[1] = bfhi(v[0]); f[2] = bflo(v[1]); f[3] = bfhi(v[1]); f[4] = bflo(v[2]); f[5] = bfhi(v[2]); f[6] = bflo(v[3]); f[7] = bfhi(v[3]); }
DI void st8bf(bf16_t* p, const float* f) { u32x4 v; v[0] = pk_bf16(f[0], f[1]); v[1] = pk_bf16(f[2], f[3]); v[2] = pk_bf16(f[4], f[5]); v[3] = pk_bf16(f[6], f[7]); *(u32x4*)p = v; }
DI float4 ld4bf(const bf16_t* p) { const uint2 v = *(const uint2*)p; return make_float4(bflo(v.x), bfhi(v.x), bflo(v.y), bfhi(v.y)); }
template <int N> DI float dot_row(const float* q, const bf16_t* kr) {
    float dot = 0.f;
#pragma unroll
    for (int d = 0; d < N; d += 8) { const uint4 v = *(const uint4*)(kr + d);
        dot = fmaf(q[d], bflo(v.x), dot); dot = fmaf(q[d + 1], bfhi(v.x), dot); dot = fmaf(q[d + 2], bflo(v.y), dot); dot = fmaf(q[d + 3], bfhi(v.y), dot);
        dot = fmaf(q[d + 4], bflo(v.z), dot); dot = fmaf(q[d + 5], bfhi(v.z), dot); dot = fmaf(q[d + 6], bflo(v.w), dot); dot = fmaf(q[d + 7], bfhi(v.w), dot); }
    return dot;
}
template <int N> DI float dot_row(const float* q, const float* kr) {
    float dot = 0.f;
#pragma unroll
    for (int d = 0; d < N; ++d) dot = fmaf(q[d], kr[d], dot);
    return dot;
}
template <int N> DI void axpy_row(float* o, float pr, float corr, const bf16_t* vr) {
#pragma unroll
    for (int d = 0; d < N; d += 8) { const uint4 v = *(const uint4*)(vr + d);
        o[d] = fmaf(pr, bflo(v.x), o[d] * corr); o[d + 1] = fmaf(pr, bfhi(v.x), o[d + 1] * corr); o[d + 2] = fmaf(pr, bflo(v.y), o[d + 2] * corr); o[d + 3] = fmaf(pr, bfhi(v.y), o[d + 3] * corr);
        o[d + 4] = fmaf(pr, bflo(v.z), o[d + 4] * corr); o[d + 5] = fmaf(pr, bfhi(v.z), o[d + 5] * corr); o[d + 6] = fmaf(pr, bflo(v.w), o[d + 6] * corr); o[d + 7] = fmaf(pr, bfhi(v.w), o[d + 7] * corr); }
}
template <int N> DI void axpy_row(float* o, float pr, float corr, const float* vr) {
#pragma unroll
    for (int d = 0; d < N; ++d) o[d] = fmaf(pr, vr[d], o[d] * corr);
}
template <int N> DI void ld_row(float* q, const bf16_t* p) {
#pragma unroll
    for (int d = 0; d < N; d += 8) { const uint4 v = *(const uint4*)(p + d);
        q[d] = bflo(v.x); q[d + 1] = bfhi(v.x); q[d + 2] = bflo(v.y); q[d + 3] = bfhi(v.y); q[d + 4] = bflo(v.z); q[d + 5] = bfhi(v.z); q[d + 6] = bflo(v.w); q[d + 7] = bfhi(v.w); }
}
template <int N> DI void ld_row(float* q, const float* p) {
#pragma unroll
    for (int d = 0; d < N; d += 4) { const float4 v = *(const float4*)(p + d); q[d] = v.x; q[d + 1] = v.y; q[d + 2] = v.z; q[d + 3] = v.w; }
}

struct MG { const bf16_t* A; long lda; const bf16_t* Wt; long ldw; int K; };

struct NoFlush { DI void operator()(int, f32x16 (&)[2][2]) const {} };
struct NoPre { DI void operator()(int) const {} };
template <class RowFn, class Flush, class Pre>
DI void mgemm_tile_f(const MG& g, int n0, RowFn rowfn, f32x16 (&acc)[2][2], unsigned char* lds, bool zero, int flush_every, Flush flush, Pre pre) {
    constexpr int XI = G_BM * 8 / NT, WI = G_BN * 8 / NT;
    const int tid = tidx(), lane = tid & 63, wid = tid >> 6, r = lane & 31, h = lane >> 5;
    const int wm = wid % G_WM, wn = wid / G_WM;
    const int cc = tid & 7, row0 = tid >> 3;
    const bf16_t* xp[XI]; const bf16_t* wp[WI];
#pragma unroll
    for (int i = 0; i < XI; ++i) xp[i] = g.A + (long)rowfn(row0 + (NT / 8) * i) * g.lda + cc * 8;
#pragma unroll
    for (int i = 0; i < WI; ++i) wp[i] = g.Wt + (long)(n0 + row0 + (NT / 8) * i) * g.ldw + cc * 8;
    const int st_off = row0 * G_RS + cc * 16;
    if (zero)
#pragma unroll
    for (int a = 0; a < 2; ++a)
#pragma unroll
        for (int b = 0; b < 2; ++b)
#pragma unroll
            for (int i = 0; i < 16; ++i) acc[a][b][i] = 0.f;
    const int nk = g.K >> 6;
    u32x4 xv0[XI], wv0[WI], xv1[XI], wv1[WI];
#define MG_GLOAD(XV, WV, KT) do { _Pragma("unroll") for (int i = 0; i < XI; ++i) XV[i] = *(const u32x4*)(xp[i] + (KT) * 64); \
                                  _Pragma("unroll") for (int i = 0; i < WI; ++i) WV[i] = *(const u32x4*)(wp[i] + (KT) * 64); } while (0)
#define MG_LSTORE(XV, WV, STG) do { unsigned char* _s = lds + (STG) * G_STAGE; \
        _Pragma("unroll") for (int i = 0; i < XI; ++i) *(u32x4*)(_s + st_off + (NT / 8) * i * G_RS) = XV[i]; \
        _Pragma("unroll") for (int i = 0; i < WI; ++i) *(u32x4*)(_s + G_BM * G_RS + st_off + (NT / 8) * i * G_RS) = WV[i]; } while (0)
    MG_GLOAD(xv0, wv0, 0);
    if (nk > 1) MG_GLOAD(xv1, wv1, 1);
    __syncthreads();
    MG_LSTORE(xv0, wv0, 0);
    if (nk > 2) MG_GLOAD(xv0, wv0, 2);
    __syncthreads();
    const int xf_off = (wm * 64 + r) * G_RS + h * 16, wf_off = G_BM * G_RS + (wn * 64 + r) * G_RS + h * 16;
#define MG_COMPUTE(STG) do { const unsigned char* st = lds + (STG) * G_STAGE; \
        _Pragma("unroll") for (int ks = 0; ks < 4; ++ks) { \
            const bf16x8 w0 = *(const bf16x8*)(st + wf_off + ks * 32), w1 = *(const bf16x8*)(st + wf_off + 32 * G_RS + ks * 32); \
            const bf16x8 x0 = *(const bf16x8*)(st + xf_off + ks * 32), x1 = *(const bf16x8*)(st + xf_off + 32 * G_RS + ks * 32); \
            acc[0][0] = __builtin_amdgcn_mfma_f32_32x32x16_bf16(w0, x0, acc[0][0], 0, 0, 0); \
            acc[0][1] = __builtin_amdgcn_mfma_f32_32x32x16_bf16(w0, x1, acc[0][1], 0, 0, 0); \
            acc[1][0] = __builtin_amdgcn_mfma_f32_32x32x16_bf16(w1, x0, acc[1][0], 0, 0, 0); \
            acc[1][1] = __builtin_amdgcn_mfma_f32_32x32x16_bf16(w1, x1, acc[1][1], 0, 0, 0); } } while (0)
    for (int kt = 0; kt < nk; kt += 2) {
        if (flush_every && kt % flush_every == 0) pre(kt / flush_every);
        MG_COMPUTE(0);
        if (kt + 1 < nk) { MG_LSTORE(xv1, wv1, 1); if (kt + 3 < nk) MG_GLOAD(xv1, wv1, kt + 3); }
        if (flush_every && (kt + 1) % flush_every == 0) flush(kt / flush_every, acc);
        __syncthreads();
        if (kt + 1 < nk) {
            MG_COMPUTE(1);
            if (kt + 2 < nk) { MG_LSTORE(xv0, wv0, 0); if (kt + 4 < nk) MG_GLOAD(xv0, wv0, kt + 4); }
            if (flush_every && (kt + 2) % flush_every == 0) flush((kt + 1) / flush_every, acc);
            __syncthreads();
        }
    }
#undef MG_GLOAD
#undef MG_LSTORE
#undef MG_COMPUTE
}
template <class RowFn>
DI void mgemm_tile(const MG& g, int n0, RowFn rowfn, f32x16 (&acc)[2][2], unsigned char* lds, bool zero = true) { mgemm_tile_f(g, n0, rowfn, acc, lds, zero, 0, NoFlush{}, NoPre{}); }
#define MG_FOREACH(acc, LROW, FEAT, V, ...) do { const int _l = tidx() & 63, _w = tidx() >> 6, _wm = _w % G_WM, _wn = _w / G_WM; \
    _Pragma("unroll") for (int _ft = 0; _ft < 2; ++_ft) _Pragma("unroll") for (int _tt = 0; _tt < 2; ++_tt) _Pragma("unroll") for (int _i = 0; _i < 4; ++_i) { \
        const int LROW = _wm * 64 + _tt * 32 + (_l & 31); const int FEAT = _wn * 64 + _ft * 32 + 8 * _i + 4 * (_l >> 5); \
        float V[4] = {acc[_ft][_tt][4 * _i], acc[_ft][_tt][4 * _i + 1], acc[_ft][_tt][4 * _i + 2], acc[_ft][_tt][4 * _i + 3]}; __VA_ARGS__ } } while (0)

struct RowId { int m0; DI long operator()(int r) const { return m0 + r; } };

template <int OUTMODE>
DI void mgemm_job(const MG& g, int M, int N, void* out, long ldo, int bid, int nblk, unsigned char* lds) {
    const int tm = M / G_BM, tn = N / G_BN;
    for (int u = bid; u < tm * tn; u += nblk) {
        const int grp = u / (16 * tn), rem = u % (16 * tn);
        const int gm = (tm - grp * 16) < 16 ? (tm - grp * 16) : 16;
        const int mt = grp * 16 + rem % gm, nt = rem / gm;
        const int m0 = mt * G_BM, n0 = nt * G_BN;
        f32x16 acc[2][2];
        mgemm_tile(g, n0, RowId{m0}, acc, lds);
        MG_FOREACH(acc, lrow, feat, v, {
            const long o = (long)(m0 + lrow) * ldo + n0 + feat;
            if (OUTMODE == 1) *(float4*)((float*)out + o) = make_float4(v[0], v[1], v[2], v[3]);
            else {
                if (OUTMODE == 2 && n0 + feat >= O_MG) { v[0] = sigm(v[0]); v[1] = sigm(v[1]); v[2] = sigm(v[2]); v[3] = sigm(v[3]); }
                st4bf((bf16_t*)out + o, v[0], v[1], v[2], v[3]);
            } });
    }
}

namespace pg8 {
#define PG8_LAS __attribute__((address_space(3)))
typedef float f32x4 __attribute__((ext_vector_type(4)));
constexpr int BM = 256, BK = 64, HALF = 128, HTB = HALF * BK * 2  , STAGE_BYTES = 8 * HTB, NXCD = 8, WGM = 8;
__host__ __device__ __forceinline__ int lds_byte(int r, int c) { const int st = (r >> 4) * 2 + (c >> 5), rr = r & 15, cc = c & 31, ob = rr * 64 + cc * 2; return st * 1024 + (ob ^ (((ob >> 9) & 1) << 5)); }
__host__ __device__ __forceinline__ void stage_rc(int b, int& R, int& C) { const int st = b / 1024, sb = b % 1024, swz = sb ^ (((sb >> 9) & 1) << 5); R = (st >> 1) * 16 + swz / 64; C = (st & 1) * 32 + (swz % 64) / 2; }
__host__ __device__ __forceinline__ int perm32(int rho) { const int n = rho >> 4, i = rho & 15; return 8 * (i >> 2) + 4 * n + (i & 3); }
struct Unit { int pm, pn, e, gt, nv; };
struct Gemm { const bf16_t* A; const bf16_t* Bt; int M, N, K; const int* rowidx; };
struct StaticOrder {
    int nM, nN, nwg, G, c;
    __device__ void init(int M, int N, int G_, int c_) { nM = M / BM; nN = N / BM; nwg = nM * nN; G = G_; c = c_; }
    __device__ bool next(int i, Unit& u) const {
        const long L = (long)i * G + c; if (L >= nwg) return false;
        int wgid = (int)L; { const int q = nwg / NXCD, r = nwg % NXCD, xcd = wgid % NXCD, off = wgid / NXCD; wgid = (xcd < r ? xcd * (q + 1) : r * (q + 1) + (xcd - r) * q) + off; }
        const int nig = WGM * nN, gid = wgid / nig, fm = gid * WGM, gsz = (nM - fm) < WGM ? (nM - fm) : WGM;
        u.pm = fm + ((wgid % nig) % gsz); u.pn = (wgid % nig) / gsz; u.e = 0; u.gt = 0; u.nv = 0; return true;
    }
    __device__ __forceinline__ void a_ready(const Unit&) const {}
    __device__ __forceinline__ void done(const Unit&) const {}
};
struct ListOrder {
    Unit u0, u1, u2; int n;
    __device__ bool next(int i, Unit& u) const { if (i >= n) return false; u = (i == 0) ? u0 : ((i == 1) ? u1 : u2); return true; }
    __device__ __forceinline__ void a_ready(const Unit&) const {}
    __device__ __forceinline__ void done(const Unit&) const {}
};
template <class Epi, class Sched, bool ALIGN_EPI = false, bool SP2 = false, bool GATHER = false>
__device__ __forceinline__ void gemm_phase(PG8_LAS unsigned char* lds, const Gemm g, const Sched& S, const Epi& E) {
    const int tid = tidx(), wid = __builtin_amdgcn_readfirstlane(tid >> 6), lane = tid & 63, wr = wid >> 2, wc = wid & 3, fr = lane & 15, fq = lane >> 4;
    const int K = g.K, nt = K / BK;
    unsigned voffA[2], voffB[2];
#pragma unroll
    for (int i = 0; i < 2; ++i) { int R, C; stage_rc(tid * 16 + i * 8192, R, C); const int Rb = Epi::PERM ? ((R & ~31) + perm32(R & 31)) : R;
        voffA[i] = (unsigned)(R * K + C) * 2u; voffB[i] = (unsigned)(Rb * K + C) * 2u; }
    unsigned voffC[2][2] = {{0u, 0u}, {0u, 0u}}, voffN[2][2] = {{0u, 0u}, {0u, 0u}};
    auto gather_offs = [&](const Unit& uu, unsigned (&vo)[2][2]) {
#pragma unroll
        for (int hh = 0; hh < 2; ++hh)
#pragma unroll
            for (int i = 0; i < 2; ++i) { int R, C; stage_rc(tid * 16 + i * 8192, R, C); const int lr = hh * HALF + R; int a = g.rowidx[uu.gt * BM + lr]; a = lr < uu.nv ? (a >> 1) : 0; vo[hh][i] = (unsigned)(a * K + C) * 2u; }
    };
    const size_t kstep = (size_t)(BK * 2);
    const size_t hstep = (size_t)HALF * K * 2;
    const size_t tstep = 2 * hstep;
    const size_t estep = (size_t)g.N * K * 2;
    const unsigned ldsw = (unsigned)wid * 1024u;
    const int aoff = lds_byte(wr * 64 + fr, fq * 8), boff = lds_byte(wc * 32 + fr, fq * 8);
#define PG8_SA(b, h) (((b) * 2 + (h)) * HTB)
#define PG8_SB(b, h) ((4 + (b) * 2 + (h)) * HTB)
#define PG8_STAGE(bufoff, gbase, voff) do { _Pragma("unroll") for (int _i = 0; _i < 2; ++_i) \
        __builtin_amdgcn_global_load_lds((const unsigned*)((const char*)(gbase) + (voff)[_i]), (PG8_LAS unsigned*)(lds + (bufoff) + ldsw + _i * 8192), 16, 0, 0); } while (0)
#define PG8_STAGE_A(bufoff, HH, KT, NX, densebase) do { if constexpr (GATHER) { const char* _gb = (const char*)g.A + (size_t)(KT) * kstep; if (NX) PG8_STAGE(bufoff, _gb, voffN[HH]); else PG8_STAGE(bufoff, _gb, voffC[HH]); } else PG8_STAGE(bufoff, densebase, voffA); } while (0)
#define PG8_LDA(dst, b, h) do { _Pragma("unroll") for (int m = 0; m < 4; ++m) _Pragma("unroll") for (int k = 0; k < 2; ++k) dst[m][k] = *(const PG8_LAS bf16x8*)(lds + PG8_SA(b, h) + aoff + m * 2048 + k * 1024); } while (0)
#define PG8_LDB(dst, b, h) do { _Pragma("unroll") for (int n = 0; n < 2; ++n) _Pragma("unroll") for (int k = 0; k < 2; ++k) dst[n][k] = *(const PG8_LAS bf16x8*)(lds + PG8_SB(b, h) + boff + n * 2048 + k * 1024); } while (0)
#define PG8_MMA(ai, bj, At, Bt) do { __builtin_amdgcn_s_setprio(1); _Pragma("unroll") for (int m = 0; m < 4; ++m) _Pragma("unroll") for (int n = 0; n < 2; ++n) _Pragma("unroll") for (int k = 0; k < 2; ++k) \
        acc[ai][bj][m][n] = __builtin_amdgcn_mfma_f32_16x16x32_bf16(Bt[n][k], At[m][k], acc[ai][bj][m][n], 0, 0, 0); __builtin_amdgcn_s_setprio(0); } while (0)
#define PG8_WAIT_V(n) asm volatile("s_waitcnt vmcnt(" #n ")" ::: "memory")
#define PG8_WAIT_L(n) asm volatile("s_waitcnt lgkmcnt(" #n ")" ::: "memory")
#define PG8_BAR __builtin_amdgcn_s_barrier()
#define PG8_SCHED __builtin_amdgcn_sched_barrier(0)
    Unit cur, nxt; int ui = 0;
    if (!S.next(0, cur)) return;
    f32x4 acc[2][2][4][2];
#pragma unroll
    for (int a = 0; a < 2; ++a)
#pragma unroll
        for (int b = 0; b < 2; ++b)
#pragma unroll
            for (int m = 0; m < 4; ++m)
#pragma unroll
                for (int n = 0; n < 2; ++n) acc[a][b][m][n] = (f32x4){0.f, 0.f, 0.f, 0.f};
    bf16x8 At[4][2], B0[2][2], B1[2][2];
    const char* cA = (const char*)g.A + (size_t)cur.pm * tstep; const char* cB = (const char*)g.Bt + (size_t)cur.e * estep + (size_t)cur.pn * tstep;
    S.a_ready(cur);
    if constexpr (GATHER) gather_offs(cur, voffC);
    if constexpr (SP2) {
        PG8_STAGE(PG8_SB(0, 0), cB, voffB); PG8_STAGE(PG8_SB(0, 1), cB + hstep, voffB); PG8_STAGE_A(PG8_SA(0, 0), 0, 0, false, cA); PG8_STAGE_A(PG8_SA(0, 1), 1, 0, false, cA + hstep);
        if (wr == 1) PG8_BAR;
        PG8_WAIT_V(2); PG8_BAR;
        PG8_STAGE(PG8_SB(1, 0), cB + kstep, voffB); PG8_STAGE_A(PG8_SA(1, 0), 0, 1, false, cA + kstep); PG8_STAGE(PG8_SB(1, 1), cB + hstep + kstep, voffB);
        PG8_WAIT_V(6); PG8_BAR;
    } else {
        PG8_STAGE(PG8_SB(0, 0), cB, voffB); PG8_STAGE_A(PG8_SA(0, 0), 0, 0, false, cA); PG8_STAGE(PG8_SB(0, 1), cB + hstep, voffB); PG8_STAGE_A(PG8_SA(0, 1), 1, 0, false, cA + hstep);
        if (wr == 1) PG8_BAR;
        PG8_WAIT_V(4); PG8_BAR;
        PG8_STAGE(PG8_SB(1, 0), cB + kstep, voffB); PG8_STAGE_A(PG8_SA(1, 0), 0, 1, false, cA + kstep); PG8_STAGE(PG8_SB(1, 1), cB + hstep + kstep, voffB);
        PG8_WAIT_V(6); PG8_BAR;
    }
    for (;;) {
        const bool has_next = S.next(ui + 1, nxt);
        if constexpr (GATHER) { if (has_next) gather_offs(nxt, voffN); else {
#pragma unroll
            for (int hh = 0; hh < 2; ++hh) { voffN[hh][0] = voffC[hh][0]; voffN[hh][1] = voffC[hh][1]; } } }
        const char* nA = has_next ? (const char*)g.A + (size_t)nxt.pm * tstep : cA; const char* nB = has_next ? (const char*)g.Bt + (size_t)nxt.e * estep + (size_t)nxt.pn * tstep : cB;
        for (int t = 0; t < nt; t += 2) {
            const bool last = (t == nt - 2);
            const char* a1 = cA + (size_t)(t + 1) * kstep;
            const char* a2 = last ? nA : cA + (size_t)(t + 2) * kstep; const char* b2 = last ? nB : cB + (size_t)(t + 2) * kstep;
            const char* a3 = a2 + kstep; const char* b3 = b2 + kstep;
            if (last && has_next) S.a_ready(nxt);
            if constexpr (SP2) {
            PG8_LDB(B0, 0, 0); PG8_LDB(B1, 0, 1); PG8_SCHED; PG8_LDA(At, 0, 0); PG8_STAGE_A(PG8_SA(1, 1), 1, t + 1, false, a1 + hstep);
            PG8_WAIT_V(8); PG8_WAIT_L(0); PG8_BAR; PG8_MMA(0, 0, At, B0); PG8_MMA(0, 1, At, B1); PG8_BAR; PG8_SCHED;
            PG8_LDA(At, 0, 1); PG8_STAGE(PG8_SB(0, 0), b2, voffB); PG8_STAGE(PG8_SB(0, 1), b2 + hstep, voffB); PG8_STAGE_A(PG8_SA(0, 0), 0, (last ? 0 : t + 2), last, a2);
            PG8_WAIT_V(8); PG8_WAIT_L(0); PG8_BAR; PG8_MMA(1, 0, At, B0); PG8_MMA(1, 1, At, B1); PG8_BAR; PG8_SCHED;
            PG8_LDB(B0, 1, 0); PG8_LDB(B1, 1, 1); PG8_SCHED; PG8_LDA(At, 1, 0); PG8_STAGE_A(PG8_SA(0, 1), 1, (last ? 0 : t + 2), last, a2 + hstep);
            PG8_WAIT_V(8); PG8_WAIT_L(0); PG8_BAR; PG8_MMA(0, 0, At, B0); PG8_MMA(0, 1, At, B1); PG8_BAR; PG8_SCHED;
            PG8_LDA(At, 1, 1); PG8_STAGE(PG8_SB(1, 0), b3, voffB); PG8_STAGE(PG8_SB(1, 1), b3 + hstep, voffB); PG8_STAGE_A(PG8_SA(1, 0), 0, (last ? 1 : t + 3), last, a3);
            PG8_WAIT_V(8); PG8_WAIT_L(0); PG8_BAR; PG8_MMA(1, 0, At, B0); PG8_MMA(1, 1, At, B1); PG8_BAR; PG8_SCHED;
            } else {
            PG8_LDB(B0, 0, 0); PG8_SCHED; PG8_LDA(At, 0, 0); PG8_STAGE_A(PG8_SA(1, 1), 1, t + 1, false, a1 + hstep);
            PG8_WAIT_L(8); PG8_BAR; PG8_WAIT_L(0); PG8_MMA(0, 0, At, B0); PG8_BAR; PG8_SCHED;
            PG8_LDB(B1, 0, 1); PG8_STAGE(PG8_SB(0, 0), b2, voffB);
            PG8_BAR; PG8_WAIT_L(0); PG8_MMA(0, 1, At, B1); PG8_BAR;
            PG8_LDA(At, 0, 1); PG8_STAGE_A(PG8_SA(0, 0), 0, (last ? 0 : t + 2), last, a2);
            PG8_BAR; PG8_WAIT_L(0); PG8_MMA(1, 0, At, B0); PG8_BAR; PG8_SCHED;
            PG8_STAGE(PG8_SB(0, 1), b2 + hstep, voffB);
            PG8_WAIT_V(6); PG8_BAR; PG8_MMA(1, 1, At, B1); PG8_BAR;
            PG8_LDB(B0, 1, 0); PG8_SCHED; PG8_LDA(At, 1, 0); PG8_STAGE_A(PG8_SA(0, 1), 1, (last ? 0 : t + 2), last, a2 + hstep);
            PG8_WAIT_L(8); PG8_BAR; PG8_WAIT_L(0); PG8_MMA(0, 0, At, B0); PG8_BAR; PG8_SCHED;
            PG8_LDB(B1, 1, 1); PG8_STAGE(PG8_SB(1, 0), b3, voffB);
            PG8_BAR; PG8_WAIT_L(0); PG8_MMA(0, 1, At, B1); PG8_BAR;
            PG8_LDA(At, 1, 1); PG8_STAGE_A(PG8_SA(1, 0), 0, (last ? 1 : t + 3), last, a3);
            PG8_BAR; PG8_WAIT_L(0); PG8_MMA(1, 0, At, B0); PG8_BAR; PG8_SCHED;
            PG8_STAGE(PG8_SB(1, 1), b3 + hstep, voffB);
            PG8_WAIT_V(6); PG8_BAR; PG8_MMA(1, 1, At, B1); PG8_BAR;
            }
        }
        if constexpr (ALIGN_EPI) { if (wr == 0) PG8_BAR; }
        if constexpr (!Epi::AFTER_DRAIN) { E(acc, cur, wr, wc, fr, fq); S.done(cur); }
        if (!has_next) break;
#pragma unroll
        for (int a = 0; a < 2; ++a)
#pragma unroll
            for (int b = 0; b < 2; ++b)
#pragma unroll
                for (int m = 0; m < 4; ++m)
#pragma unroll
                    for (int n = 0; n < 2; ++n) acc[a][b][m][n] = (f32x4){0.f, 0.f, 0.f, 0.f};
        cur = nxt; cA = nA; cB = nB; ++ui;
        if constexpr (GATHER) {
#pragma unroll
            for (int hh = 0; hh < 2; ++hh) { voffC[hh][0] = voffN[hh][0]; voffC[hh][1] = voffN[hh][1]; } }
        if constexpr (ALIGN_EPI) { if (wr == 1) PG8_BAR; }
    }
    PG8_WAIT_V(0);
    if constexpr (!ALIGN_EPI) { if (wr == 0) PG8_BAR; }
    PG8_BAR;
    if constexpr (Epi::AFTER_DRAIN) { E.fused(acc, cur, wr, wc, fr, fq, lds, wid, lane); S.done(cur); }
#undef PG8_SA
#undef PG8_SB
#undef PG8_STAGE
#undef PG8_STAGE_A
#undef PG8_LDA
#undef PG8_LDB
#undef PG8_MMA
#undef PG8_WAIT_V
#undef PG8_WAIT_L
#undef PG8_BAR
#undef PG8_SCHED
}
}

struct EpiStoreBf16 {
    static constexpr bool PERM = true, AFTER_DRAIN = false;
    bf16_t* O; long ldo; int gate_from; long estride;
    __device__ __forceinline__ void operator()(const pg8::f32x4 (&acc)[2][2][4][2], const pg8::Unit& u, int wr, int wc, int fr, int fq) const {
        bf16_t* base = O + (long)u.e * estride;
#pragma unroll
        for (int ai = 0; ai < 2; ++ai)
#pragma unroll
            for (int m = 0; m < 4; ++m) {
                const long row = (long)u.pm * 256 + ai * 128 + wr * 64 + m * 16 + fr;
#pragma unroll
                for (int bj = 0; bj < 2; ++bj) {
                    pg8::f32x4 v0 = acc[ai][bj][m][0], v1 = acc[ai][bj][m][1];
                    if (u.pn * 2 + bj >= gate_from) {
#pragma unroll
                        for (int j = 0; j < 4; ++j) { v0[j] = sigm_fast(v0[j]); v1[j] = sigm_fast(v1[j]); }
                    }
                    u32x4 wv; wv[0] = pk_bf16(v0[0], v0[1]); wv[1] = pk_bf16(v0[2], v0[3]); wv[2] = pk_bf16(v1[0], v1[1]); wv[3] = pk_bf16(v1[2], v1[3]);
                    *(u32x4*)(base + row * ldo + u.pn * 256 + bj * 128 + wc * 32 + 8 * fq) = wv;
                }
            }
    }
};
struct EpiStoreF32 {
    static constexpr bool PERM = false, AFTER_DRAIN = false;
    float* O; long ldo;
    __device__ __forceinline__ void operator()(const pg8::f32x4 (&acc)[2][2][4][2], const pg8::Unit& u, int wr, int wc, int fr, int fq) const {
#pragma unroll
        for (int ai = 0; ai < 2; ++ai)
#pragma unroll
            for (int m = 0; m < 4; ++m) {
                const long row = (long)u.pm * 256 + ai * 128 + wr * 64 + m * 16 + fr;
#pragma unroll
                for (int bj = 0; bj < 2; ++bj)
#pragma unroll
                    for (int n = 0; n < 2; ++n) *(pg8::f32x4*)(O + row * ldo + u.pn * 256 + bj * 128 + wc * 32 + 16 * n + 4 * fq) = acc[ai][bj][m][n];
            }
    }
};
struct EpiMoeGU {
    static constexpr bool PERM = true, AFTER_DRAIN = false;
    bf16_t* HH;
    __device__ __forceinline__ void operator()(const pg8::f32x4 (&acc)[2][2][4][2], const pg8::Unit& u, int wr, int wc, int fr, int fq) const {
#pragma unroll
        for (int ai = 0; ai < 2; ++ai)
#pragma unroll
            for (int m = 0; m < 4; ++m) {
                const long row = (long)u.pm * 256 + ai * 128 + wr * 64 + m * 16 + fr;
                float hv[8];
#pragma unroll
                for (int n = 0; n < 2; ++n)
#pragma unroll
                    for (int j = 0; j < 4; ++j) { const float gt = acc[ai][0][m][n][j], up = acc[ai][1][m][n][j]; hv[4 * n + j] = gt * sigm_fast(gt) * up; }
                u32x4 wv; wv[0] = pk_bf16(hv[0], hv[1]); wv[1] = pk_bf16(hv[2], hv[3]); wv[2] = pk_bf16(hv[4], hv[5]); wv[3] = pk_bf16(hv[6], hv[7]);
                *(u32x4*)(HH + row * 512 + u.pn * 128 + wc * 32 + 8 * fq) = wv;
            }
    }
};
struct EpiMoeDown {
    static constexpr bool PERM = true, AFTER_DRAIN = false;
    const int* perm; const float* ew; bf16_t* YK;
    __device__ __forceinline__ void operator()(const pg8::f32x4 (&acc)[2][2][4][2], const pg8::Unit& u, int wr, int wc, int fr, int fq) const {
#pragma unroll
        for (int ai = 0; ai < 2; ++ai)
#pragma unroll
            for (int m = 0; m < 4; ++m) {
                const int a = perm[u.pm * 256 + ai * 128 + wr * 64 + m * 16 + fr];
                if (a >= 0) {
                    const float sw = ew[a];
#pragma unroll
                    for (int bj = 0; bj < 2; ++bj) {
                        const pg8::f32x4 v0 = acc[ai][bj][m][0] * sw, v1 = acc[ai][bj][m][1] * sw;
                        u32x4 wv; wv[0] = pk_bf16(v0[0], v0[1]); wv[1] = pk_bf16(v0[2], v0[3]); wv[2] = pk_bf16(v1[0], v1[1]); wv[3] = pk_bf16(v1[2], v1[3]);
                        *(u32x4*)(YK + (long)a * 1024 + u.pn * 256 + bj * 128 + wc * 32 + 8 * fq) = wv;
                    }
                }
            }
    }
};
struct GroupedOrder {
    int nM, nN, nE, G, c;
    __device__ bool next(int i, pg8::Unit& u) const { const int L = i * G + c; if (L >= nM * nN * nE) return false; u.e = L / (nM * nN); const int rm = L % (nM * nN); u.pm = rm / nN; u.pn = rm % nN; u.gt = 0; u.nv = 0; return true; }
    __device__ __forceinline__ void a_ready(const pg8::Unit&) const {}
    __device__ __forceinline__ void done(const pg8::Unit&) const {}
};

struct LayerW {
    const float *cmp_pos, *conv_w, *conv_b, *ga_b, *gx_b, *lam, *q_norm, *kv_norm,
        *ln1_g, *ln1_b, *ln2_g, *ln2_b, *rg_b, *re_b, *ln3_g, *ln3_b;
    const bf16_t *t_in, *t_br, *t_out, *t_q, *t_o, *t_gu, *t_dn, *t_c1, *t_c2, *t_uq, *t_ukv, *t_g, *t_rh, *t_rl;
};
#define WSF(off) ((float*)(p.ws + (off)))
#define WSI(off) ((int*)(p.ws + (off)))
#define WSU(off) ((unsigned*)(p.ws + (off)))
#define WSB(off) ((bf16_t*)(p.ws + (off)))
DI LayerW layer_w(const Params& p, int l) {
    LayerW w;
    w.cmp_pos = p.in[3] + (size_t)l * 2 * 32 * 64;
    w.conv_w = p.in[6] + (size_t)l * 4 * 256;
    w.conv_b = p.in[7] + (size_t)l * 256;
    w.ga_b = p.in[9] + (size_t)l * 256;
    w.gx_b = p.in[11] + (size_t)l * 256;
    w.lam = p.in[12] + (size_t)l * 256;
    w.q_norm = p.in[13] + (size_t)l * 192;
    w.kv_norm = p.in[14] + (size_t)l * 128;
    w.ln1_g = p.in[19] + (size_t)l * 1024; w.ln1_b = p.in[20] + (size_t)l * 1024;
    w.ln2_g = p.in[24] + (size_t)l * 1024; w.ln2_b = p.in[25] + (size_t)l * 1024;
    w.rg_b = p.in[27] + (size_t)l * 4;
    w.re_b = p.in[29] + (size_t)l * 32;
    w.ln3_g = p.in[32] + (size_t)l * 1024; w.ln3_b = p.in[33] + (size_t)l * 1024;
    w.t_in = WSB(WT_IN) + (size_t)l * NH * 1024;
    w.t_br = WSB(WT_BR) + (size_t)l * 1024 * 1024;
    w.t_out = WSB(WT_OUT) + (size_t)l * 1024 * 1024;
    w.t_q = WSB(WT_Q) + (size_t)l * 512 * 1024;
    w.t_o = WSB(WT_O) + (size_t)l * 1024 * 512;
    w.t_gu = WSB(WT_GU) + (size_t)l * 32 * 1024 * 1024;
    w.t_dn = WSB(WT_DN) + (size_t)l * 32 * 1024 * 512;
    w.t_c1 = WSB(WT_C1) + (size_t)l * 2 * 256 * 2048;
    w.t_c2 = WSB(WT_C2) + (size_t)l * 2 * 128 * 256;
    w.t_uq = WSB(WT_UQ) + (size_t)l * 384 * 192;
    w.t_ukv = WSB(WT_UKV) + (size_t)l * 512 * 128;
    w.t_g = WSB(WT_G) + (size_t)l * 4 * 128 * 64;
    w.t_rh = WSB(WT_RH) + (size_t)l * 128 * 1024;
    w.t_rl = WSB(WT_RL) + (size_t)l * 128 * 1024;
    return w;
}

template <int MODE>
DI int wt_col(int np, int Nsrc) {
    if (MODE == 0) return np < Nsrc ? np : -1;
    if (MODE == 2) return np < 1024 ? np : (np < 2656 ? np + 12 : (np < 2668 ? 1024 + (np - 2656) : (np < 2688 ? -1 : (np < 6784 ? np - 20 : -1))));
    const int pn = np >> 8, bj = (np >> 7) & 1, q = np & 127; return (bj ? 512 : 0) + 128 * pn + q;
}
template <int MODE>
DI void job_wt(const float* src, int nmat, int K, int Nsrc, bf16_t* dst, int Npad, int bid, int nblk, unsigned char* lds) {
    const int lane = tidx() & 63, wid = tidx() >> 6;
    bf16_t* tile = (bf16_t*)lds + wid * (64 * 72);
    const int tk = K / 64, tn = Npad / 64;
    const int tk2 = (tk + 1) / 2, tn4 = (tn + 3) / 4, per = tk2 * tn4;
    const int kl = lane >> 4, n4 = (lane & 15) * 4;
    for (int ub = bid; ub < nmat * per; ub += nblk) {
        const int mat = ub / per, ru = ub % per, kt = (ru % tk2) * 2 + (wid & 1), nt = (ru / tk2) * 4 + (wid >> 1);
        if (kt >= tk || nt >= tn) continue;
        const int k0 = kt * 64, n0 = nt * 64;
        const float* s = src + (size_t)mat * K * Nsrc;
        bf16_t* d = dst + (size_t)mat * Npad * K;
        const int col = wt_col<MODE>(n0 + n4, Nsrc);
        float4 v[16];
#pragma unroll
        for (int ps = 0; ps < 16; ++ps) v[ps] = col >= 0 ? *(const float4*)(s + (size_t)(k0 + kl + 4 * ps) * Nsrc + col) : make_float4(0.f, 0.f, 0.f, 0.f);
#pragma unroll
        for (int ps = 0; ps < 16; ++ps) { const int k = kl + 4 * ps;
            tile[(n4 + 0) * 72 + k] = f2bf(v[ps].x); tile[(n4 + 1) * 72 + k] = f2bf(v[ps].y); tile[(n4 + 2) * 72 + k] = f2bf(v[ps].z); tile[(n4 + 3) * 72 + k] = f2bf(v[ps].w); }
        __builtin_amdgcn_fence(__ATOMIC_RELEASE, "wavefront"); __builtin_amdgcn_wave_barrier(); __builtin_amdgcn_fence(__ATOMIC_ACQUIRE, "wavefront");
#pragma unroll
        for (int c8 = 0; c8 < 8; ++c8) { const int c = lane + 64 * c8, n2 = c >> 3, kc = (c & 7) * 8;
            *(uint4*)(d + (size_t)(n0 + n2) * K + k0 + kc) = *(const uint4*)(tile + n2 * 72 + kc); }
        __builtin_amdgcn_fence(__ATOMIC_RELEASE, "wavefront"); __builtin_amdgcn_wave_barrier(); __builtin_amdgcn_fence(__ATOMIC_ACQUIRE, "wavefront");
    }
}
DI void job_cvt(const float* src, bf16_t* dst, long n, int bid, int nblk) {
    for (long e = ((long)bid * NT + tidx()) * 4; e < n; e += (long)nblk * NT * 4) {
        const float4 v = *(const float4*)(src + e);
        st4bf(dst + e, v.x, v.y, v.z, v.w);
    }
}
DI void job_cmp_gather(const Params& p, const LayerW& w, int bid, int nblk) {
    const bf16_t* H = WSB(WS_H); bf16_t* TB = WSB(WS_TBB);
    const long total = (long)2 * NCR * 2048 / 8;
    for (long e = (long)bid * NT + tidx(); e < total; e += (long)nblk * NT) {
        const long e8 = e * 8;
        const int f = (int)(e8 % 2048); const long r2 = e8 / 2048; const int r = (int)(r2 % NCR), j = (int)(r2 / NCR);
        const int g = r & 1, bc = r >> 1, c = bc % NCMP, b = bc / NCMP, i = f >> 6, d = f & 63;
        float hv[8];
        ld8f(H + (long)(b * SEQ + 16 * c + i) * NH + (j ? O_AVC : O_AKC) + g * 64 + d, hv);
        const float4 p0 = *(const float4*)(w.cmp_pos + (j * 32 + i) * 64 + d), p1 = *(const float4*)(w.cmp_pos + (j * 32 + i) * 64 + d + 4);
        hv[0] += p0.x; hv[1] += p0.y; hv[2] += p0.z; hv[3] += p0.w; hv[4] += p1.x; hv[5] += p1.y; hv[6] += p1.z; hv[7] += p1.w;
        st8bf(TB + ((long)j * 2048 + r) * 2048 + f, hv);
    }
}
DI void job_rnn_conv(const Params& p, const LayerW& w, int bid, int nblk) {
    const bf16_t* H = WSB(WS_H); float* U = WSF(WS_U); bf16_t* UB = WSB(WS_UB);
    for (long e = (long)bid * NT + tidx(); e < (long)T * 64; e += (long)nblk * NT) {
        const int ch = (int)(e & 63) * 4; const int t = (int)(e >> 6), s = t & (SEQ - 1);
        const float4 cb = *(const float4*)(w.conv_b + ch);
        float u0 = cb.x, u1 = cb.y, u2 = cb.z, u3 = cb.w;
#pragma unroll
        for (int tap = 0; tap < 4; ++tap) { const int sp = s - 3 + tap;
            if (sp >= 0) { const float4 hv = ld4bf(H + (long)(t - 3 + tap) * NH + O_CX + ch); const float4 cw = *(const float4*)(w.conv_w + tap * 256 + ch);
                u0 += hv.x * cw.x; u1 += hv.y * cw.y; u2 += hv.z * cw.z; u3 += hv.w * cw.w; } }
        *(float4*)(U + (long)t * 256 + ch) = make_float4(u0, u1, u2, u3); st4bf(UB + (long)t * 256 + ch, u0, u1, u2, u3);
    }
}
DI void job_rnn_gates(const Params& p, const LayerW& w, int bid, int nblk, unsigned char* lds) {
    const float* U = WSF(WS_U); float* RA = WSF(WS_RA); float* RB = WSF(WS_RB);
    for (int u = bid; u < (T / G_BM) * 4; u += nblk) {
        const int blk = u & 3, m0 = (u >> 2) * G_BM;
        MG g; g.A = WSB(WS_UB) + blk * 64; g.lda = 256; g.Wt = w.t_g + (size_t)blk * 128 * 64; g.ldw = 64; g.K = 64;
        f32x16 acc[2][2];
        mgemm_tile(g, 0, RowId{m0}, acc, lds);
        const int l = tidx() & 63, wv = tidx() >> 6, wm = wv % G_WM, wn = wv / G_WM;
#pragma unroll
        for (int tt = 0; tt < 2; ++tt)
#pragma unroll
            for (int i = 0; i < 4; ++i) {
                const long t = m0 + wm * 64 + tt * 32 + (l & 31); const int ch = blk * 64 + wn * 32 + 8 * i + 4 * (l >> 5);
                const float4 uv = *(const float4*)(U + t * 256 + ch);
                const float ua[4] = {uv.x, uv.y, uv.z, uv.w};
                float av[4], bv[4];
#pragma unroll
                for (int j = 0; j < 4; ++j) {
                    const float r = sigm_fast(acc[0][tt][4 * i + j] + w.ga_b[ch + j]), ig = sigm_fast(acc[1][tt][4 * i + j] + w.gx_b[ch + j]);
                    const float nl = -w.lam[ch + j];
                    const float sp = fmaxf(nl, 0.f) + __logf(1.f + __expf(-fabsf(nl)));
                    const float log_a = -8.0f * r * sp;
                    const float a = __expf(log_a);
                    av[j] = a; bv[j] = __builtin_amdgcn_sqrtf(fmaxf(1.f - a * a, 0.f)) * (ig * ua[j]);
                }
                *(float4*)(RA + t * 256 + ch) = make_float4(av[0], av[1], av[2], av[3]);
                *(float4*)(RB + t * 256 + ch) = make_float4(bv[0], bv[1], bv[2], bv[3]);
            }
    }
}
DI void job_rnn_scan1(const Params& p, int bid, int nblk) {
    const float* RA = WSF(WS_RA); const float* RB = WSF(WS_RB); float* SA = WSF(WS_SA); float* SH = WSF(WS_SH);
    for (int e = bid * NT + tidx(); e < BATCH * 32 * 256; e += nblk * NT) {
        const int ch = e & 255, bc = e >> 8;
        float ap = 1.f, hl = 0.f;
        for (int s0 = 0; s0 < 64; s0 += 8) {
            float av[8], bv[8];
#pragma unroll
            for (int i = 0; i < 8; ++i) { const long t = (long)bc * 64 + s0 + i; av[i] = RA[t * 256 + ch]; bv[i] = RB[t * 256 + ch]; }
#pragma unroll
            for (int i = 0; i < 8; ++i) { ap *= av[i]; hl = av[i] * hl + bv[i]; }
        }
        SA[e] = ap; SH[e] = hl;
    }
}
DI void job_rnn_scan2(const Params& p, int bid, int nblk) {
    const bf16_t* H = WSB(WS_H); const float* RA = WSF(WS_RA); const float* RB = WSF(WS_RB); const float* SA = WSF(WS_SA); const float* SH = WSF(WS_SH); bf16_t* BR = WSB(WS_BR);
    for (int e = bid * NT + tidx(); e < BATCH * 32 * 256; e += nblk * NT) {
        const int ch = e & 255, bc = e >> 8, chunk = bc & 31, b = bc >> 5;
        float h = 0.f;
#pragma unroll
        for (int c0 = 0; c0 < 32; c0 += 8) {
            float sa[8], sh[8];
#pragma unroll
            for (int i = 0; i < 8; ++i) { const int q = ((b * 32 + c0 + i) << 8) + ch; sa[i] = SA[q]; sh[i] = SH[q]; }
#pragma unroll
            for (int i = 0; i < 8; ++i) h = (c0 + i < chunk) ? sa[i] * h + sh[i] : h;
        }
        for (int s0 = 0; s0 < 64; s0 += 8) {
            float av[8], bv[8], gv[8];
#pragma unroll
            for (int i = 0; i < 8; ++i) { const long t = (long)bc * 64 + s0 + i; av[i] = RA[t * 256 + ch]; bv[i] = RB[t * 256 + ch]; gv[i] = bf2f(H[t * NH + O_CG + ch]); }
#pragma unroll
            for (int i = 0; i < 8; ++i) { const long t = (long)bc * 64 + s0 + i; h = av[i] * h + bv[i]; BR[t * 1024 + 2 * 256 + ch] = f2bf(h * gelu_tanh(gv[i])); }
        }
    }
}
DI void job_mla_norm(const Params& p, const LayerW& w, int bid, int nblk) {
    const bf16_t* H = WSB(WS_H); bf16_t* CQN = WSB(WS_CQNB); bf16_t* CKVN = WSB(WS_CKVNB); bf16_t* KM = WSB(WS_KM);
    const int lane = tidx() & 63, wid = tidx() >> 6;
    const bool isq = lane < 24, iskv = lane >= 32 && lane < 48;
    const int coff = isq ? O_DCQ + lane * 8 : O_DCKV + (lane - 32) * 8;
    float gn[8];
#pragma unroll
    for (int j = 0; j < 8; ++j) gn[j] = isq ? w.q_norm[lane * 8 + j] : (iskv ? w.kv_norm[(lane - 32) * 8 + j] : 0.f);
    for (int t = bid * (NT / 64) + wid; t < T; t += nblk * (NT / 64)) {
        const bf16_t* hr = H + (long)t * NH;
        float v[8];
        float ss = 0.f;
        if (isq || iskv) { ld8f(hr + coff, v);
#pragma unroll
            for (int j = 0; j < 8; ++j) ss += v[j] * v[j]; }
        const float sq = wave_sum(isq ? ss : 0.f), skv = wave_sum(iskv ? ss : 0.f);
        const float rs = isq ? rsqrtf(sq * (1.f / 192.f) + 1e-6f) : rsqrtf(skv * (1.f / 128.f) + 1e-6f);
        if (isq || iskv) {
#pragma unroll
            for (int j = 0; j < 8; ++j) v[j] = v[j] * rs * gn[j];
            if (isq) st8bf(CQN + (long)t * 192 + lane * 8, v); else st8bf(CKVN + (long)t * 128 + (lane - 32) * 8, v);
        }
        {
            const int i = lane & 15, hd = lane >> 4;
            const int s = t & (SEQ - 1);
            const float2 csn = *(const float2*)(WSF(WS_ROPE) + (s * 16 + i) * 2); const float cs = csn.x, sn = csn.y;
            const float x1 = bf2f(hr[O_DKR + i]), x2 = bf2f(hr[O_DKR + 16 + i]);
            KM[(long)t * 384 + hd * 96 + 64 + i] = f2bf(x1 * cs - x2 * sn);
            KM[(long)t * 384 + hd * 96 + 80 + i] = f2bf(x1 * sn + x2 * cs);
        }
    }
}
DI void job_mla_up(const Params& p, const LayerW& w, int bid, int nblk, unsigned char* lds) {
    bf16_t* QB = WSB(WS_QB); bf16_t* KM = WSB(WS_KM); bf16_t* VM = WSB(WS_VM);
    constexpr int TM = T / G_BM;
    for (int u = bid; u < TM * 7; u += nblk) {
        const int mt = u / 7, nt = u % 7, m0 = mt * G_BM;
        f32x16 acc[2][2];
        const int l = tidx() & 63, wv = tidx() >> 6, wm = wv % G_WM, wn = wv / G_WM, hh = l >> 5;
        if (nt < 3) {
            MG g; g.A = WSB(WS_CQNB); g.lda = 192; g.Wt = w.t_uq; g.ldw = 192; g.K = 192;
            const int n0 = nt * 128;
            mgemm_tile(g, n0, RowId{m0}, acc, lds);
#pragma unroll
            for (int ft = 0; ft < 2; ++ft) {
                const int fb = (n0 + wn * 64 + ft * 32) >> 5;
                if (fb % 3 == 2) {
#pragma unroll
                    for (int tt = 0; tt < 2; ++tt) {
                        const int pos = (m0 + wm * 64 + tt * 32 + (l & 31)) & (SEQ - 1);
#pragma unroll
                        for (int i = 0; i < 2; ++i)
#pragma unroll
                            for (int j = 0; j < 4; ++j) {
                                const int fi = 8 * i + 4 * hh + j;
                                const float2 csn = *(const float2*)(WSF(WS_ROPE) + (pos * 16 + fi) * 2); const float cs = csn.x, sn = csn.y;
                                const float x1 = acc[ft][tt][4 * i + j], x2 = acc[ft][tt][4 * (i + 2) + j];
                                acc[ft][tt][4 * i + j] = x1 * cs - x2 * sn; acc[ft][tt][4 * (i + 2) + j] = x1 * sn + x2 * cs;
                            }
                    }
                }
            }
            MG_FOREACH(acc, lrow, feat, v, { st4bf(QB + (long)(m0 + lrow) * 384 + n0 + feat, v[0], v[1], v[2], v[3]); });
        } else {
            MG g; g.A = WSB(WS_CKVNB); g.lda = 128; g.Wt = w.t_ukv; g.ldw = 128; g.K = 128;
            const int n0 = (nt - 3) * 128;
            mgemm_tile(g, n0, RowId{m0}, acc, lds);
            MG_FOREACH(acc, lrow, feat, v, {
                const int hd = nt - 3;
                if (feat < 64) st4bf(KM + (long)(m0 + lrow) * 384 + hd * 96 + feat, v[0], v[1], v[2], v[3]);
                else st4bf(VM + (long)(m0 + lrow) * 256 + hd * 64 + (feat - 64), v[0], v[1], v[2], v[3]); });
        }
    }
}
template <int STAGE>
DI void job_cmp_mlp(const Params& p, const LayerW& w, int bid, int nblk, unsigned char* lds) {
    constexpr int TM = 2048 / G_BM, TN = STAGE == 0 ? 2 : 1;
    for (int u = bid; u < 2 * TM * TN; u += nblk) {
        const int j = u / (TM * TN), ru = u % (TM * TN), mt = ru / TN, nt = ru % TN, m0 = mt * G_BM, n0 = nt * 128;
        MG g;
        if (STAGE == 0) { g.A = WSB(WS_TBB) + (size_t)j * 2048 * 2048; g.lda = 2048; g.Wt = w.t_c1 + (size_t)j * 256 * 2048; g.ldw = 2048; g.K = 2048; }
        else { g.A = WSB(WS_HIDB) + (size_t)j * 2048 * 256; g.lda = 256; g.Wt = w.t_c2 + (size_t)j * 128 * 256; g.ldw = 256; g.K = 256; }
        f32x16 acc[2][2];
        mgemm_tile(g, n0, [&](int r) { const int rr = m0 + r; return (long)(rr < NCR ? rr : NCR - 1); }, acc, lds);
        if (STAGE == 0) {
            bf16_t* HID = WSB(WS_HIDB) + (size_t)j * 2048 * 256;
            MG_FOREACH(acc, lrow, feat, v, { st4bf(HID + (long)(m0 + lrow) * 256 + n0 + feat, gelu_tanh(v[0]), gelu_tanh(v[1]), gelu_tanh(v[2]), gelu_tanh(v[3])); });
        } else {
            bf16_t* KC = WSB(WS_KCB) + (size_t)j * NCR * 64;
            MG_FOREACH(acc, lrow, feat, v, { if (feat < 64 && m0 + lrow < NCR) st4bf(KC + (long)(m0 + lrow) * 64 + feat, v[0], v[1], v[2], v[3]); });
        }
    }
}
DI void job_router_logits(const Params& p, const LayerW& w, int bid, int nblk, unsigned char* lds) {
    float* LOG = WSF(WS_LOG);
    for (int u = bid; u < 3 * (T / G_BM); u += nblk) {
        const int pass = u / (T / G_BM), m0 = (u % (T / G_BM)) * G_BM;
        f32x16 acc[2][2];
        MG g; g.lda = 1024; g.ldw = 1024; g.K = 1024;
        g.A = pass == 1 ? WSB(WS_XBL) : WSB(WS_XBB); g.Wt = pass == 2 ? w.t_rl : w.t_rh;
        mgemm_tile(g, 0, RowId{m0}, acc, lds, true);
        float* dst = LOG + (size_t)pass * T * 36;
        MG_FOREACH(acc, lrow, feat, v, { if (feat < 36) *(float4*)(dst + (long)(m0 + lrow) * 36 + feat) = make_float4(v[0], v[1], v[2], v[3]); });
    }
}
DI void job_pack_small(const Params& p, int bid, int nblk) {
    bf16_t* TG = WSB(WT_G); bf16_t* RH = WSB(WT_RH); bf16_t* RL = WSB(WT_RL);
    for (int e = bid * NT + tidx(); e < SEQ * 16; e += nblk * NT) {
        const int i = e & 15, pos = e >> 4;
        const float inv = powf(10000.f, -(float)(2 * i) / 32.f);
        const float ang = (float)pos * inv;
        WSF(WS_ROPE)[e * 2] = cosf(ang); WSF(WS_ROPE)[e * 2 + 1] = sinf(ang);
    }
    for (int e = bid * NT + tidx(); e < DEPTH * 4 * 128 * 64; e += nblk * NT) {
        const int c = e & 63, q = (e >> 6) & 127, lb = e >> 13;
        const int seg = q >> 5, i = q & 31, chl = (seg >> 1) * 32 + i;
        const float* src = (seg & 1) ? p.in[10] : p.in[8];
        TG[e] = f2bf(src[((size_t)lb * 64 + c) * 64 + chl]);
    }
    for (int e = bid * NT + tidx(); e < DEPTH * 128 * 1024; e += nblk * NT) {
        const int k = e & 1023, n = (e >> 10) & 127, l = e >> 17;
        float v = 0.f;
        if (n < 4) v = p.in[26][((size_t)l * 1024 + k) * 4 + n];
        else if (n < 36) v = p.in[28][((size_t)l * 1024 + k) * 32 + (n - 4)];
        const bf16_t hi = f2bf(v);
        RH[e] = hi; RL[e] = f2bf(v - bf2f(hi));
    }
}

DI void job_merge(const Params& p, const LayerW& w, int bid, int nblk, unsigned char* lds) {
    const bf16_t* H = WSB(WS_H); bf16_t* M = WSB(WS_M);
    for (int u0 = bid; u0 < (T / G_BM) * 8; u0 += nblk) {
        int u = u0;
        if ((nblk & 7) == 0) { const int per = nblk >> 3, x = u0 & 7, q = u0 >> 3, ul = (q % per) + per * (q / per);
            u = ((x + 8 * (ul >> 3)) << 3) + (ul & 7); }
        const int m0 = (u >> 3) * G_BM, n0 = (u & 7) * G_BN;
        f32x16 macc[2][2];
#pragma unroll
        for (int a = 0; a < 2; ++a)
#pragma unroll
            for (int b = 0; b < 2; ++b)
#pragma unroll
                for (int i = 0; i < 16; ++i) macc[a][b][i] = 0.f;
        MG g; g.A = WSB(WS_BR); g.lda = 1024; g.Wt = w.t_br; g.ldw = 1024; g.K = 1024;
        f32x16 acc[2][2];
        uint2 gq[2][2][4];
        mgemm_tile_f(g, n0, RowId{m0}, acc, lds, true, 4, [&](int n, f32x16 (&a)[2][2]) {
#pragma unroll
            for (int ft = 0; ft < 2; ++ft)
#pragma unroll
                for (int tt = 0; tt < 2; ++tt)
#pragma unroll
                    for (int i = 0; i < 4; ++i) {
                        const uint2 q = gq[ft][tt][i];
                        macc[ft][tt][4 * i] += bflo(q.x) * a[ft][tt][4 * i]; macc[ft][tt][4 * i + 1] += bfhi(q.x) * a[ft][tt][4 * i + 1];
                        macc[ft][tt][4 * i + 2] += bflo(q.y) * a[ft][tt][4 * i + 2]; macc[ft][tt][4 * i + 3] += bfhi(q.y) * a[ft][tt][4 * i + 3];
                        a[ft][tt][4 * i] = 0.f; a[ft][tt][4 * i + 1] = 0.f; a[ft][tt][4 * i + 2] = 0.f; a[ft][tt][4 * i + 3] = 0.f;
                    }
        }, [&](int n) {
            const int l = tidx() & 63, wv = tidx() >> 6, wm = wv % G_WM, wn = wv / G_WM;
#pragma unroll
            for (int ft = 0; ft < 2; ++ft)
#pragma unroll
                for (int tt = 0; tt < 2; ++tt)
#pragma unroll
                    for (int i = 0; i < 4; ++i) {
                        const int lrow = wm * 64 + tt * 32 + (l & 31), feat = wn * 64 + ft * 32 + 8 * i + 4 * (l >> 5);
                        gq[ft][tt][i] = *(const uint2*)(H + (long)(m0 + lrow) * NH + O_MG + n * 1024 + n0 + feat);
                    }
        });
        MG_FOREACH(macc, lrow, feat, v, { st4bf(M + (long)(m0 + lrow) * 1024 + n0 + feat, v[0], v[1], v[2], v[3]); });
    }
}
DI int pad_rows(int c) { return (c + G_BM - 1) / G_BM * G_BM; }
DI void job_ln(const float* xin, const bf16_t* xinb, const bf16_t* xinl, const bf16_t* y, const int* eidx, const int* eslot, unsigned* cnt, const float* ew, const float* gw, const float* bw, float* out, bf16_t* outb, bf16_t* outl, int bid, int nblk, unsigned char* lds) {
    const int lane = tidx() & 63, wid = tidx() >> 6;
    int* s_base = (int*)lds;
    if (eidx) {
        __syncthreads();
        if (tidx() < 32) s_base[32 + tidx()] = pad_rows((int)__hip_atomic_load(&cnt[tidx()], __ATOMIC_RELAXED, __HIP_MEMORY_SCOPE_AGENT));
        __syncthreads();
        if (tidx() == 0) { int o = 0; for (int e = 0; e < 32; ++e) { s_base[e] = o; o += s_base[32 + e]; } }
        __syncthreads();
    }
    float gv[16], bv[16];
#pragma unroll
    for (int i = 0; i < 2; ++i)
#pragma unroll
        for (int j = 0; j < 8; j += 4) { const int c = i * 512 + lane * 8 + j; const float4 g4 = *(const float4*)(gw + c), b4 = *(const float4*)(bw + c);
            gv[i * 8 + j] = g4.x; gv[i * 8 + j + 1] = g4.y; gv[i * 8 + j + 2] = g4.z; gv[i * 8 + j + 3] = g4.w; bv[i * 8 + j] = b4.x; bv[i * 8 + j + 1] = b4.y; bv[i * 8 + j + 2] = b4.z; bv[i * 8 + j + 3] = b4.w; }
    for (int t = bid * (NT / 64) + wid; t < T; t += nblk * (NT / 64)) {
        float v[16];
        float s = 0.f;
        int r0 = 0, r1 = 0; float w0 = 0.f, w1 = 0.f;
        if (eidx) { r0 = s_base[eidx[t * 2]] + eslot[t * 2]; r1 = s_base[eidx[t * 2 + 1]] + eslot[t * 2 + 1]; w0 = ew[t * 2]; w1 = ew[t * 2 + 1]; }
#pragma unroll
        for (int i = 0; i < 2; ++i) {
            const int c = i * 512 + lane * 8;
            float xv[8], yv[8];
            if (xin) { const float4 a = *(const float4*)(xin + (long)t * 1024 + c), b = *(const float4*)(xin + (long)t * 1024 + c + 4);
                xv[0] = a.x; xv[1] = a.y; xv[2] = a.z; xv[3] = a.w; xv[4] = b.x; xv[5] = b.y; xv[6] = b.z; xv[7] = b.w; }
            else ld8f(xinb + (long)t * 1024 + c, xv);
            if (xinl) { float z[8]; ld8f(xinl + (long)t * 1024 + c, z);
#pragma unroll
                for (int j = 0; j < 8; ++j) xv[j] += z[j]; }
            if (!eidx) ld8f(y + (long)t * 1024 + c, yv);
            else { float z0[8], z1[8]; ld8f(y + (long)r0 * 1024 + c, z0); ld8f(y + (long)r1 * 1024 + c, z1);
#pragma unroll
                for (int j = 0; j < 8; ++j) yv[j] = w0 * z0[j] + w1 * z1[j]; }
#pragma unroll
            for (int j = 0; j < 8; ++j) { v[i * 8 + j] = DN_ALPHA * xv[j] + yv[j]; s += v[i * 8 + j]; }
        }
        float q = 0.f;
#pragma unroll
        for (int i = 0; i < 16; ++i) q += v[i] * v[i];
        wave_sum2(s, q);
        const float mu = s * (1.f / 1024.f);
        const float rstd = rsqrtf(fmaxf(q * (1.f / 1024.f) - mu * mu, 0.f) + 1e-5f);
#pragma unroll
        for (int i = 0; i < 2; ++i) {
            const int c = i * 512 + lane * 8;
            float o[8];
#pragma unroll
            for (int j = 0; j < 8; ++j) o[j] = (v[i * 8 + j] - mu) * rstd * gv[i * 8 + j] + bv[i * 8 + j];
            if (out) { *(float4*)(out + (long)t * 1024 + c) = make_float4(o[0], o[1], o[2], o[3]); *(float4*)(out + (long)t * 1024 + c + 4) = make_float4(o[4], o[5], o[6], o[7]); }
            if (outb) st8bf(outb + (long)t * 1024 + c, o);
            if (outl) { float lo[8];
#pragma unroll
                for (int j = 0; j < 8; ++j) lo[j] = o[j] - bf2f(f2bf(o[j]));
                st8bf(outl + (long)t * 1024 + c, lo); }
        }
    }
}
DI void job_router(const Params& p, const LayerW& w, int layer, int bid, int nblk) {
    const float* LOG = WSF(WS_LOG); int* EIDX = WSI(WS_EIDX); int* ESLOT = WSI(WS_ESLOT); float* EW = WSF(WS_EW);
    unsigned* cnt = WSU(WS_CTL) + CW_CNT + layer * 32;
    for (int t = bid * NT + tidx(); t < T; t += nblk * NT) {
        const float* lr = LOG + (long)t * 36; const float* lr1 = lr + (size_t)T * 36; const float* lr2 = lr1 + (size_t)T * 36;
#define LG(i) ((lr[i] + lr1[i]) + lr2[i])
        const float g0 = LG(0) + w.rg_b[0], g1 = LG(1) + w.rg_b[1], g2 = LG(2) + w.rg_b[2], g3 = LG(3) + w.rg_b[3];
        const float gm = fmaxf(fmaxf(g0, g1), fmaxf(g2, g3));
        const float e0 = expf(g0 - gm), e1 = expf(g1 - gm), e2 = expf(g2 - gm), e3 = expf(g3 - gm);
        const float gs = (e0 + e1) + (e2 + e3);
        const float p0 = e0 / gs, p1 = e1 / gs, p2 = e2 / gs, p3 = e3 / gs;
        int grp = 0; float pg = p0;
        if (p1 > pg) { pg = p1; grp = 1; }
        if (p2 > pg) { pg = p2; grp = 2; }
        if (p3 > pg) { pg = p3; grp = 3; }
        float el[8];
#pragma unroll
        for (int i = 0; i < 8; ++i) el[i] = LG(4 + grp * 8 + i) + w.re_b[grp * 8 + i];
#undef LG
        float em = el[0];
#pragma unroll
        for (int i = 1; i < 8; ++i) em = fmaxf(em, el[i]);
        float es = 0.f;
#pragma unroll
        for (int i = 0; i < 8; ++i) { el[i] = expf(el[i] - em); es += el[i]; }
#pragma unroll
        for (int i = 0; i < 8; ++i) el[i] = el[i] / es;
        float b0 = el[0]; int i0 = 0;
#pragma unroll
        for (int i = 1; i < 8; ++i) if (el[i] > b0) { b0 = el[i]; i0 = i; }
        float b1 = -1.f; int i1 = 0;
#pragma unroll
        for (int i = 0; i < 8; ++i) if (i != i0 && el[i] > b1) { b1 = el[i]; i1 = i; }
        const float den = b0 + b1;
        const int ex0 = grp * 8 + i0, ex1 = grp * 8 + i1;
        EIDX[t * 2] = ex0; EIDX[t * 2 + 1] = ex1;
        EW[t * 2] = pg * b0 / den; EW[t * 2 + 1] = pg * b1 / den;
        const int s0 = (int)atomicAdd(&cnt[ex0], 1u), s1 = (int)atomicAdd(&cnt[ex1], 1u);
        ESLOT[t * 2] = s0; ESLOT[t * 2 + 1] = s1;
        WSI(WS_PERM)[ex0 * PCAP + s0] = t * 2; WSI(WS_PERM)[ex1 * PCAP + s1] = t * 2 + 1;
    }
}
DI pg8::ListOrder moe_units(unsigned* cnt, int bid, int nblk, unsigned char* lds) {
    pg8::ListOrder S; S.n = 0; S.u0 = S.u1 = S.u2 = pg8::Unit{0, 0, 0, 0, 0};
    int* s_cnt = (int*)lds;
    __syncthreads();
    if (tidx() < 32) s_cnt[tidx()] = (int)__hip_atomic_load(&cnt[tidx()], __ATOMIC_RELAXED, __HIP_MEMORY_SCOPE_AGENT);
    __syncthreads();
    int rt = 0, ub = 0;
    for (int e = 0; e < 32; ++e) {
        const int ce = s_cnt[e];
        const int c = pad_rows(ce) >> 8, ue = c * 4;
#pragma unroll
        for (int k = 0; k < 3; ++k) {
            const int L = bid + k * nblk;
            if (L >= ub && L < ub + ue) { const int lu = L - ub, mt = lu >> 2; const int nv = ce - mt * 256 < 256 ? ce - mt * 256 : 256;
                const pg8::Unit u{rt + mt, lu & 3, e, e * (PCAP / 256) + mt, nv};
                if (k == 0) S.u0 = u; else if (k == 1) S.u1 = u; else S.u2 = u;
                S.n = k + 1; }
        }
        rt += c; ub += ue;
    }
#define RFL(x) x = __builtin_amdgcn_readfirstlane(x)
    RFL(S.n); RFL(S.u0.pm); RFL(S.u0.pn); RFL(S.u0.e); RFL(S.u0.gt); RFL(S.u0.nv); RFL(S.u1.pm); RFL(S.u1.pn); RFL(S.u1.e); RFL(S.u1.gt); RFL(S.u1.nv);
    RFL(S.u2.pm); RFL(S.u2.pn); RFL(S.u2.e); RFL(S.u2.gt); RFL(S.u2.nv);
#undef RFL
    return S;
}

typedef short s16x4 __attribute__((ext_vector_type(4)));
typedef short v4i16_t __attribute__((ext_vector_type(4)));
DI unsigned cvtpk(float lo, float hi) { return pk_bf16(lo, hi); }
DI int crow(int reg, int h) { return (reg & 3) + 8 * (reg >> 2) + 4 * h; }
DI s16x4 tr_read(const unsigned char* p) { return __builtin_bit_cast(s16x4, __builtin_amdgcn_ds_read_tr16_b64_v4i16((LAS v4i16_t*)p)); }
DI float xhalf_max(float m) { auto rr = __builtin_amdgcn_permlane32_swap(__float_as_uint(m), __float_as_uint(m), false, false); return fmaxf(__uint_as_float(rr[0]), __uint_as_float(rr[1])); }
DI float xhalf_sum(float m) { auto rr = __builtin_amdgcn_permlane32_swap(__float_as_uint(m), __float_as_uint(m), false, false); return __uint_as_float(rr[0]) + __uint_as_float(rr[1]); }
DI float xhalf_other(float v, int h) { auto rr = __builtin_amdgcn_permlane32_swap(__float_as_uint(v), __float_as_uint(v), false, false); return __uint_as_float(h ? rr[0] : rr[1]); }
DI bf16x8 pack8(const f32x16& x, int s2) {
    u32x4 pk; pk[0] = cvtpk(x[8 * s2], x[8 * s2 + 1]); pk[1] = cvtpk(x[8 * s2 + 2], x[8 * s2 + 3]); pk[2] = cvtpk(x[8 * s2 + 4], x[8 * s2 + 5]); pk[3] = cvtpk(x[8 * s2 + 6], x[8 * s2 + 7]);
    return __builtin_bit_cast(bf16x8, pk);
}
constexpr int ATT_QB = (NT / 64) * 32;
template <int DC> struct TileCfg { static constexpr int RS = DC * 2 + 16, BYTES = 64 * RS, NCH = 64 * DC / 8, NI = (NCH + NT - 1) / NT; };
template <int DC, class RowPtr> DI void tile_gload(u32x4 (&rg)[TileCfg<DC>::NI], RowPtr rp) {
#pragma unroll
    for (int i = 0; i < TileCfg<DC>::NI; ++i) { const int c = tidx() + NT * i; if (c < TileCfg<DC>::NCH) { const int row = c / (DC / 8), cc = c % (DC / 8); rg[i] = *(const u32x4*)(rp(row) + cc * 8); } }
}
template <int DC> DI void tile_lstore(const u32x4 (&rg)[TileCfg<DC>::NI], unsigned char* base) {
#pragma unroll
    for (int i = 0; i < TileCfg<DC>::NI; ++i) { const int c = tidx() + NT * i; if (c < TileCfg<DC>::NCH) { const int row = c / (DC / 8), cc = c % (DC / 8); *(u32x4*)(base + row * TileCfg<DC>::RS + cc * 16) = rg[i]; } }
}
template <int DK> DI void qk_tile(f32x16 (&s)[2], const bf16x8 (&qf)[DK / 16], const unsigned char* kl, int r, int h) {
    constexpr int RS = TileCfg<DK>::RS;
#pragma unroll
    for (int i = 0; i < 16; ++i) { s[0][i] = 0.f; s[1][i] = 0.f; }
#pragma unroll
    for (int ks = 0; ks < DK / 16; ++ks) {
        const bf16x8 k0 = *(const bf16x8*)(kl + r * RS + ks * 32 + h * 16), k1 = *(const bf16x8*)(kl + (32 + r) * RS + ks * 32 + h * 16);
        s[0] = __builtin_amdgcn_mfma_f32_32x32x16_bf16(k0, qf[ks], s[0], 0, 0, 0);
        s[1] = __builtin_amdgcn_mfma_f32_32x32x16_bf16(k1, qf[ks], s[1], 0, 0, 0);
    }
}
template <int DV> DI void pv_tile(f32x16 (&o)[DV / 32], const f32x16 (&pp)[2], const unsigned char* vl, int lane) {
    constexpr int RS = TileCfg<DV>::RS;
    const int h = lane >> 5, i16 = lane & 15, q = i16 >> 2, pq = i16 & 3, blk = (lane >> 4) & 1;
    const unsigned char* vb = vl + (4 * h + q) * RS + 2 * (16 * blk + 4 * pq);
#pragma unroll
    for (int kt = 0; kt < 2; ++kt)
#pragma unroll
        for (int s2 = 0; s2 < 2; ++s2) {
            const bf16x8 pf = pack8(pp[kt], s2);
#pragma unroll
            for (int dvt = 0; dvt < DV / 32; ++dvt) {
                const s16x4 lo = tr_read(vb + (kt * 32 + 16 * s2) * RS + dvt * 64), hi = tr_read(vb + (kt * 32 + 16 * s2 + 8) * RS + dvt * 64);
                const bf16x8 vf = __builtin_shufflevector(lo, hi, 0, 1, 2, 3, 4, 5, 6, 7);
                o[dvt] = __builtin_amdgcn_mfma_f32_32x32x16_bf16(vf, pf, o[dvt], 0, 0, 0);
            }
        }
}
constexpr float LOG2E = 1.4426950408889634f;
template <int DK, int DV, bool ALIBI, bool BOUNDARY, class ValidFn>
DI void softmax_tile(const bf16x8 (&qf)[DK / 16], f32x16 (&o)[DV / 32], float& m, float& l, const unsigned char* kl, const unsigned char* vl, int kb,
                     float c1, float sl2, int qpos, ValidFn valid, int lane) {
    const int r = lane & 31, h = lane >> 5;
    f32x16 s[2];
    qk_tile<DK>(s, qf, kl, r, h);
    const float base = ALIBI ? sl2 * (float)(kb + 4 * h - qpos) : 0.f;
    float tmax = -INFINITY;
#pragma unroll
    for (int kt = 0; kt < 2; ++kt)
#pragma unroll
        for (int i = 0; i < 16; ++i) {
            float v = ALIBI ? fmaf(s[kt][i], c1, fmaf(sl2, (float)(kt * 32 + (i & 3) + 8 * (i >> 2)), base)) : s[kt][i] * c1;
            if (BOUNDARY) v = valid(kb + kt * 32 + crow(i, h)) ? v : -INFINITY;
            s[kt][i] = v; tmax = fmaxf(tmax, v);
        }
    tmax = xhalf_max(tmax);
    const float mn = fmaxf(m, tmax);
    if (__any(mn > m)) {
        const float corr = __builtin_amdgcn_exp2f(m - mn);
        l *= corr;
#pragma unroll
        for (int dvt = 0; dvt < DV / 32; ++dvt)
#pragma unroll
            for (int i = 0; i < 16; ++i) o[dvt][i] *= corr;
        m = mn;
    }
    float ps = 0.f;
#pragma unroll
    for (int kt = 0; kt < 2; ++kt)
#pragma unroll
        for (int i = 0; i < 16; ++i) { const float pr = __builtin_amdgcn_exp2f(s[kt][i] - mn); s[kt][i] = pr; ps += pr; }
    l += ps;
    pv_tile<DV>(o, s, vl, lane);
}
template <int DK, int DV, bool ALIBI, class KPtr, class VPtr, class ValidFn, class InteriorFn>
DI void attn_stream(const bf16x8 (&qf)[DK / 16], f32x16 (&o)[DV / 32], float& m, float& l, unsigned tmask, int wave_qmax, int wave_kmin,
                    KPtr kp, VPtr vp, float c1, float sl2, int qpos, ValidFn valid, InteriorFn interior, unsigned char* lds) {
    unsigned char* kl = lds; unsigned char* vl = lds + TileCfg<DK>::BYTES;
    const int lane = tidx() & 63;
    u32x4 kA[TileCfg<DK>::NI], vA[TileCfg<DV>::NI], kB[TileCfg<DK>::NI], vB[TileCfg<DV>::NI];
    int ja = -1, jb = -1;
#define AS_NEXT(J, KR, VR) do { if (tmask) { J = __builtin_ctz(tmask); tmask &= tmask - 1; const int _j = J; \
        tile_gload<DK>(KR, [&](int row) { return kp(_j * 64 + row); }); tile_gload<DV>(VR, [&](int row) { return vp(_j * 64 + row); }); } else J = -1; } while (0)
#define AS_COMPUTE(J) do { const int _jc = (J); if (_jc * 64 <= wave_qmax && _jc * 64 + 63 >= wave_kmin) { \
        if (interior(_jc)) softmax_tile<DK, DV, ALIBI, false>(qf, o, m, l, kl, vl, _jc * 64, c1, sl2, qpos, valid, lane); \
        else softmax_tile<DK, DV, ALIBI, true>(qf, o, m, l, kl, vl, _jc * 64, c1, sl2, qpos, valid, lane); } } while (0)
    AS_NEXT(ja, kA, vA);
    AS_NEXT(jb, kB, vB);
    while (ja >= 0) {
        __syncthreads();
        tile_lstore<DK>(kA, kl); tile_lstore<DV>(vA, vl);
        __syncthreads();
        const int jc = ja;
        AS_NEXT(ja, kA, vA);
        AS_COMPUTE(jc);
        if (jb < 0) break;
        __syncthreads();
        tile_lstore<DK>(kB, kl); tile_lstore<DV>(vB, vl);
        __syncthreads();
        const int jd = jb;
        AS_NEXT(jb, kB, vB);
        AS_COMPUTE(jd);
    }
#undef AS_NEXT
#undef AS_COMPUTE
}

DI void job_mla_attn(const Params& p, int bid, int nblk, unsigned char* lds) {
    const bf16_t* QB = WSB(WS_QB); const bf16_t* KM = WSB(WS_KM); const bf16_t* VM = WSB(WS_VM); bf16_t* BR = WSB(WS_BR);
    constexpr int NQB = SEQ / ATT_QB, NU = BATCH * 4 * NQB;
    const int lane = tidx() & 63, wid = tidx() >> 6, r = lane & 31, h = lane >> 5;
    for (int u = bid; u < NU; u += nblk) {
        const int qblk = u / (BATCH * 4), bh = u % (BATCH * 4);
        const int b = bh >> 2, hd = bh & 3;
        const int q0 = qblk * ATT_QB, qw = q0 + wid * 32, qpos = qw + r;
        const long trow = (long)b * SEQ;
        bf16x8 qf[6];
#pragma unroll
        for (int ks = 0; ks < 6; ++ks) qf[ks] = *(const bf16x8*)(QB + (trow + qpos) * 384 + hd * 96 + ks * 16 + 8 * h);
        f32x16 o[2];
#pragma unroll
        for (int i = 0; i < 16; ++i) { o[0][i] = 0.f; o[1][i] = 0.f; }
        float m = -1e30f, l = 0.f;
        const int ntile = (q0 + ATT_QB - 1) / 64 + 1;
        const unsigned tmask = ntile >= 32 ? 0xffffffffu : ((1u << ntile) - 1u);
        attn_stream<96, 64, false>(qf, o, m, l, tmask, qw + 31, 0,
            [&](int row) { return KM + (trow + row) * 384 + hd * 96; },
            [&](int row) { return VM + (trow + row) * 256 + hd * 64; },
            0.10206207261596577f * LOG2E, 0.f, qpos,
            [&](int key) { return key <= qpos; }, [&](int j) { return j * 64 + 63 <= qw; }, lds);
        const float rl = 1.f / fmaxf(xhalf_sum(l), 1e-30f);
        bf16_t* dst = BR + (trow + qpos) * 1024 + 3 * 256 + hd * 64;
#pragma unroll
        for (int dvt = 0; dvt < 2; ++dvt)
#pragma unroll
            for (int i = 0; i < 4; ++i)
                st4bf(dst + dvt * 32 + 8 * i + 4 * h, o[dvt][4 * i] * rl, o[dvt][4 * i + 1] * rl, o[dvt][4 * i + 2] * rl, o[dvt][4 * i + 3] * rl);
    }
}
DI void job_cross_attn(const Params& p, int layer, int bid, int nblk, unsigned char* lds) {
    const bf16_t* XQ = WSB(WS_XQ); const bf16_t* KVM = WSB(WS_KVM) + (size_t)layer * 2048 * 1024; bf16_t* XO = WSB(WS_XO);
    constexpr int NQB = SEQ / ATT_QB, NU = BATCH * 4 * NQB;
    const int lane = tidx() & 63, wid = tidx() >> 6, r = lane & 31, h = lane >> 5;
    for (int u = bid; u < NU; u += nblk) {
        const int bh = u % (BATCH * 4), qblk = u / (BATCH * 4);
        const int b = bh >> 2, hd = bh & 3;
        const int qpos = qblk * ATT_QB + wid * 32 + r;
        const long trow = (long)b * SEQ;
        bf16x8 qf[8];
#pragma unroll
        for (int ks = 0; ks < 8; ++ks) qf[ks] = *(const bf16x8*)(XQ + (trow + qpos) * 512 + hd * 128 + ks * 16 + 8 * h);
        f32x16 o[4];
#pragma unroll
        for (int d = 0; d < 4; ++d)
#pragma unroll
            for (int i = 0; i < 16; ++i) o[d][i] = 0.f;
        float m = -1e30f, l = 0.f;
        attn_stream<128, 128, false>(qf, o, m, l, 0xFu, 1 << 30, 0,
            [&](int row) { return KVM + (long)(b * MEM_LEN + row) * 1024 + hd * 128; },
            [&](int row) { return KVM + (long)(b * MEM_LEN + row) * 1024 + 512 + hd * 128; },
            0.08838834764831845f * LOG2E, 0.f, qpos, [&](int) { return true; }, [&](int) { return true; }, lds);
        const float rl = 1.f / fmaxf(xhalf_sum(l), 1e-30f);
        bf16_t* dst = XO + (trow + qpos) * 512 + hd * 128;
#pragma unroll
        for (int dvt = 0; dvt < 4; ++dvt)
#pragma unroll
            for (int i = 0; i < 4; ++i)
                st4bf(dst + dvt * 32 + 8 * i + 4 * h, o[dvt][4 * i] * rl, o[dvt][4 * i + 1] * rl, o[dvt][4 * i + 2] * rl, o[dvt][4 * i + 3] * rl);
    }
}
DI float logsig_fast(float z) { return fminf(z, 0.f) - __logf(1.f + __expf(-fabsf(z))); }
DI void job_sb_attn(const Params& p, int bid, int nblk, unsigned char* lds) {
    const bf16_t* H = WSB(WS_H); bf16_t* BR = WSB(WS_BR);
    constexpr int NQB = SEQ / ATT_QB, NU = BATCH * 4 * NQB;
    const int lane = tidx() & 63, wid = tidx() >> 6, r = lane & 31, h = lane >> 5;
    unsigned char* kl = lds; unsigned char* vl = lds + TileCfg<64>::BYTES;
    for (int u = bid; u < NU; u += nblk) {
        const int half = u / (NU / 2), ru = u % (NU / 2);
        const int qi = ru / (BATCH * 4), bh = ru % (BATCH * 4);
        const int qblk = half == 0 ? (NQB - 1 - qi) : qi;
        const int b = bh >> 2, hd = bh & 3;
        const int q0 = qblk * ATT_QB, qw = q0 + wid * 32, qpos = qw + r;
        const long trow = (long)b * SEQ;
        bf16x8 qf[4];
#pragma unroll
        for (int ks = 0; ks < 4; ++ks) qf[ks] = *(const bf16x8*)(H + (trow + qpos) * NH + O_BQ + hd * 64 + ks * 16 + 8 * h);
        f32x16 o[2];
#pragma unroll
        for (int i = 0; i < 16; ++i) { o[0][i] = 0.f; o[1][i] = 0.f; }
        float trun = 0.f;
        int j = (q0 + ATT_QB - 1) >> 6;
        volatile int* flag = (volatile int*)(lds + 2 * TileCfg<64>::BYTES);
        if (tidx() == 0) { flag[0] = 0; flag[1] = 0; }
        u32x4 kr[TileCfg<64>::NI], vr[TileCfg<64>::NI];
        tile_gload<64>(kr, [&](int row) { return H + (trow + j * 64 + row) * NH + O_BK + hd * 64; });
        tile_gload<64>(vr, [&](int row) { return H + (trow + j * 64 + row) * NH + O_BV + hd * 64; });
        for (int it = 0; j >= 0; --j, ++it) {
            __syncthreads();
            if (it > 0 && flag[(it - 1) & 1] == 0) break;
            tile_lstore<64>(kr, kl); tile_lstore<64>(vr, vl);
            __syncthreads();
            if (tidx() == 0) flag[(it + 1) & 1] = 0;
            if (j > 0) { const int jn = j - 1;
                tile_gload<64>(kr, [&](int row) { return H + (trow + jn * 64 + row) * NH + O_BK + hd * 64; });
                tile_gload<64>(vr, [&](int row) { return H + (trow + jn * 64 + row) * NH + O_BV + hd * 64; }); }
            const bool wave_dead = __all(trun < -110.f);
            if (j * 64 < qw + 31 && !wave_dead) {
                const int kb = j * 64;
                f32x16 s[2], L[2];
                qk_tile<64>(s, qf, kl, r, h);
#pragma unroll
                for (int kt = 0; kt < 2; ++kt)
#pragma unroll
                    for (int i = 0; i < 16; ++i) {
                        const int key = kb + kt * 32 + crow(i, h);
                        const float z = s[kt][i] * 0.125f, lsp = logsig_fast(z);
                        const bool valid = key < qpos;
                        L[kt][i] = valid ? lsp - z : 0.f;
                        s[kt][i] = valid ? lsp : -INFINITY;
                    }
                float G[2][4], O[2][4];
#pragma unroll
                for (int kt = 0; kt < 2; ++kt)
#pragma unroll
                    for (int ig = 0; ig < 4; ++ig) { G[kt][ig] = (L[kt][4 * ig] + L[kt][4 * ig + 1]) + (L[kt][4 * ig + 2] + L[kt][4 * ig + 3]); O[kt][ig] = xhalf_other(G[kt][ig], h); }
                float run = trun;
#pragma unroll
                for (int kt = 1; kt >= 0; --kt)
#pragma unroll
                    for (int ig = 3; ig >= 0; --ig) {
                        const float t3 = run + (h == 0 ? O[kt][ig] : 0.f);
                        const float t2 = t3 + L[kt][4 * ig + 3], t1 = t2 + L[kt][4 * ig + 2], t0 = t1 + L[kt][4 * ig + 1];
                        s[kt][4 * ig + 3] = __expf(s[kt][4 * ig + 3] + t3); s[kt][4 * ig + 2] = __expf(s[kt][4 * ig + 2] + t2);
                        s[kt][4 * ig + 1] = __expf(s[kt][4 * ig + 1] + t1); s[kt][4 * ig + 0] = __expf(s[kt][4 * ig + 0] + t0);
                        run += G[kt][ig] + O[kt][ig];
                    }
                trun = run;
                pv_tile<64>(o, s, vl, lane);
            }
            if (!__all(trun < -110.f)) flag[it & 1] = 1;
        }
        bf16_t* dst = BR + (trow + qpos) * 1024 + 1 * 256 + hd * 64;
#pragma unroll
        for (int dvt = 0; dvt < 2; ++dvt)
#pragma unroll
            for (int i = 0; i < 4; ++i) st4bf(dst + dvt * 32 + 8 * i + 4 * h, o[dvt][4 * i], o[dvt][4 * i + 1], o[dvt][4 * i + 2], o[dvt][4 * i + 3]);
    }
}
constexpr int NSA_QB = (NT / 128) * 32;
DI void job_nsa(const Params& p, int bid, int nblk, unsigned char* lds) {
    const bf16_t* H = WSB(WS_H); const bf16_t* KCB = WSB(WS_KCB); const bf16_t* VCB = KCB + (size_t)NCR * 64;
    float* OACC = WSF(WS_OC); bf16_t* BR = WSB(WS_BR);
    constexpr int NQB = SEQ / NSA_QB, NU = BATCH * 2 * NQB;
    constexpr int TB_ = TileCfg<64>::BYTES;
    const int lane = tidx() & 63, wid = tidx() >> 6, r = lane & 31, h = lane >> 5;
    const int n = wid & 1, sub = wid >> 1;
    unsigned* orw = (unsigned*)(lds + 4 * TB_);
    float* impx = (float*)(lds + 4 * TB_ + 64);
    for (int u = bid; u < NU; u += nblk) {
        const int qblk = NQB - 1 - u / (BATCH * 2), bg = u % (BATCH * 2), b = bg >> 1, g = bg & 1;
        const int q0 = qblk * NSA_QB, qw = q0 + sub * 32, qpos = qw + r;
        const int head = g * 2 + n;
        const long trow = (long)b * SEQ;
        const bf16_t* hq_row = H + (trow + qpos) * NH;
        bf16x8 qf[1][4];
#pragma unroll
        for (int ks = 0; ks < 4; ++ks) qf[0][ks] = *(const bf16x8*)(hq_row + O_AQ + head * 64 + ks * 16 + 8 * h);
        const float sl = exp2f(-2.f * (float)(head + 1));
        const float gate0 = sigm(bf2f(hq_row[O_AG + head * 3 + 0])), gate1 = sigm(bf2f(hq_row[O_AG + head * 3 + 1])), gate2 = sigm(bf2f(hq_row[O_AG + head * 3 + 2]));
        float* oacc = OACC + (trow + qpos) * 256 + head * 64;
        __syncthreads();
        if (tidx() == 0) *orw = 0u;
        {
            u32x4 rg[TileCfg<64>::NI];
#pragma unroll
            for (int tl = 0; tl < 4; ++tl) {
                const bf16_t* src = (tl & 2) ? VCB : KCB; const int cb = (tl & 1) * 64;
                tile_gload<64>(rg, [&](int row) { const int c = cb + row < NCMP ? cb + row : NCMP - 1; return src + ((long)(b * NCMP + c) * 2 + g) * 64; });
                tile_lstore<64>(rg, lds + tl * TB_);
            }
        }
        __syncthreads();
        float imp[16];
        {
            f32x16 s[2][2];
            qk_tile<64>(s[0], qf[0], lds, r, h);
            qk_tile<64>(s[1], qf[0], lds + TB_, r, h);
            float tmax = -INFINITY;
#pragma unroll
            for (int tl = 0; tl < 2; ++tl)
#pragma unroll
                for (int kt = 0; kt < 2; ++kt)
#pragma unroll
                    for (int i = 0; i < 16; ++i) {
                        const int c = tl * 64 + kt * 32 + crow(i, h), dist = qpos - (16 * c + 31);
                        const float v = (c < NCMP && dist >= 0) ? s[tl][kt][i] * 0.125f - sl * (float)dist : -INFINITY;
                        s[tl][kt][i] = v; tmax = fmaxf(tmax, v);
                    }
            const float mn = fmaxf(xhalf_max(tmax), -1e30f);
            float ps = 0.f;
#pragma unroll
            for (int tl = 0; tl < 2; ++tl)
#pragma unroll
                for (int kt = 0; kt < 2; ++kt)
#pragma unroll
                    for (int i = 0; i < 16; ++i) { const float pr = __expf(s[tl][kt][i] - mn); s[tl][kt][i] = pr; ps += pr; }
            const float rl = 1.f / fmaxf(xhalf_sum(ps), 1e-30f);
            float P3[16];
#pragma unroll
            for (int tl = 0; tl < 2; ++tl)
#pragma unroll
                for (int kt = 0; kt < 2; ++kt) {
#pragma unroll
                    for (int ig = 0; ig < 4; ++ig) {
                        const float p0 = s[tl][kt][4 * ig] * rl, p1 = s[tl][kt][4 * ig + 1] * rl, p2 = s[tl][kt][4 * ig + 2] * rl, p3 = s[tl][kt][4 * ig + 3] * rl;
                        imp[tl * 8 + kt * 4 + ig] = (p0 + p1) + (p2 + 0.5f * p3);
                        P3[tl * 8 + kt * 4 + ig] = 0.5f * p3;
                    }
                    const float gs = rl * gate0;
#pragma unroll
                    for (int i = 0; i < 16; ++i) s[tl][kt][i] *= gs;
                }
#pragma unroll
            for (int idx = 0; idx < 16; ++idx) {
                const float pp = xhalf_other(P3[idx], h);
                float prevp;
                if (idx == 0) prevp = h ? pp : 0.f; else { const float ppm = xhalf_other(P3[idx - 1], h); prevp = h ? pp : ppm; }
                imp[idx] += prevp;
                impx[(wid * 16 + idx) * 64 + lane] = imp[idx];
            }
            f32x16 oc[2];
#pragma unroll
            for (int i = 0; i < 16; ++i) { oc[0][i] = 0.f; oc[1][i] = 0.f; }
            pv_tile<64>(oc, s[0], lds + 2 * TB_, lane);
            pv_tile<64>(oc, s[1], lds + 3 * TB_, lane);
#pragma unroll
            for (int dvt = 0; dvt < 2; ++dvt)
#pragma unroll
                for (int i = 0; i < 4; ++i) *(float4*)(oacc + dvt * 32 + 8 * i + 4 * h) = make_float4(oc[dvt][4 * i], oc[dvt][4 * i + 1], oc[dvt][4 * i + 2], oc[dvt][4 * i + 3]);
        }
        __syncthreads();
        unsigned sel = 0u;
        {
            const int cur = qpos >> 6;
#pragma unroll
            for (int idx = 0; idx < 16; ++idx) {
                const float other = impx[((wid ^ 1) * 16 + idx) * 64 + lane];
                const float tot = n == 0 ? imp[idx] + other : other + imp[idx];
                const int j = 2 * idx + h;
                const bool forced = (j == 0) || (j == cur), valid = (j * 64 <= qpos);
                imp[idx] = forced ? 1e4f : (valid ? tot : -1.0f);
            }
#pragma unroll 1
            for (int it = 0; it < 8; ++it) {
                float best = -INFINITY; int bj = 64;
#pragma unroll
                for (int idx = 0; idx < 16; ++idx) if (imp[idx] > best) { best = imp[idx]; bj = 2 * idx + h; }
                const float pb = xhalf_other(best, h); const int pj = __float_as_int(xhalf_other(__int_as_float(bj), h));
                const bool own = (best > pb) || (best == pb && bj < pj);
                const int wj = own ? bj : pj;
                sel |= 1u << wj;
#pragma unroll
                for (int idx = 0; idx < 16; ++idx) if (2 * idx + h == wj) imp[idx] = -INFINITY;
            }
        }
        atomicOr(orw, sel);
        __syncthreads();
        const unsigned bmask = *orw;
        const int jhi = (q0 + NSA_QB - 1) >> 6;
        const unsigned upto = jhi >= 31 ? 0xffffffffu : ((1u << (jhi + 1)) - 1u);
        const float c1 = 0.125f * LOG2E, sl2 = sl * LOG2E;
        {
            f32x16 o[2];
#pragma unroll
            for (int i = 0; i < 16; ++i) { o[0][i] = 0.f; o[1][i] = 0.f; }
            float m = -1e30f, l = 0.f;
            const int jlo = (q0 - 511 > 0 ? q0 - 511 : 0) >> 6;
            const unsigned tmask = upto & ~((1u << jlo) - 1u);
            attn_stream<64, 64, true>(qf[0], o, m, l, tmask, qw + 31, qw - 511,
                [&](int row) { return H + (trow + row) * NH + O_AKW + g * 64; },
                [&](int row) { return H + (trow + row) * NH + O_AVW + g * 64; },
                c1, sl2, qpos,
                [&](int key) { const int dist = qpos - key; return dist >= 0 && dist < 512; },
                [&](int j) { return j * 64 + 63 <= qw && qw + 31 - j * 64 < 512; }, lds);
            const float rl = gate2 / fmaxf(xhalf_sum(l), 1e-30f);
#pragma unroll
            for (int dvt = 0; dvt < 2; ++dvt)
#pragma unroll
                for (int i = 0; i < 4; ++i) { float4* a = (float4*)(oacc + dvt * 32 + 8 * i + 4 * h); float4 c = *a;
                    c.x += o[dvt][4 * i] * rl; c.y += o[dvt][4 * i + 1] * rl; c.z += o[dvt][4 * i + 2] * rl; c.w += o[dvt][4 * i + 3] * rl; *a = c; }
        }
        {
            f32x16 o[2];
#pragma unroll
            for (int i = 0; i < 16; ++i) { o[0][i] = 0.f; o[1][i] = 0.f; }
            float m = -1e30f, l = 0.f;
            attn_stream<64, 64, true>(qf[0], o, m, l, bmask & upto, qw + 31, 0,
                [&](int row) { return H + (trow + row) * NH + O_AKS + g * 64; },
                [&](int row) { return H + (trow + row) * NH + O_AVS + g * 64; },
                c1, sl2, qpos,
                [&](int key) { return key <= qpos && ((sel >> (key >> 6)) & 1u); },
                [&](int j) { return j * 64 + 63 <= qw && __all((sel >> j) & 1u); }, lds);
            const float rl = gate1 / fmaxf(xhalf_sum(l), 1e-30f);
            bf16_t* dst = BR + (trow + qpos) * 1024 + head * 64;
#pragma unroll
            for (int dvt = 0; dvt < 2; ++dvt)
#pragma unroll
                for (int i = 0; i < 4; ++i) { const float4 c = *(const float4*)(oacc + dvt * 32 + 8 * i + 4 * h);
                    st4bf(dst + dvt * 32 + 8 * i + 4 * h, c.x + o[dvt][4 * i] * rl, c.y + o[dvt][4 * i + 1] * rl, c.z + o[dvt][4 * i + 2] * rl, c.w + o[dvt][4 * i + 3] * rl); }
        }
    }
}

namespace pg8 { typedef PG8_LAS unsigned char* PG8_LAS_T; }
#define LDS3 ((pg8::PG8_LAS_T)lds)
#define GEMM256(EPI, SCHED, g, S, E) do { __syncthreads(); pg8::gemm_phase<EPI, SCHED, true, true>(LDS3, g, S, E); } while (0)
constexpr int NPH = 17;
constexpr int NPHASES = 2 + DEPTH * NPH;

__global__ void __launch_bounds__(NT, 2) mega(Params pk, int ph_lo, int ph_hi) {
    extern __shared__ __attribute__((aligned(16))) unsigned char lds[];
    const int bid = blockIdx.x, nblk = gridDim.x;
#define XB_HERE XcdBarrier bar_; bar_.bar = (unsigned*)(pk.ws + WS_CTL) + CW_BAR; bar_.x = xb_xcc_id(); bar_.st = (volatile LAS unsigned*)(lds + 131072)
    const bool multi = (ph_hi - ph_lo) > 1;
    if (multi) {
        uint4* xbw = (uint4*)(lds + 131072);
        if (tidx() == 0) *xbw = make_uint4(0u, 0u, 0u, 0u);
        __syncthreads();
        (void)xcd_barrier_post((unsigned*)(pk.ws + WS_CTL) + CW_BAR, (volatile LAS unsigned*)xbw);
    }
#ifndef PROBE_PH
#define PROBE_PH -100
#endif
#define PHASE(id, ...) do { const int _id = (id); if (ph_lo <= _id && _id < ph_hi) { for (int _rep = 0; _rep < ((PROBE_PH == -1 ? _id < 2 : (_id >= 2 && (_id - 2) % NPH == PROBE_PH)) ? 2 : 1); ++_rep) { if (_rep) { XB_HERE; xcd_barrier(bar_); } { Params p = pk; int layer = layer_; asm volatile("" : "+s"(p.ws), "+s"(p.out), "+s"(layer)); \
        const LayerW w = layer_w(p, layer); const float* Xin = (layer == 0) ? p.in[0] : WSF(WS_XC); const bf16_t* XinB = (layer == 0) ? WSB(WS_X0B) : WSB(WS_XCB); float* Xout = (layer == DEPTH - 1) ? p.out : WSF(WS_XC); \
        (void)w; (void)Xin; (void)XinB; (void)Xout; __VA_ARGS__; } } if (_id + 1 < ph_hi) { XB_HERE; xcd_barrier(bar_); } } } while (0)

    { const int layer_ = 0;
    PHASE(0, {
        job_wt<2>(p.in[2], DEPTH, 1024, NIN, WSB(WT_IN), NH, bid, nblk, lds);
        job_wt<0>(p.in[17], DEPTH, 1024, 1024, WSB(WT_BR), 1024, bid, nblk, lds);
        job_wt<0>(p.in[18], DEPTH, 1024, 1024, WSB(WT_OUT), 1024, bid, nblk, lds);
        job_wt<0>(p.in[21], DEPTH, 1024, 512, WSB(WT_Q), 512, bid, nblk, lds);
        job_wt<0>(p.in[22], DEPTH, 1024, 1024, WSB(WT_KV), 1024, bid, nblk, lds);
        job_wt<0>(p.in[23], DEPTH, 512, 1024, WSB(WT_O), 1024, bid, nblk, lds);
        job_wt<1>(p.in[30], DEPTH * 32, 1024, 1024, WSB(WT_GU), 1024, bid, nblk, lds);
        job_wt<0>(p.in[31], DEPTH * 32, 512, 1024, WSB(WT_DN), 1024, bid, nblk, lds);
        job_wt<0>(p.in[4], DEPTH * 2, 2048, 256, WSB(WT_C1), 256, bid, nblk, lds);
        job_wt<0>(p.in[5], DEPTH * 2, 256, 64, WSB(WT_C2), 128, bid, nblk, lds);
        job_wt<0>(p.in[15], DEPTH, 192, 384, WSB(WT_UQ), 384, bid, nblk, lds);
        job_wt<0>(p.in[16], DEPTH, 128, 512, WSB(WT_UKV), 512, bid, nblk, lds);
        job_pack_small(p, bid, nblk);
        job_cvt(p.in[0], WSB(WS_X0B), (long)T * 1024, bid, nblk);
        job_cvt(p.in[1], WSB(WS_MEMB), (long)2048 * 1024, bid, nblk);
    });
    PHASE(1, {
        pg8::Gemm g{WSB(WS_MEMB), WSB(WT_KV), BATCH * MEM_LEN, 1024, 1024, nullptr};
        GroupedOrder S{8, 4, DEPTH, nblk, bid};
        EpiStoreBf16 E{WSB(WS_KVM), 1024, 1 << 30, (long)2048 * 1024};
        GEMM256(EpiStoreBf16, GroupedOrder, g, S, E);
    });
    }
    for (int layer_ = 0; layer_ < DEPTH; ++layer_) {
        const int base = 2 + layer_ * NPH;
        PHASE(base + 0, { pg8::Gemm g{XinB, w.t_in, T, NH, 1024, nullptr}; pg8::StaticOrder S; S.init(T, NH, nblk, bid); EpiStoreBf16 E{WSB(WS_H), NH, O_MG / 128, 0}; GEMM256(EpiStoreBf16, pg8::StaticOrder, g, S, E); });
        PHASE(base + 1, { job_sb_attn(p, bid, nblk, lds); job_cmp_gather(p, w, bid, nblk); job_rnn_conv(p, w, bid, nblk); job_mla_norm(p, w, bid, nblk); });
        PHASE(base + 2, { if (bid < 32) job_cmp_mlp<0>(p, w, bid, 32, lds); else { job_rnn_gates(p, w, bid - 32, nblk - 32, lds); job_mla_up(p, w, bid - 32, nblk - 32, lds); } });
        PHASE(base + 3, { job_cmp_mlp<1>(p, w, bid, nblk, lds); job_rnn_scan1(p, bid, nblk); });
        PHASE(base + 4, { job_nsa(p, bid, nblk, lds); job_mla_attn(p, bid, nblk, lds); job_rnn_scan2(p, bid, nblk); });
        PHASE(base + 5, { job_merge(p, w, bid, nblk, lds); });
        PHASE(base + 6, { pg8::Gemm g{WSB(WS_M), w.t_out, T, 1024, 1024, nullptr}; pg8::StaticOrder S; S.init(T, 1024, nblk, bid); EpiStoreBf16 E{WSB(WS_Y), 1024, 1 << 30, 0}; GEMM256(EpiStoreBf16, pg8::StaticOrder, g, S, E); });
        PHASE(base + 7, { job_ln(layer == 0 ? p.in[0] : nullptr, WSB(WS_XCB), nullptr, WSB(WS_Y), nullptr, nullptr, nullptr, nullptr, w.ln1_g, w.ln1_b, nullptr, WSB(WS_XAB), nullptr, bid, nblk, lds); });
        PHASE(base + 8, { pg8::Gemm g{WSB(WS_XAB), w.t_q, T, 512, 1024, nullptr}; pg8::StaticOrder S; S.init(T, 512, nblk, bid); EpiStoreBf16 E{WSB(WS_XQ), 512, 1 << 30, 0}; GEMM256(EpiStoreBf16, pg8::StaticOrder, g, S, E); });
        PHASE(base + 9, { job_cross_attn(p, layer, bid, nblk, lds); });
        PHASE(base + 10, { pg8::Gemm g{WSB(WS_XO), w.t_o, T, 1024, 512, nullptr}; pg8::StaticOrder S; S.init(T, 1024, nblk, bid); EpiStoreBf16 E{WSB(WS_Y), 1024, 1 << 30, 0}; GEMM256(EpiStoreBf16, pg8::StaticOrder, g, S, E); });
        PHASE(base + 11, { job_ln(nullptr, WSB(WS_XAB), nullptr, WSB(WS_Y), nullptr, nullptr, nullptr, nullptr, w.ln2_g, w.ln2_b, nullptr, WSB(WS_XBB), WSB(WS_XBL), bid, nblk, lds); });
        PHASE(base + 12, { job_router_logits(p, w, bid, nblk, lds); });
        PHASE(base + 13, { job_router(p, w, layer, bid, nblk); });
        PHASE(base + 14, { const pg8::ListOrder S = moe_units(WSU(WS_CTL) + CW_CNT + layer * 32, bid, nblk, lds); pg8::Gemm g{WSB(WS_XBB), w.t_gu, PADROWS, 1024, 1024, WSI(WS_PERM)}; EpiMoeGU E{WSB(WS_HH)}; __syncthreads(); pg8::gemm_phase<EpiMoeGU, pg8::ListOrder, true, true, true>(LDS3, g, S, E); });
        PHASE(base + 15, { const pg8::ListOrder S = moe_units(WSU(WS_CTL) + CW_CNT + layer * 32, bid, nblk, lds); pg8::Gemm g{WSB(WS_HH), w.t_dn, PADROWS, 1024, 512, nullptr}; EpiStoreBf16 E{WSB(WS_YK), 1024, 1 << 30, 0}; GEMM256(EpiStoreBf16, pg8::ListOrder, g, S, E); });
        PHASE(base + 16, { job_ln(nullptr, WSB(WS_XBB), WSB(WS_XBL), WSB(WS_YK), WSI(WS_EIDX), WSI(WS_ESLOT), WSU(WS_CTL) + CW_CNT + layer * 32, WSF(WS_EW), w.ln3_g, w.ln3_b, (layer == DEPTH - 1) ? p.out : nullptr, (layer == DEPTH - 1) ? nullptr : WSB(WS_XCB), nullptr, bid, nblk, lds); });
    }
}

extern "C" void kernel_launch(void* const* d_in, const int* in_sizes, int n_in, void* d_out, int out_size, void* d_ws, size_t ws_size, hipStream_t stream) {
    constexpr size_t kDynLds = 131072 + 1024;
    static_assert(2 * G_STAGE + 1024 <= 131072, "engine stages fit");
    static int grid = 0;
    if (!grid) {
        int dev = 0, cus = 0, per_cu = 0;
        (void)hipGetDevice(&dev);
        (void)hipDeviceGetAttribute(&cus, hipDeviceAttributeMultiprocessorCount, dev);
        (void)hipFuncSetAttribute((const void*)mega, hipFuncAttributeMaxDynamicSharedMemorySize, (int)kDynLds);
        (void)hipOccupancyMaxActiveBlocksPerMultiprocessor(&per_cu, mega, NT, kDynLds);
        if (per_cu < 1) per_cu = 1;
        grid = cus * (per_cu < 2 ? per_cu : 2);
    }
    if (ws_size < WS_END) { fprintf(stderr, "workspace too small: %zu < %zu\n", ws_size, (size_t)WS_END); return; }
    Params p{};
    for (int i = 0; i < 34; ++i) p.in[i] = (const float*)d_in[i];
    p.out = (float*)d_out;
    p.ws = (unsigned char*)d_ws;
    (void)hipMemsetAsync(d_ws, 0, CTL_BYTES, stream);
#if MK_ONE_LAUNCH
    hipLaunchKernelGGL(mega, dim3(grid), dim3(NT), kDynLds, stream, p, 0, NPHASES);
#else
    for (int ph = 0; ph < NPHASES; ++ph) hipLaunchKernelGGL(mega, dim3(grid), dim3(NT), kDynLds, stream, p, ph, ph + 1);
#endif
}
```

```cpp
#include <hip/hip_runtime.h>
#include <stdint.h>
#include <stdio.h>

#ifndef MK_ONE_LAUNCH
#define MK_ONE_LAUNCH 1
#endif

#define DI __device__ __forceinline__
#define LAS __attribute__((address_space(3)))
DI int tidx() { int t = threadIdx.x; asm volatile("" : "+v"(t)); return t; }

constexpr int NT = 512;
constexpr int D = 1024, BATCH = 8, SEQ = 2048, T = BATCH * SEQ, DEPTH = 4;
constexpr int MEM_LEN = 256;
constexpr int NIN = 6764, NH = 6912;
constexpr int O_AQ = 0, O_AKC = 256, O_AVC = 384, O_AKS = 512, O_AVS = 640, O_AKW = 768, O_AVW = 896,
              O_BQ = 1024, O_BK = 1280, O_BV = 1536, O_CX = 1792, O_CG = 2048, O_DCQ = 2304, O_DCKV = 2496, O_DKR = 2624,
              O_AG = 2656, O_MG = 2688;
constexpr int NCMP = 127, NCR = BATCH * NCMP * 2;
constexpr int NEXP = 32, NASSIGN = T * 2;
constexpr int PCAP = T;
constexpr float DN_ALPHA = 1.681792830507429f;

typedef unsigned short bf16_t;
typedef short bf16x8 __attribute__((ext_vector_type(8)));
typedef float f32x16 __attribute__((ext_vector_type(16)));
typedef unsigned u32x4 __attribute__((ext_vector_type(4)));

constexpr int G_WM = NT / 128;
constexpr int G_BM = 64 * G_WM;
constexpr int G_BN = 128;
constexpr int G_RS = 144;
constexpr int G_STAGE = (G_BM + G_BN) * G_RS;
constexpr int PADROWS = ((NASSIGN + NEXP * (G_BM - 1) + G_BM - 1) / G_BM) * G_BM;

constexpr size_t MiB = 1u << 20;
constexpr size_t al(size_t x) { return (x + 255) & ~(size_t)255; }
constexpr size_t WS_CTL = 0, CTL_BYTES = 1 * MiB;
constexpr size_t WT_IN = WS_CTL + CTL_BYTES;
constexpr size_t WT_BR = WT_IN + al((size_t)DEPTH * NH * 1024 * 2);
constexpr size_t WT_OUT = WT_BR + al((size_t)DEPTH * 4 * 1024 * 256 * 2);
constexpr size_t WT_Q = WT_OUT + al((size_t)DEPTH * 1024 * 1024 * 2);
constexpr size_t WT_KV = WT_Q + al((size_t)DEPTH * 512 * 1024 * 2);
constexpr size_t WT_O = WT_KV + al((size_t)DEPTH * 1024 * 1024 * 2);
constexpr size_t WT_GU = WT_O + al((size_t)DEPTH * 1024 * 512 * 2);
constexpr size_t WT_DN = WT_GU + al((size_t)DEPTH * 32 * 1024 * 1024 * 2);
constexpr size_t WS_X0B = WT_DN + al((size_t)DEPTH * 32 * 1024 * 512 * 2);
constexpr size_t WS_MEMB = WS_X0B + al((size_t)T * 1024 * 2);
constexpr size_t WS_H = WS_MEMB + al((size_t)2048 * 1024 * 2);
constexpr size_t SZ_H = al((size_t)T * NH * 2);
constexpr size_t WS_YK = WS_H;
constexpr size_t WS_HH = WS_YK + (size_t)PADROWS * 1024 * 2;
static_assert(WS_HH + (size_t)PADROWS * 512 * 2 <= WS_H + SZ_H, "moe overlay fits in H");
constexpr size_t WS_TB = WS_H + SZ_H;
constexpr size_t WS_HID = WS_TB + al((size_t)2 * NCR * 2048 * 4);
constexpr size_t WS_KCVC = WS_HID + al((size_t)2 * NCR * 256 * 4);
constexpr size_t WS_PC = WS_KCVC + al((size_t)2 * NCR * 64 * 4);
constexpr size_t WS_SEL = WS_PC + al((size_t)BATCH * 4 * SEQ * 128 * 4);
constexpr size_t WS_OW = WS_SEL + al((size_t)BATCH * 2 * SEQ * 4);
constexpr size_t WS_OC = WS_OW + al((size_t)T * 256 * 4);
constexpr size_t WS_BR = WS_OC + al((size_t)T * 256 * 4);
constexpr size_t WS_U = WS_BR + al((size_t)T * 1024 * 2);
constexpr size_t WS_RA = WS_U + al((size_t)T * 256 * 4);
constexpr size_t WS_RB = WS_RA + al((size_t)T * 256 * 4);
constexpr size_t WS_CQN = WS_RB + al((size_t)T * 256 * 4);
constexpr size_t WS_CKVN = WS_CQN + al((size_t)T * 192 * 4);
constexpr size_t WS_KR = WS_CKVN + al((size_t)T * 128 * 4);
constexpr size_t WS_Q = WS_KR + al((size_t)T * 32 * 4);
constexpr size_t WS_KV = WS_Q + al((size_t)T * 384 * 4);
constexpr size_t WS_M = WS_KV + al((size_t)T * 512 * 4);
constexpr size_t WS_Y = WS_M + al((size_t)T * 1024 * 2);
constexpr size_t WS_XA = WS_Y + al((size_t)T * 1024 * 4);
constexpr size_t WS_XB = WS_XA + al((size_t)T * 1024 * 4);
constexpr size_t WS_XC = WS_XB + al((size_t)T * 1024 * 4);
constexpr size_t WS_XAB = WS_XC + al((size_t)T * 1024 * 4);
constexpr size_t WS_XBB = WS_XAB + al((size_t)T * 1024 * 2);
constexpr size_t WS_XCB = WS_XBB + al((size_t)T * 1024 * 2);
constexpr size_t WS_XQ = WS_XCB + al((size_t)T * 1024 * 2);
constexpr size_t WS_XO = WS_XQ + al((size_t)T * 512 * 2);
constexpr size_t WS_KVM = WS_XO + al((size_t)T * 512 * 2);
constexpr size_t WS_LOG = WS_KVM + al((size_t)DEPTH * 2048 * 1024 * 2);
constexpr size_t WS_EIDX = WS_LOG + al((size_t)3 * T * 36 * 4);
constexpr size_t WS_ESLOT = WS_EIDX + al((size_t)NASSIGN * 4);
constexpr size_t WS_EW = WS_ESLOT + al((size_t)NASSIGN * 4);
constexpr size_t WS_PERM = WS_EW + al((size_t)NASSIGN * 4);
constexpr size_t WS_QB = WS_PERM + al((size_t)NEXP * T * 4);
constexpr size_t WS_KM = WS_QB + al((size_t)T * 384 * 2);
constexpr size_t WS_VM = WS_KM + al((size_t)T * 384 * 2);
constexpr size_t WS_KCB = WS_VM + al((size_t)T * 256 * 2);
constexpr size_t WT_C1 = WS_KCB + al((size_t)2 * NCR * 64 * 2);
constexpr size_t WT_C2 = WT_C1 + al((size_t)DEPTH * 2 * 256 * 2048 * 2);
constexpr size_t WT_UQ = WT_C2 + al((size_t)DEPTH * 2 * 128 * 256 * 2);
constexpr size_t WT_UKV = WT_UQ + al((size_t)DEPTH * 384 * 192 * 2);
constexpr size_t WT_G = WT_UKV + al((size_t)DEPTH * 512 * 128 * 2);
constexpr size_t WT_RH = WT_G + al((size_t)DEPTH * 4 * 128 * 64 * 2);
constexpr size_t WT_RL = WT_RH + al((size_t)DEPTH * 128 * 1024 * 2);
constexpr size_t WS_TBB = WT_RL + al((size_t)DEPTH * 128 * 1024 * 2);
constexpr size_t WS_HIDB = WS_TBB + al((size_t)2 * 2048 * 2048 * 2);
constexpr size_t WS_UB = WS_HIDB + al((size_t)2 * 2048 * 256 * 2);
constexpr size_t WS_CQNB = WS_UB + al((size_t)T * 256 * 2);
constexpr size_t WS_CKVNB = WS_CQNB + al((size_t)T * 192 * 2);
constexpr size_t WS_XBL = WS_CKVNB + al((size_t)T * 128 * 2);
constexpr size_t WS_SA = WS_XBL + al((size_t)T * 1024 * 2);
constexpr size_t WS_SH = WS_SA + al((size_t)BATCH * 32 * 256 * 4);
constexpr size_t WS_XG = WS_SH + al((size_t)BATCH * 32 * 256 * 4);
constexpr size_t WS_ROWOF = WS_XG + al((size_t)PADROWS * 1024 * 2);
constexpr size_t WS_ROPE_PRE = WS_ROWOF + al((size_t)NASSIGN * 4);
constexpr size_t WS_ROPE = WS_ROPE_PRE;
constexpr size_t WS_END = WS_ROPE + al((size_t)SEQ * 16 * 2 * 4);

constexpr int CW_BAR = 4096;
constexpr int CW_CNT = 16384;

struct Params {
    const float* in[34];
    float* out;
    unsigned char* ws;
};

#define XB_TMO      128
#define XB_XCNT(j)  (256  + 64 * (j))
#define XB_XSUB(j)  (1280 + 64 * (j))
#define XB_XGEN(j)  (2304 + 64 * (j))
#define XB_TOP      3328
#define XB_TOPGEN   3392
#define XCD_BAR_WORDS 3456
#define XB_SPIN_CAP (1u << 22)

__device__ __forceinline__ unsigned xb_ld(unsigned* p)              { return __hip_atomic_load(p, __ATOMIC_RELAXED, __HIP_MEMORY_SCOPE_AGENT); }
__device__ __forceinline__ unsigned xb_add(unsigned* p, unsigned v) { return __hip_atomic_fetch_add(p, v, __ATOMIC_RELAXED, __HIP_MEMORY_SCOPE_AGENT); }
__device__ __forceinline__ unsigned xb_xcc_id() { return (unsigned)__builtin_amdgcn_s_getreg((3 << 11) | 20) & 0xFu; }
#define XB_SPIN(cond, bar) do { unsigned _sp = 0; while (cond) { __builtin_amdgcn_s_sleep(1); \
    if ((++_sp & 255u) == 0u) { if (xb_ld(&(bar)[XB_TMO])) break; if (_sp > XB_SPIN_CAP) { atomicAdd(&(bar)[XB_TMO], 1u); break; } } } } while (0)

struct XcdBarrier { unsigned* bar; unsigned x; volatile LAS unsigned* st; };

__device__ __forceinline__ XcdBarrier xcd_barrier_post(unsigned* bar, volatile LAS unsigned* st) {
    XcdBarrier b; b.bar = bar; b.x = xb_xcc_id(); b.st = st;
    if (threadIdx.x == 0) (void)xb_add(&bar[XB_XCNT(b.x)], 1u);
    return b;
}
__device__ __forceinline__ void xcd_barrier_complete(unsigned* bar, unsigned x, unsigned& nloc, unsigned& nx) {
    const unsigned G = gridDim.x * gridDim.y * gridDim.z;
    unsigned sum, cnt, mine, sp = 0u;
    for (;;) {
        sum = 0u; cnt = 0u; mine = 0u;
#pragma unroll
        for (unsigned j = 0; j < 16; ++j) { const unsigned c = xb_ld(&bar[XB_XCNT(j)]); sum += c; cnt += (c > 0u) ? 1u : 0u; mine = (j == x) ? c : mine; }
        if (sum == G) break;
        __builtin_amdgcn_s_sleep(1);
        if ((++sp & 255u) == 0u) { if (xb_ld(&bar[XB_TMO])) break; if (sp > XB_SPIN_CAP) { atomicAdd(&bar[XB_TMO], 1u); break; } }
    }
    nloc = mine > 0u ? mine : 1u; nx = cnt > 0u ? cnt : 1u;
}
__device__ __forceinline__ void xcd_barrier(const XcdBarrier& b) {
    asm volatile("s_waitcnt vmcnt(0)" ::: "memory");
    __syncthreads();
    if (threadIdx.x == 0) {
        unsigned* bar = b.bar;
        __builtin_amdgcn_s_waitcnt(0);
        unsigned nloc = b.st[0], nx = b.st[1];
        if (nloc == 0u) { xcd_barrier_complete(bar, b.x, nloc, nx); b.st[0] = nloc; b.st[1] = nx; }
        const unsigned old = xb_add(&bar[XB_XSUB(b.x)], 1u);
        const unsigned gen = old / nloc;
        if (old + 1u == (gen + 1u) * nloc) {
            __builtin_amdgcn_fence(__ATOMIC_RELEASE, "agent");
            asm volatile("s_waitcnt vmcnt(0)" ::: "memory");
            const unsigned og = xb_add(&bar[XB_TOP], 1u);
            const unsigned tg = og / nx;
            if (og + 1u == (tg + 1u) * nx) xb_add(&bar[XB_TOPGEN], 1u);
            else XB_SPIN(xb_ld(&bar[XB_TOPGEN]) == tg, bar);
            __builtin_amdgcn_fence(__ATOMIC_ACQUIRE, "agent");
            xb_add(&bar[XB_XGEN(b.x)], 1u);
            asm volatile("s_waitcnt vmcnt(0)" ::: "memory");
        } else {
            XB_SPIN(xb_ld(&bar[XB_XGEN(b.x)]) == gen, bar);
            __builtin_amdgcn_fence(__ATOMIC_ACQUIRE, "agent");
            asm volatile("s_waitcnt vmcnt(0)" ::: "memory");
        }
    }
    __syncthreads();
}

DI float gelu_tanh(float x) { const float u = 0.7978845608028654f * (x + 0.044715f * x * x * x); return 0.5f * x * (1.f + tanhf(u)); }
DI float sigm(float x) { return 1.f / (1.f + expf(-x)); }
DI float sigm_fast(float x) { return __builtin_amdgcn_rcpf(1.f + __expf(-x)); }
DI float logsig(float z) { return fminf(z, 0.f) - log1pf(expf(-fabsf(z))); }
DI float wave_sum(float v) {
    const int lane = tidx() & 63;
#pragma unroll
    for (int o = 32; o > 0; o >>= 1) v += __int_as_float(__builtin_amdgcn_ds_bpermute((lane ^ o) << 2, __float_as_int(v)));
    return v;
}
DI void wave_sum2(float& a, float& b) {
    const int lane = tidx() & 63;
#pragma unroll
    for (int o = 32; o > 0; o >>= 1) {
        const float a2 = __int_as_float(__builtin_amdgcn_ds_bpermute((lane ^ o) << 2, __float_as_int(a)));
        const float b2 = __int_as_float(__builtin_amdgcn_ds_bpermute((lane ^ o) << 2, __float_as_int(b)));
        a += a2; b += b2;
    }
}

DI float bflo(unsigned u) { return __uint_as_float(u << 16); }
DI float bfhi(unsigned u) { return __uint_as_float(u & 0xffff0000u); }
DI float bf2f(bf16_t x) { return __uint_as_float((unsigned)x << 16); }
typedef float f32x2_t __attribute__((ext_vector_type(2)));
typedef __bf16 bf16x2_t __attribute__((ext_vector_type(2)));
DI unsigned pk_bf16(float lo, float hi) { f32x2_t v = {lo, hi}; bf16x2_t b = __builtin_convertvector(v, bf16x2_t); return __builtin_bit_cast(unsigned, b); }
DI bf16_t f2bf(float x) { return (bf16_t)(pk_bf16(x, 0.f) & 0xffffu); }
DI void st4bf(bf16_t* p, float a, float b, float c, float d) { uint2 v; v.x = pk_bf16(a, b); v.y = pk_bf16(c, d); *(uint2*)p = v; }
DI void ld8f(const bf16_t* p, float* f) { const u32x4 v = *(const u32x4*)p; f[0] = bflo(v[0]); f[1] = bfhi(v[0]); f[2] = bflo(v[1]); f[3] = bfhi(v[1]); f[4] = bflo(v[2]); f[5] = bfhi(v[2]); f[6] = bflo(v[3]); f[7] = bfhi(v[3]); }
DI void st8bf(bf16_t* p, const float* f) { u32x4 v; v[0] = pk_bf16(f[0], f[1]); v[1] = pk_bf16(f[2], f[3]); v[2] = pk_bf16(f[4], f[5]); v[3] = pk_bf16(f[6], f[7]); *(u32x4*)p = v; }
DI float4 ld4bf(const bf16_t* p) { const uint2 v = *(const uint2*)p; return make_float4(bflo(v.x), bfhi(v.x), bflo(v.y), bfhi(v.y)); }
template <int N> DI float dot_row(const float* q, const bf16_t* kr) {
    float dot = 0.f;
#pragma unroll
    for (int d = 0; d < N; d += 8) { const uint4 v = *(const uint4*)(kr + d);
        dot = fmaf(q[d], bflo(v.x), dot); dot = fmaf(q[d + 1], bfhi(v.x), dot); dot = fmaf(q[d + 2], bflo(v.y), dot); dot = fmaf(q[d + 3], bfhi(v.y), dot);
        dot = fmaf(q[d + 4], bflo(v.z), dot); dot = fmaf(q[d + 5], bfhi(v.z), dot); dot = fmaf(q[d + 6], bflo(v.w), dot); dot = fmaf(q[d + 7], bfhi(v.w), dot); }
    return dot;
}
template <int N> DI float dot_row(const float* q, const float* kr) {
    float dot = 0.f;
#pragma unroll
    for (int d = 0; d < N; ++d) dot = fmaf(q[d], kr[d], dot);
    return dot;
}
template <int N> DI void axpy_row(float* o, float pr, float corr, const bf16_t* vr) {
#pragma unroll
    for (int d = 0; d < N; d += 8) { const uint4 v = *(const uint4*)(vr + d);
        o[d] = fmaf(pr, bflo(v.x), o[d] * corr); o[d + 1] = fmaf(pr, bfhi(v.x), o[d + 1] * corr); o[d + 2] = fmaf(pr, bflo(v.y), o[d + 2] * corr); o[d + 3] = fmaf(pr, bfhi(v.y), o[d + 3] * corr);
        o[d + 4] = fmaf(pr, bflo(v.z), o[d + 4] * corr); o[d + 5] = fmaf(pr, bfhi(v.z), o[d + 5] * corr); o[d + 6] = fmaf(pr, bflo(v.w), o[d + 6] * corr); o[d + 7] = fmaf(pr, bfhi(v.w), o[d + 7] * corr); }
}
template <int N> DI void axpy_row(float* o, float pr, float corr, const float* vr) {
#pragma unroll
    for (int d = 0; d < N; ++d) o[d] = fmaf(pr, vr[d], o[d] * corr);
}
template <int N> DI void ld_row(float* q, const bf16_t* p) {
#pragma unroll
    for (int d = 0; d < N; d += 8) { const uint4 v = *(const uint4*)(p + d);
        q[d] = bflo(v.x); q[d + 1] = bfhi(v.x); q[d + 2] = bflo(v.y); q[d + 3] = bfhi(v.y); q[d + 4] = bflo(v.z); q[d + 5] = bfhi(v.z); q[d + 6] = bflo(v.w); q[d + 7] = bfhi(v.w); }
}
template <int N> DI void ld_row(float* q, const float* p) {
#pragma unroll
    for (int d = 0; d < N; d += 4) { const float4 v = *(const float4*)(p + d); q[d] = v.x; q[d + 1] = v.y; q[d + 2] = v.z; q[d + 3] = v.w; }
}

struct MG { const bf16_t* A; long lda; const bf16_t* Wt; long ldw; int K; };

struct NoFlush { DI void operator()(int, f32x16 (&)[2][2]) const {} };
struct NoPre { DI void operator()(int) const {} };
template <class RowFn, class Flush, class Pre>
DI void mgemm_tile_f(const MG& g, int n0, RowFn rowfn, f32x16 (&acc)[2][2], unsigned char* lds, bool zero, int flush_every, Flush flush, Pre pre) {
    constexpr int XI = G_BM * 8 / NT, WI = G_BN * 8 / NT;
    const int tid = tidx(), lane = tid & 63, wid = tid >> 6, r = lane & 31, h = lane >> 5;
    const int wm = wid % G_WM, wn = wid / G_WM;
    const int cc = tid & 7, row0 = tid >> 3;
    const bf16_t* xp[XI]; const bf16_t* wp[WI];
#pragma unroll
    for (int i = 0; i < XI; ++i) xp[i] = g.A + (long)rowfn(row0 + (NT / 8) * i) * g.lda + cc * 8;
#pragma unroll
    for (int i = 0; i < WI; ++i) wp[i] = g.Wt + (long)(n0 + row0 + (NT / 8) * i) * g.ldw + cc * 8;
    const int st_off = row0 * G_RS + cc * 16;
    if (zero)
#pragma unroll
    for (int a = 0; a < 2; ++a)
#pragma unroll
        for (int b = 0; b < 2; ++b)
#pragma unroll
            for (int i = 0; i < 16; ++i) acc[a][b][i] = 0.f;
    const int nk = g.K >> 6;
    u32x4 xv0[XI], wv0[WI], xv1[XI], wv1[WI];
#define MG_GLOAD(XV, WV, KT) do { _Pragma("unroll") for (int i = 0; i < XI; ++i) XV[i] = *(const u32x4*)(xp[i] + (KT) * 64); \
                                  _Pragma("unroll") for (int i = 0; i < WI; ++i) WV[i] = *(const u32x4*)(wp[i] + (KT) * 64); } while (0)
#define MG_LSTORE(XV, WV, STG) do { unsigned char* _s = lds + (STG) * G_STAGE; \
        _Pragma("unroll") for (int i = 0; i < XI; ++i) *(u32x4*)(_s + st_off + (NT / 8) * i * G_RS) = XV[i]; \
        _Pragma("unroll") for (int i = 0; i < WI; ++i) *(u32x4*)(_s + G_BM * G_RS + st_off + (NT / 8) * i * G_RS) = WV[i]; } while (0)
    MG_GLOAD(xv0, wv0, 0);
    if (nk > 1) MG_GLOAD(xv1, wv1, 1);
    __syncthreads();
    MG_LSTORE(xv0, wv0, 0);
    if (nk > 2) MG_GLOAD(xv0, wv0, 2);
    __syncthreads();
    const int xf_off = (wm * 64 + r) * G_RS + h * 16, wf_off = G_BM * G_RS + (wn * 64 + r) * G_RS + h * 16;
#define MG_COMPUTE(STG) do { const unsigned char* st = lds + (STG) * G_STAGE; \
        _Pragma("unroll") for (int ks = 0; ks < 4; ++ks) { \
            const bf16x8 w0 = *(const bf16x8*)(st + wf_off + ks * 32), w1 = *(const bf16x8*)(st + wf_off + 32 * G_RS + ks * 32); \
            const bf16x8 x0 = *(const bf16x8*)(st + xf_off + ks * 32), x1 = *(const bf16x8*)(st + xf_off + 32 * G_RS + ks * 32); \
            acc[0][0] = __builtin_amdgcn_mfma_f32_32x32x16_bf16(w0, x0, acc[0][0], 0, 0, 0); \
            acc[0][1] = __builtin_amdgcn_mfma_f32_32x32x16_bf16(w0, x1, acc[0][1], 0, 0, 0); \
            acc[1][0] = __builtin_amdgcn_mfma_f32_32x32x16_bf16(w1, x0, acc[1][0], 0, 0, 0); \
            acc[1][1] = __builtin_amdgcn_mfma_f32_32x32x16_bf16(w1, x1, acc[1][1], 0, 0, 0); } } while (0)
    for (int kt = 0; kt < nk; kt += 2) {
        if (flush_every && kt % flush_every == 0) pre(kt / flush_every);
        MG_COMPUTE(0);
        if (kt + 1 < nk) { MG_LSTORE(xv1, wv1, 1); if (kt + 3 < nk) MG_GLOAD(xv1, wv1, kt + 3); }
        if (flush_every && (kt + 1) % flush_every == 0) flush(kt / flush_every, acc);
        __syncthreads();
        if (kt + 1 < nk) {
            MG_COMPUTE(1);
            if (kt + 2 < nk) { MG_LSTORE(xv0, wv0, 0); if (kt + 4 < nk) MG_GLOAD(xv0, wv0, kt + 4); }
            if (flush_every && (kt + 2) % flush_every == 0) flush((kt + 1) / flush_every, acc);
            __syncthreads();
        }
    }
#undef MG_GLOAD
#undef MG_LSTORE
#undef MG_COMPUTE
}
template <class RowFn>
DI void mgemm_tile(const MG& g, int n0, RowFn rowfn, f32x16 (&acc)[2][2], unsigned char* lds, bool zero = true) { mgemm_tile_f(g, n0, rowfn, acc, lds, zero, 0, NoFlush{}, NoPre{}); }
#define MG_FOREACH(acc, LROW, FEAT, V, ...) do { const int _l = tidx() & 63, _w = tidx() >> 6, _wm = _w % G_WM, _wn = _w / G_WM; \
    _Pragma("unroll") for (int _ft = 0; _ft < 2; ++_ft) _Pragma("unroll") for (int _tt = 0; _tt < 2; ++_tt) _Pragma("unroll") for (int _i = 0; _i < 4; ++_i) { \
        const int LROW = _wm * 64 + _tt * 32 + (_l & 31); const int FEAT = _wn * 64 + _ft * 32 + 8 * _i + 4 * (_l >> 5); \
        float V[4] = {acc[_ft][_tt][4 * _i], acc[_ft][_tt][4 * _i + 1], acc[_ft][_tt][4 * _i + 2], acc[_ft][_tt][4 * _i + 3]}; __VA_ARGS__ } } while (0)

struct RowId { int m0; DI long operator()(int r) const { return m0 + r; } };

template <int OUTMODE>
DI void mgemm_job(const MG& g, int M, int N, void* out, long ldo, int bid, int nblk, unsigned char* lds) {
    const int tm = M / G_BM, tn = N / G_BN;
    for (int u = bid; u < tm * tn; u += nblk) {
        const int grp = u / (16 * tn), rem = u % (16 * tn);
        const int gm = (tm - grp * 16) < 16 ? (tm - grp * 16) : 16;
        const int mt = grp * 16 + rem % gm, nt = rem / gm;
        const int m0 = mt * G_BM, n0 = nt * G_BN;
        f32x16 acc[2][2];
        mgemm_tile(g, n0, RowId{m0}, acc, lds);
        MG_FOREACH(acc, lrow, feat, v, {
            const long o = (long)(m0 + lrow) * ldo + n0 + feat;
            if (OUTMODE == 1) *(float4*)((float*)out + o) = make_float4(v[0], v[1], v[2], v[3]);
            else {
                if (OUTMODE == 2 && n0 + feat >= O_MG) { v[0] = sigm(v[0]); v[1] = sigm(v[1]); v[2] = sigm(v[2]); v[3] = sigm(v[3]); }
                st4bf((bf16_t*)out + o, v[0], v[1], v[2], v[3]);
            } });
    }
}

namespace pg8 {
#define PG8_LAS __attribute__((address_space(3)))
typedef float f32x4 __attribute__((ext_vector_type(4)));
constexpr int BM = 256, BK = 64, HALF = 128, HTB = HALF * BK * 2  , STAGE_BYTES = 8 * HTB, NXCD = 8, WGM = 8;
__host__ __device__ __forceinline__ int lds_byte(int r, int c) { const int st = (r >> 4) * 2 + (c >> 5), rr = r & 15, cc = c & 31, ob = rr * 64 + cc * 2; return st * 1024 + (ob ^ (((ob >> 9) & 1) << 5)); }
__host__ __device__ __forceinline__ void stage_rc(int b, int& R, int& C) { const int st = b / 1024, sb = b % 1024, swz = sb ^ (((sb >> 9) & 1) << 5); R = (st >> 1) * 16 + swz / 64; C = (st & 1) * 32 + (swz % 64) / 2; }
__host__ __device__ __forceinline__ int perm32(int rho) { const int n = rho >> 4, i = rho & 15; return 8 * (i >> 2) + 4 * n + (i & 3); }
struct Unit { int pm, pn, e, gt, nv; };
struct Gemm { const bf16_t* A; const bf16_t* Bt; int M, N, K; const int* rowidx; };
struct StaticOrder {
    int nM, nN, nwg, G, c;
    __device__ void init(int M, int N, int G_, int c_) { nM = M / BM; nN = N / BM; nwg = nM * nN; G = G_; c = c_; }
    __device__ bool next(int i, Unit& u) const {
        const long L = (long)i * G + c; if (L >= nwg) return false;
        int wgid = (int)L; { const int q = nwg / NXCD, r = nwg % NXCD, xcd = wgid % NXCD, off = wgid / NXCD; wgid = (xcd < r ? xcd * (q + 1) : r * (q + 1) + (xcd - r) * q) + off; }
        const int nig = WGM * nN, gid = wgid / nig, fm = gid * WGM, gsz = (nM - fm) < WGM ? (nM - fm) : WGM;
        u.pm = fm + ((wgid % nig) % gsz); u.pn = (wgid % nig) / gsz; u.e = 0; u.gt = 0; u.nv = 0; return true;
    }
    __device__ __forceinline__ void a_ready(const Unit&) const {}
    __device__ __forceinline__ void done(const Unit&) const {}
};
struct ListOrder {
    Unit u0, u1, u2; int n;
    __device__ bool next(int i, Unit& u) const { if (i >= n) return false; u = (i == 0) ? u0 : ((i == 1) ? u1 : u2); return true; }
    __device__ __forceinline__ void a_ready(const Unit&) const {}
    __device__ __forceinline__ void done(const Unit&) const {}
};
template <class Epi, class Sched, bool ALIGN_EPI = false, bool SP2 = false, bool GATHER = false>
__device__ __forceinline__ void gemm_phase(PG8_LAS unsigned char* lds, const Gemm g, const Sched& S, const Epi& E) {
    const int tid = tidx(), wid = __builtin_amdgcn_readfirstlane(tid >> 6), lane = tid & 63, wr = wid >> 2, wc = wid & 3, fr = lane & 15, fq = lane >> 4;
    const int K = g.K, nt = K / BK;
    unsigned voffA[2], voffB[2];
#pragma unroll
    for (int i = 0; i < 2; ++i) { int R, C; stage_rc(tid * 16 + i * 8192, R, C); const int Rb = Epi::PERM ? ((R & ~31) + perm32(R & 31)) : R;
        voffA[i] = (unsigned)(R * K + C) * 2u; voffB[i] = (unsigned)(Rb * K + C) * 2u; }
    unsigned voffC[2][2] = {{0u, 0u}, {0u, 0u}}, voffN[2][2] = {{0u, 0u}, {0u, 0u}};
    auto gather_offs = [&](const Unit& uu, unsigned (&vo)[2][2]) {
#pragma unroll
        for (int hh = 0; hh < 2; ++hh)
#pragma unroll
            for (int i = 0; i < 2; ++i) { int R, C; stage_rc(tid * 16 + i * 8192, R, C); const int lr = hh * HALF + R; int a = g.rowidx[uu.gt * BM + lr]; a = lr < uu.nv ? (a >> 1) : 0; vo[hh][i] = (unsigned)(a * K + C) * 2u; }
    };
    const size_t kstep = (size_t)(BK * 2);
    const size_t hstep = (size_t)HALF * K * 2;
    const size_t tstep = 2 * hstep;
    const size_t estep = (size_t)g.N * K * 2;
    const unsigned ldsw = (unsigned)wid * 1024u;
    const int aoff = lds_byte(wr * 64 + fr, fq * 8), boff = lds_byte(wc * 32 + fr, fq * 8);
#define PG8_SA(b, h) (((b) * 2 + (h)) * HTB)
#define PG8_SB(b, h) ((4 + (b) * 2 + (h)) * HTB)
#define PG8_STAGE(bufoff, gbase, voff) do { _Pragma("unroll") for (int _i = 0; _i < 2; ++_i) \
        __builtin_amdgcn_global_load_lds((const unsigned*)((const char*)(gbase) + (voff)[_i]), (PG8_LAS unsigned*)(lds + (bufoff) + ldsw + _i * 8192), 16, 0, 0); } while (0)
#define PG8_STAGE_A(bufoff, HH, KT, NX, densebase) do { if constexpr (GATHER) { const char* _gb = (const char*)g.A + (size_t)(KT) * kstep; if (NX) PG8_STAGE(bufoff, _gb, voffN[HH]); else PG8_STAGE(bufoff, _gb, voffC[HH]); } else PG8_STAGE(bufoff, densebase, voffA); } while (0)
#define PG8_LDA(dst, b, h) do { _Pragma("unroll") for (int m = 0; m < 4; ++m) _Pragma("unroll") for (int k = 0; k < 2; ++k) dst[m][k] = *(const PG8_LAS bf16x8*)(lds + PG8_SA(b, h) + aoff + m * 2048 + k * 1024); } while (0)
#define PG8_LDB(dst, b, h) do { _Pragma("unroll") for (int n = 0; n < 2; ++n) _Pragma("unroll") for (int k = 0; k < 2; ++k) dst[n][k] = *(const PG8_LAS bf16x8*)(lds + PG8_SB(b, h) + boff + n * 2048 + k * 1024); } while (0)
#define PG8_MMA(ai, bj, At, Bt) do { __builtin_amdgcn_s_setprio(1); _Pragma("unroll") for (int m = 0; m < 4; ++m) _Pragma("unroll") for (int n = 0; n < 2; ++n) _Pragma("unroll") for (int k = 0; k < 2; ++k) \
        acc[ai][bj][m][n] = __builtin_amdgcn_mfma_f32_16x16x32_bf16(Bt[n][k], At[m][k], acc[ai][bj][m][n], 0, 0, 0); __builtin_amdgcn_s_setprio(0); } while (0)
#define PG8_WAIT_V(n) asm volatile("s_waitcnt vmcnt(" #n ")" ::: "memory")
#define PG8_WAIT_L(n) asm volatile("s_waitcnt lgkmcnt(" #n ")" ::: "memory")
#define PG8_BAR __builtin_amdgcn_s_barrier()
#define PG8_SCHED __builtin_amdgcn_sched_barrier(0)
    Unit cur, nxt; int ui = 0;
    if (!S.next(0, cur)) return;
    f32x4 acc[2][2][4][2];
#pragma unroll
    for (int a = 0; a < 2; ++a)
#pragma unroll
        for (int b = 0; b < 2; ++b)
#pragma unroll
            for (int m = 0; m < 4; ++m)
#pragma unroll
                for (int n = 0; n < 2; ++n) acc[a][b][m][n] = (f32x4){0.f, 0.f, 0.f, 0.f};
    bf16x8 At[4][2], B0[2][2], B1[2][2];
    const char* cA = (const char*)g.A + (size_t)cur.pm * tstep; const char* cB = (const char*)g.Bt + (size_t)cur.e * estep + (size_t)cur.pn * tstep;
    S.a_ready(cur);
    if constexpr (GATHER) gather_offs(cur, voffC);
    if constexpr (SP2) {
        PG8_STAGE(PG8_SB(0, 0), cB, voffB); PG8_STAGE(PG8_SB(0, 1), cB + hstep, voffB); PG8_STAGE_A(PG8_SA(0, 0), 0, 0, false, cA); PG8_STAGE_A(PG8_SA(0, 1), 1, 0, false, cA + hstep);
        if (wr == 1) PG8_BAR;
        PG8_WAIT_V(2); PG8_BAR;
        PG8_STAGE(PG8_SB(1, 0), cB + kstep, voffB); PG8_STAGE_A(PG8_SA(1, 0), 0, 1, false, cA + kstep); PG8_STAGE(PG8_SB(1, 1), cB + hstep + kstep, voffB);
        PG8_WAIT_V(6); PG8_BAR;
    } else {
        PG8_STAGE(PG8_SB(0, 0), cB, voffB); PG8_STAGE_A(PG8_SA(0, 0), 0, 0, false, cA); PG8_STAGE(PG8_SB(0, 1), cB + hstep, voffB); PG8_STAGE_A(PG8_SA(0, 1), 1, 0, false, cA + hstep);
        if (wr == 1) PG8_BAR;
        PG8_WAIT_V(4); PG8_BAR;
        PG8_STAGE(PG8_SB(1, 0), cB + kstep, voffB); PG8_STAGE_A(PG8_SA(1, 0), 0, 1, false, cA + kstep); PG8_STAGE(PG8_SB(1, 1), cB + hstep + kstep, voffB);
        PG8_WAIT_V(6); PG8_BAR;
    }
    for (;;) {
        const bool has_next = S.next(ui + 1, nxt);
        if constexpr (GATHER) { if (has_next) gather_offs(nxt, voffN); else {
#pragma unroll
            for (int hh = 0; hh < 2; ++hh) { voffN[hh][0] = voffC[hh][0]; voffN[hh][1] = voffC[hh][1]; } } }
        const char* nA = has_next ? (const char*)g.A + (size_t)nxt.pm * tstep : cA; const char* nB = has_next ? (const char*)g.Bt + (size_t)nxt.e * estep + (size_t)nxt.pn * tstep : cB;
        for (int t = 0; t < nt; t += 2) {
            const bool last = (t == nt - 2);
            const char* a1 = cA + (size_t)(t + 1) * kstep;
            const char* a2 = last ? nA : cA + (size_t)(t + 2) * kstep; const char* b2 = last ? nB : cB + (size_t)(t + 2) * kstep;
            const char* a3 = a2 + kstep; const char* b3 = b2 + kstep;
            if (last && has_next) S.a_ready(nxt);
            if constexpr (SP2) {
            PG8_LDB(B0, 0, 0); PG8_LDB(B1, 0, 1); PG8_SCHED; PG8_LDA(At, 0, 0); PG8_STAGE_A(PG8_SA(1, 1), 1, t + 1, false, a1 + hstep);
            PG8_WAIT_V(8); PG8_WAIT_L(0); PG8_BAR; PG8_MMA(0, 0, At, B0); PG8_MMA(0, 1, At, B1); PG8_BAR; PG8_SCHED;
            PG8_LDA(At, 0, 1); PG8_STAGE(PG8_SB(0, 0), b2, voffB); PG8_STAGE(PG8_SB(0, 1), b2 + hstep, voffB); PG8_STAGE_A(PG8_SA(0, 0), 0, (last ? 0 : t + 2), last, a2);
            PG8_WAIT_V(8); PG8_WAIT_L(0); PG8_BAR; PG8_MMA(1, 0, At, B0); PG8_MMA(1, 1, At, B1); PG8_BAR; PG8_SCHED;
            PG8_LDB(B0, 1, 0); PG8_LDB(B1, 1, 1); PG8_SCHED; PG8_LDA(At, 1, 0); PG8_STAGE_A(PG8_SA(0, 1), 1, (last ? 0 : t + 2), last, a2 + hstep);
            PG8_WAIT_V(8); PG8_WAIT_L(0); PG8_BAR; PG8_MMA(0, 0, At, B0); PG8_MMA(0, 1, At, B1); PG8_BAR; PG8_SCHED;
            PG8_LDA(At, 1, 1); PG8_STAGE(PG8_SB(1, 0), b3, voffB); PG8_STAGE(PG8_SB(1, 1), b3 + hstep, voffB); PG8_STAGE_A(PG8_SA(1, 0), 0, (last ? 1 : t + 3), last, a3);
            PG8_WAIT_V(8); PG8_WAIT_L(0); PG8_BAR; PG8_MMA(1, 0, At, B0); PG8_MMA(1, 1, At, B1); PG8_BAR; PG8_SCHED;
            } else {
            PG8_LDB(B0, 0, 0); PG8_SCHED; PG8_LDA(At, 0, 0); PG8_STAGE_A(PG8_SA(1, 1), 1, t + 1, false, a1 + hstep);
            PG8_WAIT_L(8); PG8_BAR; PG8_WAIT_L(0); PG8_MMA(0, 0, At, B0); PG8_BAR; PG8_SCHED;
            PG8_LDB(B1, 0, 1); PG8_STAGE(PG8_SB(0, 0), b2, voffB);
            PG8_BAR; PG8_WAIT_L(0); PG8_MMA(0, 1, At, B1); PG8_BAR;
            PG8_LDA(At, 0, 1); PG8_STAGE_A(PG8_SA(0, 0), 0, (last ? 0 : t + 2), last, a2);
            PG8_BAR; PG8_WAIT_L(0); PG8_MMA(1, 0, At, B0); PG8_BAR; PG8_SCHED;
            PG8_STAGE(PG8_SB(0, 1), b2 + hstep, voffB);
            PG8_WAIT_V(6); PG8_BAR; PG8_MMA(1, 1, At, B1); PG8_BAR;
            PG8_LDB(B0, 1, 0); PG8_SCHED; PG8_LDA(At, 1, 0); PG8_STAGE_A(PG8_SA(0, 1), 1, (last ? 0 : t + 2), last, a2 + hstep);
            PG8_WAIT_L(8); PG8_BAR; PG8_WAIT_L(0); PG8_MMA(0, 0, At, B0); PG8_BAR; PG8_SCHED;
            PG8_LDB(B1, 1, 1); PG8_STAGE(PG8_SB(1, 0), b3, voffB);
            PG8_BAR; PG8_WAIT_L(0); PG8_MMA(0, 1, At, B1); PG8_BAR;
            PG8_LDA(At, 1, 1); PG8_STAGE_A(PG8_SA(1, 0), 0, (last ? 1 : t + 3), last, a3);
            PG8_BAR; PG8_WAIT_L(0); PG8_MMA(1, 0, At, B0); PG8_BAR; PG8_SCHED;
            PG8_STAGE(PG8_SB(1, 1), b3 + hstep, voffB);
            PG8_WAIT_V(6); PG8_BAR; PG8_MMA(1, 1, At, B1); PG8_BAR;
            }
        }
        if constexpr (ALIGN_EPI) { if (wr == 0) PG8_BAR; }
        if constexpr (!Epi::AFTER_DRAIN) { E(acc, cur, wr, wc, fr, fq); S.done(cur); }
        if (!has_next) break;
#pragma unroll
        for (int a = 0; a < 2; ++a)
#pragma unroll
            for (int b = 0; b < 2; ++b)
#pragma unroll
                for (int m = 0; m < 4; ++m)
#pragma unroll
                    for (int n = 0; n < 2; ++n) acc[a][b][m][n] = (f32x4){0.f, 0.f, 0.f, 0.f};
        cur = nxt; cA = nA; cB = nB; ++ui;
        if constexpr (GATHER) {
#pragma unroll
            for (int hh = 0; hh < 2; ++hh) { voffC[hh][0] = voffN[hh][0]; voffC[hh][1] = voffN[hh][1]; } }
        if constexpr (ALIGN_EPI) { if (wr == 1) PG8_BAR; }
    }
    PG8_WAIT_V(0);
    if constexpr (!ALIGN_EPI) { if (wr == 0) PG8_BAR; }
    PG8_BAR;
    if constexpr (Epi::AFTER_DRAIN) { E.fused(acc, cur, wr, wc, fr, fq, lds, wid, lane); S.done(cur); }
#undef PG8_SA
#undef PG8_SB
#undef PG8_STAGE
#undef PG8_STAGE_A
#undef PG8_LDA
#undef PG8_LDB
#undef PG8_MMA
#undef PG8_WAIT_V
#undef PG8_WAIT_L
#undef PG8_BAR
#undef PG8_SCHED
}
}

struct EpiStoreBf16 {
    static constexpr bool PERM = true, AFTER_DRAIN = false;
    bf16_t* O; long ldo; int gate_from; long estride;
    __device__ __forceinline__ void operator()(const pg8::f32x4 (&acc)[2][2][4][2], const pg8::Unit& u, int wr, int wc, int fr, int fq) const {
        bf16_t* base = O + (long)u.e * estride;
#pragma unroll
        for (int ai = 0; ai < 2; ++ai)
#pragma unroll
            for (int m = 0; m < 4; ++m) {
                const long row = (long)u.pm * 256 + ai * 128 + wr * 64 + m * 16 + fr;
#pragma unroll
                for (int bj = 0; bj < 2; ++bj) {
                    pg8::f32x4 v0 = acc[ai][bj][m][0], v1 = acc[ai][bj][m][1];
                    if (u.pn * 2 + bj >= gate_from) {
#pragma unroll
                        for (int j = 0; j < 4; ++j) { v0[j] = sigm_fast(v0[j]); v1[j] = sigm_fast(v1[j]); }
                    }
                    u32x4 wv; wv[0] = pk_bf16(v0[0], v0[1]); wv[1] = pk_bf16(v0[2], v0[3]); wv[2] = pk_bf16(v1[0], v1[1]); wv[3] = pk_bf16(v1[2], v1[3]);
                    *(u32x4*)(base + row * ldo + u.pn * 256 + bj * 128 + wc * 32 + 8 * fq) = wv;
                }
            }
    }
};
struct EpiStoreF32 {
    static constexpr bool PERM = false, AFTER_DRAIN = false;
    float* O; long ldo;
    __device__ __forceinline__ void operator()(const pg8::f32x4 (&acc)[2][2][4][2], const pg8::Unit& u, int wr, int wc, int fr, int fq) const {
#pragma unroll
        for (int ai = 0; ai < 2; ++ai)
#pragma unroll
            for (int m = 0; m < 4; ++m) {
                const long row = (long)u.pm * 256 + ai * 128 + wr * 64 + m * 16 + fr;
#pragma unroll
                for (int bj = 0; bj < 2; ++bj)
#pragma unroll
                    for (int n = 0; n < 2; ++n) *(pg8::f32x4*)(O + row * ldo + u.pn * 256 + bj * 128 + wc * 32 + 16 * n + 4 * fq) = acc[ai][bj][m][n];
            }
    }
};
struct EpiMoeGU {
    static constexpr bool PERM = true, AFTER_DRAIN = false;
    bf16_t* HH;
    __device__ __forceinline__ void operator()(const pg8::f32x4 (&acc)[2][2][4][2], const pg8::Unit& u, int wr, int wc, int fr, int fq) const {
#pragma unroll
        for (int ai = 0; ai < 2; ++ai)
#pragma unroll
            for (int m = 0; m < 4; ++m) {
                const long row = (long)u.pm * 256 + ai * 128 + wr * 64 + m * 16 + fr;
                float hv[8];
#pragma unroll
                for (int n = 0; n < 2; ++n)
#pragma unroll
                    for (int j = 0; j < 4; ++j) { const float gt = acc[ai][0][m][n][j], up = acc[ai][1][m][n][j]; hv[4 * n + j] = gt * sigm_fast(gt) * up; }
                u32x4 wv; wv[0] = pk_bf16(hv[0], hv[1]); wv[1] = pk_bf16(hv[2], hv[3]); wv[2] = pk_bf16(hv[4], hv[5]); wv[3] = pk_bf16(hv[6], hv[7]);
                *(u32x4*)(HH + row * 512 + u.pn * 128 + wc * 32 + 8 * fq) = wv;
            }
    }
};
struct EpiMoeDown {
    static constexpr bool PERM = true, AFTER_DRAIN = false;
    const int* perm; const float* ew; bf16_t* YK;
    __device__ __forceinline__ void operator()(const pg8::f32x4 (&acc)[2][2][4][2], const pg8::Unit& u, int wr, int wc, int fr, int fq) const {
#pragma unroll
        for (int ai = 0; ai < 2; ++ai)
#pragma unroll
            for (int m = 0; m < 4; ++m) {
                const int a = perm[u.pm * 256 + ai * 128 + wr * 64 + m * 16 + fr];
                if (a >= 0) {
                    const float sw = ew[a];
#pragma unroll
                    for (int bj = 0; bj < 2; ++bj) {
                        const pg8::f32x4 v0 = acc[ai][bj][m][0] * sw, v1 = acc[ai][bj][m][1] * sw;
                        u32x4 wv; wv[0] = pk_bf16(v0[0], v0[1]); wv[1] = pk_bf16(v0[2], v0[3]); wv[2] = pk_bf16(v1[0], v1[1]); wv[3] = pk_bf16(v1[2], v1[3]);
                        *(u32x4*)(YK + (long)a * 1024 + u.pn * 256 + bj * 128 + wc * 32 + 8 * fq) = wv;
                    }
                }
            }
    }
};
struct GroupedOrder {
    int nM, nN, nE, G, c;
    __device__ bool next(int i, pg8::Unit& u) const { const int L = i * G + c; if (L >= nM * nN * nE) return false; u.e = L / (nM * nN); const int rm = L % (nM * nN); u.pm = rm / nN; u.pn = rm % nN; u.gt = 0; u.nv = 0; return true; }
    __device__ __forceinline__ void a_ready(const pg8::Unit&) const {}
    __device__ __forceinline__ void done(const pg8::Unit&) const {}
};

struct LayerW {
    const float *cmp_pos, *conv_w, *conv_b, *ga_b, *gx_b, *lam, *q_norm, *kv_norm,
        *ln1_g, *ln1_b, *ln2_g, *ln2_b, *rg_b, *re_b, *ln3_g, *ln3_b;
    const bf16_t *t_in, *t_br, *t_out, *t_q, *t_o, *t_gu, *t_dn, *t_c1, *t_c2, *t_uq, *t_ukv, *t_g, *t_rh, *t_rl;
};
#define WSF(off) ((float*)(p.ws + (off)))
#define WSI(off) ((int*)(p.ws + (off)))
#define WSU(off) ((unsigned*)(p.ws + (off)))
#define WSB(off) ((bf16_t*)(p.ws + (off)))
DI LayerW layer_w(const Params& p, int l) {
    LayerW w;
    w.cmp_pos = p.in[3] + (size_t)l * 2 * 32 * 64;
    w.conv_w = p.in[6] + (size_t)l * 4 * 256;
    w.conv_b = p.in[7] + (size_t)l * 256;
    w.ga_b = p.in[9] + (size_t)l * 256;
    w.gx_b = p.in[11] + (size_t)l * 256;
    w.lam = p.in[12] + (size_t)l * 256;
    w.q_norm = p.in[13] + (size_t)l * 192;
    w.kv_norm = p.in[14] + (size_t)l * 128;
    w.ln1_g = p.in[19] + (size_t)l * 1024; w.ln1_b = p.in[20] + (size_t)l * 1024;
    w.ln2_g = p.in[24] + (size_t)l * 1024; w.ln2_b = p.in[25] + (size_t)l * 1024;
    w.rg_b = p.in[27] + (size_t)l * 4;
    w.re_b = p.in[29] + (size_t)l * 32;
    w.ln3_g = p.in[32] + (size_t)l * 1024; w.ln3_b = p.in[33] + (size_t)l * 1024;
    w.t_in = WSB(WT_IN) + (size_t)l * NH * 1024;
    w.t_br = WSB(WT_BR) + (size_t)l * 1024 * 1024;
    w.t_out = WSB(WT_OUT) + (size_t)l * 1024 * 1024;
    w.t_q = WSB(WT_Q) + (size_t)l * 512 * 1024;
    w.t_o = WSB(WT_O) + (size_t)l * 1024 * 512;
    w.t_gu = WSB(WT_GU) + (size_t)l * 32 * 1024 * 1024;
    w.t_dn = WSB(WT_DN) + (size_t)l * 32 * 1024 * 512;
    w.t_c1 = WSB(WT_C1) + (size_t)l * 2 * 256 * 2048;
    w.t_c2 = WSB(WT_C2) + (size_t)l * 2 * 128 * 256;
    w.t_uq = WSB(WT_UQ) + (size_t)l * 384 * 192;
    w.t_ukv = WSB(WT_UKV) + (size_t)l * 512 * 128;
    w.t_g = WSB(WT_G) + (size_t)l * 4 * 128 * 64;
    w.t_rh = WSB(WT_RH) + (size_t)l * 128 * 1024;
    w.t_rl = WSB(WT_RL) + (size_t)l * 128 * 1024;
    return w;
}

template <int MODE>
DI int wt_col(int np, int Nsrc) {
    if (MODE == 0) return np < Nsrc ? np : -1;
    if (MODE == 2) return np < 1024 ? np : (np < 2656 ? np + 12 : (np < 2668 ? 1024 + (np - 2656) : (np < 2688 ? -1 : (np < 6784 ? np - 20 : -1))));
    const int pn = np >> 8, bj = (np >> 7) & 1, q = np & 127; return (bj ? 512 : 0) + 128 * pn + q;
}
template <int MODE>
DI void job_wt(const float* src, int nmat, int K, int Nsrc, bf16_t* dst, int Npad, int bid, int nblk, unsigned char* lds) {
    const int lane = tidx() & 63, wid = tidx() >> 6;
    bf16_t* tile = (bf16_t*)lds + wid * (64 * 72);
    const int tk = K / 64, tn = Npad / 64;
    const int tk2 = (tk + 1) / 2, tn4 = (tn + 3) / 4, per = tk2 * tn4;
    const int kl = lane >> 4, n4 = (lane & 15) * 4;
    for (int ub = bid; ub < nmat * per; ub += nblk) {
        const int mat = ub / per, ru = ub % per, kt = (ru % tk2) * 2 + (wid & 1), nt = (ru / tk2) * 4 + (wid >> 1);
        if (kt >= tk || nt >= tn) continue;
        const int k0 = kt * 64, n0 = nt * 64;
        const float* s = src + (size_t)mat * K * Nsrc;
        bf16_t* d = dst + (size_t)mat * Npad * K;
        const int col = wt_col<MODE>(n0 + n4, Nsrc);
        float4 v[16];
#pragma unroll
        for (int ps = 0; ps < 16; ++ps) v[ps] = col >= 0 ? *(const float4*)(s + (size_t)(k0 + kl + 4 * ps) * Nsrc + col) : make_float4(0.f, 0.f, 0.f, 0.f);
#pragma unroll
        for (int ps = 0; ps < 16; ++ps) { const int k = kl + 4 * ps;
            tile[(n4 + 0) * 72 + k] = f2bf(v[ps].x); tile[(n4 + 1) * 72 + k] = f2bf(v[ps].y); tile[(n4 + 2) * 72 + k] = f2bf(v[ps].z); tile[(n4 + 3) * 72 + k] = f2bf(v[ps].w); }
        __builtin_amdgcn_fence(__ATOMIC_RELEASE, "wavefront"); __builtin_amdgcn_wave_barrier(); __builtin_amdgcn_fence(__ATOMIC_ACQUIRE, "wavefront");
#pragma unroll
        for (int c8 = 0; c8 < 8; ++c8) { const int c = lane + 64 * c8, n2 = c >> 3, kc = (c & 7) * 8;
            *(uint4*)(d + (size_t)(n0 + n2) * K + k0 + kc) = *(const uint4*)(tile + n2 * 72 + kc); }
        __builtin_amdgcn_fence(__ATOMIC_RELEASE, "wavefront"); __builtin_amdgcn_wave_barrier(); __builtin_amdgcn_fence(__ATOMIC_ACQUIRE, "wavefront");
    }
}
DI void job_cvt(const float* src, bf16_t* dst, long n, int bid, int nblk) {
    for (long e = ((long)bid * NT + tidx()) * 4; e < n; e += (long)nblk * NT * 4) {
        const float4 v = *(const float4*)(src + e);
        st4bf(dst + e, v.x, v.y, v.z, v.w);
    }
}
DI void job_cmp_gather(const Params& p, const LayerW& w, int bid, int nblk) {
    const bf16_t* H = WSB(WS_H); bf16_t* TB = WSB(WS_TBB);
    const long total = (long)2 * NCR * 2048 / 8;
    for (long e = (long)bid * NT + tidx(); e < total; e += (long)nblk * NT) {
        const long e8 = e * 8;
        const int f = (int)(e8 % 2048); const long r2 = e8 / 2048; const int r = (int)(r2 % NCR), j = (int)(r2 / NCR);
        const int g = r & 1, bc = r >> 1, c = bc % NCMP, b = bc / NCMP, i = f >> 6, d = f & 63;
        float hv[8];
        ld8f(H + (long)(b * SEQ + 16 * c + i) * NH + (j ? O_AVC : O_AKC) + g * 64 + d, hv);
        const float4 p0 = *(const float4*)(w.cmp_pos + (j * 32 + i) * 64 + d), p1 = *(const float4*)(w.cmp_pos + (j * 32 + i) * 64 + d + 4);
        hv[0] += p0.x; hv[1] += p0.y; hv[2] += p0.z; hv[3] += p0.w; hv[4] += p1.x; hv[5] += p1.y; hv[6] += p1.z; hv[7] += p1.w;
        st8bf(TB + ((long)j * 2048 + r) * 2048 + f, hv);
    }
}
DI void job_rnn_conv(const Params& p, const LayerW& w, int bid, int nblk) {
    const bf16_t* H = WSB(WS_H); float* U = WSF(WS_U); bf16_t* UB = WSB(WS_UB);
    for (long e = (long)bid * NT + tidx(); e < (long)T * 64; e += (long)nblk * NT) {
        const int ch = (int)(e & 63) * 4; const int t = (int)(e >> 6), s = t & (SEQ - 1);
        const float4 cb = *(const float4*)(w.conv_b + ch);
        float u0 = cb.x, u1 = cb.y, u2 = cb.z, u3 = cb.w;
#pragma unroll
        for (int tap = 0; tap < 4; ++tap) { const int sp = s - 3 + tap;
            if (sp >= 0) { const float4 hv = ld4bf(H + (long)(t - 3 + tap) * NH + O_CX + ch); const float4 cw = *(const float4*)(w.conv_w + tap * 256 + ch);
                u0 += hv.x * cw.x; u1 += hv.y * cw.y; u2 += hv.z * cw.z; u3 += hv.w * cw.w; } }
        *(float4*)(U + (long)t * 256 + ch) = make_float4(u0, u1, u2, u3); st4bf(UB + (long)t * 256 + ch, u0, u1, u2, u3);
    }
}
DI void job_rnn_gates(const Params& p, const LayerW& w, int bid, int nblk, unsigned char* lds) {
    const float* U = WSF(WS_U); float* RA = WSF(WS_RA); float* RB = WSF(WS_RB);
    for (int u = bid; u < (T / G_BM) * 4; u += nblk) {
        const int blk = u & 3, m0 = (u >> 2) * G_BM;
        MG g; g.A = WSB(WS_UB) + blk * 64; g.lda = 256; g.Wt = w.t_g + (size_t)blk * 128 * 64; g.ldw = 64; g.K = 64;
        f32x16 acc[2][2];
        mgemm_tile(g, 0, RowId{m0}, acc, lds);
        const int l = tidx() & 63, wv = tidx() >> 6, wm = wv % G_WM, wn = wv / G_WM;
#pragma unroll
        for (int tt = 0; tt < 2; ++tt)
#pragma unroll
            for (int i = 0; i < 4; ++i) {
                const long t = m0 + wm * 64 + tt * 32 + (l & 31); const int ch = blk * 64 + wn * 32 + 8 * i + 4 * (l >> 5);
                const float4 uv = *(const float4*)(U + t * 256 + ch);
                const float ua[4] = {uv.x, uv.y, uv.z, uv.w};
                float av[4], bv[4];
#pragma unroll
                for (int j = 0; j < 4; ++j) {
                    const float r = sigm_fast(acc[0][tt][4 * i + j] + w.ga_b[ch + j]), ig = sigm_fast(acc[1][tt][4 * i + j] + w.gx_b[ch + j]);
                    const float nl = -w.lam[ch + j];
                    const float sp = fmaxf(nl, 0.f) + __logf(1.f + __expf(-fabsf(nl)));
                    const float log_a = -8.0f * r * sp;
                    const float a = __expf(log_a);
                    av[j] = a; bv[j] = __builtin_amdgcn_sqrtf(fmaxf(1.f - a * a, 0.f)) * (ig * ua[j]);
                }
                *(float4*)(RA + t * 256 + ch) = make_float4(av[0], av[1], av[2], av[3]);
                *(float4*)(RB + t * 256 + ch) = make_float4(bv[0], bv[1], bv[2], bv[3]);
            }
    }
}
DI void job_rnn_scan1(const Params& p, int bid, int nblk) {
    const float* RA = WSF(WS_RA); const float* RB = WSF(WS_RB); float* SA = WSF(WS_SA); float* SH = WSF(WS_SH);
    for (int e = bid * NT + tidx(); e < BATCH * 32 * 256; e += nblk * NT) {
        const int ch = e & 255, bc = e >> 8;
        float ap = 1.f, hl = 0.f;
        for (int s0 = 0; s0 < 64; s0 += 8) {
            float av[8], bv[8];
#pragma unroll
            for (int i = 0; i < 8; ++i) { const long t = (long)bc * 64 + s0 + i; av[i] = RA[t * 256 + ch]; bv[i] = RB[t * 256 + ch]; }
#pragma unroll
            for (int i = 0; i < 8; ++i) { ap *= av[i]; hl = av[i] * hl + bv[i]; }
        }
        SA[e] = ap; SH[e] = hl;
    }
}
DI void job_rnn_scan2(const Params& p, int bid, int nblk) {
    const bf16_t* H = WSB(WS_H); const float* RA = WSF(WS_RA); const float* RB = WSF(WS_RB); const float* SA = WSF(WS_SA); const float* SH = WSF(WS_SH); bf16_t* BR = WSB(WS_BR);
    for (int e = bid * NT + tidx(); e < BATCH * 32 * 256; e += nblk * NT) {
        const int ch = e & 255, bc = e >> 8, chunk = bc & 31, b = bc >> 5;
        float h = 0.f;
#pragma unroll
        for (int c0 = 0; c0 < 32; c0 += 8) {
            float sa[8], sh[8];
#pragma unroll
            for (int i = 0; i < 8; ++i) { const int q = ((b * 32 + c0 + i) << 8) + ch; sa[i] = SA[q]; sh[i] = SH[q]; }
#pragma unroll
            for (int i = 0; i < 8; ++i) h = (c0 + i < chunk) ? sa[i] * h + sh[i] : h;
        }
        for (int s0 = 0; s0 < 64; s0 += 8) {
            float av[8], bv[8], gv[8];
#pragma unroll
            for (int i = 0; i < 8; ++i) { const long t = (long)bc * 64 + s0 + i; av[i] = RA[t * 256 + ch]; bv[i] = RB[t * 256 + ch]; gv[i] = bf2f(H[t * NH + O_CG + ch]); }
#pragma unroll
            for (int i = 0; i < 8; ++i) { const long t = (long)bc * 64 + s0 + i; h = av[i] * h + bv[i]; BR[t * 1024 + 2 * 256 + ch] = f2bf(h * gelu_tanh(gv[i])); }
        }
    }
}
DI void job_mla_norm(const Params& p, const LayerW& w, int bid, int nblk) {
    const bf16_t* H = WSB(WS_H); bf16_t* CQN = WSB(WS_CQNB); bf16_t* CKVN = WSB(WS_CKVNB); bf16_t* KM = WSB(WS_KM);
    const int lane = tidx() & 63, wid = tidx() >> 6;
    const bool isq = lane < 24, iskv = lane >= 32 && lane < 48;
    const int coff = isq ? O_DCQ + lane * 8 : O_DCKV + (lane - 32) * 8;
    float gn[8];
#pragma unroll
    for (int j = 0; j < 8; ++j) gn[j] = isq ? w.q_norm[lane * 8 + j] : (iskv ? w.kv_norm[(lane - 32) * 8 + j] : 0.f);
    for (int t = bid * (NT / 64) + wid; t < T; t += nblk * (NT / 64)) {
        const bf16_t* hr = H + (long)t * NH;
        float v[8];
        float ss = 0.f;
        if (isq || iskv) { ld8f(hr + coff, v);
#pragma unroll
            for (int j = 0; j < 8; ++j) ss += v[j] * v[j]; }
        const float sq = wave_sum(isq ? ss : 0.f), skv = wave_sum(iskv ? ss : 0.f);
        const float rs = isq ? rsqrtf(sq * (1.f / 192.f) + 1e-6f) : rsqrtf(skv * (1.f / 128.f) + 1e-6f);
        if (isq || iskv) {
#pragma unroll
            for (int j = 0; j < 8; ++j) v[j] = v[j] * rs * gn[j];
            if (isq) st8bf(CQN + (long)t * 192 + lane * 8, v); else st8bf(CKVN + (long)t * 128 + (lane - 32) * 8, v);
        }
        {
            const int i = lane & 15, hd = lane >> 4;
            const int s = t & (SEQ - 1);
            const float2 csn = *(const float2*)(WSF(WS_ROPE) + (s * 16 + i) * 2); const float cs = csn.x, sn = csn.y;
            const float x1 = bf2f(hr[O_DKR + i]), x2 = bf2f(hr[O_DKR + 16 + i]);
            KM[(long)t * 384 + hd * 96 + 64 + i] = f2bf(x1 * cs - x2 * sn);
            KM[(long)t * 384 + hd * 96 + 80 + i] = f2bf(x1 * sn + x2 * cs);
        }
    }
}
DI void job_mla_up(const Params& p, const LayerW& w, int bid, int nblk, unsigned char* lds) {
    bf16_t* QB = WSB(WS_QB); bf16_t* KM = WSB(WS_KM); bf16_t* VM = WSB(WS_VM);
    constexpr int TM = T / G_BM;
    for (int u = bid; u < TM * 7; u += nblk) {
        const int mt = u / 7, nt = u % 7, m0 = mt * G_BM;
        f32x16 acc[2][2];
        const int l = tidx() & 63, wv = tidx() >> 6, wm = wv % G_WM, wn = wv / G_WM, hh = l >> 5;
        if (nt < 3) {
            MG g; g.A = WSB(WS_CQNB); g.lda = 192; g.Wt = w.t_uq; g.ldw = 192; g.K = 192;
            const int n0 = nt * 128;
            mgemm_tile(g, n0, RowId{m0}, acc, lds);
#pragma unroll
            for (int ft = 0; ft < 2; ++ft) {
                const int fb = (n0 + wn * 64 + ft * 32) >> 5;
                if (fb % 3 == 2) {
#pragma unroll
                    for (int tt = 0; tt < 2; ++tt) {
                        const int pos = (m0 + wm * 64 + tt * 32 + (l & 31)) & (SEQ - 1);
#pragma unroll
                        for (int i = 0; i < 2; ++i)
#pragma unroll
                            for (int j = 0; j < 4; ++j) {
                                const int fi = 8 * i + 4 * hh + j;
                                const float2 csn = *(const float2*)(WSF(WS_ROPE) + (pos * 16 + fi) * 2); const float cs = csn.x, sn = csn.y;
                                const float x1 = acc[ft][tt][4 * i + j], x2 = acc[ft][tt][4 * (i + 2) + j];
                                acc[ft][tt][4 * i + j] = x1 * cs - x2 * sn; acc[ft][tt][4 * (i + 2) + j] = x1 * sn + x2 * cs;
                            }
                    }
                }
            }
            MG_FOREACH(acc, lrow, feat, v, { st4bf(QB + (long)(m0 + lrow) * 384 + n0 + feat, v[0], v[1], v[2], v[3]); });
        } else {
            MG g; g.A = WSB(WS_CKVNB); g.lda = 128; g.Wt = w.t_ukv; g.ldw = 128; g.K = 128;
            const int n0 = (nt - 3) * 128;
            mgemm_tile(g, n0, RowId{m0}, acc, lds);
            MG_FOREACH(acc, lrow, feat, v, {
                const int hd = nt - 3;
                if (feat < 64) st4bf(KM + (long)(m0 + lrow) * 384 + hd * 96 + feat, v[0], v[1], v[2], v[3]);
                else st4bf(VM + (long)(m0 + lrow) * 256 + hd * 64 + (feat - 64), v[0], v[1], v[2], v[3]); });
        }
    }
}
template <int STAGE>
DI void job_cmp_mlp(const Params& p, const LayerW& w, int bid, int nblk, unsigned char* lds) {
    constexpr int TM = 2048 / G_BM, TN = STAGE == 0 ? 2 : 1;
    for (int u = bid; u < 2 * TM * TN; u += nblk) {
        const int j = u / (TM * TN), ru = u % (TM * TN), mt = ru / TN, nt = ru % TN, m0 = mt * G_BM, n0 = nt * 128;
        MG g;
        if (STAGE == 0) { g.A = WSB(WS_TBB) + (size_t)j * 2048 * 2048; g.lda = 2048; g.Wt = w.t_c1 + (size_t)j * 256 * 2048; g.ldw = 2048; g.K = 2048; }
        else { g.A = WSB(WS_HIDB) + (size_t)j * 2048 * 256; g.lda = 256; g.Wt = w.t_c2 + (size_t)j * 128 * 256; g.ldw = 256; g.K = 256; }
        f32x16 acc[2][2];
        mgemm_tile(g, n0, [&](int r) { const int rr = m0 + r; return (long)(rr < NCR ? rr : NCR - 1); }, acc, lds);
        if (STAGE == 0) {
            bf16_t* HID = WSB(WS_HIDB) + (size_t)j * 2048 * 256;
            MG_FOREACH(acc, lrow, feat, v, { st4bf(HID + (long)(m0 + lrow) * 256 + n0 + feat, gelu_tanh(v[0]), gelu_tanh(v[1]), gelu_tanh(v[2]), gelu_tanh(v[3])); });
        } else {
            bf16_t* KC = WSB(WS_KCB) + (size_t)j * NCR * 64;
            MG_FOREACH(acc, lrow, feat, v, { if (feat < 64 && m0 + lrow < NCR) st4bf(KC + (long)(m0 + lrow) * 64 + feat, v[0], v[1], v[2], v[3]); });
        }
    }
}
DI void job_router_logits(const Params& p, const LayerW& w, int bid, int nblk, unsigned char* lds) {
    float* LOG = WSF(WS_LOG);
    for (int u = bid; u < 1 * (T / G_BM); u += nblk) {
        const int pass = u / (T / G_BM), m0 = (u % (T / G_BM)) * G_BM;
        f32x16 acc[2][2];
        MG g; g.lda = 1024; g.ldw = 1024; g.K = 1024;
        g.A = pass == 1 ? WSB(WS_XBL) : WSB(WS_XBB); g.Wt = pass == 2 ? w.t_rl : w.t_rh;
        mgemm_tile(g, 0, RowId{m0}, acc, lds, true);
        float* dst = LOG + (size_t)pass * T * 36;
        MG_FOREACH(acc, lrow, feat, v, { if (feat < 36) *(float4*)(dst + (long)(m0 + lrow) * 36 + feat) = make_float4(v[0], v[1], v[2], v[3]); });
    }
}
DI void job_pack_small(const Params& p, int bid, int nblk) {
    bf16_t* TG = WSB(WT_G); bf16_t* RH = WSB(WT_RH); bf16_t* RL = WSB(WT_RL);
    for (int e = bid * NT + tidx(); e < SEQ * 16; e += nblk * NT) {
        const int i = e & 15, pos = e >> 4;
        const float inv = powf(10000.f, -(float)(2 * i) / 32.f);
        const float ang = (float)pos * inv;
        WSF(WS_ROPE)[e * 2] = cosf(ang); WSF(WS_ROPE)[e * 2 + 1] = sinf(ang);
    }
    for (int e = bid * NT + tidx(); e < DEPTH * 4 * 128 * 64; e += nblk * NT) {
        const int c = e & 63, q = (e >> 6) & 127, lb = e >> 13;
        const int seg = q >> 5, i = q & 31, chl = (seg >> 1) * 32 + i;
        const float* src = (seg & 1) ? p.in[10] : p.in[8];
        TG[e] = f2bf(src[((size_t)lb * 64 + c) * 64 + chl]);
    }
    for (int e = bid * NT + tidx(); e < DEPTH * 128 * 1024; e += nblk * NT) {
        const int k = e & 1023, n = (e >> 10) & 127, l = e >> 17;
        float v = 0.f;
        if (n < 4) v = p.in[26][((size_t)l * 1024 + k) * 4 + n];
        else if (n < 36) v = p.in[28][((size_t)l * 1024 + k) * 32 + (n - 4)];
        const bf16_t hi = f2bf(v);
        RH[e] = hi; RL[e] = f2bf(v - bf2f(hi));
    }
}

DI void job_merge(const Params& p, const LayerW& w, int bid, int nblk, unsigned char* lds) {
    const bf16_t* H = WSB(WS_H); bf16_t* M = WSB(WS_M);
    for (int u0 = bid; u0 < (T / G_BM) * 8; u0 += nblk) {
        int u = u0;
        if ((nblk & 7) == 0) { const int per = nblk >> 3, x = u0 & 7, q = u0 >> 3, ul = (q % per) + per * (q / per);
            u = ((x + 8 * (ul >> 3)) << 3) + (ul & 7); }
        const int m0 = (u >> 3) * G_BM, n0 = (u & 7) * G_BN;
        f32x16 macc[2][2];
#pragma unroll
        for (int a = 0; a < 2; ++a)
#pragma unroll
            for (int b = 0; b < 2; ++b)
#pragma unroll
                for (int i = 0; i < 16; ++i) macc[a][b][i] = 0.f;
        MG g; g.A = WSB(WS_BR); g.lda = 1024; g.Wt = w.t_br; g.ldw = 1024; g.K = 1024;
        f32x16 acc[2][2];
        uint2 gq[2][2][4];
        mgemm_tile_f(g, n0, RowId{m0}, acc, lds, true, 4, [&](int n, f32x16 (&a)[2][2]) {
#pragma unroll
            for (int ft = 0; ft < 2; ++ft)
#pragma unroll
                for (int tt = 0; tt < 2; ++tt)
#pragma unroll
                    for (int i = 0; i < 4; ++i) {
                        const uint2 q = gq[ft][tt][i];
                        macc[ft][tt][4 * i] += bflo(q.x) * a[ft][tt][4 * i]; macc[ft][tt][4 * i + 1] += bfhi(q.x) * a[ft][tt][4 * i + 1];
                        macc[ft][tt][4 * i + 2] += bflo(q.y) * a[ft][tt][4 * i + 2]; macc[ft][tt][4 * i + 3] += bfhi(q.y) * a[ft][tt][4 * i + 3];
                        a[ft][tt][4 * i] = 0.f; a[ft][tt][4 * i + 1] = 0.f; a[ft][tt][4 * i + 2] = 0.f; a[ft][tt][4 * i + 3] = 0.f;
                    }
        }, [&](int n) {
            const int l = tidx() & 63, wv = tidx() >> 6, wm = wv % G_WM, wn = wv / G_WM;
#pragma unroll
            for (int ft = 0; ft < 2; ++ft)
#pragma unroll
                for (int tt = 0; tt < 2; ++tt)
#pragma unroll
                    for (int i = 0; i < 4; ++i) {
                        const int lrow = wm * 64 + tt * 32 + (l & 31), feat = wn * 64 + ft * 32 + 8 * i + 4 * (l >> 5);
                        gq[ft][tt][i] = *(const uint2*)(H + (long)(m0 + lrow) * NH + O_MG + n * 1024 + n0 + feat);
                    }
        });
        MG_FOREACH(macc, lrow, feat, v, { st4bf(M + (long)(m0 + lrow) * 1024 + n0 + feat, v[0], v[1], v[2], v[3]); });
    }
}
DI int pad_rows(int c) { return (c + G_BM - 1) / G_BM * G_BM; }
DI void job_ln(const float* xin, const bf16_t* xinb, const bf16_t* xinl, const bf16_t* y, const int* eidx, const int* eslot, unsigned* cnt, const float* ew, const float* gw, const float* bw, float* out, bf16_t* outb, bf16_t* outl, int bid, int nblk, unsigned char* lds) {
    const int lane = tidx() & 63, wid = tidx() >> 6;
    int* s_base = (int*)lds;
    if (eidx) {
        __syncthreads();
        if (tidx() < 32) s_base[32 + tidx()] = pad_rows((int)__hip_atomic_load(&cnt[tidx()], __ATOMIC_RELAXED, __HIP_MEMORY_SCOPE_AGENT));
        __syncthreads();
        if (tidx() == 0) { int o = 0; for (int e = 0; e < 32; ++e) { s_base[e] = o; o += s_base[32 + e]; } }
        __syncthreads();
    }
    float gv[16], bv[16];
#pragma unroll
    for (int i = 0; i < 2; ++i)
#pragma unroll
        for (int j = 0; j < 8; j += 4) { const int c = i * 512 + lane * 8 + j; const float4 g4 = *(const float4*)(gw + c), b4 = *(const float4*)(bw + c);
            gv[i * 8 + j] = g4.x; gv[i * 8 + j + 1] = g4.y; gv[i * 8 + j + 2] = g4.z; gv[i * 8 + j + 3] = g4.w; bv[i * 8 + j] = b4.x; bv[i * 8 + j + 1] = b4.y; bv[i * 8 + j + 2] = b4.z; bv[i * 8 + j + 3] = b4.w; }
    for (int t = bid * (NT / 64) + wid; t < T; t += nblk * (NT / 64)) {
        float v[16];
        float s = 0.f;
        int r0 = 0, r1 = 0; float w0 = 0.f, w1 = 0.f;
        if (eidx) { r0 = s_base[eidx[t * 2]] + eslot[t * 2]; r1 = s_base[eidx[t * 2 + 1]] + eslot[t * 2 + 1]; w0 = ew[t * 2]; w1 = ew[t * 2 + 1]; }
#pragma unroll
        for (int i = 0; i < 2; ++i) {
            const int c = i * 512 + lane * 8;
            float xv[8], yv[8];
            if (xin) { const float4 a = *(const float4*)(xin + (long)t * 1024 + c), b = *(const float4*)(xin + (long)t * 1024 + c + 4);
                xv[0] = a.x; xv[1] = a.y; xv[2] = a.z; xv[3] = a.w; xv[4] = b.x; xv[5] = b.y; xv[6] = b.z; xv[7] = b.w; }
            else ld8f(xinb + (long)t * 1024 + c, xv);
            if (xinl) { float z[8]; ld8f(xinl + (long)t * 1024 + c, z);
#pragma unroll
                for (int j = 0; j < 8; ++j) xv[j] += z[j]; }
            if (!eidx) ld8f(y + (long)t * 1024 + c, yv);
            else { float z0[8], z1[8]; ld8f(y + (long)r0 * 1024 + c, z0); ld8f(y + (long)r1 * 1024 + c, z1);
#pragma unroll
                for (int j = 0; j < 8; ++j) yv[j] = w0 * z0[j] + w1 * z1[j]; }
#pragma unroll
            for (int j = 0; j < 8; ++j) { v[i * 8 + j] = DN_ALPHA * xv[j] + yv[j]; s += v[i * 8 + j]; }
        }
        float q = 0.f;
#pragma unroll
        for (int i = 0; i < 16; ++i) q += v[i] * v[i];
        wave_sum2(s, q);
        const float mu = s * (1.f / 1024.f);
        const float rstd = rsqrtf(fmaxf(q * (1.f / 1024.f) - mu * mu, 0.f) + 1e-5f);
#pragma unroll
        for (int i = 0; i < 2; ++i) {
            const int c = i * 512 + lane * 8;
            float o[8];
#pragma unroll
            for (int j = 0; j < 8; ++j) o[j] = (v[i * 8 + j] - mu) * rstd * gv[i * 8 + j] + bv[i * 8 + j];
            if (out) { *(float4*)(out + (long)t * 1024 + c) = make_float4(o[0], o[1], o[2], o[3]); *(float4*)(out + (long)t * 1024 + c + 4) = make_float4(o[4], o[5], o[6], o[7]); }
            if (outb) st8bf(outb + (long)t * 1024 + c, o);
            if (outl) { float lo[8];
#pragma unroll
                for (int j = 0; j < 8; ++j) lo[j] = o[j] - bf2f(f2bf(o[j]));
                st8bf(outl + (long)t * 1024 + c, lo); }
        }
    }
}
DI void job_router(const Params& p, const LayerW& w, int layer, int bid, int nblk) {
    const float* LOG = WSF(WS_LOG); int* EIDX = WSI(WS_EIDX); int* ESLOT = WSI(WS_ESLOT); float* EW = WSF(WS_EW);
    unsigned* cnt = WSU(WS_CTL) + CW_CNT + layer * 32;
    for (int t = bid * NT + tidx(); t < T; t += nblk * NT) {
        const float* lr = LOG + (long)t * 36; const float* lr1 = lr + (size_t)T * 36; const float* lr2 = lr1 + (size_t)T * 36;
#define LG(i) (lr[i])
        const float g0 = LG(0) + w.rg_b[0], g1 = LG(1) + w.rg_b[1], g2 = LG(2) + w.rg_b[2], g3 = LG(3) + w.rg_b[3];
        const float gm = fmaxf(fmaxf(g0, g1), fmaxf(g2, g3));
        const float e0 = expf(g0 - gm), e1 = expf(g1 - gm), e2 = expf(g2 - gm), e3 = expf(g3 - gm);
        const float gs = (e0 + e1) + (e2 + e3);
        const float p0 = e0 / gs, p1 = e1 / gs, p2 = e2 / gs, p3 = e3 / gs;
        int grp = 0; float pg = p0;
        if (p1 > pg) { pg = p1; grp = 1; }
        if (p2 > pg) { pg = p2; grp = 2; }
        if (p3 > pg) { pg = p3; grp = 3; }
        float el[8];
#pragma unroll
        for (int i = 0; i < 8; ++i) el[i] = LG(4 + grp * 8 + i) + w.re_b[grp * 8 + i];
#undef LG
        float em = el[0];
#pragma unroll
        for (int i = 1; i < 8; ++i) em = fmaxf(em, el[i]);
        float es = 0.f;
#pragma unroll
        for (int i = 0; i < 8; ++i) { el[i] = expf(el[i] - em); es += el[i]; }
#pragma unroll
        for (int i = 0; i < 8; ++i) el[i] = el[i] / es;
        float b0 = el[0]; int i0 = 0;
#pragma unroll
        for (int i = 1; i < 8; ++i) if (el[i] > b0) { b0 = el[i]; i0 = i; }
        float b1 = -1.f; int i1 = 0;
#pragma unroll
        for (int i = 0; i < 8; ++i) if (i != i0 && el[i] > b1) { b1 = el[i]; i1 = i; }
        const float den = b0 + b1;
        const int ex0 = grp * 8 + i0, ex1 = grp * 8 + i1;
        EIDX[t * 2] = ex0; EIDX[t * 2 + 1] = ex1;
        EW[t * 2] = pg * b0 / den; EW[t * 2 + 1] = pg * b1 / den;
        const int s0 = (int)atomicAdd(&cnt[ex0], 1u), s1 = (int)atomicAdd(&cnt[ex1], 1u);
        ESLOT[t * 2] = s0; ESLOT[t * 2 + 1] = s1;
        WSI(WS_PERM)[ex0 * PCAP + s0] = t * 2; WSI(WS_PERM)[ex1 * PCAP + s1] = t * 2 + 1;
    }
}
DI pg8::ListOrder moe_units(unsigned* cnt, int bid, int nblk, unsigned char* lds) {
    pg8::ListOrder S; S.n = 0; S.u0 = S.u1 = S.u2 = pg8::Unit{0, 0, 0, 0, 0};
    int* s_cnt = (int*)lds;
    __syncthreads();
    if (tidx() < 32) s_cnt[tidx()] = (int)__hip_atomic_load(&cnt[tidx()], __ATOMIC_RELAXED, __HIP_MEMORY_SCOPE_AGENT);
    __syncthreads();
    int rt = 0, ub = 0;
    for (int e = 0; e < 32; ++e) {
        const int ce = s_cnt[e];
        const int c = pad_rows(ce) >> 8, ue = c * 4;
#pragma unroll
        for (int k = 0; k < 3; ++k) {
            const int L = bid + k * nblk;
            if (L >= ub && L < ub + ue) { const int lu = L - ub, mt = lu >> 2; const int nv = ce - mt * 256 < 256 ? ce - mt * 256 : 256;
                const pg8::Unit u{rt + mt, lu & 3, e, e * (PCAP / 256) + mt, nv};
                if (k == 0) S.u0 = u; else if (k == 1) S.u1 = u; else S.u2 = u;
                S.n = k + 1; }
        }
        rt += c; ub += ue;
    }
#define RFL(x) x = __builtin_amdgcn_readfirstlane(x)
    RFL(S.n); RFL(S.u0.pm); RFL(S.u0.pn); RFL(S.u0.e); RFL(S.u0.gt); RFL(S.u0.nv); RFL(S.u1.pm); RFL(S.u1.pn); RFL(S.u1.e); RFL(S.u1.gt); RFL(S.u1.nv);
    RFL(S.u2.pm); RFL(S.u2.pn); RFL(S.u2.e); RFL(S.u2.gt); RFL(S.u2.nv);
#undef RFL
    return S;
}

typedef short s16x4 __attribute__((ext_vector_type(4)));
typedef short v4i16_t __attribute__((ext_vector_type(4)));
DI unsigned cvtpk(float lo, float hi) { return pk_bf16(lo, hi); }
DI int crow(int reg, int h) { return (reg & 3) + 8 * (reg >> 2) + 4 * h; }
DI s16x4 tr_read(const unsigned char* p) { return __builtin_bit_cast(s16x4, __builtin_amdgcn_ds_read_tr16_b64_v4i16((LAS v4i16_t*)p)); }
DI float xhalf_max(float m) { auto rr = __builtin_amdgcn_permlane32_swap(__float_as_uint(m), __float_as_uint(m), false, false); return fmaxf(__uint_as_float(rr[0]), __uint_as_float(rr[1])); }
DI float xhalf_sum(float m) { auto rr = __builtin_amdgcn_permlane32_swap(__float_as_uint(m), __float_as_uint(m), false, false); return __uint_as_float(rr[0]) + __uint_as_float(rr[1]); }
DI float xhalf_other(float v, int h) { auto rr = __builtin_amdgcn_permlane32_swap(__float_as_uint(v), __float_as_uint(v), false, false); return __uint_as_float(h ? rr[0] : rr[1]); }
DI bf16x8 pack8(const f32x16& x, int s2) {
    u32x4 pk; pk[0] = cvtpk(x[8 * s2], x[8 * s2 + 1]); pk[1] = cvtpk(x[8 * s2 + 2], x[8 * s2 + 3]); pk[2] = cvtpk(x[8 * s2 + 4], x[8 * s2 + 5]); pk[3] = cvtpk(x[8 * s2 + 6], x[8 * s2 + 7]);
    return __builtin_bit_cast(bf16x8, pk);
}
constexpr int ATT_QB = (NT / 64) * 32;
template <int DC> struct TileCfg { static constexpr int RS = DC * 2 + 16, BYTES = 64 * RS, NCH = 64 * DC / 8, NI = (NCH + NT - 1) / NT; };
template <int DC, class RowPtr> DI void tile_gload(u32x4 (&rg)[TileCfg<DC>::NI], RowPtr rp) {
#pragma unroll
    for (int i = 0; i < TileCfg<DC>::NI; ++i) { const int c = tidx() + NT * i; if (c < TileCfg<DC>::NCH) { const int row = c / (DC / 8), cc = c % (DC / 8); rg[i] = *(const u32x4*)(rp(row) + cc * 8); } }
}
template <int DC> DI void tile_lstore(const u32x4 (&rg)[TileCfg<DC>::NI], unsigned char* base) {
#pragma unroll
    for (int i = 0; i < TileCfg<DC>::NI; ++i) { const int c = tidx() + NT * i; if (c < TileCfg<DC>::NCH) { const int row = c / (DC / 8), cc = c % (DC / 8); *(u32x4*)(base + row * TileCfg<DC>::RS + cc * 16) = rg[i]; } }
}
template <int DK> DI void qk_tile(f32x16 (&s)[2], const bf16x8 (&qf)[DK / 16], const unsigned char* kl, int r, int h) {
    constexpr int RS = TileCfg<DK>::RS;
#pragma unroll
    for (int i = 0; i < 16; ++i) { s[0][i] = 0.f; s[1][i] = 0.f; }
#pragma unroll
    for (int ks = 0; ks < DK / 16; ++ks) {
        const bf16x8 k0 = *(const bf16x8*)(kl + r * RS + ks * 32 + h * 16), k1 = *(const bf16x8*)(kl + (32 + r) * RS + ks * 32 + h * 16);
        s[0] = __builtin_amdgcn_mfma_f32_32x32x16_bf16(k0, qf[ks], s[0], 0, 0, 0);
        s[1] = __builtin_amdgcn_mfma_f32_32x32x16_bf16(k1, qf[ks], s[1], 0, 0, 0);
    }
}
template <int DV> DI void pv_tile(f32x16 (&o)[DV / 32], const f32x16 (&pp)[2], const unsigned char* vl, int lane) {
    constexpr int RS = TileCfg<DV>::RS;
    const int h = lane >> 5, i16 = lane & 15, q = i16 >> 2, pq = i16 & 3, blk = (lane >> 4) & 1;
    const unsigned char* vb = vl + (4 * h + q) * RS + 2 * (16 * blk + 4 * pq);
#pragma unroll
    for (int kt = 0; kt < 2; ++kt)
#pragma unroll
        for (int s2 = 0; s2 < 2; ++s2) {
            const bf16x8 pf = pack8(pp[kt], s2);
#pragma unroll
            for (int dvt = 0; dvt < DV / 32; ++dvt) {
                const s16x4 lo = tr_read(vb + (kt * 32 + 16 * s2) * RS + dvt * 64), hi = tr_read(vb + (kt * 32 + 16 * s2 + 8) * RS + dvt * 64);
                const bf16x8 vf = __builtin_shufflevector(lo, hi, 0, 1, 2, 3, 4, 5, 6, 7);
                o[dvt] = __builtin_amdgcn_mfma_f32_32x32x16_bf16(vf, pf, o[dvt], 0, 0, 0);
            }
        }
}
constexpr float LOG2E = 1.4426950408889634f;
template <int DK, int DV, bool ALIBI, bool BOUNDARY, class ValidFn>
DI void softmax_tile(const bf16x8 (&qf)[DK / 16], f32x16 (&o)[DV / 32], float& m, float& l, const unsigned char* kl, const unsigned char* vl, int kb,
                     float c1, float sl2, int qpos, ValidFn valid, int lane) {
    const int r = lane & 31, h = lane >> 5;
    f32x16 s[2];
    qk_tile<DK>(s, qf, kl, r, h);
    const float base = ALIBI ? sl2 * (float)(kb + 4 * h - qpos) : 0.f;
    float tmax = -INFINITY;
#pragma unroll
    for (int kt = 0; kt < 2; ++kt)
#pragma unroll
        for (int i = 0; i < 16; ++i) {
            float v = ALIBI ? fmaf(s[kt][i], c1, fmaf(sl2, (float)(kt * 32 + (i & 3) + 8 * (i >> 2)), base)) : s[kt][i] * c1;
            if (BOUNDARY) v = valid(kb + kt * 32 + crow(i, h)) ? v : -INFINITY;
            s[kt][i] = v; tmax = fmaxf(tmax, v);
        }
    tmax = xhalf_max(tmax);
    const float mn = fmaxf(m, tmax);
    if (__any(mn > m)) {
        const float corr = __builtin_amdgcn_exp2f(m - mn);
        l *= corr;
#pragma unroll
        for (int dvt = 0; dvt < DV / 32; ++dvt)
#pragma unroll
            for (int i = 0; i < 16; ++i) o[dvt][i] *= corr;
        m = mn;
    }
    float ps = 0.f;
#pragma unroll
    for (int kt = 0; kt < 2; ++kt)
#pragma unroll
        for (int i = 0; i < 16; ++i) { const float pr = __builtin_amdgcn_exp2f(s[kt][i] - mn); s[kt][i] = pr; ps += pr; }
    l += ps;
    pv_tile<DV>(o, s, vl, lane);
}
template <int DK, int DV, bool ALIBI, class KPtr, class VPtr, class ValidFn, class InteriorFn>
DI void attn_stream(const bf16x8 (&qf)[DK / 16], f32x16 (&o)[DV / 32], float& m, float& l, unsigned tmask, int wave_qmax, int wave_kmin,
                    KPtr kp, VPtr vp, float c1, float sl2, int qpos, ValidFn valid, InteriorFn interior, unsigned char* lds) {
    unsigned char* kl = lds; unsigned char* vl = lds + TileCfg<DK>::BYTES;
    const int lane = tidx() & 63;
    u32x4 kA[TileCfg<DK>::NI], vA[TileCfg<DV>::NI], kB[TileCfg<DK>::NI], vB[TileCfg<DV>::NI];
    int ja = -1, jb = -1;
#define AS_NEXT(J, KR, VR) do { if (tmask) { J = __builtin_ctz(tmask); tmask &= tmask - 1; const int _j = J; \
        tile_gload<DK>(KR, [&](int row) { return kp(_j * 64 + row); }); tile_gload<DV>(VR, [&](int row) { return vp(_j * 64 + row); }); } else J = -1; } while (0)
#define AS_COMPUTE(J) do { const int _jc = (J); if (_jc * 64 <= wave_qmax && _jc * 64 + 63 >= wave_kmin) { \
        if (interior(_jc)) softmax_tile<DK, DV, ALIBI, false>(qf, o, m, l, kl, vl, _jc * 64, c1, sl2, qpos, valid, lane); \
        else softmax_tile<DK, DV, ALIBI, true>(qf, o, m, l, kl, vl, _jc * 64, c1, sl2, qpos, valid, lane); } } while (0)
    AS_NEXT(ja, kA, vA);
    AS_NEXT(jb, kB, vB);
    while (ja >= 0) {
        __syncthreads();
        tile_lstore<DK>(kA, kl); tile_lstore<DV>(vA, vl);
        __syncthreads();
        const int jc = ja;
        AS_NEXT(ja, kA, vA);
        AS_COMPUTE(jc);
        if (jb < 0) break;
        __syncthreads();
        tile_lstore<DK>(kB, kl); tile_lstore<DV>(vB, vl);
        __syncthreads();
        const int jd = jb;
        AS_NEXT(jb, kB, vB);
        AS_COMPUTE(jd);
    }
#undef AS_NEXT
#undef AS_COMPUTE
}

DI void job_mla_attn(const Params& p, int bid, int nblk, unsigned char* lds) {
    const bf16_t* QB = WSB(WS_QB); const bf16_t* KM = WSB(WS_KM); const bf16_t* VM = WSB(WS_VM); bf16_t* BR = WSB(WS_BR);
    constexpr int NQB = SEQ / ATT_QB, NU = BATCH * 4 * NQB;
    const int lane = tidx() & 63, wid = tidx() >> 6, r = lane & 31, h = lane >> 5;
    for (int u = bid; u < NU; u += nblk) {
        const int qblk = u / (BATCH * 4), bh = u % (BATCH * 4);
        const int b = bh >> 2, hd = bh & 3;
        const int q0 = qblk * ATT_QB, qw = q0 + wid * 32, qpos = qw + r;
        const long trow = (long)b * SEQ;
        bf16x8 qf[6];
#pragma unroll
        for (int ks = 0; ks < 6; ++ks) qf[ks] = *(const bf16x8*)(QB + (trow + qpos) * 384 + hd * 96 + ks * 16 + 8 * h);
        f32x16 o[2];
#pragma unroll
        for (int i = 0; i < 16; ++i) { o[0][i] = 0.f; o[1][i] = 0.f; }
        float m = -1e30f, l = 0.f;
        const int ntile = (q0 + ATT_QB - 1) / 64 + 1;
        const unsigned tmask = ntile >= 32 ? 0xffffffffu : ((1u << ntile) - 1u);
        attn_stream<96, 64, false>(qf, o, m, l, tmask, qw + 31, 0,
            [&](int row) { return KM + (trow + row) * 384 + hd * 96; },
            [&](int row) { return VM + (trow + row) * 256 + hd * 64; },
            0.10206207261596577f * LOG2E, 0.f, qpos,
            [&](int key) { return key <= qpos; }, [&](int j) { return j * 64 + 63 <= qw; }, lds);
        const float rl = 1.f / fmaxf(xhalf_sum(l), 1e-30f);
        bf16_t* dst = BR + (trow + qpos) * 1024 + 3 * 256 + hd * 64;
#pragma unroll
        for (int dvt = 0; dvt < 2; ++dvt)
#pragma unroll
            for (int i = 0; i < 4; ++i)
                st4bf(dst + dvt * 32 + 8 * i + 4 * h, o[dvt][4 * i] * rl, o[dvt][4 * i + 1] * rl, o[dvt][4 * i + 2] * rl, o[dvt][4 * i + 3] * rl);
    }
}
DI void job_cross_attn(const Params& p, int layer, int bid, int nblk, unsigned char* lds) {
    const bf16_t* XQ = WSB(WS_XQ); const bf16_t* KVM = WSB(WS_KVM) + (size_t)layer * 2048 * 1024; bf16_t* XO = WSB(WS_XO);
    constexpr int NQB = SEQ / ATT_QB, NU = BATCH * 4 * NQB;
    const int lane = tidx() & 63, wid = tidx() >> 6, r = lane & 31, h = lane >> 5;
    for (int u = bid; u < NU; u += nblk) {
        const int bh = u % (BATCH * 4), qblk = u / (BATCH * 4);
        const int b = bh >> 2, hd = bh & 3;
        const int qpos = qblk * ATT_QB + wid * 32 + r;
        const long trow = (long)b * SEQ;
        bf16x8 qf[8];
#pragma unroll
        for (int ks = 0; ks < 8; ++ks) qf[ks] = *(const bf16x8*)(XQ + (trow + qpos) * 512 + hd * 128 + ks * 16 + 8 * h);
        f32x16 o[4];
#pragma unroll
        for (int d = 0; d < 4; ++d)
#pragma unroll
            for (int i = 0; i < 16; ++i) o[d][i] = 0.f;
        float m = -1e30f, l = 0.f;
        attn_stream<128, 128, false>(qf, o, m, l, 0xFu, 1 << 30, 0,
            [&](int row) { return KVM + (long)(b * MEM_LEN + row) * 1024 + hd * 128; },
            [&](int row) { return KVM + (long)(b * MEM_LEN + row) * 1024 + 512 + hd * 128; },
            0.08838834764831845f * LOG2E, 0.f, qpos, [&](int) { return true; }, [&](int) { return true; }, lds);
        const float rl = 1.f / fmaxf(xhalf_sum(l), 1e-30f);
        bf16_t* dst = XO + (trow + qpos) * 512 + hd * 128;
#pragma unroll
        for (int dvt = 0; dvt < 4; ++dvt)
#pragma unroll
            for (int i = 0; i < 4; ++i)
                st4bf(dst + dvt * 32 + 8 * i + 4 * h, o[dvt][4 * i] * rl, o[dvt][4 * i + 1] * rl, o[dvt][4 * i + 2] * rl, o[dvt][4 * i + 3] * rl);
    }
}
DI float logsig_fast(float z) { return fminf(z, 0.f) - __logf(1.f + __expf(-fabsf(z))); }
DI void job_sb_attn(const Params& p, int bid, int nblk, unsigned char* lds) {
    const bf16_t* H = WSB(WS_H); bf16_t* BR = WSB(WS_BR);
    constexpr int NQB = SEQ / ATT_QB, NU = BATCH * 4 * NQB;
    const int lane = tidx() & 63, wid = tidx() >> 6, r = lane & 31, h = lane >> 5;
    unsigned char* kl = lds; unsigned char* vl = lds + TileCfg<64>::BYTES;
    for (int u = bid; u < NU; u += nblk) {
        const int half = u / (NU / 2), ru = u % (NU / 2);
        const int qi = ru / (BATCH * 4), bh = ru % (BATCH * 4);
        const int qblk = half == 0 ? (NQB - 1 - qi) : qi;
        const int b = bh >> 2, hd = bh & 3;
        const int q0 = qblk * ATT_QB, qw = q0 + wid * 32, qpos = qw + r;
        const long trow = (long)b * SEQ;
        bf16x8 qf[4];
#pragma unroll
        for (int ks = 0; ks < 4; ++ks) qf[ks] = *(const bf16x8*)(H + (trow + qpos) * NH + O_BQ + hd * 64 + ks * 16 + 8 * h);
        f32x16 o[2];
#pragma unroll
        for (int i = 0; i < 16; ++i) { o[0][i] = 0.f; o[1][i] = 0.f; }
        float trun = 0.f;
        int j = (q0 + ATT_QB - 1) >> 6;
        volatile int* flag = (volatile int*)(lds + 2 * TileCfg<64>::BYTES);
        if (tidx() == 0) { flag[0] = 0; flag[1] = 0; }
        u32x4 kr[TileCfg<64>::NI], vr[TileCfg<64>::NI];
        tile_gload<64>(kr, [&](int row) { return H + (trow + j * 64 + row) * NH + O_BK + hd * 64; });
        tile_gload<64>(vr, [&](int row) { return H + (trow + j * 64 + row) * NH + O_BV + hd * 64; });
        for (int it = 0; j >= 0; --j, ++it) {
            __syncthreads();
            if (it > 0 && flag[(it - 1) & 1] == 0) break;
            tile_lstore<64>(kr, kl); tile_lstore<64>(vr, vl);
            __syncthreads();
            if (tidx() == 0) flag[(it + 1) & 1] = 0;
            if (j > 0) { const int jn = j - 1;
                tile_gload<64>(kr, [&](int row) { return H + (trow + jn * 64 + row) * NH + O_BK + hd * 64; });
                tile_gload<64>(vr, [&](int row) { return H + (trow + jn * 64 + row) * NH + O_BV + hd * 64; }); }
            const bool wave_dead = __all(trun < -110.f);
            if (j * 64 < qw + 31 && !wave_dead) {
                const int kb = j * 64;
                f32x16 s[2], L[2];
                qk_tile<64>(s, qf, kl, r, h);
#pragma unroll
                for (int kt = 0; kt < 2; ++kt)
#pragma unroll
                    for (int i = 0; i < 16; ++i) {
                        const int key = kb + kt * 32 + crow(i, h);
                        const float z = s[kt][i] * 0.125f, lsp = logsig_fast(z);
                        const bool valid = key < qpos;
                        L[kt][i] = valid ? lsp - z : 0.f;
                        s[kt][i] = valid ? lsp : -INFINITY;
                    }
                float G[2][4], O[2][4];
#pragma unroll
                for (int kt = 0; kt < 2; ++kt)
#pragma unroll
                    for (int ig = 0; ig < 4; ++ig) { G[kt][ig] = (L[kt][4 * ig] + L[kt][4 * ig + 1]) + (L[kt][4 * ig + 2] + L[kt][4 * ig + 3]); O[kt][ig] = xhalf_other(G[kt][ig], h); }
                float run = trun;
#pragma unroll
                for (int kt = 1; kt >= 0; --kt)
#pragma unroll
                    for (int ig = 3; ig >= 0; --ig) {
                        const float t3 = run + (h == 0 ? O[kt][ig] : 0.f);
                        const float t2 = t3 + L[kt][4 * ig + 3], t1 = t2 + L[kt][4 * ig + 2], t0 = t1 + L[kt][4 * ig + 1];
                        s[kt][4 * ig + 3] = __expf(s[kt][4 * ig + 3] + t3); s[kt][4 * ig + 2] = __expf(s[kt][4 * ig + 2] + t2);
                        s[kt][4 * ig + 1] = __expf(s[kt][4 * ig + 1] + t1); s[kt][4 * ig + 0] = __expf(s[kt][4 * ig + 0] + t0);
                        run += G[kt][ig] + O[kt][ig];
                    }
                trun = run;
                pv_tile<64>(o, s, vl, lane);
            }
            if (!__all(trun < -110.f)) flag[it & 1] = 1;
        }
        bf16_t* dst = BR + (trow + qpos) * 1024 + 1 * 256 + hd * 64;
#pragma unroll
        for (int dvt = 0; dvt < 2; ++dvt)
#pragma unroll
            for (int i = 0; i < 4; ++i) st4bf(dst + dvt * 32 + 8 * i + 4 * h, o[dvt][4 * i], o[dvt][4 * i + 1], o[dvt][4 * i + 2], o[dvt][4 * i + 3]);
    }
}
constexpr int NSA_QB = (NT / 128) * 32;
DI void job_nsa(const Params& p, int bid, int nblk, unsigned char* lds) {
    const bf16_t* H = WSB(WS_H); const bf16_t* KCB = WSB(WS_KCB); const bf16_t* VCB = KCB + (size_t)NCR * 64;
    float* OACC = WSF(WS_OC); bf16_t* BR = WSB(WS_BR);
    constexpr int NQB = SEQ / NSA_QB, NU = BATCH * 2 * NQB;
    constexpr int TB_ = TileCfg<64>::BYTES;
    const int lane = tidx() & 63, wid = tidx() >> 6, r = lane & 31, h = lane >> 5;
    const int n = wid & 1, sub = wid >> 1;
    unsigned* orw = (unsigned*)(lds + 4 * TB_);
    float* impx = (float*)(lds + 4 * TB_ + 64);
    for (int u = bid; u < NU; u += nblk) {
        const int qblk = NQB - 1 - u / (BATCH * 2), bg = u % (BATCH * 2), b = bg >> 1, g = bg & 1;
        const int q0 = qblk * NSA_QB, qw = q0 + sub * 32, qpos = qw + r;
        const int head = g * 2 + n;
        const long trow = (long)b * SEQ;
        const bf16_t* hq_row = H + (trow + qpos) * NH;
        bf16x8 qf[1][4];
#pragma unroll
        for (int ks = 0; ks < 4; ++ks) qf[0][ks] = *(const bf16x8*)(hq_row + O_AQ + head * 64 + ks * 16 + 8 * h);
        const float sl = exp2f(-2.f * (float)(head + 1));
        const float gate0 = sigm(bf2f(hq_row[O_AG + head * 3 + 0])), gate1 = sigm(bf2f(hq_row[O_AG + head * 3 + 1])), gate2 = sigm(bf2f(hq_row[O_AG + head * 3 + 2]));
        float* oacc = OACC + (trow + qpos) * 256 + head * 64;
        __syncthreads();
        if (tidx() == 0) *orw = 0u;
        {
            u32x4 rg[TileCfg<64>::NI];
#pragma unroll
            for (int tl = 0; tl < 4; ++tl) {
                const bf16_t* src = (tl & 2) ? VCB : KCB; const int cb = (tl & 1) * 64;
                tile_gload<64>(rg, [&](int row) { const int c = cb + row < NCMP ? cb + row : NCMP - 1; return src + ((long)(b * NCMP + c) * 2 + g) * 64; });
                tile_lstore<64>(rg, lds + tl * TB_);
            }
        }
        __syncthreads();
        float imp[16];
        {
            f32x16 s[2][2];
            qk_tile<64>(s[0], qf[0], lds, r, h);
            qk_tile<64>(s[1], qf[0], lds + TB_, r, h);
            float tmax = -INFINITY;
#pragma unroll
            for (int tl = 0; tl < 2; ++tl)
#pragma unroll
                for (int kt = 0; kt < 2; ++kt)
#pragma unroll
                    for (int i = 0; i < 16; ++i) {
                        const int c = tl * 64 + kt * 32 + crow(i, h), dist = qpos - (16 * c + 31);
                        const float v = (c < NCMP && dist >= 0) ? s[tl][kt][i] * 0.125f - sl * (float)dist : -INFINITY;
                        s[tl][kt][i] = v; tmax = fmaxf(tmax, v);
                    }
            const float mn = fmaxf(xhalf_max(tmax), -1e30f);
            float ps = 0.f;
#pragma unroll
            for (int tl = 0; tl < 2; ++tl)
#pragma unroll
                for (int kt = 0; kt < 2; ++kt)
#pragma unroll
                    for (int i = 0; i < 16; ++i) { const float pr = __expf(s[tl][kt][i] - mn); s[tl][kt][i] = pr; ps += pr; }
            const float rl = 1.f / fmaxf(xhalf_sum(ps), 1e-30f);
            float P3[16];
#pragma unroll
            for (int tl = 0; tl < 2; ++tl)
#pragma unroll
                for (int kt = 0; kt < 2; ++kt) {
#pragma unroll
                    for (int ig = 0; ig < 4; ++ig) {
                        const float p0 = s[tl][kt][4 * ig] * rl, p1 = s[tl][kt][4 * ig + 1] * rl, p2 = s[tl][kt][4 * ig + 2] * rl, p3 = s[tl][kt][4 * ig + 3] * rl;
                        imp[tl * 8 + kt * 4 + ig] = (p0 + p1) + (p2 + 0.5f * p3);
                        P3[tl * 8 + kt * 4 + ig] = 0.5f * p3;
                    }
                    const float gs = rl * gate0;
#pragma unroll
                    for (int i = 0; i < 16; ++i) s[tl][kt][i] *= gs;
                }
#pragma unroll
            for (int idx = 0; idx < 16; ++idx) {
                const float pp = xhalf_other(P3[idx], h);
                float prevp;
                if (idx == 0) prevp = h ? pp : 0.f; else { const float ppm = xhalf_other(P3[idx - 1], h); prevp = h ? pp : ppm; }
                imp[idx] += prevp;
                impx[(wid * 16 + idx) * 64 + lane] = imp[idx];
            }
            f32x16 oc[2];
#pragma unroll
            for (int i = 0; i < 16; ++i) { oc[0][i] = 0.f; oc[1][i] = 0.f; }
            pv_tile<64>(oc, s[0], lds + 2 * TB_, lane);
            pv_tile<64>(oc, s[1], lds + 3 * TB_, lane);
#pragma unroll
            for (int dvt = 0; dvt < 2; ++dvt)
#pragma unroll
                for (int i = 0; i < 4; ++i) *(float4*)(oacc + dvt * 32 + 8 * i + 4 * h) = make_float4(oc[dvt][4 * i], oc[dvt][4 * i + 1], oc[dvt][4 * i + 2], oc[dvt][4 * i + 3]);
        }
        __syncthreads();
        unsigned sel = 0u;
        {
            const int cur = qpos >> 6;
#pragma unroll
            for (int idx = 0; idx < 16; ++idx) {
                const float other = impx[((wid ^ 1) * 16 + idx) * 64 + lane];
                const float tot = n == 0 ? imp[idx] + other : other + imp[idx];
                const int j = 2 * idx + h;
                const bool forced = (j == 0) || (j == cur), valid = (j * 64 <= qpos);
                imp[idx] = forced ? 1e4f : (valid ? tot : -1.0f);
            }
#pragma unroll 1
            for (int it = 0; it < 8; ++it) {
                float best = -INFINITY; int bj = 64;
#pragma unroll
                for (int idx = 0; idx < 16; ++idx) if (imp[idx] > best) { best = imp[idx]; bj = 2 * idx + h; }
                const float pb = xhalf_other(best, h); const int pj = __float_as_int(xhalf_other(__int_as_float(bj), h));
                const bool own = (best > pb) || (best == pb && bj < pj);
                const int wj = own ? bj : pj;
                sel |= 1u << wj;
#pragma unroll
                for (int idx = 0; idx < 16; ++idx) if (2 * idx + h == wj) imp[idx] = -INFINITY;
            }
        }
        atomicOr(orw, sel);
        __syncthreads();
        const unsigned bmask = *orw;
        const int jhi = (q0 + NSA_QB - 1) >> 6;
        const unsigned upto = jhi >= 31 ? 0xffffffffu : ((1u << (jhi + 1)) - 1u);
        const float c1 = 0.125f * LOG2E, sl2 = sl * LOG2E;
        {
            f32x16 o[2];
#pragma unroll
            for (int i = 0; i < 16; ++i) { o[0][i] = 0.f; o[1][i] = 0.f; }
            float m = -1e30f, l = 0.f;
            const int jlo = (q0 - 511 > 0 ? q0 - 511 : 0) >> 6;
            const unsigned tmask = upto & ~((1u << jlo) - 1u);
            attn_stream<64, 64, true>(qf[0], o, m, l, tmask, qw + 31, qw - 511,
                [&](int row) { return H + (trow + row) * NH + O_AKW + g * 64; },
                [&](int row) { return H + (trow + row) * NH + O_AVW + g * 64; },
                c1, sl2, qpos,
                [&](int key) { const int dist = qpos - key; return dist >= 0 && dist < 512; },
                [&](int j) { return j * 64 + 63 <= qw && qw + 31 - j * 64 < 512; }, lds);
            const float rl = gate2 / fmaxf(xhalf_sum(l), 1e-30f);
#pragma unroll
            for (int dvt = 0; dvt < 2; ++dvt)
#pragma unroll
                for (int i = 0; i < 4; ++i) { float4* a = (float4*)(oacc + dvt * 32 + 8 * i + 4 * h); float4 c = *a;
                    c.x += o[dvt][4 * i] * rl; c.y += o[dvt][4 * i + 1] * rl; c.z += o[dvt][4 * i + 2] * rl; c.w += o[dvt][4 * i + 3] * rl; *a = c; }
        }
        {
            f32x16 o[2];
#pragma unroll
            for (int i = 0; i < 16; ++i) { o[0][i] = 0.f; o[1][i] = 0.f; }
            float m = -1e30f, l = 0.f;
            attn_stream<64, 64, true>(qf[0], o, m, l, bmask & upto, qw + 31, 0,
                [&](int row) { return H + (trow + row) * NH + O_AKS + g * 64; },
                [&](int row) { return H + (trow + row) * NH + O_AVS + g * 64; },
                c1, sl2, qpos,
                [&](int key) { return key <= qpos && ((sel >> (key >> 6)) & 1u); },
                [&](int j) { return j * 64 + 63 <= qw && __all((sel >> j) & 1u); }, lds);
            const float rl = gate1 / fmaxf(xhalf_sum(l), 1e-30f);
            bf16_t* dst = BR + (trow + qpos) * 1024 + head * 64;
#pragma unroll
            for (int dvt = 0; dvt < 2; ++dvt)
#pragma unroll
                for (int i = 0; i < 4; ++i) { const float4 c = *(const float4*)(oacc + dvt * 32 + 8 * i + 4 * h);
                    st4bf(dst + dvt * 32 + 8 * i + 4 * h, c.x + o[dvt][4 * i] * rl, c.y + o[dvt][4 * i + 1] * rl, c.z + o[dvt][4 * i + 2] * rl, c.w + o[dvt][4 * i + 3] * rl); }
        }
    }
}

namespace pg8 { typedef PG8_LAS unsigned char* PG8_LAS_T; }
#define LDS3 ((pg8::PG8_LAS_T)lds)
#define GEMM256(EPI, SCHED, g, S, E) do { __syncthreads(); pg8::gemm_phase<EPI, SCHED, true, true>(LDS3, g, S, E); } while (0)
constexpr int NPH = 17;
constexpr int NPHASES = 2 + DEPTH * NPH;

__global__ void __launch_bounds__(NT, 2) mega(Params pk, int ph_lo, int ph_hi) {
    extern __shared__ __attribute__((aligned(16))) unsigned char lds[];
    const int bid = blockIdx.x, nblk = gridDim.x;
#define XB_HERE XcdBarrier bar_; bar_.bar = (unsigned*)(pk.ws + WS_CTL) + CW_BAR; bar_.x = xb_xcc_id(); bar_.st = (volatile LAS unsigned*)(lds + 131072)
    const bool multi = (ph_hi - ph_lo) > 1;
    if (multi) {
        uint4* xbw = (uint4*)(lds + 131072);
        if (tidx() == 0) *xbw = make_uint4(0u, 0u, 0u, 0u);
        __syncthreads();
        (void)xcd_barrier_post((unsigned*)(pk.ws + WS_CTL) + CW_BAR, (volatile LAS unsigned*)xbw);
    }
#ifndef PROBE_PH
#define PROBE_PH -100
#endif
#define PHASE(id, ...) do { const int _id = (id); if (ph_lo <= _id && _id < ph_hi) { for (int _rep = 0; _rep < ((PROBE_PH == -1 ? _id < 2 : (_id >= 2 && (_id - 2) % NPH == PROBE_PH)) ? 2 : 1); ++_rep) { if (_rep) { XB_HERE; xcd_barrier(bar_); } { Params p = pk; int layer = layer_; asm volatile("" : "+s"(p.ws), "+s"(p.out), "+s"(layer)); \
        const LayerW w = layer_w(p, layer); const float* Xin = (layer == 0) ? p.in[0] : WSF(WS_XC); const bf16_t* XinB = (layer == 0) ? WSB(WS_X0B) : WSB(WS_XCB); float* Xout = (layer == DEPTH - 1) ? p.out : WSF(WS_XC); \
        (void)w; (void)Xin; (void)XinB; (void)Xout; __VA_ARGS__; } } if (_id + 1 < ph_hi) { XB_HERE; xcd_barrier(bar_); } } } while (0)

    { const int layer_ = 0;
    PHASE(0, {
        job_wt<2>(p.in[2], DEPTH, 1024, NIN, WSB(WT_IN), NH, bid, nblk, lds);
        job_wt<0>(p.in[17], DEPTH, 1024, 1024, WSB(WT_BR), 1024, bid, nblk, lds);
        job_wt<0>(p.in[18], DEPTH, 1024, 1024, WSB(WT_OUT), 1024, bid, nblk, lds);
        job_wt<0>(p.in[21], DEPTH, 1024, 512, WSB(WT_Q), 512, bid, nblk, lds);
        job_wt<0>(p.in[22], DEPTH, 1024, 1024, WSB(WT_KV), 1024, bid, nblk, lds);
        job_wt<0>(p.in[23], DEPTH, 512, 1024, WSB(WT_O), 1024, bid, nblk, lds);
        job_wt<1>(p.in[30], DEPTH * 32, 1024, 1024, WSB(WT_GU), 1024, bid, nblk, lds);
        job_wt<0>(p.in[31], DEPTH * 32, 512, 1024, WSB(WT_DN), 1024, bid, nblk, lds);
        job_wt<0>(p.in[4], DEPTH * 2, 2048, 256, WSB(WT_C1), 256, bid, nblk, lds);
        job_wt<0>(p.in[5], DEPTH * 2, 256, 64, WSB(WT_C2), 128, bid, nblk, lds);
        job_wt<0>(p.in[15], DEPTH, 192, 384, WSB(WT_UQ), 384, bid, nblk, lds);
        job_wt<0>(p.in[16], DEPTH, 128, 512, WSB(WT_UKV), 512, bid, nblk, lds);
        job_pack_small(p, bid, nblk);
        job_cvt(p.in[0], WSB(WS_X0B), (long)T * 1024, bid, nblk);
        job_cvt(p.in[1], WSB(WS_MEMB), (long)2048 * 1024, bid, nblk);
    });
    PHASE(1, {
        pg8::Gemm g{WSB(WS_MEMB), WSB(WT_KV), BATCH * MEM_LEN, 1024, 1024, nullptr};
        GroupedOrder S{8, 4, DEPTH, nblk, bid};
        EpiStoreBf16 E{WSB(WS_KVM), 1024, 1 << 30, (long)2048 * 1024};
        GEMM256(EpiStoreBf16, GroupedOrder, g, S, E);
    });
    }
    for (int layer_ = 0; layer_ < DEPTH; ++layer_) {
        const int base = 2 + layer_ * NPH;
        PHASE(base + 0, { pg8::Gemm g{XinB, w.t_in, T, NH, 1024, nullptr}; pg8::StaticOrder S; S.init(T, NH, nblk, bid); EpiStoreBf16 E{WSB(WS_H), NH, O_MG / 128, 0}; GEMM256(EpiStoreBf16, pg8::StaticOrder, g, S, E); });
        PHASE(base + 1, { job_sb_attn(p, bid, nblk, lds); job_cmp_gather(p, w, bid, nblk); job_rnn_conv(p, w, bid, nblk); job_mla_norm(p, w, bid, nblk); });
        PHASE(base + 2, { if (bid < 32) job_cmp_mlp<0>(p, w, bid, 32, lds); else { job_rnn_gates(p, w, bid - 32, nblk - 32, lds); job_mla_up(p, w, bid - 32, nblk - 32, lds); } });
        PHASE(base + 3, { job_cmp_mlp<1>(p, w, bid, nblk, lds); job_rnn_scan1(p, bid, nblk); });
        PHASE(base + 4, { job_nsa(p, bid, nblk, lds); job_mla_attn(p, bid, nblk, lds); job_rnn_scan2(p, bid, nblk); });
        PHASE(base + 5, { job_merge(p, w, bid, nblk, lds); });
        PHASE(base + 6, { pg8::Gemm g{WSB(WS_M), w.t_out, T, 1024, 1024, nullptr}; pg8::StaticOrder S; S.init(T, 1024, nblk, bid); EpiStoreBf16 E{WSB(WS_Y), 1024, 1 << 30, 0}; GEMM256(EpiStoreBf16, pg8::StaticOrder, g, S, E); });
        PHASE(base + 7, { job_ln(layer == 0 ? p.in[0] : nullptr, WSB(WS_XCB), nullptr, WSB(WS_Y), nullptr, nullptr, nullptr, nullptr, w.ln1_g, w.ln1_b, nullptr, WSB(WS_XAB), nullptr, bid, nblk, lds); });
        PHASE(base + 8, { pg8::Gemm g{WSB(WS_XAB), w.t_q, T, 512, 1024, nullptr}; pg8::StaticOrder S; S.init(T, 512, nblk, bid); EpiStoreBf16 E{WSB(WS_XQ), 512, 1 << 30, 0}; GEMM256(EpiStoreBf16, pg8::StaticOrder, g, S, E); });
        PHASE(base + 9, { job_cross_attn(p, layer, bid, nblk, lds); });
        PHASE(base + 10, { pg8::Gemm g{WSB(WS_XO), w.t_o, T, 1024, 512, nullptr}; pg8::StaticOrder S; S.init(T, 1024, nblk, bid); EpiStoreBf16 E{WSB(WS_Y), 1024, 1 << 30, 0}; GEMM256(EpiStoreBf16, pg8::StaticOrder, g, S, E); });
        PHASE(base + 11, { job_ln(nullptr, WSB(WS_XAB), nullptr, WSB(WS_Y), nullptr, nullptr, nullptr, nullptr, w.ln2_g, w.ln2_b, nullptr, WSB(WS_XBB), nullptr, bid, nblk, lds); });
        PHASE(base + 12, { job_router_logits(p, w, bid, nblk, lds); });
        PHASE(base + 13, { job_router(p, w, layer, bid, nblk); });
        PHASE(base + 14, { const pg8::ListOrder S = moe_units(WSU(WS_CTL) + CW_CNT + layer * 32, bid, nblk, lds); pg8::Gemm g{WSB(WS_XBB), w.t_gu, PADROWS, 1024, 1024, WSI(WS_PERM)}; EpiMoeGU E{WSB(WS_HH)}; __syncthreads(); pg8::gemm_phase<EpiMoeGU, pg8::ListOrder, true, true, true>(LDS3, g, S, E); });
        PHASE(base + 15, { const pg8::ListOrder S = moe_units(WSU(WS_CTL) + CW_CNT + layer * 32, bid, nblk, lds); pg8::Gemm g{WSB(WS_HH), w.t_dn, PADROWS, 1024, 512, nullptr}; EpiStoreBf16 E{WSB(WS_YK), 1024, 1 << 30, 0}; GEMM256(EpiStoreBf16, pg8::ListOrder, g, S, E); });
        PHASE(base + 16, { job_ln(nullptr, WSB(WS_XBB), nullptr, WSB(WS_YK), WSI(WS_EIDX), WSI(WS_ESLOT), WSU(WS_CTL) + CW_CNT + layer * 32, WSF(WS_EW), w.ln3_g, w.ln3_b, (layer == DEPTH - 1) ? p.out : nullptr, (layer == DEPTH - 1) ? nullptr : WSB(WS_XCB), nullptr, bid, nblk, lds); });
    }
}

extern "C" void kernel_launch(void* const* d_in, const int* in_sizes, int n_in, void* d_out, int out_size, void* d_ws, size_t ws_size, hipStream_t stream) {
    constexpr size_t kDynLds = 131072 + 1024;
    static_assert(2 * G_STAGE + 1024 <= 131072, "engine stages fit");
    static int grid = 0;
    if (!grid) {
        int dev = 0, cus = 0, per_cu = 0;
        (void)hipGetDevice(&dev);
        (void)hipDeviceGetAttribute(&cus, hipDeviceAttributeMultiprocessorCount, dev);
        (void)hipFuncSetAttribute((const void*)mega, hipFuncAttributeMaxDynamicSharedMemorySize, (int)kDynLds);
        (void)hipOccupancyMaxActiveBlocksPerMultiprocessor(&per_cu, mega, NT, kDynLds);
        if (per_cu < 1) per_cu = 1;
        grid = cus * (per_cu < 2 ? per_cu : 2);
    }
    if (ws_size < WS_END) { fprintf(stderr, "workspace too small: %zu < %zu\n", ws_size, (size_t)WS_END); return; }
    Params p{};
    for (int i = 0; i < 34; ++i) p.in[i] = (const float*)d_in[i];
    p.out = (float*)d_out;
    p.ws = (unsigned char*)d_ws;
    (void)hipMemsetAsync(d_ws, 0, CTL_BYTES, stream);
#if MK_ONE_LAUNCH
    hipLaunchKernelGGL(mega, dim3(grid), dim3(NT), kDynLds, stream, p, 0, NPHASES);
#else
    for (int ph = 0; ph < NPHASES; ++ph) hipLaunchKernelGGL(mega, dim3(grid), dim3(NT), kDynLds, stream, p, ph, ph + 1);
#endif
}
```

```cpp
#include <hip/hip_runtime.h>
#include <stdint.h>
#include <stdio.h>

#ifndef MK_ONE_LAUNCH
#define MK_ONE_LAUNCH 1
#endif

#define DI __device__ __forceinline__
#define LAS __attribute__((address_space(3)))
DI int tidx() { int t = threadIdx.x; asm volatile("" : "+v"(t)); return t; }

constexpr int NT = 512;
constexpr int D = 1024, BATCH = 8, SEQ = 2048, T = BATCH * SEQ, DEPTH = 4;
constexpr int MEM_LEN = 256;
constexpr int NIN = 6764, NH = 6912;
constexpr int O_AQ = 0, O_AKC = 256, O_AVC = 384, O_AKS = 512, O_AVS = 640, O_AKW = 768, O_AVW = 896,
              O_BQ = 1024, O_BK = 1280, O_BV = 1536, O_CX = 1792, O_CG = 2048, O_DCQ = 2304, O_DCKV = 2496, O_DKR = 2624,
              O_AG = 2656, O_MG = 2688;
constexpr int NCMP = 127, NCR = BATCH * NCMP * 2;
constexpr int NEXP = 32, NASSIGN = T * 2;
constexpr int PCAP = T;
constexpr float DN_ALPHA = 1.681792830507429f;

typedef unsigned short bf16_t;
typedef short bf16x8 __attribute__((ext_vector_type(8)));
typedef float f32x16 __attribute__((ext_vector_type(16)));
typedef unsigned u32x4 __attribute__((ext_vector_type(4)));

constexpr int G_WM = NT / 128;
constexpr int G_BM = 64 * G_WM;
constexpr int G_BN = 128;
constexpr int G_RS = 144;
constexpr int G_STAGE = (G_BM + G_BN) * G_RS;
constexpr int PADROWS = ((NASSIGN + NEXP * (G_BM - 1) + G_BM - 1) / G_BM) * G_BM;

constexpr size_t MiB = 1u << 20;
constexpr size_t al(size_t x) { return (x + 255) & ~(size_t)255; }
constexpr size_t WS_CTL = 0, CTL_BYTES = 1 * MiB;
constexpr size_t WT_IN = WS_CTL + CTL_BYTES;
constexpr size_t WT_BR = WT_IN + al((size_t)DEPTH * NH * 1024 * 2);
constexpr size_t WT_OUT = WT_BR + al((size_t)DEPTH * 4 * 1024 * 256 * 2);
constexpr size_t WT_Q = WT_OUT + al((size_t)DEPTH * 1024 * 1024 * 2);
constexpr size_t WT_KV = WT_Q + al((size_t)DEPTH * 512 * 1024 * 2);
constexpr size_t WT_O = WT_KV + al((size_t)DEPTH * 1024 * 1024 * 2);
constexpr size_t WT_GU = WT_O + al((size_t)DEPTH * 1024 * 512 * 2);
constexpr size_t WT_DN = WT_GU + al((size_t)DEPTH * 32 * 1024 * 1024 * 2);
constexpr size_t WS_X0B = WT_DN + al((size_t)DEPTH * 32 * 1024 * 512 * 2);
constexpr size_t WS_MEMB = WS_X0B + al((size_t)T * 1024 * 2);
constexpr size_t WS_H = WS_MEMB + al((size_t)2048 * 1024 * 2);
constexpr size_t SZ_H = al((size_t)T * NH * 2);
constexpr size_t WS_YK = WS_H;
constexpr size_t WS_HH = WS_YK + (size_t)PADROWS * 1024 * 2;
static_assert(WS_HH + (size_t)PADROWS * 512 * 2 <= WS_H + SZ_H, "moe overlay fits in H");
constexpr size_t WS_TB = WS_H + SZ_H;
constexpr size_t WS_HID = WS_TB + al((size_t)2 * NCR * 2048 * 4);
constexpr size_t WS_KCVC = WS_HID + al((size_t)2 * NCR * 256 * 4);
constexpr size_t WS_PC = WS_KCVC + al((size_t)2 * NCR * 64 * 4);
constexpr size_t WS_SEL = WS_PC + al((size_t)BATCH * 4 * SEQ * 128 * 4);
constexpr size_t WS_OW = WS_SEL + al((size_t)BATCH * 2 * SEQ * 4);
constexpr size_t WS_OC = WS_OW + al((size_t)T * 256 * 4);
constexpr size_t WS_BR = WS_OC + al((size_t)T * 256 * 4);
constexpr size_t WS_U = WS_BR + al((size_t)T * 1024 * 2);
constexpr size_t WS_RA = WS_U + al((size_t)T * 256 * 4);
constexpr size_t WS_RB = WS_RA + al((size_t)T * 256 * 4);
constexpr size_t WS_CQN = WS_RB + al((size_t)T * 256 * 4);
constexpr size_t WS_CKVN = WS_CQN + al((size_t)T * 192 * 4);
constexpr size_t WS_KR = WS_CKVN + al((size_t)T * 128 * 4);
constexpr size_t WS_Q = WS_KR + al((size_t)T * 32 * 4);
constexpr size_t WS_KV = WS_Q + al((size_t)T * 384 * 4);
constexpr size_t WS_M = WS_KV + al((size_t)T * 512 * 4);
constexpr size_t WS_Y = WS_M + al((size_t)T * 1024 * 2);
constexpr size_t WS_XA = WS_Y + al((size_t)T * 1024 * 4);
constexpr size_t WS_XB = WS_XA + al((size_t)T * 1024 * 4);
constexpr size_t WS_XC = WS_XB + al((size_t)T * 1024 * 4);
constexpr size_t WS_XAB = WS_XC + al((size_t)T * 1024 * 4);
constexpr size_t WS_XBB = WS_XAB + al((size_t)T * 1024 * 2);
constexpr size_t WS_XCB = WS_XBB + al((size_t)T * 1024 * 2);
constexpr size_t WS_XQ = WS_XCB + al((size_t)T * 1024 * 2);
constexpr size_t WS_XO = WS_XQ + al((size_t)T * 512 * 2);
constexpr size_t WS_KVM = WS_XO + al((size_t)T * 512 * 2);
constexpr size_t WS_LOG = WS_KVM + al((size_t)DEPTH * 2048 * 1024 * 2);
constexpr size_t WS_EIDX = WS_LOG + al((size_t)4 * T * 36 * 4);
constexpr size_t WS_ESLOT = WS_EIDX + al((size_t)NASSIGN * 4);
constexpr size_t WS_EW = WS_ESLOT + al((size_t)NASSIGN * 4);
constexpr size_t WS_PERM = WS_EW + al((size_t)NASSIGN * 4);
constexpr size_t WS_QB = WS_PERM + al((size_t)NEXP * T * 4);
constexpr size_t WS_KM = WS_QB + al((size_t)T * 384 * 2);
constexpr size_t WS_VM = WS_KM + al((size_t)T * 384 * 2);
constexpr size_t WS_KCB = WS_VM + al((size_t)T * 256 * 2);
constexpr size_t WT_C1 = WS_KCB + al((size_t)2 * NCR * 64 * 2);
constexpr size_t WT_C2 = WT_C1 + al((size_t)DEPTH * 2 * 256 * 2048 * 2);
constexpr size_t WT_UQ = WT_C2 + al((size_t)DEPTH * 2 * 128 * 256 * 2);
constexpr size_t WT_UKV = WT_UQ + al((size_t)DEPTH * 384 * 192 * 2);
constexpr size_t WT_G = WT_UKV + al((size_t)DEPTH * 512 * 128 * 2);
constexpr size_t WT_RH = WT_G + al((size_t)DEPTH * 4 * 128 * 64 * 2);
constexpr size_t WT_RL = WT_RH + al((size_t)DEPTH * 128 * 1024 * 2);
constexpr size_t WS_TBB = WT_RL + al((size_t)DEPTH * 128 * 1024 * 2);
constexpr size_t WS_HIDB = WS_TBB + al((size_t)2 * 2048 * 2048 * 2);
constexpr size_t WS_UB = WS_HIDB + al((size_t)2 * 2048 * 256 * 2);
constexpr size_t WS_CQNB = WS_UB + al((size_t)T * 256 * 2);
constexpr size_t WS_CKVNB = WS_CQNB + al((size_t)T * 192 * 2);
constexpr size_t WS_XBL = WS_CKVNB + al((size_t)T * 128 * 2);
constexpr size_t WS_SA = WS_XBL + al((size_t)T * 1024 * 2);
constexpr size_t WS_SH = WS_SA + al((size_t)BATCH * 32 * 256 * 4);
constexpr size_t WS_XG = WS_SH + al((size_t)BATCH * 32 * 256 * 4);
constexpr size_t WS_ROWOF = WS_XG + al((size_t)PADROWS * 1024 * 2);
constexpr size_t WS_ROPE_PRE = WS_ROWOF + al((size_t)NASSIGN * 4);
constexpr size_t WS_ROPE = WS_ROPE_PRE;
constexpr size_t WS_END = WS_ROPE + al((size_t)SEQ * 16 * 2 * 4);

constexpr int CW_BAR = 4096;
constexpr int CW_CNT = 16384;

struct Params {
    const float* in[34];
    float* out;
    unsigned char* ws;
};

#define XB_TMO      128
#define XB_XCNT(j)  (256  + 64 * (j))
#define XB_XSUB(j)  (1280 + 64 * (j))
#define XB_XGEN(j)  (2304 + 64 * (j))
#define XB_TOP      3328
#define XB_TOPGEN   3392
#define XCD_BAR_WORDS 3456
#define XB_SPIN_CAP (1u << 22)

__device__ __forceinline__ unsigned xb_ld(unsigned* p)              { return __hip_atomic_load(p, __ATOMIC_RELAXED, __HIP_MEMORY_SCOPE_AGENT); }
__device__ __forceinline__ unsigned xb_add(unsigned* p, unsigned v) { return __hip_atomic_fetch_add(p, v, __ATOMIC_RELAXED, __HIP_MEMORY_SCOPE_AGENT); }
__device__ __forceinline__ unsigned xb_xcc_id() { return (unsigned)__builtin_amdgcn_s_getreg((3 << 11) | 20) & 0xFu; }
#define XB_SPIN(cond, bar) do { unsigned _sp = 0; while (cond) { __builtin_amdgcn_s_sleep(1); \
    if ((++_sp & 255u) == 0u) { if (xb_ld(&(bar)[XB_TMO])) break; if (_sp > XB_SPIN_CAP) { atomicAdd(&(bar)[XB_TMO], 1u); break; } } } } while (0)

struct XcdBarrier { unsigned* bar; unsigned x; volatile LAS unsigned* st; };

__device__ __forceinline__ XcdBarrier xcd_barrier_post(unsigned* bar, volatile LAS unsigned* st) {
    XcdBarrier b; b.bar = bar; b.x = xb_xcc_id(); b.st = st;
    if (threadIdx.x == 0) (void)xb_add(&bar[XB_XCNT(b.x)], 1u);
    return b;
}
__device__ __forceinline__ void xcd_barrier_complete(unsigned* bar, unsigned x, unsigned& nloc, unsigned& nx) {
    const unsigned G = gridDim.x * gridDim.y * gridDim.z;
    unsigned sum, cnt, mine, sp = 0u;
    for (;;) {
        sum = 0u; cnt = 0u; mine = 0u;
#pragma unroll
        for (unsigned j = 0; j < 16; ++j) { const unsigned c = xb_ld(&bar[XB_XCNT(j)]); sum += c; cnt += (c > 0u) ? 1u : 0u; mine = (j == x) ? c : mine; }
        if (sum == G) break;
        __builtin_amdgcn_s_sleep(1);
        if ((++sp & 255u) == 0u) { if (xb_ld(&bar[XB_TMO])) break; if (sp > XB_SPIN_CAP) { atomicAdd(&bar[XB_TMO], 1u); break; } }
    }
    nloc = mine > 0u ? mine : 1u; nx = cnt > 0u ? cnt : 1u;
}
__device__ __forceinline__ void xcd_barrier(const XcdBarrier& b) {
    asm volatile("s_waitcnt vmcnt(0)" ::: "memory");
    __syncthreads();
    if (threadIdx.x == 0) {
        unsigned* bar = b.bar;
        __builtin_amdgcn_s_waitcnt(0);
        unsigned nloc = b.st[0], nx = b.st[1];
        if (nloc == 0u) { xcd_barrier_complete(bar, b.x, nloc, nx); b.st[0] = nloc; b.st[1] = nx; }
        const unsigned old = xb_add(&bar[XB_XSUB(b.x)], 1u);
        const unsigned gen = old / nloc;
        if (old + 1u == (gen + 1u) * nloc) {
            __builtin_amdgcn_fence(__ATOMIC_RELEASE, "agent");
            asm volatile("s_waitcnt vmcnt(0)" ::: "memory");
            const unsigned og = xb_add(&bar[XB_TOP], 1u);
            const unsigned tg = og / nx;
            if (og + 1u == (tg + 1u) * nx) xb_add(&bar[XB_TOPGEN], 1u);
            else XB_SPIN(xb_ld(&bar[XB_TOPGEN]) == tg, bar);
            __builtin_amdgcn_fence(__ATOMIC_ACQUIRE, "agent");
            xb_add(&bar[XB_XGEN(b.x)], 1u);
            asm volatile("s_waitcnt vmcnt(0)" ::: "memory");
        } else {
            XB_SPIN(xb_ld(&bar[XB_XGEN(b.x)]) == gen, bar);
            __builtin_amdgcn_fence(__ATOMIC_ACQUIRE, "agent");
            asm volatile("s_waitcnt vmcnt(0)" ::: "memory");
        }
    }
    __syncthreads();
}

DI float gelu_tanh(float x) { const float u = 0.7978845608028654f * (x + 0.044715f * x * x * x); return 0.5f * x * (1.f + tanhf(u)); }
DI float sigm(float x) { return 1.f / (1.f + expf(-x)); }
DI float sigm_fast(float x) { return __builtin_amdgcn_rcpf(1.f + __expf(-x)); }
DI float logsig(float z) { return fminf(z, 0.f) - log1pf(expf(-fabsf(z))); }
DI float wave_sum(float v) {
    const int lane = tidx() & 63;
#pragma unroll
    for (int o = 32; o > 0; o >>= 1) v += __int_as_float(__builtin_amdgcn_ds_bpermute((lane ^ o) << 2, __float_as_int(v)));
    return v;
}
DI void wave_sum2(float& a, float& b) {
    const int lane = tidx() & 63;
#pragma unroll
    for (int o = 32; o > 0; o >>= 1) {
        const float a2 = __int_as_float(__builtin_amdgcn_ds_bpermute((lane ^ o) << 2, __float_as_int(a)));
        const float b2 = __int_as_float(__builtin_amdgcn_ds_bpermute((lane ^ o) << 2, __float_as_int(b)));
        a += a2; b += b2;
    }
}

DI float bflo(unsigned u) { return __uint_as_float(u << 16); }
DI float bfhi(unsigned u) { return __uint_as_float(u & 0xffff0000u); }
DI float bf2f(bf16_t x) { return __uint_as_float((unsigned)x << 16); }
typedef float f32x2_t __attribute__((ext_vector_type(2)));
typedef __bf16 bf16x2_t __attribute__((ext_vector_type(2)));
DI unsigned pk_bf16(float lo, float hi) { f32x2_t v = {lo, hi}; bf16x2_t b = __builtin_convertvector(v, bf16x2_t); return __builtin_bit_cast(unsigned, b); }
DI bf16_t f2bf(float x) { return (bf16_t)(pk_bf16(x, 0.f) & 0xffffu); }
DI void st4bf(bf16_t* p, float a, float b, float c, float d) { uint2 v; v.x = pk_bf16(a, b); v.y = pk_bf16(c, d); *(uint2*)p = v; }
DI void ld8f(const bf16_t* p, float* f) { const u32x4 v = *(const u32x4*)p; f[0] = bflo(v[0]); f[1] = bfhi(v[0]); f[2] = bflo(v[1]); f[3] = bfhi(v[1]); f[4] = bflo(v[2]); f[5] = bfhi(v[2]); f[6] = bflo(v[3]); f[7] = bfhi(v[3]); }
DI void st8bf(bf16_t* p, const float* f) { u32x4 v; v[0] = pk_bf16(f[0], f[1]); v[1] = pk_bf16(f[2], f[3]); v[2] = pk_bf16(f[4], f[5]); v[3] = pk_bf16(f[6], f[7]); *(u32x4*)p = v; }
DI float4 ld4bf(const bf16_t* p) { const uint2 v = *(const uint2*)p; return make_float4(bflo(v.x), bfhi(v.x), bflo(v.y), bfhi(v.y)); }
template <int N> DI float dot_row(const float* q, const bf16_t* kr) {
    float dot = 0.f;
#pragma unroll
    for (int d = 0; d < N; d += 8) { const uint4 v = *(const uint4*)(kr + d);
        dot = fmaf(q[d], bflo(v.x), dot); dot = fmaf(q[d + 1], bfhi(v.x), dot); dot = fmaf(q[d + 2], bflo(v.y), dot); dot = fmaf(q[d + 3], bfhi(v.y), dot);
        dot = fmaf(q[d + 4], bflo(v.z), dot); dot = fmaf(q[d + 5], bfhi(v.z), dot); dot = fmaf(q[d + 6], bflo(v.w), dot); dot = fmaf(q[d + 7], bfhi(v.w), dot); }
    return dot;
}
template <int N> DI float dot_row(const float* q, const float* kr) {
    float dot = 0.f;
#pragma unroll
    for (int d = 0; d < N; ++d) dot = fmaf(q[d], kr[d], dot);
    return dot;
}
template <int N> DI void axpy_row(float* o, float pr, float corr, const bf16_t* vr) {
#pragma unroll
    for (int d = 0; d < N; d += 8) { const uint4 v = *(const uint4*)(vr + d);
        o[d] = fmaf(pr, bflo(v.x), o[d] * corr); o[d + 1] = fmaf(pr, bfhi(v.x), o[d + 1] * corr); o[d + 2] = fmaf(pr, bflo(v.y), o[d + 2] * corr); o[d + 3] = fmaf(pr, bfhi(v.y), o[d + 3] * corr);
        o[d + 4] = fmaf(pr, bflo(v.z), o[d + 4] * corr); o[d + 5] = fmaf(pr, bfhi(v.z), o[d + 5] * corr); o[d + 6] = fmaf(pr, bflo(v.w), o[d + 6] * corr); o[d + 7] = fmaf(pr, bfhi(v.w), o[d + 7] * corr); }
}
template <int N> DI void axpy_row(float* o, float pr, float corr, const float* vr) {
#pragma unroll
    for (int d = 0; d < N; ++d) o[d] = fmaf(pr, vr[d], o[d] * corr);
}
template <int N> DI void ld_row(float* q, const bf16_t* p) {
#pragma unroll
    for (int d = 0; d < N; d += 8) { const uint4 v = *(const uint4*)(p + d);
        q[d] = bflo(v.x); q[d + 1] = bfhi(v.x); q[d + 2] = bflo(v.y); q[d + 3] = bfhi(v.y); q[d + 4] = bflo(v.z); q[d + 5] = bfhi(v.z); q[d + 6] = bflo(v.w); q[d + 7] = bfhi(v.w); }
}
template <int N> DI void ld_row(float* q, const float* p) {
#pragma unroll
    for (int d = 0; d < N; d += 4) { const float4 v = *(const float4*)(p + d); q[d] = v.x; q[d + 1] = v.y; q[d + 2] = v.z; q[d + 3] = v.w; }
}

struct MG { const bf16_t* A; long lda; const bf16_t* Wt; long ldw; int K; };

struct NoFlush { DI void operator()(int, f32x16 (&)[2][2]) const {} };
struct NoPre { DI void operator()(int) const {} };
template <class RowFn, class Flush, class Pre>
DI void mgemm_tile_f(const MG& g, int n0, RowFn rowfn, f32x16 (&acc)[2][2], unsigned char* lds, bool zero, int flush_every, Flush flush, Pre pre) {
    constexpr int XI = G_BM * 8 / NT, WI = G_BN * 8 / NT;
    const int tid = tidx(), lane = tid & 63, wid = tid >> 6, r = lane & 31, h = lane >> 5;
    const int wm = wid % G_WM, wn = wid / G_WM;
    const int cc = tid & 7, row0 = tid >> 3;
    const bf16_t* xp[XI]; const bf16_t* wp[WI];
#pragma unroll
    for (int i = 0; i < XI; ++i) xp[i] = g.A + (long)rowfn(row0 + (NT / 8) * i) * g.lda + cc * 8;
#pragma unroll
    for (int i = 0; i < WI; ++i) wp[i] = g.Wt + (long)(n0 + row0 + (NT / 8) * i) * g.ldw + cc * 8;
    const int st_off = row0 * G_RS + cc * 16;
    if (zero)
#pragma unroll
    for (int a = 0; a < 2; ++a)
#pragma unroll
        for (int b = 0; b < 2; ++b)
#pragma unroll
            for (int i = 0; i < 16; ++i) acc[a][b][i] = 0.f;
    const int nk = g.K >> 6;
    u32x4 xv0[XI], wv0[WI], xv1[XI], wv1[WI];
#define MG_GLOAD(XV, WV, KT) do { _Pragma("unroll") for (int i = 0; i < XI; ++i) XV[i] = *(const u32x4*)(xp[i] + (KT) * 64); \
                                  _Pragma("unroll") for (int i = 0; i < WI; ++i) WV[i] = *(const u32x4*)(wp[i] + (KT) * 64); } while (0)
#define MG_LSTORE(XV, WV, STG) do { unsigned char* _s = lds + (STG) * G_STAGE; \
        _Pragma("unroll") for (int i = 0; i < XI; ++i) *(u32x4*)(_s + st_off + (NT / 8) * i * G_RS) = XV[i]; \
        _Pragma("unroll") for (int i = 0; i < WI; ++i) *(u32x4*)(_s + G_BM * G_RS + st_off + (NT / 8) * i * G_RS) = WV[i]; } while (0)
    MG_GLOAD(xv0, wv0, 0);
    if (nk > 1) MG_GLOAD(xv1, wv1, 1);
    __syncthreads();
    MG_LSTORE(xv0, wv0, 0);
    if (nk > 2) MG_GLOAD(xv0, wv0, 2);
    __syncthreads();
    const int xf_off = (wm * 64 + r) * G_RS + h * 16, wf_off = G_BM * G_RS + (wn * 64 + r) * G_RS + h * 16;
#define MG_COMPUTE(STG) do { const unsigned char* st = lds + (STG) * G_STAGE; \
        _Pragma("unroll") for (int ks = 0; ks < 4; ++ks) { \
            const bf16x8 w0 = *(const bf16x8*)(st + wf_off + ks * 32), w1 = *(const bf16x8*)(st + wf_off + 32 * G_RS + ks * 32); \
            const bf16x8 x0 = *(const bf16x8*)(st + xf_off + ks * 32), x1 = *(const bf16x8*)(st + xf_off + 32 * G_RS + ks * 32); \
            acc[0][0] = __builtin_amdgcn_mfma_f32_32x32x16_bf16(w0, x0, acc[0][0], 0, 0, 0); \
            acc[0][1] = __builtin_amdgcn_mfma_f32_32x32x16_bf16(w0, x1, acc[0][1], 0, 0, 0); \
            acc[1][0] = __builtin_amdgcn_mfma_f32_32x32x16_bf16(w1, x0, acc[1][0], 0, 0, 0); \
            acc[1][1] = __builtin_amdgcn_mfma_f32_32x32x16_bf16(w1, x1, acc[1][1], 0, 0, 0); } } while (0)
    for (int kt = 0; kt < nk; kt += 2) {
        if (flush_every && kt % flush_every == 0) pre(kt / flush_every);
        MG_COMPUTE(0);
        if (kt + 1 < nk) { MG_LSTORE(xv1, wv1, 1); if (kt + 3 < nk) MG_GLOAD(xv1, wv1, kt + 3); }
        if (flush_every && (kt + 1) % flush_every == 0) flush(kt / flush_every, acc);
        __syncthreads();
        if (kt + 1 < nk) {
            MG_COMPUTE(1);
            if (kt + 2 < nk) { MG_LSTORE(xv0, wv0, 0); if (kt + 4 < nk) MG_GLOAD(xv0, wv0, kt + 4); }
            if (flush_every && (kt + 2) % flush_every == 0) flush((kt + 1) / flush_every, acc);
            __syncthreads();
        }
    }
#undef MG_GLOAD
#undef MG_LSTORE
#undef MG_COMPUTE
}
template <class RowFn>
DI void mgemm_tile(const MG& g, int n0, RowFn rowfn, f32x16 (&acc)[2][2], unsigned char* lds, bool zero = true) { mgemm_tile_f(g, n0, rowfn, acc, lds, zero, 0, NoFlush{}, NoPre{}); }
#define MG_FOREACH(acc, LROW, FEAT, V, ...) do { const int _l = tidx() & 63, _w = tidx() >> 6, _wm = _w % G_WM, _wn = _w / G_WM; \
    _Pragma("unroll") for (int _ft = 0; _ft < 2; ++_ft) _Pragma("unroll") for (int _tt = 0; _tt < 2; ++_tt) _Pragma("unroll") for (int _i = 0; _i < 4; ++_i) { \
        const int LROW = _wm * 64 + _tt * 32 + (_l & 31); const int FEAT = _wn * 64 + _ft * 32 + 8 * _i + 4 * (_l >> 5); \
        float V[4] = {acc[_ft][_tt][4 * _i], acc[_ft][_tt][4 * _i + 1], acc[_ft][_tt][4 * _i + 2], acc[_ft][_tt][4 * _i + 3]}; __VA_ARGS__ } } while (0)

struct RowId { int m0; DI long operator()(int r) const { return m0 + r; } };

template <int OUTMODE>
DI void mgemm_job(const MG& g, int M, int N, void* out, long ldo, int bid, int nblk, unsigned char* lds) {
    const int tm = M / G_BM, tn = N / G_BN;
    for (int u = bid; u < tm * tn; u += nblk) {
        const int grp = u / (16 * tn), rem = u % (16 * tn);
        const int gm = (tm - grp * 16) < 16 ? (tm - grp * 16) : 16;
        const int mt = grp * 16 + rem % gm, nt = rem / gm;
        const int m0 = mt * G_BM, n0 = nt * G_BN;
        f32x16 acc[2][2];
        mgemm_tile(g, n0, RowId{m0}, acc, lds);
        MG_FOREACH(acc, lrow, feat, v, {
            const long o = (long)(m0 + lrow) * ldo + n0 + feat;
            if (OUTMODE == 1) *(float4*)((float*)out + o) = make_float4(v[0], v[1], v[2], v[3]);
            else {
                if (OUTMODE == 2 && n0 + feat >= O_MG) { v[0] = sigm(v[0]); v[1] = sigm(v[1]); v[2] = sigm(v[2]); v[3] = sigm(v[3]); }
                st4bf((bf16_t*)out + o, v[0], v[1], v[2], v[3]);
            } });
    }
}

namespace pg8 {
#define PG8_LAS __attribute__((address_space(3)))
typedef float f32x4 __attribute__((ext_vector_type(4)));
constexpr int BM = 256, BK = 64, HALF = 128, HTB = HALF * BK * 2  , STAGE_BYTES = 8 * HTB, NXCD = 8, WGM = 8;
__host__ __device__ __forceinline__ int lds_byte(int r, int c) { const int st = (r >> 4) * 2 + (c >> 5), rr = r & 15, cc = c & 31, ob = rr * 64 + cc * 2; return st * 1024 + (ob ^ (((ob >> 9) & 1) << 5)); }
__host__ __device__ __forceinline__ void stage_rc(int b, int& R, int& C) { const int st = b / 1024, sb = b % 1024, swz = sb ^ (((sb >> 9) & 1) << 5); R = (st >> 1) * 16 + swz / 64; C = (st & 1) * 32 + (swz % 64) / 2; }
__host__ __device__ __forceinline__ int perm32(int rho) { const int n = rho >> 4, i = rho & 15; return 8 * (i >> 2) + 4 * n + (i & 3); }
struct Unit { int pm, pn, e, gt, nv; };
struct Gemm { const bf16_t* A; const bf16_t* Bt; int M, N, K; const int* rowidx; };
struct StaticOrder {
    int nM, nN, nwg, G, c;
    __device__ void init(int M, int N, int G_, int c_) { nM = M / BM; nN = N / BM; nwg = nM * nN; G = G_; c = c_; }
    __device__ bool next(int i, Unit& u) const {
        const long L = (long)i * G + c; if (L >= nwg) return false;
        int wgid = (int)L; { const int q = nwg / NXCD, r = nwg % NXCD, xcd = wgid % NXCD, off = wgid / NXCD; wgid = (xcd < r ? xcd * (q + 1) : r * (q + 1) + (xcd - r) * q) + off; }
        const int nig = WGM * nN, gid = wgid / nig, fm = gid * WGM, gsz = (nM - fm) < WGM ? (nM - fm) : WGM;
        u.pm = fm + ((wgid % nig) % gsz); u.pn = (wgid % nig) / gsz; u.e = 0; u.gt = 0; u.nv = 0; return true;
    }
    __device__ __forceinline__ void a_ready(const Unit&) const {}
    __device__ __forceinline__ void done(const Unit&) const {}
};
struct ListOrder {
    Unit u0, u1, u2; int n;
    __device__ bool next(int i, Unit& u) const { if (i >= n) return false; u = (i == 0) ? u0 : ((i == 1) ? u1 : u2); return true; }
    __device__ __forceinline__ void a_ready(const Unit&) const {}
    __device__ __forceinline__ void done(const Unit&) const {}
};
template <class Epi, class Sched, bool ALIGN_EPI = false, bool SP2 = false, bool GATHER = false>
__device__ __forceinline__ void gemm_phase(PG8_LAS unsigned char* lds, const Gemm g, const Sched& S, const Epi& E) {
    const int tid = tidx(), wid = __builtin_amdgcn_readfirstlane(tid >> 6), lane = tid & 63, wr = wid >> 2, wc = wid & 3, fr = lane & 15, fq = lane >> 4;
    const int K = g.K, nt = K / BK;
    unsigned voffA[2], voffB[2];
#pragma unroll
    for (int i = 0; i < 2; ++i) { int R, C; stage_rc(tid * 16 + i * 8192, R, C); const int Rb = Epi::PERM ? ((R & ~31) + perm32(R & 31)) : R;
        voffA[i] = (unsigned)(R * K + C) * 2u; voffB[i] = (unsigned)(Rb * K + C) * 2u; }
    unsigned voffC[2][2] = {{0u, 0u}, {0u, 0u}}, voffN[2][2] = {{0u, 0u}, {0u, 0u}};
    auto gather_offs = [&](const Unit& uu, unsigned (&vo)[2][2]) {
#pragma unroll
        for (int hh = 0; hh < 2; ++hh)
#pragma unroll
            for (int i = 0; i < 2; ++i) { int R, C; stage_rc(tid * 16 + i * 8192, R, C); const int lr = hh * HALF + R; int a = g.rowidx[uu.gt * BM + lr]; a = lr < uu.nv ? (a >> 1) : 0; vo[hh][i] = (unsigned)(a * K + C) * 2u; }
    };
    const size_t kstep = (size_t)(BK * 2);
    const size_t hstep = (size_t)HALF * K * 2;
    const size_t tstep = 2 * hstep;
    const size_t estep = (size_t)g.N * K * 2;
    const unsigned ldsw = (unsigned)wid * 1024u;
    const int aoff = lds_byte(wr * 64 + fr, fq * 8), boff = lds_byte(wc * 32 + fr, fq * 8);
#define PG8_SA(b, h) (((b) * 2 + (h)) * HTB)
#define PG8_SB(b, h) ((4 + (b) * 2 + (h)) * HTB)
#define PG8_STAGE(bufoff, gbase, voff) do { _Pragma("unroll") for (int _i = 0; _i < 2; ++_i) \
        __builtin_amdgcn_global_load_lds((const unsigned*)((const char*)(gbase) + (voff)[_i]), (PG8_LAS unsigned*)(lds + (bufoff) + ldsw + _i * 8192), 16, 0, 0); } while (0)
#define PG8_STAGE_A(bufoff, HH, KT, NX, densebase) do { if constexpr (GATHER) { const char* _gb = (const char*)g.A + (size_t)(KT) * kstep; if (NX) PG8_STAGE(bufoff, _gb, voffN[HH]); else PG8_STAGE(bufoff, _gb, voffC[HH]); } else PG8_STAGE(bufoff, densebase, voffA); } while (0)
#define PG8_LDA(dst, b, h) do { _Pragma("unroll") for (int m = 0; m < 4; ++m) _Pragma("unroll") for (int k = 0; k < 2; ++k) dst[m][k] = *(const PG8_LAS bf16x8*)(lds + PG8_SA(b, h) + aoff + m * 2048 + k * 1024); } while (0)
#define PG8_LDB(dst, b, h) do { _Pragma("unroll") for (int n = 0; n < 2; ++n) _Pragma("unroll") for (int k = 0; k < 2; ++k) dst[n][k] = *(const PG8_LAS bf16x8*)(lds + PG8_SB(b, h) + boff + n * 2048 + k * 1024); } while (0)
#define PG8_MMA(ai, bj, At, Bt) do { __builtin_amdgcn_s_setprio(1); _Pragma("unroll") for (int m = 0; m < 4; ++m) _Pragma("unroll") for (int n = 0; n < 2; ++n) _Pragma("unroll") for (int k = 0; k < 2; ++k) \
        acc[ai][bj][m][n] = __builtin_amdgcn_mfma_f32_16x16x32_bf16(Bt[n][k], At[m][k], acc[ai][bj][m][n], 0, 0, 0); __builtin_amdgcn_s_setprio(0); } while (0)
#define PG8_WAIT_V(n) asm volatile("s_waitcnt vmcnt(" #n ")" ::: "memory")
#define PG8_WAIT_L(n) asm volatile("s_waitcnt lgkmcnt(" #n ")" ::: "memory")
#define PG8_BAR __builtin_amdgcn_s_barrier()
#define PG8_SCHED __builtin_amdgcn_sched_barrier(0)
    Unit cur, nxt; int ui = 0;
    if (!S.next(0, cur)) return;
    f32x4 acc[2][2][4][2];
#pragma unroll
    for (int a = 0; a < 2; ++a)
#pragma unroll
        for (int b = 0; b < 2; ++b)
#pragma unroll
            for (int m = 0; m < 4; ++m)
#pragma unroll
                for (int n = 0; n < 2; ++n) acc[a][b][m][n] = (f32x4){0.f, 0.f, 0.f, 0.f};
    bf16x8 At[4][2], B0[2][2], B1[2][2];
    const char* cA = (const char*)g.A + (size_t)cur.pm * tstep; const char* cB = (const char*)g.Bt + (size_t)cur.e * estep + (size_t)cur.pn * tstep;
    S.a_ready(cur);
    if constexpr (GATHER) gather_offs(cur, voffC);
    if constexpr (SP2) {
        PG8_STAGE(PG8_SB(0, 0), cB, voffB); PG8_STAGE(PG8_SB(0, 1), cB + hstep, voffB); PG8_STAGE_A(PG8_SA(0, 0), 0, 0, false, cA); PG8_STAGE_A(PG8_SA(0, 1), 1, 0, false, cA + hstep);
        if (wr == 1) PG8_BAR;
        PG8_WAIT_V(2); PG8_BAR;
        PG8_STAGE(PG8_SB(1, 0), cB + kstep, voffB); PG8_STAGE_A(PG8_SA(1, 0), 0, 1, false, cA + kstep); PG8_STAGE(PG8_SB(1, 1), cB + hstep + kstep, voffB);
        PG8_WAIT_V(6); PG8_BAR;
    } else {
        PG8_STAGE(PG8_SB(0, 0), cB, voffB); PG8_STAGE_A(PG8_SA(0, 0), 0, 0, false, cA); PG8_STAGE(PG8_SB(0, 1), cB + hstep, voffB); PG8_STAGE_A(PG8_SA(0, 1), 1, 0, false, cA + hstep);
        if (wr == 1) PG8_BAR;
        PG8_WAIT_V(4); PG8_BAR;
        PG8_STAGE(PG8_SB(1, 0), cB + kstep, voffB); PG8_STAGE_A(PG8_SA(1, 0), 0, 1, false, cA + kstep); PG8_STAGE(PG8_SB(1, 1), cB + hstep + kstep, voffB);
        PG8_WAIT_V(6); PG8_BAR;
    }
    for (;;) {
        const bool has_next = S.next(ui + 1, nxt);
        if constexpr (GATHER) { if (has_next) gather_offs(nxt, voffN); else {
#pragma unroll
            for (int hh = 0; hh < 2; ++hh) { voffN[hh][0] = voffC[hh][0]; voffN[hh][1] = voffC[hh][1]; } } }
        const char* nA = has_next ? (const char*)g.A + (size_t)nxt.pm * tstep : cA; const char* nB = has_next ? (const char*)g.Bt + (size_t)nxt.e * estep + (size_t)nxt.pn * tstep : cB;
        for (int t = 0; t < nt; t += 2) {
            const bool last = (t == nt - 2);
            const char* a1 = cA + (size_t)(t + 1) * kstep;
            const char* a2 = last ? nA : cA + (size_t)(t + 2) * kstep; const char* b2 = last ? nB : cB + (size_t)(t + 2) * kstep;
            const char* a3 = a2 + kstep; const char* b3 = b2 + kstep;
            if (last && has_next) S.a_ready(nxt);
            if constexpr (SP2) {
            PG8_LDB(B0, 0, 0); PG8_LDB(B1, 0, 1); PG8_SCHED; PG8_LDA(At, 0, 0); PG8_STAGE_A(PG8_SA(1, 1), 1, t + 1, false, a1 + hstep);
            PG8_WAIT_V(8); PG8_WAIT_L(0); PG8_BAR; PG8_MMA(0, 0, At, B0); PG8_MMA(0, 1, At, B1); PG8_BAR; PG8_SCHED;
            PG8_LDA(At, 0, 1); PG8_STAGE(PG8_SB(0, 0), b2, voffB); PG8_STAGE(PG8_SB(0, 1), b2 + hstep, voffB); PG8_STAGE_A(PG8_SA(0, 0), 0, (last ? 0 : t + 2), last, a2);
            PG8_WAIT_V(8); PG8_WAIT_L(0); PG8_BAR; PG8_MMA(1, 0, At, B0); PG8_MMA(1, 1, At, B1); PG8_BAR; PG8_SCHED;
            PG8_LDB(B0, 1, 0); PG8_LDB(B1, 1, 1); PG8_SCHED; PG8_LDA(At, 1, 0); PG8_STAGE_A(PG8_SA(0, 1), 1, (last ? 0 : t + 2), last, a2 + hstep);
            PG8_WAIT_V(8); PG8_WAIT_L(0); PG8_BAR; PG8_MMA(0, 0, At, B0); PG8_MMA(0, 1, At, B1); PG8_BAR; PG8_SCHED;
            PG8_LDA(At, 1, 1); PG8_STAGE(PG8_SB(1, 0), b3, voffB); PG8_STAGE(PG8_SB(1, 1), b3 + hstep, voffB); PG8_STAGE_A(PG8_SA(1, 0), 0, (last ? 1 : t + 3), last, a3);
            PG8_WAIT_V(8); PG8_WAIT_L(0); PG8_BAR; PG8_MMA(1, 0, At, B0); PG8_MMA(1, 1, At, B1); PG8_BAR; PG8_SCHED;
            } else {
            PG8_LDB(B0, 0, 0); PG8_SCHED; PG8_LDA(At, 0, 0); PG8_STAGE_A(PG8_SA(1, 1), 1, t + 1, false, a1 + hstep);
            PG8_WAIT_L(8); PG8_BAR; PG8_WAIT_L(0); PG8_MMA(0, 0, At, B0); PG8_BAR; PG8_SCHED;
            PG8_LDB(B1, 0, 1); PG8_STAGE(PG8_SB(0, 0), b2, voffB);
            PG8_BAR; PG8_WAIT_L(0); PG8_MMA(0, 1, At, B1); PG8_BAR;
            PG8_LDA(At, 0, 1); PG8_STAGE_A(PG8_SA(0, 0), 0, (last ? 0 : t + 2), last, a2);
            PG8_BAR; PG8_WAIT_L(0); PG8_MMA(1, 0, At, B0); PG8_BAR; PG8_SCHED;
            PG8_STAGE(PG8_SB(0, 1), b2 + hstep, voffB);
            PG8_WAIT_V(6); PG8_BAR; PG8_MMA(1, 1, At, B1); PG8_BAR;
            PG8_LDB(B0, 1, 0); PG8_SCHED; PG8_LDA(At, 1, 0); PG8_STAGE_A(PG8_SA(0, 1), 1, (last ? 0 : t + 2), last, a2 + hstep);
            PG8_WAIT_L(8); PG8_BAR; PG8_WAIT_L(0); PG8_MMA(0, 0, At, B0); PG8_BAR; PG8_SCHED;
            PG8_LDB(B1, 1, 1); PG8_STAGE(PG8_SB(1, 0), b3, voffB);
            PG8_BAR; PG8_WAIT_L(0); PG8_MMA(0, 1, At, B1); PG8_BAR;
            PG8_LDA(At, 1, 1); PG8_STAGE_A(PG8_SA(1, 0), 0, (last ? 1 : t + 3), last, a3);
            PG8_BAR; PG8_WAIT_L(0); PG8_MMA(1, 0, At, B0); PG8_BAR; PG8_SCHED;
            PG8_STAGE(PG8_SB(1, 1), b3 + hstep, voffB);
            PG8_WAIT_V(6); PG8_BAR; PG8_MMA(1, 1, At, B1); PG8_BAR;
            }
        }
        if constexpr (ALIGN_EPI) { if (wr == 0) PG8_BAR; }
        if constexpr (!Epi::AFTER_DRAIN) { E(acc, cur, wr, wc, fr, fq); S.done(cur); }
        if (!has_next) break;
#pragma unroll
        for (int a = 0; a < 2; ++a)
#pragma unroll
            for (int b = 0; b < 2; ++b)
#pragma unroll
                for (int m = 0; m < 4; ++m)
#pragma unroll
                    for (int n = 0; n < 2; ++n) acc[a][b][m][n] = (f32x4){0.f, 0.f, 0.f, 0.f};
        cur = nxt; cA = nA; cB = nB; ++ui;
        if constexpr (GATHER) {
#pragma unroll
            for (int hh = 0; hh < 2; ++hh) { voffC[hh][0] = voffN[hh][0]; voffC[hh][1] = voffN[hh][1]; } }
        if constexpr (ALIGN_EPI) { if (wr == 1) PG8_BAR; }
    }
    PG8_WAIT_V(0);
    if constexpr (!ALIGN_EPI) { if (wr == 0) PG8_BAR; }
    PG8_BAR;
    if constexpr (Epi::AFTER_DRAIN) { E.fused(acc, cur, wr, wc, fr, fq, lds, wid, lane); S.done(cur); }
#undef PG8_SA
#undef PG8_SB
#undef PG8_STAGE
#undef PG8_STAGE_A
#undef PG8_LDA
#undef PG8_LDB
#undef PG8_MMA
#undef PG8_WAIT_V
#undef PG8_WAIT_L
#undef PG8_BAR
#undef PG8_SCHED
}
}

struct EpiStoreBf16 {
    static constexpr bool PERM = true, AFTER_DRAIN = false;
    bf16_t* O; long ldo; int gate_from; long estride;
    __device__ __forceinline__ void operator()(const pg8::f32x4 (&acc)[2][2][4][2], const pg8::Unit& u, int wr, int wc, int fr, int fq) const {
        bf16_t* base = O + (long)u.e * estride;
#pragma unroll
        for (int ai = 0; ai < 2; ++ai)
#pragma unroll
            for (int m = 0; m < 4; ++m) {
                const long row = (long)u.pm * 256 + ai * 128 + wr * 64 + m * 16 + fr;
#pragma unroll
                for (int bj = 0; bj < 2; ++bj) {
                    pg8::f32x4 v0 = acc[ai][bj][m][0], v1 = acc[ai][bj][m][1];
                    if (u.pn * 2 + bj >= gate_from) {
#pragma unroll
                        for (int j = 0; j < 4; ++j) { v0[j] = sigm_fast(v0[j]); v1[j] = sigm_fast(v1[j]); }
                    }
                    u32x4 wv; wv[0] = pk_bf16(v0[0], v0[1]); wv[1] = pk_bf16(v0[2], v0[3]); wv[2] = pk_bf16(v1[0], v1[1]); wv[3] = pk_bf16(v1[2], v1[3]);
                    *(u32x4*)(base + row * ldo + u.pn * 256 + bj * 128 + wc * 32 + 8 * fq) = wv;
                }
            }
    }
};
struct EpiStoreF32 {
    static constexpr bool PERM = false, AFTER_DRAIN = false;
    float* O; long ldo;
    __device__ __forceinline__ void operator()(const pg8::f32x4 (&acc)[2][2][4][2], const pg8::Unit& u, int wr, int wc, int fr, int fq) const {
#pragma unroll
        for (int ai = 0; ai < 2; ++ai)
#pragma unroll
            for (int m = 0; m < 4; ++m) {
                const long row = (long)u.pm * 256 + ai * 128 + wr * 64 + m * 16 + fr;
#pragma unroll
                for (int bj = 0; bj < 2; ++bj)
#pragma unroll
                    for (int n = 0; n < 2; ++n) *(pg8::f32x4*)(O + row * ldo + u.pn * 256 + bj * 128 + wc * 32 + 16 * n + 4 * fq) = acc[ai][bj][m][n];
            }
    }
};
struct EpiMoeGU {
    static constexpr bool PERM = true, AFTER_DRAIN = false;
    bf16_t* HH;
    __device__ __forceinline__ void operator()(const pg8::f32x4 (&acc)[2][2][4][2], const pg8::Unit& u, int wr, int wc, int fr, int fq) const {
#pragma unroll
        for (int ai = 0; ai < 2; ++ai)
#pragma unroll
            for (int m = 0; m < 4; ++m) {
                const long row = (long)u.pm * 256 + ai * 128 + wr * 64 + m * 16 + fr;
                float hv[8];
#pragma unroll
                for (int n = 0; n < 2; ++n)
#pragma unroll
                    for (int j = 0; j < 4; ++j) { const float gt = acc[ai][0][m][n][j], up = acc[ai][1][m][n][j]; hv[4 * n + j] = gt * sigm_fast(gt) * up; }
                u32x4 wv; wv[0] = pk_bf16(hv[0], hv[1]); wv[1] = pk_bf16(hv[2], hv[3]); wv[2] = pk_bf16(hv[4], hv[5]); wv[3] = pk_bf16(hv[6], hv[7]);
                *(u32x4*)(HH + row * 512 + u.pn * 128 + wc * 32 + 8 * fq) = wv;
            }
    }
};
struct EpiMoeDown {
    static constexpr bool PERM = true, AFTER_DRAIN = false;
    const int* perm; const float* ew; bf16_t* YK;
    __device__ __forceinline__ void operator()(const pg8::f32x4 (&acc)[2][2][4][2], const pg8::Unit& u, int wr, int wc, int fr, int fq) const {
#pragma unroll
        for (int ai = 0; ai < 2; ++ai)
#pragma unroll
            for (int m = 0; m < 4; ++m) {
                const int a = perm[u.pm * 256 + ai * 128 + wr * 64 + m * 16 + fr];
                if (a >= 0) {
                    const float sw = ew[a];
#pragma unroll
                    for (int bj = 0; bj < 2; ++bj) {
                        const pg8::f32x4 v0 = acc[ai][bj][m][0] * sw, v1 = acc[ai][bj][m][1] * sw;
                        u32x4 wv; wv[0] = pk_bf16(v0[0], v0[1]); wv[1] = pk_bf16(v0[2], v0[3]); wv[2] = pk_bf16(v1[0], v1[1]); wv[3] = pk_bf16(v1[2], v1[3]);
                        *(u32x4*)(YK + (long)a * 1024 + u.pn * 256 + bj * 128 + wc * 32 + 8 * fq) = wv;
                    }
                }
            }
    }
};
struct GroupedOrder {
    int nM, nN, nE, G, c;
    __device__ bool next(int i, pg8::Unit& u) const { const int L = i * G + c; if (L >= nM * nN * nE) return false; u.e = L / (nM * nN); const int rm = L % (nM * nN); u.pm = rm / nN; u.pn = rm % nN; u.gt = 0; u.nv = 0; return true; }
    __device__ __forceinline__ void a_ready(const pg8::Unit&) const {}
    __device__ __forceinline__ void done(const pg8::Unit&) const {}
};

struct LayerW {
    const float *cmp_pos, *conv_w, *conv_b, *ga_b, *gx_b, *lam, *q_norm, *kv_norm,
        *ln1_g, *ln1_b, *ln2_g, *ln2_b, *rg_b, *re_b, *ln3_g, *ln3_b;
    const bf16_t *t_in, *t_br, *t_out, *t_q, *t_o, *t_gu, *t_dn, *t_c1, *t_c2, *t_uq, *t_ukv, *t_g, *t_rh, *t_rl;
};
#define WSF(off) ((float*)(p.ws + (off)))
#define WSI(off) ((int*)(p.ws + (off)))
#define WSU(off) ((unsigned*)(p.ws + (off)))
#define WSB(off) ((bf16_t*)(p.ws + (off)))
DI LayerW layer_w(const Params& p, int l) {
    LayerW w;
    w.cmp_pos = p.in[3] + (size_t)l * 2 * 32 * 64;
    w.conv_w = p.in[6] + (size_t)l * 4 * 256;
    w.conv_b = p.in[7] + (size_t)l * 256;
    w.ga_b = p.in[9] + (size_t)l * 256;
    w.gx_b = p.in[11] + (size_t)l * 256;
    w.lam = p.in[12] + (size_t)l * 256;
    w.q_norm = p.in[13] + (size_t)l * 192;
    w.kv_norm = p.in[14] + (size_t)l * 128;
    w.ln1_g = p.in[19] + (size_t)l * 1024; w.ln1_b = p.in[20] + (size_t)l * 1024;
    w.ln2_g = p.in[24] + (size_t)l * 1024; w.ln2_b = p.in[25] + (size_t)l * 1024;
    w.rg_b = p.in[27] + (size_t)l * 4;
    w.re_b = p.in[29] + (size_t)l * 32;
    w.ln3_g = p.in[32] + (size_t)l * 1024; w.ln3_b = p.in[33] + (size_t)l * 1024;
    w.t_in = WSB(WT_IN) + (size_t)l * NH * 1024;
    w.t_br = WSB(WT_BR) + (size_t)l * 1024 * 1024;
    w.t_out = WSB(WT_OUT) + (size_t)l * 1024 * 1024;
    w.t_q = WSB(WT_Q) + (size_t)l * 512 * 1024;
    w.t_o = WSB(WT_O) + (size_t)l * 1024 * 512;
    w.t_gu = WSB(WT_GU) + (size_t)l * 32 * 1024 * 1024;
    w.t_dn = WSB(WT_DN) + (size_t)l * 32 * 1024 * 512;
    w.t_c1 = WSB(WT_C1) + (size_t)l * 2 * 256 * 2048;
    w.t_c2 = WSB(WT_C2) + (size_t)l * 2 * 128 * 256;
    w.t_uq = WSB(WT_UQ) + (size_t)l * 384 * 192;
    w.t_ukv = WSB(WT_UKV) + (size_t)l * 512 * 128;
    w.t_g = WSB(WT_G) + (size_t)l * 4 * 128 * 64;
    w.t_rh = WSB(WT_RH) + (size_t)l * 128 * 1024;
    w.t_rl = WSB(WT_RL) + (size_t)l * 128 * 1024;
    return w;
}

template <int MODE>
DI int wt_col(int np, int Nsrc) {
    if (MODE == 0) return np < Nsrc ? np : -1;
    if (MODE == 2) return np < 1024 ? np : (np < 2656 ? np + 12 : (np < 2668 ? 1024 + (np - 2656) : (np < 2688 ? -1 : (np < 6784 ? np - 20 : -1))));
    const int pn = np >> 8, bj = (np >> 7) & 1, q = np & 127; return (bj ? 512 : 0) + 128 * pn + q;
}
template <int MODE>
DI void job_wt(const float* src, int nmat, int K, int Nsrc, bf16_t* dst, int Npad, int bid, int nblk, unsigned char* lds) {
    const int lane = tidx() & 63, wid = tidx() >> 6;
    bf16_t* tile = (bf16_t*)lds + wid * (64 * 72);
    const int tk = K / 64, tn = Npad / 64;
    const int tk2 = (tk + 1) / 2, tn4 = (tn + 3) / 4, per = tk2 * tn4;
    const int kl = lane >> 4, n4 = (lane & 15) * 4;
    for (int ub = bid; ub < nmat * per; ub += nblk) {
        const int mat = ub / per, ru = ub % per, kt = (ru % tk2) * 2 + (wid & 1), nt = (ru / tk2) * 4 + (wid >> 1);
        if (kt >= tk || nt >= tn) continue;
        const int k0 = kt * 64, n0 = nt * 64;
        const float* s = src + (size_t)mat * K * Nsrc;
        bf16_t* d = dst + (size_t)mat * Npad * K;
        const int col = wt_col<MODE>(n0 + n4, Nsrc);
        float4 v[16];
#pragma unroll
        for (int ps = 0; ps < 16; ++ps) v[ps] = col >= 0 ? *(const float4*)(s + (size_t)(k0 + kl + 4 * ps) * Nsrc + col) : make_float4(0.f, 0.f, 0.f, 0.f);
#pragma unroll
        for (int ps = 0; ps < 16; ++ps) { const int k = kl + 4 * ps;
            tile[(n4 + 0) * 72 + k] = f2bf(v[ps].x); tile[(n4 + 1) * 72 + k] = f2bf(v[ps].y); tile[(n4 + 2) * 72 + k] = f2bf(v[ps].z); tile[(n4 + 3) * 72 + k] = f2bf(v[ps].w); }
        __builtin_amdgcn_fence(__ATOMIC_RELEASE, "wavefront"); __builtin_amdgcn_wave_barrier(); __builtin_amdgcn_fence(__ATOMIC_ACQUIRE, "wavefront");
#pragma unroll
        for (int c8 = 0; c8 < 8; ++c8) { const int c = lane + 64 * c8, n2 = c >> 3, kc = (c & 7) * 8;
            *(uint4*)(d + (size_t)(n0 + n2) * K + k0 + kc) = *(const uint4*)(tile + n2 * 72 + kc); }
        __builtin_amdgcn_fence(__ATOMIC_RELEASE, "wavefront"); __builtin_amdgcn_wave_barrier(); __builtin_amdgcn_fence(__ATOMIC_ACQUIRE, "wavefront");
    }
}
DI void job_cvt(const float* src, bf16_t* dst, long n, int bid, int nblk) {
    for (long e = ((long)bid * NT + tidx()) * 4; e < n; e += (long)nblk * NT * 4) {
        const float4 v = *(const float4*)(src + e);
        st4bf(dst + e, v.x, v.y, v.z, v.w);
    }
}
DI void job_cmp_gather(const Params& p, const LayerW& w, int bid, int nblk) {
    const bf16_t* H = WSB(WS_H); bf16_t* TB = WSB(WS_TBB);
    const long total = (long)2 * NCR * 2048 / 8;
    for (long e = (long)bid * NT + tidx(); e < total; e += (long)nblk * NT) {
        const long e8 = e * 8;
        const int f = (int)(e8 % 2048); const long r2 = e8 / 2048; const int r = (int)(r2 % NCR), j = (int)(r2 / NCR);
        const int g = r & 1, bc = r >> 1, c = bc % NCMP, b = bc / NCMP, i = f >> 6, d = f & 63;
        float hv[8];
        ld8f(H + (long)(b * SEQ + 16 * c + i) * NH + (j ? O_AVC : O_AKC) + g * 64 + d, hv);
        const float4 p0 = *(const float4*)(w.cmp_pos + (j * 32 + i) * 64 + d), p1 = *(const float4*)(w.cmp_pos + (j * 32 + i) * 64 + d + 4);
        hv[0] += p0.x; hv[1] += p0.y; hv[2] += p0.z; hv[3] += p0.w; hv[4] += p1.x; hv[5] += p1.y; hv[6] += p1.z; hv[7] += p1.w;
        st8bf(TB + ((long)j * 2048 + r) * 2048 + f, hv);
    }
}
DI void job_rnn_conv(const Params& p, const LayerW& w, int bid, int nblk) {
    const bf16_t* H = WSB(WS_H); float* U = WSF(WS_U); bf16_t* UB = WSB(WS_UB);
    for (long e = (long)bid * NT + tidx(); e < (long)T * 64; e += (long)nblk * NT) {
        const int ch = (int)(e & 63) * 4; const int t = (int)(e >> 6), s = t & (SEQ - 1);
        const float4 cb = *(const float4*)(w.conv_b + ch);
        float u0 = cb.x, u1 = cb.y, u2 = cb.z, u3 = cb.w;
#pragma unroll
        for (int tap = 0; tap < 4; ++tap) { const int sp = s - 3 + tap;
            if (sp >= 0) { const float4 hv = ld4bf(H + (long)(t - 3 + tap) * NH + O_CX + ch); const float4 cw = *(const float4*)(w.conv_w + tap * 256 + ch);
                u0 += hv.x * cw.x; u1 += hv.y * cw.y; u2 += hv.z * cw.z; u3 += hv.w * cw.w; } }
        *(float4*)(U + (long)t * 256 + ch) = make_float4(u0, u1, u2, u3); st4bf(UB + (long)t * 256 + ch, u0, u1, u2, u3);
    }
}
DI void job_rnn_gates(const Params& p, const LayerW& w, int bid, int nblk, unsigned char* lds) {
    const float* U = WSF(WS_U); float* RA = WSF(WS_RA); float* RB = WSF(WS_RB);
    for (int u = bid; u < (T / G_BM) * 4; u += nblk) {
        const int blk = u & 3, m0 = (u >> 2) * G_BM;
        MG g; g.A = WSB(WS_UB) + blk * 64; g.lda = 256; g.Wt = w.t_g + (size_t)blk * 128 * 64; g.ldw = 64; g.K = 64;
        f32x16 acc[2][2];
        mgemm_tile(g, 0, RowId{m0}, acc, lds);
        const int l = tidx() & 63, wv = tidx() >> 6, wm = wv % G_WM, wn = wv / G_WM;
#pragma unroll
        for (int tt = 0; tt < 2; ++tt)
#pragma unroll
            for (int i = 0; i < 4; ++i) {
                const long t = m0 + wm * 64 + tt * 32 + (l & 31); const int ch = blk * 64 + wn * 32 + 8 * i + 4 * (l >> 5);
                const float4 uv = *(const float4*)(U + t * 256 + ch);
                const float ua[4] = {uv.x, uv.y, uv.z, uv.w};
                float av[4], bv[4];
#pragma unroll
                for (int j = 0; j < 4; ++j) {
                    const float r = sigm_fast(acc[0][tt][4 * i + j] + w.ga_b[ch + j]), ig = sigm_fast(acc[1][tt][4 * i + j] + w.gx_b[ch + j]);
                    const float nl = -w.lam[ch + j];
                    const float sp = fmaxf(nl, 0.f) + __logf(1.f + __expf(-fabsf(nl)));
                    const float log_a = -8.0f * r * sp;
                    const float a = __expf(log_a);
                    av[j] = a; bv[j] = __builtin_amdgcn_sqrtf(fmaxf(1.f - a * a, 0.f)) * (ig * ua[j]);
                }
                *(float4*)(RA + t * 256 + ch) = make_float4(av[0], av[1], av[2], av[3]);
                *(float4*)(RB + t * 256 + ch) = make_float4(bv[0], bv[1], bv[2], bv[3]);
            }
    }
}
DI void job_rnn_scan1(const Params& p, int bid, int nblk) {
    const float* RA = WSF(WS_RA); const float* RB = WSF(WS_RB); float* SA = WSF(WS_SA); float* SH = WSF(WS_SH);
    for (int e = bid * NT + tidx(); e < BATCH * 32 * 256; e += nblk * NT) {
        const int ch = e & 255, bc = e >> 8;
        float ap = 1.f, hl = 0.f;
        for (int s0 = 0; s0 < 64; s0 += 8) {
            float av[8], bv[8];
#pragma unroll
            for (int i = 0; i < 8; ++i) { const long t = (long)bc * 64 + s0 + i; av[i] = RA[t * 256 + ch]; bv[i] = RB[t * 256 + ch]; }
#pragma unroll
            for (int i = 0; i < 8; ++i) { ap *= av[i]; hl = av[i] * hl + bv[i]; }
        }
        SA[e] = ap; SH[e] = hl;
    }
}
DI void job_rnn_scan2(const Params& p, int bid, int nblk) {
    const bf16_t* H = WSB(WS_H); const float* RA = WSF(WS_RA); const float* RB = WSF(WS_RB); const float* SA = WSF(WS_SA); const float* SH = WSF(WS_SH); bf16_t* BR = WSB(WS_BR);
    for (int e = bid * NT + tidx(); e < BATCH * 32 * 256; e += nblk * NT) {
        const int ch = e & 255, bc = e >> 8, chunk = bc & 31, b = bc >> 5;
        float h = 0.f;
#pragma unroll
        for (int c0 = 0; c0 < 32; c0 += 8) {
            float sa[8], sh[8];
#pragma unroll
            for (int i = 0; i < 8; ++i) { const int q = ((b * 32 + c0 + i) << 8) + ch; sa[i] = SA[q]; sh[i] = SH[q]; }
#pragma unroll
            for (int i = 0; i < 8; ++i) h = (c0 + i < chunk) ? sa[i] * h + sh[i] : h;
        }
        for (int s0 = 0; s0 < 64; s0 += 8) {
            float av[8], bv[8], gv[8];
#pragma unroll
            for (int i = 0; i < 8; ++i) { const long t = (long)bc * 64 + s0 + i; av[i] = RA[t * 256 + ch]; bv[i] = RB[t * 256 + ch]; gv[i] = bf2f(H[t * NH + O_CG + ch]); }
#pragma unroll
            for (int i = 0; i < 8; ++i) { const long t = (long)bc * 64 + s0 + i; h = av[i] * h + bv[i]; BR[t * 1024 + 2 * 256 + ch] = f2bf(h * gelu_tanh(gv[i])); }
        }
    }
}
DI void job_mla_norm(const Params& p, const LayerW& w, int bid, int nblk) {
    const bf16_t* H = WSB(WS_H); bf16_t* CQN = WSB(WS_CQNB); bf16_t* CKVN = WSB(WS_CKVNB); bf16_t* KM = WSB(WS_KM);
    const int lane = tidx() & 63, wid = tidx() >> 6;
    const bool isq = lane < 24, iskv = lane >= 32 && lane < 48;
    const int coff = isq ? O_DCQ + lane * 8 : O_DCKV + (lane - 32) * 8;
    float gn[8];
#pragma unroll
    for (int j = 0; j < 8; ++j) gn[j] = isq ? w.q_norm[lane * 8 + j] : (iskv ? w.kv_norm[(lane - 32) * 8 + j] : 0.f);
    for (int t = bid * (NT / 64) + wid; t < T; t += nblk * (NT / 64)) {
        const bf16_t* hr = H + (long)t * NH;
        float v[8];
        float ss = 0.f;
        if (isq || iskv) { ld8f(hr + coff, v);
#pragma unroll
            for (int j = 0; j < 8; ++j) ss += v[j] * v[j]; }
        const float sq = wave_sum(isq ? ss : 0.f), skv = wave_sum(iskv ? ss : 0.f);
        const float rs = isq ? rsqrtf(sq * (1.f / 192.f) + 1e-6f) : rsqrtf(skv * (1.f / 128.f) + 1e-6f);
        if (isq || iskv) {
#pragma unroll
            for (int j = 0; j < 8; ++j) v[j] = v[j] * rs * gn[j];
            if (isq) st8bf(CQN + (long)t * 192 + lane * 8, v); else st8bf(CKVN + (long)t * 128 + (lane - 32) * 8, v);
        }
        {
            const int i = lane & 15, hd = lane >> 4;
            const int s = t & (SEQ - 1);
            const float2 csn = *(const float2*)(WSF(WS_ROPE) + (s * 16 + i) * 2); const float cs = csn.x, sn = csn.y;
            const float x1 = bf2f(hr[O_DKR + i]), x2 = bf2f(hr[O_DKR + 16 + i]);
            KM[(long)t * 384 + hd * 96 + 64 + i] = f2bf(x1 * cs - x2 * sn);
            KM[(long)t * 384 + hd * 96 + 80 + i] = f2bf(x1 * sn + x2 * cs);
        }
    }
}
DI void job_mla_up(const Params& p, const LayerW& w, int bid, int nblk, unsigned char* lds) {
    bf16_t* QB = WSB(WS_QB); bf16_t* KM = WSB(WS_KM); bf16_t* VM = WSB(WS_VM);
    constexpr int TM = T / G_BM;
    for (int u = bid; u < TM * 7; u += nblk) {
        const int mt = u / 7, nt = u % 7, m0 = mt * G_BM;
        f32x16 acc[2][2];
        const int l = tidx() & 63, wv = tidx() >> 6, wm = wv % G_WM, wn = wv / G_WM, hh = l >> 5;
        if (nt < 3) {
            MG g; g.A = WSB(WS_CQNB); g.lda = 192; g.Wt = w.t_uq; g.ldw = 192; g.K = 192;
            const int n0 = nt * 128;
            mgemm_tile(g, n0, RowId{m0}, acc, lds);
#pragma unroll
            for (int ft = 0; ft < 2; ++ft) {
                const int fb = (n0 + wn * 64 + ft * 32) >> 5;
                if (fb % 3 == 2) {
#pragma unroll
                    for (int tt = 0; tt < 2; ++tt) {
                        const int pos = (m0 + wm * 64 + tt * 32 + (l & 31)) & (SEQ - 1);
#pragma unroll
                        for (int i = 0; i < 2; ++i)
#pragma unroll
                            for (int j = 0; j < 4; ++j) {
                                const int fi = 8 * i + 4 * hh + j;
                                const float2 csn = *(const float2*)(WSF(WS_ROPE) + (pos * 16 + fi) * 2); const float cs = csn.x, sn = csn.y;
                                const float x1 = acc[ft][tt][4 * i + j], x2 = acc[ft][tt][4 * (i + 2) + j];
                                acc[ft][tt][4 * i + j] = x1 * cs - x2 * sn; acc[ft][tt][4 * (i + 2) + j] = x1 * sn + x2 * cs;
                            }
                    }
                }
            }
            MG_FOREACH(acc, lrow, feat, v, { st4bf(QB + (long)(m0 + lrow) * 384 + n0 + feat, v[0], v[1], v[2], v[3]); });
        } else {
            MG g; g.A = WSB(WS_CKVNB); g.lda = 128; g.Wt = w.t_ukv; g.ldw = 128; g.K = 128;
            const int n0 = (nt - 3) * 128;
            mgemm_tile(g, n0, RowId{m0}, acc, lds);
            MG_FOREACH(acc, lrow, feat, v, {
                const int hd = nt - 3;
                if (feat < 64) st4bf(KM + (long)(m0 + lrow) * 384 + hd * 96 + feat, v[0], v[1], v[2], v[3]);
                else st4bf(VM + (long)(m0 + lrow) * 256 + hd * 64 + (feat - 64), v[0], v[1], v[2], v[3]); });
        }
    }
}
template <int STAGE>
DI void job_cmp_mlp(const Params& p, const LayerW& w, int bid, int nblk, unsigned char* lds) {
    constexpr int TM = 2048 / G_BM, TN = STAGE == 0 ? 2 : 1;
    for (int u = bid; u < 2 * TM * TN; u += nblk) {
        const int j = u / (TM * TN), ru = u % (TM * TN), mt = ru / TN, nt = ru % TN, m0 = mt * G_BM, n0 = nt * 128;
        MG g;
        if (STAGE == 0) { g.A = WSB(WS_TBB) + (size_t)j * 2048 * 2048; g.lda = 2048; g.Wt = w.t_c1 + (size_t)j * 256 * 2048; g.ldw = 2048; g.K = 2048; }
        else { g.A = WSB(WS_HIDB) + (size_t)j * 2048 * 256; g.lda = 256; g.Wt = w.t_c2 + (size_t)j * 128 * 256; g.ldw = 256; g.K = 256; }
        f32x16 acc[2][2];
        mgemm_tile(g, n0, [&](int r) { const int rr = m0 + r; return (long)(rr < NCR ? rr : NCR - 1); }, acc, lds);
        if (STAGE == 0) {
            bf16_t* HID = WSB(WS_HIDB) + (size_t)j * 2048 * 256;
            MG_FOREACH(acc, lrow, feat, v, { st4bf(HID + (long)(m0 + lrow) * 256 + n0 + feat, gelu_tanh(v[0]), gelu_tanh(v[1]), gelu_tanh(v[2]), gelu_tanh(v[3])); });
        } else {
            bf16_t* KC = WSB(WS_KCB) + (size_t)j * NCR * 64;
            MG_FOREACH(acc, lrow, feat, v, { if (feat < 64 && m0 + lrow < NCR) st4bf(KC + (long)(m0 + lrow) * 64 + feat, v[0], v[1], v[2], v[3]); });
        }
    }
}
DI void job_router_logits(const Params& p, const LayerW& w, int bid, int nblk, unsigned char* lds) {
    float* LOG = WSF(WS_LOG);
    for (int u = bid; u < 4 * (T / G_BM); u += nblk) {
        const int kq = u / (T / G_BM), m0 = (u % (T / G_BM)) * G_BM;
        f32x16 acc[2][2];
        MG g; g.lda = 1024; g.ldw = 1024; g.K = 256;
        g.A = WSB(WS_XBB) + kq * 256; g.Wt = w.t_rh + kq * 256;
        mgemm_tile(g, 0, RowId{m0}, acc, lds, true);
        float* dst = LOG + (size_t)kq * T * 36;
        MG_FOREACH(acc, lrow, feat, v, { if (feat < 36) *(float4*)(dst + (long)(m0 + lrow) * 36 + feat) = make_float4(v[0], v[1], v[2], v[3]); });
    }
}
DI void job_pack_small(const Params& p, int bid, int nblk) {
    bf16_t* TG = WSB(WT_G); bf16_t* RH = WSB(WT_RH); bf16_t* RL = WSB(WT_RL);
    for (int e = bid * NT + tidx(); e < SEQ * 16; e += nblk * NT) {
        const int i = e & 15, pos = e >> 4;
        const float inv = powf(10000.f, -(float)(2 * i) / 32.f);
        const float ang = (float)pos * inv;
        WSF(WS_ROPE)[e * 2] = cosf(ang); WSF(WS_ROPE)[e * 2 + 1] = sinf(ang);
    }
    for (int e = bid * NT + tidx(); e < DEPTH * 4 * 128 * 64; e += nblk * NT) {
        const int c = e & 63, q = (e >> 6) & 127, lb = e >> 13;
        const int seg = q >> 5, i = q & 31, chl = (seg >> 1) * 32 + i;
        const float* src = (seg & 1) ? p.in[10] : p.in[8];
        TG[e] = f2bf(src[((size_t)lb * 64 + c) * 64 + chl]);
    }
    for (int e = bid * NT + tidx(); e < DEPTH * 128 * 1024; e += nblk * NT) {
        const int k = e & 1023, n = (e >> 10) & 127, l = e >> 17;
        float v = 0.f;
        if (n < 4) v = p.in[26][((size_t)l * 1024 + k) * 4 + n];
        else if (n < 36) v = p.in[28][((size_t)l * 1024 + k) * 32 + (n - 4)];
        const bf16_t hi = f2bf(v);
        RH[e] = hi; RL[e] = f2bf(v - bf2f(hi));
    }
}

DI void job_merge(const Params& p, const LayerW& w, int bid, int nblk, unsigned char* lds) {
    const bf16_t* H = WSB(WS_H); bf16_t* M = WSB(WS_M);
    for (int u0 = bid; u0 < (T / G_BM) * 8; u0 += nblk) {
        int u = u0;
        if ((nblk & 7) == 0) { const int per = nblk >> 3, x = u0 & 7, q = u0 >> 3, ul = (q % per) + per * (q / per);
            u = ((x + 8 * (ul >> 3)) << 3) + (ul & 7); }
        const int m0 = (u >> 3) * G_BM, n0 = (u & 7) * G_BN;
        f32x16 macc[2][2];
#pragma unroll
        for (int a = 0; a < 2; ++a)
#pragma unroll
            for (int b = 0; b < 2; ++b)
#pragma unroll
                for (int i = 0; i < 16; ++i) macc[a][b][i] = 0.f;
        MG g; g.A = WSB(WS_BR); g.lda = 1024; g.Wt = w.t_br; g.ldw = 1024; g.K = 1024;
        f32x16 acc[2][2];
        uint2 gq[2][2][4];
        mgemm_tile_f(g, n0, RowId{m0}, acc, lds, true, 4, [&](int n, f32x16 (&a)[2][2]) {
#pragma unroll
            for (int ft = 0; ft < 2; ++ft)
#pragma unroll
                for (int tt = 0; tt < 2; ++tt)
#pragma unroll
                    for (int i = 0; i < 4; ++i) {
                        const uint2 q = gq[ft][tt][i];
                        macc[ft][tt][4 * i] += bflo(q.x) * a[ft][tt][4 * i]; macc[ft][tt][4 * i + 1] += bfhi(q.x) * a[ft][tt][4 * i + 1];
                        macc[ft][tt][4 * i + 2] += bflo(q.y) * a[ft][tt][4 * i + 2]; macc[ft][tt][4 * i + 3] += bfhi(q.y) * a[ft][tt][4 * i + 3];
                        a[ft][tt][4 * i] = 0.f; a[ft][tt][4 * i + 1] = 0.f; a[ft][tt][4 * i + 2] = 0.f; a[ft][tt][4 * i + 3] = 0.f;
                    }
        }, [&](int n) {
            const int l = tidx() & 63, wv = tidx() >> 6, wm = wv % G_WM, wn = wv / G_WM;
#pragma unroll
            for (int ft = 0; ft < 2; ++ft)
#pragma unroll
                for (int tt = 0; tt < 2; ++tt)
#pragma unroll
                    for (int i = 0; i < 4; ++i) {
                        const int lrow = wm * 64 + tt * 32 + (l & 31), feat = wn * 64 + ft * 32 + 8 * i + 4 * (l >> 5);
                        gq[ft][tt][i] = *(const uint2*)(H + (long)(m0 + lrow) * NH + O_MG + n * 1024 + n0 + feat);
                    }
        });
        MG_FOREACH(macc, lrow, feat, v, { st4bf(M + (long)(m0 + lrow) * 1024 + n0 + feat, v[0], v[1], v[2], v[3]); });
    }
}
DI int pad_rows(int c) { return (c + G_BM - 1) / G_BM * G_BM; }
DI void job_ln(const float* xin, const bf16_t* xinb, const bf16_t* xinl, const bf16_t* y, const int* eidx, const int* eslot, unsigned* cnt, const float* ew, const float* gw, const float* bw, float* out, bf16_t* outb, bf16_t* outl, int bid, int nblk, unsigned char* lds) {
    const int lane = tidx() & 63, wid = tidx() >> 6;
    int* s_base = (int*)lds;
    if (eidx) {
        __syncthreads();
        if (tidx() < 32) s_base[32 + tidx()] = pad_rows((int)__hip_atomic_load(&cnt[tidx()], __ATOMIC_RELAXED, __HIP_MEMORY_SCOPE_AGENT));
        __syncthreads();
        if (tidx() == 0) { int o = 0; for (int e = 0; e < 32; ++e) { s_base[e] = o; o += s_base[32 + e]; } }
        __syncthreads();
    }
    float gv[16], bv[16];
#pragma unroll
    for (int i = 0; i < 2; ++i)
#pragma unroll
        for (int j = 0; j < 8; j += 4) { const int c = i * 512 + lane * 8 + j; const float4 g4 = *(const float4*)(gw + c), b4 = *(const float4*)(bw + c);
            gv[i * 8 + j] = g4.x; gv[i * 8 + j + 1] = g4.y; gv[i * 8 + j + 2] = g4.z; gv[i * 8 + j + 3] = g4.w; bv[i * 8 + j] = b4.x; bv[i * 8 + j + 1] = b4.y; bv[i * 8 + j + 2] = b4.z; bv[i * 8 + j + 3] = b4.w; }
    for (int t = bid * (NT / 64) + wid; t < T; t += nblk * (NT / 64)) {
        float v[16];
        float s = 0.f;
        int r0 = 0, r1 = 0; float w0 = 0.f, w1 = 0.f;
        if (eidx) { r0 = s_base[eidx[t * 2]] + eslot[t * 2]; r1 = s_base[eidx[t * 2 + 1]] + eslot[t * 2 + 1]; w0 = ew[t * 2]; w1 = ew[t * 2 + 1]; }
#pragma unroll
        for (int i = 0; i < 2; ++i) {
            const int c = i * 512 + lane * 8;
            float xv[8], yv[8];
            if (xin) { const float4 a = *(const float4*)(xin + (long)t * 1024 + c), b = *(const float4*)(xin + (long)t * 1024 + c + 4);
                xv[0] = a.x; xv[1] = a.y; xv[2] = a.z; xv[3] = a.w; xv[4] = b.x; xv[5] = b.y; xv[6] = b.z; xv[7] = b.w; }
            else ld8f(xinb + (long)t * 1024 + c, xv);
            if (xinl) { float z[8]; ld8f(xinl + (long)t * 1024 + c, z);
#pragma unroll
                for (int j = 0; j < 8; ++j) xv[j] += z[j]; }
            if (!eidx) ld8f(y + (long)t * 1024 + c, yv);
            else { float z0[8], z1[8]; ld8f(y + (long)r0 * 1024 + c, z0); ld8f(y + (long)r1 * 1024 + c, z1);
#pragma unroll
                for (int j = 0; j < 8; ++j) yv[j] = w0 * z0[j] + w1 * z1[j]; }
#pragma unroll
            for (int j = 0; j < 8; ++j) { v[i * 8 + j] = DN_ALPHA * xv[j] + yv[j]; s += v[i * 8 + j]; }
        }
        float q = 0.f;
#pragma unroll
        for (int i = 0; i < 16; ++i) q += v[i] * v[i];
        wave_sum2(s, q);
        const float mu = s * (1.f / 1024.f);
        const float rstd = rsqrtf(fmaxf(q * (1.f / 1024.f) - mu * mu, 0.f) + 1e-5f);
#pragma unroll
        for (int i = 0; i < 2; ++i) {
            const int c = i * 512 + lane * 8;
            float o[8];
#pragma unroll
            for (int j = 0; j < 8; ++j) o[j] = (v[i * 8 + j] - mu) * rstd * gv[i * 8 + j] + bv[i * 8 + j];
            if (out) { *(float4*)(out + (long)t * 1024 + c) = make_float4(o[0], o[1], o[2], o[3]); *(float4*)(out + (long)t * 1024 + c + 4) = make_float4(o[4], o[5], o[6], o[7]); }
            if (outb) st8bf(outb + (long)t * 1024 + c, o);
            if (outl) { float lo[8];
#pragma unroll
                for (int j = 0; j < 8; ++j) lo[j] = o[j] - bf2f(f2bf(o[j]));
                st8bf(outl + (long)t * 1024 + c, lo); }
        }
    }
}
DI void job_router(const Params& p, const LayerW& w, int layer, int bid, int nblk) {
    const float* LOG = WSF(WS_LOG); int* EIDX = WSI(WS_EIDX); int* ESLOT = WSI(WS_ESLOT); float* EW = WSF(WS_EW);
    unsigned* cnt = WSU(WS_CTL) + CW_CNT + layer * 32;
    for (int t = bid * NT + tidx(); t < T; t += nblk * NT) {
        const float* lr = LOG + (long)t * 36; const float* lr1 = lr + (size_t)T * 36; const float* lr2 = lr1 + (size_t)T * 36; const float* lr3 = lr2 + (size_t)T * 36;
#define LG(i) ((lr[i] + lr1[i]) + (lr2[i] + lr3[i]))
        const float g0 = LG(0) + w.rg_b[0], g1 = LG(1) + w.rg_b[1], g2 = LG(2) + w.rg_b[2], g3 = LG(3) + w.rg_b[3];
        const float gm = fmaxf(fmaxf(g0, g1), fmaxf(g2, g3));
        const float e0 = expf(g0 - gm), e1 = expf(g1 - gm), e2 = expf(g2 - gm), e3 = expf(g3 - gm);
        const float gs = (e0 + e1) + (e2 + e3);
        const float p0 = e0 / gs, p1 = e1 / gs, p2 = e2 / gs, p3 = e3 / gs;
        int grp = 0; float pg = p0;
        if (p1 > pg) { pg = p1; grp = 1; }
        if (p2 > pg) { pg = p2; grp = 2; }
        if (p3 > pg) { pg = p3; grp = 3; }
        float el[8];
#pragma unroll
        for (int i = 0; i < 8; ++i) el[i] = LG(4 + grp * 8 + i) + w.re_b[grp * 8 + i];
#undef LG
        float em = el[0];
#pragma unroll
        for (int i = 1; i < 8; ++i) em = fmaxf(em, el[i]);
        float es = 0.f;
#pragma unroll
        for (int i = 0; i < 8; ++i) { el[i] = expf(el[i] - em); es += el[i]; }
#pragma unroll
        for (int i = 0; i < 8; ++i) el[i] = el[i] / es;
        float b0 = el[0]; int i0 = 0;
#pragma unroll
        for (int i = 1; i < 8; ++i) if (el[i] > b0) { b0 = el[i]; i0 = i; }
        float b1 = -1.f; int i1 = 0;
#pragma unroll
        for (int i = 0; i < 8; ++i) if (i != i0 && el[i] > b1) { b1 = el[i]; i1 = i; }
        const float den = b0 + b1;
        const int ex0 = grp * 8 + i0, ex1 = grp * 8 + i1;
        EIDX[t * 2] = ex0; EIDX[t * 2 + 1] = ex1;
        EW[t * 2] = pg * b0 / den; EW[t * 2 + 1] = pg * b1 / den;
        const int s0 = (int)atomicAdd(&cnt[ex0], 1u), s1 = (int)atomicAdd(&cnt[ex1], 1u);
        ESLOT[t * 2] = s0; ESLOT[t * 2 + 1] = s1;
        WSI(WS_PERM)[ex0 * PCAP + s0] = t * 2; WSI(WS_PERM)[ex1 * PCAP + s1] = t * 2 + 1;
    }
}
DI pg8::ListOrder moe_units(unsigned* cnt, int bid, int nblk, unsigned char* lds) {
    pg8::ListOrder S; S.n = 0; S.u0 = S.u1 = S.u2 = pg8::Unit{0, 0, 0, 0, 0};
    int* s_cnt = (int*)lds;
    __syncthreads();
    if (tidx() < 32) s_cnt[tidx()] = (int)__hip_atomic_load(&cnt[tidx()], __ATOMIC_RELAXED, __HIP_MEMORY_SCOPE_AGENT);
    __syncthreads();
    int rt = 0, ub = 0;
    for (int e = 0; e < 32; ++e) {
        const int ce = s_cnt[e];
        const int c = pad_rows(ce) >> 8, ue = c * 4;
#pragma unroll
        for (int k = 0; k < 3; ++k) {
            const int L = bid + k * nblk;
            if (L >= ub && L < ub + ue) { const int lu = L - ub, mt = lu >> 2; const int nv = ce - mt * 256 < 256 ? ce - mt * 256 : 256;
                const pg8::Unit u{rt + mt, lu & 3, e, e * (PCAP / 256) + mt, nv};
                if (k == 0) S.u0 = u; else if (k == 1) S.u1 = u; else S.u2 = u;
                S.n = k + 1; }
        }
        rt += c; ub += ue;
    }
#define RFL(x) x = __builtin_amdgcn_readfirstlane(x)
    RFL(S.n); RFL(S.u0.pm); RFL(S.u0.pn); RFL(S.u0.e); RFL(S.u0.gt); RFL(S.u0.nv); RFL(S.u1.pm); RFL(S.u1.pn); RFL(S.u1.e); RFL(S.u1.gt); RFL(S.u1.nv);
    RFL(S.u2.pm); RFL(S.u2.pn); RFL(S.u2.e); RFL(S.u2.gt); RFL(S.u2.nv);
#undef RFL
    return S;
}

typedef short s16x4 __attribute__((ext_vector_type(4)));
typedef short v4i16_t __attribute__((ext_vector_type(4)));
DI unsigned cvtpk(float lo, float hi) { return pk_bf16(lo, hi); }
DI int crow(int reg, int h) { return (reg & 3) + 8 * (reg >> 2) + 4 * h; }
DI s16x4 tr_read(const unsigned char* p) { return __builtin_bit_cast(s16x4, __builtin_amdgcn_ds_read_tr16_b64_v4i16((LAS v4i16_t*)p)); }
DI float xhalf_max(float m) { auto rr = __builtin_amdgcn_permlane32_swap(__float_as_uint(m), __float_as_uint(m), false, false); return fmaxf(__uint_as_float(rr[0]), __uint_as_float(rr[1])); }
DI float xhalf_sum(float m) { auto rr = __builtin_amdgcn_permlane32_swap(__float_as_uint(m), __float_as_uint(m), false, false); return __uint_as_float(rr[0]) + __uint_as_float(rr[1]); }
DI float xhalf_other(float v, int h) { auto rr = __builtin_amdgcn_permlane32_swap(__float_as_uint(v), __float_as_uint(v), false, false); return __uint_as_float(h ? rr[0] : rr[1]); }
DI bf16x8 pack8(const f32x16& x, int s2) {
    u32x4 pk; pk[0] = cvtpk(x[8 * s2], x[8 * s2 + 1]); pk[1] = cvtpk(x[8 * s2 + 2], x[8 * s2 + 3]); pk[2] = cvtpk(x[8 * s2 + 4], x[8 * s2 + 5]); pk[3] = cvtpk(x[8 * s2 + 6], x[8 * s2 + 7]);
    return __builtin_bit_cast(bf16x8, pk);
}
constexpr int ATT_QB = (NT / 64) * 32;
template <int DC> struct TileCfg { static constexpr int RS = DC * 2 + 16, BYTES = 64 * RS, NCH = 64 * DC / 8, NI = (NCH + NT - 1) / NT; };
template <int DC, class RowPtr> DI void tile_gload(u32x4 (&rg)[TileCfg<DC>::NI], RowPtr rp) {
#pragma unroll
    for (int i = 0; i < TileCfg<DC>::NI; ++i) { const int c = tidx() + NT * i; if (c < TileCfg<DC>::NCH) { const int row = c / (DC / 8), cc = c % (DC / 8); rg[i] = *(const u32x4*)(rp(row) + cc * 8); } }
}
template <int DC> DI void tile_lstore(const u32x4 (&rg)[TileCfg<DC>::NI], unsigned char* base) {
#pragma unroll
    for (int i = 0; i < TileCfg<DC>::NI; ++i) { const int c = tidx() + NT * i; if (c < TileCfg<DC>::NCH) { const int row = c / (DC / 8), cc = c % (DC / 8); *(u32x4*)(base + row * TileCfg<DC>::RS + cc * 16) = rg[i]; } }
}
template <int DK> DI void qk_tile(f32x16 (&s)[2], const bf16x8 (&qf)[DK / 16], const unsigned char* kl, int r, int h) {
    constexpr int RS = TileCfg<DK>::RS;
#pragma unroll
    for (int i = 0; i < 16; ++i) { s[0][i] = 0.f; s[1][i] = 0.f; }
#pragma unroll
    for (int ks = 0; ks < DK / 16; ++ks) {
        const bf16x8 k0 = *(const bf16x8*)(kl + r * RS + ks * 32 + h * 16), k1 = *(const bf16x8*)(kl + (32 + r) * RS + ks * 32 + h * 16);
        s[0] = __builtin_amdgcn_mfma_f32_32x32x16_bf16(k0, qf[ks], s[0], 0, 0, 0);
        s[1] = __builtin_amdgcn_mfma_f32_32x32x16_bf16(k1, qf[ks], s[1], 0, 0, 0);
    }
}
template <int DV> DI void pv_tile(f32x16 (&o)[DV / 32], const f32x16 (&pp)[2], const unsigned char* vl, int lane) {
    constexpr int RS = TileCfg<DV>::RS;
    const int h = lane >> 5, i16 = lane & 15, q = i16 >> 2, pq = i16 & 3, blk = (lane >> 4) & 1;
    const unsigned char* vb = vl + (4 * h + q) * RS + 2 * (16 * blk + 4 * pq);
#pragma unroll
    for (int kt = 0; kt < 2; ++kt)
#pragma unroll
        for (int s2 = 0; s2 < 2; ++s2) {
            const bf16x8 pf = pack8(pp[kt], s2);
#pragma unroll
            for (int dvt = 0; dvt < DV / 32; ++dvt) {
                const s16x4 lo = tr_read(vb + (kt * 32 + 16 * s2) * RS + dvt * 64), hi = tr_read(vb + (kt * 32 + 16 * s2 + 8) * RS + dvt * 64);
                const bf16x8 vf = __builtin_shufflevector(lo, hi, 0, 1, 2, 3, 4, 5, 6, 7);
                o[dvt] = __builtin_amdgcn_mfma_f32_32x32x16_bf16(vf, pf, o[dvt], 0, 0, 0);
            }
        }
}
constexpr float LOG2E = 1.4426950408889634f;
template <int DK, int DV, bool ALIBI, bool BOUNDARY, class ValidFn>
DI void softmax_tile(const bf16x8 (&qf)[DK / 16], f32x16 (&o)[DV / 32], float& m, float& l, const unsigned char* kl, const unsigned char* vl, int kb,
                     float c1, float sl2, int qpos, ValidFn valid, int lane) {
    const int r = lane & 31, h = lane >> 5;
    f32x16 s[2];
    qk_tile<DK>(s, qf, kl, r, h);
    const float base = ALIBI ? sl2 * (float)(kb + 4 * h - qpos) : 0.f;
    float tmax = -INFINITY;
#pragma unroll
    for (int kt = 0; kt < 2; ++kt)
#pragma unroll
        for (int i = 0; i < 16; ++i) {
            float v = ALIBI ? fmaf(s[kt][i], c1, fmaf(sl2, (float)(kt * 32 + (i & 3) + 8 * (i >> 2)), base)) : s[kt][i] * c1;
            if (BOUNDARY) v = valid(kb + kt * 32 + crow(i, h)) ? v : -INFINITY;
            s[kt][i] = v; tmax = fmaxf(tmax, v);
        }
    tmax = xhalf_max(tmax);
    const float mn = fmaxf(m, tmax);
    if (__any(mn > m)) {
        const float corr = __builtin_amdgcn_exp2f(m - mn);
        l *= corr;
#pragma unroll
        for (int dvt = 0; dvt < DV / 32; ++dvt)
#pragma unroll
            for (int i = 0; i < 16; ++i) o[dvt][i] *= corr;
        m = mn;
    }
    float ps = 0.f;
#pragma unroll
    for (int kt = 0; kt < 2; ++kt)
#pragma unroll
        for (int i = 0; i < 16; ++i) { const float pr = __builtin_amdgcn_exp2f(s[kt][i] - mn); s[kt][i] = pr; ps += pr; }
    l += ps;
    pv_tile<DV>(o, s, vl, lane);
}
template <int DK, int DV, bool ALIBI, class KPtr, class VPtr, class ValidFn, class InteriorFn>
DI void attn_stream(const bf16x8 (&qf)[DK / 16], f32x16 (&o)[DV / 32], float& m, float& l, unsigned tmask, int wave_qmax, int wave_kmin,
                    KPtr kp, VPtr vp, float c1, float sl2, int qpos, ValidFn valid, InteriorFn interior, unsigned char* lds) {
    unsigned char* kl = lds; unsigned char* vl = lds + TileCfg<DK>::BYTES;
    const int lane = tidx() & 63;
    u32x4 kA[TileCfg<DK>::NI], vA[TileCfg<DV>::NI], kB[TileCfg<DK>::NI], vB[TileCfg<DV>::NI];
    int ja = -1, jb = -1;
#define AS_NEXT(J, KR, VR) do { if (tmask) { J = __builtin_ctz(tmask); tmask &= tmask - 1; const int _j = J; \
        tile_gload<DK>(KR, [&](int row) { return kp(_j * 64 + row); }); tile_gload<DV>(VR, [&](int row) { return vp(_j * 64 + row); }); } else J = -1; } while (0)
#define AS_COMPUTE(J) do { const int _jc = (J); if (_jc * 64 <= wave_qmax && _jc * 64 + 63 >= wave_kmin) { \
        if (interior(_jc)) softmax_tile<DK, DV, ALIBI, false>(qf, o, m, l, kl, vl, _jc * 64, c1, sl2, qpos, valid, lane); \
        else softmax_tile<DK, DV, ALIBI, true>(qf, o, m, l, kl, vl, _jc * 64, c1, sl2, qpos, valid, lane); } } while (0)
    AS_NEXT(ja, kA, vA);
    AS_NEXT(jb, kB, vB);
    while (ja >= 0) {
        __syncthreads();
        tile_lstore<DK>(kA, kl); tile_lstore<DV>(vA, vl);
        __syncthreads();
        const int jc = ja;
        AS_NEXT(ja, kA, vA);
        AS_COMPUTE(jc);
        if (jb < 0) break;
        __syncthreads();
        tile_lstore<DK>(kB, kl); tile_lstore<DV>(vB, vl);
        __syncthreads();
        const int jd = jb;
        AS_NEXT(jb, kB, vB);
        AS_COMPUTE(jd);
    }
#undef AS_NEXT
#undef AS_COMPUTE
}

DI void job_mla_attn(const Params& p, int bid, int nblk, unsigned char* lds) {
    const bf16_t* QB = WSB(WS_QB); const bf16_t* KM = WSB(WS_KM); const bf16_t* VM = WSB(WS_VM); bf16_t* BR = WSB(WS_BR);
    constexpr int NQB = SEQ / ATT_QB, NU = BATCH * 4 * NQB;
    const int lane = tidx() & 63, wid = tidx() >> 6, r = lane & 31, h = lane >> 5;
    for (int u = bid; u < NU; u += nblk) {
        const int qblk = u / (BATCH * 4), bh = u % (BATCH * 4);
        const int b = bh >> 2, hd = bh & 3;
        const int q0 = qblk * ATT_QB, qw = q0 + wid * 32, qpos = qw + r;
        const long trow = (long)b * SEQ;
        bf16x8 qf[6];
#pragma unroll
        for (int ks = 0; ks < 6; ++ks) qf[ks] = *(const bf16x8*)(QB + (trow + qpos) * 384 + hd * 96 + ks * 16 + 8 * h);
        f32x16 o[2];
#pragma unroll
        for (int i = 0; i < 16; ++i) { o[0][i] = 0.f; o[1][i] = 0.f; }
        float m = -1e30f, l = 0.f;
        const int ntile = (q0 + ATT_QB - 1) / 64 + 1;
        const unsigned tmask = ntile >= 32 ? 0xffffffffu : ((1u << ntile) - 1u);
        attn_stream<96, 64, false>(qf, o, m, l, tmask, qw + 31, 0,
            [&](int row) { return KM + (trow + row) * 384 + hd * 96; },
            [&](int row) { return VM + (trow + row) * 256 + hd * 64; },
            0.10206207261596577f * LOG2E, 0.f, qpos,
            [&](int key) { return key <= qpos; }, [&](int j) { return j * 64 + 63 <= qw; }, lds);
        const float rl = 1.f / fmaxf(xhalf_sum(l), 1e-30f);
        bf16_t* dst = BR + (trow + qpos) * 1024 + 3 * 256 + hd * 64;
#pragma unroll
        for (int dvt = 0; dvt < 2; ++dvt)
#pragma unroll
            for (int i = 0; i < 4; ++i)
                st4bf(dst + dvt * 32 + 8 * i + 4 * h, o[dvt][4 * i] * rl, o[dvt][4 * i + 1] * rl, o[dvt][4 * i + 2] * rl, o[dvt][4 * i + 3] * rl);
    }
}
DI void job_cross_attn(const Params& p, int layer, int bid, int nblk, unsigned char* lds) {
    const bf16_t* XQ = WSB(WS_XQ); const bf16_t* KVM = WSB(WS_KVM) + (size_t)layer * 2048 * 1024; bf16_t* XO = WSB(WS_XO);
    constexpr int NQB = SEQ / ATT_QB, NU = BATCH * 4 * NQB;
    const int lane = tidx() & 63, wid = tidx() >> 6, r = lane & 31, h = lane >> 5;
    for (int u = bid; u < NU; u += nblk) {
        const int bh = u % (BATCH * 4), qblk = u / (BATCH * 4);
        const int b = bh >> 2, hd = bh & 3;
        const int qpos = qblk * ATT_QB + wid * 32 + r;
        const long trow = (long)b * SEQ;
        bf16x8 qf[8];
#pragma unroll
        for (int ks = 0; ks < 8; ++ks) qf[ks] = *(const bf16x8*)(XQ + (trow + qpos) * 512 + hd * 128 + ks * 16 + 8 * h);
        f32x16 o[4];
#pragma unroll
        for (int d = 0; d < 4; ++d)
#pragma unroll
            for (int i = 0; i < 16; ++i) o[d][i] = 0.f;
        float m = -1e30f, l = 0.f;
        attn_stream<128, 128, false>(qf, o, m, l, 0xFu, 1 << 30, 0,
            [&](int row) { return KVM + (long)(b * MEM_LEN + row) * 1024 + hd * 128; },
            [&](int row) { return KVM + (long)(b * MEM_LEN + row) * 1024 + 512 + hd * 128; },
            0.08838834764831845f * LOG2E, 0.f, qpos, [&](int) { return true; }, [&](int) { return true; }, lds);
        const float rl = 1.f / fmaxf(xhalf_sum(l), 1e-30f);
        bf16_t* dst = XO + (trow + qpos) * 512 + hd * 128;
#pragma unroll
        for (int dvt = 0; dvt < 4; ++dvt)
#pragma unroll
            for (int i = 0; i < 4; ++i)
                st4bf(dst + dvt * 32 + 8 * i + 4 * h, o[dvt][4 * i] * rl, o[dvt][4 * i + 1] * rl, o[dvt][4 * i + 2] * rl, o[dvt][4 * i + 3] * rl);
    }
}
DI float logsig_fast(float z) { return fminf(z, 0.f) - __logf(1.f + __expf(-fabsf(z))); }
DI void job_sb_attn(const Params& p, int bid, int nblk, unsigned char* lds) {
    const bf16_t* H = WSB(WS_H); bf16_t* BR = WSB(WS_BR);
    constexpr int NQB = SEQ / ATT_QB, NU = BATCH * 4 * NQB;
    const int lane = tidx() & 63, wid = tidx() >> 6, r = lane & 31, h = lane >> 5;
    unsigned char* kl = lds; unsigned char* vl = lds + TileCfg<64>::BYTES;
    for (int u = bid; u < NU; u += nblk) {
        const int half = u / (NU / 2), ru = u % (NU / 2);
        const int qi = ru / (BATCH * 4), bh = ru % (BATCH * 4);
        const int qblk = half == 0 ? (NQB - 1 - qi) : qi;
        const int b = bh >> 2, hd = bh & 3;
        const int q0 = qblk * ATT_QB, qw = q0 + wid * 32, qpos = qw + r;
        const long trow = (long)b * SEQ;
        bf16x8 qf[4];
#pragma unroll
        for (int ks = 0; ks < 4; ++ks) qf[ks] = *(const bf16x8*)(H + (trow + qpos) * NH + O_BQ + hd * 64 + ks * 16 + 8 * h);
        f32x16 o[2];
#pragma unroll
        for (int i = 0; i < 16; ++i) { o[0][i] = 0.f; o[1][i] = 0.f; }
        float trun = 0.f;
        int j = (q0 + ATT_QB - 1) >> 6;
        volatile int* flag = (volatile int*)(lds + 2 * TileCfg<64>::BYTES);
        if (tidx() == 0) { flag[0] = 0; flag[1] = 0; }
        u32x4 kr[TileCfg<64>::NI], vr[TileCfg<64>::NI];
        tile_gload<64>(kr, [&](int row) { return H + (trow + j * 64 + row) * NH + O_BK + hd * 64; });
        tile_gload<64>(vr, [&](int row) { return H + (trow + j * 64 + row) * NH + O_BV + hd * 64; });
        for (int it = 0; j >= 0; --j, ++it) {
            __syncthreads();
            if (it > 0 && flag[(it - 1) & 1] == 0) break;
            tile_lstore<64>(kr, kl); tile_lstore<64>(vr, vl);
            __syncthreads();
            if (tidx() == 0) flag[(it + 1) & 1] = 0;
            if (j > 0) { const int jn = j - 1;
                tile_gload<64>(kr, [&](int row) { return H + (trow + jn * 64 + row) * NH + O_BK + hd * 64; });
                tile_gload<64>(vr, [&](int row) { return H + (trow + jn * 64 + row) * NH + O_BV + hd * 64; }); }
            const bool wave_dead = __all(trun < -110.f);
            if (j * 64 < qw + 31 && !wave_dead) {
                const int kb = j * 64;
                f32x16 s[2], L[2];
                qk_tile<64>(s, qf, kl, r, h);
#pragma unroll
                for (int kt = 0; kt < 2; ++kt)
#pragma unroll
                    for (int i = 0; i < 16; ++i) {
                        const int key = kb + kt * 32 + crow(i, h);
                        const float z = s[kt][i] * 0.125f, lsp = logsig_fast(z);
                        const bool valid = key < qpos;
                        L[kt][i] = valid ? lsp - z : 0.f;
                        s[kt][i] = valid ? lsp : -INFINITY;
                    }
                float G[2][4], O[2][4];
#pragma unroll
                for (int kt = 0; kt < 2; ++kt)
#pragma unroll
                    for (int ig = 0; ig < 4; ++ig) { G[kt][ig] = (L[kt][4 * ig] + L[kt][4 * ig + 1]) + (L[kt][4 * ig + 2] + L[kt][4 * ig + 3]); O[kt][ig] = xhalf_other(G[kt][ig], h); }
                float run = trun;
#pragma unroll
                for (int kt = 1; kt >= 0; --kt)
#pragma unroll
                    for (int ig = 3; ig >= 0; --ig) {
                        const float t3 = run + (h == 0 ? O[kt][ig] : 0.f);
                        const float t2 = t3 + L[kt][4 * ig + 3], t1 = t2 + L[kt][4 * ig + 2], t0 = t1 + L[kt][4 * ig + 1];
                        s[kt][4 * ig + 3] = __expf(s[kt][4 * ig + 3] + t3); s[kt][4 * ig + 2] = __expf(s[kt][4 * ig + 2] + t2);
                        s[kt][4 * ig + 1] = __expf(s[kt][4 * ig + 1] + t1); s[kt][4 * ig + 0] = __expf(s[kt][4 * ig + 0] + t0);
                        run += G[kt][ig] + O[kt][ig];
                    }
                trun = run;
                pv_tile<64>(o, s, vl, lane);
            }
            if (!__all(trun < -110.f)) flag[it & 1] = 1;
        }
        bf16_t* dst = BR + (trow + qpos) * 1024 + 1 * 256 + hd * 64;
#pragma unroll
        for (int dvt = 0; dvt < 2; ++dvt)
#pragma unroll
            for (int i = 0; i < 4; ++i) st4bf(dst + dvt * 32 + 8 * i + 4 * h, o[dvt][4 * i], o[dvt][4 * i + 1], o[dvt][4 * i + 2], o[dvt][4 * i + 3]);
    }
}
constexpr int NSA_QB = (NT / 128) * 32;
DI void job_nsa(const Params& p, int bid, int nblk, unsigned char* lds) {
    const bf16_t* H = WSB(WS_H); const bf16_t* KCB = WSB(WS_KCB); const bf16_t* VCB = KCB + (size_t)NCR * 64;
    float* OACC = WSF(WS_OC); bf16_t* BR = WSB(WS_BR);
    constexpr int NQB = SEQ / NSA_QB, NU = BATCH * 2 * NQB;
    constexpr int TB_ = TileCfg<64>::BYTES;
    const int lane = tidx() & 63, wid = tidx() >> 6, r = lane & 31, h = lane >> 5;
    const int n = wid & 1, sub = wid >> 1;
    unsigned* orw = (unsigned*)(lds + 4 * TB_);
    float* impx = (float*)(lds + 4 * TB_ + 64);
    for (int u = bid; u < NU; u += nblk) {
        const int qblk = NQB - 1 - u / (BATCH * 2), bg = u % (BATCH * 2), b = bg >> 1, g = bg & 1;
        const int q0 = qblk * NSA_QB, qw = q0 + sub * 32, qpos = qw + r;
        const int head = g * 2 + n;
        const long trow = (long)b * SEQ;
        const bf16_t* hq_row = H + (trow + qpos) * NH;
        bf16x8 qf[1][4];
#pragma unroll
        for (int ks = 0; ks < 4; ++ks) qf[0][ks] = *(const bf16x8*)(hq_row + O_AQ + head * 64 + ks * 16 + 8 * h);
        const float sl = exp2f(-2.f * (float)(head + 1));
        const float gate0 = sigm(bf2f(hq_row[O_AG + head * 3 + 0])), gate1 = sigm(bf2f(hq_row[O_AG + head * 3 + 1])), gate2 = sigm(bf2f(hq_row[O_AG + head * 3 + 2]));
        float* oacc = OACC + (trow + qpos) * 256 + head * 64;
        __syncthreads();
        if (tidx() == 0) *orw = 0u;
        {
            u32x4 rg[TileCfg<64>::NI];
#pragma unroll
            for (int tl = 0; tl < 4; ++tl) {
                const bf16_t* src = (tl & 2) ? VCB : KCB; const int cb = (tl & 1) * 64;
                tile_gload<64>(rg, [&](int row) { const int c = cb + row < NCMP ? cb + row : NCMP - 1; return src + ((long)(b * NCMP + c) * 2 + g) * 64; });
                tile_lstore<64>(rg, lds + tl * TB_);
            }
        }
        __syncthreads();
        float imp[16];
        {
            f32x16 s[2][2];
            qk_tile<64>(s[0], qf[0], lds, r, h);
            qk_tile<64>(s[1], qf[0], lds + TB_, r, h);
            float tmax = -INFINITY;
#pragma unroll
            for (int tl = 0; tl < 2; ++tl)
#pragma unroll
                for (int kt = 0; kt < 2; ++kt)
#pragma unroll
                    for (int i = 0; i < 16; ++i) {
                        const int c = tl * 64 + kt * 32 + crow(i, h), dist = qpos - (16 * c + 31);
                        const float v = (c < NCMP && dist >= 0) ? s[tl][kt][i] * 0.125f - sl * (float)dist : -INFINITY;
                        s[tl][kt][i] = v; tmax = fmaxf(tmax, v);
                    }
            const float mn = fmaxf(xhalf_max(tmax), -1e30f);
            float ps = 0.f;
#pragma unroll
            for (int tl = 0; tl < 2; ++tl)
#pragma unroll
                for (int kt = 0; kt < 2; ++kt)
#pragma unroll
                    for (int i = 0; i < 16; ++i) { const float pr = __expf(s[tl][kt][i] - mn); s[tl][kt][i] = pr; ps += pr; }
            const float rl = 1.f / fmaxf(xhalf_sum(ps), 1e-30f);
            float P3[16];
#pragma unroll
            for (int tl = 0; tl < 2; ++tl)
#pragma unroll
                for (int kt = 0; kt < 2; ++kt) {
#pragma unroll
                    for (int ig = 0; ig < 4; ++ig) {
                        const float p0 = s[tl][kt][4 * ig] * rl, p1 = s[tl][kt][4 * ig + 1] * rl, p2 = s[tl][kt][4 * ig + 2] * rl, p3 = s[tl][kt][4 * ig + 3] * rl;
                        imp[tl * 8 + kt * 4 + ig] = (p0 + p1) + (p2 + 0.5f * p3);
                        P3[tl * 8 + kt * 4 + ig] = 0.5f * p3;
                    }
                    const float gs = rl * gate0;
#pragma unroll
                    for (int i = 0; i < 16; ++i) s[tl][kt][i] *= gs;
                }
#pragma unroll
            for (int idx = 0; idx < 16; ++idx) {
                const float pp = xhalf_other(P3[idx], h);
                float prevp;
                if (idx == 0) prevp = h ? pp : 0.f; else { const float ppm = xhalf_other(P3[idx - 1], h); prevp = h ? pp : ppm; }
                imp[idx] += prevp;
                impx[(wid * 16 + idx) * 64 + lane] = imp[idx];
            }
            f32x16 oc[2];
#pragma unroll
            for (int i = 0; i < 16; ++i) { oc[0][i] = 0.f; oc[1][i] = 0.f; }
            pv_tile<64>(oc, s[0], lds + 2 * TB_, lane);
            pv_tile<64>(oc, s[1], lds + 3 * TB_, lane);
#pragma unroll
            for (int dvt = 0; dvt < 2; ++dvt)
#pragma unroll
                for (int i = 0; i < 4; ++i) *(float4*)(oacc + dvt * 32 + 8 * i + 4 * h) = make_float4(oc[dvt][4 * i], oc[dvt][4 * i + 1], oc[dvt][4 * i + 2], oc[dvt][4 * i + 3]);
        }
        __syncthreads();
        unsigned sel = 0u;
        {
            const int cur = qpos >> 6;
#pragma unroll
            for (int idx = 0; idx < 16; ++idx) {
                const float other = impx[((wid ^ 1) * 16 + idx) * 64 + lane];
                const float tot = n == 0 ? imp[idx] + other : other + imp[idx];
                const int j = 2 * idx + h;
                const bool forced = (j == 0) || (j == cur), valid = (j * 64 <= qpos);
                imp[idx] = forced ? 1e4f : (valid ? tot : -1.0f);
            }
#pragma unroll 1
            for (int it = 0; it < 8; ++it) {
                float best = -INFINITY; int bj = 64;
#pragma unroll
                for (int idx = 0; idx < 16; ++idx) if (imp[idx] > best) { best = imp[idx]; bj = 2 * idx + h; }
                const float pb = xhalf_other(best, h); const int pj = __float_as_int(xhalf_other(__int_as_float(bj), h));
                const bool own = (best > pb) || (best == pb && bj < pj);
                const int wj = own ? bj : pj;
                sel |= 1u << wj;
#pragma unroll
                for (int idx = 0; idx < 16; ++idx) if (2 * idx + h == wj) imp[idx] = -INFINITY;
            }
        }
        atomicOr(orw, sel);
        __syncthreads();
        const unsigned bmask = *orw;
        const int jhi = (q0 + NSA_QB - 1) >> 6;
        const unsigned upto = jhi >= 31 ? 0xffffffffu : ((1u << (jhi + 1)) - 1u);
        const float c1 = 0.125f * LOG2E, sl2 = sl * LOG2E;
        {
            f32x16 o[2];
#pragma unroll
            for (int i = 0; i < 16; ++i) { o[0][i] = 0.f; o[1][i] = 0.f; }
            float m = -1e30f, l = 0.f;
            const int jlo = (q0 - 511 > 0 ? q0 - 511 : 0) >> 6;
            const unsigned tmask = upto & ~((1u << jlo) - 1u);
            attn_stream<64, 64, true>(qf[0], o, m, l, tmask, qw + 31, qw - 511,
                [&](int row) { return H + (trow + row) * NH + O_AKW + g * 64; },
                [&](int row) { return H + (trow + row) * NH + O_AVW + g * 64; },
                c1, sl2, qpos,
                [&](int key) { const int dist = qpos - key; return dist >= 0 && dist < 512; },
                [&](int j) { return j * 64 + 63 <= qw && qw + 31 - j * 64 < 512; }, lds);
            const float rl = gate2 / fmaxf(xhalf_sum(l), 1e-30f);
#pragma unroll
            for (int dvt = 0; dvt < 2; ++dvt)
#pragma unroll
                for (int i = 0; i < 4; ++i) { float4* a = (float4*)(oacc + dvt * 32 + 8 * i + 4 * h); float4 c = *a;
                    c.x += o[dvt][4 * i] * rl; c.y += o[dvt][4 * i + 1] * rl; c.z += o[dvt][4 * i + 2] * rl; c.w += o[dvt][4 * i + 3] * rl; *a = c; }
        }
        {
            f32x16 o[2];
#pragma unroll
            for (int i = 0; i < 16; ++i) { o[0][i] = 0.f; o[1][i] = 0.f; }
            float m = -1e30f, l = 0.f;
            attn_stream<64, 64, true>(qf[0], o, m, l, bmask & upto, qw + 31, 0,
                [&](int row) { return H + (trow + row) * NH + O_AKS + g * 64; },
                [&](int row) { return H + (trow + row) * NH + O_AVS + g * 64; },
                c1, sl2, qpos,
                [&](int key) { return key <= qpos && ((sel >> (key >> 6)) & 1u); },
                [&](int j) { return j * 64 + 63 <= qw && __all((sel >> j) & 1u); }, lds);
            const float rl = gate1 / fmaxf(xhalf_sum(l), 1e-30f);
            bf16_t* dst = BR + (trow + qpos) * 1024 + head * 64;
#pragma unroll
            for (int dvt = 0; dvt < 2; ++dvt)
#pragma unroll
                for (int i = 0; i < 4; ++i) { const float4 c = *(const float4*)(oacc + dvt * 32 + 8 * i + 4 * h);
                    st4bf(dst + dvt * 32 + 8 * i + 4 * h, c.x + o[dvt][4 * i] * rl, c.y + o[dvt][4 * i + 1] * rl, c.z + o[dvt][4 * i + 2] * rl, c.w + o[dvt][4 * i + 3] * rl); }
        }
    }
}

namespace pg8 { typedef PG8_LAS unsigned char* PG8_LAS_T; }
#define LDS3 ((pg8::PG8_LAS_T)lds)
#define GEMM256(EPI, SCHED, g, S, E) do { __syncthreads(); pg8::gemm_phase<EPI, SCHED, true, true>(LDS3, g, S, E); } while (0)
constexpr int NPH = 17;
constexpr int NPHASES = 2 + DEPTH * NPH;

__global__ void __launch_bounds__(NT, 2) mega(Params pk, int ph_lo, int ph_hi) {
    extern __shared__ __attribute__((aligned(16))) unsigned char lds[];
    const int bid = blockIdx.x, nblk = gridDim.x;
#define XB_HERE XcdBarrier bar_; bar_.bar = (unsigned*)(pk.ws + WS_CTL) + CW_BAR; bar_.x = xb_xcc_id(); bar_.st = (volatile LAS unsigned*)(lds + 131072)
    const bool multi = (ph_hi - ph_lo) > 1;
    if (multi) {
        uint4* xbw = (uint4*)(lds + 131072);
        if (tidx() == 0) *xbw = make_uint4(0u, 0u, 0u, 0u);
        __syncthreads();
        (void)xcd_barrier_post((unsigned*)(pk.ws + WS_CTL) + CW_BAR, (volatile LAS unsigned*)xbw);
    }
#ifndef PROBE_PH
#define PROBE_PH -100
#endif
#define PHASE(id, ...) do { const int _id = (id); if (ph_lo <= _id && _id < ph_hi) { for (int _rep = 0; _rep < ((PROBE_PH == -1 ? _id < 2 : (_id >= 2 && (_id - 2) % NPH == PROBE_PH)) ? 2 : 1); ++_rep) { if (_rep) { XB_HERE; xcd_barrier(bar_); } { Params p = pk; int layer = layer_; asm volatile("" : "+s"(p.ws), "+s"(p.out), "+s"(layer)); \
        const LayerW w = layer_w(p, layer); const float* Xin = (layer == 0) ? p.in[0] : WSF(WS_XC); const bf16_t* XinB = (layer == 0) ? WSB(WS_X0B) : WSB(WS_XCB); float* Xout = (layer == DEPTH - 1) ? p.out : WSF(WS_XC); \
        (void)w; (void)Xin; (void)XinB; (void)Xout; __VA_ARGS__; } } if (_id + 1 < ph_hi) { XB_HERE; xcd_barrier(bar_); } } } while (0)

    { const int layer_ = 0;
    PHASE(0, {
        job_wt<2>(p.in[2], DEPTH, 1024, NIN, WSB(WT_IN), NH, bid, nblk, lds);
        job_wt<0>(p.in[17], DEPTH, 1024, 1024, WSB(WT_BR), 1024, bid, nblk, lds);
        job_wt<0>(p.in[18], DEPTH, 1024, 1024, WSB(WT_OUT), 1024, bid, nblk, lds);
        job_wt<0>(p.in[21], DEPTH, 1024, 512, WSB(WT_Q), 512, bid, nblk, lds);
        job_wt<0>(p.in[22], DEPTH, 1024, 1024, WSB(WT_KV), 1024, bid, nblk, lds);
        job_wt<0>(p.in[23], DEPTH, 512, 1024, WSB(WT_O), 1024, bid, nblk, lds);
        job_wt<1>(p.in[30], DEPTH * 32, 1024, 1024, WSB(WT_GU), 1024, bid, nblk, lds);
        job_wt<0>(p.in[31], DEPTH * 32, 512, 1024, WSB(WT_DN), 1024, bid, nblk, lds);
        job_wt<0>(p.in[4], DEPTH * 2, 2048, 256, WSB(WT_C1), 256, bid, nblk, lds);
        job_wt<0>(p.in[5], DEPTH * 2, 256, 64, WSB(WT_C2), 128, bid, nblk, lds);
        job_wt<0>(p.in[15], DEPTH, 192, 384, WSB(WT_UQ), 384, bid, nblk, lds);
        job_wt<0>(p.in[16], DEPTH, 128, 512, WSB(WT_UKV), 512, bid, nblk, lds);
        job_pack_small(p, bid, nblk);
        job_cvt(p.in[0], WSB(WS_X0B), (long)T * 1024, bid, nblk);
        job_cvt(p.in[1], WSB(WS_MEMB), (long)2048 * 1024, bid, nblk);
    });
    PHASE(1, {
        pg8::Gemm g{WSB(WS_MEMB), WSB(WT_KV), BATCH * MEM_LEN, 1024, 1024, nullptr};
        GroupedOrder S{8, 4, DEPTH, nblk, bid};
        EpiStoreBf16 E{WSB(WS_KVM), 1024, 1 << 30, (long)2048 * 1024};
        GEMM256(EpiStoreBf16, GroupedOrder, g, S, E);
    });
    }
    for (int layer_ = 0; layer_ < DEPTH; ++layer_) {
        const int base = 2 + layer_ * NPH;
        PHASE(base + 0, { pg8::Gemm g{XinB, w.t_in, T, NH, 1024, nullptr}; pg8::StaticOrder S; S.init(T, NH, nblk, bid); EpiStoreBf16 E{WSB(WS_H), NH, O_MG / 128, 0}; GEMM256(EpiStoreBf16, pg8::StaticOrder, g, S, E); });
        PHASE(base + 1, { job_sb_attn(p, bid, nblk, lds); job_cmp_gather(p, w, bid, nblk); job_rnn_conv(p, w, bid, nblk); job_mla_norm(p, w, bid, nblk); });
        PHASE(base + 2, { if (bid < 32) job_cmp_mlp<0>(p, w, bid, 32, lds); else { job_rnn_gates(p, w, bid - 32, nblk - 32, lds); job_mla_up(p, w, bid - 32, nblk - 32, lds); } });
        PHASE(base + 3, { job_cmp_mlp<1>(p, w, bid, nblk, lds); job_rnn_scan1(p, bid, nblk); });
        PHASE(base + 4, { job_nsa(p, bid, nblk, lds); job_mla_attn(p, bid, nblk, lds); job_rnn_scan2(p, bid, nblk); });
        PHASE(base + 5, { job_merge(p, w, bid, nblk, lds); });
        PHASE(base + 6, { pg8::Gemm g{WSB(WS_M), w.t_out, T, 1024, 1024, nullptr}; pg8::StaticOrder S; S.init(T, 1024, nblk, bid); EpiStoreBf16 E{WSB(WS_Y), 1024, 1 << 30, 0}; GEMM256(EpiStoreBf16, pg8::StaticOrder, g, S, E); });
        PHASE(base + 7, { job_ln(layer == 0 ? p.in[0] : nullptr, WSB(WS_XCB), nullptr, WSB(WS_Y), nullptr, nullptr, nullptr, nullptr, w.ln1_g, w.ln1_b, nullptr, WSB(WS_XAB), nullptr, bid, nblk, lds); });
        PHASE(base + 8, { pg8::Gemm g{WSB(WS_XAB), w.t_q, T, 512, 1024, nullptr}; pg8::StaticOrder S; S.init(T, 512, nblk, bid); EpiStoreBf16 E{WSB(WS_XQ), 512, 1 << 30, 0}; GEMM256(EpiStoreBf16, pg8::StaticOrder, g, S, E); });
        PHASE(base + 9, { job_cross_attn(p, layer, bid, nblk, lds); });
        PHASE(base + 10, { pg8::Gemm g{WSB(WS_XO), w.t_o, T, 1024, 512, nullptr}; pg8::StaticOrder S; S.init(T, 1024, nblk, bid); EpiStoreBf16 E{WSB(WS_Y), 1024, 1 << 30, 0}; GEMM256(EpiStoreBf16, pg8::StaticOrder, g, S, E); });
        PHASE(base + 11, { job_ln(nullptr, WSB(WS_XAB), nullptr, WSB(WS_Y), nullptr, nullptr, nullptr, nullptr, w.ln2_g, w.ln2_b, nullptr, WSB(WS_XBB), nullptr, bid, nblk, lds); });
        PHASE(base + 12, { job_router_logits(p, w, bid, nblk, lds); });
        PHASE(base + 13, { job_router(p, w, layer, bid, nblk); });
        PHASE(base + 14, { const pg8::ListOrder S = moe_units(WSU(WS_CTL) + CW_CNT + layer * 32, bid, nblk, lds); pg8::Gemm g{WSB(WS_XBB), w.t_gu, PADROWS, 1024, 1024, WSI(WS_PERM)}; EpiMoeGU E{WSB(WS_HH)}; __syncthreads(); pg8::gemm_phase<EpiMoeGU, pg8::ListOrder, true, true, true>(LDS3, g, S, E); });
        PHASE(base + 15, { const pg8::ListOrder S = moe_units(WSU(WS_CTL) + CW_CNT + layer * 32, bid, nblk, lds); pg8::Gemm g{WSB(WS_HH), w.t_dn, PADROWS, 1024, 512, nullptr}; EpiStoreBf16 E{WSB(WS_YK), 1024, 1 << 30, 0}; GEMM256(EpiStoreBf16, pg8::ListOrder, g, S, E); });
        PHASE(base + 16, { job_ln(nullptr, WSB(WS_XBB), nullptr, WSB(WS_YK), WSI(WS_EIDX), WSI(WS_ESLOT), WSU(WS_CTL) + CW_CNT + layer * 32, WSF(WS_EW), w.ln3_g, w.ln3_b, (layer == DEPTH - 1) ? p.out : nullptr, (layer == DEPTH - 1) ? nullptr : WSB(WS_XCB), nullptr, bid, nblk, lds); });
    }
}

extern "C" void kernel_launch(void* const* d_in, const int* in_sizes, int n_in, void* d_out, int out_size, void* d_ws, size_t ws_size, hipStream_t stream) {
    constexpr size_t kDynLds = 131072 + 1024;
    static_assert(2 * G_STAGE + 1024 <= 131072, "engine stages fit");
    static int grid = 0;
    if (!grid) {
        int dev = 0, cus = 0, per_cu = 0;
        (void)hipGetDevice(&dev);
        (void)hipDeviceGetAttribute(&cus, hipDeviceAttributeMultiprocessorCount, dev);
        (void)hipFuncSetAttribute((const void*)mega, hipFuncAttributeMaxDynamicSharedMemorySize, (int)kDynLds);
        (void)hipOccupancyMaxActiveBlocksPerMultiprocessor(&per_cu, mega, NT, kDynLds);
        if (per_cu < 1) per_cu = 1;
        grid = cus * (per_cu < 2 ? per_cu : 2);
    }
    if (ws_size < WS_END) { fprintf(stderr, "workspace too small: %zu < %zu\n", ws_size, (size_t)WS_END); return; }
    Params p{};
    for (int i = 0; i < 34; ++i) p.in[i] = (const float*)d_in[i];
    p.out = (float*)d_out;
    p.ws = (unsigned char*)d_ws;
    (void)hipMemsetAsync(d_ws, 0, CTL_BYTES, stream);
#if MK_ONE_LAUNCH
    hipLaunchKernelGGL(mega, dim3(grid), dim3(NT), kDynLds, stream, p, 0, NPHASES);
#else
    for (int ph = 0; ph < NPHASES; ++ph) hipLaunchKernelGGL(mega, dim3(grid), dim3(NT), kDynLds, stream, p, ph, ph + 1);
#endif
}
```

```cpp
#include <hip/hip_runtime.h>
#include <stdint.h>
#include <stdio.h>

#ifndef MK_ONE_LAUNCH
#define MK_ONE_LAUNCH 1
#endif

#define DI __device__ __forceinline__
#define LAS __attribute__((address_space(3)))
DI int tidx() { int t = threadIdx.x; asm volatile("" : "+v"(t)); return t; }

constexpr int NT = 512;
constexpr int D = 1024, BATCH = 8, SEQ = 2048, T = BATCH * SEQ, DEPTH = 4;
constexpr int MEM_LEN = 256;
constexpr int NIN = 6764, NH = 6912;
constexpr int O_AQ = 0, O_AKC = 256, O_AVC = 384, O_AKS = 512, O_AVS = 640, O_AKW = 768, O_AVW = 896,
              O_BQ = 1024, O_BK = 1280, O_BV = 1536, O_CX = 1792, O_CG = 2048, O_DCQ = 2304, O_DCKV = 2496, O_DKR = 2624,
              O_AG = 2656, O_MG = 2688;
constexpr int NCMP = 127, NCR = BATCH * NCMP * 2;
constexpr int NEXP = 32, NASSIGN = T * 2;
constexpr int PCAP = T;
constexpr float DN_ALPHA = 1.681792830507429f;

typedef unsigned short bf16_t;
typedef short bf16x8 __attribute__((ext_vector_type(8)));
typedef float f32x16 __attribute__((ext_vector_type(16)));
typedef unsigned u32x4 __attribute__((ext_vector_type(4)));

constexpr int G_WM = NT / 128;
constexpr int G_BM = 64 * G_WM;
constexpr int G_BN = 128;
constexpr int G_RS = 144;
constexpr int G_STAGE = (G_BM + G_BN) * G_RS;
constexpr int PADROWS = ((NASSIGN + NEXP * (G_BM - 1) + G_BM - 1) / G_BM) * G_BM;

constexpr size_t MiB = 1u << 20;
constexpr size_t al(size_t x) { return (x + 255) & ~(size_t)255; }
constexpr size_t WS_CTL = 0, CTL_BYTES = 1 * MiB;
constexpr size_t WT_IN = WS_CTL + CTL_BYTES;
constexpr size_t WT_BR = WT_IN + al((size_t)DEPTH * NH * 1024 * 2);
constexpr size_t WT_OUT = WT_BR + al((size_t)DEPTH * 4 * 1024 * 256 * 2);
constexpr size_t WT_Q = WT_OUT + al((size_t)DEPTH * 1024 * 1024 * 2);
constexpr size_t WT_KV = WT_Q + al((size_t)DEPTH * 512 * 1024 * 2);
constexpr size_t WT_O = WT_KV + al((size_t)DEPTH * 1024 * 1024 * 2);
constexpr size_t WT_GU = WT_O + al((size_t)DEPTH * 1024 * 512 * 2);
constexpr size_t WT_DN = WT_GU + al((size_t)DEPTH * 32 * 1024 * 1024 * 2);
constexpr size_t WS_X0B = WT_DN + al((size_t)DEPTH * 32 * 1024 * 512 * 2);
constexpr size_t WS_MEMB = WS_X0B + al((size_t)T * 1024 * 2);
constexpr size_t WS_H = WS_MEMB + al((size_t)2048 * 1024 * 2);
constexpr size_t SZ_H = al((size_t)T * NH * 2);
constexpr size_t WS_YK = WS_H;
constexpr size_t WS_HH = WS_YK + (size_t)PADROWS * 1024 * 2;
static_assert(WS_HH + (size_t)PADROWS * 512 * 2 <= WS_H + SZ_H, "moe overlay fits in H");
constexpr size_t WS_TB = WS_H + SZ_H;
constexpr size_t WS_HID = WS_TB + al((size_t)2 * NCR * 2048 * 4);
constexpr size_t WS_KCVC = WS_HID + al((size_t)2 * NCR * 256 * 4);
constexpr size_t WS_PC = WS_KCVC + al((size_t)2 * NCR * 64 * 4);
constexpr size_t WS_SEL = WS_PC + al((size_t)BATCH * 4 * SEQ * 128 * 4);
constexpr size_t WS_OW = WS_SEL + al((size_t)BATCH * 2 * SEQ * 4);
constexpr size_t WS_OC = WS_OW + al((size_t)T * 256 * 4);
constexpr size_t WS_BR = WS_OC + al((size_t)T * 256 * 4);
constexpr size_t WS_U = WS_BR + al((size_t)T * 1024 * 2);
constexpr size_t WS_RA = WS_U + al((size_t)T * 256 * 4);
constexpr size_t WS_RB = WS_RA + al((size_t)T * 256 * 4);
constexpr size_t WS_CQN = WS_RB + al((size_t)T * 256 * 4);
constexpr size_t WS_CKVN = WS_CQN + al((size_t)T * 192 * 4);
constexpr size_t WS_KR = WS_CKVN + al((size_t)T * 128 * 4);
constexpr size_t WS_Q = WS_KR + al((size_t)T * 32 * 4);
constexpr size_t WS_KV = WS_Q + al((size_t)T * 384 * 4);
constexpr size_t WS_M = WS_KV + al((size_t)T * 512 * 4);
constexpr size_t WS_Y = WS_M + al((size_t)T * 1024 * 2);
constexpr size_t WS_XA = WS_Y + al((size_t)T * 1024 * 4);
constexpr size_t WS_XB = WS_XA + al((size_t)T * 1024 * 4);
constexpr size_t WS_XC = WS_XB + al((size_t)T * 1024 * 4);
constexpr size_t WS_XAB = WS_XC + al((size_t)T * 1024 * 4);
constexpr size_t WS_XBB = WS_XAB + al((size_t)T * 1024 * 2);
constexpr size_t WS_XCB = WS_XBB + al((size_t)T * 1024 * 2);
constexpr size_t WS_XQ = WS_XCB + al((size_t)T * 1024 * 2);
constexpr size_t WS_XO = WS_XQ + al((size_t)T * 512 * 2);
constexpr size_t WS_KVM = WS_XO + al((size_t)T * 512 * 2);
constexpr size_t WS_LOG = WS_KVM + al((size_t)DEPTH * 2048 * 1024 * 2);
constexpr size_t WS_EIDX = WS_LOG + al((size_t)4 * T * 36 * 4);
constexpr size_t WS_ESLOT = WS_EIDX + al((size_t)NASSIGN * 4);
constexpr size_t WS_EW = WS_ESLOT + al((size_t)NASSIGN * 4);
constexpr size_t WS_PERM = WS_EW + al((size_t)NASSIGN * 4);
constexpr size_t WS_QB = WS_PERM + al((size_t)NEXP * T * 4);
constexpr size_t WS_KM = WS_QB + al((size_t)T * 384 * 2);
constexpr size_t WS_VM = WS_KM + al((size_t)T * 384 * 2);
constexpr size_t WS_KCB = WS_VM + al((size_t)T * 256 * 2);
constexpr size_t WT_C1 = WS_KCB + al((size_t)2 * NCR * 64 * 2);
constexpr size_t WT_C2 = WT_C1 + al((size_t)DEPTH * 2 * 256 * 2048 * 2);
constexpr size_t WT_UQ = WT_C2 + al((size_t)DEPTH * 2 * 128 * 256 * 2);
constexpr size_t WT_UKV = WT_UQ + al((size_t)DEPTH * 384 * 192 * 2);
constexpr size_t WT_G = WT_UKV + al((size_t)DEPTH * 512 * 128 * 2);
constexpr size_t WT_RH = WT_G + al((size_t)DEPTH * 4 * 128 * 64 * 2);
constexpr size_t WT_RL = WT_RH + al((size_t)DEPTH * 128 * 1024 * 2);
constexpr size_t WS_TBB = WT_RL + al((size_t)DEPTH * 128 * 1024 * 2);
constexpr size_t WS_HIDB = WS_TBB + al((size_t)2 * 2048 * 2048 * 2);
constexpr size_t WS_UB = WS_HIDB + al((size_t)2 * 2048 * 256 * 2);
constexpr size_t WS_CQNB = WS_UB + al((size_t)T * 256 * 2);
constexpr size_t WS_CKVNB = WS_CQNB + al((size_t)T * 192 * 2);
constexpr size_t WS_XBL = WS_CKVNB + al((size_t)T * 128 * 2);
constexpr size_t WS_SA = WS_XBL + al((size_t)T * 1024 * 2);
constexpr size_t WS_SH = WS_SA + al((size_t)BATCH * 32 * 256 * 4);
constexpr size_t WS_XG = WS_SH + al((size_t)BATCH * 32 * 256 * 4);
constexpr size_t WS_ROWOF = WS_XG + al((size_t)PADROWS * 1024 * 2);
constexpr size_t WS_ROPE_PRE = WS_ROWOF + al((size_t)NASSIGN * 4);
constexpr size_t WS_ROPE = WS_ROPE_PRE;
constexpr size_t WS_END = WS_ROPE + al((size_t)SEQ * 16 * 2 * 4);

constexpr int CW_BAR = 4096;
constexpr int CW_CNT = 16384;

struct Params {
    const float* in[34];
    float* out;
    unsigned char* ws;
};

#define XB_TMO      128
#define XB_XCNT(j)  (256  + 64 * (j))
#define XB_XSUB(j)  (1280 + 64 * (j))
#define XB_XGEN(j)  (2304 + 64 * (j))
#define XB_TOP      3328
#define XB_TOPGEN   3392
#define XCD_BAR_WORDS 3456
#define XB_SPIN_CAP (1u << 22)

__device__ __forceinline__ unsigned xb_ld(unsigned* p)              { return __hip_atomic_load(p, __ATOMIC_RELAXED, __HIP_MEMORY_SCOPE_AGENT); }
__device__ __forceinline__ unsigned xb_add(unsigned* p, unsigned v) { return __hip_atomic_fetch_add(p, v, __ATOMIC_RELAXED, __HIP_MEMORY_SCOPE_AGENT); }
__device__ __forceinline__ unsigned xb_xcc_id() { return (unsigned)__builtin_amdgcn_s_getreg((3 << 11) | 20) & 0xFu; }
#define XB_SPIN(cond, bar) do { unsigned _sp = 0; while (cond) { __builtin_amdgcn_s_sleep(1); \
    if ((++_sp & 255u) == 0u) { if (xb_ld(&(bar)[XB_TMO])) break; if (_sp > XB_SPIN_CAP) { atomicAdd(&(bar)[XB_TMO], 1u); break; } } } } while (0)

struct XcdBarrier { unsigned* bar; unsigned x; volatile LAS unsigned* st; };

__device__ __forceinline__ XcdBarrier xcd_barrier_post(unsigned* bar, volatile LAS unsigned* st) {
    XcdBarrier b; b.bar = bar; b.x = xb_xcc_id(); b.st = st;
    if (threadIdx.x == 0) (void)xb_add(&bar[XB_XCNT(b.x)], 1u);
    return b;
}
__device__ __forceinline__ void xcd_barrier_complete(unsigned* bar, unsigned x, unsigned& nloc, unsigned& nx) {
    const unsigned G = gridDim.x * gridDim.y * gridDim.z;
    unsigned sum, cnt, mine, sp = 0u;
    for (;;) {
        sum = 0u; cnt = 0u; mine = 0u;
#pragma unroll
        for (unsigned j = 0; j < 16; ++j) { const unsigned c = xb_ld(&bar[XB_XCNT(j)]); sum += c; cnt += (c > 0u) ? 1u : 0u; mine = (j == x) ? c : mine; }
        if (sum == G) break;
        __builtin_amdgcn_s_sleep(1);
        if ((++sp & 255u) == 0u) { if (xb_ld(&bar[XB_TMO])) break; if (sp > XB_SPIN_CAP) { atomicAdd(&bar[XB_TMO], 1u); break; } }
    }
    nloc = mine > 0u ? mine : 1u; nx = cnt > 0u ? cnt : 1u;
}
__device__ __forceinline__ void xcd_barrier(const XcdBarrier& b) {
    asm volatile("s_waitcnt vmcnt(0)" ::: "memory");
    __syncthreads();
    if (threadIdx.x == 0) {
        unsigned* bar = b.bar;
        __builtin_amdgcn_s_waitcnt(0);
        unsigned nloc = b.st[0], nx = b.st[1];
        if (nloc == 0u) { xcd_barrier_complete(bar, b.x, nloc, nx); b.st[0] = nloc; b.st[1] = nx; }
        const unsigned old = xb_add(&bar[XB_XSUB(b.x)], 1u);
        const unsigned gen = old / nloc;
        if (old + 1u == (gen + 1u) * nloc) {
            __builtin_amdgcn_fence(__ATOMIC_RELEASE, "agent");
            asm volatile("s_waitcnt vmcnt(0)" ::: "memory");
            const unsigned og = xb_add(&bar[XB_TOP], 1u);
            const unsigned tg = og / nx;
            if (og + 1u == (tg + 1u) * nx) xb_add(&bar[XB_TOPGEN], 1u);
            else XB_SPIN(xb_ld(&bar[XB_TOPGEN]) == tg, bar);
            __builtin_amdgcn_fence(__ATOMIC_ACQUIRE, "agent");
            xb_add(&bar[XB_XGEN(b.x)], 1u);
            asm volatile("s_waitcnt vmcnt(0)" ::: "memory");
        } else {
            XB_SPIN(xb_ld(&bar[XB_XGEN(b.x)]) == gen, bar);
            __builtin_amdgcn_fence(__ATOMIC_ACQUIRE, "agent");
            asm volatile("s_waitcnt vmcnt(0)" ::: "memory");
        }
    }
    __syncthreads();
}

DI float gelu_tanh(float x) { const float u = 0.7978845608028654f * (x + 0.044715f * x * x * x); return 0.5f * x * (1.f + tanhf(u)); }
DI float sigm(float x) { return 1.f / (1.f + expf(-x)); }
DI float sigm_fast(float x) { return __builtin_amdgcn_rcpf(1.f + __expf(-x)); }
DI float logsig(float z) { return fminf(z, 0.f) - log1pf(expf(-fabsf(z))); }
DI float wave_sum(float v) {
    const int lane = tidx() & 63;
#pragma unroll
    for (int o = 32; o > 0; o >>= 1) v += __int_as_float(__builtin_amdgcn_ds_bpermute((lane ^ o) << 2, __float_as_int(v)));
    return v;
}
DI void wave_sum2(float& a, float& b) {
    const int lane = tidx() & 63;
#pragma unroll
    for (int o = 32; o > 0; o >>= 1) {
        const float a2 = __int_as_float(__builtin_amdgcn_ds_bpermute((lane ^ o) << 2, __float_as_int(a)));
        const float b2 = __int_as_float(__builtin_amdgcn_ds_bpermute((lane ^ o) << 2, __float_as_int(b)));
        a += a2; b += b2;
    }
}

DI float bflo(unsigned u) { return __uint_as_float(u << 16); }
DI float bfhi(unsigned u) { return __uint_as_float(u & 0xffff0000u); }
DI float bf2f(bf16_t x) { return __uint_as_float((unsigned)x << 16); }
typedef float f32x2_t __attribute__((ext_vector_type(2)));
typedef __bf16 bf16x2_t __attribute__((ext_vector_type(2)));
DI unsigned pk_bf16(float lo, float hi) { f32x2_t v = {lo, hi}; bf16x2_t b = __builtin_convertvector(v, bf16x2_t); return __builtin_bit_cast(unsigned, b); }
DI bf16_t f2bf(float x) { return (bf16_t)(pk_bf16(x, 0.f) & 0xffffu); }
DI void st4bf(bf16_t* p, float a, float b, float c, float d) { uint2 v; v.x = pk_bf16(a, b); v.y = pk_bf16(c, d); *(uint2*)p = v; }
DI void ld8f(const bf16_t* p, float* f) { const u32x4 v = *(const u32x4*)p; f[0] = bflo(v[0]); f[1] = bfhi(v[0]); f[2] = bflo(v[1]); f[3] = bfhi(v[1]); f[4] = bflo(v[2]); f[5] = bfhi(v[2]); f[6] = bflo(v[3]); f[7] = bfhi(v[3]); }
DI void st8bf(bf16_t* p, const float* f) { u32x4 v; v[0] = pk_bf16(f[0], f[1]); v[1] = pk_bf16(f[2], f[3]); v[2] = pk_bf16(f[4], f[5]); v[3] = pk_bf16(f[6], f[7]); *(u32x4*)p = v; }
DI float4 ld4bf(const bf16_t* p) { const uint2 v = *(const uint2*)p; return make_float4(bflo(v.x), bfhi(v.x), bflo(v.y), bfhi(v.y)); }
template <int N> DI float dot_row(const float* q, const bf16_t* kr) {
    float dot = 0.f;
#pragma unroll
    for (int d = 0; d < N; d += 8) { const uint4 v = *(const uint4*)(kr + d);
        dot = fmaf(q[d], bflo(v.x), dot); dot = fmaf(q[d + 1], bfhi(v.x), dot); dot = fmaf(q[d + 2], bflo(v.y), dot); dot = fmaf(q[d + 3], bfhi(v.y), dot);
        dot = fmaf(q[d + 4], bflo(v.z), dot); dot = fmaf(q[d + 5], bfhi(v.z), dot); dot = fmaf(q[d + 6], bflo(v.w), dot); dot = fmaf(q[d + 7], bfhi(v.w), dot); }
    return dot;
}
template <int N> DI float dot_row(const float* q, const float* kr) {
    float dot = 0.f;
#pragma unroll
    for (int d = 0; d < N; ++d) dot = fmaf(q[d], kr[d], dot);
    return dot;
}
template <int N> DI void axpy_row(float* o, float pr, float corr, const bf16_t* vr) {
#pragma unroll
    for (int d = 0; d < N; d += 8) { const uint4 v = *(const uint4*)(vr + d);
        o[d] = fmaf(pr, bflo(v.x), o[d] * corr); o[d + 1] = fmaf(pr, bfhi(v.x), o[d + 1] * corr); o[d + 2] = fmaf(pr, bflo(v.y), o[d + 2] * corr); o[d + 3] = fmaf(pr, bfhi(v.y), o[d + 3] * corr);
        o[d + 4] = fmaf(pr, bflo(v.z), o[d + 4] * corr); o[d + 5] = fmaf(pr, bfhi(v.z), o[d + 5] * corr); o[d + 6] = fmaf(pr, bflo(v.w), o[d + 6] * corr); o[d + 7] = fmaf(pr, bfhi(v.w), o[d + 7] * corr); }
}
template <int N> DI void axpy_row(float* o, float pr, float corr, const float* vr) {
#pragma unroll
    for (int d = 0; d < N; ++d) o[d] = fmaf(pr, vr[d], o[d] * corr);
}
template <int N> DI void ld_row(float* q, const bf16_t* p) {
#pragma unroll
    for (int d = 0; d < N; d += 8) { const uint4 v = *(const uint4*)(p + d);
        q[d] = bflo(v.x); q[d + 1] = bfhi(v.x); q[d + 2] = bflo(v.y); q[d + 3] = bfhi(v.y); q[d + 4] = bflo(v.z); q[d + 5] = bfhi(v.z); q[d + 6] = bflo(v.w); q[d + 7] = bfhi(v.w); }
}
template <int N> DI void ld_row(float* q, const float* p) {
#pragma unroll
    for (int d = 0; d < N; d += 4) { const float4 v = *(const float4*)(p + d); q[d] = v.x; q[d + 1] = v.y; q[d + 2] = v.z; q[d + 3] = v.w; }
}

struct MG { const bf16_t* A; long lda; const bf16_t* Wt; long ldw; int K; };

struct NoFlush { DI void operator()(int, f32x16 (&)[2][2]) const {} };
struct NoPre { DI void operator()(int) const {} };
template <class RowFn, class Flush, class Pre>
DI void mgemm_tile_f(const MG& g, int n0, RowFn rowfn, f32x16 (&acc)[2][2], unsigned char* lds, bool zero, int flush_every, Flush flush, Pre pre) {
    constexpr int XI = G_BM * 8 / NT, WI = G_BN * 8 / NT;
    const int tid = tidx(), lane = tid & 63, wid = tid >> 6, r = lane & 31, h = lane >> 5;
    const int wm = wid % G_WM, wn = wid / G_WM;
    const int cc = tid & 7, row0 = tid >> 3;
    const bf16_t* xp[XI]; const bf16_t* wp[WI];
#pragma unroll
    for (int i = 0; i < XI; ++i) xp[i] = g.A + (long)rowfn(row0 + (NT / 8) * i) * g.lda + cc * 8;
#pragma unroll
    for (int i = 0; i < WI; ++i) wp[i] = g.Wt + (long)(n0 + row0 + (NT / 8) * i) * g.ldw + cc * 8;
    const int st_off = row0 * G_RS + cc * 16;
    if (zero)
#pragma unroll
    for (int a = 0; a < 2; ++a)
#pragma unroll
        for (int b = 0; b < 2; ++b)
#pragma unroll
            for (int i = 0; i < 16; ++i) acc[a][b][i] = 0.f;
    const int nk = g.K >> 6;
    u32x4 xv0[XI], wv0[WI], xv1[XI], wv1[WI];
#define MG_GLOAD(XV, WV, KT) do { _Pragma("unroll") for (int i = 0; i < XI; ++i) XV[i] = *(const u32x4*)(xp[i] + (KT) * 64); \
                                  _Pragma("unroll") for (int i = 0; i < WI; ++i) WV[i] = *(const u32x4*)(wp[i] + (KT) * 64); } while (0)
#define MG_LSTORE(XV, WV, STG) do { unsigned char* _s = lds + (STG) * G_STAGE; \
        _Pragma("unroll") for (int i = 0; i < XI; ++i) *(u32x4*)(_s + st_off + (NT / 8) * i * G_RS) = XV[i]; \
        _Pragma("unroll") for (int i = 0; i < WI; ++i) *(u32x4*)(_s + G_BM * G_RS + st_off + (NT / 8) * i * G_RS) = WV[i]; } while (0)
    MG_GLOAD(xv0, wv0, 0);
    if (nk > 1) MG_GLOAD(xv1, wv1, 1);
    __syncthreads();
    MG_LSTORE(xv0, wv0, 0);
    if (nk > 2) MG_GLOAD(xv0, wv0, 2);
    __syncthreads();
    const int xf_off = (wm * 64 + r) * G_RS + h * 16, wf_off = G_BM * G_RS + (wn * 64 + r) * G_RS + h * 16;
#define MG_COMPUTE(STG) do { const unsigned char* st = lds + (STG) * G_STAGE; \
        _Pragma("unroll") for (int ks = 0; ks < 4; ++ks) { \
            const bf16x8 w0 = *(const bf16x8*)(st + wf_off + ks * 32), w1 = *(const bf16x8*)(st + wf_off + 32 * G_RS + ks * 32); \
            const bf16x8 x0 = *(const bf16x8*)(st + xf_off + ks * 32), x1 = *(const bf16x8*)(st + xf_off + 32 * G_RS + ks * 32); \
            acc[0][0] = __builtin_amdgcn_mfma_f32_32x32x16_bf16(w0, x0, acc[0][0], 0, 0, 0); \
            acc[0][1] = __builtin_amdgcn_mfma_f32_32x32x16_bf16(w0, x1, acc[0][1], 0, 0, 0); \
            acc[1][0] = __builtin_amdgcn_mfma_f32_32x32x16_bf16(w1, x0, acc[1][0], 0, 0, 0); \
            acc[1][1] = __builtin_amdgcn_mfma_f32_32x32x16_bf16(w1, x1, acc[1][1], 0, 0, 0); } } while (0)
    for (int kt = 0; kt < nk; kt += 2) {
        if (flush_every && kt % flush_every == 0) pre(kt / flush_every);
        MG_COMPUTE(0);
        if (kt + 1 < nk) { MG_LSTORE(xv1, wv1, 1); if (kt + 3 < nk) MG_GLOAD(xv1, wv1, kt + 3); }
        if (flush_every && (kt + 1) % flush_every == 0) flush(kt / flush_every, acc);
        __syncthreads();
        if (kt + 1 < nk) {
            MG_COMPUTE(1);
            if (kt + 2 < nk) { MG_LSTORE(xv0, wv0, 0); if (kt + 4 < nk) MG_GLOAD(xv0, wv0, kt + 4); }
            if (flush_every && (kt + 2) % flush_every == 0) flush((kt + 1) / flush_every, acc);
            __syncthreads();
        }
    }
#undef MG_GLOAD
#undef MG_LSTORE
#undef MG_COMPUTE
}
template <class RowFn>
DI void mgemm_tile(const MG& g, int n0, RowFn rowfn, f32x16 (&acc)[2][2], unsigned char* lds, bool zero = true) { mgemm_tile_f(g, n0, rowfn, acc, lds, zero, 0, NoFlush{}, NoPre{}); }
#define MG_FOREACH(acc, LROW, FEAT, V, ...) do { const int _l = tidx() & 63, _w = tidx() >> 6, _wm = _w % G_WM, _wn = _w / G_WM; \
    _Pragma("unroll") for (int _ft = 0; _ft < 2; ++_ft) _Pragma("unroll") for (int _tt = 0; _tt < 2; ++_tt) _Pragma("unroll") for (int _i = 0; _i < 4; ++_i) { \
        const int LROW = _wm * 64 + _tt * 32 + (_l & 31); const int FEAT = _wn * 64 + _ft * 32 + 8 * _i + 4 * (_l >> 5); \
        float V[4] = {acc[_ft][_tt][4 * _i], acc[_ft][_tt][4 * _i + 1], acc[_ft][_tt][4 * _i + 2], acc[_ft][_tt][4 * _i + 3]}; __VA_ARGS__ } } while (0)

struct RowId { int m0; DI long operator()(int r) const { return m0 + r; } };

template <int OUTMODE>
DI void mgemm_job(const MG& g, int M, int N, void* out, long ldo, int bid, int nblk, unsigned char* lds) {
    const int tm = M / G_BM, tn = N / G_BN;
    for (int u = bid; u < tm * tn; u += nblk) {
        const int grp = u / (16 * tn), rem = u % (16 * tn);
        const int gm = (tm - grp * 16) < 16 ? (tm - grp * 16) : 16;
        const int mt = grp * 16 + rem % gm, nt = rem / gm;
        const int m0 = mt * G_BM, n0 = nt * G_BN;
        f32x16 acc[2][2];
        mgemm_tile(g, n0, RowId{m0}, acc, lds);
        MG_FOREACH(acc, lrow, feat, v, {
            const long o = (long)(m0 + lrow) * ldo + n0 + feat;
            if (OUTMODE == 1) *(float4*)((float*)out + o) = make_float4(v[0], v[1], v[2], v[3]);
            else {
                if (OUTMODE == 2 && n0 + feat >= O_MG) { v[0] = sigm(v[0]); v[1] = sigm(v[1]); v[2] = sigm(v[2]); v[3] = sigm(v[3]); }
                st4bf((bf16_t*)out + o, v[0], v[1], v[2], v[3]);
            } });
    }
}

namespace pg8 {
#define PG8_LAS __attribute__((address_space(3)))
typedef float f32x4 __attribute__((ext_vector_type(4)));
constexpr int BM = 256, BK = 64, HALF = 128, HTB = HALF * BK * 2  , STAGE_BYTES = 8 * HTB, NXCD = 8, WGM = 8;
__host__ __device__ __forceinline__ int lds_byte(int r, int c) { const int st = (r >> 4) * 2 + (c >> 5), rr = r & 15, cc = c & 31, ob = rr * 64 + cc * 2; return st * 1024 + (ob ^ (((ob >> 9) & 1) << 5)); }
__host__ __device__ __forceinline__ void stage_rc(int b, int& R, int& C) { const int st = b / 1024, sb = b % 1024, swz = sb ^ (((sb >> 9) & 1) << 5); R = (st >> 1) * 16 + swz / 64; C = (st & 1) * 32 + (swz % 64) / 2; }
__host__ __device__ __forceinline__ int perm32(int rho) { const int n = rho >> 4, i = rho & 15; return 8 * (i >> 2) + 4 * n + (i & 3); }
struct Unit { int pm, pn, e, gt, nv; };
struct Gemm { const bf16_t* A; const bf16_t* Bt; int M, N, K; const int* rowidx; };
struct StaticOrder {
    int nM, nN, nwg, G, c;
    __device__ void init(int M, int N, int G_, int c_) { nM = M / BM; nN = N / BM; nwg = nM * nN; G = G_; c = c_; }
    __device__ bool next(int i, Unit& u) const {
        const long L = (long)i * G + c; if (L >= nwg) return false;
        int wgid = (int)L; { const int q = nwg / NXCD, r = nwg % NXCD, xcd = wgid % NXCD, off = wgid / NXCD; wgid = (xcd < r ? xcd * (q + 1) : r * (q + 1) + (xcd - r) * q) + off; }
        const int nig = WGM * nN, gid = wgid / nig, fm = gid * WGM, gsz = (nM - fm) < WGM ? (nM - fm) : WGM;
        u.pm = fm + ((wgid % nig) % gsz); u.pn = (wgid % nig) / gsz; u.e = 0; u.gt = 0; u.nv = 0; return true;
    }
    __device__ __forceinline__ void a_ready(const Unit&) const {}
    __device__ __forceinline__ void done(const Unit&) const {}
};
struct ListOrder {
    Unit u0, u1, u2; int n;
    __device__ bool next(int i, Unit& u) const { if (i >= n) return false; u = (i == 0) ? u0 : ((i == 1) ? u1 : u2); return true; }
    __device__ __forceinline__ void a_ready(const Unit&) const {}
    __device__ __forceinline__ void done(const Unit&) const {}
};
template <class Epi, class Sched, bool ALIGN_EPI = false, bool SP2 = false, bool GATHER = false>
__device__ __forceinline__ void gemm_phase(PG8_LAS unsigned char* lds, const Gemm g, const Sched& S, const Epi& E) {
    const int tid = tidx(), wid = __builtin_amdgcn_readfirstlane(tid >> 6), lane = tid & 63, wr = wid >> 2, wc = wid & 3, fr = lane & 15, fq = lane >> 4;
    const int K = g.K, nt = K / BK;
    unsigned voffA[2], voffB[2];
#pragma unroll
    for (int i = 0; i < 2; ++i) { int R, C; stage_rc(tid * 16 + i * 8192, R, C); const int Rb = Epi::PERM ? ((R & ~31) + perm32(R & 31)) : R;
        voffA[i] = (unsigned)(R * K + C) * 2u; voffB[i] = (unsigned)(Rb * K + C) * 2u; }
    unsigned voffC[2][2] = {{0u, 0u}, {0u, 0u}}, voffN[2][2] = {{0u, 0u}, {0u, 0u}};
    auto gather_offs = [&](const Unit& uu, unsigned (&vo)[2][2]) {
#pragma unroll
        for (int hh = 0; hh < 2; ++hh)
#pragma unroll
            for (int i = 0; i < 2; ++i) { int R, C; stage_rc(tid * 16 + i * 8192, R, C); const int lr = hh * HALF + R; int a = g.rowidx[uu.gt * BM + lr]; a = lr < uu.nv ? (a >> 1) : 0; vo[hh][i] = (unsigned)(a * K + C) * 2u; }
    };
    const size_t kstep = (size_t)(BK * 2);
    const size_t hstep = (size_t)HALF * K * 2;
    const size_t tstep = 2 * hstep;
    const size_t estep = (size_t)g.N * K * 2;
    const unsigned ldsw = (unsigned)wid * 1024u;
    const int aoff = lds_byte(wr * 64 + fr, fq * 8), boff = lds_byte(wc * 32 + fr, fq * 8);
#define PG8_SA(b, h) (((b) * 2 + (h)) * HTB)
#define PG8_SB(b, h) ((4 + (b) * 2 + (h)) * HTB)
#define PG8_STAGE(bufoff, gbase, voff) do { _Pragma("unroll") for (int _i = 0; _i < 2; ++_i) \
        __builtin_amdgcn_global_load_lds((const unsigned*)((const char*)(gbase) + (voff)[_i]), (PG8_LAS unsigned*)(lds + (bufoff) + ldsw + _i * 8192), 16, 0, 0); } while (0)
#define PG8_STAGE_A(bufoff, HH, KT, NX, densebase) do { if constexpr (GATHER) { const char* _gb = (const char*)g.A + (size_t)(KT) * kstep; if (NX) PG8_STAGE(bufoff, _gb, voffN[HH]); else PG8_STAGE(bufoff, _gb, voffC[HH]); } else PG8_STAGE(bufoff, densebase, voffA); } while (0)
#define PG8_LDA(dst, b, h) do { _Pragma("unroll") for (int m = 0; m < 4; ++m) _Pragma("unroll") for (int k = 0; k < 2; ++k) dst[m][k] = *(const PG8_LAS bf16x8*)(lds + PG8_SA(b, h) + aoff + m * 2048 + k * 1024); } while (0)
#define PG8_LDB(dst, b, h) do { _Pragma("unroll") for (int n = 0; n < 2; ++n) _Pragma("unroll") for (int k = 0; k < 2; ++k) dst[n][k] = *(const PG8_LAS bf16x8*)(lds + PG8_SB(b, h) + boff + n * 2048 + k * 1024); } while (0)
#define PG8_MMA(ai, bj, At, Bt) do { __builtin_amdgcn_s_setprio(1); _Pragma("unroll") for (int m = 0; m < 4; ++m) _Pragma("unroll") for (int n = 0; n < 2; ++n) _Pragma("unroll") for (int k = 0; k < 2; ++k) \
        acc[ai][bj][m][n] = __builtin_amdgcn_mfma_f32_16x16x32_bf16(Bt[n][k], At[m][k], acc[ai][bj][m][n], 0, 0, 0); __builtin_amdgcn_s_setprio(0); } while (0)
#define PG8_WAIT_V(n) asm volatile("s_waitcnt vmcnt(" #n ")" ::: "memory")
#define PG8_WAIT_L(n) asm volatile("s_waitcnt lgkmcnt(" #n ")" ::: "memory")
#define PG8_BAR __builtin_amdgcn_s_barrier()
#define PG8_SCHED __builtin_amdgcn_sched_barrier(0)
    Unit cur, nxt; int ui = 0;
    if (!S.next(0, cur)) return;
    f32x4 acc[2][2][4][2];
#pragma unroll
    for (int a = 0; a < 2; ++a)
#pragma unroll
        for (int b = 0; b < 2; ++b)
#pragma unroll
            for (int m = 0; m < 4; ++m)
#pragma unroll
                for (int n = 0; n < 2; ++n) acc[a][b][m][n] = (f32x4){0.f, 0.f, 0.f, 0.f};
    bf16x8 At[4][2], B0[2][2], B1[2][2];
    const char* cA = (const char*)g.A + (size_t)cur.pm * tstep; const char* cB = (const char*)g.Bt + (size_t)cur.e * estep + (size_t)cur.pn * tstep;
    S.a_ready(cur);
    if constexpr (GATHER) gather_offs(cur, voffC);
    if constexpr (SP2) {
        PG8_STAGE(PG8_SB(0, 0), cB, voffB); PG8_STAGE(PG8_SB(0, 1), cB + hstep, voffB); PG8_STAGE_A(PG8_SA(0, 0), 0, 0, false, cA); PG8_STAGE_A(PG8_SA(0, 1), 1, 0, false, cA + hstep);
        if (wr == 1) PG8_BAR;
        PG8_WAIT_V(2); PG8_BAR;
        PG8_STAGE(PG8_SB(1, 0), cB + kstep, voffB); PG8_STAGE_A(PG8_SA(1, 0), 0, 1, false, cA + kstep); PG8_STAGE(PG8_SB(1, 1), cB + hstep + kstep, voffB);
        PG8_WAIT_V(6); PG8_BAR;
    } else {
        PG8_STAGE(PG8_SB(0, 0), cB, voffB); PG8_STAGE_A(PG8_SA(0, 0), 0, 0, false, cA); PG8_STAGE(PG8_SB(0, 1), cB + hstep, voffB); PG8_STAGE_A(PG8_SA(0, 1), 1, 0, false, cA + hstep);
        if (wr == 1) PG8_BAR;
        PG8_WAIT_V(4); PG8_BAR;
        PG8_STAGE(PG8_SB(1, 0), cB + kstep, voffB); PG8_STAGE_A(PG8_SA(1, 0), 0, 1, false, cA + kstep); PG8_STAGE(PG8_SB(1, 1), cB + hstep + kstep, voffB);
        PG8_WAIT_V(6); PG8_BAR;
    }
    for (;;) {
        const bool has_next = S.next(ui + 1, nxt);
        if constexpr (GATHER) { if (has_next) gather_offs(nxt, voffN); else {
#pragma unroll
            for (int hh = 0; hh < 2; ++hh) { voffN[hh][0] = voffC[hh][0]; voffN[hh][1] = voffC[hh][1]; } } }
        const char* nA = has_next ? (const char*)g.A + (size_t)nxt.pm * tstep : cA; const char* nB = has_next ? (const char*)g.Bt + (size_t)nxt.e * estep + (size_t)nxt.pn * tstep : cB;
        for (int t = 0; t < nt; t += 2) {
            const bool last = (t == nt - 2);
            const char* a1 = cA + (size_t)(t + 1) * kstep;
            const char* a2 = last ? nA : cA + (size_t)(t + 2) * kstep; const char* b2 = last ? nB : cB + (size_t)(t + 2) * kstep;
            const char* a3 = a2 + kstep; const char* b3 = b2 + kstep;
            if (last && has_next) S.a_ready(nxt);
            if constexpr (SP2) {
            PG8_LDB(B0, 0, 0); PG8_LDB(B1, 0, 1); PG8_SCHED; PG8_LDA(At, 0, 0); PG8_STAGE_A(PG8_SA(1, 1), 1, t + 1, false, a1 + hstep);
            PG8_WAIT_V(8); PG8_WAIT_L(0); PG8_BAR; PG8_MMA(0, 0, At, B0); PG8_MMA(0, 1, At, B1); PG8_BAR; PG8_SCHED;
            PG8_LDA(At, 0, 1); PG8_STAGE(PG8_SB(0, 0), b2, voffB); PG8_STAGE(PG8_SB(0, 1), b2 + hstep, voffB); PG8_STAGE_A(PG8_SA(0, 0), 0, (last ? 0 : t + 2), last, a2);
            PG8_WAIT_V(8); PG8_WAIT_L(0); PG8_BAR; PG8_MMA(1, 0, At, B0); PG8_MMA(1, 1, At, B1); PG8_BAR; PG8_SCHED;
            PG8_LDB(B0, 1, 0); PG8_LDB(B1, 1, 1); PG8_SCHED; PG8_LDA(At, 1, 0); PG8_STAGE_A(PG8_SA(0, 1), 1, (last ? 0 : t + 2), last, a2 + hstep);
            PG8_WAIT_V(8); PG8_WAIT_L(0); PG8_BAR; PG8_MMA(0, 0, At, B0); PG8_MMA(0, 1, At, B1); PG8_BAR; PG8_SCHED;
            PG8_LDA(At, 1, 1); PG8_STAGE(PG8_SB(1, 0), b3, voffB); PG8_STAGE(PG8_SB(1, 1), b3 + hstep, voffB); PG8_STAGE_A(PG8_SA(1, 0), 0, (last ? 1 : t + 3), last, a3);
            PG8_WAIT_V(8); PG8_WAIT_L(0); PG8_BAR; PG8_MMA(1, 0, At, B0); PG8_MMA(1, 1, At, B1); PG8_BAR; PG8_SCHED;
            } else {
            PG8_LDB(B0, 0, 0); PG8_SCHED; PG8_LDA(At, 0, 0); PG8_STAGE_A(PG8_SA(1, 1), 1, t + 1, false, a1 + hstep);
            PG8_WAIT_L(8); PG8_BAR; PG8_WAIT_L(0); PG8_MMA(0, 0, At, B0); PG8_BAR; PG8_SCHED;
            PG8_LDB(B1, 0, 1); PG8_STAGE(PG8_SB(0, 0), b2, voffB);
            PG8_BAR; PG8_WAIT_L(0); PG8_MMA(0, 1, At, B1); PG8_BAR;
            PG8_LDA(At, 0, 1); PG8_STAGE_A(PG8_SA(0, 0), 0, (last ? 0 : t + 2), last, a2);
            PG8_BAR; PG8_WAIT_L(0); PG8_MMA(1, 0, At, B0); PG8_BAR; PG8_SCHED;
            PG8_STAGE(PG8_SB(0, 1), b2 + hstep, voffB);
            PG8_WAIT_V(6); PG8_BAR; PG8_MMA(1, 1, At, B1); PG8_BAR;
            PG8_LDB(B0, 1, 0); PG8_SCHED; PG8_LDA(At, 1, 0); PG8_STAGE_A(PG8_SA(0, 1), 1, (last ? 0 : t + 2), last, a2 + hstep);
            PG8_WAIT_L(8); PG8_BAR; PG8_WAIT_L(0); PG8_MMA(0, 0, At, B0); PG8_BAR; PG8_SCHED;
            PG8_LDB(B1, 1, 1); PG8_STAGE(PG8_SB(1, 0), b3, voffB);
            PG8_BAR; PG8_WAIT_L(0); PG8_MMA(0, 1, At, B1); PG8_BAR;
            PG8_LDA(At, 1, 1); PG8_STAGE_A(PG8_SA(1, 0), 0, (last ? 1 : t + 3), last, a3);
            PG8_BAR; PG8_WAIT_L(0); PG8_MMA(1, 0, At, B0); PG8_BAR; PG8_SCHED;
            PG8_STAGE(PG8_SB(1, 1), b3 + hstep, voffB);
            PG8_WAIT_V(6); PG8_BAR; PG8_MMA(1, 1, At, B1); PG8_BAR;
            }
        }
        if constexpr (ALIGN_EPI) { if (wr == 0) PG8_BAR; }
        if constexpr (!Epi::AFTER_DRAIN) { E(acc, cur, wr, wc, fr, fq); S.done(cur); }
        if (!has_next) break;
#pragma unroll
        for (int a = 0; a < 2; ++a)
#pragma unroll
            for (int b = 0; b < 2; ++b)
#pragma unroll
                for (int m = 0; m < 4; ++m)
#pragma unroll
                    for (int n = 0; n < 2; ++n) acc[a][b][m][n] = (f32x4){0.f, 0.f, 0.f, 0.f};
        cur = nxt; cA = nA; cB = nB; ++ui;
        if constexpr (GATHER) {
#pragma unroll
            for (int hh = 0; hh < 2; ++hh) { voffC[hh][0] = voffN[hh][0]; voffC[hh][1] = voffN[hh][1]; } }
        if constexpr (ALIGN_EPI) { if (wr == 1) PG8_BAR; }
    }
    PG8_WAIT_V(0);
    if constexpr (!ALIGN_EPI) { if (wr == 0) PG8_BAR; }
    PG8_BAR;
    if constexpr (Epi::AFTER_DRAIN) { E.fused(acc, cur, wr, wc, fr, fq, lds, wid, lane); S.done(cur); }
#undef PG8_SA
#undef PG8_SB
#undef PG8_STAGE
#undef PG8_STAGE_A
#undef PG8_LDA
#undef PG8_LDB
#undef PG8_MMA
#undef PG8_WAIT_V
#undef PG8_WAIT_L
#undef PG8_BAR
#undef PG8_SCHED
}
}

struct EpiStoreBf16 {
    static constexpr bool PERM = true, AFTER_DRAIN = false;
    bf16_t* O; long ldo; int gate_from; long estride;
    __device__ __forceinline__ void operator()(const pg8::f32x4 (&acc)[2][2][4][2], const pg8::Unit& u, int wr, int wc, int fr, int fq) const {
        bf16_t* base = O + (long)u.e * estride;
#pragma unroll
        for (int ai = 0; ai < 2; ++ai)
#pragma unroll
            for (int m = 0; m < 4; ++m) {
                const long row = (long)u.pm * 256 + ai * 128 + wr * 64 + m * 16 + fr;
#pragma unroll
                for (int bj = 0; bj < 2; ++bj) {
                    pg8::f32x4 v0 = acc[ai][bj][m][0], v1 = acc[ai][bj][m][1];
                    if (u.pn * 2 + bj >= gate_from) {
#pragma unroll
                        for (int j = 0; j < 4; ++j) { v0[j] = sigm_fast(v0[j]); v1[j] = sigm_fast(v1[j]); }
                    }
                    u32x4 wv; wv[0] = pk_bf16(v0[0], v0[1]); wv[1] = pk_bf16(v0[2], v0[3]); wv[2] = pk_bf16(v1[0], v1[1]); wv[3] = pk_bf16(v1[2], v1[3]);
                    *(u32x4*)(base + row * ldo + u.pn * 256 + bj * 128 + wc * 32 + 8 * fq) = wv;
                }
            }
    }
};
struct EpiStoreF32 {
    static constexpr bool PERM = false, AFTER_DRAIN = false;
    float* O; long ldo;
    __device__ __forceinline__ void operator()(const pg8::f32x4 (&acc)[2][2][4][2], const pg8::Unit& u, int wr, int wc, int fr, int fq) const {
#pragma unroll
        for (int ai = 0; ai < 2; ++ai)
#pragma unroll
            for (int m = 0; m < 4; ++m) {
                const long row = (long)u.pm * 256 + ai * 128 + wr * 64 + m * 16 + fr;
#pragma unroll
                for (int bj = 0; bj < 2; ++bj)
#pragma unroll
                    for (int n = 0; n < 2; ++n) *(pg8::f32x4*)(O + row * ldo + u.pn * 256 + bj * 128 + wc * 32 + 16 * n + 4 * fq) = acc[ai][bj][m][n];
            }
    }
};
struct EpiMoeGU {
    static constexpr bool PERM = true, AFTER_DRAIN = false;
    bf16_t* HH;
    __device__ __forceinline__ void operator()(const pg8::f32x4 (&acc)[2][2][4][2], const pg8::Unit& u, int wr, int wc, int fr, int fq) const {
#pragma unroll
        for (int ai = 0; ai < 2; ++ai)
#pragma unroll
            for (int m = 0; m < 4; ++m) {
                const long row = (long)u.pm * 256 + ai * 128 + wr * 64 + m * 16 + fr;
                float hv[8];
#pragma unroll
                for (int n = 0; n < 2; ++n)
#pragma unroll
                    for (int j = 0; j < 4; ++j) { const float gt = acc[ai][0][m][n][j], up = acc[ai][1][m][n][j]; hv[4 * n + j] = gt * sigm_fast(gt) * up; }
                u32x4 wv; wv[0] = pk_bf16(hv[0], hv[1]); wv[1] = pk_bf16(hv[2], hv[3]); wv[2] = pk_bf16(hv[4], hv[5]); wv[3] = pk_bf16(hv[6], hv[7]);
                *(u32x4*)(HH + row * 512 + u.pn * 128 + wc * 32 + 8 * fq) = wv;
            }
    }
};
struct EpiMoeDown {
    static constexpr bool PERM = true, AFTER_DRAIN = false;
    const int* perm; const float* ew; bf16_t* YK;
    __device__ __forceinline__ void operator()(const pg8::f32x4 (&acc)[2][2][4][2], const pg8::Unit& u, int wr, int wc, int fr, int fq) const {
#pragma unroll
        for (int ai = 0; ai < 2; ++ai)
#pragma unroll
            for (int m = 0; m < 4; ++m) {
                const int a = perm[u.pm * 256 + ai * 128 + wr * 64 + m * 16 + fr];
                if (a >= 0) {
                    const float sw = ew[a];
#pragma unroll
                    for (int bj = 0; bj < 2; ++bj) {
                        const pg8::f32x4 v0 = acc[ai][bj][m][0] * sw, v1 = acc[ai][bj][m][1] * sw;
                        u32x4 wv; wv[0] = pk_bf16(v0[0], v0[1]); wv[1] = pk_bf16(v0[2], v0[3]); wv[2] = pk_bf16(v1[0], v1[1]); wv[3] = pk_bf16(v1[2], v1[3]);
                        *(u32x4*)(YK + (long)a * 1024 + u.pn * 256 + bj * 128 + wc * 32 + 8 * fq) = wv;
                    }
                }
            }
    }
};
struct GroupedOrder {
    int nM, nN, nE, G, c;
    __device__ bool next(int i, pg8::Unit& u) const { const int L = i * G + c; if (L >= nM * nN * nE) return false; u.e = L / (nM * nN); const int rm = L % (nM * nN); u.pm = rm / nN; u.pn = rm % nN; u.gt = 0; u.nv = 0; return true; }
    __device__ __forceinline__ void a_ready(const pg8::Unit&) const {}
    __device__ __forceinline__ void done(const pg8::Unit&) const {}
};

struct LayerW {
    const float *cmp_pos, *conv_w, *conv_b, *ga_b, *gx_b, *lam, *q_norm, *kv_norm,
        *ln1_g, *ln1_b, *ln2_g, *ln2_b, *rg_b, *re_b, *ln3_g, *ln3_b;
    const bf16_t *t_in, *t_br, *t_out, *t_q, *t_o, *t_gu, *t_dn, *t_c1, *t_c2, *t_uq, *t_ukv, *t_g, *t_rh, *t_rl;
};
#define WSF(off) ((float*)(p.ws + (off)))
#define WSI(off) ((int*)(p.ws + (off)))
#define WSU(off) ((unsigned*)(p.ws + (off)))
#define WSB(off) ((bf16_t*)(p.ws + (off)))
DI LayerW layer_w(const Params& p, int l) {
    LayerW w;
    w.cmp_pos = p.in[3] + (size_t)l * 2 * 32 * 64;
    w.conv_w = p.in[6] + (size_t)l * 4 * 256;
    w.conv_b = p.in[7] + (size_t)l * 256;
    w.ga_b = p.in[9] + (size_t)l * 256;
    w.gx_b = p.in[11] + (size_t)l * 256;
    w.lam = p.in[12] + (size_t)l * 256;
    w.q_norm = p.in[13] + (size_t)l * 192;
    w.kv_norm = p.in[14] + (size_t)l * 128;
    w.ln1_g = p.in[19] + (size_t)l * 1024; w.ln1_b = p.in[20] + (size_t)l * 1024;
    w.ln2_g = p.in[24] + (size_t)l * 1024; w.ln2_b = p.in[25] + (size_t)l * 1024;
    w.rg_b = p.in[27] + (size_t)l * 4;
    w.re_b = p.in[29] + (size_t)l * 32;
    w.ln3_g = p.in[32] + (size_t)l * 1024; w.ln3_b = p.in[33] + (size_t)l * 1024;
    w.t_in = WSB(WT_IN) + (size_t)l * NH * 1024;
    w.t_br = WSB(WT_BR) + (size_t)l * 1024 * 1024;
    w.t_out = WSB(WT_OUT) + (size_t)l * 1024 * 1024;
    w.t_q = WSB(WT_Q) + (size_t)l * 512 * 1024;
    w.t_o = WSB(WT_O) + (size_t)l * 1024 * 512;
    w.t_gu = WSB(WT_GU) + (size_t)l * 32 * 1024 * 1024;
    w.t_dn = WSB(WT_DN) + (size_t)l * 32 * 1024 * 512;
    w.t_c1 = WSB(WT_C1) + (size_t)l * 2 * 256 * 2048;
    w.t_c2 = WSB(WT_C2) + (size_t)l * 2 * 128 * 256;
    w.t_uq = WSB(WT_UQ) + (size_t)l * 384 * 192;
    w.t_ukv = WSB(WT_UKV) + (size_t)l * 512 * 128;
    w.t_g = WSB(WT_G) + (size_t)l * 4 * 128 * 64;
    w.t_rh = WSB(WT_RH) + (size_t)l * 128 * 1024;
    w.t_rl = WSB(WT_RL) + (size_t)l * 128 * 1024;
    return w;
}

template <int MODE>
DI int wt_col(int np, int Nsrc) {
    if (MODE == 0) return np < Nsrc ? np : -1;
    if (MODE == 2) return np < 1024 ? np : (np < 2656 ? np + 12 : (np < 2668 ? 1024 + (np - 2656) : (np < 2688 ? -1 : (np < 6784 ? np - 20 : -1))));
    const int pn = np >> 8, bj = (np >> 7) & 1, q = np & 127; return (bj ? 512 : 0) + 128 * pn + q;
}
template <int MODE>
DI void job_wt(const float* src, int nmat, int K, int Nsrc, bf16_t* dst, int Npad, int bid, int nblk, unsigned char* lds) {
    const int lane = tidx() & 63, wid = tidx() >> 6;
    bf16_t* tile = (bf16_t*)lds + wid * (64 * 72);
    const int tk = K / 64, tn = Npad / 64;
    const int tk2 = (tk + 1) / 2, tn4 = (tn + 3) / 4, per = tk2 * tn4;
    const int kl = lane >> 4, n4 = (lane & 15) * 4;
    for (int ub = bid; ub < nmat * per; ub += nblk) {
        const int mat = ub / per, ru = ub % per, kt = (ru % tk2) * 2 + (wid & 1), nt = (ru / tk2) * 4 + (wid >> 1);
        if (kt >= tk || nt >= tn) continue;
        const int k0 = kt * 64, n0 = nt * 64;
        const float* s = src + (size_t)mat * K * Nsrc;
        bf16_t* d = dst + (size_t)mat * Npad * K;
        const int col = wt_col<MODE>(n0 + n4, Nsrc);
        float4 v[16];
#pragma unroll
        for (int ps = 0; ps < 16; ++ps) v[ps] = col >= 0 ? *(const float4*)(s + (size_t)(k0 + kl + 4 * ps) * Nsrc + col) : make_float4(0.f, 0.f, 0.f, 0.f);
#pragma unroll
        for (int ps = 0; ps < 16; ++ps) { const int k = kl + 4 * ps;
            tile[(n4 + 0) * 72 + k] = f2bf(v[ps].x); tile[(n4 + 1) * 72 + k] = f2bf(v[ps].y); tile[(n4 + 2) * 72 + k] = f2bf(v[ps].z); tile[(n4 + 3) * 72 + k] = f2bf(v[ps].w); }
        __builtin_amdgcn_fence(__ATOMIC_RELEASE, "wavefront"); __builtin_amdgcn_wave_barrier(); __builtin_amdgcn_fence(__ATOMIC_ACQUIRE, "wavefront");
#pragma unroll
        for (int c8 = 0; c8 < 8; ++c8) { const int c = lane + 64 * c8, n2 = c >> 3, kc = (c & 7) * 8;
            *(uint4*)(d + (size_t)(n0 + n2) * K + k0 + kc) = *(const uint4*)(tile + n2 * 72 + kc); }
        __builtin_amdgcn_fence(__ATOMIC_RELEASE, "wavefront"); __builtin_amdgcn_wave_barrier(); __builtin_amdgcn_fence(__ATOMIC_ACQUIRE, "wavefront");
    }
}
DI void job_cvt(const float* src, bf16_t* dst, long n, int bid, int nblk) {
    for (long e = ((long)bid * NT + tidx()) * 4; e < n; e += (long)nblk * NT * 4) {
        const float4 v = *(const float4*)(src + e);
        st4bf(dst + e, v.x, v.y, v.z, v.w);
    }
}
DI void job_cmp_gather(const Params& p, const LayerW& w, int bid, int nblk) {
    const bf16_t* H = WSB(WS_H); bf16_t* TB = WSB(WS_TBB);
    const long total = (long)2 * NCR * 2048 / 8;
    for (long e = (long)bid * NT + tidx(); e < total; e += (long)nblk * NT) {
        const long e8 = e * 8;
        const int f = (int)(e8 % 2048); const long r2 = e8 / 2048; const int r = (int)(r2 % NCR), j = (int)(r2 / NCR);
        const int g = r & 1, bc = r >> 1, c = bc % NCMP, b = bc / NCMP, i = f >> 6, d = f & 63;
        float hv[8];
        ld8f(H + (long)(b * SEQ + 16 * c + i) * NH + (j ? O_AVC : O_AKC) + g * 64 + d, hv);
        const float4 p0 = *(const float4*)(w.cmp_pos + (j * 32 + i) * 64 + d), p1 = *(const float4*)(w.cmp_pos + (j * 32 + i) * 64 + d + 4);
        hv[0] += p0.x; hv[1] += p0.y; hv[2] += p0.z; hv[3] += p0.w; hv[4] += p1.x; hv[5] += p1.y; hv[6] += p1.z; hv[7] += p1.w;
        st8bf(TB + ((long)j * 2048 + r) * 2048 + f, hv);
    }
}
DI void job_rnn_conv(const Params& p, const LayerW& w, int bid, int nblk) {
    const bf16_t* H = WSB(WS_H); float* U = WSF(WS_U); bf16_t* UB = WSB(WS_UB);
    for (long e = (long)bid * NT + tidx(); e < (long)T * 64; e += (long)nblk * NT) {
        const int ch = (int)(e & 63) * 4; const int t = (int)(e >> 6), s = t & (SEQ - 1);
        const float4 cb = *(const float4*)(w.conv_b + ch);
        float u0 = cb.x, u1 = cb.y, u2 = cb.z, u3 = cb.w;
#pragma unroll
        for (int tap = 0; tap < 4; ++tap) { const int sp = s - 3 + tap;
            if (sp >= 0) { const float4 hv = ld4bf(H + (long)(t - 3 + tap) * NH + O_CX + ch); const float4 cw = *(const float4*)(w.conv_w + tap * 256 + ch);
                u0 += hv.x * cw.x; u1 += hv.y * cw.y; u2 += hv.z * cw.z; u3 += hv.w * cw.w; } }
        *(float4*)(U + (long)t * 256 + ch) = make_float4(u0, u1, u2, u3); st4bf(UB + (long)t * 256 + ch, u0, u1, u2, u3);
    }
}
DI void job_rnn_gates(const Params& p, const LayerW& w, int bid, int nblk, unsigned char* lds) {
    const float* U = WSF(WS_U); float* RA = WSF(WS_RA); float* RB = WSF(WS_RB);
    for (int u = bid; u < (T / G_BM) * 4; u += nblk) {
        const int blk = u & 3, m0 = (u >> 2) * G_BM;
        MG g; g.A = WSB(WS_UB) + blk * 64; g.lda = 256; g.Wt = w.t_g + (size_t)blk * 128 * 64; g.ldw = 64; g.K = 64;
        f32x16 acc[2][2];
        mgemm_tile(g, 0, RowId{m0}, acc, lds);
        const int l = tidx() & 63, wv = tidx() >> 6, wm = wv % G_WM, wn = wv / G_WM;
#pragma unroll
        for (int tt = 0; tt < 2; ++tt)
#pragma unroll
            for (int i = 0; i < 4; ++i) {
                const long t = m0 + wm * 64 + tt * 32 + (l & 31); const int ch = blk * 64 + wn * 32 + 8 * i + 4 * (l >> 5);
                const float4 uv = *(const float4*)(U + t * 256 + ch);
                const float ua[4] = {uv.x, uv.y, uv.z, uv.w};
                float av[4], bv[4];
#pragma unroll
                for (int j = 0; j < 4; ++j) {
                    const float r = sigm_fast(acc[0][tt][4 * i + j] + w.ga_b[ch + j]), ig = sigm_fast(acc[1][tt][4 * i + j] + w.gx_b[ch + j]);
                    const float nl = -w.lam[ch + j];
                    const float sp = fmaxf(nl, 0.f) + __logf(1.f + __expf(-fabsf(nl)));
                    const float log_a = -8.0f * r * sp;
                    const float a = __expf(log_a);
                    av[j] = a; bv[j] = __builtin_amdgcn_sqrtf(fmaxf(1.f - a * a, 0.f)) * (ig * ua[j]);
                }
                *(float4*)(RA + t * 256 + ch) = make_float4(av[0], av[1], av[2], av[3]);
                *(float4*)(RB + t * 256 + ch) = make_float4(bv[0], bv[1], bv[2], bv[3]);
            }
    }
}
DI void job_rnn_scan1(const Params& p, int bid, int nblk) {
    const float* RA = WSF(WS_RA); const float* RB = WSF(WS_RB); float* SA = WSF(WS_SA); float* SH = WSF(WS_SH);
    for (int e = bid * NT + tidx(); e < BATCH * 32 * 256; e += nblk * NT) {
        const int ch = e & 255, bc = e >> 8;
        float ap = 1.f, hl = 0.f;
        for (int s0 = 0; s0 < 64; s0 += 8) {
            float av[8], bv[8];
#pragma unroll
            for (int i = 0; i < 8; ++i) { const long t = (long)bc * 64 + s0 + i; av[i] = RA[t * 256 + ch]; bv[i] = RB[t * 256 + ch]; }
#pragma unroll
            for (int i = 0; i < 8; ++i) { ap *= av[i]; hl = av[i] * hl + bv[i]; }
        }
        SA[e] = ap; SH[e] = hl;
    }
}
DI void job_rnn_scan2(const Params& p, int bid, int nblk) {
    const bf16_t* H = WSB(WS_H); const float* RA = WSF(WS_RA); const float* RB = WSF(WS_RB); const float* SA = WSF(WS_SA); const float* SH = WSF(WS_SH); bf16_t* BR = WSB(WS_BR);
    for (int e = bid * NT + tidx(); e < BATCH * 32 * 256; e += nblk * NT) {
        const int ch = e & 255, bc = e >> 8, chunk = bc & 31, b = bc >> 5;
        float h = 0.f;
#pragma unroll
        for (int c0 = 0; c0 < 32; c0 += 8) {
            float sa[8], sh[8];
#pragma unroll
            for (int i = 0; i < 8; ++i) { const int q = ((b * 32 + c0 + i) << 8) + ch; sa[i] = SA[q]; sh[i] = SH[q]; }
#pragma unroll
            for (int i = 0; i < 8; ++i) h = (c0 + i < chunk) ? sa[i] * h + sh[i] : h;
        }
        for (int s0 = 0; s0 < 64; s0 += 8) {
            float av[8], bv[8], gv[8];
#pragma unroll
            for (int i = 0; i < 8; ++i) { const long t = (long)bc * 64 + s0 + i; av[i] = RA[t * 256 + ch]; bv[i] = RB[t * 256 + ch]; gv[i] = bf2f(H[t * NH + O_CG + ch]); }
#pragma unroll
            for (int i = 0; i < 8; ++i) { const long t = (long)bc * 64 + s0 + i; h = av[i] * h + bv[i]; BR[t * 1024 + 2 * 256 + ch] = f2bf(h * gelu_tanh(gv[i])); }
        }
    }
}
DI void job_mla_norm(const Params& p, const LayerW& w, int bid, int nblk) {
    const bf16_t* H = WSB(WS_H); bf16_t* CQN = WSB(WS_CQNB); bf16_t* CKVN = WSB(WS_CKVNB); bf16_t* KM = WSB(WS_KM);
    const int lane = tidx() & 63, wid = tidx() >> 6;
    const bool isq = lane < 24, iskv = lane >= 32 && lane < 48;
    const int coff = isq ? O_DCQ + lane * 8 : O_DCKV + (lane - 32) * 8;
    float gn[8];
#pragma unroll
    for (int j = 0; j < 8; ++j) gn[j] = isq ? w.q_norm[lane * 8 + j] : (iskv ? w.kv_norm[(lane - 32) * 8 + j] : 0.f);
    for (int t = bid * (NT / 64) + wid; t < T; t += nblk * (NT / 64)) {
        const bf16_t* hr = H + (long)t * NH;
        float v[8];
        float ss = 0.f;
        if (isq || iskv) { ld8f(hr + coff, v);
#pragma unroll
            for (int j = 0; j < 8; ++j) ss += v[j] * v[j]; }
        const float sq = wave_sum(isq ? ss : 0.f), skv = wave_sum(iskv ? ss : 0.f);
        const float rs = isq ? rsqrtf(sq * (1.f / 192.f) + 1e-6f) : rsqrtf(skv * (1.f / 128.f) + 1e-6f);
        if (isq || iskv) {
#pragma unroll
            for (int j = 0; j < 8; ++j) v[j] = v[j] * rs * gn[j];
            if (isq) st8bf(CQN + (long)t * 192 + lane * 8, v); else st8bf(CKVN + (long)t * 128 + (lane - 32) * 8, v);
        }
        {
            const int i = lane & 15, hd = lane >> 4;
            const int s = t & (SEQ - 1);
            const float2 csn = *(const float2*)(WSF(WS_ROPE) + (s * 16 + i) * 2); const float cs = csn.x, sn = csn.y;
            const float x1 = bf2f(hr[O_DKR + i]), x2 = bf2f(hr[O_DKR + 16 + i]);
            KM[(long)t * 384 + hd * 96 + 64 + i] = f2bf(x1 * cs - x2 * sn);
            KM[(long)t * 384 + hd * 96 + 80 + i] = f2bf(x1 * sn + x2 * cs);
        }
    }
}
DI void job_mla_up(const Params& p, const LayerW& w, int bid, int nblk, unsigned char* lds) {
    bf16_t* QB = WSB(WS_QB); bf16_t* KM = WSB(WS_KM); bf16_t* VM = WSB(WS_VM);
    constexpr int TM = T / G_BM;
    for (int u = bid; u < TM * 7; u += nblk) {
        const int mt = u / 7, nt = u % 7, m0 = mt * G_BM;
        f32x16 acc[2][2];
        const int l = tidx() & 63, wv = tidx() >> 6, wm = wv % G_WM, wn = wv / G_WM, hh = l >> 5;
        if (nt < 3) {
            MG g; g.A = WSB(WS_CQNB); g.lda = 192; g.Wt = w.t_uq; g.ldw = 192; g.K = 192;
            const int n0 = nt * 128;
            mgemm_tile(g, n0, RowId{m0}, acc, lds);
#pragma unroll
            for (int ft = 0; ft < 2; ++ft) {
                const int fb = (n0 + wn * 64 + ft * 32) >> 5;
                if (fb % 3 == 2) {
#pragma unroll
                    for (int tt = 0; tt < 2; ++tt) {
                        const int pos = (m0 + wm * 64 + tt * 32 + (l & 31)) & (SEQ - 1);
#pragma unroll
                        for (int i = 0; i < 2; ++i)
#pragma unroll
                            for (int j = 0; j < 4; ++j) {
                                const int fi = 8 * i + 4 * hh + j;
                                const float2 csn = *(const float2*)(WSF(WS_ROPE) + (pos * 16 + fi) * 2); const float cs = csn.x, sn = csn.y;
                                const float x1 = acc[ft][tt][4 * i + j], x2 = acc[ft][tt][4 * (i + 2) + j];
                                acc[ft][tt][4 * i + j] = x1 * cs - x2 * sn; acc[ft][tt][4 * (i + 2) + j] = x1 * sn + x2 * cs;
                            }
                    }
                }
            }
            MG_FOREACH(acc, lrow, feat, v, { st4bf(QB + (long)(m0 + lrow) * 384 + n0 + feat, v[0], v[1], v[2], v[3]); });
        } else {
            MG g; g.A = WSB(WS_CKVNB); g.lda = 128; g.Wt = w.t_ukv; g.ldw = 128; g.K = 128;
            const int n0 = (nt - 3) * 128;
            mgemm_tile(g, n0, RowId{m0}, acc, lds);
            MG_FOREACH(acc, lrow, feat, v, {
                const int hd = nt - 3;
                if (feat < 64) st4bf(KM + (long)(m0 + lrow) * 384 + hd * 96 + feat, v[0], v[1], v[2], v[3]);
                else st4bf(VM + (long)(m0 + lrow) * 256 + hd * 64 + (feat - 64), v[0], v[1], v[2], v[3]); });
        }
    }
}
template <int STAGE>
DI void job_cmp_mlp(const Params& p, const LayerW& w, int bid, int nblk, unsigned char* lds) {
    constexpr int TM = 2048 / G_BM, TN = STAGE == 0 ? 2 : 1;
    for (int u = bid; u < 2 * TM * TN; u += nblk) {
        const int j = u / (TM * TN), ru = u % (TM * TN), mt = ru / TN, nt = ru % TN, m0 = mt * G_BM, n0 = nt * 128;
        MG g;
        if (STAGE == 0) { g.A = WSB(WS_TBB) + (size_t)j * 2048 * 2048; g.lda = 2048; g.Wt = w.t_c1 + (size_t)j * 256 * 2048; g.ldw = 2048; g.K = 2048; }
        else { g.A = WSB(WS_HIDB) + (size_t)j * 2048 * 256; g.lda = 256; g.Wt = w.t_c2 + (size_t)j * 128 * 256; g.ldw = 256; g.K = 256; }
        f32x16 acc[2][2];
        mgemm_tile(g, n0, [&](int r) { const int rr = m0 + r; return (long)(rr < NCR ? rr : NCR - 1); }, acc, lds);
        if (STAGE == 0) {
            bf16_t* HID = WSB(WS_HIDB) + (size_t)j * 2048 * 256;
            MG_FOREACH(acc, lrow, feat, v, { st4bf(HID + (long)(m0 + lrow) * 256 + n0 + feat, gelu_tanh(v[0]), gelu_tanh(v[1]), gelu_tanh(v[2]), gelu_tanh(v[3])); });
        } else {
            bf16_t* KC = WSB(WS_KCB) + (size_t)j * NCR * 64;
            MG_FOREACH(acc, lrow, feat, v, { if (feat < 64 && m0 + lrow < NCR) st4bf(KC + (long)(m0 + lrow) * 64 + feat, v[0], v[1], v[2], v[3]); });
        }
    }
}
DI void job_router_logits(const Params& p, const LayerW& w, int bid, int nblk, unsigned char* lds) {
    float* LOG = WSF(WS_LOG);
    for (int u = bid; u < 4 * (T / G_BM); u += nblk) {
        const int kq = u / (T / G_BM), m0 = (u % (T / G_BM)) * G_BM;
        f32x16 acc[2][2];
        MG g; g.lda = 1024; g.ldw = 1024; g.K = 256;
        g.A = WSB(WS_XBB) + kq * 256; g.Wt = w.t_rh + kq * 256;
        mgemm_tile(g, 0, RowId{m0}, acc, lds, true);
        float* dst = LOG + (size_t)kq * T * 36;
        MG_FOREACH(acc, lrow, feat, v, { if (feat < 36) *(float4*)(dst + (long)(m0 + lrow) * 36 + feat) = make_float4(v[0], v[1], v[2], v[3]); });
    }
}
DI void job_pack_small(const Params& p, int bid, int nblk) {
    bf16_t* TG = WSB(WT_G); bf16_t* RH = WSB(WT_RH); bf16_t* RL = WSB(WT_RL);
    for (int e = bid * NT + tidx(); e < SEQ * 16; e += nblk * NT) {
        const int i = e & 15, pos = e >> 4;
        const float inv = powf(10000.f, -(float)(2 * i) / 32.f);
        const float ang = (float)pos * inv;
        WSF(WS_ROPE)[e * 2] = cosf(ang); WSF(WS_ROPE)[e * 2 + 1] = sinf(ang);
    }
    for (int e = bid * NT + tidx(); e < DEPTH * 4 * 128 * 64; e += nblk * NT) {
        const int c = e & 63, q = (e >> 6) & 127, lb = e >> 13;
        const int seg = q >> 5, i = q & 31, chl = (seg >> 1) * 32 + i;
        const float* src = (seg & 1) ? p.in[10] : p.in[8];
        TG[e] = f2bf(src[((size_t)lb * 64 + c) * 64 + chl]);
    }
    for (int e = bid * NT + tidx(); e < DEPTH * 128 * 1024; e += nblk * NT) {
        const int k = e & 1023, n = (e >> 10) & 127, l = e >> 17;
        float v = 0.f;
        if (n < 4) v = p.in[26][((size_t)l * 1024 + k) * 4 + n];
        else if (n < 36) v = p.in[28][((size_t)l * 1024 + k) * 32 + (n - 4)];
        const bf16_t hi = f2bf(v);
        RH[e] = hi; RL[e] = f2bf(v - bf2f(hi));
    }
}

DI void job_merge(const Params& p, const LayerW& w, int bid, int nblk, unsigned char* lds) {
    const bf16_t* H = WSB(WS_H); bf16_t* M = WSB(WS_M);
    for (int u0 = bid; u0 < (T / G_BM) * 8; u0 += nblk) {
        int u = u0;
        if ((nblk & 7) == 0) { const int per = nblk >> 3, x = u0 & 7, q = u0 >> 3, ul = (q % per) + per * (q / per);
            u = ((x + 8 * (ul >> 3)) << 3) + (ul & 7); }
        const int m0 = (u >> 3) * G_BM, n0 = (u & 7) * G_BN;
        f32x16 macc[2][2];
#pragma unroll
        for (int a = 0; a < 2; ++a)
#pragma unroll
            for (int b = 0; b < 2; ++b)
#pragma unroll
                for (int i = 0; i < 16; ++i) macc[a][b][i] = 0.f;
        MG g; g.A = WSB(WS_BR); g.lda = 1024; g.Wt = w.t_br; g.ldw = 1024; g.K = 1024;
        f32x16 acc[2][2];
        uint2 gq[2][2][4];
        mgemm_tile_f(g, n0, RowId{m0}, acc, lds, true, 4, [&](int n, f32x16 (&a)[2][2]) {
#pragma unroll
            for (int ft = 0; ft < 2; ++ft)
#pragma unroll
                for (int tt = 0; tt < 2; ++tt)
#pragma unroll
                    for (int i = 0; i < 4; ++i) {
                        const uint2 q = gq[ft][tt][i];
                        macc[ft][tt][4 * i] += bflo(q.x) * a[ft][tt][4 * i]; macc[ft][tt][4 * i + 1] += bfhi(q.x) * a[ft][tt][4 * i + 1];
                        macc[ft][tt][4 * i + 2] += bflo(q.y) * a[ft][tt][4 * i + 2]; macc[ft][tt][4 * i + 3] += bfhi(q.y) * a[ft][tt][4 * i + 3];
                        a[ft][tt][4 * i] = 0.f; a[ft][tt][4 * i + 1] = 0.f; a[ft][tt][4 * i + 2] = 0.f; a[ft][tt][4 * i + 3] = 0.f;
                    }
        }, [&](int n) {
            const int l = tidx() & 63, wv = tidx() >> 6, wm = wv % G_WM, wn = wv / G_WM;
#pragma unroll
            for (int ft = 0; ft < 2; ++ft)
#pragma unroll
                for (int tt = 0; tt < 2; ++tt)
#pragma unroll
                    for (int i = 0; i < 4; ++i) {
                        const int lrow = wm * 64 + tt * 32 + (l & 31), feat = wn * 64 + ft * 32 + 8 * i + 4 * (l >> 5);
                        gq[ft][tt][i] = *(const uint2*)(H + (long)(m0 + lrow) * NH + O_MG + n * 1024 + n0 + feat);
                    }
        });
        MG_FOREACH(macc, lrow, feat, v, { st4bf(M + (long)(m0 + lrow) * 1024 + n0 + feat, v[0], v[1], v[2], v[3]); });
    }
}
DI int pad_rows(int c) { return (c + G_BM - 1) / G_BM * G_BM; }
DI void job_ln(const float* xin, const bf16_t* xinb, const bf16_t* xinl, const bf16_t* y, const int* eidx, const int* eslot, unsigned* cnt, const float* ew, const float* gw, const float* bw, float* out, bf16_t* outb, bf16_t* outl, int bid, int nblk, unsigned char* lds) {
    const int lane = tidx() & 63, wid = tidx() >> 6;
    int* s_base = (int*)lds;
    if (eidx) {
        __syncthreads();
        if (tidx() < 32) s_base[32 + tidx()] = pad_rows((int)__hip_atomic_load(&cnt[tidx()], __ATOMIC_RELAXED, __HIP_MEMORY_SCOPE_AGENT));
        __syncthreads();
        if (tidx() == 0) { int o = 0; for (int e = 0; e < 32; ++e) { s_base[e] = o; o += s_base[32 + e]; } }
        __syncthreads();
    }
    float gv[16], bv[16];
#pragma unroll
    for (int i = 0; i < 2; ++i)
#pragma unroll
        for (int j = 0; j < 8; j += 4) { const int c = i * 512 + lane * 8 + j; const float4 g4 = *(const float4*)(gw + c), b4 = *(const float4*)(bw + c);
            gv[i * 8 + j] = g4.x; gv[i * 8 + j + 1] = g4.y; gv[i * 8 + j + 2] = g4.z; gv[i * 8 + j + 3] = g4.w; bv[i * 8 + j] = b4.x; bv[i * 8 + j + 1] = b4.y; bv[i * 8 + j + 2] = b4.z; bv[i * 8 + j + 3] = b4.w; }
    for (int t = bid * (NT / 64) + wid; t < T; t += nblk * (NT / 64)) {
        float v[16];
        float s = 0.f;
        int r0 = 0, r1 = 0; float w0 = 0.f, w1 = 0.f;
        if (eidx) { r0 = s_base[eidx[t * 2]] + eslot[t * 2]; r1 = s_base[eidx[t * 2 + 1]] + eslot[t * 2 + 1]; w0 = ew[t * 2]; w1 = ew[t * 2 + 1]; }
#pragma unroll
        for (int i = 0; i < 2; ++i) {
            const int c = i * 512 + lane * 8;
            float xv[8], yv[8];
            if (xin) { const float4 a = *(const float4*)(xin + (long)t * 1024 + c), b = *(const float4*)(xin + (long)t * 1024 + c + 4);
                xv[0] = a.x; xv[1] = a.y; xv[2] = a.z; xv[3] = a.w; xv[4] = b.x; xv[5] = b.y; xv[6] = b.z; xv[7] = b.w; }
            else ld8f(xinb + (long)t * 1024 + c, xv);
            if (xinl) { float z[8]; ld8f(xinl + (long)t * 1024 + c, z);
#pragma unroll
                for (int j = 0; j < 8; ++j) xv[j] += z[j]; }
            if (!eidx) ld8f(y + (long)t * 1024 + c, yv);
            else { float z0[8], z1[8]; ld8f(y + (long)r0 * 1024 + c, z0); ld8f(y + (long)r1 * 1024 + c, z1);
#pragma unroll
                for (int j = 0; j < 8; ++j) yv[j] = w0 * z0[j] + w1 * z1[j]; }
#pragma unroll
            for (int j = 0; j < 8; ++j) { v[i * 8 + j] = DN_ALPHA * xv[j] + yv[j]; s += v[i * 8 + j]; }
        }
        float q = 0.f;
#pragma unroll
        for (int i = 0; i < 16; ++i) q += v[i] * v[i];
        wave_sum2(s, q);
        const float mu = s * (1.f / 1024.f);
        const float rstd = rsqrtf(fmaxf(q * (1.f / 1024.f) - mu * mu, 0.f) + 1e-5f);
#pragma unroll
        for (int i = 0; i < 2; ++i) {
            const int c = i * 512 + lane * 8;
            float o[8];
#pragma unroll
            for (int j = 0; j < 8; ++j) o[j] = (v[i * 8 + j] - mu) * rstd * gv[i * 8 + j] + bv[i * 8 + j];
            if (out) { *(float4*)(out + (long)t * 1024 + c) = make_float4(o[0], o[1], o[2], o[3]); *(float4*)(out + (long)t * 1024 + c + 4) = make_float4(o[4], o[5], o[6], o[7]); }
            if (outb) st8bf(outb + (long)t * 1024 + c, o);
            if (outl) { float lo[8];
#pragma unroll
                for (int j = 0; j < 8; ++j) lo[j] = o[j] - bf2f(f2bf(o[j]));
                st8bf(outl + (long)t * 1024 + c, lo); }
        }
    }
}
DI void job_router(const Params& p, const LayerW& w, int layer, int bid, int nblk) {
    const float* LOG = WSF(WS_LOG); int* EIDX = WSI(WS_EIDX); int* ESLOT = WSI(WS_ESLOT); float* EW = WSF(WS_EW);
    unsigned* cnt = WSU(WS_CTL) + CW_CNT + layer * 32;
    for (int t = bid * NT + tidx(); t < T; t += nblk * NT) {
        const float* lr = LOG + (long)t * 36; const float* lr1 = lr + (size_t)T * 36; const float* lr2 = lr1 + (size_t)T * 36; const float* lr3 = lr2 + (size_t)T * 36;
#define LG(i) ((lr[i] + lr1[i]) + (lr2[i] + lr3[i]))
        const float g0 = LG(0) + w.rg_b[0], g1 = LG(1) + w.rg_b[1], g2 = LG(2) + w.rg_b[2], g3 = LG(3) + w.rg_b[3];
        const float gm = fmaxf(fmaxf(g0, g1), fmaxf(g2, g3));
        const float e0 = expf(g0 - gm), e1 = expf(g1 - gm), e2 = expf(g2 - gm), e3 = expf(g3 - gm);
        const float gs = (e0 + e1) + (e2 + e3);
        const float p0 = e0 / gs, p1 = e1 / gs, p2 = e2 / gs, p3 = e3 / gs;
        int grp = 0; float pg = p0;
        if (p1 > pg) { pg = p1; grp = 1; }
        if (p2 > pg) { pg = p2; grp = 2; }
        if (p3 > pg) { pg = p3; grp = 3; }
        float el[8];
#pragma unroll
        for (int i = 0; i < 8; ++i) el[i] = LG(4 + grp * 8 + i) + w.re_b[grp * 8 + i];
#undef LG
        float em = el[0];
#pragma unroll
        for (int i = 1; i < 8; ++i) em = fmaxf(em, el[i]);
        float es = 0.f;
#pragma unroll
        for (int i = 0; i < 8; ++i) { el[i] = expf(el[i] - em); es += el[i]; }
#pragma unroll
        for (int i = 0; i < 8; ++i) el[i] = el[i] / es;
        float b0 = el[0]; int i0 = 0;
#pragma unroll
        for (int i = 1; i < 8; ++i) if (el[i] > b0) { b0 = el[i]; i0 = i; }
        float b1 = -1.f; int i1 = 0;
#pragma unroll
        for (int i = 0; i < 8; ++i) if (i != i0 && el[i] > b1) { b1 = el[i]; i1 = i; }
        const float den = b0 + b1;
        const int ex0 = grp * 8 + i0, ex1 = grp * 8 + i1;
        EIDX[t * 2] = ex0; EIDX[t * 2 + 1] = ex1;
        EW[t * 2] = pg * b0 / den; EW[t * 2 + 1] = pg * b1 / den;
        const int s0 = (int)atomicAdd(&cnt[ex0], 1u), s1 = (int)atomicAdd(&cnt[ex1], 1u);
        ESLOT[t * 2] = s0; ESLOT[t * 2 + 1] = s1;
        WSI(WS_PERM)[ex0 * PCAP + s0] = t * 2; WSI(WS_PERM)[ex1 * PCAP + s1] = t * 2 + 1;
    }
}
DI pg8::ListOrder moe_units(unsigned* cnt, int bid, int nblk, unsigned char* lds) {
    pg8::ListOrder S; S.n = 0; S.u0 = S.u1 = S.u2 = pg8::Unit{0, 0, 0, 0, 0};
    int* s_cnt = (int*)lds;
    __syncthreads();
    if (tidx() < 32) s_cnt[tidx()] = (int)__hip_atomic_load(&cnt[tidx()], __ATOMIC_RELAXED, __HIP_MEMORY_SCOPE_AGENT);
    __syncthreads();
    int rt = 0, ub = 0;
    for (int e = 0; e < 32; ++e) {
        const int ce = s_cnt[e];
        const int c = pad_rows(ce) >> 8, ue = c * 4;
#pragma unroll
        for (int k = 0; k < 3; ++k) {
            const int L = bid + k * nblk;
            if (L >= ub && L < ub + ue) { const int lu = L - ub, mt = lu >> 2; const int nv = ce - mt * 256 < 256 ? ce - mt * 256 : 256;
                const pg8::Unit u{rt + mt, lu & 3, e, e * (PCAP / 256) + mt, nv};
                if (k == 0) S.u0 = u; else if (k == 1) S.u1 = u; else S.u2 = u;
                S.n = k + 1; }
        }
        rt += c; ub += ue;
    }
#define RFL(x) x = __builtin_amdgcn_readfirstlane(x)
    RFL(S.n); RFL(S.u0.pm); RFL(S.u0.pn); RFL(S.u0.e); RFL(S.u0.gt); RFL(S.u0.nv); RFL(S.u1.pm); RFL(S.u1.pn); RFL(S.u1.e); RFL(S.u1.gt); RFL(S.u1.nv);
    RFL(S.u2.pm); RFL(S.u2.pn); RFL(S.u2.e); RFL(S.u2.gt); RFL(S.u2.nv);
#undef RFL
    return S;
}

typedef short s16x4 __attribute__((ext_vector_type(4)));
typedef short v4i16_t __attribute__((ext_vector_type(4)));
DI unsigned cvtpk(float lo, float hi) { return pk_bf16(lo, hi); }
DI int crow(int reg, int h) { return (reg & 3) + 8 * (reg >> 2) + 4 * h; }
DI s16x4 tr_read(const unsigned char* p) { return __builtin_bit_cast(s16x4, __builtin_amdgcn_ds_read_tr16_b64_v4i16((LAS v4i16_t*)p)); }
DI float xhalf_max(float m) { auto rr = __builtin_amdgcn_permlane32_swap(__float_as_uint(m), __float_as_uint(m), false, false); return fmaxf(__uint_as_float(rr[0]), __uint_as_float(rr[1])); }
DI float xhalf_sum(float m) { auto rr = __builtin_amdgcn_permlane32_swap(__float_as_uint(m), __float_as_uint(m), false, false); return __uint_as_float(rr[0]) + __uint_as_float(rr[1]); }
DI float xhalf_other(float v, int h) { auto rr = __builtin_amdgcn_permlane32_swap(__float_as_uint(v), __float_as_uint(v), false, false); return __uint_as_float(h ? rr[0] : rr[1]); }
DI bf16x8 pack8(const f32x16& x, int s2) {
    u32x4 pk; pk[0] = cvtpk(x[8 * s2], x[8 * s2 + 1]); pk[1] = cvtpk(x[8 * s2 + 2], x[8 * s2 + 3]); pk[2] = cvtpk(x[8 * s2 + 4], x[8 * s2 + 5]); pk[3] = cvtpk(x[8 * s2 + 6], x[8 * s2 + 7]);
    return __builtin_bit_cast(bf16x8, pk);
}
constexpr int ATT_QB = (NT / 64) * 32;
template <int DC> struct TileCfg { static constexpr int RS = DC * 2 + 16, BYTES = 64 * RS, NCH = 64 * DC / 8, NI = (NCH + NT - 1) / NT; };
template <int DC, class RowPtr> DI void tile_gload(u32x4 (&rg)[TileCfg<DC>::NI], RowPtr rp) {
#pragma unroll
    for (int i = 0; i < TileCfg<DC>::NI; ++i) { const int c = tidx() + NT * i; if (c < TileCfg<DC>::NCH) { const int row = c / (DC / 8), cc = c % (DC / 8); rg[i] = *(const u32x4*)(rp(row) + cc * 8); } }
}
template <int DC> DI void tile_lstore(const u32x4 (&rg)[TileCfg<DC>::NI], unsigned char* base) {
#pragma unroll
    for (int i = 0; i < TileCfg<DC>::NI; ++i) { const int c = tidx() + NT * i; if (c < TileCfg<DC>::NCH) { const int row = c / (DC / 8), cc = c % (DC / 8); *(u32x4*)(base + row * TileCfg<DC>::RS + cc * 16) = rg[i]; } }
}
template <int DK> DI void qk_tile(f32x16 (&s)[2], const bf16x8 (&qf)[DK / 16], const unsigned char* kl, int r, int h) {
    constexpr int RS = TileCfg<DK>::RS;
#pragma unroll
    for (int i = 0; i < 16; ++i) { s[0][i] = 0.f; s[1][i] = 0.f; }
#pragma unroll
    for (int ks = 0; ks < DK / 16; ++ks) {
        const bf16x8 k0 = *(const bf16x8*)(kl + r * RS + ks * 32 + h * 16), k1 = *(const bf16x8*)(kl + (32 + r) * RS + ks * 32 + h * 16);
        s[0] = __builtin_amdgcn_mfma_f32_32x32x16_bf16(k0, qf[ks], s[0], 0, 0, 0);
        s[1] = __builtin_amdgcn_mfma_f32_32x32x16_bf16(k1, qf[ks], s[1], 0, 0, 0);
    }
}
template <int DV> DI void pv_tile(f32x16 (&o)[DV / 32], const f32x16 (&pp)[2], const unsigned char* vl, int lane) {
    constexpr int RS = TileCfg<DV>::RS;
    const int h = lane >> 5, i16 = lane & 15, q = i16 >> 2, pq = i16 & 3, blk = (lane >> 4) & 1;
    const unsigned char* vb = vl + (4 * h + q) * RS + 2 * (16 * blk + 4 * pq);
#pragma unroll
    for (int kt = 0; kt < 2; ++kt)
#pragma unroll
        for (int s2 = 0; s2 < 2; ++s2) {
            const bf16x8 pf = pack8(pp[kt], s2);
#pragma unroll
            for (int dvt = 0; dvt < DV / 32; ++dvt) {
                const s16x4 lo = tr_read(vb + (kt * 32 + 16 * s2) * RS + dvt * 64), hi = tr_read(vb + (kt * 32 + 16 * s2 + 8) * RS + dvt * 64);
                const bf16x8 vf = __builtin_shufflevector(lo, hi, 0, 1, 2, 3, 4, 5, 6, 7);
                o[dvt] = __builtin_amdgcn_mfma_f32_32x32x16_bf16(vf, pf, o[dvt], 0, 0, 0);
            }
        }
}
constexpr float LOG2E = 1.4426950408889634f;
template <int DK, int DV, bool ALIBI, bool BOUNDARY, class ValidFn>
DI void softmax_tile(const bf16x8 (&qf)[DK / 16], f32x16 (&o)[DV / 32], float& m, float& l, const unsigned char* kl, const unsigned char* vl, int kb,
                     float c1, float sl2, int qpos, ValidFn valid, int lane) {
    const int r = lane & 31, h = lane >> 5;
    f32x16 s[2];
    qk_tile<DK>(s, qf, kl, r, h);
    const float base = ALIBI ? sl2 * (float)(kb + 4 * h - qpos) : 0.f;
    float tmax = -INFINITY;
#pragma unroll
    for (int kt = 0; kt < 2; ++kt)
#pragma unroll
        for (int i = 0; i < 16; ++i) {
            float v = ALIBI ? fmaf(s[kt][i], c1, fmaf(sl2, (float)(kt * 32 + (i & 3) + 8 * (i >> 2)), base)) : s[kt][i] * c1;
            if (BOUNDARY) v = valid(kb + kt * 32 + crow(i, h)) ? v : -INFINITY;
            s[kt][i] = v; tmax = fmaxf(tmax, v);
        }
    tmax = xhalf_max(tmax);
    const float mn = fmaxf(m, tmax);
    constexpr float RESCALE_THR = 8.0f;
    if (__any(mn - m > RESCALE_THR)) {
        const float corr = __builtin_amdgcn_exp2f(m - mn);
        l *= corr;
#pragma unroll
        for (int dvt = 0; dvt < DV / 32; ++dvt)
#pragma unroll
            for (int i = 0; i < 16; ++i) o[dvt][i] *= corr;
        m = mn;
    }
    float ps = 0.f;
#pragma unroll
    for (int kt = 0; kt < 2; ++kt)
#pragma unroll
        for (int i = 0; i < 16; ++i) { const float pr = __builtin_amdgcn_exp2f(s[kt][i] - m); s[kt][i] = pr; ps += pr; }
    l += ps;
    pv_tile<DV>(o, s, vl, lane);
}
template <int DK, int DV, bool ALIBI, class KPtr, class VPtr, class ValidFn, class InteriorFn>
DI void attn_stream(const bf16x8 (&qf)[DK / 16], f32x16 (&o)[DV / 32], float& m, float& l, unsigned tmask, int wave_qmax, int wave_kmin,
                    KPtr kp, VPtr vp, float c1, float sl2, int qpos, ValidFn valid, InteriorFn interior, unsigned char* lds) {
    unsigned char* kl = lds; unsigned char* vl = lds + TileCfg<DK>::BYTES;
    const int lane = tidx() & 63;
    u32x4 kA[TileCfg<DK>::NI], vA[TileCfg<DV>::NI], kB[TileCfg<DK>::NI], vB[TileCfg<DV>::NI];
    int ja = -1, jb = -1;
#define AS_NEXT(J, KR, VR) do { if (tmask) { J = __builtin_ctz(tmask); tmask &= tmask - 1; const int _j = J; \
        tile_gload<DK>(KR, [&](int row) { return kp(_j * 64 + row); }); tile_gload<DV>(VR, [&](int row) { return vp(_j * 64 + row); }); } else J = -1; } while (0)
#define AS_COMPUTE(J) do { const int _jc = (J); if (_jc * 64 <= wave_qmax && _jc * 64 + 63 >= wave_kmin) { \
        if (interior(_jc)) softmax_tile<DK, DV, ALIBI, false>(qf, o, m, l, kl, vl, _jc * 64, c1, sl2, qpos, valid, lane); \
        else softmax_tile<DK, DV, ALIBI, true>(qf, o, m, l, kl, vl, _jc * 64, c1, sl2, qpos, valid, lane); } } while (0)
    AS_NEXT(ja, kA, vA);
    AS_NEXT(jb, kB, vB);
    while (ja >= 0) {
        __syncthreads();
        tile_lstore<DK>(kA, kl); tile_lstore<DV>(vA, vl);
        __syncthreads();
        const int jc = ja;
        AS_NEXT(ja, kA, vA);
        AS_COMPUTE(jc);
        if (jb < 0) break;
        __syncthreads();
        tile_lstore<DK>(kB, kl); tile_lstore<DV>(vB, vl);
        __syncthreads();
        const int jd = jb;
        AS_NEXT(jb, kB, vB);
        AS_COMPUTE(jd);
    }
#undef AS_NEXT
#undef AS_COMPUTE
}

DI void job_mla_attn(const Params& p, int bid, int nblk, unsigned char* lds) {
    const bf16_t* QB = WSB(WS_QB); const bf16_t* KM = WSB(WS_KM); const bf16_t* VM = WSB(WS_VM); bf16_t* BR = WSB(WS_BR);
    constexpr int NQB = SEQ / ATT_QB, NU = BATCH * 4 * NQB;
    const int lane = tidx() & 63, wid = tidx() >> 6, r = lane & 31, h = lane >> 5;
    for (int u = bid; u < NU; u += nblk) {
        const int qblk = u / (BATCH * 4), bh = u % (BATCH * 4);
        const int b = bh >> 2, hd = bh & 3;
        const int q0 = qblk * ATT_QB, qw = q0 + wid * 32, qpos = qw + r;
        const long trow = (long)b * SEQ;
        bf16x8 qf[6];
#pragma unroll
        for (int ks = 0; ks < 6; ++ks) qf[ks] = *(const bf16x8*)(QB + (trow + qpos) * 384 + hd * 96 + ks * 16 + 8 * h);
        f32x16 o[2];
#pragma unroll
        for (int i = 0; i < 16; ++i) { o[0][i] = 0.f; o[1][i] = 0.f; }
        float m = -1e30f, l = 0.f;
        const int ntile = (q0 + ATT_QB - 1) / 64 + 1;
        const unsigned tmask = ntile >= 32 ? 0xffffffffu : ((1u << ntile) - 1u);
        attn_stream<96, 64, false>(qf, o, m, l, tmask, qw + 31, 0,
            [&](int row) { return KM + (trow + row) * 384 + hd * 96; },
            [&](int row) { return VM + (trow + row) * 256 + hd * 64; },
            0.10206207261596577f * LOG2E, 0.f, qpos,
            [&](int key) { return key <= qpos; }, [&](int j) { return j * 64 + 63 <= qw; }, lds);
        const float rl = 1.f / fmaxf(xhalf_sum(l), 1e-30f);
        bf16_t* dst = BR + (trow + qpos) * 1024 + 3 * 256 + hd * 64;
#pragma unroll
        for (int dvt = 0; dvt < 2; ++dvt)
#pragma unroll
            for (int i = 0; i < 4; ++i)
                st4bf(dst + dvt * 32 + 8 * i + 4 * h, o[dvt][4 * i] * rl, o[dvt][4 * i + 1] * rl, o[dvt][4 * i + 2] * rl, o[dvt][4 * i + 3] * rl);
    }
}
DI void job_cross_attn(const Params& p, int layer, int bid, int nblk, unsigned char* lds) {
    const bf16_t* XQ = WSB(WS_XQ); const bf16_t* KVM = WSB(WS_KVM) + (size_t)layer * 2048 * 1024; bf16_t* XO = WSB(WS_XO);
    constexpr int NQB = SEQ / ATT_QB, NU = BATCH * 4 * NQB;
    const int lane = tidx() & 63, wid = tidx() >> 6, r = lane & 31, h = lane >> 5;
    for (int u = bid; u < NU; u += nblk) {
        const int bh = u % (BATCH * 4), qblk = u / (BATCH * 4);
        const int b = bh >> 2, hd = bh & 3;
        const int qpos = qblk * ATT_QB + wid * 32 + r;
        const long trow = (long)b * SEQ;
        bf16x8 qf[8];
#pragma unroll
        for (int ks = 0; ks < 8; ++ks) qf[ks] = *(const bf16x8*)(XQ + (trow + qpos) * 512 + hd * 128 + ks * 16 + 8 * h);
        f32x16 o[4];
#pragma unroll
        for (int d = 0; d < 4; ++d)
#pragma unroll
            for (int i = 0; i < 16; ++i) o[d][i] = 0.f;
        float m = -1e30f, l = 0.f;
        attn_stream<128, 128, false>(qf, o, m, l, 0xFu, 1 << 30, 0,
            [&](int row) { return KVM + (long)(b * MEM_LEN + row) * 1024 + hd * 128; },
            [&](int row) { return KVM + (long)(b * MEM_LEN + row) * 1024 + 512 + hd * 128; },
            0.08838834764831845f * LOG2E, 0.f, qpos, [&](int) { return true; }, [&](int) { return true; }, lds);
        const float rl = 1.f / fmaxf(xhalf_sum(l), 1e-30f);
        bf16_t* dst = XO + (trow + qpos) * 512 + hd * 128;
#pragma unroll
        for (int dvt = 0; dvt < 4; ++dvt)
#pragma unroll
            for (int i = 0; i < 4; ++i)
                st4bf(dst + dvt * 32 + 8 * i + 4 * h, o[dvt][4 * i] * rl, o[dvt][4 * i + 1] * rl, o[dvt][4 * i + 2] * rl, o[dvt][4 * i + 3] * rl);
    }
}
DI float logsig_fast(float z) { return fminf(z, 0.f) - __logf(1.f + __expf(-fabsf(z))); }
DI void job_sb_attn(const Params& p, int bid, int nblk, unsigned char* lds) {
    const bf16_t* H = WSB(WS_H); bf16_t* BR = WSB(WS_BR);
    constexpr int NQB = SEQ / ATT_QB, NU = BATCH * 4 * NQB;
    const int lane = tidx() & 63, wid = tidx() >> 6, r = lane & 31, h = lane >> 5;
    unsigned char* kl = lds; unsigned char* vl = lds + TileCfg<64>::BYTES;
    for (int u = bid; u < NU; u += nblk) {
        const int half = u / (NU / 2), ru = u % (NU / 2);
        const int qi = ru / (BATCH * 4), bh = ru % (BATCH * 4);
        const int qblk = half == 0 ? (NQB - 1 - qi) : qi;
        const int b = bh >> 2, hd = bh & 3;
        const int q0 = qblk * ATT_QB, qw = q0 + wid * 32, qpos = qw + r;
        const long trow = (long)b * SEQ;
        bf16x8 qf[4];
#pragma unroll
        for (int ks = 0; ks < 4; ++ks) qf[ks] = *(const bf16x8*)(H + (trow + qpos) * NH + O_BQ + hd * 64 + ks * 16 + 8 * h);
        f32x16 o[2];
#pragma unroll
        for (int i = 0; i < 16; ++i) { o[0][i] = 0.f; o[1][i] = 0.f; }
        float trun = 0.f;
        int j = (q0 + ATT_QB - 1) >> 6;
        volatile int* flag = (volatile int*)(lds + 2 * TileCfg<64>::BYTES);
        if (tidx() == 0) { flag[0] = 0; flag[1] = 0; }
        u32x4 kr[TileCfg<64>::NI], vr[TileCfg<64>::NI];
        tile_gload<64>(kr, [&](int row) { return H + (trow + j * 64 + row) * NH + O_BK + hd * 64; });
        tile_gload<64>(vr, [&](int row) { return H + (trow + j * 64 + row) * NH + O_BV + hd * 64; });
        for (int it = 0; j >= 0; --j, ++it) {
            __syncthreads();
            if (it > 0 && flag[(it - 1) & 1] == 0) break;
            tile_lstore<64>(kr, kl); tile_lstore<64>(vr, vl);
            __syncthreads();
            if (tidx() == 0) flag[(it + 1) & 1] = 0;
            if (j > 0) { const int jn = j - 1;
                tile_gload<64>(kr, [&](int row) { return H + (trow + jn * 64 + row) * NH + O_BK + hd * 64; });
                tile_gload<64>(vr, [&](int row) { return H + (trow + jn * 64 + row) * NH + O_BV + hd * 64; }); }
            const bool wave_dead = __all(trun < -110.f);
            if (j * 64 < qw + 31 && !wave_dead) {
                const int kb = j * 64;
                f32x16 s[2], L[2];
                qk_tile<64>(s, qf, kl, r, h);
#pragma unroll
                for (int kt = 0; kt < 2; ++kt)
#pragma unroll
                    for (int i = 0; i < 16; ++i) {
                        const int key = kb + kt * 32 + crow(i, h);
                        const float z = s[kt][i] * 0.125f, lsp = logsig_fast(z);
                        const bool valid = key < qpos;
                        L[kt][i] = valid ? lsp - z : 0.f;
                        s[kt][i] = valid ? lsp : -INFINITY;
                    }
                float G[2][4], O[2][4];
#pragma unroll
                for (int kt = 0; kt < 2; ++kt)
#pragma unroll
                    for (int ig = 0; ig < 4; ++ig) { G[kt][ig] = (L[kt][4 * ig] + L[kt][4 * ig + 1]) + (L[kt][4 * ig + 2] + L[kt][4 * ig + 3]); O[kt][ig] = xhalf_other(G[kt][ig], h); }
                float run = trun;
#pragma unroll
                for (int kt = 1; kt >= 0; --kt)
#pragma unroll
                    for (int ig = 3; ig >= 0; --ig) {
                        const float t3 = run + (h == 0 ? O[kt][ig] : 0.f);
                        const float t2 = t3 + L[kt][4 * ig + 3], t1 = t2 + L[kt][4 * ig + 2], t0 = t1 + L[kt][4 * ig + 1];
                        s[kt][4 * ig + 3] = __expf(s[kt][4 * ig + 3] + t3); s[kt][4 * ig + 2] = __expf(s[kt][4 * ig + 2] + t2);
                        s[kt][4 * ig + 1] = __expf(s[kt][4 * ig + 1] + t1); s[kt][4 * ig + 0] = __expf(s[kt][4 * ig + 0] + t0);
                        run += G[kt][ig] + O[kt][ig];
                    }
                trun = run;
                pv_tile<64>(o, s, vl, lane);
            }
            if (!__all(trun < -110.f)) flag[it & 1] = 1;
        }
        bf16_t* dst = BR + (trow + qpos) * 1024 + 1 * 256 + hd * 64;
#pragma unroll
        for (int dvt = 0; dvt < 2; ++dvt)
#pragma unroll
            for (int i = 0; i < 4; ++i) st4bf(dst + dvt * 32 + 8 * i + 4 * h, o[dvt][4 * i], o[dvt][4 * i + 1], o[dvt][4 * i + 2], o[dvt][4 * i + 3]);
    }
}
constexpr int NSA_QB = (NT / 128) * 32;
DI void job_nsa(const Params& p, int bid, int nblk, unsigned char* lds) {
    const bf16_t* H = WSB(WS_H); const bf16_t* KCB = WSB(WS_KCB); const bf16_t* VCB = KCB + (size_t)NCR * 64;
    float* OACC = WSF(WS_OC); bf16_t* BR = WSB(WS_BR);
    constexpr int NQB = SEQ / NSA_QB, NU = BATCH * 2 * NQB;
    constexpr int TB_ = TileCfg<64>::BYTES;
    const int lane = tidx() & 63, wid = tidx() >> 6, r = lane & 31, h = lane >> 5;
    const int n = wid & 1, sub = wid >> 1;
    unsigned* orw = (unsigned*)(lds + 4 * TB_);
    float* impx = (float*)(lds + 4 * TB_ + 64);
    for (int u = bid; u < NU; u += nblk) {
        const int qblk = NQB - 1 - u / (BATCH * 2), bg = u % (BATCH * 2), b = bg >> 1, g = bg & 1;
        const int q0 = qblk * NSA_QB, qw = q0 + sub * 32, qpos = qw + r;
        const int head = g * 2 + n;
        const long trow = (long)b * SEQ;
        const bf16_t* hq_row = H + (trow + qpos) * NH;
        bf16x8 qf[1][4];
#pragma unroll
        for (int ks = 0; ks < 4; ++ks) qf[0][ks] = *(const bf16x8*)(hq_row + O_AQ + head * 64 + ks * 16 + 8 * h);
        const float sl = exp2f(-2.f * (float)(head + 1));
        const float gate0 = sigm(bf2f(hq_row[O_AG + head * 3 + 0])), gate1 = sigm(bf2f(hq_row[O_AG + head * 3 + 1])), gate2 = sigm(bf2f(hq_row[O_AG + head * 3 + 2]));
        float* oacc = OACC + (trow + qpos) * 256 + head * 64;
        __syncthreads();
        if (tidx() == 0) *orw = 0u;
        {
            u32x4 rg[TileCfg<64>::NI];
#pragma unroll
            for (int tl = 0; tl < 4; ++tl) {
                const bf16_t* src = (tl & 2) ? VCB : KCB; const int cb = (tl & 1) * 64;
                tile_gload<64>(rg, [&](int row) { const int c = cb + row < NCMP ? cb + row : NCMP - 1; return src + ((long)(b * NCMP + c) * 2 + g) * 64; });
                tile_lstore<64>(rg, lds + tl * TB_);
            }
        }
        __syncthreads();
        float imp[16];
        {
            f32x16 s[2][2];
            qk_tile<64>(s[0], qf[0], lds, r, h);
            qk_tile<64>(s[1], qf[0], lds + TB_, r, h);
            float tmax = -INFINITY;
#pragma unroll
            for (int tl = 0; tl < 2; ++tl)
#pragma unroll
                for (int kt = 0; kt < 2; ++kt)
#pragma unroll
                    for (int i = 0; i < 16; ++i) {
                        const int c = tl * 64 + kt * 32 + crow(i, h), dist = qpos - (16 * c + 31);
                        const float v = (c < NCMP && dist >= 0) ? s[tl][kt][i] * 0.125f - sl * (float)dist : -INFINITY;
                        s[tl][kt][i] = v; tmax = fmaxf(tmax, v);
                    }
            const float mn = fmaxf(xhalf_max(tmax), -1e30f);
            float ps = 0.f;
#pragma unroll
            for (int tl = 0; tl < 2; ++tl)
#pragma unroll
                for (int kt = 0; kt < 2; ++kt)
#pragma unroll
                    for (int i = 0; i < 16; ++i) { const float pr = __expf(s[tl][kt][i] - mn); s[tl][kt][i] = pr; ps += pr; }
            const float rl = 1.f / fmaxf(xhalf_sum(ps), 1e-30f);
            float P3[16];
#pragma unroll
            for (int tl = 0; tl < 2; ++tl)
#pragma unroll
                for (int kt = 0; kt < 2; ++kt) {
#pragma unroll
                    for (int ig = 0; ig < 4; ++ig) {
                        const float p0 = s[tl][kt][4 * ig] * rl, p1 = s[tl][kt][4 * ig + 1] * rl, p2 = s[tl][kt][4 * ig + 2] * rl, p3 = s[tl][kt][4 * ig + 3] * rl;
                        imp[tl * 8 + kt * 4 + ig] = (p0 + p1) + (p2 + 0.5f * p3);
                        P3[tl * 8 + kt * 4 + ig] = 0.5f * p3;
                    }
                    const float gs = rl * gate0;
#pragma unroll
                    for (int i = 0; i < 16; ++i) s[tl][kt][i] *= gs;
                }
#pragma unroll
            for (int idx = 0; idx < 16; ++idx) {
                const float pp = xhalf_other(P3[idx], h);
                float prevp;
                if (idx == 0) prevp = h ? pp : 0.f; else { const float ppm = xhalf_other(P3[idx - 1], h); prevp = h ? pp : ppm; }
                imp[idx] += prevp;
                impx[(wid * 16 + idx) * 64 + lane] = imp[idx];
            }
            f32x16 oc[2];
#pragma unroll
            for (int i = 0; i < 16; ++i) { oc[0][i] = 0.f; oc[1][i] = 0.f; }
            pv_tile<64>(oc, s[0], lds + 2 * TB_, lane);
            pv_tile<64>(oc, s[1], lds + 3 * TB_, lane);
#pragma unroll
            for (int dvt = 0; dvt < 2; ++dvt)
#pragma unroll
                for (int i = 0; i < 4; ++i) *(float4*)(oacc + dvt * 32 + 8 * i + 4 * h) = make_float4(oc[dvt][4 * i], oc[dvt][4 * i + 1], oc[dvt][4 * i + 2], oc[dvt][4 * i + 3]);
        }
        __syncthreads();
        unsigned sel = 0u;
        {
            const int cur = qpos >> 6;
#pragma unroll
            for (int idx = 0; idx < 16; ++idx) {
                const float other = impx[((wid ^ 1) * 16 + idx) * 64 + lane];
                const float tot = n == 0 ? imp[idx] + other : other + imp[idx];
                const int j = 2 * idx + h;
                const bool forced = (j == 0) || (j == cur), valid = (j * 64 <= qpos);
                imp[idx] = forced ? 1e4f : (valid ? tot : -1.0f);
            }
#pragma unroll 1
            for (int it = 0; it < 8; ++it) {
                float best = -INFINITY; int bj = 64;
#pragma unroll
                for (int idx = 0; idx < 16; ++idx) if (imp[idx] > best) { best = imp[idx]; bj = 2 * idx + h; }
                const float pb = xhalf_other(best, h); const int pj = __float_as_int(xhalf_other(__int_as_float(bj), h));
                const bool own = (best > pb) || (best == pb && bj < pj);
                const int wj = own ? bj : pj;
                sel |= 1u << wj;
#pragma unroll
                for (int idx = 0; idx < 16; ++idx) if (2 * idx + h == wj) imp[idx] = -INFINITY;
            }
        }
        atomicOr(orw, sel);
        __syncthreads();
        const unsigned bmask = *orw;
        const int jhi = (q0 + NSA_QB - 1) >> 6;
        const unsigned upto = jhi >= 31 ? 0xffffffffu : ((1u << (jhi + 1)) - 1u);
        const float c1 = 0.125f * LOG2E, sl2 = sl * LOG2E;
        {
            f32x16 o[2];
#pragma unroll
            for (int i = 0; i < 16; ++i) { o[0][i] = 0.f; o[1][i] = 0.f; }
            float m = -1e30f, l = 0.f;
            const int jlo = (q0 - 511 > 0 ? q0 - 511 : 0) >> 6;
            const unsigned tmask = upto & ~((1u << jlo) - 1u);
            attn_stream<64, 64, true>(qf[0], o, m, l, tmask, qw + 31, qw - 511,
                [&](int row) { return H + (trow + row) * NH + O_AKW + g * 64; },
                [&](int row) { return H + (trow + row) * NH + O_AVW + g * 64; },
                c1, sl2, qpos,
                [&](int key) { const int dist = qpos - key; return dist >= 0 && dist < 512; },
                [&](int j) { return j * 64 + 63 <= qw && qw + 31 - j * 64 < 512; }, lds);
            const float rl = gate2 / fmaxf(xhalf_sum(l), 1e-30f);
#pragma unroll
            for (int dvt = 0; dvt < 2; ++dvt)
#pragma unroll
                for (int i = 0; i < 4; ++i) { float4* a = (float4*)(oacc + dvt * 32 + 8 * i + 4 * h); float4 c = *a;
                    c.x += o[dvt][4 * i] * rl; c.y += o[dvt][4 * i + 1] * rl; c.z += o[dvt][4 * i + 2] * rl; c.w += o[dvt][4 * i + 3] * rl; *a = c; }
        }
        {
            f32x16 o[2];
#pragma unroll
            for (int i = 0; i < 16; ++i) { o[0][i] = 0.f; o[1][i] = 0.f; }
            float m = -1e30f, l = 0.f;
            attn_stream<64, 64, true>(qf[0], o, m, l, bmask & upto, qw + 31, 0,
                [&](int row) { return H + (trow + row) * NH + O_AKS + g * 64; },
                [&](int row) { return H + (trow + row) * NH + O_AVS + g * 64; },
                c1, sl2, qpos,
                [&](int key) { return key <= qpos && ((sel >> (key >> 6)) & 1u); },
                [&](int j) { return j * 64 + 63 <= qw && __all((sel >> j) & 1u); }, lds);
            const float rl = gate1 / fmaxf(xhalf_sum(l), 1e-30f);
            bf16_t* dst = BR + (trow + qpos) * 1024 + head * 64;
#pragma unroll
            for (int dvt = 0; dvt < 2; ++dvt)
#pragma unroll
                for (int i = 0; i < 4; ++i) { const float4 c = *(const float4*)(oacc + dvt * 32 + 8 * i + 4 * h);
                    st4bf(dst + dvt * 32 + 8 * i + 4 * h, c.x + o[dvt][4 * i] * rl, c.y + o[dvt][4 * i + 1] * rl, c.z + o[dvt][4 * i + 2] * rl, c.w + o[dvt][4 * i + 3] * rl); }
        }
    }
}

namespace pg8 { typedef PG8_LAS unsigned char* PG8_LAS_T; }
#define LDS3 ((pg8::PG8_LAS_T)lds)
#define GEMM256(EPI, SCHED, g, S, E) do { __syncthreads(); pg8::gemm_phase<EPI, SCHED, true, true>(LDS3, g, S, E); } while (0)
constexpr int NPH = 17;
constexpr int NPHASES = 2 + DEPTH * NPH;

__global__ void __launch_bounds__(NT, 2) mega(Params pk, int ph_lo, int ph_hi) {
    extern __shared__ __attribute__((aligned(16))) unsigned char lds[];
    const int bid = blockIdx.x, nblk = gridDim.x;
#define XB_HERE XcdBarrier bar_; bar_.bar = (unsigned*)(pk.ws + WS_CTL) + CW_BAR; bar_.x = xb_xcc_id(); bar_.st = (volatile LAS unsigned*)(lds + 131072)
    const bool multi = (ph_hi - ph_lo) > 1;
    if (multi) {
        uint4* xbw = (uint4*)(lds + 131072);
        if (tidx() == 0) *xbw = make_uint4(0u, 0u, 0u, 0u);
        __syncthreads();
        (void)xcd_barrier_post((unsigned*)(pk.ws + WS_CTL) + CW_BAR, (volatile LAS unsigned*)xbw);
    }
#ifndef PROBE_PH
#define PROBE_PH -100
#endif
#define PHASE(id, ...) do { const int _id = (id); if (ph_lo <= _id && _id < ph_hi) { for (int _rep = 0; _rep < ((PROBE_PH == -1 ? _id < 2 : (_id >= 2 && (_id - 2) % NPH == PROBE_PH)) ? 2 : 1); ++_rep) { if (_rep) { XB_HERE; xcd_barrier(bar_); } { Params p = pk; int layer = layer_; asm volatile("" : "+s"(p.ws), "+s"(p.out), "+s"(layer)); \
        const LayerW w = layer_w(p, layer); const float* Xin = (layer == 0) ? p.in[0] : WSF(WS_XC); const bf16_t* XinB = (layer == 0) ? WSB(WS_X0B) : WSB(WS_XCB); float* Xout = (layer == DEPTH - 1) ? p.out : WSF(WS_XC); \
        (void)w; (void)Xin; (void)XinB; (void)Xout; __VA_ARGS__; } } if (_id + 1 < ph_hi) { XB_HERE; xcd_barrier(bar_); } } } while (0)

    { const int layer_ = 0;
    PHASE(0, {
        job_wt<2>(p.in[2], DEPTH, 1024, NIN, WSB(WT_IN), NH, bid, nblk, lds);
        job_wt<0>(p.in[17], DEPTH, 1024, 1024, WSB(WT_BR), 1024, bid, nblk, lds);
        job_wt<0>(p.in[18], DEPTH, 1024, 1024, WSB(WT_OUT), 1024, bid, nblk, lds);
        job_wt<0>(p.in[21], DEPTH, 1024, 512, WSB(WT_Q), 512, bid, nblk, lds);
        job_wt<0>(p.in[22], DEPTH, 1024, 1024, WSB(WT_KV), 1024, bid, nblk, lds);
        job_wt<0>(p.in[23], DEPTH, 512, 1024, WSB(WT_O), 1024, bid, nblk, lds);
        job_wt<1>(p.in[30], DEPTH * 32, 1024, 1024, WSB(WT_GU), 1024, bid, nblk, lds);
        job_wt<0>(p.in[31], DEPTH * 32, 512, 1024, WSB(WT_DN), 1024, bid, nblk, lds);
        job_wt<0>(p.in[4], DEPTH * 2, 2048, 256, WSB(WT_C1), 256, bid, nblk, lds);
        job_wt<0>(p.in[5], DEPTH * 2, 256, 64, WSB(WT_C2), 128, bid, nblk, lds);
        job_wt<0>(p.in[15], DEPTH, 192, 384, WSB(WT_UQ), 384, bid, nblk, lds);
        job_wt<0>(p.in[16], DEPTH, 128, 512, WSB(WT_UKV), 512, bid, nblk, lds);
        job_pack_small(p, bid, nblk);
        job_cvt(p.in[0], WSB(WS_X0B), (long)T * 1024, bid, nblk);
        job_cvt(p.in[1], WSB(WS_MEMB), (long)2048 * 1024, bid, nblk);
    });
    PHASE(1, {
        pg8::Gemm g{WSB(WS_MEMB), WSB(WT_KV), BATCH * MEM_LEN, 1024, 1024, nullptr};
        GroupedOrder S{8, 4, DEPTH, nblk, bid};
        EpiStoreBf16 E{WSB(WS_KVM), 1024, 1 << 30, (long)2048 * 1024};
        GEMM256(EpiStoreBf16, GroupedOrder, g, S, E);
    });
    }
    for (int layer_ = 0; layer_ < DEPTH; ++layer_) {
        const int base = 2 + layer_ * NPH;
        PHASE(base + 0, { pg8::Gemm g{XinB, w.t_in, T, NH, 1024, nullptr}; pg8::StaticOrder S; S.init(T, NH, nblk, bid); EpiStoreBf16 E{WSB(WS_H), NH, O_MG / 128, 0}; GEMM256(EpiStoreBf16, pg8::StaticOrder, g, S, E); });
        PHASE(base + 1, { job_sb_attn(p, bid, nblk, lds); job_cmp_gather(p, w, bid, nblk); job_rnn_conv(p, w, bid, nblk); job_mla_norm(p, w, bid, nblk); });
        PHASE(base + 2, { if (bid < 32) job_cmp_mlp<0>(p, w, bid, 32, lds); else { job_rnn_gates(p, w, bid - 32, nblk - 32, lds); job_mla_up(p, w, bid - 32, nblk - 32, lds); } });
        PHASE(base + 3, { job_cmp_mlp<1>(p, w, bid, nblk, lds); job_rnn_scan1(p, bid, nblk); });
        PHASE(base + 4, { job_nsa(p, bid, nblk, lds); job_mla_attn(p, bid, nblk, lds); job_rnn_scan2(p, bid, nblk); });
        PHASE(base + 5, { job_merge(p, w, bid, nblk, lds); });
        PHASE(base + 6, { pg8::Gemm g{WSB(WS_M), w.t_out, T, 1024, 1024, nullptr}; pg8::StaticOrder S; S.init(T, 1024, nblk, bid); EpiStoreBf16 E{WSB(WS_Y), 1024, 1 << 30, 0}; GEMM256(EpiStoreBf16, pg8::StaticOrder, g, S, E); });
        PHASE(base + 7, { job_ln(layer == 0 ? p.in[0] : nullptr, WSB(WS_XCB), nullptr, WSB(WS_Y), nullptr, nullptr, nullptr, nullptr, w.ln1_g, w.ln1_b, nullptr, WSB(WS_XAB), nullptr, bid, nblk, lds); });
        PHASE(base + 8, { pg8::Gemm g{WSB(WS_XAB), w.t_q, T, 512, 1024, nullptr}; pg8::StaticOrder S; S.init(T, 512, nblk, bid); EpiStoreBf16 E{WSB(WS_XQ), 512, 1 << 30, 0}; GEMM256(EpiStoreBf16, pg8::StaticOrder, g, S, E); });
        PHASE(base + 9, { job_cross_attn(p, layer, bid, nblk, lds); });
        PHASE(base + 10, { pg8::Gemm g{WSB(WS_XO), w.t_o, T, 1024, 512, nullptr}; pg8::StaticOrder S; S.init(T, 1024, nblk, bid); EpiStoreBf16 E{WSB(WS_Y), 1024, 1 << 30, 0}; GEMM256(EpiStoreBf16, pg8::StaticOrder, g, S, E); });
        PHASE(base + 11, { job_ln(nullptr, WSB(WS_XAB), nullptr, WSB(WS_Y), nullptr, nullptr, nullptr, nullptr, w.ln2_g, w.ln2_b, nullptr, WSB(WS_XBB), nullptr, bid, nblk, lds); });
        PHASE(base + 12, { job_router_logits(p, w, bid, nblk, lds); });
        PHASE(base + 13, { job_router(p, w, layer, bid, nblk); });
        PHASE(base + 14, { const pg8::ListOrder S = moe_units(WSU(WS_CTL) + CW_CNT + layer * 32, bid, nblk, lds); pg8::Gemm g{WSB(WS_XBB), w.t_gu, PADROWS, 1024, 1024, WSI(WS_PERM)}; EpiMoeGU E{WSB(WS_HH)}; __syncthreads(); pg8::gemm_phase<EpiMoeGU, pg8::ListOrder, true, true, true>(LDS3, g, S, E); });
        PHASE(base + 15, { const pg8::ListOrder S = moe_units(WSU(WS_CTL) + CW_CNT + layer * 32, bid, nblk, lds); pg8::Gemm g{WSB(WS_HH), w.t_dn, PADROWS, 1024, 512, nullptr}; EpiStoreBf16 E{WSB(WS_YK), 1024, 1 << 30, 0}; GEMM256(EpiStoreBf16, pg8::ListOrder, g, S, E); });
        PHASE(base + 16, { job_ln(nullptr, WSB(WS_XBB), nullptr, WSB(WS_YK), WSI(WS_EIDX), WSI(WS_ESLOT), WSU(WS_CTL) + CW_CNT + layer * 32, WSF(WS_EW), w.ln3_g, w.ln3_b, (layer == DEPTH - 1) ? p.out : nullptr, (layer == DEPTH - 1) ? nullptr : WSB(WS_XCB), nullptr, bid, nblk, lds); });
    }
}

extern "C" void kernel_launch(void* const* d_in, const int* in_sizes, int n_in, void* d_out, int out_size, void* d_ws, size_t ws_size, hipStream_t stream) {
    constexpr size_t kDynLds = 131072 + 1024;
    static_assert(2 * G_STAGE + 1024 <= 131072, "engine stages fit");
    static int grid = 0;
    if (!grid) {
        int dev = 0, cus = 0, per_cu = 0;
        (void)hipGetDevice(&dev);
        (void)hipDeviceGetAttribute(&cus, hipDeviceAttributeMultiprocessorCount, dev);
        (void)hipFuncSetAttribute((const void*)mega, hipFuncAttributeMaxDynamicSharedMemorySize, (int)kDynLds);
        (void)hipOccupancyMaxActiveBlocksPerMultiprocessor(&per_cu, mega, NT, kDynLds);
        if (per_cu < 1) per_cu = 1;
        grid = cus * (per_cu < 2 ? per_cu : 2);
    }
    if (ws_size < WS_END) { fprintf(stderr, "workspace too small: %zu < %zu\n", ws_size, (size_t)WS_END); return; }
    Params p{};
    for (int i = 0; i < 34; ++i) p.in[i] = (const float*)d_in[i];
    p.out = (float*)d_out;
    p.ws = (unsigned char*)d_ws;
    (void)hipMemsetAsync(d_ws, 0, CTL_BYTES, stream);
#if MK_ONE_LAUNCH
    hipLaunchKernelGGL(mega, dim3(grid), dim3(NT), kDynLds, stream, p, 0, NPHASES);
#else
    for (int ph = 0; ph < NPHASES; ++ph) hipLaunchKernelGGL(mega, dim3(grid), dim3(NT), kDynLds, stream, p, ph, ph + 1);
#endif
}
```
